# Optimizing an MI355X kernel written in HIP

```python
import jax, jax.numpy as jnp
from jax import lax
import numpy as np

D_MODEL = 1024
BATCH = 4
SEQ = 8192
DEPTH = 4

GRID_W = 64
CTX_LEN = 256
N_MIXERS = 2
RWKV_SLOT = 0
N_RWKV_LAYERS = (DEPTH + N_MIXERS - 1) // N_MIXERS
N_CONV_LAYERS = DEPTH // N_MIXERS
HEAD_SIZE = 64
N_HEADS = D_MODEL // HEAD_SIZE
DECAY_LORA = D_MODEL // 16
ICLR_LORA = D_MODEL // 16
GATE_LORA = D_MODEL // 8
GN_EPS = HEAD_SIZE * 1e-5
CONV_WIDTH = 3
N_EXPERTS = 32
TOP_K = 4
D_FF = D_MODEL
SWIGLU_LIMIT = 7.0
SWIGLU_ALPHA = 1.702
EXPERT_BLOCK = 256
RMS_EPS = 1e-6
N_MOD = 6

kernel_name = 'hybrid_rwkv7_shortconv_moe_dit'


def rmsnorm(x, g):
    xf = x.astype(jnp.float32)
    y = xf * lax.rsqrt(jnp.mean(xf * xf, axis=-1, keepdims=True) + RMS_EPS)
    return (y * g.astype(jnp.float32)).astype(x.dtype)


def ada_mods(cond, w, b):
    mods = jax.nn.silu(cond) @ w + b
    return jnp.split(mods[:, None, :], N_MOD, axis=-1)


def modulate(x, g, shift, scale):
    return rmsnorm(x, g) * (1 + scale) + shift


def row_neighbours(x, n_rows):
    b, l, ch = x.shape
    rows = jnp.pad(x.reshape(b, n_rows, l // n_rows, ch), ((0, 0), (0, 0), (1, 1), (0, 0)))
    return rows[:, :, :-2].reshape(b, l, ch), rows[:, :, 2:].reshape(b, l, ch)


def split_heads(t):
    return t.reshape(t.shape[:-1] + (N_HEADS, HEAD_SIZE))


def rwkv_streams(h, n_rows, mu, w_rkv, w0, w1, w2, a0, a1, a2, g1, g2, k_k, k_a, readout):
    f32 = jnp.float32
    x_prev, x_next = row_neighbours(h, n_rows)
    d_prev, d_next = x_prev - h, x_next - h

    def lerp(j):
        return h + mu[j, 0] * d_prev + mu[j, 1] * d_next

    k = (lerp(1) @ w_rkv[1]).astype(f32)
    v = split_heads((lerp(2) @ w_rkv[2]).astype(f32))
    xw, xa = lerp(3), lerp(4)
    w_log = w0[:, None, None, :] + jnp.einsum(
        'eblr,erd->ebld', jnp.tanh(jnp.einsum('bld,edr->eblr', xw, w1)), w2)
    decay = jnp.exp(-jnp.exp(-jax.nn.softplus(-w_log.astype(f32)) - 0.5))
    a = jax.nn.sigmoid((a0[:, None, None, :] + jnp.einsum(
        'eblr,erd->ebld', jnp.einsum('bld,edr->eblr', xa, a1), a2)).astype(f32))
    kk = split_heads(k * k_k)
    kk = kk / jnp.maximum(jnp.sqrt(jnp.sum(kk * kk, axis=-1, keepdims=True)), 1e-12)
    k_dir = split_heads(k * (1 + (a - 1) * k_a))
    s = {'decay': split_heads(decay), 'a': split_heads(a), 'k': k_dir, 'v': v, 'kk': kk}
    if readout:
        s['r'] = split_heads((lerp(0) @ w_rkv[0]).astype(f32))
        s['g'] = jax.nn.sigmoid(lerp(5) @ g1) @ g2
    return s


def wkv_scan(state0, s, d, reverse, readout):
    xs = [s['decay'][d], s['k'][d], s['v'], s['kk'], s['a'][d]] + ([s['r']] if readout else [])
    xs = tuple(jnp.moveaxis(t, 1, 0) for t in xs)

    def step(S, inp):
        w_t, k_t, v_t, kk_t, a_t = inp[:5]
        sa = jnp.einsum('bhvk,bhk->bhv', S, kk_t)
        S = (S * w_t[:, :, None, :] - sa[..., None] * (kk_t * a_t)[:, :, None, :]
             + v_t[..., None] * k_t[:, :, None, :])
        return S, (jnp.einsum('bhvk,bhk->bhv', S, inp[5]) if readout else None)

    s_last, ys = lax.scan(step, state0, xs, reverse=reverse)
    return s_last, (jnp.moveaxis(ys, 0, 1) if readout else None)


def rwkv_readout(y, s, ln_g, ln_b, r_k, w_o, out_dtype):
    b, l = y.shape[:2]
    mean = jnp.mean(y, axis=-1, keepdims=True)
    var = jnp.mean(jnp.square(y - mean), axis=-1, keepdims=True)
    yn = ((y - mean) * lax.rsqrt(var + GN_EPS)).reshape(b, l, D_MODEL) * ln_g + ln_b
    bonus = jnp.einsum('blhn,dblhn,hn->blh', s['r'], s['k'], r_k)[..., None] * s['v']
    z = (yn + bonus.reshape(b, l, D_MODEL)).astype(out_dtype) * s['g']
    return z @ w_o


def rwkv_mixer(h_lat, h_ctx, n_rows, mu, w_rkv, w0, w1, w2, a0, a1, a2, g1, g2, k_k, k_a,
               r_k, ln_g, ln_b, w_o, ctx_readout):
    s_ctx = rwkv_streams(h_ctx, 1, mu, w_rkv, w0, w1, w2, a0, a1, a2, g1, g2, k_k, k_a, ctx_readout)
    s_lat = rwkv_streams(h_lat, n_rows, mu, w_rkv, w0, w1, w2, a0, a1, a2, g1, g2, k_k, k_a, True)
    state0 = jnp.zeros((h_lat.shape[0], N_HEADS, HEAD_SIZE, HEAD_SIZE), jnp.float32)
    y_lat, y_ctx = 0.0, 0.0
    for d in range(2):
        rev = d == 1
        s_c, yc = wkv_scan(state0, s_ctx, d, rev, ctx_readout)
        _, yl = wkv_scan(s_c, s_lat, d, rev, True)
        y_lat = y_lat + yl
        if ctx_readout:
            y_ctx = y_ctx + yc
    out_lat = rwkv_readout(y_lat, s_lat, ln_g, ln_b, r_k, w_o, h_lat.dtype)
    out_ctx = rwkv_readout(y_ctx, s_ctx, ln_g, ln_b, r_k, w_o, h_ctx.dtype) if ctx_readout else None
    return out_lat, out_ctx


def short_conv_mixer(h, n_rows, w_in, conv_w, w_out):
    b_gate, c_gate, u = jnp.split(h @ w_in, 3, axis=-1)
    z = c_gate * u
    z_prev, z_next = row_neighbours(z, n_rows)
    z = conv_w[0] * z_prev + conv_w[1] * z + conv_w[2] * z_next
    return (b_gate * z) @ w_out


def moe_ffn(h, router_w, router_b, w_gu, b_gu, w_down, b_down):
    f32 = jnp.float32
    t, d = h.shape
    logits = h.astype(f32) @ router_w.astype(f32) + router_b.astype(f32)
    top_logit, top_e = lax.top_k(logits, TOP_K)
    gate = jax.nn.softmax(top_logit, axis=-1)
    expert = top_e.reshape(-1).astype(jnp.int32)
    token = jnp.repeat(jnp.arange(t, dtype=jnp.int32), TOP_K)
    n_assign = t * TOP_K
    counts = jnp.zeros((N_EXPERTS,), jnp.int32).at[expert].add(1)
    padded = (counts + EXPERT_BLOCK - 1) // EXPERT_BLOCK * EXPERT_BLOCK
    start = jnp.cumsum(counts) - counts
    pad_end = jnp.cumsum(padded)
    pad_start = pad_end - padded
    order = jnp.argsort(expert)
    e_sorted = expert[order]
    dest = pad_start[e_sorted] + jnp.arange(n_assign, dtype=jnp.int32) - start[e_sorted]
    n_blocks = -(-(n_assign + N_EXPERTS * (EXPERT_BLOCK - 1)) // EXPERT_BLOCK)
    n_rows = n_blocks * EXPERT_BLOCK
    row_tok = jnp.zeros((n_rows,), jnp.int32).at[dest].set(token[order])
    row_w = jnp.zeros((n_rows,), f32).at[dest].set(gate.reshape(-1)[order])
    block_start = jnp.arange(n_blocks, dtype=jnp.int32) * EXPERT_BLOCK
    block_e = jnp.minimum(jnp.searchsorted(pad_end, block_start, side='right'), N_EXPERTS - 1)
    xb = h[row_tok].reshape(n_blocks, EXPERT_BLOCK, d)

    def expert_block(args):
        xe, e = args
        g_, u_ = jnp.split(xe @ w_gu[e] + b_gu[e], 2, axis=-1)
        g_ = jnp.minimum(g_, SWIGLU_LIMIT)
        u_ = jnp.clip(u_, -SWIGLU_LIMIT, SWIGLU_LIMIT)
        return ((u_ + 1) * (g_ * jax.nn.sigmoid(SWIGLU_ALPHA * g_))) @ w_down[e] + b_down[e]

    yb = lax.map(expert_block, (xb, block_e))
    y = (yb.reshape(n_rows, d) * row_w[:, None]).astype(h.dtype)
    return jnp.zeros_like(h).at[row_tok].add(y)


def context_read_later(i):
    return any(j % N_MIXERS == RWKV_SLOT for j in range(i + 1, DEPTH))


def setup_inputs(seed: int = 0) -> dict:
    key = jax.random.key(seed)
    ks = iter(jax.random.split(key, 48))
    D, NA, NB, E, F = D_MODEL, N_RWKV_LAYERS, N_CONV_LAYERS, N_EXPERTS, D_FF

    def nrm(shape, scale):
        return jax.random.normal(next(ks), shape, jnp.float32) * scale

    chan = jnp.arange(D, dtype=jnp.float32) / (D - 1)
    return {
        'x': nrm((BATCH, SEQ, D), 1.0),
        'c': nrm((BATCH, D), 1.0),
        'ctx': nrm((BATCH, CTX_LEN, D), 1.0),
        'c_ctx': nrm((D,), 1.0),
        'ada_w': nrm((DEPTH, D, N_MOD * D), 0.5 * D ** -0.5),
        'ada_b': nrm((DEPTH, N_MOD * D), 0.01),
        'norm_g': 1.0 + nrm((DEPTH, 2, D), 0.05),
        'final_norm_g': 1.0 + nrm((D,), 0.05),
        'rw_mu': 0.5 * jax.random.uniform(next(ks), (NA, 6, 2, D), jnp.float32),
        'rw_w_rkv': nrm((NA, 3, D, D), D ** -0.5),
        'rw_w0': (-6.5 + 5.0 * chan ** 0.85)[None, None, :] + nrm((NA, 2, D), 0.1),
        'rw_w1': nrm((NA, 2, D, DECAY_LORA), D ** -0.5),
        'rw_w2': nrm((NA, 2, DECAY_LORA, D), 0.1 * DECAY_LORA ** -0.5),
        'rw_a0': nrm((NA, 2, D), 0.1),
        'rw_a1': nrm((NA, 2, D, ICLR_LORA), D ** -0.5),
        'rw_a2': nrm((NA, 2, ICLR_LORA, D), 0.1 * ICLR_LORA ** -0.5),
        'rw_g1': nrm((NA, D, GATE_LORA), D ** -0.5),
        'rw_g2': nrm((NA, GATE_LORA, D), GATE_LORA ** -0.5),
        'rw_k_k': 0.85 + nrm((NA, D), 0.02),
        'rw_k_a': 1.0 + nrm((NA, D), 0.02),
        'rw_r_k': nrm((NA, N_HEADS, HEAD_SIZE), 0.1),
        'rw_ln_g': 1.0 + nrm((NA, D), 0.05),
        'rw_ln_b': nrm((NA, D), 0.01),
        'rw_w_o': nrm((NA, D, D), D ** -0.5),
        'sc_w_in': nrm((NB, D, 3 * D), D ** -0.5),
        'sc_conv': nrm((NB, CONV_WIDTH, D), CONV_WIDTH ** -0.5),
        'sc_w_out': nrm((NB, D, D), D ** -0.5),
        'moe_router_w': nrm((DEPTH, D, E), D ** -0.5),
        'moe_router_b': nrm((DEPTH, E), 0.01),
        'moe_w_gu': nrm((DEPTH, E, D, 2 * F), D ** -0.5),
        'moe_b_gu': nrm((DEPTH, E, 2 * F), 0.01),
        'moe_w_down': nrm((DEPTH, E, F, D), F ** -0.5),
        'moe_b_down': nrm((DEPTH, E, D), 0.01),
    }


def reference(x, c, ctx, c_ctx, ada_w, ada_b, norm_g, final_norm_g, rw_mu, rw_w_rkv, rw_w0, rw_w1,
              rw_w2, rw_a0, rw_a1, rw_a2, rw_g1, rw_g2, rw_k_k, rw_k_a, rw_r_k, rw_ln_g, rw_ln_b,
              rw_w_o, sc_w_in, sc_conv, sc_w_out, moe_router_w, moe_router_b, moe_w_gu, moe_b_gu,
              moe_w_down, moe_b_down):
    b, seq, d = x.shape
    rows = seq // GRID_W
    xc = ctx
    for i in range(DEPTH):
        kind, j = i % N_MIXERS, i // N_MIXERS
        ctx_on = context_read_later(i)
        m = ada_mods(c, ada_w[i], ada_b[i])
        mc = ada_mods(c_ctx[None], ada_w[i], ada_b[i]) if (kind == RWKV_SLOT or ctx_on) else None
        h = modulate(x, norm_g[i, 0], m[0], m[1])
        if kind == RWKV_SLOT:
            hc = modulate(xc, norm_g[i, 0], mc[0], mc[1])
            y, yc = rwkv_mixer(h, hc, rows, rw_mu[j], rw_w_rkv[j], rw_w0[j], rw_w1[j], rw_w2[j],
                               rw_a0[j], rw_a1[j], rw_a2[j], rw_g1[j], rw_g2[j], rw_k_k[j],
                               rw_k_a[j], rw_r_k[j], rw_ln_g[j], rw_ln_b[j], rw_w_o[j], ctx_on)
        else:
            y = short_conv_mixer(h, rows, sc_w_in[j], sc_conv[j], sc_w_out[j])
            yc = (short_conv_mixer(modulate(xc, norm_g[i, 0], mc[0], mc[1]), 1, sc_w_in[j],
                                   sc_conv[j], sc_w_out[j]) if ctx_on else None)
        x = x + m[2] * y
        h = modulate(x, norm_g[i, 1], m[3], m[4]).reshape(-1, d)
        if ctx_on:
            xc = xc + mc[2] * yc
            hc = modulate(xc, norm_g[i, 1], mc[3], mc[4]).reshape(-1, d)
            f = moe_ffn(jnp.concatenate([h, hc], axis=0), moe_router_w[i], moe_router_b[i],
                        moe_w_gu[i], moe_b_gu[i], moe_w_down[i], moe_b_down[i])
            x = x + m[5] * f[:b * seq].reshape(b, seq, d)
            xc = xc + mc[5] * f[b * seq:].reshape(xc.shape)
        else:
            f = moe_ffn(h, moe_router_w[i], moe_router_b[i], moe_w_gu[i], moe_b_gu[i],
                        moe_w_down[i], moe_b_down[i])
            x = x + m[5] * f.reshape(b, seq, d)
    return rmsnorm(x, final_norm_g)
```

```cpp
#include <hip/hip_runtime.h>
#include <cstdio>
#include <cstdint>

#ifndef MK_PER_PHASE
#define MK_PER_PHASE 0
#endif

constexpr int D = 1024, NBATCH = 4, SEQ = 8192, TL = NBATCH * SEQ, CTXL = 256, TC = NBATCH * CTXL, T = TL + TC;
constexpr int NH = 16, HS = 64, NE = 32, TOPK = 4, DEPTH = 4;
constexpr int NMT = T / 256;
constexpr int NMT_L = TL / 256;
constexpr int MAXTILES = (T * TOPK) / 256 + NE;
constexpr int NSTEP = CTXL + SEQ;

__device__ __forceinline__ int lane_id() { return (int)__builtin_amdgcn_mbcnt_hi(~0u, __builtin_amdgcn_mbcnt_lo(~0u, 0u)); }
namespace pg8 {
#define PG8_LAS __attribute__((address_space(3)))
typedef unsigned short bf16_t;
typedef short bf16x8 __attribute__((ext_vector_type(8)));
typedef float f32x4 __attribute__((ext_vector_type(4)));
typedef unsigned u32x4 __attribute__((ext_vector_type(4)));
typedef unsigned u32x2 __attribute__((ext_vector_type(2)));
constexpr int BM = 256, BK = 64, HALF = 128, HTB = HALF * BK * 2  , STAGE_BYTES = 8 * HTB, NXCD = 8, WGM = 8;

__host__ __device__ __forceinline__ int lds_byte(int r, int c) { const int st = (r >> 4) * 2 + (c >> 5), rr = r & 15, cc = c & 31, ob = rr * 64 + cc * 2; return st * 1024 + (ob ^ (((ob >> 9) & 1) << 5)); }
__host__ __device__ __forceinline__ void stage_rc(int b, int& R, int& C) { const int st = b / 1024, sb = b % 1024, swz = sb ^ (((sb >> 9) & 1) << 5); R = (st >> 1) * 16 + swz / 64; C = (st & 1) * 32 + (swz % 64) / 2; }
__host__ __device__ __forceinline__ int perm32(int rho) { const int n = rho >> 4, i = rho & 15; return 8 * (i >> 2) + 4 * n + (i & 3); }

struct Unit { int pm, pn, e, nv; };
struct Gemm { const bf16_t* A; const bf16_t* Bt; int M, N, K; };

__device__ __forceinline__ void tile_map(int wgid, int nM, int nN, int& pm, int& pn) {
    const int nwg = nM * nN;
    { const int q = nwg / NXCD, r = nwg % NXCD, xcd = wgid % NXCD, off = wgid / NXCD; wgid = (xcd < r ? xcd * (q + 1) : r * (q + 1) + (xcd - r) * q) + off; }
    const int nig = WGM * nN, gid = wgid / nig, fm = gid * WGM, gsz = (nM - fm) < WGM ? (nM - fm) : WGM;
    pm = fm + ((wgid % nig) % gsz); pn = (wgid % nig) / gsz;
}
typedef __bf16 bf16x2_t __attribute__((ext_vector_type(2)));
typedef float f32x2_t __attribute__((ext_vector_type(2)));
__device__ __forceinline__ unsigned cvt_pk_bf16(float lo, float hi) { const f32x2_t v = {lo, hi}; const bf16x2_t b = __builtin_convertvector(v, bf16x2_t); return __builtin_bit_cast(unsigned, b); }

template <class Epi, class Sched, bool ALIGN_EPI = false, bool SP2 = false, bool GATHER = false>
__device__ __forceinline__ void gemm_phase(PG8_LAS unsigned char* lds, const Gemm g, const Sched& S, const Epi& E, int tid_in) {
    int tid_ = tid_in; asm volatile("" : "+v"(tid_));
    const int tid = tid_, wid = __builtin_amdgcn_readfirstlane(tid >> 6), lane = tid & 63, wr = wid >> 2, wc = wid & 3, fr = lane & 15, fq = lane >> 4;
    int K_ = g.K; asm volatile("" : "+s"(K_));
    const int K = K_, nt = K / BK;
    unsigned voffA[2], voffB[2]; int gR[2]; unsigned gC[2];
#pragma unroll
    for (int i = 0; i < 2; ++i) { int R, C; stage_rc(tid * 16 + i * 8192, R, C); const int Rb = Epi::PERM ? ((R & ~31) + perm32(R & 31)) : R;
        voffA[i] = (unsigned)(R * K + C) * 2u; voffB[i] = (unsigned)(Rb * K + C) * 2u; gR[i] = R; gC[i] = (unsigned)C * 2u; }
    unsigned oc[2][2], on[2][2], o2[2][2];
#pragma unroll
    for (int h = 0; h < 2; ++h)
#pragma unroll
        for (int i = 0; i < 2; ++i) { oc[h][i] = 0u; on[h][i] = 0u; o2[h][i] = 0u; }
    const size_t kstep = (size_t)(BK * 2);
    const size_t hstep = (size_t)HALF * K * 2;
    const size_t tstep = 2 * hstep;
    const unsigned ldsw = (unsigned)wid * 1024u;
    const int aoff = lds_byte(wr * 64 + fr, fq * 8), boff = lds_byte(wc * 32 + fr, fq * 8);
#define PG8_SA(b, h) (((b) * 2 + (h)) * HTB)
#define PG8_SB(b, h) ((4 + (b) * 2 + (h)) * HTB)
#define PG8_STAGE(bufoff, gbase, voff) do { _Pragma("unroll") for (int _i = 0; _i < 2; ++_i) \
        __builtin_amdgcn_global_load_lds((const unsigned*)((const char*)(gbase) + (voff)[_i]), (PG8_LAS unsigned*)(lds + (bufoff) + ldsw + _i * 8192), 16, 0, 0); } while (0)
#define PG8_STAGE_A(bufoff, base, h, O) do { if constexpr (GATHER) { PG8_STAGE(bufoff, base, (O)[h]); } else { PG8_STAGE(bufoff, (base) + (h) * hstep, voffA); } } while (0)
#define PG8_LDA(dst, b, h) do { _Pragma("unroll") for (int m = 0; m < 4; ++m) _Pragma("unroll") for (int k = 0; k < 2; ++k) dst[m][k] = *(const PG8_LAS bf16x8*)(lds + PG8_SA(b, h) + aoff + m * 2048 + k * 1024); } while (0)
#define PG8_LDB(dst, b, h) do { _Pragma("unroll") for (int n = 0; n < 2; ++n) _Pragma("unroll") for (int k = 0; k < 2; ++k) dst[n][k] = *(const PG8_LAS bf16x8*)(lds + PG8_SB(b, h) + boff + n * 2048 + k * 1024); } while (0)
#define PG8_MMA(ai, bj, At, Bt) do { __builtin_amdgcn_s_setprio(1); _Pragma("unroll") for (int m = 0; m < 4; ++m) _Pragma("unroll") for (int n = 0; n < 2; ++n) _Pragma("unroll") for (int k = 0; k < 2; ++k) \
        acc[ai][bj][m][n] = __builtin_amdgcn_mfma_f32_16x16x32_bf16(Bt[n][k], At[m][k], acc[ai][bj][m][n], 0, 0, 0); __builtin_amdgcn_s_setprio(0); } while (0)
#define PG8_WAIT_V(n) asm volatile("s_waitcnt vmcnt(" #n ")" ::: "memory")
#define PG8_WAIT_L(n) asm volatile("s_waitcnt lgkmcnt(" #n ")" ::: "memory")
#define PG8_BAR __builtin_amdgcn_s_barrier()
#define PG8_SCHED __builtin_amdgcn_sched_barrier(0)
    Unit cur, nxt; int ui = 0;
    if (!S.next(0, cur)) return;
    f32x4 acc[2][2][4][2];
#pragma unroll
    for (int a = 0; a < 2; ++a)
#pragma unroll
        for (int b = 0; b < 2; ++b)
#pragma unroll
            for (int m = 0; m < 4; ++m)
#pragma unroll
                for (int n = 0; n < 2; ++n) acc[a][b][m][n] = (f32x4){0.f, 0.f, 0.f, 0.f};
    bf16x8 At[4][2], B0[2][2], B1[2][2];
    const char* cA = GATHER ? (const char*)g.A : (const char*)g.A + (size_t)cur.pm * tstep; const char* cB = (const char*)g.Bt + (size_t)cur.pn * tstep;
    S.a_ready(cur);
    if constexpr (GATHER) {
#pragma unroll
        for (int h = 0; h < 2; ++h)
#pragma unroll
            for (int i = 0; i < 2; ++i) oc[h][i] = S.row_off(cur, h * HALF + gR[i]) + gC[i];
    }
    if constexpr (SP2) {
        PG8_STAGE(PG8_SB(0, 0), cB, voffB); PG8_STAGE(PG8_SB(0, 1), cB + hstep, voffB); PG8_STAGE_A(PG8_SA(0, 0), cA, 0, oc); PG8_STAGE_A(PG8_SA(0, 1), cA, 1, oc);
        if (wr == 1) PG8_BAR;
        PG8_WAIT_V(2); PG8_BAR;
        PG8_STAGE(PG8_SB(1, 0), cB + kstep, voffB); PG8_STAGE_A(PG8_SA(1, 0), cA + kstep, 0, oc); PG8_STAGE(PG8_SB(1, 1), cB + hstep + kstep, voffB);
        PG8_WAIT_V(6); PG8_BAR;
    } else {
        PG8_STAGE(PG8_SB(0, 0), cB, voffB); PG8_STAGE_A(PG8_SA(0, 0), cA, 0, oc); PG8_STAGE(PG8_SB(0, 1), cB + hstep, voffB); PG8_STAGE_A(PG8_SA(0, 1), cA, 1, oc);
        if (wr == 1) PG8_BAR;
        PG8_WAIT_V(4); PG8_BAR;
        PG8_STAGE(PG8_SB(1, 0), cB + kstep, voffB); PG8_STAGE_A(PG8_SA(1, 0), cA + kstep, 0, oc); PG8_STAGE(PG8_SB(1, 1), cB + hstep + kstep, voffB);
        PG8_WAIT_V(6); PG8_BAR;
    }
    for (;;) {
        const bool has_next = S.next(ui + 1, nxt);
        const char* nA = GATHER ? (const char*)g.A : (has_next ? (const char*)g.A + (size_t)nxt.pm * tstep : cA); const char* nB = has_next ? (const char*)g.Bt + (size_t)nxt.pn * tstep : cB;
        if constexpr (GATHER) {
#pragma unroll
            for (int h = 0; h < 2; ++h)
#pragma unroll
                for (int i = 0; i < 2; ++i) on[h][i] = has_next ? (S.row_off(nxt, h * HALF + gR[i]) + gC[i]) : oc[h][i];
        }
        for (int t = 0; t < nt; t += 2) {
            const bool last = (t == nt - 2);
            const char* a1 = cA + (size_t)(t + 1) * kstep;
            const char* a2 = last ? nA : cA + (size_t)(t + 2) * kstep; const char* b2 = last ? nB : cB + (size_t)(t + 2) * kstep;
            const char* a3 = a2 + kstep; const char* b3 = b2 + kstep;
            if constexpr (GATHER) {
#pragma unroll
                for (int h = 0; h < 2; ++h)
#pragma unroll
                    for (int i = 0; i < 2; ++i) o2[h][i] = last ? on[h][i] : oc[h][i];
            }
            if (last && has_next) S.a_ready(nxt);
            if constexpr (SP2) {
            PG8_LDB(B0, 0, 0); PG8_LDB(B1, 0, 1); PG8_SCHED; PG8_LDA(At, 0, 0); PG8_STAGE_A(PG8_SA(1, 1), a1, 1, oc);
            PG8_WAIT_V(8); PG8_WAIT_L(0); PG8_BAR; PG8_MMA(0, 0, At, B0); PG8_MMA(0, 1, At, B1); PG8_BAR; PG8_SCHED;
            PG8_LDA(At, 0, 1); PG8_STAGE(PG8_SB(0, 0), b2, voffB); PG8_STAGE(PG8_SB(0, 1), b2 + hstep, voffB); PG8_STAGE_A(PG8_SA(0, 0), a2, 0, o2);
            PG8_WAIT_V(8); PG8_WAIT_L(0); PG8_BAR; PG8_MMA(1, 0, At, B0); PG8_MMA(1, 1, At, B1); PG8_BAR; PG8_SCHED;
            PG8_LDB(B0, 1, 0); PG8_LDB(B1, 1, 1); PG8_SCHED; PG8_LDA(At, 1, 0); PG8_STAGE_A(PG8_SA(0, 1), a2, 1, o2);
            PG8_WAIT_V(8); PG8_WAIT_L(0); PG8_BAR; PG8_MMA(0, 0, At, B0); PG8_MMA(0, 1, At, B1); PG8_BAR; PG8_SCHED;
            PG8_LDA(At, 1, 1); PG8_STAGE(PG8_SB(1, 0), b3, voffB); PG8_STAGE(PG8_SB(1, 1), b3 + hstep, voffB); PG8_STAGE_A(PG8_SA(1, 0), a3, 0, o2);
            PG8_WAIT_V(8); PG8_WAIT_L(0); PG8_BAR; PG8_MMA(1, 0, At, B0); PG8_MMA(1, 1, At, B1); PG8_BAR; PG8_SCHED;
            } else {
            PG8_LDB(B0, 0, 0); PG8_SCHED; PG8_LDA(At, 0, 0); PG8_STAGE_A(PG8_SA(1, 1), a1, 1, oc);
            PG8_WAIT_L(8); PG8_BAR; PG8_WAIT_L(0); PG8_MMA(0, 0, At, B0); PG8_BAR; PG8_SCHED;
            PG8_LDB(B1, 0, 1); PG8_STAGE(PG8_SB(0, 0), b2, voffB);
            PG8_BAR; PG8_WAIT_L(0); PG8_MMA(0, 1, At, B1); PG8_BAR;
            PG8_LDA(At, 0, 1); PG8_STAGE_A(PG8_SA(0, 0), a2, 0, o2);
            PG8_BAR; PG8_WAIT_L(0); PG8_MMA(1, 0, At, B0); PG8_BAR; PG8_SCHED;
            PG8_STAGE(PG8_SB(0, 1), b2 + hstep, voffB);
            PG8_WAIT_V(6); PG8_BAR; PG8_MMA(1, 1, At, B1); PG8_BAR;
            PG8_LDB(B0, 1, 0); PG8_SCHED; PG8_LDA(At, 1, 0); PG8_STAGE_A(PG8_SA(0, 1), a2, 1, o2);
            PG8_WAIT_L(8); PG8_BAR; PG8_WAIT_L(0); PG8_MMA(0, 0, At, B0); PG8_BAR; PG8_SCHED;
            PG8_LDB(B1, 1, 1); PG8_STAGE(PG8_SB(1, 0), b3, voffB);
            PG8_BAR; PG8_WAIT_L(0); PG8_MMA(0, 1, At, B1); PG8_BAR;
            PG8_LDA(At, 1, 1); PG8_STAGE_A(PG8_SA(1, 0), a3, 0, o2);
            PG8_BAR; PG8_WAIT_L(0); PG8_MMA(1, 0, At, B0); PG8_BAR; PG8_SCHED;
            PG8_STAGE(PG8_SB(1, 1), b3 + hstep, voffB);
            PG8_WAIT_V(6); PG8_BAR; PG8_MMA(1, 1, At, B1); PG8_BAR;
            }
        }
        if constexpr (ALIGN_EPI) { if (wr == 0) PG8_BAR; }
        if constexpr (!Epi::AFTER_DRAIN) { E(acc, cur, wr, wc, fr, fq); S.done(cur); }
        if (!has_next) break;
#pragma unroll
        for (int a = 0; a < 2; ++a)
#pragma unroll
            for (int b = 0; b < 2; ++b)
#pragma unroll
                for (int m = 0; m < 4; ++m)
#pragma unroll
                    for (int n = 0; n < 2; ++n) acc[a][b][m][n] = (f32x4){0.f, 0.f, 0.f, 0.f};
        cur = nxt; cA = nA; cB = nB; ++ui;
        if constexpr (GATHER) {
#pragma unroll
            for (int h = 0; h < 2; ++h)
#pragma unroll
                for (int i = 0; i < 2; ++i) oc[h][i] = on[h][i];
        }
        if constexpr (ALIGN_EPI) { if (wr == 1) PG8_BAR; }
    }
    PG8_WAIT_V(0);
    if constexpr (!ALIGN_EPI) { if (wr == 0) PG8_BAR; }
    PG8_BAR;
    if constexpr (Epi::AFTER_DRAIN) { E.fused(acc, cur, wr, wc, fr, fq, lds, wid, lane); S.done(cur); }
#undef PG8_SA
#undef PG8_SB
#undef PG8_STAGE
#undef PG8_STAGE_A
#undef PG8_LDA
#undef PG8_LDB
#undef PG8_MMA
#undef PG8_WAIT_V
#undef PG8_WAIT_L
#undef PG8_BAR
#undef PG8_SCHED
}
}

#define LAS __attribute__((address_space(3)))
typedef unsigned short bf16;
typedef float f32x4 __attribute__((ext_vector_type(4)));
typedef unsigned u32x2 __attribute__((ext_vector_type(2)));
typedef unsigned u32x4 __attribute__((ext_vector_type(4)));
#define LDS_WAIT() asm volatile("s_waitcnt lgkmcnt(0)" ::: "memory")
__device__ __forceinline__ unsigned pk2(float lo, float hi) { return pg8::cvt_pk_bf16(lo, hi); }
__device__ __forceinline__ unsigned f2bf(float f) { return pk2(f, f) & 0xffffu; }
__device__ __forceinline__ float bflo(unsigned w) { return __builtin_bit_cast(float, w << 16); }
__device__ __forceinline__ float bfhi(unsigned w) { return __builtin_bit_cast(float, w & 0xffff0000u); }
__device__ __forceinline__ float wave_sum(float v) {
#pragma unroll
    for (int o = 1; o < 64; o <<= 1) v += __shfl_xor(v, o);
    return v;
}
__device__ __forceinline__ float sigm(float x) { return 1.0f / (1.0f + __expf(-x)); }
__device__ __forceinline__ float tanh_fast(float x) { const float e = __expf(2.0f * x); return 1.0f - 2.0f / (e + 1.0f); }

constexpr size_t MiB = 1u << 20;
constexpr size_t RF = (size_t)T * D * 4;
constexpr size_t RB = (size_t)T * D * 2;
constexpr size_t WS_CTL = 0, CTL_ZERO_BYTES = 1 * MiB;
constexpr size_t WS_MODS = 1 * MiB;
constexpr size_t WS_XSA = 2 * MiB, WS_XSB = WS_XSA + RF;
constexpr size_t WS_XL = WS_XSB + RF;
constexpr size_t WS_RKV = WS_XL + 6 * RB;
constexpr size_t WS_L1 = WS_RKV + 3 * RF;
constexpr size_t WS_WDEC = WS_L1 + 50 * MiB;
constexpr size_t WS_AA = WS_WDEC + 2 * RF;
constexpr size_t WS_G = WS_AA + 2 * RF;
constexpr size_t WS_KK = WS_G + RB;
constexpr size_t WS_KD = WS_KK + RF;
constexpr size_t WS_BETA = WS_KD + 2 * RF;
constexpr size_t WS_RKB = WS_BETA + 2 * RF;
constexpr size_t WS_C12 = WS_RKB + 3 * MiB;
constexpr size_t WS_Y = WS_C12 + 9 * MiB;
constexpr size_t WS_Z = WS_Y + 2 * RF;
constexpr size_t WS_H2 = WS_Z + RB;
constexpr size_t WS_SLOTL = WS_H2 + RB;
constexpr size_t WS_GATEL = WS_SLOTL + 5 * MiB;
constexpr size_t WS_WRKV = WS_GATEL + 5 * MiB;
constexpr size_t WS_L2T = WS_WRKV + 15 * MiB;
constexpr size_t WS_WO = WS_L2T + 5 * MiB;
constexpr size_t WS_WIN = WS_WO + 4 * MiB;
constexpr size_t WS_WOUT = WS_WIN + 12 * MiB;
constexpr size_t WS_WGU = WS_WOUT + 4 * MiB;
constexpr size_t WS_WDN = WS_WGU + 512 * MiB;
constexpr size_t WS_END = WS_WDN + 256 * MiB;
constexpr size_t WS_INTER = WS_WDEC;
constexpr size_t WS_YS = WS_KD;
constexpr size_t WS_BG = WS_RKV, WS_CUZ = WS_RKV + RB;
constexpr size_t WS_RAWW = WS_AA, WS_RAWA = WS_AA + RF;
constexpr size_t WS_RH = WS_AA;
constexpr size_t WS_PM = WS_AA + RF;
constexpr size_t WS_QT = WS_XL;
constexpr size_t WS_HT = WS_XL + RF;
static_assert((size_t)128 * 132 * 4096 * 2 <= RF, "chunk state tensors");
static_assert((size_t)MAXTILES * 256 * 1024 * 2 <= 4 * RF, "INTER overlay");
static_assert((size_t)T * 4 * 1024 * 2 <= 2 * RF, "YS overlay");
static_assert((size_t)3 * T * 256 * 2 <= 50 * MiB, "L1OUT");
constexpr int CW_BAR = 4096;
constexpr int CW_CNT = 16384;

constexpr int RING_BYTES = 131072;
constexpr int LDSCTL_OFF = RING_BYTES;
constexpr int LDS_BYTES = 147456;

struct Args { const float* in[33]; float* out; unsigned char* ws; int ph_lo, ph_hi; };

__device__ __forceinline__ void transpose_item(const float* W, int N, bf16* WT, int dstK, int drow0, int k0, int n0, LAS float* scr, int lane) {
    float tv[32];
#pragma unroll
    for (int i = 0; i < 32; ++i) { const int kk = 2 * i + (lane >> 5); tv[i] = W[(size_t)(k0 + kk) * N + n0 + (lane & 31)]; }
#pragma unroll
    for (int i = 0; i < 32; ++i) { const int kk = 2 * i + (lane >> 5); scr[kk * 33 + (lane & 31)] = tv[i]; }
    LDS_WAIT(); asm volatile("" ::: "memory");
    const int c = lane & 7;
#pragma unroll
    for (int j = 0; j < 4; ++j) { const int n = (lane >> 3) + 8 * j; const LAS float* s = scr + (8 * c) * 33 + n;
        u32x4 o; o.x = pk2(s[0 * 33], s[1 * 33]); o.y = pk2(s[2 * 33], s[3 * 33]); o.z = pk2(s[4 * 33], s[5 * 33]); o.w = pk2(s[6 * 33], s[7 * 33]);
        *(u32x4*)(WT + (size_t)(drow0 + n) * dstK + k0 + 8 * c) = o; }
    LDS_WAIT(); asm volatile("" ::: "memory");
}
__device__ __forceinline__ int gu_map(int n0) { const int bj = n0 >= 1024 ? 1 : 0, f0 = n0 - bj * 1024; return (f0 >> 7) * 256 + bj * 128 + (f0 & 127); }
__device__ __forceinline__ int conv_map(int n0) { if (n0 < 1024) return n0; const int q = (n0 - 1024) >> 10, f0 = (n0 - 1024) & 1023; return 1024 + (f0 >> 7) * 256 + q * 128 + (f0 & 127); }

__device__ __forceinline__ void p0_prologue(const Args& a, LAS unsigned char* lds, int tid, int lane, int wave, int G) {
    unsigned char* ws = a.ws;
    LAS float* sl = (LAS float*)lds;
    LAS float* red = (LAS float*)(lds + 20480);
    for (int i = tid; i < 5 * 1024; i += 512) { const int r = i >> 10, k = i & 1023; const float cv = r < 4 ? a.in[1][r * 1024 + k] : a.in[3][k]; sl[i] = cv / (1.0f + __expf(-cv)); }
    __syncthreads();
    float* MODS = (float*)(ws + WS_MODS);
    for (int it = blockIdx.x; it < 4 * 96; it += G) {
        const int l = it / 96, n = (it % 96) * 64 + lane;
        const float* W = a.in[4] + (size_t)l * 1024 * 6144 + n;
        float acc[5] = {0.f, 0.f, 0.f, 0.f, 0.f};
        const int kb = wave * 128;
#pragma unroll 8
        for (int k = 0; k < 128; ++k) { const float wv = W[(size_t)(kb + k) * 6144];
#pragma unroll
            for (int r = 0; r < 5; ++r) acc[r] += sl[r * 1024 + kb + k] * wv; }
#pragma unroll
        for (int r = 0; r < 5; ++r) red[(wave * 5 + r) * 64 + lane] = acc[r];
        __syncthreads();
        if (wave < 5) { float s = a.in[5][l * 6144 + n];
#pragma unroll
            for (int w = 0; w < 8; ++w) s += red[(w * 5 + wave) * 64 + lane];
            MODS[(size_t)(l * 5 + wave) * 6144 + n] = s; }
        __syncthreads();
    }
    LAS float* scr = (LAS float*)(lds + 32768 + wave * 8448);
    const int gw = blockIdx.x * 8 + wave, NGW = G * 8;
    bf16* WRKV = (bf16*)(ws + WS_WRKV); bf16* WOt = (bf16*)(ws + WS_WO); bf16* WINt = (bf16*)(ws + WS_WIN); bf16* WOUTt = (bf16*)(ws + WS_WOUT);
    bf16* WGU = (bf16*)(ws + WS_WGU); bf16* WDN = (bf16*)(ws + WS_WDN);
    constexpr int I_GU = 128 * 1024, I_DN = 128 * 512, I_RKV = 6 * 512, I_WO = 2 * 512, I_WIN = 2 * 1536, I_WOUT = 2 * 512, I_W1 = 4 * 32, I_A1 = 4 * 32, I_G1 = 2 * 64;
    constexpr int NITEMS = I_GU + I_DN + I_RKV + I_WO + I_WIN + I_WOUT + I_W1 + I_A1 + I_G1;
    for (int it = gw; it < NITEMS; it += NGW) {
        int r = it;
        if (r < I_GU) { const int m = r >> 10, q = r & 1023, kb = q >> 6, nb = q & 63;
            transpose_item(a.in[29] + (size_t)m * 1024 * 2048, 2048, WGU + (size_t)m * 2048 * 1024, 1024, gu_map(nb * 32), kb * 64, nb * 32, scr, lane); continue; } r -= I_GU;
        if (r < I_DN) { const int m = r >> 9, q = r & 511, kb = q >> 5, nb = q & 31;
            transpose_item(a.in[31] + (size_t)m * 1024 * 1024, 1024, WDN + (size_t)m * 1024 * 1024, 1024, nb * 32, kb * 64, nb * 32, scr, lane); continue; } r -= I_DN;
        if (r < I_RKV) { const int m = r >> 9, q = r & 511, kb = q >> 5, nb = q & 31, lr = m / 3, j = m % 3;
            transpose_item(a.in[9] + (size_t)m * 1024 * 1024, 1024, WRKV + (size_t)lr * 3840 * 1024, 1024, j * 1024 + nb * 32, kb * 64, nb * 32, scr, lane); continue; } r -= I_RKV;
        if (r < I_WO) { const int m = r >> 9, q = r & 511, kb = q >> 5, nb = q & 31;
            transpose_item(a.in[23] + (size_t)m * 1024 * 1024, 1024, WOt + (size_t)m * 1024 * 1024, 1024, nb * 32, kb * 64, nb * 32, scr, lane); continue; } r -= I_WO;
        if (r < I_WIN) { const int m = r / 1536, q = r % 1536, kb = q / 96, nb = q % 96;
            transpose_item(a.in[24] + (size_t)m * 1024 * 3072, 3072, WINt + (size_t)m * 3072 * 1024, 1024, conv_map(nb * 32), kb * 64, nb * 32, scr, lane); continue; } r -= I_WIN;
        if (r < I_WOUT) { const int m = r >> 9, q = r & 511, kb = q >> 5, nb = q & 31;
            transpose_item(a.in[26] + (size_t)m * 1024 * 1024, 1024, WOUTt + (size_t)m * 1024 * 1024, 1024, nb * 32, kb * 64, nb * 32, scr, lane); continue; } r -= I_WOUT;
        if (r < I_W1) { const int m = r >> 5, q = r & 31, kb = q >> 1, nb = q & 1, lr = m >> 1, e = m & 1;
            transpose_item(a.in[11] + (size_t)m * 1024 * 64, 64, WRKV + (size_t)lr * 3840 * 1024, 1024, 3072 + e * 64 + nb * 32, kb * 64, nb * 32, scr, lane); continue; } r -= I_W1;
        if (r < I_A1) { const int m = r >> 5, q = r & 31, kb = q >> 1, nb = q & 1, lr = m >> 1, e = m & 1;
            transpose_item(a.in[14] + (size_t)m * 1024 * 64, 64, WRKV + (size_t)lr * 3840 * 1024, 1024, 3328 + e * 64 + nb * 32, kb * 64, nb * 32, scr, lane); continue; } r -= I_A1;
        { const int m = r >> 6, q = r & 63, kb = q >> 2, nb = q & 3;
            transpose_item(a.in[16] + (size_t)m * 1024 * 128, 128, WRKV + (size_t)m * 3840 * 1024, 1024, 3584 + nb * 32, kb * 64, nb * 32, scr, lane); }
    }
    const int gt = blockIdx.x * 512 + tid, NGT = G * 512;
    for (int i = gt; i < 2 * 3 * 128 * 128; i += NGT) {
        const int pc = i & 127, rw = (i >> 7) & 127, pd = (i >> 14) % 3, lr = i / (3 * 16384);
        *(u32x4*)(WRKV + ((size_t)lr * 3840 + 3072 + pd * 256 + 128 + rw) * 1024 + pc * 8) = (u32x4){0u, 0u, 0u, 0u}; }
    bf16* L2T = (bf16*)(ws + WS_L2T);
    for (int i = gt; i < 2 * 256 * 5120; i += NGT) {
        const int n = i % 5120, k = (i / 5120) & 255, lr = i / (5120 * 256);
        float v = 0.f;
        if (n < 2048) { const int e = n >> 10, d = n & 1023; if ((k >> 6) == e) v = a.in[12][(((size_t)lr * 2 + e) * 64 + (k & 63)) * 1024 + d]; }
        else if (n < 4096) { const int e = (n - 2048) >> 10, d = n & 1023; if ((k >> 6) == e) v = a.in[15][(((size_t)lr * 2 + e) * 64 + (k & 63)) * 1024 + d]; }
        else { const int d = n - 4096; if (k < 128) v = a.in[17][((size_t)lr * 128 + k) * 1024 + d]; }
        L2T[((size_t)lr * 5120 + n) * 256 + k] = (bf16)f2bf(v);
    }
}
#define XB_TMO      128
#define XB_XCNT(j)  (256  + 64 * (j))
#define XB_XSUB(j)  (1280 + 64 * (j))
#define XB_XGEN(j)  (2304 + 64 * (j))
#define XB_TOP      3328
#define XB_TOPGEN   3392
#define XCD_BAR_WORDS 3456
#define XB_SPIN_CAP (1u << 23)

__device__ __forceinline__ unsigned xb_ld(unsigned* p)              { return __hip_atomic_load(p, __ATOMIC_RELAXED, __HIP_MEMORY_SCOPE_AGENT); }
__device__ __forceinline__ unsigned xb_add(unsigned* p, unsigned v) { return __hip_atomic_fetch_add(p, v, __ATOMIC_RELAXED, __HIP_MEMORY_SCOPE_AGENT); }
__device__ __forceinline__ unsigned xb_xcc_id() { return (unsigned)__builtin_amdgcn_s_getreg((3 << 11) | 20) & 0xFu; }
#define XB_SPIN(cond, bar) do { unsigned _sp = 0; while (cond) { __builtin_amdgcn_s_sleep(1); \
    if ((++_sp & 255u) == 0u) { if (xb_ld(&(bar)[XB_TMO])) break; if (_sp > XB_SPIN_CAP) { atomicAdd(&(bar)[XB_TMO], 1u); break; } } } } while (0)

struct XcdBarrier {
    unsigned wv;
    unsigned* bar; unsigned x;
    volatile LAS unsigned* st;
};

__device__ __forceinline__ XcdBarrier xcd_barrier_post(unsigned* bar, volatile LAS unsigned* st) {
    XcdBarrier b; b.wv = (unsigned)__builtin_amdgcn_readfirstlane((int)(threadIdx.x >> 6)); b.bar = bar; b.x = xb_xcc_id(); b.st = st;
    if (threadIdx.x == 0) (void)xb_add(&bar[XB_XCNT(b.x)], 1u);
    return b;
}
__device__ __forceinline__ void xcd_barrier_complete(unsigned* bar, unsigned x, unsigned& nloc, unsigned& nx) {
    const unsigned G = gridDim.x * gridDim.y * gridDim.z;
    unsigned sum, cnt, mine, sp = 0u;
    for (;;) {
        sum = 0u; cnt = 0u; mine = 0u;
#pragma unroll
        for (unsigned j = 0; j < 16; ++j) { const unsigned c = xb_ld(&bar[XB_XCNT(j)]); sum += c; cnt += (c > 0u) ? 1u : 0u; mine = (j == x) ? c : mine; }
        if (sum == G) break;
        __builtin_amdgcn_s_sleep(1);
        if ((++sp & 255u) == 0u) { if (xb_ld(&bar[XB_TMO])) break; if (sp > XB_SPIN_CAP) { atomicAdd(&bar[XB_TMO], 1u); break; } }
    }
    nloc = mine > 0u ? mine : 1u; nx = cnt > 0u ? cnt : 1u;
}

__device__ __forceinline__ void xcd_barrier(const XcdBarrier& b) {
    asm volatile("s_waitcnt vmcnt(0)" ::: "memory");
    __syncthreads();
    if (b.wv == 0u && lane_id() == 0) {
        unsigned* bar = b.bar;
        __builtin_amdgcn_s_waitcnt(0);
        unsigned nloc = b.st[0], nx = b.st[1];
        if (nloc == 0u) { xcd_barrier_complete(bar, b.x, nloc, nx); b.st[0] = nloc; b.st[1] = nx; }
        const unsigned old = xb_add(&bar[XB_XSUB(b.x)], 1u);
        const unsigned gen = old / nloc;
        if (old + 1u == (gen + 1u) * nloc) {
            __builtin_amdgcn_fence(__ATOMIC_RELEASE, "agent");
            asm volatile("s_waitcnt vmcnt(0)" ::: "memory");
            const unsigned og = xb_add(&bar[XB_TOP], 1u);
            const unsigned tg = og / nx;
            if (og + 1u == (tg + 1u) * nx) xb_add(&bar[XB_TOPGEN], 1u);
            else XB_SPIN(xb_ld(&bar[XB_TOPGEN]) == tg, bar);
            __builtin_amdgcn_fence(__ATOMIC_ACQUIRE, "agent");
            xb_add(&bar[XB_XGEN(b.x)], 1u);
            asm volatile("s_waitcnt vmcnt(0)" ::: "memory");
        } else {
            XB_SPIN(xb_ld(&bar[XB_XGEN(b.x)]) == gen, bar);
            __builtin_amdgcn_fence(__ATOMIC_ACQUIRE, "agent");
            asm volatile("s_waitcnt vmcnt(0)" ::: "memory");
        }
    }
    __syncthreads();
}

__device__ __forceinline__ int mod_row(int row) { return row < TL ? (row >> 13) : 4; }

__device__ __forceinline__ void load_x_combined(f32x4 (&x)[4], const float* xrow, bool has_prev, const bf16* YS, int t, const f32x4 (&m5)[4], int lane) {
#pragma unroll
    for (int j = 0; j < 4; ++j) x[j] = *(const f32x4*)(xrow + 256 * j + 4 * lane);
    if (has_prev) {
        f32x4 s[4];
#pragma unroll
        for (int j = 0; j < 4; ++j) s[j] = (f32x4){0.f, 0.f, 0.f, 0.f};
#pragma unroll
        for (int k = 0; k < 4; ++k) { const bf16* yr = YS + ((size_t)t * 4 + k) * 1024;
#pragma unroll
            for (int j = 0; j < 4; ++j) { const u32x2 w = *(const u32x2*)(yr + 256 * j + 4 * lane); s[j] += (f32x4){bflo(w.x), bfhi(w.x), bflo(w.y), bfhi(w.y)}; } }
#pragma unroll
        for (int j = 0; j < 4; ++j) x[j] += m5[j] * s[j];
    }
}
__device__ __forceinline__ float row_rstd(const f32x4 (&x)[4]) {
    float ss = 0.f;
#pragma unroll
    for (int j = 0; j < 4; ++j) ss += (x[j].x * x[j].x + x[j].y * x[j].y) + (x[j].z * x[j].z + x[j].w * x[j].w);
    return rsqrtf(wave_sum(ss) * (1.0f / 1024.0f) + 1e-6f);
}

__device__ __forceinline__ void phase_a_rwkv(const Args& a, int layer, LAS unsigned char* lds, int tid, int gw, int NGW, int lane) {
    unsigned char* ws = a.ws; const int lj = layer >> 1; const bool has_prev = layer > 0;
    const float* xin_lat = layer == 0 ? a.in[0] : (const float*)(ws + WS_XSA);
    const float* xin_ctx = layer == 0 ? a.in[2] : (const float*)(ws + WS_XSA) + (size_t)TL * D;
    float* xout = (float*)(ws + (layer == 0 ? WS_XSA : WS_XSB));
    const float* MODS = (const float*)(ws + WS_MODS); const bf16* YS = (const bf16*)(ws + WS_YS); bf16* XL = (bf16*)(ws + WS_XL);
    const float* mug = a.in[8] + (size_t)lj * 6 * 2 * 1024; const float* ng = a.in[6] + (size_t)(layer * 2 + 0) * 1024;
    LAS float* mu = (LAS float*)lds;
    for (int i = tid; i < 6 * 2 * 1024 / 4; i += 512) ((LAS f32x4*)mu)[i] = ((const f32x4*)mug)[i];
    __syncthreads();
    for (int it = gw; it < TL / 8 + TC / 2; it += NGW) {
        const int ntok = it < TL / 8 ? 8 : 2, t0 = it < TL / 8 ? it * 8 : TL + (it - TL / 8) * 2, mr = mod_row(t0);
        int rs, re; if (t0 < TL) { rs = t0 & ~63; re = rs + 63; } else { const int loc = t0 - TL; rs = TL + (loc & ~255); re = rs + 255; }
        const float* mod = MODS + (size_t)(layer * 5 + mr) * 6144;
        const float* m5p = MODS + (size_t)((has_prev ? layer - 1 : 0) * 5 + mr) * 6144 + 5 * 1024;
        f32x4 hm[4], h0[4], hp[4];
#pragma unroll
        for (int j = 0; j < 4; ++j) { hm[j] = (f32x4){0.f, 0.f, 0.f, 0.f}; h0[j] = hm[j]; hp[j] = hm[j]; }
        f32x4 rx[4], nx[4]; u32x2 ry[4][4], ny[4][4];
#define PA_LOAD(X, Y, tt) do { const int t_ = (tt); if (t_ >= rs && t_ <= re) { \
            const float* xrow_ = t_ < TL ? xin_lat + (size_t)t_ * D : xin_ctx + (size_t)(t_ - TL) * D; \
            _Pragma("unroll") for (int j = 0; j < 4; ++j) X[j] = *(const f32x4*)(xrow_ + 256 * j + 4 * lane); \
            if (has_prev) { _Pragma("unroll") for (int k = 0; k < 4; ++k) _Pragma("unroll") for (int j = 0; j < 4; ++j) Y[k][j] = *(const u32x2*)(YS + ((size_t)t_ * 4 + k) * 1024 + 256 * j + 4 * lane); } } } while (0)
#pragma unroll
        for (int j = 0; j < 4; ++j) { rx[j] = (f32x4){0.f, 0.f, 0.f, 0.f}; nx[j] = rx[j];
#pragma unroll
            for (int k = 0; k < 4; ++k) { ry[k][j] = (u32x2){0u, 0u}; ny[k][j] = ry[k][j]; } }
        PA_LOAD(rx, ry, t0 - 1);
#pragma unroll 1
        for (int i = -1; i <= ntok; ++i) {
            const int t = t0 + i;
            if (i < ntok) PA_LOAD(nx, ny, t + 1);
            f32x4 hn[4];
            if (t >= rs && t <= re) {
                f32x4 x[4];
#pragma unroll
                for (int j = 0; j < 4; ++j) x[j] = rx[j];
                if (has_prev) {
#pragma unroll
                    for (int j = 0; j < 4; ++j) { f32x4 sm = (f32x4){0.f, 0.f, 0.f, 0.f};
#pragma unroll
                        for (int k = 0; k < 4; ++k) sm += (f32x4){bflo(ry[k][j].x), bfhi(ry[k][j].x), bflo(ry[k][j].y), bfhi(ry[k][j].y)};
                        x[j] += *(const f32x4*)(m5p + 256 * j + 4 * lane) * sm; } }
                if (i >= 0 && i < ntok) {
#pragma unroll
                    for (int j = 0; j < 4; ++j) *(f32x4*)(xout + (size_t)t * D + 256 * j + 4 * lane) = x[j]; }
                const float rstd = row_rstd(x);
#pragma unroll
                for (int j = 0; j < 4; ++j) { const int col = 256 * j + 4 * lane; hn[j] = x[j] * rstd * *(const f32x4*)(ng + col) * (*(const f32x4*)(mod + 1024 + col) + 1.0f) + *(const f32x4*)(mod + col); }
            } else {
#pragma unroll
                for (int j = 0; j < 4; ++j) hn[j] = (f32x4){0.f, 0.f, 0.f, 0.f};
            }
#pragma unroll
            for (int j = 0; j < 4; ++j) { hm[j] = h0[j]; h0[j] = hp[j]; hp[j] = hn[j]; rx[j] = nx[j];
#pragma unroll
                for (int k = 0; k < 4; ++k) ry[k][j] = ny[k][j]; }
            if (i >= 1) {
                const int te = t - 1;
#pragma unroll
                for (int q = 0; q < 6; ++q) {
                    bf16* orow = XL + ((size_t)q * T + te) * D;
#pragma unroll
                    for (int j = 0; j < 4; ++j) { const int col = 256 * j + 4 * lane;
                        const f32x4 m0 = *(const LAS f32x4*)(mu + (q * 2 + 0) * 1024 + col), m1 = *(const LAS f32x4*)(mu + (q * 2 + 1) * 1024 + col);
                        const f32x4 o = h0[j] + m0 * (hm[j] - h0[j]) + m1 * (hp[j] - h0[j]);
                        u32x2 w; w.x = pk2(o.x, o.y); w.y = pk2(o.z, o.w); *(u32x2*)(orow + col) = w; }
                }
            }
        }
#undef PA_LOAD
    }
}
__device__ __forceinline__ void phase_a_conv(const Args& a, int layer, int rows, int gw, int NGW, int lane) {
    unsigned char* ws = a.ws;
    float* xs = (float*)(ws + (layer < 2 ? WS_XSA : WS_XSB));
    const float* MODS = (const float*)(ws + WS_MODS); const bf16* YS = (const bf16*)(ws + WS_YS); bf16* H = (bf16*)(ws + WS_XL);
    const float* ng = a.in[6] + (size_t)(layer * 2 + 0) * 1024;
    for (int t = gw; t < rows; t += NGW) {
        const int mr = mod_row(t);
        const float* mod = MODS + (size_t)(layer * 5 + mr) * 6144;
        f32x4 m5[4], x[4];
#pragma unroll
        for (int j = 0; j < 4; ++j) m5[j] = *(const f32x4*)(MODS + (size_t)((layer - 1) * 5 + mr) * 6144 + 5 * 1024 + 256 * j + 4 * lane);
        load_x_combined(x, xs + (size_t)t * D, true, YS, t, m5, lane);
        const float rstd = row_rstd(x);
#pragma unroll
        for (int j = 0; j < 4; ++j) { const int col = 256 * j + 4 * lane;
            *(f32x4*)(xs + (size_t)t * D + col) = x[j];
            const f32x4 h = x[j] * rstd * *(const f32x4*)(ng + col) * (*(const f32x4*)(mod + 1024 + col) + 1.0f) + *(const f32x4*)(mod + col);
            u32x2 w; w.x = pk2(h.x, h.y); w.y = pk2(h.z, h.w); *(u32x2*)(H + (size_t)t * D + col) = w; }
    }
}
#define DPPF(x, ctrl) __builtin_bit_cast(float, __builtin_amdgcn_update_dpp(0, __builtin_bit_cast(int, (x)), (ctrl), 0xf, 0xf, false))
__device__ __forceinline__ float row16_sum(float v) { v += DPPF(v, 0xB1); v += DPPF(v, 0x4E); v += DPPF(v, 0x141); v += DPPF(v, 0x140); return v; }
__device__ __forceinline__ f32x4 bf4(u32x2 w) { return (f32x4){bflo(w.x), bfhi(w.x), bflo(w.y), bfhi(w.y)}; }
__device__ __forceinline__ u32x2 pk4(f32x4 v) { u32x2 w; w.x = pk2(v[0], v[1]); w.y = pk2(v[2], v[3]); return w; }
__device__ __forceinline__ void phase_c_prep(const Args& a, int lj, LAS unsigned char* lds, int tid, int gw, int NGW, int lane) {
    unsigned char* ws = a.ws;
    const bf16* Rr = (const bf16*)(ws + WS_RKV); const bf16* Kk = Rr + (size_t)T * D; const bf16* RA = (const bf16*)(ws + WS_RAWA); const bf16* RW = (const bf16*)(ws + WS_RAWW);
    float* LW = (float*)(ws + WS_WDEC); bf16* KK = (bf16*)(ws + WS_KK); bf16* KD = (bf16*)(ws + WS_KD); bf16* BE = (bf16*)(ws + WS_BETA); float* RKB = (float*)(ws + WS_RKB);
    LAS float* tb = (LAS float*)lds;
    for (int i = tid; i < 7 * 256; i += 512) { const int t7 = i >> 8, q = i & 255;
        const float* src = t7 == 0 ? a.in[18] + lj * 1024 : t7 == 1 ? a.in[19] + lj * 1024 : t7 == 2 ? a.in[20] + lj * 1024 : t7 < 5 ? a.in[10] + lj * 2048 + (t7 - 3) * 1024 : a.in[13] + lj * 2048 + (t7 - 5) * 1024;
        ((LAS f32x4*)tb)[i] = ((const f32x4*)src)[q]; }
    __syncthreads();
    for (int row = gw; row < T; row += NGW) {
#pragma unroll
        for (int j = 0; j < 4; ++j) {
            const int col = 256 * j + 4 * lane; const size_t ro = (size_t)row * D + col;
            const f32x4 k = bf4(*(const u32x2*)(Kk + ro)), r = bf4(*(const u32x2*)(Rr + ro));
            f32x4 a0 = bf4(*(const u32x2*)(RA + ro)) + *(const LAS f32x4*)(tb + 5 * 1024 + col), a1 = bf4(*(const u32x2*)(RA + (size_t)T * D + ro)) + *(const LAS f32x4*)(tb + 6 * 1024 + col);
            f32x4 d0 = bf4(*(const u32x2*)(RW + ro)) + *(const LAS f32x4*)(tb + 3 * 1024 + col), d1 = bf4(*(const u32x2*)(RW + (size_t)T * D + ro)) + *(const LAS f32x4*)(tb + 4 * 1024 + col);
#pragma unroll
            for (int z = 0; z < 4; ++z) { a0[z] = sigm(a0[z]); a1[z] = sigm(a1[z]); d0[z] = -0.60653066f * sigm(d0[z]); d1[z] = -0.60653066f * sigm(d1[z]); }
            *(f32x4*)(LW + ro) = d0; *(f32x4*)(LW + (size_t)T * D + ro) = d1;
            const f32x4 ck = *(const LAS f32x4*)(tb + col), ca = *(const LAS f32x4*)(tb + 1024 + col), cr = *(const LAS f32x4*)(tb + 2048 + col);
            const f32x4 kk = k * ck;
            const float ss = row16_sum((kk.x * kk.x + kk.y * kk.y) + (kk.z * kk.z + kk.w * kk.w));
            const f32x4 kd0 = k * ((a0 - 1.0f) * ca + 1.0f), kd1 = k * ((a1 - 1.0f) * ca + 1.0f);
            *(u32x2*)(KD + ro) = pk4(kd0); *(u32x2*)(KD + (size_t)T * D + ro) = pk4(kd1);
            const f32x4 p = r * (kd0 + kd1) * cr;
            const float rk = row16_sum((p.x + p.y) + (p.z + p.w));
            const f32x4 kkn = kk * (1.0f / fmaxf(sqrtf(ss), 1e-12f));
            *(u32x2*)(KK + ro) = pk4(kkn); *(u32x2*)(BE + ro) = pk4(kkn * a0); *(u32x2*)(BE + (size_t)T * D + ro) = pk4(kkn * a1);
            if ((lane & 15) == 0) RKB[(size_t)row * 16 + 4 * j + (lane >> 4)] = rk;
        }
    }
}
typedef short bf16x8 __attribute__((ext_vector_type(8)));
__device__ __forceinline__ f32x4 mfma16(bf16x8 a, bf16x8 b, f32x4 c) { return __builtin_amdgcn_mfma_f32_16x16x32_bf16(a, b, c, 0, 0, 0); }
__device__ __forceinline__ bf16x8 as_frag(u32x4 w) { return __builtin_bit_cast(bf16x8, w); }
constexpr int CH_LD = 144;
constexpr int CH_MS = 64 * CH_LD;
constexpr int CH_AB = 0 * CH_MS, CH_KT = 1 * CH_MS, CH_BT = 2 * CH_MS, CH_RB = 3 * CH_MS, CH_VT = 4 * CH_MS, CH_ABT = 5 * CH_MS, CH_KHT = 6 * CH_MS, CH_BHT = 7 * CH_MS,
              CH_LK = 8 * CH_MS, CH_LB = 9 * CH_MS, CH_MK = 10 * CH_MS, CH_MB = 11 * CH_MS, CH_WT = 12 * CH_MS, CH_U0 = 13 * CH_MS, CH_DINV = 14 * CH_MS;
constexpr int CH_GC = LDSCTL_OFF + 2048;
constexpr int CH_PART = LDSCTL_OFF + 4096;
constexpr int NCHUNK = NSTEP / 64;
static_assert(CH_DINV + 2048 <= RING_BYTES, "chunk LDS map");

__device__ __forceinline__ int scan_row(int s, int dir, int b) {
    if (s < CTXL) return TL + b * CTXL + (dir ? CTXL - 1 - s : s);
    const int i = s - CTXL; return b * SEQ + (dir ? SEQ - 1 - i : i);
}
#define CH_FRAG(mat, row, ks, kg) as_frag(*(const LAS u32x4*)(lds + (mat) + (row) * CH_LD + ((ks) * 32 + (kg) * 8) * 2))

__device__ __forceinline__ void phase_s1_chunks(const Args& a, LAS unsigned char* lds, int tid, int G) {
    unsigned char* ws = a.ws;
    const int lane = tid & 63, wave = __builtin_amdgcn_readfirstlane(tid >> 6), l15 = lane & 15, g = lane >> 4;
    LAS float* part = (LAS float*)(lds + CH_PART); LAS float* gammaC = (LAS float*)(lds + CH_GC);
    float nlw[8], nkd[8], nbe[8], nkk[8], nrr[8], nvv[8];
#define S1_LOAD(ctx_) do { unsigned char* wsl = ws; asm volatile("" : "+s"(wsl));     \
        const float* LWp = (const float*)(wsl + WS_WDEC); const bf16* KDp = (const bf16*)(wsl + WS_KD); const bf16* BEp = (const bf16*)(wsl + WS_BETA); \
        const bf16* KKp = (const bf16*)(wsl + WS_KK); const bf16* Rp = (const bf16*)(wsl + WS_RKV); const bf16* Vp = Rp + (size_t)2 * T * D; \
        const int chain_ = (ctx_) / NCHUNK, c_ = (ctx_) - chain_ * NCHUNK, dir_ = chain_ >> 6, b_ = (chain_ >> 4) & 3, h_ = chain_ & 15; \
        _Pragma("unroll") for (int j = 0; j < 8; ++j) { const int row = scan_row(64 * c_ + 8 * wave + j, dir_, b_); const size_t o = (size_t)row * D + h_ * 64 + lane; \
            nlw[j] = LWp[(size_t)dir_ * T * D + o]; nkd[j] = bflo((unsigned)KDp[(size_t)dir_ * T * D + o]); nbe[j] = bflo((unsigned)BEp[(size_t)dir_ * T * D + o]); nkk[j] = bflo((unsigned)KKp[o]); nrr[j] = bflo((unsigned)Rp[o]); nvv[j] = bflo((unsigned)Vp[o]); } } while (0)
    if ((int)blockIdx.x < 128 * NCHUNK) S1_LOAD((int)blockIdx.x);
    for (int ct = blockIdx.x; ct < 128 * NCHUNK; ct += G) {
        const int chain = ct / NCHUNK, c = ct - chain * NCHUNK, dir = chain >> 6, b = (chain >> 4) & 3, h = chain & 15;
        unsigned zq = 0u; asm volatile("" : "+v"(zq));
        {
            const int k = lane, tq = wave;
            float lw[8], kd[8], be[8], kk[8], rr[8], vv[8];
#pragma unroll
            for (int j = 0; j < 8; ++j) { lw[j] = nlw[j]; kd[j] = nkd[j]; be[j] = nbe[j]; kk[j] = nkk[j]; rr[j] = nrr[j]; vv[j] = nvv[j]; }
            if (ct + G < 128 * NCHUNK) S1_LOAD(ct + G);
            float p[8]; p[0] = lw[0];
#pragma unroll
            for (int j = 1; j < 8; ++j) p[j] = p[j - 1] + lw[j];
            part[tq * 64 + k] = p[7];
            __syncthreads();
            float off = 0.f, tot = 0.f;
#pragma unroll
            for (int q = 0; q < 8; ++q) { const float pv = part[q * 64 + k]; tot += pv; off += q < tq ? pv : 0.f; }
            if (tq == 0) gammaC[k] = __expf(tot);
            unsigned abw[4], khw[4], bhw[4], vw[4];
#pragma unroll
            for (int j = 0; j < 8; j += 2) {
                float ab2[2], kt2[2], bt2[2], rb2[2], kh2[2], bh2[2];
#pragma unroll
                for (int z = 0; z < 2; ++z) { const float cu = off + p[j + z]; const float eP = __expf(cu), eM = __expf(-cu), ePrev = __expf(cu - lw[j + z]), eC = __expf(tot - cu);
                    ab2[z] = kk[j + z] * ePrev; kt2[z] = kd[j + z] * eM; bt2[z] = be[j + z] * eM; rb2[z] = rr[j + z] * eP; kh2[z] = kd[j + z] * eC; bh2[z] = be[j + z] * eC;
                    const int t = 8 * tq + j + z;
                    *(LAS bf16*)(lds + CH_AB + t * CH_LD + k * 2) = (bf16)f2bf(ab2[z]); *(LAS bf16*)(lds + CH_KT + t * CH_LD + k * 2) = (bf16)f2bf(kt2[z]);
                    *(LAS bf16*)(lds + CH_BT + t * CH_LD + k * 2) = (bf16)f2bf(bt2[z]); *(LAS bf16*)(lds + CH_RB + t * CH_LD + k * 2) = (bf16)f2bf(rb2[z]); }
                abw[j >> 1] = pk2(ab2[0], ab2[1]); khw[j >> 1] = pk2(kh2[0], kh2[1]); bhw[j >> 1] = pk2(bh2[0], bh2[1]); vw[j >> 1] = pk2(vv[j], vv[j + 1]);
            }
            *(LAS u32x4*)(lds + CH_ABT + k * CH_LD + tq * 16) = (u32x4){abw[0], abw[1], abw[2], abw[3]};
            *(LAS u32x4*)(lds + CH_KHT + k * CH_LD + tq * 16) = (u32x4){khw[0], khw[1], khw[2], khw[3]};
            *(LAS u32x4*)(lds + CH_BHT + k * CH_LD + tq * 16) = (u32x4){bhw[0], bhw[1], bhw[2], bhw[3]};
            *(LAS u32x4*)(lds + CH_VT + k * CH_LD + tq * 16) = (u32x4){vw[0], vw[1], vw[2], vw[3]};
            *(LAS u32x4*)(lds + CH_WT + k * CH_LD + tq * 16) = (u32x4){zq, zq, zq, zq}; *(LAS u32x4*)(lds + CH_U0 + k * CH_LD + tq * 16) = (u32x4){zq, zq, zq, zq};
        }
        __syncthreads();
        {
            const int mi = wave >> 1, half = wave & 1;
            const int matS = (mi & 1) ? CH_BT : CH_KT, matT = (mi & 2) ? CH_RB : CH_AB, matO = CH_LK + mi * CH_MS;
            const bool incl = (mi & 2) != 0;
            bf16x8 fs[4][2], ft[2][2];
#pragma unroll
            for (int ms = 0; ms < 4; ++ms)
#pragma unroll
                for (int ks = 0; ks < 2; ++ks) fs[ms][ks] = CH_FRAG(matS, 16 * ms + l15, ks, g);
#pragma unroll
            for (int nt = 0; nt < 2; ++nt)
#pragma unroll
                for (int ks = 0; ks < 2; ++ks) ft[nt][ks] = CH_FRAG(matT, 32 * half + 16 * nt + l15, ks, g);
#pragma unroll
            for (int nt = 0; nt < 2; ++nt) { const int t = 32 * half + 16 * nt + l15;
#pragma unroll
                for (int ms = 0; ms < 4; ++ms) { f32x4 d = (f32x4){0.f, 0.f, 0.f, 0.f};
                    d = mfma16(fs[ms][0], ft[nt][0], d); d = mfma16(fs[ms][1], ft[nt][1], d);
                    const int s0 = 16 * ms + 4 * g;
#pragma unroll
                    for (int i = 0; i < 4; ++i) { const bool keep = incl ? (s0 + i <= t) : (s0 + i < t); d[i] = keep ? d[i] : __builtin_bit_cast(float, zq); }
                    u32x2 w; w.x = pk2(d[0], d[1]); w.y = pk2(d[2], d[3]);
                    *(LAS u32x2*)(lds + matO + t * CH_LD + s0 * 2) = w; } }
        }
        __syncthreads();
        f32x4 rhsU[4];
#pragma unroll
        for (int I = 0; I < 4; ++I) rhsU[I] = (f32x4){0.f, 0.f, 0.f, 0.f};
        if (wave >= 4) {
            const int ctv = (wave & 3) * 16;
            const bf16x8 fv0 = CH_FRAG(CH_VT, ctv + l15, 0, g), fv1 = CH_FRAG(CH_VT, ctv + l15, 1, g);
#pragma unroll
            for (int I = 0; I < 4; ++I) { f32x4 d = (f32x4){0.f, 0.f, 0.f, 0.f};
                d = mfma16(CH_FRAG(CH_LK, 16 * I + l15, 0, g), fv0, d); d = mfma16(CH_FRAG(CH_LK, 16 * I + l15, 1, g), fv1, d); rhsU[I] = -d; }
        }
        if (wave == 0) {
            const int bb = lane >> 4, j = lane & 15;
            float x[16];
#pragma unroll
            for (int t = 0; t < 16; ++t) {
                const u32x4 r0 = *(const LAS u32x4*)(lds + CH_LB + (16 * bb + t) * CH_LD + 32 * bb), r1 = *(const LAS u32x4*)(lds + CH_LB + (16 * bb + t) * CH_LD + 32 * bb + 16);
                const unsigned rw[8] = {r0.x, r0.y, r0.z, r0.w, r1.x, r1.y, r1.z, r1.w};
                float acc = (t == j) ? 1.0f : 0.0f;
#pragma unroll
                for (int s = 0; s < t; ++s) { const float lv = (s & 1) ? bfhi(rw[s >> 1]) : bflo(rw[s >> 1]); acc -= lv * x[s]; }
                x[t] = acc;
                *(LAS bf16*)(lds + CH_DINV + ((bb * 16 + t) * 16 + j) * 2) = (bf16)f2bf(acc);
            }
        }
        __syncthreads();
        {
            const int matZ = wave < 4 ? CH_WT : CH_U0, ct16 = (wave & 3) * 16;
#pragma unroll
            for (int I = 0; I < 4; ++I) {
                f32x4 rhs;
                if (wave < 4) { const u32x2 w = *(const LAS u32x2*)(lds + CH_ABT + (ct16 + l15) * CH_LD + (16 * I + 4 * g) * 2); rhs = (f32x4){bflo(w.x), bfhi(w.x), bflo(w.y), bfhi(w.y)}; }
                else rhs = rhsU[I];
                f32x4 d = (f32x4){0.f, 0.f, 0.f, 0.f};
                d = mfma16(CH_FRAG(CH_LB, 16 * I + l15, 0, g), CH_FRAG(matZ, ct16 + l15, 0, g), d); d = mfma16(CH_FRAG(CH_LB, 16 * I + l15, 1, g), CH_FRAG(matZ, ct16 + l15, 1, g), d);
                const f32x4 ac = rhs - d;
                const u32x2 dv = *(const LAS u32x2*)(lds + CH_DINV + ((I * 16 + l15) * 16 + 4 * g) * 2);
                const bf16x8 fa = as_frag((u32x4){dv.x, dv.y, zq, zq}), fb = as_frag((u32x4){pk2(ac[0], ac[1]), pk2(ac[2], ac[3]), zq, zq});
                const f32x4 z = mfma16(fa, fb, (f32x4){0.f, 0.f, 0.f, 0.f});
                u32x2 w; w.x = pk2(z[0], z[1]); w.y = pk2(z[2], z[3]);
                *(LAS u32x2*)(lds + matZ + (ct16 + l15) * CH_LD + (16 * I + 4 * g) * 2) = w;
                LDS_WAIT(); asm volatile("" ::: "memory");
            }
        }
        __syncthreads();
        {
            const int rt = wave >> 1, cp = (wave & 1) * 2;
            unsigned char* wsl = ws; asm volatile("" : "+s"(wsl));
            float* YL = (float*)(wsl + WS_Y); bf16* RH = (bf16*)(wsl + WS_RH); bf16* PM = (bf16*)(wsl + WS_PM); bf16* QT = (bf16*)(wsl + WS_QT);
            const int trow = scan_row(64 * c + 16 * rt + l15, dir, b);
#pragma unroll
            for (int q = 0; q < 2; ++q) { const int vt = cp + q; f32x4 d = (f32x4){0.f, 0.f, 0.f, 0.f};
#pragma unroll
                for (int ks = 0; ks < 2; ++ks) { d = mfma16(CH_FRAG(CH_VT, 16 * vt + l15, ks, g), CH_FRAG(CH_MK, 16 * rt + l15, ks, g), d); d = mfma16(CH_FRAG(CH_U0, 16 * vt + l15, ks, g), CH_FRAG(CH_MB, 16 * rt + l15, ks, g), d); }
                *(f32x4*)(YL + ((size_t)dir * T + trow) * D + h * 64 + 16 * vt + 4 * g) = d; }
#pragma unroll
            for (int q = 0; q < 2; ++q) { const int kt = cp + q; f32x4 d = (f32x4){0.f, 0.f, 0.f, 0.f};
#pragma unroll
                for (int ks = 0; ks < 2; ++ks) d = mfma16(CH_FRAG(CH_WT, 16 * kt + l15, ks, g), CH_FRAG(CH_MB, 16 * rt + l15, ks, g), d);
                const u32x2 rbw = *(const LAS u32x2*)(lds + CH_RB + (16 * rt + l15) * CH_LD + (16 * kt + 4 * g) * 2);
                u32x2 w; w.x = pk2(bflo(rbw.x) - d[0], bfhi(rbw.x) - d[1]); w.y = pk2(bflo(rbw.y) - d[2], bfhi(rbw.y) - d[3]);
                *(u32x2*)(RH + ((size_t)dir * T + trow) * D + h * 64 + 16 * kt + 4 * g) = w; }
            bf16* Pc = PM + ((size_t)chain * NCHUNK + c) * 4096; bf16* Qc = QT + ((size_t)chain * NCHUNK + c) * 4096;
            { const int krow = 16 * rt + l15; const float gc = gammaC[krow];
#pragma unroll
                for (int q = 0; q < 2; ++q) { const int kt = cp + q; f32x4 d = (f32x4){0.f, 0.f, 0.f, 0.f};
#pragma unroll
                    for (int ks = 0; ks < 2; ++ks) d = mfma16(CH_FRAG(CH_WT, 16 * kt + l15, ks, g), CH_FRAG(CH_BHT, krow, ks, g), d);
                    const int k0 = 16 * kt + 4 * g; f32x4 o;
#pragma unroll
                    for (int i = 0; i < 4; ++i) o[i] = ((k0 + i == krow) ? gc : 0.f) - d[i];
                    u32x2 w; w.x = pk2(o[0], o[1]); w.y = pk2(o[2], o[3]);
                    *(u32x2*)(Pc + krow * 64 + 32 * (kt >> 1) + 8 * g + 4 * (kt & 1)) = w; } }
            { const int vrow = 16 * rt + l15;
#pragma unroll
                for (int q = 0; q < 2; ++q) { const int kt = cp + q; f32x4 d = (f32x4){0.f, 0.f, 0.f, 0.f};
#pragma unroll
                    for (int ks = 0; ks < 2; ++ks) { d = mfma16(CH_FRAG(CH_KHT, 16 * kt + l15, ks, g), CH_FRAG(CH_VT, vrow, ks, g), d); d = mfma16(CH_FRAG(CH_BHT, 16 * kt + l15, ks, g), CH_FRAG(CH_U0, vrow, ks, g), d); }
                    u32x2 w; w.x = pk2(d[0], d[1]); w.y = pk2(d[2], d[3]);
                    *(u32x2*)(Qc + vrow * 64 + 16 * g + 4 * kt) = w; } }
        }
        __syncthreads();
    }
}

struct S2Set { u32x4 p[4][2]; u32x4 q[2]; };
__device__ __forceinline__ void s2_load(S2Set& s, const bf16* Pc, const bf16* Qc, int vt, int l15, int g) {
    s.q[0] = *(const u32x4*)(Qc + (16 * vt + l15) * 64 + 16 * g); s.q[1] = *(const u32x4*)(Qc + (16 * vt + l15) * 64 + 16 * g + 8);
#pragma unroll
    for (int m = 0; m < 4; ++m)
#pragma unroll
        for (int j = 0; j < 2; ++j) s.p[m][j] = *(const u32x4*)(Pc + (16 * m + l15) * 64 + 32 * j + 8 * g);
}
__device__ __forceinline__ void s2_step(f32x4 (&acc)[4], const S2Set& s, bf16* Hc, int g) {
    unsigned hw[4][2];
#pragma unroll
    for (int m = 0; m < 4; ++m) { hw[m][0] = pk2(acc[m][0], acc[m][1]); hw[m][1] = pk2(acc[m][2], acc[m][3]); }
#pragma unroll
    for (int m = 0; m < 4; ++m) *(u32x2*)(Hc + 16 * m + 4 * g) = (u32x2){hw[m][0], hw[m][1]};
    const bf16x8 hb0 = as_frag((u32x4){hw[0][0], hw[0][1], hw[1][0], hw[1][1]}), hb1 = as_frag((u32x4){hw[2][0], hw[2][1], hw[3][0], hw[3][1]});
#pragma unroll
    for (int m = 0; m < 4; ++m) {
        const unsigned q0 = (m & 2) ? ((m & 1) ? s.q[1].z : s.q[1].x) : ((m & 1) ? s.q[0].z : s.q[0].x), q1 = (m & 2) ? ((m & 1) ? s.q[1].w : s.q[1].y) : ((m & 1) ? s.q[0].w : s.q[0].y);
        f32x4 d = (f32x4){bflo(q0), bfhi(q0), bflo(q1), bfhi(q1)};
        d = mfma16(as_frag(s.p[m][0]), hb0, d);
        d = mfma16(as_frag(s.p[m][1]), hb1, d);
        acc[m] = d;
    }
}
__device__ __forceinline__ void phase_s2_chain(const Args& a, int wave, int lane, int G) {
    unsigned char* ws = a.ws;
    const bf16* PM = (const bf16*)(ws + WS_PM); const bf16* QT = (const bf16*)(ws + WS_QT); bf16* HT = (bf16*)(ws + WS_HT);
    const int l15 = lane & 15, g = lane >> 4;
    if (wave >= 2) return;
    static_assert(NCHUNK % 4 == 0, "S2 ring");
    for (int wt = blockIdx.x * 2 + wave; wt < 512; wt += G * 2) {
        const int chain = wt >> 2, vt = wt & 3;
        f32x4 acc[4];
#pragma unroll
        for (int m = 0; m < 4; ++m) acc[m] = (f32x4){0.f, 0.f, 0.f, 0.f};
        const bf16* Pc = PM + (size_t)chain * NCHUNK * 4096; const bf16* Qc = QT + (size_t)chain * NCHUNK * 4096;
        bf16* Hc = HT + (size_t)chain * NCHUNK * 4096 + (16 * vt + l15) * 64;
        S2Set s0, s1, s2, s3;
        s2_load(s0, Pc, Qc, vt, l15, g); s2_load(s1, Pc + 4096, Qc + 4096, vt, l15, g); s2_load(s2, Pc + 2 * 4096, Qc + 2 * 4096, vt, l15, g); s2_load(s3, Pc + 3 * 4096, Qc + 3 * 4096, vt, l15, g);
#pragma unroll 1
        for (int c = 0; c < NCHUNK; c += 4) {
            const int cn = c + 4 < NCHUNK ? c + 4 : c;
            const bf16* Pn = Pc + (size_t)cn * 4096; const bf16* Qn = Qc + (size_t)cn * 4096;
            s2_step(acc, s0, Hc + (size_t)c * 4096, g);       s2_load(s0, Pn, Qn, vt, l15, g);
            s2_step(acc, s1, Hc + (size_t)(c + 1) * 4096, g); s2_load(s1, Pn + 4096, Qn + 4096, vt, l15, g);
            s2_step(acc, s2, Hc + (size_t)(c + 2) * 4096, g); s2_load(s2, Pn + 2 * 4096, Qn + 2 * 4096, vt, l15, g);
            s2_step(acc, s3, Hc + (size_t)(c + 3) * 4096, g); s2_load(s3, Pn + 3 * 4096, Qn + 3 * 4096, vt, l15, g);
        }
    }
}

__device__ __forceinline__ void phase_s3_readout(const Args& a, int lj, int gw, int NGW, int lane) {
    unsigned char* ws = a.ws;
    const float* YL = (const float*)(ws + WS_Y); const bf16* RH = (const bf16*)(ws + WS_RH); const bf16* HT = (const bf16*)(ws + WS_HT);
    const bf16* Vv = (const bf16*)(ws + WS_RKV) + (size_t)2 * T * D; const float* RKB = (const float*)(ws + WS_RKB); const bf16* Gg = (const bf16*)(ws + WS_G); bf16* Z = (bf16*)(ws + WS_Z);
    const float* lng = a.in[21] + lj * 1024; const float* lnb = a.in[22] + lj * 1024;
    const int l15 = lane & 15, g = lane >> 4;
    for (int task = gw; task < (T / 16) * 16; task += NGW) {
        const int tt = task >> 4, h = task & 15, r0 = tt * 16, row = r0 + l15;
        int b, cc[2];
        if (r0 < TL) { b = r0 >> 13; const int tb = (r0 & (SEQ - 1)) >> 6; cc[0] = 4 + tb; cc[1] = 4 + (127 - tb); }
        else { const int loc = r0 - TL; b = loc >> 8; const int tb = (loc & 255) >> 6; cc[0] = tb; cc[1] = 3 - tb; }
        f32x4 acc[4];
        const size_t ro = (size_t)row * D + h * 64 + 4 * g;
#pragma unroll
        for (int vt = 0; vt < 4; ++vt) acc[vt] = *(const f32x4*)(YL + ro + 16 * vt) + *(const f32x4*)(YL + (size_t)T * D + ro + 16 * vt);
#pragma unroll
        for (int dir = 0; dir < 2; ++dir) {
            const int chain = dir * 64 + b * 16 + h;
            const bf16* rh = RH + ((size_t)dir * T + row) * D + h * 64 + 8 * g;
            const bf16x8 f0 = as_frag(*(const u32x4*)(rh)), f1 = as_frag(*(const u32x4*)(rh + 32));
            const bf16* hc = HT + ((size_t)chain * NCHUNK + cc[dir]) * 4096;
#pragma unroll
            for (int vt = 0; vt < 4; ++vt) { const bf16* hr = hc + (16 * vt + l15) * 64 + 8 * g;
                acc[vt] = mfma16(as_frag(*(const u32x4*)(hr)), f0, acc[vt]); acc[vt] = mfma16(as_frag(*(const u32x4*)(hr + 32)), f1, acc[vt]); }
        }
        float s = 0.f;
#pragma unroll
        for (int vt = 0; vt < 4; ++vt) s += (acc[vt][0] + acc[vt][1]) + (acc[vt][2] + acc[vt][3]);
        s += __shfl_xor(s, 16); s += __shfl_xor(s, 32);
        const float mean = s * (1.0f / 64.0f); float vs = 0.f;
#pragma unroll
        for (int vt = 0; vt < 4; ++vt) { acc[vt] = acc[vt] - mean; vs += (acc[vt][0] * acc[vt][0] + acc[vt][1] * acc[vt][1]) + (acc[vt][2] * acc[vt][2] + acc[vt][3] * acc[vt][3]); }
        vs += __shfl_xor(vs, 16); vs += __shfl_xor(vs, 32);
        const float rstd = rsqrtf(vs * (1.0f / 64.0f) + 64.0f * 1e-5f), bon = RKB[(size_t)row * 16 + h];
#pragma unroll
        for (int vt = 0; vt < 4; ++vt) { const int col = h * 64 + 16 * vt + 4 * g; const size_t o = (size_t)row * D + col;
            const f32x4 vq = bf4(*(const u32x2*)(Vv + o)), lg4 = *(const f32x4*)(lng + col), lb4 = *(const f32x4*)(lnb + col); const u32x2 gw2 = *(const u32x2*)(Gg + o);
            const f32x4 zz = acc[vt] * rstd * lg4 + lb4 + vq * bon;
            u32x2 w; w.x = pk2(zz[0] * bflo(gw2.x), zz[1] * bfhi(gw2.x)); w.y = pk2(zz[2] * bflo(gw2.y), zz[3] * bfhi(gw2.y));
            *(u32x2*)(Z + o) = w; }
    }
}
__device__ __forceinline__ void phase_cv(const Args& a, int lc, int rows, int gw, int NGW, int lane) {
    unsigned char* ws = a.ws;
    const bf16* BG = (const bf16*)(ws + WS_BG); const bf16* CU = (const bf16*)(ws + WS_CUZ); bf16* Z = (bf16*)(ws + WS_Z);
    const float* cw = a.in[25] + (size_t)lc * 3 * 1024;
    for (int t = gw; t < rows; t += NGW) {
        int rs, re; if (t < TL) { rs = t & ~63; re = rs + 63; } else { const int loc = t - TL; rs = TL + (loc & ~255); re = rs + 255; }
        const bool hp = t > rs, hn = t < re;
#pragma unroll
        for (int j = 0; j < 4; ++j) { const int col = 256 * j + 4 * lane; const size_t o = (size_t)t * D + col;
            const u32x2 zc = *(const u32x2*)(CU + o), bg = *(const u32x2*)(BG + o);
            const u32x2 zp = hp ? *(const u32x2*)(CU + o - D) : (u32x2){0u, 0u}, zn = hn ? *(const u32x2*)(CU + o + D) : (u32x2){0u, 0u};
            const f32x4 w0 = *(const f32x4*)(cw + col), w1 = *(const f32x4*)(cw + 1024 + col), w2 = *(const f32x4*)(cw + 2048 + col);
            const f32x4 zv = (f32x4){bflo(zc.x), bfhi(zc.x), bflo(zc.y), bfhi(zc.y)}, pv = (f32x4){bflo(zp.x), bfhi(zp.x), bflo(zp.y), bfhi(zp.y)}, nv = (f32x4){bflo(zn.x), bfhi(zn.x), bflo(zn.y), bfhi(zn.y)};
            const f32x4 bv = (f32x4){bflo(bg.x), bfhi(bg.x), bflo(bg.y), bfhi(bg.y)};
            const f32x4 r = bv * (w0 * pv + w1 * zv + w2 * nv);
            u32x2 w; w.x = pk2(r.x, r.y); w.y = pk2(r.z, r.w); *(u32x2*)(Z + o) = w; }
    }
}
__device__ __forceinline__ float lane_bcast(float v, int srclane) { return __builtin_bit_cast(float, __builtin_amdgcn_readlane(__builtin_bit_cast(int, v), srclane)); }
__device__ __forceinline__ void phase_e_route(const Args& a, int layer, int rows, LAS unsigned char* lds, int tid, int gw, int NGW, int lane) {
    unsigned char* ws = a.ws;
    const float* xs = (const float*)(ws + (layer < 2 ? WS_XSA : WS_XSB));
    const float* MODS = (const float*)(ws + WS_MODS); bf16* H2 = (bf16*)(ws + WS_H2);
    const float* ng = a.in[6] + (size_t)(layer * 2 + 1) * 1024;
    const float* rw = a.in[27] + (size_t)layer * 1024 * 32; const float* rb = a.in[28] + layer * 32;
    unsigned* cnt = (unsigned*)(ws + WS_CTL) + CW_CNT + layer * 64;
    int* SLOTL = (int*)(ws + WS_SLOTL); float* GATEL = (float*)(ws + WS_GATEL);
    LAS float* wt = (LAS float*)lds;
    for (int i = tid; i < 32768; i += 512) wt[(i & 31) * 1024 + (i >> 5)] = rw[i];
    __syncthreads();
    const int my_e = lane >> 1; const float my_b = rb[my_e];
    const bool b5 = (lane & 32) != 0, b4 = (lane & 16) != 0, b3 = (lane & 8) != 0, b2 = (lane & 4) != 0, b1 = (lane & 2) != 0;
    for (int t = gw; t < rows; t += NGW) {
        const int mr = mod_row(t);
        const float* mod = MODS + (size_t)(layer * 5 + mr) * 6144;
        f32x4 x[4];
#pragma unroll
        for (int j = 0; j < 4; ++j) x[j] = *(const f32x4*)(xs + (size_t)t * D + 256 * j + 4 * lane);
        const float rstd = row_rstd(x);
#pragma unroll
        for (int j = 0; j < 4; ++j) { const int col = 256 * j + 4 * lane;
            x[j] = x[j] * rstd * *(const f32x4*)(ng + col) * (*(const f32x4*)(mod + 4 * 1024 + col) + 1.0f) + *(const f32x4*)(mod + 3 * 1024 + col);
            u32x2 w; w.x = pk2(x[j].x, x[j].y); w.y = pk2(x[j].z, x[j].w); *(u32x2*)(H2 + (size_t)t * D + col) = w; }
        float p[32];
#pragma unroll
        for (int eg = 0; eg < 8; ++eg) {
#pragma unroll
            for (int ee = 0; ee < 4; ++ee) { const int e = eg * 4 + ee; float s = 0.f;
#pragma unroll
                for (int j = 0; j < 4; ++j) { const f32x4 wv = *(const LAS f32x4*)(wt + e * 1024 + 256 * j + 4 * lane); s += (x[j].x * wv.x + x[j].y * wv.y) + (x[j].z * wv.z + x[j].w * wv.w); }
                p[e] = s; }
            asm volatile("" ::: "memory");
        }
        float q16[16];
#pragma unroll
        for (int i = 0; i < 16; ++i) { const float send = b5 ? p[i] : p[i + 16]; const float keep = b5 ? p[i + 16] : p[i]; q16[i] = keep + __shfl_xor(send, 32); }
        float q8[8];
#pragma unroll
        for (int i = 0; i < 8; ++i) { const float send = b4 ? q16[i] : q16[i + 8]; const float keep = b4 ? q16[i + 8] : q16[i]; q8[i] = keep + __shfl_xor(send, 16); }
        float q4[4];
#pragma unroll
        for (int i = 0; i < 4; ++i) { const float send = b3 ? q8[i] : q8[i + 4]; const float keep = b3 ? q8[i + 4] : q8[i]; q4[i] = keep + __shfl_xor(send, 8); }
        float q2[2];
#pragma unroll
        for (int i = 0; i < 2; ++i) { const float send = b2 ? q4[i] : q4[i + 2]; const float keep = b2 ? q4[i + 2] : q4[i]; q2[i] = keep + __shfl_xor(send, 4); }
        float q1; { const float send = b1 ? q2[0] : q2[1]; const float keep = b1 ? q2[1] : q2[0]; q1 = keep + __shfl_xor(send, 2); }
        const float lg = q1 + __shfl_xor(q1, 1) + my_b;
        int rank = 0;
#pragma unroll 1
        for (int e = 0; e < 32; ++e) { const float o = lane_bcast(lg, 2 * e); rank += (o > lg || (o == lg && e < my_e)) ? 1 : 0; }
        const bool sel = rank < 4 && !(lane & 1);
        const unsigned long long m0 = __ballot(sel && rank == 0), m1 = __ballot(sel && rank == 1), m2 = __ballot(sel && rank == 2), m3 = __ballot(sel && rank == 3);
        const float v0 = lane_bcast(lg, (int)__builtin_ctzll(m0)), v1 = lane_bcast(lg, (int)__builtin_ctzll(m1)), v2 = lane_bcast(lg, (int)__builtin_ctzll(m2)), v3 = lane_bcast(lg, (int)__builtin_ctzll(m3));
        const float e1 = __expf(v1 - v0), e2 = __expf(v2 - v0), e3 = __expf(v3 - v0);
        const float inv = 1.0f / (1.0f + e1 + e2 + e3);
        if (sel) {
            const float gk = __expf(lg - v0) * inv;
            const unsigned pos = atomicAdd(cnt + my_e, 1u);
            SLOTL[(size_t)my_e * T + pos] = t * 4 + rank; GATEL[(size_t)my_e * T + pos] = gk;
        }
    }
}
__device__ __forceinline__ void phase_final(const Args& a, int gw, int NGW, int lane) {
    unsigned char* ws = a.ws;
    const float* xs = (const float*)(ws + WS_XSB); const float* MODS = (const float*)(ws + WS_MODS); const bf16* YS = (const bf16*)(ws + WS_YS);
    for (int t = gw; t < TL; t += NGW) {
        const int mr = t >> 13;
        f32x4 m5[4], x[4];
#pragma unroll
        for (int j = 0; j < 4; ++j) m5[j] = *(const f32x4*)(MODS + (size_t)(3 * 5 + mr) * 6144 + 5 * 1024 + 256 * j + 4 * lane);
        load_x_combined(x, xs + (size_t)t * D, true, YS, t, m5, lane);
        const float rstd = row_rstd(x);
#pragma unroll
        for (int j = 0; j < 4; ++j) { const int col = 256 * j + 4 * lane; *(f32x4*)(a.out + (size_t)t * D + col) = x[j] * rstd * *(const f32x4*)(a.in[7] + col); }
    }
}

using pg8::Unit; using pg8::tile_map;
struct SchedStd {
    int G, c, nM, nN;
    __device__ __forceinline__ bool next(int i, Unit& u) const { const long L = (long)i * G + c; if (L >= (long)nM * nN) return false; int pm, pn; tile_map((int)L, nM, nN, pm, pn); u.pm = pm; u.pn = pn; u.e = 0; u.nv = pm; return true; }
    __device__ __forceinline__ void a_ready(const Unit&) const {}
    __device__ __forceinline__ void done(const Unit&) const {}
    __device__ __forceinline__ unsigned row_off(const Unit&, int) const { return 0u; }
};
struct SchedB1 {
    int G, c;
    __device__ __forceinline__ bool next(int i, Unit& u) const { const long L = (long)i * G + c; constexpr int n1 = 3 * NMT * 4; if (L >= n1 + 3 * NMT) return false; const int l = (int)L;
        if (l < n1) { const int j = l / (NMT * 4), r = l % (NMT * 4); int pm, pn; tile_map(r, NMT, 4, pm, pn); u.pm = j * NMT + pm; u.pn = j * 4 + pn; u.e = j; u.nv = pm; }
        else { const int r = l - n1, j = r / NMT, pm = r % NMT; u.pm = (3 + j) * NMT + pm; u.pn = 12 + j; u.e = 3 + j; u.nv = pm; }
        return true; }
    __device__ __forceinline__ void a_ready(const Unit&) const {}
    __device__ __forceinline__ void done(const Unit&) const {}
    __device__ __forceinline__ unsigned row_off(const Unit&, int) const { return 0u; }
};
struct SchedB2 {
    int G, c;
    __device__ __forceinline__ bool next(int i, Unit& u) const { const long L = (long)i * G + c; constexpr int n1 = 2 * NMT * 8; if (L >= n1 + NMT * 4) return false; const int l = (int)L;
        if (l < n1) { const int j = l / (NMT * 8), r = l % (NMT * 8); int pm, pn; tile_map(r, NMT, 8, pm, pn); u.pm = j * NMT + pm; u.pn = j * 8 + pn; u.e = j; u.nv = pm; }
        else { const int r = l - n1; int pm, pn; tile_map(r, NMT, 4, pm, pn); u.pm = 2 * NMT + pm; u.pn = 16 + pn; u.e = 2; u.nv = pm; }
        return true; }
    __device__ __forceinline__ void a_ready(const Unit&) const {}
    __device__ __forceinline__ void done(const Unit&) const {}
    __device__ __forceinline__ unsigned row_off(const Unit&, int) const { return 0u; }
};
struct SchedMoe {
    int G, c, nnt, ntiles; LAS unsigned char* lds; const int* slotl;
    __device__ __forceinline__ bool next(int i, Unit& u) const { const long L = (long)i * G + c; if (L >= (long)((ntiles + 7) & ~7) * nnt) return false;
        const LAS int* tpre = (const LAS int*)(lds + LDSCTL_OFF + 64); const LAS int* ecnt = (const LAS int*)(lds + LDSCTL_OFF + 256); const LAS unsigned short* tile_e = (const LAS unsigned short*)(lds + LDSCTL_OFF + 512);
        const int xq = (int)(L >> 3), x8 = (int)(L & 7); int tile = (xq / nnt) * 8 + x8; const int pnl = xq % nnt; const bool dead = tile >= ntiles; tile = dead ? 0 : tile;
        const int e = __builtin_amdgcn_readfirstlane((int)tile_e[tile]), r0 = (tile - __builtin_amdgcn_readfirstlane(tpre[e])) * 256; int nv = __builtin_amdgcn_readfirstlane(ecnt[e]) - r0; nv = nv > 256 ? 256 : nv; nv = dead ? 0 : nv;
        u.pm = dead ? MAXTILES : tile; u.pn = e * nnt + pnl; u.e = e; u.nv = nv | (r0 << 9); return true; }
    __device__ __forceinline__ void a_ready(const Unit&) const {}
    __device__ __forceinline__ void done(const Unit&) const {}
    __device__ __forceinline__ unsigned row_off(const Unit& u, int r) const { const int nv = u.nv & 511, r0 = u.nv >> 9; const int tok = r < nv ? (slotl[(size_t)u.e * T + r0 + r] >> 2) : 0; return (unsigned)tok * 2048u; }
};

using pg8::cvt_pk_bf16;
template <class P> __device__ __forceinline__ P* pin_ptr(P* p) { asm volatile("" : "+v"(p)); return p; }
struct EpiB1 {
    static constexpr bool PERM = true, AFTER_DRAIN = false;
    bf16* RKV; bf16* L1;
    __device__ __forceinline__ void operator()(const f32x4 (&acc)[2][2][4][2], const Unit& u, int wr, int wc, int fr, int fq) const {
        const int seg = u.e, row0 = u.nv * 256 + wr * 64 + fr;
        const int jj = seg - 3, ld = seg < 3 ? D : 256, col0 = (seg < 3 ? (u.pn - seg * 4) * 256 : 0) + wc * 32 + 8 * fq;
        bf16* base = seg < 3 ? RKV + (size_t)seg * T * D : L1 + (size_t)jj * T * 256;
#pragma unroll
        for (int ai = 0; ai < 2; ++ai)
#pragma unroll
            for (int m = 0; m < 4; ++m) { bf16* rowp = base + (size_t)(row0 + ai * 128 + m * 16) * ld + col0;
#pragma unroll
                for (int bj = 0; bj < 2; ++bj) { f32x4 v0 = acc[ai][bj][m][0], v1 = acc[ai][bj][m][1];
                    if (jj == 0) {
#pragma unroll
                        for (int q = 0; q < 4; ++q) { v0[q] = tanh_fast(v0[q]); v1[q] = tanh_fast(v1[q]); } }
                    else if (jj == 2) {
#pragma unroll
                        for (int q = 0; q < 4; ++q) { v0[q] = sigm(v0[q]); v1[q] = sigm(v1[q]); } }
                    u32x4 w; w.x = cvt_pk_bf16(v0[0], v0[1]); w.y = cvt_pk_bf16(v0[2], v0[3]); w.z = cvt_pk_bf16(v1[0], v1[1]); w.w = cvt_pk_bf16(v1[2], v1[3]);
                    *(u32x4*)(rowp + bj * 128) = w; } }
    }
};
struct EpiB2 {
    static constexpr bool PERM = true, AFTER_DRAIN = false;
    bf16* RW; bf16* RA; bf16* Gg;
    __device__ __forceinline__ void operator()(const f32x4 (&acc)[2][2][4][2], const Unit& u, int wr, int wc, int fr, int fq) const {
        const int jj = u.e, row0 = u.nv * 256 + wr * 64 + fr, pnl = u.pn - jj * 8;
        const int dirn = jj < 2 ? (pnl >> 2) : 0, col0 = (jj < 2 ? (pnl & 3) : pnl) * 256 + wc * 32 + 8 * fq;
        bf16* base = (jj == 0 ? RW : jj == 1 ? RA : Gg) + (size_t)dirn * T * D;
#pragma unroll
        for (int ai = 0; ai < 2; ++ai)
#pragma unroll
            for (int m = 0; m < 4; ++m) { bf16* rowp = base + (size_t)(row0 + ai * 128 + m * 16) * D + col0;
#pragma unroll
                for (int bj = 0; bj < 2; ++bj) { const f32x4 v0 = acc[ai][bj][m][0], v1 = acc[ai][bj][m][1];
                    u32x4 w; w.x = cvt_pk_bf16(v0[0], v0[1]); w.y = cvt_pk_bf16(v0[2], v0[3]); w.z = cvt_pk_bf16(v1[0], v1[1]); w.w = cvt_pk_bf16(v1[2], v1[3]);
                    *(u32x4*)(rowp + bj * 128) = w; } }
    }
};
struct EpiRes {
    static constexpr bool PERM = true, AFTER_DRAIN = false;
    float* X; const float* gate;
    __device__ __forceinline__ void operator()(const f32x4 (&acc)[2][2][4][2], const Unit& u, int wr, int wc, int fr, int fq) const {
        const int row0 = u.pm * 256 + wr * 64 + fr, col0 = u.pn * 256 + wc * 32 + 8 * fq, mr = u.pm < NMT_L ? (u.pm >> 5) : 4;
        const float* gp = pin_ptr(gate + (size_t)mr * 6144 + col0);
        f32x4 gv[2][2];
#pragma unroll
        for (int bj = 0; bj < 2; ++bj)
#pragma unroll
            for (int n = 0; n < 2; ++n) gv[bj][n] = *(const f32x4*)(gp + bj * 128 + 4 * n);
#pragma unroll
        for (int ai = 0; ai < 2; ++ai)
#pragma unroll
            for (int m = 0; m < 4; ++m) { float* rowp = X + (size_t)(row0 + ai * 128 + m * 16) * D + col0;
#pragma unroll
                for (int bj = 0; bj < 2; ++bj)
#pragma unroll
                    for (int n = 0; n < 2; ++n) { float* p = rowp + bj * 128 + 4 * n; *(f32x4*)p = *(const f32x4*)p + gv[bj][n] * acc[ai][bj][m][n]; } }
    }
};
struct EpiWin {
    static constexpr bool PERM = true, AFTER_DRAIN = false;
    bf16* BG; bf16* CU;
    __device__ __forceinline__ void operator()(const f32x4 (&acc)[2][2][4][2], const Unit& u, int wr, int wc, int fr, int fq) const {
        const int row0 = u.pm * 256 + wr * 64 + fr;
        if (u.pn < 4) {
            const int col0 = u.pn * 256 + wc * 32 + 8 * fq;
#pragma unroll
            for (int ai = 0; ai < 2; ++ai)
#pragma unroll
                for (int m = 0; m < 4; ++m) { bf16* rowp = BG + (size_t)(row0 + ai * 128 + m * 16) * D + col0;
#pragma unroll
                    for (int bj = 0; bj < 2; ++bj) { const f32x4 v0 = acc[ai][bj][m][0], v1 = acc[ai][bj][m][1];
                        u32x4 w; w.x = cvt_pk_bf16(v0[0], v0[1]); w.y = cvt_pk_bf16(v0[2], v0[3]); w.z = cvt_pk_bf16(v1[0], v1[1]); w.w = cvt_pk_bf16(v1[2], v1[3]);
                        *(u32x4*)(rowp + bj * 128) = w; } }
        } else {
            const int f0 = (u.pn - 4) * 128 + wc * 32 + 8 * fq;
#pragma unroll
            for (int ai = 0; ai < 2; ++ai)
#pragma unroll
                for (int m = 0; m < 4; ++m) { const f32x4 v0 = acc[ai][0][m][0] * acc[ai][1][m][0], v1 = acc[ai][0][m][1] * acc[ai][1][m][1];
                    u32x4 w; w.x = cvt_pk_bf16(v0[0], v0[1]); w.y = cvt_pk_bf16(v0[2], v0[3]); w.z = cvt_pk_bf16(v1[0], v1[1]); w.w = cvt_pk_bf16(v1[2], v1[3]);
                    *(u32x4*)(CU + (size_t)(row0 + ai * 128 + m * 16) * D + f0) = w; }
        }
    }
};
struct EpiGU {
    static constexpr bool PERM = true, AFTER_DRAIN = false;
    bf16* INTER; const float* bgu;
    __device__ __forceinline__ void operator()(const f32x4 (&acc)[2][2][4][2], const Unit& u, int wr, int wc, int fr, int fq) const {
        const int e = u.e, pnl = u.pn - e * 8, row0 = u.pm * 256 + wr * 64 + fr, f0 = pnl * 128 + wc * 32 + 8 * fq;
        const float* bp = pin_ptr(bgu + (size_t)e * 2048 + f0);
        f32x4 bg[2], bu[2];
#pragma unroll
        for (int n = 0; n < 2; ++n) { bg[n] = *(const f32x4*)(bp + 4 * n); bu[n] = *(const f32x4*)(bp + 1024 + 4 * n); }
#pragma unroll
        for (int ai = 0; ai < 2; ++ai)
#pragma unroll
            for (int m = 0; m < 4; ++m) { f32x4 o[2];
#pragma unroll
                for (int n = 0; n < 2; ++n) { const f32x4 g = acc[ai][0][m][n] + bg[n], uu = acc[ai][1][m][n] + bu[n];
#pragma unroll
                    for (int q = 0; q < 4; ++q) { const float gc = fminf(g[q], 7.0f), uc = fminf(fmaxf(uu[q], -7.0f), 7.0f); o[n][q] = (uc + 1.0f) * gc * sigm(1.702f * gc); } }
                u32x4 w; w.x = cvt_pk_bf16(o[0][0], o[0][1]); w.y = cvt_pk_bf16(o[0][2], o[0][3]); w.z = cvt_pk_bf16(o[1][0], o[1][1]); w.w = cvt_pk_bf16(o[1][2], o[1][3]);
                *(u32x4*)(INTER + (size_t)(row0 + ai * 128 + m * 16) * 1024 + f0) = w; }
    }
};
struct EpiDown {
    static constexpr bool PERM = true, AFTER_DRAIN = false;
    bf16* YS; const float* bdn; const int* slotl; const float* gatel;
    __device__ __forceinline__ void operator()(const f32x4 (&acc)[2][2][4][2], const Unit& u, int wr, int wc, int fr, int fq) const {
        const int e = u.e, pnl = u.pn - e * 4, col0 = pnl * 256 + wc * 32 + 8 * fq, nv = u.nv & 511, r0 = u.nv >> 9;
        const float* bp = pin_ptr(bdn + (size_t)e * 1024 + col0);
        f32x4 bv[2][2];
#pragma unroll
        for (int bj = 0; bj < 2; ++bj)
#pragma unroll
            for (int n = 0; n < 2; ++n) bv[bj][n] = *(const f32x4*)(bp + bj * 128 + 4 * n);
#pragma unroll
        for (int ai = 0; ai < 2; ++ai)
#pragma unroll
            for (int m = 0; m < 4; ++m) { const int r = ai * 128 + wr * 64 + m * 16 + fr;
                if (r < nv) { const size_t li = (size_t)e * T + r0 + r; const int slot = slotl[li]; const float gt = gatel[li];
                    bf16* rowp = YS + (size_t)slot * 1024 + col0;
#pragma unroll
                    for (int bj = 0; bj < 2; ++bj) { const f32x4 v0 = (acc[ai][bj][m][0] + bv[bj][0]) * gt, v1 = (acc[ai][bj][m][1] + bv[bj][1]) * gt;
                        u32x4 w; w.x = cvt_pk_bf16(v0[0], v0[1]); w.y = cvt_pk_bf16(v0[2], v0[3]); w.z = cvt_pk_bf16(v1[0], v1[1]); w.w = cvt_pk_bf16(v1[2], v1[3]);
                        *(u32x4*)(rowp + bj * 128) = w; } } }
    }
};

__device__ __forceinline__ int moe_tables(const unsigned* cnt, LAS unsigned char* lds, int tid) {
    LAS int* tpre = (LAS int*)(lds + LDSCTL_OFF + 64); LAS int* ecnt = (LAS int*)(lds + LDSCTL_OFF + 256); LAS unsigned short* tile_e = (LAS unsigned short*)(lds + LDSCTL_OFF + 512);
    if (tid == 0) { int p = 0; for (int e = 0; e < 32; ++e) { const int cn = (int)__hip_atomic_load(cnt + e, __ATOMIC_RELAXED, __HIP_MEMORY_SCOPE_AGENT); ecnt[e] = cn; tpre[e] = p; p += (cn + 255) >> 8; } tpre[32] = p; }
    __syncthreads();
    const int nt = tpre[32];
    for (int t = tid; t < nt; t += 512) { int e = 0; while (e < 31 && t >= tpre[e + 1]) ++e; tile_e[t] = (unsigned short)e; }
    __syncthreads();
    return nt;
}

constexpr int NPHASES = 38;
typedef const Args __attribute__((address_space(4))) CArgs;
__global__ void __launch_bounds__(512, 2) fwd_kernel(Args a_) {
    extern __shared__ __attribute__((aligned(16))) unsigned char lds_raw[];
    LAS unsigned char* lds = (LAS unsigned char*)lds_raw;
    const int G = gridDim.x, NGW = G * 8;
    CArgs* ap0 = (CArgs*)__builtin_amdgcn_kernarg_segment_ptr();
    if (threadIdx.x < 4) ((LAS unsigned*)(lds + LDSCTL_OFF))[threadIdx.x] = 0u;
    __syncthreads();
    XcdBarrier bar = xcd_barrier_post((unsigned*)(a_.ws + WS_CTL) + CW_BAR, (volatile LAS unsigned*)(lds + LDSCTL_OFF));
    const int lo = a_.ph_lo, hi = a_.ph_hi;
    int ph = 0;
#ifndef MK_ONLY
#define MK_ONLY -1
#endif
#ifndef MK_DBL
#define MK_DBL 0
#endif
#define PH_BEGIN(id) if ((MK_ONLY < 0 || MK_ONLY == (id)) && ph >= lo && ph < hi) { for (int rep_ = 0; rep_ <= ((MK_DBL >> (id)) & 1); ++rep_) { CArgs* ap = ap0; asm volatile("" : "+s"(ap)); const Args a = *(const Args*)ap; unsigned char* const ws = a.ws; (void)ws; const int wave = (int)bar.wv; int tid = wave * 64 + lane_id(); asm volatile("" : "+v"(tid)); const int lane = tid & 63, gw = blockIdx.x * 8 + wave; (void)lane; (void)gw;
#define PH_END } } if (ph >= lo && ph + 1 < hi) xcd_barrier(bar); ++ph;

    PH_BEGIN(0) p0_prologue(a, lds, tid, lane, wave, G); PH_END

#pragma unroll 1
    for (int layer = 0; layer < DEPTH; ++layer) {
        const int kind = layer & 1, lj = layer >> 1;
        const int rows = layer == 3 ? TL : T, nmt = rows / 256;
        const int rows_moe = layer < 2 ? T : TL;
        if (kind == 0) {
            PH_BEGIN(1) phase_a_rwkv(a, layer, lds, tid, gw, NGW, lane); PH_END
            PH_BEGIN(2) {
                pg8::Gemm g{(const bf16*)(ws + WS_XL), (const bf16*)(ws + WS_WRKV) + (size_t)lj * 3840 * 1024, 6 * T, 3840, 1024};
                SchedB1 S{G, (int)blockIdx.x}; EpiB1 E{(bf16*)(ws + WS_RKV), (bf16*)(ws + WS_L1)};
                pg8::gemm_phase<EpiB1, SchedB1, true, true, false>(lds, g, S, E, tid); } PH_END
            PH_BEGIN(3) {
                pg8::Gemm g{(const bf16*)(ws + WS_L1), (const bf16*)(ws + WS_L2T) + (size_t)lj * 5120 * 256, 3 * T, 5120, 256};
                SchedB2 S{G, (int)blockIdx.x}; EpiB2 E{(bf16*)(ws + WS_RAWW), (bf16*)(ws + WS_RAWA), (bf16*)(ws + WS_G)};
                pg8::gemm_phase<EpiB2, SchedB2, true, true, false>(lds, g, S, E, tid); } PH_END
            PH_BEGIN(4) phase_c_prep(a, lj, lds, tid, gw, NGW, lane); PH_END
            PH_BEGIN(5) phase_s1_chunks(a, lds, tid, G); PH_END
            PH_BEGIN(15) phase_s2_chain(a, wave, lane, G); PH_END
            PH_BEGIN(6) phase_s3_readout(a, lj, gw, NGW, lane); PH_END
        } else {
            PH_BEGIN(7) phase_a_conv(a, layer, rows, gw, NGW, lane); PH_END
            PH_BEGIN(8) {
                pg8::Gemm g{(const bf16*)(ws + WS_XL), (const bf16*)(ws + WS_WIN) + (size_t)lj * 3072 * 1024, rows, 3072, 1024};
                SchedStd S{G, (int)blockIdx.x, nmt, 12}; EpiWin E{(bf16*)(ws + WS_BG), (bf16*)(ws + WS_CUZ)};
                pg8::gemm_phase<EpiWin, SchedStd, true, true, false>(lds, g, S, E, tid); } PH_END
            PH_BEGIN(9) phase_cv(a, lj, rows, gw, NGW, lane); PH_END
        }
        PH_BEGIN(10) {
            const bf16* Wt = kind == 0 ? (const bf16*)(ws + WS_WO) + (size_t)lj * 1024 * 1024 : (const bf16*)(ws + WS_WOUT) + (size_t)lj * 1024 * 1024;
            pg8::Gemm g{(const bf16*)(ws + WS_Z), Wt, rows, 1024, 1024};
            SchedStd S{G, (int)blockIdx.x, nmt, 4}; EpiRes E{(float*)(ws + (layer < 2 ? WS_XSA : WS_XSB)), (const float*)(ws + WS_MODS) + (size_t)layer * 5 * 6144 + 2 * 1024};
            pg8::gemm_phase<EpiRes, SchedStd, true, true, false>(lds, g, S, E, tid); } PH_END
        PH_BEGIN(11) phase_e_route(a, layer, rows_moe, lds, tid, gw, NGW, lane); PH_END
        PH_BEGIN(12) {
            const int nt = __builtin_amdgcn_readfirstlane(moe_tables((const unsigned*)(ws + WS_CTL) + CW_CNT + layer * 64, lds, tid));
            pg8::Gemm g{(const bf16*)(ws + WS_H2), (const bf16*)(ws + WS_WGU) + (size_t)layer * 32 * 2048 * 1024, 0, 0, 1024};
            SchedMoe S{G, (int)blockIdx.x, 8, nt, lds, (const int*)(ws + WS_SLOTL)};
            EpiGU E{(bf16*)(ws + WS_INTER), a.in[30] + (size_t)layer * 32 * 2048};
            pg8::gemm_phase<EpiGU, SchedMoe, true, true, true>(lds, g, S, E, tid); } PH_END
        PH_BEGIN(13) {
            const int nt = __builtin_amdgcn_readfirstlane(moe_tables((const unsigned*)(ws + WS_CTL) + CW_CNT + layer * 64, lds, tid));
            pg8::Gemm g{(const bf16*)(ws + WS_INTER), (const bf16*)(ws + WS_WDN) + (size_t)layer * 32 * 1024 * 1024, 0, 0, 1024};
            SchedMoe S{G, (int)blockIdx.x, 4, nt, lds, (const int*)(ws + WS_SLOTL)};
            EpiDown E{(bf16*)(ws + WS_YS), a.in[32] + (size_t)layer * 32 * 1024, (const int*)(ws + WS_SLOTL), (const float*)(ws + WS_GATEL)};
            pg8::gemm_phase<EpiDown, SchedMoe, true, true, false>(lds, g, S, E, tid); } PH_END
    }
    PH_BEGIN(14) phase_final(a, gw, NGW, lane); PH_END
#undef PH_BEGIN
#undef PH_END
}

extern "C" void kernel_launch(void* const* d_in, const int* in_sizes, int n_in, void* d_out, int out_size, void* d_ws, size_t ws_size, hipStream_t stream) {
    static int grid = 0;
    if (grid == 0) {
        if (n_in != 33 || in_sizes[0] != TL * D || out_size != TL * D || ws_size < WS_END) { fprintf(stderr, "kernel_launch: unexpected problem (n_in %d, in0 %d, out %d, ws %zu < %zu)\n", n_in, n_in > 0 ? in_sizes[0] : -1, out_size, ws_size, (size_t)WS_END); grid = -1; return; }
        int dev = 0, cus = 0, per_cu = 0;
        if (hipGetDevice(&dev) != hipSuccess || hipDeviceGetAttribute(&cus, hipDeviceAttributeMultiprocessorCount, dev) != hipSuccess) { grid = -1; return; }
        if (hipFuncSetAttribute((const void*)fwd_kernel, hipFuncAttributeMaxDynamicSharedMemorySize, LDS_BYTES) != hipSuccess) { fprintf(stderr, "kernel_launch: hipFuncSetAttribute failed\n"); grid = -1; return; }
        if (hipOccupancyMaxActiveBlocksPerMultiprocessor(&per_cu, (const void*)fwd_kernel, 512, LDS_BYTES) != hipSuccess || per_cu < 1) fprintf(stderr, "kernel_launch: occupancy query says %d\n", per_cu);
        (void)hipGetLastError();
        grid = cus;
    }
    if (grid < 0) return;
    if (hipMemsetAsync((char*)d_ws + WS_CTL, 0, CTL_ZERO_BYTES, stream) != hipSuccess) return;
    Args a{};
    for (int i = 0; i < 33; ++i) a.in[i] = (const float*)d_in[i];
    a.out = (float*)d_out; a.ws = (unsigned char*)d_ws;
#if MK_PER_PHASE
    for (int p = 0; p < NPHASES; ++p) { a.ph_lo = p; a.ph_hi = p + 1; hipLaunchKernelGGL(fwd_kernel, dim3(grid), dim3(512), LDS_BYTES, stream, a); }
#else
    a.ph_lo = 0; a.ph_hi = NPHASES;
    hipLaunchKernelGGL(fwd_kernel, dim3(grid), dim3(512), LDS_BYTES, stream, a);
#endif
    const hipError_t le = hipPeekAtLastError();
    if (le != hipSuccess) fprintf(stderr, "kernel_launch: launch failed: %s\n", hipGetErrorName(le));
}
```

```cpp
#include <hip/hip_runtime.h>
#include <cstdio>
#include <cstdint>

#ifndef MK_PER_PHASE
#define MK_PER_PHASE 0
#endif

constexpr int D = 1024, NBATCH = 4, SEQ = 8192, TL = NBATCH * SEQ, CTXL = 256, TC = NBATCH * CTXL, T = TL + TC;
constexpr int NH = 16, HS = 64, NE = 32, TOPK = 4, DEPTH = 4;
constexpr int NMT = T / 256;
constexpr int NMT_L = TL / 256;
constexpr int MAXTILES = (T * TOPK) / 256 + NE;
constexpr int NSTEP = CTXL + SEQ;

__device__ __forceinline__ int lane_id() { return (int)__builtin_amdgcn_mbcnt_hi(~0u, __builtin_amdgcn_mbcnt_lo(~0u, 0u)); }
namespace pg8 {
#define PG8_LAS __attribute__((address_space(3)))
typedef unsigned short bf16_t;
typedef short bf16x8 __attribute__((ext_vector_type(8)));
typedef float f32x4 __attribute__((ext_vector_type(4)));
typedef unsigned u32x4 __attribute__((ext_vector_type(4)));
typedef unsigned u32x2 __attribute__((ext_vector_type(2)));
constexpr int BM = 256, BK = 64, HALF = 128, HTB = HALF * BK * 2  , STAGE_BYTES = 8 * HTB, NXCD = 8, WGM = 8;

__host__ __device__ __forceinline__ int lds_byte(int r, int c) { const int st = (r >> 4) * 2 + (c >> 5), rr = r & 15, cc = c & 31, ob = rr * 64 + cc * 2; return st * 1024 + (ob ^ (((ob >> 9) & 1) << 5)); }
__host__ __device__ __forceinline__ void stage_rc(int b, int& R, int& C) { const int st = b / 1024, sb = b % 1024, swz = sb ^ (((sb >> 9) & 1) << 5); R = (st >> 1) * 16 + swz / 64; C = (st & 1) * 32 + (swz % 64) / 2; }
__host__ __device__ __forceinline__ int perm32(int rho) { const int n = rho >> 4, i = rho & 15; return 8 * (i >> 2) + 4 * n + (i & 3); }

struct Unit { int pm, pn, e, nv; };
struct Gemm { const bf16_t* A; const bf16_t* Bt; int M, N, K; };

__device__ __forceinline__ void tile_map(int wgid, int nM, int nN, int& pm, int& pn) {
    const int nwg = nM * nN;
    { const int q = nwg / NXCD, r = nwg % NXCD, xcd = wgid % NXCD, off = wgid / NXCD; wgid = (xcd < r ? xcd * (q + 1) : r * (q + 1) + (xcd - r) * q) + off; }
    const int nig = WGM * nN, gid = wgid / nig, fm = gid * WGM, gsz = (nM - fm) < WGM ? (nM - fm) : WGM;
    pm = fm + ((wgid % nig) % gsz); pn = (wgid % nig) / gsz;
}
typedef __bf16 bf16x2_t __attribute__((ext_vector_type(2)));
typedef float f32x2_t __attribute__((ext_vector_type(2)));
__device__ __forceinline__ unsigned cvt_pk_bf16(float lo, float hi) { const f32x2_t v = {lo, hi}; const bf16x2_t b = __builtin_convertvector(v, bf16x2_t); return __builtin_bit_cast(unsigned, b); }

template <class Epi, class Sched, bool ALIGN_EPI = false, bool SP2 = false, bool GATHER = false>
__device__ __forceinline__ void gemm_phase(PG8_LAS unsigned char* lds, const Gemm g, const Sched& S, const Epi& E, int tid_in) {
    int tid_ = tid_in; asm volatile("" : "+v"(tid_));
    const int tid = tid_, wid = __builtin_amdgcn_readfirstlane(tid >> 6), lane = tid & 63, wr = wid >> 2, wc = wid & 3, fr = lane & 15, fq = lane >> 4;
    int K_ = g.K; asm volatile("" : "+s"(K_));
    const int K = K_, nt = K / BK;
    unsigned voffA[2], voffB[2]; int gR[2]; unsigned gC[2];
#pragma unroll
    for (int i = 0; i < 2; ++i) { int R, C; stage_rc(tid * 16 + i * 8192, R, C); const int Rb = Epi::PERM ? ((R & ~31) + perm32(R & 31)) : R;
        voffA[i] = (unsigned)(R * K + C) * 2u; voffB[i] = (unsigned)(Rb * K + C) * 2u; gR[i] = R; gC[i] = (unsigned)C * 2u; }
    unsigned oc[2][2], on[2][2], o2[2][2];
#pragma unroll
    for (int h = 0; h < 2; ++h)
#pragma unroll
        for (int i = 0; i < 2; ++i) { oc[h][i] = 0u; on[h][i] = 0u; o2[h][i] = 0u; }
    const size_t kstep = (size_t)(BK * 2);
    const size_t hstep = (size_t)HALF * K * 2;
    const size_t tstep = 2 * hstep;
    const unsigned ldsw = (unsigned)wid * 1024u;
    const int aoff = lds_byte(wr * 64 + fr, fq * 8), boff = lds_byte(wc * 32 + fr, fq * 8);
#define PG8_SA(b, h) (((b) * 2 + (h)) * HTB)
#define PG8_SB(b, h) ((4 + (b) * 2 + (h)) * HTB)
#define PG8_STAGE(bufoff, gbase, voff) do { _Pragma("unroll") for (int _i = 0; _i < 2; ++_i) \
        __builtin_amdgcn_global_load_lds((const unsigned*)((const char*)(gbase) + (voff)[_i]), (PG8_LAS unsigned*)(lds + (bufoff) + ldsw + _i * 8192), 16, 0, 0); } while (0)
#define PG8_STAGE_A(bufoff, base, h, O) do { if constexpr (GATHER) { PG8_STAGE(bufoff, base, (O)[h]); } else { PG8_STAGE(bufoff, (base) + (h) * hstep, voffA); } } while (0)
#define PG8_LDA(dst, b, h) do { _Pragma("unroll") for (int m = 0; m < 4; ++m) _Pragma("unroll") for (int k = 0; k < 2; ++k) dst[m][k] = *(const PG8_LAS bf16x8*)(lds + PG8_SA(b, h) + aoff + m * 2048 + k * 1024); } while (0)
#define PG8_LDB(dst, b, h) do { _Pragma("unroll") for (int n = 0; n < 2; ++n) _Pragma("unroll") for (int k = 0; k < 2; ++k) dst[n][k] = *(const PG8_LAS bf16x8*)(lds + PG8_SB(b, h) + boff + n * 2048 + k * 1024); } while (0)
#define PG8_MMA(ai, bj, At, Bt) do { __builtin_amdgcn_s_setprio(1); _Pragma("unroll") for (int m = 0; m < 4; ++m) _Pragma("unroll") for (int n = 0; n < 2; ++n) _Pragma("unroll") for (int k = 0; k < 2; ++k) \
        acc[ai][bj][m][n] = __builtin_amdgcn_mfma_f32_16x16x32_bf16(Bt[n][k], At[m][k], acc[ai][bj][m][n], 0, 0, 0); __builtin_amdgcn_s_setprio(0); } while (0)
#define PG8_WAIT_V(n) asm volatile("s_waitcnt vmcnt(" #n ")" ::: "memory")
#define PG8_WAIT_L(n) asm volatile("s_waitcnt lgkmcnt(" #n ")" ::: "memory")
#define PG8_BAR __builtin_amdgcn_s_barrier()
#define PG8_SCHED __builtin_amdgcn_sched_barrier(0)
    Unit cur, nxt; int ui = 0;
    if (!S.next(0, cur)) return;
    f32x4 acc[2][2][4][2];
#pragma unroll
    for (int a = 0; a < 2; ++a)
#pragma unroll
        for (int b = 0; b < 2; ++b)
#pragma unroll
            for (int m = 0; m < 4; ++m)
#pragma unroll
                for (int n = 0; n < 2; ++n) acc[a][b][m][n] = (f32x4){0.f, 0.f, 0.f, 0.f};
    bf16x8 At[4][2], B0[2][2], B1[2][2];
    const char* cA = GATHER ? (const char*)g.A : (const char*)g.A + (size_t)cur.pm * tstep; const char* cB = (const char*)g.Bt + (size_t)cur.pn * tstep;
    S.a_ready(cur);
    if constexpr (GATHER) {
#pragma unroll
        for (int h = 0; h < 2; ++h)
#pragma unroll
            for (int i = 0; i < 2; ++i) oc[h][i] = S.row_off(cur, h * HALF + gR[i]) + gC[i];
    }
    if constexpr (SP2) {
        PG8_STAGE(PG8_SB(0, 0), cB, voffB); PG8_STAGE(PG8_SB(0, 1), cB + hstep, voffB); PG8_STAGE_A(PG8_SA(0, 0), cA, 0, oc); PG8_STAGE_A(PG8_SA(0, 1), cA, 1, oc);
        if (wr == 1) PG8_BAR;
        PG8_WAIT_V(2); PG8_BAR;
        PG8_STAGE(PG8_SB(1, 0), cB + kstep, voffB); PG8_STAGE_A(PG8_SA(1, 0), cA + kstep, 0, oc); PG8_STAGE(PG8_SB(1, 1), cB + hstep + kstep, voffB);
        PG8_WAIT_V(6); PG8_BAR;
    } else {
        PG8_STAGE(PG8_SB(0, 0), cB, voffB); PG8_STAGE_A(PG8_SA(0, 0), cA, 0, oc); PG8_STAGE(PG8_SB(0, 1), cB + hstep, voffB); PG8_STAGE_A(PG8_SA(0, 1), cA, 1, oc);
        if (wr == 1) PG8_BAR;
        PG8_WAIT_V(4); PG8_BAR;
        PG8_STAGE(PG8_SB(1, 0), cB + kstep, voffB); PG8_STAGE_A(PG8_SA(1, 0), cA + kstep, 0, oc); PG8_STAGE(PG8_SB(1, 1), cB + hstep + kstep, voffB);
        PG8_WAIT_V(6); PG8_BAR;
    }
    for (;;) {
        const bool has_next = S.next(ui + 1, nxt);
        const char* nA = GATHER ? (const char*)g.A : (has_next ? (const char*)g.A + (size_t)nxt.pm * tstep : cA); const char* nB = has_next ? (const char*)g.Bt + (size_t)nxt.pn * tstep : cB;
        if constexpr (GATHER) {
#pragma unroll
            for (int h = 0; h < 2; ++h)
#pragma unroll
                for (int i = 0; i < 2; ++i) on[h][i] = has_next ? (S.row_off(nxt, h * HALF + gR[i]) + gC[i]) : oc[h][i];
        }
        for (int t = 0; t < nt; t += 2) {
            const bool last = (t == nt - 2);
            const char* a1 = cA + (size_t)(t + 1) * kstep;
            const char* a2 = last ? nA : cA + (size_t)(t + 2) * kstep; const char* b2 = last ? nB : cB + (size_t)(t + 2) * kstep;
            const char* a3 = a2 + kstep; const char* b3 = b2 + kstep;
            if constexpr (GATHER) {
#pragma unroll
                for (int h = 0; h < 2; ++h)
#pragma unroll
                    for (int i = 0; i < 2; ++i) o2[h][i] = last ? on[h][i] : oc[h][i];
            }
            if (last && has_next) S.a_ready(nxt);
            if constexpr (SP2) {
            PG8_LDB(B0, 0, 0); PG8_LDB(B1, 0, 1); PG8_SCHED; PG8_LDA(At, 0, 0); PG8_STAGE_A(PG8_SA(1, 1), a1, 1, oc);
            PG8_WAIT_V(8); PG8_WAIT_L(0); PG8_BAR; PG8_MMA(0, 0, At, B0); PG8_MMA(0, 1, At, B1); PG8_BAR; PG8_SCHED;
            PG8_LDA(At, 0, 1); PG8_STAGE(PG8_SB(0, 0), b2, voffB); PG8_STAGE(PG8_SB(0, 1), b2 + hstep, voffB); PG8_STAGE_A(PG8_SA(0, 0), a2, 0, o2);
            PG8_WAIT_V(8); PG8_WAIT_L(0); PG8_BAR; PG8_MMA(1, 0, At, B0); PG8_MMA(1, 1, At, B1); PG8_BAR; PG8_SCHED;
            PG8_LDB(B0, 1, 0); PG8_LDB(B1, 1, 1); PG8_SCHED; PG8_LDA(At, 1, 0); PG8_STAGE_A(PG8_SA(0, 1), a2, 1, o2);
            PG8_WAIT_V(8); PG8_WAIT_L(0); PG8_BAR; PG8_MMA(0, 0, At, B0); PG8_MMA(0, 1, At, B1); PG8_BAR; PG8_SCHED;
            PG8_LDA(At, 1, 1); PG8_STAGE(PG8_SB(1, 0), b3, voffB); PG8_STAGE(PG8_SB(1, 1), b3 + hstep, voffB); PG8_STAGE_A(PG8_SA(1, 0), a3, 0, o2);
            PG8_WAIT_V(8); PG8_WAIT_L(0); PG8_BAR; PG8_MMA(1, 0, At, B0); PG8_MMA(1, 1, At, B1); PG8_BAR; PG8_SCHED;
            } else {
            PG8_LDB(B0, 0, 0); PG8_SCHED; PG8_LDA(At, 0, 0); PG8_STAGE_A(PG8_SA(1, 1), a1, 1, oc);
            PG8_WAIT_L(8); PG8_BAR; PG8_WAIT_L(0); PG8_MMA(0, 0, At, B0); PG8_BAR; PG8_SCHED;
            PG8_LDB(B1, 0, 1); PG8_STAGE(PG8_SB(0, 0), b2, voffB);
            PG8_BAR; PG8_WAIT_L(0); PG8_MMA(0, 1, At, B1); PG8_BAR;
            PG8_LDA(At, 0, 1); PG8_STAGE_A(PG8_SA(0, 0), a2, 0, o2);
            PG8_BAR; PG8_WAIT_L(0); PG8_MMA(1, 0, At, B0); PG8_BAR; PG8_SCHED;
            PG8_STAGE(PG8_SB(0, 1), b2 + hstep, voffB);
            PG8_WAIT_V(6); PG8_BAR; PG8_MMA(1, 1, At, B1); PG8_BAR;
            PG8_LDB(B0, 1, 0); PG8_SCHED; PG8_LDA(At, 1, 0); PG8_STAGE_A(PG8_SA(0, 1), a2, 1, o2);
            PG8_WAIT_L(8); PG8_BAR; PG8_WAIT_L(0); PG8_MMA(0, 0, At, B0); PG8_BAR; PG8_SCHED;
            PG8_LDB(B1, 1, 1); PG8_STAGE(PG8_SB(1, 0), b3, voffB);
            PG8_BAR; PG8_WAIT_L(0); PG8_MMA(0, 1, At, B1); PG8_BAR;
            PG8_LDA(At, 1, 1); PG8_STAGE_A(PG8_SA(1, 0), a3, 0, o2);
            PG8_BAR; PG8_WAIT_L(0); PG8_MMA(1, 0, At, B0); PG8_BAR; PG8_SCHED;
            PG8_STAGE(PG8_SB(1, 1), b3 + hstep, voffB);
            PG8_WAIT_V(6); PG8_BAR; PG8_MMA(1, 1, At, B1); PG8_BAR;
            }
        }
        if constexpr (ALIGN_EPI) { if (wr == 0) PG8_BAR; }
        if constexpr (!Epi::AFTER_DRAIN) { E(acc, cur, wr, wc, fr, fq); S.done(cur); }
        if (!has_next) break;
#pragma unroll
        for (int a = 0; a < 2; ++a)
#pragma unroll
            for (int b = 0; b < 2; ++b)
#pragma unroll
                for (int m = 0; m < 4; ++m)
#pragma unroll
                    for (int n = 0; n < 2; ++n) acc[a][b][m][n] = (f32x4){0.f, 0.f, 0.f, 0.f};
        cur = nxt; cA = nA; cB = nB; ++ui;
        if constexpr (GATHER) {
#pragma unroll
            for (int h = 0; h < 2; ++h)
#pragma unroll
                for (int i = 0; i < 2; ++i) oc[h][i] = on[h][i];
        }
        if constexpr (ALIGN_EPI) { if (wr == 1) PG8_BAR; }
    }
    PG8_WAIT_V(0);
    if constexpr (!ALIGN_EPI) { if (wr == 0) PG8_BAR; }
    PG8_BAR;
    if constexpr (Epi::AFTER_DRAIN) { E.fused(acc, cur, wr, wc, fr, fq, lds, wid, lane); S.done(cur); }
#undef PG8_SA
#undef PG8_SB
#undef PG8_STAGE
#undef PG8_STAGE_A
#undef PG8_LDA
#undef PG8_LDB
#undef PG8_MMA
#undef PG8_WAIT_V
#undef PG8_WAIT_L
#undef PG8_BAR
#undef PG8_SCHED
}
}

#define LAS __attribute__((address_space(3)))
typedef unsigned short bf16;
typedef float f32x4 __attribute__((ext_vector_type(4)));
typedef unsigned u32x2 __attribute__((ext_vector_type(2)));
typedef unsigned u32x4 __attribute__((ext_vector_type(4)));
#define LDS_WAIT() asm volatile("s_waitcnt lgkmcnt(0)" ::: "memory")
__device__ __forceinline__ unsigned pk2(float lo, float hi) { return pg8::cvt_pk_bf16(lo, hi); }
__device__ __forceinline__ unsigned f2bf(float f) { return pk2(f, f) & 0xffffu; }
__device__ __forceinline__ float bflo(unsigned w) { return __builtin_bit_cast(float, w << 16); }
__device__ __forceinline__ float bfhi(unsigned w) { return __builtin_bit_cast(float, w & 0xffff0000u); }
__device__ __forceinline__ float wave_sum(float v) {
#pragma unroll
    for (int o = 1; o < 64; o <<= 1) v += __shfl_xor(v, o);
    return v;
}
__device__ __forceinline__ float sigm(float x) { return 1.0f / (1.0f + __expf(-x)); }
__device__ __forceinline__ float tanh_fast(float x) { const float e = __expf(2.0f * x); return 1.0f - 2.0f / (e + 1.0f); }

constexpr size_t MiB = 1u << 20;
constexpr size_t RF = (size_t)T * D * 4;
constexpr size_t RB = (size_t)T * D * 2;
constexpr size_t WS_CTL = 0, CTL_ZERO_BYTES = 1 * MiB;
constexpr size_t WS_MODS = 1 * MiB;
constexpr size_t WS_XSA = 2 * MiB, WS_XSB = WS_XSA + RF;
constexpr size_t WS_XL = WS_XSB + RF;
constexpr size_t WS_RKV = WS_XL + 6 * RB;
constexpr size_t WS_L1 = WS_RKV + 3 * RF;
constexpr size_t WS_WDEC = WS_L1 + 50 * MiB;
constexpr size_t WS_AA = WS_WDEC + 2 * RF;
constexpr size_t WS_G = WS_AA + 2 * RF;
constexpr size_t WS_KK = WS_G + RB;
constexpr size_t WS_KD = WS_KK + RF;
constexpr size_t WS_BETA = WS_KD + 2 * RF;
constexpr size_t WS_RKB = WS_BETA + 2 * RF;
constexpr size_t WS_C12 = WS_RKB + 3 * MiB;
constexpr size_t WS_Y = WS_C12 + 9 * MiB;
constexpr size_t WS_Z = WS_Y + 2 * RF;
constexpr size_t WS_H2 = WS_Z + RB;
constexpr size_t WS_SLOTL = WS_H2 + RB;
constexpr size_t WS_GATEL = WS_SLOTL + 5 * MiB;
constexpr size_t WS_WRKV = WS_GATEL + 5 * MiB;
constexpr size_t WS_L2T = WS_WRKV + 15 * MiB;
constexpr size_t WS_WO = WS_L2T + 5 * MiB;
constexpr size_t WS_WIN = WS_WO + 4 * MiB;
constexpr size_t WS_WOUT = WS_WIN + 12 * MiB;
constexpr size_t WS_WGU = WS_WOUT + 4 * MiB;
constexpr size_t WS_WDN = WS_WGU + 512 * MiB;
constexpr size_t WS_END = WS_WDN + 256 * MiB;
constexpr size_t WS_INTER = WS_WDEC;
constexpr size_t WS_YS = WS_KD;
constexpr size_t WS_BG = WS_RKV, WS_CUZ = WS_RKV + RB;
constexpr size_t WS_RAWW = WS_AA, WS_RAWA = WS_AA + RF;
constexpr size_t WS_RH = WS_AA;
constexpr size_t WS_PM = WS_AA + RF;
constexpr size_t WS_QT = WS_XL;
constexpr size_t WS_HT = WS_XL + RF;
static_assert((size_t)128 * 132 * 4096 * 2 <= RF, "chunk state tensors");
static_assert((size_t)MAXTILES * 256 * 1024 * 2 <= 4 * RF, "INTER overlay");
static_assert((size_t)T * 4 * 1024 * 2 <= 2 * RF, "YS overlay");
static_assert((size_t)3 * T * 256 * 2 <= 50 * MiB, "L1OUT");
constexpr int CW_BAR = 4096;
constexpr int CW_CNT = 16384;

constexpr int RING_BYTES = 131072;
constexpr int LDSCTL_OFF = RING_BYTES;
constexpr int LDS_BYTES = 147456;

struct Args { const float* in[33]; float* out; unsigned char* ws; int ph_lo, ph_hi; };

__device__ __forceinline__ void transpose_item(const float* W, int N, bf16* WT, int dstK, int drow0, int k0, int n0, LAS float* scr, int lane) {
    float tv[32];
#pragma unroll
    for (int i = 0; i < 32; ++i) { const int kk = 2 * i + (lane >> 5); tv[i] = W[(size_t)(k0 + kk) * N + n0 + (lane & 31)]; }
#pragma unroll
    for (int i = 0; i < 32; ++i) { const int kk = 2 * i + (lane >> 5); scr[kk * 33 + (lane & 31)] = tv[i]; }
    LDS_WAIT(); asm volatile("" ::: "memory");
    const int c = lane & 7;
#pragma unroll
    for (int j = 0; j < 4; ++j) { const int n = (lane >> 3) + 8 * j; const LAS float* s = scr + (8 * c) * 33 + n;
        u32x4 o; o.x = pk2(s[0 * 33], s[1 * 33]); o.y = pk2(s[2 * 33], s[3 * 33]); o.z = pk2(s[4 * 33], s[5 * 33]); o.w = pk2(s[6 * 33], s[7 * 33]);
        *(u32x4*)(WT + (size_t)(drow0 + n) * dstK + k0 + 8 * c) = o; }
    LDS_WAIT(); asm volatile("" ::: "memory");
}
__device__ __forceinline__ int gu_map(int n0) { const int bj = n0 >= 1024 ? 1 : 0, f0 = n0 - bj * 1024; return (f0 >> 7) * 256 + bj * 128 + (f0 & 127); }
__device__ __forceinline__ int conv_map(int n0) { if (n0 < 1024) return n0; const int q = (n0 - 1024) >> 10, f0 = (n0 - 1024) & 1023; return 1024 + (f0 >> 7) * 256 + q * 128 + (f0 & 127); }

__device__ __forceinline__ void p0_prologue(const Args& a, LAS unsigned char* lds, int tid, int lane, int wave, int G) {
    unsigned char* ws = a.ws;
    LAS float* sl = (LAS float*)lds;
    LAS float* red = (LAS float*)(lds + 20480);
    for (int i = tid; i < 5 * 1024; i += 512) { const int r = i >> 10, k = i & 1023; const float cv = r < 4 ? a.in[1][r * 1024 + k] : a.in[3][k]; sl[i] = cv / (1.0f + __expf(-cv)); }
    __syncthreads();
    float* MODS = (float*)(ws + WS_MODS);
    for (int it = blockIdx.x; it < 4 * 96; it += G) {
        const int l = it / 96, n = (it % 96) * 64 + lane;
        const float* W = a.in[4] + (size_t)l * 1024 * 6144 + n;
        float acc[5] = {0.f, 0.f, 0.f, 0.f, 0.f};
        const int kb = wave * 128;
#pragma unroll 8
        for (int k = 0; k < 128; ++k) { const float wv = W[(size_t)(kb + k) * 6144];
#pragma unroll
            for (int r = 0; r < 5; ++r) acc[r] += sl[r * 1024 + kb + k] * wv; }
#pragma unroll
        for (int r = 0; r < 5; ++r) red[(wave * 5 + r) * 64 + lane] = acc[r];
        __syncthreads();
        if (wave < 5) { float s = a.in[5][l * 6144 + n];
#pragma unroll
            for (int w = 0; w < 8; ++w) s += red[(w * 5 + wave) * 64 + lane];
            MODS[(size_t)(l * 5 + wave) * 6144 + n] = s; }
        __syncthreads();
    }
    LAS float* scr = (LAS float*)(lds + 32768 + wave * 8448);
    const int gw = blockIdx.x * 8 + wave, NGW = G * 8;
    bf16* WRKV = (bf16*)(ws + WS_WRKV); bf16* WOt = (bf16*)(ws + WS_WO); bf16* WINt = (bf16*)(ws + WS_WIN); bf16* WOUTt = (bf16*)(ws + WS_WOUT);
    bf16* WGU = (bf16*)(ws + WS_WGU); bf16* WDN = (bf16*)(ws + WS_WDN);
    constexpr int I_GU = 128 * 1024, I_DN = 128 * 512, I_RKV = 6 * 512, I_WO = 2 * 512, I_WIN = 2 * 1536, I_WOUT = 2 * 512, I_W1 = 4 * 32, I_A1 = 4 * 32, I_G1 = 2 * 64;
    constexpr int NITEMS = I_GU + I_DN + I_RKV + I_WO + I_WIN + I_WOUT + I_W1 + I_A1 + I_G1;
    for (int it = gw; it < NITEMS; it += NGW) {
        int r = it;
        if (r < I_GU) { const int m = r >> 10, q = r & 1023, kb = q >> 6, nb = q & 63;
            transpose_item(a.in[29] + (size_t)m * 1024 * 2048, 2048, WGU + (size_t)m * 2048 * 1024, 1024, gu_map(nb * 32), kb * 64, nb * 32, scr, lane); continue; } r -= I_GU;
        if (r < I_DN) { const int m = r >> 9, q = r & 511, kb = q >> 5, nb = q & 31;
            transpose_item(a.in[31] + (size_t)m * 1024 * 1024, 1024, WDN + (size_t)m * 1024 * 1024, 1024, nb * 32, kb * 64, nb * 32, scr, lane); continue; } r -= I_DN;
        if (r < I_RKV) { const int m = r >> 9, q = r & 511, kb = q >> 5, nb = q & 31, lr = m / 3, j = m % 3;
            transpose_item(a.in[9] + (size_t)m * 1024 * 1024, 1024, WRKV + (size_t)lr * 3840 * 1024, 1024, j * 1024 + nb * 32, kb * 64, nb * 32, scr, lane); continue; } r -= I_RKV;
        if (r < I_WO) { const int m = r >> 9, q = r & 511, kb = q >> 5, nb = q & 31;
            transpose_item(a.in[23] + (size_t)m * 1024 * 1024, 1024, WOt + (size_t)m * 1024 * 1024, 1024, nb * 32, kb * 64, nb * 32, scr, lane); continue; } r -= I_WO;
        if (r < I_WIN) { const int m = r / 1536, q = r % 1536, kb = q / 96, nb = q % 96;
            transpose_item(a.in[24] + (size_t)m * 1024 * 3072, 3072, WINt + (size_t)m * 3072 * 1024, 1024, conv_map(nb * 32), kb * 64, nb * 32, scr, lane); continue; } r -= I_WIN;
        if (r < I_WOUT) { const int m = r >> 9, q = r & 511, kb = q >> 5, nb = q & 31;
            transpose_item(a.in[26] + (size_t)m * 1024 * 1024, 1024, WOUTt + (size_t)m * 1024 * 1024, 1024, nb * 32, kb * 64, nb * 32, scr, lane); continue; } r -= I_WOUT;
        if (r < I_W1) { const int m = r >> 5, q = r & 31, kb = q >> 1, nb = q & 1, lr = m >> 1, e = m & 1;
            transpose_item(a.in[11] + (size_t)m * 1024 * 64, 64, WRKV + (size_t)lr * 3840 * 1024, 1024, 3072 + e * 64 + nb * 32, kb * 64, nb * 32, scr, lane); continue; } r -= I_W1;
        if (r < I_A1) { const int m = r >> 5, q = r & 31, kb = q >> 1, nb = q & 1, lr = m >> 1, e = m & 1;
            transpose_item(a.in[14] + (size_t)m * 1024 * 64, 64, WRKV + (size_t)lr * 3840 * 1024, 1024, 3328 + e * 64 + nb * 32, kb * 64, nb * 32, scr, lane); continue; } r -= I_A1;
        { const int m = r >> 6, q = r & 63, kb = q >> 2, nb = q & 3;
            transpose_item(a.in[16] + (size_t)m * 1024 * 128, 128, WRKV + (size_t)m * 3840 * 1024, 1024, 3584 + nb * 32, kb * 64, nb * 32, scr, lane); }
    }
    const int gt = blockIdx.x * 512 + tid, NGT = G * 512;
    for (int i = gt; i < 2 * 3 * 128 * 128; i += NGT) {
        const int pc = i & 127, rw = (i >> 7) & 127, pd = (i >> 14) % 3, lr = i / (3 * 16384);
        *(u32x4*)(WRKV + ((size_t)lr * 3840 + 3072 + pd * 256 + 128 + rw) * 1024 + pc * 8) = (u32x4){0u, 0u, 0u, 0u}; }
    bf16* L2T = (bf16*)(ws + WS_L2T);
    for (int i = gt; i < 2 * 256 * 5120; i += NGT) {
        const int n = i % 5120, k = (i / 5120) & 255, lr = i / (5120 * 256);
        float v = 0.f;
        if (n < 2048) { const int e = n >> 10, d = n & 1023; if ((k >> 6) == e) v = a.in[12][(((size_t)lr * 2 + e) * 64 + (k & 63)) * 1024 + d]; }
        else if (n < 4096) { const int e = (n - 2048) >> 10, d = n & 1023; if ((k >> 6) == e) v = a.in[15][(((size_t)lr * 2 + e) * 64 + (k & 63)) * 1024 + d]; }
        else { const int d = n - 4096; if (k < 128) v = a.in[17][((size_t)lr * 128 + k) * 1024 + d]; }
        L2T[((size_t)lr * 5120 + n) * 256 + k] = (bf16)f2bf(v);
    }
}
#define XB_TMO      128
#define XB_XCNT(j)  (256  + 64 * (j))
#define XB_XSUB(j)  (1280 + 64 * (j))
#define XB_XGEN(j)  (2304 + 64 * (j))
#define XB_TOP      3328
#define XB_TOPGEN   3392
#define XCD_BAR_WORDS 3456
#define XB_SPIN_CAP (1u << 23)

__device__ __forceinline__ unsigned xb_ld(unsigned* p)              { return __hip_atomic_load(p, __ATOMIC_RELAXED, __HIP_MEMORY_SCOPE_AGENT); }
__device__ __forceinline__ unsigned xb_add(unsigned* p, unsigned v) { return __hip_atomic_fetch_add(p, v, __ATOMIC_RELAXED, __HIP_MEMORY_SCOPE_AGENT); }
__device__ __forceinline__ unsigned xb_xcc_id() { return (unsigned)__builtin_amdgcn_s_getreg((3 << 11) | 20) & 0xFu; }
#define XB_SPIN(cond, bar) do { unsigned _sp = 0; while (cond) { __builtin_amdgcn_s_sleep(1); \
    if ((++_sp & 255u) == 0u) { if (xb_ld(&(bar)[XB_TMO])) break; if (_sp > XB_SPIN_CAP) { atomicAdd(&(bar)[XB_TMO], 1u); break; } } } } while (0)

struct XcdBarrier {
    unsigned wv;
    unsigned* bar; unsigned x;
    volatile LAS unsigned* st;
};

__device__ __forceinline__ XcdBarrier xcd_barrier_post(unsigned* bar, volatile LAS unsigned* st) {
    XcdBarrier b; b.wv = (unsigned)__builtin_amdgcn_readfirstlane((int)(threadIdx.x >> 6)); b.bar = bar; b.x = xb_xcc_id(); b.st = st;
    if (threadIdx.x == 0) (void)xb_add(&bar[XB_XCNT(b.x)], 1u);
    return b;
}
__device__ __forceinline__ void xcd_barrier_complete(unsigned* bar, unsigned x, unsigned& nloc, unsigned& nx) {
    const unsigned G = gridDim.x * gridDim.y * gridDim.z;
    unsigned sum, cnt, mine, sp = 0u;
    for (;;) {
        sum = 0u; cnt = 0u; mine = 0u;
#pragma unroll
        for (unsigned j = 0; j < 16; ++j) { const unsigned c = xb_ld(&bar[XB_XCNT(j)]); sum += c; cnt += (c > 0u) ? 1u : 0u; mine = (j == x) ? c : mine; }
        if (sum == G) break;
        __builtin_amdgcn_s_sleep(1);
        if ((++sp & 255u) == 0u) { if (xb_ld(&bar[XB_TMO])) break; if (sp > XB_SPIN_CAP) { atomicAdd(&bar[XB_TMO], 1u); break; } }
    }
    nloc = mine > 0u ? mine : 1u; nx = cnt > 0u ? cnt : 1u;
}

__device__ __forceinline__ void xcd_barrier(const XcdBarrier& b) {
    asm volatile("s_waitcnt vmcnt(0)" ::: "memory");
    __syncthreads();
    if (b.wv == 0u && lane_id() == 0) {
        unsigned* bar = b.bar;
        __builtin_amdgcn_s_waitcnt(0);
        unsigned nloc = b.st[0], nx = b.st[1];
        if (nloc == 0u) { xcd_barrier_complete(bar, b.x, nloc, nx); b.st[0] = nloc; b.st[1] = nx; }
        const unsigned old = xb_add(&bar[XB_XSUB(b.x)], 1u);
        const unsigned gen = old / nloc;
        if (old + 1u == (gen + 1u) * nloc) {
            __builtin_amdgcn_fence(__ATOMIC_RELEASE, "agent");
            asm volatile("s_waitcnt vmcnt(0)" ::: "memory");
            const unsigned og = xb_add(&bar[XB_TOP], 1u);
            const unsigned tg = og / nx;
            if (og + 1u == (tg + 1u) * nx) xb_add(&bar[XB_TOPGEN], 1u);
            else XB_SPIN(xb_ld(&bar[XB_TOPGEN]) == tg, bar);
            __builtin_amdgcn_fence(__ATOMIC_ACQUIRE, "agent");
            xb_add(&bar[XB_XGEN(b.x)], 1u);
            asm volatile("s_waitcnt vmcnt(0)" ::: "memory");
        } else {
            XB_SPIN(xb_ld(&bar[XB_XGEN(b.x)]) == gen, bar);
            __builtin_amdgcn_fence(__ATOMIC_ACQUIRE, "agent");
            asm volatile("s_waitcnt vmcnt(0)" ::: "memory");
        }
    }
    __syncthreads();
}

__device__ __forceinline__ int mod_row(int row) { return row < TL ? (row >> 13) : 4; }

__device__ __forceinline__ void load_x_combined(f32x4 (&x)[4], const float* xrow, bool has_prev, const bf16* YS, int t, const f32x4 (&m5)[4], int lane) {
#pragma unroll
    for (int j = 0; j < 4; ++j) x[j] = *(const f32x4*)(xrow + 256 * j + 4 * lane);
    if (has_prev) {
        f32x4 s[4];
#pragma unroll
        for (int j = 0; j < 4; ++j) s[j] = (f32x4){0.f, 0.f, 0.f, 0.f};
#pragma unroll
        for (int k = 0; k < 4; ++k) { const bf16* yr = YS + ((size_t)t * 4 + k) * 1024;
#pragma unroll
            for (int j = 0; j < 4; ++j) { const u32x2 w = *(const u32x2*)(yr + 256 * j + 4 * lane); s[j] += (f32x4){bflo(w.x), bfhi(w.x), bflo(w.y), bfhi(w.y)}; } }
#pragma unroll
        for (int j = 0; j < 4; ++j) x[j] += m5[j] * s[j];
    }
}
__device__ __forceinline__ float row_rstd(const f32x4 (&x)[4]) {
    float ss = 0.f;
#pragma unroll
    for (int j = 0; j < 4; ++j) ss += (x[j].x * x[j].x + x[j].y * x[j].y) + (x[j].z * x[j].z + x[j].w * x[j].w);
    return rsqrtf(wave_sum(ss) * (1.0f / 1024.0f) + 1e-6f);
}

__device__ __forceinline__ void phase_a_rwkv(const Args& a, int layer, LAS unsigned char* lds, int tid, int gw, int NGW, int lane) {
    unsigned char* ws = a.ws; const int lj = layer >> 1; const bool has_prev = layer > 0;
    const float* xin_lat = layer == 0 ? a.in[0] : (const float*)(ws + WS_XSA);
    const float* xin_ctx = layer == 0 ? a.in[2] : (const float*)(ws + WS_XSA) + (size_t)TL * D;
    float* xout = (float*)(ws + (layer == 0 ? WS_XSA : WS_XSB));
    const float* MODS = (const float*)(ws + WS_MODS); const bf16* YS = (const bf16*)(ws + WS_YS); bf16* XL = (bf16*)(ws + WS_XL);
    const float* mug = a.in[8] + (size_t)lj * 6 * 2 * 1024; const float* ng = a.in[6] + (size_t)(layer * 2 + 0) * 1024;
    LAS float* mu = (LAS float*)lds;
    for (int i = tid; i < 6 * 2 * 1024 / 4; i += 512) ((LAS f32x4*)mu)[i] = ((const f32x4*)mug)[i];
    __syncthreads();
    for (int it = gw; it < TL / 8 + TC / 2; it += NGW) {
        const int ntok = it < TL / 8 ? 8 : 2, t0 = it < TL / 8 ? it * 8 : TL + (it - TL / 8) * 2, mr = mod_row(t0);
        int rs, re; if (t0 < TL) { rs = t0 & ~63; re = rs + 63; } else { const int loc = t0 - TL; rs = TL + (loc & ~255); re = rs + 255; }
        const float* mod = MODS + (size_t)(layer * 5 + mr) * 6144;
        const float* m5p = MODS + (size_t)((has_prev ? layer - 1 : 0) * 5 + mr) * 6144 + 5 * 1024;
        f32x4 hm[4], h0[4], hp[4];
#pragma unroll
        for (int j = 0; j < 4; ++j) { hm[j] = (f32x4){0.f, 0.f, 0.f, 0.f}; h0[j] = hm[j]; hp[j] = hm[j]; }
        f32x4 rx[4], nx[4]; u32x2 ry[4][4], ny[4][4];
#define PA_LOAD(X, Y, tt) do { const int t_ = (tt); if (t_ >= rs && t_ <= re) { \
            const float* xrow_ = t_ < TL ? xin_lat + (size_t)t_ * D : xin_ctx + (size_t)(t_ - TL) * D; \
            _Pragma("unroll") for (int j = 0; j < 4; ++j) X[j] = *(const f32x4*)(xrow_ + 256 * j + 4 * lane); \
            if (has_prev) { _Pragma("unroll") for (int k = 0; k < 4; ++k) _Pragma("unroll") for (int j = 0; j < 4; ++j) Y[k][j] = *(const u32x2*)(YS + ((size_t)t_ * 4 + k) * 1024 + 256 * j + 4 * lane); } } } while (0)
#pragma unroll
        for (int j = 0; j < 4; ++j) { rx[j] = (f32x4){0.f, 0.f, 0.f, 0.f}; nx[j] = rx[j];
#pragma unroll
            for (int k = 0; k < 4; ++k) { ry[k][j] = (u32x2){0u, 0u}; ny[k][j] = ry[k][j]; } }
        PA_LOAD(rx, ry, t0 - 1);
#pragma unroll 1
        for (int i = -1; i <= ntok; ++i) {
            const int t = t0 + i;
            if (i < ntok) PA_LOAD(nx, ny, t + 1);
            f32x4 hn[4];
            if (t >= rs && t <= re) {
                f32x4 x[4];
#pragma unroll
                for (int j = 0; j < 4; ++j) x[j] = rx[j];
                if (has_prev) {
#pragma unroll
                    for (int j = 0; j < 4; ++j) { f32x4 sm = (f32x4){0.f, 0.f, 0.f, 0.f};
#pragma unroll
                        for (int k = 0; k < 4; ++k) sm += (f32x4){bflo(ry[k][j].x), bfhi(ry[k][j].x), bflo(ry[k][j].y), bfhi(ry[k][j].y)};
                        x[j] += *(const f32x4*)(m5p + 256 * j + 4 * lane) * sm; } }
                if (i >= 0 && i < ntok) {
#pragma unroll
                    for (int j = 0; j < 4; ++j) *(f32x4*)(xout + (size_t)t * D + 256 * j + 4 * lane) = x[j]; }
                const float rstd = row_rstd(x);
#pragma unroll
                for (int j = 0; j < 4; ++j) { const int col = 256 * j + 4 * lane; hn[j] = x[j] * rstd * *(const f32x4*)(ng + col) * (*(const f32x4*)(mod + 1024 + col) + 1.0f) + *(const f32x4*)(mod + col); }
            } else {
#pragma unroll
                for (int j = 0; j < 4; ++j) hn[j] = (f32x4){0.f, 0.f, 0.f, 0.f};
            }
#pragma unroll
            for (int j = 0; j < 4; ++j) { hm[j] = h0[j]; h0[j] = hp[j]; hp[j] = hn[j]; rx[j] = nx[j];
#pragma unroll
                for (int k = 0; k < 4; ++k) ry[k][j] = ny[k][j]; }
            if (i >= 1) {
                const int te = t - 1;
#pragma unroll
                for (int q = 0; q < 6; ++q) {
                    bf16* orow = XL + ((size_t)q * T + te) * D;
#pragma unroll
                    for (int j = 0; j < 4; ++j) { const int col = 256 * j + 4 * lane;
                        const f32x4 m0 = *(const LAS f32x4*)(mu + (q * 2 + 0) * 1024 + col), m1 = *(const LAS f32x4*)(mu + (q * 2 + 1) * 1024 + col);
                        const f32x4 o = h0[j] + m0 * (hm[j] - h0[j]) + m1 * (hp[j] - h0[j]);
                        u32x2 w; w.x = pk2(o.x, o.y); w.y = pk2(o.z, o.w); *(u32x2*)(orow + col) = w; }
                }
            }
        }
#undef PA_LOAD
    }
}
__device__ __forceinline__ void phase_a_conv(const Args& a, int layer, int rows, int gw, int NGW, int lane) {
    unsigned char* ws = a.ws;
    float* xs = (float*)(ws + (layer < 2 ? WS_XSA : WS_XSB));
    const float* MODS = (const float*)(ws + WS_MODS); const bf16* YS = (const bf16*)(ws + WS_YS); bf16* H = (bf16*)(ws + WS_XL);
    const float* ng = a.in[6] + (size_t)(layer * 2 + 0) * 1024;
    for (int t = gw; t < rows; t += NGW) {
        const int mr = mod_row(t);
        const float* mod = MODS + (size_t)(layer * 5 + mr) * 6144;
        f32x4 m5[4], x[4];
#pragma unroll
        for (int j = 0; j < 4; ++j) m5[j] = *(const f32x4*)(MODS + (size_t)((layer - 1) * 5 + mr) * 6144 + 5 * 1024 + 256 * j + 4 * lane);
        load_x_combined(x, xs + (size_t)t * D, true, YS, t, m5, lane);
        const float rstd = row_rstd(x);
#pragma unroll
        for (int j = 0; j < 4; ++j) { const int col = 256 * j + 4 * lane;
            *(f32x4*)(xs + (size_t)t * D + col) = x[j];
            const f32x4 h = x[j] * rstd * *(const f32x4*)(ng + col) * (*(const f32x4*)(mod + 1024 + col) + 1.0f) + *(const f32x4*)(mod + col);
            u32x2 w; w.x = pk2(h.x, h.y); w.y = pk2(h.z, h.w); *(u32x2*)(H + (size_t)t * D + col) = w; }
    }
}
#define DPPF(x, ctrl) __builtin_bit_cast(float, __builtin_amdgcn_update_dpp(0, __builtin_bit_cast(int, (x)), (ctrl), 0xf, 0xf, false))
__device__ __forceinline__ float row16_sum(float v) { v += DPPF(v, 0xB1); v += DPPF(v, 0x4E); v += DPPF(v, 0x141); v += DPPF(v, 0x140); return v; }
__device__ __forceinline__ f32x4 bf4(u32x2 w) { return (f32x4){bflo(w.x), bfhi(w.x), bflo(w.y), bfhi(w.y)}; }
__device__ __forceinline__ u32x2 pk4(f32x4 v) { u32x2 w; w.x = pk2(v[0], v[1]); w.y = pk2(v[2], v[3]); return w; }
__device__ __forceinline__ void phase_c_prep(const Args& a, int lj, LAS unsigned char* lds, int tid, int gw, int NGW, int lane) {
    unsigned char* ws = a.ws;
    const bf16* Rr = (const bf16*)(ws + WS_RKV); const bf16* Kk = Rr + (size_t)T * D; const bf16* RA = (const bf16*)(ws + WS_RAWA); const bf16* RW = (const bf16*)(ws + WS_RAWW);
    float* LW = (float*)(ws + WS_WDEC); bf16* KK = (bf16*)(ws + WS_KK); bf16* KD = (bf16*)(ws + WS_KD); bf16* BE = (bf16*)(ws + WS_BETA); float* RKB = (float*)(ws + WS_RKB);
    LAS float* tb = (LAS float*)lds;
    for (int i = tid; i < 7 * 256; i += 512) { const int t7 = i >> 8, q = i & 255;
        const float* src = t7 == 0 ? a.in[18] + lj * 1024 : t7 == 1 ? a.in[19] + lj * 1024 : t7 == 2 ? a.in[20] + lj * 1024 : t7 < 5 ? a.in[10] + lj * 2048 + (t7 - 3) * 1024 : a.in[13] + lj * 2048 + (t7 - 5) * 1024;
        ((LAS f32x4*)tb)[i] = ((const f32x4*)src)[q]; }
    __syncthreads();
    for (int row = gw; row < T; row += NGW) {
#pragma unroll
        for (int j = 0; j < 4; ++j) {
            const int col = 256 * j + 4 * lane; const size_t ro = (size_t)row * D + col;
            const f32x4 k = bf4(*(const u32x2*)(Kk + ro)), r = bf4(*(const u32x2*)(Rr + ro));
            f32x4 a0 = bf4(*(const u32x2*)(RA + ro)) + *(const LAS f32x4*)(tb + 5 * 1024 + col), a1 = bf4(*(const u32x2*)(RA + (size_t)T * D + ro)) + *(const LAS f32x4*)(tb + 6 * 1024 + col);
            f32x4 d0 = bf4(*(const u32x2*)(RW + ro)) + *(const LAS f32x4*)(tb + 3 * 1024 + col), d1 = bf4(*(const u32x2*)(RW + (size_t)T * D + ro)) + *(const LAS f32x4*)(tb + 4 * 1024 + col);
#pragma unroll
            for (int z = 0; z < 4; ++z) { a0[z] = sigm(a0[z]); a1[z] = sigm(a1[z]); d0[z] = -0.60653066f * sigm(d0[z]); d1[z] = -0.60653066f * sigm(d1[z]); }
            *(f32x4*)(LW + ro) = d0; *(f32x4*)(LW + (size_t)T * D + ro) = d1;
            const f32x4 ck = *(const LAS f32x4*)(tb + col), ca = *(const LAS f32x4*)(tb + 1024 + col), cr = *(const LAS f32x4*)(tb + 2048 + col);
            const f32x4 kk = k * ck;
            const float ss = row16_sum((kk.x * kk.x + kk.y * kk.y) + (kk.z * kk.z + kk.w * kk.w));
            const f32x4 kd0 = k * ((a0 - 1.0f) * ca + 1.0f), kd1 = k * ((a1 - 1.0f) * ca + 1.0f);
            *(u32x2*)(KD + ro) = pk4(kd0); *(u32x2*)(KD + (size_t)T * D + ro) = pk4(kd1);
            const f32x4 p = r * (kd0 + kd1) * cr;
            const float rk = row16_sum((p.x + p.y) + (p.z + p.w));
            const f32x4 kkn = kk * (1.0f / fmaxf(sqrtf(ss), 1e-12f));
            *(u32x2*)(KK + ro) = pk4(kkn); *(u32x2*)(BE + ro) = pk4(kkn * a0); *(u32x2*)(BE + (size_t)T * D + ro) = pk4(kkn * a1);
            if ((lane & 15) == 0) RKB[(size_t)row * 16 + 4 * j + (lane >> 4)] = rk;
        }
    }
}
typedef short bf16x8 __attribute__((ext_vector_type(8)));
__device__ __forceinline__ f32x4 mfma16(bf16x8 a, bf16x8 b, f32x4 c) { return __builtin_amdgcn_mfma_f32_16x16x32_bf16(a, b, c, 0, 0, 0); }
__device__ __forceinline__ bf16x8 as_frag(u32x4 w) { return __builtin_bit_cast(bf16x8, w); }
constexpr int CH_LD = 144;
constexpr int CH_MS = 64 * CH_LD;
constexpr int CH_AB = 0 * CH_MS, CH_KT = 1 * CH_MS, CH_BT = 2 * CH_MS, CH_RB = 3 * CH_MS, CH_VT = 4 * CH_MS, CH_ABT = 5 * CH_MS, CH_KHT = 6 * CH_MS, CH_BHT = 7 * CH_MS,
              CH_LK = 8 * CH_MS, CH_LB = 9 * CH_MS, CH_MK = 10 * CH_MS, CH_MB = 11 * CH_MS, CH_WT = 12 * CH_MS, CH_U0 = 13 * CH_MS, CH_DINV = 14 * CH_MS;
constexpr int CH_GC = LDSCTL_OFF + 2048;
constexpr int CH_PART = LDSCTL_OFF + 4096;
constexpr int NCHUNK = NSTEP / 64;
static_assert(CH_DINV + 2048 <= RING_BYTES, "chunk LDS map");

__device__ __forceinline__ int scan_row(int s, int dir, int b) {
    if (s < CTXL) return TL + b * CTXL + (dir ? CTXL - 1 - s : s);
    const int i = s - CTXL; return b * SEQ + (dir ? SEQ - 1 - i : i);
}
#define CH_FRAG(mat, row, ks, kg) as_frag(*(const LAS u32x4*)(lds + (mat) + (row) * CH_LD + ((ks) * 32 + (kg) * 8) * 2))

__device__ __forceinline__ void phase_s1_chunks(const Args& a, LAS unsigned char* lds, int tid, int G) {
    unsigned char* ws = a.ws;
    const int lane = tid & 63, wave = __builtin_amdgcn_readfirstlane(tid >> 6), l15 = lane & 15, g = lane >> 4;
    LAS float* part = (LAS float*)(lds + CH_PART); LAS float* gammaC = (LAS float*)(lds + CH_GC);
    float nlw[8], nkd[8], nbe[8], nkk[8], nrr[8], nvv[8];
#define S1_LOAD(ctx_) do { unsigned char* wsl = ws; asm volatile("" : "+s"(wsl));     \
        const float* LWp = (const float*)(wsl + WS_WDEC); const bf16* KDp = (const bf16*)(wsl + WS_KD); const bf16* BEp = (const bf16*)(wsl + WS_BETA); \
        const bf16* KKp = (const bf16*)(wsl + WS_KK); const bf16* Rp = (const bf16*)(wsl + WS_RKV); const bf16* Vp = Rp + (size_t)2 * T * D; \
        const int chain_ = (ctx_) / NCHUNK, c_ = (ctx_) - chain_ * NCHUNK, dir_ = chain_ >> 6, b_ = (chain_ >> 4) & 3, h_ = chain_ & 15; \
        _Pragma("unroll") for (int j = 0; j < 8; ++j) { const int row = scan_row(64 * c_ + 8 * wave + j, dir_, b_); const size_t o = (size_t)row * D + h_ * 64 + lane; \
            nlw[j] = LWp[(size_t)dir_ * T * D + o]; nkd[j] = bflo((unsigned)KDp[(size_t)dir_ * T * D + o]); nbe[j] = bflo((unsigned)BEp[(size_t)dir_ * T * D + o]); nkk[j] = bflo((unsigned)KKp[o]); nrr[j] = bflo((unsigned)Rp[o]); nvv[j] = bflo((unsigned)Vp[o]); } } while (0)
    if ((int)blockIdx.x < 128 * NCHUNK) S1_LOAD((int)blockIdx.x);
    for (int ct = blockIdx.x; ct < 128 * NCHUNK; ct += G) {
        const int chain = ct / NCHUNK, c = ct - chain * NCHUNK, dir = chain >> 6, b = (chain >> 4) & 3, h = chain & 15;
        unsigned zq = 0u; asm volatile("" : "+v"(zq));
        {
            const int k = lane, tq = wave;
            float lw[8], kd[8], be[8], kk[8], rr[8], vv[8];
#pragma unroll
            for (int j = 0; j < 8; ++j) { lw[j] = nlw[j]; kd[j] = nkd[j]; be[j] = nbe[j]; kk[j] = nkk[j]; rr[j] = nrr[j]; vv[j] = nvv[j]; }
            if (ct + G < 128 * NCHUNK) S1_LOAD(ct + G);
            float p[8]; p[0] = lw[0];
#pragma unroll
            for (int j = 1; j < 8; ++j) p[j] = p[j - 1] + lw[j];
            part[tq * 64 + k] = p[7];
            __syncthreads();
            float off = 0.f, tot = 0.f;
#pragma unroll
            for (int q = 0; q < 8; ++q) { const float pv = part[q * 64 + k]; tot += pv; off += q < tq ? pv : 0.f; }
            if (tq == 0) gammaC[k] = __expf(tot);
            unsigned abw[4], khw[4], bhw[4], vw[4];
#pragma unroll
            for (int j = 0; j < 8; j += 2) {
                float ab2[2], kt2[2], bt2[2], rb2[2], kh2[2], bh2[2];
#pragma unroll
                for (int z = 0; z < 2; ++z) { const float cu = off + p[j + z]; const float eP = __expf(cu), eM = __expf(-cu), ePrev = __expf(cu - lw[j + z]), eC = __expf(tot - cu);
                    ab2[z] = kk[j + z] * ePrev; kt2[z] = kd[j + z] * eM; bt2[z] = be[j + z] * eM; rb2[z] = rr[j + z] * eP; kh2[z] = kd[j + z] * eC; bh2[z] = be[j + z] * eC;
                    const int t = 8 * tq + j + z;
                    *(LAS bf16*)(lds + CH_AB + t * CH_LD + k * 2) = (bf16)f2bf(ab2[z]); *(LAS bf16*)(lds + CH_KT + t * CH_LD + k * 2) = (bf16)f2bf(kt2[z]);
                    *(LAS bf16*)(lds + CH_BT + t * CH_LD + k * 2) = (bf16)f2bf(bt2[z]); *(LAS bf16*)(lds + CH_RB + t * CH_LD + k * 2) = (bf16)f2bf(rb2[z]); }
                abw[j >> 1] = pk2(ab2[0], ab2[1]); khw[j >> 1] = pk2(kh2[0], kh2[1]); bhw[j >> 1] = pk2(bh2[0], bh2[1]); vw[j >> 1] = pk2(vv[j], vv[j + 1]);
            }
            *(LAS u32x4*)(lds + CH_ABT + k * CH_LD + tq * 16) = (u32x4){abw[0], abw[1], abw[2], abw[3]};
            *(LAS u32x4*)(lds + CH_KHT + k * CH_LD + tq * 16) = (u32x4){khw[0], khw[1], khw[2], khw[3]};
            *(LAS u32x4*)(lds + CH_BHT + k * CH_LD + tq * 16) = (u32x4){bhw[0], bhw[1], bhw[2], bhw[3]};
            *(LAS u32x4*)(lds + CH_VT + k * CH_LD + tq * 16) = (u32x4){vw[0], vw[1], vw[2], vw[3]};
            *(LAS u32x4*)(lds + CH_WT + k * CH_LD + tq * 16) = (u32x4){zq, zq, zq, zq}; *(LAS u32x4*)(lds + CH_U0 + k * CH_LD + tq * 16) = (u32x4){zq, zq, zq, zq};
        }
        __syncthreads();
        {
            const int mi = wave >> 1, half = wave & 1;
            const int matS = (mi & 1) ? CH_BT : CH_KT, matT = (mi & 2) ? CH_RB : CH_AB, matO = CH_LK + mi * CH_MS;
            const bool incl = (mi & 2) != 0;
            bf16x8 fs[4][2], ft[2][2];
#pragma unroll
            for (int ms = 0; ms < 4; ++ms)
#pragma unroll
                for (int ks = 0; ks < 2; ++ks) fs[ms][ks] = CH_FRAG(matS, 16 * ms + l15, ks, g);
#pragma unroll
            for (int nt = 0; nt < 2; ++nt)
#pragma unroll
                for (int ks = 0; ks < 2; ++ks) ft[nt][ks] = CH_FRAG(matT, 32 * half + 16 * nt + l15, ks, g);
#pragma unroll
            for (int nt = 0; nt < 2; ++nt) { const int t = 32 * half + 16 * nt + l15;
#pragma unroll
                for (int ms = 0; ms < 4; ++ms) { f32x4 d = (f32x4){0.f, 0.f, 0.f, 0.f};
                    d = mfma16(fs[ms][0], ft[nt][0], d); d = mfma16(fs[ms][1], ft[nt][1], d);
                    const int s0 = 16 * ms + 4 * g;
#pragma unroll
                    for (int i = 0; i < 4; ++i) { const bool keep = incl ? (s0 + i <= t) : (s0 + i < t); d[i] = keep ? d[i] : __builtin_bit_cast(float, zq); }
                    u32x2 w; w.x = pk2(d[0], d[1]); w.y = pk2(d[2], d[3]);
                    *(LAS u32x2*)(lds + matO + t * CH_LD + s0 * 2) = w; } }
        }
        __syncthreads();
        f32x4 rhsU[4];
#pragma unroll
        for (int I = 0; I < 4; ++I) rhsU[I] = (f32x4){0.f, 0.f, 0.f, 0.f};
        if (wave >= 4) {
            const int ctv = (wave & 3) * 16;
            const bf16x8 fv0 = CH_FRAG(CH_VT, ctv + l15, 0, g), fv1 = CH_FRAG(CH_VT, ctv + l15, 1, g);
#pragma unroll
            for (int I = 0; I < 4; ++I) { f32x4 d = (f32x4){0.f, 0.f, 0.f, 0.f};
                d = mfma16(CH_FRAG(CH_LK, 16 * I + l15, 0, g), fv0, d); d = mfma16(CH_FRAG(CH_LK, 16 * I + l15, 1, g), fv1, d); rhsU[I] = -d; }
        }
        if (wave == 0) {
            const int bb = lane >> 4, j = lane & 15;
            float x[16];
#pragma unroll
            for (int t = 0; t < 16; ++t) {
                const u32x4 r0 = *(const LAS u32x4*)(lds + CH_LB + (16 * bb + t) * CH_LD + 32 * bb), r1 = *(const LAS u32x4*)(lds + CH_LB + (16 * bb + t) * CH_LD + 32 * bb + 16);
                const unsigned rw[8] = {r0.x, r0.y, r0.z, r0.w, r1.x, r1.y, r1.z, r1.w};
                float acc = (t == j) ? 1.0f : 0.0f;
#pragma unroll
                for (int s = 0; s < t; ++s) { const float lv = (s & 1) ? bfhi(rw[s >> 1]) : bflo(rw[s >> 1]); acc -= lv * x[s]; }
                x[t] = acc;
                *(LAS bf16*)(lds + CH_DINV + ((bb * 16 + t) * 16 + j) * 2) = (bf16)f2bf(acc);
            }
        }
        __syncthreads();
        {
            const int matZ = wave < 4 ? CH_WT : CH_U0, ct16 = (wave & 3) * 16;
#pragma unroll
            for (int I = 0; I < 4; ++I) {
                f32x4 rhs;
                if (wave < 4) { const u32x2 w = *(const LAS u32x2*)(lds + CH_ABT + (ct16 + l15) * CH_LD + (16 * I + 4 * g) * 2); rhs = (f32x4){bflo(w.x), bfhi(w.x), bflo(w.y), bfhi(w.y)}; }
                else rhs = rhsU[I];
                f32x4 d = (f32x4){0.f, 0.f, 0.f, 0.f};
                d = mfma16(CH_FRAG(CH_LB, 16 * I + l15, 0, g), CH_FRAG(matZ, ct16 + l15, 0, g), d); d = mfma16(CH_FRAG(CH_LB, 16 * I + l15, 1, g), CH_FRAG(matZ, ct16 + l15, 1, g), d);
                const f32x4 ac = rhs - d;
                const u32x2 dv = *(const LAS u32x2*)(lds + CH_DINV + ((I * 16 + l15) * 16 + 4 * g) * 2);
                const bf16x8 fa = as_frag((u32x4){dv.x, dv.y, zq, zq}), fb = as_frag((u32x4){pk2(ac[0], ac[1]), pk2(ac[2], ac[3]), zq, zq});
                const f32x4 z = mfma16(fa, fb, (f32x4){0.f, 0.f, 0.f, 0.f});
                u32x2 w; w.x = pk2(z[0], z[1]); w.y = pk2(z[2], z[3]);
                *(LAS u32x2*)(lds + matZ + (ct16 + l15) * CH_LD + (16 * I + 4 * g) * 2) = w;
                LDS_WAIT(); asm volatile("" ::: "memory");
            }
        }
        __syncthreads();
        {
            const int rt = wave >> 1, cp = (wave & 1) * 2;
            unsigned char* wsl = ws; asm volatile("" : "+s"(wsl));
            float* YL = (float*)(wsl + WS_Y); bf16* RH = (bf16*)(wsl + WS_RH); bf16* PM = (bf16*)(wsl + WS_PM); bf16* QT = (bf16*)(wsl + WS_QT);
            const int trow = scan_row(64 * c + 16 * rt + l15, dir, b);
#pragma unroll
            for (int q = 0; q < 2; ++q) { const int vt = cp + q; f32x4 d = (f32x4){0.f, 0.f, 0.f, 0.f};
#pragma unroll
                for (int ks = 0; ks < 2; ++ks) { d = mfma16(CH_FRAG(CH_VT, 16 * vt + l15, ks, g), CH_FRAG(CH_MK, 16 * rt + l15, ks, g), d); d = mfma16(CH_FRAG(CH_U0, 16 * vt + l15, ks, g), CH_FRAG(CH_MB, 16 * rt + l15, ks, g), d); }
                *(f32x4*)(YL + ((size_t)dir * T + trow) * D + h * 64 + 16 * vt + 4 * g) = d; }
#pragma unroll
            for (int q = 0; q < 2; ++q) { const int kt = cp + q; f32x4 d = (f32x4){0.f, 0.f, 0.f, 0.f};
#pragma unroll
                for (int ks = 0; ks < 2; ++ks) d = mfma16(CH_FRAG(CH_WT, 16 * kt + l15, ks, g), CH_FRAG(CH_MB, 16 * rt + l15, ks, g), d);
                const u32x2 rbw = *(const LAS u32x2*)(lds + CH_RB + (16 * rt + l15) * CH_LD + (16 * kt + 4 * g) * 2);
                u32x2 w; w.x = pk2(bflo(rbw.x) - d[0], bfhi(rbw.x) - d[1]); w.y = pk2(bflo(rbw.y) - d[2], bfhi(rbw.y) - d[3]);
                *(u32x2*)(RH + ((size_t)dir * T + trow) * D + h * 64 + 16 * kt + 4 * g) = w; }
            bf16* Pc = PM + ((size_t)chain * NCHUNK + c) * 4096; bf16* Qc = QT + ((size_t)chain * NCHUNK + c) * 4096;
            { const int krow = 16 * rt + l15; const float gc = gammaC[krow];
#pragma unroll
                for (int q = 0; q < 2; ++q) { const int kt = cp + q; f32x4 d = (f32x4){0.f, 0.f, 0.f, 0.f};
#pragma unroll
                    for (int ks = 0; ks < 2; ++ks) d = mfma16(CH_FRAG(CH_WT, 16 * kt + l15, ks, g), CH_FRAG(CH_BHT, krow, ks, g), d);
                    const int k0 = 16 * kt + 4 * g; f32x4 o;
#pragma unroll
                    for (int i = 0; i < 4; ++i) o[i] = ((k0 + i == krow) ? gc : 0.f) - d[i];
                    u32x2 w; w.x = pk2(o[0], o[1]); w.y = pk2(o[2], o[3]);
                    *(u32x2*)(Pc + krow * 64 + 32 * (kt >> 1) + 8 * g + 4 * (kt & 1)) = w; } }
            { const int vrow = 16 * rt + l15;
#pragma unroll
                for (int q = 0; q < 2; ++q) { const int kt = cp + q; f32x4 d = (f32x4){0.f, 0.f, 0.f, 0.f};
#pragma unroll
                    for (int ks = 0; ks < 2; ++ks) { d = mfma16(CH_FRAG(CH_KHT, 16 * kt + l15, ks, g), CH_FRAG(CH_VT, vrow, ks, g), d); d = mfma16(CH_FRAG(CH_BHT, 16 * kt + l15, ks, g), CH_FRAG(CH_U0, vrow, ks, g), d); }
                    u32x2 w; w.x = pk2(d[0], d[1]); w.y = pk2(d[2], d[3]);
                    *(u32x2*)(Qc + vrow * 64 + 16 * g + 4 * kt) = w; } }
        }
        __syncthreads();
    }
}

struct S2Set { u32x4 p[4][2]; u32x4 q[2]; };
__device__ __forceinline__ void s2_load(S2Set& s, const bf16* Pc, const bf16* Qc, int vt, int l15, int g) {
    s.q[0] = *(const u32x4*)(Qc + (16 * vt + l15) * 64 + 16 * g); s.q[1] = *(const u32x4*)(Qc + (16 * vt + l15) * 64 + 16 * g + 8);
#pragma unroll
    for (int m = 0; m < 4; ++m)
#pragma unroll
        for (int j = 0; j < 2; ++j) s.p[m][j] = *(const u32x4*)(Pc + (16 * m + l15) * 64 + 32 * j + 8 * g);
}
__device__ __forceinline__ void s2_step(f32x4 (&acc)[4], const S2Set& s, bf16* Hc, int g) {
    unsigned hw[4][2];
#pragma unroll
    for (int m = 0; m < 4; ++m) { hw[m][0] = pk2(acc[m][0], acc[m][1]); hw[m][1] = pk2(acc[m][2], acc[m][3]); }
#pragma unroll
    for (int m = 0; m < 4; ++m) *(u32x2*)(Hc + 16 * m + 4 * g) = (u32x2){hw[m][0], hw[m][1]};
    const bf16x8 hb0 = as_frag((u32x4){hw[0][0], hw[0][1], hw[1][0], hw[1][1]}), hb1 = as_frag((u32x4){hw[2][0], hw[2][1], hw[3][0], hw[3][1]});
#pragma unroll
    for (int m = 0; m < 4; ++m) {
        const unsigned q0 = (m & 2) ? ((m & 1) ? s.q[1].z : s.q[1].x) : ((m & 1) ? s.q[0].z : s.q[0].x), q1 = (m & 2) ? ((m & 1) ? s.q[1].w : s.q[1].y) : ((m & 1) ? s.q[0].w : s.q[0].y);
        f32x4 d = (f32x4){bflo(q0), bfhi(q0), bflo(q1), bfhi(q1)};
        d = mfma16(as_frag(s.p[m][0]), hb0, d);
        d = mfma16(as_frag(s.p[m][1]), hb1, d);
        acc[m] = d;
    }
}
__device__ __forceinline__ void phase_s2_chain(const Args& a, int wave, int lane, int G) {
    unsigned char* ws = a.ws;
    const bf16* PM = (const bf16*)(ws + WS_PM); const bf16* QT = (const bf16*)(ws + WS_QT); bf16* HT = (bf16*)(ws + WS_HT);
    const int l15 = lane & 15, g = lane >> 4;
    if (wave >= 2) return;
    static_assert(NCHUNK % 4 == 0, "S2 ring");
    for (int wt = blockIdx.x * 2 + wave; wt < 512; wt += G * 2) {
        const int chain = wt >> 2, vt = wt & 3;
        f32x4 acc[4];
#pragma unroll
        for (int m = 0; m < 4; ++m) acc[m] = (f32x4){0.f, 0.f, 0.f, 0.f};
        const bf16* Pc = PM + (size_t)chain * NCHUNK * 4096; const bf16* Qc = QT + (size_t)chain * NCHUNK * 4096;
        bf16* Hc = HT + (size_t)chain * NCHUNK * 4096 + (16 * vt + l15) * 64;
        S2Set s0, s1, s2, s3;
        s2_load(s0, Pc, Qc, vt, l15, g); s2_load(s1, Pc + 4096, Qc + 4096, vt, l15, g); s2_load(s2, Pc + 2 * 4096, Qc + 2 * 4096, vt, l15, g); s2_load(s3, Pc + 3 * 4096, Qc + 3 * 4096, vt, l15, g);
#pragma unroll 1
        for (int c = 0; c < NCHUNK; c += 4) {
            const int cn = c + 4 < NCHUNK ? c + 4 : c;
            const bf16* Pn = Pc + (size_t)cn * 4096; const bf16* Qn = Qc + (size_t)cn * 4096;
            s2_step(acc, s0, Hc + (size_t)c * 4096, g);       s2_load(s0, Pn, Qn, vt, l15, g);
            s2_step(acc, s1, Hc + (size_t)(c + 1) * 4096, g); s2_load(s1, Pn + 4096, Qn + 4096, vt, l15, g);
            s2_step(acc, s2, Hc + (size_t)(c + 2) * 4096, g); s2_load(s2, Pn + 2 * 4096, Qn + 2 * 4096, vt, l15, g);
            s2_step(acc, s3, Hc + (size_t)(c + 3) * 4096, g); s2_load(s3, Pn + 3 * 4096, Qn + 3 * 4096, vt, l15, g);
        }
    }
}

__device__ __forceinline__ void phase_s3_readout(const Args& a, int lj, int nrows, int gw, int NGW, int lane) {
    unsigned char* ws = a.ws;
    const float* YL = (const float*)(ws + WS_Y); const bf16* RH = (const bf16*)(ws + WS_RH); const bf16* HT = (const bf16*)(ws + WS_HT);
    const bf16* Vv = (const bf16*)(ws + WS_RKV) + (size_t)2 * T * D; const float* RKB = (const float*)(ws + WS_RKB); const bf16* Gg = (const bf16*)(ws + WS_G); bf16* Z = (bf16*)(ws + WS_Z);
    const float* lng = a.in[21] + lj * 1024; const float* lnb = a.in[22] + lj * 1024;
    const int l15 = lane & 15, g = lane >> 4;
    for (int task = gw; task < (nrows / 16) * 16; task += NGW) {
        const int tt = task >> 4, h = task & 15, r0 = tt * 16, row = r0 + l15;
        int b, cc[2];
        if (r0 < TL) { b = r0 >> 13; const int tb = (r0 & (SEQ - 1)) >> 6; cc[0] = 4 + tb; cc[1] = 4 + (127 - tb); }
        else { const int loc = r0 - TL; b = loc >> 8; const int tb = (loc & 255) >> 6; cc[0] = tb; cc[1] = 3 - tb; }
        f32x4 acc[4];
        const size_t ro = (size_t)row * D + h * 64 + 4 * g;
#pragma unroll
        for (int vt = 0; vt < 4; ++vt) acc[vt] = *(const f32x4*)(YL + ro + 16 * vt) + *(const f32x4*)(YL + (size_t)T * D + ro + 16 * vt);
#pragma unroll
        for (int dir = 0; dir < 2; ++dir) {
            const int chain = dir * 64 + b * 16 + h;
            const bf16* rh = RH + ((size_t)dir * T + row) * D + h * 64 + 8 * g;
            const bf16x8 f0 = as_frag(*(const u32x4*)(rh)), f1 = as_frag(*(const u32x4*)(rh + 32));
            const bf16* hc = HT + ((size_t)chain * NCHUNK + cc[dir]) * 4096;
#pragma unroll
            for (int vt = 0; vt < 4; ++vt) { const bf16* hr = hc + (16 * vt + l15) * 64 + 8 * g;
                acc[vt] = mfma16(as_frag(*(const u32x4*)(hr)), f0, acc[vt]); acc[vt] = mfma16(as_frag(*(const u32x4*)(hr + 32)), f1, acc[vt]); }
        }
        float s = 0.f;
#pragma unroll
        for (int vt = 0; vt < 4; ++vt) s += (acc[vt][0] + acc[vt][1]) + (acc[vt][2] + acc[vt][3]);
        s += __shfl_xor(s, 16); s += __shfl_xor(s, 32);
        const float mean = s * (1.0f / 64.0f); float vs = 0.f;
#pragma unroll
        for (int vt = 0; vt < 4; ++vt) { acc[vt] = acc[vt] - mean; vs += (acc[vt][0] * acc[vt][0] + acc[vt][1] * acc[vt][1]) + (acc[vt][2] * acc[vt][2] + acc[vt][3] * acc[vt][3]); }
        vs += __shfl_xor(vs, 16); vs += __shfl_xor(vs, 32);
        const float rstd = rsqrtf(vs * (1.0f / 64.0f) + 64.0f * 1e-5f), bon = RKB[(size_t)row * 16 + h];
#pragma unroll
        for (int vt = 0; vt < 4; ++vt) { const int col = h * 64 + 16 * vt + 4 * g; const size_t o = (size_t)row * D + col;
            const f32x4 vq = bf4(*(const u32x2*)(Vv + o)), lg4 = *(const f32x4*)(lng + col), lb4 = *(const f32x4*)(lnb + col); const u32x2 gw2 = *(const u32x2*)(Gg + o);
            const f32x4 zz = acc[vt] * rstd * lg4 + lb4 + vq * bon;
            u32x2 w; w.x = pk2(zz[0] * bflo(gw2.x), zz[1] * bfhi(gw2.x)); w.y = pk2(zz[2] * bflo(gw2.y), zz[3] * bfhi(gw2.y));
            *(u32x2*)(Z + o) = w; }
    }
}
__device__ __forceinline__ void phase_cv(const Args& a, int lc, int rows, int gw, int NGW, int lane) {
    unsigned char* ws = a.ws;
    const bf16* BG = (const bf16*)(ws + WS_BG); const bf16* CU = (const bf16*)(ws + WS_CUZ); bf16* Z = (bf16*)(ws + WS_Z);
    const float* cw = a.in[25] + (size_t)lc * 3 * 1024;
    for (int t = gw; t < rows; t += NGW) {
        int rs, re; if (t < TL) { rs = t & ~63; re = rs + 63; } else { const int loc = t - TL; rs = TL + (loc & ~255); re = rs + 255; }
        const bool hp = t > rs, hn = t < re;
#pragma unroll
        for (int j = 0; j < 4; ++j) { const int col = 256 * j + 4 * lane; const size_t o = (size_t)t * D + col;
            const u32x2 zc = *(const u32x2*)(CU + o), bg = *(const u32x2*)(BG + o);
            const u32x2 zp = hp ? *(const u32x2*)(CU + o - D) : (u32x2){0u, 0u}, zn = hn ? *(const u32x2*)(CU + o + D) : (u32x2){0u, 0u};
            const f32x4 w0 = *(const f32x4*)(cw + col), w1 = *(const f32x4*)(cw + 1024 + col), w2 = *(const f32x4*)(cw + 2048 + col);
            const f32x4 zv = (f32x4){bflo(zc.x), bfhi(zc.x), bflo(zc.y), bfhi(zc.y)}, pv = (f32x4){bflo(zp.x), bfhi(zp.x), bflo(zp.y), bfhi(zp.y)}, nv = (f32x4){bflo(zn.x), bfhi(zn.x), bflo(zn.y), bfhi(zn.y)};
            const f32x4 bv = (f32x4){bflo(bg.x), bfhi(bg.x), bflo(bg.y), bfhi(bg.y)};
            const f32x4 r = bv * (w0 * pv + w1 * zv + w2 * nv);
            u32x2 w; w.x = pk2(r.x, r.y); w.y = pk2(r.z, r.w); *(u32x2*)(Z + o) = w; }
    }
}
__device__ __forceinline__ float lane_bcast(float v, int srclane) { return __builtin_bit_cast(float, __builtin_amdgcn_readlane(__builtin_bit_cast(int, v), srclane)); }
__device__ __forceinline__ void phase_e_route(const Args& a, int layer, int rows, LAS unsigned char* lds, int tid, int gw, int NGW, int lane) {
    unsigned char* ws = a.ws;
    const float* xs = (const float*)(ws + (layer < 2 ? WS_XSA : WS_XSB));
    const float* MODS = (const float*)(ws + WS_MODS); bf16* H2 = (bf16*)(ws + WS_H2);
    const float* ng = a.in[6] + (size_t)(layer * 2 + 1) * 1024;
    const float* rw = a.in[27] + (size_t)layer * 1024 * 32; const float* rb = a.in[28] + layer * 32;
    unsigned* cnt = (unsigned*)(ws + WS_CTL) + CW_CNT + layer * 64;
    int* SLOTL = (int*)(ws + WS_SLOTL); float* GATEL = (float*)(ws + WS_GATEL);
    LAS float* wt = (LAS float*)lds;
    for (int i = tid; i < 32768; i += 512) wt[(i & 31) * 1024 + (i >> 5)] = rw[i];
    __syncthreads();
    const int my_e = lane >> 1; const float my_b = rb[my_e];
    const bool b5 = (lane & 32) != 0, b4 = (lane & 16) != 0, b3 = (lane & 8) != 0, b2 = (lane & 4) != 0, b1 = (lane & 2) != 0;
    for (int t = gw; t < rows; t += NGW) {
        const int mr = mod_row(t);
        const float* mod = MODS + (size_t)(layer * 5 + mr) * 6144;
        f32x4 x[4];
#pragma unroll
        for (int j = 0; j < 4; ++j) x[j] = *(const f32x4*)(xs + (size_t)t * D + 256 * j + 4 * lane);
        const float rstd = row_rstd(x);
#pragma unroll
        for (int j = 0; j < 4; ++j) { const int col = 256 * j + 4 * lane;
            x[j] = x[j] * rstd * *(const f32x4*)(ng + col) * (*(const f32x4*)(mod + 4 * 1024 + col) + 1.0f) + *(const f32x4*)(mod + 3 * 1024 + col);
            u32x2 w; w.x = pk2(x[j].x, x[j].y); w.y = pk2(x[j].z, x[j].w); *(u32x2*)(H2 + (size_t)t * D + col) = w; }
        float p[32];
#pragma unroll
        for (int eg = 0; eg < 8; ++eg) {
#pragma unroll
            for (int ee = 0; ee < 4; ++ee) { const int e = eg * 4 + ee; float s = 0.f;
#pragma unroll
                for (int j = 0; j < 4; ++j) { const f32x4 wv = *(const LAS f32x4*)(wt + e * 1024 + 256 * j + 4 * lane); s += (x[j].x * wv.x + x[j].y * wv.y) + (x[j].z * wv.z + x[j].w * wv.w); }
                p[e] = s; }
            asm volatile("" ::: "memory");
        }
        float q16[16];
#pragma unroll
        for (int i = 0; i < 16; ++i) { const float send = b5 ? p[i] : p[i + 16]; const float keep = b5 ? p[i + 16] : p[i]; q16[i] = keep + __shfl_xor(send, 32); }
        float q8[8];
#pragma unroll
        for (int i = 0; i < 8; ++i) { const float send = b4 ? q16[i] : q16[i + 8]; const float keep = b4 ? q16[i + 8] : q16[i]; q8[i] = keep + __shfl_xor(send, 16); }
        float q4[4];
#pragma unroll
        for (int i = 0; i < 4; ++i) { const float send = b3 ? q8[i] : q8[i + 4]; const float keep = b3 ? q8[i + 4] : q8[i]; q4[i] = keep + __shfl_xor(send, 8); }
        float q2[2];
#pragma unroll
        for (int i = 0; i < 2; ++i) { const float send = b2 ? q4[i] : q4[i + 2]; const float keep = b2 ? q4[i + 2] : q4[i]; q2[i] = keep + __shfl_xor(send, 4); }
        float q1; { const float send = b1 ? q2[0] : q2[1]; const float keep = b1 ? q2[1] : q2[0]; q1 = keep + __shfl_xor(send, 2); }
        const float lg = q1 + __shfl_xor(q1, 1) + my_b;
        int rank = 0;
#pragma unroll 1
        for (int e = 0; e < 32; ++e) { const float o = lane_bcast(lg, 2 * e); rank += (o > lg || (o == lg && e < my_e)) ? 1 : 0; }
        const bool sel = rank < 4 && !(lane & 1);
        const unsigned long long m0 = __ballot(sel && rank == 0), m1 = __ballot(sel && rank == 1), m2 = __ballot(sel && rank == 2), m3 = __ballot(sel && rank == 3);
        const float v0 = lane_bcast(lg, (int)__builtin_ctzll(m0)), v1 = lane_bcast(lg, (int)__builtin_ctzll(m1)), v2 = lane_bcast(lg, (int)__builtin_ctzll(m2)), v3 = lane_bcast(lg, (int)__builtin_ctzll(m3));
        const float e1 = __expf(v1 - v0), e2 = __expf(v2 - v0), e3 = __expf(v3 - v0);
        const float inv = 1.0f / (1.0f + e1 + e2 + e3);
        if (sel) {
            const float gk = __expf(lg - v0) * inv;
            const unsigned pos = atomicAdd(cnt + my_e, 1u);
            SLOTL[(size_t)my_e * T + pos] = t * 4 + rank; GATEL[(size_t)my_e * T + pos] = gk;
        }
    }
}
__device__ __forceinline__ void phase_final(const Args& a, int gw, int NGW, int lane) {
    unsigned char* ws = a.ws;
    const float* xs = (const float*)(ws + WS_XSB); const float* MODS = (const float*)(ws + WS_MODS); const bf16* YS = (const bf16*)(ws + WS_YS);
    for (int t = gw; t < TL; t += NGW) {
        const int mr = t >> 13;
        f32x4 m5[4], x[4];
#pragma unroll
        for (int j = 0; j < 4; ++j) m5[j] = *(const f32x4*)(MODS + (size_t)(3 * 5 + mr) * 6144 + 5 * 1024 + 256 * j + 4 * lane);
        load_x_combined(x, xs + (size_t)t * D, true, YS, t, m5, lane);
        const float rstd = row_rstd(x);
#pragma unroll
        for (int j = 0; j < 4; ++j) { const int col = 256 * j + 4 * lane; *(f32x4*)(a.out + (size_t)t * D + col) = x[j] * rstd * *(const f32x4*)(a.in[7] + col); }
    }
}

using pg8::Unit; using pg8::tile_map;
struct SchedStd {
    int G, c, nM, nN;
    __device__ __forceinline__ bool next(int i, Unit& u) const { const long L = (long)i * G + c; if (L >= (long)nM * nN) return false; int pm, pn; tile_map((int)L, nM, nN, pm, pn); u.pm = pm; u.pn = pn; u.e = 0; u.nv = pm; return true; }
    __device__ __forceinline__ void a_ready(const Unit&) const {}
    __device__ __forceinline__ void done(const Unit&) const {}
    __device__ __forceinline__ unsigned row_off(const Unit&, int) const { return 0u; }
};
struct SchedB1 {
    int G, c;
    __device__ __forceinline__ bool next(int i, Unit& u) const { const long L = (long)i * G + c; constexpr int n1 = 3 * NMT * 4; if (L >= n1 + 3 * NMT) return false; const int l = (int)L;
        if (l < n1) { const int j = l / (NMT * 4), r = l % (NMT * 4); int pm, pn; tile_map(r, NMT, 4, pm, pn); u.pm = j * NMT + pm; u.pn = j * 4 + pn; u.e = j; u.nv = pm; }
        else { const int r = l - n1, j = r / NMT, pm = r % NMT; u.pm = (3 + j) * NMT + pm; u.pn = 12 + j; u.e = 3 + j; u.nv = pm; }
        return true; }
    __device__ __forceinline__ void a_ready(const Unit&) const {}
    __device__ __forceinline__ void done(const Unit&) const {}
    __device__ __forceinline__ unsigned row_off(const Unit&, int) const { return 0u; }
};
struct SchedB2 {
    int G, c;
    __device__ __forceinline__ bool next(int i, Unit& u) const { const long L = (long)i * G + c; constexpr int n1 = 2 * NMT * 8; if (L >= n1 + NMT * 4) return false; const int l = (int)L;
        if (l < n1) { const int j = l / (NMT * 8), r = l % (NMT * 8); int pm, pn; tile_map(r, NMT, 8, pm, pn); u.pm = j * NMT + pm; u.pn = j * 8 + pn; u.e = j; u.nv = pm; }
        else { const int r = l - n1; int pm, pn; tile_map(r, NMT, 4, pm, pn); u.pm = 2 * NMT + pm; u.pn = 16 + pn; u.e = 2; u.nv = pm; }
        return true; }
    __device__ __forceinline__ void a_ready(const Unit&) const {}
    __device__ __forceinline__ void done(const Unit&) const {}
    __device__ __forceinline__ unsigned row_off(const Unit&, int) const { return 0u; }
};
struct SchedMoe {
    int G, c, nnt, ntiles; LAS unsigned char* lds; const int* slotl;
    __device__ __forceinline__ bool next(int i, Unit& u) const { const long L = (long)i * G + c; if (L >= (long)((ntiles + 7) & ~7) * nnt) return false;
        const LAS int* tpre = (const LAS int*)(lds + LDSCTL_OFF + 64); const LAS int* ecnt = (const LAS int*)(lds + LDSCTL_OFF + 256); const LAS unsigned short* tile_e = (const LAS unsigned short*)(lds + LDSCTL_OFF + 512);
        const int xq = (int)(L >> 3), x8 = (int)(L & 7); int tile = (xq / nnt) * 8 + x8; const int pnl = xq % nnt; const bool dead = tile >= ntiles; tile = dead ? 0 : tile;
        const int e = __builtin_amdgcn_readfirstlane((int)tile_e[tile]), r0 = (tile - __builtin_amdgcn_readfirstlane(tpre[e])) * 256; int nv = __builtin_amdgcn_readfirstlane(ecnt[e]) - r0; nv = nv > 256 ? 256 : nv; nv = dead ? 0 : nv;
        u.pm = dead ? MAXTILES : tile; u.pn = e * nnt + pnl; u.e = e; u.nv = nv | (r0 << 9); return true; }
    __device__ __forceinline__ void a_ready(const Unit&) const {}
    __device__ __forceinline__ void done(const Unit&) const {}
    __device__ __forceinline__ unsigned row_off(const Unit& u, int r) const { const int nv = u.nv & 511, r0 = u.nv >> 9; const int tok = r < nv ? (slotl[(size_t)u.e * T + r0 + r] >> 2) : 0; return (unsigned)tok * 2048u; }
};

using pg8::cvt_pk_bf16;
template <class P> __device__ __forceinline__ P* pin_ptr(P* p) { asm volatile("" : "+v"(p)); return p; }
struct EpiB1 {
    static constexpr bool PERM = true, AFTER_DRAIN = false;
    bf16* RKV; bf16* L1;
    __device__ __forceinline__ void operator()(const f32x4 (&acc)[2][2][4][2], const Unit& u, int wr, int wc, int fr, int fq) const {
        const int seg = u.e, row0 = u.nv * 256 + wr * 64 + fr;
        const int jj = seg - 3, ld = seg < 3 ? D : 256, col0 = (seg < 3 ? (u.pn - seg * 4) * 256 : 0) + wc * 32 + 8 * fq;
        bf16* base = seg < 3 ? RKV + (size_t)seg * T * D : L1 + (size_t)jj * T * 256;
#pragma unroll
        for (int ai = 0; ai < 2; ++ai)
#pragma unroll
            for (int m = 0; m < 4; ++m) { bf16* rowp = base + (size_t)(row0 + ai * 128 + m * 16) * ld + col0;
#pragma unroll
                for (int bj = 0; bj < 2; ++bj) { f32x4 v0 = acc[ai][bj][m][0], v1 = acc[ai][bj][m][1];
                    if (jj == 0) {
#pragma unroll
                        for (int q = 0; q < 4; ++q) { v0[q] = tanh_fast(v0[q]); v1[q] = tanh_fast(v1[q]); } }
                    else if (jj == 2) {
#pragma unroll
                        for (int q = 0; q < 4; ++q) { v0[q] = sigm(v0[q]); v1[q] = sigm(v1[q]); } }
                    u32x4 w; w.x = cvt_pk_bf16(v0[0], v0[1]); w.y = cvt_pk_bf16(v0[2], v0[3]); w.z = cvt_pk_bf16(v1[0], v1[1]); w.w = cvt_pk_bf16(v1[2], v1[3]);
                    *(u32x4*)(rowp + bj * 128) = w; } }
    }
};
struct EpiB2 {
    static constexpr bool PERM = true, AFTER_DRAIN = false;
    bf16* RW; bf16* RA; bf16* Gg;
    __device__ __forceinline__ void operator()(const f32x4 (&acc)[2][2][4][2], const Unit& u, int wr, int wc, int fr, int fq) const {
        const int jj = u.e, row0 = u.nv * 256 + wr * 64 + fr, pnl = u.pn - jj * 8;
        const int dirn = jj < 2 ? (pnl >> 2) : 0, col0 = (jj < 2 ? (pnl & 3) : pnl) * 256 + wc * 32 + 8 * fq;
        bf16* base = (jj == 0 ? RW : jj == 1 ? RA : Gg) + (size_t)dirn * T * D;
#pragma unroll
        for (int ai = 0; ai < 2; ++ai)
#pragma unroll
            for (int m = 0; m < 4; ++m) { bf16* rowp = base + (size_t)(row0 + ai * 128 + m * 16) * D + col0;
#pragma unroll
                for (int bj = 0; bj < 2; ++bj) { const f32x4 v0 = acc[ai][bj][m][0], v1 = acc[ai][bj][m][1];
                    u32x4 w; w.x = cvt_pk_bf16(v0[0], v0[1]); w.y = cvt_pk_bf16(v0[2], v0[3]); w.z = cvt_pk_bf16(v1[0], v1[1]); w.w = cvt_pk_bf16(v1[2], v1[3]);
                    *(u32x4*)(rowp + bj * 128) = w; } }
    }
};
struct EpiRes {
    static constexpr bool PERM = true, AFTER_DRAIN = false;
    float* X; const float* gate;
    __device__ __forceinline__ void operator()(const f32x4 (&acc)[2][2][4][2], const Unit& u, int wr, int wc, int fr, int fq) const {
        const int row0 = u.pm * 256 + wr * 64 + fr, col0 = u.pn * 256 + wc * 32 + 8 * fq, mr = u.pm < NMT_L ? (u.pm >> 5) : 4;
        const float* gp = pin_ptr(gate + (size_t)mr * 6144 + col0);
        f32x4 gv[2][2];
#pragma unroll
        for (int bj = 0; bj < 2; ++bj)
#pragma unroll
            for (int n = 0; n < 2; ++n) gv[bj][n] = *(const f32x4*)(gp + bj * 128 + 4 * n);
#pragma unroll
        for (int ai = 0; ai < 2; ++ai)
#pragma unroll
            for (int m = 0; m < 4; ++m) { float* rowp = X + (size_t)(row0 + ai * 128 + m * 16) * D + col0;
#pragma unroll
                for (int bj = 0; bj < 2; ++bj)
#pragma unroll
                    for (int n = 0; n < 2; ++n) { float* p = rowp + bj * 128 + 4 * n; *(f32x4*)p = *(const f32x4*)p + gv[bj][n] * acc[ai][bj][m][n]; } }
    }
};
struct EpiWin {
    static constexpr bool PERM = true, AFTER_DRAIN = false;
    bf16* BG; bf16* CU;
    __device__ __forceinline__ void operator()(const f32x4 (&acc)[2][2][4][2], const Unit& u, int wr, int wc, int fr, int fq) const {
        const int row0 = u.pm * 256 + wr * 64 + fr;
        if (u.pn < 4) {
            const int col0 = u.pn * 256 + wc * 32 + 8 * fq;
#pragma unroll
            for (int ai = 0; ai < 2; ++ai)
#pragma unroll
                for (int m = 0; m < 4; ++m) { bf16* rowp = BG + (size_t)(row0 + ai * 128 + m * 16) * D + col0;
#pragma unroll
                    for (int bj = 0; bj < 2; ++bj) { const f32x4 v0 = acc[ai][bj][m][0], v1 = acc[ai][bj][m][1];
                        u32x4 w; w.x = cvt_pk_bf16(v0[0], v0[1]); w.y = cvt_pk_bf16(v0[2], v0[3]); w.z = cvt_pk_bf16(v1[0], v1[1]); w.w = cvt_pk_bf16(v1[2], v1[3]);
                        *(u32x4*)(rowp + bj * 128) = w; } }
        } else {
            const int f0 = (u.pn - 4) * 128 + wc * 32 + 8 * fq;
#pragma unroll
            for (int ai = 0; ai < 2; ++ai)
#pragma unroll
                for (int m = 0; m < 4; ++m) { const f32x4 v0 = acc[ai][0][m][0] * acc[ai][1][m][0], v1 = acc[ai][0][m][1] * acc[ai][1][m][1];
                    u32x4 w; w.x = cvt_pk_bf16(v0[0], v0[1]); w.y = cvt_pk_bf16(v0[2], v0[3]); w.z = cvt_pk_bf16(v1[0], v1[1]); w.w = cvt_pk_bf16(v1[2], v1[3]);
                    *(u32x4*)(CU + (size_t)(row0 + ai * 128 + m * 16) * D + f0) = w; }
        }
    }
};
struct EpiGU {
    static constexpr bool PERM = true, AFTER_DRAIN = false;
    bf16* INTER; const float* bgu;
    __device__ __forceinline__ void operator()(const f32x4 (&acc)[2][2][4][2], const Unit& u, int wr, int wc, int fr, int fq) const {
        const int e = u.e, pnl = u.pn - e * 8, row0 = u.pm * 256 + wr * 64 + fr, f0 = pnl * 128 + wc * 32 + 8 * fq;
        const float* bp = pin_ptr(bgu + (size_t)e * 2048 + f0);
        f32x4 bg[2], bu[2];
#pragma unroll
        for (int n = 0; n < 2; ++n) { bg[n] = *(const f32x4*)(bp + 4 * n); bu[n] = *(const f32x4*)(bp + 1024 + 4 * n); }
#pragma unroll
        for (int ai = 0; ai < 2; ++ai)
#pragma unroll
            for (int m = 0; m < 4; ++m) { f32x4 o[2];
#pragma unroll
                for (int n = 0; n < 2; ++n) { const f32x4 g = acc[ai][0][m][n] + bg[n], uu = acc[ai][1][m][n] + bu[n];
#pragma unroll
                    for (int q = 0; q < 4; ++q) { const float gc = fminf(g[q], 7.0f), uc = fminf(fmaxf(uu[q], -7.0f), 7.0f); o[n][q] = (uc + 1.0f) * gc * sigm(1.702f * gc); } }
                u32x4 w; w.x = cvt_pk_bf16(o[0][0], o[0][1]); w.y = cvt_pk_bf16(o[0][2], o[0][3]); w.z = cvt_pk_bf16(o[1][0], o[1][1]); w.w = cvt_pk_bf16(o[1][2], o[1][3]);
                *(u32x4*)(INTER + (size_t)(row0 + ai * 128 + m * 16) * 1024 + f0) = w; }
    }
};
struct EpiDown {
    static constexpr bool PERM = true, AFTER_DRAIN = false;
    bf16* YS; const float* bdn; const int* slotl; const float* gatel;
    __device__ __forceinline__ void operator()(const f32x4 (&acc)[2][2][4][2], const Unit& u, int wr, int wc, int fr, int fq) const {
        const int e = u.e, pnl = u.pn - e * 4, col0 = pnl * 256 + wc * 32 + 8 * fq, nv = u.nv & 511, r0 = u.nv >> 9;
        const float* bp = pin_ptr(bdn + (size_t)e * 1024 + col0);
        f32x4 bv[2][2];
#pragma unroll
        for (int bj = 0; bj < 2; ++bj)
#pragma unroll
            for (int n = 0; n < 2; ++n) bv[bj][n] = *(const f32x4*)(bp + bj * 128 + 4 * n);
#pragma unroll
        for (int ai = 0; ai < 2; ++ai)
#pragma unroll
            for (int m = 0; m < 4; ++m) { const int r = ai * 128 + wr * 64 + m * 16 + fr;
                if (r < nv) { const size_t li = (size_t)e * T + r0 + r; const int slot = slotl[li]; const float gt = gatel[li];
                    bf16* rowp = YS + (size_t)slot * 1024 + col0;
#pragma unroll
                    for (int bj = 0; bj < 2; ++bj) { const f32x4 v0 = (acc[ai][bj][m][0] + bv[bj][0]) * gt, v1 = (acc[ai][bj][m][1] + bv[bj][1]) * gt;
                        u32x4 w; w.x = cvt_pk_bf16(v0[0], v0[1]); w.y = cvt_pk_bf16(v0[2], v0[3]); w.z = cvt_pk_bf16(v1[0], v1[1]); w.w = cvt_pk_bf16(v1[2], v1[3]);
                        *(u32x4*)(rowp + bj * 128) = w; } } }
    }
};

__device__ __forceinline__ int moe_tables(const unsigned* cnt, LAS unsigned char* lds, int tid) {
    LAS int* tpre = (LAS int*)(lds + LDSCTL_OFF + 64); LAS int* ecnt = (LAS int*)(lds + LDSCTL_OFF + 256); LAS unsigned short* tile_e = (LAS unsigned short*)(lds + LDSCTL_OFF + 512);
    if (tid == 0) { int p = 0; for (int e = 0; e < 32; ++e) { const int cn = (int)__hip_atomic_load(cnt + e, __ATOMIC_RELAXED, __HIP_MEMORY_SCOPE_AGENT); ecnt[e] = cn; tpre[e] = p; p += (cn + 255) >> 8; } tpre[32] = p; }
    __syncthreads();
    const int nt = tpre[32];
    for (int t = tid; t < nt; t += 512) { int e = 0; while (e < 31 && t >= tpre[e + 1]) ++e; tile_e[t] = (unsigned short)e; }
    __syncthreads();
    return nt;
}

constexpr int NPHASES = 38;
typedef const Args __attribute__((address_space(4))) CArgs;
__global__ void __launch_bounds__(512, 2) fwd_kernel(Args a_) {
    extern __shared__ __attribute__((aligned(16))) unsigned char lds_raw[];
    LAS unsigned char* lds = (LAS unsigned char*)lds_raw;
    const int G = gridDim.x, NGW = G * 8;
    CArgs* ap0 = (CArgs*)__builtin_amdgcn_kernarg_segment_ptr();
    if (threadIdx.x < 4) ((LAS unsigned*)(lds + LDSCTL_OFF))[threadIdx.x] = 0u;
    __syncthreads();
    XcdBarrier bar = xcd_barrier_post((unsigned*)(a_.ws + WS_CTL) + CW_BAR, (volatile LAS unsigned*)(lds + LDSCTL_OFF));
    const int lo = a_.ph_lo, hi = a_.ph_hi;
    int ph = 0;
#ifndef MK_ONLY
#define MK_ONLY -1
#endif
#ifndef MK_DBL
#define MK_DBL 0
#endif
#define PH_BEGIN(id) if ((MK_ONLY < 0 || MK_ONLY == (id)) && ph >= lo && ph < hi) { for (int rep_ = 0; rep_ <= ((MK_DBL >> (id)) & 1); ++rep_) { CArgs* ap = ap0; asm volatile("" : "+s"(ap)); const Args a = *(const Args*)ap; unsigned char* const ws = a.ws; (void)ws; const int wave = (int)bar.wv; int tid = wave * 64 + lane_id(); asm volatile("" : "+v"(tid)); const int lane = tid & 63, gw = blockIdx.x * 8 + wave; (void)lane; (void)gw;
#define PH_END } } if (ph >= lo && ph + 1 < hi) xcd_barrier(bar); ++ph;

    PH_BEGIN(0) p0_prologue(a, lds, tid, lane, wave, G); PH_END

#pragma unroll 1
    for (int layer = 0; layer < DEPTH; ++layer) {
        const int kind = layer & 1, lj = layer >> 1;
        const int rows = layer == 3 ? TL : T, nmt = rows / 256;
        const int rows_moe = layer < 2 ? T : TL;
        if (kind == 0) {
            PH_BEGIN(1) phase_a_rwkv(a, layer, lds, tid, gw, NGW, lane); PH_END
            PH_BEGIN(2) {
                pg8::Gemm g{(const bf16*)(ws + WS_XL), (const bf16*)(ws + WS_WRKV) + (size_t)lj * 3840 * 1024, 6 * T, 3840, 1024};
                SchedB1 S{G, (int)blockIdx.x}; EpiB1 E{(bf16*)(ws + WS_RKV), (bf16*)(ws + WS_L1)};
                pg8::gemm_phase<EpiB1, SchedB1, true, true, false>(lds, g, S, E, tid); } PH_END
            PH_BEGIN(3) {
                pg8::Gemm g{(const bf16*)(ws + WS_L1), (const bf16*)(ws + WS_L2T) + (size_t)lj * 5120 * 256, 3 * T, 5120, 256};
                SchedB2 S{G, (int)blockIdx.x}; EpiB2 E{(bf16*)(ws + WS_RAWW), (bf16*)(ws + WS_RAWA), (bf16*)(ws + WS_G)};
                pg8::gemm_phase<EpiB2, SchedB2, true, true, false>(lds, g, S, E, tid); } PH_END
            PH_BEGIN(4) phase_c_prep(a, lj, lds, tid, gw, NGW, lane); PH_END
            PH_BEGIN(5) phase_s1_chunks(a, lds, tid, G); PH_END
            PH_BEGIN(15) phase_s2_chain(a, wave, lane, G); PH_END
            PH_BEGIN(6) phase_s3_readout(a, lj, layer == 2 ? TL : T, gw, NGW, lane); PH_END
        } else {
            PH_BEGIN(7) phase_a_conv(a, layer, rows, gw, NGW, lane); PH_END
            PH_BEGIN(8) {
                pg8::Gemm g{(const bf16*)(ws + WS_XL), (const bf16*)(ws + WS_WIN) + (size_t)lj * 3072 * 1024, rows, 3072, 1024};
                SchedStd S{G, (int)blockIdx.x, nmt, 12}; EpiWin E{(bf16*)(ws + WS_BG), (bf16*)(ws + WS_CUZ)};
                pg8::gemm_phase<EpiWin, SchedStd, true, true, false>(lds, g, S, E, tid); } PH_END
            PH_BEGIN(9) phase_cv(a, lj, rows, gw, NGW, lane); PH_END
        }
        PH_BEGIN(10) {
            const bf16* Wt = kind == 0 ? (const bf16*)(ws + WS_WO) + (size_t)lj * 1024 * 1024 : (const bf16*)(ws + WS_WOUT) + (size_t)lj * 1024 * 1024;
            pg8::Gemm g{(const bf16*)(ws + WS_Z), Wt, rows, 1024, 1024};
            SchedStd S{G, (int)blockIdx.x, layer == 2 ? NMT_L : nmt, 4}; EpiRes E{(float*)(ws + (layer < 2 ? WS_XSA : WS_XSB)), (const float*)(ws + WS_MODS) + (size_t)layer * 5 * 6144 + 2 * 1024};
            pg8::gemm_phase<EpiRes, SchedStd, true, true, false>(lds, g, S, E, tid); } PH_END
        PH_BEGIN(11) phase_e_route(a, layer, rows_moe, lds, tid, gw, NGW, lane); PH_END
        PH_BEGIN(12) {
            const int nt = __builtin_amdgcn_readfirstlane(moe_tables((const unsigned*)(ws + WS_CTL) + CW_CNT + layer * 64, lds, tid));
            pg8::Gemm g{(const bf16*)(ws + WS_H2), (const bf16*)(ws + WS_WGU) + (size_t)layer * 32 * 2048 * 1024, 0, 0, 1024};
            SchedMoe S{G, (int)blockIdx.x, 8, nt, lds, (const int*)(ws + WS_SLOTL)};
            EpiGU E{(bf16*)(ws + WS_INTER), a.in[30] + (size_t)layer * 32 * 2048};
            pg8::gemm_phase<EpiGU, SchedMoe, true, true, true>(lds, g, S, E, tid); } PH_END
        PH_BEGIN(13) {
            const int nt = __builtin_amdgcn_readfirstlane(moe_tables((const unsigned*)(ws + WS_CTL) + CW_CNT + layer * 64, lds, tid));
            pg8::Gemm g{(const bf16*)(ws + WS_INTER), (const bf16*)(ws + WS_WDN) + (size_t)layer * 32 * 1024 * 1024, 0, 0, 1024};
            SchedMoe S{G, (int)blockIdx.x, 4, nt, lds, (const int*)(ws + WS_SLOTL)};
            EpiDown E{(bf16*)(ws + WS_YS), a.in[32] + (size_t)layer * 32 * 1024, (const int*)(ws + WS_SLOTL), (const float*)(ws + WS_GATEL)};
            pg8::gemm_phase<EpiDown, SchedMoe, true, true, false>(lds, g, S, E, tid); } PH_END
    }
    PH_BEGIN(14) phase_final(a, gw, NGW, lane); PH_END
#undef PH_BEGIN
#undef PH_END
}

extern "C" void kernel_launch(void* const* d_in, const int* in_sizes, int n_in, void* d_out, int out_size, void* d_ws, size_t ws_size, hipStream_t stream) {
    static int grid = 0;
    if (grid == 0) {
        if (n_in != 33 || in_sizes[0] != TL * D || out_size != TL * D || ws_size < WS_END) { fprintf(stderr, "kernel_launch: unexpected problem (n_in %d, in0 %d, out %d, ws %zu < %zu)\n", n_in, n_in > 0 ? in_sizes[0] : -1, out_size, ws_size, (size_t)WS_END); grid = -1; return; }
        int dev = 0, cus = 0, per_cu = 0;
        if (hipGetDevice(&dev) != hipSuccess || hipDeviceGetAttribute(&cus, hipDeviceAttributeMultiprocessorCount, dev) != hipSuccess) { grid = -1; return; }
        if (hipFuncSetAttribute((const void*)fwd_kernel, hipFuncAttributeMaxDynamicSharedMemorySize, LDS_BYTES) != hipSuccess) { fprintf(stderr, "kernel_launch: hipFuncSetAttribute failed\n"); grid = -1; return; }
        if (hipOccupancyMaxActiveBlocksPerMultiprocessor(&per_cu, (const void*)fwd_kernel, 512, LDS_BYTES) != hipSuccess || per_cu < 1) fprintf(stderr, "kernel_launch: occupancy query says %d\n", per_cu);
        (void)hipGetLastError();
        grid = cus;
    }
    if (grid < 0) return;
    if (hipMemsetAsync((char*)d_ws + WS_CTL, 0, CTL_ZERO_BYTES, stream) != hipSuccess) return;
    Args a{};
    for (int i = 0; i < 33; ++i) a.in[i] = (const float*)d_in[i];
    a.out = (float*)d_out; a.ws = (unsigned char*)d_ws;
#if MK_PER_PHASE
    for (int p = 0; p < NPHASES; ++p) { a.ph_lo = p; a.ph_hi = p + 1; hipLaunchKernelGGL(fwd_kernel, dim3(grid), dim3(512), LDS_BYTES, stream, a); }
#else
    a.ph_lo = 0; a.ph_hi = NPHASES;
    hipLaunchKernelGGL(fwd_kernel, dim3(grid), dim3(512), LDS_BYTES, stream, a);
#endif
    const hipError_t le = hipPeekAtLastError();
    if (le != hipSuccess) fprintf(stderr, "kernel_launch: launch failed: %s\n", hipGetErrorName(le));
}
```

```cpp
#include <hip/hip_runtime.h>
#include <cstdio>
#include <cstdint>

#ifndef MK_PER_PHASE
#define MK_PER_PHASE 0
#endif

constexpr int D = 1024, NBATCH = 4, SEQ = 8192, TL = NBATCH * SEQ, CTXL = 256, TC = NBATCH * CTXL, T = TL + TC;
constexpr int NH = 16, HS = 64, NE = 32, TOPK = 4, DEPTH = 4;
constexpr int NMT = T / 256;
constexpr int NMT_L = TL / 256;
constexpr int MAXTILES = (T * TOPK) / 256 + NE;
constexpr int NSTEP = CTXL + SEQ;

__device__ __forceinline__ int lane_id() { return (int)__builtin_amdgcn_mbcnt_hi(~0u, __builtin_amdgcn_mbcnt_lo(~0u, 0u)); }
namespace pg8 {
#define PG8_LAS __attribute__((address_space(3)))
typedef unsigned short bf16_t;
typedef short bf16x8 __attribute__((ext_vector_type(8)));
typedef float f32x4 __attribute__((ext_vector_type(4)));
typedef unsigned u32x4 __attribute__((ext_vector_type(4)));
typedef unsigned u32x2 __attribute__((ext_vector_type(2)));
constexpr int BM = 256, BK = 64, HALF = 128, HTB = HALF * BK * 2  , STAGE_BYTES = 8 * HTB, NXCD = 8, WGM = 8;

__host__ __device__ __forceinline__ int lds_byte(int r, int c) { const int st = (r >> 4) * 2 + (c >> 5), rr = r & 15, cc = c & 31, ob = rr * 64 + cc * 2; return st * 1024 + (ob ^ (((ob >> 9) & 1) << 5)); }
__host__ __device__ __forceinline__ void stage_rc(int b, int& R, int& C) { const int st = b / 1024, sb = b % 1024, swz = sb ^ (((sb >> 9) & 1) << 5); R = (st >> 1) * 16 + swz / 64; C = (st & 1) * 32 + (swz % 64) / 2; }
__host__ __device__ __forceinline__ int perm32(int rho) { const int n = rho >> 4, i = rho & 15; return 8 * (i >> 2) + 4 * n + (i & 3); }

struct Unit { int pm, pn, e, nv; };
struct Gemm { const bf16_t* A; const bf16_t* Bt; int M, N, K; };

__device__ __forceinline__ void tile_map(int wgid, int nM, int nN, int& pm, int& pn) {
    const int nwg = nM * nN;
    { const int q = nwg / NXCD, r = nwg % NXCD, xcd = wgid % NXCD, off = wgid / NXCD; wgid = (xcd < r ? xcd * (q + 1) : r * (q + 1) + (xcd - r) * q) + off; }
    const int nig = WGM * nN, gid = wgid / nig, fm = gid * WGM, gsz = (nM - fm) < WGM ? (nM - fm) : WGM;
    pm = fm + ((wgid % nig) % gsz); pn = (wgid % nig) / gsz;
}
typedef __bf16 bf16x2_t __attribute__((ext_vector_type(2)));
typedef float f32x2_t __attribute__((ext_vector_type(2)));
__device__ __forceinline__ unsigned cvt_pk_bf16(float lo, float hi) { const f32x2_t v = {lo, hi}; const bf16x2_t b = __builtin_convertvector(v, bf16x2_t); return __builtin_bit_cast(unsigned, b); }

template <class Epi, class Sched, bool ALIGN_EPI = false, bool SP2 = false, bool GATHER = false>
__device__ __forceinline__ void gemm_phase(PG8_LAS unsigned char* lds, const Gemm g, const Sched& S, const Epi& E, int tid_in) {
    int tid_ = tid_in; asm volatile("" : "+v"(tid_));
    const int tid = tid_, wid = __builtin_amdgcn_readfirstlane(tid >> 6), lane = tid & 63, wr = wid >> 2, wc = wid & 3, fr = lane & 15, fq = lane >> 4;
    int K_ = g.K; asm volatile("" : "+s"(K_));
    const int K = K_, nt = K / BK;
    unsigned voffA[2], voffB[2]; int gR[2]; unsigned gC[2];
#pragma unroll
    for (int i = 0; i < 2; ++i) { int R, C; stage_rc(tid * 16 + i * 8192, R, C); const int Rb = Epi::PERM ? ((R & ~31) + perm32(R & 31)) : R;
        voffA[i] = (unsigned)(R * K + C) * 2u; voffB[i] = (unsigned)(Rb * K + C) * 2u; gR[i] = R; gC[i] = (unsigned)C * 2u; }
    unsigned oc[2][2], on[2][2], o2[2][2];
#pragma unroll
    for (int h = 0; h < 2; ++h)
#pragma unroll
        for (int i = 0; i < 2; ++i) { oc[h][i] = 0u; on[h][i] = 0u; o2[h][i] = 0u; }
    const size_t kstep = (size_t)(BK * 2);
    const size_t hstep = (size_t)HALF * K * 2;
    const size_t tstep = 2 * hstep;
    const unsigned ldsw = (unsigned)wid * 1024u;
    const int aoff = lds_byte(wr * 64 + fr, fq * 8), boff = lds_byte(wc * 32 + fr, fq * 8);
#define PG8_SA(b, h) (((b) * 2 + (h)) * HTB)
#define PG8_SB(b, h) ((4 + (b) * 2 + (h)) * HTB)
#define PG8_STAGE(bufoff, gbase, voff) do { _Pragma("unroll") for (int _i = 0; _i < 2; ++_i) \
        __builtin_amdgcn_global_load_lds((const unsigned*)((const char*)(gbase) + (voff)[_i]), (PG8_LAS unsigned*)(lds + (bufoff) + ldsw + _i * 8192), 16, 0, 0); } while (0)
#define PG8_STAGE_A(bufoff, base, h, O) do { if constexpr (GATHER) { PG8_STAGE(bufoff, base, (O)[h]); } else { PG8_STAGE(bufoff, (base) + (h) * hstep, voffA); } } while (0)
#define PG8_LDA(dst, b, h) do { _Pragma("unroll") for (int m = 0; m < 4; ++m) _Pragma("unroll") for (int k = 0; k < 2; ++k) dst[m][k] = *(const PG8_LAS bf16x8*)(lds + PG8_SA(b, h) + aoff + m * 2048 + k * 1024); } while (0)
#define PG8_LDB(dst, b, h) do { _Pragma("unroll") for (int n = 0; n < 2; ++n) _Pragma("unroll") for (int k = 0; k < 2; ++k) dst[n][k] = *(const PG8_LAS bf16x8*)(lds + PG8_SB(b, h) + boff + n * 2048 + k * 1024); } while (0)
#define PG8_MMA(ai, bj, At, Bt) do { __builtin_amdgcn_s_setprio(1); _Pragma("unroll") for (int m = 0; m < 4; ++m) _Pragma("unroll") for (int n = 0; n < 2; ++n) _Pragma("unroll") for (int k = 0; k < 2; ++k) \
        acc[ai][bj][m][n] = __builtin_amdgcn_mfma_f32_16x16x32_bf16(Bt[n][k], At[m][k], acc[ai][bj][m][n], 0, 0, 0); __builtin_amdgcn_s_setprio(0); } while (0)
#define PG8_WAIT_V(n) asm volatile("s_waitcnt vmcnt(" #n ")" ::: "memory")
#define PG8_WAIT_L(n) asm volatile("s_waitcnt lgkmcnt(" #n ")" ::: "memory")
#define PG8_BAR __builtin_amdgcn_s_barrier()
#define PG8_SCHED __builtin_amdgcn_sched_barrier(0)
    Unit cur, nxt; int ui = 0;
    if (!S.next(0, cur)) return;
    f32x4 acc[2][2][4][2];
#pragma unroll
    for (int a = 0; a < 2; ++a)
#pragma unroll
        for (int b = 0; b < 2; ++b)
#pragma unroll
            for (int m = 0; m < 4; ++m)
#pragma unroll
                for (int n = 0; n < 2; ++n) acc[a][b][m][n] = (f32x4){0.f, 0.f, 0.f, 0.f};
    bf16x8 At[4][2], B0[2][2], B1[2][2];
    const char* cA = GATHER ? (const char*)g.A : (const char*)g.A + (size_t)cur.pm * tstep; const char* cB = (const char*)g.Bt + (size_t)cur.pn * tstep;
    S.a_ready(cur);
    if constexpr (GATHER) {
#pragma unroll
        for (int h = 0; h < 2; ++h)
#pragma unroll
            for (int i = 0; i < 2; ++i) oc[h][i] = S.row_off(cur, h * HALF + gR[i]) + gC[i];
    }
    if constexpr (SP2) {
        PG8_STAGE(PG8_SB(0, 0), cB, voffB); PG8_STAGE(PG8_SB(0, 1), cB + hstep, voffB); PG8_STAGE_A(PG8_SA(0, 0), cA, 0, oc); PG8_STAGE_A(PG8_SA(0, 1), cA, 1, oc);
        if (wr == 1) PG8_BAR;
        PG8_WAIT_V(2); PG8_BAR;
        PG8_STAGE(PG8_SB(1, 0), cB + kstep, voffB); PG8_STAGE_A(PG8_SA(1, 0), cA + kstep, 0, oc); PG8_STAGE(PG8_SB(1, 1), cB + hstep + kstep, voffB);
        PG8_WAIT_V(6); PG8_BAR;
    } else {
        PG8_STAGE(PG8_SB(0, 0), cB, voffB); PG8_STAGE_A(PG8_SA(0, 0), cA, 0, oc); PG8_STAGE(PG8_SB(0, 1), cB + hstep, voffB); PG8_STAGE_A(PG8_SA(0, 1), cA, 1, oc);
        if (wr == 1) PG8_BAR;
        PG8_WAIT_V(4); PG8_BAR;
        PG8_STAGE(PG8_SB(1, 0), cB + kstep, voffB); PG8_STAGE_A(PG8_SA(1, 0), cA + kstep, 0, oc); PG8_STAGE(PG8_SB(1, 1), cB + hstep + kstep, voffB);
        PG8_WAIT_V(6); PG8_BAR;
    }
    for (;;) {
        const bool has_next = S.next(ui + 1, nxt);
        const char* nA = GATHER ? (const char*)g.A : (has_next ? (const char*)g.A + (size_t)nxt.pm * tstep : cA); const char* nB = has_next ? (const char*)g.Bt + (size_t)nxt.pn * tstep : cB;
        if constexpr (GATHER) {
#pragma unroll
            for (int h = 0; h < 2; ++h)
#pragma unroll
                for (int i = 0; i < 2; ++i) on[h][i] = has_next ? (S.row_off(nxt, h * HALF + gR[i]) + gC[i]) : oc[h][i];
        }
        for (int t = 0; t < nt; t += 2) {
            const bool last = (t == nt - 2);
            const char* a1 = cA + (size_t)(t + 1) * kstep;
            const char* a2 = last ? nA : cA + (size_t)(t + 2) * kstep; const char* b2 = last ? nB : cB + (size_t)(t + 2) * kstep;
            const char* a3 = a2 + kstep; const char* b3 = b2 + kstep;
            if constexpr (GATHER) {
#pragma unroll
                for (int h = 0; h < 2; ++h)
#pragma unroll
                    for (int i = 0; i < 2; ++i) o2[h][i] = last ? on[h][i] : oc[h][i];
            }
            if (last && has_next) S.a_ready(nxt);
            if constexpr (SP2) {
            PG8_LDB(B0, 0, 0); PG8_LDB(B1, 0, 1); PG8_SCHED; PG8_LDA(At, 0, 0); PG8_STAGE_A(PG8_SA(1, 1), a1, 1, oc);
            PG8_WAIT_V(8); PG8_WAIT_L(0); PG8_BAR; PG8_MMA(0, 0, At, B0); PG8_MMA(0, 1, At, B1); PG8_BAR; PG8_SCHED;
            PG8_LDA(At, 0, 1); PG8_STAGE(PG8_SB(0, 0), b2, voffB); PG8_STAGE(PG8_SB(0, 1), b2 + hstep, voffB); PG8_STAGE_A(PG8_SA(0, 0), a2, 0, o2);
            PG8_WAIT_V(8); PG8_WAIT_L(0); PG8_BAR; PG8_MMA(1, 0, At, B0); PG8_MMA(1, 1, At, B1); PG8_BAR; PG8_SCHED;
            PG8_LDB(B0, 1, 0); PG8_LDB(B1, 1, 1); PG8_SCHED; PG8_LDA(At, 1, 0); PG8_STAGE_A(PG8_SA(0, 1), a2, 1, o2);
            PG8_WAIT_V(8); PG8_WAIT_L(0); PG8_BAR; PG8_MMA(0, 0, At, B0); PG8_MMA(0, 1, At, B1); PG8_BAR; PG8_SCHED;
            PG8_LDA(At, 1, 1); PG8_STAGE(PG8_SB(1, 0), b3, voffB); PG8_STAGE(PG8_SB(1, 1), b3 + hstep, voffB); PG8_STAGE_A(PG8_SA(1, 0), a3, 0, o2);
            PG8_WAIT_V(8); PG8_WAIT_L(0); PG8_BAR; PG8_MMA(1, 0, At, B0); PG8_MMA(1, 1, At, B1); PG8_BAR; PG8_SCHED;
            } else {
            PG8_LDB(B0, 0, 0); PG8_SCHED; PG8_LDA(At, 0, 0); PG8_STAGE_A(PG8_SA(1, 1), a1, 1, oc);
            PG8_WAIT_L(8); PG8_BAR; PG8_WAIT_L(0); PG8_MMA(0, 0, At, B0); PG8_BAR; PG8_SCHED;
            PG8_LDB(B1, 0, 1); PG8_STAGE(PG8_SB(0, 0), b2, voffB);
            PG8_BAR; PG8_WAIT_L(0); PG8_MMA(0, 1, At, B1); PG8_BAR;
            PG8_LDA(At, 0, 1); PG8_STAGE_A(PG8_SA(0, 0), a2, 0, o2);
            PG8_BAR; PG8_WAIT_L(0); PG8_MMA(1, 0, At, B0); PG8_BAR; PG8_SCHED;
            PG8_STAGE(PG8_SB(0, 1), b2 + hstep, voffB);
            PG8_WAIT_V(6); PG8_BAR; PG8_MMA(1, 1, At, B1); PG8_BAR;
            PG8_LDB(B0, 1, 0); PG8_SCHED; PG8_LDA(At, 1, 0); PG8_STAGE_A(PG8_SA(0, 1), a2, 1, o2);
            PG8_WAIT_L(8); PG8_BAR; PG8_WAIT_L(0); PG8_MMA(0, 0, At, B0); PG8_BAR; PG8_SCHED;
            PG8_LDB(B1, 1, 1); PG8_STAGE(PG8_SB(1, 0), b3, voffB);
            PG8_BAR; PG8_WAIT_L(0); PG8_MMA(0, 1, At, B1); PG8_BAR;
            PG8_LDA(At, 1, 1); PG8_STAGE_A(PG8_SA(1, 0), a3, 0, o2);
            PG8_BAR; PG8_WAIT_L(0); PG8_MMA(1, 0, At, B0); PG8_BAR; PG8_SCHED;
            PG8_STAGE(PG8_SB(1, 1), b3 + hstep, voffB);
            PG8_WAIT_V(6); PG8_BAR; PG8_MMA(1, 1, At, B1); PG8_BAR;
            }
        }
        if constexpr (ALIGN_EPI) { if (wr == 0) PG8_BAR; }
        if constexpr (!Epi::AFTER_DRAIN) { E(acc, cur, wr, wc, fr, fq); S.done(cur); }
        if (!has_next) break;
#pragma unroll
        for (int a = 0; a < 2; ++a)
#pragma unroll
            for (int b = 0; b < 2; ++b)
#pragma unroll
                for (int m = 0; m < 4; ++m)
#pragma unroll
                    for (int n = 0; n < 2; ++n) acc[a][b][m][n] = (f32x4){0.f, 0.f, 0.f, 0.f};
        cur = nxt; cA = nA; cB = nB; ++ui;
        if constexpr (GATHER) {
#pragma unroll
            for (int h = 0; h < 2; ++h)
#pragma unroll
                for (int i = 0; i < 2; ++i) oc[h][i] = on[h][i];
        }
        if constexpr (ALIGN_EPI) { if (wr == 1) PG8_BAR; }
    }
    PG8_WAIT_V(0);
    if constexpr (!ALIGN_EPI) { if (wr == 0) PG8_BAR; }
    PG8_BAR;
    if constexpr (Epi::AFTER_DRAIN) { E.fused(acc, cur, wr, wc, fr, fq, lds, wid, lane); S.done(cur); }
#undef PG8_SA
#undef PG8_SB
#undef PG8_STAGE
#undef PG8_STAGE_A
#undef PG8_LDA
#undef PG8_LDB
#undef PG8_MMA
#undef PG8_WAIT_V
#undef PG8_WAIT_L
#undef PG8_BAR
#undef PG8_SCHED
}
}

#define LAS __attribute__((address_space(3)))
typedef unsigned short bf16;
typedef float f32x4 __attribute__((ext_vector_type(4)));
typedef unsigned u32x2 __attribute__((ext_vector_type(2)));
typedef unsigned u32x4 __attribute__((ext_vector_type(4)));
#define LDS_WAIT() asm volatile("s_waitcnt lgkmcnt(0)" ::: "memory")
__device__ __forceinline__ unsigned pk2(float lo, float hi) { return pg8::cvt_pk_bf16(lo, hi); }
__device__ __forceinline__ unsigned f2bf(float f) { return pk2(f, f) & 0xffffu; }
__device__ __forceinline__ float bflo(unsigned w) { return __builtin_bit_cast(float, w << 16); }
__device__ __forceinline__ float bfhi(unsigned w) { return __builtin_bit_cast(float, w & 0xffff0000u); }
__device__ __forceinline__ float wave_sum(float v) {
#pragma unroll
    for (int o = 1; o < 64; o <<= 1) v += __shfl_xor(v, o);
    return v;
}
__device__ __forceinline__ float sigm(float x) { return 1.0f / (1.0f + __expf(-x)); }
__device__ __forceinline__ float tanh_fast(float x) { const float e = __expf(2.0f * x); return 1.0f - 2.0f / (e + 1.0f); }

constexpr size_t MiB = 1u << 20;
constexpr size_t RF = (size_t)T * D * 4;
constexpr size_t RB = (size_t)T * D * 2;
constexpr size_t WS_CTL = 0, CTL_ZERO_BYTES = 1 * MiB;
constexpr size_t WS_MODS = 1 * MiB;
constexpr size_t WS_XSA = 2 * MiB, WS_XSB = WS_XSA + RF;
constexpr size_t WS_XL = WS_XSB + RF;
constexpr size_t WS_RKV = WS_XL + 6 * RB;
constexpr size_t WS_L1 = WS_RKV + 3 * RF;
constexpr size_t WS_WDEC = WS_L1 + 50 * MiB;
constexpr size_t WS_AA = WS_WDEC + 2 * RF;
constexpr size_t WS_G = WS_AA + 2 * RF;
constexpr size_t WS_KK = WS_G + RB;
constexpr size_t WS_KD = WS_KK + RF;
constexpr size_t WS_BETA = WS_KD + 2 * RF;
constexpr size_t WS_RKB = WS_BETA + 2 * RF;
constexpr size_t WS_C12 = WS_RKB + 3 * MiB;
constexpr size_t WS_Y = WS_C12 + 9 * MiB;
constexpr size_t WS_Z = WS_Y + 2 * RF;
constexpr size_t WS_H2 = WS_Z + RB;
constexpr size_t WS_SLOTL = WS_H2 + RB;
constexpr size_t WS_GATEL = WS_SLOTL + 5 * MiB;
constexpr size_t WS_WRKV = WS_GATEL + 5 * MiB;
constexpr size_t WS_L2T = WS_WRKV + 15 * MiB;
constexpr size_t WS_WO = WS_L2T + 5 * MiB;
constexpr size_t WS_WIN = WS_WO + 4 * MiB;
constexpr size_t WS_WOUT = WS_WIN + 12 * MiB;
constexpr size_t WS_WGU = WS_WOUT + 4 * MiB;
constexpr size_t WS_WDN = WS_WGU + 512 * MiB;
constexpr size_t WS_END = WS_WDN + 256 * MiB;
constexpr size_t WS_INTER = WS_WDEC;
constexpr size_t WS_YS = WS_KD;
constexpr size_t WS_BG = WS_RKV, WS_CUZ = WS_RKV + RB;
constexpr size_t WS_RAWW = WS_AA, WS_RAWA = WS_AA + RF;
constexpr size_t WS_RH = WS_AA;
constexpr size_t WS_PM = WS_AA + RF;
constexpr size_t WS_QT = WS_XL;
constexpr size_t WS_HT = WS_XL + RF;
static_assert((size_t)128 * 132 * 4096 * 2 <= RF, "chunk state tensors");
static_assert((size_t)MAXTILES * 256 * 1024 * 2 <= 4 * RF, "INTER overlay");
static_assert((size_t)T * 4 * 1024 * 2 <= 2 * RF, "YS overlay");
static_assert((size_t)3 * T * 256 * 2 <= 50 * MiB, "L1OUT");
constexpr int CW_BAR = 4096;
constexpr int CW_CNT = 16384, CNT_STRIDE = 64;

constexpr int RING_BYTES = 131072;
constexpr int LDSCTL_OFF = RING_BYTES;
constexpr int LDS_BYTES = 147456;

struct Args { const float* in[33]; float* out; unsigned char* ws; int ph_lo, ph_hi; };

__device__ __forceinline__ void transpose_item(const float* W, int N, bf16* WT, int dstK, int drow0, int k0, int n0, LAS float* scr, int lane) {
    float tv[32];
#pragma unroll
    for (int i = 0; i < 32; ++i) { const int kk = 2 * i + (lane >> 5); tv[i] = W[(size_t)(k0 + kk) * N + n0 + (lane & 31)]; }
#pragma unroll
    for (int i = 0; i < 32; ++i) { const int kk = 2 * i + (lane >> 5); scr[kk * 33 + (lane & 31)] = tv[i]; }
    LDS_WAIT(); asm volatile("" ::: "memory");
    const int c = lane & 7;
#pragma unroll
    for (int j = 0; j < 4; ++j) { const int n = (lane >> 3) + 8 * j; const LAS float* s = scr + (8 * c) * 33 + n;
        u32x4 o; o.x = pk2(s[0 * 33], s[1 * 33]); o.y = pk2(s[2 * 33], s[3 * 33]); o.z = pk2(s[4 * 33], s[5 * 33]); o.w = pk2(s[6 * 33], s[7 * 33]);
        *(u32x4*)(WT + (size_t)(drow0 + n) * dstK + k0 + 8 * c) = o; }
    LDS_WAIT(); asm volatile("" ::: "memory");
}
__device__ __forceinline__ int gu_map(int n0) { const int bj = n0 >= 1024 ? 1 : 0, f0 = n0 - bj * 1024; return (f0 >> 7) * 256 + bj * 128 + (f0 & 127); }
__device__ __forceinline__ int conv_map(int n0) { if (n0 < 1024) return n0; const int q = (n0 - 1024) >> 10, f0 = (n0 - 1024) & 1023; return 1024 + (f0 >> 7) * 256 + q * 128 + (f0 & 127); }

__device__ __forceinline__ void p0_prologue(const Args& a, LAS unsigned char* lds, int tid, int lane, int wave, int G) {
    unsigned char* ws = a.ws;
    LAS float* sl = (LAS float*)lds;
    LAS float* red = (LAS float*)(lds + 20480);
    for (int i = tid; i < 5 * 1024; i += 512) { const int r = i >> 10, k = i & 1023; const float cv = r < 4 ? a.in[1][r * 1024 + k] : a.in[3][k]; sl[i] = cv / (1.0f + __expf(-cv)); }
    __syncthreads();
    float* MODS = (float*)(ws + WS_MODS);
    for (int it = blockIdx.x; it < 4 * 96; it += G) {
        const int l = it / 96, n = (it % 96) * 64 + lane;
        const float* W = a.in[4] + (size_t)l * 1024 * 6144 + n;
        float acc[5] = {0.f, 0.f, 0.f, 0.f, 0.f};
        const int kb = wave * 128;
#pragma unroll 8
        for (int k = 0; k < 128; ++k) { const float wv = W[(size_t)(kb + k) * 6144];
#pragma unroll
            for (int r = 0; r < 5; ++r) acc[r] += sl[r * 1024 + kb + k] * wv; }
#pragma unroll
        for (int r = 0; r < 5; ++r) red[(wave * 5 + r) * 64 + lane] = acc[r];
        __syncthreads();
        if (wave < 5) { float s = a.in[5][l * 6144 + n];
#pragma unroll
            for (int w = 0; w < 8; ++w) s += red[(w * 5 + wave) * 64 + lane];
            MODS[(size_t)(l * 5 + wave) * 6144 + n] = s; }
        __syncthreads();
    }
    LAS float* scr = (LAS float*)(lds + 32768 + wave * 8448);
    const int gw = blockIdx.x * 8 + wave, NGW = G * 8;
    bf16* WRKV = (bf16*)(ws + WS_WRKV); bf16* WOt = (bf16*)(ws + WS_WO); bf16* WINt = (bf16*)(ws + WS_WIN); bf16* WOUTt = (bf16*)(ws + WS_WOUT);
    bf16* WGU = (bf16*)(ws + WS_WGU); bf16* WDN = (bf16*)(ws + WS_WDN);
    constexpr int I_GU = 128 * 1024, I_DN = 128 * 512, I_RKV = 6 * 512, I_WO = 2 * 512, I_WIN = 2 * 1536, I_WOUT = 2 * 512, I_W1 = 4 * 32, I_A1 = 4 * 32, I_G1 = 2 * 64;
    constexpr int NITEMS = I_GU + I_DN + I_RKV + I_WO + I_WIN + I_WOUT + I_W1 + I_A1 + I_G1;
    for (int it = gw; it < NITEMS; it += NGW) {
        int r = it;
        if (r < I_GU) { const int m = r >> 10, q = r & 1023, kb = q >> 6, nb = q & 63;
            transpose_item(a.in[29] + (size_t)m * 1024 * 2048, 2048, WGU + (size_t)m * 2048 * 1024, 1024, gu_map(nb * 32), kb * 64, nb * 32, scr, lane); continue; } r -= I_GU;
        if (r < I_DN) { const int m = r >> 9, q = r & 511, kb = q >> 5, nb = q & 31;
            transpose_item(a.in[31] + (size_t)m * 1024 * 1024, 1024, WDN + (size_t)m * 1024 * 1024, 1024, nb * 32, kb * 64, nb * 32, scr, lane); continue; } r -= I_DN;
        if (r < I_RKV) { const int m = r >> 9, q = r & 511, kb = q >> 5, nb = q & 31, lr = m / 3, j = m % 3;
            transpose_item(a.in[9] + (size_t)m * 1024 * 1024, 1024, WRKV + (size_t)lr * 3840 * 1024, 1024, j * 1024 + nb * 32, kb * 64, nb * 32, scr, lane); continue; } r -= I_RKV;
        if (r < I_WO) { const int m = r >> 9, q = r & 511, kb = q >> 5, nb = q & 31;
            transpose_item(a.in[23] + (size_t)m * 1024 * 1024, 1024, WOt + (size_t)m * 1024 * 1024, 1024, nb * 32, kb * 64, nb * 32, scr, lane); continue; } r -= I_WO;
        if (r < I_WIN) { const int m = r / 1536, q = r % 1536, kb = q / 96, nb = q % 96;
            transpose_item(a.in[24] + (size_t)m * 1024 * 3072, 3072, WINt + (size_t)m * 3072 * 1024, 1024, conv_map(nb * 32), kb * 64, nb * 32, scr, lane); continue; } r -= I_WIN;
        if (r < I_WOUT) { const int m = r >> 9, q = r & 511, kb = q >> 5, nb = q & 31;
            transpose_item(a.in[26] + (size_t)m * 1024 * 1024, 1024, WOUTt + (size_t)m * 1024 * 1024, 1024, nb * 32, kb * 64, nb * 32, scr, lane); continue; } r -= I_WOUT;
        if (r < I_W1) { const int m = r >> 5, q = r & 31, kb = q >> 1, nb = q & 1, lr = m >> 1, e = m & 1;
            transpose_item(a.in[11] + (size_t)m * 1024 * 64, 64, WRKV + (size_t)lr * 3840 * 1024, 1024, 3072 + e * 64 + nb * 32, kb * 64, nb * 32, scr, lane); continue; } r -= I_W1;
        if (r < I_A1) { const int m = r >> 5, q = r & 31, kb = q >> 1, nb = q & 1, lr = m >> 1, e = m & 1;
            transpose_item(a.in[14] + (size_t)m * 1024 * 64, 64, WRKV + (size_t)lr * 3840 * 1024, 1024, 3328 + e * 64 + nb * 32, kb * 64, nb * 32, scr, lane); continue; } r -= I_A1;
        { const int m = r >> 6, q = r & 63, kb = q >> 2, nb = q & 3;
            transpose_item(a.in[16] + (size_t)m * 1024 * 128, 128, WRKV + (size_t)m * 3840 * 1024, 1024, 3584 + nb * 32, kb * 64, nb * 32, scr, lane); }
    }
    const int gt = blockIdx.x * 512 + tid, NGT = G * 512;
    for (int i = gt; i < 2 * 3 * 128 * 128; i += NGT) {
        const int pc = i & 127, rw = (i >> 7) & 127, pd = (i >> 14) % 3, lr = i / (3 * 16384);
        *(u32x4*)(WRKV + ((size_t)lr * 3840 + 3072 + pd * 256 + 128 + rw) * 1024 + pc * 8) = (u32x4){0u, 0u, 0u, 0u}; }
    bf16* L2T = (bf16*)(ws + WS_L2T);
    for (int i = gt; i < 2 * 256 * 5120; i += NGT) {
        const int n = i % 5120, k = (i / 5120) & 255, lr = i / (5120 * 256);
        float v = 0.f;
        if (n < 2048) { const int e = n >> 10, d = n & 1023; if ((k >> 6) == e) v = a.in[12][(((size_t)lr * 2 + e) * 64 + (k & 63)) * 1024 + d]; }
        else if (n < 4096) { const int e = (n - 2048) >> 10, d = n & 1023; if ((k >> 6) == e) v = a.in[15][(((size_t)lr * 2 + e) * 64 + (k & 63)) * 1024 + d]; }
        else { const int d = n - 4096; if (k < 128) v = a.in[17][((size_t)lr * 128 + k) * 1024 + d]; }
        L2T[((size_t)lr * 5120 + n) * 256 + k] = (bf16)f2bf(v);
    }
}
#define XB_TMO      128
#define XB_XCNT(j)  (256  + 64 * (j))
#define XB_XSUB(j)  (1280 + 64 * (j))
#define XB_XGEN(j)  (2304 + 64 * (j))
#define XB_TOP      3328
#define XB_TOPGEN   3392
#define XCD_BAR_WORDS 3456
#define XB_SPIN_CAP (1u << 23)

__device__ __forceinline__ unsigned xb_ld(unsigned* p)              { return __hip_atomic_load(p, __ATOMIC_RELAXED, __HIP_MEMORY_SCOPE_AGENT); }
__device__ __forceinline__ unsigned xb_add(unsigned* p, unsigned v) { return __hip_atomic_fetch_add(p, v, __ATOMIC_RELAXED, __HIP_MEMORY_SCOPE_AGENT); }
__device__ __forceinline__ unsigned xb_xcc_id() { return (unsigned)__builtin_amdgcn_s_getreg((3 << 11) | 20) & 0xFu; }
#define XB_SPIN(cond, bar) do { unsigned _sp = 0; while (cond) { __builtin_amdgcn_s_sleep(1); \
    if ((++_sp & 255u) == 0u) { if (xb_ld(&(bar)[XB_TMO])) break; if (_sp > XB_SPIN_CAP) { atomicAdd(&(bar)[XB_TMO], 1u); break; } } } } while (0)

struct XcdBarrier {
    unsigned wv;
    unsigned* bar; unsigned x;
    volatile LAS unsigned* st;
};

__device__ __forceinline__ XcdBarrier xcd_barrier_post(unsigned* bar, volatile LAS unsigned* st) {
    XcdBarrier b; b.wv = (unsigned)__builtin_amdgcn_readfirstlane((int)(threadIdx.x >> 6)); b.bar = bar; b.x = xb_xcc_id(); b.st = st;
    if (threadIdx.x == 0) (void)xb_add(&bar[XB_XCNT(b.x)], 1u);
    return b;
}
__device__ __forceinline__ void xcd_barrier_complete(unsigned* bar, unsigned x, unsigned& nloc, unsigned& nx) {
    const unsigned G = gridDim.x * gridDim.y * gridDim.z;
    unsigned sum, cnt, mine, sp = 0u;
    for (;;) {
        sum = 0u; cnt = 0u; mine = 0u;
#pragma unroll
        for (unsigned j = 0; j < 16; ++j) { const unsigned c = xb_ld(&bar[XB_XCNT(j)]); sum += c; cnt += (c > 0u) ? 1u : 0u; mine = (j == x) ? c : mine; }
        if (sum == G) break;
        __builtin_amdgcn_s_sleep(1);
        if ((++sp & 255u) == 0u) { if (xb_ld(&bar[XB_TMO])) break; if (sp > XB_SPIN_CAP) { atomicAdd(&bar[XB_TMO], 1u); break; } }
    }
    nloc = mine > 0u ? mine : 1u; nx = cnt > 0u ? cnt : 1u;
}

__device__ __forceinline__ void xcd_barrier(const XcdBarrier& b) {
    asm volatile("s_waitcnt vmcnt(0)" ::: "memory");
    __syncthreads();
    if (b.wv == 0u && lane_id() == 0) {
        unsigned* bar = b.bar;
        __builtin_amdgcn_s_waitcnt(0);
        unsigned nloc = b.st[0], nx = b.st[1];
        if (nloc == 0u) { xcd_barrier_complete(bar, b.x, nloc, nx); b.st[0] = nloc; b.st[1] = nx; }
        const unsigned old = xb_add(&bar[XB_XSUB(b.x)], 1u);
        const unsigned gen = old / nloc;
        if (old + 1u == (gen + 1u) * nloc) {
            __builtin_amdgcn_fence(__ATOMIC_RELEASE, "agent");
            asm volatile("s_waitcnt vmcnt(0)" ::: "memory");
            const unsigned og = xb_add(&bar[XB_TOP], 1u);
            const unsigned tg = og / nx;
            if (og + 1u == (tg + 1u) * nx) xb_add(&bar[XB_TOPGEN], 1u);
            else XB_SPIN(xb_ld(&bar[XB_TOPGEN]) == tg, bar);
            __builtin_amdgcn_fence(__ATOMIC_ACQUIRE, "agent");
            xb_add(&bar[XB_XGEN(b.x)], 1u);
            asm volatile("s_waitcnt vmcnt(0)" ::: "memory");
        } else {
            XB_SPIN(xb_ld(&bar[XB_XGEN(b.x)]) == gen, bar);
            __builtin_amdgcn_fence(__ATOMIC_ACQUIRE, "agent");
            asm volatile("s_waitcnt vmcnt(0)" ::: "memory");
        }
    }
    __syncthreads();
}

__device__ __forceinline__ int mod_row(int row) { return row < TL ? (row >> 13) : 4; }

__device__ __forceinline__ void load_x_combined(f32x4 (&x)[4], const float* xrow, bool has_prev, const bf16* YS, int t, const f32x4 (&m5)[4], int lane) {
#pragma unroll
    for (int j = 0; j < 4; ++j) x[j] = *(const f32x4*)(xrow + 256 * j + 4 * lane);
    if (has_prev) {
        f32x4 s[4];
#pragma unroll
        for (int j = 0; j < 4; ++j) s[j] = (f32x4){0.f, 0.f, 0.f, 0.f};
#pragma unroll
        for (int k = 0; k < 4; ++k) { const bf16* yr = YS + ((size_t)t * 4 + k) * 1024;
#pragma unroll
            for (int j = 0; j < 4; ++j) { const u32x2 w = *(const u32x2*)(yr + 256 * j + 4 * lane); s[j] += (f32x4){bflo(w.x), bfhi(w.x), bflo(w.y), bfhi(w.y)}; } }
#pragma unroll
        for (int j = 0; j < 4; ++j) x[j] += m5[j] * s[j];
    }
}
__device__ __forceinline__ float row_rstd(const f32x4 (&x)[4]) {
    float ss = 0.f;
#pragma unroll
    for (int j = 0; j < 4; ++j) ss += (x[j].x * x[j].x + x[j].y * x[j].y) + (x[j].z * x[j].z + x[j].w * x[j].w);
    return rsqrtf(wave_sum(ss) * (1.0f / 1024.0f) + 1e-6f);
}

__device__ __forceinline__ void phase_a_rwkv(const Args& a, int layer, LAS unsigned char* lds, int tid, int gw, int NGW, int lane) {
    unsigned char* ws = a.ws; const int lj = layer >> 1; const bool has_prev = layer > 0;
    const float* xin_lat = layer == 0 ? a.in[0] : (const float*)(ws + WS_XSA);
    const float* xin_ctx = layer == 0 ? a.in[2] : (const float*)(ws + WS_XSA) + (size_t)TL * D;
    float* xout = (float*)(ws + (layer == 0 ? WS_XSA : WS_XSB));
    const float* MODS = (const float*)(ws + WS_MODS); const bf16* YS = (const bf16*)(ws + WS_YS); bf16* XL = (bf16*)(ws + WS_XL);
    const float* mug = a.in[8] + (size_t)lj * 6 * 2 * 1024; const float* ng = a.in[6] + (size_t)(layer * 2 + 0) * 1024;
    LAS float* mu = (LAS float*)lds;
    for (int i = tid; i < 6 * 2 * 1024 / 4; i += 512) ((LAS f32x4*)mu)[i] = ((const f32x4*)mug)[i];
    __syncthreads();
    for (int it = gw; it < TL / 8 + TC / 2; it += NGW) {
        const int ntok = it < TL / 8 ? 8 : 2, t0 = it < TL / 8 ? it * 8 : TL + (it - TL / 8) * 2, mr = mod_row(t0);
        int rs, re; if (t0 < TL) { rs = t0 & ~63; re = rs + 63; } else { const int loc = t0 - TL; rs = TL + (loc & ~255); re = rs + 255; }
        const float* mod = MODS + (size_t)(layer * 5 + mr) * 6144;
        const float* m5p = MODS + (size_t)((has_prev ? layer - 1 : 0) * 5 + mr) * 6144 + 5 * 1024;
        f32x4 hm[4], h0[4], hp[4];
#pragma unroll
        for (int j = 0; j < 4; ++j) { hm[j] = (f32x4){0.f, 0.f, 0.f, 0.f}; h0[j] = hm[j]; hp[j] = hm[j]; }
        f32x4 rx[4], nx[4]; u32x2 ry[4][4], ny[4][4];
#define PA_LOAD(X, Y, tt) do { const int t_ = (tt); if (t_ >= rs && t_ <= re) { \
            const float* xrow_ = t_ < TL ? xin_lat + (size_t)t_ * D : xin_ctx + (size_t)(t_ - TL) * D; \
            _Pragma("unroll") for (int j = 0; j < 4; ++j) X[j] = *(const f32x4*)(xrow_ + 256 * j + 4 * lane); \
            if (has_prev) { _Pragma("unroll") for (int k = 0; k < 4; ++k) _Pragma("unroll") for (int j = 0; j < 4; ++j) Y[k][j] = *(const u32x2*)(YS + ((size_t)t_ * 4 + k) * 1024 + 256 * j + 4 * lane); } } } while (0)
#pragma unroll
        for (int j = 0; j < 4; ++j) { rx[j] = (f32x4){0.f, 0.f, 0.f, 0.f}; nx[j] = rx[j];
#pragma unroll
            for (int k = 0; k < 4; ++k) { ry[k][j] = (u32x2){0u, 0u}; ny[k][j] = ry[k][j]; } }
        PA_LOAD(rx, ry, t0 - 1);
#pragma unroll 1
        for (int i = -1; i <= ntok; ++i) {
            const int t = t0 + i;
            if (i < ntok) PA_LOAD(nx, ny, t + 1);
            f32x4 hn[4];
            if (t >= rs && t <= re) {
                f32x4 x[4];
#pragma unroll
                for (int j = 0; j < 4; ++j) x[j] = rx[j];
                if (has_prev) {
#pragma unroll
                    for (int j = 0; j < 4; ++j) { f32x4 sm = (f32x4){0.f, 0.f, 0.f, 0.f};
#pragma unroll
                        for (int k = 0; k < 4; ++k) sm += (f32x4){bflo(ry[k][j].x), bfhi(ry[k][j].x), bflo(ry[k][j].y), bfhi(ry[k][j].y)};
                        x[j] += *(const f32x4*)(m5p + 256 * j + 4 * lane) * sm; } }
                if (i >= 0 && i < ntok) {
#pragma unroll
                    for (int j = 0; j < 4; ++j) *(f32x4*)(xout + (size_t)t * D + 256 * j + 4 * lane) = x[j]; }
                const float rstd = row_rstd(x);
#pragma unroll
                for (int j = 0; j < 4; ++j) { const int col = 256 * j + 4 * lane; hn[j] = x[j] * rstd * *(const f32x4*)(ng + col) * (*(const f32x4*)(mod + 1024 + col) + 1.0f) + *(const f32x4*)(mod + col); }
            } else {
#pragma unroll
                for (int j = 0; j < 4; ++j) hn[j] = (f32x4){0.f, 0.f, 0.f, 0.f};
            }
#pragma unroll
            for (int j = 0; j < 4; ++j) { hm[j] = h0[j]; h0[j] = hp[j]; hp[j] = hn[j]; rx[j] = nx[j];
#pragma unroll
                for (int k = 0; k < 4; ++k) ry[k][j] = ny[k][j]; }
            if (i >= 1) {
                const int te = t - 1;
#pragma unroll
                for (int q = 0; q < 6; ++q) {
                    bf16* orow = XL + ((size_t)q * T + te) * D;
#pragma unroll
                    for (int j = 0; j < 4; ++j) { const int col = 256 * j + 4 * lane;
                        const f32x4 m0 = *(const LAS f32x4*)(mu + (q * 2 + 0) * 1024 + col), m1 = *(const LAS f32x4*)(mu + (q * 2 + 1) * 1024 + col);
                        const f32x4 o = h0[j] + m0 * (hm[j] - h0[j]) + m1 * (hp[j] - h0[j]);
                        u32x2 w; w.x = pk2(o.x, o.y); w.y = pk2(o.z, o.w); *(u32x2*)(orow + col) = w; }
                }
            }
        }
#undef PA_LOAD
    }
}
__device__ __forceinline__ void phase_a_conv(const Args& a, int layer, int rows, int gw, int NGW, int lane) {
    unsigned char* ws = a.ws;
    float* xs = (float*)(ws + (layer < 2 ? WS_XSA : WS_XSB));
    const float* MODS = (const float*)(ws + WS_MODS); const bf16* YS = (const bf16*)(ws + WS_YS); bf16* H = (bf16*)(ws + WS_XL);
    const float* ng = a.in[6] + (size_t)(layer * 2 + 0) * 1024;
    for (int t = gw; t < rows; t += NGW) {
        const int mr = mod_row(t);
        const float* mod = MODS + (size_t)(layer * 5 + mr) * 6144;
        f32x4 m5[4], x[4];
#pragma unroll
        for (int j = 0; j < 4; ++j) m5[j] = *(const f32x4*)(MODS + (size_t)((layer - 1) * 5 + mr) * 6144 + 5 * 1024 + 256 * j + 4 * lane);
        load_x_combined(x, xs + (size_t)t * D, true, YS, t, m5, lane);
        const float rstd = row_rstd(x);
#pragma unroll
        for (int j = 0; j < 4; ++j) { const int col = 256 * j + 4 * lane;
            *(f32x4*)(xs + (size_t)t * D + col) = x[j];
            const f32x4 h = x[j] * rstd * *(const f32x4*)(ng + col) * (*(const f32x4*)(mod + 1024 + col) + 1.0f) + *(const f32x4*)(mod + col);
            u32x2 w; w.x = pk2(h.x, h.y); w.y = pk2(h.z, h.w); *(u32x2*)(H + (size_t)t * D + col) = w; }
    }
}
#define DPPF(x, ctrl) __builtin_bit_cast(float, __builtin_amdgcn_update_dpp(0, __builtin_bit_cast(int, (x)), (ctrl), 0xf, 0xf, false))
__device__ __forceinline__ float row16_sum(float v) { v += DPPF(v, 0xB1); v += DPPF(v, 0x4E); v += DPPF(v, 0x141); v += DPPF(v, 0x140); return v; }
__device__ __forceinline__ f32x4 bf4(u32x2 w) { return (f32x4){bflo(w.x), bfhi(w.x), bflo(w.y), bfhi(w.y)}; }
__device__ __forceinline__ u32x2 pk4(f32x4 v) { u32x2 w; w.x = pk2(v[0], v[1]); w.y = pk2(v[2], v[3]); return w; }
__device__ __forceinline__ void phase_c_prep(const Args& a, int lj, LAS unsigned char* lds, int tid, int gw, int NGW, int lane) {
    unsigned char* ws = a.ws;
    const bf16* Rr = (const bf16*)(ws + WS_RKV); const bf16* Kk = Rr + (size_t)T * D; const bf16* RA = (const bf16*)(ws + WS_RAWA); const bf16* RW = (const bf16*)(ws + WS_RAWW);
    float* LW = (float*)(ws + WS_WDEC); bf16* KK = (bf16*)(ws + WS_KK); bf16* KD = (bf16*)(ws + WS_KD); bf16* BE = (bf16*)(ws + WS_BETA); float* RKB = (float*)(ws + WS_RKB);
    LAS float* tb = (LAS float*)lds;
    for (int i = tid; i < 7 * 256; i += 512) { const int t7 = i >> 8, q = i & 255;
        const float* src = t7 == 0 ? a.in[18] + lj * 1024 : t7 == 1 ? a.in[19] + lj * 1024 : t7 == 2 ? a.in[20] + lj * 1024 : t7 < 5 ? a.in[10] + lj * 2048 + (t7 - 3) * 1024 : a.in[13] + lj * 2048 + (t7 - 5) * 1024;
        ((LAS f32x4*)tb)[i] = ((const f32x4*)src)[q]; }
    __syncthreads();
    for (int row = gw; row < T; row += NGW) {
#pragma unroll
        for (int j = 0; j < 4; ++j) {
            const int col = 256 * j + 4 * lane; const size_t ro = (size_t)row * D + col;
            const f32x4 k = bf4(*(const u32x2*)(Kk + ro)), r = bf4(*(const u32x2*)(Rr + ro));
            f32x4 a0 = bf4(*(const u32x2*)(RA + ro)) + *(const LAS f32x4*)(tb + 5 * 1024 + col), a1 = bf4(*(const u32x2*)(RA + (size_t)T * D + ro)) + *(const LAS f32x4*)(tb + 6 * 1024 + col);
            f32x4 d0 = bf4(*(const u32x2*)(RW + ro)) + *(const LAS f32x4*)(tb + 3 * 1024 + col), d1 = bf4(*(const u32x2*)(RW + (size_t)T * D + ro)) + *(const LAS f32x4*)(tb + 4 * 1024 + col);
#pragma unroll
            for (int z = 0; z < 4; ++z) { a0[z] = sigm(a0[z]); a1[z] = sigm(a1[z]); d0[z] = -0.60653066f * sigm(d0[z]); d1[z] = -0.60653066f * sigm(d1[z]); }
            *(f32x4*)(LW + ro) = d0; *(f32x4*)(LW + (size_t)T * D + ro) = d1;
            const f32x4 ck = *(const LAS f32x4*)(tb + col), ca = *(const LAS f32x4*)(tb + 1024 + col), cr = *(const LAS f32x4*)(tb + 2048 + col);
            const f32x4 kk = k * ck;
            const float ss = row16_sum((kk.x * kk.x + kk.y * kk.y) + (kk.z * kk.z + kk.w * kk.w));
            const f32x4 kd0 = k * ((a0 - 1.0f) * ca + 1.0f), kd1 = k * ((a1 - 1.0f) * ca + 1.0f);
            *(u32x2*)(KD + ro) = pk4(kd0); *(u32x2*)(KD + (size_t)T * D + ro) = pk4(kd1);
            const f32x4 p = r * (kd0 + kd1) * cr;
            const float rk = row16_sum((p.x + p.y) + (p.z + p.w));
            const f32x4 kkn = kk * (1.0f / fmaxf(sqrtf(ss), 1e-12f));
            *(u32x2*)(KK + ro) = pk4(kkn); *(u32x2*)(BE + ro) = pk4(kkn * a0); *(u32x2*)(BE + (size_t)T * D + ro) = pk4(kkn * a1);
            if ((lane & 15) == 0) RKB[(size_t)row * 16 + 4 * j + (lane >> 4)] = rk;
        }
    }
}
typedef short bf16x8 __attribute__((ext_vector_type(8)));
__device__ __forceinline__ f32x4 mfma16(bf16x8 a, bf16x8 b, f32x4 c) { return __builtin_amdgcn_mfma_f32_16x16x32_bf16(a, b, c, 0, 0, 0); }
__device__ __forceinline__ bf16x8 as_frag(u32x4 w) { return __builtin_bit_cast(bf16x8, w); }
constexpr int CH_LD = 144;
constexpr int CH_MS = 64 * CH_LD;
constexpr int CH_AB = 0 * CH_MS, CH_KT = 1 * CH_MS, CH_BT = 2 * CH_MS, CH_RB = 3 * CH_MS, CH_VT = 4 * CH_MS, CH_ABT = 5 * CH_MS, CH_KHT = 6 * CH_MS, CH_BHT = 7 * CH_MS,
              CH_LK = 8 * CH_MS, CH_LB = 9 * CH_MS, CH_MK = 10 * CH_MS, CH_MB = 11 * CH_MS, CH_WT = 12 * CH_MS, CH_U0 = 13 * CH_MS, CH_DINV = 14 * CH_MS;
constexpr int CH_GC = LDSCTL_OFF + 2048;
constexpr int CH_PART = LDSCTL_OFF + 4096;
constexpr int NCHUNK = NSTEP / 64;
static_assert(CH_DINV + 2048 <= RING_BYTES, "chunk LDS map");

__device__ __forceinline__ int scan_row(int s, int dir, int b) {
    if (s < CTXL) return TL + b * CTXL + (dir ? CTXL - 1 - s : s);
    const int i = s - CTXL; return b * SEQ + (dir ? SEQ - 1 - i : i);
}
#define CH_FRAG(mat, row, ks, kg) as_frag(*(const LAS u32x4*)(lds + (mat) + (row) * CH_LD + ((ks) * 32 + (kg) * 8) * 2))

__device__ __forceinline__ void phase_s1_chunks(const Args& a, LAS unsigned char* lds, int tid, int G) {
    unsigned char* ws = a.ws;
    const int lane = tid & 63, wave = __builtin_amdgcn_readfirstlane(tid >> 6), l15 = lane & 15, g = lane >> 4;
    LAS float* part = (LAS float*)(lds + CH_PART); LAS float* gammaC = (LAS float*)(lds + CH_GC);
    float nlw[8], nkd[8], nbe[8], nkk[8], nrr[8], nvv[8];
#define S1_LOAD(ctx_) do { unsigned char* wsl = ws; asm volatile("" : "+s"(wsl));     \
        const float* LWp = (const float*)(wsl + WS_WDEC); const bf16* KDp = (const bf16*)(wsl + WS_KD); const bf16* BEp = (const bf16*)(wsl + WS_BETA); \
        const bf16* KKp = (const bf16*)(wsl + WS_KK); const bf16* Rp = (const bf16*)(wsl + WS_RKV); const bf16* Vp = Rp + (size_t)2 * T * D; \
        const int chain_ = (ctx_) / NCHUNK, c_ = (ctx_) - chain_ * NCHUNK, dir_ = chain_ >> 6, b_ = (chain_ >> 4) & 3, h_ = chain_ & 15; \
        _Pragma("unroll") for (int j = 0; j < 8; ++j) { const int row = scan_row(64 * c_ + 8 * wave + j, dir_, b_); const size_t o = (size_t)row * D + h_ * 64 + lane; \
            nlw[j] = LWp[(size_t)dir_ * T * D + o]; nkd[j] = bflo((unsigned)KDp[(size_t)dir_ * T * D + o]); nbe[j] = bflo((unsigned)BEp[(size_t)dir_ * T * D + o]); nkk[j] = bflo((unsigned)KKp[o]); nrr[j] = bflo((unsigned)Rp[o]); nvv[j] = bflo((unsigned)Vp[o]); } } while (0)
    if ((int)blockIdx.x < 128 * NCHUNK) S1_LOAD((int)blockIdx.x);
    for (int ct = blockIdx.x; ct < 128 * NCHUNK; ct += G) {
        const int chain = ct / NCHUNK, c = ct - chain * NCHUNK, dir = chain >> 6, b = (chain >> 4) & 3, h = chain & 15;
        unsigned zq = 0u; asm volatile("" : "+v"(zq));
        {
            const int k = lane, tq = wave;
            float lw[8], kd[8], be[8], kk[8], rr[8], vv[8];
#pragma unroll
            for (int j = 0; j < 8; ++j) { lw[j] = nlw[j]; kd[j] = nkd[j]; be[j] = nbe[j]; kk[j] = nkk[j]; rr[j] = nrr[j]; vv[j] = nvv[j]; }
            if (ct + G < 128 * NCHUNK) S1_LOAD(ct + G);
            float p[8]; p[0] = lw[0];
#pragma unroll
            for (int j = 1; j < 8; ++j) p[j] = p[j - 1] + lw[j];
            part[tq * 64 + k] = p[7];
            __syncthreads();
            float off = 0.f, tot = 0.f;
#pragma unroll
            for (int q = 0; q < 8; ++q) { const float pv = part[q * 64 + k]; tot += pv; off += q < tq ? pv : 0.f; }
            if (tq == 0) gammaC[k] = __expf(tot);
            unsigned abw[4], khw[4], bhw[4], vw[4];
#pragma unroll
            for (int j = 0; j < 8; j += 2) {
                float ab2[2], kt2[2], bt2[2], rb2[2], kh2[2], bh2[2];
#pragma unroll
                for (int z = 0; z < 2; ++z) { const float cu = off + p[j + z]; const float eP = __expf(cu), eM = __expf(-cu), ePrev = __expf(cu - lw[j + z]), eC = __expf(tot - cu);
                    ab2[z] = kk[j + z] * ePrev; kt2[z] = kd[j + z] * eM; bt2[z] = be[j + z] * eM; rb2[z] = rr[j + z] * eP; kh2[z] = kd[j + z] * eC; bh2[z] = be[j + z] * eC;
                    const int t = 8 * tq + j + z;
                    *(LAS bf16*)(lds + CH_AB + t * CH_LD + k * 2) = (bf16)f2bf(ab2[z]); *(LAS bf16*)(lds + CH_KT + t * CH_LD + k * 2) = (bf16)f2bf(kt2[z]);
                    *(LAS bf16*)(lds + CH_BT + t * CH_LD + k * 2) = (bf16)f2bf(bt2[z]); *(LAS bf16*)(lds + CH_RB + t * CH_LD + k * 2) = (bf16)f2bf(rb2[z]); }
                abw[j >> 1] = pk2(ab2[0], ab2[1]); khw[j >> 1] = pk2(kh2[0], kh2[1]); bhw[j >> 1] = pk2(bh2[0], bh2[1]); vw[j >> 1] = pk2(vv[j], vv[j + 1]);
            }
            *(LAS u32x4*)(lds + CH_ABT + k * CH_LD + tq * 16) = (u32x4){abw[0], abw[1], abw[2], abw[3]};
            *(LAS u32x4*)(lds + CH_KHT + k * CH_LD + tq * 16) = (u32x4){khw[0], khw[1], khw[2], khw[3]};
            *(LAS u32x4*)(lds + CH_BHT + k * CH_LD + tq * 16) = (u32x4){bhw[0], bhw[1], bhw[2], bhw[3]};
            *(LAS u32x4*)(lds + CH_VT + k * CH_LD + tq * 16) = (u32x4){vw[0], vw[1], vw[2], vw[3]};
            *(LAS u32x4*)(lds + CH_WT + k * CH_LD + tq * 16) = (u32x4){zq, zq, zq, zq}; *(LAS u32x4*)(lds + CH_U0 + k * CH_LD + tq * 16) = (u32x4){zq, zq, zq, zq};
        }
        __syncthreads();
        {
            const int mi = wave >> 1, half = wave & 1;
            const int matS = (mi & 1) ? CH_BT : CH_KT, matT = (mi & 2) ? CH_RB : CH_AB, matO = CH_LK + mi * CH_MS;
            const bool incl = (mi & 2) != 0;
            bf16x8 fs[4][2], ft[2][2];
#pragma unroll
            for (int ms = 0; ms < 4; ++ms)
#pragma unroll
                for (int ks = 0; ks < 2; ++ks) fs[ms][ks] = CH_FRAG(matS, 16 * ms + l15, ks, g);
#pragma unroll
            for (int nt = 0; nt < 2; ++nt)
#pragma unroll
                for (int ks = 0; ks < 2; ++ks) ft[nt][ks] = CH_FRAG(matT, 32 * half + 16 * nt + l15, ks, g);
#pragma unroll
            for (int nt = 0; nt < 2; ++nt) { const int t = 32 * half + 16 * nt + l15;
#pragma unroll
                for (int ms = 0; ms < 4; ++ms) { f32x4 d = (f32x4){0.f, 0.f, 0.f, 0.f};
                    d = mfma16(fs[ms][0], ft[nt][0], d); d = mfma16(fs[ms][1], ft[nt][1], d);
                    const int s0 = 16 * ms + 4 * g;
#pragma unroll
                    for (int i = 0; i < 4; ++i) { const bool keep = incl ? (s0 + i <= t) : (s0 + i < t); d[i] = keep ? d[i] : __builtin_bit_cast(float, zq); }
                    u32x2 w; w.x = pk2(d[0], d[1]); w.y = pk2(d[2], d[3]);
                    *(LAS u32x2*)(lds + matO + t * CH_LD + s0 * 2) = w; } }
        }
        __syncthreads();
        f32x4 rhsU[4];
#pragma unroll
        for (int I = 0; I < 4; ++I) rhsU[I] = (f32x4){0.f, 0.f, 0.f, 0.f};
        if (wave >= 4) {
            const int ctv = (wave & 3) * 16;
            const bf16x8 fv0 = CH_FRAG(CH_VT, ctv + l15, 0, g), fv1 = CH_FRAG(CH_VT, ctv + l15, 1, g);
#pragma unroll
            for (int I = 0; I < 4; ++I) { f32x4 d = (f32x4){0.f, 0.f, 0.f, 0.f};
                d = mfma16(CH_FRAG(CH_LK, 16 * I + l15, 0, g), fv0, d); d = mfma16(CH_FRAG(CH_LK, 16 * I + l15, 1, g), fv1, d); rhsU[I] = -d; }
        }
        if (wave == 0) {
            const int bb = lane >> 4, j = lane & 15;
            float x[16];
#pragma unroll
            for (int t = 0; t < 16; ++t) {
                const u32x4 r0 = *(const LAS u32x4*)(lds + CH_LB + (16 * bb + t) * CH_LD + 32 * bb), r1 = *(const LAS u32x4*)(lds + CH_LB + (16 * bb + t) * CH_LD + 32 * bb + 16);
                const unsigned rw[8] = {r0.x, r0.y, r0.z, r0.w, r1.x, r1.y, r1.z, r1.w};
                float acc = (t == j) ? 1.0f : 0.0f;
#pragma unroll
                for (int s = 0; s < t; ++s) { const float lv = (s & 1) ? bfhi(rw[s >> 1]) : bflo(rw[s >> 1]); acc -= lv * x[s]; }
                x[t] = acc;
                *(LAS bf16*)(lds + CH_DINV + ((bb * 16 + t) * 16 + j) * 2) = (bf16)f2bf(acc);
            }
        }
        __syncthreads();
        {
            const int matZ = wave < 4 ? CH_WT : CH_U0, ct16 = (wave & 3) * 16;
#pragma unroll
            for (int I = 0; I < 4; ++I) {
                f32x4 rhs;
                if (wave < 4) { const u32x2 w = *(const LAS u32x2*)(lds + CH_ABT + (ct16 + l15) * CH_LD + (16 * I + 4 * g) * 2); rhs = (f32x4){bflo(w.x), bfhi(w.x), bflo(w.y), bfhi(w.y)}; }
                else rhs = rhsU[I];
                f32x4 d = (f32x4){0.f, 0.f, 0.f, 0.f};
                d = mfma16(CH_FRAG(CH_LB, 16 * I + l15, 0, g), CH_FRAG(matZ, ct16 + l15, 0, g), d); d = mfma16(CH_FRAG(CH_LB, 16 * I + l15, 1, g), CH_FRAG(matZ, ct16 + l15, 1, g), d);
                const f32x4 ac = rhs - d;
                const u32x2 dv = *(const LAS u32x2*)(lds + CH_DINV + ((I * 16 + l15) * 16 + 4 * g) * 2);
                const bf16x8 fa = as_frag((u32x4){dv.x, dv.y, zq, zq}), fb = as_frag((u32x4){pk2(ac[0], ac[1]), pk2(ac[2], ac[3]), zq, zq});
                const f32x4 z = mfma16(fa, fb, (f32x4){0.f, 0.f, 0.f, 0.f});
                u32x2 w; w.x = pk2(z[0], z[1]); w.y = pk2(z[2], z[3]);
                *(LAS u32x2*)(lds + matZ + (ct16 + l15) * CH_LD + (16 * I + 4 * g) * 2) = w;
                LDS_WAIT(); asm volatile("" ::: "memory");
            }
        }
        __syncthreads();
        {
            const int rt = wave >> 1, cp = (wave & 1) * 2;
            unsigned char* wsl = ws; asm volatile("" : "+s"(wsl));
            bf16* YL = (bf16*)(wsl + WS_Y); bf16* RH = (bf16*)(wsl + WS_RH); bf16* PM = (bf16*)(wsl + WS_PM); bf16* QT = (bf16*)(wsl + WS_QT);
            const int trow = scan_row(64 * c + 16 * rt + l15, dir, b);
#pragma unroll
            for (int q = 0; q < 2; ++q) { const int vt = cp + q; f32x4 d = (f32x4){0.f, 0.f, 0.f, 0.f};
#pragma unroll
                for (int ks = 0; ks < 2; ++ks) { d = mfma16(CH_FRAG(CH_VT, 16 * vt + l15, ks, g), CH_FRAG(CH_MK, 16 * rt + l15, ks, g), d); d = mfma16(CH_FRAG(CH_U0, 16 * vt + l15, ks, g), CH_FRAG(CH_MB, 16 * rt + l15, ks, g), d); }
                *(u32x2*)(YL + ((size_t)dir * T + trow) * D + h * 64 + 16 * vt + 4 * g) = pk4(d); }
#pragma unroll
            for (int q = 0; q < 2; ++q) { const int kt = cp + q; f32x4 d = (f32x4){0.f, 0.f, 0.f, 0.f};
#pragma unroll
                for (int ks = 0; ks < 2; ++ks) d = mfma16(CH_FRAG(CH_WT, 16 * kt + l15, ks, g), CH_FRAG(CH_MB, 16 * rt + l15, ks, g), d);
                const u32x2 rbw = *(const LAS u32x2*)(lds + CH_RB + (16 * rt + l15) * CH_LD + (16 * kt + 4 * g) * 2);
                u32x2 w; w.x = pk2(bflo(rbw.x) - d[0], bfhi(rbw.x) - d[1]); w.y = pk2(bflo(rbw.y) - d[2], bfhi(rbw.y) - d[3]);
                *(u32x2*)(RH + ((size_t)dir * T + trow) * D + h * 64 + 16 * kt + 4 * g) = w; }
            bf16* Pc = PM + ((size_t)chain * NCHUNK + c) * 4096; bf16* Qc = QT + ((size_t)chain * NCHUNK + c) * 4096;
            { const int krow = 16 * rt + l15; const float gc = gammaC[krow];
#pragma unroll
                for (int q = 0; q < 2; ++q) { const int kt = cp + q; f32x4 d = (f32x4){0.f, 0.f, 0.f, 0.f};
#pragma unroll
                    for (int ks = 0; ks < 2; ++ks) d = mfma16(CH_FRAG(CH_WT, 16 * kt + l15, ks, g), CH_FRAG(CH_BHT, krow, ks, g), d);
                    const int k0 = 16 * kt + 4 * g; f32x4 o;
#pragma unroll
                    for (int i = 0; i < 4; ++i) o[i] = ((k0 + i == krow) ? gc : 0.f) - d[i];
                    u32x2 w; w.x = pk2(o[0], o[1]); w.y = pk2(o[2], o[3]);
                    *(u32x2*)(Pc + krow * 64 + 32 * (kt >> 1) + 8 * g + 4 * (kt & 1)) = w; } }
            { const int vrow = 16 * rt + l15;
#pragma unroll
                for (int q = 0; q < 2; ++q) { const int kt = cp + q; f32x4 d = (f32x4){0.f, 0.f, 0.f, 0.f};
#pragma unroll
                    for (int ks = 0; ks < 2; ++ks) { d = mfma16(CH_FRAG(CH_KHT, 16 * kt + l15, ks, g), CH_FRAG(CH_VT, vrow, ks, g), d); d = mfma16(CH_FRAG(CH_BHT, 16 * kt + l15, ks, g), CH_FRAG(CH_U0, vrow, ks, g), d); }
                    u32x2 w; w.x = pk2(d[0], d[1]); w.y = pk2(d[2], d[3]);
                    *(u32x2*)(Qc + vrow * 64 + 16 * g + 4 * kt) = w; } }
        }
        __syncthreads();
    }
}

struct S2Set { u32x4 p[4][2]; u32x4 q[2]; };
__device__ __forceinline__ void s2_load(S2Set& s, const bf16* Pc, const bf16* Qc, int vt, int l15, int g) {
    s.q[0] = *(const u32x4*)(Qc + (16 * vt + l15) * 64 + 16 * g); s.q[1] = *(const u32x4*)(Qc + (16 * vt + l15) * 64 + 16 * g + 8);
#pragma unroll
    for (int m = 0; m < 4; ++m)
#pragma unroll
        for (int j = 0; j < 2; ++j) s.p[m][j] = *(const u32x4*)(Pc + (16 * m + l15) * 64 + 32 * j + 8 * g);
}
__device__ __forceinline__ void s2_step(f32x4 (&acc)[4], const S2Set& s, bf16* Hc, int g) {
    unsigned hw[4][2];
#pragma unroll
    for (int m = 0; m < 4; ++m) { hw[m][0] = pk2(acc[m][0], acc[m][1]); hw[m][1] = pk2(acc[m][2], acc[m][3]); }
#pragma unroll
    for (int m = 0; m < 4; ++m) *(u32x2*)(Hc + 16 * m + 4 * g) = (u32x2){hw[m][0], hw[m][1]};
    const bf16x8 hb0 = as_frag((u32x4){hw[0][0], hw[0][1], hw[1][0], hw[1][1]}), hb1 = as_frag((u32x4){hw[2][0], hw[2][1], hw[3][0], hw[3][1]});
#pragma unroll
    for (int m = 0; m < 4; ++m) {
        const unsigned q0 = (m & 2) ? ((m & 1) ? s.q[1].z : s.q[1].x) : ((m & 1) ? s.q[0].z : s.q[0].x), q1 = (m & 2) ? ((m & 1) ? s.q[1].w : s.q[1].y) : ((m & 1) ? s.q[0].w : s.q[0].y);
        f32x4 d = (f32x4){bflo(q0), bfhi(q0), bflo(q1), bfhi(q1)};
        d = mfma16(as_frag(s.p[m][0]), hb0, d);
        d = mfma16(as_frag(s.p[m][1]), hb1, d);
        acc[m] = d;
    }
}
__device__ __forceinline__ void phase_s2_chain(const Args& a, int wave, int lane, int G) {
    unsigned char* ws = a.ws;
    const bf16* PM = (const bf16*)(ws + WS_PM); const bf16* QT = (const bf16*)(ws + WS_QT); bf16* HT = (bf16*)(ws + WS_HT);
    const int l15 = lane & 15, g = lane >> 4;
    if (wave >= 2) return;
    static_assert(NCHUNK % 4 == 0, "S2 ring");
    for (int wt = blockIdx.x * 2 + wave; wt < 512; wt += G * 2) {
        const int chain = wt >> 2, vt = wt & 3;
        f32x4 acc[4];
#pragma unroll
        for (int m = 0; m < 4; ++m) acc[m] = (f32x4){0.f, 0.f, 0.f, 0.f};
        const bf16* Pc = PM + (size_t)chain * NCHUNK * 4096; const bf16* Qc = QT + (size_t)chain * NCHUNK * 4096;
        bf16* Hc = HT + (size_t)chain * NCHUNK * 4096 + (16 * vt + l15) * 64;
        S2Set s0, s1, s2, s3;
        s2_load(s0, Pc, Qc, vt, l15, g); s2_load(s1, Pc + 4096, Qc + 4096, vt, l15, g); s2_load(s2, Pc + 2 * 4096, Qc + 2 * 4096, vt, l15, g); s2_load(s3, Pc + 3 * 4096, Qc + 3 * 4096, vt, l15, g);
#pragma unroll 1
        for (int c = 0; c < NCHUNK; c += 4) {
            const int cn = c + 4 < NCHUNK ? c + 4 : c;
            const bf16* Pn = Pc + (size_t)cn * 4096; const bf16* Qn = Qc + (size_t)cn * 4096;
            s2_step(acc, s0, Hc + (size_t)c * 4096, g);       s2_load(s0, Pn, Qn, vt, l15, g);
            s2_step(acc, s1, Hc + (size_t)(c + 1) * 4096, g); s2_load(s1, Pn + 4096, Qn + 4096, vt, l15, g);
            s2_step(acc, s2, Hc + (size_t)(c + 2) * 4096, g); s2_load(s2, Pn + 2 * 4096, Qn + 2 * 4096, vt, l15, g);
            s2_step(acc, s3, Hc + (size_t)(c + 3) * 4096, g); s2_load(s3, Pn + 3 * 4096, Qn + 3 * 4096, vt, l15, g);
        }
    }
}

__device__ __forceinline__ void phase_s3_readout(const Args& a, int lj, int nrows, int gw, int NGW, int lane) {
    unsigned char* ws = a.ws;
    const bf16* YL = (const bf16*)(ws + WS_Y); const bf16* RH = (const bf16*)(ws + WS_RH); const bf16* HT = (const bf16*)(ws + WS_HT);
    const bf16* Vv = (const bf16*)(ws + WS_RKV) + (size_t)2 * T * D; const float* RKB = (const float*)(ws + WS_RKB); const bf16* Gg = (const bf16*)(ws + WS_G); bf16* Z = (bf16*)(ws + WS_Z);
    const float* lng = a.in[21] + lj * 1024; const float* lnb = a.in[22] + lj * 1024;
    const int l15 = lane & 15, g = lane >> 4;
    for (int task = gw; task < (nrows / 16) * 16; task += NGW) {
        const int tt = task >> 4, h = task & 15, r0 = tt * 16, row = r0 + l15;
        int b, cc[2];
        if (r0 < TL) { b = r0 >> 13; const int tb = (r0 & (SEQ - 1)) >> 6; cc[0] = 4 + tb; cc[1] = 4 + (127 - tb); }
        else { const int loc = r0 - TL; b = loc >> 8; const int tb = (loc & 255) >> 6; cc[0] = tb; cc[1] = 3 - tb; }
        f32x4 acc[4];
        const size_t ro = (size_t)row * D + h * 64 + 4 * g;
#pragma unroll
        for (int vt = 0; vt < 4; ++vt) acc[vt] = bf4(*(const u32x2*)(YL + ro + 16 * vt)) + bf4(*(const u32x2*)(YL + (size_t)T * D + ro + 16 * vt));
#pragma unroll
        for (int dir = 0; dir < 2; ++dir) {
            const int chain = dir * 64 + b * 16 + h;
            const bf16* rh = RH + ((size_t)dir * T + row) * D + h * 64 + 8 * g;
            const bf16x8 f0 = as_frag(*(const u32x4*)(rh)), f1 = as_frag(*(const u32x4*)(rh + 32));
            const bf16* hc = HT + ((size_t)chain * NCHUNK + cc[dir]) * 4096;
#pragma unroll
            for (int vt = 0; vt < 4; ++vt) { const bf16* hr = hc + (16 * vt + l15) * 64 + 8 * g;
                acc[vt] = mfma16(as_frag(*(const u32x4*)(hr)), f0, acc[vt]); acc[vt] = mfma16(as_frag(*(const u32x4*)(hr + 32)), f1, acc[vt]); }
        }
        float s = 0.f;
#pragma unroll
        for (int vt = 0; vt < 4; ++vt) s += (acc[vt][0] + acc[vt][1]) + (acc[vt][2] + acc[vt][3]);
        s += __shfl_xor(s, 16); s += __shfl_xor(s, 32);
        const float mean = s * (1.0f / 64.0f); float vs = 0.f;
#pragma unroll
        for (int vt = 0; vt < 4; ++vt) { acc[vt] = acc[vt] - mean; vs += (acc[vt][0] * acc[vt][0] + acc[vt][1] * acc[vt][1]) + (acc[vt][2] * acc[vt][2] + acc[vt][3] * acc[vt][3]); }
        vs += __shfl_xor(vs, 16); vs += __shfl_xor(vs, 32);
        const float rstd = rsqrtf(vs * (1.0f / 64.0f) + 64.0f * 1e-5f), bon = RKB[(size_t)row * 16 + h];
#pragma unroll
        for (int vt = 0; vt < 4; ++vt) { const int col = h * 64 + 16 * vt + 4 * g; const size_t o = (size_t)row * D + col;
            const f32x4 vq = bf4(*(const u32x2*)(Vv + o)), lg4 = *(const f32x4*)(lng + col), lb4 = *(const f32x4*)(lnb + col); const u32x2 gw2 = *(const u32x2*)(Gg + o);
            const f32x4 zz = acc[vt] * rstd * lg4 + lb4 + vq * bon;
            u32x2 w; w.x = pk2(zz[0] * bflo(gw2.x), zz[1] * bfhi(gw2.x)); w.y = pk2(zz[2] * bflo(gw2.y), zz[3] * bfhi(gw2.y));
            *(u32x2*)(Z + o) = w; }
    }
}
__device__ __forceinline__ void phase_cv(const Args& a, int lc, int rows, int gw, int NGW, int lane) {
    unsigned char* ws = a.ws;
    const bf16* BG = (const bf16*)(ws + WS_BG); const bf16* CU = (const bf16*)(ws + WS_CUZ); bf16* Z = (bf16*)(ws + WS_Z);
    const float* cw = a.in[25] + (size_t)lc * 3 * 1024;
    for (int t = gw; t < rows; t += NGW) {
        int rs, re; if (t < TL) { rs = t & ~63; re = rs + 63; } else { const int loc = t - TL; rs = TL + (loc & ~255); re = rs + 255; }
        const bool hp = t > rs, hn = t < re;
#pragma unroll
        for (int j = 0; j < 4; ++j) { const int col = 256 * j + 4 * lane; const size_t o = (size_t)t * D + col;
            const u32x2 zc = *(const u32x2*)(CU + o), bg = *(const u32x2*)(BG + o);
            const u32x2 zp = hp ? *(const u32x2*)(CU + o - D) : (u32x2){0u, 0u}, zn = hn ? *(const u32x2*)(CU + o + D) : (u32x2){0u, 0u};
            const f32x4 w0 = *(const f32x4*)(cw + col), w1 = *(const f32x4*)(cw + 1024 + col), w2 = *(const f32x4*)(cw + 2048 + col);
            const f32x4 zv = (f32x4){bflo(zc.x), bfhi(zc.x), bflo(zc.y), bfhi(zc.y)}, pv = (f32x4){bflo(zp.x), bfhi(zp.x), bflo(zp.y), bfhi(zp.y)}, nv = (f32x4){bflo(zn.x), bfhi(zn.x), bflo(zn.y), bfhi(zn.y)};
            const f32x4 bv = (f32x4){bflo(bg.x), bfhi(bg.x), bflo(bg.y), bfhi(bg.y)};
            const f32x4 r = bv * (w0 * pv + w1 * zv + w2 * nv);
            u32x2 w; w.x = pk2(r.x, r.y); w.y = pk2(r.z, r.w); *(u32x2*)(Z + o) = w; }
    }
}
__device__ __forceinline__ float lane_bcast(float v, int srclane) { return __builtin_bit_cast(float, __builtin_amdgcn_readlane(__builtin_bit_cast(int, v), srclane)); }
__device__ __forceinline__ void phase_e_route(const Args& a, int layer, int rows, LAS unsigned char* lds, int tid, int gw, int NGW, int lane, int probe_rep = 0) {
    unsigned char* ws = a.ws;
    const float* xs = (const float*)(ws + (layer < 2 ? WS_XSA : WS_XSB));
    const float* MODS = (const float*)(ws + WS_MODS); bf16* H2 = (bf16*)(ws + WS_H2);
    const float* ng = a.in[6] + (size_t)(layer * 2 + 1) * 1024;
    const float* rw = a.in[27] + (size_t)layer * 1024 * 32; const float* rb = a.in[28] + layer * 32;
    unsigned* cnt = (unsigned*)(ws + WS_CTL) + CW_CNT + (layer + 4 * probe_rep) * 32 * CNT_STRIDE;
    int* SLOTL = (int*)(ws + (probe_rep ? WS_L1 : WS_SLOTL)); float* GATEL = (float*)(ws + (probe_rep ? WS_L1 + 8 * MiB : WS_GATEL));
    LAS float* wt = (LAS float*)lds;
    LAS int* hist = (LAS int*)(lds + LDSCTL_OFF + 3072); LAS int* base = hist + 32; LAS int* lcnt = hist + 64;
    int* TKE = (int*)(ws + WS_C12); float* TKG = (float*)(ws + WS_C12 + 4 * MiB);
    for (int i = tid; i < 32768; i += 512) wt[(i & 31) * 1024 + (i >> 5)] = rw[i];
    if (tid < 32) hist[tid] = 0;
    __syncthreads();
    const int my_e = lane >> 1; const float my_b = rb[my_e];
    const bool b5 = (lane & 32) != 0, b4 = (lane & 16) != 0, b3 = (lane & 8) != 0, b2 = (lane & 4) != 0, b1 = (lane & 2) != 0;
    for (int t = gw; t < rows; t += NGW) {
        const int mr = mod_row(t);
        const float* mod = MODS + (size_t)(layer * 5 + mr) * 6144;
        f32x4 x[4];
#pragma unroll
        for (int j = 0; j < 4; ++j) x[j] = *(const f32x4*)(xs + (size_t)t * D + 256 * j + 4 * lane);
        const float rstd = row_rstd(x);
#pragma unroll
        for (int j = 0; j < 4; ++j) { const int col = 256 * j + 4 * lane;
            x[j] = x[j] * rstd * *(const f32x4*)(ng + col) * (*(const f32x4*)(mod + 4 * 1024 + col) + 1.0f) + *(const f32x4*)(mod + 3 * 1024 + col);
            u32x2 w; w.x = pk2(x[j].x, x[j].y); w.y = pk2(x[j].z, x[j].w); *(u32x2*)(H2 + (size_t)t * D + col) = w; }
        float p[32];
#pragma unroll
        for (int eg = 0; eg < 8; ++eg) {
#pragma unroll
            for (int ee = 0; ee < 4; ++ee) { const int e = eg * 4 + ee; float s = 0.f;
#pragma unroll
                for (int j = 0; j < 4; ++j) { const f32x4 wv = *(const LAS f32x4*)(wt + e * 1024 + 256 * j + 4 * lane); s += (x[j].x * wv.x + x[j].y * wv.y) + (x[j].z * wv.z + x[j].w * wv.w); }
                p[e] = s; }
            asm volatile("" ::: "memory");
        }
        float q16[16];
#pragma unroll
        for (int i = 0; i < 16; ++i) { const float send = b5 ? p[i] : p[i + 16]; const float keep = b5 ? p[i + 16] : p[i]; q16[i] = keep + __shfl_xor(send, 32); }
        float q8[8];
#pragma unroll
        for (int i = 0; i < 8; ++i) { const float send = b4 ? q16[i] : q16[i + 8]; const float keep = b4 ? q16[i + 8] : q16[i]; q8[i] = keep + __shfl_xor(send, 16); }
        float q4[4];
#pragma unroll
        for (int i = 0; i < 4; ++i) { const float send = b3 ? q8[i] : q8[i + 4]; const float keep = b3 ? q8[i + 4] : q8[i]; q4[i] = keep + __shfl_xor(send, 8); }
        float q2[2];
#pragma unroll
        for (int i = 0; i < 2; ++i) { const float send = b2 ? q4[i] : q4[i + 2]; const float keep = b2 ? q4[i + 2] : q4[i]; q2[i] = keep + __shfl_xor(send, 4); }
        float q1; { const float send = b1 ? q2[0] : q2[1]; const float keep = b1 ? q2[1] : q2[0]; q1 = keep + __shfl_xor(send, 2); }
        const float lg = q1 + __shfl_xor(q1, 1) + my_b;
        int rank = 0;
#pragma unroll 1
        for (int e = 0; e < 32; ++e) { const float o = lane_bcast(lg, 2 * e); rank += (o > lg || (o == lg && e < my_e)) ? 1 : 0; }
        const bool sel = rank < 4 && !(lane & 1);
        const unsigned long long m0 = __ballot(sel && rank == 0), m1 = __ballot(sel && rank == 1), m2 = __ballot(sel && rank == 2), m3 = __ballot(sel && rank == 3);
        const float v0 = lane_bcast(lg, (int)__builtin_ctzll(m0)), v1 = lane_bcast(lg, (int)__builtin_ctzll(m1)), v2 = lane_bcast(lg, (int)__builtin_ctzll(m2)), v3 = lane_bcast(lg, (int)__builtin_ctzll(m3));
        const float e1 = __expf(v1 - v0), e2 = __expf(v2 - v0), e3 = __expf(v3 - v0);
        const float inv = 1.0f / (1.0f + e1 + e2 + e3);
        if (sel) {
            TKE[t * 4 + rank] = my_e; TKG[t * 4 + rank] = __expf(lg - v0) * inv;
            __hip_atomic_fetch_add(hist + my_e, 1, __ATOMIC_RELAXED, __HIP_MEMORY_SCOPE_WORKGROUP);
        }
    }
    asm volatile("s_waitcnt vmcnt(0) lgkmcnt(0)" ::: "memory"); __syncthreads();
    if (tid < 32) { base[tid] = (int)atomicAdd(cnt + tid * CNT_STRIDE, (unsigned)hist[tid]); lcnt[tid] = 0; }
    __syncthreads();
    for (int t = gw; t < rows; t += NGW) {
        if (lane < 4) { const int e = TKE[t * 4 + lane]; const float gk = TKG[t * 4 + lane];
            const int pos = base[e] + __hip_atomic_fetch_add(lcnt + e, 1, __ATOMIC_RELAXED, __HIP_MEMORY_SCOPE_WORKGROUP);
            SLOTL[(size_t)e * T + pos] = t * 4 + lane; GATEL[(size_t)e * T + pos] = gk; }
    }
}
__device__ __forceinline__ void phase_final(const Args& a, int gw, int NGW, int lane) {
    unsigned char* ws = a.ws;
    const float* xs = (const float*)(ws + WS_XSB); const float* MODS = (const float*)(ws + WS_MODS); const bf16* YS = (const bf16*)(ws + WS_YS);
    for (int t = gw; t < TL; t += NGW) {
        const int mr = t >> 13;
        f32x4 m5[4], x[4];
#pragma unroll
        for (int j = 0; j < 4; ++j) m5[j] = *(const f32x4*)(MODS + (size_t)(3 * 5 + mr) * 6144 + 5 * 1024 + 256 * j + 4 * lane);
        load_x_combined(x, xs + (size_t)t * D, true, YS, t, m5, lane);
        const float rstd = row_rstd(x);
#pragma unroll
        for (int j = 0; j < 4; ++j) { const int col = 256 * j + 4 * lane; *(f32x4*)(a.out + (size_t)t * D + col) = x[j] * rstd * *(const f32x4*)(a.in[7] + col); }
    }
}

using pg8::Unit; using pg8::tile_map;
struct SchedStd {
    int G, c, nM, nN;
    __device__ __forceinline__ bool next(int i, Unit& u) const { const long L = (long)i * G + c; if (L >= (long)nM * nN) return false; int pm, pn; tile_map((int)L, nM, nN, pm, pn); u.pm = pm; u.pn = pn; u.e = 0; u.nv = pm; return true; }
    __device__ __forceinline__ void a_ready(const Unit&) const {}
    __device__ __forceinline__ void done(const Unit&) const {}
    __device__ __forceinline__ unsigned row_off(const Unit&, int) const { return 0u; }
};
struct SchedB1 {
    int G, c;
    __device__ __forceinline__ bool next(int i, Unit& u) const { const long L = (long)i * G + c; constexpr int n1 = 3 * NMT * 4; if (L >= n1 + 3 * NMT) return false; const int l = (int)L;
        if (l < n1) { const int j = l / (NMT * 4), r = l % (NMT * 4); int pm, pn; tile_map(r, NMT, 4, pm, pn); u.pm = j * NMT + pm; u.pn = j * 4 + pn; u.e = j; u.nv = pm; }
        else { const int r = l - n1, j = r / NMT, pm = r % NMT; u.pm = (3 + j) * NMT + pm; u.pn = 12 + j; u.e = 3 + j; u.nv = pm; }
        return true; }
    __device__ __forceinline__ void a_ready(const Unit&) const {}
    __device__ __forceinline__ void done(const Unit&) const {}
    __device__ __forceinline__ unsigned row_off(const Unit&, int) const { return 0u; }
};
struct SchedB2 {
    int G, c;
    __device__ __forceinline__ bool next(int i, Unit& u) const { const long L = (long)i * G + c; constexpr int n1 = 2 * NMT * 8; if (L >= n1 + NMT * 4) return false; const int l = (int)L;
        if (l < n1) { const int j = l / (NMT * 8), r = l % (NMT * 8); int pm, pn; tile_map(r, NMT, 8, pm, pn); u.pm = j * NMT + pm; u.pn = j * 8 + pn; u.e = j; u.nv = pm; }
        else { const int r = l - n1; int pm, pn; tile_map(r, NMT, 4, pm, pn); u.pm = 2 * NMT + pm; u.pn = 16 + pn; u.e = 2; u.nv = pm; }
        return true; }
    __device__ __forceinline__ void a_ready(const Unit&) const {}
    __device__ __forceinline__ void done(const Unit&) const {}
    __device__ __forceinline__ unsigned row_off(const Unit&, int) const { return 0u; }
};
struct SchedMoe {
    int G, c, nnt, ntiles, P; LAS unsigned char* lds; const int* slotl;
    __device__ __forceinline__ bool next(int i, Unit& u) const { const long L = (long)i * G + c; const int ntp = (ntiles + P - 1) / P, ppg = nnt / (8 / P); if (L >= (long)ntp * ppg * 8) return false;
        const LAS int* tpre = (const LAS int*)(lds + LDSCTL_OFF + 64); const LAS int* ecnt = (const LAS int*)(lds + LDSCTL_OFF + 256); const LAS unsigned short* tile_e = (const LAS unsigned short*)(lds + LDSCTL_OFF + 512);
        const int xq = (int)(L >> 3), x8 = (int)(L & 7); int tile = (xq / ppg) * P + (x8 % P); const int pnl = (x8 / P) * ppg + xq % ppg; const bool dead = tile >= ntiles; tile = dead ? 0 : tile;
        const int e = __builtin_amdgcn_readfirstlane((int)tile_e[tile]), r0 = (tile - __builtin_amdgcn_readfirstlane(tpre[e])) * 256; int nv = __builtin_amdgcn_readfirstlane(ecnt[e]) - r0; nv = nv > 256 ? 256 : nv; nv = dead ? 0 : nv;
        u.pm = dead ? MAXTILES : tile; u.pn = e * nnt + pnl; u.e = e; u.nv = nv | (r0 << 9); return true; }
    __device__ __forceinline__ void a_ready(const Unit&) const {}
    __device__ __forceinline__ void done(const Unit&) const {}
    __device__ __forceinline__ unsigned row_off(const Unit& u, int r) const { const int nv = u.nv & 511, r0 = u.nv >> 9; const int tok = r < nv ? (slotl[(size_t)u.e * T + r0 + r] >> 2) : 0; return (unsigned)tok * 2048u; }
};

using pg8::cvt_pk_bf16;
template <class P> __device__ __forceinline__ P* pin_ptr(P* p) { asm volatile("" : "+v"(p)); return p; }
struct EpiB1 {
    static constexpr bool PERM = true, AFTER_DRAIN = false;
    bf16* RKV; bf16* L1;
    __device__ __forceinline__ void operator()(const f32x4 (&acc)[2][2][4][2], const Unit& u, int wr, int wc, int fr, int fq) const {
        const int seg = u.e, row0 = u.nv * 256 + wr * 64 + fr;
        const int jj = seg - 3, ld = seg < 3 ? D : 256, col0 = (seg < 3 ? (u.pn - seg * 4) * 256 : 0) + wc * 32 + 8 * fq;
        bf16* base = seg < 3 ? RKV + (size_t)seg * T * D : L1 + (size_t)jj * T * 256;
#pragma unroll
        for (int ai = 0; ai < 2; ++ai)
#pragma unroll
            for (int m = 0; m < 4; ++m) { bf16* rowp = base + (size_t)(row0 + ai * 128 + m * 16) * ld + col0;
#pragma unroll
                for (int bj = 0; bj < 2; ++bj) { f32x4 v0 = acc[ai][bj][m][0], v1 = acc[ai][bj][m][1];
                    if (jj == 0) {
#pragma unroll
                        for (int q = 0; q < 4; ++q) { v0[q] = tanh_fast(v0[q]); v1[q] = tanh_fast(v1[q]); } }
                    else if (jj == 2) {
#pragma unroll
                        for (int q = 0; q < 4; ++q) { v0[q] = sigm(v0[q]); v1[q] = sigm(v1[q]); } }
                    u32x4 w; w.x = cvt_pk_bf16(v0[0], v0[1]); w.y = cvt_pk_bf16(v0[2], v0[3]); w.z = cvt_pk_bf16(v1[0], v1[1]); w.w = cvt_pk_bf16(v1[2], v1[3]);
                    *(u32x4*)(rowp + bj * 128) = w; } }
    }
};
struct EpiB2 {
    static constexpr bool PERM = true, AFTER_DRAIN = false;
    bf16* RW; bf16* RA; bf16* Gg;
    __device__ __forceinline__ void operator()(const f32x4 (&acc)[2][2][4][2], const Unit& u, int wr, int wc, int fr, int fq) const {
        const int jj = u.e, row0 = u.nv * 256 + wr * 64 + fr, pnl = u.pn - jj * 8;
        const int dirn = jj < 2 ? (pnl >> 2) : 0, col0 = (jj < 2 ? (pnl & 3) : pnl) * 256 + wc * 32 + 8 * fq;
        bf16* base = (jj == 0 ? RW : jj == 1 ? RA : Gg) + (size_t)dirn * T * D;
#pragma unroll
        for (int ai = 0; ai < 2; ++ai)
#pragma unroll
            for (int m = 0; m < 4; ++m) { bf16* rowp = base + (size_t)(row0 + ai * 128 + m * 16) * D + col0;
#pragma unroll
                for (int bj = 0; bj < 2; ++bj) { const f32x4 v0 = acc[ai][bj][m][0], v1 = acc[ai][bj][m][1];
                    u32x4 w; w.x = cvt_pk_bf16(v0[0], v0[1]); w.y = cvt_pk_bf16(v0[2], v0[3]); w.z = cvt_pk_bf16(v1[0], v1[1]); w.w = cvt_pk_bf16(v1[2], v1[3]);
                    *(u32x4*)(rowp + bj * 128) = w; } }
    }
};
struct EpiRes {
    static constexpr bool PERM = true, AFTER_DRAIN = false;
    float* X; const float* gate; float* Xo;
    __device__ __forceinline__ void operator()(const f32x4 (&acc)[2][2][4][2], const Unit& u, int wr, int wc, int fr, int fq) const {
        const int row0 = u.pm * 256 + wr * 64 + fr, col0 = u.pn * 256 + wc * 32 + 8 * fq, mr = u.pm < NMT_L ? (u.pm >> 5) : 4;
        const float* gp = pin_ptr(gate + (size_t)mr * 6144 + col0);
        f32x4 gv[2][2];
#pragma unroll
        for (int bj = 0; bj < 2; ++bj)
#pragma unroll
            for (int n = 0; n < 2; ++n) gv[bj][n] = *(const f32x4*)(gp + bj * 128 + 4 * n);
#pragma unroll
        for (int ai = 0; ai < 2; ++ai)
#pragma unroll
            for (int m = 0; m < 4; ++m) { float* rowp = X + (size_t)(row0 + ai * 128 + m * 16) * D + col0;
#pragma unroll
                for (int bj = 0; bj < 2; ++bj)
#pragma unroll
                    for (int n = 0; n < 2; ++n) { float* p = rowp + bj * 128 + 4 * n; *(f32x4*)(Xo + (p - X)) = *(const f32x4*)p + gv[bj][n] * acc[ai][bj][m][n]; } }
    }
};
struct EpiWin {
    static constexpr bool PERM = true, AFTER_DRAIN = false;
    bf16* BG; bf16* CU;
    __device__ __forceinline__ void operator()(const f32x4 (&acc)[2][2][4][2], const Unit& u, int wr, int wc, int fr, int fq) const {
        const int row0 = u.pm * 256 + wr * 64 + fr;
        if (u.pn < 4) {
            const int col0 = u.pn * 256 + wc * 32 + 8 * fq;
#pragma unroll
            for (int ai = 0; ai < 2; ++ai)
#pragma unroll
                for (int m = 0; m < 4; ++m) { bf16* rowp = BG + (size_t)(row0 + ai * 128 + m * 16) * D + col0;
#pragma unroll
                    for (int bj = 0; bj < 2; ++bj) { const f32x4 v0 = acc[ai][bj][m][0], v1 = acc[ai][bj][m][1];
                        u32x4 w; w.x = cvt_pk_bf16(v0[0], v0[1]); w.y = cvt_pk_bf16(v0[2], v0[3]); w.z = cvt_pk_bf16(v1[0], v1[1]); w.w = cvt_pk_bf16(v1[2], v1[3]);
                        *(u32x4*)(rowp + bj * 128) = w; } }
        } else {
            const int f0 = (u.pn - 4) * 128 + wc * 32 + 8 * fq;
#pragma unroll
            for (int ai = 0; ai < 2; ++ai)
#pragma unroll
                for (int m = 0; m < 4; ++m) { const f32x4 v0 = acc[ai][0][m][0] * acc[ai][1][m][0], v1 = acc[ai][0][m][1] * acc[ai][1][m][1];
                    u32x4 w; w.x = cvt_pk_bf16(v0[0], v0[1]); w.y = cvt_pk_bf16(v0[2], v0[3]); w.z = cvt_pk_bf16(v1[0], v1[1]); w.w = cvt_pk_bf16(v1[2], v1[3]);
                    *(u32x4*)(CU + (size_t)(row0 + ai * 128 + m * 16) * D + f0) = w; }
        }
    }
};
struct EpiGU {
    static constexpr bool PERM = true, AFTER_DRAIN = false;
    bf16* INTER; const float* bgu;
    __device__ __forceinline__ void operator()(const f32x4 (&acc)[2][2][4][2], const Unit& u, int wr, int wc, int fr, int fq) const {
        const int e = u.e, pnl = u.pn - e * 8, row0 = u.pm * 256 + wr * 64 + fr, f0 = pnl * 128 + wc * 32 + 8 * fq;
        const float* bp = pin_ptr(bgu + (size_t)e * 2048 + f0);
        f32x4 bg[2], bu[2];
#pragma unroll
        for (int n = 0; n < 2; ++n) { bg[n] = *(const f32x4*)(bp + 4 * n); bu[n] = *(const f32x4*)(bp + 1024 + 4 * n); }
#pragma unroll
        for (int ai = 0; ai < 2; ++ai)
#pragma unroll
            for (int m = 0; m < 4; ++m) { f32x4 o[2];
#pragma unroll
                for (int n = 0; n < 2; ++n) { const f32x4 g = acc[ai][0][m][n] + bg[n], uu = acc[ai][1][m][n] + bu[n];
#pragma unroll
                    for (int q = 0; q < 4; ++q) { const float gc = fminf(g[q], 7.0f), uc = fminf(fmaxf(uu[q], -7.0f), 7.0f); o[n][q] = (uc + 1.0f) * gc * sigm(1.702f * gc); } }
                u32x4 w; w.x = cvt_pk_bf16(o[0][0], o[0][1]); w.y = cvt_pk_bf16(o[0][2], o[0][3]); w.z = cvt_pk_bf16(o[1][0], o[1][1]); w.w = cvt_pk_bf16(o[1][2], o[1][3]);
                *(u32x4*)(INTER + (size_t)(row0 + ai * 128 + m * 16) * 1024 + f0) = w; }
    }
};
struct EpiDown {
    static constexpr bool PERM = true, AFTER_DRAIN = false;
    bf16* YS; const float* bdn; const int* slotl; const float* gatel;
    __device__ __forceinline__ void operator()(const f32x4 (&acc)[2][2][4][2], const Unit& u, int wr, int wc, int fr, int fq) const {
        const int e = u.e, pnl = u.pn - e * 4, col0 = pnl * 256 + wc * 32 + 8 * fq, nv = u.nv & 511, r0 = u.nv >> 9;
        const float* bp = pin_ptr(bdn + (size_t)e * 1024 + col0);
        f32x4 bv[2][2];
#pragma unroll
        for (int bj = 0; bj < 2; ++bj)
#pragma unroll
            for (int n = 0; n < 2; ++n) bv[bj][n] = *(const f32x4*)(bp + bj * 128 + 4 * n);
#pragma unroll
        for (int ai = 0; ai < 2; ++ai)
#pragma unroll
            for (int m = 0; m < 4; ++m) { const int r = ai * 128 + wr * 64 + m * 16 + fr;
                if (r < nv) { const size_t li = (size_t)e * T + r0 + r; const int slot = slotl[li]; const float gt = gatel[li];
                    bf16* rowp = YS + (size_t)slot * 1024 + col0;
#pragma unroll
                    for (int bj = 0; bj < 2; ++bj) { const f32x4 v0 = (acc[ai][bj][m][0] + bv[bj][0]) * gt, v1 = (acc[ai][bj][m][1] + bv[bj][1]) * gt;
                        u32x4 w; w.x = cvt_pk_bf16(v0[0], v0[1]); w.y = cvt_pk_bf16(v0[2], v0[3]); w.z = cvt_pk_bf16(v1[0], v1[1]); w.w = cvt_pk_bf16(v1[2], v1[3]);
                        *(u32x4*)(rowp + bj * 128) = w; } } }
    }
};

__device__ __forceinline__ int moe_tables(const unsigned* cnt, LAS unsigned char* lds, int tid) {
    LAS int* tpre = (LAS int*)(lds + LDSCTL_OFF + 64); LAS int* ecnt = (LAS int*)(lds + LDSCTL_OFF + 256); LAS unsigned short* tile_e = (LAS unsigned short*)(lds + LDSCTL_OFF + 512);
    if (tid == 0) { int p = 0; for (int e = 0; e < 32; ++e) { const int cn = (int)__hip_atomic_load(cnt + e * CNT_STRIDE, __ATOMIC_RELAXED, __HIP_MEMORY_SCOPE_AGENT); ecnt[e] = cn; tpre[e] = p; p += (cn + 255) >> 8; } tpre[32] = p; }
    __syncthreads();
    const int nt = tpre[32];
    for (int t = tid; t < nt; t += 512) { int e = 0; while (e < 31 && t >= tpre[e + 1]) ++e; tile_e[t] = (unsigned short)e; }
    __syncthreads();
    return nt;
}

constexpr int NPHASES = 38;
typedef const Args __attribute__((address_space(4))) CArgs;
__global__ void __launch_bounds__(512, 2) fwd_kernel(Args a_) {
    extern __shared__ __attribute__((aligned(16))) unsigned char lds_raw[];
    LAS unsigned char* lds = (LAS unsigned char*)lds_raw;
    const int G = gridDim.x, NGW = G * 8;
    CArgs* ap0 = (CArgs*)__builtin_amdgcn_kernarg_segment_ptr();
    if (threadIdx.x < 4) ((LAS unsigned*)(lds + LDSCTL_OFF))[threadIdx.x] = 0u;
    __syncthreads();
    XcdBarrier bar = xcd_barrier_post((unsigned*)(a_.ws + WS_CTL) + CW_BAR, (volatile LAS unsigned*)(lds + LDSCTL_OFF));
    const int lo = a_.ph_lo, hi = a_.ph_hi;
    int ph = 0;
#ifndef MK_ONLY
#define MK_ONLY -1
#endif
#ifndef MK_DBL
#define MK_DBL 0
#endif
#define PH_BEGIN(id) if ((MK_ONLY < 0 || MK_ONLY == (id)) && ph >= lo && ph < hi) { for (int rep_ = 0; rep_ <= ((MK_DBL >> (id)) & 1); ++rep_) { CArgs* ap = ap0; asm volatile("" : "+s"(ap)); const Args a = *(const Args*)ap; unsigned char* const ws = a.ws; (void)ws; const int wave = (int)bar.wv; int tid = wave * 64 + lane_id(); asm volatile("" : "+v"(tid)); const int lane = tid & 63, gw = blockIdx.x * 8 + wave; (void)lane; (void)gw;
#define PH_END } } if (ph >= lo && ph + 1 < hi) xcd_barrier(bar); ++ph;

    PH_BEGIN(0) p0_prologue(a, lds, tid, lane, wave, G); PH_END

#pragma unroll 1
    for (int layer = 0; layer < DEPTH; ++layer) {
        const int kind = layer & 1, lj = layer >> 1;
        const int rows = layer == 3 ? TL : T, nmt = rows / 256;
        const int rows_moe = layer < 2 ? T : TL;
        if (kind == 0) {
            PH_BEGIN(1) phase_a_rwkv(a, layer, lds, tid, gw, NGW, lane); PH_END
            PH_BEGIN(2) {
                pg8::Gemm g{(const bf16*)(ws + WS_XL), (const bf16*)(ws + WS_WRKV) + (size_t)lj * 3840 * 1024, 6 * T, 3840, 1024};
                SchedB1 S{G, (int)blockIdx.x}; EpiB1 E{(bf16*)(ws + WS_RKV), (bf16*)(ws + WS_L1)};
                pg8::gemm_phase<EpiB1, SchedB1, true, true, false>(lds, g, S, E, tid); } PH_END
            PH_BEGIN(3) {
                pg8::Gemm g{(const bf16*)(ws + WS_L1), (const bf16*)(ws + WS_L2T) + (size_t)lj * 5120 * 256, 3 * T, 5120, 256};
                SchedB2 S{G, (int)blockIdx.x}; EpiB2 E{(bf16*)(ws + WS_RAWW), (bf16*)(ws + WS_RAWA), (bf16*)(ws + WS_G)};
                pg8::gemm_phase<EpiB2, SchedB2, true, true, false>(lds, g, S, E, tid); } PH_END
            PH_BEGIN(4) phase_c_prep(a, lj, lds, tid, gw, NGW, lane); PH_END
            PH_BEGIN(5) phase_s1_chunks(a, lds, tid, G); PH_END
            PH_BEGIN(15) phase_s2_chain(a, wave, lane, G); PH_END
            PH_BEGIN(6) phase_s3_readout(a, lj, layer == 2 ? TL : T, gw, NGW, lane); PH_END
        } else {
            PH_BEGIN(7) phase_a_conv(a, layer, rows, gw, NGW, lane); PH_END
            PH_BEGIN(8) {
                pg8::Gemm g{(const bf16*)(ws + WS_XL), (const bf16*)(ws + WS_WIN) + (size_t)lj * 3072 * 1024, rows, 3072, 1024};
                SchedStd S{G, (int)blockIdx.x, nmt, 12}; EpiWin E{(bf16*)(ws + WS_BG), (bf16*)(ws + WS_CUZ)};
                pg8::gemm_phase<EpiWin, SchedStd, true, true, false>(lds, g, S, E, tid); } PH_END
            PH_BEGIN(9) phase_cv(a, lj, rows, gw, NGW, lane); PH_END
        }
        PH_BEGIN(10) {
            const bf16* Wt = kind == 0 ? (const bf16*)(ws + WS_WO) + (size_t)lj * 1024 * 1024 : (const bf16*)(ws + WS_WOUT) + (size_t)lj * 1024 * 1024;
            pg8::Gemm g{(const bf16*)(ws + WS_Z), Wt, rows, 1024, 1024};
            SchedStd S{G, (int)blockIdx.x, layer == 2 ? NMT_L : nmt, 4}; EpiRes E{(float*)(ws + (layer < 2 ? WS_XSA : WS_XSB)), (const float*)(ws + WS_MODS) + (size_t)layer * 5 * 6144 + 2 * 1024, (float*)(ws + (rep_ ? WS_XL : (layer < 2 ? WS_XSA : WS_XSB)))};
            pg8::gemm_phase<EpiRes, SchedStd, true, true, false>(lds, g, S, E, tid); } PH_END
        PH_BEGIN(11) phase_e_route(a, layer, rows_moe, lds, tid, gw, NGW, lane, rep_); PH_END
        PH_BEGIN(12) {
            const int nt = __builtin_amdgcn_readfirstlane(moe_tables((const unsigned*)(ws + WS_CTL) + CW_CNT + layer * 32 * CNT_STRIDE, lds, tid));
            pg8::Gemm g{(const bf16*)(ws + WS_H2), (const bf16*)(ws + WS_WGU) + (size_t)layer * 32 * 2048 * 1024, 0, 0, 1024};
            SchedMoe S{G, (int)blockIdx.x, 8, nt, 2, lds, (const int*)(ws + WS_SLOTL)};
            EpiGU E{(bf16*)(ws + WS_INTER), a.in[30] + (size_t)layer * 32 * 2048};
            pg8::gemm_phase<EpiGU, SchedMoe, true, true, true>(lds, g, S, E, tid); } PH_END
        PH_BEGIN(13) {
            const int nt = __builtin_amdgcn_readfirstlane(moe_tables((const unsigned*)(ws + WS_CTL) + CW_CNT + layer * 32 * CNT_STRIDE, lds, tid));
            pg8::Gemm g{(const bf16*)(ws + WS_INTER), (const bf16*)(ws + WS_WDN) + (size_t)layer * 32 * 1024 * 1024, 0, 0, 1024};
            SchedMoe S{G, (int)blockIdx.x, 4, nt, 8, lds, (const int*)(ws + WS_SLOTL)};
            EpiDown E{(bf16*)(ws + WS_YS), a.in[32] + (size_t)layer * 32 * 1024, (const int*)(ws + WS_SLOTL), (const float*)(ws + WS_GATEL)};
            pg8::gemm_phase<EpiDown, SchedMoe, true, true, false>(lds, g, S, E, tid); } PH_END
    }
    PH_BEGIN(14) phase_final(a, gw, NGW, lane); PH_END
#undef PH_BEGIN
#undef PH_END
}

extern "C" void kernel_launch(void* const* d_in, const int* in_sizes, int n_in, void* d_out, int out_size, void* d_ws, size_t ws_size, hipStream_t stream) {
    static int grid = 0;
    if (grid == 0) {
        if (n_in != 33 || in_sizes[0] != TL * D || out_size != TL * D || ws_size < WS_END) { fprintf(stderr, "kernel_launch: unexpected problem (n_in %d, in0 %d, out %d, ws %zu < %zu)\n", n_in, n_in > 0 ? in_sizes[0] : -1, out_size, ws_size, (size_t)WS_END); grid = -1; return; }
        int dev = 0, cus = 0, per_cu = 0;
        if (hipGetDevice(&dev) != hipSuccess || hipDeviceGetAttribute(&cus, hipDeviceAttributeMultiprocessorCount, dev) != hipSuccess) { grid = -1; return; }
        if (hipFuncSetAttribute((const void*)fwd_kernel, hipFuncAttributeMaxDynamicSharedMemorySize, LDS_BYTES) != hipSuccess) { fprintf(stderr, "kernel_launch: hipFuncSetAttribute failed\n"); grid = -1; return; }
        if (hipOccupancyMaxActiveBlocksPerMultiprocessor(&per_cu, (const void*)fwd_kernel, 512, LDS_BYTES) != hipSuccess || per_cu < 1) fprintf(stderr, "kernel_launch: occupancy query says %d\n", per_cu);
        (void)hipGetLastError();
        grid = cus;
    }
    if (grid < 0) return;
    if (hipMemsetAsync((char*)d_ws + WS_CTL, 0, CTL_ZERO_BYTES, stream) != hipSuccess) return;
    Args a{};
    for (int i = 0; i < 33; ++i) a.in[i] = (const float*)d_in[i];
    a.out = (float*)d_out; a.ws = (unsigned char*)d_ws;
#if MK_PER_PHASE
    for (int p = 0; p < NPHASES; ++p) { a.ph_lo = p; a.ph_hi = p + 1; hipLaunchKernelGGL(fwd_kernel, dim3(grid), dim3(512), LDS_BYTES, stream, a); }
#else
    a.ph_lo = 0; a.ph_hi = NPHASES;
    hipLaunchKernelGGL(fwd_kernel, dim3(grid), dim3(512), LDS_BYTES, stream, a);
#endif
    const hipError_t le = hipPeekAtLastError();
    if (le != hipSuccess) fprintf(stderr, "kernel_launch: launch failed: %s\n", hipGetErrorName(le));
}
```

```cpp
#include <hip/hip_runtime.h>
#include <cstdio>
#include <cstdint>

#ifndef MK_PER_PHASE
#define MK_PER_PHASE 0
#endif

constexpr int D = 1024, NBATCH = 4, SEQ = 8192, TL = NBATCH * SEQ, CTXL = 256, TC = NBATCH * CTXL, T = TL + TC;
constexpr int NH = 16, HS = 64, NE = 32, TOPK = 4, DEPTH = 4;
constexpr int NMT = T / 256;
constexpr int NMT_L = TL / 256;
constexpr int MAXTILES = (T * TOPK) / 256 + NE;
constexpr int NSTEP = CTXL + SEQ;

__device__ __forceinline__ int lane_id() { return (int)__builtin_amdgcn_mbcnt_hi(~0u, __builtin_amdgcn_mbcnt_lo(~0u, 0u)); }
namespace pg8 {
#define PG8_LAS __attribute__((address_space(3)))
typedef unsigned short bf16_t;
typedef short bf16x8 __attribute__((ext_vector_type(8)));
typedef float f32x4 __attribute__((ext_vector_type(4)));
typedef unsigned u32x4 __attribute__((ext_vector_type(4)));
typedef unsigned u32x2 __attribute__((ext_vector_type(2)));
constexpr int BM = 256, BK = 64, HALF = 128, HTB = HALF * BK * 2  , STAGE_BYTES = 8 * HTB, NXCD = 8, WGM = 8;

__host__ __device__ __forceinline__ int lds_byte(int r, int c) { const int st = (r >> 4) * 2 + (c >> 5), rr = r & 15, cc = c & 31, ob = rr * 64 + cc * 2; return st * 1024 + (ob ^ (((ob >> 9) & 1) << 5)); }
__host__ __device__ __forceinline__ void stage_rc(int b, int& R, int& C) { const int st = b / 1024, sb = b % 1024, swz = sb ^ (((sb >> 9) & 1) << 5); R = (st >> 1) * 16 + swz / 64; C = (st & 1) * 32 + (swz % 64) / 2; }
__host__ __device__ __forceinline__ int perm32(int rho) { const int n = rho >> 4, i = rho & 15; return 8 * (i >> 2) + 4 * n + (i & 3); }

struct Unit { int pm, pn, e, nv; };
struct Gemm { const bf16_t* A; const bf16_t* Bt; int M, N, K; };

__device__ __forceinline__ void tile_map(int wgid, int nM, int nN, int& pm, int& pn) {
    const int nwg = nM * nN;
    { const int q = nwg / NXCD, r = nwg % NXCD, xcd = wgid % NXCD, off = wgid / NXCD; wgid = (xcd < r ? xcd * (q + 1) : r * (q + 1) + (xcd - r) * q) + off; }
    const int nig = WGM * nN, gid = wgid / nig, fm = gid * WGM, gsz = (nM - fm) < WGM ? (nM - fm) : WGM;
    pm = fm + ((wgid % nig) % gsz); pn = (wgid % nig) / gsz;
}
typedef __bf16 bf16x2_t __attribute__((ext_vector_type(2)));
typedef float f32x2_t __attribute__((ext_vector_type(2)));
__device__ __forceinline__ unsigned cvt_pk_bf16(float lo, float hi) { const f32x2_t v = {lo, hi}; const bf16x2_t b = __builtin_convertvector(v, bf16x2_t); return __builtin_bit_cast(unsigned, b); }

template <class Epi, class Sched, bool ALIGN_EPI = false, bool SP2 = false, bool GATHER = false>
__device__ __forceinline__ void gemm_phase(PG8_LAS unsigned char* lds, const Gemm g, const Sched& S, const Epi& E, int tid_in) {
    int tid_ = tid_in; asm volatile("" : "+v"(tid_));
    const int tid = tid_, wid = __builtin_amdgcn_readfirstlane(tid >> 6), lane = tid & 63, wr = wid >> 2, wc = wid & 3, fr = lane & 15, fq = lane >> 4;
    int K_ = g.K; asm volatile("" : "+s"(K_));
    const int K = K_, nt = K / BK;
    unsigned voffA[2], voffB[2]; int gR[2]; unsigned gC[2];
#pragma unroll
    for (int i = 0; i < 2; ++i) { int R, C; stage_rc(tid * 16 + i * 8192, R, C); const int Rb = Epi::PERM ? ((R & ~31) + perm32(R & 31)) : R;
        voffA[i] = (unsigned)(R * K + C) * 2u; voffB[i] = (unsigned)(Rb * K + C) * 2u; gR[i] = R; gC[i] = (unsigned)C * 2u; }
    unsigned oc[2][2], on[2][2], o2[2][2];
#pragma unroll
    for (int h = 0; h < 2; ++h)
#pragma unroll
        for (int i = 0; i < 2; ++i) { oc[h][i] = 0u; on[h][i] = 0u; o2[h][i] = 0u; }
    const size_t kstep = (size_t)(BK * 2);
    const size_t hstep = (size_t)HALF * K * 2;
    const size_t tstep = 2 * hstep;
    const unsigned ldsw = (unsigned)wid * 1024u;
    const int aoff = lds_byte(wr * 64 + fr, fq * 8), boff = lds_byte(wc * 32 + fr, fq * 8);
#define PG8_SA(b, h) (((b) * 2 + (h)) * HTB)
#define PG8_SB(b, h) ((4 + (b) * 2 + (h)) * HTB)
#define PG8_STAGE(bufoff, gbase, voff) do { _Pragma("unroll") for (int _i = 0; _i < 2; ++_i) \
        __builtin_amdgcn_global_load_lds((const unsigned*)((const char*)(gbase) + (voff)[_i]), (PG8_LAS unsigned*)(lds + (bufoff) + ldsw + _i * 8192), 16, 0, 0); } while (0)
#define PG8_STAGE_A(bufoff, base, h, O) do { if constexpr (GATHER) { PG8_STAGE(bufoff, base, (O)[h]); } else { PG8_STAGE(bufoff, (base) + (h) * hstep, voffA); } } while (0)
#define PG8_LDA(dst, b, h) do { _Pragma("unroll") for (int m = 0; m < 4; ++m) _Pragma("unroll") for (int k = 0; k < 2; ++k) dst[m][k] = *(const PG8_LAS bf16x8*)(lds + PG8_SA(b, h) + aoff + m * 2048 + k * 1024); } while (0)
#define PG8_LDB(dst, b, h) do { _Pragma("unroll") for (int n = 0; n < 2; ++n) _Pragma("unroll") for (int k = 0; k < 2; ++k) dst[n][k] = *(const PG8_LAS bf16x8*)(lds + PG8_SB(b, h) + boff + n * 2048 + k * 1024); } while (0)
#define PG8_MMA(ai, bj, At, Bt) do { __builtin_amdgcn_s_setprio(1); _Pragma("unroll") for (int m = 0; m < 4; ++m) _Pragma("unroll") for (int n = 0; n < 2; ++n) _Pragma("unroll") for (int k = 0; k < 2; ++k) \
        acc[ai][bj][m][n] = __builtin_amdgcn_mfma_f32_16x16x32_bf16(Bt[n][k], At[m][k], acc[ai][bj][m][n], 0, 0, 0); __builtin_amdgcn_s_setprio(0); } while (0)
#define PG8_WAIT_V(n) asm volatile("s_waitcnt vmcnt(" #n ")" ::: "memory")
#define PG8_WAIT_L(n) asm volatile("s_waitcnt lgkmcnt(" #n ")" ::: "memory")
#define PG8_BAR __builtin_amdgcn_s_barrier()
#define PG8_SCHED __builtin_amdgcn_sched_barrier(0)
    Unit cur, nxt; int ui = 0;
    if (!S.next(0, cur)) return;
    f32x4 acc[2][2][4][2];
#pragma unroll
    for (int a = 0; a < 2; ++a)
#pragma unroll
        for (int b = 0; b < 2; ++b)
#pragma unroll
            for (int m = 0; m < 4; ++m)
#pragma unroll
                for (int n = 0; n < 2; ++n) acc[a][b][m][n] = (f32x4){0.f, 0.f, 0.f, 0.f};
    bf16x8 At[4][2], B0[2][2], B1[2][2];
    const char* cA = GATHER ? (const char*)g.A : (const char*)g.A + (size_t)cur.pm * tstep; const char* cB = (const char*)g.Bt + (size_t)cur.pn * tstep;
    S.a_ready(cur);
    if constexpr (GATHER) {
#pragma unroll
        for (int h = 0; h < 2; ++h)
#pragma unroll
            for (int i = 0; i < 2; ++i) oc[h][i] = S.row_off(cur, h * HALF + gR[i]) + gC[i];
    }
    if constexpr (SP2) {
        PG8_STAGE(PG8_SB(0, 0), cB, voffB); PG8_STAGE(PG8_SB(0, 1), cB + hstep, voffB); PG8_STAGE_A(PG8_SA(0, 0), cA, 0, oc); PG8_STAGE_A(PG8_SA(0, 1), cA, 1, oc);
        if (wr == 1) PG8_BAR;
        PG8_WAIT_V(2); PG8_BAR;
        PG8_STAGE(PG8_SB(1, 0), cB + kstep, voffB); PG8_STAGE_A(PG8_SA(1, 0), cA + kstep, 0, oc); PG8_STAGE(PG8_SB(1, 1), cB + hstep + kstep, voffB);
        PG8_WAIT_V(6); PG8_BAR;
    } else {
        PG8_STAGE(PG8_SB(0, 0), cB, voffB); PG8_STAGE_A(PG8_SA(0, 0), cA, 0, oc); PG8_STAGE(PG8_SB(0, 1), cB + hstep, voffB); PG8_STAGE_A(PG8_SA(0, 1), cA, 1, oc);
        if (wr == 1) PG8_BAR;
        PG8_WAIT_V(4); PG8_BAR;
        PG8_STAGE(PG8_SB(1, 0), cB + kstep, voffB); PG8_STAGE_A(PG8_SA(1, 0), cA + kstep, 0, oc); PG8_STAGE(PG8_SB(1, 1), cB + hstep + kstep, voffB);
        PG8_WAIT_V(6); PG8_BAR;
    }
    for (;;) {
        const bool has_next = S.next(ui + 1, nxt);
        const char* nA = GATHER ? (const char*)g.A : (has_next ? (const char*)g.A + (size_t)nxt.pm * tstep : cA); const char* nB = has_next ? (const char*)g.Bt + (size_t)nxt.pn * tstep : cB;
        if constexpr (GATHER) {
#pragma unroll
            for (int h = 0; h < 2; ++h)
#pragma unroll
                for (int i = 0; i < 2; ++i) on[h][i] = has_next ? (S.row_off(nxt, h * HALF + gR[i]) + gC[i]) : oc[h][i];
        }
        for (int t = 0; t < nt; t += 2) {
            const bool last = (t == nt - 2);
            const char* a1 = cA + (size_t)(t + 1) * kstep;
            const char* a2 = last ? nA : cA + (size_t)(t + 2) * kstep; const char* b2 = last ? nB : cB + (size_t)(t + 2) * kstep;
            const char* a3 = a2 + kstep; const char* b3 = b2 + kstep;
            if constexpr (GATHER) {
#pragma unroll
                for (int h = 0; h < 2; ++h)
#pragma unroll
                    for (int i = 0; i < 2; ++i) o2[h][i] = last ? on[h][i] : oc[h][i];
            }
            if (last && has_next) S.a_ready(nxt);
            if constexpr (SP2) {
            PG8_LDB(B0, 0, 0); PG8_LDB(B1, 0, 1); PG8_SCHED; PG8_LDA(At, 0, 0); PG8_STAGE_A(PG8_SA(1, 1), a1, 1, oc);
            PG8_WAIT_V(8); PG8_WAIT_L(0); PG8_BAR; PG8_MMA(0, 0, At, B0); PG8_MMA(0, 1, At, B1); PG8_BAR; PG8_SCHED;
            PG8_LDA(At, 0, 1); PG8_STAGE(PG8_SB(0, 0), b2, voffB); PG8_STAGE(PG8_SB(0, 1), b2 + hstep, voffB); PG8_STAGE_A(PG8_SA(0, 0), a2, 0, o2);
            PG8_WAIT_V(8); PG8_WAIT_L(0); PG8_BAR; PG8_MMA(1, 0, At, B0); PG8_MMA(1, 1, At, B1); PG8_BAR; PG8_SCHED;
            PG8_LDB(B0, 1, 0); PG8_LDB(B1, 1, 1); PG8_SCHED; PG8_LDA(At, 1, 0); PG8_STAGE_A(PG8_SA(0, 1), a2, 1, o2);
            PG8_WAIT_V(8); PG8_WAIT_L(0); PG8_BAR; PG8_MMA(0, 0, At, B0); PG8_MMA(0, 1, At, B1); PG8_BAR; PG8_SCHED;
            PG8_LDA(At, 1, 1); PG8_STAGE(PG8_SB(1, 0), b3, voffB); PG8_STAGE(PG8_SB(1, 1), b3 + hstep, voffB); PG8_STAGE_A(PG8_SA(1, 0), a3, 0, o2);
            PG8_WAIT_V(8); PG8_WAIT_L(0); PG8_BAR; PG8_MMA(1, 0, At, B0); PG8_MMA(1, 1, At, B1); PG8_BAR; PG8_SCHED;
            } else {
            PG8_LDB(B0, 0, 0); PG8_SCHED; PG8_LDA(At, 0, 0); PG8_STAGE_A(PG8_SA(1, 1), a1, 1, oc);
            PG8_WAIT_L(8); PG8_BAR; PG8_WAIT_L(0); PG8_MMA(0, 0, At, B0); PG8_BAR; PG8_SCHED;
            PG8_LDB(B1, 0, 1); PG8_STAGE(PG8_SB(0, 0), b2, voffB);
            PG8_BAR; PG8_WAIT_L(0); PG8_MMA(0, 1, At, B1); PG8_BAR;
            PG8_LDA(At, 0, 1); PG8_STAGE_A(PG8_SA(0, 0), a2, 0, o2);
            PG8_BAR; PG8_WAIT_L(0); PG8_MMA(1, 0, At, B0); PG8_BAR; PG8_SCHED;
            PG8_STAGE(PG8_SB(0, 1), b2 + hstep, voffB);
            PG8_WAIT_V(6); PG8_BAR; PG8_MMA(1, 1, At, B1); PG8_BAR;
            PG8_LDB(B0, 1, 0); PG8_SCHED; PG8_LDA(At, 1, 0); PG8_STAGE_A(PG8_SA(0, 1), a2, 1, o2);
            PG8_WAIT_L(8); PG8_BAR; PG8_WAIT_L(0); PG8_MMA(0, 0, At, B0); PG8_BAR; PG8_SCHED;
            PG8_LDB(B1, 1, 1); PG8_STAGE(PG8_SB(1, 0), b3, voffB);
            PG8_BAR; PG8_WAIT_L(0); PG8_MMA(0, 1, At, B1); PG8_BAR;
            PG8_LDA(At, 1, 1); PG8_STAGE_A(PG8_SA(1, 0), a3, 0, o2);
            PG8_BAR; PG8_WAIT_L(0); PG8_MMA(1, 0, At, B0); PG8_BAR; PG8_SCHED;
            PG8_STAGE(PG8_SB(1, 1), b3 + hstep, voffB);
            PG8_WAIT_V(6); PG8_BAR; PG8_MMA(1, 1, At, B1); PG8_BAR;
            }
        }
        if constexpr (ALIGN_EPI) { if (wr == 0) PG8_BAR; }
        if constexpr (!Epi::AFTER_DRAIN) { E(acc, cur, wr, wc, fr, fq); S.done(cur); }
        if (!has_next) break;
#pragma unroll
        for (int a = 0; a < 2; ++a)
#pragma unroll
            for (int b = 0; b < 2; ++b)
#pragma unroll
                for (int m = 0; m < 4; ++m)
#pragma unroll
                    for (int n = 0; n < 2; ++n) acc[a][b][m][n] = (f32x4){0.f, 0.f, 0.f, 0.f};
        cur = nxt; cA = nA; cB = nB; ++ui;
        if constexpr (GATHER) {
#pragma unroll
            for (int h = 0; h < 2; ++h)
#pragma unroll
                for (int i = 0; i < 2; ++i) oc[h][i] = on[h][i];
        }
        if constexpr (ALIGN_EPI) { if (wr == 1) PG8_BAR; }
    }
    PG8_WAIT_V(0);
    if constexpr (!ALIGN_EPI) { if (wr == 0) PG8_BAR; }
    PG8_BAR;
    if constexpr (Epi::AFTER_DRAIN) { E.fused(acc, cur, wr, wc, fr, fq, lds, wid, lane); S.done(cur); }
#undef PG8_SA
#undef PG8_SB
#undef PG8_STAGE
#undef PG8_STAGE_A
#undef PG8_LDA
#undef PG8_LDB
#undef PG8_MMA
#undef PG8_WAIT_V
#undef PG8_WAIT_L
#undef PG8_BAR
#undef PG8_SCHED
}
}

#define LAS __attribute__((address_space(3)))
typedef unsigned short bf16;
typedef float f32x4 __attribute__((ext_vector_type(4)));
typedef unsigned u32x2 __attribute__((ext_vector_type(2)));
typedef unsigned u32x4 __attribute__((ext_vector_type(4)));
#define LDS_WAIT() asm volatile("s_waitcnt lgkmcnt(0)" ::: "memory")
__device__ __forceinline__ unsigned pk2(float lo, float hi) { return pg8::cvt_pk_bf16(lo, hi); }
__device__ __forceinline__ unsigned f2bf(float f) { return pk2(f, f) & 0xffffu; }
__device__ __forceinline__ float bflo(unsigned w) { return __builtin_bit_cast(float, w << 16); }
__device__ __forceinline__ float bfhi(unsigned w) { return __builtin_bit_cast(float, w & 0xffff0000u); }
__device__ __forceinline__ float wave_sum(float v) {
#pragma unroll
    for (int o = 1; o < 64; o <<= 1) v += __shfl_xor(v, o);
    return v;
}
__device__ __forceinline__ float sigm(float x) { return 1.0f / (1.0f + __expf(-x)); }
__device__ __forceinline__ float tanh_fast(float x) { const float e = __expf(2.0f * x); return 1.0f - 2.0f / (e + 1.0f); }

constexpr size_t MiB = 1u << 20;
constexpr size_t RF = (size_t)T * D * 4;
constexpr size_t RB = (size_t)T * D * 2;
constexpr size_t WS_CTL = 0, CTL_ZERO_BYTES = 1 * MiB;
constexpr size_t WS_MODS = 1 * MiB;
constexpr size_t WS_XSA = 2 * MiB, WS_XSB = WS_XSA + RF;
constexpr size_t WS_XL = WS_XSB + RF;
constexpr size_t WS_RKV = WS_XL + 6 * RB;
constexpr size_t WS_L1 = WS_RKV + 3 * RF;
constexpr size_t WS_WDEC = WS_L1 + 50 * MiB;
constexpr size_t WS_AA = WS_WDEC + 2 * RF;
constexpr size_t WS_G = WS_AA + 2 * RF;
constexpr size_t WS_KK = WS_G + RB;
constexpr size_t WS_KD = WS_KK + RF;
constexpr size_t WS_BETA = WS_KD + 2 * RF;
constexpr size_t WS_RKB = WS_BETA + 2 * RF;
constexpr size_t WS_C12 = WS_RKB + 3 * MiB;
constexpr size_t WS_Y = WS_C12 + 9 * MiB;
constexpr size_t WS_Z = WS_Y + 2 * RF;
constexpr size_t WS_H2 = WS_Z + RB;
constexpr size_t WS_SLOTL = WS_H2 + RB;
constexpr size_t WS_GATEL = WS_SLOTL + 5 * MiB;
constexpr size_t WS_WRKV = WS_GATEL + 5 * MiB;
constexpr size_t WS_L2T = WS_WRKV + 15 * MiB;
constexpr size_t WS_WO = WS_L2T + 5 * MiB;
constexpr size_t WS_WIN = WS_WO + 4 * MiB;
constexpr size_t WS_WOUT = WS_WIN + 12 * MiB;
constexpr size_t WS_WGU = WS_WOUT + 4 * MiB;
constexpr size_t WS_WDN = WS_WGU + 512 * MiB;
constexpr size_t WS_END = WS_WDN + 256 * MiB;
constexpr size_t WS_INTER = WS_WDEC;
constexpr size_t WS_YS = WS_KD;
constexpr size_t WS_BG = WS_RKV, WS_CUZ = WS_RKV + RB;
constexpr size_t WS_RAWW = WS_AA, WS_RAWA = WS_AA + RF;
constexpr size_t WS_RH = WS_AA;
constexpr size_t WS_PM = WS_AA + RF;
constexpr size_t WS_QT = WS_XL;
constexpr size_t WS_HT = WS_XL + RF;
static_assert((size_t)128 * 132 * 4096 * 2 <= RF, "chunk state tensors");
static_assert((size_t)MAXTILES * 256 * 1024 * 2 <= 4 * RF, "INTER overlay");
static_assert((size_t)T * 4 * 1024 * 2 <= 2 * RF, "YS overlay");
static_assert((size_t)3 * T * 256 * 2 <= 50 * MiB, "L1OUT");
constexpr int CW_BAR = 4096;
constexpr int CW_CNT = 16384, CNT_STRIDE = 64;

constexpr int RING_BYTES = 131072;
constexpr int LDSCTL_OFF = RING_BYTES;
constexpr int LDS_BYTES = 147456;

struct Args { const float* in[33]; float* out; unsigned char* ws; int ph_lo, ph_hi; };

__device__ __forceinline__ void transpose_item(const float* W, int N, bf16* WT, int dstK, int drow0, int k0, int n0, LAS float* scr, int lane) {
    float tv[32];
#pragma unroll
    for (int i = 0; i < 32; ++i) { const int kk = 2 * i + (lane >> 5); tv[i] = W[(size_t)(k0 + kk) * N + n0 + (lane & 31)]; }
#pragma unroll
    for (int i = 0; i < 32; ++i) { const int kk = 2 * i + (lane >> 5); scr[kk * 33 + (lane & 31)] = tv[i]; }
    LDS_WAIT(); asm volatile("" ::: "memory");
    const int c = lane & 7;
#pragma unroll
    for (int j = 0; j < 4; ++j) { const int n = (lane >> 3) + 8 * j; const LAS float* s = scr + (8 * c) * 33 + n;
        u32x4 o; o.x = pk2(s[0 * 33], s[1 * 33]); o.y = pk2(s[2 * 33], s[3 * 33]); o.z = pk2(s[4 * 33], s[5 * 33]); o.w = pk2(s[6 * 33], s[7 * 33]);
        *(u32x4*)(WT + (size_t)(drow0 + n) * dstK + k0 + 8 * c) = o; }
    LDS_WAIT(); asm volatile("" ::: "memory");
}
__device__ __forceinline__ int gu_map(int n0) { const int bj = n0 >= 1024 ? 1 : 0, f0 = n0 - bj * 1024; return (f0 >> 7) * 256 + bj * 128 + (f0 & 127); }
__device__ __forceinline__ int conv_map(int n0) { if (n0 < 1024) return n0; const int q = (n0 - 1024) >> 10, f0 = (n0 - 1024) & 1023; return 1024 + (f0 >> 7) * 256 + q * 128 + (f0 & 127); }

__device__ __forceinline__ void p0_prologue(const Args& a, LAS unsigned char* lds, int tid, int lane, int wave, int G) {
    unsigned char* ws = a.ws;
    LAS float* sl = (LAS float*)lds;
    LAS float* red = (LAS float*)(lds + 20480);
    for (int i = tid; i < 5 * 1024; i += 512) { const int r = i >> 10, k = i & 1023; const float cv = r < 4 ? a.in[1][r * 1024 + k] : a.in[3][k]; sl[i] = cv / (1.0f + __expf(-cv)); }
    __syncthreads();
    float* MODS = (float*)(ws + WS_MODS);
    for (int it = blockIdx.x; it < 4 * 96; it += G) {
        const int l = it / 96, n = (it % 96) * 64 + lane;
        const float* W = a.in[4] + (size_t)l * 1024 * 6144 + n;
        float acc[5] = {0.f, 0.f, 0.f, 0.f, 0.f};
        const int kb = wave * 128;
#pragma unroll 8
        for (int k = 0; k < 128; ++k) { const float wv = W[(size_t)(kb + k) * 6144];
#pragma unroll
            for (int r = 0; r < 5; ++r) acc[r] += sl[r * 1024 + kb + k] * wv; }
#pragma unroll
        for (int r = 0; r < 5; ++r) red[(wave * 5 + r) * 64 + lane] = acc[r];
        __syncthreads();
        if (wave < 5) { float s = a.in[5][l * 6144 + n];
#pragma unroll
            for (int w = 0; w < 8; ++w) s += red[(w * 5 + wave) * 64 + lane];
            MODS[(size_t)(l * 5 + wave) * 6144 + n] = s; }
        __syncthreads();
    }
    LAS float* scr = (LAS float*)(lds + 32768 + wave * 8448);
    const int gw = blockIdx.x * 8 + wave, NGW = G * 8;
    bf16* WRKV = (bf16*)(ws + WS_WRKV); bf16* WOt = (bf16*)(ws + WS_WO); bf16* WINt = (bf16*)(ws + WS_WIN); bf16* WOUTt = (bf16*)(ws + WS_WOUT);
    bf16* WGU = (bf16*)(ws + WS_WGU); bf16* WDN = (bf16*)(ws + WS_WDN);
    constexpr int I_GU = 128 * 1024, I_DN = 128 * 512, I_RKV = 6 * 512, I_WO = 2 * 512, I_WIN = 2 * 1536, I_WOUT = 2 * 512, I_W1 = 4 * 32, I_A1 = 4 * 32, I_G1 = 2 * 64;
    constexpr int NITEMS = I_GU + I_DN + I_RKV + I_WO + I_WIN + I_WOUT + I_W1 + I_A1 + I_G1;
    for (int it = gw; it < NITEMS; it += NGW) {
        int r = it;
        if (r < I_GU) { const int m = r >> 10, q = r & 1023, kb = q >> 6, nb = q & 63;
            transpose_item(a.in[29] + (size_t)m * 1024 * 2048, 2048, WGU + (size_t)m * 2048 * 1024, 1024, gu_map(nb * 32), kb * 64, nb * 32, scr, lane); continue; } r -= I_GU;
        if (r < I_DN) { const int m = r >> 9, q = r & 511, kb = q >> 5, nb = q & 31;
            transpose_item(a.in[31] + (size_t)m * 1024 * 1024, 1024, WDN + (size_t)m * 1024 * 1024, 1024, nb * 32, kb * 64, nb * 32, scr, lane); continue; } r -= I_DN;
        if (r < I_RKV) { const int m = r >> 9, q = r & 511, kb = q >> 5, nb = q & 31, lr = m / 3, j = m % 3;
            transpose_item(a.in[9] + (size_t)m * 1024 * 1024, 1024, WRKV + (size_t)lr * 3840 * 1024, 1024, j * 1024 + nb * 32, kb * 64, nb * 32, scr, lane); continue; } r -= I_RKV;
        if (r < I_WO) { const int m = r >> 9, q = r & 511, kb = q >> 5, nb = q & 31;
            transpose_item(a.in[23] + (size_t)m * 1024 * 1024, 1024, WOt + (size_t)m * 1024 * 1024, 1024, nb * 32, kb * 64, nb * 32, scr, lane); continue; } r -= I_WO;
        if (r < I_WIN) { const int m = r / 1536, q = r % 1536, kb = q / 96, nb = q % 96;
            transpose_item(a.in[24] + (size_t)m * 1024 * 3072, 3072, WINt + (size_t)m * 3072 * 1024, 1024, conv_map(nb * 32), kb * 64, nb * 32, scr, lane); continue; } r -= I_WIN;
        if (r < I_WOUT) { const int m = r >> 9, q = r & 511, kb = q >> 5, nb = q & 31;
            transpose_item(a.in[26] + (size_t)m * 1024 * 1024, 1024, WOUTt + (size_t)m * 1024 * 1024, 1024, nb * 32, kb * 64, nb * 32, scr, lane); continue; } r -= I_WOUT;
        if (r < I_W1) { const int m = r >> 5, q = r & 31, kb = q >> 1, nb = q & 1, lr = m >> 1, e = m & 1;
            transpose_item(a.in[11] + (size_t)m * 1024 * 64, 64, WRKV + (size_t)lr * 3840 * 1024, 1024, 3072 + e * 64 + nb * 32, kb * 64, nb * 32, scr, lane); continue; } r -= I_W1;
        if (r < I_A1) { const int m = r >> 5, q = r & 31, kb = q >> 1, nb = q & 1, lr = m >> 1, e = m & 1;
            transpose_item(a.in[14] + (size_t)m * 1024 * 64, 64, WRKV + (size_t)lr * 3840 * 1024, 1024, 3328 + e * 64 + nb * 32, kb * 64, nb * 32, scr, lane); continue; } r -= I_A1;
        { const int m = r >> 6, q = r & 63, kb = q >> 2, nb = q & 3;
            transpose_item(a.in[16] + (size_t)m * 1024 * 128, 128, WRKV + (size_t)m * 3840 * 1024, 1024, 3584 + nb * 32, kb * 64, nb * 32, scr, lane); }
    }
    const int gt = blockIdx.x * 512 + tid, NGT = G * 512;
    for (int i = gt; i < 2 * 3 * 128 * 128; i += NGT) {
        const int pc = i & 127, rw = (i >> 7) & 127, pd = (i >> 14) % 3, lr = i / (3 * 16384);
        *(u32x4*)(WRKV + ((size_t)lr * 3840 + 3072 + pd * 256 + 128 + rw) * 1024 + pc * 8) = (u32x4){0u, 0u, 0u, 0u}; }
    bf16* L2T = (bf16*)(ws + WS_L2T);
    for (int i = gt; i < 2 * 128 * 5120; i += NGT) {
        const int n = i % 5120, k = (i / 5120) & 127, lr = i / (5120 * 128);
        float v = 0.f;
        if (n < 2048) { const int e = n >> 10, d = n & 1023; if ((k >> 6) == e) v = a.in[12][(((size_t)lr * 2 + e) * 64 + (k & 63)) * 1024 + d]; }
        else if (n < 4096) { const int e = (n - 2048) >> 10, d = n & 1023; if ((k >> 6) == e) v = a.in[15][(((size_t)lr * 2 + e) * 64 + (k & 63)) * 1024 + d]; }
        else { const int d = n - 4096; v = a.in[17][((size_t)lr * 128 + k) * 1024 + d]; }
        L2T[((size_t)lr * 5120 + n) * 128 + k] = (bf16)f2bf(v);
    }
}
#define XB_TMO      128
#define XB_XCNT(j)  (256  + 64 * (j))
#define XB_XSUB(j)  (1280 + 64 * (j))
#define XB_XGEN(j)  (2304 + 64 * (j))
#define XB_TOP      3328
#define XB_TOPGEN   3392
#define XCD_BAR_WORDS 3456
#define XB_SPIN_CAP (1u << 23)

__device__ __forceinline__ unsigned xb_ld(unsigned* p)              { return __hip_atomic_load(p, __ATOMIC_RELAXED, __HIP_MEMORY_SCOPE_AGENT); }
__device__ __forceinline__ unsigned xb_add(unsigned* p, unsigned v) { return __hip_atomic_fetch_add(p, v, __ATOMIC_RELAXED, __HIP_MEMORY_SCOPE_AGENT); }
__device__ __forceinline__ unsigned xb_xcc_id() { return (unsigned)__builtin_amdgcn_s_getreg((3 << 11) | 20) & 0xFu; }
#define XB_SPIN(cond, bar) do { unsigned _sp = 0; while (cond) { __builtin_amdgcn_s_sleep(1); \
    if ((++_sp & 255u) == 0u) { if (xb_ld(&(bar)[XB_TMO])) break; if (_sp > XB_SPIN_CAP) { atomicAdd(&(bar)[XB_TMO], 1u); break; } } } } while (0)

struct XcdBarrier {
    unsigned wv;
    unsigned* bar; unsigned x;
    volatile LAS unsigned* st;
};

__device__ __forceinline__ XcdBarrier xcd_barrier_post(unsigned* bar, volatile LAS unsigned* st) {
    XcdBarrier b; b.wv = (unsigned)__builtin_amdgcn_readfirstlane((int)(threadIdx.x >> 6)); b.bar = bar; b.x = xb_xcc_id(); b.st = st;
    if (threadIdx.x == 0) (void)xb_add(&bar[XB_XCNT(b.x)], 1u);
    return b;
}
__device__ __forceinline__ void xcd_barrier_complete(unsigned* bar, unsigned x, unsigned& nloc, unsigned& nx) {
    const unsigned G = gridDim.x * gridDim.y * gridDim.z;
    unsigned sum, cnt, mine, sp = 0u;
    for (;;) {
        sum = 0u; cnt = 0u; mine = 0u;
#pragma unroll
        for (unsigned j = 0; j < 16; ++j) { const unsigned c = xb_ld(&bar[XB_XCNT(j)]); sum += c; cnt += (c > 0u) ? 1u : 0u; mine = (j == x) ? c : mine; }
        if (sum == G) break;
        __builtin_amdgcn_s_sleep(1);
        if ((++sp & 255u) == 0u) { if (xb_ld(&bar[XB_TMO])) break; if (sp > XB_SPIN_CAP) { atomicAdd(&bar[XB_TMO], 1u); break; } }
    }
    nloc = mine > 0u ? mine : 1u; nx = cnt > 0u ? cnt : 1u;
}

__device__ __forceinline__ void xcd_barrier(const XcdBarrier& b) {
    asm volatile("s_waitcnt vmcnt(0)" ::: "memory");
    __syncthreads();
    if (b.wv == 0u && lane_id() == 0) {
        unsigned* bar = b.bar;
        __builtin_amdgcn_s_waitcnt(0);
        unsigned nloc = b.st[0], nx = b.st[1];
        if (nloc == 0u) { xcd_barrier_complete(bar, b.x, nloc, nx); b.st[0] = nloc; b.st[1] = nx; }
        const unsigned old = xb_add(&bar[XB_XSUB(b.x)], 1u);
        const unsigned gen = old / nloc;
        if (old + 1u == (gen + 1u) * nloc) {
            __builtin_amdgcn_fence(__ATOMIC_RELEASE, "agent");
            asm volatile("s_waitcnt vmcnt(0)" ::: "memory");
            const unsigned og = xb_add(&bar[XB_TOP], 1u);
            const unsigned tg = og / nx;
            if (og + 1u == (tg + 1u) * nx) xb_add(&bar[XB_TOPGEN], 1u);
            else XB_SPIN(xb_ld(&bar[XB_TOPGEN]) == tg, bar);
            __builtin_amdgcn_fence(__ATOMIC_ACQUIRE, "agent");
            xb_add(&bar[XB_XGEN(b.x)], 1u);
            asm volatile("s_waitcnt vmcnt(0)" ::: "memory");
        } else {
            XB_SPIN(xb_ld(&bar[XB_XGEN(b.x)]) == gen, bar);
            __builtin_amdgcn_fence(__ATOMIC_ACQUIRE, "agent");
            asm volatile("s_waitcnt vmcnt(0)" ::: "memory");
        }
    }
    __syncthreads();
}

__device__ __forceinline__ int mod_row(int row) { return row < TL ? (row >> 13) : 4; }

__device__ __forceinline__ void load_x_combined(f32x4 (&x)[4], const float* xrow, bool has_prev, const bf16* YS, int t, const f32x4 (&m5)[4], int lane) {
#pragma unroll
    for (int j = 0; j < 4; ++j) x[j] = *(const f32x4*)(xrow + 256 * j + 4 * lane);
    if (has_prev) {
        f32x4 s[4];
#pragma unroll
        for (int j = 0; j < 4; ++j) s[j] = (f32x4){0.f, 0.f, 0.f, 0.f};
#pragma unroll
        for (int k = 0; k < 4; ++k) { const bf16* yr = YS + ((size_t)t * 4 + k) * 1024;
#pragma unroll
            for (int j = 0; j < 4; ++j) { const u32x2 w = *(const u32x2*)(yr + 256 * j + 4 * lane); s[j] += (f32x4){bflo(w.x), bfhi(w.x), bflo(w.y), bfhi(w.y)}; } }
#pragma unroll
        for (int j = 0; j < 4; ++j) x[j] += m5[j] * s[j];
    }
}
__device__ __forceinline__ float row_rstd(const f32x4 (&x)[4]) {
    float ss = 0.f;
#pragma unroll
    for (int j = 0; j < 4; ++j) ss += (x[j].x * x[j].x + x[j].y * x[j].y) + (x[j].z * x[j].z + x[j].w * x[j].w);
    return rsqrtf(wave_sum(ss) * (1.0f / 1024.0f) + 1e-6f);
}

__device__ __forceinline__ void phase_a_rwkv(const Args& a, int layer, LAS unsigned char* lds, int tid, int gw, int NGW, int lane) {
    unsigned char* ws = a.ws; const int lj = layer >> 1; const bool has_prev = layer > 0;
    const float* xin_lat = layer == 0 ? a.in[0] : (const float*)(ws + WS_XSA);
    const float* xin_ctx = layer == 0 ? a.in[2] : (const float*)(ws + WS_XSA) + (size_t)TL * D;
    float* xout = (float*)(ws + (layer == 0 ? WS_XSA : WS_XSB));
    const float* MODS = (const float*)(ws + WS_MODS); const bf16* YS = (const bf16*)(ws + WS_YS); bf16* XL = (bf16*)(ws + WS_XL);
    const float* mug = a.in[8] + (size_t)lj * 6 * 2 * 1024; const float* ng = a.in[6] + (size_t)(layer * 2 + 0) * 1024;
    LAS float* mu = (LAS float*)lds;
    for (int i = tid; i < 6 * 2 * 1024 / 4; i += 512) ((LAS f32x4*)mu)[i] = ((const f32x4*)mug)[i];
    __syncthreads();
    for (int it = gw; it < TL / 8 + TC / 2; it += NGW) {
        const int ntok = it < TL / 8 ? 8 : 2, t0 = it < TL / 8 ? it * 8 : TL + (it - TL / 8) * 2, mr = mod_row(t0);
        int rs, re; if (t0 < TL) { rs = t0 & ~63; re = rs + 63; } else { const int loc = t0 - TL; rs = TL + (loc & ~255); re = rs + 255; }
        const float* mod = MODS + (size_t)(layer * 5 + mr) * 6144;
        const float* m5p = MODS + (size_t)((has_prev ? layer - 1 : 0) * 5 + mr) * 6144 + 5 * 1024;
        f32x4 hm[4], h0[4], hp[4];
#pragma unroll
        for (int j = 0; j < 4; ++j) { hm[j] = (f32x4){0.f, 0.f, 0.f, 0.f}; h0[j] = hm[j]; hp[j] = hm[j]; }
        f32x4 rx[4], nx[4]; u32x2 ry[4][4], ny[4][4];
#define PA_LOAD(X, Y, tt) do { const int t_ = (tt); if (t_ >= rs && t_ <= re) { \
            const float* xrow_ = t_ < TL ? xin_lat + (size_t)t_ * D : xin_ctx + (size_t)(t_ - TL) * D; \
            _Pragma("unroll") for (int j = 0; j < 4; ++j) X[j] = *(const f32x4*)(xrow_ + 256 * j + 4 * lane); \
            if (has_prev) { _Pragma("unroll") for (int k = 0; k < 4; ++k) _Pragma("unroll") for (int j = 0; j < 4; ++j) Y[k][j] = *(const u32x2*)(YS + ((size_t)t_ * 4 + k) * 1024 + 256 * j + 4 * lane); } } } while (0)
#pragma unroll
        for (int j = 0; j < 4; ++j) { rx[j] = (f32x4){0.f, 0.f, 0.f, 0.f}; nx[j] = rx[j];
#pragma unroll
            for (int k = 0; k < 4; ++k) { ry[k][j] = (u32x2){0u, 0u}; ny[k][j] = ry[k][j]; } }
        PA_LOAD(rx, ry, t0 - 1);
#pragma unroll 1
        for (int i = -1; i <= ntok; ++i) {
            const int t = t0 + i;
            if (i < ntok) PA_LOAD(nx, ny, t + 1);
            f32x4 hn[4];
            if (t >= rs && t <= re) {
                f32x4 x[4];
#pragma unroll
                for (int j = 0; j < 4; ++j) x[j] = rx[j];
                if (has_prev) {
#pragma unroll
                    for (int j = 0; j < 4; ++j) { f32x4 sm = (f32x4){0.f, 0.f, 0.f, 0.f};
#pragma unroll
                        for (int k = 0; k < 4; ++k) sm += (f32x4){bflo(ry[k][j].x), bfhi(ry[k][j].x), bflo(ry[k][j].y), bfhi(ry[k][j].y)};
                        x[j] += *(const f32x4*)(m5p + 256 * j + 4 * lane) * sm; } }
                if (i >= 0 && i < ntok) {
#pragma unroll
                    for (int j = 0; j < 4; ++j) *(f32x4*)(xout + (size_t)t * D + 256 * j + 4 * lane) = x[j]; }
                const float rstd = row_rstd(x);
#pragma unroll
                for (int j = 0; j < 4; ++j) { const int col = 256 * j + 4 * lane; hn[j] = x[j] * rstd * *(const f32x4*)(ng + col) * (*(const f32x4*)(mod + 1024 + col) + 1.0f) + *(const f32x4*)(mod + col); }
            } else {
#pragma unroll
                for (int j = 0; j < 4; ++j) hn[j] = (f32x4){0.f, 0.f, 0.f, 0.f};
            }
#pragma unroll
            for (int j = 0; j < 4; ++j) { hm[j] = h0[j]; h0[j] = hp[j]; hp[j] = hn[j]; rx[j] = nx[j];
#pragma unroll
                for (int k = 0; k < 4; ++k) ry[k][j] = ny[k][j]; }
            if (i >= 1) {
                const int te = t - 1;
#pragma unroll
                for (int q = 0; q < 6; ++q) {
                    bf16* orow = XL + ((size_t)q * T + te) * D;
#pragma unroll
                    for (int j = 0; j < 4; ++j) { const int col = 256 * j + 4 * lane;
                        const f32x4 m0 = *(const LAS f32x4*)(mu + (q * 2 + 0) * 1024 + col), m1 = *(const LAS f32x4*)(mu + (q * 2 + 1) * 1024 + col);
                        const f32x4 o = h0[j] + m0 * (hm[j] - h0[j]) + m1 * (hp[j] - h0[j]);
                        u32x2 w; w.x = pk2(o.x, o.y); w.y = pk2(o.z, o.w); *(u32x2*)(orow + col) = w; }
                }
            }
        }
#undef PA_LOAD
    }
}
__device__ __forceinline__ void phase_a_conv(const Args& a, int layer, int rows, int gw, int NGW, int lane) {
    unsigned char* ws = a.ws;
    float* xs = (float*)(ws + (layer < 2 ? WS_XSA : WS_XSB));
    const float* MODS = (const float*)(ws + WS_MODS); const bf16* YS = (const bf16*)(ws + WS_YS); bf16* H = (bf16*)(ws + WS_XL);
    const float* ng = a.in[6] + (size_t)(layer * 2 + 0) * 1024;
    for (int t = gw; t < rows; t += NGW) {
        const int mr = mod_row(t);
        const float* mod = MODS + (size_t)(layer * 5 + mr) * 6144;
        f32x4 m5[4], x[4];
#pragma unroll
        for (int j = 0; j < 4; ++j) m5[j] = *(const f32x4*)(MODS + (size_t)((layer - 1) * 5 + mr) * 6144 + 5 * 1024 + 256 * j + 4 * lane);
        load_x_combined(x, xs + (size_t)t * D, true, YS, t, m5, lane);
        const float rstd = row_rstd(x);
#pragma unroll
        for (int j = 0; j < 4; ++j) { const int col = 256 * j + 4 * lane;
            *(f32x4*)(xs + (size_t)t * D + col) = x[j];
            const f32x4 h = x[j] * rstd * *(const f32x4*)(ng + col) * (*(const f32x4*)(mod + 1024 + col) + 1.0f) + *(const f32x4*)(mod + col);
            u32x2 w; w.x = pk2(h.x, h.y); w.y = pk2(h.z, h.w); *(u32x2*)(H + (size_t)t * D + col) = w; }
    }
}
#define DPPF(x, ctrl) __builtin_bit_cast(float, __builtin_amdgcn_update_dpp(0, __builtin_bit_cast(int, (x)), (ctrl), 0xf, 0xf, false))
__device__ __forceinline__ float row16_sum(float v) { v += DPPF(v, 0xB1); v += DPPF(v, 0x4E); v += DPPF(v, 0x141); v += DPPF(v, 0x140); return v; }
__device__ __forceinline__ f32x4 bf4(u32x2 w) { return (f32x4){bflo(w.x), bfhi(w.x), bflo(w.y), bfhi(w.y)}; }
__device__ __forceinline__ u32x2 pk4(f32x4 v) { u32x2 w; w.x = pk2(v[0], v[1]); w.y = pk2(v[2], v[3]); return w; }
__device__ __forceinline__ void phase_c_prep(const Args& a, int lj, LAS unsigned char* lds, int tid, int gw, int NGW, int lane) {
    unsigned char* ws = a.ws;
    const bf16* Rr = (const bf16*)(ws + WS_RKV); const bf16* Kk = Rr + (size_t)T * D; const bf16* RA = (const bf16*)(ws + WS_RAWA); const bf16* RW = (const bf16*)(ws + WS_RAWW);
    bf16* KK = (bf16*)(ws + WS_KK); bf16* KD = (bf16*)(ws + WS_KD); bf16* BE = (bf16*)(ws + WS_BETA); float* RKB = (float*)(ws + WS_RKB);
    LAS float* tb = (LAS float*)lds;
    for (int i = tid; i < 7 * 256; i += 512) { const int t7 = i >> 8, q = i & 255;
        const float* src = t7 == 0 ? a.in[18] + lj * 1024 : t7 == 1 ? a.in[19] + lj * 1024 : t7 == 2 ? a.in[20] + lj * 1024 : t7 < 5 ? a.in[10] + lj * 2048 + (t7 - 3) * 1024 : a.in[13] + lj * 2048 + (t7 - 5) * 1024;
        ((LAS f32x4*)tb)[i] = ((const f32x4*)src)[q]; }
    __syncthreads();
    for (int row = gw; row < T; row += NGW) {
#pragma unroll
        for (int j = 0; j < 4; ++j) {
            const int col = 256 * j + 4 * lane; const size_t ro = (size_t)row * D + col;
            const f32x4 k = bf4(*(const u32x2*)(Kk + ro)), r = bf4(*(const u32x2*)(Rr + ro));
            f32x4 a0 = bf4(*(const u32x2*)(RA + ro)) + *(const LAS f32x4*)(tb + 5 * 1024 + col), a1 = bf4(*(const u32x2*)(RA + (size_t)T * D + ro)) + *(const LAS f32x4*)(tb + 6 * 1024 + col);
#pragma unroll
            for (int z = 0; z < 4; ++z) { a0[z] = sigm(a0[z]); a1[z] = sigm(a1[z]); }
            const f32x4 ck = *(const LAS f32x4*)(tb + col), ca = *(const LAS f32x4*)(tb + 1024 + col), cr = *(const LAS f32x4*)(tb + 2048 + col);
            const f32x4 kk = k * ck;
            const float ss = row16_sum((kk.x * kk.x + kk.y * kk.y) + (kk.z * kk.z + kk.w * kk.w));
            const f32x4 kd0 = k * ((a0 - 1.0f) * ca + 1.0f), kd1 = k * ((a1 - 1.0f) * ca + 1.0f);
            *(u32x2*)(KD + ro) = pk4(kd0); *(u32x2*)(KD + (size_t)T * D + ro) = pk4(kd1);
            const f32x4 p = r * (kd0 + kd1) * cr;
            const float rk = row16_sum((p.x + p.y) + (p.z + p.w));
            const f32x4 kkn = kk * (1.0f / fmaxf(sqrtf(ss), 1e-12f));
            *(u32x2*)(KK + ro) = pk4(kkn); *(u32x2*)(BE + ro) = pk4(kkn * a0); *(u32x2*)(BE + (size_t)T * D + ro) = pk4(kkn * a1);
            if ((lane & 15) == 0) RKB[(size_t)row * 16 + 4 * j + (lane >> 4)] = rk;
        }
    }
}
typedef short bf16x8 __attribute__((ext_vector_type(8)));
__device__ __forceinline__ f32x4 mfma16(bf16x8 a, bf16x8 b, f32x4 c) { return __builtin_amdgcn_mfma_f32_16x16x32_bf16(a, b, c, 0, 0, 0); }
__device__ __forceinline__ bf16x8 as_frag(u32x4 w) { return __builtin_bit_cast(bf16x8, w); }
constexpr int CH_LD = 144;
constexpr int CH_MS = 64 * CH_LD;
constexpr int CH_AB = 0 * CH_MS, CH_KT = 1 * CH_MS, CH_BT = 2 * CH_MS, CH_RB = 3 * CH_MS, CH_VT = 4 * CH_MS, CH_ABT = 5 * CH_MS, CH_KHT = 6 * CH_MS, CH_BHT = 7 * CH_MS,
              CH_LK = 8 * CH_MS, CH_LB = 9 * CH_MS, CH_MK = 10 * CH_MS, CH_MB = 11 * CH_MS, CH_WT = 12 * CH_MS, CH_U0 = 13 * CH_MS, CH_DINV = 14 * CH_MS;
constexpr int CH_GC = LDSCTL_OFF + 2048;
constexpr int CH_PART = LDSCTL_OFF + 4096;
constexpr int NCHUNK = NSTEP / 64;
static_assert(CH_DINV + 2048 <= RING_BYTES, "chunk LDS map");

__device__ __forceinline__ int scan_row(int s, int dir, int b) {
    if (s < CTXL) return TL + b * CTXL + (dir ? CTXL - 1 - s : s);
    const int i = s - CTXL; return b * SEQ + (dir ? SEQ - 1 - i : i);
}
#define CH_FRAG(mat, row, ks, kg) as_frag(*(const LAS u32x4*)(lds + (mat) + (row) * CH_LD + ((ks) * 32 + (kg) * 8) * 2))

__device__ __forceinline__ void phase_s1_chunks(const Args& a, int lj, LAS unsigned char* lds, int tid, int G) {
    unsigned char* ws = a.ws; const float* w0l = a.in[10] + lj * 2048;
    const int lane = tid & 63, wave = __builtin_amdgcn_readfirstlane(tid >> 6), l15 = lane & 15, g = lane >> 4;
    LAS float* part = (LAS float*)(lds + CH_PART); LAS float* gammaC = (LAS float*)(lds + CH_GC);
    float nlw[8], nkd[8], nbe[8], nkk[8], nrr[8], nvv[8];
#define S1_LOAD(ctx_) do { unsigned char* wsl = ws; asm volatile("" : "+s"(wsl));     \
        const bf16* LWp = (const bf16*)(wsl + WS_RAWW); const bf16* KDp = (const bf16*)(wsl + WS_KD); const bf16* BEp = (const bf16*)(wsl + WS_BETA); \
        const bf16* KKp = (const bf16*)(wsl + WS_KK); const bf16* Rp = (const bf16*)(wsl + WS_RKV); const bf16* Vp = Rp + (size_t)2 * T * D; \
        const int chain_ = (ctx_) / NCHUNK, c_ = (ctx_) - chain_ * NCHUNK, dir_ = chain_ >> 6, b_ = (chain_ >> 4) & 3, h_ = chain_ & 15; \
        _Pragma("unroll") for (int j = 0; j < 8; ++j) { const int row = scan_row(64 * c_ + 8 * wave + j, dir_, b_); const size_t o = (size_t)row * D + h_ * 64 + lane; \
            nlw[j] = bflo((unsigned)LWp[(size_t)dir_ * T * D + o]); nkd[j] = bflo((unsigned)KDp[(size_t)dir_ * T * D + o]); nbe[j] = bflo((unsigned)BEp[(size_t)dir_ * T * D + o]); nkk[j] = bflo((unsigned)KKp[o]); nrr[j] = bflo((unsigned)Rp[o]); nvv[j] = bflo((unsigned)Vp[o]); } } while (0)
    if ((int)blockIdx.x < 128 * NCHUNK) S1_LOAD((int)blockIdx.x);
    for (int ct = blockIdx.x; ct < 128 * NCHUNK; ct += G) {
        const int chain = ct / NCHUNK, c = ct - chain * NCHUNK, dir = chain >> 6, b = (chain >> 4) & 3, h = chain & 15;
        unsigned zq = 0u; asm volatile("" : "+v"(zq));
        {
            const int k = lane, tq = wave;
            float lw[8], kd[8], be[8], kk[8], rr[8], vv[8];
const float w0k = w0l[dir * 1024 + h * 64 + k];
#pragma unroll
            for (int j = 0; j < 8; ++j) { lw[j] = -0.60653066f * sigm(nlw[j] + w0k); kd[j] = nkd[j]; be[j] = nbe[j]; kk[j] = nkk[j]; rr[j] = nrr[j]; vv[j] = nvv[j]; }
            if (ct + G < 128 * NCHUNK) S1_LOAD(ct + G);
            float p[8]; p[0] = lw[0];
#pragma unroll
            for (int j = 1; j < 8; ++j) p[j] = p[j - 1] + lw[j];
            part[tq * 64 + k] = p[7];
            __syncthreads();
            float off = 0.f, tot = 0.f;
#pragma unroll
            for (int q = 0; q < 8; ++q) { const float pv = part[q * 64 + k]; tot += pv; off += q < tq ? pv : 0.f; }
            const float eTot = __expf(tot); float ePrev = __expf(off);
            if (tq == 0) gammaC[k] = eTot;
            unsigned abw[4], khw[4], bhw[4], vw[4];
#pragma unroll
            for (int j = 0; j < 8; j += 2) {
                float ab2[2], kt2[2], bt2[2], rb2[2], kh2[2], bh2[2];
#pragma unroll
                for (int z = 0; z < 2; ++z) { const float cu = off + p[j + z]; const float eP = __expf(cu), eM = __expf(-cu), eC = eTot * eM;
                    ab2[z] = kk[j + z] * ePrev; ePrev = eP; kt2[z] = kd[j + z] * eM; bt2[z] = be[j + z] * eM; rb2[z] = rr[j + z] * eP; kh2[z] = kd[j + z] * eC; bh2[z] = be[j + z] * eC;
                    const int t = 8 * tq + j + z;
                    *(LAS bf16*)(lds + CH_AB + t * CH_LD + k * 2) = (bf16)f2bf(ab2[z]); *(LAS bf16*)(lds + CH_KT + t * CH_LD + k * 2) = (bf16)f2bf(kt2[z]);
                    *(LAS bf16*)(lds + CH_BT + t * CH_LD + k * 2) = (bf16)f2bf(bt2[z]); *(LAS bf16*)(lds + CH_RB + t * CH_LD + k * 2) = (bf16)f2bf(rb2[z]); }
                abw[j >> 1] = pk2(ab2[0], ab2[1]); khw[j >> 1] = pk2(kh2[0], kh2[1]); bhw[j >> 1] = pk2(bh2[0], bh2[1]); vw[j >> 1] = pk2(vv[j], vv[j + 1]);
            }
            *(LAS u32x4*)(lds + CH_ABT + k * CH_LD + tq * 16) = (u32x4){abw[0], abw[1], abw[2], abw[3]};
            *(LAS u32x4*)(lds + CH_KHT + k * CH_LD + tq * 16) = (u32x4){khw[0], khw[1], khw[2], khw[3]};
            *(LAS u32x4*)(lds + CH_BHT + k * CH_LD + tq * 16) = (u32x4){bhw[0], bhw[1], bhw[2], bhw[3]};
            *(LAS u32x4*)(lds + CH_VT + k * CH_LD + tq * 16) = (u32x4){vw[0], vw[1], vw[2], vw[3]};
            *(LAS u32x4*)(lds + CH_WT + k * CH_LD + tq * 16) = (u32x4){zq, zq, zq, zq}; *(LAS u32x4*)(lds + CH_U0 + k * CH_LD + tq * 16) = (u32x4){zq, zq, zq, zq};
        }
        __syncthreads();
        {
            const int mi = wave >> 1, half = wave & 1;
            const int matS = (mi & 1) ? CH_BT : CH_KT, matT = (mi & 2) ? CH_RB : CH_AB, matO = CH_LK + mi * CH_MS;
            const bool incl = (mi & 2) != 0;
            bf16x8 fs[4][2], ft[2][2];
#pragma unroll
            for (int ms = 0; ms < 4; ++ms)
#pragma unroll
                for (int ks = 0; ks < 2; ++ks) fs[ms][ks] = CH_FRAG(matS, 16 * ms + l15, ks, g);
#pragma unroll
            for (int nt = 0; nt < 2; ++nt)
#pragma unroll
                for (int ks = 0; ks < 2; ++ks) ft[nt][ks] = CH_FRAG(matT, 32 * half + 16 * nt + l15, ks, g);
#pragma unroll
            for (int nt = 0; nt < 2; ++nt) { const int t = 32 * half + 16 * nt + l15;
#pragma unroll
                for (int ms = 0; ms < 4; ++ms) { f32x4 d = (f32x4){0.f, 0.f, 0.f, 0.f};
                    d = mfma16(fs[ms][0], ft[nt][0], d); d = mfma16(fs[ms][1], ft[nt][1], d);
                    const int s0 = 16 * ms + 4 * g;
#pragma unroll
                    for (int i = 0; i < 4; ++i) { const bool keep = incl ? (s0 + i <= t) : (s0 + i < t); d[i] = keep ? d[i] : __builtin_bit_cast(float, zq); }
                    u32x2 w; w.x = pk2(d[0], d[1]); w.y = pk2(d[2], d[3]);
                    *(LAS u32x2*)(lds + matO + t * CH_LD + s0 * 2) = w; } }
        }
        __syncthreads();
        f32x4 rhsU[4];
#pragma unroll
        for (int I = 0; I < 4; ++I) rhsU[I] = (f32x4){0.f, 0.f, 0.f, 0.f};
        if (wave >= 4) {
            const int ctv = (wave & 3) * 16;
            const bf16x8 fv0 = CH_FRAG(CH_VT, ctv + l15, 0, g), fv1 = CH_FRAG(CH_VT, ctv + l15, 1, g);
#pragma unroll
            for (int I = 0; I < 4; ++I) { f32x4 d = (f32x4){0.f, 0.f, 0.f, 0.f};
                d = mfma16(CH_FRAG(CH_LK, 16 * I + l15, 0, g), fv0, d); d = mfma16(CH_FRAG(CH_LK, 16 * I + l15, 1, g), fv1, d); rhsU[I] = -d; }
        }
        if (wave == 0) {
            const int bb = lane >> 4, j = lane & 15;
            float x[16];
#pragma unroll
            for (int t = 0; t < 16; ++t) {
                const u32x4 r0 = *(const LAS u32x4*)(lds + CH_LB + (16 * bb + t) * CH_LD + 32 * bb), r1 = *(const LAS u32x4*)(lds + CH_LB + (16 * bb + t) * CH_LD + 32 * bb + 16);
                const unsigned rw[8] = {r0.x, r0.y, r0.z, r0.w, r1.x, r1.y, r1.z, r1.w};
                float acc = (t == j) ? 1.0f : 0.0f;
#pragma unroll
                for (int s = 0; s < t; ++s) { const float lv = (s & 1) ? bfhi(rw[s >> 1]) : bflo(rw[s >> 1]); acc -= lv * x[s]; }
                x[t] = acc;
                *(LAS bf16*)(lds + CH_DINV + ((bb * 16 + t) * 16 + j) * 2) = (bf16)f2bf(acc);
            }
        }
        __syncthreads();
        {
            const int matZ = wave < 4 ? CH_WT : CH_U0, ct16 = (wave & 3) * 16;
#pragma unroll
            for (int I = 0; I < 4; ++I) {
                f32x4 rhs;
                if (wave < 4) { const u32x2 w = *(const LAS u32x2*)(lds + CH_ABT + (ct16 + l15) * CH_LD + (16 * I + 4 * g) * 2); rhs = (f32x4){bflo(w.x), bfhi(w.x), bflo(w.y), bfhi(w.y)}; }
                else rhs = rhsU[I];
                f32x4 d = (f32x4){0.f, 0.f, 0.f, 0.f};
                d = mfma16(CH_FRAG(CH_LB, 16 * I + l15, 0, g), CH_FRAG(matZ, ct16 + l15, 0, g), d); d = mfma16(CH_FRAG(CH_LB, 16 * I + l15, 1, g), CH_FRAG(matZ, ct16 + l15, 1, g), d);
                const f32x4 ac = rhs - d;
                const u32x2 dv = *(const LAS u32x2*)(lds + CH_DINV + ((I * 16 + l15) * 16 + 4 * g) * 2);
                const bf16x8 fa = as_frag((u32x4){dv.x, dv.y, zq, zq}), fb = as_frag((u32x4){pk2(ac[0], ac[1]), pk2(ac[2], ac[3]), zq, zq});
                const f32x4 z = mfma16(fa, fb, (f32x4){0.f, 0.f, 0.f, 0.f});
                u32x2 w; w.x = pk2(z[0], z[1]); w.y = pk2(z[2], z[3]);
                *(LAS u32x2*)(lds + matZ + (ct16 + l15) * CH_LD + (16 * I + 4 * g) * 2) = w;
                LDS_WAIT(); asm volatile("" ::: "memory");
            }
        }
        __syncthreads();
        {
            const int rt = wave >> 1, cp = (wave & 1) * 2;
            unsigned char* wsl = ws; asm volatile("" : "+s"(wsl));
            bf16* YL = (bf16*)(wsl + WS_Y); bf16* RH = (bf16*)(wsl + WS_RH); bf16* PM = (bf16*)(wsl + WS_PM); bf16* QT = (bf16*)(wsl + WS_QT);
            const int trow = scan_row(64 * c + 16 * rt + l15, dir, b);
#pragma unroll
            for (int q = 0; q < 2; ++q) { const int vt = cp + q; f32x4 d = (f32x4){0.f, 0.f, 0.f, 0.f};
#pragma unroll
                for (int ks = 0; ks < 2; ++ks) { d = mfma16(CH_FRAG(CH_VT, 16 * vt + l15, ks, g), CH_FRAG(CH_MK, 16 * rt + l15, ks, g), d); d = mfma16(CH_FRAG(CH_U0, 16 * vt + l15, ks, g), CH_FRAG(CH_MB, 16 * rt + l15, ks, g), d); }
                *(u32x2*)(YL + ((size_t)dir * T + trow) * D + h * 64 + 16 * vt + 4 * g) = pk4(d); }
#pragma unroll
            for (int q = 0; q < 2; ++q) { const int kt = cp + q; f32x4 d = (f32x4){0.f, 0.f, 0.f, 0.f};
#pragma unroll
                for (int ks = 0; ks < 2; ++ks) d = mfma16(CH_FRAG(CH_WT, 16 * kt + l15, ks, g), CH_FRAG(CH_MB, 16 * rt + l15, ks, g), d);
                const u32x2 rbw = *(const LAS u32x2*)(lds + CH_RB + (16 * rt + l15) * CH_LD + (16 * kt + 4 * g) * 2);
                u32x2 w; w.x = pk2(bflo(rbw.x) - d[0], bfhi(rbw.x) - d[1]); w.y = pk2(bflo(rbw.y) - d[2], bfhi(rbw.y) - d[3]);
                *(u32x2*)(RH + ((size_t)dir * T + trow) * D + h * 64 + 16 * kt + 4 * g) = w; }
            bf16* Pc = PM + ((size_t)chain * NCHUNK + c) * 4096; bf16* Qc = QT + ((size_t)chain * NCHUNK + c) * 4096;
            { const int krow = 16 * rt + l15; const float gc = gammaC[krow];
#pragma unroll
                for (int q = 0; q < 2; ++q) { const int kt = cp + q; f32x4 d = (f32x4){0.f, 0.f, 0.f, 0.f};
#pragma unroll
                    for (int ks = 0; ks < 2; ++ks) d = mfma16(CH_FRAG(CH_WT, 16 * kt + l15, ks, g), CH_FRAG(CH_BHT, krow, ks, g), d);
                    const int k0 = 16 * kt + 4 * g; f32x4 o;
#pragma unroll
                    for (int i = 0; i < 4; ++i) o[i] = ((k0 + i == krow) ? gc : 0.f) - d[i];
                    u32x2 w; w.x = pk2(o[0], o[1]); w.y = pk2(o[2], o[3]);
                    *(u32x2*)(Pc + krow * 64 + 32 * (kt >> 1) + 8 * g + 4 * (kt & 1)) = w; } }
            { const int vrow = 16 * rt + l15;
#pragma unroll
                for (int q = 0; q < 2; ++q) { const int kt = cp + q; f32x4 d = (f32x4){0.f, 0.f, 0.f, 0.f};
#pragma unroll
                    for (int ks = 0; ks < 2; ++ks) { d = mfma16(CH_FRAG(CH_KHT, 16 * kt + l15, ks, g), CH_FRAG(CH_VT, vrow, ks, g), d); d = mfma16(CH_FRAG(CH_BHT, 16 * kt + l15, ks, g), CH_FRAG(CH_U0, vrow, ks, g), d); }
                    u32x2 w; w.x = pk2(d[0], d[1]); w.y = pk2(d[2], d[3]);
                    *(u32x2*)(Qc + vrow * 64 + 16 * g + 4 * kt) = w; } }
        }
        __syncthreads();
    }
}

struct S2Set { u32x4 p[4][2]; u32x4 q[2]; };
__device__ __forceinline__ void s2_load(S2Set& s, const bf16* Pc, const bf16* Qc, int vt, int l15, int g) {
    s.q[0] = *(const u32x4*)(Qc + (16 * vt + l15) * 64 + 16 * g); s.q[1] = *(const u32x4*)(Qc + (16 * vt + l15) * 64 + 16 * g + 8);
#pragma unroll
    for (int m = 0; m < 4; ++m)
#pragma unroll
        for (int j = 0; j < 2; ++j) s.p[m][j] = *(const u32x4*)(Pc + (16 * m + l15) * 64 + 32 * j + 8 * g);
}
__device__ __forceinline__ void s2_step(f32x4 (&acc)[4], const S2Set& s, bf16* Hc, int g) {
    unsigned hw[4][2];
#pragma unroll
    for (int m = 0; m < 4; ++m) { hw[m][0] = pk2(acc[m][0], acc[m][1]); hw[m][1] = pk2(acc[m][2], acc[m][3]); }
#pragma unroll
    for (int m = 0; m < 4; ++m) *(u32x2*)(Hc + 16 * m + 4 * g) = (u32x2){hw[m][0], hw[m][1]};
    const bf16x8 hb0 = as_frag((u32x4){hw[0][0], hw[0][1], hw[1][0], hw[1][1]}), hb1 = as_frag((u32x4){hw[2][0], hw[2][1], hw[3][0], hw[3][1]});
#pragma unroll
    for (int m = 0; m < 4; ++m) {
        const unsigned q0 = (m & 2) ? ((m & 1) ? s.q[1].z : s.q[1].x) : ((m & 1) ? s.q[0].z : s.q[0].x), q1 = (m & 2) ? ((m & 1) ? s.q[1].w : s.q[1].y) : ((m & 1) ? s.q[0].w : s.q[0].y);
        f32x4 d = (f32x4){bflo(q0), bfhi(q0), bflo(q1), bfhi(q1)};
        d = mfma16(as_frag(s.p[m][0]), hb0, d);
        d = mfma16(as_frag(s.p[m][1]), hb1, d);
        acc[m] = d;
    }
}
__device__ __forceinline__ void phase_s2_chain(const Args& a, int wave, int lane, int G) {
    unsigned char* ws = a.ws;
    const bf16* PM = (const bf16*)(ws + WS_PM); const bf16* QT = (const bf16*)(ws + WS_QT); bf16* HT = (bf16*)(ws + WS_HT);
    const int l15 = lane & 15, g = lane >> 4;
    if (wave >= 2) return;
    static_assert(NCHUNK % 4 == 0, "S2 ring");
    for (int wt = blockIdx.x * 2 + wave; wt < 512; wt += G * 2) {
        const int chain = wt >> 2, vt = wt & 3;
        f32x4 acc[4];
#pragma unroll
        for (int m = 0; m < 4; ++m) acc[m] = (f32x4){0.f, 0.f, 0.f, 0.f};
        const bf16* Pc = PM + (size_t)chain * NCHUNK * 4096; const bf16* Qc = QT + (size_t)chain * NCHUNK * 4096;
        bf16* Hc = HT + (size_t)chain * NCHUNK * 4096 + (16 * vt + l15) * 64;
        S2Set s0, s1, s2, s3;
        s2_load(s0, Pc, Qc, vt, l15, g); s2_load(s1, Pc + 4096, Qc + 4096, vt, l15, g); s2_load(s2, Pc + 2 * 4096, Qc + 2 * 4096, vt, l15, g); s2_load(s3, Pc + 3 * 4096, Qc + 3 * 4096, vt, l15, g);
#pragma unroll 1
        for (int c = 0; c < NCHUNK; c += 4) {
            const int cn = c + 4 < NCHUNK ? c + 4 : c;
            const bf16* Pn = Pc + (size_t)cn * 4096; const bf16* Qn = Qc + (size_t)cn * 4096;
            s2_step(acc, s0, Hc + (size_t)c * 4096, g);       s2_load(s0, Pn, Qn, vt, l15, g);
            s2_step(acc, s1, Hc + (size_t)(c + 1) * 4096, g); s2_load(s1, Pn + 4096, Qn + 4096, vt, l15, g);
            s2_step(acc, s2, Hc + (size_t)(c + 2) * 4096, g); s2_load(s2, Pn + 2 * 4096, Qn + 2 * 4096, vt, l15, g);
            s2_step(acc, s3, Hc + (size_t)(c + 3) * 4096, g); s2_load(s3, Pn + 3 * 4096, Qn + 3 * 4096, vt, l15, g);
        }
    }
}

__device__ __forceinline__ void phase_s3_readout(const Args& a, int lj, int nrows, int gw, int NGW, int lane) {
    unsigned char* ws = a.ws;
    const bf16* YL = (const bf16*)(ws + WS_Y); const bf16* RH = (const bf16*)(ws + WS_RH); const bf16* HT = (const bf16*)(ws + WS_HT);
    const bf16* Vv = (const bf16*)(ws + WS_RKV) + (size_t)2 * T * D; const float* RKB = (const float*)(ws + WS_RKB); const bf16* Gg = (const bf16*)(ws + WS_G); bf16* Z = (bf16*)(ws + WS_Z);
    const float* lng = a.in[21] + lj * 1024; const float* lnb = a.in[22] + lj * 1024;
    const int l15 = lane & 15, g = lane >> 4;
    for (int task = gw; task < (nrows / 16) * 16; task += NGW) {
        const int tt = task >> 4, h = task & 15, r0 = tt * 16, row = r0 + l15;
        int b, cc[2];
        if (r0 < TL) { b = r0 >> 13; const int tb = (r0 & (SEQ - 1)) >> 6; cc[0] = 4 + tb; cc[1] = 4 + (127 - tb); }
        else { const int loc = r0 - TL; b = loc >> 8; const int tb = (loc & 255) >> 6; cc[0] = tb; cc[1] = 3 - tb; }
        f32x4 acc[4];
        const size_t ro = (size_t)row * D + h * 64 + 4 * g;
#pragma unroll
        for (int vt = 0; vt < 4; ++vt) acc[vt] = bf4(*(const u32x2*)(YL + ro + 16 * vt)) + bf4(*(const u32x2*)(YL + (size_t)T * D + ro + 16 * vt));
#pragma unroll
        for (int dir = 0; dir < 2; ++dir) {
            const int chain = dir * 64 + b * 16 + h;
            const bf16* rh = RH + ((size_t)dir * T + row) * D + h * 64 + 8 * g;
            const bf16x8 f0 = as_frag(*(const u32x4*)(rh)), f1 = as_frag(*(const u32x4*)(rh + 32));
            const bf16* hc = HT + ((size_t)chain * NCHUNK + cc[dir]) * 4096;
#pragma unroll
            for (int vt = 0; vt < 4; ++vt) { const bf16* hr = hc + (16 * vt + l15) * 64 + 8 * g;
                acc[vt] = mfma16(as_frag(*(const u32x4*)(hr)), f0, acc[vt]); acc[vt] = mfma16(as_frag(*(const u32x4*)(hr + 32)), f1, acc[vt]); }
        }
        float s = 0.f;
#pragma unroll
        for (int vt = 0; vt < 4; ++vt) s += (acc[vt][0] + acc[vt][1]) + (acc[vt][2] + acc[vt][3]);
        s += __shfl_xor(s, 16); s += __shfl_xor(s, 32);
        const float mean = s * (1.0f / 64.0f); float vs = 0.f;
#pragma unroll
        for (int vt = 0; vt < 4; ++vt) { acc[vt] = acc[vt] - mean; vs += (acc[vt][0] * acc[vt][0] + acc[vt][1] * acc[vt][1]) + (acc[vt][2] * acc[vt][2] + acc[vt][3] * acc[vt][3]); }
        vs += __shfl_xor(vs, 16); vs += __shfl_xor(vs, 32);
        const float rstd = rsqrtf(vs * (1.0f / 64.0f) + 64.0f * 1e-5f), bon = RKB[(size_t)row * 16 + h];
#pragma unroll
        for (int vt = 0; vt < 4; ++vt) { const int col = h * 64 + 16 * vt + 4 * g; const size_t o = (size_t)row * D + col;
            const f32x4 vq = bf4(*(const u32x2*)(Vv + o)), lg4 = *(const f32x4*)(lng + col), lb4 = *(const f32x4*)(lnb + col); const u32x2 gw2 = *(const u32x2*)(Gg + o);
            const f32x4 zz = acc[vt] * rstd * lg4 + lb4 + vq * bon;
            u32x2 w; w.x = pk2(zz[0] * bflo(gw2.x), zz[1] * bfhi(gw2.x)); w.y = pk2(zz[2] * bflo(gw2.y), zz[3] * bfhi(gw2.y));
            *(u32x2*)(Z + o) = w; }
    }
}
__device__ __forceinline__ void phase_cv(const Args& a, int lc, int rows, int gw, int NGW, int lane) {
    unsigned char* ws = a.ws;
    const bf16* BG = (const bf16*)(ws + WS_BG); const bf16* CU = (const bf16*)(ws + WS_CUZ); bf16* Z = (bf16*)(ws + WS_Z);
    const float* cw = a.in[25] + (size_t)lc * 3 * 1024;
    for (int t = gw; t < rows; t += NGW) {
        int rs, re; if (t < TL) { rs = t & ~63; re = rs + 63; } else { const int loc = t - TL; rs = TL + (loc & ~255); re = rs + 255; }
        const bool hp = t > rs, hn = t < re;
#pragma unroll
        for (int j = 0; j < 4; ++j) { const int col = 256 * j + 4 * lane; const size_t o = (size_t)t * D + col;
            const u32x2 zc = *(const u32x2*)(CU + o), bg = *(const u32x2*)(BG + o);
            const u32x2 zp = hp ? *(const u32x2*)(CU + o - D) : (u32x2){0u, 0u}, zn = hn ? *(const u32x2*)(CU + o + D) : (u32x2){0u, 0u};
            const f32x4 w0 = *(const f32x4*)(cw + col), w1 = *(const f32x4*)(cw + 1024 + col), w2 = *(const f32x4*)(cw + 2048 + col);
            const f32x4 zv = (f32x4){bflo(zc.x), bfhi(zc.x), bflo(zc.y), bfhi(zc.y)}, pv = (f32x4){bflo(zp.x), bfhi(zp.x), bflo(zp.y), bfhi(zp.y)}, nv = (f32x4){bflo(zn.x), bfhi(zn.x), bflo(zn.y), bfhi(zn.y)};
            const f32x4 bv = (f32x4){bflo(bg.x), bfhi(bg.x), bflo(bg.y), bfhi(bg.y)};
            const f32x4 r = bv * (w0 * pv + w1 * zv + w2 * nv);
            u32x2 w; w.x = pk2(r.x, r.y); w.y = pk2(r.z, r.w); *(u32x2*)(Z + o) = w; }
    }
}
typedef float f32x2v __attribute__((ext_vector_type(2)));
__device__ __forceinline__ float lane_bcast(float v, int srclane) { return __builtin_bit_cast(float, __builtin_amdgcn_readlane(__builtin_bit_cast(int, v), srclane)); }
__device__ __forceinline__ void phase_e_route(const Args& a, int layer, int rows, LAS unsigned char* lds, int tid, int gw, int NGW, int lane, int probe_rep = 0) {
    unsigned char* ws = a.ws;
    const float* xs = (const float*)(ws + (layer < 2 ? WS_XSA : WS_XSB));
    const float* MODS = (const float*)(ws + WS_MODS); bf16* H2 = (bf16*)(ws + WS_H2);
    const float* ng = a.in[6] + (size_t)(layer * 2 + 1) * 1024;
    const float* rw = a.in[27] + (size_t)layer * 1024 * 32; const float* rb = a.in[28] + layer * 32;
    unsigned* cnt = (unsigned*)(ws + WS_CTL) + CW_CNT + (layer + 4 * probe_rep) * 32 * CNT_STRIDE;
    int* SLOTL = (int*)(ws + (probe_rep ? WS_L1 : WS_SLOTL)); float* GATEL = (float*)(ws + (probe_rep ? WS_L1 + 8 * MiB : WS_GATEL));
    LAS float* wt = (LAS float*)lds;
    LAS int* hist = (LAS int*)(lds + LDSCTL_OFF + 3072); LAS int* base = hist + 32; LAS int* lcnt = hist + 64;
    int* TKE = (int*)(ws + WS_C12); float* TKG = (float*)(ws + WS_C12 + 4 * MiB);
    for (int i = tid; i < 32768; i += 512) wt[(i & 31) * 1024 + (i >> 5)] = rw[i];
    if (tid < 32) hist[tid] = 0;
    __syncthreads();
    const int my_e = lane >> 1; const float my_b = rb[my_e];
    const bool b5 = (lane & 32) != 0, b4 = (lane & 16) != 0, b3 = (lane & 8) != 0, b2 = (lane & 4) != 0, b1 = (lane & 2) != 0;
    for (int t = gw; t < rows; t += NGW) {
        const int mr = mod_row(t);
        const float* mod = MODS + (size_t)(layer * 5 + mr) * 6144;
        f32x4 x[4];
#pragma unroll
        for (int j = 0; j < 4; ++j) x[j] = *(const f32x4*)(xs + (size_t)t * D + 256 * j + 4 * lane);
        const float rstd = row_rstd(x);
#pragma unroll
        for (int j = 0; j < 4; ++j) { const int col = 256 * j + 4 * lane;
            x[j] = x[j] * rstd * *(const f32x4*)(ng + col) * (*(const f32x4*)(mod + 4 * 1024 + col) + 1.0f) + *(const f32x4*)(mod + 3 * 1024 + col);
            u32x2 w; w.x = pk2(x[j].x, x[j].y); w.y = pk2(x[j].z, x[j].w); *(u32x2*)(H2 + (size_t)t * D + col) = w; }
        float p[32];
#pragma unroll
        for (int eg = 0; eg < 8; ++eg) {
#pragma unroll
            for (int ee = 0; ee < 4; ++ee) { const int e = eg * 4 + ee; f32x2v s2 = (f32x2v){0.f, 0.f};
#pragma unroll
                for (int j = 0; j < 4; ++j) { const f32x4 wv = *(const LAS f32x4*)(wt + e * 1024 + 256 * j + 4 * lane);
                    s2 = __builtin_elementwise_fma((f32x2v){x[j].x, x[j].y}, (f32x2v){wv.x, wv.y}, s2); s2 = __builtin_elementwise_fma((f32x2v){x[j].z, x[j].w}, (f32x2v){wv.z, wv.w}, s2); }
                p[e] = s2.x + s2.y; }
            asm volatile("" ::: "memory");
        }
        float q16[16];
#pragma unroll
        for (int i = 0; i < 16; ++i) { const float send = b5 ? p[i] : p[i + 16]; const float keep = b5 ? p[i + 16] : p[i]; q16[i] = keep + __shfl_xor(send, 32); }
        float q8[8];
#pragma unroll
        for (int i = 0; i < 8; ++i) { const float send = b4 ? q16[i] : q16[i + 8]; const float keep = b4 ? q16[i + 8] : q16[i]; q8[i] = keep + __shfl_xor(send, 16); }
        float q4[4];
#pragma unroll
        for (int i = 0; i < 4; ++i) { const float send = b3 ? q8[i] : q8[i + 4]; const float keep = b3 ? q8[i + 4] : q8[i]; q4[i] = keep + __shfl_xor(send, 8); }
        float q2[2];
#pragma unroll
        for (int i = 0; i < 2; ++i) { const float send = b2 ? q4[i] : q4[i + 2]; const float keep = b2 ? q4[i + 2] : q4[i]; q2[i] = keep + __shfl_xor(send, 4); }
        float q1; { const float send = b1 ? q2[0] : q2[1]; const float keep = b1 ? q2[1] : q2[0]; q1 = keep + __shfl_xor(send, 2); }
        const float lg = q1 + __shfl_xor(q1, 1) + my_b;
        int rank = 0;
#pragma unroll 1
        for (int e = 0; e < 32; ++e) { const float o = lane_bcast(lg, 2 * e); rank += (o > lg || (o == lg && e < my_e)) ? 1 : 0; }
        const bool sel = rank < 4 && !(lane & 1);
        const unsigned long long m0 = __ballot(sel && rank == 0), m1 = __ballot(sel && rank == 1), m2 = __ballot(sel && rank == 2), m3 = __ballot(sel && rank == 3);
        const float v0 = lane_bcast(lg, (int)__builtin_ctzll(m0)), v1 = lane_bcast(lg, (int)__builtin_ctzll(m1)), v2 = lane_bcast(lg, (int)__builtin_ctzll(m2)), v3 = lane_bcast(lg, (int)__builtin_ctzll(m3));
        const float e1 = __expf(v1 - v0), e2 = __expf(v2 - v0), e3 = __expf(v3 - v0);
        const float inv = 1.0f / (1.0f + e1 + e2 + e3);
        if (sel) {
            TKE[t * 4 + rank] = my_e; TKG[t * 4 + rank] = __expf(lg - v0) * inv;
            __hip_atomic_fetch_add(hist + my_e, 1, __ATOMIC_RELAXED, __HIP_MEMORY_SCOPE_WORKGROUP);
        }
    }
    asm volatile("s_waitcnt vmcnt(0) lgkmcnt(0)" ::: "memory"); __syncthreads();
    if (tid < 32) { base[tid] = (int)atomicAdd(cnt + tid * CNT_STRIDE, (unsigned)hist[tid]); lcnt[tid] = 0; }
    __syncthreads();
    for (int t = gw; t < rows; t += NGW) {
        if (lane < 4) { const int e = TKE[t * 4 + lane]; const float gk = TKG[t * 4 + lane];
            const int pos = base[e] + __hip_atomic_fetch_add(lcnt + e, 1, __ATOMIC_RELAXED, __HIP_MEMORY_SCOPE_WORKGROUP);
            SLOTL[(size_t)e * T + pos] = t * 4 + lane; GATEL[(size_t)e * T + pos] = gk; }
    }
}
__device__ __forceinline__ void phase_final(const Args& a, int gw, int NGW, int lane) {
    unsigned char* ws = a.ws;
    const float* xs = (const float*)(ws + WS_XSB); const float* MODS = (const float*)(ws + WS_MODS); const bf16* YS = (const bf16*)(ws + WS_YS);
    for (int t = gw; t < TL; t += NGW) {
        const int mr = t >> 13;
        f32x4 m5[4], x[4];
#pragma unroll
        for (int j = 0; j < 4; ++j) m5[j] = *(const f32x4*)(MODS + (size_t)(3 * 5 + mr) * 6144 + 5 * 1024 + 256 * j + 4 * lane);
        load_x_combined(x, xs + (size_t)t * D, true, YS, t, m5, lane);
        const float rstd = row_rstd(x);
#pragma unroll
        for (int j = 0; j < 4; ++j) { const int col = 256 * j + 4 * lane; *(f32x4*)(a.out + (size_t)t * D + col) = x[j] * rstd * *(const f32x4*)(a.in[7] + col); }
    }
}

using pg8::Unit; using pg8::tile_map;
struct SchedStd {
    int G, c, nM, nN;
    __device__ __forceinline__ bool next(int i, Unit& u) const { const long L = (long)i * G + c; if (L >= (long)nM * nN) return false; int pm, pn; tile_map((int)L, nM, nN, pm, pn); u.pm = pm; u.pn = pn; u.e = 0; u.nv = pm; return true; }
    __device__ __forceinline__ void a_ready(const Unit&) const {}
    __device__ __forceinline__ void done(const Unit&) const {}
    __device__ __forceinline__ unsigned row_off(const Unit&, int) const { return 0u; }
};
struct SchedB1 {
    int G, c;
    __device__ __forceinline__ bool next(int i, Unit& u) const { const long L = (long)i * G + c; constexpr int n1 = 3 * NMT * 4; if (L >= n1 + 3 * NMT) return false; const int l = (int)L;
        if (l < n1) { const int j = l / (NMT * 4), r = l % (NMT * 4); int pm, pn; tile_map(r, NMT, 4, pm, pn); u.pm = j * NMT + pm; u.pn = j * 4 + pn; u.e = j; u.nv = pm; }
        else { const int r = l - n1, j = r / NMT, pm = r % NMT; u.pm = (3 + j) * NMT + pm; u.pn = 12 + j; u.e = 3 + j; u.nv = pm; }
        return true; }
    __device__ __forceinline__ void a_ready(const Unit&) const {}
    __device__ __forceinline__ void done(const Unit&) const {}
    __device__ __forceinline__ unsigned row_off(const Unit&, int) const { return 0u; }
};
struct SchedB2 {
    int G, c;
    __device__ __forceinline__ bool next(int i, Unit& u) const { const long L = (long)i * G + c; constexpr int n1 = 2 * NMT * 8; if (L >= n1 + NMT * 4) return false; const int l = (int)L;
        if (l < n1) { const int j = l / (NMT * 8), r = l % (NMT * 8); int pm, pn; tile_map(r, NMT, 8, pm, pn); u.pm = j * NMT + pm; u.pn = j * 8 + pn; u.e = j; u.nv = pm; }
        else { const int r = l - n1; int pm, pn; tile_map(r, NMT, 4, pm, pn); u.pm = 2 * NMT + pm; u.pn = 16 + pn; u.e = 2; u.nv = pm; }
        return true; }
    __device__ __forceinline__ void a_ready(const Unit&) const {}
    __device__ __forceinline__ void done(const Unit&) const {}
    __device__ __forceinline__ unsigned row_off(const Unit&, int) const { return 0u; }
};
struct SchedMoe {
    int G, c, nnt, ntiles, P; LAS unsigned char* lds; const int* slotl;
    __device__ __forceinline__ bool next(int i, Unit& u) const { const long L = (long)i * G + c; const int ntp = (ntiles + P - 1) / P, ppg = nnt / (8 / P); if (L >= (long)ntp * ppg * 8) return false;
        const LAS int* tpre = (const LAS int*)(lds + LDSCTL_OFF + 64); const LAS int* ecnt = (const LAS int*)(lds + LDSCTL_OFF + 256); const LAS unsigned short* tile_e = (const LAS unsigned short*)(lds + LDSCTL_OFF + 512);
        const int xq = (int)(L >> 3), x8 = (int)(L & 7); int tile = (xq / ppg) * P + (x8 % P); const int pnl = (x8 / P) * ppg + xq % ppg; const bool dead = tile >= ntiles; tile = dead ? 0 : tile;
        const int e = __builtin_amdgcn_readfirstlane((int)tile_e[tile]), r0 = (tile - __builtin_amdgcn_readfirstlane(tpre[e])) * 256; int nv = __builtin_amdgcn_readfirstlane(ecnt[e]) - r0; nv = nv > 256 ? 256 : nv; nv = dead ? 0 : nv;
        u.pm = dead ? MAXTILES : tile; u.pn = e * nnt + pnl; u.e = e; u.nv = nv | (r0 << 9); return true; }
    __device__ __forceinline__ void a_ready(const Unit&) const {}
    __device__ __forceinline__ void done(const Unit&) const {}
    __device__ __forceinline__ unsigned row_off(const Unit& u, int r) const { const int nv = u.nv & 511, r0 = u.nv >> 9; const int tok = r < nv ? (slotl[(size_t)u.e * T + r0 + r] >> 2) : 0; return (unsigned)tok * 2048u; }
};

using pg8::cvt_pk_bf16;
template <class P> __device__ __forceinline__ P* pin_ptr(P* p) { asm volatile("" : "+v"(p)); return p; }
struct EpiB1 {
    static constexpr bool PERM = true, AFTER_DRAIN = false;
    bf16* RKV; bf16* L1;
    __device__ __forceinline__ void operator()(const f32x4 (&acc)[2][2][4][2], const Unit& u, int wr, int wc, int fr, int fq) const {
        const int seg = u.e, row0 = u.nv * 256 + wr * 64 + fr;
        const int jj = seg - 3, ld = seg < 3 ? D : 128, col0 = (seg < 3 ? (u.pn - seg * 4) * 256 : 0) + wc * 32 + 8 * fq;
        bf16* base = seg < 3 ? RKV + (size_t)seg * T * D : L1 + (size_t)jj * T * 128;
#pragma unroll
        for (int ai = 0; ai < 2; ++ai)
#pragma unroll
            for (int m = 0; m < 4; ++m) { bf16* rowp = base + (size_t)(row0 + ai * 128 + m * 16) * ld + col0;
#pragma unroll
                for (int bj = 0; bj < 2; ++bj) { if (seg >= 3 && bj == 1) continue; f32x4 v0 = acc[ai][bj][m][0], v1 = acc[ai][bj][m][1];
                    if (jj == 0) {
#pragma unroll
                        for (int q = 0; q < 4; ++q) { v0[q] = tanh_fast(v0[q]); v1[q] = tanh_fast(v1[q]); } }
                    else if (jj == 2) {
#pragma unroll
                        for (int q = 0; q < 4; ++q) { v0[q] = sigm(v0[q]); v1[q] = sigm(v1[q]); } }
                    u32x4 w; w.x = cvt_pk_bf16(v0[0], v0[1]); w.y = cvt_pk_bf16(v0[2], v0[3]); w.z = cvt_pk_bf16(v1[0], v1[1]); w.w = cvt_pk_bf16(v1[2], v1[3]);
                    *(u32x4*)(rowp + bj * 128) = w; } }
    }
};
struct EpiB2 {
    static constexpr bool PERM = true, AFTER_DRAIN = false;
    bf16* RW; bf16* RA; bf16* Gg;
    __device__ __forceinline__ void operator()(const f32x4 (&acc)[2][2][4][2], const Unit& u, int wr, int wc, int fr, int fq) const {
        const int jj = u.e, row0 = u.nv * 256 + wr * 64 + fr, pnl = u.pn - jj * 8;
        const int dirn = jj < 2 ? (pnl >> 2) : 0, col0 = (jj < 2 ? (pnl & 3) : pnl) * 256 + wc * 32 + 8 * fq;
        bf16* base = (jj == 0 ? RW : jj == 1 ? RA : Gg) + (size_t)dirn * T * D;
#pragma unroll
        for (int ai = 0; ai < 2; ++ai)
#pragma unroll
            for (int m = 0; m < 4; ++m) { bf16* rowp = base + (size_t)(row0 + ai * 128 + m * 16) * D + col0;
#pragma unroll
                for (int bj = 0; bj < 2; ++bj) { const f32x4 v0 = acc[ai][bj][m][0], v1 = acc[ai][bj][m][1];
                    u32x4 w; w.x = cvt_pk_bf16(v0[0], v0[1]); w.y = cvt_pk_bf16(v0[2], v0[3]); w.z = cvt_pk_bf16(v1[0], v1[1]); w.w = cvt_pk_bf16(v1[2], v1[3]);
                    *(u32x4*)(rowp + bj * 128) = w; } }
    }
};
struct EpiRes {
    static constexpr bool PERM = true, AFTER_DRAIN = false;
    float* X; const float* gate; float* Xo;
    __device__ __forceinline__ void operator()(const f32x4 (&acc)[2][2][4][2], const Unit& u, int wr, int wc, int fr, int fq) const {
        const int row0 = u.pm * 256 + wr * 64 + fr, col0 = u.pn * 256 + wc * 32 + 8 * fq, mr = u.pm < NMT_L ? (u.pm >> 5) : 4;
        const float* gp = pin_ptr(gate + (size_t)mr * 6144 + col0);
        f32x4 gv[2][2];
#pragma unroll
        for (int bj = 0; bj < 2; ++bj)
#pragma unroll
            for (int n = 0; n < 2; ++n) gv[bj][n] = *(const f32x4*)(gp + bj * 128 + 4 * n);
#pragma unroll
        for (int ai = 0; ai < 2; ++ai)
#pragma unroll
            for (int m = 0; m < 4; ++m) { float* rowp = X + (size_t)(row0 + ai * 128 + m * 16) * D + col0;
#pragma unroll
                for (int bj = 0; bj < 2; ++bj)
#pragma unroll
                    for (int n = 0; n < 2; ++n) { float* p = rowp + bj * 128 + 4 * n; *(f32x4*)(Xo + (p - X)) = *(const f32x4*)p + gv[bj][n] * acc[ai][bj][m][n]; } }
    }
};
struct EpiWin {
    static constexpr bool PERM = true, AFTER_DRAIN = false;
    bf16* BG; bf16* CU;
    __device__ __forceinline__ void operator()(const f32x4 (&acc)[2][2][4][2], const Unit& u, int wr, int wc, int fr, int fq) const {
        const int row0 = u.pm * 256 + wr * 64 + fr;
        if (u.pn < 4) {
            const int col0 = u.pn * 256 + wc * 32 + 8 * fq;
#pragma unroll
            for (int ai = 0; ai < 2; ++ai)
#pragma unroll
                for (int m = 0; m < 4; ++m) { bf16* rowp = BG + (size_t)(row0 + ai * 128 + m * 16) * D + col0;
#pragma unroll
                    for (int bj = 0; bj < 2; ++bj) { const f32x4 v0 = acc[ai][bj][m][0], v1 = acc[ai][bj][m][1];
                        u32x4 w; w.x = cvt_pk_bf16(v0[0], v0[1]); w.y = cvt_pk_bf16(v0[2], v0[3]); w.z = cvt_pk_bf16(v1[0], v1[1]); w.w = cvt_pk_bf16(v1[2], v1[3]);
                        *(u32x4*)(rowp + bj * 128) = w; } }
        } else {
            const int f0 = (u.pn - 4) * 128 + wc * 32 + 8 * fq;
#pragma unroll
            for (int ai = 0; ai < 2; ++ai)
#pragma unroll
                for (int m = 0; m < 4; ++m) { const f32x4 v0 = acc[ai][0][m][0] * acc[ai][1][m][0], v1 = acc[ai][0][m][1] * acc[ai][1][m][1];
                    u32x4 w; w.x = cvt_pk_bf16(v0[0], v0[1]); w.y = cvt_pk_bf16(v0[2], v0[3]); w.z = cvt_pk_bf16(v1[0], v1[1]); w.w = cvt_pk_bf16(v1[2], v1[3]);
                    *(u32x4*)(CU + (size_t)(row0 + ai * 128 + m * 16) * D + f0) = w; }
        }
    }
};
struct EpiGU {
    static constexpr bool PERM = true, AFTER_DRAIN = false;
    bf16* INTER; const float* bgu;
    __device__ __forceinline__ void operator()(const f32x4 (&acc)[2][2][4][2], const Unit& u, int wr, int wc, int fr, int fq) const {
        const int e = u.e, pnl = u.pn - e * 8, row0 = u.pm * 256 + wr * 64 + fr, f0 = pnl * 128 + wc * 32 + 8 * fq;
        const float* bp = pin_ptr(bgu + (size_t)e * 2048 + f0);
        f32x4 bg[2], bu[2];
#pragma unroll
        for (int n = 0; n < 2; ++n) { bg[n] = *(const f32x4*)(bp + 4 * n); bu[n] = *(const f32x4*)(bp + 1024 + 4 * n); }
#pragma unroll
        for (int ai = 0; ai < 2; ++ai)
#pragma unroll
            for (int m = 0; m < 4; ++m) { f32x4 o[2];
#pragma unroll
                for (int n = 0; n < 2; ++n) { const f32x4 g = acc[ai][0][m][n] + bg[n], uu = acc[ai][1][m][n] + bu[n];
#pragma unroll
                    for (int q = 0; q < 4; ++q) { const float gc = fminf(g[q], 7.0f), uc = fminf(fmaxf(uu[q], -7.0f), 7.0f); o[n][q] = (uc + 1.0f) * gc * sigm(1.702f * gc); } }
                u32x4 w; w.x = cvt_pk_bf16(o[0][0], o[0][1]); w.y = cvt_pk_bf16(o[0][2], o[0][3]); w.z = cvt_pk_bf16(o[1][0], o[1][1]); w.w = cvt_pk_bf16(o[1][2], o[1][3]);
                *(u32x4*)(INTER + (size_t)(row0 + ai * 128 + m * 16) * 1024 + f0) = w; }
    }
};
struct EpiDown {
    static constexpr bool PERM = true, AFTER_DRAIN = false;
    bf16* YS; const float* bdn; const int* slotl; const float* gatel;
    __device__ __forceinline__ void operator()(const f32x4 (&acc)[2][2][4][2], const Unit& u, int wr, int wc, int fr, int fq) const {
        const int e = u.e, pnl = u.pn - e * 4, col0 = pnl * 256 + wc * 32 + 8 * fq, nv = u.nv & 511, r0 = u.nv >> 9;
        const float* bp = pin_ptr(bdn + (size_t)e * 1024 + col0);
        f32x4 bv[2][2];
#pragma unroll
        for (int bj = 0; bj < 2; ++bj)
#pragma unroll
            for (int n = 0; n < 2; ++n) bv[bj][n] = *(const f32x4*)(bp + bj * 128 + 4 * n);
#pragma unroll
        for (int ai = 0; ai < 2; ++ai)
#pragma unroll
            for (int m = 0; m < 4; ++m) { const int r = ai * 128 + wr * 64 + m * 16 + fr;
                if (r < nv) { const size_t li = (size_t)e * T + r0 + r; const int slot = slotl[li]; const float gt = gatel[li];
                    bf16* rowp = YS + (size_t)slot * 1024 + col0;
#pragma unroll
                    for (int bj = 0; bj < 2; ++bj) { const f32x4 v0 = (acc[ai][bj][m][0] + bv[bj][0]) * gt, v1 = (acc[ai][bj][m][1] + bv[bj][1]) * gt;
                        u32x4 w; w.x = cvt_pk_bf16(v0[0], v0[1]); w.y = cvt_pk_bf16(v0[2], v0[3]); w.z = cvt_pk_bf16(v1[0], v1[1]); w.w = cvt_pk_bf16(v1[2], v1[3]);
                        *(u32x4*)(rowp + bj * 128) = w; } } }
    }
};

__device__ __forceinline__ int moe_tables(const unsigned* cnt, LAS unsigned char* lds, int tid) {
    LAS int* tpre = (LAS int*)(lds + LDSCTL_OFF + 64); LAS int* ecnt = (LAS int*)(lds + LDSCTL_OFF + 256); LAS unsigned short* tile_e = (LAS unsigned short*)(lds + LDSCTL_OFF + 512);
    if (tid == 0) { int p = 0; for (int e = 0; e < 32; ++e) { const int cn = (int)__hip_atomic_load(cnt + e * CNT_STRIDE, __ATOMIC_RELAXED, __HIP_MEMORY_SCOPE_AGENT); ecnt[e] = cn; tpre[e] = p; p += (cn + 255) >> 8; } tpre[32] = p; }
    __syncthreads();
    const int nt = tpre[32];
    for (int t = tid; t < nt; t += 512) { int e = 0; while (e < 31 && t >= tpre[e + 1]) ++e; tile_e[t] = (unsigned short)e; }
    __syncthreads();
    return nt;
}

constexpr int NPHASES = 38;
typedef const Args __attribute__((address_space(4))) CArgs;
__global__ void __launch_bounds__(512, 2) fwd_kernel(Args a_) {
    extern __shared__ __attribute__((aligned(16))) unsigned char lds_raw[];
    LAS unsigned char* lds = (LAS unsigned char*)lds_raw;
    const int G = gridDim.x, NGW = G * 8;
    CArgs* ap0 = (CArgs*)__builtin_amdgcn_kernarg_segment_ptr();
    if (threadIdx.x < 4) ((LAS unsigned*)(lds + LDSCTL_OFF))[threadIdx.x] = 0u;
    __syncthreads();
    XcdBarrier bar = xcd_barrier_post((unsigned*)(a_.ws + WS_CTL) + CW_BAR, (volatile LAS unsigned*)(lds + LDSCTL_OFF));
    const int lo = a_.ph_lo, hi = a_.ph_hi;
    int ph = 0;
#ifndef MK_ONLY
#define MK_ONLY -1
#endif
#ifndef MK_DBL
#define MK_DBL 0
#endif
#define PH_BEGIN(id) if ((MK_ONLY < 0 || MK_ONLY == (id)) && ph >= lo && ph < hi) { for (int rep_ = 0; rep_ <= ((MK_DBL >> (id)) & 1); ++rep_) { CArgs* ap = ap0; asm volatile("" : "+s"(ap)); const Args a = *(const Args*)ap; unsigned char* const ws = a.ws; (void)ws; const int wave = (int)bar.wv; int tid = wave * 64 + lane_id(); asm volatile("" : "+v"(tid)); const int lane = tid & 63, gw = blockIdx.x * 8 + wave; (void)lane; (void)gw;
#define PH_END } } if (ph >= lo && ph + 1 < hi) xcd_barrier(bar); ++ph;

    PH_BEGIN(0) p0_prologue(a, lds, tid, lane, wave, G); PH_END

#pragma unroll 1
    for (int layer = 0; layer < DEPTH; ++layer) {
        const int kind = layer & 1, lj = layer >> 1;
        const int rows = layer == 3 ? TL : T, nmt = rows / 256;
        const int rows_moe = layer < 2 ? T : TL;
        if (kind == 0) {
            PH_BEGIN(1) phase_a_rwkv(a, layer, lds, tid, gw, NGW, lane); PH_END
            PH_BEGIN(2) {
                pg8::Gemm g{(const bf16*)(ws + WS_XL), (const bf16*)(ws + WS_WRKV) + (size_t)lj * 3840 * 1024, 6 * T, 3840, 1024};
                SchedB1 S{G, (int)blockIdx.x}; EpiB1 E{(bf16*)(ws + WS_RKV), (bf16*)(ws + WS_L1)};
                pg8::gemm_phase<EpiB1, SchedB1, true, true, false>(lds, g, S, E, tid); } PH_END
            PH_BEGIN(3) {
                pg8::Gemm g{(const bf16*)(ws + WS_L1), (const bf16*)(ws + WS_L2T) + (size_t)lj * 5120 * 128, 3 * T, 5120, 128};
                SchedB2 S{G, (int)blockIdx.x}; EpiB2 E{(bf16*)(ws + WS_RAWW), (bf16*)(ws + WS_RAWA), (bf16*)(ws + WS_G)};
                pg8::gemm_phase<EpiB2, SchedB2, true, true, false>(lds, g, S, E, tid); } PH_END
            PH_BEGIN(4) phase_c_prep(a, lj, lds, tid, gw, NGW, lane); PH_END
            PH_BEGIN(5) phase_s1_chunks(a, lj, lds, tid, G); PH_END
            PH_BEGIN(15) phase_s2_chain(a, wave, lane, G); PH_END
            PH_BEGIN(6) phase_s3_readout(a, lj, layer == 2 ? TL : T, gw, NGW, lane); PH_END
        } else {
            PH_BEGIN(7) phase_a_conv(a, layer, rows, gw, NGW, lane); PH_END
            PH_BEGIN(8) {
                pg8::Gemm g{(const bf16*)(ws + WS_XL), (const bf16*)(ws + WS_WIN) + (size_t)lj * 3072 * 1024, rows, 3072, 1024};
                SchedStd S{G, (int)blockIdx.x, nmt, 12}; EpiWin E{(bf16*)(ws + WS_BG), (bf16*)(ws + WS_CUZ)};
                pg8::gemm_phase<EpiWin, SchedStd, true, true, false>(lds, g, S, E, tid); } PH_END
            PH_BEGIN(9) phase_cv(a, lj, rows, gw, NGW, lane); PH_END
        }
        PH_BEGIN(10) {
            const bf16* Wt = kind == 0 ? (const bf16*)(ws + WS_WO) + (size_t)lj * 1024 * 1024 : (const bf16*)(ws + WS_WOUT) + (size_t)lj * 1024 * 1024;
            pg8::Gemm g{(const bf16*)(ws + WS_Z), Wt, rows, 1024, 1024};
            SchedStd S{G, (int)blockIdx.x, layer == 2 ? NMT_L : nmt, 4}; EpiRes E{(float*)(ws + (layer < 2 ? WS_XSA : WS_XSB)), (const float*)(ws + WS_MODS) + (size_t)layer * 5 * 6144 + 2 * 1024, (float*)(ws + (rep_ ? WS_XL : (layer < 2 ? WS_XSA : WS_XSB)))};
            pg8::gemm_phase<EpiRes, SchedStd, true, true, false>(lds, g, S, E, tid); } PH_END
        PH_BEGIN(11) phase_e_route(a, layer, rows_moe, lds, tid, gw, NGW, lane, rep_); PH_END
        PH_BEGIN(12) {
            const int nt = __builtin_amdgcn_readfirstlane(moe_tables((const unsigned*)(ws + WS_CTL) + CW_CNT + layer * 32 * CNT_STRIDE, lds, tid));
            pg8::Gemm g{(const bf16*)(ws + WS_H2), (const bf16*)(ws + WS_WGU) + (size_t)layer * 32 * 2048 * 1024, 0, 0, 1024};
            SchedMoe S{G, (int)blockIdx.x, 8, nt, 2, lds, (const int*)(ws + WS_SLOTL)};
            EpiGU E{(bf16*)(ws + WS_INTER), a.in[30] + (size_t)layer * 32 * 2048};
            pg8::gemm_phase<EpiGU, SchedMoe, true, true, true>(lds, g, S, E, tid); } PH_END
        PH_BEGIN(13) {
            const int nt = __builtin_amdgcn_readfirstlane(moe_tables((const unsigned*)(ws + WS_CTL) + CW_CNT + layer * 32 * CNT_STRIDE, lds, tid));
            pg8::Gemm g{(const bf16*)(ws + WS_INTER), (const bf16*)(ws + WS_WDN) + (size_t)layer * 32 * 1024 * 1024, 0, 0, 1024};
            SchedMoe S{G, (int)blockIdx.x, 4, nt, 8, lds, (const int*)(ws + WS_SLOTL)};
            EpiDown E{(bf16*)(ws + WS_YS), a.in[32] + (size_t)layer * 32 * 1024, (const int*)(ws + WS_SLOTL), (const float*)(ws + WS_GATEL)};
            pg8::gemm_phase<EpiDown, SchedMoe, true, true, false>(lds, g, S, E, tid); } PH_END
    }
    PH_BEGIN(14) phase_final(a, gw, NGW, lane); PH_END
#undef PH_BEGIN
#undef PH_END
}

extern "C" void kernel_launch(void* const* d_in, const int* in_sizes, int n_in, void* d_out, int out_size, void* d_ws, size_t ws_size, hipStream_t stream) {
    static int grid = 0;
    if (grid == 0) {
        if (n_in != 33 || in_sizes[0] != TL * D || out_size != TL * D || ws_size < WS_END) { fprintf(stderr, "kernel_launch: unexpected problem (n_in %d, in0 %d, out %d, ws %zu < %zu)\n", n_in, n_in > 0 ? in_sizes[0] : -1, out_size, ws_size, (size_t)WS_END); grid = -1; return; }
        int dev = 0, cus = 0, per_cu = 0;
        if (hipGetDevice(&dev) != hipSuccess || hipDeviceGetAttribute(&cus, hipDeviceAttributeMultiprocessorCount, dev) != hipSuccess) { grid = -1; return; }
        if (hipFuncSetAttribute((const void*)fwd_kernel, hipFuncAttributeMaxDynamicSharedMemorySize, LDS_BYTES) != hipSuccess) { fprintf(stderr, "kernel_launch: hipFuncSetAttribute failed\n"); grid = -1; return; }
        if (hipOccupancyMaxActiveBlocksPerMultiprocessor(&per_cu, (const void*)fwd_kernel, 512, LDS_BYTES) != hipSuccess || per_cu < 1) fprintf(stderr, "kernel_launch: occupancy query says %d\n", per_cu);
        (void)hipGetLastError();
        grid = cus;
    }
    if (grid < 0) return;
    if (hipMemsetAsync((char*)d_ws + WS_CTL, 0, CTL_ZERO_BYTES, stream) != hipSuccess) return;
    Args a{};
    for (int i = 0; i < 33; ++i) a.in[i] = (const float*)d_in[i];
    a.out = (float*)d_out; a.ws = (unsigned char*)d_ws;
#if MK_PER_PHASE
    for (int p = 0; p < NPHASES; ++p) { a.ph_lo = p; a.ph_hi = p + 1; hipLaunchKernelGGL(fwd_kernel, dim3(grid), dim3(512), LDS_BYTES, stream, a); }
#else
    a.ph_lo = 0; a.ph_hi = NPHASES;
    hipLaunchKernelGGL(fwd_kernel, dim3(grid), dim3(512), LDS_BYTES, stream, a);
#endif
    const hipError_t le = hipPeekAtLastError();
    if (le != hipSuccess) fprintf(stderr, "kernel_launch: launch failed: %s\n", hipGetErrorName(le));
}
```

```cpp
#include <hip/hip_runtime.h>
#include <cstdio>
#include <cstdint>

#ifndef MK_PER_PHASE
#define MK_PER_PHASE 0
#endif

constexpr int D = 1024, NBATCH = 4, SEQ = 8192, TL = NBATCH * SEQ, CTXL = 256, TC = NBATCH * CTXL, T = TL + TC;
constexpr int NH = 16, HS = 64, NE = 32, TOPK = 4, DEPTH = 4;
constexpr int NMT = T / 256;
constexpr int NMT_L = TL / 256;
constexpr int MAXTILES = (T * TOPK) / 256 + NE;
constexpr int NSTEP = CTXL + SEQ;

__device__ __forceinline__ int lane_id() { return (int)__builtin_amdgcn_mbcnt_hi(~0u, __builtin_amdgcn_mbcnt_lo(~0u, 0u)); }
namespace pg8 {
#define PG8_LAS __attribute__((address_space(3)))
typedef unsigned short bf16_t;
typedef short bf16x8 __attribute__((ext_vector_type(8)));
typedef float f32x4 __attribute__((ext_vector_type(4)));
typedef unsigned u32x4 __attribute__((ext_vector_type(4)));
typedef unsigned u32x2 __attribute__((ext_vector_type(2)));
constexpr int BM = 256, BK = 64, HALF = 128, HTB = HALF * BK * 2  , STAGE_BYTES = 8 * HTB, NXCD = 8, WGM = 8;

__host__ __device__ __forceinline__ int lds_byte(int r, int c) { const int st = (r >> 4) * 2 + (c >> 5), rr = r & 15, cc = c & 31, ob = rr * 64 + cc * 2; return st * 1024 + (ob ^ (((ob >> 9) & 1) << 5)); }
__host__ __device__ __forceinline__ void stage_rc(int b, int& R, int& C) { const int st = b / 1024, sb = b % 1024, swz = sb ^ (((sb >> 9) & 1) << 5); R = (st >> 1) * 16 + swz / 64; C = (st & 1) * 32 + (swz % 64) / 2; }
__host__ __device__ __forceinline__ int perm32(int rho) { const int n = rho >> 4, i = rho & 15; return 8 * (i >> 2) + 4 * n + (i & 3); }

struct Unit { int pm, pn, e, nv; };
struct Gemm { const bf16_t* A; const bf16_t* Bt; int M, N, K; };

__device__ __forceinline__ void tile_map(int wgid, int nM, int nN, int& pm, int& pn) {
    const int nwg = nM * nN;
    { const int q = nwg / NXCD, r = nwg % NXCD, xcd = wgid % NXCD, off = wgid / NXCD; wgid = (xcd < r ? xcd * (q + 1) : r * (q + 1) + (xcd - r) * q) + off; }
    const int nig = WGM * nN, gid = wgid / nig, fm = gid * WGM, gsz = (nM - fm) < WGM ? (nM - fm) : WGM;
    pm = fm + ((wgid % nig) % gsz); pn = (wgid % nig) / gsz;
}
typedef __bf16 bf16x2_t __attribute__((ext_vector_type(2)));
typedef float f32x2_t __attribute__((ext_vector_type(2)));
__device__ __forceinline__ unsigned cvt_pk_bf16(float lo, float hi) { const f32x2_t v = {lo, hi}; const bf16x2_t b = __builtin_convertvector(v, bf16x2_t); return __builtin_bit_cast(unsigned, b); }

template <class Epi, class Sched, bool ALIGN_EPI = false, bool SP2 = false, bool GATHER = false>
__device__ __forceinline__ void gemm_phase(PG8_LAS unsigned char* lds, const Gemm g, const Sched& S, const Epi& E, int tid_in) {
    int tid_ = tid_in; asm volatile("" : "+v"(tid_));
    const int tid = tid_, wid = __builtin_amdgcn_readfirstlane(tid >> 6), lane = tid & 63, wr = wid >> 2, wc = wid & 3, fr = lane & 15, fq = lane >> 4;
    int K_ = g.K; asm volatile("" : "+s"(K_));
    const int K = K_, nt = K / BK;
    unsigned voffA[2], voffB[2]; int gR[2]; unsigned gC[2];
#pragma unroll
    for (int i = 0; i < 2; ++i) { int R, C; stage_rc(tid * 16 + i * 8192, R, C); const int Rb = Epi::PERM ? ((R & ~31) + perm32(R & 31)) : R;
        voffA[i] = (unsigned)(R * K + C) * 2u; voffB[i] = (unsigned)(Rb * K + C) * 2u; gR[i] = R; gC[i] = (unsigned)C * 2u; }
    unsigned oc[2][2], on[2][2], o2[2][2];
#pragma unroll
    for (int h = 0; h < 2; ++h)
#pragma unroll
        for (int i = 0; i < 2; ++i) { oc[h][i] = 0u; on[h][i] = 0u; o2[h][i] = 0u; }
    const size_t kstep = (size_t)(BK * 2);
    const size_t hstep = (size_t)HALF * K * 2;
    const size_t tstep = 2 * hstep;
    const unsigned ldsw = (unsigned)wid * 1024u;
    const int aoff = lds_byte(wr * 64 + fr, fq * 8), boff = lds_byte(wc * 32 + fr, fq * 8);
#define PG8_SA(b, h) (((b) * 2 + (h)) * HTB)
#define PG8_SB(b, h) ((4 + (b) * 2 + (h)) * HTB)
#define PG8_STAGE(bufoff, gbase, voff) do { _Pragma("unroll") for (int _i = 0; _i < 2; ++_i) \
        __builtin_amdgcn_global_load_lds((const unsigned*)((const char*)(gbase) + (voff)[_i]), (PG8_LAS unsigned*)(lds + (bufoff) + ldsw + _i * 8192), 16, 0, 0); } while (0)
#define PG8_STAGE_A(bufoff, base, h, O) do { if constexpr (GATHER) { PG8_STAGE(bufoff, base, (O)[h]); } else { PG8_STAGE(bufoff, (base) + (h) * hstep, voffA); } } while (0)
#define PG8_LDA(dst, b, h) do { _Pragma("unroll") for (int m = 0; m < 4; ++m) _Pragma("unroll") for (int k = 0; k < 2; ++k) dst[m][k] = *(const PG8_LAS bf16x8*)(lds + PG8_SA(b, h) + aoff + m * 2048 + k * 1024); } while (0)
#define PG8_LDB(dst, b, h) do { _Pragma("unroll") for (int n = 0; n < 2; ++n) _Pragma("unroll") for (int k = 0; k < 2; ++k) dst[n][k] = *(const PG8_LAS bf16x8*)(lds + PG8_SB(b, h) + boff + n * 2048 + k * 1024); } while (0)
#define PG8_MMA(ai, bj, At, Bt) do { __builtin_amdgcn_s_setprio(1); _Pragma("unroll") for (int m = 0; m < 4; ++m) _Pragma("unroll") for (int n = 0; n < 2; ++n) _Pragma("unroll") for (int k = 0; k < 2; ++k) \
        acc[ai][bj][m][n] = __builtin_amdgcn_mfma_f32_16x16x32_bf16(Bt[n][k], At[m][k], acc[ai][bj][m][n], 0, 0, 0); __builtin_amdgcn_s_setprio(0); } while (0)
#define PG8_WAIT_V(n) asm volatile("s_waitcnt vmcnt(" #n ")" ::: "memory")
#define PG8_WAIT_L(n) asm volatile("s_waitcnt lgkmcnt(" #n ")" ::: "memory")
#define PG8_BAR __builtin_amdgcn_s_barrier()
#define PG8_SCHED __builtin_amdgcn_sched_barrier(0)
    Unit cur, nxt; int ui = 0;
    if (!S.next(0, cur)) return;
    f32x4 acc[2][2][4][2];
#pragma unroll
    for (int a = 0; a < 2; ++a)
#pragma unroll
        for (int b = 0; b < 2; ++b)
#pragma unroll
            for (int m = 0; m < 4; ++m)
#pragma unroll
                for (int n = 0; n < 2; ++n) acc[a][b][m][n] = (f32x4){0.f, 0.f, 0.f, 0.f};
    bf16x8 At[4][2], B0[2][2], B1[2][2];
    const char* cA = GATHER ? (const char*)g.A : (const char*)g.A + (size_t)cur.pm * tstep; const char* cB = (const char*)g.Bt + (size_t)cur.pn * tstep;
    S.a_ready(cur);
    if constexpr (GATHER) {
#pragma unroll
        for (int h = 0; h < 2; ++h)
#pragma unroll
            for (int i = 0; i < 2; ++i) oc[h][i] = S.row_off(cur, h * HALF + gR[i]) + gC[i];
    }
    if constexpr (SP2) {
        PG8_STAGE(PG8_SB(0, 0), cB, voffB); PG8_STAGE(PG8_SB(0, 1), cB + hstep, voffB); PG8_STAGE_A(PG8_SA(0, 0), cA, 0, oc); PG8_STAGE_A(PG8_SA(0, 1), cA, 1, oc);
        if (wr == 1) PG8_BAR;
        PG8_WAIT_V(2); PG8_BAR;
        PG8_STAGE(PG8_SB(1, 0), cB + kstep, voffB); PG8_STAGE_A(PG8_SA(1, 0), cA + kstep, 0, oc); PG8_STAGE(PG8_SB(1, 1), cB + hstep + kstep, voffB);
        PG8_WAIT_V(6); PG8_BAR;
    } else {
        PG8_STAGE(PG8_SB(0, 0), cB, voffB); PG8_STAGE_A(PG8_SA(0, 0), cA, 0, oc); PG8_STAGE(PG8_SB(0, 1), cB + hstep, voffB); PG8_STAGE_A(PG8_SA(0, 1), cA, 1, oc);
        if (wr == 1) PG8_BAR;
        PG8_WAIT_V(4); PG8_BAR;
        PG8_STAGE(PG8_SB(1, 0), cB + kstep, voffB); PG8_STAGE_A(PG8_SA(1, 0), cA + kstep, 0, oc); PG8_STAGE(PG8_SB(1, 1), cB + hstep + kstep, voffB);
        PG8_WAIT_V(6); PG8_BAR;
    }
    for (;;) {
        const bool has_next = S.next(ui + 1, nxt);
        const char* nA = GATHER ? (const char*)g.A : (has_next ? (const char*)g.A + (size_t)nxt.pm * tstep : cA); const char* nB = has_next ? (const char*)g.Bt + (size_t)nxt.pn * tstep : cB;
        if constexpr (GATHER) {
#pragma unroll
            for (int h = 0; h < 2; ++h)
#pragma unroll
                for (int i = 0; i < 2; ++i) on[h][i] = has_next ? (S.row_off(nxt, h * HALF + gR[i]) + gC[i]) : oc[h][i];
        }
        for (int t = 0; t < nt; t += 2) {
            const bool last = (t == nt - 2);
            const char* a1 = cA + (size_t)(t + 1) * kstep;
            const char* a2 = last ? nA : cA + (size_t)(t + 2) * kstep; const char* b2 = last ? nB : cB + (size_t)(t + 2) * kstep;
            const char* a3 = a2 + kstep; const char* b3 = b2 + kstep;
            if constexpr (GATHER) {
#pragma unroll
                for (int h = 0; h < 2; ++h)
#pragma unroll
                    for (int i = 0; i < 2; ++i) o2[h][i] = last ? on[h][i] : oc[h][i];
            }
            if (last && has_next) S.a_ready(nxt);
            if constexpr (SP2) {
            PG8_LDB(B0, 0, 0); PG8_LDB(B1, 0, 1); PG8_SCHED; PG8_LDA(At, 0, 0); PG8_STAGE_A(PG8_SA(1, 1), a1, 1, oc);
            PG8_WAIT_V(8); PG8_WAIT_L(0); PG8_BAR; PG8_MMA(0, 0, At, B0); PG8_MMA(0, 1, At, B1); PG8_BAR; PG8_SCHED;
            PG8_LDA(At, 0, 1); PG8_STAGE(PG8_SB(0, 0), b2, voffB); PG8_STAGE(PG8_SB(0, 1), b2 + hstep, voffB); PG8_STAGE_A(PG8_SA(0, 0), a2, 0, o2);
            PG8_WAIT_V(8); PG8_WAIT_L(0); PG8_BAR; PG8_MMA(1, 0, At, B0); PG8_MMA(1, 1, At, B1); PG8_BAR; PG8_SCHED;
            PG8_LDB(B0, 1, 0); PG8_LDB(B1, 1, 1); PG8_SCHED; PG8_LDA(At, 1, 0); PG8_STAGE_A(PG8_SA(0, 1), a2, 1, o2);
            PG8_WAIT_V(8); PG8_WAIT_L(0); PG8_BAR; PG8_MMA(0, 0, At, B0); PG8_MMA(0, 1, At, B1); PG8_BAR; PG8_SCHED;
            PG8_LDA(At, 1, 1); PG8_STAGE(PG8_SB(1, 0), b3, voffB); PG8_STAGE(PG8_SB(1, 1), b3 + hstep, voffB); PG8_STAGE_A(PG8_SA(1, 0), a3, 0, o2);
            PG8_WAIT_V(8); PG8_WAIT_L(0); PG8_BAR; PG8_MMA(1, 0, At, B0); PG8_MMA(1, 1, At, B1); PG8_BAR; PG8_SCHED;
            } else {
            PG8_LDB(B0, 0, 0); PG8_SCHED; PG8_LDA(At, 0, 0); PG8_STAGE_A(PG8_SA(1, 1), a1, 1, oc);
            PG8_WAIT_L(8); PG8_BAR; PG8_WAIT_L(0); PG8_MMA(0, 0, At, B0); PG8_BAR; PG8_SCHED;
            PG8_LDB(B1, 0, 1); PG8_STAGE(PG8_SB(0, 0), b2, voffB);
            PG8_BAR; PG8_WAIT_L(0); PG8_MMA(0, 1, At, B1); PG8_BAR;
            PG8_LDA(At, 0, 1); PG8_STAGE_A(PG8_SA(0, 0), a2, 0, o2);
            PG8_BAR; PG8_WAIT_L(0); PG8_MMA(1, 0, At, B0); PG8_BAR; PG8_SCHED;
            PG8_STAGE(PG8_SB(0, 1), b2 + hstep, voffB);
            PG8_WAIT_V(6); PG8_BAR; PG8_MMA(1, 1, At, B1); PG8_BAR;
            PG8_LDB(B0, 1, 0); PG8_SCHED; PG8_LDA(At, 1, 0); PG8_STAGE_A(PG8_SA(0, 1), a2, 1, o2);
            PG8_WAIT_L(8); PG8_BAR; PG8_WAIT_L(0); PG8_MMA(0, 0, At, B0); PG8_BAR; PG8_SCHED;
            PG8_LDB(B1, 1, 1); PG8_STAGE(PG8_SB(1, 0), b3, voffB);
            PG8_BAR; PG8_WAIT_L(0); PG8_MMA(0, 1, At, B1); PG8_BAR;
            PG8_LDA(At, 1, 1); PG8_STAGE_A(PG8_SA(1, 0), a3, 0, o2);
            PG8_BAR; PG8_WAIT_L(0); PG8_MMA(1, 0, At, B0); PG8_BAR; PG8_SCHED;
            PG8_STAGE(PG8_SB(1, 1), b3 + hstep, voffB);
            PG8_WAIT_V(6); PG8_BAR; PG8_MMA(1, 1, At, B1); PG8_BAR;
            }
        }
        if constexpr (ALIGN_EPI) { if (wr == 0) PG8_BAR; }
        if constexpr (!Epi::AFTER_DRAIN) { E(acc, cur, wr, wc, fr, fq); S.done(cur); }
        if (!has_next) break;
#pragma unroll
        for (int a = 0; a < 2; ++a)
#pragma unroll
            for (int b = 0; b < 2; ++b)
#pragma unroll
                for (int m = 0; m < 4; ++m)
#pragma unroll
                    for (int n = 0; n < 2; ++n) acc[a][b][m][n] = (f32x4){0.f, 0.f, 0.f, 0.f};
        cur = nxt; cA = nA; cB = nB; ++ui;
        if constexpr (GATHER) {
#pragma unroll
            for (int h = 0; h < 2; ++h)
#pragma unroll
                for (int i = 0; i < 2; ++i) oc[h][i] = on[h][i];
        }
        if constexpr (ALIGN_EPI) { if (wr == 1) PG8_BAR; }
    }
    PG8_WAIT_V(0);
    if constexpr (!ALIGN_EPI) { if (wr == 0) PG8_BAR; }
    PG8_BAR;
    if constexpr (Epi::AFTER_DRAIN) { E.fused(acc, cur, wr, wc, fr, fq, lds, wid, lane); S.done(cur); }
#undef PG8_SA
#undef PG8_SB
#undef PG8_STAGE
#undef PG8_STAGE_A
#undef PG8_LDA
#undef PG8_LDB
#undef PG8_MMA
#undef PG8_WAIT_V
#undef PG8_WAIT_L
#undef PG8_BAR
#undef PG8_SCHED
}
}

#define LAS __attribute__((address_space(3)))
typedef unsigned short bf16;
typedef float f32x4 __attribute__((ext_vector_type(4)));
typedef unsigned u32x2 __attribute__((ext_vector_type(2)));
typedef unsigned u32x4 __attribute__((ext_vector_type(4)));
#define LDS_WAIT() asm volatile("s_waitcnt lgkmcnt(0)" ::: "memory")
__device__ __forceinline__ unsigned pk2(float lo, float hi) { return pg8::cvt_pk_bf16(lo, hi); }
__device__ __forceinline__ unsigned f2bf(float f) { return pk2(f, f) & 0xffffu; }
__device__ __forceinline__ float bflo(unsigned w) { return __builtin_bit_cast(float, w << 16); }
__device__ __forceinline__ float bfhi(unsigned w) { return __builtin_bit_cast(float, w & 0xffff0000u); }
__device__ __forceinline__ float wave_sum(float v) {
#pragma unroll
    for (int o = 1; o < 64; o <<= 1) v += __shfl_xor(v, o);
    return v;
}
__device__ __forceinline__ float sigm(float x) { return 1.0f / (1.0f + __expf(-x)); }
__device__ __forceinline__ float tanh_fast(float x) { const float e = __expf(2.0f * x); return 1.0f - 2.0f / (e + 1.0f); }

constexpr size_t MiB = 1u << 20;
constexpr size_t RF = (size_t)T * D * 4;
constexpr size_t RB = (size_t)T * D * 2;
constexpr size_t WS_CTL = 0, CTL_ZERO_BYTES = 1 * MiB;
constexpr size_t WS_MODS = 1 * MiB;
constexpr size_t WS_XSA = 2 * MiB, WS_XSB = WS_XSA + RF;
constexpr size_t WS_XL = WS_XSB + RF;
constexpr size_t WS_RKV = WS_XL + 6 * RB;
constexpr size_t WS_L1 = WS_RKV + 3 * RF;
constexpr size_t WS_WDEC = WS_L1 + 50 * MiB;
constexpr size_t WS_AA = WS_WDEC + 2 * RF;
constexpr size_t WS_G = WS_AA + 2 * RF;
constexpr size_t WS_KK = WS_G + RB;
constexpr size_t WS_KD = WS_KK + RF;
constexpr size_t WS_BETA = WS_KD + 2 * RF;
constexpr size_t WS_RKB = WS_BETA + 2 * RF;
constexpr size_t WS_C12 = WS_RKB + 3 * MiB;
constexpr size_t WS_Y = WS_C12 + 9 * MiB;
constexpr size_t WS_Z = WS_Y + 2 * RF;
constexpr size_t WS_H2 = WS_Z + RB;
constexpr size_t WS_SLOTL = WS_H2 + RB;
constexpr size_t WS_GATEL = WS_SLOTL + 5 * MiB;
constexpr size_t WS_WRKV = WS_GATEL + 5 * MiB;
constexpr size_t WS_L2T = WS_WRKV + 15 * MiB;
constexpr size_t WS_WO = WS_L2T + 5 * MiB;
constexpr size_t WS_WIN = WS_WO + 4 * MiB;
constexpr size_t WS_WOUT = WS_WIN + 12 * MiB;
constexpr size_t WS_WGU = WS_WOUT + 4 * MiB;
constexpr size_t WS_WDN = WS_WGU + 512 * MiB;
constexpr size_t WS_END = WS_WDN + 256 * MiB;
constexpr size_t WS_INTER = WS_WDEC;
constexpr size_t WS_YS = WS_KD;
constexpr size_t WS_BG = WS_RKV, WS_CUZ = WS_RKV + RB;
constexpr size_t WS_RAWW = WS_AA, WS_RAWA = WS_AA + RF;
constexpr size_t WS_RH = WS_AA;
constexpr size_t WS_PM = WS_AA + RF;
constexpr size_t WS_QT = WS_XL;
constexpr size_t WS_HT = WS_XL + RF;
static_assert((size_t)128 * 132 * 4096 * 2 <= RF, "chunk state tensors");
static_assert((size_t)MAXTILES * 256 * 1024 * 2 <= 4 * RF, "INTER overlay");
static_assert((size_t)T * 4 * 1024 * 2 <= 2 * RF, "YS overlay");
static_assert((size_t)3 * T * 256 * 2 <= 50 * MiB, "L1OUT");
constexpr int CW_BAR = 4096;
constexpr int CW_CNT = 16384, CNT_STRIDE = 64;

constexpr int RING_BYTES = 131072;
constexpr int LDSCTL_OFF = RING_BYTES;
constexpr int LDS_BYTES = 147456;

struct Args { const float* in[33]; float* out; unsigned char* ws; int ph_lo, ph_hi; };

__device__ __forceinline__ void transpose_item(const float* W, int N, bf16* WT, int dstK, int drow0, int k0, int n0, LAS float* scr, int lane) {
    float tv[32];
#pragma unroll
    for (int i = 0; i < 32; ++i) { const int kk = 2 * i + (lane >> 5); tv[i] = W[(size_t)(k0 + kk) * N + n0 + (lane & 31)]; }
#pragma unroll
    for (int i = 0; i < 32; ++i) { const int kk = 2 * i + (lane >> 5); scr[kk * 33 + (lane & 31)] = tv[i]; }
    LDS_WAIT(); asm volatile("" ::: "memory");
    const int c = lane & 7;
#pragma unroll
    for (int j = 0; j < 4; ++j) { const int n = (lane >> 3) + 8 * j; const LAS float* s = scr + (8 * c) * 33 + n;
        u32x4 o; o.x = pk2(s[0 * 33], s[1 * 33]); o.y = pk2(s[2 * 33], s[3 * 33]); o.z = pk2(s[4 * 33], s[5 * 33]); o.w = pk2(s[6 * 33], s[7 * 33]);
        *(u32x4*)(WT + (size_t)(drow0 + n) * dstK + k0 + 8 * c) = o; }
    LDS_WAIT(); asm volatile("" ::: "memory");
}
__device__ __forceinline__ int gu_map(int n0) { const int bj = n0 >= 1024 ? 1 : 0, f0 = n0 - bj * 1024; return (f0 >> 7) * 256 + bj * 128 + (f0 & 127); }
__device__ __forceinline__ int conv_map(int n0) { if (n0 < 1024) return n0; const int q = (n0 - 1024) >> 10, f0 = (n0 - 1024) & 1023; return 1024 + (f0 >> 7) * 256 + q * 128 + (f0 & 127); }

__device__ __forceinline__ void p0_prologue(const Args& a, LAS unsigned char* lds, int tid, int lane, int wave, int G) {
    unsigned char* ws = a.ws;
    LAS float* sl = (LAS float*)lds;
    LAS float* red = (LAS float*)(lds + 20480);
    for (int i = tid; i < 5 * 1024; i += 512) { const int r = i >> 10, k = i & 1023; const float cv = r < 4 ? a.in[1][r * 1024 + k] : a.in[3][k]; sl[i] = cv / (1.0f + __expf(-cv)); }
    __syncthreads();
    float* MODS = (float*)(ws + WS_MODS);
    for (int it = blockIdx.x; it < 4 * 96; it += G) {
        const int l = it / 96, n = (it % 96) * 64 + lane;
        const float* W = a.in[4] + (size_t)l * 1024 * 6144 + n;
        float acc[5] = {0.f, 0.f, 0.f, 0.f, 0.f};
        const int kb = wave * 128;
#pragma unroll 8
        for (int k = 0; k < 128; ++k) { const float wv = W[(size_t)(kb + k) * 6144];
#pragma unroll
            for (int r = 0; r < 5; ++r) acc[r] += sl[r * 1024 + kb + k] * wv; }
#pragma unroll
        for (int r = 0; r < 5; ++r) red[(wave * 5 + r) * 64 + lane] = acc[r];
        __syncthreads();
        if (wave < 5) { float s = a.in[5][l * 6144 + n];
#pragma unroll
            for (int w = 0; w < 8; ++w) s += red[(w * 5 + wave) * 64 + lane];
            MODS[(size_t)(l * 5 + wave) * 6144 + n] = s; }
        __syncthreads();
    }
    LAS float* scr = (LAS float*)(lds + 32768 + wave * 8448);
    const int gw = blockIdx.x * 8 + wave, NGW = G * 8;
    bf16* WRKV = (bf16*)(ws + WS_WRKV); bf16* WOt = (bf16*)(ws + WS_WO); bf16* WINt = (bf16*)(ws + WS_WIN); bf16* WOUTt = (bf16*)(ws + WS_WOUT);
    bf16* WGU = (bf16*)(ws + WS_WGU); bf16* WDN = (bf16*)(ws + WS_WDN);
    constexpr int I_GU = 128 * 1024, I_DN = 128 * 512, I_RKV = 6 * 512, I_WO = 2 * 512, I_WIN = 2 * 1536, I_WOUT = 2 * 512, I_W1 = 4 * 32, I_A1 = 4 * 32, I_G1 = 2 * 64;
    constexpr int NITEMS = I_GU + I_DN + I_RKV + I_WO + I_WIN + I_WOUT + I_W1 + I_A1 + I_G1;
    for (int it = gw; it < NITEMS; it += NGW) {
        int r = it;
        if (r < I_GU) { const int m = r >> 10, q = r & 1023, kb = q >> 6, nb = q & 63;
            transpose_item(a.in[29] + (size_t)m * 1024 * 2048, 2048, WGU + (size_t)m * 2048 * 1024, 1024, gu_map(nb * 32), kb * 64, nb * 32, scr, lane); continue; } r -= I_GU;
        if (r < I_DN) { const int m = r >> 9, q = r & 511, kb = q >> 5, nb = q & 31;
            transpose_item(a.in[31] + (size_t)m * 1024 * 1024, 1024, WDN + (size_t)m * 1024 * 1024, 1024, nb * 32, kb * 64, nb * 32, scr, lane); continue; } r -= I_DN;
        if (r < I_RKV) { const int m = r >> 9, q = r & 511, kb = q >> 5, nb = q & 31, lr = m / 3, j = m % 3;
            transpose_item(a.in[9] + (size_t)m * 1024 * 1024, 1024, WRKV + (size_t)lr * 3840 * 1024, 1024, j * 1024 + nb * 32, kb * 64, nb * 32, scr, lane); continue; } r -= I_RKV;
        if (r < I_WO) { const int m = r >> 9, q = r & 511, kb = q >> 5, nb = q & 31;
            transpose_item(a.in[23] + (size_t)m * 1024 * 1024, 1024, WOt + (size_t)m * 1024 * 1024, 1024, nb * 32, kb * 64, nb * 32, scr, lane); continue; } r -= I_WO;
        if (r < I_WIN) { const int m = r / 1536, q = r % 1536, kb = q / 96, nb = q % 96;
            transpose_item(a.in[24] + (size_t)m * 1024 * 3072, 3072, WINt + (size_t)m * 3072 * 1024, 1024, conv_map(nb * 32), kb * 64, nb * 32, scr, lane); continue; } r -= I_WIN;
        if (r < I_WOUT) { const int m = r >> 9, q = r & 511, kb = q >> 5, nb = q & 31;
            transpose_item(a.in[26] + (size_t)m * 1024 * 1024, 1024, WOUTt + (size_t)m * 1024 * 1024, 1024, nb * 32, kb * 64, nb * 32, scr, lane); continue; } r -= I_WOUT;
        if (r < I_W1) { const int m = r >> 5, q = r & 31, kb = q >> 1, nb = q & 1, lr = m >> 1, e = m & 1;
            transpose_item(a.in[11] + (size_t)m * 1024 * 64, 64, WRKV + (size_t)lr * 3840 * 1024, 1024, 3072 + e * 64 + nb * 32, kb * 64, nb * 32, scr, lane); continue; } r -= I_W1;
        if (r < I_A1) { const int m = r >> 5, q = r & 31, kb = q >> 1, nb = q & 1, lr = m >> 1, e = m & 1;
            transpose_item(a.in[14] + (size_t)m * 1024 * 64, 64, WRKV + (size_t)lr * 3840 * 1024, 1024, 3328 + e * 64 + nb * 32, kb * 64, nb * 32, scr, lane); continue; } r -= I_A1;
        { const int m = r >> 6, q = r & 63, kb = q >> 2, nb = q & 3;
            transpose_item(a.in[16] + (size_t)m * 1024 * 128, 128, WRKV + (size_t)m * 3840 * 1024, 1024, 3584 + nb * 32, kb * 64, nb * 32, scr, lane); }
    }
    const int gt = blockIdx.x * 512 + tid, NGT = G * 512;
    for (int i = gt; i < 2 * 3 * 128 * 128; i += NGT) {
        const int pc = i & 127, rw = (i >> 7) & 127, pd = (i >> 14) % 3, lr = i / (3 * 16384);
        *(u32x4*)(WRKV + ((size_t)lr * 3840 + 3072 + pd * 256 + 128 + rw) * 1024 + pc * 8) = (u32x4){0u, 0u, 0u, 0u}; }
    bf16* L2T = (bf16*)(ws + WS_L2T);
    for (int i = gt; i < 2 * 128 * 5120; i += NGT) {
        const int n = i % 5120, k = (i / 5120) & 127, lr = i / (5120 * 128);
        float v = 0.f;
        if (n < 2048) { const int e = n >> 10, d = n & 1023; if ((k >> 6) == e) v = a.in[12][(((size_t)lr * 2 + e) * 64 + (k & 63)) * 1024 + d]; }
        else if (n < 4096) { const int e = (n - 2048) >> 10, d = n & 1023; if ((k >> 6) == e) v = a.in[15][(((size_t)lr * 2 + e) * 64 + (k & 63)) * 1024 + d]; }
        else { const int d = n - 4096; v = a.in[17][((size_t)lr * 128 + k) * 1024 + d]; }
        L2T[((size_t)lr * 5120 + n) * 128 + k] = (bf16)f2bf(v);
    }
}
#define XB_TMO      128
#define XB_XCNT(j)  (256  + 64 * (j))
#define XB_XSUB(j)  (1280 + 64 * (j))
#define XB_XGEN(j)  (2304 + 64 * (j))
#define XB_TOP      3328
#define XB_TOPGEN   3392
#define XCD_BAR_WORDS 3456
#define XB_SPIN_CAP (1u << 23)

__device__ __forceinline__ unsigned xb_ld(unsigned* p)              { return __hip_atomic_load(p, __ATOMIC_RELAXED, __HIP_MEMORY_SCOPE_AGENT); }
__device__ __forceinline__ unsigned xb_add(unsigned* p, unsigned v) { return __hip_atomic_fetch_add(p, v, __ATOMIC_RELAXED, __HIP_MEMORY_SCOPE_AGENT); }
__device__ __forceinline__ unsigned xb_xcc_id() { return (unsigned)__builtin_amdgcn_s_getreg((3 << 11) | 20) & 0xFu; }
#define XB_SPIN(cond, bar) do { unsigned _sp = 0; while (cond) { __builtin_amdgcn_s_sleep(1); \
    if ((++_sp & 255u) == 0u) { if (xb_ld(&(bar)[XB_TMO])) break; if (_sp > XB_SPIN_CAP) { atomicAdd(&(bar)[XB_TMO], 1u); break; } } } } while (0)

struct XcdBarrier {
    unsigned wv;
    unsigned* bar; unsigned x;
    volatile LAS unsigned* st;
};

__device__ __forceinline__ XcdBarrier xcd_barrier_post(unsigned* bar, volatile LAS unsigned* st) {
    XcdBarrier b; b.wv = (unsigned)__builtin_amdgcn_readfirstlane((int)(threadIdx.x >> 6)); b.bar = bar; b.x = xb_xcc_id(); b.st = st;
    if (threadIdx.x == 0) (void)xb_add(&bar[XB_XCNT(b.x)], 1u);
    return b;
}
__device__ __forceinline__ void xcd_barrier_complete(unsigned* bar, unsigned x, unsigned& nloc, unsigned& nx) {
    const unsigned G = gridDim.x * gridDim.y * gridDim.z;
    unsigned sum, cnt, mine, sp = 0u;
    for (;;) {
        sum = 0u; cnt = 0u; mine = 0u;
#pragma unroll
        for (unsigned j = 0; j < 16; ++j) { const unsigned c = xb_ld(&bar[XB_XCNT(j)]); sum += c; cnt += (c > 0u) ? 1u : 0u; mine = (j == x) ? c : mine; }
        if (sum == G) break;
        __builtin_amdgcn_s_sleep(1);
        if ((++sp & 255u) == 0u) { if (xb_ld(&bar[XB_TMO])) break; if (sp > XB_SPIN_CAP) { atomicAdd(&bar[XB_TMO], 1u); break; } }
    }
    nloc = mine > 0u ? mine : 1u; nx = cnt > 0u ? cnt : 1u;
}

__device__ __forceinline__ void xcd_barrier(const XcdBarrier& b) {
    asm volatile("s_waitcnt vmcnt(0)" ::: "memory");
    __syncthreads();
    if (b.wv == 0u && lane_id() == 0) {
        unsigned* bar = b.bar;
        __builtin_amdgcn_s_waitcnt(0);
        unsigned nloc = b.st[0], nx = b.st[1];
        if (nloc == 0u) { xcd_barrier_complete(bar, b.x, nloc, nx); b.st[0] = nloc; b.st[1] = nx; }
        const unsigned old = xb_add(&bar[XB_XSUB(b.x)], 1u);
        const unsigned gen = old / nloc;
        if (old + 1u == (gen + 1u) * nloc) {
            __builtin_amdgcn_fence(__ATOMIC_RELEASE, "agent");
            asm volatile("s_waitcnt vmcnt(0)" ::: "memory");
            const unsigned og = xb_add(&bar[XB_TOP], 1u);
            const unsigned tg = og / nx;
            if (og + 1u == (tg + 1u) * nx) xb_add(&bar[XB_TOPGEN], 1u);
            else XB_SPIN(xb_ld(&bar[XB_TOPGEN]) == tg, bar);
            __builtin_amdgcn_fence(__ATOMIC_ACQUIRE, "agent");
            xb_add(&bar[XB_XGEN(b.x)], 1u);
            asm volatile("s_waitcnt vmcnt(0)" ::: "memory");
        } else {
            XB_SPIN(xb_ld(&bar[XB_XGEN(b.x)]) == gen, bar);
            __builtin_amdgcn_fence(__ATOMIC_ACQUIRE, "agent");
            asm volatile("s_waitcnt vmcnt(0)" ::: "memory");
        }
    }
    __syncthreads();
}

__device__ __forceinline__ int mod_row(int row) { return row < TL ? (row >> 13) : 4; }

__device__ __forceinline__ void load_x_combined(f32x4 (&x)[4], const float* xrow, bool has_prev, const bf16* YS, int t, const f32x4 (&m5)[4], int lane) {
#pragma unroll
    for (int j = 0; j < 4; ++j) x[j] = *(const f32x4*)(xrow + 256 * j + 4 * lane);
    if (has_prev) {
        f32x4 s[4];
#pragma unroll
        for (int j = 0; j < 4; ++j) s[j] = (f32x4){0.f, 0.f, 0.f, 0.f};
#pragma unroll
        for (int k = 0; k < 4; ++k) { const bf16* yr = YS + ((size_t)t * 4 + k) * 1024;
#pragma unroll
            for (int j = 0; j < 4; ++j) { const u32x2 w = *(const u32x2*)(yr + 256 * j + 4 * lane); s[j] += (f32x4){bflo(w.x), bfhi(w.x), bflo(w.y), bfhi(w.y)}; } }
#pragma unroll
        for (int j = 0; j < 4; ++j) x[j] += m5[j] * s[j];
    }
}
__device__ __forceinline__ float row_rstd(const f32x4 (&x)[4]) {
    float ss = 0.f;
#pragma unroll
    for (int j = 0; j < 4; ++j) ss += (x[j].x * x[j].x + x[j].y * x[j].y) + (x[j].z * x[j].z + x[j].w * x[j].w);
    return rsqrtf(wave_sum(ss) * (1.0f / 1024.0f) + 1e-6f);
}

__device__ __forceinline__ void phase_a_rwkv(const Args& a, int layer, LAS unsigned char* lds, int tid, int gw, int NGW, int lane) {
    unsigned char* ws = a.ws; const int lj = layer >> 1; const bool has_prev = layer > 0;
    const float* xin_lat = layer == 0 ? a.in[0] : (const float*)(ws + WS_XSA);
    const float* xin_ctx = layer == 0 ? a.in[2] : (const float*)(ws + WS_XSA) + (size_t)TL * D;
    float* xout = (float*)(ws + (layer == 0 ? WS_XSA : WS_XSB));
    const float* MODS = (const float*)(ws + WS_MODS); const bf16* YS = (const bf16*)(ws + WS_YS); bf16* XL = (bf16*)(ws + WS_XL);
    const float* mug = a.in[8] + (size_t)lj * 6 * 2 * 1024; const float* ng = a.in[6] + (size_t)(layer * 2 + 0) * 1024;
    LAS float* mu = (LAS float*)lds;
    for (int i = tid; i < 6 * 2 * 1024 / 4; i += 512) ((LAS f32x4*)mu)[i] = ((const f32x4*)mug)[i];
    __syncthreads();
    for (int it = gw; it < TL / 8 + TC / 2; it += NGW) {
        const int ntok = it < TL / 8 ? 8 : 2, t0 = it < TL / 8 ? it * 8 : TL + (it - TL / 8) * 2, mr = mod_row(t0);
        int rs, re; if (t0 < TL) { rs = t0 & ~63; re = rs + 63; } else { const int loc = t0 - TL; rs = TL + (loc & ~255); re = rs + 255; }
        const float* mod = MODS + (size_t)(layer * 5 + mr) * 6144;
        const float* m5p = MODS + (size_t)((has_prev ? layer - 1 : 0) * 5 + mr) * 6144 + 5 * 1024;
        f32x4 hm[4], h0[4], hp[4];
#pragma unroll
        for (int j = 0; j < 4; ++j) { hm[j] = (f32x4){0.f, 0.f, 0.f, 0.f}; h0[j] = hm[j]; hp[j] = hm[j]; }
        f32x4 rx[4], nx[4]; u32x2 ry[4][4], ny[4][4];
#define PA_LOAD(X, Y, tt) do { const int t_ = (tt); if (t_ >= rs && t_ <= re) { \
            const float* xrow_ = t_ < TL ? xin_lat + (size_t)t_ * D : xin_ctx + (size_t)(t_ - TL) * D; \
            _Pragma("unroll") for (int j = 0; j < 4; ++j) X[j] = *(const f32x4*)(xrow_ + 256 * j + 4 * lane); \
            if (has_prev) { _Pragma("unroll") for (int k = 0; k < 4; ++k) _Pragma("unroll") for (int j = 0; j < 4; ++j) Y[k][j] = *(const u32x2*)(YS + ((size_t)t_ * 4 + k) * 1024 + 256 * j + 4 * lane); } } } while (0)
#pragma unroll
        for (int j = 0; j < 4; ++j) { rx[j] = (f32x4){0.f, 0.f, 0.f, 0.f}; nx[j] = rx[j];
#pragma unroll
            for (int k = 0; k < 4; ++k) { ry[k][j] = (u32x2){0u, 0u}; ny[k][j] = ry[k][j]; } }
        PA_LOAD(rx, ry, t0 - 1);
#pragma unroll 1
        for (int i = -1; i <= ntok; ++i) {
            const int t = t0 + i;
            if (i < ntok) PA_LOAD(nx, ny, t + 1);
            f32x4 hn[4];
            if (t >= rs && t <= re) {
                f32x4 x[4];
#pragma unroll
                for (int j = 0; j < 4; ++j) x[j] = rx[j];
                if (has_prev) {
#pragma unroll
                    for (int j = 0; j < 4; ++j) { f32x4 sm = (f32x4){0.f, 0.f, 0.f, 0.f};
#pragma unroll
                        for (int k = 0; k < 4; ++k) sm += (f32x4){bflo(ry[k][j].x), bfhi(ry[k][j].x), bflo(ry[k][j].y), bfhi(ry[k][j].y)};
                        x[j] += *(const f32x4*)(m5p + 256 * j + 4 * lane) * sm; } }
                if (i >= 0 && i < ntok) {
#pragma unroll
                    for (int j = 0; j < 4; ++j) *(f32x4*)(xout + (size_t)t * D + 256 * j + 4 * lane) = x[j]; }
                const float rstd = row_rstd(x);
#pragma unroll
                for (int j = 0; j < 4; ++j) { const int col = 256 * j + 4 * lane; hn[j] = x[j] * rstd * *(const f32x4*)(ng + col) * (*(const f32x4*)(mod + 1024 + col) + 1.0f) + *(const f32x4*)(mod + col); }
            } else {
#pragma unroll
                for (int j = 0; j < 4; ++j) hn[j] = (f32x4){0.f, 0.f, 0.f, 0.f};
            }
#pragma unroll
            for (int j = 0; j < 4; ++j) { hm[j] = h0[j]; h0[j] = hp[j]; hp[j] = hn[j]; rx[j] = nx[j];
#pragma unroll
                for (int k = 0; k < 4; ++k) ry[k][j] = ny[k][j]; }
            if (i >= 1) {
                const int te = t - 1;
#pragma unroll
                for (int q = 0; q < 6; ++q) {
                    bf16* orow = XL + ((size_t)q * T + te) * D;
#pragma unroll
                    for (int j = 0; j < 4; ++j) { const int col = 256 * j + 4 * lane;
                        const f32x4 m0 = *(const LAS f32x4*)(mu + (q * 2 + 0) * 1024 + col), m1 = *(const LAS f32x4*)(mu + (q * 2 + 1) * 1024 + col);
                        const f32x4 o = h0[j] + m0 * (hm[j] - h0[j]) + m1 * (hp[j] - h0[j]);
                        u32x2 w; w.x = pk2(o.x, o.y); w.y = pk2(o.z, o.w); *(u32x2*)(orow + col) = w; }
                }
            }
        }
#undef PA_LOAD
    }
}
__device__ __forceinline__ void phase_a_conv(const Args& a, int layer, int rows, int gw, int NGW, int lane) {
    unsigned char* ws = a.ws;
    float* xs = (float*)(ws + (layer < 2 ? WS_XSA : WS_XSB));
    const float* MODS = (const float*)(ws + WS_MODS); const bf16* YS = (const bf16*)(ws + WS_YS); bf16* H = (bf16*)(ws + WS_XL);
    const float* ng = a.in[6] + (size_t)(layer * 2 + 0) * 1024;
    for (int t = gw; t < rows; t += NGW) {
        const int mr = mod_row(t);
        const float* mod = MODS + (size_t)(layer * 5 + mr) * 6144;
        f32x4 m5[4], x[4];
#pragma unroll
        for (int j = 0; j < 4; ++j) m5[j] = *(const f32x4*)(MODS + (size_t)((layer - 1) * 5 + mr) * 6144 + 5 * 1024 + 256 * j + 4 * lane);
        load_x_combined(x, xs + (size_t)t * D, true, YS, t, m5, lane);
        const float rstd = row_rstd(x);
#pragma unroll
        for (int j = 0; j < 4; ++j) { const int col = 256 * j + 4 * lane;
            *(f32x4*)(xs + (size_t)t * D + col) = x[j];
            const f32x4 h = x[j] * rstd * *(const f32x4*)(ng + col) * (*(const f32x4*)(mod + 1024 + col) + 1.0f) + *(const f32x4*)(mod + col);
            u32x2 w; w.x = pk2(h.x, h.y); w.y = pk2(h.z, h.w); *(u32x2*)(H + (size_t)t * D + col) = w; }
    }
}
#define DPPF(x, ctrl) __builtin_bit_cast(float, __builtin_amdgcn_update_dpp(0, __builtin_bit_cast(int, (x)), (ctrl), 0xf, 0xf, false))
__device__ __forceinline__ float row16_sum(float v) { v += DPPF(v, 0xB1); v += DPPF(v, 0x4E); v += DPPF(v, 0x141); v += DPPF(v, 0x140); return v; }
__device__ __forceinline__ f32x4 bf4(u32x2 w) { return (f32x4){bflo(w.x), bfhi(w.x), bflo(w.y), bfhi(w.y)}; }
__device__ __forceinline__ u32x2 pk4(f32x4 v) { u32x2 w; w.x = pk2(v[0], v[1]); w.y = pk2(v[2], v[3]); return w; }
__device__ __forceinline__ void phase_c_prep(const Args& a, int lj, LAS unsigned char* lds, int tid, int gw, int NGW, int lane) {
    unsigned char* ws = a.ws;
    const bf16* Rr = (const bf16*)(ws + WS_RKV); const bf16* Kk = Rr + (size_t)T * D; const bf16* RA = (const bf16*)(ws + WS_RAWA); const bf16* RW = (const bf16*)(ws + WS_RAWW);
    bf16* KK = (bf16*)(ws + WS_KK); bf16* KD = (bf16*)(ws + WS_KD); bf16* BE = (bf16*)(ws + WS_BETA); float* RKB = (float*)(ws + WS_RKB);
    LAS float* tb = (LAS float*)lds;
    for (int i = tid; i < 7 * 256; i += 512) { const int t7 = i >> 8, q = i & 255;
        const float* src = t7 == 0 ? a.in[18] + lj * 1024 : t7 == 1 ? a.in[19] + lj * 1024 : t7 == 2 ? a.in[20] + lj * 1024 : t7 < 5 ? a.in[10] + lj * 2048 + (t7 - 3) * 1024 : a.in[13] + lj * 2048 + (t7 - 5) * 1024;
        ((LAS f32x4*)tb)[i] = ((const f32x4*)src)[q]; }
    __syncthreads();
    for (int row = gw; row < T; row += NGW) {
#pragma unroll
        for (int j = 0; j < 4; ++j) {
            const int col = 256 * j + 4 * lane; const size_t ro = (size_t)row * D + col;
            const f32x4 k = bf4(*(const u32x2*)(Kk + ro)), r = bf4(*(const u32x2*)(Rr + ro));
            f32x4 a0 = bf4(*(const u32x2*)(RA + ro)) + *(const LAS f32x4*)(tb + 5 * 1024 + col), a1 = bf4(*(const u32x2*)(RA + (size_t)T * D + ro)) + *(const LAS f32x4*)(tb + 6 * 1024 + col);
#pragma unroll
            for (int z = 0; z < 4; ++z) { a0[z] = sigm(a0[z]); a1[z] = sigm(a1[z]); }
            const f32x4 ck = *(const LAS f32x4*)(tb + col), ca = *(const LAS f32x4*)(tb + 1024 + col), cr = *(const LAS f32x4*)(tb + 2048 + col);
            const f32x4 kk = k * ck;
            const float ss = row16_sum((kk.x * kk.x + kk.y * kk.y) + (kk.z * kk.z + kk.w * kk.w));
            const f32x4 kd0 = k * ((a0 - 1.0f) * ca + 1.0f), kd1 = k * ((a1 - 1.0f) * ca + 1.0f);
            *(u32x2*)(KD + ro) = pk4(kd0); *(u32x2*)(KD + (size_t)T * D + ro) = pk4(kd1);
            const f32x4 p = r * (kd0 + kd1) * cr;
            const float rk = row16_sum((p.x + p.y) + (p.z + p.w));
            const f32x4 kkn = kk * (1.0f / fmaxf(sqrtf(ss), 1e-12f));
            *(u32x2*)(KK + ro) = pk4(kkn); *(u32x2*)(BE + ro) = pk4(kkn * a0); *(u32x2*)(BE + (size_t)T * D + ro) = pk4(kkn * a1);
            if ((lane & 15) == 0) RKB[(size_t)row * 16 + 4 * j + (lane >> 4)] = rk;
        }
    }
}
typedef short bf16x8 __attribute__((ext_vector_type(8)));
__device__ __forceinline__ f32x4 mfma16(bf16x8 a, bf16x8 b, f32x4 c) { return __builtin_amdgcn_mfma_f32_16x16x32_bf16(a, b, c, 0, 0, 0); }
__device__ __forceinline__ bf16x8 as_frag(u32x4 w) { return __builtin_bit_cast(bf16x8, w); }
constexpr int CH_LD = 144;
constexpr int CH_MS = 64 * CH_LD;
constexpr int CH_AB = 0 * CH_MS, CH_KT = 1 * CH_MS, CH_BT = 2 * CH_MS, CH_RB = 3 * CH_MS, CH_VT = 4 * CH_MS, CH_ABT = 5 * CH_MS, CH_KHT = 6 * CH_MS, CH_BHT = 7 * CH_MS,
              CH_LK = 8 * CH_MS, CH_LB = 9 * CH_MS, CH_MK = 10 * CH_MS, CH_MB = 11 * CH_MS, CH_WT = 12 * CH_MS, CH_U0 = 13 * CH_MS, CH_DINV = 14 * CH_MS;
constexpr int CH_GC = LDSCTL_OFF + 2048;
constexpr int CH_PART = LDSCTL_OFF + 4096;
constexpr int NCHUNK = NSTEP / 64;
#ifndef S1_DBL
#define S1_DBL 0
#endif
static_assert(CH_DINV + 2048 <= RING_BYTES, "chunk LDS map");

__device__ __forceinline__ int scan_row(int s, int dir, int b) {
    if (s < CTXL) return TL + b * CTXL + (dir ? CTXL - 1 - s : s);
    const int i = s - CTXL; return b * SEQ + (dir ? SEQ - 1 - i : i);
}
#define CH_FRAG(mat, row, ks, kg) as_frag(*(const LAS u32x4*)(lds + (mat) + (row) * CH_LD + ((ks) * 32 + (kg) * 8) * 2))

#define S1_BAR() do { asm volatile("s_waitcnt lgkmcnt(0)" ::: "memory"); __builtin_amdgcn_s_barrier(); asm volatile("" ::: "memory"); } while (0)
__device__ __forceinline__ void phase_s1_chunks(const Args& a, int lj, LAS unsigned char* lds, int tid, int G, int rh_scratch = 0) {
    unsigned char* ws = a.ws; const float* w0l = a.in[10] + lj * 2048;
    const int lane = tid & 63, wave = __builtin_amdgcn_readfirstlane(tid >> 6), l15 = lane & 15, g = lane >> 4;
    LAS float* part = (LAS float*)(lds + CH_PART); LAS float* gammaC = (LAS float*)(lds + CH_GC);
    float nlw[8], nkd[8], nbe[8], nkk[8], nrr[8], nvv[8], nw0 = 0.f;
#define S1_LOAD(ctx_) do { unsigned char* wsl = ws; asm volatile("" : "+s"(wsl));     \
        const int chain_ = (ctx_) / NCHUNK, c_ = (ctx_) - chain_ * NCHUNK, dir_ = chain_ >> 6, b_ = (chain_ >> 4) & 3, h_ = chain_ & 15; \
          \
        const long o0 = (long)scan_row(64 * c_ + 8 * wave, dir_, b_) * D + h_ * 64 + lane, od = (long)dir_ * T * D, st = dir_ ? -(long)D : (long)D; \
        const bf16* LWp = (const bf16*)(wsl + WS_RAWW) + od + o0; const bf16* KDp = (const bf16*)(wsl + WS_KD) + od + o0; const bf16* BEp = (const bf16*)(wsl + WS_BETA) + od + o0; \
        const bf16* KKp = (const bf16*)(wsl + WS_KK) + o0; const bf16* Rp = (const bf16*)(wsl + WS_RKV) + o0; const bf16* Vp = Rp + (size_t)2 * T * D; \
        nw0 = w0l[dir_ * 1024 + h_ * 64 + lane]; \
        _Pragma("unroll") for (int j = 0; j < 8; ++j) { const long oj = st * j; \
            nlw[j] = bflo((unsigned)LWp[oj]); nkd[j] = bflo((unsigned)KDp[oj]); nbe[j] = bflo((unsigned)BEp[oj]); nkk[j] = bflo((unsigned)KKp[oj]); nrr[j] = bflo((unsigned)Rp[oj]); nvv[j] = bflo((unsigned)Vp[oj]); } } while (0)
    if ((int)blockIdx.x < 128 * NCHUNK) S1_LOAD((int)blockIdx.x);
    for (int ct = blockIdx.x; ct < 128 * NCHUNK; ct += G) {
        const int chain = ct / NCHUNK, c = ct - chain * NCHUNK, dir = chain >> 6, b = (chain >> 4) & 3, h = chain & 15;
        unsigned zq = 0u; asm volatile("" : "+v"(zq));
        {
            const int k = lane, tq = wave;
            float lw[8], kd[8], be[8], kk[8], rr[8], vv[8];
const float w0k = nw0;
#pragma unroll
            for (int j = 0; j < 8; ++j) { lw[j] = -0.60653066f * sigm(nlw[j] + w0k); kd[j] = nkd[j]; be[j] = nbe[j]; kk[j] = nkk[j]; rr[j] = nrr[j]; vv[j] = nvv[j]; }
            if (ct + G < 128 * NCHUNK) S1_LOAD(ct + G);
            for (int r0_ = 0; r0_ <= ((S1_DBL >> 3) & 1); ++r0_) { if (r0_) S1_BAR();
            float p[8]; p[0] = lw[0];
#pragma unroll
            for (int j = 1; j < 8; ++j) p[j] = p[j - 1] + lw[j];
            part[tq * 64 + k] = p[7];
            S1_BAR();
            float off = 0.f, tot = 0.f;
#pragma unroll
            for (int q = 0; q < 8; ++q) { const float pv = part[q * 64 + k]; tot += pv; off += q < tq ? pv : 0.f; }
            const float eTot = __expf(tot); float ePrev = __expf(off);
            if (tq == 0) gammaC[k] = eTot;
            unsigned abw[4], khw[4], bhw[4], vw[4];
#pragma unroll
            for (int j = 0; j < 8; j += 2) {
                float ab2[2], kt2[2], bt2[2], rb2[2], kh2[2], bh2[2];
#pragma unroll
                for (int z = 0; z < 2; ++z) { const float cu = off + p[j + z]; const float eP = __expf(cu), eM = __expf(-cu), eC = eTot * eM;
                    ab2[z] = kk[j + z] * ePrev; ePrev = eP; kt2[z] = kd[j + z] * eM; bt2[z] = be[j + z] * eM; rb2[z] = rr[j + z] * eP; kh2[z] = kd[j + z] * eC; bh2[z] = be[j + z] * eC;
                    const int t = 8 * tq + j + z;
                    *(LAS bf16*)(lds + CH_AB + t * CH_LD + k * 2) = (bf16)f2bf(ab2[z]); *(LAS bf16*)(lds + CH_KT + t * CH_LD + k * 2) = (bf16)f2bf(kt2[z]);
                    *(LAS bf16*)(lds + CH_BT + t * CH_LD + k * 2) = (bf16)f2bf(bt2[z]); *(LAS bf16*)(lds + CH_RB + t * CH_LD + k * 2) = (bf16)f2bf(rb2[z]); }
                abw[j >> 1] = pk2(ab2[0], ab2[1]); khw[j >> 1] = pk2(kh2[0], kh2[1]); bhw[j >> 1] = pk2(bh2[0], bh2[1]); vw[j >> 1] = pk2(vv[j], vv[j + 1]);
            }
            *(LAS u32x4*)(lds + CH_ABT + k * CH_LD + tq * 16) = (u32x4){abw[0], abw[1], abw[2], abw[3]};
            *(LAS u32x4*)(lds + CH_KHT + k * CH_LD + tq * 16) = (u32x4){khw[0], khw[1], khw[2], khw[3]};
            *(LAS u32x4*)(lds + CH_BHT + k * CH_LD + tq * 16) = (u32x4){bhw[0], bhw[1], bhw[2], bhw[3]};
            *(LAS u32x4*)(lds + CH_VT + k * CH_LD + tq * 16) = (u32x4){vw[0], vw[1], vw[2], vw[3]};
            *(LAS u32x4*)(lds + CH_WT + k * CH_LD + tq * 16) = (u32x4){zq, zq, zq, zq}; *(LAS u32x4*)(lds + CH_U0 + k * CH_LD + tq * 16) = (u32x4){zq, zq, zq, zq};
            }
        }
        S1_BAR();
        for (int r1_ = 0; r1_ <= (S1_DBL & 1); ++r1_) { if (r1_) S1_BAR();
            const int mi = wave >> 1, half = wave & 1;
            const int matS = (mi & 1) ? CH_BT : CH_KT, matT = (mi & 2) ? CH_RB : CH_AB, matO = CH_LK + mi * CH_MS;
            const bool incl = (mi & 2) != 0;
            bf16x8 fs[4][2], ft[2][2];
#pragma unroll
            for (int ms = 0; ms < 4; ++ms)
#pragma unroll
                for (int ks = 0; ks < 2; ++ks) fs[ms][ks] = CH_FRAG(matS, 16 * ms + l15, ks, g);
#pragma unroll
            for (int nt = 0; nt < 2; ++nt)
#pragma unroll
                for (int ks = 0; ks < 2; ++ks) ft[nt][ks] = CH_FRAG(matT, 32 * half + 16 * nt + l15, ks, g);
#pragma unroll
            for (int nt = 0; nt < 2; ++nt) { const int t = 32 * half + 16 * nt + l15;
#pragma unroll
                for (int ms = 0; ms < 4; ++ms) { f32x4 d = (f32x4){0.f, 0.f, 0.f, 0.f};
                    d = mfma16(fs[ms][0], ft[nt][0], d); d = mfma16(fs[ms][1], ft[nt][1], d);
                    const int s0 = 16 * ms + 4 * g;
#pragma unroll
                    for (int i = 0; i < 4; ++i) { const bool keep = incl ? (s0 + i <= t) : (s0 + i < t); d[i] = keep ? d[i] : __builtin_bit_cast(float, zq); }
                    u32x2 w; w.x = pk2(d[0], d[1]); w.y = pk2(d[2], d[3]);
                    *(LAS u32x2*)(lds + matO + t * CH_LD + s0 * 2) = w; } }
        }
        S1_BAR();
        f32x4 rhsU[4];
#pragma unroll
        for (int I = 0; I < 4; ++I) rhsU[I] = (f32x4){0.f, 0.f, 0.f, 0.f};
        if (wave >= 4) {
            const int ctv = (wave & 3) * 16;
            const bf16x8 fv0 = CH_FRAG(CH_VT, ctv + l15, 0, g), fv1 = CH_FRAG(CH_VT, ctv + l15, 1, g);
#pragma unroll
            for (int I = 0; I < 4; ++I) { f32x4 d = (f32x4){0.f, 0.f, 0.f, 0.f};
                d = mfma16(CH_FRAG(CH_LK, 16 * I + l15, 0, g), fv0, d); d = mfma16(CH_FRAG(CH_LK, 16 * I + l15, 1, g), fv1, d); rhsU[I] = -d; }
        }
        for (int r2_ = 0; r2_ <= ((S1_DBL >> 1) & 1); ++r2_) if (wave == 0) {
            const int bb = lane >> 4, j = lane & 15;
            float x[16];
#pragma unroll
            for (int t = 0; t < 16; ++t) {
                const u32x4 r0 = *(const LAS u32x4*)(lds + CH_LB + (16 * bb + t) * CH_LD + 32 * bb), r1 = *(const LAS u32x4*)(lds + CH_LB + (16 * bb + t) * CH_LD + 32 * bb + 16);
                const unsigned rw[8] = {r0.x, r0.y, r0.z, r0.w, r1.x, r1.y, r1.z, r1.w};
                float acc = (t == j) ? 1.0f : 0.0f;
#pragma unroll
                for (int s = 0; s < t; ++s) { const float lv = (s & 1) ? bfhi(rw[s >> 1]) : bflo(rw[s >> 1]); acc -= lv * x[s]; }
                x[t] = acc;
                *(LAS bf16*)(lds + CH_DINV + ((bb * 16 + t) * 16 + j) * 2) = (bf16)f2bf(acc);
            }
        }
        S1_BAR();
        {
            const int matZ = wave < 4 ? CH_WT : CH_U0, ct16 = (wave & 3) * 16;
            for (int r4_ = 0; r4_ <= ((S1_DBL >> 4) & 1); ++r4_) { if (r4_) { *(LAS u32x4*)(lds + matZ + (ct16 + l15) * CH_LD + g * 32) = (u32x4){zq, zq, zq, zq}; *(LAS u32x4*)(lds + matZ + (ct16 + l15) * CH_LD + g * 32 + 16) = (u32x4){zq, zq, zq, zq}; LDS_WAIT(); }
#pragma unroll
            for (int I = 0; I < 4; ++I) {
                f32x4 rhs;
                if (wave < 4) { const u32x2 w = *(const LAS u32x2*)(lds + CH_ABT + (ct16 + l15) * CH_LD + (16 * I + 4 * g) * 2); rhs = (f32x4){bflo(w.x), bfhi(w.x), bflo(w.y), bfhi(w.y)}; }
                else rhs = rhsU[I];
                f32x4 d = (f32x4){0.f, 0.f, 0.f, 0.f};
                d = mfma16(CH_FRAG(CH_LB, 16 * I + l15, 0, g), CH_FRAG(matZ, ct16 + l15, 0, g), d); d = mfma16(CH_FRAG(CH_LB, 16 * I + l15, 1, g), CH_FRAG(matZ, ct16 + l15, 1, g), d);
                const f32x4 ac = rhs - d;
                const u32x2 dv = *(const LAS u32x2*)(lds + CH_DINV + ((I * 16 + l15) * 16 + 4 * g) * 2);
                const bf16x8 fa = as_frag((u32x4){dv.x, dv.y, zq, zq}), fb = as_frag((u32x4){pk2(ac[0], ac[1]), pk2(ac[2], ac[3]), zq, zq});
                const f32x4 z = mfma16(fa, fb, (f32x4){0.f, 0.f, 0.f, 0.f});
                u32x2 w; w.x = pk2(z[0], z[1]); w.y = pk2(z[2], z[3]);
                *(LAS u32x2*)(lds + matZ + (ct16 + l15) * CH_LD + (16 * I + 4 * g) * 2) = w;
                LDS_WAIT(); asm volatile("" ::: "memory");
            }
            }
        }
        S1_BAR();
        for (int r3_ = 0; r3_ <= ((S1_DBL >> 2) & 1); ++r3_) { if (r3_) S1_BAR();
            const int rt = wave >> 1, cp = (wave & 1) * 2;
            unsigned char* wsl = ws; asm volatile("" : "+s"(wsl));
            bf16* YL = (bf16*)(wsl + WS_Y); bf16* RH = (bf16*)(wsl + (rh_scratch ? WS_BETA + RF : WS_RH)); bf16* PM = (bf16*)(wsl + WS_PM); bf16* QT = (bf16*)(wsl + WS_QT);
            const int trow = scan_row(64 * c + 16 * rt + l15, dir, b);
#pragma unroll
            for (int q = 0; q < 2; ++q) { const int vt = cp + q; f32x4 d = (f32x4){0.f, 0.f, 0.f, 0.f};
#pragma unroll
                for (int ks = 0; ks < 2; ++ks) { d = mfma16(CH_FRAG(CH_VT, 16 * vt + l15, ks, g), CH_FRAG(CH_MK, 16 * rt + l15, ks, g), d); d = mfma16(CH_FRAG(CH_U0, 16 * vt + l15, ks, g), CH_FRAG(CH_MB, 16 * rt + l15, ks, g), d); }
                *(u32x2*)(YL + ((size_t)dir * T + trow) * D + h * 64 + 16 * vt + 4 * g) = pk4(d); }
#pragma unroll
            for (int q = 0; q < 2; ++q) { const int kt = cp + q; f32x4 d = (f32x4){0.f, 0.f, 0.f, 0.f};
#pragma unroll
                for (int ks = 0; ks < 2; ++ks) d = mfma16(CH_FRAG(CH_WT, 16 * kt + l15, ks, g), CH_FRAG(CH_MB, 16 * rt + l15, ks, g), d);
                const u32x2 rbw = *(const LAS u32x2*)(lds + CH_RB + (16 * rt + l15) * CH_LD + (16 * kt + 4 * g) * 2);
                u32x2 w; w.x = pk2(bflo(rbw.x) - d[0], bfhi(rbw.x) - d[1]); w.y = pk2(bflo(rbw.y) - d[2], bfhi(rbw.y) - d[3]);
                *(u32x2*)(RH + ((size_t)dir * T + trow) * D + h * 64 + 16 * kt + 4 * g) = w; }
            bf16* Pc = PM + ((size_t)chain * NCHUNK + c) * 4096; bf16* Qc = QT + ((size_t)chain * NCHUNK + c) * 4096;
            { const int krow = 16 * rt + l15; const float gc = gammaC[krow];
#pragma unroll
                for (int q = 0; q < 2; ++q) { const int kt = cp + q; f32x4 d = (f32x4){0.f, 0.f, 0.f, 0.f};
#pragma unroll
                    for (int ks = 0; ks < 2; ++ks) d = mfma16(CH_FRAG(CH_WT, 16 * kt + l15, ks, g), CH_FRAG(CH_BHT, krow, ks, g), d);
                    const int k0 = 16 * kt + 4 * g; f32x4 o;
#pragma unroll
                    for (int i = 0; i < 4; ++i) o[i] = ((k0 + i == krow) ? gc : 0.f) - d[i];
                    u32x2 w; w.x = pk2(o[0], o[1]); w.y = pk2(o[2], o[3]);
                    *(u32x2*)(Pc + krow * 64 + 32 * (kt >> 1) + 8 * g + 4 * (kt & 1)) = w; } }
            { const int vrow = 16 * rt + l15;
#pragma unroll
                for (int q = 0; q < 2; ++q) { const int kt = cp + q; f32x4 d = (f32x4){0.f, 0.f, 0.f, 0.f};
#pragma unroll
                    for (int ks = 0; ks < 2; ++ks) { d = mfma16(CH_FRAG(CH_KHT, 16 * kt + l15, ks, g), CH_FRAG(CH_VT, vrow, ks, g), d); d = mfma16(CH_FRAG(CH_BHT, 16 * kt + l15, ks, g), CH_FRAG(CH_U0, vrow, ks, g), d); }
                    u32x2 w; w.x = pk2(d[0], d[1]); w.y = pk2(d[2], d[3]);
                    *(u32x2*)(Qc + vrow * 64 + 16 * g + 4 * kt) = w; } }
        }
        S1_BAR();
    }
}

struct S2Set { u32x4 p[4][2]; u32x4 q[2]; };
__device__ __forceinline__ void s2_load(S2Set& s, const bf16* Pc, const bf16* Qc, int vt, int l15, int g) {
    s.q[0] = *(const u32x4*)(Qc + (16 * vt + l15) * 64 + 16 * g); s.q[1] = *(const u32x4*)(Qc + (16 * vt + l15) * 64 + 16 * g + 8);
#pragma unroll
    for (int m = 0; m < 4; ++m)
#pragma unroll
        for (int j = 0; j < 2; ++j) s.p[m][j] = *(const u32x4*)(Pc + (16 * m + l15) * 64 + 32 * j + 8 * g);
}
__device__ __forceinline__ void s2_step(f32x4 (&acc)[4], const S2Set& s, bf16* Hc, int g) {
    unsigned hw[4][2];
#pragma unroll
    for (int m = 0; m < 4; ++m) { hw[m][0] = pk2(acc[m][0], acc[m][1]); hw[m][1] = pk2(acc[m][2], acc[m][3]); }
#pragma unroll
    for (int m = 0; m < 4; ++m) *(u32x2*)(Hc + 16 * m + 4 * g) = (u32x2){hw[m][0], hw[m][1]};
    const bf16x8 hb0 = as_frag((u32x4){hw[0][0], hw[0][1], hw[1][0], hw[1][1]}), hb1 = as_frag((u32x4){hw[2][0], hw[2][1], hw[3][0], hw[3][1]});
#pragma unroll
    for (int m = 0; m < 4; ++m) {
        const unsigned q0 = (m & 2) ? ((m & 1) ? s.q[1].z : s.q[1].x) : ((m & 1) ? s.q[0].z : s.q[0].x), q1 = (m & 2) ? ((m & 1) ? s.q[1].w : s.q[1].y) : ((m & 1) ? s.q[0].w : s.q[0].y);
        f32x4 d = (f32x4){bflo(q0), bfhi(q0), bflo(q1), bfhi(q1)};
        d = mfma16(as_frag(s.p[m][0]), hb0, d);
        d = mfma16(as_frag(s.p[m][1]), hb1, d);
        acc[m] = d;
    }
}
__device__ __forceinline__ void phase_s2_chain(const Args& a, int wave, int lane, int G) {
    unsigned char* ws = a.ws;
    const bf16* PM = (const bf16*)(ws + WS_PM); const bf16* QT = (const bf16*)(ws + WS_QT); bf16* HT = (bf16*)(ws + WS_HT);
    const int l15 = lane & 15, g = lane >> 4;
    if (wave >= 2) return;
    static_assert(NCHUNK % 4 == 0, "S2 ring");
    for (int wt = blockIdx.x * 2 + wave; wt < 512; wt += G * 2) {
        const int chain = wt >> 2, vt = wt & 3;
        f32x4 acc[4];
#pragma unroll
        for (int m = 0; m < 4; ++m) acc[m] = (f32x4){0.f, 0.f, 0.f, 0.f};
        const bf16* Pc = PM + (size_t)chain * NCHUNK * 4096; const bf16* Qc = QT + (size_t)chain * NCHUNK * 4096;
        bf16* Hc = HT + (size_t)chain * NCHUNK * 4096 + (16 * vt + l15) * 64;
        S2Set s0, s1, s2, s3;
        s2_load(s0, Pc, Qc, vt, l15, g); s2_load(s1, Pc + 4096, Qc + 4096, vt, l15, g); s2_load(s2, Pc + 2 * 4096, Qc + 2 * 4096, vt, l15, g); s2_load(s3, Pc + 3 * 4096, Qc + 3 * 4096, vt, l15, g);
#pragma unroll 1
        for (int c = 0; c < NCHUNK; c += 4) {
            const int cn = c + 4 < NCHUNK ? c + 4 : c;
            const bf16* Pn = Pc + (size_t)cn * 4096; const bf16* Qn = Qc + (size_t)cn * 4096;
            s2_step(acc, s0, Hc + (size_t)c * 4096, g);       s2_load(s0, Pn, Qn, vt, l15, g);
            s2_step(acc, s1, Hc + (size_t)(c + 1) * 4096, g); s2_load(s1, Pn + 4096, Qn + 4096, vt, l15, g);
            s2_step(acc, s2, Hc + (size_t)(c + 2) * 4096, g); s2_load(s2, Pn + 2 * 4096, Qn + 2 * 4096, vt, l15, g);
            s2_step(acc, s3, Hc + (size_t)(c + 3) * 4096, g); s2_load(s3, Pn + 3 * 4096, Qn + 3 * 4096, vt, l15, g);
        }
    }
}

__device__ __forceinline__ void phase_s3_readout(const Args& a, int lj, int nrows, int gw, int NGW, int lane) {
    unsigned char* ws = a.ws;
    const bf16* YL = (const bf16*)(ws + WS_Y); const bf16* RH = (const bf16*)(ws + WS_RH); const bf16* HT = (const bf16*)(ws + WS_HT);
    const bf16* Vv = (const bf16*)(ws + WS_RKV) + (size_t)2 * T * D; const float* RKB = (const float*)(ws + WS_RKB); const bf16* Gg = (const bf16*)(ws + WS_G); bf16* Z = (bf16*)(ws + WS_Z);
    const float* lng = a.in[21] + lj * 1024; const float* lnb = a.in[22] + lj * 1024;
    const int l15 = lane & 15, g = lane >> 4;
    for (int task = gw; task < (nrows / 16) * 16; task += NGW) {
        const int tt = task >> 4, h = task & 15, r0 = tt * 16, row = r0 + l15;
        int b, cc[2];
        if (r0 < TL) { b = r0 >> 13; const int tb = (r0 & (SEQ - 1)) >> 6; cc[0] = 4 + tb; cc[1] = 4 + (127 - tb); }
        else { const int loc = r0 - TL; b = loc >> 8; const int tb = (loc & 255) >> 6; cc[0] = tb; cc[1] = 3 - tb; }
        f32x4 acc[4];
        const size_t ro = (size_t)row * D + h * 64 + 4 * g;
#pragma unroll
        for (int vt = 0; vt < 4; ++vt) acc[vt] = bf4(*(const u32x2*)(YL + ro + 16 * vt)) + bf4(*(const u32x2*)(YL + (size_t)T * D + ro + 16 * vt));
#pragma unroll
        for (int dir = 0; dir < 2; ++dir) {
            const int chain = dir * 64 + b * 16 + h;
            const bf16* rh = RH + ((size_t)dir * T + row) * D + h * 64 + 8 * g;
            const bf16x8 f0 = as_frag(*(const u32x4*)(rh)), f1 = as_frag(*(const u32x4*)(rh + 32));
            const bf16* hc = HT + ((size_t)chain * NCHUNK + cc[dir]) * 4096;
#pragma unroll
            for (int vt = 0; vt < 4; ++vt) { const bf16* hr = hc + (16 * vt + l15) * 64 + 8 * g;
                acc[vt] = mfma16(as_frag(*(const u32x4*)(hr)), f0, acc[vt]); acc[vt] = mfma16(as_frag(*(const u32x4*)(hr + 32)), f1, acc[vt]); }
        }
        float s = 0.f;
#pragma unroll
        for (int vt = 0; vt < 4; ++vt) s += (acc[vt][0] + acc[vt][1]) + (acc[vt][2] + acc[vt][3]);
        s += __shfl_xor(s, 16); s += __shfl_xor(s, 32);
        const float mean = s * (1.0f / 64.0f); float vs = 0.f;
#pragma unroll
        for (int vt = 0; vt < 4; ++vt) { acc[vt] = acc[vt] - mean; vs += (acc[vt][0] * acc[vt][0] + acc[vt][1] * acc[vt][1]) + (acc[vt][2] * acc[vt][2] + acc[vt][3] * acc[vt][3]); }
        vs += __shfl_xor(vs, 16); vs += __shfl_xor(vs, 32);
        const float rstd = rsqrtf(vs * (1.0f / 64.0f) + 64.0f * 1e-5f), bon = RKB[(size_t)row * 16 + h];
#pragma unroll
        for (int vt = 0; vt < 4; ++vt) { const int col = h * 64 + 16 * vt + 4 * g; const size_t o = (size_t)row * D + col;
            const f32x4 vq = bf4(*(const u32x2*)(Vv + o)), lg4 = *(const f32x4*)(lng + col), lb4 = *(const f32x4*)(lnb + col); const u32x2 gw2 = *(const u32x2*)(Gg + o);
            const f32x4 zz = acc[vt] * rstd * lg4 + lb4 + vq * bon;
            u32x2 w; w.x = pk2(zz[0] * bflo(gw2.x), zz[1] * bfhi(gw2.x)); w.y = pk2(zz[2] * bflo(gw2.y), zz[3] * bfhi(gw2.y));
            *(u32x2*)(Z + o) = w; }
    }
}
__device__ __forceinline__ void phase_cv(const Args& a, int lc, int rows, int gw, int NGW, int lane) {
    unsigned char* ws = a.ws;
    const bf16* BG = (const bf16*)(ws + WS_BG); const bf16* CU = (const bf16*)(ws + WS_CUZ); bf16* Z = (bf16*)(ws + WS_Z);
    const float* cw = a.in[25] + (size_t)lc * 3 * 1024;
    for (int t = gw; t < rows; t += NGW) {
        int rs, re; if (t < TL) { rs = t & ~63; re = rs + 63; } else { const int loc = t - TL; rs = TL + (loc & ~255); re = rs + 255; }
        const bool hp = t > rs, hn = t < re;
#pragma unroll
        for (int j = 0; j < 4; ++j) { const int col = 256 * j + 4 * lane; const size_t o = (size_t)t * D + col;
            const u32x2 zc = *(const u32x2*)(CU + o), bg = *(const u32x2*)(BG + o);
            const u32x2 zp = hp ? *(const u32x2*)(CU + o - D) : (u32x2){0u, 0u}, zn = hn ? *(const u32x2*)(CU + o + D) : (u32x2){0u, 0u};
            const f32x4 w0 = *(const f32x4*)(cw + col), w1 = *(const f32x4*)(cw + 1024 + col), w2 = *(const f32x4*)(cw + 2048 + col);
            const f32x4 zv = (f32x4){bflo(zc.x), bfhi(zc.x), bflo(zc.y), bfhi(zc.y)}, pv = (f32x4){bflo(zp.x), bfhi(zp.x), bflo(zp.y), bfhi(zp.y)}, nv = (f32x4){bflo(zn.x), bfhi(zn.x), bflo(zn.y), bfhi(zn.y)};
            const f32x4 bv = (f32x4){bflo(bg.x), bfhi(bg.x), bflo(bg.y), bfhi(bg.y)};
            const f32x4 r = bv * (w0 * pv + w1 * zv + w2 * nv);
            u32x2 w; w.x = pk2(r.x, r.y); w.y = pk2(r.z, r.w); *(u32x2*)(Z + o) = w; }
    }
}
typedef float f32x2v __attribute__((ext_vector_type(2)));
__device__ __forceinline__ float lane_bcast(float v, int srclane) { return __builtin_bit_cast(float, __builtin_amdgcn_readlane(__builtin_bit_cast(int, v), srclane)); }
__device__ __forceinline__ void phase_e_route(const Args& a, int layer, int rows, LAS unsigned char* lds, int tid, int gw, int NGW, int lane, int probe_rep = 0) {
    unsigned char* ws = a.ws;
    const float* xs = (const float*)(ws + (layer < 2 ? WS_XSA : WS_XSB));
    const float* MODS = (const float*)(ws + WS_MODS); bf16* H2 = (bf16*)(ws + WS_H2);
    const float* ng = a.in[6] + (size_t)(layer * 2 + 1) * 1024;
    const float* rw = a.in[27] + (size_t)layer * 1024 * 32; const float* rb = a.in[28] + layer * 32;
    unsigned* cnt = (unsigned*)(ws + WS_CTL) + CW_CNT + (layer + 4 * probe_rep) * 32 * CNT_STRIDE;
    int* SLOTL = (int*)(ws + (probe_rep ? WS_L1 : WS_SLOTL)); float* GATEL = (float*)(ws + (probe_rep ? WS_L1 + 8 * MiB : WS_GATEL));
    LAS float* wt = (LAS float*)lds;
    LAS int* hist = (LAS int*)(lds + LDSCTL_OFF + 3072); LAS int* base = hist + 32; LAS int* lcnt = hist + 64;
    int* TKE = (int*)(ws + WS_C12); float* TKG = (float*)(ws + WS_C12 + 4 * MiB);
    for (int i = tid; i < 32768; i += 512) wt[(i & 31) * 1024 + (i >> 5)] = rw[i];
    if (tid < 32) hist[tid] = 0;
    __syncthreads();
    const int my_e = lane >> 1; const float my_b = rb[my_e];
    const bool b5 = (lane & 32) != 0, b4 = (lane & 16) != 0, b3 = (lane & 8) != 0, b2 = (lane & 4) != 0, b1 = (lane & 2) != 0;
    for (int t = gw; t < rows; t += NGW) {
        const int mr = mod_row(t);
        const float* mod = MODS + (size_t)(layer * 5 + mr) * 6144;
        f32x4 x[4];
#pragma unroll
        for (int j = 0; j < 4; ++j) x[j] = *(const f32x4*)(xs + (size_t)t * D + 256 * j + 4 * lane);
        const float rstd = row_rstd(x);
#pragma unroll
        for (int j = 0; j < 4; ++j) { const int col = 256 * j + 4 * lane;
            x[j] = x[j] * rstd * *(const f32x4*)(ng + col) * (*(const f32x4*)(mod + 4 * 1024 + col) + 1.0f) + *(const f32x4*)(mod + 3 * 1024 + col);
            u32x2 w; w.x = pk2(x[j].x, x[j].y); w.y = pk2(x[j].z, x[j].w); *(u32x2*)(H2 + (size_t)t * D + col) = w; }
        float p[32];
#pragma unroll
        for (int eg = 0; eg < 8; ++eg) {
#pragma unroll
            for (int ee = 0; ee < 4; ++ee) { const int e = eg * 4 + ee; f32x2v s2 = (f32x2v){0.f, 0.f};
#pragma unroll
                for (int j = 0; j < 4; ++j) { const f32x4 wv = *(const LAS f32x4*)(wt + e * 1024 + 256 * j + 4 * lane);
                    s2 = __builtin_elementwise_fma((f32x2v){x[j].x, x[j].y}, (f32x2v){wv.x, wv.y}, s2); s2 = __builtin_elementwise_fma((f32x2v){x[j].z, x[j].w}, (f32x2v){wv.z, wv.w}, s2); }
                p[e] = s2.x + s2.y; }
            asm volatile("" ::: "memory");
        }
        float q16[16];
#pragma unroll
        for (int i = 0; i < 16; ++i) { const float send = b5 ? p[i] : p[i + 16]; const float keep = b5 ? p[i + 16] : p[i]; q16[i] = keep + __shfl_xor(send, 32); }
        float q8[8];
#pragma unroll
        for (int i = 0; i < 8; ++i) { const float send = b4 ? q16[i] : q16[i + 8]; const float keep = b4 ? q16[i + 8] : q16[i]; q8[i] = keep + __shfl_xor(send, 16); }
        float q4[4];
#pragma unroll
        for (int i = 0; i < 4; ++i) { const float send = b3 ? q8[i] : q8[i + 4]; const float keep = b3 ? q8[i + 4] : q8[i]; q4[i] = keep + __shfl_xor(send, 8); }
        float q2[2];
#pragma unroll
        for (int i = 0; i < 2; ++i) { const float send = b2 ? q4[i] : q4[i + 2]; const float keep = b2 ? q4[i + 2] : q4[i]; q2[i] = keep + __shfl_xor(send, 4); }
        float q1; { const float send = b1 ? q2[0] : q2[1]; const float keep = b1 ? q2[1] : q2[0]; q1 = keep + __shfl_xor(send, 2); }
        const float lg = q1 + __shfl_xor(q1, 1) + my_b;
        int rank = 0;
#pragma unroll 1
        for (int e = 0; e < 32; ++e) { const float o = lane_bcast(lg, 2 * e); rank += (o > lg || (o == lg && e < my_e)) ? 1 : 0; }
        const bool sel = rank < 4 && !(lane & 1);
        const unsigned long long m0 = __ballot(sel && rank == 0), m1 = __ballot(sel && rank == 1), m2 = __ballot(sel && rank == 2), m3 = __ballot(sel && rank == 3);
        const float v0 = lane_bcast(lg, (int)__builtin_ctzll(m0)), v1 = lane_bcast(lg, (int)__builtin_ctzll(m1)), v2 = lane_bcast(lg, (int)__builtin_ctzll(m2)), v3 = lane_bcast(lg, (int)__builtin_ctzll(m3));
        const float e1 = __expf(v1 - v0), e2 = __expf(v2 - v0), e3 = __expf(v3 - v0);
        const float inv = 1.0f / (1.0f + e1 + e2 + e3);
        if (sel) {
            TKE[t * 4 + rank] = my_e; TKG[t * 4 + rank] = __expf(lg - v0) * inv;
            __hip_atomic_fetch_add(hist + my_e, 1, __ATOMIC_RELAXED, __HIP_MEMORY_SCOPE_WORKGROUP);
        }
    }
    asm volatile("s_waitcnt vmcnt(0) lgkmcnt(0)" ::: "memory"); __syncthreads();
    if (tid < 32) { base[tid] = (int)atomicAdd(cnt + tid * CNT_STRIDE, (unsigned)hist[tid]); lcnt[tid] = 0; }
    __syncthreads();
    for (int t = gw; t < rows; t += NGW) {
        if (lane < 4) { const int e = TKE[t * 4 + lane]; const float gk = TKG[t * 4 + lane];
            const int pos = base[e] + __hip_atomic_fetch_add(lcnt + e, 1, __ATOMIC_RELAXED, __HIP_MEMORY_SCOPE_WORKGROUP);
            SLOTL[(size_t)e * T + pos] = t * 4 + lane; GATEL[(size_t)e * T + pos] = gk; }
    }
}
__device__ __forceinline__ void phase_final(const Args& a, int gw, int NGW, int lane) {
    unsigned char* ws = a.ws;
    const float* xs = (const float*)(ws + WS_XSB); const float* MODS = (const float*)(ws + WS_MODS); const bf16* YS = (const bf16*)(ws + WS_YS);
    for (int t = gw; t < TL; t += NGW) {
        const int mr = t >> 13;
        f32x4 m5[4], x[4];
#pragma unroll
        for (int j = 0; j < 4; ++j) m5[j] = *(const f32x4*)(MODS + (size_t)(3 * 5 + mr) * 6144 + 5 * 1024 + 256 * j + 4 * lane);
        load_x_combined(x, xs + (size_t)t * D, true, YS, t, m5, lane);
        const float rstd = row_rstd(x);
#pragma unroll
        for (int j = 0; j < 4; ++j) { const int col = 256 * j + 4 * lane; *(f32x4*)(a.out + (size_t)t * D + col) = x[j] * rstd * *(const f32x4*)(a.in[7] + col); }
    }
}

using pg8::Unit; using pg8::tile_map;
struct SchedStd {
    int G, c, nM, nN;
    __device__ __forceinline__ bool next(int i, Unit& u) const { const long L = (long)i * G + c; if (L >= (long)nM * nN) return false; int pm, pn; tile_map((int)L, nM, nN, pm, pn); u.pm = pm; u.pn = pn; u.e = 0; u.nv = pm; return true; }
    __device__ __forceinline__ void a_ready(const Unit&) const {}
    __device__ __forceinline__ void done(const Unit&) const {}
    __device__ __forceinline__ unsigned row_off(const Unit&, int) const { return 0u; }
};
struct SchedB1 {
    int G, c;
    __device__ __forceinline__ bool next(int i, Unit& u) const { const long L = (long)i * G + c; constexpr int n1 = 3 * NMT * 4; if (L >= n1 + 3 * NMT) return false; const int l = (int)L;
        if (l < n1) { const int j = l / (NMT * 4), r = l % (NMT * 4); int pm, pn; tile_map(r, NMT, 4, pm, pn); u.pm = j * NMT + pm; u.pn = j * 4 + pn; u.e = j; u.nv = pm; }
        else { const int r = l - n1, j = r / NMT, pm = r % NMT; u.pm = (3 + j) * NMT + pm; u.pn = 12 + j; u.e = 3 + j; u.nv = pm; }
        return true; }
    __device__ __forceinline__ void a_ready(const Unit&) const {}
    __device__ __forceinline__ void done(const Unit&) const {}
    __device__ __forceinline__ unsigned row_off(const Unit&, int) const { return 0u; }
};
struct SchedB2 {
    int G, c;
    __device__ __forceinline__ bool next(int i, Unit& u) const { const long L = (long)i * G + c; constexpr int n1 = 2 * NMT * 8; if (L >= n1 + NMT * 4) return false; const int l = (int)L;
        if (l < n1) { const int j = l / (NMT * 8), r = l % (NMT * 8); int pm, pn; tile_map(r, NMT, 8, pm, pn); u.pm = j * NMT + pm; u.pn = j * 8 + pn; u.e = j; u.nv = pm; }
        else { const int r = l - n1; int pm, pn; tile_map(r, NMT, 4, pm, pn); u.pm = 2 * NMT + pm; u.pn = 16 + pn; u.e = 2; u.nv = pm; }
        return true; }
    __device__ __forceinline__ void a_ready(const Unit&) const {}
    __device__ __forceinline__ void done(const Unit&) const {}
    __device__ __forceinline__ unsigned row_off(const Unit&, int) const { return 0u; }
};
struct SchedMoe {
    int G, c, nnt, ntiles, P; LAS unsigned char* lds; const int* slotl;
    __device__ __forceinline__ bool next(int i, Unit& u) const { const long L = (long)i * G + c; const int ntp = (ntiles + P - 1) / P, ppg = nnt / (8 / P); if (L >= (long)ntp * ppg * 8) return false;
        const LAS int* tpre = (const LAS int*)(lds + LDSCTL_OFF + 64); const LAS int* ecnt = (const LAS int*)(lds + LDSCTL_OFF + 256); const LAS unsigned short* tile_e = (const LAS unsigned short*)(lds + LDSCTL_OFF + 512);
        const int xq = (int)(L >> 3), x8 = (int)(L & 7); int tile = (xq / ppg) * P + (x8 % P); const int pnl = (x8 / P) * ppg + xq % ppg; const bool dead = tile >= ntiles; tile = dead ? 0 : tile;
        const int e = __builtin_amdgcn_readfirstlane((int)tile_e[tile]), r0 = (tile - __builtin_amdgcn_readfirstlane(tpre[e])) * 256; int nv = __builtin_amdgcn_readfirstlane(ecnt[e]) - r0; nv = nv > 256 ? 256 : nv; nv = dead ? 0 : nv;
        u.pm = dead ? MAXTILES : tile; u.pn = e * nnt + pnl; u.e = e; u.nv = nv | (r0 << 9); return true; }
    __device__ __forceinline__ void a_ready(const Unit&) const {}
    __device__ __forceinline__ void done(const Unit&) const {}
    __device__ __forceinline__ unsigned row_off(const Unit& u, int r) const { const int nv = u.nv & 511, r0 = u.nv >> 9; const int tok = r < nv ? (slotl[(size_t)u.e * T + r0 + r] >> 2) : 0; return (unsigned)tok * 2048u; }
};

using pg8::cvt_pk_bf16;
template <class P> __device__ __forceinline__ P* pin_ptr(P* p) { asm volatile("" : "+v"(p)); return p; }
struct EpiB1 {
    static constexpr bool PERM = true, AFTER_DRAIN = false;
    bf16* RKV; bf16* L1;
    __device__ __forceinline__ void operator()(const f32x4 (&acc)[2][2][4][2], const Unit& u, int wr, int wc, int fr, int fq) const {
        const int seg = u.e, row0 = u.nv * 256 + wr * 64 + fr;
        const int jj = seg - 3, ld = seg < 3 ? D : 128, col0 = (seg < 3 ? (u.pn - seg * 4) * 256 : 0) + wc * 32 + 8 * fq;
        bf16* base = seg < 3 ? RKV + (size_t)seg * T * D : L1 + (size_t)jj * T * 128;
#pragma unroll
        for (int ai = 0; ai < 2; ++ai)
#pragma unroll
            for (int m = 0; m < 4; ++m) { bf16* rowp = base + (size_t)(row0 + ai * 128 + m * 16) * ld + col0;
#pragma unroll
                for (int bj = 0; bj < 2; ++bj) { if (seg >= 3 && bj == 1) continue; f32x4 v0 = acc[ai][bj][m][0], v1 = acc[ai][bj][m][1];
                    if (jj == 0) {
#pragma unroll
                        for (int q = 0; q < 4; ++q) { v0[q] = tanh_fast(v0[q]); v1[q] = tanh_fast(v1[q]); } }
                    else if (jj == 2) {
#pragma unroll
                        for (int q = 0; q < 4; ++q) { v0[q] = sigm(v0[q]); v1[q] = sigm(v1[q]); } }
                    u32x4 w; w.x = cvt_pk_bf16(v0[0], v0[1]); w.y = cvt_pk_bf16(v0[2], v0[3]); w.z = cvt_pk_bf16(v1[0], v1[1]); w.w = cvt_pk_bf16(v1[2], v1[3]);
                    *(u32x4*)(rowp + bj * 128) = w; } }
    }
};
struct EpiB2 {
    static constexpr bool PERM = true, AFTER_DRAIN = false;
    bf16* RW; bf16* RA; bf16* Gg;
    __device__ __forceinline__ void operator()(const f32x4 (&acc)[2][2][4][2], const Unit& u, int wr, int wc, int fr, int fq) const {
        const int jj = u.e, row0 = u.nv * 256 + wr * 64 + fr, pnl = u.pn - jj * 8;
        const int dirn = jj < 2 ? (pnl >> 2) : 0, col0 = (jj < 2 ? (pnl & 3) : pnl) * 256 + wc * 32 + 8 * fq;
        bf16* base = (jj == 0 ? RW : jj == 1 ? RA : Gg) + (size_t)dirn * T * D;
#pragma unroll
        for (int ai = 0; ai < 2; ++ai)
#pragma unroll
            for (int m = 0; m < 4; ++m) { bf16* rowp = base + (size_t)(row0 + ai * 128 + m * 16) * D + col0;
#pragma unroll
                for (int bj = 0; bj < 2; ++bj) { const f32x4 v0 = acc[ai][bj][m][0], v1 = acc[ai][bj][m][1];
                    u32x4 w; w.x = cvt_pk_bf16(v0[0], v0[1]); w.y = cvt_pk_bf16(v0[2], v0[3]); w.z = cvt_pk_bf16(v1[0], v1[1]); w.w = cvt_pk_bf16(v1[2], v1[3]);
                    *(u32x4*)(rowp + bj * 128) = w; } }
    }
};
struct EpiRes {
    static constexpr bool PERM = true, AFTER_DRAIN = false;
    float* X; const float* gate; float* Xo;
    __device__ __forceinline__ void operator()(const f32x4 (&acc)[2][2][4][2], const Unit& u, int wr, int wc, int fr, int fq) const {
        const int row0 = u.pm * 256 + wr * 64 + fr, col0 = u.pn * 256 + wc * 32 + 8 * fq, mr = u.pm < NMT_L ? (u.pm >> 5) : 4;
        const float* gp = pin_ptr(gate + (size_t)mr * 6144 + col0);
        f32x4 gv[2][2];
#pragma unroll
        for (int bj = 0; bj < 2; ++bj)
#pragma unroll
            for (int n = 0; n < 2; ++n) gv[bj][n] = *(const f32x4*)(gp + bj * 128 + 4 * n);
#pragma unroll
        for (int ai = 0; ai < 2; ++ai)
#pragma unroll
            for (int m = 0; m < 4; ++m) { float* rowp = X + (size_t)(row0 + ai * 128 + m * 16) * D + col0;
#pragma unroll
                for (int bj = 0; bj < 2; ++bj)
#pragma unroll
                    for (int n = 0; n < 2; ++n) { float* p = rowp + bj * 128 + 4 * n; *(f32x4*)(Xo + (p - X)) = *(const f32x4*)p + gv[bj][n] * acc[ai][bj][m][n]; } }
    }
};
struct EpiWin {
    static constexpr bool PERM = true, AFTER_DRAIN = false;
    bf16* BG; bf16* CU;
    __device__ __forceinline__ void operator()(const f32x4 (&acc)[2][2][4][2], const Unit& u, int wr, int wc, int fr, int fq) const {
        const int row0 = u.pm * 256 + wr * 64 + fr;
        if (u.pn < 4) {
            const int col0 = u.pn * 256 + wc * 32 + 8 * fq;
#pragma unroll
            for (int ai = 0; ai < 2; ++ai)
#pragma unroll
                for (int m = 0; m < 4; ++m) { bf16* rowp = BG + (size_t)(row0 + ai * 128 + m * 16) * D + col0;
#pragma unroll
                    for (int bj = 0; bj < 2; ++bj) { const f32x4 v0 = acc[ai][bj][m][0], v1 = acc[ai][bj][m][1];
                        u32x4 w; w.x = cvt_pk_bf16(v0[0], v0[1]); w.y = cvt_pk_bf16(v0[2], v0[3]); w.z = cvt_pk_bf16(v1[0], v1[1]); w.w = cvt_pk_bf16(v1[2], v1[3]);
                        *(u32x4*)(rowp + bj * 128) = w; } }
        } else {
            const int f0 = (u.pn - 4) * 128 + wc * 32 + 8 * fq;
#pragma unroll
            for (int ai = 0; ai < 2; ++ai)
#pragma unroll
                for (int m = 0; m < 4; ++m) { const f32x4 v0 = acc[ai][0][m][0] * acc[ai][1][m][0], v1 = acc[ai][0][m][1] * acc[ai][1][m][1];
                    u32x4 w; w.x = cvt_pk_bf16(v0[0], v0[1]); w.y = cvt_pk_bf16(v0[2], v0[3]); w.z = cvt_pk_bf16(v1[0], v1[1]); w.w = cvt_pk_bf16(v1[2], v1[3]);
                    *(u32x4*)(CU + (size_t)(row0 + ai * 128 + m * 16) * D + f0) = w; }
        }
    }
};
struct EpiGU {
    static constexpr bool PERM = true, AFTER_DRAIN = false;
    bf16* INTER; const float* bgu;
    __device__ __forceinline__ void operator()(const f32x4 (&acc)[2][2][4][2], const Unit& u, int wr, int wc, int fr, int fq) const {
        const int e = u.e, pnl = u.pn - e * 8, row0 = u.pm * 256 + wr * 64 + fr, f0 = pnl * 128 + wc * 32 + 8 * fq;
        const float* bp = pin_ptr(bgu + (size_t)e * 2048 + f0);
        f32x4 bg[2], bu[2];
#pragma unroll
        for (int n = 0; n < 2; ++n) { bg[n] = *(const f32x4*)(bp + 4 * n); bu[n] = *(const f32x4*)(bp + 1024 + 4 * n); }
#pragma unroll
        for (int ai = 0; ai < 2; ++ai)
#pragma unroll
            for (int m = 0; m < 4; ++m) { f32x4 o[2];
#pragma unroll
                for (int n = 0; n < 2; ++n) { const f32x4 g = acc[ai][0][m][n] + bg[n], uu = acc[ai][1][m][n] + bu[n];
#pragma unroll
                    for (int q = 0; q < 4; ++q) { const float gc = fminf(g[q], 7.0f), uc = fminf(fmaxf(uu[q], -7.0f), 7.0f); o[n][q] = (uc + 1.0f) * gc * sigm(1.702f * gc); } }
                u32x4 w; w.x = cvt_pk_bf16(o[0][0], o[0][1]); w.y = cvt_pk_bf16(o[0][2], o[0][3]); w.z = cvt_pk_bf16(o[1][0], o[1][1]); w.w = cvt_pk_bf16(o[1][2], o[1][3]);
                *(u32x4*)(INTER + (size_t)(row0 + ai * 128 + m * 16) * 1024 + f0) = w; }
    }
};
struct EpiDown {
    static constexpr bool PERM = true, AFTER_DRAIN = false;
    bf16* YS; const float* bdn; const int* slotl; const float* gatel;
    __device__ __forceinline__ void operator()(const f32x4 (&acc)[2][2][4][2], const Unit& u, int wr, int wc, int fr, int fq) const {
        const int e = u.e, pnl = u.pn - e * 4, col0 = pnl * 256 + wc * 32 + 8 * fq, nv = u.nv & 511, r0 = u.nv >> 9;
        const float* bp = pin_ptr(bdn + (size_t)e * 1024 + col0);
        f32x4 bv[2][2];
#pragma unroll
        for (int bj = 0; bj < 2; ++bj)
#pragma unroll
            for (int n = 0; n < 2; ++n) bv[bj][n] = *(const f32x4*)(bp + bj * 128 + 4 * n);
#pragma unroll
        for (int ai = 0; ai < 2; ++ai)
#pragma unroll
            for (int m = 0; m < 4; ++m) { const int r = ai * 128 + wr * 64 + m * 16 + fr;
                if (r < nv) { const size_t li = (size_t)e * T + r0 + r; const int slot = slotl[li]; const float gt = gatel[li];
                    bf16* rowp = YS + (size_t)slot * 1024 + col0;
#pragma unroll
                    for (int bj = 0; bj < 2; ++bj) { const f32x4 v0 = (acc[ai][bj][m][0] + bv[bj][0]) * gt, v1 = (acc[ai][bj][m][1] + bv[bj][1]) * gt;
                        u32x4 w; w.x = cvt_pk_bf16(v0[0], v0[1]); w.y = cvt_pk_bf16(v0[2], v0[3]); w.z = cvt_pk_bf16(v1[0], v1[1]); w.w = cvt_pk_bf16(v1[2], v1[3]);
                        *(u32x4*)(rowp + bj * 128) = w; } } }
    }
};

__device__ __forceinline__ int moe_tables(const unsigned* cnt, LAS unsigned char* lds, int tid) {
    LAS int* tpre = (LAS int*)(lds + LDSCTL_OFF + 64); LAS int* ecnt = (LAS int*)(lds + LDSCTL_OFF + 256); LAS unsigned short* tile_e = (LAS unsigned short*)(lds + LDSCTL_OFF + 512);
    if (tid == 0) { int p = 0; for (int e = 0; e < 32; ++e) { const int cn = (int)__hip_atomic_load(cnt + e * CNT_STRIDE, __ATOMIC_RELAXED, __HIP_MEMORY_SCOPE_AGENT); ecnt[e] = cn; tpre[e] = p; p += (cn + 255) >> 8; } tpre[32] = p; }
    __syncthreads();
    const int nt = tpre[32];
    for (int t = tid; t < nt; t += 512) { int e = 0; while (e < 31 && t >= tpre[e + 1]) ++e; tile_e[t] = (unsigned short)e; }
    __syncthreads();
    return nt;
}

constexpr int NPHASES = 38;
typedef const Args __attribute__((address_space(4))) CArgs;
__global__ void __launch_bounds__(512, 2) fwd_kernel(Args a_) {
    extern __shared__ __attribute__((aligned(16))) unsigned char lds_raw[];
    LAS unsigned char* lds = (LAS unsigned char*)lds_raw;
    const int G = gridDim.x, NGW = G * 8;
    CArgs* ap0 = (CArgs*)__builtin_amdgcn_kernarg_segment_ptr();
    if (threadIdx.x < 4) ((LAS unsigned*)(lds + LDSCTL_OFF))[threadIdx.x] = 0u;
    __syncthreads();
    XcdBarrier bar = xcd_barrier_post((unsigned*)(a_.ws + WS_CTL) + CW_BAR, (volatile LAS unsigned*)(lds + LDSCTL_OFF));
    const int lo = a_.ph_lo, hi = a_.ph_hi;
    int ph = 0;
#ifndef MK_ONLY
#define MK_ONLY -1
#endif
#ifndef MK_DBL
#define MK_DBL 0
#endif
#define PH_BEGIN(id) if ((MK_ONLY < 0 || MK_ONLY == (id)) && ph >= lo && ph < hi) { for (int rep_ = 0; rep_ <= ((MK_DBL >> (id)) & 1); ++rep_) { CArgs* ap = ap0; asm volatile("" : "+s"(ap)); const Args a = *(const Args*)ap; unsigned char* const ws = a.ws; (void)ws; const int wave = (int)bar.wv; int tid = wave * 64 + lane_id(); asm volatile("" : "+v"(tid)); const int lane = tid & 63, gw = blockIdx.x * 8 + wave; (void)lane; (void)gw;
#define PH_END } } if (ph >= lo && ph + 1 < hi) xcd_barrier(bar); ++ph;

    PH_BEGIN(0) p0_prologue(a, lds, tid, lane, wave, G); PH_END

#pragma unroll 1
    for (int layer = 0; layer < DEPTH; ++layer) {
        const int kind = layer & 1, lj = layer >> 1;
        const int rows = layer == 3 ? TL : T, nmt = rows / 256;
        const int rows_moe = layer < 2 ? T : TL;
        if (kind == 0) {
            PH_BEGIN(1) phase_a_rwkv(a, layer, lds, tid, gw, NGW, lane); PH_END
            PH_BEGIN(2) {
                pg8::Gemm g{(const bf16*)(ws + WS_XL), (const bf16*)(ws + WS_WRKV) + (size_t)lj * 3840 * 1024, 6 * T, 3840, 1024};
                SchedB1 S{G, (int)blockIdx.x}; EpiB1 E{(bf16*)(ws + WS_RKV), (bf16*)(ws + WS_L1)};
                pg8::gemm_phase<EpiB1, SchedB1, true, true, false>(lds, g, S, E, tid); } PH_END
            PH_BEGIN(3) {
                pg8::Gemm g{(const bf16*)(ws + WS_L1), (const bf16*)(ws + WS_L2T) + (size_t)lj * 5120 * 128, 3 * T, 5120, 128};
                SchedB2 S{G, (int)blockIdx.x}; EpiB2 E{(bf16*)(ws + WS_RAWW), (bf16*)(ws + WS_RAWA), (bf16*)(ws + WS_G)};
                pg8::gemm_phase<EpiB2, SchedB2, true, true, false>(lds, g, S, E, tid); } PH_END
            PH_BEGIN(4) phase_c_prep(a, lj, lds, tid, gw, NGW, lane); PH_END
            PH_BEGIN(5) phase_s1_chunks(a, lj, lds, tid, G, (MK_DBL >> 5) & 1 & (rep_ == 0)); PH_END
            PH_BEGIN(15) phase_s2_chain(a, wave, lane, G); PH_END
            PH_BEGIN(6) phase_s3_readout(a, lj, layer == 2 ? TL : T, gw, NGW, lane); PH_END
        } else {
            PH_BEGIN(7) phase_a_conv(a, layer, rows, gw, NGW, lane); PH_END
            PH_BEGIN(8) {
                pg8::Gemm g{(const bf16*)(ws + WS_XL), (const bf16*)(ws + WS_WIN) + (size_t)lj * 3072 * 1024, rows, 3072, 1024};
                SchedStd S{G, (int)blockIdx.x, nmt, 12}; EpiWin E{(bf16*)(ws + WS_BG), (bf16*)(ws + WS_CUZ)};
                pg8::gemm_phase<EpiWin, SchedStd, true, true, false>(lds, g, S, E, tid); } PH_END
            PH_BEGIN(9) phase_cv(a, lj, rows, gw, NGW, lane); PH_END
        }
        PH_BEGIN(10) {
            const bf16* Wt = kind == 0 ? (const bf16*)(ws + WS_WO) + (size_t)lj * 1024 * 1024 : (const bf16*)(ws + WS_WOUT) + (size_t)lj * 1024 * 1024;
            pg8::Gemm g{(const bf16*)(ws + WS_Z), Wt, rows, 1024, 1024};
            SchedStd S{G, (int)blockIdx.x, layer == 2 ? NMT_L : nmt, 4}; EpiRes E{(float*)(ws + (layer < 2 ? WS_XSA : WS_XSB)), (const float*)(ws + WS_MODS) + (size_t)layer * 5 * 6144 + 2 * 1024, (float*)(ws + (rep_ ? WS_XL : (layer < 2 ? WS_XSA : WS_XSB)))};
            pg8::gemm_phase<EpiRes, SchedStd, true, true, false>(lds, g, S, E, tid); } PH_END
        PH_BEGIN(11) phase_e_route(a, layer, rows_moe, lds, tid, gw, NGW, lane, rep_); PH_END
        PH_BEGIN(12) {
            const int nt = __builtin_amdgcn_readfirstlane(moe_tables((const unsigned*)(ws + WS_CTL) + CW_CNT + layer * 32 * CNT_STRIDE, lds, tid));
            pg8::Gemm g{(const bf16*)(ws + WS_H2), (const bf16*)(ws + WS_WGU) + (size_t)layer * 32 * 2048 * 1024, 0, 0, 1024};
            SchedMoe S{G, (int)blockIdx.x, 8, nt, 2, lds, (const int*)(ws + WS_SLOTL)};
            EpiGU E{(bf16*)(ws + WS_INTER), a.in[30] + (size_t)layer * 32 * 2048};
            pg8::gemm_phase<EpiGU, SchedMoe, true, true, true>(lds, g, S, E, tid); } PH_END
        PH_BEGIN(13) {
            const int nt = __builtin_amdgcn_readfirstlane(moe_tables((const unsigned*)(ws + WS_CTL) + CW_CNT + layer * 32 * CNT_STRIDE, lds, tid));
            pg8::Gemm g{(const bf16*)(ws + WS_INTER), (const bf16*)(ws + WS_WDN) + (size_t)layer * 32 * 1024 * 1024, 0, 0, 1024};
            SchedMoe S{G, (int)blockIdx.x, 4, nt, 8, lds, (const int*)(ws + WS_SLOTL)};
            EpiDown E{(bf16*)(ws + WS_YS), a.in[32] + (size_t)layer * 32 * 1024, (const int*)(ws + WS_SLOTL), (const float*)(ws + WS_GATEL)};
            pg8::gemm_phase<EpiDown, SchedMoe, true, true, false>(lds, g, S, E, tid); } PH_END
    }
    PH_BEGIN(14) phase_final(a, gw, NGW, lane); PH_END
#undef PH_BEGIN
#undef PH_END
}

extern "C" void kernel_launch(void* const* d_in, const int* in_sizes, int n_in, void* d_out, int out_size, void* d_ws, size_t ws_size, hipStream_t stream) {
    static int grid = 0;
    if (grid == 0) {
        if (n_in != 33 || in_sizes[0] != TL * D || out_size != TL * D || ws_size < WS_END) { fprintf(stderr, "kernel_launch: unexpected problem (n_in %d, in0 %d, out %d, ws %zu < %zu)\n", n_in, n_in > 0 ? in_sizes[0] : -1, out_size, ws_size, (size_t)WS_END); grid = -1; return; }
        int dev = 0, cus = 0, per_cu = 0;
        if (hipGetDevice(&dev) != hipSuccess || hipDeviceGetAttribute(&cus, hipDeviceAttributeMultiprocessorCount, dev) != hipSuccess) { grid = -1; return; }
        if (hipFuncSetAttribute((const void*)fwd_kernel, hipFuncAttributeMaxDynamicSharedMemorySize, LDS_BYTES) != hipSuccess) { fprintf(stderr, "kernel_launch: hipFuncSetAttribute failed\n"); grid = -1; return; }
        if (hipOccupancyMaxActiveBlocksPerMultiprocessor(&per_cu, (const void*)fwd_kernel, 512, LDS_BYTES) != hipSuccess || per_cu < 1) fprintf(stderr, "kernel_launch: occupancy query says %d\n", per_cu);
        (void)hipGetLastError();
        grid = cus;
    }
    if (grid < 0) return;
    if (hipMemsetAsync((char*)d_ws + WS_CTL, 0, CTL_ZERO_BYTES, stream) != hipSuccess) return;
    Args a{};
    for (int i = 0; i < 33; ++i) a.in[i] = (const float*)d_in[i];
    a.out = (float*)d_out; a.ws = (unsigned char*)d_ws;
#if MK_PER_PHASE
    for (int p = 0; p < NPHASES; ++p) { a.ph_lo = p; a.ph_hi = p + 1; hipLaunchKernelGGL(fwd_kernel, dim3(grid), dim3(512), LDS_BYTES, stream, a); }
#else
    a.ph_lo = 0; a.ph_hi = NPHASES;
    hipLaunchKernelGGL(fwd_kernel, dim3(grid), dim3(512), LDS_BYTES, stream, a);
#endif
    const hipError_t le = hipPeekAtLastError();
    if (le != hipSuccess) fprintf(stderr, "kernel_launch: launch failed: %s\n", hipGetErrorName(le));
}
```

```cpp
#include <hip/hip_runtime.h>
#include <cstdio>
#include <cstdint>

#ifndef MK_PER_PHASE
#define MK_PER_PHASE 0
#endif

constexpr int D = 1024, NBATCH = 4, SEQ = 8192, TL = NBATCH * SEQ, CTXL = 256, TC = NBATCH * CTXL, T = TL + TC;
constexpr int NH = 16, HS = 64, NE = 32, TOPK = 4, DEPTH = 4;
constexpr int NMT = T / 256;
constexpr int NMT_L = TL / 256;
constexpr int MAXTILES = (T * TOPK) / 256 + NE;
constexpr int NSTEP = CTXL + SEQ;

__device__ __forceinline__ int lane_id() { return (int)__builtin_amdgcn_mbcnt_hi(~0u, __builtin_amdgcn_mbcnt_lo(~0u, 0u)); }
namespace pg8 {
#define PG8_LAS __attribute__((address_space(3)))
typedef unsigned short bf16_t;
typedef short bf16x8 __attribute__((ext_vector_type(8)));
typedef float f32x4 __attribute__((ext_vector_type(4)));
typedef unsigned u32x4 __attribute__((ext_vector_type(4)));
typedef unsigned u32x2 __attribute__((ext_vector_type(2)));
constexpr int BM = 256, BK = 64, HALF = 128, HTB = HALF * BK * 2  , STAGE_BYTES = 8 * HTB, NXCD = 8, WGM = 8;

__host__ __device__ __forceinline__ int lds_byte(int r, int c) { const int st = (r >> 4) * 2 + (c >> 5), rr = r & 15, cc = c & 31, ob = rr * 64 + cc * 2; return st * 1024 + (ob ^ (((ob >> 9) & 1) << 5)); }
__host__ __device__ __forceinline__ void stage_rc(int b, int& R, int& C) { const int st = b / 1024, sb = b % 1024, swz = sb ^ (((sb >> 9) & 1) << 5); R = (st >> 1) * 16 + swz / 64; C = (st & 1) * 32 + (swz % 64) / 2; }
__host__ __device__ __forceinline__ int perm32(int rho) { const int n = rho >> 4, i = rho & 15; return 8 * (i >> 2) + 4 * n + (i & 3); }

struct Unit { int pm, pn, e, nv; };
struct Gemm { const bf16_t* A; const bf16_t* Bt; int M, N, K; };

__device__ __forceinline__ void tile_map(int wgid, int nM, int nN, int& pm, int& pn) {
    const int nwg = nM * nN;
    { const int q = nwg / NXCD, r = nwg % NXCD, xcd = wgid % NXCD, off = wgid / NXCD; wgid = (xcd < r ? xcd * (q + 1) : r * (q + 1) + (xcd - r) * q) + off; }
    const int nig = WGM * nN, gid = wgid / nig, fm = gid * WGM, gsz = (nM - fm) < WGM ? (nM - fm) : WGM;
    pm = fm + ((wgid % nig) % gsz); pn = (wgid % nig) / gsz;
}
typedef __bf16 bf16x2_t __attribute__((ext_vector_type(2)));
typedef float f32x2_t __attribute__((ext_vector_type(2)));
__device__ __forceinline__ unsigned cvt_pk_bf16(float lo, float hi) { const f32x2_t v = {lo, hi}; const bf16x2_t b = __builtin_convertvector(v, bf16x2_t); return __builtin_bit_cast(unsigned, b); }

template <class Epi, class Sched, bool ALIGN_EPI = false, bool SP2 = false, bool GATHER = false>
__device__ __forceinline__ void gemm_phase(PG8_LAS unsigned char* lds, const Gemm g, const Sched& S, const Epi& E, int tid_in) {
    int tid_ = tid_in; asm volatile("" : "+v"(tid_));
    const int tid = tid_, wid = __builtin_amdgcn_readfirstlane(tid >> 6), lane = tid & 63, wr = wid >> 2, wc = wid & 3, fr = lane & 15, fq = lane >> 4;
    int K_ = g.K; asm volatile("" : "+s"(K_));
    const int K = K_, nt = K / BK;
    unsigned voffA[2], voffB[2]; int gR[2]; unsigned gC[2];
#pragma unroll
    for (int i = 0; i < 2; ++i) { int R, C; stage_rc(tid * 16 + i * 8192, R, C); const int Rb = Epi::PERM ? ((R & ~31) + perm32(R & 31)) : R;
        voffA[i] = (unsigned)(R * K + C) * 2u; voffB[i] = (unsigned)(Rb * K + C) * 2u; gR[i] = R; gC[i] = (unsigned)C * 2u; }
    unsigned oc[2][2], on[2][2], o2[2][2];
#pragma unroll
    for (int h = 0; h < 2; ++h)
#pragma unroll
        for (int i = 0; i < 2; ++i) { oc[h][i] = 0u; on[h][i] = 0u; o2[h][i] = 0u; }
    const size_t kstep = (size_t)(BK * 2);
    const size_t hstep = (size_t)HALF * K * 2;
    const size_t tstep = 2 * hstep;
    const unsigned ldsw = (unsigned)wid * 1024u;
    const int aoff = lds_byte(wr * 64 + fr, fq * 8), boff = lds_byte(wc * 32 + fr, fq * 8);
#define PG8_SA(b, h) (((b) * 2 + (h)) * HTB)
#define PG8_SB(b, h) ((4 + (b) * 2 + (h)) * HTB)
#define PG8_STAGE(bufoff, gbase, voff) do { _Pragma("unroll") for (int _i = 0; _i < 2; ++_i) \
        __builtin_amdgcn_global_load_lds((const unsigned*)((const char*)(gbase) + (voff)[_i]), (PG8_LAS unsigned*)(lds + (bufoff) + ldsw + _i * 8192), 16, 0, 0); } while (0)
#define PG8_STAGE_A(bufoff, base, h, O) do { if constexpr (GATHER) { PG8_STAGE(bufoff, base, (O)[h]); } else { PG8_STAGE(bufoff, (base) + (h) * hstep, voffA); } } while (0)
#define PG8_LDA(dst, b, h) do { _Pragma("unroll") for (int m = 0; m < 4; ++m) _Pragma("unroll") for (int k = 0; k < 2; ++k) dst[m][k] = *(const PG8_LAS bf16x8*)(lds + PG8_SA(b, h) + aoff + m * 2048 + k * 1024); } while (0)
#define PG8_LDB(dst, b, h) do { _Pragma("unroll") for (int n = 0; n < 2; ++n) _Pragma("unroll") for (int k = 0; k < 2; ++k) dst[n][k] = *(const PG8_LAS bf16x8*)(lds + PG8_SB(b, h) + boff + n * 2048 + k * 1024); } while (0)
#define PG8_MMA(ai, bj, At, Bt) do { __builtin_amdgcn_s_setprio(1); _Pragma("unroll") for (int m = 0; m < 4; ++m) _Pragma("unroll") for (int n = 0; n < 2; ++n) _Pragma("unroll") for (int k = 0; k < 2; ++k) \
        acc[ai][bj][m][n] = __builtin_amdgcn_mfma_f32_16x16x32_bf16(Bt[n][k], At[m][k], acc[ai][bj][m][n], 0, 0, 0); __builtin_amdgcn_s_setprio(0); } while (0)
#define PG8_WAIT_V(n) asm volatile("s_waitcnt vmcnt(" #n ")" ::: "memory")
#define PG8_WAIT_L(n) asm volatile("s_waitcnt lgkmcnt(" #n ")" ::: "memory")
#define PG8_BAR __builtin_amdgcn_s_barrier()
#define PG8_SCHED __builtin_amdgcn_sched_barrier(0)
    Unit cur, nxt; int ui = 0;
    if (!S.next(0, cur)) return;
    f32x4 acc[2][2][4][2];
#pragma unroll
    for (int a = 0; a < 2; ++a)
#pragma unroll
        for (int b = 0; b < 2; ++b)
#pragma unroll
            for (int m = 0; m < 4; ++m)
#pragma unroll
                for (int n = 0; n < 2; ++n) acc[a][b][m][n] = (f32x4){0.f, 0.f, 0.f, 0.f};
    bf16x8 At[4][2], B0[2][2], B1[2][2];
    const char* cA = GATHER ? (const char*)g.A : (const char*)g.A + (size_t)cur.pm * tstep; const char* cB = (const char*)g.Bt + (size_t)cur.pn * tstep;
    S.a_ready(cur);
    if constexpr (GATHER) {
#pragma unroll
        for (int h = 0; h < 2; ++h)
#pragma unroll
            for (int i = 0; i < 2; ++i) oc[h][i] = S.row_off(cur, h * HALF + gR[i]) + gC[i];
    }
    if constexpr (SP2) {
        PG8_STAGE(PG8_SB(0, 0), cB, voffB); PG8_STAGE(PG8_SB(0, 1), cB + hstep, voffB); PG8_STAGE_A(PG8_SA(0, 0), cA, 0, oc); PG8_STAGE_A(PG8_SA(0, 1), cA, 1, oc);
        if (wr == 1) PG8_BAR;
        PG8_WAIT_V(2); PG8_BAR;
        PG8_STAGE(PG8_SB(1, 0), cB + kstep, voffB); PG8_STAGE_A(PG8_SA(1, 0), cA + kstep, 0, oc); PG8_STAGE(PG8_SB(1, 1), cB + hstep + kstep, voffB);
        PG8_WAIT_V(6); PG8_BAR;
    } else {
        PG8_STAGE(PG8_SB(0, 0), cB, voffB); PG8_STAGE_A(PG8_SA(0, 0), cA, 0, oc); PG8_STAGE(PG8_SB(0, 1), cB + hstep, voffB); PG8_STAGE_A(PG8_SA(0, 1), cA, 1, oc);
        if (wr == 1) PG8_BAR;
        PG8_WAIT_V(4); PG8_BAR;
        PG8_STAGE(PG8_SB(1, 0), cB + kstep, voffB); PG8_STAGE_A(PG8_SA(1, 0), cA + kstep, 0, oc); PG8_STAGE(PG8_SB(1, 1), cB + hstep + kstep, voffB);
        PG8_WAIT_V(6); PG8_BAR;
    }
    for (;;) {
        const bool has_next = S.next(ui + 1, nxt);
        const char* nA = GATHER ? (const char*)g.A : (has_next ? (const char*)g.A + (size_t)nxt.pm * tstep : cA); const char* nB = has_next ? (const char*)g.Bt + (size_t)nxt.pn * tstep : cB;
        if constexpr (GATHER) {
#pragma unroll
            for (int h = 0; h < 2; ++h)
#pragma unroll
                for (int i = 0; i < 2; ++i) on[h][i] = has_next ? (S.row_off(nxt, h * HALF + gR[i]) + gC[i]) : oc[h][i];
        }
        for (int t = 0; t < nt; t += 2) {
            const bool last = (t == nt - 2);
            const char* a1 = cA + (size_t)(t + 1) * kstep;
            const char* a2 = last ? nA : cA + (size_t)(t + 2) * kstep; const char* b2 = last ? nB : cB + (size_t)(t + 2) * kstep;
            const char* a3 = a2 + kstep; const char* b3 = b2 + kstep;
            if constexpr (GATHER) {
#pragma unroll
                for (int h = 0; h < 2; ++h)
#pragma unroll
                    for (int i = 0; i < 2; ++i) o2[h][i] = last ? on[h][i] : oc[h][i];
            }
            if (last && has_next) S.a_ready(nxt);
            if constexpr (SP2) {
            PG8_LDB(B0, 0, 0); PG8_LDB(B1, 0, 1); PG8_SCHED; PG8_LDA(At, 0, 0); PG8_STAGE_A(PG8_SA(1, 1), a1, 1, oc);
            PG8_WAIT_V(8); PG8_WAIT_L(0); PG8_BAR; PG8_MMA(0, 0, At, B0); PG8_MMA(0, 1, At, B1); PG8_BAR; PG8_SCHED;
            PG8_LDA(At, 0, 1); PG8_STAGE(PG8_SB(0, 0), b2, voffB); PG8_STAGE(PG8_SB(0, 1), b2 + hstep, voffB); PG8_STAGE_A(PG8_SA(0, 0), a2, 0, o2);
            PG8_WAIT_V(8); PG8_WAIT_L(0); PG8_BAR; PG8_MMA(1, 0, At, B0); PG8_MMA(1, 1, At, B1); PG8_BAR; PG8_SCHED;
            PG8_LDB(B0, 1, 0); PG8_LDB(B1, 1, 1); PG8_SCHED; PG8_LDA(At, 1, 0); PG8_STAGE_A(PG8_SA(0, 1), a2, 1, o2);
            PG8_WAIT_V(8); PG8_WAIT_L(0); PG8_BAR; PG8_MMA(0, 0, At, B0); PG8_MMA(0, 1, At, B1); PG8_BAR; PG8_SCHED;
            PG8_LDA(At, 1, 1); PG8_STAGE(PG8_SB(1, 0), b3, voffB); PG8_STAGE(PG8_SB(1, 1), b3 + hstep, voffB); PG8_STAGE_A(PG8_SA(1, 0), a3, 0, o2);
            PG8_WAIT_V(8); PG8_WAIT_L(0); PG8_BAR; PG8_MMA(1, 0, At, B0); PG8_MMA(1, 1, At, B1); PG8_BAR; PG8_SCHED;
            } else {
            PG8_LDB(B0, 0, 0); PG8_SCHED; PG8_LDA(At, 0, 0); PG8_STAGE_A(PG8_SA(1, 1), a1, 1, oc);
            PG8_WAIT_L(8); PG8_BAR; PG8_WAIT_L(0); PG8_MMA(0, 0, At, B0); PG8_BAR; PG8_SCHED;
            PG8_LDB(B1, 0, 1); PG8_STAGE(PG8_SB(0, 0), b2, voffB);
            PG8_BAR; PG8_WAIT_L(0); PG8_MMA(0, 1, At, B1); PG8_BAR;
            PG8_LDA(At, 0, 1); PG8_STAGE_A(PG8_SA(0, 0), a2, 0, o2);
            PG8_BAR; PG8_WAIT_L(0); PG8_MMA(1, 0, At, B0); PG8_BAR; PG8_SCHED;
            PG8_STAGE(PG8_SB(0, 1), b2 + hstep, voffB);
            PG8_WAIT_V(6); PG8_BAR; PG8_MMA(1, 1, At, B1); PG8_BAR;
            PG8_LDB(B0, 1, 0); PG8_SCHED; PG8_LDA(At, 1, 0); PG8_STAGE_A(PG8_SA(0, 1), a2, 1, o2);
            PG8_WAIT_L(8); PG8_BAR; PG8_WAIT_L(0); PG8_MMA(0, 0, At, B0); PG8_BAR; PG8_SCHED;
            PG8_LDB(B1, 1, 1); PG8_STAGE(PG8_SB(1, 0), b3, voffB);
            PG8_BAR; PG8_WAIT_L(0); PG8_MMA(0, 1, At, B1); PG8_BAR;
            PG8_LDA(At, 1, 1); PG8_STAGE_A(PG8_SA(1, 0), a3, 0, o2);
            PG8_BAR; PG8_WAIT_L(0); PG8_MMA(1, 0, At, B0); PG8_BAR; PG8_SCHED;
            PG8_STAGE(PG8_SB(1, 1), b3 + hstep, voffB);
            PG8_WAIT_V(6); PG8_BAR; PG8_MMA(1, 1, At, B1); PG8_BAR;
            }
        }
        if constexpr (ALIGN_EPI) { if (wr == 0) PG8_BAR; }
        if constexpr (!Epi::AFTER_DRAIN) { E(acc, cur, wr, wc, fr, fq); S.done(cur); }
        if (!has_next) break;
#pragma unroll
        for (int a = 0; a < 2; ++a)
#pragma unroll
            for (int b = 0; b < 2; ++b)
#pragma unroll
                for (int m = 0; m < 4; ++m)
#pragma unroll
                    for (int n = 0; n < 2; ++n) acc[a][b][m][n] = (f32x4){0.f, 0.f, 0.f, 0.f};
        cur = nxt; cA = nA; cB = nB; ++ui;
        if constexpr (GATHER) {
#pragma unroll
            for (int h = 0; h < 2; ++h)
#pragma unroll
                for (int i = 0; i < 2; ++i) oc[h][i] = on[h][i];
        }
        if constexpr (ALIGN_EPI) { if (wr == 1) PG8_BAR; }
    }
    PG8_WAIT_V(0);
    if constexpr (!ALIGN_EPI) { if (wr == 0) PG8_BAR; }
    PG8_BAR;
    if constexpr (Epi::AFTER_DRAIN) { E.fused(acc, cur, wr, wc, fr, fq, lds, wid, lane); S.done(cur); }
#undef PG8_SA
#undef PG8_SB
#undef PG8_STAGE
#undef PG8_STAGE_A
#undef PG8_LDA
#undef PG8_LDB
#undef PG8_MMA
#undef PG8_WAIT_V
#undef PG8_WAIT_L
#undef PG8_BAR
#undef PG8_SCHED
}
}

#define LAS __attribute__((address_space(3)))
typedef unsigned short bf16;
typedef float f32x4 __attribute__((ext_vector_type(4)));
typedef unsigned u32x2 __attribute__((ext_vector_type(2)));
typedef unsigned u32x4 __attribute__((ext_vector_type(4)));
#define LDS_WAIT() asm volatile("s_waitcnt lgkmcnt(0)" ::: "memory")
__device__ __forceinline__ unsigned pk2(float lo, float hi) { return pg8::cvt_pk_bf16(lo, hi); }
__device__ __forceinline__ unsigned f2bf(float f) { return pk2(f, f) & 0xffffu; }
__device__ __forceinline__ float bflo(unsigned w) { return __builtin_bit_cast(float, w << 16); }
__device__ __forceinline__ float bfhi(unsigned w) { return __builtin_bit_cast(float, w & 0xffff0000u); }
__device__ __forceinline__ float wave_sum(float v) {
#pragma unroll
    for (int o = 1; o < 64; o <<= 1) v += __shfl_xor(v, o);
    return v;
}
__device__ __forceinline__ float sigm(float x) { return 1.0f / (1.0f + __expf(-x)); }
__device__ __forceinline__ float tanh_fast(float x) { const float e = __expf(2.0f * x); return 1.0f - 2.0f / (e + 1.0f); }

constexpr size_t MiB = 1u << 20;
constexpr size_t RF = (size_t)T * D * 4;
constexpr size_t RB = (size_t)T * D * 2;
constexpr size_t WS_CTL = 0, CTL_ZERO_BYTES = 1 * MiB;
constexpr size_t WS_MODS = 1 * MiB;
constexpr size_t WS_XSA = 2 * MiB, WS_XSB = WS_XSA + RF;
constexpr size_t WS_XL = WS_XSB + RF;
constexpr size_t WS_RKV = WS_XL + 6 * RB;
constexpr size_t WS_L1 = WS_RKV + 3 * RF;
constexpr size_t WS_WDEC = WS_L1 + 50 * MiB;
constexpr size_t WS_AA = WS_WDEC + 2 * RF;
constexpr size_t WS_G = WS_AA + 2 * RF;
constexpr size_t WS_KK = WS_G + RB;
constexpr size_t WS_KD = WS_KK + RF;
constexpr size_t WS_BETA = WS_KD + 2 * RF;
constexpr size_t WS_RKB = WS_BETA + 2 * RF;
constexpr size_t WS_C12 = WS_RKB + 3 * MiB;
constexpr size_t WS_WRT = WS_C12 + 6 * MiB;
constexpr size_t WS_Y = WS_C12 + 9 * MiB;
constexpr size_t WS_Z = WS_Y + 2 * RF;
constexpr size_t WS_H2 = WS_Z + RB;
constexpr size_t WS_SLOTL = WS_H2 + RB;
constexpr size_t WS_GATEL = WS_SLOTL + 5 * MiB;
constexpr size_t WS_WRKV = WS_GATEL + 5 * MiB;
constexpr size_t WS_L2T = WS_WRKV + 15 * MiB;
constexpr size_t WS_WO = WS_L2T + 5 * MiB;
constexpr size_t WS_WIN = WS_WO + 4 * MiB;
constexpr size_t WS_WOUT = WS_WIN + 12 * MiB;
constexpr size_t WS_WGU = WS_WOUT + 4 * MiB;
constexpr size_t WS_WDN = WS_WGU + 512 * MiB;
constexpr size_t WS_END = WS_WDN + 256 * MiB;
constexpr size_t WS_INTER = WS_WDEC;
constexpr size_t WS_YS = WS_KD;
constexpr size_t WS_BG = WS_RKV, WS_CUZ = WS_RKV + RB;
constexpr size_t WS_RAWW = WS_AA, WS_RAWA = WS_AA + RF;
constexpr size_t WS_RH = WS_AA;
constexpr size_t WS_PM = WS_AA + RF;
constexpr size_t WS_QT = WS_XL;
constexpr size_t WS_HT = WS_XL + RF;
static_assert((size_t)128 * 132 * 4096 * 2 <= RF, "chunk state tensors");
static_assert((size_t)MAXTILES * 256 * 1024 * 2 <= 4 * RF, "INTER overlay");
static_assert((size_t)T * 4 * 1024 * 2 <= 2 * RF, "YS overlay");
static_assert((size_t)3 * T * 256 * 2 <= 50 * MiB, "L1OUT");
constexpr int CW_BAR = 4096;
constexpr int CW_CNT = 16384, CNT_STRIDE = 64;

constexpr int RING_BYTES = 131072;
constexpr int LDSCTL_OFF = RING_BYTES;
constexpr int LDS_BYTES = 147456;

struct Args { const float* in[33]; float* out; unsigned char* ws; int ph_lo, ph_hi; };

__device__ __forceinline__ void transpose_item(const float* W, int N, bf16* WT, int dstK, int drow0, int k0, int n0, LAS float* scr, int lane) {
    float tv[32];
#pragma unroll
    for (int i = 0; i < 32; ++i) { const int kk = 2 * i + (lane >> 5); tv[i] = W[(size_t)(k0 + kk) * N + n0 + (lane & 31)]; }
#pragma unroll
    for (int i = 0; i < 32; ++i) { const int kk = 2 * i + (lane >> 5); scr[kk * 33 + (lane & 31)] = tv[i]; }
    LDS_WAIT(); asm volatile("" ::: "memory");
    const int c = lane & 7;
#pragma unroll
    for (int j = 0; j < 4; ++j) { const int n = (lane >> 3) + 8 * j; const LAS float* s = scr + (8 * c) * 33 + n;
        u32x4 o; o.x = pk2(s[0 * 33], s[1 * 33]); o.y = pk2(s[2 * 33], s[3 * 33]); o.z = pk2(s[4 * 33], s[5 * 33]); o.w = pk2(s[6 * 33], s[7 * 33]);
        *(u32x4*)(WT + (size_t)(drow0 + n) * dstK + k0 + 8 * c) = o; }
    LDS_WAIT(); asm volatile("" ::: "memory");
}
__device__ __forceinline__ int gu_map(int n0) { const int bj = n0 >= 1024 ? 1 : 0, f0 = n0 - bj * 1024; return (f0 >> 7) * 256 + bj * 128 + (f0 & 127); }
__device__ __forceinline__ int conv_map(int n0) { if (n0 < 1024) return n0; const int q = (n0 - 1024) >> 10, f0 = (n0 - 1024) & 1023; return 1024 + (f0 >> 7) * 256 + q * 128 + (f0 & 127); }

__device__ __forceinline__ void p0_prologue(const Args& a, LAS unsigned char* lds, int tid, int lane, int wave, int G) {
    unsigned char* ws = a.ws;
    LAS float* sl = (LAS float*)lds;
    LAS float* red = (LAS float*)(lds + 20480);
    for (int i = tid; i < 5 * 1024; i += 512) { const int r = i >> 10, k = i & 1023; const float cv = r < 4 ? a.in[1][r * 1024 + k] : a.in[3][k]; sl[i] = cv / (1.0f + __expf(-cv)); }
    __syncthreads();
    float* MODS = (float*)(ws + WS_MODS);
    for (int it = blockIdx.x; it < 4 * 96; it += G) {
        const int l = it / 96, n = (it % 96) * 64 + lane;
        const float* W = a.in[4] + (size_t)l * 1024 * 6144 + n;
        float acc[5] = {0.f, 0.f, 0.f, 0.f, 0.f};
        const int kb = wave * 128;
#pragma unroll 8
        for (int k = 0; k < 128; ++k) { const float wv = W[(size_t)(kb + k) * 6144];
#pragma unroll
            for (int r = 0; r < 5; ++r) acc[r] += sl[r * 1024 + kb + k] * wv; }
#pragma unroll
        for (int r = 0; r < 5; ++r) red[(wave * 5 + r) * 64 + lane] = acc[r];
        __syncthreads();
        if (wave < 5) { float s = a.in[5][l * 6144 + n];
#pragma unroll
            for (int w = 0; w < 8; ++w) s += red[(w * 5 + wave) * 64 + lane];
            MODS[(size_t)(l * 5 + wave) * 6144 + n] = s; }
        __syncthreads();
    }
    LAS float* scr = (LAS float*)(lds + 32768 + wave * 8448);
    const int gw = blockIdx.x * 8 + wave, NGW = G * 8;
    bf16* WRKV = (bf16*)(ws + WS_WRKV); bf16* WOt = (bf16*)(ws + WS_WO); bf16* WINt = (bf16*)(ws + WS_WIN); bf16* WOUTt = (bf16*)(ws + WS_WOUT);
    bf16* WGU = (bf16*)(ws + WS_WGU); bf16* WDN = (bf16*)(ws + WS_WDN);
    constexpr int I_GU = 128 * 1024, I_DN = 128 * 512, I_RKV = 6 * 512, I_WO = 2 * 512, I_WIN = 2 * 1536, I_WOUT = 2 * 512, I_W1 = 4 * 32, I_A1 = 4 * 32, I_G1 = 2 * 64;
    constexpr int NITEMS = I_GU + I_DN + I_RKV + I_WO + I_WIN + I_WOUT + I_W1 + I_A1 + I_G1;
    for (int it = gw; it < NITEMS; it += NGW) {
        int r = it;
        if (r < I_GU) { const int m = r >> 10, q = r & 1023, kb = q >> 6, nb = q & 63;
            transpose_item(a.in[29] + (size_t)m * 1024 * 2048, 2048, WGU + (size_t)m * 2048 * 1024, 1024, gu_map(nb * 32), kb * 64, nb * 32, scr, lane); continue; } r -= I_GU;
        if (r < I_DN) { const int m = r >> 9, q = r & 511, kb = q >> 5, nb = q & 31;
            transpose_item(a.in[31] + (size_t)m * 1024 * 1024, 1024, WDN + (size_t)m * 1024 * 1024, 1024, nb * 32, kb * 64, nb * 32, scr, lane); continue; } r -= I_DN;
        if (r < I_RKV) { const int m = r >> 9, q = r & 511, kb = q >> 5, nb = q & 31, lr = m / 3, j = m % 3;
            transpose_item(a.in[9] + (size_t)m * 1024 * 1024, 1024, WRKV + (size_t)lr * 3840 * 1024, 1024, j * 1024 + nb * 32, kb * 64, nb * 32, scr, lane); continue; } r -= I_RKV;
        if (r < I_WO) { const int m = r >> 9, q = r & 511, kb = q >> 5, nb = q & 31;
            transpose_item(a.in[23] + (size_t)m * 1024 * 1024, 1024, WOt + (size_t)m * 1024 * 1024, 1024, nb * 32, kb * 64, nb * 32, scr, lane); continue; } r -= I_WO;
        if (r < I_WIN) { const int m = r / 1536, q = r % 1536, kb = q / 96, nb = q % 96;
            transpose_item(a.in[24] + (size_t)m * 1024 * 3072, 3072, WINt + (size_t)m * 3072 * 1024, 1024, conv_map(nb * 32), kb * 64, nb * 32, scr, lane); continue; } r -= I_WIN;
        if (r < I_WOUT) { const int m = r >> 9, q = r & 511, kb = q >> 5, nb = q & 31;
            transpose_item(a.in[26] + (size_t)m * 1024 * 1024, 1024, WOUTt + (size_t)m * 1024 * 1024, 1024, nb * 32, kb * 64, nb * 32, scr, lane); continue; } r -= I_WOUT;
        if (r < I_W1) { const int m = r >> 5, q = r & 31, kb = q >> 1, nb = q & 1, lr = m >> 1, e = m & 1;
            transpose_item(a.in[11] + (size_t)m * 1024 * 64, 64, WRKV + (size_t)lr * 3840 * 1024, 1024, 3072 + e * 64 + nb * 32, kb * 64, nb * 32, scr, lane); continue; } r -= I_W1;
        if (r < I_A1) { const int m = r >> 5, q = r & 31, kb = q >> 1, nb = q & 1, lr = m >> 1, e = m & 1;
            transpose_item(a.in[14] + (size_t)m * 1024 * 64, 64, WRKV + (size_t)lr * 3840 * 1024, 1024, 3328 + e * 64 + nb * 32, kb * 64, nb * 32, scr, lane); continue; } r -= I_A1;
        { const int m = r >> 6, q = r & 63, kb = q >> 2, nb = q & 3;
            transpose_item(a.in[16] + (size_t)m * 1024 * 128, 128, WRKV + (size_t)m * 3840 * 1024, 1024, 3584 + nb * 32, kb * 64, nb * 32, scr, lane); }
    }
    const int gt = blockIdx.x * 512 + tid, NGT = G * 512;
    for (int i = gt; i < 2 * 3 * 128 * 128; i += NGT) {
        const int pc = i & 127, rw = (i >> 7) & 127, pd = (i >> 14) % 3, lr = i / (3 * 16384);
        *(u32x4*)(WRKV + ((size_t)lr * 3840 + 3072 + pd * 256 + 128 + rw) * 1024 + pc * 8) = (u32x4){0u, 0u, 0u, 0u}; }
    bf16* L2T = (bf16*)(ws + WS_L2T);
    for (int i = gt; i < 2 * 128 * 5120; i += NGT) {
        const int n = i % 5120, k = (i / 5120) & 127, lr = i / (5120 * 128);
        float v = 0.f;
        if (n < 2048) { const int e = n >> 10, d = n & 1023; if ((k >> 6) == e) v = a.in[12][(((size_t)lr * 2 + e) * 64 + (k & 63)) * 1024 + d]; }
        else if (n < 4096) { const int e = (n - 2048) >> 10, d = n & 1023; if ((k >> 6) == e) v = a.in[15][(((size_t)lr * 2 + e) * 64 + (k & 63)) * 1024 + d]; }
        else { const int d = n - 4096; v = a.in[17][((size_t)lr * 128 + k) * 1024 + d]; }
        L2T[((size_t)lr * 5120 + n) * 128 + k] = (bf16)f2bf(v);
    }
    bf16* WRT = (bf16*)(ws + WS_WRT);
    for (int i = gt; i < 4 * 32 * 1024; i += NGT) { const int k = i & 1023, e = (i >> 10) & 31, l = i >> 15;
        const float w = a.in[27][((size_t)l * 1024 + k) * 32 + e]; const unsigned hi = f2bf(w); const float lo = w - bflo(hi);
        WRT[((size_t)(l * 2 + 0) * 32 + e) * 1024 + k] = (bf16)hi; WRT[((size_t)(l * 2 + 1) * 32 + e) * 1024 + k] = (bf16)f2bf(lo); }
}
#define XB_TMO      128
#define XB_XCNT(j)  (256  + 64 * (j))
#define XB_XSUB(j)  (1280 + 64 * (j))
#define XB_XGEN(j)  (2304 + 64 * (j))
#define XB_TOP      3328
#define XB_TOPGEN   3392
#define XCD_BAR_WORDS 3456
#define XB_SPIN_CAP (1u << 23)

__device__ __forceinline__ unsigned xb_ld(unsigned* p)              { return __hip_atomic_load(p, __ATOMIC_RELAXED, __HIP_MEMORY_SCOPE_AGENT); }
__device__ __forceinline__ unsigned xb_add(unsigned* p, unsigned v) { return __hip_atomic_fetch_add(p, v, __ATOMIC_RELAXED, __HIP_MEMORY_SCOPE_AGENT); }
__device__ __forceinline__ unsigned xb_xcc_id() { return (unsigned)__builtin_amdgcn_s_getreg((3 << 11) | 20) & 0xFu; }
#define XB_SPIN(cond, bar) do { unsigned _sp = 0; while (cond) { __builtin_amdgcn_s_sleep(1); \
    if ((++_sp & 255u) == 0u) { if (xb_ld(&(bar)[XB_TMO])) break; if (_sp > XB_SPIN_CAP) { atomicAdd(&(bar)[XB_TMO], 1u); break; } } } } while (0)

struct XcdBarrier {
    unsigned wv;
    unsigned* bar; unsigned x;
    volatile LAS unsigned* st;
};

__device__ __forceinline__ XcdBarrier xcd_barrier_post(unsigned* bar, volatile LAS unsigned* st) {
    XcdBarrier b; b.wv = (unsigned)__builtin_amdgcn_readfirstlane((int)(threadIdx.x >> 6)); b.bar = bar; b.x = xb_xcc_id(); b.st = st;
    if (threadIdx.x == 0) (void)xb_add(&bar[XB_XCNT(b.x)], 1u);
    return b;
}
__device__ __forceinline__ void xcd_barrier_complete(unsigned* bar, unsigned x, unsigned& nloc, unsigned& nx) {
    const unsigned G = gridDim.x * gridDim.y * gridDim.z;
    unsigned sum, cnt, mine, sp = 0u;
    for (;;) {
        sum = 0u; cnt = 0u; mine = 0u;
#pragma unroll
        for (unsigned j = 0; j < 16; ++j) { const unsigned c = xb_ld(&bar[XB_XCNT(j)]); sum += c; cnt += (c > 0u) ? 1u : 0u; mine = (j == x) ? c : mine; }
        if (sum == G) break;
        __builtin_amdgcn_s_sleep(1);
        if ((++sp & 255u) == 0u) { if (xb_ld(&bar[XB_TMO])) break; if (sp > XB_SPIN_CAP) { atomicAdd(&bar[XB_TMO], 1u); break; } }
    }
    nloc = mine > 0u ? mine : 1u; nx = cnt > 0u ? cnt : 1u;
}

__device__ __forceinline__ void xcd_barrier(const XcdBarrier& b) {
    asm volatile("s_waitcnt vmcnt(0)" ::: "memory");
    __syncthreads();
    if (b.wv == 0u && lane_id() == 0) {
        unsigned* bar = b.bar;
        __builtin_amdgcn_s_waitcnt(0);
        unsigned nloc = b.st[0], nx = b.st[1];
        if (nloc == 0u) { xcd_barrier_complete(bar, b.x, nloc, nx); b.st[0] = nloc; b.st[1] = nx; }
        const unsigned old = xb_add(&bar[XB_XSUB(b.x)], 1u);
        const unsigned gen = old / nloc;
        if (old + 1u == (gen + 1u) * nloc) {
            __builtin_amdgcn_fence(__ATOMIC_RELEASE, "agent");
            asm volatile("s_waitcnt vmcnt(0)" ::: "memory");
            const unsigned og = xb_add(&bar[XB_TOP], 1u);
            const unsigned tg = og / nx;
            if (og + 1u == (tg + 1u) * nx) xb_add(&bar[XB_TOPGEN], 1u);
            else XB_SPIN(xb_ld(&bar[XB_TOPGEN]) == tg, bar);
            __builtin_amdgcn_fence(__ATOMIC_ACQUIRE, "agent");
            xb_add(&bar[XB_XGEN(b.x)], 1u);
            asm volatile("s_waitcnt vmcnt(0)" ::: "memory");
        } else {
            XB_SPIN(xb_ld(&bar[XB_XGEN(b.x)]) == gen, bar);
            __builtin_amdgcn_fence(__ATOMIC_ACQUIRE, "agent");
            asm volatile("s_waitcnt vmcnt(0)" ::: "memory");
        }
    }
    __syncthreads();
}

__device__ __forceinline__ int mod_row(int row) { return row < TL ? (row >> 13) : 4; }

__device__ __forceinline__ void load_x_combined(f32x4 (&x)[4], const float* xrow, bool has_prev, const bf16* YS, int t, const f32x4 (&m5)[4], int lane) {
#pragma unroll
    for (int j = 0; j < 4; ++j) x[j] = *(const f32x4*)(xrow + 256 * j + 4 * lane);
    if (has_prev) {
        f32x4 s[4];
#pragma unroll
        for (int j = 0; j < 4; ++j) s[j] = (f32x4){0.f, 0.f, 0.f, 0.f};
#pragma unroll
        for (int k = 0; k < 4; ++k) { const bf16* yr = YS + ((size_t)t * 4 + k) * 1024;
#pragma unroll
            for (int j = 0; j < 4; ++j) { const u32x2 w = *(const u32x2*)(yr + 256 * j + 4 * lane); s[j] += (f32x4){bflo(w.x), bfhi(w.x), bflo(w.y), bfhi(w.y)}; } }
#pragma unroll
        for (int j = 0; j < 4; ++j) x[j] += m5[j] * s[j];
    }
}
__device__ __forceinline__ float row_rstd(const f32x4 (&x)[4]) {
    float ss = 0.f;
#pragma unroll
    for (int j = 0; j < 4; ++j) ss += (x[j].x * x[j].x + x[j].y * x[j].y) + (x[j].z * x[j].z + x[j].w * x[j].w);
    return rsqrtf(wave_sum(ss) * (1.0f / 1024.0f) + 1e-6f);
}

__device__ __forceinline__ void phase_a_rwkv(const Args& a, int layer, LAS unsigned char* lds, int tid, int gw, int NGW, int lane) {
    unsigned char* ws = a.ws; const int lj = layer >> 1; const bool has_prev = layer > 0;
    const float* xin_lat = layer == 0 ? a.in[0] : (const float*)(ws + WS_XSA);
    const float* xin_ctx = layer == 0 ? a.in[2] : (const float*)(ws + WS_XSA) + (size_t)TL * D;
    float* xout = (float*)(ws + (layer == 0 ? WS_XSA : WS_XSB));
    const float* MODS = (const float*)(ws + WS_MODS); const bf16* YS = (const bf16*)(ws + WS_YS); bf16* XL = (bf16*)(ws + WS_XL);
    const float* mug = a.in[8] + (size_t)lj * 6 * 2 * 1024; const float* ng = a.in[6] + (size_t)(layer * 2 + 0) * 1024;
    LAS float* mu = (LAS float*)lds;
    for (int i = tid; i < 6 * 2 * 1024 / 4; i += 512) ((LAS f32x4*)mu)[i] = ((const f32x4*)mug)[i];
    __syncthreads();
    for (int it = gw; it < TL / 8 + TC / 2; it += NGW) {
        const int ntok = it < TL / 8 ? 8 : 2, t0 = it < TL / 8 ? it * 8 : TL + (it - TL / 8) * 2, mr = mod_row(t0);
        int rs, re; if (t0 < TL) { rs = t0 & ~63; re = rs + 63; } else { const int loc = t0 - TL; rs = TL + (loc & ~255); re = rs + 255; }
        const float* mod = MODS + (size_t)(layer * 5 + mr) * 6144;
        const float* m5p = MODS + (size_t)((has_prev ? layer - 1 : 0) * 5 + mr) * 6144 + 5 * 1024;
        f32x4 hm[4], h0[4], hp[4];
#pragma unroll
        for (int j = 0; j < 4; ++j) { hm[j] = (f32x4){0.f, 0.f, 0.f, 0.f}; h0[j] = hm[j]; hp[j] = hm[j]; }
        f32x4 rx[4], nx[4]; u32x2 ry[4][4], ny[4][4];
#define PA_LOAD(X, Y, tt) do { const int t_ = (tt); if (t_ >= rs && t_ <= re) { \
            const float* xrow_ = t_ < TL ? xin_lat + (size_t)t_ * D : xin_ctx + (size_t)(t_ - TL) * D; \
            _Pragma("unroll") for (int j = 0; j < 4; ++j) X[j] = *(const f32x4*)(xrow_ + 256 * j + 4 * lane); \
            if (has_prev) { _Pragma("unroll") for (int k = 0; k < 4; ++k) _Pragma("unroll") for (int j = 0; j < 4; ++j) Y[k][j] = *(const u32x2*)(YS + ((size_t)t_ * 4 + k) * 1024 + 256 * j + 4 * lane); } } } while (0)
#pragma unroll
        for (int j = 0; j < 4; ++j) { rx[j] = (f32x4){0.f, 0.f, 0.f, 0.f}; nx[j] = rx[j];
#pragma unroll
            for (int k = 0; k < 4; ++k) { ry[k][j] = (u32x2){0u, 0u}; ny[k][j] = ry[k][j]; } }
        PA_LOAD(rx, ry, t0 - 1);
#pragma unroll 1
        for (int i = -1; i <= ntok; ++i) {
            const int t = t0 + i;
            if (i < ntok) PA_LOAD(nx, ny, t + 1);
            f32x4 hn[4];
            if (t >= rs && t <= re) {
                f32x4 x[4];
#pragma unroll
                for (int j = 0; j < 4; ++j) x[j] = rx[j];
                if (has_prev) {
#pragma unroll
                    for (int j = 0; j < 4; ++j) { f32x4 sm = (f32x4){0.f, 0.f, 0.f, 0.f};
#pragma unroll
                        for (int k = 0; k < 4; ++k) sm += (f32x4){bflo(ry[k][j].x), bfhi(ry[k][j].x), bflo(ry[k][j].y), bfhi(ry[k][j].y)};
                        x[j] += *(const f32x4*)(m5p + 256 * j + 4 * lane) * sm; } }
                if (i >= 0 && i < ntok) {
#pragma unroll
                    for (int j = 0; j < 4; ++j) *(f32x4*)(xout + (size_t)t * D + 256 * j + 4 * lane) = x[j]; }
                const float rstd = row_rstd(x);
#pragma unroll
                for (int j = 0; j < 4; ++j) { const int col = 256 * j + 4 * lane; hn[j] = x[j] * rstd * *(const f32x4*)(ng + col) * (*(const f32x4*)(mod + 1024 + col) + 1.0f) + *(const f32x4*)(mod + col); }
            } else {
#pragma unroll
                for (int j = 0; j < 4; ++j) hn[j] = (f32x4){0.f, 0.f, 0.f, 0.f};
            }
#pragma unroll
            for (int j = 0; j < 4; ++j) { hm[j] = h0[j]; h0[j] = hp[j]; hp[j] = hn[j]; rx[j] = nx[j];
#pragma unroll
                for (int k = 0; k < 4; ++k) ry[k][j] = ny[k][j]; }
            if (i >= 1) {
                const int te = t - 1;
#pragma unroll
                for (int q = 0; q < 6; ++q) {
                    bf16* orow = XL + ((size_t)q * T + te) * D;
#pragma unroll
                    for (int j = 0; j < 4; ++j) { const int col = 256 * j + 4 * lane;
                        const f32x4 m0 = *(const LAS f32x4*)(mu + (q * 2 + 0) * 1024 + col), m1 = *(const LAS f32x4*)(mu + (q * 2 + 1) * 1024 + col);
                        const f32x4 o = h0[j] + m0 * (hm[j] - h0[j]) + m1 * (hp[j] - h0[j]);
                        u32x2 w; w.x = pk2(o.x, o.y); w.y = pk2(o.z, o.w); *(u32x2*)(orow + col) = w; }
                }
            }
        }
#undef PA_LOAD
    }
}
__device__ __forceinline__ void phase_a_conv(const Args& a, int layer, int rows, int gw, int NGW, int lane) {
    unsigned char* ws = a.ws;
    float* xs = (float*)(ws + (layer < 2 ? WS_XSA : WS_XSB));
    const float* MODS = (const float*)(ws + WS_MODS); const bf16* YS = (const bf16*)(ws + WS_YS); bf16* H = (bf16*)(ws + WS_XL);
    const float* ng = a.in[6] + (size_t)(layer * 2 + 0) * 1024;
    for (int t = gw; t < rows; t += NGW) {
        const int mr = mod_row(t);
        const float* mod = MODS + (size_t)(layer * 5 + mr) * 6144;
        f32x4 m5[4], x[4];
#pragma unroll
        for (int j = 0; j < 4; ++j) m5[j] = *(const f32x4*)(MODS + (size_t)((layer - 1) * 5 + mr) * 6144 + 5 * 1024 + 256 * j + 4 * lane);
        load_x_combined(x, xs + (size_t)t * D, true, YS, t, m5, lane);
        const float rstd = row_rstd(x);
#pragma unroll
        for (int j = 0; j < 4; ++j) { const int col = 256 * j + 4 * lane;
            *(f32x4*)(xs + (size_t)t * D + col) = x[j];
            const f32x4 h = x[j] * rstd * *(const f32x4*)(ng + col) * (*(const f32x4*)(mod + 1024 + col) + 1.0f) + *(const f32x4*)(mod + col);
            u32x2 w; w.x = pk2(h.x, h.y); w.y = pk2(h.z, h.w); *(u32x2*)(H + (size_t)t * D + col) = w; }
    }
}
#define DPPF(x, ctrl) __builtin_bit_cast(float, __builtin_amdgcn_update_dpp(0, __builtin_bit_cast(int, (x)), (ctrl), 0xf, 0xf, false))
__device__ __forceinline__ float row16_sum(float v) { v += DPPF(v, 0xB1); v += DPPF(v, 0x4E); v += DPPF(v, 0x141); v += DPPF(v, 0x140); return v; }
__device__ __forceinline__ f32x4 bf4(u32x2 w) { return (f32x4){bflo(w.x), bfhi(w.x), bflo(w.y), bfhi(w.y)}; }
__device__ __forceinline__ u32x2 pk4(f32x4 v) { u32x2 w; w.x = pk2(v[0], v[1]); w.y = pk2(v[2], v[3]); return w; }
__device__ __forceinline__ void phase_c_prep(const Args& a, int lj, LAS unsigned char* lds, int tid, int gw, int NGW, int lane) {
    unsigned char* ws = a.ws;
    const bf16* Rr = (const bf16*)(ws + WS_RKV); const bf16* Kk = Rr + (size_t)T * D; const bf16* RA = (const bf16*)(ws + WS_RAWA); const bf16* RW = (const bf16*)(ws + WS_RAWW);
    bf16* KK = (bf16*)(ws + WS_KK); bf16* KD = (bf16*)(ws + WS_KD); bf16* BE = (bf16*)(ws + WS_BETA); float* RKB = (float*)(ws + WS_RKB);
    LAS float* tb = (LAS float*)lds;
    for (int i = tid; i < 7 * 256; i += 512) { const int t7 = i >> 8, q = i & 255;
        const float* src = t7 == 0 ? a.in[18] + lj * 1024 : t7 == 1 ? a.in[19] + lj * 1024 : t7 == 2 ? a.in[20] + lj * 1024 : t7 < 5 ? a.in[10] + lj * 2048 + (t7 - 3) * 1024 : a.in[13] + lj * 2048 + (t7 - 5) * 1024;
        ((LAS f32x4*)tb)[i] = ((const f32x4*)src)[q]; }
    __syncthreads();
    for (int row = gw; row < T; row += NGW) {
#pragma unroll
        for (int j = 0; j < 4; ++j) {
            const int col = 256 * j + 4 * lane; const size_t ro = (size_t)row * D + col;
            const f32x4 k = bf4(*(const u32x2*)(Kk + ro)), r = bf4(*(const u32x2*)(Rr + ro));
            f32x4 a0 = bf4(*(const u32x2*)(RA + ro)) + *(const LAS f32x4*)(tb + 5 * 1024 + col), a1 = bf4(*(const u32x2*)(RA + (size_t)T * D + ro)) + *(const LAS f32x4*)(tb + 6 * 1024 + col);
#pragma unroll
            for (int z = 0; z < 4; ++z) { a0[z] = sigm(a0[z]); a1[z] = sigm(a1[z]); }
            const f32x4 ck = *(const LAS f32x4*)(tb + col), ca = *(const LAS f32x4*)(tb + 1024 + col), cr = *(const LAS f32x4*)(tb + 2048 + col);
            const f32x4 kk = k * ck;
            const float ss = row16_sum((kk.x * kk.x + kk.y * kk.y) + (kk.z * kk.z + kk.w * kk.w));
            const f32x4 kd0 = k * ((a0 - 1.0f) * ca + 1.0f), kd1 = k * ((a1 - 1.0f) * ca + 1.0f);
            *(u32x2*)(KD + ro) = pk4(kd0); *(u32x2*)(KD + (size_t)T * D + ro) = pk4(kd1);
            const f32x4 p = r * (kd0 + kd1) * cr;
            const float rk = row16_sum((p.x + p.y) + (p.z + p.w));
            const f32x4 kkn = kk * (1.0f / fmaxf(sqrtf(ss), 1e-12f));
            *(u32x2*)(KK + ro) = pk4(kkn); *(u32x2*)(BE + ro) = pk4(kkn * a0); *(u32x2*)(BE + (size_t)T * D + ro) = pk4(kkn * a1);
            if ((lane & 15) == 0) RKB[(size_t)row * 16 + 4 * j + (lane >> 4)] = rk;
        }
    }
}
typedef short bf16x8 __attribute__((ext_vector_type(8)));
__device__ __forceinline__ f32x4 mfma16(bf16x8 a, bf16x8 b, f32x4 c) { return __builtin_amdgcn_mfma_f32_16x16x32_bf16(a, b, c, 0, 0, 0); }
__device__ __forceinline__ bf16x8 as_frag(u32x4 w) { return __builtin_bit_cast(bf16x8, w); }
constexpr int CH_LD = 144;
constexpr int CH_MS = 64 * CH_LD;
constexpr int CH_AB = 0 * CH_MS, CH_KT = 1 * CH_MS, CH_BT = 2 * CH_MS, CH_RB = 3 * CH_MS, CH_VT = 4 * CH_MS, CH_ABT = 5 * CH_MS, CH_KHT = 6 * CH_MS, CH_BHT = 7 * CH_MS,
              CH_LK = 8 * CH_MS, CH_LB = 9 * CH_MS, CH_MK = 10 * CH_MS, CH_MB = 11 * CH_MS, CH_WT = 12 * CH_MS, CH_U0 = 13 * CH_MS, CH_DINV = 14 * CH_MS;
constexpr int CH_GC = LDSCTL_OFF + 2048;
constexpr int CH_PART = LDSCTL_OFF + 4096;
constexpr int NCHUNK = NSTEP / 64;
#ifndef S1_DBL
#define S1_DBL 0
#endif
static_assert(CH_DINV + 2048 <= RING_BYTES, "chunk LDS map");

__device__ __forceinline__ int scan_row(int s, int dir, int b) {
    if (s < CTXL) return TL + b * CTXL + (dir ? CTXL - 1 - s : s);
    const int i = s - CTXL; return b * SEQ + (dir ? SEQ - 1 - i : i);
}
#define CH_FRAG(mat, row, ks, kg) as_frag(*(const LAS u32x4*)(lds + (mat) + (row) * CH_LD + ((ks) * 32 + (kg) * 8) * 2))

#define S1_BAR() do { asm volatile("s_waitcnt lgkmcnt(0)" ::: "memory"); __builtin_amdgcn_s_barrier(); asm volatile("" ::: "memory"); } while (0)
__device__ __forceinline__ void phase_s1_chunks(const Args& a, int lj, LAS unsigned char* lds, int tid, int G, int rh_scratch = 0) {
    unsigned char* ws = a.ws; const float* w0l = a.in[10] + lj * 2048;
    const int lane = tid & 63, wave = __builtin_amdgcn_readfirstlane(tid >> 6), l15 = lane & 15, g = lane >> 4;
    LAS float* part = (LAS float*)(lds + CH_PART); LAS float* gammaC = (LAS float*)(lds + CH_GC);
    float nlw[8], nkd[8], nbe[8], nkk[8], nrr[8], nvv[8], nw0 = 0.f;
#define S1_LOAD(ctx_) do { unsigned char* wsl = ws; asm volatile("" : "+s"(wsl));     \
        const int chain_ = (ctx_) / NCHUNK, c_ = (ctx_) - chain_ * NCHUNK, dir_ = chain_ >> 6, b_ = (chain_ >> 4) & 3, h_ = chain_ & 15; \
          \
        const long o0 = (long)scan_row(64 * c_ + 8 * wave, dir_, b_) * D + h_ * 64 + lane, od = (long)dir_ * T * D, st = dir_ ? -(long)D : (long)D; \
        const bf16* LWp = (const bf16*)(wsl + WS_RAWW) + od + o0; const bf16* KDp = (const bf16*)(wsl + WS_KD) + od + o0; const bf16* BEp = (const bf16*)(wsl + WS_BETA) + od + o0; \
        const bf16* KKp = (const bf16*)(wsl + WS_KK) + o0; const bf16* Rp = (const bf16*)(wsl + WS_RKV) + o0; const bf16* Vp = Rp + (size_t)2 * T * D; \
        nw0 = w0l[dir_ * 1024 + h_ * 64 + lane]; \
        _Pragma("unroll") for (int j = 0; j < 8; ++j) { const long oj = st * j; \
            nlw[j] = bflo((unsigned)LWp[oj]); nkd[j] = bflo((unsigned)KDp[oj]); nbe[j] = bflo((unsigned)BEp[oj]); nkk[j] = bflo((unsigned)KKp[oj]); nrr[j] = bflo((unsigned)Rp[oj]); nvv[j] = bflo((unsigned)Vp[oj]); } } while (0)
    if ((int)blockIdx.x < 128 * NCHUNK) S1_LOAD((int)blockIdx.x);
    for (int ct = blockIdx.x; ct < 128 * NCHUNK; ct += G) {
        const int chain = ct / NCHUNK, c = ct - chain * NCHUNK, dir = chain >> 6, b = (chain >> 4) & 3, h = chain & 15;
        unsigned zq = 0u; asm volatile("" : "+v"(zq));
        {
            const int k = lane, tq = wave;
            float lw[8], kd[8], be[8], kk[8], rr[8], vv[8];
const float w0k = nw0;
#pragma unroll
            for (int j = 0; j < 8; ++j) { lw[j] = -0.60653066f * sigm(nlw[j] + w0k); kd[j] = nkd[j]; be[j] = nbe[j]; kk[j] = nkk[j]; rr[j] = nrr[j]; vv[j] = nvv[j]; }
            if (ct + G < 128 * NCHUNK) S1_LOAD(ct + G);
            for (int r0_ = 0; r0_ <= ((S1_DBL >> 3) & 1); ++r0_) { if (r0_) S1_BAR();
            float p[8]; p[0] = lw[0];
#pragma unroll
            for (int j = 1; j < 8; ++j) p[j] = p[j - 1] + lw[j];
            part[tq * 64 + k] = p[7];
            S1_BAR();
            float off = 0.f, tot = 0.f;
#pragma unroll
            for (int q = 0; q < 8; ++q) { const float pv = part[q * 64 + k]; tot += pv; off += q < tq ? pv : 0.f; }
            const float eTot = __expf(tot); float ePrev = __expf(off);
            if (tq == 0) gammaC[k] = eTot;
            unsigned abw[4], khw[4], bhw[4], vw[4];
#pragma unroll
            for (int j = 0; j < 8; j += 2) {
                float ab2[2], kt2[2], bt2[2], rb2[2], kh2[2], bh2[2];
#pragma unroll
                for (int z = 0; z < 2; ++z) { const float cu = off + p[j + z]; const float eP = __expf(cu), eM = __expf(-cu), eC = eTot * eM;
                    ab2[z] = kk[j + z] * ePrev; ePrev = eP; kt2[z] = kd[j + z] * eM; bt2[z] = be[j + z] * eM; rb2[z] = rr[j + z] * eP; kh2[z] = kd[j + z] * eC; bh2[z] = be[j + z] * eC;
                    const int t = 8 * tq + j + z;
                    *(LAS bf16*)(lds + CH_AB + t * CH_LD + k * 2) = (bf16)f2bf(ab2[z]); *(LAS bf16*)(lds + CH_KT + t * CH_LD + k * 2) = (bf16)f2bf(kt2[z]);
                    *(LAS bf16*)(lds + CH_BT + t * CH_LD + k * 2) = (bf16)f2bf(bt2[z]); *(LAS bf16*)(lds + CH_RB + t * CH_LD + k * 2) = (bf16)f2bf(rb2[z]); }
                abw[j >> 1] = pk2(ab2[0], ab2[1]); khw[j >> 1] = pk2(kh2[0], kh2[1]); bhw[j >> 1] = pk2(bh2[0], bh2[1]); vw[j >> 1] = pk2(vv[j], vv[j + 1]);
            }
            *(LAS u32x4*)(lds + CH_ABT + k * CH_LD + tq * 16) = (u32x4){abw[0], abw[1], abw[2], abw[3]};
            *(LAS u32x4*)(lds + CH_KHT + k * CH_LD + tq * 16) = (u32x4){khw[0], khw[1], khw[2], khw[3]};
            *(LAS u32x4*)(lds + CH_BHT + k * CH_LD + tq * 16) = (u32x4){bhw[0], bhw[1], bhw[2], bhw[3]};
            *(LAS u32x4*)(lds + CH_VT + k * CH_LD + tq * 16) = (u32x4){vw[0], vw[1], vw[2], vw[3]};
            *(LAS u32x4*)(lds + CH_WT + k * CH_LD + tq * 16) = (u32x4){zq, zq, zq, zq}; *(LAS u32x4*)(lds + CH_U0 + k * CH_LD + tq * 16) = (u32x4){zq, zq, zq, zq};
            }
        }
        S1_BAR();
        for (int r1_ = 0; r1_ <= (S1_DBL & 1); ++r1_) { if (r1_) S1_BAR();
            const int mi = wave >> 1, half = wave & 1;
            const int matS = (mi & 1) ? CH_BT : CH_KT, matT = (mi & 2) ? CH_RB : CH_AB, matO = CH_LK + mi * CH_MS;
            const bool incl = (mi & 2) != 0;
            bf16x8 fs[4][2], ft[2][2];
#pragma unroll
            for (int ms = 0; ms < 4; ++ms)
#pragma unroll
                for (int ks = 0; ks < 2; ++ks) fs[ms][ks] = CH_FRAG(matS, 16 * ms + l15, ks, g);
#pragma unroll
            for (int nt = 0; nt < 2; ++nt)
#pragma unroll
                for (int ks = 0; ks < 2; ++ks) ft[nt][ks] = CH_FRAG(matT, 32 * half + 16 * nt + l15, ks, g);
#pragma unroll
            for (int nt = 0; nt < 2; ++nt) { const int t = 32 * half + 16 * nt + l15;
#pragma unroll
                for (int ms = 0; ms < 4; ++ms) { f32x4 d = (f32x4){0.f, 0.f, 0.f, 0.f};
                    d = mfma16(fs[ms][0], ft[nt][0], d); d = mfma16(fs[ms][1], ft[nt][1], d);
                    const int s0 = 16 * ms + 4 * g;
#pragma unroll
                    for (int i = 0; i < 4; ++i) { const bool keep = incl ? (s0 + i <= t) : (s0 + i < t); d[i] = keep ? d[i] : __builtin_bit_cast(float, zq); }
                    u32x2 w; w.x = pk2(d[0], d[1]); w.y = pk2(d[2], d[3]);
                    *(LAS u32x2*)(lds + matO + t * CH_LD + s0 * 2) = w; } }
        }
        S1_BAR();
        f32x4 rhsU[4];
#pragma unroll
        for (int I = 0; I < 4; ++I) rhsU[I] = (f32x4){0.f, 0.f, 0.f, 0.f};
        if (wave >= 4) {
            const int ctv = (wave & 3) * 16;
            const bf16x8 fv0 = CH_FRAG(CH_VT, ctv + l15, 0, g), fv1 = CH_FRAG(CH_VT, ctv + l15, 1, g);
#pragma unroll
            for (int I = 0; I < 4; ++I) { f32x4 d = (f32x4){0.f, 0.f, 0.f, 0.f};
                d = mfma16(CH_FRAG(CH_LK, 16 * I + l15, 0, g), fv0, d); d = mfma16(CH_FRAG(CH_LK, 16 * I + l15, 1, g), fv1, d); rhsU[I] = -d; }
        }
        for (int r2_ = 0; r2_ <= ((S1_DBL >> 1) & 1); ++r2_) if (wave == 0) {
            const int bb = lane >> 4, j = lane & 15;
            float x[16];
#pragma unroll
            for (int t = 0; t < 16; ++t) {
                const u32x4 r0 = *(const LAS u32x4*)(lds + CH_LB + (16 * bb + t) * CH_LD + 32 * bb), r1 = *(const LAS u32x4*)(lds + CH_LB + (16 * bb + t) * CH_LD + 32 * bb + 16);
                const unsigned rw[8] = {r0.x, r0.y, r0.z, r0.w, r1.x, r1.y, r1.z, r1.w};
                float acc = (t == j) ? 1.0f : 0.0f;
#pragma unroll
                for (int s = 0; s < t; ++s) { const float lv = (s & 1) ? bfhi(rw[s >> 1]) : bflo(rw[s >> 1]); acc -= lv * x[s]; }
                x[t] = acc;
                *(LAS bf16*)(lds + CH_DINV + ((bb * 16 + t) * 16 + j) * 2) = (bf16)f2bf(acc);
            }
        }
        S1_BAR();
        {
            const int matZ = wave < 4 ? CH_WT : CH_U0, ct16 = (wave & 3) * 16;
            for (int r4_ = 0; r4_ <= ((S1_DBL >> 4) & 1); ++r4_) { if (r4_) { *(LAS u32x4*)(lds + matZ + (ct16 + l15) * CH_LD + g * 32) = (u32x4){zq, zq, zq, zq}; *(LAS u32x4*)(lds + matZ + (ct16 + l15) * CH_LD + g * 32 + 16) = (u32x4){zq, zq, zq, zq}; LDS_WAIT(); }
#pragma unroll
            for (int I = 0; I < 4; ++I) {
                f32x4 rhs;
                if (wave < 4) { const u32x2 w = *(const LAS u32x2*)(lds + CH_ABT + (ct16 + l15) * CH_LD + (16 * I + 4 * g) * 2); rhs = (f32x4){bflo(w.x), bfhi(w.x), bflo(w.y), bfhi(w.y)}; }
                else rhs = rhsU[I];
                f32x4 d = (f32x4){0.f, 0.f, 0.f, 0.f};
                d = mfma16(CH_FRAG(CH_LB, 16 * I + l15, 0, g), CH_FRAG(matZ, ct16 + l15, 0, g), d); d = mfma16(CH_FRAG(CH_LB, 16 * I + l15, 1, g), CH_FRAG(matZ, ct16 + l15, 1, g), d);
                const f32x4 ac = rhs - d;
                const u32x2 dv = *(const LAS u32x2*)(lds + CH_DINV + ((I * 16 + l15) * 16 + 4 * g) * 2);
                const bf16x8 fa = as_frag((u32x4){dv.x, dv.y, zq, zq}), fb = as_frag((u32x4){pk2(ac[0], ac[1]), pk2(ac[2], ac[3]), zq, zq});
                const f32x4 z = mfma16(fa, fb, (f32x4){0.f, 0.f, 0.f, 0.f});
                u32x2 w; w.x = pk2(z[0], z[1]); w.y = pk2(z[2], z[3]);
                *(LAS u32x2*)(lds + matZ + (ct16 + l15) * CH_LD + (16 * I + 4 * g) * 2) = w;
                LDS_WAIT(); asm volatile("" ::: "memory");
            }
            }
        }
        S1_BAR();
        for (int r3_ = 0; r3_ <= ((S1_DBL >> 2) & 1); ++r3_) { if (r3_) S1_BAR();
            const int rt = wave >> 1, cp = (wave & 1) * 2;
            unsigned char* wsl = ws; asm volatile("" : "+s"(wsl));
            bf16* YL = (bf16*)(wsl + WS_Y); bf16* RH = (bf16*)(wsl + (rh_scratch ? WS_BETA + RF : WS_RH)); bf16* PM = (bf16*)(wsl + WS_PM); bf16* QT = (bf16*)(wsl + WS_QT);
            const int trow = scan_row(64 * c + 16 * rt + l15, dir, b);
#pragma unroll
            for (int q = 0; q < 2; ++q) { const int vt = cp + q; f32x4 d = (f32x4){0.f, 0.f, 0.f, 0.f};
#pragma unroll
                for (int ks = 0; ks < 2; ++ks) { d = mfma16(CH_FRAG(CH_VT, 16 * vt + l15, ks, g), CH_FRAG(CH_MK, 16 * rt + l15, ks, g), d); d = mfma16(CH_FRAG(CH_U0, 16 * vt + l15, ks, g), CH_FRAG(CH_MB, 16 * rt + l15, ks, g), d); }
                *(u32x2*)(YL + ((size_t)dir * T + trow) * D + h * 64 + 16 * vt + 4 * g) = pk4(d); }
#pragma unroll
            for (int q = 0; q < 2; ++q) { const int kt = cp + q; f32x4 d = (f32x4){0.f, 0.f, 0.f, 0.f};
#pragma unroll
                for (int ks = 0; ks < 2; ++ks) d = mfma16(CH_FRAG(CH_WT, 16 * kt + l15, ks, g), CH_FRAG(CH_MB, 16 * rt + l15, ks, g), d);
                const u32x2 rbw = *(const LAS u32x2*)(lds + CH_RB + (16 * rt + l15) * CH_LD + (16 * kt + 4 * g) * 2);
                u32x2 w; w.x = pk2(bflo(rbw.x) - d[0], bfhi(rbw.x) - d[1]); w.y = pk2(bflo(rbw.y) - d[2], bfhi(rbw.y) - d[3]);
                *(u32x2*)(RH + ((size_t)dir * T + trow) * D + h * 64 + 16 * kt + 4 * g) = w; }
            bf16* Pc = PM + ((size_t)chain * NCHUNK + c) * 4096; bf16* Qc = QT + ((size_t)chain * NCHUNK + c) * 4096;
            { const int krow = 16 * rt + l15; const float gc = gammaC[krow];
#pragma unroll
                for (int q = 0; q < 2; ++q) { const int kt = cp + q; f32x4 d = (f32x4){0.f, 0.f, 0.f, 0.f};
#pragma unroll
                    for (int ks = 0; ks < 2; ++ks) d = mfma16(CH_FRAG(CH_WT, 16 * kt + l15, ks, g), CH_FRAG(CH_BHT, krow, ks, g), d);
                    const int k0 = 16 * kt + 4 * g; f32x4 o;
#pragma unroll
                    for (int i = 0; i < 4; ++i) o[i] = ((k0 + i == krow) ? gc : 0.f) - d[i];
                    u32x2 w; w.x = pk2(o[0], o[1]); w.y = pk2(o[2], o[3]);
                    *(u32x2*)(Pc + krow * 64 + 32 * (kt >> 1) + 8 * g + 4 * (kt & 1)) = w; } }
            { const int vrow = 16 * rt + l15;
#pragma unroll
                for (int q = 0; q < 2; ++q) { const int kt = cp + q; f32x4 d = (f32x4){0.f, 0.f, 0.f, 0.f};
#pragma unroll
                    for (int ks = 0; ks < 2; ++ks) { d = mfma16(CH_FRAG(CH_KHT, 16 * kt + l15, ks, g), CH_FRAG(CH_VT, vrow, ks, g), d); d = mfma16(CH_FRAG(CH_BHT, 16 * kt + l15, ks, g), CH_FRAG(CH_U0, vrow, ks, g), d); }
                    u32x2 w; w.x = pk2(d[0], d[1]); w.y = pk2(d[2], d[3]);
                    *(u32x2*)(Qc + vrow * 64 + 16 * g + 4 * kt) = w; } }
        }
        S1_BAR();
    }
}

struct S2Set { u32x4 p[4][2]; u32x4 q[2]; };
__device__ __forceinline__ void s2_load(S2Set& s, const bf16* Pc, const bf16* Qc, int vt, int l15, int g) {
    s.q[0] = *(const u32x4*)(Qc + (16 * vt + l15) * 64 + 16 * g); s.q[1] = *(const u32x4*)(Qc + (16 * vt + l15) * 64 + 16 * g + 8);
#pragma unroll
    for (int m = 0; m < 4; ++m)
#pragma unroll
        for (int j = 0; j < 2; ++j) s.p[m][j] = *(const u32x4*)(Pc + (16 * m + l15) * 64 + 32 * j + 8 * g);
}
__device__ __forceinline__ void s2_step(f32x4 (&acc)[4], const S2Set& s, bf16* Hc, int g) {
    unsigned hw[4][2];
#pragma unroll
    for (int m = 0; m < 4; ++m) { hw[m][0] = pk2(acc[m][0], acc[m][1]); hw[m][1] = pk2(acc[m][2], acc[m][3]); }
#pragma unroll
    for (int m = 0; m < 4; ++m) *(u32x2*)(Hc + 16 * m + 4 * g) = (u32x2){hw[m][0], hw[m][1]};
    const bf16x8 hb0 = as_frag((u32x4){hw[0][0], hw[0][1], hw[1][0], hw[1][1]}), hb1 = as_frag((u32x4){hw[2][0], hw[2][1], hw[3][0], hw[3][1]});
#pragma unroll
    for (int m = 0; m < 4; ++m) {
        const unsigned q0 = (m & 2) ? ((m & 1) ? s.q[1].z : s.q[1].x) : ((m & 1) ? s.q[0].z : s.q[0].x), q1 = (m & 2) ? ((m & 1) ? s.q[1].w : s.q[1].y) : ((m & 1) ? s.q[0].w : s.q[0].y);
        f32x4 d = (f32x4){bflo(q0), bfhi(q0), bflo(q1), bfhi(q1)};
        d = mfma16(as_frag(s.p[m][0]), hb0, d);
        d = mfma16(as_frag(s.p[m][1]), hb1, d);
        acc[m] = d;
    }
}
__device__ __forceinline__ void phase_s2_chain(const Args& a, int wave, int lane, int G) {
    unsigned char* ws = a.ws;
    const bf16* PM = (const bf16*)(ws + WS_PM); const bf16* QT = (const bf16*)(ws + WS_QT); bf16* HT = (bf16*)(ws + WS_HT);
    const int l15 = lane & 15, g = lane >> 4;
    if (wave >= 2) return;
    static_assert(NCHUNK % 4 == 0, "S2 ring");
    for (int wt = blockIdx.x * 2 + wave; wt < 512; wt += G * 2) {
        const int chain = wt >> 2, vt = wt & 3;
        f32x4 acc[4];
#pragma unroll
        for (int m = 0; m < 4; ++m) acc[m] = (f32x4){0.f, 0.f, 0.f, 0.f};
        const bf16* Pc = PM + (size_t)chain * NCHUNK * 4096; const bf16* Qc = QT + (size_t)chain * NCHUNK * 4096;
        bf16* Hc = HT + (size_t)chain * NCHUNK * 4096 + (16 * vt + l15) * 64;
        S2Set s0, s1, s2, s3;
        s2_load(s0, Pc, Qc, vt, l15, g); s2_load(s1, Pc + 4096, Qc + 4096, vt, l15, g); s2_load(s2, Pc + 2 * 4096, Qc + 2 * 4096, vt, l15, g); s2_load(s3, Pc + 3 * 4096, Qc + 3 * 4096, vt, l15, g);
#pragma unroll 1
        for (int c = 0; c < NCHUNK; c += 4) {
            const int cn = c + 4 < NCHUNK ? c + 4 : c;
            const bf16* Pn = Pc + (size_t)cn * 4096; const bf16* Qn = Qc + (size_t)cn * 4096;
            s2_step(acc, s0, Hc + (size_t)c * 4096, g);       s2_load(s0, Pn, Qn, vt, l15, g);
            s2_step(acc, s1, Hc + (size_t)(c + 1) * 4096, g); s2_load(s1, Pn + 4096, Qn + 4096, vt, l15, g);
            s2_step(acc, s2, Hc + (size_t)(c + 2) * 4096, g); s2_load(s2, Pn + 2 * 4096, Qn + 2 * 4096, vt, l15, g);
            s2_step(acc, s3, Hc + (size_t)(c + 3) * 4096, g); s2_load(s3, Pn + 3 * 4096, Qn + 3 * 4096, vt, l15, g);
        }
    }
}

__device__ __forceinline__ void phase_s3_readout(const Args& a, int lj, int nrows, int gw, int NGW, int lane) {
    unsigned char* ws = a.ws;
    const bf16* YL = (const bf16*)(ws + WS_Y); const bf16* RH = (const bf16*)(ws + WS_RH); const bf16* HT = (const bf16*)(ws + WS_HT);
    const bf16* Vv = (const bf16*)(ws + WS_RKV) + (size_t)2 * T * D; const float* RKB = (const float*)(ws + WS_RKB); const bf16* Gg = (const bf16*)(ws + WS_G); bf16* Z = (bf16*)(ws + WS_Z);
    const float* lng = a.in[21] + lj * 1024; const float* lnb = a.in[22] + lj * 1024;
    const int l15 = lane & 15, g = lane >> 4;
    for (int task = gw; task < (nrows / 16) * 16; task += NGW) {
        const int tt = task >> 4, h = task & 15, r0 = tt * 16, row = r0 + l15;
        int b, cc[2];
        if (r0 < TL) { b = r0 >> 13; const int tb = (r0 & (SEQ - 1)) >> 6; cc[0] = 4 + tb; cc[1] = 4 + (127 - tb); }
        else { const int loc = r0 - TL; b = loc >> 8; const int tb = (loc & 255) >> 6; cc[0] = tb; cc[1] = 3 - tb; }
        f32x4 acc[4];
        const size_t ro = (size_t)row * D + h * 64 + 4 * g;
#pragma unroll
        for (int vt = 0; vt < 4; ++vt) acc[vt] = bf4(*(const u32x2*)(YL + ro + 16 * vt)) + bf4(*(const u32x2*)(YL + (size_t)T * D + ro + 16 * vt));
#pragma unroll
        for (int dir = 0; dir < 2; ++dir) {
            const int chain = dir * 64 + b * 16 + h;
            const bf16* rh = RH + ((size_t)dir * T + row) * D + h * 64 + 8 * g;
            const bf16x8 f0 = as_frag(*(const u32x4*)(rh)), f1 = as_frag(*(const u32x4*)(rh + 32));
            const bf16* hc = HT + ((size_t)chain * NCHUNK + cc[dir]) * 4096;
#pragma unroll
            for (int vt = 0; vt < 4; ++vt) { const bf16* hr = hc + (16 * vt + l15) * 64 + 8 * g;
                acc[vt] = mfma16(as_frag(*(const u32x4*)(hr)), f0, acc[vt]); acc[vt] = mfma16(as_frag(*(const u32x4*)(hr + 32)), f1, acc[vt]); }
        }
        float s = 0.f;
#pragma unroll
        for (int vt = 0; vt < 4; ++vt) s += (acc[vt][0] + acc[vt][1]) + (acc[vt][2] + acc[vt][3]);
        s += __shfl_xor(s, 16); s += __shfl_xor(s, 32);
        const float mean = s * (1.0f / 64.0f); float vs = 0.f;
#pragma unroll
        for (int vt = 0; vt < 4; ++vt) { acc[vt] = acc[vt] - mean; vs += (acc[vt][0] * acc[vt][0] + acc[vt][1] * acc[vt][1]) + (acc[vt][2] * acc[vt][2] + acc[vt][3] * acc[vt][3]); }
        vs += __shfl_xor(vs, 16); vs += __shfl_xor(vs, 32);
        const float rstd = rsqrtf(vs * (1.0f / 64.0f) + 64.0f * 1e-5f), bon = RKB[(size_t)row * 16 + h];
#pragma unroll
        for (int vt = 0; vt < 4; ++vt) { const int col = h * 64 + 16 * vt + 4 * g; const size_t o = (size_t)row * D + col;
            const f32x4 vq = bf4(*(const u32x2*)(Vv + o)), lg4 = *(const f32x4*)(lng + col), lb4 = *(const f32x4*)(lnb + col); const u32x2 gw2 = *(const u32x2*)(Gg + o);
            const f32x4 zz = acc[vt] * rstd * lg4 + lb4 + vq * bon;
            u32x2 w; w.x = pk2(zz[0] * bflo(gw2.x), zz[1] * bfhi(gw2.x)); w.y = pk2(zz[2] * bflo(gw2.y), zz[3] * bfhi(gw2.y));
            *(u32x2*)(Z + o) = w; }
    }
}
__device__ __forceinline__ void phase_cv(const Args& a, int lc, int rows, int gw, int NGW, int lane) {
    unsigned char* ws = a.ws;
    const bf16* BG = (const bf16*)(ws + WS_BG); const bf16* CU = (const bf16*)(ws + WS_CUZ); bf16* Z = (bf16*)(ws + WS_Z);
    const float* cw = a.in[25] + (size_t)lc * 3 * 1024;
    for (int t = gw; t < rows; t += NGW) {
        int rs, re; if (t < TL) { rs = t & ~63; re = rs + 63; } else { const int loc = t - TL; rs = TL + (loc & ~255); re = rs + 255; }
        const bool hp = t > rs, hn = t < re;
#pragma unroll
        for (int j = 0; j < 4; ++j) { const int col = 256 * j + 4 * lane; const size_t o = (size_t)t * D + col;
            const u32x2 zc = *(const u32x2*)(CU + o), bg = *(const u32x2*)(BG + o);
            const u32x2 zp = hp ? *(const u32x2*)(CU + o - D) : (u32x2){0u, 0u}, zn = hn ? *(const u32x2*)(CU + o + D) : (u32x2){0u, 0u};
            const f32x4 w0 = *(const f32x4*)(cw + col), w1 = *(const f32x4*)(cw + 1024 + col), w2 = *(const f32x4*)(cw + 2048 + col);
            const f32x4 zv = (f32x4){bflo(zc.x), bfhi(zc.x), bflo(zc.y), bfhi(zc.y)}, pv = (f32x4){bflo(zp.x), bfhi(zp.x), bflo(zp.y), bfhi(zp.y)}, nv = (f32x4){bflo(zn.x), bfhi(zn.x), bflo(zn.y), bfhi(zn.y)};
            const f32x4 bv = (f32x4){bflo(bg.x), bfhi(bg.x), bflo(bg.y), bfhi(bg.y)};
            const f32x4 r = bv * (w0 * pv + w1 * zv + w2 * nv);
            u32x2 w; w.x = pk2(r.x, r.y); w.y = pk2(r.z, r.w); *(u32x2*)(Z + o) = w; }
    }
}
typedef float f32x2v __attribute__((ext_vector_type(2)));
__device__ __forceinline__ float lane_bcast(float v, int srclane) { return __builtin_bit_cast(float, __builtin_amdgcn_readlane(__builtin_bit_cast(int, v), srclane)); }
__device__ __forceinline__ void phase_e_route(const Args& a, int layer, int rows, LAS unsigned char* lds, int tid, int gw, int NGW, int lane, int probe_rep = 0) {
    unsigned char* ws = a.ws;
    const float* xs = (const float*)(ws + (layer < 2 ? WS_XSA : WS_XSB));
    const float* MODS = (const float*)(ws + WS_MODS); bf16* H2 = (bf16*)(ws + WS_H2);
    const float* ng = a.in[6] + (size_t)(layer * 2 + 1) * 1024;
    const float* rw = a.in[27] + (size_t)layer * 1024 * 32; const float* rb = a.in[28] + layer * 32;
    unsigned* cnt = (unsigned*)(ws + WS_CTL) + CW_CNT + (layer + 4 * probe_rep) * 32 * CNT_STRIDE;
    int* SLOTL = (int*)(ws + (probe_rep ? WS_L1 : WS_SLOTL)); float* GATEL = (float*)(ws + (probe_rep ? WS_L1 + 8 * MiB : WS_GATEL));
    LAS float* wt = (LAS float*)lds;
    LAS int* hist = (LAS int*)(lds + LDSCTL_OFF + 3072); LAS int* base = hist + 32; LAS int* lcnt = hist + 64;
    int* TKE = (int*)(ws + WS_C12); float* TKG = (float*)(ws + WS_C12 + 4 * MiB);
    for (int i = tid; i < 32768; i += 512) wt[(i & 31) * 1024 + (i >> 5)] = rw[i];
    if (tid < 32) hist[tid] = 0;
    __syncthreads();
    const int my_e = lane >> 1; const float my_b = rb[my_e];
    const bool b5 = (lane & 32) != 0, b4 = (lane & 16) != 0, b3 = (lane & 8) != 0, b2 = (lane & 4) != 0, b1 = (lane & 2) != 0;
    for (int t = gw; t < rows; t += NGW) {
        const int mr = mod_row(t);
        const float* mod = MODS + (size_t)(layer * 5 + mr) * 6144;
        f32x4 x[4];
#pragma unroll
        for (int j = 0; j < 4; ++j) x[j] = *(const f32x4*)(xs + (size_t)t * D + 256 * j + 4 * lane);
        const float rstd = row_rstd(x);
#pragma unroll
        for (int j = 0; j < 4; ++j) { const int col = 256 * j + 4 * lane;
            x[j] = x[j] * rstd * *(const f32x4*)(ng + col) * (*(const f32x4*)(mod + 4 * 1024 + col) + 1.0f) + *(const f32x4*)(mod + 3 * 1024 + col);
            u32x2 w; w.x = pk2(x[j].x, x[j].y); w.y = pk2(x[j].z, x[j].w); *(u32x2*)(H2 + (size_t)t * D + col) = w; }
        float p[32];
#pragma unroll
        for (int eg = 0; eg < 8; ++eg) {
#pragma unroll
            for (int ee = 0; ee < 4; ++ee) { const int e = eg * 4 + ee; f32x2v s2 = (f32x2v){0.f, 0.f};
#pragma unroll
                for (int j = 0; j < 4; ++j) { const f32x4 wv = *(const LAS f32x4*)(wt + e * 1024 + 256 * j + 4 * lane);
                    s2 = __builtin_elementwise_fma((f32x2v){x[j].x, x[j].y}, (f32x2v){wv.x, wv.y}, s2); s2 = __builtin_elementwise_fma((f32x2v){x[j].z, x[j].w}, (f32x2v){wv.z, wv.w}, s2); }
                p[e] = s2.x + s2.y; }
            asm volatile("" ::: "memory");
        }
        float q16[16];
#pragma unroll
        for (int i = 0; i < 16; ++i) { const float send = b5 ? p[i] : p[i + 16]; const float keep = b5 ? p[i + 16] : p[i]; q16[i] = keep + __shfl_xor(send, 32); }
        float q8[8];
#pragma unroll
        for (int i = 0; i < 8; ++i) { const float send = b4 ? q16[i] : q16[i + 8]; const float keep = b4 ? q16[i + 8] : q16[i]; q8[i] = keep + __shfl_xor(send, 16); }
        float q4[4];
#pragma unroll
        for (int i = 0; i < 4; ++i) { const float send = b3 ? q8[i] : q8[i + 4]; const float keep = b3 ? q8[i + 4] : q8[i]; q4[i] = keep + __shfl_xor(send, 8); }
        float q2[2];
#pragma unroll
        for (int i = 0; i < 2; ++i) { const float send = b2 ? q4[i] : q4[i + 2]; const float keep = b2 ? q4[i + 2] : q4[i]; q2[i] = keep + __shfl_xor(send, 4); }
        float q1; { const float send = b1 ? q2[0] : q2[1]; const float keep = b1 ? q2[1] : q2[0]; q1 = keep + __shfl_xor(send, 2); }
        const float lg = q1 + __shfl_xor(q1, 1) + my_b;
        int rank = 0;
#pragma unroll 1
        for (int e = 0; e < 32; ++e) { const float o = lane_bcast(lg, 2 * e); rank += (o > lg || (o == lg && e < my_e)) ? 1 : 0; }
        const bool sel = rank < 4 && !(lane & 1);
        const unsigned long long m0 = __ballot(sel && rank == 0), m1 = __ballot(sel && rank == 1), m2 = __ballot(sel && rank == 2), m3 = __ballot(sel && rank == 3);
        const float v0 = lane_bcast(lg, (int)__builtin_ctzll(m0)), v1 = lane_bcast(lg, (int)__builtin_ctzll(m1)), v2 = lane_bcast(lg, (int)__builtin_ctzll(m2)), v3 = lane_bcast(lg, (int)__builtin_ctzll(m3));
        const float e1 = __expf(v1 - v0), e2 = __expf(v2 - v0), e3 = __expf(v3 - v0);
        const float inv = 1.0f / (1.0f + e1 + e2 + e3);
        if (sel) {
            TKE[t * 4 + rank] = my_e; TKG[t * 4 + rank] = __expf(lg - v0) * inv;
            __hip_atomic_fetch_add(hist + my_e, 1, __ATOMIC_RELAXED, __HIP_MEMORY_SCOPE_WORKGROUP);
        }
    }
    asm volatile("s_waitcnt vmcnt(0) lgkmcnt(0)" ::: "memory"); __syncthreads();
    if (tid < 32) { base[tid] = (int)atomicAdd(cnt + tid * CNT_STRIDE, (unsigned)hist[tid]); lcnt[tid] = 0; }
    __syncthreads();
    for (int t = gw; t < rows; t += NGW) {
        if (lane < 4) { const int e = TKE[t * 4 + lane]; const float gk = TKG[t * 4 + lane];
            const int pos = base[e] + __hip_atomic_fetch_add(lcnt + e, 1, __ATOMIC_RELAXED, __HIP_MEMORY_SCOPE_WORKGROUP);
            SLOTL[(size_t)e * T + pos] = t * 4 + lane; GATEL[(size_t)e * T + pos] = gk; }
    }
}
__device__ __forceinline__ int okey(float v, int e) { const int i = __builtin_bit_cast(int, v); const int o = i ^ ((i >> 31) & 0x7fffffff); return (o & ~31) | (31 - e); }
__device__ __forceinline__ void phase_e_route_mfma(const Args& a, int layer, int rows, LAS unsigned char* lds, int tid, int wave, int gw, int NGW, int lane, int probe_rep = 0) {
    unsigned char* ws = a.ws;
    const float* xs = (const float*)(ws + (layer < 2 ? WS_XSA : WS_XSB));
    const float* MODS = (const float*)(ws + WS_MODS); bf16* H2 = (bf16*)(ws + WS_H2);
    const float* ng = a.in[6] + (size_t)(layer * 2 + 1) * 1024; const float* rb = a.in[28] + layer * 32;
    const bf16* WRT = (const bf16*)(ws + WS_WRT) + (size_t)layer * 2 * 32 * 1024;
    unsigned* cnt = (unsigned*)(ws + WS_CTL) + CW_CNT + (layer + 4 * probe_rep) * 32 * CNT_STRIDE;
    int* SLOTL = (int*)(ws + (probe_rep ? WS_L1 : WS_SLOTL)); float* GATEL = (float*)(ws + (probe_rep ? WS_L1 + 8 * MiB : WS_GATEL));
    LAS int* hist = (LAS int*)(lds + LDSCTL_OFF + 3072); LAS int* base = hist + 32; LAS int* lcnt = hist + 64;
    int* TKE = (int*)(ws + WS_C12); float* TKG = (float*)(ws + WS_C12 + 4 * MiB);
    LAS unsigned char* tile = lds + wave * 8448;
    if (tid < 32) hist[tid] = 0;
    __syncthreads();
    const int l15 = lane & 15, g = lane >> 4;
    const int nlat = TL / 16, nctx = rows > TL ? TC / 4 : 0, G_ = NGW / 8;
    for (int it = 0;; ++it) {
        int t0, ntok;
        { const int tl = gw + it * NGW; const int xi = (int)blockIdx.x + (it - (nlat + NGW - 1) / NGW) * G_ * 8 + wave * G_;
          if (tl < nlat) { t0 = tl * 16; ntok = 16; } else if (it >= (nlat + NGW - 1) / NGW && xi < nctx) { t0 = TL + xi * 4; ntok = 4; } else if (it >= (nlat + NGW - 1) / NGW) break; else continue; }
        const float* mod = MODS + (size_t)(layer * 5 + mod_row(t0)) * 6144;
        float rstd[16];
#pragma unroll
        for (int t = 0; t < 16; ++t) { f32x4 x[4];
            const int tr = t < ntok ? t0 + t : t0;
#pragma unroll
            for (int j = 0; j < 4; ++j) x[j] = *(const f32x4*)(xs + (size_t)tr * D + 256 * j + 4 * lane);
            rstd[t] = __builtin_bit_cast(float, __builtin_amdgcn_readfirstlane(__builtin_bit_cast(int, row_rstd(x))));
            if ((t & 3) == 3) asm volatile("" ::: "memory"); }
        f32x4 acc[2]; acc[0] = (f32x4){0.f, 0.f, 0.f, 0.f}; acc[1] = acc[0];
#pragma unroll 1
        for (int s = 0; s < 4; ++s) {
            const int col = 256 * s + 4 * lane;
            const f32x4 g4 = *(const f32x4*)(ng + col) * (*(const f32x4*)(mod + 4 * 1024 + col) + 1.0f), s4 = *(const f32x4*)(mod + 3 * 1024 + col);
            f32x4 hv[16];
#pragma unroll
            for (int t = 0; t < 16; ++t) { const int tr = t < ntok ? t0 + t : t0; hv[t] = *(const f32x4*)(xs + (size_t)tr * D + col) * rstd[t] * g4 + s4;
                const u32x2 w = pk4(hv[t]); if (t < ntok) *(u32x2*)(H2 + (size_t)tr * D + col) = w;
                *(LAS u32x2*)(tile + t * 528 + lane * 8) = w; hv[t] = hv[t] - bf4(w); }
            LDS_WAIT(); asm volatile("" ::: "memory");
            const bf16* wh = WRT + (size_t)l15 * 1024 + 256 * s + 8 * g; const bf16* wl = wh + (size_t)32 * 1024;
#pragma unroll
            for (int ks = 0; ks < 8; ++ks) { const bf16x8 fb = as_frag(*(const LAS u32x4*)(tile + l15 * 528 + ks * 64 + g * 16));
#pragma unroll
                for (int et = 0; et < 2; ++et) { acc[et] = mfma16(as_frag(*(const u32x4*)(wh + (size_t)et * 16 * 1024 + 32 * ks)), fb, acc[et]);
                    acc[et] = mfma16(as_frag(*(const u32x4*)(wl + (size_t)et * 16 * 1024 + 32 * ks)), fb, acc[et]); } }
            LDS_WAIT(); asm volatile("" ::: "memory");
#pragma unroll
            for (int t = 0; t < 16; ++t) *(LAS u32x2*)(tile + t * 528 + lane * 8) = pk4(hv[t]);
            LDS_WAIT(); asm volatile("" ::: "memory");
#pragma unroll
            for (int ks = 0; ks < 8; ++ks) { const bf16x8 fb = as_frag(*(const LAS u32x4*)(tile + l15 * 528 + ks * 64 + g * 16));
#pragma unroll
                for (int et = 0; et < 2; ++et) acc[et] = mfma16(as_frag(*(const u32x4*)(wh + (size_t)et * 16 * 1024 + 32 * ks)), fb, acc[et]); }
            LDS_WAIT(); asm volatile("" ::: "memory");
        }
        float v[8]; int key[8];
#pragma unroll
        for (int j = 0; j < 8; ++j) { const int e = (j < 4 ? 0 : 16) + 4 * g + (j & 3); v[j] = acc[j >> 2][j & 3] + rb[e]; key[j] = okey(v[j], e); }
        int kb[8], kc[8], kd2[8];
#pragma unroll
        for (int j = 0; j < 8; ++j) kb[j] = __shfl_xor(key[j], 16);
#pragma unroll
        for (int j = 0; j < 8; ++j) { kc[j] = __shfl_xor(key[j], 32); kd2[j] = __shfl_xor(kb[j], 32); }
        float vmax = fmaxf(fmaxf(fmaxf(v[0], v[1]), fmaxf(v[2], v[3])), fmaxf(fmaxf(v[4], v[5]), fmaxf(v[6], v[7])));
        vmax = fmaxf(vmax, __shfl_xor(vmax, 16)); vmax = fmaxf(vmax, __shfl_xor(vmax, 32));
        int rank[8]; float ex[8], part = 0.f;
#pragma unroll
        for (int j = 0; j < 8; ++j) { int r = 0;
#pragma unroll
            for (int q = 0; q < 8; ++q) r += (key[q] > key[j]) + (kb[q] > key[j]) + (kc[q] > key[j]) + (kd2[q] > key[j]);
            rank[j] = r; ex[j] = __expf(v[j] - vmax); part += r < 4 ? ex[j] : 0.f; }
        part += __shfl_xor(part, 16); part += __shfl_xor(part, 32);
        const float inv = 1.0f / part; const int t = t0 + l15;
#pragma unroll
        for (int j = 0; j < 8; ++j) if (rank[j] < 4 && l15 < ntok) { const int e = (j < 4 ? 0 : 16) + 4 * g + (j & 3);
            TKE[t * 4 + rank[j]] = e; TKG[t * 4 + rank[j]] = ex[j] * inv;
            __hip_atomic_fetch_add(hist + e, 1, __ATOMIC_RELAXED, __HIP_MEMORY_SCOPE_WORKGROUP); }
    }
    asm volatile("s_waitcnt vmcnt(0) lgkmcnt(0)" ::: "memory"); __syncthreads();
    if (tid < 32) { base[tid] = (int)atomicAdd(cnt + tid * CNT_STRIDE, (unsigned)hist[tid]); lcnt[tid] = 0; }
    __syncthreads();
    for (int it = 0;; ++it) {
        int t0, ntok;
        { const int tl = gw + it * NGW; const int xi = (int)blockIdx.x + (it - (nlat + NGW - 1) / NGW) * G_ * 8 + wave * G_;
          if (tl < nlat) { t0 = tl * 16; ntok = 16; } else if (it >= (nlat + NGW - 1) / NGW && xi < nctx) { t0 = TL + xi * 4; ntok = 4; } else if (it >= (nlat + NGW - 1) / NGW) break; else continue; }
        if ((lane >> 2) < ntok) { const int t = t0 + (lane >> 2), k = lane & 3;
            const int e = TKE[t * 4 + k]; const float gk = TKG[t * 4 + k];
            const int pos = base[e] + __hip_atomic_fetch_add(lcnt + e, 1, __ATOMIC_RELAXED, __HIP_MEMORY_SCOPE_WORKGROUP);
            SLOTL[(size_t)e * T + pos] = t * 4 + k; GATEL[(size_t)e * T + pos] = gk; }
    }
}
__device__ __forceinline__ void phase_final(const Args& a, int gw, int NGW, int lane) {
    unsigned char* ws = a.ws;
    const float* xs = (const float*)(ws + WS_XSB); const float* MODS = (const float*)(ws + WS_MODS); const bf16* YS = (const bf16*)(ws + WS_YS);
    for (int t = gw; t < TL; t += NGW) {
        const int mr = t >> 13;
        f32x4 m5[4], x[4];
#pragma unroll
        for (int j = 0; j < 4; ++j) m5[j] = *(const f32x4*)(MODS + (size_t)(3 * 5 + mr) * 6144 + 5 * 1024 + 256 * j + 4 * lane);
        load_x_combined(x, xs + (size_t)t * D, true, YS, t, m5, lane);
        const float rstd = row_rstd(x);
#pragma unroll
        for (int j = 0; j < 4; ++j) { const int col = 256 * j + 4 * lane; *(f32x4*)(a.out + (size_t)t * D + col) = x[j] * rstd * *(const f32x4*)(a.in[7] + col); }
    }
}

using pg8::Unit; using pg8::tile_map;
struct SchedStd {
    int G, c, nM, nN;
    __device__ __forceinline__ bool next(int i, Unit& u) const { const long L = (long)i * G + c; if (L >= (long)nM * nN) return false; int pm, pn; tile_map((int)L, nM, nN, pm, pn); u.pm = pm; u.pn = pn; u.e = 0; u.nv = pm; return true; }
    __device__ __forceinline__ void a_ready(const Unit&) const {}
    __device__ __forceinline__ void done(const Unit&) const {}
    __device__ __forceinline__ unsigned row_off(const Unit&, int) const { return 0u; }
};
struct SchedB1 {
    int G, c;
    __device__ __forceinline__ bool next(int i, Unit& u) const { const long L = (long)i * G + c; constexpr int n1 = 3 * NMT * 4; if (L >= n1 + 3 * NMT) return false; const int l = (int)L;
        if (l < n1) { const int j = l / (NMT * 4), r = l % (NMT * 4); int pm, pn; tile_map(r, NMT, 4, pm, pn); u.pm = j * NMT + pm; u.pn = j * 4 + pn; u.e = j; u.nv = pm; }
        else { const int r = l - n1, j = r / NMT, pm = r % NMT; u.pm = (3 + j) * NMT + pm; u.pn = 12 + j; u.e = 3 + j; u.nv = pm; }
        return true; }
    __device__ __forceinline__ void a_ready(const Unit&) const {}
    __device__ __forceinline__ void done(const Unit&) const {}
    __device__ __forceinline__ unsigned row_off(const Unit&, int) const { return 0u; }
};
struct SchedB2 {
    int G, c;
    __device__ __forceinline__ bool next(int i, Unit& u) const { const long L = (long)i * G + c; constexpr int n1 = 2 * NMT * 8; if (L >= n1 + NMT * 4) return false; const int l = (int)L;
        if (l < n1) { const int j = l / (NMT * 8), r = l % (NMT * 8); int pm, pn; tile_map(r, NMT, 8, pm, pn); u.pm = j * NMT + pm; u.pn = j * 8 + pn; u.e = j; u.nv = pm; }
        else { const int r = l - n1; int pm, pn; tile_map(r, NMT, 4, pm, pn); u.pm = 2 * NMT + pm; u.pn = 16 + pn; u.e = 2; u.nv = pm; }
        return true; }
    __device__ __forceinline__ void a_ready(const Unit&) const {}
    __device__ __forceinline__ void done(const Unit&) const {}
    __device__ __forceinline__ unsigned row_off(const Unit&, int) const { return 0u; }
};
struct SchedMoe {
    int G, c, nnt, ntiles, P; LAS unsigned char* lds; const int* slotl;
    __device__ __forceinline__ bool next(int i, Unit& u) const { const long L = (long)i * G + c; const int ntp = (ntiles + P - 1) / P, ppg = nnt / (8 / P); if (L >= (long)ntp * ppg * 8) return false;
        const LAS int* tpre = (const LAS int*)(lds + LDSCTL_OFF + 64); const LAS int* ecnt = (const LAS int*)(lds + LDSCTL_OFF + 256); const LAS unsigned short* tile_e = (const LAS unsigned short*)(lds + LDSCTL_OFF + 512);
        const int xq = (int)(L >> 3), x8 = (int)(L & 7); int tile = (xq / ppg) * P + (x8 % P); const int pnl = (x8 / P) * ppg + xq % ppg; const bool dead = tile >= ntiles; tile = dead ? 0 : tile;
        const int e = __builtin_amdgcn_readfirstlane((int)tile_e[tile]), r0 = (tile - __builtin_amdgcn_readfirstlane(tpre[e])) * 256; int nv = __builtin_amdgcn_readfirstlane(ecnt[e]) - r0; nv = nv > 256 ? 256 : nv; nv = dead ? 0 : nv;
        u.pm = dead ? MAXTILES : tile; u.pn = e * nnt + pnl; u.e = e; u.nv = nv | (r0 << 9); return true; }
    __device__ __forceinline__ void a_ready(const Unit&) const {}
    __device__ __forceinline__ void done(const Unit&) const {}
    __device__ __forceinline__ unsigned row_off(const Unit& u, int r) const { const int nv = u.nv & 511, r0 = u.nv >> 9; const int tok = r < nv ? (slotl[(size_t)u.e * T + r0 + r] >> 2) : 0; return (unsigned)tok * 2048u; }
};

using pg8::cvt_pk_bf16;
template <class P> __device__ __forceinline__ P* pin_ptr(P* p) { asm volatile("" : "+v"(p)); return p; }
struct EpiB1 {
    static constexpr bool PERM = true, AFTER_DRAIN = false;
    bf16* RKV; bf16* L1;
    __device__ __forceinline__ void operator()(const f32x4 (&acc)[2][2][4][2], const Unit& u, int wr, int wc, int fr, int fq) const {
        const int seg = u.e, row0 = u.nv * 256 + wr * 64 + fr;
        const int jj = seg - 3, ld = seg < 3 ? D : 128, col0 = (seg < 3 ? (u.pn - seg * 4) * 256 : 0) + wc * 32 + 8 * fq;
        bf16* base = seg < 3 ? RKV + (size_t)seg * T * D : L1 + (size_t)jj * T * 128;
#pragma unroll
        for (int ai = 0; ai < 2; ++ai)
#pragma unroll
            for (int m = 0; m < 4; ++m) { bf16* rowp = base + (size_t)(row0 + ai * 128 + m * 16) * ld + col0;
#pragma unroll
                for (int bj = 0; bj < 2; ++bj) { if (seg >= 3 && bj == 1) continue; f32x4 v0 = acc[ai][bj][m][0], v1 = acc[ai][bj][m][1];
                    if (jj == 0) {
#pragma unroll
                        for (int q = 0; q < 4; ++q) { v0[q] = tanh_fast(v0[q]); v1[q] = tanh_fast(v1[q]); } }
                    else if (jj == 2) {
#pragma unroll
                        for (int q = 0; q < 4; ++q) { v0[q] = sigm(v0[q]); v1[q] = sigm(v1[q]); } }
                    u32x4 w; w.x = cvt_pk_bf16(v0[0], v0[1]); w.y = cvt_pk_bf16(v0[2], v0[3]); w.z = cvt_pk_bf16(v1[0], v1[1]); w.w = cvt_pk_bf16(v1[2], v1[3]);
                    *(u32x4*)(rowp + bj * 128) = w; } }
    }
};
struct EpiB2 {
    static constexpr bool PERM = true, AFTER_DRAIN = false;
    bf16* RW; bf16* RA; bf16* Gg;
    __device__ __forceinline__ void operator()(const f32x4 (&acc)[2][2][4][2], const Unit& u, int wr, int wc, int fr, int fq) const {
        const int jj = u.e, row0 = u.nv * 256 + wr * 64 + fr, pnl = u.pn - jj * 8;
        const int dirn = jj < 2 ? (pnl >> 2) : 0, col0 = (jj < 2 ? (pnl & 3) : pnl) * 256 + wc * 32 + 8 * fq;
        bf16* base = (jj == 0 ? RW : jj == 1 ? RA : Gg) + (size_t)dirn * T * D;
#pragma unroll
        for (int ai = 0; ai < 2; ++ai)
#pragma unroll
            for (int m = 0; m < 4; ++m) { bf16* rowp = base + (size_t)(row0 + ai * 128 + m * 16) * D + col0;
#pragma unroll
                for (int bj = 0; bj < 2; ++bj) { const f32x4 v0 = acc[ai][bj][m][0], v1 = acc[ai][bj][m][1];
                    u32x4 w; w.x = cvt_pk_bf16(v0[0], v0[1]); w.y = cvt_pk_bf16(v0[2], v0[3]); w.z = cvt_pk_bf16(v1[0], v1[1]); w.w = cvt_pk_bf16(v1[2], v1[3]);
                    *(u32x4*)(rowp + bj * 128) = w; } }
    }
};
struct EpiRes {
    static constexpr bool PERM = true, AFTER_DRAIN = false;
    float* X; const float* gate; float* Xo;
    __device__ __forceinline__ void operator()(const f32x4 (&acc)[2][2][4][2], const Unit& u, int wr, int wc, int fr, int fq) const {
        const int row0 = u.pm * 256 + wr * 64 + fr, col0 = u.pn * 256 + wc * 32 + 8 * fq, mr = u.pm < NMT_L ? (u.pm >> 5) : 4;
        const float* gp = pin_ptr(gate + (size_t)mr * 6144 + col0);
        f32x4 gv[2][2];
#pragma unroll
        for (int bj = 0; bj < 2; ++bj)
#pragma unroll
            for (int n = 0; n < 2; ++n) gv[bj][n] = *(const f32x4*)(gp + bj * 128 + 4 * n);
#pragma unroll
        for (int ai = 0; ai < 2; ++ai)
#pragma unroll
            for (int m = 0; m < 4; ++m) { float* rowp = X + (size_t)(row0 + ai * 128 + m * 16) * D + col0;
#pragma unroll
                for (int bj = 0; bj < 2; ++bj)
#pragma unroll
                    for (int n = 0; n < 2; ++n) { float* p = rowp + bj * 128 + 4 * n; *(f32x4*)(Xo + (p - X)) = *(const f32x4*)p + gv[bj][n] * acc[ai][bj][m][n]; } }
    }
};
struct EpiWin {
    static constexpr bool PERM = true, AFTER_DRAIN = false;
    bf16* BG; bf16* CU;
    __device__ __forceinline__ void operator()(const f32x4 (&acc)[2][2][4][2], const Unit& u, int wr, int wc, int fr, int fq) const {
        const int row0 = u.pm * 256 + wr * 64 + fr;
        if (u.pn < 4) {
            const int col0 = u.pn * 256 + wc * 32 + 8 * fq;
#pragma unroll
            for (int ai = 0; ai < 2; ++ai)
#pragma unroll
                for (int m = 0; m < 4; ++m) { bf16* rowp = BG + (size_t)(row0 + ai * 128 + m * 16) * D + col0;
#pragma unroll
                    for (int bj = 0; bj < 2; ++bj) { const f32x4 v0 = acc[ai][bj][m][0], v1 = acc[ai][bj][m][1];
                        u32x4 w; w.x = cvt_pk_bf16(v0[0], v0[1]); w.y = cvt_pk_bf16(v0[2], v0[3]); w.z = cvt_pk_bf16(v1[0], v1[1]); w.w = cvt_pk_bf16(v1[2], v1[3]);
                        *(u32x4*)(rowp + bj * 128) = w; } }
        } else {
            const int f0 = (u.pn - 4) * 128 + wc * 32 + 8 * fq;
#pragma unroll
            for (int ai = 0; ai < 2; ++ai)
#pragma unroll
                for (int m = 0; m < 4; ++m) { const f32x4 v0 = acc[ai][0][m][0] * acc[ai][1][m][0], v1 = acc[ai][0][m][1] * acc[ai][1][m][1];
                    u32x4 w; w.x = cvt_pk_bf16(v0[0], v0[1]); w.y = cvt_pk_bf16(v0[2], v0[3]); w.z = cvt_pk_bf16(v1[0], v1[1]); w.w = cvt_pk_bf16(v1[2], v1[3]);
                    *(u32x4*)(CU + (size_t)(row0 + ai * 128 + m * 16) * D + f0) = w; }
        }
    }
};
struct EpiGU {
    static constexpr bool PERM = true, AFTER_DRAIN = false;
    bf16* INTER; const float* bgu;
    __device__ __forceinline__ void operator()(const f32x4 (&acc)[2][2][4][2], const Unit& u, int wr, int wc, int fr, int fq) const {
        const int e = u.e, pnl = u.pn - e * 8, row0 = u.pm * 256 + wr * 64 + fr, f0 = pnl * 128 + wc * 32 + 8 * fq;
        const float* bp = pin_ptr(bgu + (size_t)e * 2048 + f0);
        f32x4 bg[2], bu[2];
#pragma unroll
        for (int n = 0; n < 2; ++n) { bg[n] = *(const f32x4*)(bp + 4 * n); bu[n] = *(const f32x4*)(bp + 1024 + 4 * n); }
#pragma unroll
        for (int ai = 0; ai < 2; ++ai)
#pragma unroll
            for (int m = 0; m < 4; ++m) { f32x4 o[2];
#pragma unroll
                for (int n = 0; n < 2; ++n) { const f32x4 g = acc[ai][0][m][n] + bg[n], uu = acc[ai][1][m][n] + bu[n];
#pragma unroll
                    for (int q = 0; q < 4; ++q) { const float gc = fminf(g[q], 7.0f), uc = fminf(fmaxf(uu[q], -7.0f), 7.0f); o[n][q] = (uc + 1.0f) * gc * sigm(1.702f * gc); } }
                u32x4 w; w.x = cvt_pk_bf16(o[0][0], o[0][1]); w.y = cvt_pk_bf16(o[0][2], o[0][3]); w.z = cvt_pk_bf16(o[1][0], o[1][1]); w.w = cvt_pk_bf16(o[1][2], o[1][3]);
                *(u32x4*)(INTER + (size_t)(row0 + ai * 128 + m * 16) * 1024 + f0) = w; }
    }
};
struct EpiDown {
    static constexpr bool PERM = true, AFTER_DRAIN = false;
    bf16* YS; const float* bdn; const int* slotl; const float* gatel;
    __device__ __forceinline__ void operator()(const f32x4 (&acc)[2][2][4][2], const Unit& u, int wr, int wc, int fr, int fq) const {
        const int e = u.e, pnl = u.pn - e * 4, col0 = pnl * 256 + wc * 32 + 8 * fq, nv = u.nv & 511, r0 = u.nv >> 9;
        const float* bp = pin_ptr(bdn + (size_t)e * 1024 + col0);
        f32x4 bv[2][2];
#pragma unroll
        for (int bj = 0; bj < 2; ++bj)
#pragma unroll
            for (int n = 0; n < 2; ++n) bv[bj][n] = *(const f32x4*)(bp + bj * 128 + 4 * n);
#pragma unroll
        for (int ai = 0; ai < 2; ++ai)
#pragma unroll
            for (int m = 0; m < 4; ++m) { const int r = ai * 128 + wr * 64 + m * 16 + fr;
                if (r < nv) { const size_t li = (size_t)e * T + r0 + r; const int slot = slotl[li]; const float gt = gatel[li];
                    bf16* rowp = YS + (size_t)slot * 1024 + col0;
#pragma unroll
                    for (int bj = 0; bj < 2; ++bj) { const f32x4 v0 = (acc[ai][bj][m][0] + bv[bj][0]) * gt, v1 = (acc[ai][bj][m][1] + bv[bj][1]) * gt;
                        u32x4 w; w.x = cvt_pk_bf16(v0[0], v0[1]); w.y = cvt_pk_bf16(v0[2], v0[3]); w.z = cvt_pk_bf16(v1[0], v1[1]); w.w = cvt_pk_bf16(v1[2], v1[3]);
                        *(u32x4*)(rowp + bj * 128) = w; } } }
    }
};

__device__ __forceinline__ int moe_tables(const unsigned* cnt, LAS unsigned char* lds, int tid) {
    LAS int* tpre = (LAS int*)(lds + LDSCTL_OFF + 64); LAS int* ecnt = (LAS int*)(lds + LDSCTL_OFF + 256); LAS unsigned short* tile_e = (LAS unsigned short*)(lds + LDSCTL_OFF + 512);
    if (tid == 0) { int p = 0; for (int e = 0; e < 32; ++e) { const int cn = (int)__hip_atomic_load(cnt + e * CNT_STRIDE, __ATOMIC_RELAXED, __HIP_MEMORY_SCOPE_AGENT); ecnt[e] = cn; tpre[e] = p; p += (cn + 255) >> 8; } tpre[32] = p; }
    __syncthreads();
    const int nt = tpre[32];
    for (int t = tid; t < nt; t += 512) { int e = 0; while (e < 31 && t >= tpre[e + 1]) ++e; tile_e[t] = (unsigned short)e; }
    __syncthreads();
    return nt;
}

constexpr int NPHASES = 38;
typedef const Args __attribute__((address_space(4))) CArgs;
__global__ void __launch_bounds__(512, 2) fwd_kernel(Args a_) {
    extern __shared__ __attribute__((aligned(16))) unsigned char lds_raw[];
    LAS unsigned char* lds = (LAS unsigned char*)lds_raw;
    const int G = gridDim.x, NGW = G * 8;
    CArgs* ap0 = (CArgs*)__builtin_amdgcn_kernarg_segment_ptr();
    if (threadIdx.x < 4) ((LAS unsigned*)(lds + LDSCTL_OFF))[threadIdx.x] = 0u;
    __syncthreads();
    XcdBarrier bar = xcd_barrier_post((unsigned*)(a_.ws + WS_CTL) + CW_BAR, (volatile LAS unsigned*)(lds + LDSCTL_OFF));
    const int lo = a_.ph_lo, hi = a_.ph_hi;
    int ph = 0;
#ifndef MK_ONLY
#define MK_ONLY -1
#endif
#ifndef MK_DBL
#define MK_DBL 0
#endif
#define PH_BEGIN(id) if ((MK_ONLY < 0 || MK_ONLY == (id)) && ph >= lo && ph < hi) { for (int rep_ = 0; rep_ <= ((MK_DBL >> (id)) & 1); ++rep_) { CArgs* ap = ap0; asm volatile("" : "+s"(ap)); const Args a = *(const Args*)ap; unsigned char* const ws = a.ws; (void)ws; const int wave = (int)bar.wv; int tid = wave * 64 + lane_id(); asm volatile("" : "+v"(tid)); const int lane = tid & 63, gw = blockIdx.x * 8 + wave; (void)lane; (void)gw;
#define PH_END } } if (ph >= lo && ph + 1 < hi) xcd_barrier(bar); ++ph;

    PH_BEGIN(0) p0_prologue(a, lds, tid, lane, wave, G); PH_END

#pragma unroll 1
    for (int layer = 0; layer < DEPTH; ++layer) {
        const int kind = layer & 1, lj = layer >> 1;
        const int rows = layer == 3 ? TL : T, nmt = rows / 256;
        const int rows_moe = layer < 2 ? T : TL;
        if (kind == 0) {
            PH_BEGIN(1) phase_a_rwkv(a, layer, lds, tid, gw, NGW, lane); PH_END
            PH_BEGIN(2) {
                pg8::Gemm g{(const bf16*)(ws + WS_XL), (const bf16*)(ws + WS_WRKV) + (size_t)lj * 3840 * 1024, 6 * T, 3840, 1024};
                SchedB1 S{G, (int)blockIdx.x}; EpiB1 E{(bf16*)(ws + WS_RKV), (bf16*)(ws + WS_L1)};
                pg8::gemm_phase<EpiB1, SchedB1, true, true, false>(lds, g, S, E, tid); } PH_END
            PH_BEGIN(3) {
                pg8::Gemm g{(const bf16*)(ws + WS_L1), (const bf16*)(ws + WS_L2T) + (size_t)lj * 5120 * 128, 3 * T, 5120, 128};
                SchedB2 S{G, (int)blockIdx.x}; EpiB2 E{(bf16*)(ws + WS_RAWW), (bf16*)(ws + WS_RAWA), (bf16*)(ws + WS_G)};
                pg8::gemm_phase<EpiB2, SchedB2, true, true, false>(lds, g, S, E, tid); } PH_END
            PH_BEGIN(4) phase_c_prep(a, lj, lds, tid, gw, NGW, lane); PH_END
            PH_BEGIN(5) phase_s1_chunks(a, lj, lds, tid, G, (MK_DBL >> 5) & 1 & (rep_ == 0)); PH_END
            PH_BEGIN(15) phase_s2_chain(a, wave, lane, G); PH_END
            PH_BEGIN(6) phase_s3_readout(a, lj, layer == 2 ? TL : T, gw, NGW, lane); PH_END
        } else {
            PH_BEGIN(7) phase_a_conv(a, layer, rows, gw, NGW, lane); PH_END
            PH_BEGIN(8) {
                pg8::Gemm g{(const bf16*)(ws + WS_XL), (const bf16*)(ws + WS_WIN) + (size_t)lj * 3072 * 1024, rows, 3072, 1024};
                SchedStd S{G, (int)blockIdx.x, nmt, 12}; EpiWin E{(bf16*)(ws + WS_BG), (bf16*)(ws + WS_CUZ)};
                pg8::gemm_phase<EpiWin, SchedStd, true, true, false>(lds, g, S, E, tid); } PH_END
            PH_BEGIN(9) phase_cv(a, lj, rows, gw, NGW, lane); PH_END
        }
        PH_BEGIN(10) {
            const bf16* Wt = kind == 0 ? (const bf16*)(ws + WS_WO) + (size_t)lj * 1024 * 1024 : (const bf16*)(ws + WS_WOUT) + (size_t)lj * 1024 * 1024;
            pg8::Gemm g{(const bf16*)(ws + WS_Z), Wt, rows, 1024, 1024};
            SchedStd S{G, (int)blockIdx.x, layer == 2 ? NMT_L : nmt, 4}; EpiRes E{(float*)(ws + (layer < 2 ? WS_XSA : WS_XSB)), (const float*)(ws + WS_MODS) + (size_t)layer * 5 * 6144 + 2 * 1024, (float*)(ws + (rep_ ? WS_XL : (layer < 2 ? WS_XSA : WS_XSB)))};
            pg8::gemm_phase<EpiRes, SchedStd, true, true, false>(lds, g, S, E, tid); } PH_END
        PH_BEGIN(11) phase_e_route_mfma(a, layer, rows_moe, lds, tid, wave, gw, NGW, lane, rep_); PH_END
        PH_BEGIN(12) {
            const int nt = __builtin_amdgcn_readfirstlane(moe_tables((const unsigned*)(ws + WS_CTL) + CW_CNT + layer * 32 * CNT_STRIDE, lds, tid));
            pg8::Gemm g{(const bf16*)(ws + WS_H2), (const bf16*)(ws + WS_WGU) + (size_t)layer * 32 * 2048 * 1024, 0, 0, 1024};
            SchedMoe S{G, (int)blockIdx.x, 8, nt, 2, lds, (const int*)(ws + WS_SLOTL)};
            EpiGU E{(bf16*)(ws + WS_INTER), a.in[30] + (size_t)layer * 32 * 2048};
            pg8::gemm_phase<EpiGU, SchedMoe, true, true, true>(lds, g, S, E, tid); } PH_END
        PH_BEGIN(13) {
            const int nt = __builtin_amdgcn_readfirstlane(moe_tables((const unsigned*)(ws + WS_CTL) + CW_CNT + layer * 32 * CNT_STRIDE, lds, tid));
            pg8::Gemm g{(const bf16*)(ws + WS_INTER), (const bf16*)(ws + WS_WDN) + (size_t)layer * 32 * 1024 * 1024, 0, 0, 1024};
            SchedMoe S{G, (int)blockIdx.x, 4, nt, 8, lds, (const int*)(ws + WS_SLOTL)};
            EpiDown E{(bf16*)(ws + WS_YS), a.in[32] + (size_t)layer * 32 * 1024, (const int*)(ws + WS_SLOTL), (const float*)(ws + WS_GATEL)};
            pg8::gemm_phase<EpiDown, SchedMoe, true, true, false>(lds, g, S, E, tid); } PH_END
    }
    PH_BEGIN(14) phase_final(a, gw, NGW, lane); PH_END
#undef PH_BEGIN
#undef PH_END
}

extern "C" void kernel_launch(void* const* d_in, const int* in_sizes, int n_in, void* d_out, int out_size, void* d_ws, size_t ws_size, hipStream_t stream) {
    static int grid = 0;
    if (grid == 0) {
        if (n_in != 33 || in_sizes[0] != TL * D || out_size != TL * D || ws_size < WS_END) { fprintf(stderr, "kernel_launch: unexpected problem (n_in %d, in0 %d, out %d, ws %zu < %zu)\n", n_in, n_in > 0 ? in_sizes[0] : -1, out_size, ws_size, (size_t)WS_END); grid = -1; return; }
        int dev = 0, cus = 0, per_cu = 0;
        if (hipGetDevice(&dev) != hipSuccess || hipDeviceGetAttribute(&cus, hipDeviceAttributeMultiprocessorCount, dev) != hipSuccess) { grid = -1; return; }
        if (hipFuncSetAttribute((const void*)fwd_kernel, hipFuncAttributeMaxDynamicSharedMemorySize, LDS_BYTES) != hipSuccess) { fprintf(stderr, "kernel_launch: hipFuncSetAttribute failed\n"); grid = -1; return; }
        if (hipOccupancyMaxActiveBlocksPerMultiprocessor(&per_cu, (const void*)fwd_kernel, 512, LDS_BYTES) != hipSuccess || per_cu < 1) fprintf(stderr, "kernel_launch: occupancy query says %d\n", per_cu);
        (void)hipGetLastError();
        grid = cus;
    }
    if (grid < 0) return;
    if (hipMemsetAsync((char*)d_ws + WS_CTL, 0, CTL_ZERO_BYTES, stream) != hipSuccess) return;
    Args a{};
    for (int i = 0; i < 33; ++i) a.in[i] = (const float*)d_in[i];
    a.out = (float*)d_out; a.ws = (unsigned char*)d_ws;
#if MK_PER_PHASE
    for (int p = 0; p < NPHASES; ++p) { a.ph_lo = p; a.ph_hi = p + 1; hipLaunchKernelGGL(fwd_kernel, dim3(grid), dim3(512), LDS_BYTES, stream, a); }
#else
    a.ph_lo = 0; a.ph_hi = NPHASES;
    hipLaunchKernelGGL(fwd_kernel, dim3(grid), dim3(512), LDS_BYTES, stream, a);
#endif
    const hipError_t le = hipPeekAtLastError();
    if (le != hipSuccess) fprintf(stderr, "kernel_launch: launch failed: %s\n", hipGetErrorName(le));
}
```

```cpp
#include <hip/hip_runtime.h>
#include <cstdio>
#include <cstdint>

#ifndef MK_PER_PHASE
#define MK_PER_PHASE 0
#endif

constexpr int D = 1024, NBATCH = 4, SEQ = 8192, TL = NBATCH * SEQ, CTXL = 256, TC = NBATCH * CTXL, T = TL + TC;
constexpr int NH = 16, HS = 64, NE = 32, TOPK = 4, DEPTH = 4;
constexpr int NMT = T / 256;
constexpr int NMT_L = TL / 256;
constexpr int MAXTILES = (T * TOPK) / 256 + NE;
constexpr int NSTEP = CTXL + SEQ;

__device__ __forceinline__ int lane_id() { return (int)__builtin_amdgcn_mbcnt_hi(~0u, __builtin_amdgcn_mbcnt_lo(~0u, 0u)); }
namespace pg8 {
#define PG8_LAS __attribute__((address_space(3)))
typedef unsigned short bf16_t;
typedef short bf16x8 __attribute__((ext_vector_type(8)));
typedef float f32x4 __attribute__((ext_vector_type(4)));
typedef unsigned u32x4 __attribute__((ext_vector_type(4)));
typedef unsigned u32x2 __attribute__((ext_vector_type(2)));
constexpr int BM = 256, BK = 64, HALF = 128, HTB = HALF * BK * 2  , STAGE_BYTES = 8 * HTB, NXCD = 8, WGM = 8;

__host__ __device__ __forceinline__ int lds_byte(int r, int c) { const int st = (r >> 4) * 2 + (c >> 5), rr = r & 15, cc = c & 31, ob = rr * 64 + cc * 2; return st * 1024 + (ob ^ (((ob >> 9) & 1) << 5)); }
__host__ __device__ __forceinline__ void stage_rc(int b, int& R, int& C) { const int st = b / 1024, sb = b % 1024, swz = sb ^ (((sb >> 9) & 1) << 5); R = (st >> 1) * 16 + swz / 64; C = (st & 1) * 32 + (swz % 64) / 2; }
__host__ __device__ __forceinline__ int perm32(int rho) { const int n = rho >> 4, i = rho & 15; return 8 * (i >> 2) + 4 * n + (i & 3); }

struct Unit { int pm, pn, e, nv; };
struct Gemm { const bf16_t* A; const bf16_t* Bt; int M, N, K; };

__device__ __forceinline__ void tile_map(int wgid, int nM, int nN, int& pm, int& pn) {
    const int nwg = nM * nN;
    { const int q = nwg / NXCD, r = nwg % NXCD, xcd = wgid % NXCD, off = wgid / NXCD; wgid = (xcd < r ? xcd * (q + 1) : r * (q + 1) + (xcd - r) * q) + off; }
    const int nig = WGM * nN, gid = wgid / nig, fm = gid * WGM, gsz = (nM - fm) < WGM ? (nM - fm) : WGM;
    pm = fm + ((wgid % nig) % gsz); pn = (wgid % nig) / gsz;
}
typedef __bf16 bf16x2_t __attribute__((ext_vector_type(2)));
typedef float f32x2_t __attribute__((ext_vector_type(2)));
__device__ __forceinline__ unsigned cvt_pk_bf16(float lo, float hi) { const f32x2_t v = {lo, hi}; const bf16x2_t b = __builtin_convertvector(v, bf16x2_t); return __builtin_bit_cast(unsigned, b); }

template <class Epi, class Sched, bool ALIGN_EPI = false, bool SP2 = false, bool GATHER = false>
__device__ __forceinline__ void gemm_phase(PG8_LAS unsigned char* lds, const Gemm g, const Sched& S, const Epi& E, int tid_in) {
    int tid_ = tid_in; asm volatile("" : "+v"(tid_));
    const int tid = tid_, wid = __builtin_amdgcn_readfirstlane(tid >> 6), lane = tid & 63, wr = wid >> 2, wc = wid & 3, fr = lane & 15, fq = lane >> 4;
    int K_ = g.K; asm volatile("" : "+s"(K_));
    const int K = K_, nt = K / BK;
    unsigned voffA[2], voffB[2]; int gR[2]; unsigned gC[2];
#pragma unroll
    for (int i = 0; i < 2; ++i) { int R, C; stage_rc(tid * 16 + i * 8192, R, C); const int Rb = Epi::PERM ? ((R & ~31) + perm32(R & 31)) : R;
        voffA[i] = (unsigned)(R * K + C) * 2u; voffB[i] = (unsigned)(Rb * K + C) * 2u; gR[i] = R; gC[i] = (unsigned)C * 2u; }
    unsigned oc[2][2], on[2][2], o2[2][2];
#pragma unroll
    for (int h = 0; h < 2; ++h)
#pragma unroll
        for (int i = 0; i < 2; ++i) { oc[h][i] = 0u; on[h][i] = 0u; o2[h][i] = 0u; }
    const size_t kstep = (size_t)(BK * 2);
    const size_t hstep = (size_t)HALF * K * 2;
    const size_t tstep = 2 * hstep;
    const unsigned ldsw = (unsigned)wid * 1024u;
    const int aoff = lds_byte(wr * 64 + fr, fq * 8), boff = lds_byte(wc * 32 + fr, fq * 8);
#define PG8_SA(b, h) (((b) * 2 + (h)) * HTB)
#define PG8_SB(b, h) ((4 + (b) * 2 + (h)) * HTB)
#define PG8_STAGE(bufoff, gbase, voff) do { _Pragma("unroll") for (int _i = 0; _i < 2; ++_i) \
        __builtin_amdgcn_global_load_lds((const unsigned*)((const char*)(gbase) + (voff)[_i]), (PG8_LAS unsigned*)(lds + (bufoff) + ldsw + _i * 8192), 16, 0, 0); } while (0)
#define PG8_STAGE_A(bufoff, base, h, O) do { if constexpr (GATHER) { PG8_STAGE(bufoff, base, (O)[h]); } else { PG8_STAGE(bufoff, (base) + (h) * hstep, voffA); } } while (0)
#define PG8_LDA(dst, b, h) do { _Pragma("unroll") for (int m = 0; m < 4; ++m) _Pragma("unroll") for (int k = 0; k < 2; ++k) dst[m][k] = *(const PG8_LAS bf16x8*)(lds + PG8_SA(b, h) + aoff + m * 2048 + k * 1024); } while (0)
#define PG8_LDB(dst, b, h) do { _Pragma("unroll") for (int n = 0; n < 2; ++n) _Pragma("unroll") for (int k = 0; k < 2; ++k) dst[n][k] = *(const PG8_LAS bf16x8*)(lds + PG8_SB(b, h) + boff + n * 2048 + k * 1024); } while (0)
#define PG8_MMA(ai, bj, At, Bt) do { __builtin_amdgcn_s_setprio(1); _Pragma("unroll") for (int m = 0; m < 4; ++m) _Pragma("unroll") for (int n = 0; n < 2; ++n) _Pragma("unroll") for (int k = 0; k < 2; ++k) \
        acc[ai][bj][m][n] = __builtin_amdgcn_mfma_f32_16x16x32_bf16(Bt[n][k], At[m][k], acc[ai][bj][m][n], 0, 0, 0); __builtin_amdgcn_s_setprio(0); } while (0)
#define PG8_WAIT_V(n) asm volatile("s_waitcnt vmcnt(" #n ")" ::: "memory")
#define PG8_WAIT_L(n) asm volatile("s_waitcnt lgkmcnt(" #n ")" ::: "memory")
#define PG8_BAR __builtin_amdgcn_s_barrier()
#define PG8_SCHED __builtin_amdgcn_sched_barrier(0)
    Unit cur, nxt; int ui = 0;
    if (!S.next(0, cur)) return;
    f32x4 acc[2][2][4][2];
#pragma unroll
    for (int a = 0; a < 2; ++a)
#pragma unroll
        for (int b = 0; b < 2; ++b)
#pragma unroll
            for (int m = 0; m < 4; ++m)
#pragma unroll
                for (int n = 0; n < 2; ++n) acc[a][b][m][n] = (f32x4){0.f, 0.f, 0.f, 0.f};
    bf16x8 At[4][2], B0[2][2], B1[2][2];
    const char* cA = GATHER ? (const char*)g.A : (const char*)g.A + (size_t)cur.pm * tstep; const char* cB = (const char*)g.Bt + (size_t)cur.pn * tstep;
    S.a_ready(cur);
    if constexpr (GATHER) {
#pragma unroll
        for (int h = 0; h < 2; ++h)
#pragma unroll
            for (int i = 0; i < 2; ++i) oc[h][i] = S.row_off(cur, h * HALF + gR[i]) + gC[i];
    }
    if constexpr (SP2) {
        PG8_STAGE(PG8_SB(0, 0), cB, voffB); PG8_STAGE(PG8_SB(0, 1), cB + hstep, voffB); PG8_STAGE_A(PG8_SA(0, 0), cA, 0, oc); PG8_STAGE_A(PG8_SA(0, 1), cA, 1, oc);
        if (wr == 1) PG8_BAR;
        PG8_WAIT_V(2); PG8_BAR;
        PG8_STAGE(PG8_SB(1, 0), cB + kstep, voffB); PG8_STAGE_A(PG8_SA(1, 0), cA + kstep, 0, oc); PG8_STAGE(PG8_SB(1, 1), cB + hstep + kstep, voffB);
        PG8_WAIT_V(6); PG8_BAR;
    } else {
        PG8_STAGE(PG8_SB(0, 0), cB, voffB); PG8_STAGE_A(PG8_SA(0, 0), cA, 0, oc); PG8_STAGE(PG8_SB(0, 1), cB + hstep, voffB); PG8_STAGE_A(PG8_SA(0, 1), cA, 1, oc);
        if (wr == 1) PG8_BAR;
        PG8_WAIT_V(4); PG8_BAR;
        PG8_STAGE(PG8_SB(1, 0), cB + kstep, voffB); PG8_STAGE_A(PG8_SA(1, 0), cA + kstep, 0, oc); PG8_STAGE(PG8_SB(1, 1), cB + hstep + kstep, voffB);
        PG8_WAIT_V(6); PG8_BAR;
    }
    for (;;) {
        const bool has_next = S.next(ui + 1, nxt);
        const char* nA = GATHER ? (const char*)g.A : (has_next ? (const char*)g.A + (size_t)nxt.pm * tstep : cA); const char* nB = has_next ? (const char*)g.Bt + (size_t)nxt.pn * tstep : cB;
        if constexpr (GATHER) {
#pragma unroll
            for (int h = 0; h < 2; ++h)
#pragma unroll
                for (int i = 0; i < 2; ++i) on[h][i] = has_next ? (S.row_off(nxt, h * HALF + gR[i]) + gC[i]) : oc[h][i];
        }
        for (int t = 0; t < nt; t += 2) {
            const bool last = (t == nt - 2);
            const char* a1 = cA + (size_t)(t + 1) * kstep;
            const char* a2 = last ? nA : cA + (size_t)(t + 2) * kstep; const char* b2 = last ? nB : cB + (size_t)(t + 2) * kstep;
            const char* a3 = a2 + kstep; const char* b3 = b2 + kstep;
            if constexpr (GATHER) {
#pragma unroll
                for (int h = 0; h < 2; ++h)
#pragma unroll
                    for (int i = 0; i < 2; ++i) o2[h][i] = last ? on[h][i] : oc[h][i];
            }
            if (last && has_next) S.a_ready(nxt);
            if constexpr (SP2) {
            PG8_LDB(B0, 0, 0); PG8_LDB(B1, 0, 1); PG8_SCHED; PG8_LDA(At, 0, 0); PG8_STAGE_A(PG8_SA(1, 1), a1, 1, oc);
            PG8_WAIT_V(8); PG8_WAIT_L(0); PG8_BAR; PG8_MMA(0, 0, At, B0); PG8_MMA(0, 1, At, B1); PG8_BAR; PG8_SCHED;
            PG8_LDA(At, 0, 1); PG8_STAGE(PG8_SB(0, 0), b2, voffB); PG8_STAGE(PG8_SB(0, 1), b2 + hstep, voffB); PG8_STAGE_A(PG8_SA(0, 0), a2, 0, o2);
            PG8_WAIT_V(8); PG8_WAIT_L(0); PG8_BAR; PG8_MMA(1, 0, At, B0); PG8_MMA(1, 1, At, B1); PG8_BAR; PG8_SCHED;
            PG8_LDB(B0, 1, 0); PG8_LDB(B1, 1, 1); PG8_SCHED; PG8_LDA(At, 1, 0); PG8_STAGE_A(PG8_SA(0, 1), a2, 1, o2);
            PG8_WAIT_V(8); PG8_WAIT_L(0); PG8_BAR; PG8_MMA(0, 0, At, B0); PG8_MMA(0, 1, At, B1); PG8_BAR; PG8_SCHED;
            PG8_LDA(At, 1, 1); PG8_STAGE(PG8_SB(1, 0), b3, voffB); PG8_STAGE(PG8_SB(1, 1), b3 + hstep, voffB); PG8_STAGE_A(PG8_SA(1, 0), a3, 0, o2);
            PG8_WAIT_V(8); PG8_WAIT_L(0); PG8_BAR; PG8_MMA(1, 0, At, B0); PG8_MMA(1, 1, At, B1); PG8_BAR; PG8_SCHED;
            } else {
            PG8_LDB(B0, 0, 0); PG8_SCHED; PG8_LDA(At, 0, 0); PG8_STAGE_A(PG8_SA(1, 1), a1, 1, oc);
            PG8_WAIT_L(8); PG8_BAR; PG8_WAIT_L(0); PG8_MMA(0, 0, At, B0); PG8_BAR; PG8_SCHED;
            PG8_LDB(B1, 0, 1); PG8_STAGE(PG8_SB(0, 0), b2, voffB);
            PG8_BAR; PG8_WAIT_L(0); PG8_MMA(0, 1, At, B1); PG8_BAR;
            PG8_LDA(At, 0, 1); PG8_STAGE_A(PG8_SA(0, 0), a2, 0, o2);
            PG8_BAR; PG8_WAIT_L(0); PG8_MMA(1, 0, At, B0); PG8_BAR; PG8_SCHED;
            PG8_STAGE(PG8_SB(0, 1), b2 + hstep, voffB);
            PG8_WAIT_V(6); PG8_BAR; PG8_MMA(1, 1, At, B1); PG8_BAR;
            PG8_LDB(B0, 1, 0); PG8_SCHED; PG8_LDA(At, 1, 0); PG8_STAGE_A(PG8_SA(0, 1), a2, 1, o2);
            PG8_WAIT_L(8); PG8_BAR; PG8_WAIT_L(0); PG8_MMA(0, 0, At, B0); PG8_BAR; PG8_SCHED;
            PG8_LDB(B1, 1, 1); PG8_STAGE(PG8_SB(1, 0), b3, voffB);
            PG8_BAR; PG8_WAIT_L(0); PG8_MMA(0, 1, At, B1); PG8_BAR;
            PG8_LDA(At, 1, 1); PG8_STAGE_A(PG8_SA(1, 0), a3, 0, o2);
            PG8_BAR; PG8_WAIT_L(0); PG8_MMA(1, 0, At, B0); PG8_BAR; PG8_SCHED;
            PG8_STAGE(PG8_SB(1, 1), b3 + hstep, voffB);
            PG8_WAIT_V(6); PG8_BAR; PG8_MMA(1, 1, At, B1); PG8_BAR;
            }
        }
        if constexpr (ALIGN_EPI) { if (wr == 0) PG8_BAR; }
        if constexpr (!Epi::AFTER_DRAIN) { E(acc, cur, wr, wc, fr, fq); S.done(cur); }
        if (!has_next) break;
#pragma unroll
        for (int a = 0; a < 2; ++a)
#pragma unroll
            for (int b = 0; b < 2; ++b)
#pragma unroll
                for (int m = 0; m < 4; ++m)
#pragma unroll
                    for (int n = 0; n < 2; ++n) acc[a][b][m][n] = (f32x4){0.f, 0.f, 0.f, 0.f};
        cur = nxt; cA = nA; cB = nB; ++ui;
        if constexpr (GATHER) {
#pragma unroll
            for (int h = 0; h < 2; ++h)
#pragma unroll
                for (int i = 0; i < 2; ++i) oc[h][i] = on[h][i];
        }
        if constexpr (ALIGN_EPI) { if (wr == 1) PG8_BAR; }
    }
    PG8_WAIT_V(0);
    if constexpr (!ALIGN_EPI) { if (wr == 0) PG8_BAR; }
    PG8_BAR;
    if constexpr (Epi::AFTER_DRAIN) { E.fused(acc, cur, wr, wc, fr, fq, lds, wid, lane); S.done(cur); }
#undef PG8_SA
#undef PG8_SB
#undef PG8_STAGE
#undef PG8_STAGE_A
#undef PG8_LDA
#undef PG8_LDB
#undef PG8_MMA
#undef PG8_WAIT_V
#undef PG8_WAIT_L
#undef PG8_BAR
#undef PG8_SCHED
}
}

#define LAS __attribute__((address_space(3)))
typedef unsigned short bf16;
typedef float f32x4 __attribute__((ext_vector_type(4)));
typedef unsigned u32x2 __attribute__((ext_vector_type(2)));
typedef unsigned u32x4 __attribute__((ext_vector_type(4)));
#define LDS_WAIT() asm volatile("s_waitcnt lgkmcnt(0)" ::: "memory")
__device__ __forceinline__ unsigned pk2(float lo, float hi) { return pg8::cvt_pk_bf16(lo, hi); }
__device__ __forceinline__ unsigned f2bf(float f) { return pk2(f, f) & 0xffffu; }
__device__ __forceinline__ float bflo(unsigned w) { return __builtin_bit_cast(float, w << 16); }
__device__ __forceinline__ float bfhi(unsigned w) { return __builtin_bit_cast(float, w & 0xffff0000u); }
__device__ __forceinline__ float wave_sum(float v) {
#pragma unroll
    for (int o = 1; o < 64; o <<= 1) v += __shfl_xor(v, o);
    return v;
}
__device__ __forceinline__ float sigm(float x) { return 1.0f / (1.0f + __expf(-x)); }
__device__ __forceinline__ float tanh_fast(float x) { const float e = __expf(2.0f * x); return 1.0f - 2.0f / (e + 1.0f); }

constexpr size_t MiB = 1u << 20;
constexpr size_t RF = (size_t)T * D * 4;
constexpr size_t RB = (size_t)T * D * 2;
constexpr size_t WS_CTL = 0, CTL_ZERO_BYTES = 1 * MiB;
constexpr size_t WS_MODS = 1 * MiB;
constexpr size_t WS_XSA = 2 * MiB, WS_XSB = WS_XSA + RF;
constexpr size_t WS_XL = WS_XSB + RF;
constexpr size_t WS_RKV = WS_XL + 6 * RB;
constexpr size_t WS_L1 = WS_RKV + 3 * RF;
constexpr size_t WS_WDEC = WS_L1 + 50 * MiB;
constexpr size_t WS_AA = WS_WDEC + 2 * RF;
constexpr size_t WS_G = WS_AA + 2 * RF;
constexpr size_t WS_KK = WS_G + RB;
constexpr size_t WS_KD = WS_KK + RF;
constexpr size_t WS_BETA = WS_KD + 2 * RF;
constexpr size_t WS_RKB = WS_BETA + 2 * RF;
constexpr size_t WS_C12 = WS_RKB + 3 * MiB;
constexpr size_t WS_WRT = WS_C12 + 6 * MiB;
constexpr size_t WS_Y = WS_C12 + 9 * MiB;
constexpr size_t WS_Z = WS_Y + 2 * RF;
constexpr size_t WS_H2 = WS_Z + RB;
constexpr size_t WS_SLOTL = WS_H2 + RB;
constexpr size_t WS_GATEL = WS_SLOTL + 5 * MiB;
constexpr size_t WS_WRKV = WS_GATEL + 5 * MiB;
constexpr size_t WS_L2T = WS_WRKV + 15 * MiB;
constexpr size_t WS_WO = WS_L2T + 5 * MiB;
constexpr size_t WS_WIN = WS_WO + 4 * MiB;
constexpr size_t WS_WOUT = WS_WIN + 12 * MiB;
constexpr size_t WS_WGU = WS_WOUT + 4 * MiB;
constexpr size_t WS_WDN = WS_WGU + 512 * MiB;
constexpr size_t WS_END = WS_WDN + 256 * MiB;
constexpr size_t WS_INTER = WS_WDEC;
constexpr size_t WS_YS = WS_KD;
constexpr size_t WS_BG = WS_RKV, WS_CUZ = WS_RKV + RB;
constexpr size_t WS_RAWW = WS_AA, WS_RAWA = WS_AA + RF;
constexpr size_t WS_RH = WS_AA;
constexpr size_t WS_PM = WS_WDEC;
constexpr size_t WS_RKB1 = WS_C12 + 1 * MiB;
constexpr size_t WS_QT = WS_XL;
constexpr size_t WS_HT = WS_XL + RF;
static_assert((size_t)128 * 132 * 4096 * 2 <= RF, "chunk state tensors");
static_assert((size_t)MAXTILES * 256 * 1024 * 2 <= 4 * RF, "INTER overlay");
static_assert((size_t)T * 4 * 1024 * 2 <= 2 * RF, "YS overlay");
static_assert((size_t)3 * T * 256 * 2 <= 50 * MiB, "L1OUT");
constexpr int CW_BAR = 4096;
constexpr int CW_CNT = 16384, CNT_STRIDE = 64;

constexpr int RING_BYTES = 131072;
constexpr int LDSCTL_OFF = RING_BYTES;
constexpr int LDS_BYTES = 147456;

struct Args { const float* in[33]; float* out; unsigned char* ws; int ph_lo, ph_hi; };

__device__ __forceinline__ void transpose_item(const float* W, int N, bf16* WT, int dstK, int drow0, int k0, int n0, LAS float* scr, int lane) {
    float tv[32];
#pragma unroll
    for (int i = 0; i < 32; ++i) { const int kk = 2 * i + (lane >> 5); tv[i] = W[(size_t)(k0 + kk) * N + n0 + (lane & 31)]; }
#pragma unroll
    for (int i = 0; i < 32; ++i) { const int kk = 2 * i + (lane >> 5); scr[kk * 33 + (lane & 31)] = tv[i]; }
    LDS_WAIT(); asm volatile("" ::: "memory");
    const int c = lane & 7;
#pragma unroll
    for (int j = 0; j < 4; ++j) { const int n = (lane >> 3) + 8 * j; const LAS float* s = scr + (8 * c) * 33 + n;
        u32x4 o; o.x = pk2(s[0 * 33], s[1 * 33]); o.y = pk2(s[2 * 33], s[3 * 33]); o.z = pk2(s[4 * 33], s[5 * 33]); o.w = pk2(s[6 * 33], s[7 * 33]);
        *(u32x4*)(WT + (size_t)(drow0 + n) * dstK + k0 + 8 * c) = o; }
    LDS_WAIT(); asm volatile("" ::: "memory");
}
__device__ __forceinline__ int gu_map(int n0) { const int bj = n0 >= 1024 ? 1 : 0, f0 = n0 - bj * 1024; return (f0 >> 7) * 256 + bj * 128 + (f0 & 127); }
__device__ __forceinline__ int conv_map(int n0) { if (n0 < 1024) return n0; const int q = (n0 - 1024) >> 10, f0 = (n0 - 1024) & 1023; return 1024 + (f0 >> 7) * 256 + q * 128 + (f0 & 127); }

__device__ __forceinline__ void p0_prologue(const Args& a, LAS unsigned char* lds, int tid, int lane, int wave, int G) {
    unsigned char* ws = a.ws;
    LAS float* sl = (LAS float*)lds;
    LAS float* red = (LAS float*)(lds + 20480);
    for (int i = tid; i < 5 * 1024; i += 512) { const int r = i >> 10, k = i & 1023; const float cv = r < 4 ? a.in[1][r * 1024 + k] : a.in[3][k]; sl[i] = cv / (1.0f + __expf(-cv)); }
    __syncthreads();
    float* MODS = (float*)(ws + WS_MODS);
    for (int it = blockIdx.x; it < 4 * 96; it += G) {
        const int l = it / 96, n = (it % 96) * 64 + lane;
        const float* W = a.in[4] + (size_t)l * 1024 * 6144 + n;
        float acc[5] = {0.f, 0.f, 0.f, 0.f, 0.f};
        const int kb = wave * 128;
#pragma unroll 8
        for (int k = 0; k < 128; ++k) { const float wv = W[(size_t)(kb + k) * 6144];
#pragma unroll
            for (int r = 0; r < 5; ++r) acc[r] += sl[r * 1024 + kb + k] * wv; }
#pragma unroll
        for (int r = 0; r < 5; ++r) red[(wave * 5 + r) * 64 + lane] = acc[r];
        __syncthreads();
        if (wave < 5) { float s = a.in[5][l * 6144 + n];
#pragma unroll
            for (int w = 0; w < 8; ++w) s += red[(w * 5 + wave) * 64 + lane];
            MODS[(size_t)(l * 5 + wave) * 6144 + n] = s; }
        __syncthreads();
    }
    LAS float* scr = (LAS float*)(lds + 32768 + wave * 8448);
    const int gw = blockIdx.x * 8 + wave, NGW = G * 8;
    bf16* WRKV = (bf16*)(ws + WS_WRKV); bf16* WOt = (bf16*)(ws + WS_WO); bf16* WINt = (bf16*)(ws + WS_WIN); bf16* WOUTt = (bf16*)(ws + WS_WOUT);
    bf16* WGU = (bf16*)(ws + WS_WGU); bf16* WDN = (bf16*)(ws + WS_WDN);
    constexpr int I_GU = 128 * 1024, I_DN = 128 * 512, I_RKV = 6 * 512, I_WO = 2 * 512, I_WIN = 2 * 1536, I_WOUT = 2 * 512, I_W1 = 4 * 32, I_A1 = 4 * 32, I_G1 = 2 * 64;
    constexpr int NITEMS = I_GU + I_DN + I_RKV + I_WO + I_WIN + I_WOUT + I_W1 + I_A1 + I_G1;
    for (int it = gw; it < NITEMS; it += NGW) {
        int r = it;
        if (r < I_GU) { const int m = r >> 10, q = r & 1023, kb = q >> 6, nb = q & 63;
            transpose_item(a.in[29] + (size_t)m * 1024 * 2048, 2048, WGU + (size_t)m * 2048 * 1024, 1024, gu_map(nb * 32), kb * 64, nb * 32, scr, lane); continue; } r -= I_GU;
        if (r < I_DN) { const int m = r >> 9, q = r & 511, kb = q >> 5, nb = q & 31;
            transpose_item(a.in[31] + (size_t)m * 1024 * 1024, 1024, WDN + (size_t)m * 1024 * 1024, 1024, nb * 32, kb * 64, nb * 32, scr, lane); continue; } r -= I_DN;
        if (r < I_RKV) { const int m = r >> 9, q = r & 511, kb = q >> 5, nb = q & 31, lr = m / 3, j = m % 3;
            transpose_item(a.in[9] + (size_t)m * 1024 * 1024, 1024, WRKV + (size_t)lr * 3840 * 1024, 1024, j * 1024 + nb * 32, kb * 64, nb * 32, scr, lane); continue; } r -= I_RKV;
        if (r < I_WO) { const int m = r >> 9, q = r & 511, kb = q >> 5, nb = q & 31;
            transpose_item(a.in[23] + (size_t)m * 1024 * 1024, 1024, WOt + (size_t)m * 1024 * 1024, 1024, nb * 32, kb * 64, nb * 32, scr, lane); continue; } r -= I_WO;
        if (r < I_WIN) { const int m = r / 1536, q = r % 1536, kb = q / 96, nb = q % 96;
            transpose_item(a.in[24] + (size_t)m * 1024 * 3072, 3072, WINt + (size_t)m * 3072 * 1024, 1024, conv_map(nb * 32), kb * 64, nb * 32, scr, lane); continue; } r -= I_WIN;
        if (r < I_WOUT) { const int m = r >> 9, q = r & 511, kb = q >> 5, nb = q & 31;
            transpose_item(a.in[26] + (size_t)m * 1024 * 1024, 1024, WOUTt + (size_t)m * 1024 * 1024, 1024, nb * 32, kb * 64, nb * 32, scr, lane); continue; } r -= I_WOUT;
        if (r < I_W1) { const int m = r >> 5, q = r & 31, kb = q >> 1, nb = q & 1, lr = m >> 1, e = m & 1;
            transpose_item(a.in[11] + (size_t)m * 1024 * 64, 64, WRKV + (size_t)lr * 3840 * 1024, 1024, 3072 + e * 64 + nb * 32, kb * 64, nb * 32, scr, lane); continue; } r -= I_W1;
        if (r < I_A1) { const int m = r >> 5, q = r & 31, kb = q >> 1, nb = q & 1, lr = m >> 1, e = m & 1;
            transpose_item(a.in[14] + (size_t)m * 1024 * 64, 64, WRKV + (size_t)lr * 3840 * 1024, 1024, 3328 + e * 64 + nb * 32, kb * 64, nb * 32, scr, lane); continue; } r -= I_A1;
        { const int m = r >> 6, q = r & 63, kb = q >> 2, nb = q & 3;
            transpose_item(a.in[16] + (size_t)m * 1024 * 128, 128, WRKV + (size_t)m * 3840 * 1024, 1024, 3584 + nb * 32, kb * 64, nb * 32, scr, lane); }
    }
    const int gt = blockIdx.x * 512 + tid, NGT = G * 512;
    for (int i = gt; i < 2 * 3 * 128 * 128; i += NGT) {
        const int pc = i & 127, rw = (i >> 7) & 127, pd = (i >> 14) % 3, lr = i / (3 * 16384);
        *(u32x4*)(WRKV + ((size_t)lr * 3840 + 3072 + pd * 256 + 128 + rw) * 1024 + pc * 8) = (u32x4){0u, 0u, 0u, 0u}; }
    bf16* L2T = (bf16*)(ws + WS_L2T);
    for (int i = gt; i < 2 * 128 * 5120; i += NGT) {
        const int n = i % 5120, k = (i / 5120) & 127, lr = i / (5120 * 128);
        float v = 0.f;
        if (n < 2048) { const int e = n >> 10, d = n & 1023; if ((k >> 6) == e) v = a.in[12][(((size_t)lr * 2 + e) * 64 + (k & 63)) * 1024 + d]; }
        else if (n < 4096) { const int e = (n - 2048) >> 10, d = n & 1023; if ((k >> 6) == e) v = a.in[15][(((size_t)lr * 2 + e) * 64 + (k & 63)) * 1024 + d]; }
        else { const int d = n - 4096; v = a.in[17][((size_t)lr * 128 + k) * 1024 + d]; }
        L2T[((size_t)lr * 5120 + n) * 128 + k] = (bf16)f2bf(v);
    }
    bf16* WRT = (bf16*)(ws + WS_WRT);
    for (int i = gt; i < 4 * 32 * 1024; i += NGT) { const int k = i & 1023, e = (i >> 10) & 31, l = i >> 15;
        const float w = a.in[27][((size_t)l * 1024 + k) * 32 + e]; const unsigned hi = f2bf(w); const float lo = w - bflo(hi);
        WRT[((size_t)(l * 2 + 0) * 32 + e) * 1024 + k] = (bf16)hi; WRT[((size_t)(l * 2 + 1) * 32 + e) * 1024 + k] = (bf16)f2bf(lo); }
}
#define XB_TMO      128
#define XB_XCNT(j)  (256  + 64 * (j))
#define XB_XSUB(j)  (1280 + 64 * (j))
#define XB_XGEN(j)  (2304 + 64 * (j))
#define XB_TOP      3328
#define XB_TOPGEN   3392
#define XCD_BAR_WORDS 3456
#define XB_SPIN_CAP (1u << 23)

__device__ __forceinline__ unsigned xb_ld(unsigned* p)              { return __hip_atomic_load(p, __ATOMIC_RELAXED, __HIP_MEMORY_SCOPE_AGENT); }
__device__ __forceinline__ unsigned xb_add(unsigned* p, unsigned v) { return __hip_atomic_fetch_add(p, v, __ATOMIC_RELAXED, __HIP_MEMORY_SCOPE_AGENT); }
__device__ __forceinline__ unsigned xb_xcc_id() { return (unsigned)__builtin_amdgcn_s_getreg((3 << 11) | 20) & 0xFu; }
#define XB_SPIN(cond, bar) do { unsigned _sp = 0; while (cond) { __builtin_amdgcn_s_sleep(1); \
    if ((++_sp & 255u) == 0u) { if (xb_ld(&(bar)[XB_TMO])) break; if (_sp > XB_SPIN_CAP) { atomicAdd(&(bar)[XB_TMO], 1u); break; } } } } while (0)

struct XcdBarrier {
    unsigned wv;
    unsigned* bar; unsigned x;
    volatile LAS unsigned* st;
};

__device__ __forceinline__ XcdBarrier xcd_barrier_post(unsigned* bar, volatile LAS unsigned* st) {
    XcdBarrier b; b.wv = (unsigned)__builtin_amdgcn_readfirstlane((int)(threadIdx.x >> 6)); b.bar = bar; b.x = xb_xcc_id(); b.st = st;
    if (threadIdx.x == 0) (void)xb_add(&bar[XB_XCNT(b.x)], 1u);
    return b;
}
__device__ __forceinline__ void xcd_barrier_complete(unsigned* bar, unsigned x, unsigned& nloc, unsigned& nx) {
    const unsigned G = gridDim.x * gridDim.y * gridDim.z;
    unsigned sum, cnt, mine, sp = 0u;
    for (;;) {
        sum = 0u; cnt = 0u; mine = 0u;
#pragma unroll
        for (unsigned j = 0; j < 16; ++j) { const unsigned c = xb_ld(&bar[XB_XCNT(j)]); sum += c; cnt += (c > 0u) ? 1u : 0u; mine = (j == x) ? c : mine; }
        if (sum == G) break;
        __builtin_amdgcn_s_sleep(1);
        if ((++sp & 255u) == 0u) { if (xb_ld(&bar[XB_TMO])) break; if (sp > XB_SPIN_CAP) { atomicAdd(&bar[XB_TMO], 1u); break; } }
    }
    nloc = mine > 0u ? mine : 1u; nx = cnt > 0u ? cnt : 1u;
}

__device__ __forceinline__ void xcd_barrier(const XcdBarrier& b) {
    asm volatile("s_waitcnt vmcnt(0)" ::: "memory");
    __syncthreads();
    if (b.wv == 0u && lane_id() == 0) {
        unsigned* bar = b.bar;
        __builtin_amdgcn_s_waitcnt(0);
        unsigned nloc = b.st[0], nx = b.st[1];
        if (nloc == 0u) { xcd_barrier_complete(bar, b.x, nloc, nx); b.st[0] = nloc; b.st[1] = nx; }
        const unsigned old = xb_add(&bar[XB_XSUB(b.x)], 1u);
        const unsigned gen = old / nloc;
        if (old + 1u == (gen + 1u) * nloc) {
            __builtin_amdgcn_fence(__ATOMIC_RELEASE, "agent");
            asm volatile("s_waitcnt vmcnt(0)" ::: "memory");
            const unsigned og = xb_add(&bar[XB_TOP], 1u);
            const unsigned tg = og / nx;
            if (og + 1u == (tg + 1u) * nx) xb_add(&bar[XB_TOPGEN], 1u);
            else XB_SPIN(xb_ld(&bar[XB_TOPGEN]) == tg, bar);
            __builtin_amdgcn_fence(__ATOMIC_ACQUIRE, "agent");
            xb_add(&bar[XB_XGEN(b.x)], 1u);
            asm volatile("s_waitcnt vmcnt(0)" ::: "memory");
        } else {
            XB_SPIN(xb_ld(&bar[XB_XGEN(b.x)]) == gen, bar);
            __builtin_amdgcn_fence(__ATOMIC_ACQUIRE, "agent");
            asm volatile("s_waitcnt vmcnt(0)" ::: "memory");
        }
    }
    __syncthreads();
}

__device__ __forceinline__ int mod_row(int row) { return row < TL ? (row >> 13) : 4; }

__device__ __forceinline__ void load_x_combined(f32x4 (&x)[4], const float* xrow, bool has_prev, const bf16* YS, int t, const f32x4 (&m5)[4], int lane) {
#pragma unroll
    for (int j = 0; j < 4; ++j) x[j] = *(const f32x4*)(xrow + 256 * j + 4 * lane);
    if (has_prev) {
        f32x4 s[4];
#pragma unroll
        for (int j = 0; j < 4; ++j) s[j] = (f32x4){0.f, 0.f, 0.f, 0.f};
#pragma unroll
        for (int k = 0; k < 4; ++k) { const bf16* yr = YS + ((size_t)t * 4 + k) * 1024;
#pragma unroll
            for (int j = 0; j < 4; ++j) { const u32x2 w = *(const u32x2*)(yr + 256 * j + 4 * lane); s[j] += (f32x4){bflo(w.x), bfhi(w.x), bflo(w.y), bfhi(w.y)}; } }
#pragma unroll
        for (int j = 0; j < 4; ++j) x[j] += m5[j] * s[j];
    }
}
__device__ __forceinline__ float row_rstd(const f32x4 (&x)[4]) {
    float ss = 0.f;
#pragma unroll
    for (int j = 0; j < 4; ++j) ss += (x[j].x * x[j].x + x[j].y * x[j].y) + (x[j].z * x[j].z + x[j].w * x[j].w);
    return rsqrtf(wave_sum(ss) * (1.0f / 1024.0f) + 1e-6f);
}

__device__ __forceinline__ void phase_a_rwkv(const Args& a, int layer, LAS unsigned char* lds, int tid, int gw, int NGW, int lane) {
    unsigned char* ws = a.ws; const int lj = layer >> 1; const bool has_prev = layer > 0;
    const float* xin_lat = layer == 0 ? a.in[0] : (const float*)(ws + WS_XSA);
    const float* xin_ctx = layer == 0 ? a.in[2] : (const float*)(ws + WS_XSA) + (size_t)TL * D;
    float* xout = (float*)(ws + (layer == 0 ? WS_XSA : WS_XSB));
    const float* MODS = (const float*)(ws + WS_MODS); const bf16* YS = (const bf16*)(ws + WS_YS); bf16* XL = (bf16*)(ws + WS_XL);
    const float* mug = a.in[8] + (size_t)lj * 6 * 2 * 1024; const float* ng = a.in[6] + (size_t)(layer * 2 + 0) * 1024;
    LAS float* mu = (LAS float*)lds;
    for (int i = tid; i < 6 * 2 * 1024 / 4; i += 512) ((LAS f32x4*)mu)[i] = ((const f32x4*)mug)[i];
    __syncthreads();
    for (int it = gw; it < TL / 8 + TC / 2; it += NGW) {
        const int ntok = it < TL / 8 ? 8 : 2, t0 = it < TL / 8 ? it * 8 : TL + (it - TL / 8) * 2, mr = mod_row(t0);
        int rs, re; if (t0 < TL) { rs = t0 & ~63; re = rs + 63; } else { const int loc = t0 - TL; rs = TL + (loc & ~255); re = rs + 255; }
        const float* mod = MODS + (size_t)(layer * 5 + mr) * 6144;
        const float* m5p = MODS + (size_t)((has_prev ? layer - 1 : 0) * 5 + mr) * 6144 + 5 * 1024;
        f32x4 hm[4], h0[4], hp[4];
#pragma unroll
        for (int j = 0; j < 4; ++j) { hm[j] = (f32x4){0.f, 0.f, 0.f, 0.f}; h0[j] = hm[j]; hp[j] = hm[j]; }
        f32x4 rx[4], nx[4]; u32x2 ry[4][4], ny[4][4];
#define PA_LOAD(X, Y, tt) do { const int t_ = (tt); if (t_ >= rs && t_ <= re) { \
            const float* xrow_ = t_ < TL ? xin_lat + (size_t)t_ * D : xin_ctx + (size_t)(t_ - TL) * D; \
            _Pragma("unroll") for (int j = 0; j < 4; ++j) X[j] = *(const f32x4*)(xrow_ + 256 * j + 4 * lane); \
            if (has_prev) { _Pragma("unroll") for (int k = 0; k < 4; ++k) _Pragma("unroll") for (int j = 0; j < 4; ++j) Y[k][j] = *(const u32x2*)(YS + ((size_t)t_ * 4 + k) * 1024 + 256 * j + 4 * lane); } } } while (0)
#pragma unroll
        for (int j = 0; j < 4; ++j) { rx[j] = (f32x4){0.f, 0.f, 0.f, 0.f}; nx[j] = rx[j];
#pragma unroll
            for (int k = 0; k < 4; ++k) { ry[k][j] = (u32x2){0u, 0u}; ny[k][j] = ry[k][j]; } }
        PA_LOAD(rx, ry, t0 - 1);
#pragma unroll 1
        for (int i = -1; i <= ntok; ++i) {
            const int t = t0 + i;
            if (i < ntok) PA_LOAD(nx, ny, t + 1);
            f32x4 hn[4];
            if (t >= rs && t <= re) {
                f32x4 x[4];
#pragma unroll
                for (int j = 0; j < 4; ++j) x[j] = rx[j];
                if (has_prev) {
#pragma unroll
                    for (int j = 0; j < 4; ++j) { f32x4 sm = (f32x4){0.f, 0.f, 0.f, 0.f};
#pragma unroll
                        for (int k = 0; k < 4; ++k) sm += (f32x4){bflo(ry[k][j].x), bfhi(ry[k][j].x), bflo(ry[k][j].y), bfhi(ry[k][j].y)};
                        x[j] += *(const f32x4*)(m5p + 256 * j + 4 * lane) * sm; } }
                if (i >= 0 && i < ntok) {
#pragma unroll
                    for (int j = 0; j < 4; ++j) *(f32x4*)(xout + (size_t)t * D + 256 * j + 4 * lane) = x[j]; }
                const float rstd = row_rstd(x);
#pragma unroll
                for (int j = 0; j < 4; ++j) { const int col = 256 * j + 4 * lane; hn[j] = x[j] * rstd * *(const f32x4*)(ng + col) * (*(const f32x4*)(mod + 1024 + col) + 1.0f) + *(const f32x4*)(mod + col); }
            } else {
#pragma unroll
                for (int j = 0; j < 4; ++j) hn[j] = (f32x4){0.f, 0.f, 0.f, 0.f};
            }
#pragma unroll
            for (int j = 0; j < 4; ++j) { hm[j] = h0[j]; h0[j] = hp[j]; hp[j] = hn[j]; rx[j] = nx[j];
#pragma unroll
                for (int k = 0; k < 4; ++k) ry[k][j] = ny[k][j]; }
            if (i >= 1) {
                const int te = t - 1;
#pragma unroll
                for (int q = 0; q < 6; ++q) {
                    bf16* orow = XL + ((size_t)q * T + te) * D;
#pragma unroll
                    for (int j = 0; j < 4; ++j) { const int col = 256 * j + 4 * lane;
                        const f32x4 m0 = *(const LAS f32x4*)(mu + (q * 2 + 0) * 1024 + col), m1 = *(const LAS f32x4*)(mu + (q * 2 + 1) * 1024 + col);
                        const f32x4 o = h0[j] + m0 * (hm[j] - h0[j]) + m1 * (hp[j] - h0[j]);
                        u32x2 w; w.x = pk2(o.x, o.y); w.y = pk2(o.z, o.w); *(u32x2*)(orow + col) = w; }
                }
            }
        }
#undef PA_LOAD
    }
}
__device__ __forceinline__ void phase_a_conv(const Args& a, int layer, int rows, int gw, int NGW, int lane) {
    unsigned char* ws = a.ws;
    float* xs = (float*)(ws + (layer < 2 ? WS_XSA : WS_XSB));
    const float* MODS = (const float*)(ws + WS_MODS); const bf16* YS = (const bf16*)(ws + WS_YS); bf16* H = (bf16*)(ws + WS_XL);
    const float* ng = a.in[6] + (size_t)(layer * 2 + 0) * 1024;
    for (int t = gw; t < rows; t += NGW) {
        const int mr = mod_row(t);
        const float* mod = MODS + (size_t)(layer * 5 + mr) * 6144;
        f32x4 m5[4], x[4];
#pragma unroll
        for (int j = 0; j < 4; ++j) m5[j] = *(const f32x4*)(MODS + (size_t)((layer - 1) * 5 + mr) * 6144 + 5 * 1024 + 256 * j + 4 * lane);
        load_x_combined(x, xs + (size_t)t * D, true, YS, t, m5, lane);
        const float rstd = row_rstd(x);
#pragma unroll
        for (int j = 0; j < 4; ++j) { const int col = 256 * j + 4 * lane;
            *(f32x4*)(xs + (size_t)t * D + col) = x[j];
            const f32x4 h = x[j] * rstd * *(const f32x4*)(ng + col) * (*(const f32x4*)(mod + 1024 + col) + 1.0f) + *(const f32x4*)(mod + col);
            u32x2 w; w.x = pk2(h.x, h.y); w.y = pk2(h.z, h.w); *(u32x2*)(H + (size_t)t * D + col) = w; }
    }
}
#define DPPF(x, ctrl) __builtin_bit_cast(float, __builtin_amdgcn_update_dpp(0, __builtin_bit_cast(int, (x)), (ctrl), 0xf, 0xf, false))
__device__ __forceinline__ float row16_sum(float v) { v += DPPF(v, 0xB1); v += DPPF(v, 0x4E); v += DPPF(v, 0x141); v += DPPF(v, 0x140); return v; }
__device__ __forceinline__ f32x4 bf4(u32x2 w) { return (f32x4){bflo(w.x), bfhi(w.x), bflo(w.y), bfhi(w.y)}; }
__device__ __forceinline__ u32x2 pk4(f32x4 v) { u32x2 w; w.x = pk2(v[0], v[1]); w.y = pk2(v[2], v[3]); return w; }
__device__ __forceinline__ void phase_c_prep(const Args& a, int lj, LAS unsigned char* lds, int tid, int gw, int NGW, int lane) {
    unsigned char* ws = a.ws;
    const bf16* Rr = (const bf16*)(ws + WS_RKV); const bf16* Kk = Rr + (size_t)T * D; const bf16* RA = (const bf16*)(ws + WS_RAWA); const bf16* RW = (const bf16*)(ws + WS_RAWW);
    bf16* KK = (bf16*)(ws + WS_KK); bf16* KD = (bf16*)(ws + WS_KD); bf16* BE = (bf16*)(ws + WS_BETA); float* RKB = (float*)(ws + WS_RKB);
    LAS float* tb = (LAS float*)lds;
    for (int i = tid; i < 7 * 256; i += 512) { const int t7 = i >> 8, q = i & 255;
        const float* src = t7 == 0 ? a.in[18] + lj * 1024 : t7 == 1 ? a.in[19] + lj * 1024 : t7 == 2 ? a.in[20] + lj * 1024 : t7 < 5 ? a.in[10] + lj * 2048 + (t7 - 3) * 1024 : a.in[13] + lj * 2048 + (t7 - 5) * 1024;
        ((LAS f32x4*)tb)[i] = ((const f32x4*)src)[q]; }
    __syncthreads();
    for (int row = gw; row < T; row += NGW) {
#pragma unroll
        for (int j = 0; j < 4; ++j) {
            const int col = 256 * j + 4 * lane; const size_t ro = (size_t)row * D + col;
            const f32x4 k = bf4(*(const u32x2*)(Kk + ro)), r = bf4(*(const u32x2*)(Rr + ro));
            f32x4 a0 = bf4(*(const u32x2*)(RA + ro)) + *(const LAS f32x4*)(tb + 5 * 1024 + col), a1 = bf4(*(const u32x2*)(RA + (size_t)T * D + ro)) + *(const LAS f32x4*)(tb + 6 * 1024 + col);
#pragma unroll
            for (int z = 0; z < 4; ++z) { a0[z] = sigm(a0[z]); a1[z] = sigm(a1[z]); }
            const f32x4 ck = *(const LAS f32x4*)(tb + col), ca = *(const LAS f32x4*)(tb + 1024 + col), cr = *(const LAS f32x4*)(tb + 2048 + col);
            const f32x4 kk = k * ck;
            const float ss = row16_sum((kk.x * kk.x + kk.y * kk.y) + (kk.z * kk.z + kk.w * kk.w));
            const f32x4 kd0 = k * ((a0 - 1.0f) * ca + 1.0f), kd1 = k * ((a1 - 1.0f) * ca + 1.0f);
            *(u32x2*)(KD + ro) = pk4(kd0); *(u32x2*)(KD + (size_t)T * D + ro) = pk4(kd1);
            const f32x4 p = r * (kd0 + kd1) * cr;
            const float rk = row16_sum((p.x + p.y) + (p.z + p.w));
            const f32x4 kkn = kk * (1.0f / fmaxf(sqrtf(ss), 1e-12f));
            *(u32x2*)(KK + ro) = pk4(kkn); *(u32x2*)(BE + ro) = pk4(kkn * a0); *(u32x2*)(BE + (size_t)T * D + ro) = pk4(kkn * a1);
            if ((lane & 15) == 0) RKB[(size_t)row * 16 + 4 * j + (lane >> 4)] = rk;
        }
    }
}
typedef short bf16x8 __attribute__((ext_vector_type(8)));
__device__ __forceinline__ f32x4 mfma16(bf16x8 a, bf16x8 b, f32x4 c) { return __builtin_amdgcn_mfma_f32_16x16x32_bf16(a, b, c, 0, 0, 0); }
__device__ __forceinline__ bf16x8 as_frag(u32x4 w) { return __builtin_bit_cast(bf16x8, w); }
constexpr int CH_LD = 144;
constexpr int CH_MS = 64 * CH_LD;
constexpr int CH_AB = 0 * CH_MS, CH_KT = 1 * CH_MS, CH_BT = 2 * CH_MS, CH_RB = 3 * CH_MS, CH_VT = 4 * CH_MS, CH_ABT = 5 * CH_MS, CH_KHT = 6 * CH_MS, CH_BHT = 7 * CH_MS,
              CH_LK = 8 * CH_MS, CH_LB = 9 * CH_MS, CH_MK = 10 * CH_MS, CH_MB = 11 * CH_MS, CH_WT = 12 * CH_MS, CH_U0 = 13 * CH_MS, CH_DINV = 14 * CH_MS;
constexpr int CH_GC = LDSCTL_OFF + 2048;
constexpr int CH_PART = LDSCTL_OFF + 4096;
constexpr int NCHUNK = NSTEP / 64;
#ifndef S1_DBL
#define S1_DBL 0
#endif
static_assert(CH_DINV + 2048 <= RING_BYTES, "chunk LDS map");

__device__ __forceinline__ int scan_row(int s, int dir, int b) {
    if (s < CTXL) return TL + b * CTXL + (dir ? CTXL - 1 - s : s);
    const int i = s - CTXL; return b * SEQ + (dir ? SEQ - 1 - i : i);
}
#define CH_FRAG(mat, row, ks, kg) as_frag(*(const LAS u32x4*)(lds + (mat) + (row) * CH_LD + ((ks) * 32 + (kg) * 8) * 2))

__device__ __forceinline__ float s1_treduce16(const float (&a)[16], bool b3, bool b2) {
    float b[8];
#pragma unroll
    for (int i = 0; i < 8; ++i) { float x = a[i], y = a[i + 8];
        asm("s_nop 1\n\tv_permlane32_swap_b32 %0, %1" : "+v"(x), "+v"(y));
        b[i] = x + y; }
    float c[4];
#pragma unroll
    for (int i = 0; i < 4; ++i) { float x = b[i], y = b[i + 4];
        asm("s_nop 1\n\tv_permlane16_swap_b32 %0, %1" : "+v"(x), "+v"(y));
        c[i] = x + y; }
    float d[2];
#pragma unroll
    for (int i = 0; i < 2; ++i) { const float keep = b3 ? c[i + 2] : c[i], send = b3 ? c[i] : c[i + 2]; d[i] = keep + DPPF(send, 0x128); }
    const float keep = b2 ? d[1] : d[0], send = b2 ? d[0] : d[1];
    float e = keep + DPPF(send, 0x141);
    e += DPPF(e, 0xB1);
    e += DPPF(e, 0x4E);
    return e;
}
#define S1_BAR() do { asm volatile("s_waitcnt lgkmcnt(0)" ::: "memory"); __builtin_amdgcn_s_barrier(); asm volatile("" ::: "memory"); } while (0)
__device__ __forceinline__ void phase_s1_chunks(const Args& a, int lj, LAS unsigned char* lds, int tid, int G, int rh_scratch = 0) {
    unsigned char* ws = a.ws; const float* w0l = a.in[10] + lj * 2048; const float* a0l = a.in[13] + lj * 2048;
    const float* pkk = a.in[18] + lj * 1024; const float* pka = a.in[19] + lj * 1024; const float* prk = a.in[20] + lj * 1024;
    const int lane = tid & 63, wave = __builtin_amdgcn_readfirstlane(tid >> 6), l15 = lane & 15, g = lane >> 4;
    LAS float* part = (LAS float*)(lds + CH_PART); LAS float* gammaC = (LAS float*)(lds + CH_GC);
    float nlw[8], nka[8], nkr[8], nrr[8], nvv[8], nw0 = 0.f, na0 = 0.f, npkk = 0.f, npka = 0.f, nprk = 0.f;
#define S1_LOAD(ctx_) do { unsigned char* wsl = ws; asm volatile("" : "+s"(wsl));     \
        const int chain_ = (ctx_) / NCHUNK, c_ = (ctx_) - chain_ * NCHUNK, dir_ = chain_ >> 6, b_ = (chain_ >> 4) & 3, h_ = chain_ & 15; \
          \
        const long o0 = (long)scan_row(64 * c_ + 8 * wave, dir_, b_) * D + h_ * 64 + lane, od = (long)dir_ * T * D, st = dir_ ? -(long)D : (long)D; \
        const bf16* LWp = (const bf16*)(wsl + WS_RAWW) + od + o0; const bf16* RAp = (const bf16*)(wsl + WS_RAWA) + od + o0; \
        const bf16* Rp = (const bf16*)(wsl + WS_RKV) + o0; const bf16* Kp = Rp + (size_t)T * D; const bf16* Vp = Rp + (size_t)2 * T * D; \
        nw0 = w0l[dir_ * 1024 + h_ * 64 + lane]; na0 = a0l[dir_ * 1024 + h_ * 64 + lane]; npkk = pkk[h_ * 64 + lane]; npka = pka[h_ * 64 + lane]; nprk = prk[h_ * 64 + lane]; \
        _Pragma("unroll") for (int j = 0; j < 8; ++j) { const long oj = st * j; \
            nlw[j] = bflo((unsigned)LWp[oj]); nka[j] = bflo((unsigned)RAp[oj]); nkr[j] = bflo((unsigned)Kp[oj]); nrr[j] = bflo((unsigned)Rp[oj]); nvv[j] = bflo((unsigned)Vp[oj]); } } while (0)
    if ((int)blockIdx.x < 128 * NCHUNK) S1_LOAD((int)blockIdx.x);
    for (int ct = blockIdx.x; ct < 128 * NCHUNK; ct += G) {
        const int chain = ct / NCHUNK, c = ct - chain * NCHUNK, dir = chain >> 6, b = (chain >> 4) & 3, h = chain & 15;
        unsigned zq = 0u; asm volatile("" : "+v"(zq));
        {
            const int k = lane, tq = wave;
            float lw[8], kd[8], be[8], kk[8], rr[8], vv[8];
            {
                const float w0k = nw0, a0k = na0, ckk = npkk, cka = npka, crk = nprk;
                float* RKBd = (float*)(ws + (dir ? WS_RKB1 : WS_RKB));
                const int row0 = scan_row(64 * c + 8 * tq, dir, b), rst = dir ? -1 : 1;
                float av[8], kq[8], red[16];
#pragma unroll
                for (int j = 0; j < 8; ++j) { av[j] = sigm(nka[j] + a0k); const float kr = nkr[j];
                    lw[j] = -0.60653066f * sigm(nlw[j] + w0k);
                    kq[j] = kr * ckk; kd[j] = kr * ((av[j] - 1.0f) * cka + 1.0f); rr[j] = nrr[j]; vv[j] = nvv[j];
                    red[2 * j] = kq[j] * kq[j]; red[2 * j + 1] = rr[j] * kd[j] * crk; }
                const float tot = s1_treduce16(red, (lane & 8) != 0, (lane & 4) != 0);
                if ((lane & 7) == 4) RKBd[(size_t)(row0 + rst * (lane >> 3)) * 16 + h] = tot;
#pragma unroll
                for (int j = 0; j < 8; ++j) { const float ss = __builtin_bit_cast(float, __builtin_amdgcn_readlane(__builtin_bit_cast(int, tot), 8 * j));
                    kk[j] = kq[j] * (1.0f / fmaxf(sqrtf(ss), 1e-12f)); be[j] = kk[j] * av[j]; }
            }
            if (ct + G < 128 * NCHUNK) S1_LOAD(ct + G);
            for (int r0_ = 0; r0_ <= ((S1_DBL >> 3) & 1); ++r0_) { if (r0_) S1_BAR();
            float p[8]; p[0] = lw[0];
#pragma unroll
            for (int j = 1; j < 8; ++j) p[j] = p[j - 1] + lw[j];
            part[tq * 64 + k] = p[7];
            S1_BAR();
            float off = 0.f, tot = 0.f;
#pragma unroll
            for (int q = 0; q < 8; ++q) { const float pv = part[q * 64 + k]; tot += pv; off += q < tq ? pv : 0.f; }
            const float eTot = __expf(tot); float ePrev = __expf(off);
            if (tq == 0) gammaC[k] = eTot;
            unsigned abw[4], khw[4], bhw[4], vw[4];
#pragma unroll
            for (int j = 0; j < 8; j += 2) {
                float ab2[2], kt2[2], bt2[2], rb2[2], kh2[2], bh2[2];
#pragma unroll
                for (int z = 0; z < 2; ++z) { const float cu = off + p[j + z]; const float eP = __expf(cu), eM = __expf(-cu), eC = eTot * eM;
                    ab2[z] = kk[j + z] * ePrev; ePrev = eP; kt2[z] = kd[j + z] * eM; bt2[z] = be[j + z] * eM; rb2[z] = rr[j + z] * eP; kh2[z] = kd[j + z] * eC; bh2[z] = be[j + z] * eC;
                    const int t = 8 * tq + j + z;
                    *(LAS bf16*)(lds + CH_AB + t * CH_LD + k * 2) = (bf16)f2bf(ab2[z]); *(LAS bf16*)(lds + CH_KT + t * CH_LD + k * 2) = (bf16)f2bf(kt2[z]);
                    *(LAS bf16*)(lds + CH_BT + t * CH_LD + k * 2) = (bf16)f2bf(bt2[z]); *(LAS bf16*)(lds + CH_RB + t * CH_LD + k * 2) = (bf16)f2bf(rb2[z]); }
                abw[j >> 1] = pk2(ab2[0], ab2[1]); khw[j >> 1] = pk2(kh2[0], kh2[1]); bhw[j >> 1] = pk2(bh2[0], bh2[1]); vw[j >> 1] = pk2(vv[j], vv[j + 1]);
            }
            *(LAS u32x4*)(lds + CH_ABT + k * CH_LD + tq * 16) = (u32x4){abw[0], abw[1], abw[2], abw[3]};
            *(LAS u32x4*)(lds + CH_KHT + k * CH_LD + tq * 16) = (u32x4){khw[0], khw[1], khw[2], khw[3]};
            *(LAS u32x4*)(lds + CH_BHT + k * CH_LD + tq * 16) = (u32x4){bhw[0], bhw[1], bhw[2], bhw[3]};
            *(LAS u32x4*)(lds + CH_VT + k * CH_LD + tq * 16) = (u32x4){vw[0], vw[1], vw[2], vw[3]};
            *(LAS u32x4*)(lds + CH_WT + k * CH_LD + tq * 16) = (u32x4){zq, zq, zq, zq}; *(LAS u32x4*)(lds + CH_U0 + k * CH_LD + tq * 16) = (u32x4){zq, zq, zq, zq};
            }
        }
        S1_BAR();
        for (int r1_ = 0; r1_ <= (S1_DBL & 1); ++r1_) { if (r1_) S1_BAR();
            const int mi = wave >> 1, half = wave & 1;
            const int matS = (mi & 1) ? CH_BT : CH_KT, matT = (mi & 2) ? CH_RB : CH_AB, matO = CH_LK + mi * CH_MS;
            const bool incl = (mi & 2) != 0;
            bf16x8 fs[4][2], ft[2][2];
#pragma unroll
            for (int ms = 0; ms < 4; ++ms)
#pragma unroll
                for (int ks = 0; ks < 2; ++ks) fs[ms][ks] = CH_FRAG(matS, 16 * ms + l15, ks, g);
#pragma unroll
            for (int nt = 0; nt < 2; ++nt)
#pragma unroll
                for (int ks = 0; ks < 2; ++ks) ft[nt][ks] = CH_FRAG(matT, 32 * half + 16 * nt + l15, ks, g);
#pragma unroll
            for (int nt = 0; nt < 2; ++nt) { const int t = 32 * half + 16 * nt + l15;
#pragma unroll
                for (int ms = 0; ms < 4; ++ms) { f32x4 d = (f32x4){0.f, 0.f, 0.f, 0.f};
                    d = mfma16(fs[ms][0], ft[nt][0], d); d = mfma16(fs[ms][1], ft[nt][1], d);
                    const int s0 = 16 * ms + 4 * g;
#pragma unroll
                    for (int i = 0; i < 4; ++i) { const bool keep = incl ? (s0 + i <= t) : (s0 + i < t); d[i] = keep ? d[i] : __builtin_bit_cast(float, zq); }
                    u32x2 w; w.x = pk2(d[0], d[1]); w.y = pk2(d[2], d[3]);
                    *(LAS u32x2*)(lds + matO + t * CH_LD + s0 * 2) = w; } }
        }
        S1_BAR();
        f32x4 rhsU[4];
#pragma unroll
        for (int I = 0; I < 4; ++I) rhsU[I] = (f32x4){0.f, 0.f, 0.f, 0.f};
        if (wave >= 4) {
            const int ctv = (wave & 3) * 16;
            const bf16x8 fv0 = CH_FRAG(CH_VT, ctv + l15, 0, g), fv1 = CH_FRAG(CH_VT, ctv + l15, 1, g);
#pragma unroll
            for (int I = 0; I < 4; ++I) { f32x4 d = (f32x4){0.f, 0.f, 0.f, 0.f};
                d = mfma16(CH_FRAG(CH_LK, 16 * I + l15, 0, g), fv0, d); d = mfma16(CH_FRAG(CH_LK, 16 * I + l15, 1, g), fv1, d); rhsU[I] = -d; }
        }
        for (int r2_ = 0; r2_ <= ((S1_DBL >> 1) & 1); ++r2_) if (wave == 0) {
            const int bb = lane >> 4, j = lane & 15;
            float x[16];
#pragma unroll
            for (int t = 0; t < 16; ++t) {
                const u32x4 r0 = *(const LAS u32x4*)(lds + CH_LB + (16 * bb + t) * CH_LD + 32 * bb), r1 = *(const LAS u32x4*)(lds + CH_LB + (16 * bb + t) * CH_LD + 32 * bb + 16);
                const unsigned rw[8] = {r0.x, r0.y, r0.z, r0.w, r1.x, r1.y, r1.z, r1.w};
                float acc = (t == j) ? 1.0f : 0.0f;
#pragma unroll
                for (int s = 0; s < t; ++s) { const float lv = (s & 1) ? bfhi(rw[s >> 1]) : bflo(rw[s >> 1]); acc -= lv * x[s]; }
                x[t] = acc;
                *(LAS bf16*)(lds + CH_DINV + ((bb * 16 + t) * 16 + j) * 2) = (bf16)f2bf(acc);
            }
        }
        S1_BAR();
        {
            const int matZ = wave < 4 ? CH_WT : CH_U0, ct16 = (wave & 3) * 16;
            for (int r4_ = 0; r4_ <= ((S1_DBL >> 4) & 1); ++r4_) { if (r4_) { *(LAS u32x4*)(lds + matZ + (ct16 + l15) * CH_LD + g * 32) = (u32x4){zq, zq, zq, zq}; *(LAS u32x4*)(lds + matZ + (ct16 + l15) * CH_LD + g * 32 + 16) = (u32x4){zq, zq, zq, zq}; LDS_WAIT(); }
#pragma unroll
            for (int I = 0; I < 4; ++I) {
                f32x4 rhs;
                if (wave < 4) { const u32x2 w = *(const LAS u32x2*)(lds + CH_ABT + (ct16 + l15) * CH_LD + (16 * I + 4 * g) * 2); rhs = (f32x4){bflo(w.x), bfhi(w.x), bflo(w.y), bfhi(w.y)}; }
                else rhs = rhsU[I];
                f32x4 d = (f32x4){0.f, 0.f, 0.f, 0.f};
                d = mfma16(CH_FRAG(CH_LB, 16 * I + l15, 0, g), CH_FRAG(matZ, ct16 + l15, 0, g), d); d = mfma16(CH_FRAG(CH_LB, 16 * I + l15, 1, g), CH_FRAG(matZ, ct16 + l15, 1, g), d);
                const f32x4 ac = rhs - d;
                const u32x2 dv = *(const LAS u32x2*)(lds + CH_DINV + ((I * 16 + l15) * 16 + 4 * g) * 2);
                const bf16x8 fa = as_frag((u32x4){dv.x, dv.y, zq, zq}), fb = as_frag((u32x4){pk2(ac[0], ac[1]), pk2(ac[2], ac[3]), zq, zq});
                const f32x4 z = mfma16(fa, fb, (f32x4){0.f, 0.f, 0.f, 0.f});
                u32x2 w; w.x = pk2(z[0], z[1]); w.y = pk2(z[2], z[3]);
                *(LAS u32x2*)(lds + matZ + (ct16 + l15) * CH_LD + (16 * I + 4 * g) * 2) = w;
                LDS_WAIT(); asm volatile("" ::: "memory");
            }
            }
        }
        S1_BAR();
        for (int r3_ = 0; r3_ <= ((S1_DBL >> 2) & 1); ++r3_) { if (r3_) S1_BAR();
            const int rt = wave >> 1, cp = (wave & 1) * 2;
            unsigned char* wsl = ws; asm volatile("" : "+s"(wsl));
            bf16* YL = (bf16*)(wsl + WS_Y); bf16* RH = (bf16*)(wsl + (rh_scratch ? WS_BETA + RF : WS_RH)); bf16* PM = (bf16*)(wsl + WS_PM); bf16* QT = (bf16*)(wsl + WS_QT);
            const int trow = scan_row(64 * c + 16 * rt + l15, dir, b);
#pragma unroll
            for (int q = 0; q < 2; ++q) { const int vt = cp + q; f32x4 d = (f32x4){0.f, 0.f, 0.f, 0.f};
#pragma unroll
                for (int ks = 0; ks < 2; ++ks) { d = mfma16(CH_FRAG(CH_VT, 16 * vt + l15, ks, g), CH_FRAG(CH_MK, 16 * rt + l15, ks, g), d); d = mfma16(CH_FRAG(CH_U0, 16 * vt + l15, ks, g), CH_FRAG(CH_MB, 16 * rt + l15, ks, g), d); }
                *(u32x2*)(YL + ((size_t)dir * T + trow) * D + h * 64 + 16 * vt + 4 * g) = pk4(d); }
#pragma unroll
            for (int q = 0; q < 2; ++q) { const int kt = cp + q; f32x4 d = (f32x4){0.f, 0.f, 0.f, 0.f};
#pragma unroll
                for (int ks = 0; ks < 2; ++ks) d = mfma16(CH_FRAG(CH_WT, 16 * kt + l15, ks, g), CH_FRAG(CH_MB, 16 * rt + l15, ks, g), d);
                const u32x2 rbw = *(const LAS u32x2*)(lds + CH_RB + (16 * rt + l15) * CH_LD + (16 * kt + 4 * g) * 2);
                u32x2 w; w.x = pk2(bflo(rbw.x) - d[0], bfhi(rbw.x) - d[1]); w.y = pk2(bflo(rbw.y) - d[2], bfhi(rbw.y) - d[3]);
                *(u32x2*)(RH + ((size_t)dir * T + trow) * D + h * 64 + 16 * kt + 4 * g) = w; }
            bf16* Pc = PM + ((size_t)chain * NCHUNK + c) * 4096; bf16* Qc = QT + ((size_t)chain * NCHUNK + c) * 4096;
            { const int krow = 16 * rt + l15; const float gc = gammaC[krow];
#pragma unroll
                for (int q = 0; q < 2; ++q) { const int kt = cp + q; f32x4 d = (f32x4){0.f, 0.f, 0.f, 0.f};
#pragma unroll
                    for (int ks = 0; ks < 2; ++ks) d = mfma16(CH_FRAG(CH_WT, 16 * kt + l15, ks, g), CH_FRAG(CH_BHT, krow, ks, g), d);
                    const int k0 = 16 * kt + 4 * g; f32x4 o;
#pragma unroll
                    for (int i = 0; i < 4; ++i) o[i] = ((k0 + i == krow) ? gc : 0.f) - d[i];
                    u32x2 w; w.x = pk2(o[0], o[1]); w.y = pk2(o[2], o[3]);
                    *(u32x2*)(Pc + krow * 64 + 32 * (kt >> 1) + 8 * g + 4 * (kt & 1)) = w; } }
            { const int vrow = 16 * rt + l15;
#pragma unroll
                for (int q = 0; q < 2; ++q) { const int kt = cp + q; f32x4 d = (f32x4){0.f, 0.f, 0.f, 0.f};
#pragma unroll
                    for (int ks = 0; ks < 2; ++ks) { d = mfma16(CH_FRAG(CH_KHT, 16 * kt + l15, ks, g), CH_FRAG(CH_VT, vrow, ks, g), d); d = mfma16(CH_FRAG(CH_BHT, 16 * kt + l15, ks, g), CH_FRAG(CH_U0, vrow, ks, g), d); }
                    u32x2 w; w.x = pk2(d[0], d[1]); w.y = pk2(d[2], d[3]);
                    *(u32x2*)(Qc + vrow * 64 + 16 * g + 4 * kt) = w; } }
        }
        S1_BAR();
    }
}

struct S2Set { u32x4 p[4][2]; u32x4 q[2]; };
__device__ __forceinline__ void s2_load(S2Set& s, const bf16* Pc, const bf16* Qc, int vt, int l15, int g) {
    s.q[0] = *(const u32x4*)(Qc + (16 * vt + l15) * 64 + 16 * g); s.q[1] = *(const u32x4*)(Qc + (16 * vt + l15) * 64 + 16 * g + 8);
#pragma unroll
    for (int m = 0; m < 4; ++m)
#pragma unroll
        for (int j = 0; j < 2; ++j) s.p[m][j] = *(const u32x4*)(Pc + (16 * m + l15) * 64 + 32 * j + 8 * g);
}
__device__ __forceinline__ void s2_step(f32x4 (&acc)[4], const S2Set& s, bf16* Hc, int g) {
    unsigned hw[4][2];
#pragma unroll
    for (int m = 0; m < 4; ++m) { hw[m][0] = pk2(acc[m][0], acc[m][1]); hw[m][1] = pk2(acc[m][2], acc[m][3]); }
#pragma unroll
    for (int m = 0; m < 4; ++m) *(u32x2*)(Hc + 16 * m + 4 * g) = (u32x2){hw[m][0], hw[m][1]};
    const bf16x8 hb0 = as_frag((u32x4){hw[0][0], hw[0][1], hw[1][0], hw[1][1]}), hb1 = as_frag((u32x4){hw[2][0], hw[2][1], hw[3][0], hw[3][1]});
#pragma unroll
    for (int m = 0; m < 4; ++m) {
        const unsigned q0 = (m & 2) ? ((m & 1) ? s.q[1].z : s.q[1].x) : ((m & 1) ? s.q[0].z : s.q[0].x), q1 = (m & 2) ? ((m & 1) ? s.q[1].w : s.q[1].y) : ((m & 1) ? s.q[0].w : s.q[0].y);
        f32x4 d = (f32x4){bflo(q0), bfhi(q0), bflo(q1), bfhi(q1)};
        d = mfma16(as_frag(s.p[m][0]), hb0, d);
        d = mfma16(as_frag(s.p[m][1]), hb1, d);
        acc[m] = d;
    }
}
__device__ __forceinline__ void phase_s2_chain(const Args& a, int wave, int lane, int G) {
    unsigned char* ws = a.ws;
    const bf16* PM = (const bf16*)(ws + WS_PM); const bf16* QT = (const bf16*)(ws + WS_QT); bf16* HT = (bf16*)(ws + WS_HT);
    const int l15 = lane & 15, g = lane >> 4;
    if (wave >= 2) return;
    static_assert(NCHUNK % 4 == 0, "S2 ring");
    for (int wt = blockIdx.x * 2 + wave; wt < 512; wt += G * 2) {
        const int chain = wt >> 2, vt = wt & 3;
        f32x4 acc[4];
#pragma unroll
        for (int m = 0; m < 4; ++m) acc[m] = (f32x4){0.f, 0.f, 0.f, 0.f};
        const bf16* Pc = PM + (size_t)chain * NCHUNK * 4096; const bf16* Qc = QT + (size_t)chain * NCHUNK * 4096;
        bf16* Hc = HT + (size_t)chain * NCHUNK * 4096 + (16 * vt + l15) * 64;
        S2Set s0, s1, s2, s3;
        s2_load(s0, Pc, Qc, vt, l15, g); s2_load(s1, Pc + 4096, Qc + 4096, vt, l15, g); s2_load(s2, Pc + 2 * 4096, Qc + 2 * 4096, vt, l15, g); s2_load(s3, Pc + 3 * 4096, Qc + 3 * 4096, vt, l15, g);
#pragma unroll 1
        for (int c = 0; c < NCHUNK; c += 4) {
            const int cn = c + 4 < NCHUNK ? c + 4 : c;
            const bf16* Pn = Pc + (size_t)cn * 4096; const bf16* Qn = Qc + (size_t)cn * 4096;
            s2_step(acc, s0, Hc + (size_t)c * 4096, g);       s2_load(s0, Pn, Qn, vt, l15, g);
            s2_step(acc, s1, Hc + (size_t)(c + 1) * 4096, g); s2_load(s1, Pn + 4096, Qn + 4096, vt, l15, g);
            s2_step(acc, s2, Hc + (size_t)(c + 2) * 4096, g); s2_load(s2, Pn + 2 * 4096, Qn + 2 * 4096, vt, l15, g);
            s2_step(acc, s3, Hc + (size_t)(c + 3) * 4096, g); s2_load(s3, Pn + 3 * 4096, Qn + 3 * 4096, vt, l15, g);
        }
    }
}

__device__ __forceinline__ void phase_s3_readout(const Args& a, int lj, int nrows, int gw, int NGW, int lane) {
    unsigned char* ws = a.ws;
    const bf16* YL = (const bf16*)(ws + WS_Y); const bf16* RH = (const bf16*)(ws + WS_RH); const bf16* HT = (const bf16*)(ws + WS_HT);
    const bf16* Vv = (const bf16*)(ws + WS_RKV) + (size_t)2 * T * D; const float* RKB = (const float*)(ws + WS_RKB); const float* RKB1 = (const float*)(ws + WS_RKB1); const bf16* Gg = (const bf16*)(ws + WS_G); bf16* Z = (bf16*)(ws + WS_Z);
    const float* lng = a.in[21] + lj * 1024; const float* lnb = a.in[22] + lj * 1024;
    const int l15 = lane & 15, g = lane >> 4;
    for (int task = gw; task < (nrows / 16) * 16; task += NGW) {
        const int tt = task >> 4, h = task & 15, r0 = tt * 16, row = r0 + l15;
        int b, cc[2];
        if (r0 < TL) { b = r0 >> 13; const int tb = (r0 & (SEQ - 1)) >> 6; cc[0] = 4 + tb; cc[1] = 4 + (127 - tb); }
        else { const int loc = r0 - TL; b = loc >> 8; const int tb = (loc & 255) >> 6; cc[0] = tb; cc[1] = 3 - tb; }
        f32x4 acc[4];
        const size_t ro = (size_t)row * D + h * 64 + 4 * g;
#pragma unroll
        for (int vt = 0; vt < 4; ++vt) acc[vt] = bf4(*(const u32x2*)(YL + ro + 16 * vt)) + bf4(*(const u32x2*)(YL + (size_t)T * D + ro + 16 * vt));
#pragma unroll
        for (int dir = 0; dir < 2; ++dir) {
            const int chain = dir * 64 + b * 16 + h;
            const bf16* rh = RH + ((size_t)dir * T + row) * D + h * 64 + 8 * g;
            const bf16x8 f0 = as_frag(*(const u32x4*)(rh)), f1 = as_frag(*(const u32x4*)(rh + 32));
            const bf16* hc = HT + ((size_t)chain * NCHUNK + cc[dir]) * 4096;
#pragma unroll
            for (int vt = 0; vt < 4; ++vt) { const bf16* hr = hc + (16 * vt + l15) * 64 + 8 * g;
                acc[vt] = mfma16(as_frag(*(const u32x4*)(hr)), f0, acc[vt]); acc[vt] = mfma16(as_frag(*(const u32x4*)(hr + 32)), f1, acc[vt]); }
        }
        float s = 0.f;
#pragma unroll
        for (int vt = 0; vt < 4; ++vt) s += (acc[vt][0] + acc[vt][1]) + (acc[vt][2] + acc[vt][3]);
        s += __shfl_xor(s, 16); s += __shfl_xor(s, 32);
        const float mean = s * (1.0f / 64.0f); float vs = 0.f;
#pragma unroll
        for (int vt = 0; vt < 4; ++vt) { acc[vt] = acc[vt] - mean; vs += (acc[vt][0] * acc[vt][0] + acc[vt][1] * acc[vt][1]) + (acc[vt][2] * acc[vt][2] + acc[vt][3] * acc[vt][3]); }
        vs += __shfl_xor(vs, 16); vs += __shfl_xor(vs, 32);
        const float rstd = rsqrtf(vs * (1.0f / 64.0f) + 64.0f * 1e-5f), bon = RKB[(size_t)row * 16 + h] + RKB1[(size_t)row * 16 + h];
#pragma unroll
        for (int vt = 0; vt < 4; ++vt) { const int col = h * 64 + 16 * vt + 4 * g; const size_t o = (size_t)row * D + col;
            const f32x4 vq = bf4(*(const u32x2*)(Vv + o)), lg4 = *(const f32x4*)(lng + col), lb4 = *(const f32x4*)(lnb + col); const u32x2 gw2 = *(const u32x2*)(Gg + o);
            const f32x4 zz = acc[vt] * rstd * lg4 + lb4 + vq * bon;
            u32x2 w; w.x = pk2(zz[0] * bflo(gw2.x), zz[1] * bfhi(gw2.x)); w.y = pk2(zz[2] * bflo(gw2.y), zz[3] * bfhi(gw2.y));
            *(u32x2*)(Z + o) = w; }
    }
}
__device__ __forceinline__ void phase_cv(const Args& a, int lc, int rows, int gw, int NGW, int lane) {
    unsigned char* ws = a.ws;
    const bf16* BG = (const bf16*)(ws + WS_BG); const bf16* CU = (const bf16*)(ws + WS_CUZ); bf16* Z = (bf16*)(ws + WS_Z);
    const float* cw = a.in[25] + (size_t)lc * 3 * 1024;
    for (int t = gw; t < rows; t += NGW) {
        int rs, re; if (t < TL) { rs = t & ~63; re = rs + 63; } else { const int loc = t - TL; rs = TL + (loc & ~255); re = rs + 255; }
        const bool hp = t > rs, hn = t < re;
#pragma unroll
        for (int j = 0; j < 4; ++j) { const int col = 256 * j + 4 * lane; const size_t o = (size_t)t * D + col;
            const u32x2 zc = *(const u32x2*)(CU + o), bg = *(const u32x2*)(BG + o);
            const u32x2 zp = hp ? *(const u32x2*)(CU + o - D) : (u32x2){0u, 0u}, zn = hn ? *(const u32x2*)(CU + o + D) : (u32x2){0u, 0u};
            const f32x4 w0 = *(const f32x4*)(cw + col), w1 = *(const f32x4*)(cw + 1024 + col), w2 = *(const f32x4*)(cw + 2048 + col);
            const f32x4 zv = (f32x4){bflo(zc.x), bfhi(zc.x), bflo(zc.y), bfhi(zc.y)}, pv = (f32x4){bflo(zp.x), bfhi(zp.x), bflo(zp.y), bfhi(zp.y)}, nv = (f32x4){bflo(zn.x), bfhi(zn.x), bflo(zn.y), bfhi(zn.y)};
            const f32x4 bv = (f32x4){bflo(bg.x), bfhi(bg.x), bflo(bg.y), bfhi(bg.y)};
            const f32x4 r = bv * (w0 * pv + w1 * zv + w2 * nv);
            u32x2 w; w.x = pk2(r.x, r.y); w.y = pk2(r.z, r.w); *(u32x2*)(Z + o) = w; }
    }
}
typedef float f32x2v __attribute__((ext_vector_type(2)));
__device__ __forceinline__ float lane_bcast(float v, int srclane) { return __builtin_bit_cast(float, __builtin_amdgcn_readlane(__builtin_bit_cast(int, v), srclane)); }
__device__ __forceinline__ void phase_e_route(const Args& a, int layer, int rows, LAS unsigned char* lds, int tid, int gw, int NGW, int lane, int probe_rep = 0) {
    unsigned char* ws = a.ws;
    const float* xs = (const float*)(ws + (layer < 2 ? WS_XSA : WS_XSB));
    const float* MODS = (const float*)(ws + WS_MODS); bf16* H2 = (bf16*)(ws + WS_H2);
    const float* ng = a.in[6] + (size_t)(layer * 2 + 1) * 1024;
    const float* rw = a.in[27] + (size_t)layer * 1024 * 32; const float* rb = a.in[28] + layer * 32;
    unsigned* cnt = (unsigned*)(ws + WS_CTL) + CW_CNT + (layer + 4 * probe_rep) * 32 * CNT_STRIDE;
    int* SLOTL = (int*)(ws + (probe_rep ? WS_L1 : WS_SLOTL)); float* GATEL = (float*)(ws + (probe_rep ? WS_L1 + 8 * MiB : WS_GATEL));
    LAS float* wt = (LAS float*)lds;
    LAS int* hist = (LAS int*)(lds + LDSCTL_OFF + 3072); LAS int* base = hist + 32; LAS int* lcnt = hist + 64;
    int* TKE = (int*)(ws + WS_C12); float* TKG = (float*)(ws + WS_C12 + 4 * MiB);
    for (int i = tid; i < 32768; i += 512) wt[(i & 31) * 1024 + (i >> 5)] = rw[i];
    if (tid < 32) hist[tid] = 0;
    __syncthreads();
    const int my_e = lane >> 1; const float my_b = rb[my_e];
    const bool b5 = (lane & 32) != 0, b4 = (lane & 16) != 0, b3 = (lane & 8) != 0, b2 = (lane & 4) != 0, b1 = (lane & 2) != 0;
    for (int t = gw; t < rows; t += NGW) {
        const int mr = mod_row(t);
        const float* mod = MODS + (size_t)(layer * 5 + mr) * 6144;
        f32x4 x[4];
#pragma unroll
        for (int j = 0; j < 4; ++j) x[j] = *(const f32x4*)(xs + (size_t)t * D + 256 * j + 4 * lane);
        const float rstd = row_rstd(x);
#pragma unroll
        for (int j = 0; j < 4; ++j) { const int col = 256 * j + 4 * lane;
            x[j] = x[j] * rstd * *(const f32x4*)(ng + col) * (*(const f32x4*)(mod + 4 * 1024 + col) + 1.0f) + *(const f32x4*)(mod + 3 * 1024 + col);
            u32x2 w; w.x = pk2(x[j].x, x[j].y); w.y = pk2(x[j].z, x[j].w); *(u32x2*)(H2 + (size_t)t * D + col) = w; }
        float p[32];
#pragma unroll
        for (int eg = 0; eg < 8; ++eg) {
#pragma unroll
            for (int ee = 0; ee < 4; ++ee) { const int e = eg * 4 + ee; f32x2v s2 = (f32x2v){0.f, 0.f};
#pragma unroll
                for (int j = 0; j < 4; ++j) { const f32x4 wv = *(const LAS f32x4*)(wt + e * 1024 + 256 * j + 4 * lane);
                    s2 = __builtin_elementwise_fma((f32x2v){x[j].x, x[j].y}, (f32x2v){wv.x, wv.y}, s2); s2 = __builtin_elementwise_fma((f32x2v){x[j].z, x[j].w}, (f32x2v){wv.z, wv.w}, s2); }
                p[e] = s2.x + s2.y; }
            asm volatile("" ::: "memory");
        }
        float q16[16];
#pragma unroll
        for (int i = 0; i < 16; ++i) { const float send = b5 ? p[i] : p[i + 16]; const float keep = b5 ? p[i + 16] : p[i]; q16[i] = keep + __shfl_xor(send, 32); }
        float q8[8];
#pragma unroll
        for (int i = 0; i < 8; ++i) { const float send = b4 ? q16[i] : q16[i + 8]; const float keep = b4 ? q16[i + 8] : q16[i]; q8[i] = keep + __shfl_xor(send, 16); }
        float q4[4];
#pragma unroll
        for (int i = 0; i < 4; ++i) { const float send = b3 ? q8[i] : q8[i + 4]; const float keep = b3 ? q8[i + 4] : q8[i]; q4[i] = keep + __shfl_xor(send, 8); }
        float q2[2];
#pragma unroll
        for (int i = 0; i < 2; ++i) { const float send = b2 ? q4[i] : q4[i + 2]; const float keep = b2 ? q4[i + 2] : q4[i]; q2[i] = keep + __shfl_xor(send, 4); }
        float q1; { const float send = b1 ? q2[0] : q2[1]; const float keep = b1 ? q2[1] : q2[0]; q1 = keep + __shfl_xor(send, 2); }
        const float lg = q1 + __shfl_xor(q1, 1) + my_b;
        int rank = 0;
#pragma unroll 1
        for (int e = 0; e < 32; ++e) { const float o = lane_bcast(lg, 2 * e); rank += (o > lg || (o == lg && e < my_e)) ? 1 : 0; }
        const bool sel = rank < 4 && !(lane & 1);
        const unsigned long long m0 = __ballot(sel && rank == 0), m1 = __ballot(sel && rank == 1), m2 = __ballot(sel && rank == 2), m3 = __ballot(sel && rank == 3);
        const float v0 = lane_bcast(lg, (int)__builtin_ctzll(m0)), v1 = lane_bcast(lg, (int)__builtin_ctzll(m1)), v2 = lane_bcast(lg, (int)__builtin_ctzll(m2)), v3 = lane_bcast(lg, (int)__builtin_ctzll(m3));
        const float e1 = __expf(v1 - v0), e2 = __expf(v2 - v0), e3 = __expf(v3 - v0);
        const float inv = 1.0f / (1.0f + e1 + e2 + e3);
        if (sel) {
            TKE[t * 4 + rank] = my_e; TKG[t * 4 + rank] = __expf(lg - v0) * inv;
            __hip_atomic_fetch_add(hist + my_e, 1, __ATOMIC_RELAXED, __HIP_MEMORY_SCOPE_WORKGROUP);
        }
    }
    asm volatile("s_waitcnt vmcnt(0) lgkmcnt(0)" ::: "memory"); __syncthreads();
    if (tid < 32) { base[tid] = (int)atomicAdd(cnt + tid * CNT_STRIDE, (unsigned)hist[tid]); lcnt[tid] = 0; }
    __syncthreads();
    for (int t = gw; t < rows; t += NGW) {
        if (lane < 4) { const int e = TKE[t * 4 + lane]; const float gk = TKG[t * 4 + lane];
            const int pos = base[e] + __hip_atomic_fetch_add(lcnt + e, 1, __ATOMIC_RELAXED, __HIP_MEMORY_SCOPE_WORKGROUP);
            SLOTL[(size_t)e * T + pos] = t * 4 + lane; GATEL[(size_t)e * T + pos] = gk; }
    }
}
__device__ __forceinline__ int okey(float v, int e) { const int i = __builtin_bit_cast(int, v); const int o = i ^ ((i >> 31) & 0x7fffffff); return (o & ~31) | (31 - e); }
__device__ __forceinline__ void phase_e_route_mfma(const Args& a, int layer, int rows, LAS unsigned char* lds, int tid, int wave, int gw, int NGW, int lane, int probe_rep = 0) {
    unsigned char* ws = a.ws;
    const float* xs = (const float*)(ws + (layer < 2 ? WS_XSA : WS_XSB));
    const float* MODS = (const float*)(ws + WS_MODS); bf16* H2 = (bf16*)(ws + WS_H2);
    const float* ng = a.in[6] + (size_t)(layer * 2 + 1) * 1024; const float* rb = a.in[28] + layer * 32;
    const bf16* WRT = (const bf16*)(ws + WS_WRT) + (size_t)layer * 2 * 32 * 1024;
    unsigned* cnt = (unsigned*)(ws + WS_CTL) + CW_CNT + (layer + 4 * probe_rep) * 32 * CNT_STRIDE;
    int* SLOTL = (int*)(ws + (probe_rep ? WS_L1 : WS_SLOTL)); float* GATEL = (float*)(ws + (probe_rep ? WS_L1 + 8 * MiB : WS_GATEL));
    LAS int* hist = (LAS int*)(lds + LDSCTL_OFF + 3072); LAS int* base = hist + 32; LAS int* lcnt = hist + 64;
    int* TKE = (int*)(ws + WS_C12); float* TKG = (float*)(ws + WS_C12 + 4 * MiB);
    LAS unsigned char* tile = lds + wave * 8448;
    if (tid < 32) hist[tid] = 0;
    __syncthreads();
    const int l15 = lane & 15, g = lane >> 4;
    const int nlat = TL / 16, nctx = rows > TL ? TC / 4 : 0, G_ = NGW / 8;
    for (int it = 0;; ++it) {
        int t0, ntok;
        { const int tl = gw + it * NGW; const int xi = (int)blockIdx.x + (it - (nlat + NGW - 1) / NGW) * G_ * 8 + wave * G_;
          if (tl < nlat) { t0 = tl * 16; ntok = 16; } else if (it >= (nlat + NGW - 1) / NGW && xi < nctx) { t0 = TL + xi * 4; ntok = 4; } else if (it >= (nlat + NGW - 1) / NGW) break; else continue; }
        const float* mod = MODS + (size_t)(layer * 5 + mod_row(t0)) * 6144;
        float rstd[16];
#pragma unroll
        for (int t = 0; t < 16; ++t) { f32x4 x[4];
            const int tr = t < ntok ? t0 + t : t0;
#pragma unroll
            for (int j = 0; j < 4; ++j) x[j] = *(const f32x4*)(xs + (size_t)tr * D + 256 * j + 4 * lane);
            rstd[t] = __builtin_bit_cast(float, __builtin_amdgcn_readfirstlane(__builtin_bit_cast(int, row_rstd(x))));
            if ((t & 3) == 3) asm volatile("" ::: "memory"); }
        f32x4 acc[2]; acc[0] = (f32x4){0.f, 0.f, 0.f, 0.f}; acc[1] = acc[0];
#pragma unroll 1
        for (int s = 0; s < 4; ++s) {
            const int col = 256 * s + 4 * lane;
            const f32x4 g4 = *(const f32x4*)(ng + col) * (*(const f32x4*)(mod + 4 * 1024 + col) + 1.0f), s4 = *(const f32x4*)(mod + 3 * 1024 + col);
            f32x4 hv[16];
#pragma unroll
            for (int t = 0; t < 16; ++t) { const int tr = t < ntok ? t0 + t : t0; hv[t] = *(const f32x4*)(xs + (size_t)tr * D + col) * rstd[t] * g4 + s4;
                const u32x2 w = pk4(hv[t]); if (t < ntok) *(u32x2*)(H2 + (size_t)tr * D + col) = w;
                *(LAS u32x2*)(tile + t * 528 + lane * 8) = w; hv[t] = hv[t] - bf4(w); }
            LDS_WAIT(); asm volatile("" ::: "memory");
            const bf16* wh = WRT + (size_t)l15 * 1024 + 256 * s + 8 * g; const bf16* wl = wh + (size_t)32 * 1024;
#pragma unroll
            for (int ks = 0; ks < 8; ++ks) { const bf16x8 fb = as_frag(*(const LAS u32x4*)(tile + l15 * 528 + ks * 64 + g * 16));
#pragma unroll
                for (int et = 0; et < 2; ++et) { acc[et] = mfma16(as_frag(*(const u32x4*)(wh + (size_t)et * 16 * 1024 + 32 * ks)), fb, acc[et]);
                    acc[et] = mfma16(as_frag(*(const u32x4*)(wl + (size_t)et * 16 * 1024 + 32 * ks)), fb, acc[et]); } }
            LDS_WAIT(); asm volatile("" ::: "memory");
#pragma unroll
            for (int t = 0; t < 16; ++t) *(LAS u32x2*)(tile + t * 528 + lane * 8) = pk4(hv[t]);
            LDS_WAIT(); asm volatile("" ::: "memory");
#pragma unroll
            for (int ks = 0; ks < 8; ++ks) { const bf16x8 fb = as_frag(*(const LAS u32x4*)(tile + l15 * 528 + ks * 64 + g * 16));
#pragma unroll
                for (int et = 0; et < 2; ++et) acc[et] = mfma16(as_frag(*(const u32x4*)(wh + (size_t)et * 16 * 1024 + 32 * ks)), fb, acc[et]); }
            LDS_WAIT(); asm volatile("" ::: "memory");
        }
        float v[8]; int key[8];
#pragma unroll
        for (int j = 0; j < 8; ++j) { const int e = (j < 4 ? 0 : 16) + 4 * g + (j & 3); v[j] = acc[j >> 2][j & 3] + rb[e]; key[j] = okey(v[j], e); }
        int kb[8], kc[8], kd2[8];
#pragma unroll
        for (int j = 0; j < 8; ++j) kb[j] = __shfl_xor(key[j], 16);
#pragma unroll
        for (int j = 0; j < 8; ++j) { kc[j] = __shfl_xor(key[j], 32); kd2[j] = __shfl_xor(kb[j], 32); }
        float vmax = fmaxf(fmaxf(fmaxf(v[0], v[1]), fmaxf(v[2], v[3])), fmaxf(fmaxf(v[4], v[5]), fmaxf(v[6], v[7])));
        vmax = fmaxf(vmax, __shfl_xor(vmax, 16)); vmax = fmaxf(vmax, __shfl_xor(vmax, 32));
        int rank[8]; float ex[8], part = 0.f;
#pragma unroll
        for (int j = 0; j < 8; ++j) { int r = 0;
#pragma unroll
            for (int q = 0; q < 8; ++q) r += (key[q] > key[j]) + (kb[q] > key[j]) + (kc[q] > key[j]) + (kd2[q] > key[j]);
            rank[j] = r; ex[j] = __expf(v[j] - vmax); part += r < 4 ? ex[j] : 0.f; }
        part += __shfl_xor(part, 16); part += __shfl_xor(part, 32);
        const float inv = 1.0f / part; const int t = t0 + l15;
#pragma unroll
        for (int j = 0; j < 8; ++j) if (rank[j] < 4 && l15 < ntok) { const int e = (j < 4 ? 0 : 16) + 4 * g + (j & 3);
            TKE[t * 4 + rank[j]] = e; TKG[t * 4 + rank[j]] = ex[j] * inv;
            __hip_atomic_fetch_add(hist + e, 1, __ATOMIC_RELAXED, __HIP_MEMORY_SCOPE_WORKGROUP); }
    }
    asm volatile("s_waitcnt vmcnt(0) lgkmcnt(0)" ::: "memory"); __syncthreads();
    if (tid < 32) { base[tid] = (int)atomicAdd(cnt + tid * CNT_STRIDE, (unsigned)hist[tid]); lcnt[tid] = 0; }
    __syncthreads();
    for (int it = 0;; ++it) {
        int t0, ntok;
        { const int tl = gw + it * NGW; const int xi = (int)blockIdx.x + (it - (nlat + NGW - 1) / NGW) * G_ * 8 + wave * G_;
          if (tl < nlat) { t0 = tl * 16; ntok = 16; } else if (it >= (nlat + NGW - 1) / NGW && xi < nctx) { t0 = TL + xi * 4; ntok = 4; } else if (it >= (nlat + NGW - 1) / NGW) break; else continue; }
        if ((lane >> 2) < ntok) { const int t = t0 + (lane >> 2), k = lane & 3;
            const int e = TKE[t * 4 + k]; const float gk = TKG[t * 4 + k];
            const int pos = base[e] + __hip_atomic_fetch_add(lcnt + e, 1, __ATOMIC_RELAXED, __HIP_MEMORY_SCOPE_WORKGROUP);
            SLOTL[(size_t)e * T + pos] = t * 4 + k; GATEL[(size_t)e * T + pos] = gk; }
    }
}
__device__ __forceinline__ void phase_final(const Args& a, int gw, int NGW, int lane) {
    unsigned char* ws = a.ws;
    const float* xs = (const float*)(ws + WS_XSB); const float* MODS = (const float*)(ws + WS_MODS); const bf16* YS = (const bf16*)(ws + WS_YS);
    for (int t = gw; t < TL; t += NGW) {
        const int mr = t >> 13;
        f32x4 m5[4], x[4];
#pragma unroll
        for (int j = 0; j < 4; ++j) m5[j] = *(const f32x4*)(MODS + (size_t)(3 * 5 + mr) * 6144 + 5 * 1024 + 256 * j + 4 * lane);
        load_x_combined(x, xs + (size_t)t * D, true, YS, t, m5, lane);
        const float rstd = row_rstd(x);
#pragma unroll
        for (int j = 0; j < 4; ++j) { const int col = 256 * j + 4 * lane; *(f32x4*)(a.out + (size_t)t * D + col) = x[j] * rstd * *(const f32x4*)(a.in[7] + col); }
    }
}

using pg8::Unit; using pg8::tile_map;
struct SchedStd {
    int G, c, nM, nN;
    __device__ __forceinline__ bool next(int i, Unit& u) const { const long L = (long)i * G + c; if (L >= (long)nM * nN) return false; int pm, pn; tile_map((int)L, nM, nN, pm, pn); u.pm = pm; u.pn = pn; u.e = 0; u.nv = pm; return true; }
    __device__ __forceinline__ void a_ready(const Unit&) const {}
    __device__ __forceinline__ void done(const Unit&) const {}
    __device__ __forceinline__ unsigned row_off(const Unit&, int) const { return 0u; }
};
struct SchedB1 {
    int G, c;
    __device__ __forceinline__ bool next(int i, Unit& u) const { const long L = (long)i * G + c; constexpr int n1 = 3 * NMT * 4; if (L >= n1 + 3 * NMT) return false; const int l = (int)L;
        if (l < n1) { const int j = l / (NMT * 4), r = l % (NMT * 4); int pm, pn; tile_map(r, NMT, 4, pm, pn); u.pm = j * NMT + pm; u.pn = j * 4 + pn; u.e = j; u.nv = pm; }
        else { const int r = l - n1, j = r / NMT, pm = r % NMT; u.pm = (3 + j) * NMT + pm; u.pn = 12 + j; u.e = 3 + j; u.nv = pm; }
        return true; }
    __device__ __forceinline__ void a_ready(const Unit&) const {}
    __device__ __forceinline__ void done(const Unit&) const {}
    __device__ __forceinline__ unsigned row_off(const Unit&, int) const { return 0u; }
};
struct SchedB2 {
    int G, c;
    __device__ __forceinline__ bool next(int i, Unit& u) const { const long L = (long)i * G + c; constexpr int n1 = 2 * NMT * 8; if (L >= n1 + NMT * 4) return false; const int l = (int)L;
        if (l < n1) { const int j = l / (NMT * 8), r = l % (NMT * 8); int pm, pn; tile_map(r, NMT, 8, pm, pn); u.pm = j * NMT + pm; u.pn = j * 8 + pn; u.e = j; u.nv = pm; }
        else { const int r = l - n1; int pm, pn; tile_map(r, NMT, 4, pm, pn); u.pm = 2 * NMT + pm; u.pn = 16 + pn; u.e = 2; u.nv = pm; }
        return true; }
    __device__ __forceinline__ void a_ready(const Unit&) const {}
    __device__ __forceinline__ void done(const Unit&) const {}
    __device__ __forceinline__ unsigned row_off(const Unit&, int) const { return 0u; }
};
struct SchedMoe {
    int G, c, nnt, ntiles, P; LAS unsigned char* lds; const int* slotl;
    __device__ __forceinline__ bool next(int i, Unit& u) const { const long L = (long)i * G + c; const int ntp = (ntiles + P - 1) / P, ppg = nnt / (8 / P); if (L >= (long)ntp * ppg * 8) return false;
        const LAS int* tpre = (const LAS int*)(lds + LDSCTL_OFF + 64); const LAS int* ecnt = (const LAS int*)(lds + LDSCTL_OFF + 256); const LAS unsigned short* tile_e = (const LAS unsigned short*)(lds + LDSCTL_OFF + 512);
        const int xq = (int)(L >> 3), x8 = (int)(L & 7); int tile = (xq / ppg) * P + (x8 % P); const int pnl = (x8 / P) * ppg + xq % ppg; const bool dead = tile >= ntiles; tile = dead ? 0 : tile;
        const int e = __builtin_amdgcn_readfirstlane((int)tile_e[tile]), r0 = (tile - __builtin_amdgcn_readfirstlane(tpre[e])) * 256; int nv = __builtin_amdgcn_readfirstlane(ecnt[e]) - r0; nv = nv > 256 ? 256 : nv; nv = dead ? 0 : nv;
        u.pm = dead ? MAXTILES : tile; u.pn = e * nnt + pnl; u.e = e; u.nv = nv | (r0 << 9); return true; }
    __device__ __forceinline__ void a_ready(const Unit&) const {}
    __device__ __forceinline__ void done(const Unit&) const {}
    __device__ __forceinline__ unsigned row_off(const Unit& u, int r) const { const int nv = u.nv & 511, r0 = u.nv >> 9; const int tok = r < nv ? (slotl[(size_t)u.e * T + r0 + r] >> 2) : 0; return (unsigned)tok * 2048u; }
};

using pg8::cvt_pk_bf16;
template <class P> __device__ __forceinline__ P* pin_ptr(P* p) { asm volatile("" : "+v"(p)); return p; }
struct EpiB1 {
    static constexpr bool PERM = true, AFTER_DRAIN = false;
    bf16* RKV; bf16* L1;
    __device__ __forceinline__ void operator()(const f32x4 (&acc)[2][2][4][2], const Unit& u, int wr, int wc, int fr, int fq) const {
        const int seg = u.e, row0 = u.nv * 256 + wr * 64 + fr;
        const int jj = seg - 3, ld = seg < 3 ? D : 128, col0 = (seg < 3 ? (u.pn - seg * 4) * 256 : 0) + wc * 32 + 8 * fq;
        bf16* base = seg < 3 ? RKV + (size_t)seg * T * D : L1 + (size_t)jj * T * 128;
#pragma unroll
        for (int ai = 0; ai < 2; ++ai)
#pragma unroll
            for (int m = 0; m < 4; ++m) { bf16* rowp = base + (size_t)(row0 + ai * 128 + m * 16) * ld + col0;
#pragma unroll
                for (int bj = 0; bj < 2; ++bj) { if (seg >= 3 && bj == 1) continue; f32x4 v0 = acc[ai][bj][m][0], v1 = acc[ai][bj][m][1];
                    if (jj == 0) {
#pragma unroll
                        for (int q = 0; q < 4; ++q) { v0[q] = tanh_fast(v0[q]); v1[q] = tanh_fast(v1[q]); } }
                    else if (jj == 2) {
#pragma unroll
                        for (int q = 0; q < 4; ++q) { v0[q] = sigm(v0[q]); v1[q] = sigm(v1[q]); } }
                    u32x4 w; w.x = cvt_pk_bf16(v0[0], v0[1]); w.y = cvt_pk_bf16(v0[2], v0[3]); w.z = cvt_pk_bf16(v1[0], v1[1]); w.w = cvt_pk_bf16(v1[2], v1[3]);
                    *(u32x4*)(rowp + bj * 128) = w; } }
    }
};
struct EpiB2 {
    static constexpr bool PERM = true, AFTER_DRAIN = false;
    bf16* RW; bf16* RA; bf16* Gg;
    __device__ __forceinline__ void operator()(const f32x4 (&acc)[2][2][4][2], const Unit& u, int wr, int wc, int fr, int fq) const {
        const int jj = u.e, row0 = u.nv * 256 + wr * 64 + fr, pnl = u.pn - jj * 8;
        const int dirn = jj < 2 ? (pnl >> 2) : 0, col0 = (jj < 2 ? (pnl & 3) : pnl) * 256 + wc * 32 + 8 * fq;
        bf16* base = (jj == 0 ? RW : jj == 1 ? RA : Gg) + (size_t)dirn * T * D;
#pragma unroll
        for (int ai = 0; ai < 2; ++ai)
#pragma unroll
            for (int m = 0; m < 4; ++m) { bf16* rowp = base + (size_t)(row0 + ai * 128 + m * 16) * D + col0;
#pragma unroll
                for (int bj = 0; bj < 2; ++bj) { const f32x4 v0 = acc[ai][bj][m][0], v1 = acc[ai][bj][m][1];
                    u32x4 w; w.x = cvt_pk_bf16(v0[0], v0[1]); w.y = cvt_pk_bf16(v0[2], v0[3]); w.z = cvt_pk_bf16(v1[0], v1[1]); w.w = cvt_pk_bf16(v1[2], v1[3]);
                    *(u32x4*)(rowp + bj * 128) = w; } }
    }
};
struct EpiRes {
    static constexpr bool PERM = true, AFTER_DRAIN = false;
    float* X; const float* gate; float* Xo;
    __device__ __forceinline__ void operator()(const f32x4 (&acc)[2][2][4][2], const Unit& u, int wr, int wc, int fr, int fq) const {
        const int row0 = u.pm * 256 + wr * 64 + fr, col0 = u.pn * 256 + wc * 32 + 8 * fq, mr = u.pm < NMT_L ? (u.pm >> 5) : 4;
        const float* gp = pin_ptr(gate + (size_t)mr * 6144 + col0);
        f32x4 gv[2][2];
#pragma unroll
        for (int bj = 0; bj < 2; ++bj)
#pragma unroll
            for (int n = 0; n < 2; ++n) gv[bj][n] = *(const f32x4*)(gp + bj * 128 + 4 * n);
#pragma unroll
        for (int ai = 0; ai < 2; ++ai)
#pragma unroll
            for (int m = 0; m < 4; ++m) { float* rowp = X + (size_t)(row0 + ai * 128 + m * 16) * D + col0;
#pragma unroll
                for (int bj = 0; bj < 2; ++bj)
#pragma unroll
                    for (int n = 0; n < 2; ++n) { float* p = rowp + bj * 128 + 4 * n; *(f32x4*)(Xo + (p - X)) = *(const f32x4*)p + gv[bj][n] * acc[ai][bj][m][n]; } }
    }
};
struct EpiWin {
    static constexpr bool PERM = true, AFTER_DRAIN = false;
    bf16* BG; bf16* CU;
    __device__ __forceinline__ void operator()(const f32x4 (&acc)[2][2][4][2], const Unit& u, int wr, int wc, int fr, int fq) const {
        const int row0 = u.pm * 256 + wr * 64 + fr;
        if (u.pn < 4) {
            const int col0 = u.pn * 256 + wc * 32 + 8 * fq;
#pragma unroll
            for (int ai = 0; ai < 2; ++ai)
#pragma unroll
                for (int m = 0; m < 4; ++m) { bf16* rowp = BG + (size_t)(row0 + ai * 128 + m * 16) * D + col0;
#pragma unroll
                    for (int bj = 0; bj < 2; ++bj) { const f32x4 v0 = acc[ai][bj][m][0], v1 = acc[ai][bj][m][1];
                        u32x4 w; w.x = cvt_pk_bf16(v0[0], v0[1]); w.y = cvt_pk_bf16(v0[2], v0[3]); w.z = cvt_pk_bf16(v1[0], v1[1]); w.w = cvt_pk_bf16(v1[2], v1[3]);
                        *(u32x4*)(rowp + bj * 128) = w; } }
        } else {
            const int f0 = (u.pn - 4) * 128 + wc * 32 + 8 * fq;
#pragma unroll
            for (int ai = 0; ai < 2; ++ai)
#pragma unroll
                for (int m = 0; m < 4; ++m) { const f32x4 v0 = acc[ai][0][m][0] * acc[ai][1][m][0], v1 = acc[ai][0][m][1] * acc[ai][1][m][1];
                    u32x4 w; w.x = cvt_pk_bf16(v0[0], v0[1]); w.y = cvt_pk_bf16(v0[2], v0[3]); w.z = cvt_pk_bf16(v1[0], v1[1]); w.w = cvt_pk_bf16(v1[2], v1[3]);
                    *(u32x4*)(CU + (size_t)(row0 + ai * 128 + m * 16) * D + f0) = w; }
        }
    }
};
struct EpiGU {
    static constexpr bool PERM = true, AFTER_DRAIN = false;
    bf16* INTER; const float* bgu;
    __device__ __forceinline__ void operator()(const f32x4 (&acc)[2][2][4][2], const Unit& u, int wr, int wc, int fr, int fq) const {
        const int e = u.e, pnl = u.pn - e * 8, row0 = u.pm * 256 + wr * 64 + fr, f0 = pnl * 128 + wc * 32 + 8 * fq;
        const float* bp = pin_ptr(bgu + (size_t)e * 2048 + f0);
        f32x4 bg[2], bu[2];
#pragma unroll
        for (int n = 0; n < 2; ++n) { bg[n] = *(const f32x4*)(bp + 4 * n); bu[n] = *(const f32x4*)(bp + 1024 + 4 * n); }
#pragma unroll
        for (int ai = 0; ai < 2; ++ai)
#pragma unroll
            for (int m = 0; m < 4; ++m) { f32x4 o[2];
#pragma unroll
                for (int n = 0; n < 2; ++n) { const f32x4 g = acc[ai][0][m][n] + bg[n], uu = acc[ai][1][m][n] + bu[n];
#pragma unroll
                    for (int q = 0; q < 4; ++q) { const float gc = fminf(g[q], 7.0f), uc = fminf(fmaxf(uu[q], -7.0f), 7.0f); o[n][q] = (uc + 1.0f) * gc * sigm(1.702f * gc); } }
                u32x4 w; w.x = cvt_pk_bf16(o[0][0], o[0][1]); w.y = cvt_pk_bf16(o[0][2], o[0][3]); w.z = cvt_pk_bf16(o[1][0], o[1][1]); w.w = cvt_pk_bf16(o[1][2], o[1][3]);
                *(u32x4*)(INTER + (size_t)(row0 + ai * 128 + m * 16) * 1024 + f0) = w; }
    }
};
struct EpiDown {
    static constexpr bool PERM = true, AFTER_DRAIN = false;
    bf16* YS; const float* bdn; const int* slotl; const float* gatel;
    __device__ __forceinline__ void operator()(const f32x4 (&acc)[2][2][4][2], const Unit& u, int wr, int wc, int fr, int fq) const {
        const int e = u.e, pnl = u.pn - e * 4, col0 = pnl * 256 + wc * 32 + 8 * fq, nv = u.nv & 511, r0 = u.nv >> 9;
        const float* bp = pin_ptr(bdn + (size_t)e * 1024 + col0);
        f32x4 bv[2][2];
#pragma unroll
        for (int bj = 0; bj < 2; ++bj)
#pragma unroll
            for (int n = 0; n < 2; ++n) bv[bj][n] = *(const f32x4*)(bp + bj * 128 + 4 * n);
#pragma unroll
        for (int ai = 0; ai < 2; ++ai)
#pragma unroll
            for (int m = 0; m < 4; ++m) { const int r = ai * 128 + wr * 64 + m * 16 + fr;
                if (r < nv) { const size_t li = (size_t)e * T + r0 + r; const int slot = slotl[li]; const float gt = gatel[li];
                    bf16* rowp = YS + (size_t)slot * 1024 + col0;
#pragma unroll
                    for (int bj = 0; bj < 2; ++bj) { const f32x4 v0 = (acc[ai][bj][m][0] + bv[bj][0]) * gt, v1 = (acc[ai][bj][m][1] + bv[bj][1]) * gt;
                        u32x4 w; w.x = cvt_pk_bf16(v0[0], v0[1]); w.y = cvt_pk_bf16(v0[2], v0[3]); w.z = cvt_pk_bf16(v1[0], v1[1]); w.w = cvt_pk_bf16(v1[2], v1[3]);
                        *(u32x4*)(rowp + bj * 128) = w; } } }
    }
};

__device__ __forceinline__ int moe_tables(const unsigned* cnt, LAS unsigned char* lds, int tid) {
    LAS int* tpre = (LAS int*)(lds + LDSCTL_OFF + 64); LAS int* ecnt = (LAS int*)(lds + LDSCTL_OFF + 256); LAS unsigned short* tile_e = (LAS unsigned short*)(lds + LDSCTL_OFF + 512);
    if (tid == 0) { int p = 0; for (int e = 0; e < 32; ++e) { const int cn = (int)__hip_atomic_load(cnt + e * CNT_STRIDE, __ATOMIC_RELAXED, __HIP_MEMORY_SCOPE_AGENT); ecnt[e] = cn; tpre[e] = p; p += (cn + 255) >> 8; } tpre[32] = p; }
    __syncthreads();
    const int nt = tpre[32];
    for (int t = tid; t < nt; t += 512) { int e = 0; while (e < 31 && t >= tpre[e + 1]) ++e; tile_e[t] = (unsigned short)e; }
    __syncthreads();
    return nt;
}

constexpr int NPHASES = 37;
typedef const Args __attribute__((address_space(4))) CArgs;
__global__ void __launch_bounds__(512, 2) fwd_kernel(Args a_) {
    extern __shared__ __attribute__((aligned(16))) unsigned char lds_raw[];
    LAS unsigned char* lds = (LAS unsigned char*)lds_raw;
    const int G = gridDim.x, NGW = G * 8;
    CArgs* ap0 = (CArgs*)__builtin_amdgcn_kernarg_segment_ptr();
    if (threadIdx.x < 4) ((LAS unsigned*)(lds + LDSCTL_OFF))[threadIdx.x] = 0u;
    __syncthreads();
    XcdBarrier bar = xcd_barrier_post((unsigned*)(a_.ws + WS_CTL) + CW_BAR, (volatile LAS unsigned*)(lds + LDSCTL_OFF));
    const int lo = a_.ph_lo, hi = a_.ph_hi;
    int ph = 0;
#ifndef MK_ONLY
#define MK_ONLY -1
#endif
#ifndef MK_DBL
#define MK_DBL 0
#endif
#define PH_BEGIN(id) if ((MK_ONLY < 0 || MK_ONLY == (id)) && ph >= lo && ph < hi) { for (int rep_ = 0; rep_ <= ((MK_DBL >> (id)) & 1); ++rep_) { CArgs* ap = ap0; asm volatile("" : "+s"(ap)); const Args a = *(const Args*)ap; unsigned char* const ws = a.ws; (void)ws; const int wave = (int)bar.wv; int tid = wave * 64 + lane_id(); asm volatile("" : "+v"(tid)); const int lane = tid & 63, gw = blockIdx.x * 8 + wave; (void)lane; (void)gw;
#define PH_END } } if (ph >= lo && ph + 1 < hi) xcd_barrier(bar); ++ph;

    PH_BEGIN(0) p0_prologue(a, lds, tid, lane, wave, G); PH_END

#pragma unroll 1
    for (int layer = 0; layer < DEPTH; ++layer) {
        const int kind = layer & 1, lj = layer >> 1;
        const int rows = layer == 3 ? TL : T, nmt = rows / 256;
        const int rows_moe = layer < 2 ? T : TL;
        if (kind == 0) {
            PH_BEGIN(1) phase_a_rwkv(a, layer, lds, tid, gw, NGW, lane); PH_END
            PH_BEGIN(2) {
                pg8::Gemm g{(const bf16*)(ws + WS_XL), (const bf16*)(ws + WS_WRKV) + (size_t)lj * 3840 * 1024, 6 * T, 3840, 1024};
                SchedB1 S{G, (int)blockIdx.x}; EpiB1 E{(bf16*)(ws + WS_RKV), (bf16*)(ws + WS_L1)};
                pg8::gemm_phase<EpiB1, SchedB1, true, true, false>(lds, g, S, E, tid); } PH_END
            PH_BEGIN(3) {
                pg8::Gemm g{(const bf16*)(ws + WS_L1), (const bf16*)(ws + WS_L2T) + (size_t)lj * 5120 * 128, 3 * T, 5120, 128};
                SchedB2 S{G, (int)blockIdx.x}; EpiB2 E{(bf16*)(ws + WS_RAWW), (bf16*)(ws + WS_RAWA), (bf16*)(ws + WS_G)};
                pg8::gemm_phase<EpiB2, SchedB2, true, true, false>(lds, g, S, E, tid); } PH_END
            PH_BEGIN(5) phase_s1_chunks(a, lj, lds, tid, G, (MK_DBL >> 5) & 1 & (rep_ == 0)); PH_END
            PH_BEGIN(15) phase_s2_chain(a, wave, lane, G); PH_END
            PH_BEGIN(6) phase_s3_readout(a, lj, layer == 2 ? TL : T, gw, NGW, lane); PH_END
        } else {
            PH_BEGIN(7) phase_a_conv(a, layer, rows, gw, NGW, lane); PH_END
            PH_BEGIN(8) {
                pg8::Gemm g{(const bf16*)(ws + WS_XL), (const bf16*)(ws + WS_WIN) + (size_t)lj * 3072 * 1024, rows, 3072, 1024};
                SchedStd S{G, (int)blockIdx.x, nmt, 12}; EpiWin E{(bf16*)(ws + WS_BG), (bf16*)(ws + WS_CUZ)};
                pg8::gemm_phase<EpiWin, SchedStd, true, true, false>(lds, g, S, E, tid); } PH_END
            PH_BEGIN(9) phase_cv(a, lj, rows, gw, NGW, lane); PH_END
        }
        PH_BEGIN(10) {
            const bf16* Wt = kind == 0 ? (const bf16*)(ws + WS_WO) + (size_t)lj * 1024 * 1024 : (const bf16*)(ws + WS_WOUT) + (size_t)lj * 1024 * 1024;
            pg8::Gemm g{(const bf16*)(ws + WS_Z), Wt, rows, 1024, 1024};
            SchedStd S{G, (int)blockIdx.x, layer == 2 ? NMT_L : nmt, 4}; EpiRes E{(float*)(ws + (layer < 2 ? WS_XSA : WS_XSB)), (const float*)(ws + WS_MODS) + (size_t)layer * 5 * 6144 + 2 * 1024, (float*)(ws + (rep_ ? WS_XL : (layer < 2 ? WS_XSA : WS_XSB)))};
            pg8::gemm_phase<EpiRes, SchedStd, true, true, false>(lds, g, S, E, tid); } PH_END
        PH_BEGIN(11) phase_e_route_mfma(a, layer, rows_moe, lds, tid, wave, gw, NGW, lane, rep_); PH_END
        PH_BEGIN(12) {
            const int nt = __builtin_amdgcn_readfirstlane(moe_tables((const unsigned*)(ws + WS_CTL) + CW_CNT + layer * 32 * CNT_STRIDE, lds, tid));
            pg8::Gemm g{(const bf16*)(ws + WS_H2), (const bf16*)(ws + WS_WGU) + (size_t)layer * 32 * 2048 * 1024, 0, 0, 1024};
            SchedMoe S{G, (int)blockIdx.x, 8, nt, 2, lds, (const int*)(ws + WS_SLOTL)};
            EpiGU E{(bf16*)(ws + WS_INTER), a.in[30] + (size_t)layer * 32 * 2048};
            pg8::gemm_phase<EpiGU, SchedMoe, true, true, true>(lds, g, S, E, tid); } PH_END
        PH_BEGIN(13) {
            const int nt = __builtin_amdgcn_readfirstlane(moe_tables((const unsigned*)(ws + WS_CTL) + CW_CNT + layer * 32 * CNT_STRIDE, lds, tid));
            pg8::Gemm g{(const bf16*)(ws + WS_INTER), (const bf16*)(ws + WS_WDN) + (size_t)layer * 32 * 1024 * 1024, 0, 0, 1024};
            SchedMoe S{G, (int)blockIdx.x, 4, nt, 8, lds, (const int*)(ws + WS_SLOTL)};
            EpiDown E{(bf16*)(ws + WS_YS), a.in[32] + (size_t)layer * 32 * 1024, (const int*)(ws + WS_SLOTL), (const float*)(ws + WS_GATEL)};
            pg8::gemm_phase<EpiDown, SchedMoe, true, true, false>(lds, g, S, E, tid); } PH_END
    }
    PH_BEGIN(14) phase_final(a, gw, NGW, lane); PH_END
#undef PH_BEGIN
#undef PH_END
}

extern "C" void kernel_launch(void* const* d_in, const int* in_sizes, int n_in, void* d_out, int out_size, void* d_ws, size_t ws_size, hipStream_t stream) {
    static int grid = 0;
    if (grid == 0) {
        if (n_in != 33 || in_sizes[0] != TL * D || out_size != TL * D || ws_size < WS_END) { fprintf(stderr, "kernel_launch: unexpected problem (n_in %d, in0 %d, out %d, ws %zu < %zu)\n", n_in, n_in > 0 ? in_sizes[0] : -1, out_size, ws_size, (size_t)WS_END); grid = -1; return; }
        int dev = 0, cus = 0, per_cu = 0;
        if (hipGetDevice(&dev) != hipSuccess || hipDeviceGetAttribute(&cus, hipDeviceAttributeMultiprocessorCount, dev) != hipSuccess) { grid = -1; return; }
        if (hipFuncSetAttribute((const void*)fwd_kernel, hipFuncAttributeMaxDynamicSharedMemorySize, LDS_BYTES) != hipSuccess) { fprintf(stderr, "kernel_launch: hipFuncSetAttribute failed\n"); grid = -1; return; }
        if (hipOccupancyMaxActiveBlocksPerMultiprocessor(&per_cu, (const void*)fwd_kernel, 512, LDS_BYTES) != hipSuccess || per_cu < 1) fprintf(stderr, "kernel_launch: occupancy query says %d\n", per_cu);
        (void)hipGetLastError();
        grid = cus;
    }
    if (grid < 0) return;
    if (hipMemsetAsync((char*)d_ws + WS_CTL, 0, CTL_ZERO_BYTES, stream) != hipSuccess) return;
    Args a{};
    for (int i = 0; i < 33; ++i) a.in[i] = (const float*)d_in[i];
    a.out = (float*)d_out; a.ws = (unsigned char*)d_ws;
#if MK_PER_PHASE
    for (int p = 0; p < NPHASES; ++p) { a.ph_lo = p; a.ph_hi = p + 1; hipLaunchKernelGGL(fwd_kernel, dim3(grid), dim3(512), LDS_BYTES, stream, a); }
#else
    a.ph_lo = 0; a.ph_hi = NPHASES;
    hipLaunchKernelGGL(fwd_kernel, dim3(grid), dim3(512), LDS_BYTES, stream, a);
#endif
    const hipError_t le = hipPeekAtLastError();
    if (le != hipSuccess) fprintf(stderr, "kernel_launch: launch failed: %s\n", hipGetErrorName(le));
}
```

```cpp
#include <hip/hip_runtime.h>
#include <cstdio>
#include <cstdint>

#ifndef MK_PER_PHASE
#define MK_PER_PHASE 0
#endif

constexpr int D = 1024, NBATCH = 4, SEQ = 8192, TL = NBATCH * SEQ, CTXL = 256, TC = NBATCH * CTXL, T = TL + TC;
constexpr int NH = 16, HS = 64, NE = 32, TOPK = 4, DEPTH = 4;
constexpr int NMT = T / 256;
constexpr int NMT_L = TL / 256;
constexpr int MAXTILES = (T * TOPK) / 256 + NE;
constexpr int NSTEP = CTXL + SEQ;

__device__ __forceinline__ int lane_id() { return (int)__builtin_amdgcn_mbcnt_hi(~0u, __builtin_amdgcn_mbcnt_lo(~0u, 0u)); }
namespace pg8 {
#define PG8_LAS __attribute__((address_space(3)))
typedef unsigned short bf16_t;
typedef short bf16x8 __attribute__((ext_vector_type(8)));
typedef float f32x4 __attribute__((ext_vector_type(4)));
typedef unsigned u32x4 __attribute__((ext_vector_type(4)));
typedef unsigned u32x2 __attribute__((ext_vector_type(2)));
constexpr int BM = 256, BK = 64, HALF = 128, HTB = HALF * BK * 2  , STAGE_BYTES = 8 * HTB, NXCD = 8, WGM = 8;

__host__ __device__ __forceinline__ int lds_byte(int r, int c) { const int st = (r >> 4) * 2 + (c >> 5), rr = r & 15, cc = c & 31, ob = rr * 64 + cc * 2; return st * 1024 + (ob ^ (((ob >> 9) & 1) << 5)); }
__host__ __device__ __forceinline__ void stage_rc(int b, int& R, int& C) { const int st = b / 1024, sb = b % 1024, swz = sb ^ (((sb >> 9) & 1) << 5); R = (st >> 1) * 16 + swz / 64; C = (st & 1) * 32 + (swz % 64) / 2; }
__host__ __device__ __forceinline__ int perm32(int rho) { const int n = rho >> 4, i = rho & 15; return 8 * (i >> 2) + 4 * n + (i & 3); }

struct Unit { int pm, pn, e, nv, par; };
struct Gemm { const bf16_t* A; const bf16_t* Bt; int M, N, K; };

__device__ __forceinline__ void tile_map(int wgid, int nM, int nN, int& pm, int& pn) {
    const int nwg = nM * nN;
    { const int q = nwg / NXCD, r = nwg % NXCD, xcd = wgid % NXCD, off = wgid / NXCD; wgid = (xcd < r ? xcd * (q + 1) : r * (q + 1) + (xcd - r) * q) + off; }
    const int nig = WGM * nN, gid = wgid / nig, fm = gid * WGM, gsz = (nM - fm) < WGM ? (nM - fm) : WGM;
    pm = fm + ((wgid % nig) % gsz); pn = (wgid % nig) / gsz;
}
typedef __bf16 bf16x2_t __attribute__((ext_vector_type(2)));
typedef float f32x2_t __attribute__((ext_vector_type(2)));
__device__ __forceinline__ unsigned cvt_pk_bf16(float lo, float hi) { const f32x2_t v = {lo, hi}; const bf16x2_t b = __builtin_convertvector(v, bf16x2_t); return __builtin_bit_cast(unsigned, b); }

template <class Epi, class Sched, bool ALIGN_EPI = false, bool SP2 = false, bool GATHER = false>
__device__ __forceinline__ void gemm_phase(PG8_LAS unsigned char* lds, const Gemm g, const Sched& S, const Epi& E, int tid_in) {
    int tid_ = tid_in; asm volatile("" : "+v"(tid_));
    const int tid = tid_, wid = __builtin_amdgcn_readfirstlane(tid >> 6), lane = tid & 63, wr = wid >> 2, wc = wid & 3, fr = lane & 15, fq = lane >> 4;
    int K_ = g.K; asm volatile("" : "+s"(K_));
    const int K = K_, nt = K / BK;
    unsigned voffA[2], voffB[2]; int gR[2]; unsigned gC[2];
#pragma unroll
    for (int i = 0; i < 2; ++i) { int R, C; stage_rc(tid * 16 + i * 8192, R, C); const int Rb = Epi::PERM ? ((R & ~31) + perm32(R & 31)) : R;
        voffA[i] = (unsigned)(R * K + C) * 2u; voffB[i] = (unsigned)(Rb * K + C) * 2u; gR[i] = R; gC[i] = (unsigned)C * 2u; }
    unsigned oc[2][2], on[2][2], o2[2][2];
#pragma unroll
    for (int h = 0; h < 2; ++h)
#pragma unroll
        for (int i = 0; i < 2; ++i) { oc[h][i] = 0u; on[h][i] = 0u; o2[h][i] = 0u; }
    const size_t kstep = (size_t)(BK * 2);
    const size_t hstep = (size_t)HALF * K * 2;
    const size_t tstep = 2 * hstep;
    const unsigned ldsw = (unsigned)wid * 1024u;
    const int aoff = lds_byte(wr * 64 + fr, fq * 8), boff = lds_byte(wc * 32 + fr, fq * 8);
#define PG8_SA(b, h) (((b) * 2 + (h)) * HTB)
#define PG8_SB(b, h) ((4 + (b) * 2 + (h)) * HTB)
#define PG8_STAGE(bufoff, gbase, voff) do { _Pragma("unroll") for (int _i = 0; _i < 2; ++_i) \
        __builtin_amdgcn_global_load_lds((const unsigned*)((const char*)(gbase) + (voff)[_i]), (PG8_LAS unsigned*)(lds + (bufoff) + ldsw + _i * 8192), 16, 0, 0); } while (0)
#define PG8_STAGE_A(bufoff, base, h, O) do { if constexpr (GATHER) { PG8_STAGE(bufoff, base, (O)[h]); } else { PG8_STAGE(bufoff, (base) + (h) * hstep, voffA); } } while (0)
#define PG8_LDA(dst, b, h) do { _Pragma("unroll") for (int m = 0; m < 4; ++m) _Pragma("unroll") for (int k = 0; k < 2; ++k) dst[m][k] = *(const PG8_LAS bf16x8*)(lds + PG8_SA(b, h) + aoff + m * 2048 + k * 1024); } while (0)
#define PG8_LDB(dst, b, h) do { _Pragma("unroll") for (int n = 0; n < 2; ++n) _Pragma("unroll") for (int k = 0; k < 2; ++k) dst[n][k] = *(const PG8_LAS bf16x8*)(lds + PG8_SB(b, h) + boff + n * 2048 + k * 1024); } while (0)
#define PG8_MMA(ai, bj, At, Bt) do { __builtin_amdgcn_s_setprio(1); _Pragma("unroll") for (int m = 0; m < 4; ++m) _Pragma("unroll") for (int n = 0; n < 2; ++n) _Pragma("unroll") for (int k = 0; k < 2; ++k) \
        acc[ai][bj][m][n] = __builtin_amdgcn_mfma_f32_16x16x32_bf16(Bt[n][k], At[m][k], acc[ai][bj][m][n], 0, 0, 0); __builtin_amdgcn_s_setprio(0); } while (0)
#define PG8_WAIT_V(n) asm volatile("s_waitcnt vmcnt(" #n ")" ::: "memory")
#define PG8_WAIT_L(n) asm volatile("s_waitcnt lgkmcnt(" #n ")" ::: "memory")
#define PG8_BAR __builtin_amdgcn_s_barrier()
#define PG8_SCHED __builtin_amdgcn_sched_barrier(0)
    Unit cur, nxt; int ui = 0;
    if (!S.next(0, cur)) return;
    f32x4 acc[2][2][4][2];
#pragma unroll
    for (int a = 0; a < 2; ++a)
#pragma unroll
        for (int b = 0; b < 2; ++b)
#pragma unroll
            for (int m = 0; m < 4; ++m)
#pragma unroll
                for (int n = 0; n < 2; ++n) acc[a][b][m][n] = (f32x4){0.f, 0.f, 0.f, 0.f};
    bf16x8 At[4][2], B0[2][2], B1[2][2];
    const char* cA = GATHER ? (const char*)g.A : (const char*)g.A + (size_t)cur.pm * tstep; const char* cB = (const char*)g.Bt + (size_t)cur.pn * tstep;
    S.a_ready(cur);
    if constexpr (GATHER) {
#pragma unroll
        for (int h = 0; h < 2; ++h)
#pragma unroll
            for (int i = 0; i < 2; ++i) oc[h][i] = S.row_off(cur, h * HALF + gR[i]) + gC[i];
    }
    if constexpr (SP2) {
        PG8_STAGE(PG8_SB(0, 0), cB, voffB); PG8_STAGE(PG8_SB(0, 1), cB + hstep, voffB); PG8_STAGE_A(PG8_SA(0, 0), cA, 0, oc); PG8_STAGE_A(PG8_SA(0, 1), cA, 1, oc);
        if (wr == 1) PG8_BAR;
        PG8_WAIT_V(2); PG8_BAR;
        PG8_STAGE(PG8_SB(1, 0), cB + kstep, voffB); PG8_STAGE_A(PG8_SA(1, 0), cA + kstep, 0, oc); PG8_STAGE(PG8_SB(1, 1), cB + hstep + kstep, voffB);
        PG8_WAIT_V(6); PG8_BAR;
    } else {
        PG8_STAGE(PG8_SB(0, 0), cB, voffB); PG8_STAGE_A(PG8_SA(0, 0), cA, 0, oc); PG8_STAGE(PG8_SB(0, 1), cB + hstep, voffB); PG8_STAGE_A(PG8_SA(0, 1), cA, 1, oc);
        if (wr == 1) PG8_BAR;
        PG8_WAIT_V(4); PG8_BAR;
        PG8_STAGE(PG8_SB(1, 0), cB + kstep, voffB); PG8_STAGE_A(PG8_SA(1, 0), cA + kstep, 0, oc); PG8_STAGE(PG8_SB(1, 1), cB + hstep + kstep, voffB);
        PG8_WAIT_V(6); PG8_BAR;
    }
    for (;;) {
        const bool has_next = S.next(ui + 1, nxt);
        const char* nA = GATHER ? (const char*)g.A : (has_next ? (const char*)g.A + (size_t)nxt.pm * tstep : cA); const char* nB = has_next ? (const char*)g.Bt + (size_t)nxt.pn * tstep : cB;
        if constexpr (GATHER) {
#pragma unroll
            for (int h = 0; h < 2; ++h)
#pragma unroll
                for (int i = 0; i < 2; ++i) on[h][i] = has_next ? (S.row_off(nxt, h * HALF + gR[i]) + gC[i]) : oc[h][i];
        }
        for (int t = 0; t < nt; t += 2) {
            const bool last = (t == nt - 2);
            const char* a1 = cA + (size_t)(t + 1) * kstep;
            const char* a2 = last ? nA : cA + (size_t)(t + 2) * kstep; const char* b2 = last ? nB : cB + (size_t)(t + 2) * kstep;
            const char* a3 = a2 + kstep; const char* b3 = b2 + kstep;
            if constexpr (GATHER) {
#pragma unroll
                for (int h = 0; h < 2; ++h)
#pragma unroll
                    for (int i = 0; i < 2; ++i) o2[h][i] = last ? on[h][i] : oc[h][i];
            }
            if (last && has_next) S.a_ready(nxt);
            if constexpr (SP2) {
            PG8_LDB(B0, 0, 0); PG8_LDB(B1, 0, 1); PG8_SCHED; PG8_LDA(At, 0, 0); PG8_STAGE_A(PG8_SA(1, 1), a1, 1, oc);
            PG8_WAIT_V(8); PG8_WAIT_L(0); PG8_BAR; PG8_MMA(0, 0, At, B0); PG8_MMA(0, 1, At, B1); PG8_BAR; PG8_SCHED;
            PG8_LDA(At, 0, 1); PG8_STAGE(PG8_SB(0, 0), b2, voffB); PG8_STAGE(PG8_SB(0, 1), b2 + hstep, voffB); PG8_STAGE_A(PG8_SA(0, 0), a2, 0, o2);
            PG8_WAIT_V(8); PG8_WAIT_L(0); PG8_BAR; PG8_MMA(1, 0, At, B0); PG8_MMA(1, 1, At, B1); PG8_BAR; PG8_SCHED;
            PG8_LDB(B0, 1, 0); PG8_LDB(B1, 1, 1); PG8_SCHED; PG8_LDA(At, 1, 0); PG8_STAGE_A(PG8_SA(0, 1), a2, 1, o2);
            PG8_WAIT_V(8); PG8_WAIT_L(0); PG8_BAR; PG8_MMA(0, 0, At, B0); PG8_MMA(0, 1, At, B1); PG8_BAR; PG8_SCHED;
            PG8_LDA(At, 1, 1); PG8_STAGE(PG8_SB(1, 0), b3, voffB); PG8_STAGE(PG8_SB(1, 1), b3 + hstep, voffB); PG8_STAGE_A(PG8_SA(1, 0), a3, 0, o2);
            PG8_WAIT_V(8); PG8_WAIT_L(0); PG8_BAR; PG8_MMA(1, 0, At, B0); PG8_MMA(1, 1, At, B1); PG8_BAR; PG8_SCHED;
            } else {
            PG8_LDB(B0, 0, 0); PG8_SCHED; PG8_LDA(At, 0, 0); PG8_STAGE_A(PG8_SA(1, 1), a1, 1, oc);
            PG8_WAIT_L(8); PG8_BAR; PG8_WAIT_L(0); PG8_MMA(0, 0, At, B0); PG8_BAR; PG8_SCHED;
            PG8_LDB(B1, 0, 1); PG8_STAGE(PG8_SB(0, 0), b2, voffB);
            PG8_BAR; PG8_WAIT_L(0); PG8_MMA(0, 1, At, B1); PG8_BAR;
            PG8_LDA(At, 0, 1); PG8_STAGE_A(PG8_SA(0, 0), a2, 0, o2);
            PG8_BAR; PG8_WAIT_L(0); PG8_MMA(1, 0, At, B0); PG8_BAR; PG8_SCHED;
            PG8_STAGE(PG8_SB(0, 1), b2 + hstep, voffB);
            PG8_WAIT_V(6); PG8_BAR; PG8_MMA(1, 1, At, B1); PG8_BAR;
            PG8_LDB(B0, 1, 0); PG8_SCHED; PG8_LDA(At, 1, 0); PG8_STAGE_A(PG8_SA(0, 1), a2, 1, o2);
            PG8_WAIT_L(8); PG8_BAR; PG8_WAIT_L(0); PG8_MMA(0, 0, At, B0); PG8_BAR; PG8_SCHED;
            PG8_LDB(B1, 1, 1); PG8_STAGE(PG8_SB(1, 0), b3, voffB);
            PG8_BAR; PG8_WAIT_L(0); PG8_MMA(0, 1, At, B1); PG8_BAR;
            PG8_LDA(At, 1, 1); PG8_STAGE_A(PG8_SA(1, 0), a3, 0, o2);
            PG8_BAR; PG8_WAIT_L(0); PG8_MMA(1, 0, At, B0); PG8_BAR; PG8_SCHED;
            PG8_STAGE(PG8_SB(1, 1), b3 + hstep, voffB);
            PG8_WAIT_V(6); PG8_BAR; PG8_MMA(1, 1, At, B1); PG8_BAR;
            }
        }
        if constexpr (ALIGN_EPI) { if (wr == 0) PG8_BAR; }
        if constexpr (!Epi::AFTER_DRAIN) { E(acc, cur, wr, wc, fr, fq); S.done(cur); }
        if (!has_next) break;
#pragma unroll
        for (int a = 0; a < 2; ++a)
#pragma unroll
            for (int b = 0; b < 2; ++b)
#pragma unroll
                for (int m = 0; m < 4; ++m)
#pragma unroll
                    for (int n = 0; n < 2; ++n) acc[a][b][m][n] = (f32x4){0.f, 0.f, 0.f, 0.f};
        cur = nxt; cA = nA; cB = nB; ++ui;
        if constexpr (GATHER) {
#pragma unroll
            for (int h = 0; h < 2; ++h)
#pragma unroll
                for (int i = 0; i < 2; ++i) oc[h][i] = on[h][i];
        }
        if constexpr (ALIGN_EPI) { if (wr == 1) PG8_BAR; }
    }
    PG8_WAIT_V(0);
    if constexpr (!ALIGN_EPI) { if (wr == 0) PG8_BAR; }
    PG8_BAR;
    if constexpr (Epi::AFTER_DRAIN) { E.fused(acc, cur, wr, wc, fr, fq, lds, wid, lane); S.done(cur); }
#undef PG8_SA
#undef PG8_SB
#undef PG8_STAGE
#undef PG8_STAGE_A
#undef PG8_LDA
#undef PG8_LDB
#undef PG8_MMA
#undef PG8_WAIT_V
#undef PG8_WAIT_L
#undef PG8_BAR
#undef PG8_SCHED
}
}

#define LAS __attribute__((address_space(3)))
typedef unsigned short bf16;
typedef float f32x4 __attribute__((ext_vector_type(4)));
typedef unsigned u32x2 __attribute__((ext_vector_type(2)));
typedef unsigned u32x4 __attribute__((ext_vector_type(4)));
#define LDS_WAIT() asm volatile("s_waitcnt lgkmcnt(0)" ::: "memory")
__device__ __forceinline__ unsigned pk2(float lo, float hi) { return pg8::cvt_pk_bf16(lo, hi); }
__device__ __forceinline__ unsigned f2bf(float f) { return pk2(f, f) & 0xffffu; }
__device__ __forceinline__ float bflo(unsigned w) { return __builtin_bit_cast(float, w << 16); }
__device__ __forceinline__ float bfhi(unsigned w) { return __builtin_bit_cast(float, w & 0xffff0000u); }
__device__ __forceinline__ float wave_sum(float v) {
#pragma unroll
    for (int o = 1; o < 64; o <<= 1) v += __shfl_xor(v, o);
    return v;
}
__device__ __forceinline__ float sigm(float x) { return 1.0f / (1.0f + __expf(-x)); }
__device__ __forceinline__ float tanh_fast(float x) { const float e = __expf(2.0f * x); return 1.0f - 2.0f / (e + 1.0f); }

constexpr size_t MiB = 1u << 20;
constexpr size_t RF = (size_t)T * D * 4;
constexpr size_t RB = (size_t)T * D * 2;
constexpr size_t WS_CTL = 0, CTL_ZERO_BYTES = 1 * MiB;
constexpr size_t WS_MODS = 1 * MiB;
constexpr size_t WS_XSA = 2 * MiB, WS_XSB = WS_XSA + RF;
constexpr size_t WS_XL = WS_XSB + RF;
constexpr size_t WS_RKV = WS_XL + 6 * RB;
constexpr size_t WS_L1 = WS_RKV + 3 * RF;
constexpr size_t WS_WDEC = WS_L1 + 50 * MiB;
constexpr size_t WS_AA = WS_WDEC + 2 * RF;
constexpr size_t WS_G = WS_AA + 2 * RF;
constexpr size_t WS_KK = WS_G + RB;
constexpr size_t WS_KD = WS_KK + RF;
constexpr size_t WS_BETA = WS_KD + 2 * RF;
constexpr size_t WS_RKB = WS_BETA + 2 * RF;
constexpr size_t WS_C12 = WS_RKB + 3 * MiB;
constexpr size_t WS_WRT = WS_C12 + 6 * MiB;
constexpr size_t WS_Y = WS_C12 + 9 * MiB;
constexpr size_t WS_Z = WS_Y + 2 * RF;
constexpr size_t WS_H2 = WS_Z + RB;
constexpr size_t WS_SLOTL = WS_H2 + RB;
constexpr size_t WS_GATEL = WS_SLOTL + 5 * MiB;
constexpr size_t WS_WRKV = WS_GATEL + 5 * MiB;
constexpr size_t WS_L2T = WS_WRKV + 15 * MiB;
constexpr size_t WS_WO = WS_L2T + 5 * MiB;
constexpr size_t WS_WIN = WS_WO + 4 * MiB;
constexpr size_t WS_WOUT = WS_WIN + 12 * MiB;
constexpr size_t WS_WGU = WS_WOUT + 4 * MiB;
constexpr size_t WS_WDN = WS_WGU + 512 * MiB;
constexpr size_t WS_END = WS_WDN + 256 * MiB;
constexpr size_t WS_INTER = WS_WDEC;
constexpr size_t WS_YS = WS_KD;
constexpr size_t WS_BG = WS_RKV, WS_CUZ = WS_RKV + RB;
constexpr size_t WS_RAWW = WS_AA, WS_RAWA = WS_AA + RF;
constexpr size_t WS_RH = WS_AA;
constexpr size_t WS_PM = WS_WDEC;
constexpr size_t WS_RKB1 = WS_C12 + 1 * MiB;
constexpr size_t WS_QT = WS_XL;
constexpr size_t WS_HT = WS_XL + RF;
static_assert((size_t)128 * 132 * 4096 * 2 <= RF, "chunk state tensors");
static_assert((size_t)MAXTILES * 256 * 1024 * 2 <= 4 * RF, "INTER overlay");
static_assert((size_t)T * 4 * 1024 * 2 <= 2 * RF, "YS overlay");
static_assert((size_t)3 * T * 256 * 2 <= 50 * MiB, "L1OUT");
constexpr int CW_BAR = 4096;
constexpr int CW_CNT = 16384, CNT_STRIDE = 64;

constexpr int RING_BYTES = 131072;
constexpr int LDSCTL_OFF = RING_BYTES;
constexpr int LDS_BYTES = 147456;

struct Args { const float* in[33]; float* out; unsigned char* ws; int ph_lo, ph_hi; };

__device__ __forceinline__ void transpose_item(const float* W, int N, bf16* WT, int dstK, int drow0, int k0, int n0, LAS float* scr, int lane) {
    float tv[32];
#pragma unroll
    for (int i = 0; i < 32; ++i) { const int kk = 2 * i + (lane >> 5); tv[i] = W[(size_t)(k0 + kk) * N + n0 + (lane & 31)]; }
#pragma unroll
    for (int i = 0; i < 32; ++i) { const int kk = 2 * i + (lane >> 5); scr[kk * 33 + (lane & 31)] = tv[i]; }
    LDS_WAIT(); asm volatile("" ::: "memory");
    const int c = lane & 7;
#pragma unroll
    for (int j = 0; j < 4; ++j) { const int n = (lane >> 3) + 8 * j; const LAS float* s = scr + (8 * c) * 33 + n;
        u32x4 o; o.x = pk2(s[0 * 33], s[1 * 33]); o.y = pk2(s[2 * 33], s[3 * 33]); o.z = pk2(s[4 * 33], s[5 * 33]); o.w = pk2(s[6 * 33], s[7 * 33]);
        *(u32x4*)(WT + (size_t)(drow0 + n) * dstK + k0 + 8 * c) = o; }
    LDS_WAIT(); asm volatile("" ::: "memory");
}
__device__ __forceinline__ int gu_map(int n0) { const int bj = n0 >= 1024 ? 1 : 0, f0 = n0 - bj * 1024; return (f0 >> 7) * 256 + bj * 128 + (f0 & 127); }
__device__ __forceinline__ int conv_map(int n0) { if (n0 < 1024) return n0; const int q = (n0 - 1024) >> 10, f0 = (n0 - 1024) & 1023; return 1024 + (f0 >> 7) * 256 + q * 128 + (f0 & 127); }

__device__ __forceinline__ void p0_prologue(const Args& a, LAS unsigned char* lds, int tid, int lane, int wave, int G) {
    unsigned char* ws = a.ws;
    LAS float* sl = (LAS float*)lds;
    LAS float* red = (LAS float*)(lds + 20480);
    for (int i = tid; i < 5 * 1024; i += 512) { const int r = i >> 10, k = i & 1023; const float cv = r < 4 ? a.in[1][r * 1024 + k] : a.in[3][k]; sl[i] = cv / (1.0f + __expf(-cv)); }
    __syncthreads();
    float* MODS = (float*)(ws + WS_MODS);
    for (int it = blockIdx.x; it < 4 * 96; it += G) {
        const int l = it / 96, n = (it % 96) * 64 + lane;
        const float* W = a.in[4] + (size_t)l * 1024 * 6144 + n;
        float acc[5] = {0.f, 0.f, 0.f, 0.f, 0.f};
        const int kb = wave * 128;
#pragma unroll 8
        for (int k = 0; k < 128; ++k) { const float wv = W[(size_t)(kb + k) * 6144];
#pragma unroll
            for (int r = 0; r < 5; ++r) acc[r] += sl[r * 1024 + kb + k] * wv; }
#pragma unroll
        for (int r = 0; r < 5; ++r) red[(wave * 5 + r) * 64 + lane] = acc[r];
        __syncthreads();
        if (wave < 5) { float s = a.in[5][l * 6144 + n];
#pragma unroll
            for (int w = 0; w < 8; ++w) s += red[(w * 5 + wave) * 64 + lane];
            MODS[(size_t)(l * 5 + wave) * 6144 + n] = s; }
        __syncthreads();
    }
    LAS float* scr = (LAS float*)(lds + 32768 + wave * 8448);
    const int gw = blockIdx.x * 8 + wave, NGW = G * 8;
    bf16* WRKV = (bf16*)(ws + WS_WRKV); bf16* WOt = (bf16*)(ws + WS_WO); bf16* WINt = (bf16*)(ws + WS_WIN); bf16* WOUTt = (bf16*)(ws + WS_WOUT);
    bf16* WGU = (bf16*)(ws + WS_WGU); bf16* WDN = (bf16*)(ws + WS_WDN);
    constexpr int I_GU = 128 * 1024, I_DN = 128 * 512, I_RKV = 6 * 512, I_WO = 2 * 512, I_WIN = 2 * 1536, I_WOUT = 2 * 512, I_W1 = 4 * 32, I_A1 = 4 * 32, I_G1 = 2 * 64;
    constexpr int NITEMS = I_GU + I_DN + I_RKV + I_WO + I_WIN + I_WOUT + I_W1 + I_A1 + I_G1;
    for (int it = gw; it < NITEMS; it += NGW) {
        int r = it;
        if (r < I_GU) { const int m = r >> 10, q = r & 1023, kb = q >> 6, nb = q & 63;
            transpose_item(a.in[29] + (size_t)m * 1024 * 2048, 2048, WGU + (size_t)m * 2048 * 1024, 1024, gu_map(nb * 32), kb * 64, nb * 32, scr, lane); continue; } r -= I_GU;
        if (r < I_DN) { const int m = r >> 9, q = r & 511, kb = q >> 5, nb = q & 31;
            transpose_item(a.in[31] + (size_t)m * 1024 * 1024, 1024, WDN + (size_t)m * 1024 * 1024, 1024, nb * 32, kb * 64, nb * 32, scr, lane); continue; } r -= I_DN;
        if (r < I_RKV) { const int m = r >> 9, q = r & 511, kb = q >> 5, nb = q & 31, lr = m / 3, j = m % 3;
            transpose_item(a.in[9] + (size_t)m * 1024 * 1024, 1024, WRKV + (size_t)lr * 3840 * 1024, 1024, j * 1024 + nb * 32, kb * 64, nb * 32, scr, lane); continue; } r -= I_RKV;
        if (r < I_WO) { const int m = r >> 9, q = r & 511, kb = q >> 5, nb = q & 31;
            transpose_item(a.in[23] + (size_t)m * 1024 * 1024, 1024, WOt + (size_t)m * 1024 * 1024, 1024, nb * 32, kb * 64, nb * 32, scr, lane); continue; } r -= I_WO;
        if (r < I_WIN) { const int m = r / 1536, q = r % 1536, kb = q / 96, nb = q % 96;
            transpose_item(a.in[24] + (size_t)m * 1024 * 3072, 3072, WINt + (size_t)m * 3072 * 1024, 1024, conv_map(nb * 32), kb * 64, nb * 32, scr, lane); continue; } r -= I_WIN;
        if (r < I_WOUT) { const int m = r >> 9, q = r & 511, kb = q >> 5, nb = q & 31;
            transpose_item(a.in[26] + (size_t)m * 1024 * 1024, 1024, WOUTt + (size_t)m * 1024 * 1024, 1024, nb * 32, kb * 64, nb * 32, scr, lane); continue; } r -= I_WOUT;
        if (r < I_W1) { const int m = r >> 5, q = r & 31, kb = q >> 1, nb = q & 1, lr = m >> 1, e = m & 1;
            transpose_item(a.in[11] + (size_t)m * 1024 * 64, 64, WRKV + (size_t)lr * 3840 * 1024, 1024, 3072 + e * 64 + nb * 32, kb * 64, nb * 32, scr, lane); continue; } r -= I_W1;
        if (r < I_A1) { const int m = r >> 5, q = r & 31, kb = q >> 1, nb = q & 1, lr = m >> 1, e = m & 1;
            transpose_item(a.in[14] + (size_t)m * 1024 * 64, 64, WRKV + (size_t)lr * 3840 * 1024, 1024, 3328 + e * 64 + nb * 32, kb * 64, nb * 32, scr, lane); continue; } r -= I_A1;
        { const int m = r >> 6, q = r & 63, kb = q >> 2, nb = q & 3;
            transpose_item(a.in[16] + (size_t)m * 1024 * 128, 128, WRKV + (size_t)m * 3840 * 1024, 1024, 3584 + nb * 32, kb * 64, nb * 32, scr, lane); }
    }
    const int gt = blockIdx.x * 512 + tid, NGT = G * 512;
    for (int i = gt; i < 2 * 3 * 128 * 128; i += NGT) {
        const int pc = i & 127, rw = (i >> 7) & 127, pd = (i >> 14) % 3, lr = i / (3 * 16384);
        *(u32x4*)(WRKV + ((size_t)lr * 3840 + 3072 + pd * 256 + 128 + rw) * 1024 + pc * 8) = (u32x4){0u, 0u, 0u, 0u}; }
    bf16* L2T = (bf16*)(ws + WS_L2T);
    for (int i = gt; i < 2 * 128 * 5120; i += NGT) {
        const int n = i % 5120, k = (i / 5120) & 127, lr = i / (5120 * 128);
        float v = 0.f;
        if (n < 2048) { const int e = n >> 10, d = n & 1023; if ((k >> 6) == e) v = a.in[12][(((size_t)lr * 2 + e) * 64 + (k & 63)) * 1024 + d]; }
        else if (n < 4096) { const int e = (n - 2048) >> 10, d = n & 1023; if ((k >> 6) == e) v = a.in[15][(((size_t)lr * 2 + e) * 64 + (k & 63)) * 1024 + d]; }
        else { const int d = n - 4096; v = a.in[17][((size_t)lr * 128 + k) * 1024 + d]; }
        L2T[((size_t)lr * 5120 + n) * 128 + k] = (bf16)f2bf(v);
    }
    bf16* WRT = (bf16*)(ws + WS_WRT);
    for (int i = gt; i < 4 * 32 * 1024; i += NGT) { const int k = i & 1023, e = (i >> 10) & 31, l = i >> 15;
        const float w = a.in[27][((size_t)l * 1024 + k) * 32 + e]; const unsigned hi = f2bf(w); const float lo = w - bflo(hi);
        WRT[((size_t)(l * 2 + 0) * 32 + e) * 1024 + k] = (bf16)hi; WRT[((size_t)(l * 2 + 1) * 32 + e) * 1024 + k] = (bf16)f2bf(lo); }
}
#define XB_TMO      128
#define XB_XCNT(j)  (256  + 64 * (j))
#define XB_XSUB(j)  (1280 + 64 * (j))
#define XB_XGEN(j)  (2304 + 64 * (j))
#define XB_TOP      3328
#define XB_TOPGEN   3392
#define XCD_BAR_WORDS 3456
#define XB_SPIN_CAP (1u << 23)

__device__ __forceinline__ unsigned xb_ld(unsigned* p)              { return __hip_atomic_load(p, __ATOMIC_RELAXED, __HIP_MEMORY_SCOPE_AGENT); }
__device__ __forceinline__ unsigned xb_add(unsigned* p, unsigned v) { return __hip_atomic_fetch_add(p, v, __ATOMIC_RELAXED, __HIP_MEMORY_SCOPE_AGENT); }
__device__ __forceinline__ unsigned xb_xcc_id() { return (unsigned)__builtin_amdgcn_s_getreg((3 << 11) | 20) & 0xFu; }
#define XB_SPIN(cond, bar) do { unsigned _sp = 0; while (cond) { __builtin_amdgcn_s_sleep(1); \
    if ((++_sp & 255u) == 0u) { if (xb_ld(&(bar)[XB_TMO])) break; if (_sp > XB_SPIN_CAP) { atomicAdd(&(bar)[XB_TMO], 1u); break; } } } } while (0)

struct XcdBarrier {
    unsigned wv;
    unsigned* bar; unsigned x;
    volatile LAS unsigned* st;
};

__device__ __forceinline__ XcdBarrier xcd_barrier_post(unsigned* bar, volatile LAS unsigned* st) {
    XcdBarrier b; b.wv = (unsigned)__builtin_amdgcn_readfirstlane((int)(threadIdx.x >> 6)); b.bar = bar; b.x = xb_xcc_id(); b.st = st;
    if (threadIdx.x == 0) (void)xb_add(&bar[XB_XCNT(b.x)], 1u);
    return b;
}
__device__ __forceinline__ void xcd_barrier_complete(unsigned* bar, unsigned x, unsigned& nloc, unsigned& nx) {
    const unsigned G = gridDim.x * gridDim.y * gridDim.z;
    unsigned sum, cnt, mine, sp = 0u;
    for (;;) {
        sum = 0u; cnt = 0u; mine = 0u;
#pragma unroll
        for (unsigned j = 0; j < 16; ++j) { const unsigned c = xb_ld(&bar[XB_XCNT(j)]); sum += c; cnt += (c > 0u) ? 1u : 0u; mine = (j == x) ? c : mine; }
        if (sum == G) break;
        __builtin_amdgcn_s_sleep(1);
        if ((++sp & 255u) == 0u) { if (xb_ld(&bar[XB_TMO])) break; if (sp > XB_SPIN_CAP) { atomicAdd(&bar[XB_TMO], 1u); break; } }
    }
    nloc = mine > 0u ? mine : 1u; nx = cnt > 0u ? cnt : 1u;
}

__device__ __forceinline__ void xcd_barrier(const XcdBarrier& b) {
    asm volatile("s_waitcnt vmcnt(0)" ::: "memory");
    __syncthreads();
    if (b.wv == 0u && lane_id() == 0) {
        unsigned* bar = b.bar;
        __builtin_amdgcn_s_waitcnt(0);
        unsigned nloc = b.st[0], nx = b.st[1];
        if (nloc == 0u) { xcd_barrier_complete(bar, b.x, nloc, nx); b.st[0] = nloc; b.st[1] = nx; }
        const unsigned old = xb_add(&bar[XB_XSUB(b.x)], 1u);
        const unsigned gen = old / nloc;
        if (old + 1u == (gen + 1u) * nloc) {
            __builtin_amdgcn_fence(__ATOMIC_RELEASE, "agent");
            asm volatile("s_waitcnt vmcnt(0)" ::: "memory");
            const unsigned og = xb_add(&bar[XB_TOP], 1u);
            const unsigned tg = og / nx;
            if (og + 1u == (tg + 1u) * nx) xb_add(&bar[XB_TOPGEN], 1u);
            else XB_SPIN(xb_ld(&bar[XB_TOPGEN]) == tg, bar);
            __builtin_amdgcn_fence(__ATOMIC_ACQUIRE, "agent");
            xb_add(&bar[XB_XGEN(b.x)], 1u);
            asm volatile("s_waitcnt vmcnt(0)" ::: "memory");
        } else {
            XB_SPIN(xb_ld(&bar[XB_XGEN(b.x)]) == gen, bar);
            __builtin_amdgcn_fence(__ATOMIC_ACQUIRE, "agent");
            asm volatile("s_waitcnt vmcnt(0)" ::: "memory");
        }
    }
    __syncthreads();
}

__device__ __forceinline__ int mod_row(int row) { return row < TL ? (row >> 13) : 4; }

__device__ __forceinline__ void load_x_combined(f32x4 (&x)[4], const float* xrow, bool has_prev, const bf16* YS, int t, const f32x4 (&m5)[4], int lane) {
#pragma unroll
    for (int j = 0; j < 4; ++j) x[j] = *(const f32x4*)(xrow + 256 * j + 4 * lane);
    if (has_prev) {
        f32x4 s[4];
#pragma unroll
        for (int j = 0; j < 4; ++j) s[j] = (f32x4){0.f, 0.f, 0.f, 0.f};
#pragma unroll
        for (int k = 0; k < 4; ++k) { const bf16* yr = YS + ((size_t)t * 4 + k) * 1024;
#pragma unroll
            for (int j = 0; j < 4; ++j) { const u32x2 w = *(const u32x2*)(yr + 256 * j + 4 * lane); s[j] += (f32x4){bflo(w.x), bfhi(w.x), bflo(w.y), bfhi(w.y)}; } }
#pragma unroll
        for (int j = 0; j < 4; ++j) x[j] += m5[j] * s[j];
    }
}
__device__ __forceinline__ float row_rstd(const f32x4 (&x)[4]) {
    float ss = 0.f;
#pragma unroll
    for (int j = 0; j < 4; ++j) ss += (x[j].x * x[j].x + x[j].y * x[j].y) + (x[j].z * x[j].z + x[j].w * x[j].w);
    return rsqrtf(wave_sum(ss) * (1.0f / 1024.0f) + 1e-6f);
}

__device__ __forceinline__ void phase_a_rwkv(const Args& a, int layer, LAS unsigned char* lds, int tid, int gw, int NGW, int lane) {
    unsigned char* ws = a.ws; const int lj = layer >> 1; const bool has_prev = layer > 0;
    const float* xin_lat = layer == 0 ? a.in[0] : (const float*)(ws + WS_XSA);
    const float* xin_ctx = layer == 0 ? a.in[2] : (const float*)(ws + WS_XSA) + (size_t)TL * D;
    float* xout = (float*)(ws + (layer == 0 ? WS_XSA : WS_XSB));
    const float* MODS = (const float*)(ws + WS_MODS); const bf16* YS = (const bf16*)(ws + WS_YS); bf16* XL = (bf16*)(ws + WS_XL);
    const float* mug = a.in[8] + (size_t)lj * 6 * 2 * 1024; const float* ng = a.in[6] + (size_t)(layer * 2 + 0) * 1024;
    LAS float* mu = (LAS float*)lds;
    for (int i = tid; i < 6 * 2 * 1024 / 4; i += 512) ((LAS f32x4*)mu)[i] = ((const f32x4*)mug)[i];
    __syncthreads();
    for (int it = gw; it < TL / 8 + TC / 2; it += NGW) {
        const int ntok = it < TL / 8 ? 8 : 2, t0 = it < TL / 8 ? it * 8 : TL + (it - TL / 8) * 2, mr = mod_row(t0);
        int rs, re; if (t0 < TL) { rs = t0 & ~63; re = rs + 63; } else { const int loc = t0 - TL; rs = TL + (loc & ~255); re = rs + 255; }
        const float* mod = MODS + (size_t)(layer * 5 + mr) * 6144;
        const float* m5p = MODS + (size_t)((has_prev ? layer - 1 : 0) * 5 + mr) * 6144 + 5 * 1024;
        f32x4 hm[4], h0[4], hp[4];
#pragma unroll
        for (int j = 0; j < 4; ++j) { hm[j] = (f32x4){0.f, 0.f, 0.f, 0.f}; h0[j] = hm[j]; hp[j] = hm[j]; }
        f32x4 rx[4], nx[4]; u32x2 ry[4][4], ny[4][4];
#define PA_LOAD(X, Y, tt) do { const int t_ = (tt); if (t_ >= rs && t_ <= re) { \
            const float* xrow_ = t_ < TL ? xin_lat + (size_t)t_ * D : xin_ctx + (size_t)(t_ - TL) * D; \
            _Pragma("unroll") for (int j = 0; j < 4; ++j) X[j] = *(const f32x4*)(xrow_ + 256 * j + 4 * lane); \
            if (has_prev) { _Pragma("unroll") for (int k = 0; k < 4; ++k) _Pragma("unroll") for (int j = 0; j < 4; ++j) Y[k][j] = *(const u32x2*)(YS + ((size_t)t_ * 4 + k) * 1024 + 256 * j + 4 * lane); } } } while (0)
#pragma unroll
        for (int j = 0; j < 4; ++j) { rx[j] = (f32x4){0.f, 0.f, 0.f, 0.f}; nx[j] = rx[j];
#pragma unroll
            for (int k = 0; k < 4; ++k) { ry[k][j] = (u32x2){0u, 0u}; ny[k][j] = ry[k][j]; } }
        PA_LOAD(rx, ry, t0 - 1);
#pragma unroll 1
        for (int i = -1; i <= ntok; ++i) {
            const int t = t0 + i;
            if (i < ntok) PA_LOAD(nx, ny, t + 1);
            f32x4 hn[4];
            if (t >= rs && t <= re) {
                f32x4 x[4];
#pragma unroll
                for (int j = 0; j < 4; ++j) x[j] = rx[j];
                if (has_prev) {
#pragma unroll
                    for (int j = 0; j < 4; ++j) { f32x4 sm = (f32x4){0.f, 0.f, 0.f, 0.f};
#pragma unroll
                        for (int k = 0; k < 4; ++k) sm += (f32x4){bflo(ry[k][j].x), bfhi(ry[k][j].x), bflo(ry[k][j].y), bfhi(ry[k][j].y)};
                        x[j] += *(const f32x4*)(m5p + 256 * j + 4 * lane) * sm; } }
                if (i >= 0 && i < ntok) {
#pragma unroll
                    for (int j = 0; j < 4; ++j) *(f32x4*)(xout + (size_t)t * D + 256 * j + 4 * lane) = x[j]; }
                const float rstd = row_rstd(x);
#pragma unroll
                for (int j = 0; j < 4; ++j) { const int col = 256 * j + 4 * lane; hn[j] = x[j] * rstd * *(const f32x4*)(ng + col) * (*(const f32x4*)(mod + 1024 + col) + 1.0f) + *(const f32x4*)(mod + col); }
            } else {
#pragma unroll
                for (int j = 0; j < 4; ++j) hn[j] = (f32x4){0.f, 0.f, 0.f, 0.f};
            }
#pragma unroll
            for (int j = 0; j < 4; ++j) { hm[j] = h0[j]; h0[j] = hp[j]; hp[j] = hn[j]; rx[j] = nx[j];
#pragma unroll
                for (int k = 0; k < 4; ++k) ry[k][j] = ny[k][j]; }
            if (i >= 1) {
                const int te = t - 1;
#pragma unroll
                for (int q = 0; q < 6; ++q) {
                    bf16* orow = XL + ((size_t)q * T + te) * D;
#pragma unroll
                    for (int j = 0; j < 4; ++j) { const int col = 256 * j + 4 * lane;
                        const f32x4 m0 = *(const LAS f32x4*)(mu + (q * 2 + 0) * 1024 + col), m1 = *(const LAS f32x4*)(mu + (q * 2 + 1) * 1024 + col);
                        const f32x4 o = h0[j] + m0 * (hm[j] - h0[j]) + m1 * (hp[j] - h0[j]);
                        u32x2 w; w.x = pk2(o.x, o.y); w.y = pk2(o.z, o.w); *(u32x2*)(orow + col) = w; }
                }
            }
        }
#undef PA_LOAD
    }
}
__device__ __forceinline__ void phase_a_conv(const Args& a, int layer, int rows, int gw, int NGW, int lane) {
    unsigned char* ws = a.ws;
    float* xs = (float*)(ws + (layer < 2 ? WS_XSA : WS_XSB));
    const float* MODS = (const float*)(ws + WS_MODS); const bf16* YS = (const bf16*)(ws + WS_YS); bf16* H = (bf16*)(ws + WS_XL);
    const float* ng = a.in[6] + (size_t)(layer * 2 + 0) * 1024;
    for (int t = gw; t < rows; t += NGW) {
        const int mr = mod_row(t);
        const float* mod = MODS + (size_t)(layer * 5 + mr) * 6144;
        f32x4 m5[4], x[4];
#pragma unroll
        for (int j = 0; j < 4; ++j) m5[j] = *(const f32x4*)(MODS + (size_t)((layer - 1) * 5 + mr) * 6144 + 5 * 1024 + 256 * j + 4 * lane);
        load_x_combined(x, xs + (size_t)t * D, true, YS, t, m5, lane);
        const float rstd = row_rstd(x);
#pragma unroll
        for (int j = 0; j < 4; ++j) { const int col = 256 * j + 4 * lane;
            *(f32x4*)(xs + (size_t)t * D + col) = x[j];
            const f32x4 h = x[j] * rstd * *(const f32x4*)(ng + col) * (*(const f32x4*)(mod + 1024 + col) + 1.0f) + *(const f32x4*)(mod + col);
            u32x2 w; w.x = pk2(h.x, h.y); w.y = pk2(h.z, h.w); *(u32x2*)(H + (size_t)t * D + col) = w; }
    }
}
#define DPPF(x, ctrl) __builtin_bit_cast(float, __builtin_amdgcn_update_dpp(0, __builtin_bit_cast(int, (x)), (ctrl), 0xf, 0xf, false))
__device__ __forceinline__ float row16_sum(float v) { v += DPPF(v, 0xB1); v += DPPF(v, 0x4E); v += DPPF(v, 0x141); v += DPPF(v, 0x140); return v; }
__device__ __forceinline__ f32x4 bf4(u32x2 w) { return (f32x4){bflo(w.x), bfhi(w.x), bflo(w.y), bfhi(w.y)}; }
__device__ __forceinline__ u32x2 pk4(f32x4 v) { u32x2 w; w.x = pk2(v[0], v[1]); w.y = pk2(v[2], v[3]); return w; }
__device__ __forceinline__ void phase_c_prep(const Args& a, int lj, LAS unsigned char* lds, int tid, int gw, int NGW, int lane) {
    unsigned char* ws = a.ws;
    const bf16* Rr = (const bf16*)(ws + WS_RKV); const bf16* Kk = Rr + (size_t)T * D; const bf16* RA = (const bf16*)(ws + WS_RAWA); const bf16* RW = (const bf16*)(ws + WS_RAWW);
    bf16* KK = (bf16*)(ws + WS_KK); bf16* KD = (bf16*)(ws + WS_KD); bf16* BE = (bf16*)(ws + WS_BETA); float* RKB = (float*)(ws + WS_RKB);
    LAS float* tb = (LAS float*)lds;
    for (int i = tid; i < 7 * 256; i += 512) { const int t7 = i >> 8, q = i & 255;
        const float* src = t7 == 0 ? a.in[18] + lj * 1024 : t7 == 1 ? a.in[19] + lj * 1024 : t7 == 2 ? a.in[20] + lj * 1024 : t7 < 5 ? a.in[10] + lj * 2048 + (t7 - 3) * 1024 : a.in[13] + lj * 2048 + (t7 - 5) * 1024;
        ((LAS f32x4*)tb)[i] = ((const f32x4*)src)[q]; }
    __syncthreads();
    for (int row = gw; row < T; row += NGW) {
#pragma unroll
        for (int j = 0; j < 4; ++j) {
            const int col = 256 * j + 4 * lane; const size_t ro = (size_t)row * D + col;
            const f32x4 k = bf4(*(const u32x2*)(Kk + ro)), r = bf4(*(const u32x2*)(Rr + ro));
            f32x4 a0 = bf4(*(const u32x2*)(RA + ro)) + *(const LAS f32x4*)(tb + 5 * 1024 + col), a1 = bf4(*(const u32x2*)(RA + (size_t)T * D + ro)) + *(const LAS f32x4*)(tb + 6 * 1024 + col);
#pragma unroll
            for (int z = 0; z < 4; ++z) { a0[z] = sigm(a0[z]); a1[z] = sigm(a1[z]); }
            const f32x4 ck = *(const LAS f32x4*)(tb + col), ca = *(const LAS f32x4*)(tb + 1024 + col), cr = *(const LAS f32x4*)(tb + 2048 + col);
            const f32x4 kk = k * ck;
            const float ss = row16_sum((kk.x * kk.x + kk.y * kk.y) + (kk.z * kk.z + kk.w * kk.w));
            const f32x4 kd0 = k * ((a0 - 1.0f) * ca + 1.0f), kd1 = k * ((a1 - 1.0f) * ca + 1.0f);
            *(u32x2*)(KD + ro) = pk4(kd0); *(u32x2*)(KD + (size_t)T * D + ro) = pk4(kd1);
            const f32x4 p = r * (kd0 + kd1) * cr;
            const float rk = row16_sum((p.x + p.y) + (p.z + p.w));
            const f32x4 kkn = kk * (1.0f / fmaxf(sqrtf(ss), 1e-12f));
            *(u32x2*)(KK + ro) = pk4(kkn); *(u32x2*)(BE + ro) = pk4(kkn * a0); *(u32x2*)(BE + (size_t)T * D + ro) = pk4(kkn * a1);
            if ((lane & 15) == 0) RKB[(size_t)row * 16 + 4 * j + (lane >> 4)] = rk;
        }
    }
}
typedef short bf16x8 __attribute__((ext_vector_type(8)));
__device__ __forceinline__ f32x4 mfma16(bf16x8 a, bf16x8 b, f32x4 c) { return __builtin_amdgcn_mfma_f32_16x16x32_bf16(a, b, c, 0, 0, 0); }
__device__ __forceinline__ bf16x8 as_frag(u32x4 w) { return __builtin_bit_cast(bf16x8, w); }
constexpr int CH_LD = 144;
constexpr int CH_MS = 64 * CH_LD;
constexpr int CH_AB = 0 * CH_MS, CH_KT = 1 * CH_MS, CH_BT = 2 * CH_MS, CH_RB = 3 * CH_MS, CH_VT = 4 * CH_MS, CH_ABT = 5 * CH_MS, CH_KHT = 6 * CH_MS, CH_BHT = 7 * CH_MS,
              CH_LK = 8 * CH_MS, CH_LB = 9 * CH_MS, CH_MK = 10 * CH_MS, CH_MB = 11 * CH_MS, CH_WT = 12 * CH_MS, CH_U0 = 13 * CH_MS, CH_DINV = 14 * CH_MS;
constexpr int CH_GC = LDSCTL_OFF + 2048;
constexpr int CH_PART = LDSCTL_OFF + 4096;
constexpr int NCHUNK = NSTEP / 64;
#ifndef S1_DBL
#define S1_DBL 0
#endif
static_assert(CH_DINV + 2048 <= RING_BYTES, "chunk LDS map");

__device__ __forceinline__ int scan_row(int s, int dir, int b) {
    if (s < CTXL) return TL + b * CTXL + (dir ? CTXL - 1 - s : s);
    const int i = s - CTXL; return b * SEQ + (dir ? SEQ - 1 - i : i);
}
#define CH_FRAG(mat, row, ks, kg) as_frag(*(const LAS u32x4*)(lds + (mat) + (row) * CH_LD + ((ks) * 32 + (kg) * 8) * 2))

__device__ __forceinline__ float s1_treduce16(const float (&a)[16], bool b3, bool b2) {
    float b[8];
#pragma unroll
    for (int i = 0; i < 8; ++i) { float x = a[i], y = a[i + 8];
        asm("s_nop 1\n\tv_permlane32_swap_b32 %0, %1" : "+v"(x), "+v"(y));
        b[i] = x + y; }
    float c[4];
#pragma unroll
    for (int i = 0; i < 4; ++i) { float x = b[i], y = b[i + 4];
        asm("s_nop 1\n\tv_permlane16_swap_b32 %0, %1" : "+v"(x), "+v"(y));
        c[i] = x + y; }
    float d[2];
#pragma unroll
    for (int i = 0; i < 2; ++i) { const float keep = b3 ? c[i + 2] : c[i], send = b3 ? c[i] : c[i + 2]; d[i] = keep + DPPF(send, 0x128); }
    const float keep = b2 ? d[1] : d[0], send = b2 ? d[0] : d[1];
    float e = keep + DPPF(send, 0x141);
    e += DPPF(e, 0xB1);
    e += DPPF(e, 0x4E);
    return e;
}
#define S1_BAR() do { asm volatile("s_waitcnt lgkmcnt(0)" ::: "memory"); __builtin_amdgcn_s_barrier(); asm volatile("" ::: "memory"); } while (0)
__device__ __forceinline__ void phase_s1_chunks(const Args& a, int lj, LAS unsigned char* lds, int tid, int G, int rh_scratch = 0) {
    unsigned char* ws = a.ws; const float* w0l = a.in[10] + lj * 2048; const float* a0l = a.in[13] + lj * 2048;
    const float* pkk = a.in[18] + lj * 1024; const float* pka = a.in[19] + lj * 1024; const float* prk = a.in[20] + lj * 1024;
    const int lane = tid & 63, wave = __builtin_amdgcn_readfirstlane(tid >> 6), l15 = lane & 15, g = lane >> 4;
    LAS float* part = (LAS float*)(lds + CH_PART); LAS float* gammaC = (LAS float*)(lds + CH_GC);
    float nlw[8], nka[8], nkr[8], nrr[8], nvv[8], nw0 = 0.f, na0 = 0.f, npkk = 0.f, npka = 0.f, nprk = 0.f;
#define S1_LOAD(ctx_) do { unsigned char* wsl = ws; asm volatile("" : "+s"(wsl));     \
        const int chain_ = (ctx_) / NCHUNK, c_ = (ctx_) - chain_ * NCHUNK, dir_ = chain_ >> 6, b_ = (chain_ >> 4) & 3, h_ = chain_ & 15; \
          \
        const long o0 = (long)scan_row(64 * c_ + 8 * wave, dir_, b_) * D + h_ * 64 + lane, od = (long)dir_ * T * D, st = dir_ ? -(long)D : (long)D; \
        const bf16* LWp = (const bf16*)(wsl + WS_RAWW) + od + o0; const bf16* RAp = (const bf16*)(wsl + WS_RAWA) + od + o0; \
        const bf16* Rp = (const bf16*)(wsl + WS_RKV) + o0; const bf16* Kp = Rp + (size_t)T * D; const bf16* Vp = Rp + (size_t)2 * T * D; \
        nw0 = w0l[dir_ * 1024 + h_ * 64 + lane]; na0 = a0l[dir_ * 1024 + h_ * 64 + lane]; npkk = pkk[h_ * 64 + lane]; npka = pka[h_ * 64 + lane]; nprk = prk[h_ * 64 + lane]; \
        _Pragma("unroll") for (int j = 0; j < 8; ++j) { const long oj = st * j; \
            nlw[j] = bflo((unsigned)LWp[oj]); nka[j] = bflo((unsigned)RAp[oj]); nkr[j] = bflo((unsigned)Kp[oj]); nrr[j] = bflo((unsigned)Rp[oj]); nvv[j] = bflo((unsigned)Vp[oj]); } } while (0)
    if ((int)blockIdx.x < 128 * NCHUNK) S1_LOAD((int)blockIdx.x);
    for (int ct = blockIdx.x; ct < 128 * NCHUNK; ct += G) {
        const int chain = ct / NCHUNK, c = ct - chain * NCHUNK, dir = chain >> 6, b = (chain >> 4) & 3, h = chain & 15;
        unsigned zq = 0u; asm volatile("" : "+v"(zq));
        {
            const int k = lane, tq = wave;
            float lw[8], kd[8], be[8], kk[8], rr[8], vv[8];
            {
                const float w0k = nw0, a0k = na0, ckk = npkk, cka = npka, crk = nprk;
                float* RKBd = (float*)(ws + (dir ? WS_RKB1 : WS_RKB));
                const int row0 = scan_row(64 * c + 8 * tq, dir, b), rst = dir ? -1 : 1;
                float av[8], kq[8], red[16];
#pragma unroll
                for (int j = 0; j < 8; ++j) { av[j] = sigm(nka[j] + a0k); const float kr = nkr[j];
                    lw[j] = -0.60653066f * sigm(nlw[j] + w0k);
                    kq[j] = kr * ckk; kd[j] = kr * ((av[j] - 1.0f) * cka + 1.0f); rr[j] = nrr[j]; vv[j] = nvv[j];
                    red[2 * j] = kq[j] * kq[j]; red[2 * j + 1] = rr[j] * kd[j] * crk; }
                const float tot = s1_treduce16(red, (lane & 8) != 0, (lane & 4) != 0);
                if ((lane & 7) == 4) RKBd[(size_t)(row0 + rst * (lane >> 3)) * 16 + h] = tot;
#pragma unroll
                for (int j = 0; j < 8; ++j) { const float ss = __builtin_bit_cast(float, __builtin_amdgcn_readlane(__builtin_bit_cast(int, tot), 8 * j));
                    kk[j] = kq[j] * (1.0f / fmaxf(sqrtf(ss), 1e-12f)); be[j] = kk[j] * av[j]; }
            }
            if (ct + G < 128 * NCHUNK) S1_LOAD(ct + G);
            for (int r0_ = 0; r0_ <= ((S1_DBL >> 3) & 1); ++r0_) { if (r0_) S1_BAR();
            float p[8]; p[0] = lw[0];
#pragma unroll
            for (int j = 1; j < 8; ++j) p[j] = p[j - 1] + lw[j];
            part[tq * 64 + k] = p[7];
            S1_BAR();
            float off = 0.f, tot = 0.f;
#pragma unroll
            for (int q = 0; q < 8; ++q) { const float pv = part[q * 64 + k]; tot += pv; off += q < tq ? pv : 0.f; }
            const float eTot = __expf(tot); float ePrev = __expf(off);
            if (tq == 0) gammaC[k] = eTot;
            unsigned abw[4], khw[4], bhw[4], vw[4];
#pragma unroll
            for (int j = 0; j < 8; j += 2) {
                float ab2[2], kt2[2], bt2[2], rb2[2], kh2[2], bh2[2];
#pragma unroll
                for (int z = 0; z < 2; ++z) { const float cu = off + p[j + z]; const float eP = __expf(cu), eM = __expf(-cu), eC = eTot * eM;
                    ab2[z] = kk[j + z] * ePrev; ePrev = eP; kt2[z] = kd[j + z] * eM; bt2[z] = be[j + z] * eM; rb2[z] = rr[j + z] * eP; kh2[z] = kd[j + z] * eC; bh2[z] = be[j + z] * eC;
                    const int t = 8 * tq + j + z;
                    *(LAS bf16*)(lds + CH_AB + t * CH_LD + k * 2) = (bf16)f2bf(ab2[z]); *(LAS bf16*)(lds + CH_KT + t * CH_LD + k * 2) = (bf16)f2bf(kt2[z]);
                    *(LAS bf16*)(lds + CH_BT + t * CH_LD + k * 2) = (bf16)f2bf(bt2[z]); *(LAS bf16*)(lds + CH_RB + t * CH_LD + k * 2) = (bf16)f2bf(rb2[z]); }
                abw[j >> 1] = pk2(ab2[0], ab2[1]); khw[j >> 1] = pk2(kh2[0], kh2[1]); bhw[j >> 1] = pk2(bh2[0], bh2[1]); vw[j >> 1] = pk2(vv[j], vv[j + 1]);
            }
            *(LAS u32x4*)(lds + CH_ABT + k * CH_LD + tq * 16) = (u32x4){abw[0], abw[1], abw[2], abw[3]};
            *(LAS u32x4*)(lds + CH_KHT + k * CH_LD + tq * 16) = (u32x4){khw[0], khw[1], khw[2], khw[3]};
            *(LAS u32x4*)(lds + CH_BHT + k * CH_LD + tq * 16) = (u32x4){bhw[0], bhw[1], bhw[2], bhw[3]};
            *(LAS u32x4*)(lds + CH_VT + k * CH_LD + tq * 16) = (u32x4){vw[0], vw[1], vw[2], vw[3]};
            *(LAS u32x4*)(lds + CH_WT + k * CH_LD + tq * 16) = (u32x4){zq, zq, zq, zq}; *(LAS u32x4*)(lds + CH_U0 + k * CH_LD + tq * 16) = (u32x4){zq, zq, zq, zq};
            }
        }
        S1_BAR();
        for (int r1_ = 0; r1_ <= (S1_DBL & 1); ++r1_) { if (r1_) S1_BAR();
            const int mi = wave >> 1, half = wave & 1;
            const int matS = (mi & 1) ? CH_BT : CH_KT, matT = (mi & 2) ? CH_RB : CH_AB, matO = CH_LK + mi * CH_MS;
            const bool incl = (mi & 2) != 0;
            bf16x8 fs[4][2], ft[2][2];
#pragma unroll
            for (int ms = 0; ms < 4; ++ms)
#pragma unroll
                for (int ks = 0; ks < 2; ++ks) fs[ms][ks] = CH_FRAG(matS, 16 * ms + l15, ks, g);
#pragma unroll
            for (int nt = 0; nt < 2; ++nt)
#pragma unroll
                for (int ks = 0; ks < 2; ++ks) ft[nt][ks] = CH_FRAG(matT, 32 * half + 16 * nt + l15, ks, g);
#pragma unroll
            for (int nt = 0; nt < 2; ++nt) { const int t = 32 * half + 16 * nt + l15;
#pragma unroll
                for (int ms = 0; ms < 4; ++ms) { f32x4 d = (f32x4){0.f, 0.f, 0.f, 0.f};
                    d = mfma16(fs[ms][0], ft[nt][0], d); d = mfma16(fs[ms][1], ft[nt][1], d);
                    const int s0 = 16 * ms + 4 * g;
#pragma unroll
                    for (int i = 0; i < 4; ++i) { const bool keep = incl ? (s0 + i <= t) : (s0 + i < t); d[i] = keep ? d[i] : __builtin_bit_cast(float, zq); }
                    u32x2 w; w.x = pk2(d[0], d[1]); w.y = pk2(d[2], d[3]);
                    *(LAS u32x2*)(lds + matO + t * CH_LD + s0 * 2) = w; } }
        }
        S1_BAR();
        f32x4 rhsU[4];
#pragma unroll
        for (int I = 0; I < 4; ++I) rhsU[I] = (f32x4){0.f, 0.f, 0.f, 0.f};
        if (wave >= 4) {
            const int ctv = (wave & 3) * 16;
            const bf16x8 fv0 = CH_FRAG(CH_VT, ctv + l15, 0, g), fv1 = CH_FRAG(CH_VT, ctv + l15, 1, g);
#pragma unroll
            for (int I = 0; I < 4; ++I) { f32x4 d = (f32x4){0.f, 0.f, 0.f, 0.f};
                d = mfma16(CH_FRAG(CH_LK, 16 * I + l15, 0, g), fv0, d); d = mfma16(CH_FRAG(CH_LK, 16 * I + l15, 1, g), fv1, d); rhsU[I] = -d; }
        }
        for (int r2_ = 0; r2_ <= ((S1_DBL >> 1) & 1); ++r2_) if (wave == 0) {
            const int bb = lane >> 4, j = lane & 15;
            float x[16];
#pragma unroll
            for (int t = 0; t < 16; ++t) {
                const u32x4 r0 = *(const LAS u32x4*)(lds + CH_LB + (16 * bb + t) * CH_LD + 32 * bb), r1 = *(const LAS u32x4*)(lds + CH_LB + (16 * bb + t) * CH_LD + 32 * bb + 16);
                const unsigned rw[8] = {r0.x, r0.y, r0.z, r0.w, r1.x, r1.y, r1.z, r1.w};
                float acc = (t == j) ? 1.0f : 0.0f;
#pragma unroll
                for (int s = 0; s < t; ++s) { const float lv = (s & 1) ? bfhi(rw[s >> 1]) : bflo(rw[s >> 1]); acc -= lv * x[s]; }
                x[t] = acc;
                *(LAS bf16*)(lds + CH_DINV + ((bb * 16 + t) * 16 + j) * 2) = (bf16)f2bf(acc);
            }
        }
        S1_BAR();
        {
            const int matZ = wave < 4 ? CH_WT : CH_U0, ct16 = (wave & 3) * 16;
            for (int r4_ = 0; r4_ <= ((S1_DBL >> 4) & 1); ++r4_) { if (r4_) { *(LAS u32x4*)(lds + matZ + (ct16 + l15) * CH_LD + g * 32) = (u32x4){zq, zq, zq, zq}; *(LAS u32x4*)(lds + matZ + (ct16 + l15) * CH_LD + g * 32 + 16) = (u32x4){zq, zq, zq, zq}; LDS_WAIT(); }
#pragma unroll
            for (int I = 0; I < 4; ++I) {
                f32x4 rhs;
                if (wave < 4) { const u32x2 w = *(const LAS u32x2*)(lds + CH_ABT + (ct16 + l15) * CH_LD + (16 * I + 4 * g) * 2); rhs = (f32x4){bflo(w.x), bfhi(w.x), bflo(w.y), bfhi(w.y)}; }
                else rhs = rhsU[I];
                f32x4 d = (f32x4){0.f, 0.f, 0.f, 0.f};
                d = mfma16(CH_FRAG(CH_LB, 16 * I + l15, 0, g), CH_FRAG(matZ, ct16 + l15, 0, g), d); d = mfma16(CH_FRAG(CH_LB, 16 * I + l15, 1, g), CH_FRAG(matZ, ct16 + l15, 1, g), d);
                const f32x4 ac = rhs - d;
                const u32x2 dv = *(const LAS u32x2*)(lds + CH_DINV + ((I * 16 + l15) * 16 + 4 * g) * 2);
                const bf16x8 fa = as_frag((u32x4){dv.x, dv.y, zq, zq}), fb = as_frag((u32x4){pk2(ac[0], ac[1]), pk2(ac[2], ac[3]), zq, zq});
                const f32x4 z = mfma16(fa, fb, (f32x4){0.f, 0.f, 0.f, 0.f});
                u32x2 w; w.x = pk2(z[0], z[1]); w.y = pk2(z[2], z[3]);
                *(LAS u32x2*)(lds + matZ + (ct16 + l15) * CH_LD + (16 * I + 4 * g) * 2) = w;
                LDS_WAIT(); asm volatile("" ::: "memory");
            }
            }
        }
        S1_BAR();
        for (int r3_ = 0; r3_ <= ((S1_DBL >> 2) & 1); ++r3_) { if (r3_) S1_BAR();
            const int rt = wave >> 1, cp = (wave & 1) * 2;
            unsigned char* wsl = ws; asm volatile("" : "+s"(wsl));
            bf16* YL = (bf16*)(wsl + WS_Y); bf16* RH = (bf16*)(wsl + (rh_scratch ? WS_BETA + RF : WS_RH)); bf16* PM = (bf16*)(wsl + WS_PM); bf16* QT = (bf16*)(wsl + WS_QT);
            const int trow = scan_row(64 * c + 16 * rt + l15, dir, b);
#pragma unroll
            for (int q = 0; q < 2; ++q) { const int vt = cp + q; f32x4 d = (f32x4){0.f, 0.f, 0.f, 0.f};
#pragma unroll
                for (int ks = 0; ks < 2; ++ks) { d = mfma16(CH_FRAG(CH_VT, 16 * vt + l15, ks, g), CH_FRAG(CH_MK, 16 * rt + l15, ks, g), d); d = mfma16(CH_FRAG(CH_U0, 16 * vt + l15, ks, g), CH_FRAG(CH_MB, 16 * rt + l15, ks, g), d); }
                *(u32x2*)(YL + ((size_t)dir * T + trow) * D + h * 64 + 16 * vt + 4 * g) = pk4(d); }
#pragma unroll
            for (int q = 0; q < 2; ++q) { const int kt = cp + q; f32x4 d = (f32x4){0.f, 0.f, 0.f, 0.f};
#pragma unroll
                for (int ks = 0; ks < 2; ++ks) d = mfma16(CH_FRAG(CH_WT, 16 * kt + l15, ks, g), CH_FRAG(CH_MB, 16 * rt + l15, ks, g), d);
                const u32x2 rbw = *(const LAS u32x2*)(lds + CH_RB + (16 * rt + l15) * CH_LD + (16 * kt + 4 * g) * 2);
                u32x2 w; w.x = pk2(bflo(rbw.x) - d[0], bfhi(rbw.x) - d[1]); w.y = pk2(bflo(rbw.y) - d[2], bfhi(rbw.y) - d[3]);
                *(u32x2*)(RH + ((size_t)dir * T + trow) * D + h * 64 + 16 * kt + 4 * g) = w; }
            bf16* Pc = PM + ((size_t)chain * NCHUNK + c) * 4096; bf16* Qc = QT + ((size_t)chain * NCHUNK + c) * 4096;
            { const int krow = 16 * rt + l15; const float gc = gammaC[krow];
#pragma unroll
                for (int q = 0; q < 2; ++q) { const int kt = cp + q; f32x4 d = (f32x4){0.f, 0.f, 0.f, 0.f};
#pragma unroll
                    for (int ks = 0; ks < 2; ++ks) d = mfma16(CH_FRAG(CH_WT, 16 * kt + l15, ks, g), CH_FRAG(CH_BHT, krow, ks, g), d);
                    const int k0 = 16 * kt + 4 * g; f32x4 o;
#pragma unroll
                    for (int i = 0; i < 4; ++i) o[i] = ((k0 + i == krow) ? gc : 0.f) - d[i];
                    u32x2 w; w.x = pk2(o[0], o[1]); w.y = pk2(o[2], o[3]);
                    *(u32x2*)(Pc + krow * 64 + 32 * (kt >> 1) + 8 * g + 4 * (kt & 1)) = w; } }
            { const int vrow = 16 * rt + l15;
#pragma unroll
                for (int q = 0; q < 2; ++q) { const int kt = cp + q; f32x4 d = (f32x4){0.f, 0.f, 0.f, 0.f};
#pragma unroll
                    for (int ks = 0; ks < 2; ++ks) { d = mfma16(CH_FRAG(CH_KHT, 16 * kt + l15, ks, g), CH_FRAG(CH_VT, vrow, ks, g), d); d = mfma16(CH_FRAG(CH_BHT, 16 * kt + l15, ks, g), CH_FRAG(CH_U0, vrow, ks, g), d); }
                    u32x2 w; w.x = pk2(d[0], d[1]); w.y = pk2(d[2], d[3]);
                    *(u32x2*)(Qc + vrow * 64 + 16 * g + 4 * kt) = w; } }
        }
        S1_BAR();
    }
}

struct S2Set { u32x4 p[4][2]; u32x4 q[2]; };
__device__ __forceinline__ void s2_load(S2Set& s, const bf16* Pc, const bf16* Qc, int vt, int l15, int g) {
    s.q[0] = *(const u32x4*)(Qc + (16 * vt + l15) * 64 + 16 * g); s.q[1] = *(const u32x4*)(Qc + (16 * vt + l15) * 64 + 16 * g + 8);
#pragma unroll
    for (int m = 0; m < 4; ++m)
#pragma unroll
        for (int j = 0; j < 2; ++j) s.p[m][j] = *(const u32x4*)(Pc + (16 * m + l15) * 64 + 32 * j + 8 * g);
}
__device__ __forceinline__ void s2_step(f32x4 (&acc)[4], const S2Set& s, bf16* Hc, int g) {
    unsigned hw[4][2];
#pragma unroll
    for (int m = 0; m < 4; ++m) { hw[m][0] = pk2(acc[m][0], acc[m][1]); hw[m][1] = pk2(acc[m][2], acc[m][3]); }
#pragma unroll
    for (int m = 0; m < 4; ++m) *(u32x2*)(Hc + 16 * m + 4 * g) = (u32x2){hw[m][0], hw[m][1]};
    const bf16x8 hb0 = as_frag((u32x4){hw[0][0], hw[0][1], hw[1][0], hw[1][1]}), hb1 = as_frag((u32x4){hw[2][0], hw[2][1], hw[3][0], hw[3][1]});
#pragma unroll
    for (int m = 0; m < 4; ++m) {
        const unsigned q0 = (m & 2) ? ((m & 1) ? s.q[1].z : s.q[1].x) : ((m & 1) ? s.q[0].z : s.q[0].x), q1 = (m & 2) ? ((m & 1) ? s.q[1].w : s.q[1].y) : ((m & 1) ? s.q[0].w : s.q[0].y);
        f32x4 d = (f32x4){bflo(q0), bfhi(q0), bflo(q1), bfhi(q1)};
        d = mfma16(as_frag(s.p[m][0]), hb0, d);
        d = mfma16(as_frag(s.p[m][1]), hb1, d);
        acc[m] = d;
    }
}
__device__ __forceinline__ void phase_s2_chain(const Args& a, int wave, int lane, int G) {
    unsigned char* ws = a.ws;
    const bf16* PM = (const bf16*)(ws + WS_PM); const bf16* QT = (const bf16*)(ws + WS_QT); bf16* HT = (bf16*)(ws + WS_HT);
    const int l15 = lane & 15, g = lane >> 4;
    if (wave >= 2) return;
    static_assert(NCHUNK % 4 == 0, "S2 ring");
    for (int wt = blockIdx.x * 2 + wave; wt < 512; wt += G * 2) {
        const int chain = wt >> 2, vt = wt & 3;
        f32x4 acc[4];
#pragma unroll
        for (int m = 0; m < 4; ++m) acc[m] = (f32x4){0.f, 0.f, 0.f, 0.f};
        const bf16* Pc = PM + (size_t)chain * NCHUNK * 4096; const bf16* Qc = QT + (size_t)chain * NCHUNK * 4096;
        bf16* Hc = HT + (size_t)chain * NCHUNK * 4096 + (16 * vt + l15) * 64;
        S2Set s0, s1, s2, s3;
        s2_load(s0, Pc, Qc, vt, l15, g); s2_load(s1, Pc + 4096, Qc + 4096, vt, l15, g); s2_load(s2, Pc + 2 * 4096, Qc + 2 * 4096, vt, l15, g); s2_load(s3, Pc + 3 * 4096, Qc + 3 * 4096, vt, l15, g);
#pragma unroll 1
        for (int c = 0; c < NCHUNK; c += 4) {
            const int cn = c + 4 < NCHUNK ? c + 4 : c;
            const bf16* Pn = Pc + (size_t)cn * 4096; const bf16* Qn = Qc + (size_t)cn * 4096;
            s2_step(acc, s0, Hc + (size_t)c * 4096, g);       s2_load(s0, Pn, Qn, vt, l15, g);
            s2_step(acc, s1, Hc + (size_t)(c + 1) * 4096, g); s2_load(s1, Pn + 4096, Qn + 4096, vt, l15, g);
            s2_step(acc, s2, Hc + (size_t)(c + 2) * 4096, g); s2_load(s2, Pn + 2 * 4096, Qn + 2 * 4096, vt, l15, g);
            s2_step(acc, s3, Hc + (size_t)(c + 3) * 4096, g); s2_load(s3, Pn + 3 * 4096, Qn + 3 * 4096, vt, l15, g);
        }
    }
}

__device__ __forceinline__ void phase_s3_readout(const Args& a, int lj, int nrows, int gw, int NGW, int lane) {
    unsigned char* ws = a.ws;
    const bf16* YL = (const bf16*)(ws + WS_Y); const bf16* RH = (const bf16*)(ws + WS_RH); const bf16* HT = (const bf16*)(ws + WS_HT);
    const bf16* Vv = (const bf16*)(ws + WS_RKV) + (size_t)2 * T * D; const float* RKB = (const float*)(ws + WS_RKB); const float* RKB1 = (const float*)(ws + WS_RKB1); const bf16* Gg = (const bf16*)(ws + WS_G); bf16* Z = (bf16*)(ws + WS_Z);
    const float* lng = a.in[21] + lj * 1024; const float* lnb = a.in[22] + lj * 1024;
    const int l15 = lane & 15, g = lane >> 4;
    for (int task = gw; task < (nrows / 16) * 16; task += NGW) {
        const int tt = task >> 4, h = task & 15, r0 = tt * 16, row = r0 + l15;
        int b, cc[2];
        if (r0 < TL) { b = r0 >> 13; const int tb = (r0 & (SEQ - 1)) >> 6; cc[0] = 4 + tb; cc[1] = 4 + (127 - tb); }
        else { const int loc = r0 - TL; b = loc >> 8; const int tb = (loc & 255) >> 6; cc[0] = tb; cc[1] = 3 - tb; }
        f32x4 acc[4];
        const size_t ro = (size_t)row * D + h * 64 + 4 * g;
#pragma unroll
        for (int vt = 0; vt < 4; ++vt) acc[vt] = bf4(*(const u32x2*)(YL + ro + 16 * vt)) + bf4(*(const u32x2*)(YL + (size_t)T * D + ro + 16 * vt));
#pragma unroll
        for (int dir = 0; dir < 2; ++dir) {
            const int chain = dir * 64 + b * 16 + h;
            const bf16* rh = RH + ((size_t)dir * T + row) * D + h * 64 + 8 * g;
            const bf16x8 f0 = as_frag(*(const u32x4*)(rh)), f1 = as_frag(*(const u32x4*)(rh + 32));
            const bf16* hc = HT + ((size_t)chain * NCHUNK + cc[dir]) * 4096;
#pragma unroll
            for (int vt = 0; vt < 4; ++vt) { const bf16* hr = hc + (16 * vt + l15) * 64 + 8 * g;
                acc[vt] = mfma16(as_frag(*(const u32x4*)(hr)), f0, acc[vt]); acc[vt] = mfma16(as_frag(*(const u32x4*)(hr + 32)), f1, acc[vt]); }
        }
        float s = 0.f;
#pragma unroll
        for (int vt = 0; vt < 4; ++vt) s += (acc[vt][0] + acc[vt][1]) + (acc[vt][2] + acc[vt][3]);
        s += __shfl_xor(s, 16); s += __shfl_xor(s, 32);
        const float mean = s * (1.0f / 64.0f); float vs = 0.f;
#pragma unroll
        for (int vt = 0; vt < 4; ++vt) { acc[vt] = acc[vt] - mean; vs += (acc[vt][0] * acc[vt][0] + acc[vt][1] * acc[vt][1]) + (acc[vt][2] * acc[vt][2] + acc[vt][3] * acc[vt][3]); }
        vs += __shfl_xor(vs, 16); vs += __shfl_xor(vs, 32);
        const float rstd = rsqrtf(vs * (1.0f / 64.0f) + 64.0f * 1e-5f), bon = RKB[(size_t)row * 16 + h] + RKB1[(size_t)row * 16 + h];
#pragma unroll
        for (int vt = 0; vt < 4; ++vt) { const int col = h * 64 + 16 * vt + 4 * g; const size_t o = (size_t)row * D + col;
            const f32x4 vq = bf4(*(const u32x2*)(Vv + o)), lg4 = *(const f32x4*)(lng + col), lb4 = *(const f32x4*)(lnb + col); const u32x2 gw2 = *(const u32x2*)(Gg + o);
            const f32x4 zz = acc[vt] * rstd * lg4 + lb4 + vq * bon;
            u32x2 w; w.x = pk2(zz[0] * bflo(gw2.x), zz[1] * bfhi(gw2.x)); w.y = pk2(zz[2] * bflo(gw2.y), zz[3] * bfhi(gw2.y));
            *(u32x2*)(Z + o) = w; }
    }
}
__device__ __forceinline__ void phase_cv(const Args& a, int lc, int rows, int gw, int NGW, int lane) {
    unsigned char* ws = a.ws;
    const bf16* BG = (const bf16*)(ws + WS_BG); const bf16* CU = (const bf16*)(ws + WS_CUZ); bf16* Z = (bf16*)(ws + WS_Z);
    const float* cw = a.in[25] + (size_t)lc * 3 * 1024;
    for (int t = gw; t < rows; t += NGW) {
        int rs, re; if (t < TL) { rs = t & ~63; re = rs + 63; } else { const int loc = t - TL; rs = TL + (loc & ~255); re = rs + 255; }
        const bool hp = t > rs, hn = t < re;
#pragma unroll
        for (int j = 0; j < 4; ++j) { const int col = 256 * j + 4 * lane; const size_t o = (size_t)t * D + col;
            const u32x2 zc = *(const u32x2*)(CU + o), bg = *(const u32x2*)(BG + o);
            const u32x2 zp = hp ? *(const u32x2*)(CU + o - D) : (u32x2){0u, 0u}, zn = hn ? *(const u32x2*)(CU + o + D) : (u32x2){0u, 0u};
            const f32x4 w0 = *(const f32x4*)(cw + col), w1 = *(const f32x4*)(cw + 1024 + col), w2 = *(const f32x4*)(cw + 2048 + col);
            const f32x4 zv = (f32x4){bflo(zc.x), bfhi(zc.x), bflo(zc.y), bfhi(zc.y)}, pv = (f32x4){bflo(zp.x), bfhi(zp.x), bflo(zp.y), bfhi(zp.y)}, nv = (f32x4){bflo(zn.x), bfhi(zn.x), bflo(zn.y), bfhi(zn.y)};
            const f32x4 bv = (f32x4){bflo(bg.x), bfhi(bg.x), bflo(bg.y), bfhi(bg.y)};
            const f32x4 r = bv * (w0 * pv + w1 * zv + w2 * nv);
            u32x2 w; w.x = pk2(r.x, r.y); w.y = pk2(r.z, r.w); *(u32x2*)(Z + o) = w; }
    }
}
typedef float f32x2v __attribute__((ext_vector_type(2)));
__device__ __forceinline__ float lane_bcast(float v, int srclane) { return __builtin_bit_cast(float, __builtin_amdgcn_readlane(__builtin_bit_cast(int, v), srclane)); }
__device__ __forceinline__ void phase_e_route(const Args& a, int layer, int rows, LAS unsigned char* lds, int tid, int gw, int NGW, int lane, int probe_rep = 0) {
    unsigned char* ws = a.ws;
    const float* xs = (const float*)(ws + (layer < 2 ? WS_XSA : WS_XSB));
    const float* MODS = (const float*)(ws + WS_MODS); bf16* H2 = (bf16*)(ws + WS_H2);
    const float* ng = a.in[6] + (size_t)(layer * 2 + 1) * 1024;
    const float* rw = a.in[27] + (size_t)layer * 1024 * 32; const float* rb = a.in[28] + layer * 32;
    unsigned* cnt = (unsigned*)(ws + WS_CTL) + CW_CNT + (layer + 4 * probe_rep) * 32 * CNT_STRIDE;
    int* SLOTL = (int*)(ws + (probe_rep ? WS_L1 : WS_SLOTL)); float* GATEL = (float*)(ws + (probe_rep ? WS_L1 + 8 * MiB : WS_GATEL));
    LAS float* wt = (LAS float*)lds;
    LAS int* hist = (LAS int*)(lds + LDSCTL_OFF + 3072); LAS int* base = hist + 32; LAS int* lcnt = hist + 64;
    int* TKE = (int*)(ws + WS_C12); float* TKG = (float*)(ws + WS_C12 + 4 * MiB);
    for (int i = tid; i < 32768; i += 512) wt[(i & 31) * 1024 + (i >> 5)] = rw[i];
    if (tid < 32) hist[tid] = 0;
    __syncthreads();
    const int my_e = lane >> 1; const float my_b = rb[my_e];
    const bool b5 = (lane & 32) != 0, b4 = (lane & 16) != 0, b3 = (lane & 8) != 0, b2 = (lane & 4) != 0, b1 = (lane & 2) != 0;
    for (int t = gw; t < rows; t += NGW) {
        const int mr = mod_row(t);
        const float* mod = MODS + (size_t)(layer * 5 + mr) * 6144;
        f32x4 x[4];
#pragma unroll
        for (int j = 0; j < 4; ++j) x[j] = *(const f32x4*)(xs + (size_t)t * D + 256 * j + 4 * lane);
        const float rstd = row_rstd(x);
#pragma unroll
        for (int j = 0; j < 4; ++j) { const int col = 256 * j + 4 * lane;
            x[j] = x[j] * rstd * *(const f32x4*)(ng + col) * (*(const f32x4*)(mod + 4 * 1024 + col) + 1.0f) + *(const f32x4*)(mod + 3 * 1024 + col);
            u32x2 w; w.x = pk2(x[j].x, x[j].y); w.y = pk2(x[j].z, x[j].w); *(u32x2*)(H2 + (size_t)t * D + col) = w; }
        float p[32];
#pragma unroll
        for (int eg = 0; eg < 8; ++eg) {
#pragma unroll
            for (int ee = 0; ee < 4; ++ee) { const int e = eg * 4 + ee; f32x2v s2 = (f32x2v){0.f, 0.f};
#pragma unroll
                for (int j = 0; j < 4; ++j) { const f32x4 wv = *(const LAS f32x4*)(wt + e * 1024 + 256 * j + 4 * lane);
                    s2 = __builtin_elementwise_fma((f32x2v){x[j].x, x[j].y}, (f32x2v){wv.x, wv.y}, s2); s2 = __builtin_elementwise_fma((f32x2v){x[j].z, x[j].w}, (f32x2v){wv.z, wv.w}, s2); }
                p[e] = s2.x + s2.y; }
            asm volatile("" ::: "memory");
        }
        float q16[16];
#pragma unroll
        for (int i = 0; i < 16; ++i) { const float send = b5 ? p[i] : p[i + 16]; const float keep = b5 ? p[i + 16] : p[i]; q16[i] = keep + __shfl_xor(send, 32); }
        float q8[8];
#pragma unroll
        for (int i = 0; i < 8; ++i) { const float send = b4 ? q16[i] : q16[i + 8]; const float keep = b4 ? q16[i + 8] : q16[i]; q8[i] = keep + __shfl_xor(send, 16); }
        float q4[4];
#pragma unroll
        for (int i = 0; i < 4; ++i) { const float send = b3 ? q8[i] : q8[i + 4]; const float keep = b3 ? q8[i + 4] : q8[i]; q4[i] = keep + __shfl_xor(send, 8); }
        float q2[2];
#pragma unroll
        for (int i = 0; i < 2; ++i) { const float send = b2 ? q4[i] : q4[i + 2]; const float keep = b2 ? q4[i + 2] : q4[i]; q2[i] = keep + __shfl_xor(send, 4); }
        float q1; { const float send = b1 ? q2[0] : q2[1]; const float keep = b1 ? q2[1] : q2[0]; q1 = keep + __shfl_xor(send, 2); }
        const float lg = q1 + __shfl_xor(q1, 1) + my_b;
        int rank = 0;
#pragma unroll 1
        for (int e = 0; e < 32; ++e) { const float o = lane_bcast(lg, 2 * e); rank += (o > lg || (o == lg && e < my_e)) ? 1 : 0; }
        const bool sel = rank < 4 && !(lane & 1);
        const unsigned long long m0 = __ballot(sel && rank == 0), m1 = __ballot(sel && rank == 1), m2 = __ballot(sel && rank == 2), m3 = __ballot(sel && rank == 3);
        const float v0 = lane_bcast(lg, (int)__builtin_ctzll(m0)), v1 = lane_bcast(lg, (int)__builtin_ctzll(m1)), v2 = lane_bcast(lg, (int)__builtin_ctzll(m2)), v3 = lane_bcast(lg, (int)__builtin_ctzll(m3));
        const float e1 = __expf(v1 - v0), e2 = __expf(v2 - v0), e3 = __expf(v3 - v0);
        const float inv = 1.0f / (1.0f + e1 + e2 + e3);
        if (sel) {
            TKE[t * 4 + rank] = my_e; TKG[t * 4 + rank] = __expf(lg - v0) * inv;
            __hip_atomic_fetch_add(hist + my_e, 1, __ATOMIC_RELAXED, __HIP_MEMORY_SCOPE_WORKGROUP);
        }
    }
    asm volatile("s_waitcnt vmcnt(0) lgkmcnt(0)" ::: "memory"); __syncthreads();
    if (tid < 32) { base[tid] = (int)atomicAdd(cnt + tid * CNT_STRIDE, (unsigned)hist[tid]); lcnt[tid] = 0; }
    __syncthreads();
    for (int t = gw; t < rows; t += NGW) {
        if (lane < 4) { const int e = TKE[t * 4 + lane]; const float gk = TKG[t * 4 + lane];
            const int pos = base[e] + __hip_atomic_fetch_add(lcnt + e, 1, __ATOMIC_RELAXED, __HIP_MEMORY_SCOPE_WORKGROUP);
            SLOTL[(size_t)e * T + pos] = t * 4 + lane; GATEL[(size_t)e * T + pos] = gk; }
    }
}
__device__ __forceinline__ int okey(float v, int e) { const int i = __builtin_bit_cast(int, v); const int o = i ^ ((i >> 31) & 0x7fffffff); return (o & ~31) | (31 - e); }
__device__ __forceinline__ void phase_e_route_mfma(const Args& a, int layer, int rows, LAS unsigned char* lds, int tid, int wave, int gw, int NGW, int lane, int probe_rep = 0) {
    unsigned char* ws = a.ws;
    const float* xs = (const float*)(ws + (layer < 2 ? WS_XSA : WS_XSB));
    const float* MODS = (const float*)(ws + WS_MODS); bf16* H2 = (bf16*)(ws + WS_H2);
    const float* ng = a.in[6] + (size_t)(layer * 2 + 1) * 1024; const float* rb = a.in[28] + layer * 32;
    const bf16* WRT = (const bf16*)(ws + WS_WRT) + (size_t)layer * 2 * 32 * 1024;
    unsigned* cnt = (unsigned*)(ws + WS_CTL) + CW_CNT + (layer + 4 * probe_rep) * 32 * CNT_STRIDE;
    int* SLOTL = (int*)(ws + (probe_rep ? WS_L1 : WS_SLOTL)); float* GATEL = (float*)(ws + (probe_rep ? WS_L1 + 8 * MiB : WS_GATEL));
    LAS int* hist = (LAS int*)(lds + LDSCTL_OFF + 3072); LAS int* base = hist + 32; LAS int* lcnt = hist + 64;
    int* TKE = (int*)(ws + WS_C12); float* TKG = (float*)(ws + WS_C12 + 4 * MiB);
    LAS unsigned char* tile = lds + wave * 8448;
    if (tid < 32) hist[tid] = 0;
    __syncthreads();
    const int l15 = lane & 15, g = lane >> 4;
    const int nlat = TL / 16, nctx = rows > TL ? TC / 4 : 0, G_ = NGW / 8;
    for (int it = 0;; ++it) {
        int t0, ntok;
        { const int tl = gw + it * NGW; const int xi = (int)blockIdx.x + (it - (nlat + NGW - 1) / NGW) * G_ * 8 + wave * G_;
          if (tl < nlat) { t0 = tl * 16; ntok = 16; } else if (it >= (nlat + NGW - 1) / NGW && xi < nctx) { t0 = TL + xi * 4; ntok = 4; } else if (it >= (nlat + NGW - 1) / NGW) break; else continue; }
        const float* mod = MODS + (size_t)(layer * 5 + mod_row(t0)) * 6144;
        float rstd[16];
#pragma unroll
        for (int t = 0; t < 16; ++t) { f32x4 x[4];
            const int tr = t < ntok ? t0 + t : t0;
#pragma unroll
            for (int j = 0; j < 4; ++j) x[j] = *(const f32x4*)(xs + (size_t)tr * D + 256 * j + 4 * lane);
            rstd[t] = __builtin_bit_cast(float, __builtin_amdgcn_readfirstlane(__builtin_bit_cast(int, row_rstd(x))));
            if ((t & 3) == 3) asm volatile("" ::: "memory"); }
        f32x4 acc[2]; acc[0] = (f32x4){0.f, 0.f, 0.f, 0.f}; acc[1] = acc[0];
#pragma unroll 1
        for (int s = 0; s < 4; ++s) {
            const int col = 256 * s + 4 * lane;
            const f32x4 g4 = *(const f32x4*)(ng + col) * (*(const f32x4*)(mod + 4 * 1024 + col) + 1.0f), s4 = *(const f32x4*)(mod + 3 * 1024 + col);
            f32x4 hv[16];
#pragma unroll
            for (int t = 0; t < 16; ++t) { const int tr = t < ntok ? t0 + t : t0; hv[t] = *(const f32x4*)(xs + (size_t)tr * D + col) * rstd[t] * g4 + s4;
                const u32x2 w = pk4(hv[t]); if (t < ntok) *(u32x2*)(H2 + (size_t)tr * D + col) = w;
                *(LAS u32x2*)(tile + t * 528 + lane * 8) = w; hv[t] = hv[t] - bf4(w); }
            LDS_WAIT(); asm volatile("" ::: "memory");
            const bf16* wh = WRT + (size_t)l15 * 1024 + 256 * s + 8 * g; const bf16* wl = wh + (size_t)32 * 1024;
#pragma unroll
            for (int ks = 0; ks < 8; ++ks) { const bf16x8 fb = as_frag(*(const LAS u32x4*)(tile + l15 * 528 + ks * 64 + g * 16));
#pragma unroll
                for (int et = 0; et < 2; ++et) { acc[et] = mfma16(as_frag(*(const u32x4*)(wh + (size_t)et * 16 * 1024 + 32 * ks)), fb, acc[et]);
                    acc[et] = mfma16(as_frag(*(const u32x4*)(wl + (size_t)et * 16 * 1024 + 32 * ks)), fb, acc[et]); } }
            LDS_WAIT(); asm volatile("" ::: "memory");
#pragma unroll
            for (int t = 0; t < 16; ++t) *(LAS u32x2*)(tile + t * 528 + lane * 8) = pk4(hv[t]);
            LDS_WAIT(); asm volatile("" ::: "memory");
#pragma unroll
            for (int ks = 0; ks < 8; ++ks) { const bf16x8 fb = as_frag(*(const LAS u32x4*)(tile + l15 * 528 + ks * 64 + g * 16));
#pragma unroll
                for (int et = 0; et < 2; ++et) acc[et] = mfma16(as_frag(*(const u32x4*)(wh + (size_t)et * 16 * 1024 + 32 * ks)), fb, acc[et]); }
            LDS_WAIT(); asm volatile("" ::: "memory");
        }
        float v[8]; int key[8];
#pragma unroll
        for (int j = 0; j < 8; ++j) { const int e = (j < 4 ? 0 : 16) + 4 * g + (j & 3); v[j] = acc[j >> 2][j & 3] + rb[e]; key[j] = okey(v[j], e); }
        int kb[8], kc[8], kd2[8];
#pragma unroll
        for (int j = 0; j < 8; ++j) kb[j] = __shfl_xor(key[j], 16);
#pragma unroll
        for (int j = 0; j < 8; ++j) { kc[j] = __shfl_xor(key[j], 32); kd2[j] = __shfl_xor(kb[j], 32); }
        float vmax = fmaxf(fmaxf(fmaxf(v[0], v[1]), fmaxf(v[2], v[3])), fmaxf(fmaxf(v[4], v[5]), fmaxf(v[6], v[7])));
        vmax = fmaxf(vmax, __shfl_xor(vmax, 16)); vmax = fmaxf(vmax, __shfl_xor(vmax, 32));
        int rank[8]; float ex[8], part = 0.f;
#pragma unroll
        for (int j = 0; j < 8; ++j) { int r = 0;
#pragma unroll
            for (int q = 0; q < 8; ++q) r += (key[q] > key[j]) + (kb[q] > key[j]) + (kc[q] > key[j]) + (kd2[q] > key[j]);
            rank[j] = r; ex[j] = __expf(v[j] - vmax); part += r < 4 ? ex[j] : 0.f; }
        part += __shfl_xor(part, 16); part += __shfl_xor(part, 32);
        const float inv = 1.0f / part; const int t = t0 + l15;
#pragma unroll
        for (int j = 0; j < 8; ++j) if (rank[j] < 4 && l15 < ntok) { const int e = (j < 4 ? 0 : 16) + 4 * g + (j & 3);
            TKE[t * 4 + rank[j]] = e; TKG[t * 4 + rank[j]] = ex[j] * inv;
            __hip_atomic_fetch_add(hist + e, 1, __ATOMIC_RELAXED, __HIP_MEMORY_SCOPE_WORKGROUP); }
    }
    asm volatile("s_waitcnt vmcnt(0) lgkmcnt(0)" ::: "memory"); __syncthreads();
    if (tid < 32) { base[tid] = (int)atomicAdd(cnt + tid * CNT_STRIDE, (unsigned)hist[tid]); lcnt[tid] = 0; }
    __syncthreads();
    for (int it = 0;; ++it) {
        int t0, ntok;
        { const int tl = gw + it * NGW; const int xi = (int)blockIdx.x + (it - (nlat + NGW - 1) / NGW) * G_ * 8 + wave * G_;
          if (tl < nlat) { t0 = tl * 16; ntok = 16; } else if (it >= (nlat + NGW - 1) / NGW && xi < nctx) { t0 = TL + xi * 4; ntok = 4; } else if (it >= (nlat + NGW - 1) / NGW) break; else continue; }
        if ((lane >> 2) < ntok) { const int t = t0 + (lane >> 2), k = lane & 3;
            const int e = TKE[t * 4 + k]; const float gk = TKG[t * 4 + k];
            const int pos = base[e] + __hip_atomic_fetch_add(lcnt + e, 1, __ATOMIC_RELAXED, __HIP_MEMORY_SCOPE_WORKGROUP);
            SLOTL[(size_t)e * T + pos] = t * 4 + k; GATEL[(size_t)e * T + pos] = gk; }
    }
}
__device__ __forceinline__ void phase_final(const Args& a, int gw, int NGW, int lane) {
    unsigned char* ws = a.ws;
    const float* xs = (const float*)(ws + WS_XSB); const float* MODS = (const float*)(ws + WS_MODS); const bf16* YS = (const bf16*)(ws + WS_YS);
    for (int t = gw; t < TL; t += NGW) {
        const int mr = t >> 13;
        f32x4 m5[4], x[4];
#pragma unroll
        for (int j = 0; j < 4; ++j) m5[j] = *(const f32x4*)(MODS + (size_t)(3 * 5 + mr) * 6144 + 5 * 1024 + 256 * j + 4 * lane);
        load_x_combined(x, xs + (size_t)t * D, true, YS, t, m5, lane);
        const float rstd = row_rstd(x);
#pragma unroll
        for (int j = 0; j < 4; ++j) { const int col = 256 * j + 4 * lane; *(f32x4*)(a.out + (size_t)t * D + col) = x[j] * rstd * *(const f32x4*)(a.in[7] + col); }
    }
}

using pg8::Unit; using pg8::tile_map;
struct SchedStd {
    int G, c, nM, nN;
    __device__ __forceinline__ bool next(int i, Unit& u) const { const long L = (long)i * G + c; if (L >= (long)nM * nN) return false; int pm, pn; tile_map((int)L, nM, nN, pm, pn); u.pm = pm; u.pn = pn; u.e = 0; u.nv = pm; u.par = 0; return true; }
    __device__ __forceinline__ void a_ready(const Unit&) const {}
    __device__ __forceinline__ void done(const Unit&) const {}
    __device__ __forceinline__ unsigned row_off(const Unit&, int) const { return 0u; }
};
struct SchedB1 {
    int G, c;
    __device__ __forceinline__ bool next(int i, Unit& u) const { const long L = (long)i * G + c; constexpr int n1 = 3 * NMT * 4; if (L >= n1 + 3 * NMT) return false; const int l = (int)L;
        if (l < n1) { const int j = l / (NMT * 4), r = l % (NMT * 4); int pm, pn; tile_map(r, NMT, 4, pm, pn); u.pm = j * NMT + pm; u.pn = j * 4 + pn; u.e = j; u.nv = pm; }
        else { const int r = l - n1, j = r / NMT, pm = r % NMT; u.pm = (3 + j) * NMT + pm; u.pn = 12 + j; u.e = 3 + j; u.nv = pm; }
        u.par = 0; return true; }
    __device__ __forceinline__ void a_ready(const Unit&) const {}
    __device__ __forceinline__ void done(const Unit&) const {}
    __device__ __forceinline__ unsigned row_off(const Unit&, int) const { return 0u; }
};
struct SchedB2 {
    int G, c;
    __device__ __forceinline__ bool next(int i, Unit& u) const { const long L = (long)i * G + c; constexpr int n1 = 2 * NMT * 8; if (L >= n1 + NMT * 4) return false; const int l = (int)L;
        if (l < n1) { const int j = l / (NMT * 8), r = l % (NMT * 8); int pm, pn; tile_map(r, NMT, 8, pm, pn); u.pm = j * NMT + pm; u.pn = j * 8 + pn; u.e = j; u.nv = pm; }
        else { const int r = l - n1; int pm, pn; tile_map(r, NMT, 4, pm, pn); u.pm = 2 * NMT + pm; u.pn = 16 + pn; u.e = 2; u.nv = pm; }
        u.par = 0; return true; }
    __device__ __forceinline__ void a_ready(const Unit&) const {}
    __device__ __forceinline__ void done(const Unit&) const {}
    __device__ __forceinline__ unsigned row_off(const Unit&, int) const { return 0u; }
};
struct SchedMoe {
    int G, c, nnt, ntiles, P; LAS unsigned char* lds; const int* slotl; const float* gatel; int wave;
    __device__ __forceinline__ bool next(int i, Unit& u) const { const long L = (long)i * G + c; const int ntp = (ntiles + P - 1) / P, ppg = nnt / (8 / P); if (L >= (long)ntp * ppg * 8) return false;
        const LAS int* tpre = (const LAS int*)(lds + LDSCTL_OFF + 64); const LAS int* ecnt = (const LAS int*)(lds + LDSCTL_OFF + 256); const LAS unsigned short* tile_e = (const LAS unsigned short*)(lds + LDSCTL_OFF + 512);
        const int xq = (int)(L >> 3), x8 = (int)(L & 7); int tile = (xq / ppg) * P + (x8 % P); const int pnl = (x8 / P) * ppg + xq % ppg; const bool dead = tile >= ntiles; tile = dead ? 0 : tile;
        const int e = __builtin_amdgcn_readfirstlane((int)tile_e[tile]), r0 = (tile - __builtin_amdgcn_readfirstlane(tpre[e])) * 256; int nv = __builtin_amdgcn_readfirstlane(ecnt[e]) - r0; nv = nv > 256 ? 256 : nv; nv = dead ? 0 : nv;
        u.pm = dead ? MAXTILES : tile; u.pn = e * nnt + pnl; u.e = e; u.nv = nv | (r0 << 9); u.par = i & 1; return true; }
    __device__ __forceinline__ void a_ready(const Unit& u) const {
        if (gatel != nullptr && wave == 0) { const size_t li = (size_t)u.e * T + (u.nv >> 9) + 4 * lane_id();
            __builtin_amdgcn_global_load_lds((const unsigned*)(slotl + li), (LAS unsigned*)(lds + LDSCTL_OFF + 8192 + 2048 * u.par), 16, 0, 0);
            __builtin_amdgcn_global_load_lds((const unsigned*)(gatel + li), (LAS unsigned*)(lds + LDSCTL_OFF + 8192 + 2048 * u.par + 1024), 16, 0, 0); } }
    __device__ __forceinline__ void done(const Unit&) const {}
    __device__ __forceinline__ unsigned row_off(const Unit& u, int r) const { const int nv = u.nv & 511, r0 = u.nv >> 9; const int tok = r < nv ? (slotl[(size_t)u.e * T + r0 + r] >> 2) : 0; return (unsigned)tok * 2048u; }
};

using pg8::cvt_pk_bf16;
template <class P> __device__ __forceinline__ P* pin_ptr(P* p) { asm volatile("" : "+v"(p)); return p; }
struct EpiB1 {
    static constexpr bool PERM = true, AFTER_DRAIN = false;
    bf16* RKV; bf16* L1;
    __device__ __forceinline__ void operator()(const f32x4 (&acc)[2][2][4][2], const Unit& u, int wr, int wc, int fr, int fq) const {
        const int seg = u.e, row0 = u.nv * 256 + wr * 64 + fr;
        const int jj = seg - 3, ld = seg < 3 ? D : 128, col0 = (seg < 3 ? (u.pn - seg * 4) * 256 : 0) + wc * 32 + 8 * fq;
        bf16* base = seg < 3 ? RKV + (size_t)seg * T * D : L1 + (size_t)jj * T * 128;
#pragma unroll
        for (int ai = 0; ai < 2; ++ai)
#pragma unroll
            for (int m = 0; m < 4; ++m) { bf16* rowp = base + (size_t)(row0 + ai * 128 + m * 16) * ld + col0;
#pragma unroll
                for (int bj = 0; bj < 2; ++bj) { if (seg >= 3 && bj == 1) continue; f32x4 v0 = acc[ai][bj][m][0], v1 = acc[ai][bj][m][1];
                    if (jj == 0) {
#pragma unroll
                        for (int q = 0; q < 4; ++q) { v0[q] = tanh_fast(v0[q]); v1[q] = tanh_fast(v1[q]); } }
                    else if (jj == 2) {
#pragma unroll
                        for (int q = 0; q < 4; ++q) { v0[q] = sigm(v0[q]); v1[q] = sigm(v1[q]); } }
                    u32x4 w; w.x = cvt_pk_bf16(v0[0], v0[1]); w.y = cvt_pk_bf16(v0[2], v0[3]); w.z = cvt_pk_bf16(v1[0], v1[1]); w.w = cvt_pk_bf16(v1[2], v1[3]);
                    *(u32x4*)(rowp + bj * 128) = w; } }
    }
};
struct EpiB2 {
    static constexpr bool PERM = true, AFTER_DRAIN = false;
    bf16* RW; bf16* RA; bf16* Gg;
    __device__ __forceinline__ void operator()(const f32x4 (&acc)[2][2][4][2], const Unit& u, int wr, int wc, int fr, int fq) const {
        const int jj = u.e, row0 = u.nv * 256 + wr * 64 + fr, pnl = u.pn - jj * 8;
        const int dirn = jj < 2 ? (pnl >> 2) : 0, col0 = (jj < 2 ? (pnl & 3) : pnl) * 256 + wc * 32 + 8 * fq;
        bf16* base = (jj == 0 ? RW : jj == 1 ? RA : Gg) + (size_t)dirn * T * D;
#pragma unroll
        for (int ai = 0; ai < 2; ++ai)
#pragma unroll
            for (int m = 0; m < 4; ++m) { bf16* rowp = base + (size_t)(row0 + ai * 128 + m * 16) * D + col0;
#pragma unroll
                for (int bj = 0; bj < 2; ++bj) { const f32x4 v0 = acc[ai][bj][m][0], v1 = acc[ai][bj][m][1];
                    u32x4 w; w.x = cvt_pk_bf16(v0[0], v0[1]); w.y = cvt_pk_bf16(v0[2], v0[3]); w.z = cvt_pk_bf16(v1[0], v1[1]); w.w = cvt_pk_bf16(v1[2], v1[3]);
                    *(u32x4*)(rowp + bj * 128) = w; } }
    }
};
struct EpiRes {
    static constexpr bool PERM = true, AFTER_DRAIN = false;
    float* X; const float* gate; float* Xo;
    __device__ __forceinline__ void operator()(const f32x4 (&acc)[2][2][4][2], const Unit& u, int wr, int wc, int fr, int fq) const {
        const int row0 = u.pm * 256 + wr * 64 + fr, col0 = u.pn * 256 + wc * 32 + 8 * fq, mr = u.pm < NMT_L ? (u.pm >> 5) : 4;
        const float* gp = pin_ptr(gate + (size_t)mr * 6144 + col0);
        f32x4 gv[2][2];
#pragma unroll
        for (int bj = 0; bj < 2; ++bj)
#pragma unroll
            for (int n = 0; n < 2; ++n) gv[bj][n] = *(const f32x4*)(gp + bj * 128 + 4 * n);
#pragma unroll
        for (int ai = 0; ai < 2; ++ai)
#pragma unroll
            for (int m = 0; m < 4; ++m) { float* rowp = X + (size_t)(row0 + ai * 128 + m * 16) * D + col0;
#pragma unroll
                for (int bj = 0; bj < 2; ++bj)
#pragma unroll
                    for (int n = 0; n < 2; ++n) { float* p = rowp + bj * 128 + 4 * n; *(f32x4*)(Xo + (p - X)) = *(const f32x4*)p + gv[bj][n] * acc[ai][bj][m][n]; } }
    }
};
struct EpiWin {
    static constexpr bool PERM = true, AFTER_DRAIN = false;
    bf16* BG; bf16* CU;
    __device__ __forceinline__ void operator()(const f32x4 (&acc)[2][2][4][2], const Unit& u, int wr, int wc, int fr, int fq) const {
        const int row0 = u.pm * 256 + wr * 64 + fr;
        if (u.pn < 4) {
            const int col0 = u.pn * 256 + wc * 32 + 8 * fq;
#pragma unroll
            for (int ai = 0; ai < 2; ++ai)
#pragma unroll
                for (int m = 0; m < 4; ++m) { bf16* rowp = BG + (size_t)(row0 + ai * 128 + m * 16) * D + col0;
#pragma unroll
                    for (int bj = 0; bj < 2; ++bj) { const f32x4 v0 = acc[ai][bj][m][0], v1 = acc[ai][bj][m][1];
                        u32x4 w; w.x = cvt_pk_bf16(v0[0], v0[1]); w.y = cvt_pk_bf16(v0[2], v0[3]); w.z = cvt_pk_bf16(v1[0], v1[1]); w.w = cvt_pk_bf16(v1[2], v1[3]);
                        *(u32x4*)(rowp + bj * 128) = w; } }
        } else {
            const int f0 = (u.pn - 4) * 128 + wc * 32 + 8 * fq;
#pragma unroll
            for (int ai = 0; ai < 2; ++ai)
#pragma unroll
                for (int m = 0; m < 4; ++m) { const f32x4 v0 = acc[ai][0][m][0] * acc[ai][1][m][0], v1 = acc[ai][0][m][1] * acc[ai][1][m][1];
                    u32x4 w; w.x = cvt_pk_bf16(v0[0], v0[1]); w.y = cvt_pk_bf16(v0[2], v0[3]); w.z = cvt_pk_bf16(v1[0], v1[1]); w.w = cvt_pk_bf16(v1[2], v1[3]);
                    *(u32x4*)(CU + (size_t)(row0 + ai * 128 + m * 16) * D + f0) = w; }
        }
    }
};
struct EpiGU {
    static constexpr bool PERM = true, AFTER_DRAIN = false;
    bf16* INTER; const float* bgu;
    __device__ __forceinline__ void operator()(const f32x4 (&acc)[2][2][4][2], const Unit& u, int wr, int wc, int fr, int fq) const {
        const int e = u.e, pnl = u.pn - e * 8, row0 = u.pm * 256 + wr * 64 + fr, f0 = pnl * 128 + wc * 32 + 8 * fq;
        const float* bp = pin_ptr(bgu + (size_t)e * 2048 + f0);
        f32x4 bg[2], bu[2];
#pragma unroll
        for (int n = 0; n < 2; ++n) { bg[n] = *(const f32x4*)(bp + 4 * n); bu[n] = *(const f32x4*)(bp + 1024 + 4 * n); }
#pragma unroll
        for (int ai = 0; ai < 2; ++ai)
#pragma unroll
            for (int m = 0; m < 4; ++m) { f32x4 o[2];
#pragma unroll
                for (int n = 0; n < 2; ++n) { const f32x4 g = acc[ai][0][m][n] + bg[n], uu = acc[ai][1][m][n] + bu[n];
#pragma unroll
                    for (int q = 0; q < 4; ++q) { const float gc = fminf(g[q], 7.0f), uc = fminf(fmaxf(uu[q], -7.0f), 7.0f); o[n][q] = (uc + 1.0f) * gc * sigm(1.702f * gc); } }
                u32x4 w; w.x = cvt_pk_bf16(o[0][0], o[0][1]); w.y = cvt_pk_bf16(o[0][2], o[0][3]); w.z = cvt_pk_bf16(o[1][0], o[1][1]); w.w = cvt_pk_bf16(o[1][2], o[1][3]);
                *(u32x4*)(INTER + (size_t)(row0 + ai * 128 + m * 16) * 1024 + f0) = w; }
    }
};
struct EpiDown {
    static constexpr bool PERM = true, AFTER_DRAIN = false;
    bf16* YS; const float* bdn; LAS unsigned char* lds;
    __device__ __forceinline__ void operator()(const f32x4 (&acc)[2][2][4][2], const Unit& u, int wr, int wc, int fr, int fq) const {
        const int e = u.e, pnl = u.pn - e * 4, col0 = pnl * 256 + wc * 32 + 8 * fq, nv = u.nv & 511;
        const float* bp = pin_ptr(bdn + (size_t)e * 1024 + col0);
        f32x4 bv[2][2];
#pragma unroll
        for (int bj = 0; bj < 2; ++bj)
#pragma unroll
            for (int n = 0; n < 2; ++n) bv[bj][n] = *(const f32x4*)(bp + bj * 128 + 4 * n);
#pragma unroll
        for (int ai = 0; ai < 2; ++ai)
#pragma unroll
            for (int m = 0; m < 4; ++m) { const int r = ai * 128 + wr * 64 + m * 16 + fr;
                if (r < nv) { const LAS int* sl = (const LAS int*)(lds + LDSCTL_OFF + 8192 + 2048 * u.par); const int slot = sl[r]; const float gt = ((const LAS float*)(sl + 256))[r];
                    bf16* rowp = YS + (size_t)slot * 1024 + col0;
#pragma unroll
                    for (int bj = 0; bj < 2; ++bj) { const f32x4 v0 = (acc[ai][bj][m][0] + bv[bj][0]) * gt, v1 = (acc[ai][bj][m][1] + bv[bj][1]) * gt;
                        u32x4 w; w.x = cvt_pk_bf16(v0[0], v0[1]); w.y = cvt_pk_bf16(v0[2], v0[3]); w.z = cvt_pk_bf16(v1[0], v1[1]); w.w = cvt_pk_bf16(v1[2], v1[3]);
                        *(u32x4*)(rowp + bj * 128) = w; } } }
    }
};

__device__ __forceinline__ int moe_tables(const unsigned* cnt, LAS unsigned char* lds, int tid) {
    LAS int* tpre = (LAS int*)(lds + LDSCTL_OFF + 64); LAS int* ecnt = (LAS int*)(lds + LDSCTL_OFF + 256); LAS unsigned short* tile_e = (LAS unsigned short*)(lds + LDSCTL_OFF + 512);
    if (tid == 0) { int p = 0; for (int e = 0; e < 32; ++e) { const int cn = (int)__hip_atomic_load(cnt + e * CNT_STRIDE, __ATOMIC_RELAXED, __HIP_MEMORY_SCOPE_AGENT); ecnt[e] = cn; tpre[e] = p; p += (cn + 255) >> 8; } tpre[32] = p; }
    __syncthreads();
    const int nt = tpre[32];
    for (int t = tid; t < nt; t += 512) { int e = 0; while (e < 31 && t >= tpre[e + 1]) ++e; tile_e[t] = (unsigned short)e; }
    __syncthreads();
    return nt;
}

constexpr int NPHASES = 37;
typedef const Args __attribute__((address_space(4))) CArgs;
__global__ void __launch_bounds__(512, 2) fwd_kernel(Args a_) {
    extern __shared__ __attribute__((aligned(16))) unsigned char lds_raw[];
    LAS unsigned char* lds = (LAS unsigned char*)lds_raw;
    const int G = gridDim.x, NGW = G * 8;
    CArgs* ap0 = (CArgs*)__builtin_amdgcn_kernarg_segment_ptr();
    if (threadIdx.x < 4) ((LAS unsigned*)(lds + LDSCTL_OFF))[threadIdx.x] = 0u;
    __syncthreads();
    XcdBarrier bar = xcd_barrier_post((unsigned*)(a_.ws + WS_CTL) + CW_BAR, (volatile LAS unsigned*)(lds + LDSCTL_OFF));
    const int lo = a_.ph_lo, hi = a_.ph_hi;
    int ph = 0;
#ifndef MK_ONLY
#define MK_ONLY -1
#endif
#ifndef MK_DBL
#define MK_DBL 0
#endif
#define PH_BEGIN(id) if ((MK_ONLY < 0 || MK_ONLY == (id)) && ph >= lo && ph < hi) { for (int rep_ = 0; rep_ <= ((MK_DBL >> (id)) & 1); ++rep_) { CArgs* ap = ap0; asm volatile("" : "+s"(ap)); const Args a = *(const Args*)ap; unsigned char* const ws = a.ws; (void)ws; const int wave = (int)bar.wv; int tid = wave * 64 + lane_id(); asm volatile("" : "+v"(tid)); const int lane = tid & 63, gw = blockIdx.x * 8 + wave; (void)lane; (void)gw;
#define PH_END } } if (ph >= lo && ph + 1 < hi) xcd_barrier(bar); ++ph;

    PH_BEGIN(0) p0_prologue(a, lds, tid, lane, wave, G); PH_END

#pragma unroll 1
    for (int layer = 0; layer < DEPTH; ++layer) {
        const int kind = layer & 1, lj = layer >> 1;
        const int rows = layer == 3 ? TL : T, nmt = rows / 256;
        const int rows_moe = layer < 2 ? T : TL;
        if (kind == 0) {
            PH_BEGIN(1) phase_a_rwkv(a, layer, lds, tid, gw, NGW, lane); PH_END
            PH_BEGIN(2) {
                pg8::Gemm g{(const bf16*)(ws + WS_XL), (const bf16*)(ws + WS_WRKV) + (size_t)lj * 3840 * 1024, 6 * T, 3840, 1024};
                SchedB1 S{G, (int)blockIdx.x}; EpiB1 E{(bf16*)(ws + WS_RKV), (bf16*)(ws + WS_L1)};
                pg8::gemm_phase<EpiB1, SchedB1, true, true, false>(lds, g, S, E, tid); } PH_END
            PH_BEGIN(3) {
                pg8::Gemm g{(const bf16*)(ws + WS_L1), (const bf16*)(ws + WS_L2T) + (size_t)lj * 5120 * 128, 3 * T, 5120, 128};
                SchedB2 S{G, (int)blockIdx.x}; EpiB2 E{(bf16*)(ws + WS_RAWW), (bf16*)(ws + WS_RAWA), (bf16*)(ws + WS_G)};
                pg8::gemm_phase<EpiB2, SchedB2, true, true, false>(lds, g, S, E, tid); } PH_END
            PH_BEGIN(5) phase_s1_chunks(a, lj, lds, tid, G, (MK_DBL >> 5) & 1 & (rep_ == 0)); PH_END
            PH_BEGIN(15) phase_s2_chain(a, wave, lane, G); PH_END
            PH_BEGIN(6) phase_s3_readout(a, lj, layer == 2 ? TL : T, gw, NGW, lane); PH_END
        } else {
            PH_BEGIN(7) phase_a_conv(a, layer, rows, gw, NGW, lane); PH_END
            PH_BEGIN(8) {
                pg8::Gemm g{(const bf16*)(ws + WS_XL), (const bf16*)(ws + WS_WIN) + (size_t)lj * 3072 * 1024, rows, 3072, 1024};
                SchedStd S{G, (int)blockIdx.x, nmt, 12}; EpiWin E{(bf16*)(ws + WS_BG), (bf16*)(ws + WS_CUZ)};
                pg8::gemm_phase<EpiWin, SchedStd, true, true, false>(lds, g, S, E, tid); } PH_END
            PH_BEGIN(9) phase_cv(a, lj, rows, gw, NGW, lane); PH_END
        }
        PH_BEGIN(10) {
            const bf16* Wt = kind == 0 ? (const bf16*)(ws + WS_WO) + (size_t)lj * 1024 * 1024 : (const bf16*)(ws + WS_WOUT) + (size_t)lj * 1024 * 1024;
            pg8::Gemm g{(const bf16*)(ws + WS_Z), Wt, rows, 1024, 1024};
            SchedStd S{G, (int)blockIdx.x, layer == 2 ? NMT_L : nmt, 4}; EpiRes E{(float*)(ws + (layer < 2 ? WS_XSA : WS_XSB)), (const float*)(ws + WS_MODS) + (size_t)layer * 5 * 6144 + 2 * 1024, (float*)(ws + (rep_ ? WS_XL : (layer < 2 ? WS_XSA : WS_XSB)))};
            pg8::gemm_phase<EpiRes, SchedStd, true, true, false>(lds, g, S, E, tid); } PH_END
        PH_BEGIN(11) phase_e_route_mfma(a, layer, rows_moe, lds, tid, wave, gw, NGW, lane, rep_); PH_END
        PH_BEGIN(12) {
            const int nt = __builtin_amdgcn_readfirstlane(moe_tables((const unsigned*)(ws + WS_CTL) + CW_CNT + layer * 32 * CNT_STRIDE, lds, tid));
            pg8::Gemm g{(const bf16*)(ws + WS_H2), (const bf16*)(ws + WS_WGU) + (size_t)layer * 32 * 2048 * 1024, 0, 0, 1024};
            SchedMoe S{G, (int)blockIdx.x, 8, nt, 2, lds, (const int*)(ws + WS_SLOTL), nullptr, wave};
            EpiGU E{(bf16*)(ws + WS_INTER), a.in[30] + (size_t)layer * 32 * 2048};
            pg8::gemm_phase<EpiGU, SchedMoe, true, true, true>(lds, g, S, E, tid); } PH_END
        PH_BEGIN(13) {
            const int nt = __builtin_amdgcn_readfirstlane(moe_tables((const unsigned*)(ws + WS_CTL) + CW_CNT + layer * 32 * CNT_STRIDE, lds, tid));
            pg8::Gemm g{(const bf16*)(ws + WS_INTER), (const bf16*)(ws + WS_WDN) + (size_t)layer * 32 * 1024 * 1024, 0, 0, 1024};
            SchedMoe S{G, (int)blockIdx.x, 4, nt, 8, lds, (const int*)(ws + WS_SLOTL), (const float*)(ws + WS_GATEL), wave};
            EpiDown E{(bf16*)(ws + WS_YS), a.in[32] + (size_t)layer * 32 * 1024, lds};
            pg8::gemm_phase<EpiDown, SchedMoe, true, true, false>(lds, g, S, E, tid); } PH_END
    }
    PH_BEGIN(14) phase_final(a, gw, NGW, lane); PH_END
#undef PH_BEGIN
#undef PH_END
}

extern "C" void kernel_launch(void* const* d_in, const int* in_sizes, int n_in, void* d_out, int out_size, void* d_ws, size_t ws_size, hipStream_t stream) {
    static int grid = 0;
    if (grid == 0) {
        if (n_in != 33 || in_sizes[0] != TL * D || out_size != TL * D || ws_size < WS_END) { fprintf(stderr, "kernel_launch: unexpected problem (n_in %d, in0 %d, out %d, ws %zu < %zu)\n", n_in, n_in > 0 ? in_sizes[0] : -1, out_size, ws_size, (size_t)WS_END); grid = -1; return; }
        int dev = 0, cus = 0, per_cu = 0;
        if (hipGetDevice(&dev) != hipSuccess || hipDeviceGetAttribute(&cus, hipDeviceAttributeMultiprocessorCount, dev) != hipSuccess) { grid = -1; return; }
        if (hipFuncSetAttribute((const void*)fwd_kernel, hipFuncAttributeMaxDynamicSharedMemorySize, LDS_BYTES) != hipSuccess) { fprintf(stderr, "kernel_launch: hipFuncSetAttribute failed\n"); grid = -1; return; }
        if (hipOccupancyMaxActiveBlocksPerMultiprocessor(&per_cu, (const void*)fwd_kernel, 512, LDS_BYTES) != hipSuccess || per_cu < 1) fprintf(stderr, "kernel_launch: occupancy query says %d\n", per_cu);
        (void)hipGetLastError();
        grid = cus;
    }
    if (grid < 0) return;
    if (hipMemsetAsync((char*)d_ws + WS_CTL, 0, CTL_ZERO_BYTES, stream) != hipSuccess) return;
    Args a{};
    for (int i = 0; i < 33; ++i) a.in[i] = (const float*)d_in[i];
    a.out = (float*)d_out; a.ws = (unsigned char*)d_ws;
#if MK_PER_PHASE
    for (int p = 0; p < NPHASES; ++p) { a.ph_lo = p; a.ph_hi = p + 1; hipLaunchKernelGGL(fwd_kernel, dim3(grid), dim3(512), LDS_BYTES, stream, a); }
#else
    a.ph_lo = 0; a.ph_hi = NPHASES;
    hipLaunchKernelGGL(fwd_kernel, dim3(grid), dim3(512), LDS_BYTES, stream, a);
#endif
    const hipError_t le = hipPeekAtLastError();
    if (le != hipSuccess) fprintf(stderr, "kernel_launch: launch failed: %s\n", hipGetErrorName(le));
}
```

```cpp
#include <hip/hip_runtime.h>
#include <cstdio>
#include <cstdint>

#ifndef MK_PER_PHASE
#define MK_PER_PHASE 0
#endif

constexpr int D = 1024, NBATCH = 4, SEQ = 8192, TL = NBATCH * SEQ, CTXL = 256, TC = NBATCH * CTXL, T = TL + TC;
constexpr int NH = 16, HS = 64, NE = 32, TOPK = 4, DEPTH = 4;
constexpr int NMT = T / 256;
constexpr int NMT_L = TL / 256;
constexpr int MAXTILES = (T * TOPK) / 256 + NE;
constexpr int NSTEP = CTXL + SEQ;

__device__ __forceinline__ int lane_id() { return (int)__builtin_amdgcn_mbcnt_hi(~0u, __builtin_amdgcn_mbcnt_lo(~0u, 0u)); }
namespace pg8 {
#define PG8_LAS __attribute__((address_space(3)))
typedef unsigned short bf16_t;
typedef short bf16x8 __attribute__((ext_vector_type(8)));
typedef float f32x4 __attribute__((ext_vector_type(4)));
typedef unsigned u32x4 __attribute__((ext_vector_type(4)));
typedef unsigned u32x2 __attribute__((ext_vector_type(2)));
constexpr int BM = 256, BK = 64, HALF = 128, HTB = HALF * BK * 2  , STAGE_BYTES = 8 * HTB, NXCD = 8, WGM = 8;

__host__ __device__ __forceinline__ int lds_byte(int r, int c) { const int st = (r >> 4) * 2 + (c >> 5), rr = r & 15, cc = c & 31, ob = rr * 64 + cc * 2; return st * 1024 + (ob ^ (((ob >> 9) & 1) << 5)); }
__host__ __device__ __forceinline__ void stage_rc(int b, int& R, int& C) { const int st = b / 1024, sb = b % 1024, swz = sb ^ (((sb >> 9) & 1) << 5); R = (st >> 1) * 16 + swz / 64; C = (st & 1) * 32 + (swz % 64) / 2; }
__host__ __device__ __forceinline__ int perm32(int rho) { const int n = rho >> 4, i = rho & 15; return 8 * (i >> 2) + 4 * n + (i & 3); }

struct Unit { int pm, pn, e, nv, par; };
struct Gemm { const bf16_t* A; const bf16_t* Bt; int M, N, K; };

__device__ __forceinline__ void tile_map(int wgid, int nM, int nN, int& pm, int& pn) {
    const int nwg = nM * nN;
    { const int q = nwg / NXCD, r = nwg % NXCD, xcd = wgid % NXCD, off = wgid / NXCD; wgid = (xcd < r ? xcd * (q + 1) : r * (q + 1) + (xcd - r) * q) + off; }
    const int nig = WGM * nN, gid = wgid / nig, fm = gid * WGM, gsz = (nM - fm) < WGM ? (nM - fm) : WGM;
    pm = fm + ((wgid % nig) % gsz); pn = (wgid % nig) / gsz;
}
typedef __bf16 bf16x2_t __attribute__((ext_vector_type(2)));
typedef float f32x2_t __attribute__((ext_vector_type(2)));
__device__ __forceinline__ unsigned cvt_pk_bf16(float lo, float hi) { const f32x2_t v = {lo, hi}; const bf16x2_t b = __builtin_convertvector(v, bf16x2_t); return __builtin_bit_cast(unsigned, b); }

template <class Epi, class Sched, bool ALIGN_EPI = false, bool SP2 = false, bool GATHER = false>
__device__ __forceinline__ void gemm_phase(PG8_LAS unsigned char* lds, const Gemm g, const Sched& S, const Epi& E, int tid_in) {
    int tid_ = tid_in; asm volatile("" : "+v"(tid_));
    const int tid = tid_, wid = __builtin_amdgcn_readfirstlane(tid >> 6), lane = tid & 63, wr = wid >> 2, wc = wid & 3, fr = lane & 15, fq = lane >> 4;
    int K_ = g.K; asm volatile("" : "+s"(K_));
    const int K = K_, nt = K / BK;
    unsigned voffA[2], voffB[2]; int gR[2]; unsigned gC[2];
#pragma unroll
    for (int i = 0; i < 2; ++i) { int R, C; stage_rc(tid * 16 + i * 8192, R, C); const int Rb = Epi::PERM ? ((R & ~31) + perm32(R & 31)) : R;
        voffA[i] = (unsigned)(R * K + C) * 2u; voffB[i] = (unsigned)(Rb * K + C) * 2u; gR[i] = R; gC[i] = (unsigned)C * 2u; }
    unsigned oc[2][2], on[2][2], o2[2][2];
#pragma unroll
    for (int h = 0; h < 2; ++h)
#pragma unroll
        for (int i = 0; i < 2; ++i) { oc[h][i] = 0u; on[h][i] = 0u; o2[h][i] = 0u; }
    const size_t kstep = (size_t)(BK * 2);
    const size_t hstep = (size_t)HALF * K * 2;
    const size_t tstep = 2 * hstep;
    const unsigned ldsw = (unsigned)wid * 1024u;
    const int aoff = lds_byte(wr * 64 + fr, fq * 8), boff = lds_byte(wc * 32 + fr, fq * 8);
#define PG8_SA(b, h) (((b) * 2 + (h)) * HTB)
#define PG8_SB(b, h) ((4 + (b) * 2 + (h)) * HTB)
#define PG8_STAGE(bufoff, gbase, voff) do { _Pragma("unroll") for (int _i = 0; _i < 2; ++_i) \
        __builtin_amdgcn_global_load_lds((const unsigned*)((const char*)(gbase) + (voff)[_i]), (PG8_LAS unsigned*)(lds + (bufoff) + ldsw + _i * 8192), 16, 0, 0); } while (0)
#define PG8_STAGE_A(bufoff, base, h, O) do { if constexpr (GATHER) { PG8_STAGE(bufoff, base, (O)[h]); } else { PG8_STAGE(bufoff, (base) + (h) * hstep, voffA); } } while (0)
#define PG8_LDA(dst, b, h) do { _Pragma("unroll") for (int m = 0; m < 4; ++m) _Pragma("unroll") for (int k = 0; k < 2; ++k) dst[m][k] = *(const PG8_LAS bf16x8*)(lds + PG8_SA(b, h) + aoff + m * 2048 + k * 1024); } while (0)
#define PG8_LDB(dst, b, h) do { _Pragma("unroll") for (int n = 0; n < 2; ++n) _Pragma("unroll") for (int k = 0; k < 2; ++k) dst[n][k] = *(const PG8_LAS bf16x8*)(lds + PG8_SB(b, h) + boff + n * 2048 + k * 1024); } while (0)
#define PG8_MMA(ai, bj, At, Bt) do { __builtin_amdgcn_s_setprio(1); _Pragma("unroll") for (int m = 0; m < 4; ++m) _Pragma("unroll") for (int n = 0; n < 2; ++n) _Pragma("unroll") for (int k = 0; k < 2; ++k) \
        acc[ai][bj][m][n] = __builtin_amdgcn_mfma_f32_16x16x32_bf16(Bt[n][k], At[m][k], acc[ai][bj][m][n], 0, 0, 0); __builtin_amdgcn_s_setprio(0); } while (0)
#define PG8_WAIT_V(n) asm volatile("s_waitcnt vmcnt(" #n ")" ::: "memory")
#define PG8_WAIT_L(n) asm volatile("s_waitcnt lgkmcnt(" #n ")" ::: "memory")
#define PG8_BAR __builtin_amdgcn_s_barrier()
#define PG8_SCHED __builtin_amdgcn_sched_barrier(0)
    Unit cur, nxt; int ui = 0;
    if (!S.next(0, cur)) return;
    f32x4 acc[2][2][4][2];
#pragma unroll
    for (int a = 0; a < 2; ++a)
#pragma unroll
        for (int b = 0; b < 2; ++b)
#pragma unroll
            for (int m = 0; m < 4; ++m)
#pragma unroll
                for (int n = 0; n < 2; ++n) acc[a][b][m][n] = (f32x4){0.f, 0.f, 0.f, 0.f};
    bf16x8 At[4][2], B0[2][2], B1[2][2];
    const char* cA = GATHER ? (const char*)g.A : (const char*)g.A + (size_t)cur.pm * tstep; const char* cB = (const char*)g.Bt + (size_t)cur.pn * tstep;
    S.a_ready(cur);
    if constexpr (GATHER) {
#pragma unroll
        for (int h = 0; h < 2; ++h)
#pragma unroll
            for (int i = 0; i < 2; ++i) oc[h][i] = S.row_off(cur, h * HALF + gR[i]) + gC[i];
    }
    if constexpr (SP2) {
        PG8_STAGE(PG8_SB(0, 0), cB, voffB); PG8_STAGE(PG8_SB(0, 1), cB + hstep, voffB); PG8_STAGE_A(PG8_SA(0, 0), cA, 0, oc); PG8_STAGE_A(PG8_SA(0, 1), cA, 1, oc);
        if (wr == 1) PG8_BAR;
        PG8_WAIT_V(2); PG8_BAR;
        PG8_STAGE(PG8_SB(1, 0), cB + kstep, voffB); PG8_STAGE_A(PG8_SA(1, 0), cA + kstep, 0, oc); PG8_STAGE(PG8_SB(1, 1), cB + hstep + kstep, voffB);
        PG8_WAIT_V(6); PG8_BAR;
    } else {
        PG8_STAGE(PG8_SB(0, 0), cB, voffB); PG8_STAGE_A(PG8_SA(0, 0), cA, 0, oc); PG8_STAGE(PG8_SB(0, 1), cB + hstep, voffB); PG8_STAGE_A(PG8_SA(0, 1), cA, 1, oc);
        if (wr == 1) PG8_BAR;
        PG8_WAIT_V(4); PG8_BAR;
        PG8_STAGE(PG8_SB(1, 0), cB + kstep, voffB); PG8_STAGE_A(PG8_SA(1, 0), cA + kstep, 0, oc); PG8_STAGE(PG8_SB(1, 1), cB + hstep + kstep, voffB);
        PG8_WAIT_V(6); PG8_BAR;
    }
    for (;;) {
        const bool has_next = S.next(ui + 1, nxt);
        const char* nA = GATHER ? (const char*)g.A : (has_next ? (const char*)g.A + (size_t)nxt.pm * tstep : cA); const char* nB = has_next ? (const char*)g.Bt + (size_t)nxt.pn * tstep : cB;
        if constexpr (GATHER) { if (has_next) S.prefetch_rows(nxt); }
        for (int t = 0; t < nt; t += 2) {
            const bool last = (t == nt - 2);
            const char* a1 = cA + (size_t)(t + 1) * kstep;
            const char* a2 = last ? nA : cA + (size_t)(t + 2) * kstep; const char* b2 = last ? nB : cB + (size_t)(t + 2) * kstep;
            const char* a3 = a2 + kstep; const char* b3 = b2 + kstep;
            if constexpr (GATHER) {
                if (last) {
#pragma unroll
                    for (int h = 0; h < 2; ++h)
#pragma unroll
                        for (int i = 0; i < 2; ++i) on[h][i] = has_next ? (S.row_off_lds(nxt, h * HALF + gR[i]) + gC[i]) : oc[h][i];
                }
#pragma unroll
                for (int h = 0; h < 2; ++h)
#pragma unroll
                    for (int i = 0; i < 2; ++i) o2[h][i] = last ? on[h][i] : oc[h][i];
            }
            if (last && has_next) S.a_ready(nxt);
            if constexpr (SP2) {
            PG8_LDB(B0, 0, 0); PG8_LDB(B1, 0, 1); PG8_SCHED; PG8_LDA(At, 0, 0); PG8_STAGE_A(PG8_SA(1, 1), a1, 1, oc);
            PG8_WAIT_V(8); PG8_WAIT_L(0); PG8_BAR; PG8_MMA(0, 0, At, B0); PG8_MMA(0, 1, At, B1); PG8_BAR; PG8_SCHED;
            PG8_LDA(At, 0, 1); PG8_STAGE(PG8_SB(0, 0), b2, voffB); PG8_STAGE(PG8_SB(0, 1), b2 + hstep, voffB); PG8_STAGE_A(PG8_SA(0, 0), a2, 0, o2);
            PG8_WAIT_V(8); PG8_WAIT_L(0); PG8_BAR; PG8_MMA(1, 0, At, B0); PG8_MMA(1, 1, At, B1); PG8_BAR; PG8_SCHED;
            PG8_LDB(B0, 1, 0); PG8_LDB(B1, 1, 1); PG8_SCHED; PG8_LDA(At, 1, 0); PG8_STAGE_A(PG8_SA(0, 1), a2, 1, o2);
            PG8_WAIT_V(8); PG8_WAIT_L(0); PG8_BAR; PG8_MMA(0, 0, At, B0); PG8_MMA(0, 1, At, B1); PG8_BAR; PG8_SCHED;
            PG8_LDA(At, 1, 1); PG8_STAGE(PG8_SB(1, 0), b3, voffB); PG8_STAGE(PG8_SB(1, 1), b3 + hstep, voffB); PG8_STAGE_A(PG8_SA(1, 0), a3, 0, o2);
            PG8_WAIT_V(8); PG8_WAIT_L(0); PG8_BAR; PG8_MMA(1, 0, At, B0); PG8_MMA(1, 1, At, B1); PG8_BAR; PG8_SCHED;
            } else {
            PG8_LDB(B0, 0, 0); PG8_SCHED; PG8_LDA(At, 0, 0); PG8_STAGE_A(PG8_SA(1, 1), a1, 1, oc);
            PG8_WAIT_L(8); PG8_BAR; PG8_WAIT_L(0); PG8_MMA(0, 0, At, B0); PG8_BAR; PG8_SCHED;
            PG8_LDB(B1, 0, 1); PG8_STAGE(PG8_SB(0, 0), b2, voffB);
            PG8_BAR; PG8_WAIT_L(0); PG8_MMA(0, 1, At, B1); PG8_BAR;
            PG8_LDA(At, 0, 1); PG8_STAGE_A(PG8_SA(0, 0), a2, 0, o2);
            PG8_BAR; PG8_WAIT_L(0); PG8_MMA(1, 0, At, B0); PG8_BAR; PG8_SCHED;
            PG8_STAGE(PG8_SB(0, 1), b2 + hstep, voffB);
            PG8_WAIT_V(6); PG8_BAR; PG8_MMA(1, 1, At, B1); PG8_BAR;
            PG8_LDB(B0, 1, 0); PG8_SCHED; PG8_LDA(At, 1, 0); PG8_STAGE_A(PG8_SA(0, 1), a2, 1, o2);
            PG8_WAIT_L(8); PG8_BAR; PG8_WAIT_L(0); PG8_MMA(0, 0, At, B0); PG8_BAR; PG8_SCHED;
            PG8_LDB(B1, 1, 1); PG8_STAGE(PG8_SB(1, 0), b3, voffB);
            PG8_BAR; PG8_WAIT_L(0); PG8_MMA(0, 1, At, B1); PG8_BAR;
            PG8_LDA(At, 1, 1); PG8_STAGE_A(PG8_SA(1, 0), a3, 0, o2);
            PG8_BAR; PG8_WAIT_L(0); PG8_MMA(1, 0, At, B0); PG8_BAR; PG8_SCHED;
            PG8_STAGE(PG8_SB(1, 1), b3 + hstep, voffB);
            PG8_WAIT_V(6); PG8_BAR; PG8_MMA(1, 1, At, B1); PG8_BAR;
            }
        }
        if constexpr (ALIGN_EPI) { if (wr == 0) PG8_BAR; }
        if constexpr (!Epi::AFTER_DRAIN) { E(acc, cur, wr, wc, fr, fq); S.done(cur); }
        if (!has_next) break;
#pragma unroll
        for (int a = 0; a < 2; ++a)
#pragma unroll
            for (int b = 0; b < 2; ++b)
#pragma unroll
                for (int m = 0; m < 4; ++m)
#pragma unroll
                    for (int n = 0; n < 2; ++n) acc[a][b][m][n] = (f32x4){0.f, 0.f, 0.f, 0.f};
        cur = nxt; cA = nA; cB = nB; ++ui;
        if constexpr (GATHER) {
#pragma unroll
            for (int h = 0; h < 2; ++h)
#pragma unroll
                for (int i = 0; i < 2; ++i) oc[h][i] = on[h][i];
        }
        if constexpr (ALIGN_EPI) { if (wr == 1) PG8_BAR; }
    }
    PG8_WAIT_V(0);
    if constexpr (!ALIGN_EPI) { if (wr == 0) PG8_BAR; }
    PG8_BAR;
    if constexpr (Epi::AFTER_DRAIN) { E.fused(acc, cur, wr, wc, fr, fq, lds, wid, lane); S.done(cur); }
#undef PG8_SA
#undef PG8_SB
#undef PG8_STAGE
#undef PG8_STAGE_A
#undef PG8_LDA
#undef PG8_LDB
#undef PG8_MMA
#undef PG8_WAIT_V
#undef PG8_WAIT_L
#undef PG8_BAR
#undef PG8_SCHED
}
}

#define LAS __attribute__((address_space(3)))
typedef unsigned short bf16;
typedef float f32x4 __attribute__((ext_vector_type(4)));
typedef unsigned u32x2 __attribute__((ext_vector_type(2)));
typedef unsigned u32x4 __attribute__((ext_vector_type(4)));
#define LDS_WAIT() asm volatile("s_waitcnt lgkmcnt(0)" ::: "memory")
__device__ __forceinline__ unsigned pk2(float lo, float hi) { return pg8::cvt_pk_bf16(lo, hi); }
__device__ __forceinline__ unsigned f2bf(float f) { return pk2(f, f) & 0xffffu; }
__device__ __forceinline__ float bflo(unsigned w) { return __builtin_bit_cast(float, w << 16); }
__device__ __forceinline__ float bfhi(unsigned w) { return __builtin_bit_cast(float, w & 0xffff0000u); }
__device__ __forceinline__ float wave_sum(float v) {
#pragma unroll
    for (int o = 1; o < 64; o <<= 1) v += __shfl_xor(v, o);
    return v;
}
__device__ __forceinline__ float sigm(float x) { return 1.0f / (1.0f + __expf(-x)); }
__device__ __forceinline__ float tanh_fast(float x) { const float e = __expf(2.0f * x); return 1.0f - 2.0f / (e + 1.0f); }

constexpr size_t MiB = 1u << 20;
constexpr size_t RF = (size_t)T * D * 4;
constexpr size_t RB = (size_t)T * D * 2;
constexpr size_t WS_CTL = 0, CTL_ZERO_BYTES = 1 * MiB;
constexpr size_t WS_MODS = 1 * MiB;
constexpr size_t WS_XSA = 2 * MiB, WS_XSB = WS_XSA + RF;
constexpr size_t WS_XL = WS_XSB + RF;
constexpr size_t WS_RKV = WS_XL + 6 * RB;
constexpr size_t WS_L1 = WS_RKV + 3 * RF;
constexpr size_t WS_WDEC = WS_L1 + 50 * MiB;
constexpr size_t WS_AA = WS_WDEC + 2 * RF;
constexpr size_t WS_G = WS_AA + 2 * RF;
constexpr size_t WS_KK = WS_G + RB;
constexpr size_t WS_KD = WS_KK + RF;
constexpr size_t WS_BETA = WS_KD + 2 * RF;
constexpr size_t WS_RKB = WS_BETA + 2 * RF;
constexpr size_t WS_C12 = WS_RKB + 3 * MiB;
constexpr size_t WS_WRT = WS_C12 + 6 * MiB;
constexpr size_t WS_Y = WS_C12 + 9 * MiB;
constexpr size_t WS_Z = WS_Y + 2 * RF;
constexpr size_t WS_H2 = WS_Z + RB;
constexpr size_t WS_SLOTL = WS_H2 + RB;
constexpr size_t WS_GATEL = WS_SLOTL + 5 * MiB;
constexpr size_t WS_WRKV = WS_GATEL + 5 * MiB;
constexpr size_t WS_L2T = WS_WRKV + 15 * MiB;
constexpr size_t WS_WO = WS_L2T + 5 * MiB;
constexpr size_t WS_WIN = WS_WO + 4 * MiB;
constexpr size_t WS_WOUT = WS_WIN + 12 * MiB;
constexpr size_t WS_WGU = WS_WOUT + 4 * MiB;
constexpr size_t WS_WDN = WS_WGU + 512 * MiB;
constexpr size_t WS_END = WS_WDN + 256 * MiB;
constexpr size_t WS_INTER = WS_WDEC;
constexpr size_t WS_YS = WS_KD;
constexpr size_t WS_BG = WS_RKV, WS_CUZ = WS_RKV + RB;
constexpr size_t WS_RAWW = WS_AA, WS_RAWA = WS_AA + RF;
constexpr size_t WS_RH = WS_AA;
constexpr size_t WS_PM = WS_WDEC;
constexpr size_t WS_RKB1 = WS_C12 + 1 * MiB;
constexpr size_t WS_QT = WS_XL;
constexpr size_t WS_HT = WS_XL + RF;
static_assert((size_t)128 * 132 * 4096 * 2 <= RF, "chunk state tensors");
static_assert((size_t)MAXTILES * 256 * 1024 * 2 <= 4 * RF, "INTER overlay");
static_assert((size_t)T * 4 * 1024 * 2 <= 2 * RF, "YS overlay");
static_assert((size_t)3 * T * 256 * 2 <= 50 * MiB, "L1OUT");
constexpr int CW_BAR = 4096;
constexpr int CW_CNT = 16384, CNT_STRIDE = 64;

constexpr int RING_BYTES = 131072;
constexpr int LDSCTL_OFF = RING_BYTES;
constexpr int LDS_BYTES = 147456;

struct Args { const float* in[33]; float* out; unsigned char* ws; int ph_lo, ph_hi; };

__device__ __forceinline__ void transpose_item(const float* W, int N, bf16* WT, int dstK, int drow0, int k0, int n0, LAS float* scr, int lane) {
    float tv[32];
#pragma unroll
    for (int i = 0; i < 32; ++i) { const int kk = 2 * i + (lane >> 5); tv[i] = W[(size_t)(k0 + kk) * N + n0 + (lane & 31)]; }
#pragma unroll
    for (int i = 0; i < 32; ++i) { const int kk = 2 * i + (lane >> 5); scr[kk * 33 + (lane & 31)] = tv[i]; }
    LDS_WAIT(); asm volatile("" ::: "memory");
    const int c = lane & 7;
#pragma unroll
    for (int j = 0; j < 4; ++j) { const int n = (lane >> 3) + 8 * j; const LAS float* s = scr + (8 * c) * 33 + n;
        u32x4 o; o.x = pk2(s[0 * 33], s[1 * 33]); o.y = pk2(s[2 * 33], s[3 * 33]); o.z = pk2(s[4 * 33], s[5 * 33]); o.w = pk2(s[6 * 33], s[7 * 33]);
        *(u32x4*)(WT + (size_t)(drow0 + n) * dstK + k0 + 8 * c) = o; }
    LDS_WAIT(); asm volatile("" ::: "memory");
}
__device__ __forceinline__ int gu_map(int n0) { const int bj = n0 >= 1024 ? 1 : 0, f0 = n0 - bj * 1024; return (f0 >> 7) * 256 + bj * 128 + (f0 & 127); }
__device__ __forceinline__ int conv_map(int n0) { if (n0 < 1024) return n0; const int q = (n0 - 1024) >> 10, f0 = (n0 - 1024) & 1023; return 1024 + (f0 >> 7) * 256 + q * 128 + (f0 & 127); }

__device__ __forceinline__ void p0_prologue(const Args& a, LAS unsigned char* lds, int tid, int lane, int wave, int G) {
    unsigned char* ws = a.ws;
    LAS float* sl = (LAS float*)lds;
    LAS float* red = (LAS float*)(lds + 20480);
    for (int i = tid; i < 5 * 1024; i += 512) { const int r = i >> 10, k = i & 1023; const float cv = r < 4 ? a.in[1][r * 1024 + k] : a.in[3][k]; sl[i] = cv / (1.0f + __expf(-cv)); }
    __syncthreads();
    float* MODS = (float*)(ws + WS_MODS);
    for (int it = blockIdx.x; it < 4 * 96; it += G) {
        const int l = it / 96, n = (it % 96) * 64 + lane;
        const float* W = a.in[4] + (size_t)l * 1024 * 6144 + n;
        float acc[5] = {0.f, 0.f, 0.f, 0.f, 0.f};
        const int kb = wave * 128;
#pragma unroll 8
        for (int k = 0; k < 128; ++k) { const float wv = W[(size_t)(kb + k) * 6144];
#pragma unroll
            for (int r = 0; r < 5; ++r) acc[r] += sl[r * 1024 + kb + k] * wv; }
#pragma unroll
        for (int r = 0; r < 5; ++r) red[(wave * 5 + r) * 64 + lane] = acc[r];
        __syncthreads();
        if (wave < 5) { float s = a.in[5][l * 6144 + n];
#pragma unroll
            for (int w = 0; w < 8; ++w) s += red[(w * 5 + wave) * 64 + lane];
            MODS[(size_t)(l * 5 + wave) * 6144 + n] = s; }
        __syncthreads();
    }
    LAS float* scr = (LAS float*)(lds + 32768 + wave * 8448);
    const int gw = blockIdx.x * 8 + wave, NGW = G * 8;
    bf16* WRKV = (bf16*)(ws + WS_WRKV); bf16* WOt = (bf16*)(ws + WS_WO); bf16* WINt = (bf16*)(ws + WS_WIN); bf16* WOUTt = (bf16*)(ws + WS_WOUT);
    bf16* WGU = (bf16*)(ws + WS_WGU); bf16* WDN = (bf16*)(ws + WS_WDN);
    constexpr int I_GU = 128 * 1024, I_DN = 128 * 512, I_RKV = 6 * 512, I_WO = 2 * 512, I_WIN = 2 * 1536, I_WOUT = 2 * 512, I_W1 = 4 * 32, I_A1 = 4 * 32, I_G1 = 2 * 64;
    constexpr int NITEMS = I_GU + I_DN + I_RKV + I_WO + I_WIN + I_WOUT + I_W1 + I_A1 + I_G1;
    for (int it = gw; it < NITEMS; it += NGW) {
        int r = it;
        if (r < I_GU) { const int m = r >> 10, q = r & 1023, kb = q >> 6, nb = q & 63;
            transpose_item(a.in[29] + (size_t)m * 1024 * 2048, 2048, WGU + (size_t)m * 2048 * 1024, 1024, gu_map(nb * 32), kb * 64, nb * 32, scr, lane); continue; } r -= I_GU;
        if (r < I_DN) { const int m = r >> 9, q = r & 511, kb = q >> 5, nb = q & 31;
            transpose_item(a.in[31] + (size_t)m * 1024 * 1024, 1024, WDN + (size_t)m * 1024 * 1024, 1024, nb * 32, kb * 64, nb * 32, scr, lane); continue; } r -= I_DN;
        if (r < I_RKV) { const int m = r >> 9, q = r & 511, kb = q >> 5, nb = q & 31, lr = m / 3, j = m % 3;
            transpose_item(a.in[9] + (size_t)m * 1024 * 1024, 1024, WRKV + (size_t)lr * 3840 * 1024, 1024, j * 1024 + nb * 32, kb * 64, nb * 32, scr, lane); continue; } r -= I_RKV;
        if (r < I_WO) { const int m = r >> 9, q = r & 511, kb = q >> 5, nb = q & 31;
            transpose_item(a.in[23] + (size_t)m * 1024 * 1024, 1024, WOt + (size_t)m * 1024 * 1024, 1024, nb * 32, kb * 64, nb * 32, scr, lane); continue; } r -= I_WO;
        if (r < I_WIN) { const int m = r / 1536, q = r % 1536, kb = q / 96, nb = q % 96;
            transpose_item(a.in[24] + (size_t)m * 1024 * 3072, 3072, WINt + (size_t)m * 3072 * 1024, 1024, conv_map(nb * 32), kb * 64, nb * 32, scr, lane); continue; } r -= I_WIN;
        if (r < I_WOUT) { const int m = r >> 9, q = r & 511, kb = q >> 5, nb = q & 31;
            transpose_item(a.in[26] + (size_t)m * 1024 * 1024, 1024, WOUTt + (size_t)m * 1024 * 1024, 1024, nb * 32, kb * 64, nb * 32, scr, lane); continue; } r -= I_WOUT;
        if (r < I_W1) { const int m = r >> 5, q = r & 31, kb = q >> 1, nb = q & 1, lr = m >> 1, e = m & 1;
            transpose_item(a.in[11] + (size_t)m * 1024 * 64, 64, WRKV + (size_t)lr * 3840 * 1024, 1024, 3072 + e * 64 + nb * 32, kb * 64, nb * 32, scr, lane); continue; } r -= I_W1;
        if (r < I_A1) { const int m = r >> 5, q = r & 31, kb = q >> 1, nb = q & 1, lr = m >> 1, e = m & 1;
            transpose_item(a.in[14] + (size_t)m * 1024 * 64, 64, WRKV + (size_t)lr * 3840 * 1024, 1024, 3328 + e * 64 + nb * 32, kb * 64, nb * 32, scr, lane); continue; } r -= I_A1;
        { const int m = r >> 6, q = r & 63, kb = q >> 2, nb = q & 3;
            transpose_item(a.in[16] + (size_t)m * 1024 * 128, 128, WRKV + (size_t)m * 3840 * 1024, 1024, 3584 + nb * 32, kb * 64, nb * 32, scr, lane); }
    }
    const int gt = blockIdx.x * 512 + tid, NGT = G * 512;
    for (int i = gt; i < 2 * 3 * 128 * 128; i += NGT) {
        const int pc = i & 127, rw = (i >> 7) & 127, pd = (i >> 14) % 3, lr = i / (3 * 16384);
        *(u32x4*)(WRKV + ((size_t)lr * 3840 + 3072 + pd * 256 + 128 + rw) * 1024 + pc * 8) = (u32x4){0u, 0u, 0u, 0u}; }
    bf16* L2T = (bf16*)(ws + WS_L2T);
    for (int i = gt; i < 2 * 128 * 5120; i += NGT) {
        const int n = i % 5120, k = (i / 5120) & 127, lr = i / (5120 * 128);
        float v = 0.f;
        if (n < 2048) { const int e = n >> 10, d = n & 1023; if ((k >> 6) == e) v = a.in[12][(((size_t)lr * 2 + e) * 64 + (k & 63)) * 1024 + d]; }
        else if (n < 4096) { const int e = (n - 2048) >> 10, d = n & 1023; if ((k >> 6) == e) v = a.in[15][(((size_t)lr * 2 + e) * 64 + (k & 63)) * 1024 + d]; }
        else { const int d = n - 4096; v = a.in[17][((size_t)lr * 128 + k) * 1024 + d]; }
        L2T[((size_t)lr * 5120 + n) * 128 + k] = (bf16)f2bf(v);
    }
    bf16* WRT = (bf16*)(ws + WS_WRT);
    for (int i = gt; i < 4 * 32 * 1024; i += NGT) { const int k = i & 1023, e = (i >> 10) & 31, l = i >> 15;
        const float w = a.in[27][((size_t)l * 1024 + k) * 32 + e]; const unsigned hi = f2bf(w); const float lo = w - bflo(hi);
        WRT[((size_t)(l * 2 + 0) * 32 + e) * 1024 + k] = (bf16)hi; WRT[((size_t)(l * 2 + 1) * 32 + e) * 1024 + k] = (bf16)f2bf(lo); }
}
#define XB_TMO      128
#define XB_XCNT(j)  (256  + 64 * (j))
#define XB_XSUB(j)  (1280 + 64 * (j))
#define XB_XGEN(j)  (2304 + 64 * (j))
#define XB_TOP      3328
#define XB_TOPGEN   3392
#define XCD_BAR_WORDS 3456
#define XB_SPIN_CAP (1u << 23)

__device__ __forceinline__ unsigned xb_ld(unsigned* p)              { return __hip_atomic_load(p, __ATOMIC_RELAXED, __HIP_MEMORY_SCOPE_AGENT); }
__device__ __forceinline__ unsigned xb_add(unsigned* p, unsigned v) { return __hip_atomic_fetch_add(p, v, __ATOMIC_RELAXED, __HIP_MEMORY_SCOPE_AGENT); }
__device__ __forceinline__ unsigned xb_xcc_id() { return (unsigned)__builtin_amdgcn_s_getreg((3 << 11) | 20) & 0xFu; }
#define XB_SPIN(cond, bar) do { unsigned _sp = 0; while (cond) { __builtin_amdgcn_s_sleep(1); \
    if ((++_sp & 255u) == 0u) { if (xb_ld(&(bar)[XB_TMO])) break; if (_sp > XB_SPIN_CAP) { atomicAdd(&(bar)[XB_TMO], 1u); break; } } } } while (0)

struct XcdBarrier {
    unsigned wv;
    unsigned* bar; unsigned x;
    volatile LAS unsigned* st;
};

__device__ __forceinline__ XcdBarrier xcd_barrier_post(unsigned* bar, volatile LAS unsigned* st) {
    XcdBarrier b; b.wv = (unsigned)__builtin_amdgcn_readfirstlane((int)(threadIdx.x >> 6)); b.bar = bar; b.x = xb_xcc_id(); b.st = st;
    if (threadIdx.x == 0) (void)xb_add(&bar[XB_XCNT(b.x)], 1u);
    return b;
}
__device__ __forceinline__ void xcd_barrier_complete(unsigned* bar, unsigned x, unsigned& nloc, unsigned& nx) {
    const unsigned G = gridDim.x * gridDim.y * gridDim.z;
    unsigned sum, cnt, mine, sp = 0u;
    for (;;) {
        sum = 0u; cnt = 0u; mine = 0u;
#pragma unroll
        for (unsigned j = 0; j < 16; ++j) { const unsigned c = xb_ld(&bar[XB_XCNT(j)]); sum += c; cnt += (c > 0u) ? 1u : 0u; mine = (j == x) ? c : mine; }
        if (sum == G) break;
        __builtin_amdgcn_s_sleep(1);
        if ((++sp & 255u) == 0u) { if (xb_ld(&bar[XB_TMO])) break; if (sp > XB_SPIN_CAP) { atomicAdd(&bar[XB_TMO], 1u); break; } }
    }
    nloc = mine > 0u ? mine : 1u; nx = cnt > 0u ? cnt : 1u;
}

__device__ __forceinline__ void xcd_barrier(const XcdBarrier& b) {
    asm volatile("s_waitcnt vmcnt(0)" ::: "memory");
    __syncthreads();
    if (b.wv == 0u && lane_id() == 0) {
        unsigned* bar = b.bar;
        __builtin_amdgcn_s_waitcnt(0);
        unsigned nloc = b.st[0], nx = b.st[1];
        if (nloc == 0u) { xcd_barrier_complete(bar, b.x, nloc, nx); b.st[0] = nloc; b.st[1] = nx; }
        const unsigned old = xb_add(&bar[XB_XSUB(b.x)], 1u);
        const unsigned gen = old / nloc;
        if (old + 1u == (gen + 1u) * nloc) {
            __builtin_amdgcn_fence(__ATOMIC_RELEASE, "agent");
            asm volatile("s_waitcnt vmcnt(0)" ::: "memory");
            const unsigned og = xb_add(&bar[XB_TOP], 1u);
            const unsigned tg = og / nx;
            if (og + 1u == (tg + 1u) * nx) xb_add(&bar[XB_TOPGEN], 1u);
            else XB_SPIN(xb_ld(&bar[XB_TOPGEN]) == tg, bar);
            __builtin_amdgcn_fence(__ATOMIC_ACQUIRE, "agent");
            xb_add(&bar[XB_XGEN(b.x)], 1u);
            asm volatile("s_waitcnt vmcnt(0)" ::: "memory");
        } else {
            XB_SPIN(xb_ld(&bar[XB_XGEN(b.x)]) == gen, bar);
            __builtin_amdgcn_fence(__ATOMIC_ACQUIRE, "agent");
            asm volatile("s_waitcnt vmcnt(0)" ::: "memory");
        }
    }
    __syncthreads();
}

__device__ __forceinline__ int mod_row(int row) { return row < TL ? (row >> 13) : 4; }

__device__ __forceinline__ void load_x_combined(f32x4 (&x)[4], const float* xrow, bool has_prev, const bf16* YS, int t, const f32x4 (&m5)[4], int lane) {
#pragma unroll
    for (int j = 0; j < 4; ++j) x[j] = *(const f32x4*)(xrow + 256 * j + 4 * lane);
    if (has_prev) {
        f32x4 s[4];
#pragma unroll
        for (int j = 0; j < 4; ++j) s[j] = (f32x4){0.f, 0.f, 0.f, 0.f};
#pragma unroll
        for (int k = 0; k < 4; ++k) { const bf16* yr = YS + ((size_t)t * 4 + k) * 1024;
#pragma unroll
            for (int j = 0; j < 4; ++j) { const u32x2 w = *(const u32x2*)(yr + 256 * j + 4 * lane); s[j] += (f32x4){bflo(w.x), bfhi(w.x), bflo(w.y), bfhi(w.y)}; } }
#pragma unroll
        for (int j = 0; j < 4; ++j) x[j] += m5[j] * s[j];
    }
}
__device__ __forceinline__ float row_rstd(const f32x4 (&x)[4]) {
    float ss = 0.f;
#pragma unroll
    for (int j = 0; j < 4; ++j) ss += (x[j].x * x[j].x + x[j].y * x[j].y) + (x[j].z * x[j].z + x[j].w * x[j].w);
    return rsqrtf(wave_sum(ss) * (1.0f / 1024.0f) + 1e-6f);
}

__device__ __forceinline__ void phase_a_rwkv(const Args& a, int layer, LAS unsigned char* lds, int tid, int gw, int NGW, int lane) {
    unsigned char* ws = a.ws; const int lj = layer >> 1; const bool has_prev = layer > 0;
    const float* xin_lat = layer == 0 ? a.in[0] : (const float*)(ws + WS_XSA);
    const float* xin_ctx = layer == 0 ? a.in[2] : (const float*)(ws + WS_XSA) + (size_t)TL * D;
    float* xout = (float*)(ws + (layer == 0 ? WS_XSA : WS_XSB));
    const float* MODS = (const float*)(ws + WS_MODS); const bf16* YS = (const bf16*)(ws + WS_YS); bf16* XL = (bf16*)(ws + WS_XL);
    const float* mug = a.in[8] + (size_t)lj * 6 * 2 * 1024; const float* ng = a.in[6] + (size_t)(layer * 2 + 0) * 1024;
    LAS float* mu = (LAS float*)lds;
    for (int i = tid; i < 6 * 2 * 1024 / 4; i += 512) ((LAS f32x4*)mu)[i] = ((const f32x4*)mug)[i];
    __syncthreads();
    for (int it = gw; it < TL / 8 + TC / 2; it += NGW) {
        const int ntok = it < TL / 8 ? 8 : 2, t0 = it < TL / 8 ? it * 8 : TL + (it - TL / 8) * 2, mr = mod_row(t0);
        int rs, re; if (t0 < TL) { rs = t0 & ~63; re = rs + 63; } else { const int loc = t0 - TL; rs = TL + (loc & ~255); re = rs + 255; }
        const float* mod = MODS + (size_t)(layer * 5 + mr) * 6144;
        const float* m5p = MODS + (size_t)((has_prev ? layer - 1 : 0) * 5 + mr) * 6144 + 5 * 1024;
        f32x4 hm[4], h0[4], hp[4];
#pragma unroll
        for (int j = 0; j < 4; ++j) { hm[j] = (f32x4){0.f, 0.f, 0.f, 0.f}; h0[j] = hm[j]; hp[j] = hm[j]; }
        f32x4 rx[4], nx[4]; u32x2 ry[4][4], ny[4][4];
#define PA_LOAD(X, Y, tt) do { const int t_ = (tt); if (t_ >= rs && t_ <= re) { \
            const float* xrow_ = t_ < TL ? xin_lat + (size_t)t_ * D : xin_ctx + (size_t)(t_ - TL) * D; \
            _Pragma("unroll") for (int j = 0; j < 4; ++j) X[j] = *(const f32x4*)(xrow_ + 256 * j + 4 * lane); \
            if (has_prev) { _Pragma("unroll") for (int k = 0; k < 4; ++k) _Pragma("unroll") for (int j = 0; j < 4; ++j) Y[k][j] = *(const u32x2*)(YS + ((size_t)t_ * 4 + k) * 1024 + 256 * j + 4 * lane); } } } while (0)
#pragma unroll
        for (int j = 0; j < 4; ++j) { rx[j] = (f32x4){0.f, 0.f, 0.f, 0.f}; nx[j] = rx[j];
#pragma unroll
            for (int k = 0; k < 4; ++k) { ry[k][j] = (u32x2){0u, 0u}; ny[k][j] = ry[k][j]; } }
        PA_LOAD(rx, ry, t0 - 1);
#pragma unroll 1
        for (int i = -1; i <= ntok; ++i) {
            const int t = t0 + i;
            if (i < ntok) PA_LOAD(nx, ny, t + 1);
            f32x4 hn[4];
            if (t >= rs && t <= re) {
                f32x4 x[4];
#pragma unroll
                for (int j = 0; j < 4; ++j) x[j] = rx[j];
                if (has_prev) {
#pragma unroll
                    for (int j = 0; j < 4; ++j) { f32x4 sm = (f32x4){0.f, 0.f, 0.f, 0.f};
#pragma unroll
                        for (int k = 0; k < 4; ++k) sm += (f32x4){bflo(ry[k][j].x), bfhi(ry[k][j].x), bflo(ry[k][j].y), bfhi(ry[k][j].y)};
                        x[j] += *(const f32x4*)(m5p + 256 * j + 4 * lane) * sm; } }
                if (i >= 0 && i < ntok) {
#pragma unroll
                    for (int j = 0; j < 4; ++j) *(f32x4*)(xout + (size_t)t * D + 256 * j + 4 * lane) = x[j]; }
                const float rstd = row_rstd(x);
#pragma unroll
                for (int j = 0; j < 4; ++j) { const int col = 256 * j + 4 * lane; hn[j] = x[j] * rstd * *(const f32x4*)(ng + col) * (*(const f32x4*)(mod + 1024 + col) + 1.0f) + *(const f32x4*)(mod + col); }
            } else {
#pragma unroll
                for (int j = 0; j < 4; ++j) hn[j] = (f32x4){0.f, 0.f, 0.f, 0.f};
            }
#pragma unroll
            for (int j = 0; j < 4; ++j) { hm[j] = h0[j]; h0[j] = hp[j]; hp[j] = hn[j]; rx[j] = nx[j];
#pragma unroll
                for (int k = 0; k < 4; ++k) ry[k][j] = ny[k][j]; }
            if (i >= 1) {
                const int te = t - 1;
#pragma unroll
                for (int q = 0; q < 6; ++q) {
                    bf16* orow = XL + ((size_t)q * T + te) * D;
#pragma unroll
                    for (int j = 0; j < 4; ++j) { const int col = 256 * j + 4 * lane;
                        const f32x4 m0 = *(const LAS f32x4*)(mu + (q * 2 + 0) * 1024 + col), m1 = *(const LAS f32x4*)(mu + (q * 2 + 1) * 1024 + col);
                        const f32x4 o = h0[j] + m0 * (hm[j] - h0[j]) + m1 * (hp[j] - h0[j]);
                        u32x2 w; w.x = pk2(o.x, o.y); w.y = pk2(o.z, o.w); *(u32x2*)(orow + col) = w; }
                }
            }
        }
#undef PA_LOAD
    }
}
__device__ __forceinline__ void phase_a_conv(const Args& a, int layer, int rows, int gw, int NGW, int lane) {
    unsigned char* ws = a.ws;
    float* xs = (float*)(ws + (layer < 2 ? WS_XSA : WS_XSB));
    const float* MODS = (const float*)(ws + WS_MODS); const bf16* YS = (const bf16*)(ws + WS_YS); bf16* H = (bf16*)(ws + WS_XL);
    const float* ng = a.in[6] + (size_t)(layer * 2 + 0) * 1024;
    for (int t = gw; t < rows; t += NGW) {
        const int mr = mod_row(t);
        const float* mod = MODS + (size_t)(layer * 5 + mr) * 6144;
        f32x4 m5[4], x[4];
#pragma unroll
        for (int j = 0; j < 4; ++j) m5[j] = *(const f32x4*)(MODS + (size_t)((layer - 1) * 5 + mr) * 6144 + 5 * 1024 + 256 * j + 4 * lane);
        load_x_combined(x, xs + (size_t)t * D, true, YS, t, m5, lane);
        const float rstd = row_rstd(x);
#pragma unroll
        for (int j = 0; j < 4; ++j) { const int col = 256 * j + 4 * lane;
            *(f32x4*)(xs + (size_t)t * D + col) = x[j];
            const f32x4 h = x[j] * rstd * *(const f32x4*)(ng + col) * (*(const f32x4*)(mod + 1024 + col) + 1.0f) + *(const f32x4*)(mod + col);
            u32x2 w; w.x = pk2(h.x, h.y); w.y = pk2(h.z, h.w); *(u32x2*)(H + (size_t)t * D + col) = w; }
    }
}
#define DPPF(x, ctrl) __builtin_bit_cast(float, __builtin_amdgcn_update_dpp(0, __builtin_bit_cast(int, (x)), (ctrl), 0xf, 0xf, false))
__device__ __forceinline__ float row16_sum(float v) { v += DPPF(v, 0xB1); v += DPPF(v, 0x4E); v += DPPF(v, 0x141); v += DPPF(v, 0x140); return v; }
__device__ __forceinline__ f32x4 bf4(u32x2 w) { return (f32x4){bflo(w.x), bfhi(w.x), bflo(w.y), bfhi(w.y)}; }
__device__ __forceinline__ u32x2 pk4(f32x4 v) { u32x2 w; w.x = pk2(v[0], v[1]); w.y = pk2(v[2], v[3]); return w; }
__device__ __forceinline__ void phase_c_prep(const Args& a, int lj, LAS unsigned char* lds, int tid, int gw, int NGW, int lane) {
    unsigned char* ws = a.ws;
    const bf16* Rr = (const bf16*)(ws + WS_RKV); const bf16* Kk = Rr + (size_t)T * D; const bf16* RA = (const bf16*)(ws + WS_RAWA); const bf16* RW = (const bf16*)(ws + WS_RAWW);
    bf16* KK = (bf16*)(ws + WS_KK); bf16* KD = (bf16*)(ws + WS_KD); bf16* BE = (bf16*)(ws + WS_BETA); float* RKB = (float*)(ws + WS_RKB);
    LAS float* tb = (LAS float*)lds;
    for (int i = tid; i < 7 * 256; i += 512) { const int t7 = i >> 8, q = i & 255;
        const float* src = t7 == 0 ? a.in[18] + lj * 1024 : t7 == 1 ? a.in[19] + lj * 1024 : t7 == 2 ? a.in[20] + lj * 1024 : t7 < 5 ? a.in[10] + lj * 2048 + (t7 - 3) * 1024 : a.in[13] + lj * 2048 + (t7 - 5) * 1024;
        ((LAS f32x4*)tb)[i] = ((const f32x4*)src)[q]; }
    __syncthreads();
    for (int row = gw; row < T; row += NGW) {
#pragma unroll
        for (int j = 0; j < 4; ++j) {
            const int col = 256 * j + 4 * lane; const size_t ro = (size_t)row * D + col;
            const f32x4 k = bf4(*(const u32x2*)(Kk + ro)), r = bf4(*(const u32x2*)(Rr + ro));
            f32x4 a0 = bf4(*(const u32x2*)(RA + ro)) + *(const LAS f32x4*)(tb + 5 * 1024 + col), a1 = bf4(*(const u32x2*)(RA + (size_t)T * D + ro)) + *(const LAS f32x4*)(tb + 6 * 1024 + col);
#pragma unroll
            for (int z = 0; z < 4; ++z) { a0[z] = sigm(a0[z]); a1[z] = sigm(a1[z]); }
            const f32x4 ck = *(const LAS f32x4*)(tb + col), ca = *(const LAS f32x4*)(tb + 1024 + col), cr = *(const LAS f32x4*)(tb + 2048 + col);
            const f32x4 kk = k * ck;
            const float ss = row16_sum((kk.x * kk.x + kk.y * kk.y) + (kk.z * kk.z + kk.w * kk.w));
            const f32x4 kd0 = k * ((a0 - 1.0f) * ca + 1.0f), kd1 = k * ((a1 - 1.0f) * ca + 1.0f);
            *(u32x2*)(KD + ro) = pk4(kd0); *(u32x2*)(KD + (size_t)T * D + ro) = pk4(kd1);
            const f32x4 p = r * (kd0 + kd1) * cr;
            const float rk = row16_sum((p.x + p.y) + (p.z + p.w));
            const f32x4 kkn = kk * (1.0f / fmaxf(sqrtf(ss), 1e-12f));
            *(u32x2*)(KK + ro) = pk4(kkn); *(u32x2*)(BE + ro) = pk4(kkn * a0); *(u32x2*)(BE + (size_t)T * D + ro) = pk4(kkn * a1);
            if ((lane & 15) == 0) RKB[(size_t)row * 16 + 4 * j + (lane >> 4)] = rk;
        }
    }
}
typedef short bf16x8 __attribute__((ext_vector_type(8)));
__device__ __forceinline__ f32x4 mfma16(bf16x8 a, bf16x8 b, f32x4 c) { return __builtin_amdgcn_mfma_f32_16x16x32_bf16(a, b, c, 0, 0, 0); }
__device__ __forceinline__ bf16x8 as_frag(u32x4 w) { return __builtin_bit_cast(bf16x8, w); }
constexpr int CH_LD = 144;
constexpr int CH_MS = 64 * CH_LD;
constexpr int CH_AB = 0 * CH_MS, CH_KT = 1 * CH_MS, CH_BT = 2 * CH_MS, CH_RB = 3 * CH_MS, CH_VT = 4 * CH_MS, CH_ABT = 5 * CH_MS, CH_KHT = 6 * CH_MS, CH_BHT = 7 * CH_MS,
              CH_LK = 8 * CH_MS, CH_LB = 9 * CH_MS, CH_MK = 10 * CH_MS, CH_MB = 11 * CH_MS, CH_WT = 12 * CH_MS, CH_U0 = 13 * CH_MS, CH_DINV = 14 * CH_MS;
constexpr int CH_GC = LDSCTL_OFF + 2048;
constexpr int CH_PART = LDSCTL_OFF + 4096;
constexpr int NCHUNK = NSTEP / 64;
#ifndef S1_DBL
#define S1_DBL 0
#endif
static_assert(CH_DINV + 2048 <= RING_BYTES, "chunk LDS map");

__device__ __forceinline__ int scan_row(int s, int dir, int b) {
    if (s < CTXL) return TL + b * CTXL + (dir ? CTXL - 1 - s : s);
    const int i = s - CTXL; return b * SEQ + (dir ? SEQ - 1 - i : i);
}
#define CH_FRAG(mat, row, ks, kg) as_frag(*(const LAS u32x4*)(lds + (mat) + (row) * CH_LD + ((ks) * 32 + (kg) * 8) * 2))

__device__ __forceinline__ float s1_treduce16(const float (&a)[16], bool b3, bool b2) {
    float b[8];
#pragma unroll
    for (int i = 0; i < 8; ++i) { float x = a[i], y = a[i + 8];
        asm("s_nop 1\n\tv_permlane32_swap_b32 %0, %1" : "+v"(x), "+v"(y));
        b[i] = x + y; }
    float c[4];
#pragma unroll
    for (int i = 0; i < 4; ++i) { float x = b[i], y = b[i + 4];
        asm("s_nop 1\n\tv_permlane16_swap_b32 %0, %1" : "+v"(x), "+v"(y));
        c[i] = x + y; }
    float d[2];
#pragma unroll
    for (int i = 0; i < 2; ++i) { const float keep = b3 ? c[i + 2] : c[i], send = b3 ? c[i] : c[i + 2]; d[i] = keep + DPPF(send, 0x128); }
    const float keep = b2 ? d[1] : d[0], send = b2 ? d[0] : d[1];
    float e = keep + DPPF(send, 0x141);
    e += DPPF(e, 0xB1);
    e += DPPF(e, 0x4E);
    return e;
}
#define S1_BAR() do { asm volatile("s_waitcnt lgkmcnt(0)" ::: "memory"); __builtin_amdgcn_s_barrier(); asm volatile("" ::: "memory"); } while (0)
__device__ __forceinline__ void phase_s1_chunks(const Args& a, int lj, LAS unsigned char* lds, int tid, int G, int rh_scratch = 0) {
    unsigned char* ws = a.ws; const float* w0l = a.in[10] + lj * 2048; const float* a0l = a.in[13] + lj * 2048;
    const float* pkk = a.in[18] + lj * 1024; const float* pka = a.in[19] + lj * 1024; const float* prk = a.in[20] + lj * 1024;
    const int lane = tid & 63, wave = __builtin_amdgcn_readfirstlane(tid >> 6), l15 = lane & 15, g = lane >> 4;
    LAS float* part = (LAS float*)(lds + CH_PART); LAS float* gammaC = (LAS float*)(lds + CH_GC);
    float nlw[8], nka[8], nkr[8], nrr[8], nvv[8], nw0 = 0.f, na0 = 0.f, npkk = 0.f, npka = 0.f, nprk = 0.f;
#define S1_LOAD(ctx_) do { unsigned char* wsl = ws; asm volatile("" : "+s"(wsl));     \
        const int chain_ = (ctx_) / NCHUNK, c_ = (ctx_) - chain_ * NCHUNK, dir_ = chain_ >> 6, b_ = (chain_ >> 4) & 3, h_ = chain_ & 15; \
          \
        const long o0 = (long)scan_row(64 * c_ + 8 * wave, dir_, b_) * D + h_ * 64 + lane, od = (long)dir_ * T * D, st = dir_ ? -(long)D : (long)D; \
        const bf16* LWp = (const bf16*)(wsl + WS_RAWW) + od + o0; const bf16* RAp = (const bf16*)(wsl + WS_RAWA) + od + o0; \
        const bf16* Rp = (const bf16*)(wsl + WS_RKV) + o0; const bf16* Kp = Rp + (size_t)T * D; const bf16* Vp = Rp + (size_t)2 * T * D; \
        nw0 = w0l[dir_ * 1024 + h_ * 64 + lane]; na0 = a0l[dir_ * 1024 + h_ * 64 + lane]; npkk = pkk[h_ * 64 + lane]; npka = pka[h_ * 64 + lane]; nprk = prk[h_ * 64 + lane]; \
        _Pragma("unroll") for (int j = 0; j < 8; ++j) { const long oj = st * j; \
            nlw[j] = bflo((unsigned)LWp[oj]); nka[j] = bflo((unsigned)RAp[oj]); nkr[j] = bflo((unsigned)Kp[oj]); nrr[j] = bflo((unsigned)Rp[oj]); nvv[j] = bflo((unsigned)Vp[oj]); } } while (0)
    if ((int)blockIdx.x < 128 * NCHUNK) S1_LOAD((int)blockIdx.x);
    for (int ct = blockIdx.x; ct < 128 * NCHUNK; ct += G) {
        const int chain = ct / NCHUNK, c = ct - chain * NCHUNK, dir = chain >> 6, b = (chain >> 4) & 3, h = chain & 15;
        unsigned zq = 0u; asm volatile("" : "+v"(zq));
        {
            const int k = lane, tq = wave;
            float lw[8], kd[8], be[8], kk[8], rr[8], vv[8];
            {
                const float w0k = nw0, a0k = na0, ckk = npkk, cka = npka, crk = nprk;
                float* RKBd = (float*)(ws + (dir ? WS_RKB1 : WS_RKB));
                const int row0 = scan_row(64 * c + 8 * tq, dir, b), rst = dir ? -1 : 1;
                float av[8], kq[8], red[16];
#pragma unroll
                for (int j = 0; j < 8; ++j) { av[j] = sigm(nka[j] + a0k); const float kr = nkr[j];
                    lw[j] = -0.60653066f * sigm(nlw[j] + w0k);
                    kq[j] = kr * ckk; kd[j] = kr * ((av[j] - 1.0f) * cka + 1.0f); rr[j] = nrr[j]; vv[j] = nvv[j];
                    red[2 * j] = kq[j] * kq[j]; red[2 * j + 1] = rr[j] * kd[j] * crk; }
                const float tot = s1_treduce16(red, (lane & 8) != 0, (lane & 4) != 0);
                if ((lane & 7) == 4) RKBd[(size_t)(row0 + rst * (lane >> 3)) * 16 + h] = tot;
#pragma unroll
                for (int j = 0; j < 8; ++j) { const float ss = __builtin_bit_cast(float, __builtin_amdgcn_readlane(__builtin_bit_cast(int, tot), 8 * j));
                    kk[j] = kq[j] * (1.0f / fmaxf(sqrtf(ss), 1e-12f)); be[j] = kk[j] * av[j]; }
            }
            if (ct + G < 128 * NCHUNK) S1_LOAD(ct + G);
            for (int r0_ = 0; r0_ <= ((S1_DBL >> 3) & 1); ++r0_) { if (r0_) S1_BAR();
            float p[8]; p[0] = lw[0];
#pragma unroll
            for (int j = 1; j < 8; ++j) p[j] = p[j - 1] + lw[j];
            part[tq * 64 + k] = p[7];
            S1_BAR();
            float off = 0.f, tot = 0.f;
#pragma unroll
            for (int q = 0; q < 8; ++q) { const float pv = part[q * 64 + k]; tot += pv; off += q < tq ? pv : 0.f; }
            const float eTot = __expf(tot); float ePrev = __expf(off);
            if (tq == 0) gammaC[k] = eTot;
            unsigned abw[4], khw[4], bhw[4], vw[4];
#pragma unroll
            for (int j = 0; j < 8; j += 2) {
                float ab2[2], kt2[2], bt2[2], rb2[2], kh2[2], bh2[2];
#pragma unroll
                for (int z = 0; z < 2; ++z) { const float cu = off + p[j + z]; const float eP = __expf(cu), eM = __expf(-cu), eC = eTot * eM;
                    ab2[z] = kk[j + z] * ePrev; ePrev = eP; kt2[z] = kd[j + z] * eM; bt2[z] = be[j + z] * eM; rb2[z] = rr[j + z] * eP; kh2[z] = kd[j + z] * eC; bh2[z] = be[j + z] * eC;
                    const int t = 8 * tq + j + z;
                    *(LAS bf16*)(lds + CH_AB + t * CH_LD + k * 2) = (bf16)f2bf(ab2[z]); *(LAS bf16*)(lds + CH_KT + t * CH_LD + k * 2) = (bf16)f2bf(kt2[z]);
                    *(LAS bf16*)(lds + CH_BT + t * CH_LD + k * 2) = (bf16)f2bf(bt2[z]); *(LAS bf16*)(lds + CH_RB + t * CH_LD + k * 2) = (bf16)f2bf(rb2[z]); }
                abw[j >> 1] = pk2(ab2[0], ab2[1]); khw[j >> 1] = pk2(kh2[0], kh2[1]); bhw[j >> 1] = pk2(bh2[0], bh2[1]); vw[j >> 1] = pk2(vv[j], vv[j + 1]);
            }
            *(LAS u32x4*)(lds + CH_ABT + k * CH_LD + tq * 16) = (u32x4){abw[0], abw[1], abw[2], abw[3]};
            *(LAS u32x4*)(lds + CH_KHT + k * CH_LD + tq * 16) = (u32x4){khw[0], khw[1], khw[2], khw[3]};
            *(LAS u32x4*)(lds + CH_BHT + k * CH_LD + tq * 16) = (u32x4){bhw[0], bhw[1], bhw[2], bhw[3]};
            *(LAS u32x4*)(lds + CH_VT + k * CH_LD + tq * 16) = (u32x4){vw[0], vw[1], vw[2], vw[3]};
            *(LAS u32x4*)(lds + CH_WT + k * CH_LD + tq * 16) = (u32x4){zq, zq, zq, zq}; *(LAS u32x4*)(lds + CH_U0 + k * CH_LD + tq * 16) = (u32x4){zq, zq, zq, zq};
            }
        }
        S1_BAR();
        for (int r1_ = 0; r1_ <= (S1_DBL & 1); ++r1_) { if (r1_) S1_BAR();
            const int mi = wave >> 1, half = wave & 1;
            const int matS = (mi & 1) ? CH_BT : CH_KT, matT = (mi & 2) ? CH_RB : CH_AB, matO = CH_LK + mi * CH_MS;
            const bool incl = (mi & 2) != 0;
            bf16x8 fs[4][2], ft[2][2];
#pragma unroll
            for (int ms = 0; ms < 4; ++ms)
#pragma unroll
                for (int ks = 0; ks < 2; ++ks) fs[ms][ks] = CH_FRAG(matS, 16 * ms + l15, ks, g);
#pragma unroll
            for (int nt = 0; nt < 2; ++nt)
#pragma unroll
                for (int ks = 0; ks < 2; ++ks) ft[nt][ks] = CH_FRAG(matT, 32 * half + 16 * nt + l15, ks, g);
#pragma unroll
            for (int nt = 0; nt < 2; ++nt) { const int t = 32 * half + 16 * nt + l15;
#pragma unroll
                for (int ms = 0; ms < 4; ++ms) { f32x4 d = (f32x4){0.f, 0.f, 0.f, 0.f};
                    d = mfma16(fs[ms][0], ft[nt][0], d); d = mfma16(fs[ms][1], ft[nt][1], d);
                    const int s0 = 16 * ms + 4 * g;
#pragma unroll
                    for (int i = 0; i < 4; ++i) { const bool keep = incl ? (s0 + i <= t) : (s0 + i < t); d[i] = keep ? d[i] : __builtin_bit_cast(float, zq); }
                    u32x2 w; w.x = pk2(d[0], d[1]); w.y = pk2(d[2], d[3]);
                    *(LAS u32x2*)(lds + matO + t * CH_LD + s0 * 2) = w; } }
        }
        S1_BAR();
        f32x4 rhsU[4];
#pragma unroll
        for (int I = 0; I < 4; ++I) rhsU[I] = (f32x4){0.f, 0.f, 0.f, 0.f};
        if (wave >= 4) {
            const int ctv = (wave & 3) * 16;
            const bf16x8 fv0 = CH_FRAG(CH_VT, ctv + l15, 0, g), fv1 = CH_FRAG(CH_VT, ctv + l15, 1, g);
#pragma unroll
            for (int I = 0; I < 4; ++I) { f32x4 d = (f32x4){0.f, 0.f, 0.f, 0.f};
                d = mfma16(CH_FRAG(CH_LK, 16 * I + l15, 0, g), fv0, d); d = mfma16(CH_FRAG(CH_LK, 16 * I + l15, 1, g), fv1, d); rhsU[I] = -d; }
        }
        for (int r2_ = 0; r2_ <= ((S1_DBL >> 1) & 1); ++r2_) if (wave == 0) {
            const int bb = lane >> 4, j = lane & 15;
            float x[16];
#pragma unroll
            for (int t = 0; t < 16; ++t) {
                const u32x4 r0 = *(const LAS u32x4*)(lds + CH_LB + (16 * bb + t) * CH_LD + 32 * bb), r1 = *(const LAS u32x4*)(lds + CH_LB + (16 * bb + t) * CH_LD + 32 * bb + 16);
                const unsigned rw[8] = {r0.x, r0.y, r0.z, r0.w, r1.x, r1.y, r1.z, r1.w};
                float acc = (t == j) ? 1.0f : 0.0f;
#pragma unroll
                for (int s = 0; s < t; ++s) { const float lv = (s & 1) ? bfhi(rw[s >> 1]) : bflo(rw[s >> 1]); acc -= lv * x[s]; }
                x[t] = acc;
                *(LAS bf16*)(lds + CH_DINV + ((bb * 16 + t) * 16 + j) * 2) = (bf16)f2bf(acc);
            }
        }
        S1_BAR();
        {
            const int matZ = wave < 4 ? CH_WT : CH_U0, ct16 = (wave & 3) * 16;
            for (int r4_ = 0; r4_ <= ((S1_DBL >> 4) & 1); ++r4_) { if (r4_) { *(LAS u32x4*)(lds + matZ + (ct16 + l15) * CH_LD + g * 32) = (u32x4){zq, zq, zq, zq}; *(LAS u32x4*)(lds + matZ + (ct16 + l15) * CH_LD + g * 32 + 16) = (u32x4){zq, zq, zq, zq}; LDS_WAIT(); }
#pragma unroll
            for (int I = 0; I < 4; ++I) {
                f32x4 rhs;
                if (wave < 4) { const u32x2 w = *(const LAS u32x2*)(lds + CH_ABT + (ct16 + l15) * CH_LD + (16 * I + 4 * g) * 2); rhs = (f32x4){bflo(w.x), bfhi(w.x), bflo(w.y), bfhi(w.y)}; }
                else rhs = rhsU[I];
                f32x4 d = (f32x4){0.f, 0.f, 0.f, 0.f};
                d = mfma16(CH_FRAG(CH_LB, 16 * I + l15, 0, g), CH_FRAG(matZ, ct16 + l15, 0, g), d); d = mfma16(CH_FRAG(CH_LB, 16 * I + l15, 1, g), CH_FRAG(matZ, ct16 + l15, 1, g), d);
                const f32x4 ac = rhs - d;
                const u32x2 dv = *(const LAS u32x2*)(lds + CH_DINV + ((I * 16 + l15) * 16 + 4 * g) * 2);
                const bf16x8 fa = as_frag((u32x4){dv.x, dv.y, zq, zq}), fb = as_frag((u32x4){pk2(ac[0], ac[1]), pk2(ac[2], ac[3]), zq, zq});
                const f32x4 z = mfma16(fa, fb, (f32x4){0.f, 0.f, 0.f, 0.f});
                u32x2 w; w.x = pk2(z[0], z[1]); w.y = pk2(z[2], z[3]);
                *(LAS u32x2*)(lds + matZ + (ct16 + l15) * CH_LD + (16 * I + 4 * g) * 2) = w;
                LDS_WAIT(); asm volatile("" ::: "memory");
            }
            }
        }
        S1_BAR();
        for (int r3_ = 0; r3_ <= ((S1_DBL >> 2) & 1); ++r3_) { if (r3_) S1_BAR();
            const int rt = wave >> 1, cp = (wave & 1) * 2;
            unsigned char* wsl = ws; asm volatile("" : "+s"(wsl));
            bf16* YL = (bf16*)(wsl + WS_Y); bf16* RH = (bf16*)(wsl + (rh_scratch ? WS_BETA + RF : WS_RH)); bf16* PM = (bf16*)(wsl + WS_PM); bf16* QT = (bf16*)(wsl + WS_QT);
            const int trow = scan_row(64 * c + 16 * rt + l15, dir, b);
#pragma unroll
            for (int q = 0; q < 2; ++q) { const int vt = cp + q; f32x4 d = (f32x4){0.f, 0.f, 0.f, 0.f};
#pragma unroll
                for (int ks = 0; ks < 2; ++ks) { d = mfma16(CH_FRAG(CH_VT, 16 * vt + l15, ks, g), CH_FRAG(CH_MK, 16 * rt + l15, ks, g), d); d = mfma16(CH_FRAG(CH_U0, 16 * vt + l15, ks, g), CH_FRAG(CH_MB, 16 * rt + l15, ks, g), d); }
                *(u32x2*)(YL + ((size_t)dir * T + trow) * D + h * 64 + 16 * vt + 4 * g) = pk4(d); }
#pragma unroll
            for (int q = 0; q < 2; ++q) { const int kt = cp + q; f32x4 d = (f32x4){0.f, 0.f, 0.f, 0.f};
#pragma unroll
                for (int ks = 0; ks < 2; ++ks) d = mfma16(CH_FRAG(CH_WT, 16 * kt + l15, ks, g), CH_FRAG(CH_MB, 16 * rt + l15, ks, g), d);
                const u32x2 rbw = *(const LAS u32x2*)(lds + CH_RB + (16 * rt + l15) * CH_LD + (16 * kt + 4 * g) * 2);
                u32x2 w; w.x = pk2(bflo(rbw.x) - d[0], bfhi(rbw.x) - d[1]); w.y = pk2(bflo(rbw.y) - d[2], bfhi(rbw.y) - d[3]);
                *(u32x2*)(RH + ((size_t)dir * T + trow) * D + h * 64 + 16 * kt + 4 * g) = w; }
            bf16* Pc = PM + ((size_t)chain * NCHUNK + c) * 4096; bf16* Qc = QT + ((size_t)chain * NCHUNK + c) * 4096;
            { const int krow = 16 * rt + l15; const float gc = gammaC[krow];
#pragma unroll
                for (int q = 0; q < 2; ++q) { const int kt = cp + q; f32x4 d = (f32x4){0.f, 0.f, 0.f, 0.f};
#pragma unroll
                    for (int ks = 0; ks < 2; ++ks) d = mfma16(CH_FRAG(CH_WT, 16 * kt + l15, ks, g), CH_FRAG(CH_BHT, krow, ks, g), d);
                    const int k0 = 16 * kt + 4 * g; f32x4 o;
#pragma unroll
                    for (int i = 0; i < 4; ++i) o[i] = ((k0 + i == krow) ? gc : 0.f) - d[i];
                    u32x2 w; w.x = pk2(o[0], o[1]); w.y = pk2(o[2], o[3]);
                    *(u32x2*)(Pc + krow * 64 + 32 * (kt >> 1) + 8 * g + 4 * (kt & 1)) = w; } }
            { const int vrow = 16 * rt + l15;
#pragma unroll
                for (int q = 0; q < 2; ++q) { const int kt = cp + q; f32x4 d = (f32x4){0.f, 0.f, 0.f, 0.f};
#pragma unroll
                    for (int ks = 0; ks < 2; ++ks) { d = mfma16(CH_FRAG(CH_KHT, 16 * kt + l15, ks, g), CH_FRAG(CH_VT, vrow, ks, g), d); d = mfma16(CH_FRAG(CH_BHT, 16 * kt + l15, ks, g), CH_FRAG(CH_U0, vrow, ks, g), d); }
                    u32x2 w; w.x = pk2(d[0], d[1]); w.y = pk2(d[2], d[3]);
                    *(u32x2*)(Qc + vrow * 64 + 16 * g + 4 * kt) = w; } }
        }
        S1_BAR();
    }
}

struct S2Set { u32x4 p[4][2]; u32x4 q[2]; };
__device__ __forceinline__ void s2_load(S2Set& s, const bf16* Pc, const bf16* Qc, int vt, int l15, int g) {
    s.q[0] = *(const u32x4*)(Qc + (16 * vt + l15) * 64 + 16 * g); s.q[1] = *(const u32x4*)(Qc + (16 * vt + l15) * 64 + 16 * g + 8);
#pragma unroll
    for (int m = 0; m < 4; ++m)
#pragma unroll
        for (int j = 0; j < 2; ++j) s.p[m][j] = *(const u32x4*)(Pc + (16 * m + l15) * 64 + 32 * j + 8 * g);
}
__device__ __forceinline__ void s2_step(f32x4 (&acc)[4], const S2Set& s, bf16* Hc, int g) {
    unsigned hw[4][2];
#pragma unroll
    for (int m = 0; m < 4; ++m) { hw[m][0] = pk2(acc[m][0], acc[m][1]); hw[m][1] = pk2(acc[m][2], acc[m][3]); }
#pragma unroll
    for (int m = 0; m < 4; ++m) *(u32x2*)(Hc + 16 * m + 4 * g) = (u32x2){hw[m][0], hw[m][1]};
    const bf16x8 hb0 = as_frag((u32x4){hw[0][0], hw[0][1], hw[1][0], hw[1][1]}), hb1 = as_frag((u32x4){hw[2][0], hw[2][1], hw[3][0], hw[3][1]});
#pragma unroll
    for (int m = 0; m < 4; ++m) {
        const unsigned q0 = (m & 2) ? ((m & 1) ? s.q[1].z : s.q[1].x) : ((m & 1) ? s.q[0].z : s.q[0].x), q1 = (m & 2) ? ((m & 1) ? s.q[1].w : s.q[1].y) : ((m & 1) ? s.q[0].w : s.q[0].y);
        f32x4 d = (f32x4){bflo(q0), bfhi(q0), bflo(q1), bfhi(q1)};
        d = mfma16(as_frag(s.p[m][0]), hb0, d);
        d = mfma16(as_frag(s.p[m][1]), hb1, d);
        acc[m] = d;
    }
}
__device__ __forceinline__ void phase_s2_chain(const Args& a, int wave, int lane, int G) {
    unsigned char* ws = a.ws;
    const bf16* PM = (const bf16*)(ws + WS_PM); const bf16* QT = (const bf16*)(ws + WS_QT); bf16* HT = (bf16*)(ws + WS_HT);
    const int l15 = lane & 15, g = lane >> 4;
    if (wave >= 2) return;
    static_assert(NCHUNK % 4 == 0, "S2 ring");
    for (int wt = blockIdx.x * 2 + wave; wt < 512; wt += G * 2) {
        const int chain = wt >> 2, vt = wt & 3;
        f32x4 acc[4];
#pragma unroll
        for (int m = 0; m < 4; ++m) acc[m] = (f32x4){0.f, 0.f, 0.f, 0.f};
        const bf16* Pc = PM + (size_t)chain * NCHUNK * 4096; const bf16* Qc = QT + (size_t)chain * NCHUNK * 4096;
        bf16* Hc = HT + (size_t)chain * NCHUNK * 4096 + (16 * vt + l15) * 64;
        S2Set s0, s1, s2, s3;
        s2_load(s0, Pc, Qc, vt, l15, g); s2_load(s1, Pc + 4096, Qc + 4096, vt, l15, g); s2_load(s2, Pc + 2 * 4096, Qc + 2 * 4096, vt, l15, g); s2_load(s3, Pc + 3 * 4096, Qc + 3 * 4096, vt, l15, g);
#pragma unroll 1
        for (int c = 0; c < NCHUNK; c += 4) {
            const int cn = c + 4 < NCHUNK ? c + 4 : c;
            const bf16* Pn = Pc + (size_t)cn * 4096; const bf16* Qn = Qc + (size_t)cn * 4096;
            s2_step(acc, s0, Hc + (size_t)c * 4096, g);       s2_load(s0, Pn, Qn, vt, l15, g);
            s2_step(acc, s1, Hc + (size_t)(c + 1) * 4096, g); s2_load(s1, Pn + 4096, Qn + 4096, vt, l15, g);
            s2_step(acc, s2, Hc + (size_t)(c + 2) * 4096, g); s2_load(s2, Pn + 2 * 4096, Qn + 2 * 4096, vt, l15, g);
            s2_step(acc, s3, Hc + (size_t)(c + 3) * 4096, g); s2_load(s3, Pn + 3 * 4096, Qn + 3 * 4096, vt, l15, g);
        }
    }
}

__device__ __forceinline__ void phase_s3_readout(const Args& a, int lj, int nrows, int gw, int NGW, int lane) {
    unsigned char* ws = a.ws;
    const bf16* YL = (const bf16*)(ws + WS_Y); const bf16* RH = (const bf16*)(ws + WS_RH); const bf16* HT = (const bf16*)(ws + WS_HT);
    const bf16* Vv = (const bf16*)(ws + WS_RKV) + (size_t)2 * T * D; const float* RKB = (const float*)(ws + WS_RKB); const float* RKB1 = (const float*)(ws + WS_RKB1); const bf16* Gg = (const bf16*)(ws + WS_G); bf16* Z = (bf16*)(ws + WS_Z);
    const float* lng = a.in[21] + lj * 1024; const float* lnb = a.in[22] + lj * 1024;
    const int l15 = lane & 15, g = lane >> 4;
    for (int task = gw; task < (nrows / 16) * 16; task += NGW) {
        const int tt = task >> 4, h = task & 15, r0 = tt * 16, row = r0 + l15;
        int b, cc[2];
        if (r0 < TL) { b = r0 >> 13; const int tb = (r0 & (SEQ - 1)) >> 6; cc[0] = 4 + tb; cc[1] = 4 + (127 - tb); }
        else { const int loc = r0 - TL; b = loc >> 8; const int tb = (loc & 255) >> 6; cc[0] = tb; cc[1] = 3 - tb; }
        f32x4 acc[4];
        const size_t ro = (size_t)row * D + h * 64 + 4 * g;
#pragma unroll
        for (int vt = 0; vt < 4; ++vt) acc[vt] = bf4(*(const u32x2*)(YL + ro + 16 * vt)) + bf4(*(const u32x2*)(YL + (size_t)T * D + ro + 16 * vt));
#pragma unroll
        for (int dir = 0; dir < 2; ++dir) {
            const int chain = dir * 64 + b * 16 + h;
            const bf16* rh = RH + ((size_t)dir * T + row) * D + h * 64 + 8 * g;
            const bf16x8 f0 = as_frag(*(const u32x4*)(rh)), f1 = as_frag(*(const u32x4*)(rh + 32));
            const bf16* hc = HT + ((size_t)chain * NCHUNK + cc[dir]) * 4096;
#pragma unroll
            for (int vt = 0; vt < 4; ++vt) { const bf16* hr = hc + (16 * vt + l15) * 64 + 8 * g;
                acc[vt] = mfma16(as_frag(*(const u32x4*)(hr)), f0, acc[vt]); acc[vt] = mfma16(as_frag(*(const u32x4*)(hr + 32)), f1, acc[vt]); }
        }
        float s = 0.f;
#pragma unroll
        for (int vt = 0; vt < 4; ++vt) s += (acc[vt][0] + acc[vt][1]) + (acc[vt][2] + acc[vt][3]);
        s += __shfl_xor(s, 16); s += __shfl_xor(s, 32);
        const float mean = s * (1.0f / 64.0f); float vs = 0.f;
#pragma unroll
        for (int vt = 0; vt < 4; ++vt) { acc[vt] = acc[vt] - mean; vs += (acc[vt][0] * acc[vt][0] + acc[vt][1] * acc[vt][1]) + (acc[vt][2] * acc[vt][2] + acc[vt][3] * acc[vt][3]); }
        vs += __shfl_xor(vs, 16); vs += __shfl_xor(vs, 32);
        const float rstd = rsqrtf(vs * (1.0f / 64.0f) + 64.0f * 1e-5f), bon = RKB[(size_t)row * 16 + h] + RKB1[(size_t)row * 16 + h];
#pragma unroll
        for (int vt = 0; vt < 4; ++vt) { const int col = h * 64 + 16 * vt + 4 * g; const size_t o = (size_t)row * D + col;
            const f32x4 vq = bf4(*(const u32x2*)(Vv + o)), lg4 = *(const f32x4*)(lng + col), lb4 = *(const f32x4*)(lnb + col); const u32x2 gw2 = *(const u32x2*)(Gg + o);
            const f32x4 zz = acc[vt] * rstd * lg4 + lb4 + vq * bon;
            u32x2 w; w.x = pk2(zz[0] * bflo(gw2.x), zz[1] * bfhi(gw2.x)); w.y = pk2(zz[2] * bflo(gw2.y), zz[3] * bfhi(gw2.y));
            *(u32x2*)(Z + o) = w; }
    }
}
__device__ __forceinline__ void phase_cv(const Args& a, int lc, int rows, int gw, int NGW, int lane) {
    unsigned char* ws = a.ws;
    const bf16* BG = (const bf16*)(ws + WS_BG); const bf16* CU = (const bf16*)(ws + WS_CUZ); bf16* Z = (bf16*)(ws + WS_Z);
    const float* cw = a.in[25] + (size_t)lc * 3 * 1024;
    for (int t = gw; t < rows; t += NGW) {
        int rs, re; if (t < TL) { rs = t & ~63; re = rs + 63; } else { const int loc = t - TL; rs = TL + (loc & ~255); re = rs + 255; }
        const bool hp = t > rs, hn = t < re;
#pragma unroll
        for (int j = 0; j < 4; ++j) { const int col = 256 * j + 4 * lane; const size_t o = (size_t)t * D + col;
            const u32x2 zc = *(const u32x2*)(CU + o), bg = *(const u32x2*)(BG + o);
            const u32x2 zp = hp ? *(const u32x2*)(CU + o - D) : (u32x2){0u, 0u}, zn = hn ? *(const u32x2*)(CU + o + D) : (u32x2){0u, 0u};
            const f32x4 w0 = *(const f32x4*)(cw + col), w1 = *(const f32x4*)(cw + 1024 + col), w2 = *(const f32x4*)(cw + 2048 + col);
            const f32x4 zv = (f32x4){bflo(zc.x), bfhi(zc.x), bflo(zc.y), bfhi(zc.y)}, pv = (f32x4){bflo(zp.x), bfhi(zp.x), bflo(zp.y), bfhi(zp.y)}, nv = (f32x4){bflo(zn.x), bfhi(zn.x), bflo(zn.y), bfhi(zn.y)};
            const f32x4 bv = (f32x4){bflo(bg.x), bfhi(bg.x), bflo(bg.y), bfhi(bg.y)};
            const f32x4 r = bv * (w0 * pv + w1 * zv + w2 * nv);
            u32x2 w; w.x = pk2(r.x, r.y); w.y = pk2(r.z, r.w); *(u32x2*)(Z + o) = w; }
    }
}
typedef float f32x2v __attribute__((ext_vector_type(2)));
__device__ __forceinline__ float lane_bcast(float v, int srclane) { return __builtin_bit_cast(float, __builtin_amdgcn_readlane(__builtin_bit_cast(int, v), srclane)); }
__device__ __forceinline__ void phase_e_route(const Args& a, int layer, int rows, LAS unsigned char* lds, int tid, int gw, int NGW, int lane, int probe_rep = 0) {
    unsigned char* ws = a.ws;
    const float* xs = (const float*)(ws + (layer < 2 ? WS_XSA : WS_XSB));
    const float* MODS = (const float*)(ws + WS_MODS); bf16* H2 = (bf16*)(ws + WS_H2);
    const float* ng = a.in[6] + (size_t)(layer * 2 + 1) * 1024;
    const float* rw = a.in[27] + (size_t)layer * 1024 * 32; const float* rb = a.in[28] + layer * 32;
    unsigned* cnt = (unsigned*)(ws + WS_CTL) + CW_CNT + (layer + 4 * probe_rep) * 32 * CNT_STRIDE;
    int* SLOTL = (int*)(ws + (probe_rep ? WS_L1 : WS_SLOTL)); float* GATEL = (float*)(ws + (probe_rep ? WS_L1 + 8 * MiB : WS_GATEL));
    LAS float* wt = (LAS float*)lds;
    LAS int* hist = (LAS int*)(lds + LDSCTL_OFF + 3072); LAS int* base = hist + 32; LAS int* lcnt = hist + 64;
    int* TKE = (int*)(ws + WS_C12); float* TKG = (float*)(ws + WS_C12 + 4 * MiB);
    for (int i = tid; i < 32768; i += 512) wt[(i & 31) * 1024 + (i >> 5)] = rw[i];
    if (tid < 32) hist[tid] = 0;
    __syncthreads();
    const int my_e = lane >> 1; const float my_b = rb[my_e];
    const bool b5 = (lane & 32) != 0, b4 = (lane & 16) != 0, b3 = (lane & 8) != 0, b2 = (lane & 4) != 0, b1 = (lane & 2) != 0;
    for (int t = gw; t < rows; t += NGW) {
        const int mr = mod_row(t);
        const float* mod = MODS + (size_t)(layer * 5 + mr) * 6144;
        f32x4 x[4];
#pragma unroll
        for (int j = 0; j < 4; ++j) x[j] = *(const f32x4*)(xs + (size_t)t * D + 256 * j + 4 * lane);
        const float rstd = row_rstd(x);
#pragma unroll
        for (int j = 0; j < 4; ++j) { const int col = 256 * j + 4 * lane;
            x[j] = x[j] * rstd * *(const f32x4*)(ng + col) * (*(const f32x4*)(mod + 4 * 1024 + col) + 1.0f) + *(const f32x4*)(mod + 3 * 1024 + col);
            u32x2 w; w.x = pk2(x[j].x, x[j].y); w.y = pk2(x[j].z, x[j].w); *(u32x2*)(H2 + (size_t)t * D + col) = w; }
        float p[32];
#pragma unroll
        for (int eg = 0; eg < 8; ++eg) {
#pragma unroll
            for (int ee = 0; ee < 4; ++ee) { const int e = eg * 4 + ee; f32x2v s2 = (f32x2v){0.f, 0.f};
#pragma unroll
                for (int j = 0; j < 4; ++j) { const f32x4 wv = *(const LAS f32x4*)(wt + e * 1024 + 256 * j + 4 * lane);
                    s2 = __builtin_elementwise_fma((f32x2v){x[j].x, x[j].y}, (f32x2v){wv.x, wv.y}, s2); s2 = __builtin_elementwise_fma((f32x2v){x[j].z, x[j].w}, (f32x2v){wv.z, wv.w}, s2); }
                p[e] = s2.x + s2.y; }
            asm volatile("" ::: "memory");
        }
        float q16[16];
#pragma unroll
        for (int i = 0; i < 16; ++i) { const float send = b5 ? p[i] : p[i + 16]; const float keep = b5 ? p[i + 16] : p[i]; q16[i] = keep + __shfl_xor(send, 32); }
        float q8[8];
#pragma unroll
        for (int i = 0; i < 8; ++i) { const float send = b4 ? q16[i] : q16[i + 8]; const float keep = b4 ? q16[i + 8] : q16[i]; q8[i] = keep + __shfl_xor(send, 16); }
        float q4[4];
#pragma unroll
        for (int i = 0; i < 4; ++i) { const float send = b3 ? q8[i] : q8[i + 4]; const float keep = b3 ? q8[i + 4] : q8[i]; q4[i] = keep + __shfl_xor(send, 8); }
        float q2[2];
#pragma unroll
        for (int i = 0; i < 2; ++i) { const float send = b2 ? q4[i] : q4[i + 2]; const float keep = b2 ? q4[i + 2] : q4[i]; q2[i] = keep + __shfl_xor(send, 4); }
        float q1; { const float send = b1 ? q2[0] : q2[1]; const float keep = b1 ? q2[1] : q2[0]; q1 = keep + __shfl_xor(send, 2); }
        const float lg = q1 + __shfl_xor(q1, 1) + my_b;
        int rank = 0;
#pragma unroll 1
        for (int e = 0; e < 32; ++e) { const float o = lane_bcast(lg, 2 * e); rank += (o > lg || (o == lg && e < my_e)) ? 1 : 0; }
        const bool sel = rank < 4 && !(lane & 1);
        const unsigned long long m0 = __ballot(sel && rank == 0), m1 = __ballot(sel && rank == 1), m2 = __ballot(sel && rank == 2), m3 = __ballot(sel && rank == 3);
        const float v0 = lane_bcast(lg, (int)__builtin_ctzll(m0)), v1 = lane_bcast(lg, (int)__builtin_ctzll(m1)), v2 = lane_bcast(lg, (int)__builtin_ctzll(m2)), v3 = lane_bcast(lg, (int)__builtin_ctzll(m3));
        const float e1 = __expf(v1 - v0), e2 = __expf(v2 - v0), e3 = __expf(v3 - v0);
        const float inv = 1.0f / (1.0f + e1 + e2 + e3);
        if (sel) {
            TKE[t * 4 + rank] = my_e; TKG[t * 4 + rank] = __expf(lg - v0) * inv;
            __hip_atomic_fetch_add(hist + my_e, 1, __ATOMIC_RELAXED, __HIP_MEMORY_SCOPE_WORKGROUP);
        }
    }
    asm volatile("s_waitcnt vmcnt(0) lgkmcnt(0)" ::: "memory"); __syncthreads();
    if (tid < 32) { base[tid] = (int)atomicAdd(cnt + tid * CNT_STRIDE, (unsigned)hist[tid]); lcnt[tid] = 0; }
    __syncthreads();
    for (int t = gw; t < rows; t += NGW) {
        if (lane < 4) { const int e = TKE[t * 4 + lane]; const float gk = TKG[t * 4 + lane];
            const int pos = base[e] + __hip_atomic_fetch_add(lcnt + e, 1, __ATOMIC_RELAXED, __HIP_MEMORY_SCOPE_WORKGROUP);
            SLOTL[(size_t)e * T + pos] = t * 4 + lane; GATEL[(size_t)e * T + pos] = gk; }
    }
}
__device__ __forceinline__ int okey(float v, int e) { const int i = __builtin_bit_cast(int, v); const int o = i ^ ((i >> 31) & 0x7fffffff); return (o & ~31) | (31 - e); }
__device__ __forceinline__ void phase_e_route_mfma(const Args& a, int layer, int rows, LAS unsigned char* lds, int tid, int wave, int gw, int NGW, int lane, int probe_rep = 0) {
    unsigned char* ws = a.ws;
    const float* xs = (const float*)(ws + (layer < 2 ? WS_XSA : WS_XSB));
    const float* MODS = (const float*)(ws + WS_MODS); bf16* H2 = (bf16*)(ws + WS_H2);
    const float* ng = a.in[6] + (size_t)(layer * 2 + 1) * 1024; const float* rb = a.in[28] + layer * 32;
    const bf16* WRT = (const bf16*)(ws + WS_WRT) + (size_t)layer * 2 * 32 * 1024;
    unsigned* cnt = (unsigned*)(ws + WS_CTL) + CW_CNT + (layer + 4 * probe_rep) * 32 * CNT_STRIDE;
    int* SLOTL = (int*)(ws + (probe_rep ? WS_L1 : WS_SLOTL)); float* GATEL = (float*)(ws + (probe_rep ? WS_L1 + 8 * MiB : WS_GATEL));
    LAS int* hist = (LAS int*)(lds + LDSCTL_OFF + 3072); LAS int* base = hist + 32; LAS int* lcnt = hist + 64;
    int* TKE = (int*)(ws + WS_C12); float* TKG = (float*)(ws + WS_C12 + 4 * MiB);
    LAS unsigned char* tile = lds + wave * 8448;
    if (tid < 32) hist[tid] = 0;
    __syncthreads();
    const int l15 = lane & 15, g = lane >> 4;
    const int nlat = TL / 16, nctx = rows > TL ? TC / 4 : 0, G_ = NGW / 8;
    for (int it = 0;; ++it) {
        int t0, ntok;
        { const int tl = gw + it * NGW; const int xi = (int)blockIdx.x + (it - (nlat + NGW - 1) / NGW) * G_ * 8 + wave * G_;
          if (tl < nlat) { t0 = tl * 16; ntok = 16; } else if (it >= (nlat + NGW - 1) / NGW && xi < nctx) { t0 = TL + xi * 4; ntok = 4; } else if (it >= (nlat + NGW - 1) / NGW) break; else continue; }
        const float* mod = MODS + (size_t)(layer * 5 + mod_row(t0)) * 6144;
        float rstd[16];
#pragma unroll
        for (int t = 0; t < 16; ++t) { f32x4 x[4];
            const int tr = t < ntok ? t0 + t : t0;
#pragma unroll
            for (int j = 0; j < 4; ++j) x[j] = *(const f32x4*)(xs + (size_t)tr * D + 256 * j + 4 * lane);
            rstd[t] = __builtin_bit_cast(float, __builtin_amdgcn_readfirstlane(__builtin_bit_cast(int, row_rstd(x))));
            if ((t & 3) == 3) asm volatile("" ::: "memory"); }
        f32x4 acc[2]; acc[0] = (f32x4){0.f, 0.f, 0.f, 0.f}; acc[1] = acc[0];
#pragma unroll 1
        for (int s = 0; s < 4; ++s) {
            const int col = 256 * s + 4 * lane;
            const f32x4 g4 = *(const f32x4*)(ng + col) * (*(const f32x4*)(mod + 4 * 1024 + col) + 1.0f), s4 = *(const f32x4*)(mod + 3 * 1024 + col);
            f32x4 hv[16];
#pragma unroll
            for (int t = 0; t < 16; ++t) { const int tr = t < ntok ? t0 + t : t0; hv[t] = *(const f32x4*)(xs + (size_t)tr * D + col) * rstd[t] * g4 + s4;
                const u32x2 w = pk4(hv[t]); if (t < ntok) *(u32x2*)(H2 + (size_t)tr * D + col) = w;
                *(LAS u32x2*)(tile + t * 528 + lane * 8) = w; hv[t] = hv[t] - bf4(w); }
            LDS_WAIT(); asm volatile("" ::: "memory");
            const bf16* wh = WRT + (size_t)l15 * 1024 + 256 * s + 8 * g; const bf16* wl = wh + (size_t)32 * 1024;
#pragma unroll
            for (int ks = 0; ks < 8; ++ks) { const bf16x8 fb = as_frag(*(const LAS u32x4*)(tile + l15 * 528 + ks * 64 + g * 16));
#pragma unroll
                for (int et = 0; et < 2; ++et) { acc[et] = mfma16(as_frag(*(const u32x4*)(wh + (size_t)et * 16 * 1024 + 32 * ks)), fb, acc[et]);
                    acc[et] = mfma16(as_frag(*(const u32x4*)(wl + (size_t)et * 16 * 1024 + 32 * ks)), fb, acc[et]); } }
            LDS_WAIT(); asm volatile("" ::: "memory");
#pragma unroll
            for (int t = 0; t < 16; ++t) *(LAS u32x2*)(tile + t * 528 + lane * 8) = pk4(hv[t]);
            LDS_WAIT(); asm volatile("" ::: "memory");
#pragma unroll
            for (int ks = 0; ks < 8; ++ks) { const bf16x8 fb = as_frag(*(const LAS u32x4*)(tile + l15 * 528 + ks * 64 + g * 16));
#pragma unroll
                for (int et = 0; et < 2; ++et) acc[et] = mfma16(as_frag(*(const u32x4*)(wh + (size_t)et * 16 * 1024 + 32 * ks)), fb, acc[et]); }
            LDS_WAIT(); asm volatile("" ::: "memory");
        }
        float v[8]; int key[8];
#pragma unroll
        for (int j = 0; j < 8; ++j) { const int e = (j < 4 ? 0 : 16) + 4 * g + (j & 3); v[j] = acc[j >> 2][j & 3] + rb[e]; key[j] = okey(v[j], e); }
        int kb[8], kc[8], kd2[8];
#pragma unroll
        for (int j = 0; j < 8; ++j) kb[j] = __shfl_xor(key[j], 16);
#pragma unroll
        for (int j = 0; j < 8; ++j) { kc[j] = __shfl_xor(key[j], 32); kd2[j] = __shfl_xor(kb[j], 32); }
        float vmax = fmaxf(fmaxf(fmaxf(v[0], v[1]), fmaxf(v[2], v[3])), fmaxf(fmaxf(v[4], v[5]), fmaxf(v[6], v[7])));
        vmax = fmaxf(vmax, __shfl_xor(vmax, 16)); vmax = fmaxf(vmax, __shfl_xor(vmax, 32));
        int rank[8]; float ex[8], part = 0.f;
#pragma unroll
        for (int j = 0; j < 8; ++j) { int r = 0;
#pragma unroll
            for (int q = 0; q < 8; ++q) r += (key[q] > key[j]) + (kb[q] > key[j]) + (kc[q] > key[j]) + (kd2[q] > key[j]);
            rank[j] = r; ex[j] = __expf(v[j] - vmax); part += r < 4 ? ex[j] : 0.f; }
        part += __shfl_xor(part, 16); part += __shfl_xor(part, 32);
        const float inv = 1.0f / part; const int t = t0 + l15;
#pragma unroll
        for (int j = 0; j < 8; ++j) if (rank[j] < 4 && l15 < ntok) { const int e = (j < 4 ? 0 : 16) + 4 * g + (j & 3);
            TKE[t * 4 + rank[j]] = e; TKG[t * 4 + rank[j]] = ex[j] * inv;
            __hip_atomic_fetch_add(hist + e, 1, __ATOMIC_RELAXED, __HIP_MEMORY_SCOPE_WORKGROUP); }
    }
    asm volatile("s_waitcnt vmcnt(0) lgkmcnt(0)" ::: "memory"); __syncthreads();
    if (tid < 32) { base[tid] = (int)atomicAdd(cnt + tid * CNT_STRIDE, (unsigned)hist[tid]); lcnt[tid] = 0; }
    __syncthreads();
    for (int it = 0;; ++it) {
        int t0, ntok;
        { const int tl = gw + it * NGW; const int xi = (int)blockIdx.x + (it - (nlat + NGW - 1) / NGW) * G_ * 8 + wave * G_;
          if (tl < nlat) { t0 = tl * 16; ntok = 16; } else if (it >= (nlat + NGW - 1) / NGW && xi < nctx) { t0 = TL + xi * 4; ntok = 4; } else if (it >= (nlat + NGW - 1) / NGW) break; else continue; }
        if ((lane >> 2) < ntok) { const int t = t0 + (lane >> 2), k = lane & 3;
            const int e = TKE[t * 4 + k]; const float gk = TKG[t * 4 + k];
            const int pos = base[e] + __hip_atomic_fetch_add(lcnt + e, 1, __ATOMIC_RELAXED, __HIP_MEMORY_SCOPE_WORKGROUP);
            SLOTL[(size_t)e * T + pos] = t * 4 + k; GATEL[(size_t)e * T + pos] = gk; }
    }
}
__device__ __forceinline__ void phase_final(const Args& a, int gw, int NGW, int lane) {
    unsigned char* ws = a.ws;
    const float* xs = (const float*)(ws + WS_XSB); const float* MODS = (const float*)(ws + WS_MODS); const bf16* YS = (const bf16*)(ws + WS_YS);
    for (int t = gw; t < TL; t += NGW) {
        const int mr = t >> 13;
        f32x4 m5[4], x[4];
#pragma unroll
        for (int j = 0; j < 4; ++j) m5[j] = *(const f32x4*)(MODS + (size_t)(3 * 5 + mr) * 6144 + 5 * 1024 + 256 * j + 4 * lane);
        load_x_combined(x, xs + (size_t)t * D, true, YS, t, m5, lane);
        const float rstd = row_rstd(x);
#pragma unroll
        for (int j = 0; j < 4; ++j) { const int col = 256 * j + 4 * lane; *(f32x4*)(a.out + (size_t)t * D + col) = x[j] * rstd * *(const f32x4*)(a.in[7] + col); }
    }
}

using pg8::Unit; using pg8::tile_map;
struct SchedStd {
    int G, c, nM, nN;
    __device__ __forceinline__ bool next(int i, Unit& u) const { const long L = (long)i * G + c; if (L >= (long)nM * nN) return false; int pm, pn; tile_map((int)L, nM, nN, pm, pn); u.pm = pm; u.pn = pn; u.e = 0; u.nv = pm; u.par = 0; return true; }
    __device__ __forceinline__ void a_ready(const Unit&) const {}
    __device__ __forceinline__ void done(const Unit&) const {}
    __device__ __forceinline__ unsigned row_off(const Unit&, int) const { return 0u; }
    __device__ __forceinline__ unsigned row_off_lds(const Unit&, int) const { return 0u; }
    __device__ __forceinline__ void prefetch_rows(const Unit&) const {}
};
struct SchedB1 {
    int G, c;
    __device__ __forceinline__ bool next(int i, Unit& u) const { const long L = (long)i * G + c; constexpr int n1 = 3 * NMT * 4; if (L >= n1 + 3 * NMT) return false; const int l = (int)L;
        if (l < n1) { const int j = l / (NMT * 4), r = l % (NMT * 4); int pm, pn; tile_map(r, NMT, 4, pm, pn); u.pm = j * NMT + pm; u.pn = j * 4 + pn; u.e = j; u.nv = pm; }
        else { const int r = l - n1, j = r / NMT, pm = r % NMT; u.pm = (3 + j) * NMT + pm; u.pn = 12 + j; u.e = 3 + j; u.nv = pm; }
        u.par = 0; return true; }
    __device__ __forceinline__ void a_ready(const Unit&) const {}
    __device__ __forceinline__ void done(const Unit&) const {}
    __device__ __forceinline__ unsigned row_off(const Unit&, int) const { return 0u; }
    __device__ __forceinline__ unsigned row_off_lds(const Unit&, int) const { return 0u; }
    __device__ __forceinline__ void prefetch_rows(const Unit&) const {}
};
struct SchedB2 {
    int G, c;
    __device__ __forceinline__ bool next(int i, Unit& u) const { const long L = (long)i * G + c; constexpr int n1 = 2 * NMT * 8; if (L >= n1 + NMT * 4) return false; const int l = (int)L;
        if (l < n1) { const int j = l / (NMT * 8), r = l % (NMT * 8); int pm, pn; tile_map(r, NMT, 8, pm, pn); u.pm = j * NMT + pm; u.pn = j * 8 + pn; u.e = j; u.nv = pm; }
        else { const int r = l - n1; int pm, pn; tile_map(r, NMT, 4, pm, pn); u.pm = 2 * NMT + pm; u.pn = 16 + pn; u.e = 2; u.nv = pm; }
        u.par = 0; return true; }
    __device__ __forceinline__ void a_ready(const Unit&) const {}
    __device__ __forceinline__ void done(const Unit&) const {}
    __device__ __forceinline__ unsigned row_off(const Unit&, int) const { return 0u; }
    __device__ __forceinline__ unsigned row_off_lds(const Unit&, int) const { return 0u; }
    __device__ __forceinline__ void prefetch_rows(const Unit&) const {}
};
struct SchedMoe {
    int G, c, nnt, ntiles, P; LAS unsigned char* lds; const int* slotl; const float* gatel; int wave;
    __device__ __forceinline__ bool next(int i, Unit& u) const { const long L = (long)i * G + c; const int ntp = (ntiles + P - 1) / P, ppg = nnt / (8 / P); if (L >= (long)ntp * ppg * 8) return false;
        const LAS int* tpre = (const LAS int*)(lds + LDSCTL_OFF + 64); const LAS int* ecnt = (const LAS int*)(lds + LDSCTL_OFF + 256); const LAS unsigned short* tile_e = (const LAS unsigned short*)(lds + LDSCTL_OFF + 512);
        const int xq = (int)(L >> 3), x8 = (int)(L & 7); int tile = (xq / ppg) * P + (x8 % P); const int pnl = (x8 / P) * ppg + xq % ppg; const bool dead = tile >= ntiles; tile = dead ? 0 : tile;
        const int e = __builtin_amdgcn_readfirstlane((int)tile_e[tile]), r0 = (tile - __builtin_amdgcn_readfirstlane(tpre[e])) * 256; int nv = __builtin_amdgcn_readfirstlane(ecnt[e]) - r0; nv = nv > 256 ? 256 : nv; nv = dead ? 0 : nv;
        u.pm = dead ? MAXTILES : tile; u.pn = e * nnt + pnl; u.e = e; u.nv = nv | (r0 << 9); u.par = i & 1; return true; }
    __device__ __forceinline__ void a_ready(const Unit& u) const {
        if (gatel != nullptr && wave == 0) { const size_t li = (size_t)u.e * T + (u.nv >> 9) + 4 * lane_id();
            __builtin_amdgcn_global_load_lds((const unsigned*)(slotl + li), (LAS unsigned*)(lds + LDSCTL_OFF + 8192 + 2048 * u.par), 16, 0, 0);
            __builtin_amdgcn_global_load_lds((const unsigned*)(gatel + li), (LAS unsigned*)(lds + LDSCTL_OFF + 8192 + 2048 * u.par + 1024), 16, 0, 0); } }
    __device__ __forceinline__ void done(const Unit&) const {}
    __device__ __forceinline__ void prefetch_rows(const Unit& u) const {
        if (wave == 0) __builtin_amdgcn_global_load_lds((const unsigned*)(slotl + (size_t)u.e * T + (u.nv >> 9) + 4 * lane_id()), (LAS unsigned*)(lds + LDSCTL_OFF + 8192 + 2048 * u.par), 16, 0, 0); }
    __device__ __forceinline__ unsigned row_off_lds(const Unit& u, int r) const { const int nv = u.nv & 511; const int sl = ((const LAS int*)(lds + LDSCTL_OFF + 8192 + 2048 * u.par))[r]; const int tok = r < nv ? (sl >> 2) : 0; return (unsigned)tok * 2048u; }
    __device__ __forceinline__ unsigned row_off(const Unit& u, int r) const { const int nv = u.nv & 511, r0 = u.nv >> 9; const int tok = r < nv ? (slotl[(size_t)u.e * T + r0 + r] >> 2) : 0; return (unsigned)tok * 2048u; }
};

using pg8::cvt_pk_bf16;
template <class P> __device__ __forceinline__ P* pin_ptr(P* p) { asm volatile("" : "+v"(p)); return p; }
struct EpiB1 {
    static constexpr bool PERM = true, AFTER_DRAIN = false;
    bf16* RKV; bf16* L1;
    __device__ __forceinline__ void operator()(const f32x4 (&acc)[2][2][4][2], const Unit& u, int wr, int wc, int fr, int fq) const {
        const int seg = u.e, row0 = u.nv * 256 + wr * 64 + fr;
        const int jj = seg - 3, ld = seg < 3 ? D : 128, col0 = (seg < 3 ? (u.pn - seg * 4) * 256 : 0) + wc * 32 + 8 * fq;
        bf16* base = seg < 3 ? RKV + (size_t)seg * T * D : L1 + (size_t)jj * T * 128;
#pragma unroll
        for (int ai = 0; ai < 2; ++ai)
#pragma unroll
            for (int m = 0; m < 4; ++m) { bf16* rowp = base + (size_t)(row0 + ai * 128 + m * 16) * ld + col0;
#pragma unroll
                for (int bj = 0; bj < 2; ++bj) { if (seg >= 3 && bj == 1) continue; f32x4 v0 = acc[ai][bj][m][0], v1 = acc[ai][bj][m][1];
                    if (jj == 0) {
#pragma unroll
                        for (int q = 0; q < 4; ++q) { v0[q] = tanh_fast(v0[q]); v1[q] = tanh_fast(v1[q]); } }
                    else if (jj == 2) {
#pragma unroll
                        for (int q = 0; q < 4; ++q) { v0[q] = sigm(v0[q]); v1[q] = sigm(v1[q]); } }
                    u32x4 w; w.x = cvt_pk_bf16(v0[0], v0[1]); w.y = cvt_pk_bf16(v0[2], v0[3]); w.z = cvt_pk_bf16(v1[0], v1[1]); w.w = cvt_pk_bf16(v1[2], v1[3]);
                    *(u32x4*)(rowp + bj * 128) = w; } }
    }
};
struct EpiB2 {
    static constexpr bool PERM = true, AFTER_DRAIN = false;
    bf16* RW; bf16* RA; bf16* Gg;
    __device__ __forceinline__ void operator()(const f32x4 (&acc)[2][2][4][2], const Unit& u, int wr, int wc, int fr, int fq) const {
        const int jj = u.e, row0 = u.nv * 256 + wr * 64 + fr, pnl = u.pn - jj * 8;
        const int dirn = jj < 2 ? (pnl >> 2) : 0, col0 = (jj < 2 ? (pnl & 3) : pnl) * 256 + wc * 32 + 8 * fq;
        bf16* base = (jj == 0 ? RW : jj == 1 ? RA : Gg) + (size_t)dirn * T * D;
#pragma unroll
        for (int ai = 0; ai < 2; ++ai)
#pragma unroll
            for (int m = 0; m < 4; ++m) { bf16* rowp = base + (size_t)(row0 + ai * 128 + m * 16) * D + col0;
#pragma unroll
                for (int bj = 0; bj < 2; ++bj) { const f32x4 v0 = acc[ai][bj][m][0], v1 = acc[ai][bj][m][1];
                    u32x4 w; w.x = cvt_pk_bf16(v0[0], v0[1]); w.y = cvt_pk_bf16(v0[2], v0[3]); w.z = cvt_pk_bf16(v1[0], v1[1]); w.w = cvt_pk_bf16(v1[2], v1[3]);
                    *(u32x4*)(rowp + bj * 128) = w; } }
    }
};
struct EpiRes {
    static constexpr bool PERM = true, AFTER_DRAIN = false;
    float* X; const float* gate; float* Xo;
    __device__ __forceinline__ void operator()(const f32x4 (&acc)[2][2][4][2], const Unit& u, int wr, int wc, int fr, int fq) const {
        const int row0 = u.pm * 256 + wr * 64 + fr, col0 = u.pn * 256 + wc * 32 + 8 * fq, mr = u.pm < NMT_L ? (u.pm >> 5) : 4;
        const float* gp = pin_ptr(gate + (size_t)mr * 6144 + col0);
        f32x4 gv[2][2];
#pragma unroll
        for (int bj = 0; bj < 2; ++bj)
#pragma unroll
            for (int n = 0; n < 2; ++n) gv[bj][n] = *(const f32x4*)(gp + bj * 128 + 4 * n);
#pragma unroll
        for (int ai = 0; ai < 2; ++ai)
#pragma unroll
            for (int m = 0; m < 4; ++m) { float* rowp = X + (size_t)(row0 + ai * 128 + m * 16) * D + col0;
#pragma unroll
                for (int bj = 0; bj < 2; ++bj)
#pragma unroll
                    for (int n = 0; n < 2; ++n) { float* p = rowp + bj * 128 + 4 * n; *(f32x4*)(Xo + (p - X)) = *(const f32x4*)p + gv[bj][n] * acc[ai][bj][m][n]; } }
    }
};
struct EpiWin {
    static constexpr bool PERM = true, AFTER_DRAIN = false;
    bf16* BG; bf16* CU;
    __device__ __forceinline__ void operator()(const f32x4 (&acc)[2][2][4][2], const Unit& u, int wr, int wc, int fr, int fq) const {
        const int row0 = u.pm * 256 + wr * 64 + fr;
        if (u.pn < 4) {
            const int col0 = u.pn * 256 + wc * 32 + 8 * fq;
#pragma unroll
            for (int ai = 0; ai < 2; ++ai)
#pragma unroll
                for (int m = 0; m < 4; ++m) { bf16* rowp = BG + (size_t)(row0 + ai * 128 + m * 16) * D + col0;
#pragma unroll
                    for (int bj = 0; bj < 2; ++bj) { const f32x4 v0 = acc[ai][bj][m][0], v1 = acc[ai][bj][m][1];
                        u32x4 w; w.x = cvt_pk_bf16(v0[0], v0[1]); w.y = cvt_pk_bf16(v0[2], v0[3]); w.z = cvt_pk_bf16(v1[0], v1[1]); w.w = cvt_pk_bf16(v1[2], v1[3]);
                        *(u32x4*)(rowp + bj * 128) = w; } }
        } else {
            const int f0 = (u.pn - 4) * 128 + wc * 32 + 8 * fq;
#pragma unroll
            for (int ai = 0; ai < 2; ++ai)
#pragma unroll
                for (int m = 0; m < 4; ++m) { const f32x4 v0 = acc[ai][0][m][0] * acc[ai][1][m][0], v1 = acc[ai][0][m][1] * acc[ai][1][m][1];
                    u32x4 w; w.x = cvt_pk_bf16(v0[0], v0[1]); w.y = cvt_pk_bf16(v0[2], v0[3]); w.z = cvt_pk_bf16(v1[0], v1[1]); w.w = cvt_pk_bf16(v1[2], v1[3]);
                    *(u32x4*)(CU + (size_t)(row0 + ai * 128 + m * 16) * D + f0) = w; }
        }
    }
};
struct EpiGU {
    static constexpr bool PERM = true, AFTER_DRAIN = false;
    bf16* INTER; const float* bgu;
    __device__ __forceinline__ void operator()(const f32x4 (&acc)[2][2][4][2], const Unit& u, int wr, int wc, int fr, int fq) const {
        const int e = u.e, pnl = u.pn - e * 8, row0 = u.pm * 256 + wr * 64 + fr, f0 = pnl * 128 + wc * 32 + 8 * fq;
        const float* bp = pin_ptr(bgu + (size_t)e * 2048 + f0);
        f32x4 bg[2], bu[2];
#pragma unroll
        for (int n = 0; n < 2; ++n) { bg[n] = *(const f32x4*)(bp + 4 * n); bu[n] = *(const f32x4*)(bp + 1024 + 4 * n); }
#pragma unroll
        for (int ai = 0; ai < 2; ++ai)
#pragma unroll
            for (int m = 0; m < 4; ++m) { f32x4 o[2];
#pragma unroll
                for (int n = 0; n < 2; ++n) { const f32x4 g = acc[ai][0][m][n] + bg[n], uu = acc[ai][1][m][n] + bu[n];
#pragma unroll
                    for (int q = 0; q < 4; ++q) { const float gc = fminf(g[q], 7.0f), uc = fminf(fmaxf(uu[q], -7.0f), 7.0f); o[n][q] = (uc + 1.0f) * gc * sigm(1.702f * gc); } }
                u32x4 w; w.x = cvt_pk_bf16(o[0][0], o[0][1]); w.y = cvt_pk_bf16(o[0][2], o[0][3]); w.z = cvt_pk_bf16(o[1][0], o[1][1]); w.w = cvt_pk_bf16(o[1][2], o[1][3]);
                *(u32x4*)(INTER + (size_t)(row0 + ai * 128 + m * 16) * 1024 + f0) = w; }
    }
};
struct EpiDown {
    static constexpr bool PERM = true, AFTER_DRAIN = false;
    bf16* YS; const float* bdn; LAS unsigned char* lds;
    __device__ __forceinline__ void operator()(const f32x4 (&acc)[2][2][4][2], const Unit& u, int wr, int wc, int fr, int fq) const {
        const int e = u.e, pnl = u.pn - e * 4, col0 = pnl * 256 + wc * 32 + 8 * fq, nv = u.nv & 511;
        const float* bp = pin_ptr(bdn + (size_t)e * 1024 + col0);
        f32x4 bv[2][2];
#pragma unroll
        for (int bj = 0; bj < 2; ++bj)
#pragma unroll
            for (int n = 0; n < 2; ++n) bv[bj][n] = *(const f32x4*)(bp + bj * 128 + 4 * n);
#pragma unroll
        for (int ai = 0; ai < 2; ++ai)
#pragma unroll
            for (int m = 0; m < 4; ++m) { const int r = ai * 128 + wr * 64 + m * 16 + fr;
                if (r < nv) { const LAS int* sl = (const LAS int*)(lds + LDSCTL_OFF + 8192 + 2048 * u.par); const int slot = sl[r]; const float gt = ((const LAS float*)(sl + 256))[r];
                    bf16* rowp = YS + (size_t)slot * 1024 + col0;
#pragma unroll
                    for (int bj = 0; bj < 2; ++bj) { const f32x4 v0 = (acc[ai][bj][m][0] + bv[bj][0]) * gt, v1 = (acc[ai][bj][m][1] + bv[bj][1]) * gt;
                        u32x4 w; w.x = cvt_pk_bf16(v0[0], v0[1]); w.y = cvt_pk_bf16(v0[2], v0[3]); w.z = cvt_pk_bf16(v1[0], v1[1]); w.w = cvt_pk_bf16(v1[2], v1[3]);
                        *(u32x4*)(rowp + bj * 128) = w; } } }
    }
};

__device__ __forceinline__ int moe_tables(const unsigned* cnt, LAS unsigned char* lds, int tid) {
    LAS int* tpre = (LAS int*)(lds + LDSCTL_OFF + 64); LAS int* ecnt = (LAS int*)(lds + LDSCTL_OFF + 256); LAS unsigned short* tile_e = (LAS unsigned short*)(lds + LDSCTL_OFF + 512);
    if (tid == 0) { int p = 0; for (int e = 0; e < 32; ++e) { const int cn = (int)__hip_atomic_load(cnt + e * CNT_STRIDE, __ATOMIC_RELAXED, __HIP_MEMORY_SCOPE_AGENT); ecnt[e] = cn; tpre[e] = p; p += (cn + 255) >> 8; } tpre[32] = p; }
    __syncthreads();
    const int nt = tpre[32];
    for (int t = tid; t < nt; t += 512) { int e = 0; while (e < 31 && t >= tpre[e + 1]) ++e; tile_e[t] = (unsigned short)e; }
    __syncthreads();
    return nt;
}

constexpr int NPHASES = 37;
typedef const Args __attribute__((address_space(4))) CArgs;
__global__ void __launch_bounds__(512, 2) fwd_kernel(Args a_) {
    extern __shared__ __attribute__((aligned(16))) unsigned char lds_raw[];
    LAS unsigned char* lds = (LAS unsigned char*)lds_raw;
    const int G = gridDim.x, NGW = G * 8;
    CArgs* ap0 = (CArgs*)__builtin_amdgcn_kernarg_segment_ptr();
    if (threadIdx.x < 4) ((LAS unsigned*)(lds + LDSCTL_OFF))[threadIdx.x] = 0u;
    __syncthreads();
    XcdBarrier bar = xcd_barrier_post((unsigned*)(a_.ws + WS_CTL) + CW_BAR, (volatile LAS unsigned*)(lds + LDSCTL_OFF));
    const int lo = a_.ph_lo, hi = a_.ph_hi;
    int ph = 0;
#ifndef MK_ONLY
#define MK_ONLY -1
#endif
#ifndef MK_DBL
#define MK_DBL 0
#endif
#define PH_BEGIN(id) if ((MK_ONLY < 0 || MK_ONLY == (id)) && ph >= lo && ph < hi) { for (int rep_ = 0; rep_ <= ((MK_DBL >> (id)) & 1); ++rep_) { CArgs* ap = ap0; asm volatile("" : "+s"(ap)); const Args a = *(const Args*)ap; unsigned char* const ws = a.ws; (void)ws; const int wave = (int)bar.wv; int tid = wave * 64 + lane_id(); asm volatile("" : "+v"(tid)); const int lane = tid & 63, gw = blockIdx.x * 8 + wave; (void)lane; (void)gw;
#define PH_END } } if (ph >= lo && ph + 1 < hi) xcd_barrier(bar); ++ph;

    PH_BEGIN(0) p0_prologue(a, lds, tid, lane, wave, G); PH_END

#pragma unroll 1
    for (int layer = 0; layer < DEPTH; ++layer) {
        const int kind = layer & 1, lj = layer >> 1;
        const int rows = layer == 3 ? TL : T, nmt = rows / 256;
        const int rows_moe = layer < 2 ? T : TL;
        if (kind == 0) {
            PH_BEGIN(1) phase_a_rwkv(a, layer, lds, tid, gw, NGW, lane); PH_END
            PH_BEGIN(2) {
                pg8::Gemm g{(const bf16*)(ws + WS_XL), (const bf16*)(ws + WS_WRKV) + (size_t)lj * 3840 * 1024, 6 * T, 3840, 1024};
                SchedB1 S{G, (int)blockIdx.x}; EpiB1 E{(bf16*)(ws + WS_RKV), (bf16*)(ws + WS_L1)};
                pg8::gemm_phase<EpiB1, SchedB1, true, true, false>(lds, g, S, E, tid); } PH_END
            PH_BEGIN(3) {
                pg8::Gemm g{(const bf16*)(ws + WS_L1), (const bf16*)(ws + WS_L2T) + (size_t)lj * 5120 * 128, 3 * T, 5120, 128};
                SchedB2 S{G, (int)blockIdx.x}; EpiB2 E{(bf16*)(ws + WS_RAWW), (bf16*)(ws + WS_RAWA), (bf16*)(ws + WS_G)};
                pg8::gemm_phase<EpiB2, SchedB2, true, true, false>(lds, g, S, E, tid); } PH_END
            PH_BEGIN(5) phase_s1_chunks(a, lj, lds, tid, G, (MK_DBL >> 5) & 1 & (rep_ == 0)); PH_END
            PH_BEGIN(15) phase_s2_chain(a, wave, lane, G); PH_END
            PH_BEGIN(6) phase_s3_readout(a, lj, layer == 2 ? TL : T, gw, NGW, lane); PH_END
        } else {
            PH_BEGIN(7) phase_a_conv(a, layer, rows, gw, NGW, lane); PH_END
            PH_BEGIN(8) {
                pg8::Gemm g{(const bf16*)(ws + WS_XL), (const bf16*)(ws + WS_WIN) + (size_t)lj * 3072 * 1024, rows, 3072, 1024};
                SchedStd S{G, (int)blockIdx.x, nmt, 12}; EpiWin E{(bf16*)(ws + WS_BG), (bf16*)(ws + WS_CUZ)};
                pg8::gemm_phase<EpiWin, SchedStd, true, true, false>(lds, g, S, E, tid); } PH_END
            PH_BEGIN(9) phase_cv(a, lj, rows, gw, NGW, lane); PH_END
        }
        PH_BEGIN(10) {
            const bf16* Wt = kind == 0 ? (const bf16*)(ws + WS_WO) + (size_t)lj * 1024 * 1024 : (const bf16*)(ws + WS_WOUT) + (size_t)lj * 1024 * 1024;
            pg8::Gemm g{(const bf16*)(ws + WS_Z), Wt, rows, 1024, 1024};
            SchedStd S{G, (int)blockIdx.x, layer == 2 ? NMT_L : nmt, 4}; EpiRes E{(float*)(ws + (layer < 2 ? WS_XSA : WS_XSB)), (const float*)(ws + WS_MODS) + (size_t)layer * 5 * 6144 + 2 * 1024, (float*)(ws + (rep_ ? WS_XL : (layer < 2 ? WS_XSA : WS_XSB)))};
            pg8::gemm_phase<EpiRes, SchedStd, true, true, false>(lds, g, S, E, tid); } PH_END
        PH_BEGIN(11) phase_e_route_mfma(a, layer, rows_moe, lds, tid, wave, gw, NGW, lane, rep_); PH_END
        PH_BEGIN(12) {
            const int nt = __builtin_amdgcn_readfirstlane(moe_tables((const unsigned*)(ws + WS_CTL) + CW_CNT + layer * 32 * CNT_STRIDE, lds, tid));
            pg8::Gemm g{(const bf16*)(ws + WS_H2), (const bf16*)(ws + WS_WGU) + (size_t)layer * 32 * 2048 * 1024, 0, 0, 1024};
            SchedMoe S{G, (int)blockIdx.x, 8, nt, 2, lds, (const int*)(ws + WS_SLOTL), nullptr, wave};
            EpiGU E{(bf16*)(ws + WS_INTER), a.in[30] + (size_t)layer * 32 * 2048};
            pg8::gemm_phase<EpiGU, SchedMoe, true, true, true>(lds, g, S, E, tid); } PH_END
        PH_BEGIN(13) {
            const int nt = __builtin_amdgcn_readfirstlane(moe_tables((const unsigned*)(ws + WS_CTL) + CW_CNT + layer * 32 * CNT_STRIDE, lds, tid));
            pg8::Gemm g{(const bf16*)(ws + WS_INTER), (const bf16*)(ws + WS_WDN) + (size_t)layer * 32 * 1024 * 1024, 0, 0, 1024};
            SchedMoe S{G, (int)blockIdx.x, 4, nt, 8, lds, (const int*)(ws + WS_SLOTL), (const float*)(ws + WS_GATEL), wave};
            EpiDown E{(bf16*)(ws + WS_YS), a.in[32] + (size_t)layer * 32 * 1024, lds};
            pg8::gemm_phase<EpiDown, SchedMoe, true, true, false>(lds, g, S, E, tid); } PH_END
    }
    PH_BEGIN(14) phase_final(a, gw, NGW, lane); PH_END
#undef PH_BEGIN
#undef PH_END
}

extern "C" void kernel_launch(void* const* d_in, const int* in_sizes, int n_in, void* d_out, int out_size, void* d_ws, size_t ws_size, hipStream_t stream) {
    static int grid = 0;
    if (grid == 0) {
        if (n_in != 33 || in_sizes[0] != TL * D || out_size != TL * D || ws_size < WS_END) { fprintf(stderr, "kernel_launch: unexpected problem (n_in %d, in0 %d, out %d, ws %zu < %zu)\n", n_in, n_in > 0 ? in_sizes[0] : -1, out_size, ws_size, (size_t)WS_END); grid = -1; return; }
        int dev = 0, cus = 0, per_cu = 0;
        if (hipGetDevice(&dev) != hipSuccess || hipDeviceGetAttribute(&cus, hipDeviceAttributeMultiprocessorCount, dev) != hipSuccess) { grid = -1; return; }
        if (hipFuncSetAttribute((const void*)fwd_kernel, hipFuncAttributeMaxDynamicSharedMemorySize, LDS_BYTES) != hipSuccess) { fprintf(stderr, "kernel_launch: hipFuncSetAttribute failed\n"); grid = -1; return; }
        if (hipOccupancyMaxActiveBlocksPerMultiprocessor(&per_cu, (const void*)fwd_kernel, 512, LDS_BYTES) != hipSuccess || per_cu < 1) fprintf(stderr, "kernel_launch: occupancy query says %d\n", per_cu);
        (void)hipGetLastError();
        grid = cus;
    }
    if (grid < 0) return;
    if (hipMemsetAsync((char*)d_ws + WS_CTL, 0, CTL_ZERO_BYTES, stream) != hipSuccess) return;
    Args a{};
    for (int i = 0; i < 33; ++i) a.in[i] = (const float*)d_in[i];
    a.out = (float*)d_out; a.ws = (unsigned char*)d_ws;
#if MK_PER_PHASE
    for (int p = 0; p < NPHASES; ++p) { a.ph_lo = p; a.ph_hi = p + 1; hipLaunchKernelGGL(fwd_kernel, dim3(grid), dim3(512), LDS_BYTES, stream, a); }
#else
    a.ph_lo = 0; a.ph_hi = NPHASES;
    hipLaunchKernelGGL(fwd_kernel, dim3(grid), dim3(512), LDS_BYTES, stream, a);
#endif
    const hipError_t le = hipPeekAtLastError();
    if (le != hipSuccess) fprintf(stderr, "kernel_launch: launch failed: %s\n", hipGetErrorName(le));
}
```

```cpp
#include <hip/hip_runtime.h>
#include <cstdio>
#include <cstdint>

#ifndef MK_PER_PHASE
#define MK_PER_PHASE 0
#endif

constexpr int D = 1024, NBATCH = 4, SEQ = 8192, TL = NBATCH * SEQ, CTXL = 256, TC = NBATCH * CTXL, T = TL + TC;
constexpr int NH = 16, HS = 64, NE = 32, TOPK = 4, DEPTH = 4;
constexpr int NMT = T / 256;
constexpr int NMT_L = TL / 256;
constexpr int MAXTILES = (T * TOPK) / 256 + NE;
constexpr int NSTEP = CTXL + SEQ;

__device__ __forceinline__ int lane_id() { return (int)__builtin_amdgcn_mbcnt_hi(~0u, __builtin_amdgcn_mbcnt_lo(~0u, 0u)); }
namespace pg8 {
#define PG8_LAS __attribute__((address_space(3)))
typedef unsigned short bf16_t;
typedef short bf16x8 __attribute__((ext_vector_type(8)));
typedef float f32x4 __attribute__((ext_vector_type(4)));
typedef unsigned u32x4 __attribute__((ext_vector_type(4)));
typedef unsigned u32x2 __attribute__((ext_vector_type(2)));
constexpr int BM = 256, BK = 64, HALF = 128, HTB = HALF * BK * 2  , STAGE_BYTES = 8 * HTB, NXCD = 8, WGM = 8;

__host__ __device__ __forceinline__ int lds_byte(int r, int c) { const int st = (r >> 4) * 2 + (c >> 5), rr = r & 15, cc = c & 31, ob = rr * 64 + cc * 2; return st * 1024 + (ob ^ (((ob >> 9) & 1) << 5)); }
__host__ __device__ __forceinline__ void stage_rc(int b, int& R, int& C) { const int st = b / 1024, sb = b % 1024, swz = sb ^ (((sb >> 9) & 1) << 5); R = (st >> 1) * 16 + swz / 64; C = (st & 1) * 32 + (swz % 64) / 2; }
__host__ __device__ __forceinline__ int perm32(int rho) { const int n = rho >> 4, i = rho & 15; return 8 * (i >> 2) + 4 * n + (i & 3); }

struct Unit { int pm, pn, e, nv, par; };
struct Gemm { const bf16_t* A; const bf16_t* Bt; int M, N, K; };

__device__ __forceinline__ void tile_map(int wgid, int nM, int nN, int& pm, int& pn) {
    const int nwg = nM * nN;
    { const int q = nwg / NXCD, r = nwg % NXCD, xcd = wgid % NXCD, off = wgid / NXCD; wgid = (xcd < r ? xcd * (q + 1) : r * (q + 1) + (xcd - r) * q) + off; }
    const int nig = WGM * nN, gid = wgid / nig, fm = gid * WGM, gsz = (nM - fm) < WGM ? (nM - fm) : WGM;
    pm = fm + ((wgid % nig) % gsz); pn = (wgid % nig) / gsz;
}
typedef __bf16 bf16x2_t __attribute__((ext_vector_type(2)));
typedef float f32x2_t __attribute__((ext_vector_type(2)));
__device__ __forceinline__ unsigned cvt_pk_bf16(float lo, float hi) { const f32x2_t v = {lo, hi}; const bf16x2_t b = __builtin_convertvector(v, bf16x2_t); return __builtin_bit_cast(unsigned, b); }

template <class Epi, class Sched, bool ALIGN_EPI = false, bool SP2 = false, bool GATHER = false>
__device__ __forceinline__ void gemm_phase(PG8_LAS unsigned char* lds, const Gemm g, const Sched& S, const Epi& E, int tid_in) {
    int tid_ = tid_in; asm volatile("" : "+v"(tid_));
    const int tid = tid_, wid = __builtin_amdgcn_readfirstlane(tid >> 6), lane = tid & 63, wr = wid >> 2, wc = wid & 3, fr = lane & 15, fq = lane >> 4;
    int K_ = g.K; asm volatile("" : "+s"(K_));
    const int K = K_, nt = K / BK;
    unsigned voffA[2], voffB[2]; int gR[2]; unsigned gC[2];
#pragma unroll
    for (int i = 0; i < 2; ++i) { int R, C; stage_rc(tid * 16 + i * 8192, R, C); const int Rb = Epi::PERM ? ((R & ~31) + perm32(R & 31)) : R;
        voffA[i] = (unsigned)(R * K + C) * 2u; voffB[i] = (unsigned)(Rb * K + C) * 2u; gR[i] = R; gC[i] = (unsigned)C * 2u; }
    unsigned oc[2][2], on[2][2], o2[2][2];
#pragma unroll
    for (int h = 0; h < 2; ++h)
#pragma unroll
        for (int i = 0; i < 2; ++i) { oc[h][i] = 0u; on[h][i] = 0u; o2[h][i] = 0u; }
    const size_t kstep = (size_t)(BK * 2);
    const size_t hstep = (size_t)HALF * K * 2;
    const size_t tstep = 2 * hstep;
    const unsigned ldsw = (unsigned)wid * 1024u;
    const int aoff = lds_byte(wr * 64 + fr, fq * 8), boff = lds_byte(wc * 32 + fr, fq * 8);
#define PG8_SA(b, h) (((b) * 2 + (h)) * HTB)
#define PG8_SB(b, h) ((4 + (b) * 2 + (h)) * HTB)
#define PG8_STAGE(bufoff, gbase, voff) do { _Pragma("unroll") for (int _i = 0; _i < 2; ++_i) \
        __builtin_amdgcn_global_load_lds((const unsigned*)((const char*)(gbase) + (voff)[_i]), (PG8_LAS unsigned*)(lds + (bufoff) + ldsw + _i * 8192), 16, 0, 0); } while (0)
#define PG8_STAGE_A(bufoff, base, h, O) do { if constexpr (GATHER) { PG8_STAGE(bufoff, base, (O)[h]); } else { PG8_STAGE(bufoff, (base) + (h) * hstep, voffA); } } while (0)
#define PG8_LDA(dst, b, h) do { _Pragma("unroll") for (int m = 0; m < 4; ++m) _Pragma("unroll") for (int k = 0; k < 2; ++k) dst[m][k] = *(const PG8_LAS bf16x8*)(lds + PG8_SA(b, h) + aoff + m * 2048 + k * 1024); } while (0)
#define PG8_LDB(dst, b, h) do { _Pragma("unroll") for (int n = 0; n < 2; ++n) _Pragma("unroll") for (int k = 0; k < 2; ++k) dst[n][k] = *(const PG8_LAS bf16x8*)(lds + PG8_SB(b, h) + boff + n * 2048 + k * 1024); } while (0)
#define PG8_MMA(ai, bj, At, Bt) do { __builtin_amdgcn_s_setprio(1); _Pragma("unroll") for (int m = 0; m < 4; ++m) _Pragma("unroll") for (int n = 0; n < 2; ++n) _Pragma("unroll") for (int k = 0; k < 2; ++k) \
        acc[ai][bj][m][n] = __builtin_amdgcn_mfma_f32_16x16x32_bf16(Bt[n][k], At[m][k], acc[ai][bj][m][n], 0, 0, 0); __builtin_amdgcn_s_setprio(0); } while (0)
#define PG8_WAIT_V(n) asm volatile("s_waitcnt vmcnt(" #n ")" ::: "memory")
#define PG8_WAIT_L(n) asm volatile("s_waitcnt lgkmcnt(" #n ")" ::: "memory")
#define PG8_BAR __builtin_amdgcn_s_barrier()
#define PG8_SCHED __builtin_amdgcn_sched_barrier(0)
    Unit cur, nxt; int ui = 0;
    if (!S.next(0, cur)) return;
    f32x4 acc[2][2][4][2];
#pragma unroll
    for (int a = 0; a < 2; ++a)
#pragma unroll
        for (int b = 0; b < 2; ++b)
#pragma unroll
            for (int m = 0; m < 4; ++m)
#pragma unroll
                for (int n = 0; n < 2; ++n) acc[a][b][m][n] = (f32x4){0.f, 0.f, 0.f, 0.f};
    bf16x8 At[4][2], B0[2][2], B1[2][2];
    const char* cA = GATHER ? (const char*)g.A : (const char*)g.A + (size_t)cur.pm * tstep; const char* cB = (const char*)g.Bt + (size_t)cur.pn * tstep;
    S.a_ready(cur);
    if constexpr (GATHER) {
#pragma unroll
        for (int h = 0; h < 2; ++h)
#pragma unroll
            for (int i = 0; i < 2; ++i) oc[h][i] = S.row_off(cur, h * HALF + gR[i]) + gC[i];
    }
    if constexpr (SP2) {
        PG8_STAGE(PG8_SB(0, 0), cB, voffB); PG8_STAGE(PG8_SB(0, 1), cB + hstep, voffB); PG8_STAGE_A(PG8_SA(0, 0), cA, 0, oc); PG8_STAGE_A(PG8_SA(0, 1), cA, 1, oc);
        if (wr == 1) PG8_BAR;
        PG8_WAIT_V(2); PG8_BAR;
        PG8_STAGE(PG8_SB(1, 0), cB + kstep, voffB); PG8_STAGE_A(PG8_SA(1, 0), cA + kstep, 0, oc); PG8_STAGE(PG8_SB(1, 1), cB + hstep + kstep, voffB);
        PG8_WAIT_V(6); PG8_BAR;
    } else {
        PG8_STAGE(PG8_SB(0, 0), cB, voffB); PG8_STAGE_A(PG8_SA(0, 0), cA, 0, oc); PG8_STAGE(PG8_SB(0, 1), cB + hstep, voffB); PG8_STAGE_A(PG8_SA(0, 1), cA, 1, oc);
        if (wr == 1) PG8_BAR;
        PG8_WAIT_V(4); PG8_BAR;
        PG8_STAGE(PG8_SB(1, 0), cB + kstep, voffB); PG8_STAGE_A(PG8_SA(1, 0), cA + kstep, 0, oc); PG8_STAGE(PG8_SB(1, 1), cB + hstep + kstep, voffB);
        PG8_WAIT_V(6); PG8_BAR;
    }
    for (;;) {
        const bool has_next = S.next(ui + 1, nxt);
        const char* nA = GATHER ? (const char*)g.A : (has_next ? (const char*)g.A + (size_t)nxt.pm * tstep : cA); const char* nB = has_next ? (const char*)g.Bt + (size_t)nxt.pn * tstep : cB;
        if constexpr (GATHER) { if (has_next) S.prefetch_rows(nxt); }
        for (int t = 0; t < nt; t += 2) {
            const bool last = (t == nt - 2);
            const char* a1 = cA + (size_t)(t + 1) * kstep;
            const char* a2 = last ? nA : cA + (size_t)(t + 2) * kstep; const char* b2 = last ? nB : cB + (size_t)(t + 2) * kstep;
            const char* a3 = a2 + kstep; const char* b3 = b2 + kstep;
            if constexpr (GATHER) {
                if (last) {
#pragma unroll
                    for (int h = 0; h < 2; ++h)
#pragma unroll
                        for (int i = 0; i < 2; ++i) on[h][i] = has_next ? (S.row_off_lds(nxt, h * HALF + gR[i]) + gC[i]) : oc[h][i];
                }
#pragma unroll
                for (int h = 0; h < 2; ++h)
#pragma unroll
                    for (int i = 0; i < 2; ++i) o2[h][i] = last ? on[h][i] : oc[h][i];
            }
            if (last && has_next) S.a_ready(nxt);
            if constexpr (SP2) {
            PG8_LDB(B0, 0, 0); PG8_LDB(B1, 0, 1); PG8_SCHED; PG8_LDA(At, 0, 0); PG8_STAGE_A(PG8_SA(1, 1), a1, 1, oc);
            PG8_WAIT_V(8); PG8_WAIT_L(0); PG8_BAR; PG8_MMA(0, 0, At, B0); PG8_MMA(0, 1, At, B1); PG8_BAR; PG8_SCHED;
            PG8_LDA(At, 0, 1); PG8_STAGE(PG8_SB(0, 0), b2, voffB); PG8_STAGE(PG8_SB(0, 1), b2 + hstep, voffB); PG8_STAGE_A(PG8_SA(0, 0), a2, 0, o2);
            PG8_WAIT_V(8); PG8_WAIT_L(0); PG8_BAR; PG8_MMA(1, 0, At, B0); PG8_MMA(1, 1, At, B1); PG8_BAR; PG8_SCHED;
            PG8_LDB(B0, 1, 0); PG8_LDB(B1, 1, 1); PG8_SCHED; PG8_LDA(At, 1, 0); PG8_STAGE_A(PG8_SA(0, 1), a2, 1, o2);
            PG8_WAIT_V(8); PG8_WAIT_L(0); PG8_BAR; PG8_MMA(0, 0, At, B0); PG8_MMA(0, 1, At, B1); PG8_BAR; PG8_SCHED;
            PG8_LDA(At, 1, 1); PG8_STAGE(PG8_SB(1, 0), b3, voffB); PG8_STAGE(PG8_SB(1, 1), b3 + hstep, voffB); PG8_STAGE_A(PG8_SA(1, 0), a3, 0, o2);
            PG8_WAIT_V(8); PG8_WAIT_L(0); PG8_BAR; PG8_MMA(1, 0, At, B0); PG8_MMA(1, 1, At, B1); PG8_BAR; PG8_SCHED;
            } else {
            PG8_LDB(B0, 0, 0); PG8_SCHED; PG8_LDA(At, 0, 0); PG8_STAGE_A(PG8_SA(1, 1), a1, 1, oc);
            PG8_WAIT_L(8); PG8_BAR; PG8_WAIT_L(0); PG8_MMA(0, 0, At, B0); PG8_BAR; PG8_SCHED;
            PG8_LDB(B1, 0, 1); PG8_STAGE(PG8_SB(0, 0), b2, voffB);
            PG8_BAR; PG8_WAIT_L(0); PG8_MMA(0, 1, At, B1); PG8_BAR;
            PG8_LDA(At, 0, 1); PG8_STAGE_A(PG8_SA(0, 0), a2, 0, o2);
            PG8_BAR; PG8_WAIT_L(0); PG8_MMA(1, 0, At, B0); PG8_BAR; PG8_SCHED;
            PG8_STAGE(PG8_SB(0, 1), b2 + hstep, voffB);
            PG8_WAIT_V(6); PG8_BAR; PG8_MMA(1, 1, At, B1); PG8_BAR;
            PG8_LDB(B0, 1, 0); PG8_SCHED; PG8_LDA(At, 1, 0); PG8_STAGE_A(PG8_SA(0, 1), a2, 1, o2);
            PG8_WAIT_L(8); PG8_BAR; PG8_WAIT_L(0); PG8_MMA(0, 0, At, B0); PG8_BAR; PG8_SCHED;
            PG8_LDB(B1, 1, 1); PG8_STAGE(PG8_SB(1, 0), b3, voffB);
            PG8_BAR; PG8_WAIT_L(0); PG8_MMA(0, 1, At, B1); PG8_BAR;
            PG8_LDA(At, 1, 1); PG8_STAGE_A(PG8_SA(1, 0), a3, 0, o2);
            PG8_BAR; PG8_WAIT_L(0); PG8_MMA(1, 0, At, B0); PG8_BAR; PG8_SCHED;
            PG8_STAGE(PG8_SB(1, 1), b3 + hstep, voffB);
            PG8_WAIT_V(6); PG8_BAR; PG8_MMA(1, 1, At, B1); PG8_BAR;
            }
        }
        if constexpr (ALIGN_EPI) { if (wr == 0) PG8_BAR; }
        if constexpr (!Epi::AFTER_DRAIN) { E(acc, cur, wr, wc, fr, fq); S.done(cur); }
        if (!has_next) break;
#pragma unroll
        for (int a = 0; a < 2; ++a)
#pragma unroll
            for (int b = 0; b < 2; ++b)
#pragma unroll
                for (int m = 0; m < 4; ++m)
#pragma unroll
                    for (int n = 0; n < 2; ++n) acc[a][b][m][n] = (f32x4){0.f, 0.f, 0.f, 0.f};
        cur = nxt; cA = nA; cB = nB; ++ui;
        if constexpr (GATHER) {
#pragma unroll
            for (int h = 0; h < 2; ++h)
#pragma unroll
                for (int i = 0; i < 2; ++i) oc[h][i] = on[h][i];
        }
        if constexpr (ALIGN_EPI) { if (wr == 1) PG8_BAR; }
    }
    PG8_WAIT_V(0);
    if constexpr (!ALIGN_EPI) { if (wr == 0) PG8_BAR; }
    PG8_BAR;
    if constexpr (Epi::AFTER_DRAIN) { E.fused(acc, cur, wr, wc, fr, fq, lds, wid, lane); S.done(cur); }
#undef PG8_SA
#undef PG8_SB
#undef PG8_STAGE
#undef PG8_STAGE_A
#undef PG8_LDA
#undef PG8_LDB
#undef PG8_MMA
#undef PG8_WAIT_V
#undef PG8_WAIT_L
#undef PG8_BAR
#undef PG8_SCHED
}
}

#define LAS __attribute__((address_space(3)))
typedef unsigned short bf16;
typedef float f32x4 __attribute__((ext_vector_type(4)));
typedef unsigned u32x2 __attribute__((ext_vector_type(2)));
typedef unsigned u32x4 __attribute__((ext_vector_type(4)));
#define LDS_WAIT() asm volatile("s_waitcnt lgkmcnt(0)" ::: "memory")
__device__ __forceinline__ unsigned pk2(float lo, float hi) { return pg8::cvt_pk_bf16(lo, hi); }
__device__ __forceinline__ unsigned f2bf(float f) { return pk2(f, f) & 0xffffu; }
__device__ __forceinline__ float bflo(unsigned w) { return __builtin_bit_cast(float, w << 16); }
__device__ __forceinline__ float bfhi(unsigned w) { return __builtin_bit_cast(float, w & 0xffff0000u); }
__device__ __forceinline__ float wave_sum(float v) {
#pragma unroll
    for (int o = 1; o < 64; o <<= 1) v += __shfl_xor(v, o);
    return v;
}
__device__ __forceinline__ float frcp(float x) { return __builtin_amdgcn_rcpf(x); }
__device__ __forceinline__ float sigm(float x) { return frcp(1.0f + __expf(-x)); }
__device__ __forceinline__ float tanh_fast(float x) { const float e = __expf(2.0f * x); return 1.0f - 2.0f * frcp(e + 1.0f); }

constexpr size_t MiB = 1u << 20;
constexpr size_t RF = (size_t)T * D * 4;
constexpr size_t RB = (size_t)T * D * 2;
constexpr size_t WS_CTL = 0, CTL_ZERO_BYTES = 1 * MiB;
constexpr size_t WS_MODS = 1 * MiB;
constexpr size_t WS_XSA = 2 * MiB, WS_XSB = WS_XSA + RF;
constexpr size_t WS_XL = WS_XSB + RF;
constexpr size_t WS_RKV = WS_XL + 6 * RB;
constexpr size_t WS_L1 = WS_RKV + 3 * RF;
constexpr size_t WS_WDEC = WS_L1 + 50 * MiB;
constexpr size_t WS_AA = WS_WDEC + 2 * RF;
constexpr size_t WS_G = WS_AA + 2 * RF;
constexpr size_t WS_KK = WS_G + RB;
constexpr size_t WS_KD = WS_KK + RF;
constexpr size_t WS_BETA = WS_KD + 2 * RF;
constexpr size_t WS_RKB = WS_BETA + 2 * RF;
constexpr size_t WS_C12 = WS_RKB + 3 * MiB;
constexpr size_t WS_WRT = WS_C12 + 6 * MiB;
constexpr size_t WS_Y = WS_C12 + 9 * MiB;
constexpr size_t WS_Z = WS_Y + 2 * RF;
constexpr size_t WS_H2 = WS_Z + RB;
constexpr size_t WS_SLOTL = WS_H2 + RB;
constexpr size_t WS_GATEL = WS_SLOTL + 5 * MiB;
constexpr size_t WS_WRKV = WS_GATEL + 5 * MiB;
constexpr size_t WS_L2T = WS_WRKV + 15 * MiB;
constexpr size_t WS_WO = WS_L2T + 5 * MiB;
constexpr size_t WS_WIN = WS_WO + 4 * MiB;
constexpr size_t WS_WOUT = WS_WIN + 12 * MiB;
constexpr size_t WS_WGU = WS_WOUT + 4 * MiB;
constexpr size_t WS_WDN = WS_WGU + 512 * MiB;
constexpr size_t WS_END = WS_WDN + 256 * MiB;
constexpr size_t WS_INTER = WS_WDEC;
constexpr size_t WS_YS = WS_KD;
constexpr size_t WS_BG = WS_RKV, WS_CUZ = WS_RKV + RB;
constexpr size_t WS_RAWW = WS_AA, WS_RAWA = WS_AA + RF;
constexpr size_t WS_RH = WS_AA;
constexpr size_t WS_PM = WS_WDEC;
constexpr size_t WS_RKB1 = WS_C12 + 1 * MiB;
constexpr size_t WS_QT = WS_XL;
constexpr size_t WS_HT = WS_XL + RF;
static_assert((size_t)128 * 132 * 4096 * 2 <= RF, "chunk state tensors");
static_assert((size_t)MAXTILES * 256 * 1024 * 2 <= 4 * RF, "INTER overlay");
static_assert((size_t)T * 4 * 1024 * 2 <= 2 * RF, "YS overlay");
static_assert((size_t)3 * T * 256 * 2 <= 50 * MiB, "L1OUT");
constexpr int CW_BAR = 4096;
constexpr int CW_CNT = 16384, CNT_STRIDE = 64;

constexpr int RING_BYTES = 131072;
constexpr int LDSCTL_OFF = RING_BYTES;
constexpr int LDS_BYTES = 147456;

struct Args { const float* in[33]; float* out; unsigned char* ws; int ph_lo, ph_hi; };

__device__ __forceinline__ void transpose_item(const float* W, int N, bf16* WT, int dstK, int drow0, int k0, int n0, LAS float* scr, int lane) {
    float tv[32];
#pragma unroll
    for (int i = 0; i < 32; ++i) { const int kk = 2 * i + (lane >> 5); tv[i] = W[(size_t)(k0 + kk) * N + n0 + (lane & 31)]; }
#pragma unroll
    for (int i = 0; i < 32; ++i) { const int kk = 2 * i + (lane >> 5); scr[kk * 33 + (lane & 31)] = tv[i]; }
    LDS_WAIT(); asm volatile("" ::: "memory");
    const int c = lane & 7;
#pragma unroll
    for (int j = 0; j < 4; ++j) { const int n = (lane >> 3) + 8 * j; const LAS float* s = scr + (8 * c) * 33 + n;
        u32x4 o; o.x = pk2(s[0 * 33], s[1 * 33]); o.y = pk2(s[2 * 33], s[3 * 33]); o.z = pk2(s[4 * 33], s[5 * 33]); o.w = pk2(s[6 * 33], s[7 * 33]);
        *(u32x4*)(WT + (size_t)(drow0 + n) * dstK + k0 + 8 * c) = o; }
    LDS_WAIT(); asm volatile("" ::: "memory");
}
__device__ __forceinline__ int gu_map(int n0) { const int bj = n0 >= 1024 ? 1 : 0, f0 = n0 - bj * 1024; return (f0 >> 7) * 256 + bj * 128 + (f0 & 127); }
__device__ __forceinline__ int conv_map(int n0) { if (n0 < 1024) return n0; const int q = (n0 - 1024) >> 10, f0 = (n0 - 1024) & 1023; return 1024 + (f0 >> 7) * 256 + q * 128 + (f0 & 127); }

__device__ __forceinline__ void p0_prologue(const Args& a, LAS unsigned char* lds, int tid, int lane, int wave, int G) {
    unsigned char* ws = a.ws;
    LAS float* sl = (LAS float*)lds;
    LAS float* red = (LAS float*)(lds + 20480);
    for (int i = tid; i < 5 * 1024; i += 512) { const int r = i >> 10, k = i & 1023; const float cv = r < 4 ? a.in[1][r * 1024 + k] : a.in[3][k]; sl[i] = cv * sigm(cv); }
    __syncthreads();
    float* MODS = (float*)(ws + WS_MODS);
    for (int it = blockIdx.x; it < 4 * 96; it += G) {
        const int l = it / 96, n = (it % 96) * 64 + lane;
        const float* W = a.in[4] + (size_t)l * 1024 * 6144 + n;
        float acc[5] = {0.f, 0.f, 0.f, 0.f, 0.f};
        const int kb = wave * 128;
#pragma unroll 8
        for (int k = 0; k < 128; ++k) { const float wv = W[(size_t)(kb + k) * 6144];
#pragma unroll
            for (int r = 0; r < 5; ++r) acc[r] += sl[r * 1024 + kb + k] * wv; }
#pragma unroll
        for (int r = 0; r < 5; ++r) red[(wave * 5 + r) * 64 + lane] = acc[r];
        __syncthreads();
        if (wave < 5) { float s = a.in[5][l * 6144 + n];
#pragma unroll
            for (int w = 0; w < 8; ++w) s += red[(w * 5 + wave) * 64 + lane];
            MODS[(size_t)(l * 5 + wave) * 6144 + n] = s; }
        __syncthreads();
    }
    LAS float* scr = (LAS float*)(lds + 32768 + wave * 8448);
    const int gw = blockIdx.x * 8 + wave, NGW = G * 8;
    bf16* WRKV = (bf16*)(ws + WS_WRKV); bf16* WOt = (bf16*)(ws + WS_WO); bf16* WINt = (bf16*)(ws + WS_WIN); bf16* WOUTt = (bf16*)(ws + WS_WOUT);
    bf16* WGU = (bf16*)(ws + WS_WGU); bf16* WDN = (bf16*)(ws + WS_WDN);
    constexpr int I_GU = 128 * 1024, I_DN = 128 * 512, I_RKV = 6 * 512, I_WO = 2 * 512, I_WIN = 2 * 1536, I_WOUT = 2 * 512, I_W1 = 4 * 32, I_A1 = 4 * 32, I_G1 = 2 * 64;
    constexpr int NITEMS = I_GU + I_DN + I_RKV + I_WO + I_WIN + I_WOUT + I_W1 + I_A1 + I_G1;
    for (int it = gw; it < NITEMS; it += NGW) {
        int r = it;
        if (r < I_GU) { const int m = r >> 10, q = r & 1023, kb = q >> 6, nb = q & 63;
            transpose_item(a.in[29] + (size_t)m * 1024 * 2048, 2048, WGU + (size_t)m * 2048 * 1024, 1024, gu_map(nb * 32), kb * 64, nb * 32, scr, lane); continue; } r -= I_GU;
        if (r < I_DN) { const int m = r >> 9, q = r & 511, kb = q >> 5, nb = q & 31;
            transpose_item(a.in[31] + (size_t)m * 1024 * 1024, 1024, WDN + (size_t)m * 1024 * 1024, 1024, nb * 32, kb * 64, nb * 32, scr, lane); continue; } r -= I_DN;
        if (r < I_RKV) { const int m = r >> 9, q = r & 511, kb = q >> 5, nb = q & 31, lr = m / 3, j = m % 3;
            transpose_item(a.in[9] + (size_t)m * 1024 * 1024, 1024, WRKV + (size_t)lr * 3840 * 1024, 1024, j * 1024 + nb * 32, kb * 64, nb * 32, scr, lane); continue; } r -= I_RKV;
        if (r < I_WO) { const int m = r >> 9, q = r & 511, kb = q >> 5, nb = q & 31;
            transpose_item(a.in[23] + (size_t)m * 1024 * 1024, 1024, WOt + (size_t)m * 1024 * 1024, 1024, nb * 32, kb * 64, nb * 32, scr, lane); continue; } r -= I_WO;
        if (r < I_WIN) { const int m = r / 1536, q = r % 1536, kb = q / 96, nb = q % 96;
            transpose_item(a.in[24] + (size_t)m * 1024 * 3072, 3072, WINt + (size_t)m * 3072 * 1024, 1024, conv_map(nb * 32), kb * 64, nb * 32, scr, lane); continue; } r -= I_WIN;
        if (r < I_WOUT) { const int m = r >> 9, q = r & 511, kb = q >> 5, nb = q & 31;
            transpose_item(a.in[26] + (size_t)m * 1024 * 1024, 1024, WOUTt + (size_t)m * 1024 * 1024, 1024, nb * 32, kb * 64, nb * 32, scr, lane); continue; } r -= I_WOUT;
        if (r < I_W1) { const int m = r >> 5, q = r & 31, kb = q >> 1, nb = q & 1, lr = m >> 1, e = m & 1;
            transpose_item(a.in[11] + (size_t)m * 1024 * 64, 64, WRKV + (size_t)lr * 3840 * 1024, 1024, 3072 + e * 64 + nb * 32, kb * 64, nb * 32, scr, lane); continue; } r -= I_W1;
        if (r < I_A1) { const int m = r >> 5, q = r & 31, kb = q >> 1, nb = q & 1, lr = m >> 1, e = m & 1;
            transpose_item(a.in[14] + (size_t)m * 1024 * 64, 64, WRKV + (size_t)lr * 3840 * 1024, 1024, 3328 + e * 64 + nb * 32, kb * 64, nb * 32, scr, lane); continue; } r -= I_A1;
        { const int m = r >> 6, q = r & 63, kb = q >> 2, nb = q & 3;
            transpose_item(a.in[16] + (size_t)m * 1024 * 128, 128, WRKV + (size_t)m * 3840 * 1024, 1024, 3584 + nb * 32, kb * 64, nb * 32, scr, lane); }
    }
    const int gt = blockIdx.x * 512 + tid, NGT = G * 512;
    for (int i = gt; i < 2 * 3 * 128 * 128; i += NGT) {
        const int pc = i & 127, rw = (i >> 7) & 127, pd = (i >> 14) % 3, lr = i / (3 * 16384);
        *(u32x4*)(WRKV + ((size_t)lr * 3840 + 3072 + pd * 256 + 128 + rw) * 1024 + pc * 8) = (u32x4){0u, 0u, 0u, 0u}; }
    bf16* L2T = (bf16*)(ws + WS_L2T);
    for (int i = gt; i < 2 * 128 * 5120; i += NGT) {
        const int n = i % 5120, k = (i / 5120) & 127, lr = i / (5120 * 128);
        float v = 0.f;
        if (n < 2048) { const int e = n >> 10, d = n & 1023; if ((k >> 6) == e) v = a.in[12][(((size_t)lr * 2 + e) * 64 + (k & 63)) * 1024 + d]; }
        else if (n < 4096) { const int e = (n - 2048) >> 10, d = n & 1023; if ((k >> 6) == e) v = a.in[15][(((size_t)lr * 2 + e) * 64 + (k & 63)) * 1024 + d]; }
        else { const int d = n - 4096; v = a.in[17][((size_t)lr * 128 + k) * 1024 + d]; }
        L2T[((size_t)lr * 5120 + n) * 128 + k] = (bf16)f2bf(v);
    }
    bf16* WRT = (bf16*)(ws + WS_WRT);
    for (int i = gt; i < 4 * 32 * 1024; i += NGT) { const int k = i & 1023, e = (i >> 10) & 31, l = i >> 15;
        const float w = a.in[27][((size_t)l * 1024 + k) * 32 + e]; const unsigned hi = f2bf(w); const float lo = w - bflo(hi);
        WRT[((size_t)(l * 2 + 0) * 32 + e) * 1024 + k] = (bf16)hi; WRT[((size_t)(l * 2 + 1) * 32 + e) * 1024 + k] = (bf16)f2bf(lo); }
}
#define XB_TMO      128
#define XB_XCNT(j)  (256  + 64 * (j))
#define XB_XSUB(j)  (1280 + 64 * (j))
#define XB_XGEN(j)  (2304 + 64 * (j))
#define XB_TOP      3328
#define XB_TOPGEN   3392
#define XCD_BAR_WORDS 3456
#define XB_SPIN_CAP (1u << 23)

__device__ __forceinline__ unsigned xb_ld(unsigned* p)              { return __hip_atomic_load(p, __ATOMIC_RELAXED, __HIP_MEMORY_SCOPE_AGENT); }
__device__ __forceinline__ unsigned xb_add(unsigned* p, unsigned v) { return __hip_atomic_fetch_add(p, v, __ATOMIC_RELAXED, __HIP_MEMORY_SCOPE_AGENT); }
__device__ __forceinline__ unsigned xb_xcc_id() { return (unsigned)__builtin_amdgcn_s_getreg((3 << 11) | 20) & 0xFu; }
#define XB_SPIN(cond, bar) do { unsigned _sp = 0; while (cond) { __builtin_amdgcn_s_sleep(1); \
    if ((++_sp & 255u) == 0u) { if (xb_ld(&(bar)[XB_TMO])) break; if (_sp > XB_SPIN_CAP) { atomicAdd(&(bar)[XB_TMO], 1u); break; } } } } while (0)

struct XcdBarrier {
    unsigned wv;
    unsigned* bar; unsigned x;
    volatile LAS unsigned* st;
};

__device__ __forceinline__ XcdBarrier xcd_barrier_post(unsigned* bar, volatile LAS unsigned* st) {
    XcdBarrier b; b.wv = (unsigned)__builtin_amdgcn_readfirstlane((int)(threadIdx.x >> 6)); b.bar = bar; b.x = xb_xcc_id(); b.st = st;
    if (threadIdx.x == 0) (void)xb_add(&bar[XB_XCNT(b.x)], 1u);
    return b;
}
__device__ __forceinline__ void xcd_barrier_complete(unsigned* bar, unsigned x, unsigned& nloc, unsigned& nx) {
    const unsigned G = gridDim.x * gridDim.y * gridDim.z;
    unsigned sum, cnt, mine, sp = 0u;
    for (;;) {
        sum = 0u; cnt = 0u; mine = 0u;
#pragma unroll
        for (unsigned j = 0; j < 16; ++j) { const unsigned c = xb_ld(&bar[XB_XCNT(j)]); sum += c; cnt += (c > 0u) ? 1u : 0u; mine = (j == x) ? c : mine; }
        if (sum == G) break;
        __builtin_amdgcn_s_sleep(1);
        if ((++sp & 255u) == 0u) { if (xb_ld(&bar[XB_TMO])) break; if (sp > XB_SPIN_CAP) { atomicAdd(&bar[XB_TMO], 1u); break; } }
    }
    nloc = mine > 0u ? mine : 1u; nx = cnt > 0u ? cnt : 1u;
}

__device__ __forceinline__ void xcd_barrier(const XcdBarrier& b) {
    asm volatile("s_waitcnt vmcnt(0)" ::: "memory");
    __syncthreads();
    if (b.wv == 0u && lane_id() == 0) {
        unsigned* bar = b.bar;
        __builtin_amdgcn_s_waitcnt(0);
        unsigned nloc = b.st[0], nx = b.st[1];
        if (nloc == 0u) { xcd_barrier_complete(bar, b.x, nloc, nx); b.st[0] = nloc; b.st[1] = nx; }
        const unsigned old = xb_add(&bar[XB_XSUB(b.x)], 1u);
        const unsigned gen = old / nloc;
        if (old + 1u == (gen + 1u) * nloc) {
            __builtin_amdgcn_fence(__ATOMIC_RELEASE, "agent");
            asm volatile("s_waitcnt vmcnt(0)" ::: "memory");
            const unsigned og = xb_add(&bar[XB_TOP], 1u);
            const unsigned tg = og / nx;
            if (og + 1u == (tg + 1u) * nx) xb_add(&bar[XB_TOPGEN], 1u);
            else XB_SPIN(xb_ld(&bar[XB_TOPGEN]) == tg, bar);
            __builtin_amdgcn_fence(__ATOMIC_ACQUIRE, "agent");
            xb_add(&bar[XB_XGEN(b.x)], 1u);
            asm volatile("s_waitcnt vmcnt(0)" ::: "memory");
        } else {
            XB_SPIN(xb_ld(&bar[XB_XGEN(b.x)]) == gen, bar);
            __builtin_amdgcn_fence(__ATOMIC_ACQUIRE, "agent");
            asm volatile("s_waitcnt vmcnt(0)" ::: "memory");
        }
    }
    __syncthreads();
}

__device__ __forceinline__ int mod_row(int row) { return row < TL ? (row >> 13) : 4; }

__device__ __forceinline__ void load_x_combined(f32x4 (&x)[4], const float* xrow, bool has_prev, const bf16* YS, int t, const f32x4 (&m5)[4], int lane) {
#pragma unroll
    for (int j = 0; j < 4; ++j) x[j] = *(const f32x4*)(xrow + 256 * j + 4 * lane);
    if (has_prev) {
        f32x4 s[4];
#pragma unroll
        for (int j = 0; j < 4; ++j) s[j] = (f32x4){0.f, 0.f, 0.f, 0.f};
#pragma unroll
        for (int k = 0; k < 4; ++k) { const bf16* yr = YS + ((size_t)t * 4 + k) * 1024;
#pragma unroll
            for (int j = 0; j < 4; ++j) { const u32x2 w = *(const u32x2*)(yr + 256 * j + 4 * lane); s[j] += (f32x4){bflo(w.x), bfhi(w.x), bflo(w.y), bfhi(w.y)}; } }
#pragma unroll
        for (int j = 0; j < 4; ++j) x[j] += m5[j] * s[j];
    }
}
__device__ __forceinline__ float row_rstd(const f32x4 (&x)[4]) {
    float ss = 0.f;
#pragma unroll
    for (int j = 0; j < 4; ++j) ss += (x[j].x * x[j].x + x[j].y * x[j].y) + (x[j].z * x[j].z + x[j].w * x[j].w);
    return rsqrtf(wave_sum(ss) * (1.0f / 1024.0f) + 1e-6f);
}

__device__ __forceinline__ void phase_a_rwkv(const Args& a, int layer, LAS unsigned char* lds, int tid, int gw, int NGW, int lane) {
    unsigned char* ws = a.ws; const int lj = layer >> 1; const bool has_prev = layer > 0;
    const float* xin_lat = layer == 0 ? a.in[0] : (const float*)(ws + WS_XSA);
    const float* xin_ctx = layer == 0 ? a.in[2] : (const float*)(ws + WS_XSA) + (size_t)TL * D;
    float* xout = (float*)(ws + (layer == 0 ? WS_XSA : WS_XSB));
    const float* MODS = (const float*)(ws + WS_MODS); const bf16* YS = (const bf16*)(ws + WS_YS); bf16* XL = (bf16*)(ws + WS_XL);
    const float* mug = a.in[8] + (size_t)lj * 6 * 2 * 1024; const float* ng = a.in[6] + (size_t)(layer * 2 + 0) * 1024;
    LAS float* mu = (LAS float*)lds;
    for (int i = tid; i < 6 * 2 * 1024 / 4; i += 512) ((LAS f32x4*)mu)[i] = ((const f32x4*)mug)[i];
    __syncthreads();
    for (int it = gw; it < TL / 8 + TC / 2; it += NGW) {
        const int ntok = it < TL / 8 ? 8 : 2, t0 = it < TL / 8 ? it * 8 : TL + (it - TL / 8) * 2, mr = mod_row(t0);
        int rs, re; if (t0 < TL) { rs = t0 & ~63; re = rs + 63; } else { const int loc = t0 - TL; rs = TL + (loc & ~255); re = rs + 255; }
        const float* mod = MODS + (size_t)(layer * 5 + mr) * 6144;
        const float* m5p = MODS + (size_t)((has_prev ? layer - 1 : 0) * 5 + mr) * 6144 + 5 * 1024;
        f32x4 hm[4], h0[4], hp[4];
#pragma unroll
        for (int j = 0; j < 4; ++j) { hm[j] = (f32x4){0.f, 0.f, 0.f, 0.f}; h0[j] = hm[j]; hp[j] = hm[j]; }
        f32x4 rx[4], nx[4]; u32x2 ry[4][4], ny[4][4];
#define PA_LOAD(X, Y, tt) do { const int t_ = (tt); if (t_ >= rs && t_ <= re) { \
            const float* xrow_ = t_ < TL ? xin_lat + (size_t)t_ * D : xin_ctx + (size_t)(t_ - TL) * D; \
            _Pragma("unroll") for (int j = 0; j < 4; ++j) X[j] = *(const f32x4*)(xrow_ + 256 * j + 4 * lane); \
            if (has_prev) { _Pragma("unroll") for (int k = 0; k < 4; ++k) _Pragma("unroll") for (int j = 0; j < 4; ++j) Y[k][j] = *(const u32x2*)(YS + ((size_t)t_ * 4 + k) * 1024 + 256 * j + 4 * lane); } } } while (0)
#pragma unroll
        for (int j = 0; j < 4; ++j) { rx[j] = (f32x4){0.f, 0.f, 0.f, 0.f}; nx[j] = rx[j];
#pragma unroll
            for (int k = 0; k < 4; ++k) { ry[k][j] = (u32x2){0u, 0u}; ny[k][j] = ry[k][j]; } }
        PA_LOAD(rx, ry, t0 - 1);
#pragma unroll 1
        for (int i = -1; i <= ntok; ++i) {
            const int t = t0 + i;
            if (i < ntok) PA_LOAD(nx, ny, t + 1);
            f32x4 hn[4];
            if (t >= rs && t <= re) {
                f32x4 x[4];
#pragma unroll
                for (int j = 0; j < 4; ++j) x[j] = rx[j];
                if (has_prev) {
#pragma unroll
                    for (int j = 0; j < 4; ++j) { f32x4 sm = (f32x4){0.f, 0.f, 0.f, 0.f};
#pragma unroll
                        for (int k = 0; k < 4; ++k) sm += (f32x4){bflo(ry[k][j].x), bfhi(ry[k][j].x), bflo(ry[k][j].y), bfhi(ry[k][j].y)};
                        x[j] += *(const f32x4*)(m5p + 256 * j + 4 * lane) * sm; } }
                if (i >= 0 && i < ntok) {
#pragma unroll
                    for (int j = 0; j < 4; ++j) *(f32x4*)(xout + (size_t)t * D + 256 * j + 4 * lane) = x[j]; }
                const float rstd = row_rstd(x);
#pragma unroll
                for (int j = 0; j < 4; ++j) { const int col = 256 * j + 4 * lane; hn[j] = x[j] * rstd * *(const f32x4*)(ng + col) * (*(const f32x4*)(mod + 1024 + col) + 1.0f) + *(const f32x4*)(mod + col); }
            } else {
#pragma unroll
                for (int j = 0; j < 4; ++j) hn[j] = (f32x4){0.f, 0.f, 0.f, 0.f};
            }
#pragma unroll
            for (int j = 0; j < 4; ++j) { hm[j] = h0[j]; h0[j] = hp[j]; hp[j] = hn[j]; rx[j] = nx[j];
#pragma unroll
                for (int k = 0; k < 4; ++k) ry[k][j] = ny[k][j]; }
            if (i >= 1) {
                const int te = t - 1;
#pragma unroll
                for (int q = 0; q < 6; ++q) {
                    bf16* orow = XL + ((size_t)q * T + te) * D;
#pragma unroll
                    for (int j = 0; j < 4; ++j) { const int col = 256 * j + 4 * lane;
                        const f32x4 m0 = *(const LAS f32x4*)(mu + (q * 2 + 0) * 1024 + col), m1 = *(const LAS f32x4*)(mu + (q * 2 + 1) * 1024 + col);
                        const f32x4 o = h0[j] + m0 * (hm[j] - h0[j]) + m1 * (hp[j] - h0[j]);
                        u32x2 w; w.x = pk2(o.x, o.y); w.y = pk2(o.z, o.w); *(u32x2*)(orow + col) = w; }
                }
            }
        }
#undef PA_LOAD
    }
}
__device__ __forceinline__ void phase_a_conv(const Args& a, int layer, int rows, int gw, int NGW, int lane) {
    unsigned char* ws = a.ws;
    float* xs = (float*)(ws + (layer < 2 ? WS_XSA : WS_XSB));
    const float* MODS = (const float*)(ws + WS_MODS); const bf16* YS = (const bf16*)(ws + WS_YS); bf16* H = (bf16*)(ws + WS_XL);
    const float* ng = a.in[6] + (size_t)(layer * 2 + 0) * 1024;
    for (int t = gw; t < rows; t += NGW) {
        const int mr = mod_row(t);
        const float* mod = MODS + (size_t)(layer * 5 + mr) * 6144;
        f32x4 m5[4], x[4];
#pragma unroll
        for (int j = 0; j < 4; ++j) m5[j] = *(const f32x4*)(MODS + (size_t)((layer - 1) * 5 + mr) * 6144 + 5 * 1024 + 256 * j + 4 * lane);
        load_x_combined(x, xs + (size_t)t * D, true, YS, t, m5, lane);
        const float rstd = row_rstd(x);
#pragma unroll
        for (int j = 0; j < 4; ++j) { const int col = 256 * j + 4 * lane;
            *(f32x4*)(xs + (size_t)t * D + col) = x[j];
            const f32x4 h = x[j] * rstd * *(const f32x4*)(ng + col) * (*(const f32x4*)(mod + 1024 + col) + 1.0f) + *(const f32x4*)(mod + col);
            u32x2 w; w.x = pk2(h.x, h.y); w.y = pk2(h.z, h.w); *(u32x2*)(H + (size_t)t * D + col) = w; }
    }
}
#define DPPF(x, ctrl) __builtin_bit_cast(float, __builtin_amdgcn_update_dpp(0, __builtin_bit_cast(int, (x)), (ctrl), 0xf, 0xf, false))
__device__ __forceinline__ float row16_sum(float v) { v += DPPF(v, 0xB1); v += DPPF(v, 0x4E); v += DPPF(v, 0x141); v += DPPF(v, 0x140); return v; }
__device__ __forceinline__ f32x4 bf4(u32x2 w) { return (f32x4){bflo(w.x), bfhi(w.x), bflo(w.y), bfhi(w.y)}; }
__device__ __forceinline__ u32x2 pk4(f32x4 v) { u32x2 w; w.x = pk2(v[0], v[1]); w.y = pk2(v[2], v[3]); return w; }
__device__ __forceinline__ void phase_c_prep(const Args& a, int lj, LAS unsigned char* lds, int tid, int gw, int NGW, int lane) {
    unsigned char* ws = a.ws;
    const bf16* Rr = (const bf16*)(ws + WS_RKV); const bf16* Kk = Rr + (size_t)T * D; const bf16* RA = (const bf16*)(ws + WS_RAWA); const bf16* RW = (const bf16*)(ws + WS_RAWW);
    bf16* KK = (bf16*)(ws + WS_KK); bf16* KD = (bf16*)(ws + WS_KD); bf16* BE = (bf16*)(ws + WS_BETA); float* RKB = (float*)(ws + WS_RKB);
    LAS float* tb = (LAS float*)lds;
    for (int i = tid; i < 7 * 256; i += 512) { const int t7 = i >> 8, q = i & 255;
        const float* src = t7 == 0 ? a.in[18] + lj * 1024 : t7 == 1 ? a.in[19] + lj * 1024 : t7 == 2 ? a.in[20] + lj * 1024 : t7 < 5 ? a.in[10] + lj * 2048 + (t7 - 3) * 1024 : a.in[13] + lj * 2048 + (t7 - 5) * 1024;
        ((LAS f32x4*)tb)[i] = ((const f32x4*)src)[q]; }
    __syncthreads();
    for (int row = gw; row < T; row += NGW) {
#pragma unroll
        for (int j = 0; j < 4; ++j) {
            const int col = 256 * j + 4 * lane; const size_t ro = (size_t)row * D + col;
            const f32x4 k = bf4(*(const u32x2*)(Kk + ro)), r = bf4(*(const u32x2*)(Rr + ro));
            f32x4 a0 = bf4(*(const u32x2*)(RA + ro)) + *(const LAS f32x4*)(tb + 5 * 1024 + col), a1 = bf4(*(const u32x2*)(RA + (size_t)T * D + ro)) + *(const LAS f32x4*)(tb + 6 * 1024 + col);
#pragma unroll
            for (int z = 0; z < 4; ++z) { a0[z] = sigm(a0[z]); a1[z] = sigm(a1[z]); }
            const f32x4 ck = *(const LAS f32x4*)(tb + col), ca = *(const LAS f32x4*)(tb + 1024 + col), cr = *(const LAS f32x4*)(tb + 2048 + col);
            const f32x4 kk = k * ck;
            const float ss = row16_sum((kk.x * kk.x + kk.y * kk.y) + (kk.z * kk.z + kk.w * kk.w));
            const f32x4 kd0 = k * ((a0 - 1.0f) * ca + 1.0f), kd1 = k * ((a1 - 1.0f) * ca + 1.0f);
            *(u32x2*)(KD + ro) = pk4(kd0); *(u32x2*)(KD + (size_t)T * D + ro) = pk4(kd1);
            const f32x4 p = r * (kd0 + kd1) * cr;
            const float rk = row16_sum((p.x + p.y) + (p.z + p.w));
            const f32x4 kkn = kk * fminf(__builtin_amdgcn_rsqf(ss), 1e12f);
            *(u32x2*)(KK + ro) = pk4(kkn); *(u32x2*)(BE + ro) = pk4(kkn * a0); *(u32x2*)(BE + (size_t)T * D + ro) = pk4(kkn * a1);
            if ((lane & 15) == 0) RKB[(size_t)row * 16 + 4 * j + (lane >> 4)] = rk;
        }
    }
}
typedef short bf16x8 __attribute__((ext_vector_type(8)));
__device__ __forceinline__ f32x4 mfma16(bf16x8 a, bf16x8 b, f32x4 c) { return __builtin_amdgcn_mfma_f32_16x16x32_bf16(a, b, c, 0, 0, 0); }
__device__ __forceinline__ bf16x8 as_frag(u32x4 w) { return __builtin_bit_cast(bf16x8, w); }
constexpr int CH_LD = 144;
constexpr int CH_MS = 64 * CH_LD;
constexpr int CH_AB = 0 * CH_MS, CH_KT = 1 * CH_MS, CH_BT = 2 * CH_MS, CH_RB = 3 * CH_MS, CH_VT = 4 * CH_MS, CH_ABT = 5 * CH_MS, CH_KHT = 6 * CH_MS, CH_BHT = 7 * CH_MS,
              CH_LK = 8 * CH_MS, CH_LB = 9 * CH_MS, CH_MK = 10 * CH_MS, CH_MB = 11 * CH_MS, CH_WT = 12 * CH_MS, CH_U0 = 13 * CH_MS, CH_DINV = 14 * CH_MS;
constexpr int CH_GC = LDSCTL_OFF + 2048;
constexpr int CH_PART = LDSCTL_OFF + 4096;
constexpr int NCHUNK = NSTEP / 64;
#ifndef S1_DBL
#define S1_DBL 0
#endif
static_assert(CH_DINV + 2048 <= RING_BYTES, "chunk LDS map");

__device__ __forceinline__ int scan_row(int s, int dir, int b) {
    if (s < CTXL) return TL + b * CTXL + (dir ? CTXL - 1 - s : s);
    const int i = s - CTXL; return b * SEQ + (dir ? SEQ - 1 - i : i);
}
#define CH_FRAG(mat, row, ks, kg) as_frag(*(const LAS u32x4*)(lds + (mat) + (row) * CH_LD + ((ks) * 32 + (kg) * 8) * 2))

__device__ __forceinline__ float s1_treduce16(const float (&a)[16], bool b3, bool b2) {
    float b[8];
#pragma unroll
    for (int i = 0; i < 8; ++i) { float x = a[i], y = a[i + 8];
        asm("s_nop 1\n\tv_permlane32_swap_b32 %0, %1" : "+v"(x), "+v"(y));
        b[i] = x + y; }
    float c[4];
#pragma unroll
    for (int i = 0; i < 4; ++i) { float x = b[i], y = b[i + 4];
        asm("s_nop 1\n\tv_permlane16_swap_b32 %0, %1" : "+v"(x), "+v"(y));
        c[i] = x + y; }
    float d[2];
#pragma unroll
    for (int i = 0; i < 2; ++i) { const float keep = b3 ? c[i + 2] : c[i], send = b3 ? c[i] : c[i + 2]; d[i] = keep + DPPF(send, 0x128); }
    const float keep = b2 ? d[1] : d[0], send = b2 ? d[0] : d[1];
    float e = keep + DPPF(send, 0x141);
    e += DPPF(e, 0xB1);
    e += DPPF(e, 0x4E);
    return e;
}
#define S1_BAR() do { asm volatile("s_waitcnt lgkmcnt(0)" ::: "memory"); __builtin_amdgcn_s_barrier(); asm volatile("" ::: "memory"); } while (0)
__device__ __forceinline__ void phase_s1_chunks(const Args& a, int lj, LAS unsigned char* lds, int tid, int G, int rh_scratch = 0) {
    unsigned char* ws = a.ws; const float* w0l = a.in[10] + lj * 2048; const float* a0l = a.in[13] + lj * 2048;
    const float* pkk = a.in[18] + lj * 1024; const float* pka = a.in[19] + lj * 1024; const float* prk = a.in[20] + lj * 1024;
    const int lane = tid & 63, wave = __builtin_amdgcn_readfirstlane(tid >> 6), l15 = lane & 15, g = lane >> 4;
    LAS float* part = (LAS float*)(lds + CH_PART); LAS float* gammaC = (LAS float*)(lds + CH_GC);
    unsigned nlw[8], nka[8], nkr[8], nrr[8], nvv[8]; float nw0 = 0.f, na0 = 0.f, npkk = 0.f, npka = 0.f, nprk = 0.f;
    typedef const __attribute__((address_space(1))) unsigned short* GUS;
#define S1_LOAD(ctx_) do { unsigned char* wsl = ws; asm volatile("" : "+s"(wsl));     \
        const int chain_ = (ctx_) / NCHUNK, c_ = (ctx_) - chain_ * NCHUNK, dir_ = chain_ >> 6, b_ = (chain_ >> 4) & 3, h_ = chain_ & 15; \
          \
        const long o0 = (long)scan_row(64 * c_ + 8 * wave, dir_, b_) * D + h_ * 64 + lane, od = (long)dir_ * T * D, st = dir_ ? -(long)D : (long)D; \
        const bf16* LWp = (const bf16*)(wsl + WS_RAWW) + od + o0; const bf16* RAp = (const bf16*)(wsl + WS_RAWA) + od + o0; \
        const bf16* Rp = (const bf16*)(wsl + WS_RKV) + o0; const bf16* Kp = Rp + (size_t)T * D; const bf16* Vp = Rp + (size_t)2 * T * D; \
        nw0 = w0l[dir_ * 1024 + h_ * 64 + lane]; na0 = a0l[dir_ * 1024 + h_ * 64 + lane]; npkk = pkk[h_ * 64 + lane]; npka = pka[h_ * 64 + lane]; nprk = prk[h_ * 64 + lane]; \
        _Pragma("unroll") for (int j = 0; j < 8; ++j) { const long oj = st * j; \
            nlw[j] = ((GUS)LWp)[oj]; nka[j] = ((GUS)RAp)[oj]; nkr[j] = ((GUS)Kp)[oj]; nrr[j] = ((GUS)Rp)[oj]; nvv[j] = ((GUS)Vp)[oj]; } } while (0)
    unsigned clw[8], cka_[8], ckr[8], crr[8], cvv[8]; float cw0 = 0.f, ca0 = 0.f, cpkk = 0.f, cpka = 0.f, cprk = 0.f;
#define S1_TAKE() do { _Pragma("unroll") for (int j = 0; j < 8; ++j) { clw[j] = nlw[j]; cka_[j] = nka[j]; ckr[j] = nkr[j]; crr[j] = nrr[j]; cvv[j] = nvv[j]; } \
        cw0 = nw0; ca0 = na0; cpkk = npkk; cpka = npka; cprk = nprk; \
        _Pragma("unroll") for (int j = 0; j < 8; ++j) asm volatile("" : "+v"(clw[j]), "+v"(cka_[j]), "+v"(ckr[j]), "+v"(crr[j]), "+v"(cvv[j]) :: "memory"); \
        asm volatile("" : "+v"(cw0), "+v"(ca0), "+v"(cpkk), "+v"(cpka), "+v"(cprk) :: "memory"); } while (0)
    if ((int)blockIdx.x < 128 * NCHUNK) { S1_LOAD((int)blockIdx.x); S1_TAKE(); if ((int)blockIdx.x + G < 128 * NCHUNK) S1_LOAD((int)blockIdx.x + G); }
    for (int ct = blockIdx.x; ct < 128 * NCHUNK; ct += G) {
        const int chain = ct / NCHUNK, c = ct - chain * NCHUNK, dir = chain >> 6, b = (chain >> 4) & 3, h = chain & 15;
        unsigned zq = 0u; asm volatile("" : "+v"(zq));
        {
            const int k = lane, tq = wave;
            float lw[8], kd[8], be[8], kk[8], rr[8], vv[8];
            {
                const float w0k = cw0, a0k = ca0, ckk = cpkk, cka = cpka, crk = cprk;
                float* RKBd = (float*)(ws + (dir ? WS_RKB1 : WS_RKB));
                const int row0 = scan_row(64 * c + 8 * tq, dir, b), rst = dir ? -1 : 1;
                float av[8], kq[8], red[16];
#pragma unroll
                for (int j = 0; j < 8; ++j) { av[j] = sigm(bflo(cka_[j]) + a0k); const float kr = bflo(ckr[j]);
                    lw[j] = -0.60653066f * sigm(bflo(clw[j]) + w0k);
                    kq[j] = kr * ckk; kd[j] = kr * ((av[j] - 1.0f) * cka + 1.0f); rr[j] = bflo(crr[j]); vv[j] = bflo(cvv[j]);
                    red[2 * j] = kq[j] * kq[j]; red[2 * j + 1] = rr[j] * kd[j] * crk; }
                const float tot = s1_treduce16(red, (lane & 8) != 0, (lane & 4) != 0);
                if ((lane & 7) == 4) RKBd[(size_t)(row0 + rst * (lane >> 3)) * 16 + h] = tot;
#pragma unroll
                for (int j = 0; j < 8; ++j) { const float ss = __builtin_bit_cast(float, __builtin_amdgcn_readlane(__builtin_bit_cast(int, tot), 8 * j));
                    kk[j] = kq[j] * fminf(__builtin_amdgcn_rsqf(ss), 1e12f);     be[j] = kk[j] * av[j]; }
            }
            for (int r0_ = 0; r0_ <= ((S1_DBL >> 3) & 1); ++r0_) { if (r0_) S1_BAR();
            float p[8]; p[0] = lw[0];
#pragma unroll
            for (int j = 1; j < 8; ++j) p[j] = p[j - 1] + lw[j];
            part[tq * 64 + k] = p[7];
            S1_BAR();
            float off = 0.f, tot = 0.f;
#pragma unroll
            for (int q = 0; q < 8; ++q) { const float pv = part[q * 64 + k]; tot += pv; off += q < tq ? pv : 0.f; }
            const float eTot = __expf(tot); float ePrev = __expf(off);
            if (tq == 0) gammaC[k] = eTot;
            unsigned abw[4], khw[4], bhw[4], vw[4];
#pragma unroll
            for (int j = 0; j < 8; j += 2) {
                float ab2[2], kt2[2], bt2[2], rb2[2], kh2[2], bh2[2];
#pragma unroll
                for (int z = 0; z < 2; ++z) { const float cu = off + p[j + z]; const float eP = __expf(cu), eM = __expf(-cu), eC = eTot * eM;
                    ab2[z] = kk[j + z] * ePrev; ePrev = eP; kt2[z] = kd[j + z] * eM; bt2[z] = be[j + z] * eM; rb2[z] = rr[j + z] * eP; kh2[z] = kd[j + z] * eC; bh2[z] = be[j + z] * eC;
                }
                abw[j >> 1] = pk2(ab2[0], ab2[1]); khw[j >> 1] = pk2(kh2[0], kh2[1]); bhw[j >> 1] = pk2(bh2[0], bh2[1]); vw[j >> 1] = pk2(vv[j], vv[j + 1]);
                {
                    const unsigned ktw = pk2(kt2[0], kt2[1]), btw = pk2(bt2[0], bt2[1]), rbw = pk2(rb2[0], rb2[1]), aw = abw[j >> 1];
                    const int t = 8 * tq + j;
                    *(LAS bf16*)(lds + CH_AB + t * CH_LD + k * 2) = (bf16)aw; *(LAS bf16*)(lds + CH_AB + (t + 1) * CH_LD + k * 2) = (bf16)(aw >> 16);
                    *(LAS bf16*)(lds + CH_KT + t * CH_LD + k * 2) = (bf16)ktw; *(LAS bf16*)(lds + CH_KT + (t + 1) * CH_LD + k * 2) = (bf16)(ktw >> 16);
                    *(LAS bf16*)(lds + CH_BT + t * CH_LD + k * 2) = (bf16)btw; *(LAS bf16*)(lds + CH_BT + (t + 1) * CH_LD + k * 2) = (bf16)(btw >> 16);
                    *(LAS bf16*)(lds + CH_RB + t * CH_LD + k * 2) = (bf16)rbw; *(LAS bf16*)(lds + CH_RB + (t + 1) * CH_LD + k * 2) = (bf16)(rbw >> 16); }
            }
            *(LAS u32x4*)(lds + CH_ABT + k * CH_LD + tq * 16) = (u32x4){abw[0], abw[1], abw[2], abw[3]};
            *(LAS u32x4*)(lds + CH_KHT + k * CH_LD + tq * 16) = (u32x4){khw[0], khw[1], khw[2], khw[3]};
            *(LAS u32x4*)(lds + CH_BHT + k * CH_LD + tq * 16) = (u32x4){bhw[0], bhw[1], bhw[2], bhw[3]};
            *(LAS u32x4*)(lds + CH_VT + k * CH_LD + tq * 16) = (u32x4){vw[0], vw[1], vw[2], vw[3]};
            *(LAS u32x4*)(lds + CH_WT + k * CH_LD + tq * 16) = (u32x4){zq, zq, zq, zq}; *(LAS u32x4*)(lds + CH_U0 + k * CH_LD + tq * 16) = (u32x4){zq, zq, zq, zq};
            }
        }
        S1_BAR();
        for (int r1_ = 0; r1_ <= (S1_DBL & 1); ++r1_) { if (r1_) S1_BAR();
            const int mi = wave >> 1, half = wave & 1;
            const int matS = (mi & 1) ? CH_BT : CH_KT, matT = (mi & 2) ? CH_RB : CH_AB, matO = CH_LK + mi * CH_MS;
            const bool incl = (mi & 2) != 0;
            bf16x8 fs[4][2], ft[2][2];
#pragma unroll
            for (int ms = 0; ms < 4; ++ms)
#pragma unroll
                for (int ks = 0; ks < 2; ++ks) fs[ms][ks] = CH_FRAG(matS, 16 * ms + l15, ks, g);
#pragma unroll
            for (int nt = 0; nt < 2; ++nt)
#pragma unroll
                for (int ks = 0; ks < 2; ++ks) ft[nt][ks] = CH_FRAG(matT, 32 * half + 16 * nt + l15, ks, g);
#pragma unroll
            for (int nt = 0; nt < 2; ++nt) { const int t = 32 * half + 16 * nt + l15;
#pragma unroll
                for (int ms = 0; ms < 4; ++ms) { f32x4 d = (f32x4){0.f, 0.f, 0.f, 0.f};
                    d = mfma16(fs[ms][0], ft[nt][0], d); d = mfma16(fs[ms][1], ft[nt][1], d);
                    const int s0 = 16 * ms + 4 * g;
#pragma unroll
                    for (int i = 0; i < 4; ++i) { const bool keep = incl ? (s0 + i <= t) : (s0 + i < t); d[i] = keep ? d[i] : __builtin_bit_cast(float, zq); }
                    u32x2 w; w.x = pk2(d[0], d[1]); w.y = pk2(d[2], d[3]);
                    *(LAS u32x2*)(lds + matO + t * CH_LD + s0 * 2) = w; } }
        }
        S1_BAR();
        f32x4 rhsU[4];
#pragma unroll
        for (int I = 0; I < 4; ++I) rhsU[I] = (f32x4){0.f, 0.f, 0.f, 0.f};
        if (wave >= 4) {
            const int ctv = (wave & 3) * 16;
            const bf16x8 fv0 = CH_FRAG(CH_VT, ctv + l15, 0, g), fv1 = CH_FRAG(CH_VT, ctv + l15, 1, g);
#pragma unroll
            for (int I = 0; I < 4; ++I) { f32x4 d = (f32x4){0.f, 0.f, 0.f, 0.f};
                d = mfma16(CH_FRAG(CH_LK, 16 * I + l15, 0, g), fv0, d); d = mfma16(CH_FRAG(CH_LK, 16 * I + l15, 1, g), fv1, d); rhsU[I] = -d; }
        }
        for (int r2_ = 0; r2_ <= ((S1_DBL >> 1) & 1); ++r2_) if (wave == 0) {
            const int bb = lane >> 4, j = lane & 15;
            float x[16];
#pragma unroll
            for (int t = 0; t < 16; ++t) {
                const u32x4 r0 = *(const LAS u32x4*)(lds + CH_LB + (16 * bb + t) * CH_LD + 32 * bb), r1 = *(const LAS u32x4*)(lds + CH_LB + (16 * bb + t) * CH_LD + 32 * bb + 16);
                const unsigned rw[8] = {r0.x, r0.y, r0.z, r0.w, r1.x, r1.y, r1.z, r1.w};
                float acc = (t == j) ? 1.0f : 0.0f;
#pragma unroll
                for (int s = 0; s < t; ++s) { const float lv = (s & 1) ? bfhi(rw[s >> 1]) : bflo(rw[s >> 1]); acc -= lv * x[s]; }
                x[t] = acc;
                *(LAS bf16*)(lds + CH_DINV + ((bb * 16 + t) * 16 + j) * 2) = (bf16)f2bf(acc);
            }
        }
        S1_BAR();
        {
            const int matZ = wave < 4 ? CH_WT : CH_U0, ct16 = (wave & 3) * 16;
            for (int r4_ = 0; r4_ <= ((S1_DBL >> 4) & 1); ++r4_) { if (r4_) { *(LAS u32x4*)(lds + matZ + (ct16 + l15) * CH_LD + g * 32) = (u32x4){zq, zq, zq, zq}; *(LAS u32x4*)(lds + matZ + (ct16 + l15) * CH_LD + g * 32 + 16) = (u32x4){zq, zq, zq, zq}; LDS_WAIT(); }
#pragma unroll
            for (int I = 0; I < 4; ++I) {
                f32x4 rhs;
                if (wave < 4) { const u32x2 w = *(const LAS u32x2*)(lds + CH_ABT + (ct16 + l15) * CH_LD + (16 * I + 4 * g) * 2); rhs = (f32x4){bflo(w.x), bfhi(w.x), bflo(w.y), bfhi(w.y)}; }
                else rhs = rhsU[I];
                f32x4 d = (f32x4){0.f, 0.f, 0.f, 0.f};
                d = mfma16(CH_FRAG(CH_LB, 16 * I + l15, 0, g), CH_FRAG(matZ, ct16 + l15, 0, g), d); d = mfma16(CH_FRAG(CH_LB, 16 * I + l15, 1, g), CH_FRAG(matZ, ct16 + l15, 1, g), d);
                const f32x4 ac = rhs - d;
                const u32x2 dv = *(const LAS u32x2*)(lds + CH_DINV + ((I * 16 + l15) * 16 + 4 * g) * 2);
                const bf16x8 fa = as_frag((u32x4){dv.x, dv.y, zq, zq}), fb = as_frag((u32x4){pk2(ac[0], ac[1]), pk2(ac[2], ac[3]), zq, zq});
                const f32x4 z = mfma16(fa, fb, (f32x4){0.f, 0.f, 0.f, 0.f});
                u32x2 w; w.x = pk2(z[0], z[1]); w.y = pk2(z[2], z[3]);
                *(LAS u32x2*)(lds + matZ + (ct16 + l15) * CH_LD + (16 * I + 4 * g) * 2) = w;
                LDS_WAIT(); asm volatile("" ::: "memory");
            }
            }
        }
        S1_BAR();
        if (ct + G < 128 * NCHUNK) { S1_TAKE(); if (ct + 2 * G < 128 * NCHUNK) S1_LOAD(ct + 2 * G); }
        for (int r3_ = 0; r3_ <= ((S1_DBL >> 2) & 1); ++r3_) { if (r3_) S1_BAR();
            const int rt = wave >> 1, cp = (wave & 1) * 2;
            unsigned char* wsl = ws; asm volatile("" : "+s"(wsl));
            bf16* YL = (bf16*)(wsl + WS_Y); bf16* RH = (bf16*)(wsl + (rh_scratch ? WS_BETA + RF : WS_RH)); bf16* PM = (bf16*)(wsl + WS_PM); bf16* QT = (bf16*)(wsl + WS_QT);
            const int trow = scan_row(64 * c + 16 * rt + l15, dir, b);
#pragma unroll
            for (int q = 0; q < 2; ++q) { const int vt = cp + q; f32x4 d = (f32x4){0.f, 0.f, 0.f, 0.f};
#pragma unroll
                for (int ks = 0; ks < 2; ++ks) { d = mfma16(CH_FRAG(CH_VT, 16 * vt + l15, ks, g), CH_FRAG(CH_MK, 16 * rt + l15, ks, g), d); d = mfma16(CH_FRAG(CH_U0, 16 * vt + l15, ks, g), CH_FRAG(CH_MB, 16 * rt + l15, ks, g), d); }
                *(u32x2*)(YL + ((size_t)dir * T + trow) * D + h * 64 + 16 * vt + 4 * g) = pk4(d); }
#pragma unroll
            for (int q = 0; q < 2; ++q) { const int kt = cp + q; f32x4 d = (f32x4){0.f, 0.f, 0.f, 0.f};
#pragma unroll
                for (int ks = 0; ks < 2; ++ks) d = mfma16(CH_FRAG(CH_WT, 16 * kt + l15, ks, g), CH_FRAG(CH_MB, 16 * rt + l15, ks, g), d);
                const u32x2 rbw = *(const LAS u32x2*)(lds + CH_RB + (16 * rt + l15) * CH_LD + (16 * kt + 4 * g) * 2);
                u32x2 w; w.x = pk2(bflo(rbw.x) - d[0], bfhi(rbw.x) - d[1]); w.y = pk2(bflo(rbw.y) - d[2], bfhi(rbw.y) - d[3]);
                *(u32x2*)(RH + ((size_t)dir * T + trow) * D + h * 64 + 16 * kt + 4 * g) = w; }
            bf16* Pc = PM + ((size_t)chain * NCHUNK + c) * 4096; bf16* Qc = QT + ((size_t)chain * NCHUNK + c) * 4096;
            { const int krow = 16 * rt + l15; const float gc = gammaC[krow];
#pragma unroll
                for (int q = 0; q < 2; ++q) { const int kt = cp + q; f32x4 d = (f32x4){0.f, 0.f, 0.f, 0.f};
#pragma unroll
                    for (int ks = 0; ks < 2; ++ks) d = mfma16(CH_FRAG(CH_WT, 16 * kt + l15, ks, g), CH_FRAG(CH_BHT, krow, ks, g), d);
                    const int k0 = 16 * kt + 4 * g; f32x4 o;
#pragma unroll
                    for (int i = 0; i < 4; ++i) o[i] = ((k0 + i == krow) ? gc : 0.f) - d[i];
                    u32x2 w; w.x = pk2(o[0], o[1]); w.y = pk2(o[2], o[3]);
                    *(u32x2*)(Pc + krow * 64 + 32 * (kt >> 1) + 8 * g + 4 * (kt & 1)) = w; } }
            { const int vrow = 16 * rt + l15;
#pragma unroll
                for (int q = 0; q < 2; ++q) { const int kt = cp + q; f32x4 d = (f32x4){0.f, 0.f, 0.f, 0.f};
#pragma unroll
                    for (int ks = 0; ks < 2; ++ks) { d = mfma16(CH_FRAG(CH_KHT, 16 * kt + l15, ks, g), CH_FRAG(CH_VT, vrow, ks, g), d); d = mfma16(CH_FRAG(CH_BHT, 16 * kt + l15, ks, g), CH_FRAG(CH_U0, vrow, ks, g), d); }
                    u32x2 w; w.x = pk2(d[0], d[1]); w.y = pk2(d[2], d[3]);
                    *(u32x2*)(Qc + vrow * 64 + 16 * g + 4 * kt) = w; } }
        }
        S1_BAR();
    }
}

struct S2Set { u32x4 p[4][2]; u32x4 q[2]; };
__device__ __forceinline__ void s2_load(S2Set& s, const bf16* Pc, const bf16* Qc, int vt, int l15, int g) {
    s.q[0] = *(const u32x4*)(Qc + (16 * vt + l15) * 64 + 16 * g); s.q[1] = *(const u32x4*)(Qc + (16 * vt + l15) * 64 + 16 * g + 8);
#pragma unroll
    for (int m = 0; m < 4; ++m)
#pragma unroll
        for (int j = 0; j < 2; ++j) s.p[m][j] = *(const u32x4*)(Pc + (16 * m + l15) * 64 + 32 * j + 8 * g);
}
__device__ __forceinline__ void s2_step(f32x4 (&acc)[4], const S2Set& s, bf16* Hc, int g) {
    unsigned hw[4][2];
#pragma unroll
    for (int m = 0; m < 4; ++m) { hw[m][0] = pk2(acc[m][0], acc[m][1]); hw[m][1] = pk2(acc[m][2], acc[m][3]); }
#pragma unroll
    for (int m = 0; m < 4; ++m) *(u32x2*)(Hc + 16 * m + 4 * g) = (u32x2){hw[m][0], hw[m][1]};
    const bf16x8 hb0 = as_frag((u32x4){hw[0][0], hw[0][1], hw[1][0], hw[1][1]}), hb1 = as_frag((u32x4){hw[2][0], hw[2][1], hw[3][0], hw[3][1]});
#pragma unroll
    for (int m = 0; m < 4; ++m) {
        const unsigned q0 = (m & 2) ? ((m & 1) ? s.q[1].z : s.q[1].x) : ((m & 1) ? s.q[0].z : s.q[0].x), q1 = (m & 2) ? ((m & 1) ? s.q[1].w : s.q[1].y) : ((m & 1) ? s.q[0].w : s.q[0].y);
        f32x4 d = (f32x4){bflo(q0), bfhi(q0), bflo(q1), bfhi(q1)};
        d = mfma16(as_frag(s.p[m][0]), hb0, d);
        d = mfma16(as_frag(s.p[m][1]), hb1, d);
        acc[m] = d;
    }
}
__device__ __forceinline__ void phase_s2_chain(const Args& a, int wave, int lane, int G) {
    unsigned char* ws = a.ws;
    const bf16* PM = (const bf16*)(ws + WS_PM); const bf16* QT = (const bf16*)(ws + WS_QT); bf16* HT = (bf16*)(ws + WS_HT);
    const int l15 = lane & 15, g = lane >> 4;
    if (wave >= 2) return;
    static_assert(NCHUNK % 4 == 0, "S2 ring");
    for (int wt = blockIdx.x * 2 + wave; wt < 512; wt += G * 2) {
        const int chain = wt >> 2, vt = wt & 3;
        f32x4 acc[4];
#pragma unroll
        for (int m = 0; m < 4; ++m) acc[m] = (f32x4){0.f, 0.f, 0.f, 0.f};
        const bf16* Pc = PM + (size_t)chain * NCHUNK * 4096; const bf16* Qc = QT + (size_t)chain * NCHUNK * 4096;
        bf16* Hc = HT + (size_t)chain * NCHUNK * 4096 + (16 * vt + l15) * 64;
        S2Set s0, s1, s2, s3;
        s2_load(s0, Pc, Qc, vt, l15, g); s2_load(s1, Pc + 4096, Qc + 4096, vt, l15, g); s2_load(s2, Pc + 2 * 4096, Qc + 2 * 4096, vt, l15, g); s2_load(s3, Pc + 3 * 4096, Qc + 3 * 4096, vt, l15, g);
#pragma unroll 1
        for (int c = 0; c < NCHUNK; c += 4) {
            const int cn = c + 4 < NCHUNK ? c + 4 : c;
            const bf16* Pn = Pc + (size_t)cn * 4096; const bf16* Qn = Qc + (size_t)cn * 4096;
            s2_step(acc, s0, Hc + (size_t)c * 4096, g);       s2_load(s0, Pn, Qn, vt, l15, g);
            s2_step(acc, s1, Hc + (size_t)(c + 1) * 4096, g); s2_load(s1, Pn + 4096, Qn + 4096, vt, l15, g);
            s2_step(acc, s2, Hc + (size_t)(c + 2) * 4096, g); s2_load(s2, Pn + 2 * 4096, Qn + 2 * 4096, vt, l15, g);
            s2_step(acc, s3, Hc + (size_t)(c + 3) * 4096, g); s2_load(s3, Pn + 3 * 4096, Qn + 3 * 4096, vt, l15, g);
        }
    }
}

__device__ __forceinline__ void phase_s3_readout(const Args& a, int lj, int nrows, int gw, int NGW, int lane) {
    unsigned char* ws = a.ws;
    const bf16* YL = (const bf16*)(ws + WS_Y); const bf16* RH = (const bf16*)(ws + WS_RH); const bf16* HT = (const bf16*)(ws + WS_HT);
    const bf16* Vv = (const bf16*)(ws + WS_RKV) + (size_t)2 * T * D; const float* RKB = (const float*)(ws + WS_RKB); const float* RKB1 = (const float*)(ws + WS_RKB1); const bf16* Gg = (const bf16*)(ws + WS_G); bf16* Z = (bf16*)(ws + WS_Z);
    const float* lng = a.in[21] + lj * 1024; const float* lnb = a.in[22] + lj * 1024;
    const int l15 = lane & 15, g = lane >> 4;
    for (int task = gw; task < (nrows / 16) * 16; task += NGW) {
        const int tt = task >> 4, h = task & 15, r0 = tt * 16, row = r0 + l15;
        int b, cc[2];
        if (r0 < TL) { b = r0 >> 13; const int tb = (r0 & (SEQ - 1)) >> 6; cc[0] = 4 + tb; cc[1] = 4 + (127 - tb); }
        else { const int loc = r0 - TL; b = loc >> 8; const int tb = (loc & 255) >> 6; cc[0] = tb; cc[1] = 3 - tb; }
        f32x4 acc[4];
        const size_t ro = (size_t)row * D + h * 64 + 4 * g;
#pragma unroll
        for (int vt = 0; vt < 4; ++vt) acc[vt] = bf4(*(const u32x2*)(YL + ro + 16 * vt)) + bf4(*(const u32x2*)(YL + (size_t)T * D + ro + 16 * vt));
#pragma unroll
        for (int dir = 0; dir < 2; ++dir) {
            const int chain = dir * 64 + b * 16 + h;
            const bf16* rh = RH + ((size_t)dir * T + row) * D + h * 64 + 8 * g;
            const bf16x8 f0 = as_frag(*(const u32x4*)(rh)), f1 = as_frag(*(const u32x4*)(rh + 32));
            const bf16* hc = HT + ((size_t)chain * NCHUNK + cc[dir]) * 4096;
#pragma unroll
            for (int vt = 0; vt < 4; ++vt) { const bf16* hr = hc + (16 * vt + l15) * 64 + 8 * g;
                acc[vt] = mfma16(as_frag(*(const u32x4*)(hr)), f0, acc[vt]); acc[vt] = mfma16(as_frag(*(const u32x4*)(hr + 32)), f1, acc[vt]); }
        }
        float s = 0.f;
#pragma unroll
        for (int vt = 0; vt < 4; ++vt) s += (acc[vt][0] + acc[vt][1]) + (acc[vt][2] + acc[vt][3]);
        s += __shfl_xor(s, 16); s += __shfl_xor(s, 32);
        const float mean = s * (1.0f / 64.0f); float vs = 0.f;
#pragma unroll
        for (int vt = 0; vt < 4; ++vt) { acc[vt] = acc[vt] - mean; vs += (acc[vt][0] * acc[vt][0] + acc[vt][1] * acc[vt][1]) + (acc[vt][2] * acc[vt][2] + acc[vt][3] * acc[vt][3]); }
        vs += __shfl_xor(vs, 16); vs += __shfl_xor(vs, 32);
        const float rstd = rsqrtf(vs * (1.0f / 64.0f) + 64.0f * 1e-5f), bon = RKB[(size_t)row * 16 + h] + RKB1[(size_t)row * 16 + h];
#pragma unroll
        for (int vt = 0; vt < 4; ++vt) { const int col = h * 64 + 16 * vt + 4 * g; const size_t o = (size_t)row * D + col;
            const f32x4 vq = bf4(*(const u32x2*)(Vv + o)), lg4 = *(const f32x4*)(lng + col), lb4 = *(const f32x4*)(lnb + col); const u32x2 gw2 = *(const u32x2*)(Gg + o);
            const f32x4 zz = acc[vt] * rstd * lg4 + lb4 + vq * bon;
            u32x2 w; w.x = pk2(zz[0] * bflo(gw2.x), zz[1] * bfhi(gw2.x)); w.y = pk2(zz[2] * bflo(gw2.y), zz[3] * bfhi(gw2.y));
            *(u32x2*)(Z + o) = w; }
    }
}
__device__ __forceinline__ void phase_cv(const Args& a, int lc, int rows, int gw, int NGW, int lane) {
    unsigned char* ws = a.ws;
    const bf16* BG = (const bf16*)(ws + WS_BG); const bf16* CU = (const bf16*)(ws + WS_CUZ); bf16* Z = (bf16*)(ws + WS_Z);
    const float* cw = a.in[25] + (size_t)lc * 3 * 1024;
    for (int t = gw; t < rows; t += NGW) {
        int rs, re; if (t < TL) { rs = t & ~63; re = rs + 63; } else { const int loc = t - TL; rs = TL + (loc & ~255); re = rs + 255; }
        const bool hp = t > rs, hn = t < re;
#pragma unroll
        for (int j = 0; j < 4; ++j) { const int col = 256 * j + 4 * lane; const size_t o = (size_t)t * D + col;
            const u32x2 zc = *(const u32x2*)(CU + o), bg = *(const u32x2*)(BG + o);
            const u32x2 zp = hp ? *(const u32x2*)(CU + o - D) : (u32x2){0u, 0u}, zn = hn ? *(const u32x2*)(CU + o + D) : (u32x2){0u, 0u};
            const f32x4 w0 = *(const f32x4*)(cw + col), w1 = *(const f32x4*)(cw + 1024 + col), w2 = *(const f32x4*)(cw + 2048 + col);
            const f32x4 zv = (f32x4){bflo(zc.x), bfhi(zc.x), bflo(zc.y), bfhi(zc.y)}, pv = (f32x4){bflo(zp.x), bfhi(zp.x), bflo(zp.y), bfhi(zp.y)}, nv = (f32x4){bflo(zn.x), bfhi(zn.x), bflo(zn.y), bfhi(zn.y)};
            const f32x4 bv = (f32x4){bflo(bg.x), bfhi(bg.x), bflo(bg.y), bfhi(bg.y)};
            const f32x4 r = bv * (w0 * pv + w1 * zv + w2 * nv);
            u32x2 w; w.x = pk2(r.x, r.y); w.y = pk2(r.z, r.w); *(u32x2*)(Z + o) = w; }
    }
}
typedef float f32x2v __attribute__((ext_vector_type(2)));
__device__ __forceinline__ float lane_bcast(float v, int srclane) { return __builtin_bit_cast(float, __builtin_amdgcn_readlane(__builtin_bit_cast(int, v), srclane)); }
__device__ __forceinline__ void phase_e_route(const Args& a, int layer, int rows, LAS unsigned char* lds, int tid, int gw, int NGW, int lane, int probe_rep = 0) {
    unsigned char* ws = a.ws;
    const float* xs = (const float*)(ws + (layer < 2 ? WS_XSA : WS_XSB));
    const float* MODS = (const float*)(ws + WS_MODS); bf16* H2 = (bf16*)(ws + WS_H2);
    const float* ng = a.in[6] + (size_t)(layer * 2 + 1) * 1024;
    const float* rw = a.in[27] + (size_t)layer * 1024 * 32; const float* rb = a.in[28] + layer * 32;
    unsigned* cnt = (unsigned*)(ws + WS_CTL) + CW_CNT + (layer + 4 * probe_rep) * 32 * CNT_STRIDE;
    int* SLOTL = (int*)(ws + (probe_rep ? WS_L1 : WS_SLOTL)); float* GATEL = (float*)(ws + (probe_rep ? WS_L1 + 8 * MiB : WS_GATEL));
    LAS float* wt = (LAS float*)lds;
    LAS int* hist = (LAS int*)(lds + LDSCTL_OFF + 3072); LAS int* base = hist + 32; LAS int* lcnt = hist + 64;
    int* TKE = (int*)(ws + WS_C12); float* TKG = (float*)(ws + WS_C12 + 4 * MiB);
    for (int i = tid; i < 32768; i += 512) wt[(i & 31) * 1024 + (i >> 5)] = rw[i];
    if (tid < 32) hist[tid] = 0;
    __syncthreads();
    const int my_e = lane >> 1; const float my_b = rb[my_e];
    const bool b5 = (lane & 32) != 0, b4 = (lane & 16) != 0, b3 = (lane & 8) != 0, b2 = (lane & 4) != 0, b1 = (lane & 2) != 0;
    for (int t = gw; t < rows; t += NGW) {
        const int mr = mod_row(t);
        const float* mod = MODS + (size_t)(layer * 5 + mr) * 6144;
        f32x4 x[4];
#pragma unroll
        for (int j = 0; j < 4; ++j) x[j] = *(const f32x4*)(xs + (size_t)t * D + 256 * j + 4 * lane);
        const float rstd = row_rstd(x);
#pragma unroll
        for (int j = 0; j < 4; ++j) { const int col = 256 * j + 4 * lane;
            x[j] = x[j] * rstd * *(const f32x4*)(ng + col) * (*(const f32x4*)(mod + 4 * 1024 + col) + 1.0f) + *(const f32x4*)(mod + 3 * 1024 + col);
            u32x2 w; w.x = pk2(x[j].x, x[j].y); w.y = pk2(x[j].z, x[j].w); *(u32x2*)(H2 + (size_t)t * D + col) = w; }
        float p[32];
#pragma unroll
        for (int eg = 0; eg < 8; ++eg) {
#pragma unroll
            for (int ee = 0; ee < 4; ++ee) { const int e = eg * 4 + ee; f32x2v s2 = (f32x2v){0.f, 0.f};
#pragma unroll
                for (int j = 0; j < 4; ++j) { const f32x4 wv = *(const LAS f32x4*)(wt + e * 1024 + 256 * j + 4 * lane);
                    s2 = __builtin_elementwise_fma((f32x2v){x[j].x, x[j].y}, (f32x2v){wv.x, wv.y}, s2); s2 = __builtin_elementwise_fma((f32x2v){x[j].z, x[j].w}, (f32x2v){wv.z, wv.w}, s2); }
                p[e] = s2.x + s2.y; }
            asm volatile("" ::: "memory");
        }
        float q16[16];
#pragma unroll
        for (int i = 0; i < 16; ++i) { const float send = b5 ? p[i] : p[i + 16]; const float keep = b5 ? p[i + 16] : p[i]; q16[i] = keep + __shfl_xor(send, 32); }
        float q8[8];
#pragma unroll
        for (int i = 0; i < 8; ++i) { const float send = b4 ? q16[i] : q16[i + 8]; const float keep = b4 ? q16[i + 8] : q16[i]; q8[i] = keep + __shfl_xor(send, 16); }
        float q4[4];
#pragma unroll
        for (int i = 0; i < 4; ++i) { const float send = b3 ? q8[i] : q8[i + 4]; const float keep = b3 ? q8[i + 4] : q8[i]; q4[i] = keep + __shfl_xor(send, 8); }
        float q2[2];
#pragma unroll
        for (int i = 0; i < 2; ++i) { const float send = b2 ? q4[i] : q4[i + 2]; const float keep = b2 ? q4[i + 2] : q4[i]; q2[i] = keep + __shfl_xor(send, 4); }
        float q1; { const float send = b1 ? q2[0] : q2[1]; const float keep = b1 ? q2[1] : q2[0]; q1 = keep + __shfl_xor(send, 2); }
        const float lg = q1 + __shfl_xor(q1, 1) + my_b;
        int rank = 0;
#pragma unroll 1
        for (int e = 0; e < 32; ++e) { const float o = lane_bcast(lg, 2 * e); rank += (o > lg || (o == lg && e < my_e)) ? 1 : 0; }
        const bool sel = rank < 4 && !(lane & 1);
        const unsigned long long m0 = __ballot(sel && rank == 0), m1 = __ballot(sel && rank == 1), m2 = __ballot(sel && rank == 2), m3 = __ballot(sel && rank == 3);
        const float v0 = lane_bcast(lg, (int)__builtin_ctzll(m0)), v1 = lane_bcast(lg, (int)__builtin_ctzll(m1)), v2 = lane_bcast(lg, (int)__builtin_ctzll(m2)), v3 = lane_bcast(lg, (int)__builtin_ctzll(m3));
        const float e1 = __expf(v1 - v0), e2 = __expf(v2 - v0), e3 = __expf(v3 - v0);
        const float inv = frcp(1.0f + e1 + e2 + e3);
        if (sel) {
            TKE[t * 4 + rank] = my_e; TKG[t * 4 + rank] = __expf(lg - v0) * inv;
            __hip_atomic_fetch_add(hist + my_e, 1, __ATOMIC_RELAXED, __HIP_MEMORY_SCOPE_WORKGROUP);
        }
    }
    asm volatile("s_waitcnt vmcnt(0) lgkmcnt(0)" ::: "memory"); __syncthreads();
    if (tid < 32) { base[tid] = (int)atomicAdd(cnt + tid * CNT_STRIDE, (unsigned)hist[tid]); lcnt[tid] = 0; }
    __syncthreads();
    for (int t = gw; t < rows; t += NGW) {
        if (lane < 4) { const int e = TKE[t * 4 + lane]; const float gk = TKG[t * 4 + lane];
            const int pos = base[e] + __hip_atomic_fetch_add(lcnt + e, 1, __ATOMIC_RELAXED, __HIP_MEMORY_SCOPE_WORKGROUP);
            SLOTL[(size_t)e * T + pos] = t * 4 + lane; GATEL[(size_t)e * T + pos] = gk; }
    }
}
__device__ __forceinline__ int okey(float v, int e) { const int i = __builtin_bit_cast(int, v); const int o = i ^ ((i >> 31) & 0x7fffffff); return (o & ~31) | (31 - e); }
__device__ __forceinline__ void phase_e_route_mfma(const Args& a, int layer, int rows, LAS unsigned char* lds, int tid, int wave, int gw, int NGW, int lane, int probe_rep = 0) {
    unsigned char* ws = a.ws;
    const float* xs = (const float*)(ws + (layer < 2 ? WS_XSA : WS_XSB));
    const float* MODS = (const float*)(ws + WS_MODS); bf16* H2 = (bf16*)(ws + WS_H2);
    const float* ng = a.in[6] + (size_t)(layer * 2 + 1) * 1024; const float* rb = a.in[28] + layer * 32;
    const bf16* WRT = (const bf16*)(ws + WS_WRT) + (size_t)layer * 2 * 32 * 1024;
    unsigned* cnt = (unsigned*)(ws + WS_CTL) + CW_CNT + (layer + 4 * probe_rep) * 32 * CNT_STRIDE;
    int* SLOTL = (int*)(ws + (probe_rep ? WS_L1 : WS_SLOTL)); float* GATEL = (float*)(ws + (probe_rep ? WS_L1 + 8 * MiB : WS_GATEL));
    LAS int* hist = (LAS int*)(lds + LDSCTL_OFF + 3072); LAS int* base = hist + 32; LAS int* lcnt = hist + 64;
    int* TKE = (int*)(ws + WS_C12); float* TKG = (float*)(ws + WS_C12 + 4 * MiB);
    LAS unsigned char* tile = lds + wave * 8448;
    if (tid < 32) hist[tid] = 0;
    __syncthreads();
    const int l15 = lane & 15, g = lane >> 4;
    const int nlat = TL / 16, nctx = rows > TL ? TC / 4 : 0, G_ = NGW / 8;
    for (int it = 0;; ++it) {
        int t0, ntok;
        { const int tl = gw + it * NGW; const int xi = (int)blockIdx.x + (it - (nlat + NGW - 1) / NGW) * G_ * 8 + wave * G_;
          if (tl < nlat) { t0 = tl * 16; ntok = 16; } else if (it >= (nlat + NGW - 1) / NGW && xi < nctx) { t0 = TL + xi * 4; ntok = 4; } else if (it >= (nlat + NGW - 1) / NGW) break; else continue; }
        const float* mod = MODS + (size_t)(layer * 5 + mod_row(t0)) * 6144;
        float rstd[16];
#pragma unroll
        for (int t = 0; t < 16; ++t) { f32x4 x[4];
            const int tr = t < ntok ? t0 + t : t0;
#pragma unroll
            for (int j = 0; j < 4; ++j) x[j] = *(const f32x4*)(xs + (size_t)tr * D + 256 * j + 4 * lane);
            rstd[t] = __builtin_bit_cast(float, __builtin_amdgcn_readfirstlane(__builtin_bit_cast(int, row_rstd(x))));
            if ((t & 3) == 3) asm volatile("" ::: "memory"); }
        f32x4 acc[2]; acc[0] = (f32x4){0.f, 0.f, 0.f, 0.f}; acc[1] = acc[0];
#pragma unroll 1
        for (int s = 0; s < 4; ++s) {
            const int col = 256 * s + 4 * lane;
            const f32x4 g4 = *(const f32x4*)(ng + col) * (*(const f32x4*)(mod + 4 * 1024 + col) + 1.0f), s4 = *(const f32x4*)(mod + 3 * 1024 + col);
            f32x4 hv[16];
#pragma unroll
            for (int t = 0; t < 16; ++t) { const int tr = t < ntok ? t0 + t : t0; hv[t] = *(const f32x4*)(xs + (size_t)tr * D + col) * rstd[t] * g4 + s4;
                const u32x2 w = pk4(hv[t]); if (t < ntok) *(u32x2*)(H2 + (size_t)tr * D + col) = w;
                *(LAS u32x2*)(tile + t * 528 + lane * 8) = w; hv[t] = hv[t] - bf4(w); }
            LDS_WAIT(); asm volatile("" ::: "memory");
            const bf16* wh = WRT + (size_t)l15 * 1024 + 256 * s + 8 * g; const bf16* wl = wh + (size_t)32 * 1024;
#pragma unroll
            for (int ks = 0; ks < 8; ++ks) { const bf16x8 fb = as_frag(*(const LAS u32x4*)(tile + l15 * 528 + ks * 64 + g * 16));
#pragma unroll
                for (int et = 0; et < 2; ++et) { acc[et] = mfma16(as_frag(*(const u32x4*)(wh + (size_t)et * 16 * 1024 + 32 * ks)), fb, acc[et]);
                    acc[et] = mfma16(as_frag(*(const u32x4*)(wl + (size_t)et * 16 * 1024 + 32 * ks)), fb, acc[et]); } }
            LDS_WAIT(); asm volatile("" ::: "memory");
#pragma unroll
            for (int t = 0; t < 16; ++t) *(LAS u32x2*)(tile + t * 528 + lane * 8) = pk4(hv[t]);
            LDS_WAIT(); asm volatile("" ::: "memory");
#pragma unroll
            for (int ks = 0; ks < 8; ++ks) { const bf16x8 fb = as_frag(*(const LAS u32x4*)(tile + l15 * 528 + ks * 64 + g * 16));
#pragma unroll
                for (int et = 0; et < 2; ++et) acc[et] = mfma16(as_frag(*(const u32x4*)(wh + (size_t)et * 16 * 1024 + 32 * ks)), fb, acc[et]); }
            LDS_WAIT(); asm volatile("" ::: "memory");
        }
        float v[8]; int key[8];
#pragma unroll
        for (int j = 0; j < 8; ++j) { const int e = (j < 4 ? 0 : 16) + 4 * g + (j & 3); v[j] = acc[j >> 2][j & 3] + rb[e]; key[j] = okey(v[j], e); }
        int kb[8], kc[8], kd2[8];
#pragma unroll
        for (int j = 0; j < 8; ++j) kb[j] = __shfl_xor(key[j], 16);
#pragma unroll
        for (int j = 0; j < 8; ++j) { kc[j] = __shfl_xor(key[j], 32); kd2[j] = __shfl_xor(kb[j], 32); }
        float vmax = fmaxf(fmaxf(fmaxf(v[0], v[1]), fmaxf(v[2], v[3])), fmaxf(fmaxf(v[4], v[5]), fmaxf(v[6], v[7])));
        vmax = fmaxf(vmax, __shfl_xor(vmax, 16)); vmax = fmaxf(vmax, __shfl_xor(vmax, 32));
        int rank[8]; float ex[8], part = 0.f;
#pragma unroll
        for (int j = 0; j < 8; ++j) { int r = 0;
#pragma unroll
            for (int q = 0; q < 8; ++q) r += (key[q] > key[j]) + (kb[q] > key[j]) + (kc[q] > key[j]) + (kd2[q] > key[j]);
            rank[j] = r; ex[j] = __expf(v[j] - vmax); part += r < 4 ? ex[j] : 0.f; }
        part += __shfl_xor(part, 16); part += __shfl_xor(part, 32);
        const float inv = frcp(part); const int t = t0 + l15;
#pragma unroll
        for (int j = 0; j < 8; ++j) if (rank[j] < 4 && l15 < ntok) { const int e = (j < 4 ? 0 : 16) + 4 * g + (j & 3);
            TKE[t * 4 + rank[j]] = e; TKG[t * 4 + rank[j]] = ex[j] * inv;
            __hip_atomic_fetch_add(hist + e, 1, __ATOMIC_RELAXED, __HIP_MEMORY_SCOPE_WORKGROUP); }
    }
    asm volatile("s_waitcnt vmcnt(0) lgkmcnt(0)" ::: "memory"); __syncthreads();
    if (tid < 32) { base[tid] = (int)atomicAdd(cnt + tid * CNT_STRIDE, (unsigned)hist[tid]); lcnt[tid] = 0; }
    __syncthreads();
    for (int it = 0;; ++it) {
        int t0, ntok;
        { const int tl = gw + it * NGW; const int xi = (int)blockIdx.x + (it - (nlat + NGW - 1) / NGW) * G_ * 8 + wave * G_;
          if (tl < nlat) { t0 = tl * 16; ntok = 16; } else if (it >= (nlat + NGW - 1) / NGW && xi < nctx) { t0 = TL + xi * 4; ntok = 4; } else if (it >= (nlat + NGW - 1) / NGW) break; else continue; }
        if ((lane >> 2) < ntok) { const int t = t0 + (lane >> 2), k = lane & 3;
            const int e = TKE[t * 4 + k]; const float gk = TKG[t * 4 + k];
            const int pos = base[e] + __hip_atomic_fetch_add(lcnt + e, 1, __ATOMIC_RELAXED, __HIP_MEMORY_SCOPE_WORKGROUP);
            SLOTL[(size_t)e * T + pos] = t * 4 + k; GATEL[(size_t)e * T + pos] = gk; }
    }
}
__device__ __forceinline__ void phase_final(const Args& a, int gw, int NGW, int lane) {
    unsigned char* ws = a.ws;
    const float* xs = (const float*)(ws + WS_XSB); const float* MODS = (const float*)(ws + WS_MODS); const bf16* YS = (const bf16*)(ws + WS_YS);
    for (int t = gw; t < TL; t += NGW) {
        const int mr = t >> 13;
        f32x4 m5[4], x[4];
#pragma unroll
        for (int j = 0; j < 4; ++j) m5[j] = *(const f32x4*)(MODS + (size_t)(3 * 5 + mr) * 6144 + 5 * 1024 + 256 * j + 4 * lane);
        load_x_combined(x, xs + (size_t)t * D, true, YS, t, m5, lane);
        const float rstd = row_rstd(x);
#pragma unroll
        for (int j = 0; j < 4; ++j) { const int col = 256 * j + 4 * lane; *(f32x4*)(a.out + (size_t)t * D + col) = x[j] * rstd * *(const f32x4*)(a.in[7] + col); }
    }
}

using pg8::Unit; using pg8::tile_map;
struct SchedStd {
    int G, c, nM, nN;
    __device__ __forceinline__ bool next(int i, Unit& u) const { const long L = (long)i * G + c; if (L >= (long)nM * nN) return false; int pm, pn; tile_map((int)L, nM, nN, pm, pn); u.pm = pm; u.pn = pn; u.e = 0; u.nv = pm; u.par = 0; return true; }
    __device__ __forceinline__ void a_ready(const Unit&) const {}
    __device__ __forceinline__ void done(const Unit&) const {}
    __device__ __forceinline__ unsigned row_off(const Unit&, int) const { return 0u; }
    __device__ __forceinline__ unsigned row_off_lds(const Unit&, int) const { return 0u; }
    __device__ __forceinline__ void prefetch_rows(const Unit&) const {}
};
struct SchedB1 {
    int G, c;
    __device__ __forceinline__ bool next(int i, Unit& u) const { const long L = (long)i * G + c; constexpr int n1 = 3 * NMT * 4; if (L >= n1 + 3 * NMT) return false; const int l = (int)L;
        if (l < n1) { const int j = l / (NMT * 4), r = l % (NMT * 4); int pm, pn; tile_map(r, NMT, 4, pm, pn); u.pm = j * NMT + pm; u.pn = j * 4 + pn; u.e = j; u.nv = pm; }
        else { const int r = l - n1, j = r / NMT, pm = r % NMT; u.pm = (3 + j) * NMT + pm; u.pn = 12 + j; u.e = 3 + j; u.nv = pm; }
        u.par = 0; return true; }
    __device__ __forceinline__ void a_ready(const Unit&) const {}
    __device__ __forceinline__ void done(const Unit&) const {}
    __device__ __forceinline__ unsigned row_off(const Unit&, int) const { return 0u; }
    __device__ __forceinline__ unsigned row_off_lds(const Unit&, int) const { return 0u; }
    __device__ __forceinline__ void prefetch_rows(const Unit&) const {}
};
struct SchedB2 {
    int G, c;
    __device__ __forceinline__ bool next(int i, Unit& u) const { const long L = (long)i * G + c; constexpr int n1 = 2 * NMT * 8; if (L >= n1 + NMT * 4) return false; const int l = (int)L;
        if (l < n1) { const int j = l / (NMT * 8), r = l % (NMT * 8); int pm, pn; tile_map(r, NMT, 8, pm, pn); u.pm = j * NMT + pm; u.pn = j * 8 + pn; u.e = j; u.nv = pm; }
        else { const int r = l - n1; int pm, pn; tile_map(r, NMT, 4, pm, pn); u.pm = 2 * NMT + pm; u.pn = 16 + pn; u.e = 2; u.nv = pm; }
        u.par = 0; return true; }
    __device__ __forceinline__ void a_ready(const Unit&) const {}
    __device__ __forceinline__ void done(const Unit&) const {}
    __device__ __forceinline__ unsigned row_off(const Unit&, int) const { return 0u; }
    __device__ __forceinline__ unsigned row_off_lds(const Unit&, int) const { return 0u; }
    __device__ __forceinline__ void prefetch_rows(const Unit&) const {}
};
struct SchedMoe {
    int G, c, nnt, ntiles, P; LAS unsigned char* lds; const int* slotl; const float* gatel; int wave;
    __device__ __forceinline__ bool next(int i, Unit& u) const { const long L = (long)i * G + c; const int ntp = (ntiles + P - 1) / P, ppg = nnt / (8 / P); if (L >= (long)ntp * ppg * 8) return false;
        const LAS int* tpre = (const LAS int*)(lds + LDSCTL_OFF + 64); const LAS int* ecnt = (const LAS int*)(lds + LDSCTL_OFF + 256); const LAS unsigned short* tile_e = (const LAS unsigned short*)(lds + LDSCTL_OFF + 512);
        const int xq = (int)(L >> 3), x8 = (int)(L & 7); int tile = (xq / ppg) * P + (x8 % P); const int pnl = (x8 / P) * ppg + xq % ppg; const bool dead = tile >= ntiles; tile = dead ? 0 : tile;
        const int e = __builtin_amdgcn_readfirstlane((int)tile_e[tile]), r0 = (tile - __builtin_amdgcn_readfirstlane(tpre[e])) * 256; int nv = __builtin_amdgcn_readfirstlane(ecnt[e]) - r0; nv = nv > 256 ? 256 : nv; nv = dead ? 0 : nv;
        u.pm = dead ? MAXTILES : tile; u.pn = e * nnt + pnl; u.e = e; u.nv = nv | (r0 << 9); u.par = i & 1; return true; }
    __device__ __forceinline__ void a_ready(const Unit& u) const {
        if (gatel != nullptr && wave == 0) { const size_t li = (size_t)u.e * T + (u.nv >> 9) + 4 * lane_id();
            __builtin_amdgcn_global_load_lds((const unsigned*)(slotl + li), (LAS unsigned*)(lds + LDSCTL_OFF + 8192 + 2048 * u.par), 16, 0, 0);
            __builtin_amdgcn_global_load_lds((const unsigned*)(gatel + li), (LAS unsigned*)(lds + LDSCTL_OFF + 8192 + 2048 * u.par + 1024), 16, 0, 0); } }
    __device__ __forceinline__ void done(const Unit&) const {}
    __device__ __forceinline__ void prefetch_rows(const Unit& u) const {
        if (wave == 0) __builtin_amdgcn_global_load_lds((const unsigned*)(slotl + (size_t)u.e * T + (u.nv >> 9) + 4 * lane_id()), (LAS unsigned*)(lds + LDSCTL_OFF + 8192 + 2048 * u.par), 16, 0, 0); }
    __device__ __forceinline__ unsigned row_off_lds(const Unit& u, int r) const { const int nv = u.nv & 511; const int sl = ((const LAS int*)(lds + LDSCTL_OFF + 8192 + 2048 * u.par))[r]; const int tok = r < nv ? (sl >> 2) : 0; return (unsigned)tok * 2048u; }
    __device__ __forceinline__ unsigned row_off(const Unit& u, int r) const { const int nv = u.nv & 511, r0 = u.nv >> 9; const int tok = r < nv ? (slotl[(size_t)u.e * T + r0 + r] >> 2) : 0; return (unsigned)tok * 2048u; }
};

using pg8::cvt_pk_bf16;
template <class P> __device__ __forceinline__ P* pin_ptr(P* p) { asm volatile("" : "+v"(p)); return p; }
struct EpiB1 {
    static constexpr bool PERM = true, AFTER_DRAIN = false;
    bf16* RKV; bf16* L1;
    __device__ __forceinline__ void operator()(const f32x4 (&acc)[2][2][4][2], const Unit& u, int wr, int wc, int fr, int fq) const {
        const int seg = u.e, row0 = u.nv * 256 + wr * 64 + fr;
        const int jj = seg - 3, ld = seg < 3 ? D : 128, col0 = (seg < 3 ? (u.pn - seg * 4) * 256 : 0) + wc * 32 + 8 * fq;
        bf16* base = seg < 3 ? RKV + (size_t)seg * T * D : L1 + (size_t)jj * T * 128;
#pragma unroll
        for (int ai = 0; ai < 2; ++ai)
#pragma unroll
            for (int m = 0; m < 4; ++m) { bf16* rowp = base + (size_t)(row0 + ai * 128 + m * 16) * ld + col0;
#pragma unroll
                for (int bj = 0; bj < 2; ++bj) { if (seg >= 3 && bj == 1) continue; f32x4 v0 = acc[ai][bj][m][0], v1 = acc[ai][bj][m][1];
                    if (jj == 0) {
#pragma unroll
                        for (int q = 0; q < 4; ++q) { v0[q] = tanh_fast(v0[q]); v1[q] = tanh_fast(v1[q]); } }
                    else if (jj == 2) {
#pragma unroll
                        for (int q = 0; q < 4; ++q) { v0[q] = sigm(v0[q]); v1[q] = sigm(v1[q]); } }
                    u32x4 w; w.x = cvt_pk_bf16(v0[0], v0[1]); w.y = cvt_pk_bf16(v0[2], v0[3]); w.z = cvt_pk_bf16(v1[0], v1[1]); w.w = cvt_pk_bf16(v1[2], v1[3]);
                    *(u32x4*)(rowp + bj * 128) = w; } }
    }
};
struct EpiB2 {
    static constexpr bool PERM = true, AFTER_DRAIN = false;
    bf16* RW; bf16* RA; bf16* Gg;
    __device__ __forceinline__ void operator()(const f32x4 (&acc)[2][2][4][2], const Unit& u, int wr, int wc, int fr, int fq) const {
        const int jj = u.e, row0 = u.nv * 256 + wr * 64 + fr, pnl = u.pn - jj * 8;
        const int dirn = jj < 2 ? (pnl >> 2) : 0, col0 = (jj < 2 ? (pnl & 3) : pnl) * 256 + wc * 32 + 8 * fq;
        bf16* base = (jj == 0 ? RW : jj == 1 ? RA : Gg) + (size_t)dirn * T * D;
#pragma unroll
        for (int ai = 0; ai < 2; ++ai)
#pragma unroll
            for (int m = 0; m < 4; ++m) { bf16* rowp = base + (size_t)(row0 + ai * 128 + m * 16) * D + col0;
#pragma unroll
                for (int bj = 0; bj < 2; ++bj) { const f32x4 v0 = acc[ai][bj][m][0], v1 = acc[ai][bj][m][1];
                    u32x4 w; w.x = cvt_pk_bf16(v0[0], v0[1]); w.y = cvt_pk_bf16(v0[2], v0[3]); w.z = cvt_pk_bf16(v1[0], v1[1]); w.w = cvt_pk_bf16(v1[2], v1[3]);
                    *(u32x4*)(rowp + bj * 128) = w; } }
    }
};
struct EpiRes {
    static constexpr bool PERM = true, AFTER_DRAIN = false;
    float* X; const float* gate; float* Xo;
    __device__ __forceinline__ void operator()(const f32x4 (&acc)[2][2][4][2], const Unit& u, int wr, int wc, int fr, int fq) const {
        const int row0 = u.pm * 256 + wr * 64 + fr, col0 = u.pn * 256 + wc * 32 + 8 * fq, mr = u.pm < NMT_L ? (u.pm >> 5) : 4;
        const float* gp = pin_ptr(gate + (size_t)mr * 6144 + col0);
        f32x4 gv[2][2];
#pragma unroll
        for (int bj = 0; bj < 2; ++bj)
#pragma unroll
            for (int n = 0; n < 2; ++n) gv[bj][n] = *(const f32x4*)(gp + bj * 128 + 4 * n);
#pragma unroll
        for (int ai = 0; ai < 2; ++ai)
#pragma unroll
            for (int m = 0; m < 4; ++m) { float* rowp = X + (size_t)(row0 + ai * 128 + m * 16) * D + col0;
#pragma unroll
                for (int bj = 0; bj < 2; ++bj)
#pragma unroll
                    for (int n = 0; n < 2; ++n) { float* p = rowp + bj * 128 + 4 * n; *(f32x4*)(Xo + (p - X)) = *(const f32x4*)p + gv[bj][n] * acc[ai][bj][m][n]; } }
    }
};
struct EpiWin {
    static constexpr bool PERM = true, AFTER_DRAIN = false;
    bf16* BG; bf16* CU;
    __device__ __forceinline__ void operator()(const f32x4 (&acc)[2][2][4][2], const Unit& u, int wr, int wc, int fr, int fq) const {
        const int row0 = u.pm * 256 + wr * 64 + fr;
        if (u.pn < 4) {
            const int col0 = u.pn * 256 + wc * 32 + 8 * fq;
#pragma unroll
            for (int ai = 0; ai < 2; ++ai)
#pragma unroll
                for (int m = 0; m < 4; ++m) { bf16* rowp = BG + (size_t)(row0 + ai * 128 + m * 16) * D + col0;
#pragma unroll
                    for (int bj = 0; bj < 2; ++bj) { const f32x4 v0 = acc[ai][bj][m][0], v1 = acc[ai][bj][m][1];
                        u32x4 w; w.x = cvt_pk_bf16(v0[0], v0[1]); w.y = cvt_pk_bf16(v0[2], v0[3]); w.z = cvt_pk_bf16(v1[0], v1[1]); w.w = cvt_pk_bf16(v1[2], v1[3]);
                        *(u32x4*)(rowp + bj * 128) = w; } }
        } else {
            const int f0 = (u.pn - 4) * 128 + wc * 32 + 8 * fq;
#pragma unroll
            for (int ai = 0; ai < 2; ++ai)
#pragma unroll
                for (int m = 0; m < 4; ++m) { const f32x4 v0 = acc[ai][0][m][0] * acc[ai][1][m][0], v1 = acc[ai][0][m][1] * acc[ai][1][m][1];
                    u32x4 w; w.x = cvt_pk_bf16(v0[0], v0[1]); w.y = cvt_pk_bf16(v0[2], v0[3]); w.z = cvt_pk_bf16(v1[0], v1[1]); w.w = cvt_pk_bf16(v1[2], v1[3]);
                    *(u32x4*)(CU + (size_t)(row0 + ai * 128 + m * 16) * D + f0) = w; }
        }
    }
};
struct EpiGU {
    static constexpr bool PERM = true, AFTER_DRAIN = false;
    bf16* INTER; const float* bgu;
    __device__ __forceinline__ void operator()(const f32x4 (&acc)[2][2][4][2], const Unit& u, int wr, int wc, int fr, int fq) const {
        const int e = u.e, pnl = u.pn - e * 8, row0 = u.pm * 256 + wr * 64 + fr, f0 = pnl * 128 + wc * 32 + 8 * fq;
        const float* bp = pin_ptr(bgu + (size_t)e * 2048 + f0);
        f32x4 bg[2], bu[2];
#pragma unroll
        for (int n = 0; n < 2; ++n) { bg[n] = *(const f32x4*)(bp + 4 * n); bu[n] = *(const f32x4*)(bp + 1024 + 4 * n); }
#pragma unroll
        for (int ai = 0; ai < 2; ++ai)
#pragma unroll
            for (int m = 0; m < 4; ++m) { f32x4 o[2];
#pragma unroll
                for (int n = 0; n < 2; ++n) { const f32x4 g = acc[ai][0][m][n] + bg[n], uu = acc[ai][1][m][n] + bu[n];
#pragma unroll
                    for (int q = 0; q < 4; ++q) { const float gc = fminf(g[q], 7.0f), uc = fminf(fmaxf(uu[q], -7.0f), 7.0f); o[n][q] = (uc + 1.0f) * gc * sigm(1.702f * gc); } }
                u32x4 w; w.x = cvt_pk_bf16(o[0][0], o[0][1]); w.y = cvt_pk_bf16(o[0][2], o[0][3]); w.z = cvt_pk_bf16(o[1][0], o[1][1]); w.w = cvt_pk_bf16(o[1][2], o[1][3]);
                *(u32x4*)(INTER + (size_t)(row0 + ai * 128 + m * 16) * 1024 + f0) = w; }
    }
};
struct EpiDown {
    static constexpr bool PERM = true, AFTER_DRAIN = false;
    bf16* YS; const float* bdn; LAS unsigned char* lds;
    __device__ __forceinline__ void operator()(const f32x4 (&acc)[2][2][4][2], const Unit& u, int wr, int wc, int fr, int fq) const {
        const int e = u.e, pnl = u.pn - e * 4, col0 = pnl * 256 + wc * 32 + 8 * fq, nv = u.nv & 511;
        const float* bp = pin_ptr(bdn + (size_t)e * 1024 + col0);
        f32x4 bv[2][2];
#pragma unroll
        for (int bj = 0; bj < 2; ++bj)
#pragma unroll
            for (int n = 0; n < 2; ++n) bv[bj][n] = *(const f32x4*)(bp + bj * 128 + 4 * n);
#pragma unroll
        for (int ai = 0; ai < 2; ++ai)
#pragma unroll
            for (int m = 0; m < 4; ++m) { const int r = ai * 128 + wr * 64 + m * 16 + fr;
                if (r < nv) { const LAS int* sl = (const LAS int*)(lds + LDSCTL_OFF + 8192 + 2048 * u.par); const int slot = sl[r]; const float gt = ((const LAS float*)(sl + 256))[r];
                    bf16* rowp = YS + (size_t)slot * 1024 + col0;
#pragma unroll
                    for (int bj = 0; bj < 2; ++bj) { const f32x4 v0 = (acc[ai][bj][m][0] + bv[bj][0]) * gt, v1 = (acc[ai][bj][m][1] + bv[bj][1]) * gt;
                        u32x4 w; w.x = cvt_pk_bf16(v0[0], v0[1]); w.y = cvt_pk_bf16(v0[2], v0[3]); w.z = cvt_pk_bf16(v1[0], v1[1]); w.w = cvt_pk_bf16(v1[2], v1[3]);
                        *(u32x4*)(rowp + bj * 128) = w; } } }
    }
};

__device__ __forceinline__ int moe_tables(const unsigned* cnt, LAS unsigned char* lds, int tid) {
    LAS int* tpre = (LAS int*)(lds + LDSCTL_OFF + 64); LAS int* ecnt = (LAS int*)(lds + LDSCTL_OFF + 256); LAS unsigned short* tile_e = (LAS unsigned short*)(lds + LDSCTL_OFF + 512);
    if (tid == 0) { int p = 0; for (int e = 0; e < 32; ++e) { const int cn = (int)__hip_atomic_load(cnt + e * CNT_STRIDE, __ATOMIC_RELAXED, __HIP_MEMORY_SCOPE_AGENT); ecnt[e] = cn; tpre[e] = p; p += (cn + 255) >> 8; } tpre[32] = p; }
    __syncthreads();
    const int nt = tpre[32];
    for (int t = tid; t < nt; t += 512) { int e = 0; while (e < 31 && t >= tpre[e + 1]) ++e; tile_e[t] = (unsigned short)e; }
    __syncthreads();
    return nt;
}

constexpr int NPHASES = 37;
typedef const Args __attribute__((address_space(4))) CArgs;
__global__ void __launch_bounds__(512, 2) fwd_kernel(Args a_) {
    extern __shared__ __attribute__((aligned(16))) unsigned char lds_raw[];
    LAS unsigned char* lds = (LAS unsigned char*)lds_raw;
    const int G = gridDim.x, NGW = G * 8;
    CArgs* ap0 = (CArgs*)__builtin_amdgcn_kernarg_segment_ptr();
    if (threadIdx.x < 4) ((LAS unsigned*)(lds + LDSCTL_OFF))[threadIdx.x] = 0u;
    __syncthreads();
    XcdBarrier bar = xcd_barrier_post((unsigned*)(a_.ws + WS_CTL) + CW_BAR, (volatile LAS unsigned*)(lds + LDSCTL_OFF));
    const int lo = a_.ph_lo, hi = a_.ph_hi;
    int ph = 0;
#ifndef MK_ONLY
#define MK_ONLY -1
#endif
#ifndef MK_DBL
#define MK_DBL 0
#endif
#define PH_BEGIN(id) if ((MK_ONLY < 0 || MK_ONLY == (id)) && ph >= lo && ph < hi) { for (int rep_ = 0; rep_ <= ((MK_DBL >> (id)) & 1); ++rep_) { CArgs* ap = ap0; asm volatile("" : "+s"(ap)); const Args a = *(const Args*)ap; unsigned char* const ws = a.ws; (void)ws; const int wave = (int)bar.wv; int tid = wave * 64 + lane_id(); asm volatile("" : "+v"(tid)); const int lane = tid & 63, gw = blockIdx.x * 8 + wave; (void)lane; (void)gw;
#define PH_END } } if (ph >= lo && ph + 1 < hi) xcd_barrier(bar); ++ph;

    PH_BEGIN(0) p0_prologue(a, lds, tid, lane, wave, G); PH_END

#pragma unroll 1
    for (int layer = 0; layer < DEPTH; ++layer) {
        const int kind = layer & 1, lj = layer >> 1;
        const int rows = layer == 3 ? TL : T, nmt = rows / 256;
        const int rows_moe = layer < 2 ? T : TL;
        if (kind == 0) {
            PH_BEGIN(1) phase_a_rwkv(a, layer, lds, tid, gw, NGW, lane); PH_END
            PH_BEGIN(2) {
                pg8::Gemm g{(const bf16*)(ws + WS_XL), (const bf16*)(ws + WS_WRKV) + (size_t)lj * 3840 * 1024, 6 * T, 3840, 1024};
                SchedB1 S{G, (int)blockIdx.x}; EpiB1 E{(bf16*)(ws + WS_RKV), (bf16*)(ws + WS_L1)};
                pg8::gemm_phase<EpiB1, SchedB1, true, true, false>(lds, g, S, E, tid); } PH_END
            PH_BEGIN(3) {
                pg8::Gemm g{(const bf16*)(ws + WS_L1), (const bf16*)(ws + WS_L2T) + (size_t)lj * 5120 * 128, 3 * T, 5120, 128};
                SchedB2 S{G, (int)blockIdx.x}; EpiB2 E{(bf16*)(ws + WS_RAWW), (bf16*)(ws + WS_RAWA), (bf16*)(ws + WS_G)};
                pg8::gemm_phase<EpiB2, SchedB2, true, true, false>(lds, g, S, E, tid); } PH_END
            PH_BEGIN(5) phase_s1_chunks(a, lj, lds, tid, G, (MK_DBL >> 5) & 1 & (rep_ == 0)); PH_END
            PH_BEGIN(15) phase_s2_chain(a, wave, lane, G); PH_END
            PH_BEGIN(6) phase_s3_readout(a, lj, layer == 2 ? TL : T, gw, NGW, lane); PH_END
        } else {
            PH_BEGIN(7) phase_a_conv(a, layer, rows, gw, NGW, lane); PH_END
            PH_BEGIN(8) {
                pg8::Gemm g{(const bf16*)(ws + WS_XL), (const bf16*)(ws + WS_WIN) + (size_t)lj * 3072 * 1024, rows, 3072, 1024};
                SchedStd S{G, (int)blockIdx.x, nmt, 12}; EpiWin E{(bf16*)(ws + WS_BG), (bf16*)(ws + WS_CUZ)};
                pg8::gemm_phase<EpiWin, SchedStd, true, true, false>(lds, g, S, E, tid); } PH_END
            PH_BEGIN(9) phase_cv(a, lj, rows, gw, NGW, lane); PH_END
        }
        PH_BEGIN(10) {
            const bf16* Wt = kind == 0 ? (const bf16*)(ws + WS_WO) + (size_t)lj * 1024 * 1024 : (const bf16*)(ws + WS_WOUT) + (size_t)lj * 1024 * 1024;
            pg8::Gemm g{(const bf16*)(ws + WS_Z), Wt, rows, 1024, 1024};
            SchedStd S{G, (int)blockIdx.x, layer == 2 ? NMT_L : nmt, 4}; EpiRes E{(float*)(ws + (layer < 2 ? WS_XSA : WS_XSB)), (const float*)(ws + WS_MODS) + (size_t)layer * 5 * 6144 + 2 * 1024, (float*)(ws + (rep_ ? WS_XL : (layer < 2 ? WS_XSA : WS_XSB)))};
            pg8::gemm_phase<EpiRes, SchedStd, true, true, false>(lds, g, S, E, tid); } PH_END
        PH_BEGIN(11) phase_e_route_mfma(a, layer, rows_moe, lds, tid, wave, gw, NGW, lane, rep_); PH_END
        PH_BEGIN(12) {
            const int nt = __builtin_amdgcn_readfirstlane(moe_tables((const unsigned*)(ws + WS_CTL) + CW_CNT + layer * 32 * CNT_STRIDE, lds, tid));
            pg8::Gemm g{(const bf16*)(ws + WS_H2), (const bf16*)(ws + WS_WGU) + (size_t)layer * 32 * 2048 * 1024, 0, 0, 1024};
            SchedMoe S{G, (int)blockIdx.x, 8, nt, 2, lds, (const int*)(ws + WS_SLOTL), nullptr, wave};
            EpiGU E{(bf16*)(ws + WS_INTER), a.in[30] + (size_t)layer * 32 * 2048};
            pg8::gemm_phase<EpiGU, SchedMoe, true, true, true>(lds, g, S, E, tid); } PH_END
        PH_BEGIN(13) {
            const int nt = __builtin_amdgcn_readfirstlane(moe_tables((const unsigned*)(ws + WS_CTL) + CW_CNT + layer * 32 * CNT_STRIDE, lds, tid));
            pg8::Gemm g{(const bf16*)(ws + WS_INTER), (const bf16*)(ws + WS_WDN) + (size_t)layer * 32 * 1024 * 1024, 0, 0, 1024};
            SchedMoe S{G, (int)blockIdx.x, 4, nt, 8, lds, (const int*)(ws + WS_SLOTL), (const float*)(ws + WS_GATEL), wave};
            EpiDown E{(bf16*)(ws + WS_YS), a.in[32] + (size_t)layer * 32 * 1024, lds};
            pg8::gemm_phase<EpiDown, SchedMoe, true, true, false>(lds, g, S, E, tid); } PH_END
    }
    PH_BEGIN(14) phase_final(a, gw, NGW, lane); PH_END
#undef PH_BEGIN
#undef PH_END
}

extern "C" void kernel_launch(void* const* d_in, const int* in_sizes, int n_in, void* d_out, int out_size, void* d_ws, size_t ws_size, hipStream_t stream) {
    static int grid = 0;
    if (grid == 0) {
        if (n_in != 33 || in_sizes[0] != TL * D || out_size != TL * D || ws_size < WS_END) { fprintf(stderr, "kernel_launch: unexpected problem (n_in %d, in0 %d, out %d, ws %zu < %zu)\n", n_in, n_in > 0 ? in_sizes[0] : -1, out_size, ws_size, (size_t)WS_END); grid = -1; return; }
        int dev = 0, cus = 0, per_cu = 0;
        if (hipGetDevice(&dev) != hipSuccess || hipDeviceGetAttribute(&cus, hipDeviceAttributeMultiprocessorCount, dev) != hipSuccess) { grid = -1; return; }
        if (hipFuncSetAttribute((const void*)fwd_kernel, hipFuncAttributeMaxDynamicSharedMemorySize, LDS_BYTES) != hipSuccess) { fprintf(stderr, "kernel_launch: hipFuncSetAttribute failed\n"); grid = -1; return; }
        if (hipOccupancyMaxActiveBlocksPerMultiprocessor(&per_cu, (const void*)fwd_kernel, 512, LDS_BYTES) != hipSuccess || per_cu < 1) fprintf(stderr, "kernel_launch: occupancy query says %d\n", per_cu);
        (void)hipGetLastError();
        grid = cus;
    }
    if (grid < 0) return;
    if (hipMemsetAsync((char*)d_ws + WS_CTL, 0, CTL_ZERO_BYTES, stream) != hipSuccess) return;
    Args a{};
    for (int i = 0; i < 33; ++i) a.in[i] = (const float*)d_in[i];
    a.out = (float*)d_out; a.ws = (unsigned char*)d_ws;
#if MK_PER_PHASE
    for (int p = 0; p < NPHASES; ++p) { a.ph_lo = p; a.ph_hi = p + 1; hipLaunchKernelGGL(fwd_kernel, dim3(grid), dim3(512), LDS_BYTES, stream, a); }
#else
    a.ph_lo = 0; a.ph_hi = NPHASES;
    hipLaunchKernelGGL(fwd_kernel, dim3(grid), dim3(512), LDS_BYTES, stream, a);
#endif
    const hipError_t le = hipPeekAtLastError();
    if (le != hipSuccess) fprintf(stderr, "kernel_launch: launch failed: %s\n", hipGetErrorName(le));
}
```

```cpp
#include <hip/hip_runtime.h>
#include <cstdio>
#include <cstdint>

#ifndef MK_PER_PHASE
#define MK_PER_PHASE 0
#endif

constexpr int D = 1024, NBATCH = 4, SEQ = 8192, TL = NBATCH * SEQ, CTXL = 256, TC = NBATCH * CTXL, T = TL + TC;
constexpr int NH = 16, HS = 64, NE = 32, TOPK = 4, DEPTH = 4;
constexpr int NMT = T / 256;
constexpr int NMT_L = TL / 256;
constexpr int MAXTILES = (T * TOPK) / 256 + NE;
constexpr int NSTEP = CTXL + SEQ;

__device__ __forceinline__ int lane_id() { return (int)__builtin_amdgcn_mbcnt_hi(~0u, __builtin_amdgcn_mbcnt_lo(~0u, 0u)); }
namespace pg8 {
#define PG8_LAS __attribute__((address_space(3)))
typedef unsigned short bf16_t;
typedef short bf16x8 __attribute__((ext_vector_type(8)));
typedef float f32x4 __attribute__((ext_vector_type(4)));
typedef unsigned u32x4 __attribute__((ext_vector_type(4)));
typedef unsigned u32x2 __attribute__((ext_vector_type(2)));
constexpr int BM = 256, BK = 64, HALF = 128, HTB = HALF * BK * 2  , STAGE_BYTES = 8 * HTB, NXCD = 8, WGM = 8;

__host__ __device__ __forceinline__ int lds_byte(int r, int c) { const int st = (r >> 4) * 2 + (c >> 5), rr = r & 15, cc = c & 31, ob = rr * 64 + cc * 2; return st * 1024 + (ob ^ (((ob >> 9) & 1) << 5)); }
__host__ __device__ __forceinline__ void stage_rc(int b, int& R, int& C) { const int st = b / 1024, sb = b % 1024, swz = sb ^ (((sb >> 9) & 1) << 5); R = (st >> 1) * 16 + swz / 64; C = (st & 1) * 32 + (swz % 64) / 2; }
__host__ __device__ __forceinline__ int perm32(int rho) { const int n = rho >> 4, i = rho & 15; return 8 * (i >> 2) + 4 * n + (i & 3); }

struct Unit { int pm, pn, e, nv, par; };
struct Gemm { const bf16_t* A; const bf16_t* Bt; int M, N, K; };

__device__ __forceinline__ void tile_map(int wgid, int nM, int nN, int& pm, int& pn) {
    const int nwg = nM * nN;
    { const int q = nwg / NXCD, r = nwg % NXCD, xcd = wgid % NXCD, off = wgid / NXCD; wgid = (xcd < r ? xcd * (q + 1) : r * (q + 1) + (xcd - r) * q) + off; }
    const int nig = WGM * nN, gid = wgid / nig, fm = gid * WGM, gsz = (nM - fm) < WGM ? (nM - fm) : WGM;
    pm = fm + ((wgid % nig) % gsz); pn = (wgid % nig) / gsz;
}
typedef __bf16 bf16x2_t __attribute__((ext_vector_type(2)));
typedef float f32x2_t __attribute__((ext_vector_type(2)));
__device__ __forceinline__ unsigned cvt_pk_bf16(float lo, float hi) { const f32x2_t v = {lo, hi}; const bf16x2_t b = __builtin_convertvector(v, bf16x2_t); return __builtin_bit_cast(unsigned, b); }

template <class Epi, class Sched, bool ALIGN_EPI = false, bool SP2 = false, bool GATHER = false>
__device__ __forceinline__ void gemm_phase(PG8_LAS unsigned char* lds, const Gemm g, const Sched& S, const Epi& E, int tid_in) {
    int tid_ = tid_in; asm volatile("" : "+v"(tid_));
    const int tid = tid_, wid = __builtin_amdgcn_readfirstlane(tid >> 6), lane = tid & 63, wr = wid >> 2, wc = wid & 3, fr = lane & 15, fq = lane >> 4;
    int K_ = g.K; asm volatile("" : "+s"(K_));
    const int K = K_, nt = K / BK;
    unsigned voffA[2], voffB[2]; int gR[2]; unsigned gC[2];
#pragma unroll
    for (int i = 0; i < 2; ++i) { int R, C; stage_rc(tid * 16 + i * 8192, R, C); const int Rb = Epi::PERM ? ((R & ~31) + perm32(R & 31)) : R;
        voffA[i] = (unsigned)(R * K + C) * 2u; voffB[i] = (unsigned)(Rb * K + C) * 2u; gR[i] = R; gC[i] = (unsigned)C * 2u; }
    unsigned oc[2][2], on[2][2], o2[2][2];
#pragma unroll
    for (int h = 0; h < 2; ++h)
#pragma unroll
        for (int i = 0; i < 2; ++i) { oc[h][i] = 0u; on[h][i] = 0u; o2[h][i] = 0u; }
    const size_t kstep = (size_t)(BK * 2);
    const size_t hstep = (size_t)HALF * K * 2;
    const size_t tstep = 2 * hstep;
    const unsigned ldsw = (unsigned)wid * 1024u;
    const int aoff = lds_byte(wr * 64 + fr, fq * 8), boff = lds_byte(wc * 32 + fr, fq * 8);
#define PG8_SA(b, h) (((b) * 2 + (h)) * HTB)
#define PG8_SB(b, h) ((4 + (b) * 2 + (h)) * HTB)
#define PG8_STAGE(bufoff, gbase, voff) do { _Pragma("unroll") for (int _i = 0; _i < 2; ++_i) \
        __builtin_amdgcn_global_load_lds((const unsigned*)((const char*)(gbase) + (voff)[_i]), (PG8_LAS unsigned*)(lds + (bufoff) + ldsw + _i * 8192), 16, 0, 0); } while (0)
#define PG8_STAGE_A(bufoff, base, h, O) do { if constexpr (GATHER) { PG8_STAGE(bufoff, base, (O)[h]); } else { PG8_STAGE(bufoff, (base) + (h) * hstep, voffA); } } while (0)
#define PG8_LDA(dst, b, h) do { _Pragma("unroll") for (int m = 0; m < 4; ++m) _Pragma("unroll") for (int k = 0; k < 2; ++k) dst[m][k] = *(const PG8_LAS bf16x8*)(lds + PG8_SA(b, h) + aoff + m * 2048 + k * 1024); } while (0)
#define PG8_LDB(dst, b, h) do { _Pragma("unroll") for (int n = 0; n < 2; ++n) _Pragma("unroll") for (int k = 0; k < 2; ++k) dst[n][k] = *(const PG8_LAS bf16x8*)(lds + PG8_SB(b, h) + boff + n * 2048 + k * 1024); } while (0)
#define PG8_MMA(ai, bj, At, Bt) do { __builtin_amdgcn_s_setprio(1); _Pragma("unroll") for (int m = 0; m < 4; ++m) _Pragma("unroll") for (int n = 0; n < 2; ++n) _Pragma("unroll") for (int k = 0; k < 2; ++k) \
        acc[ai][bj][m][n] = __builtin_amdgcn_mfma_f32_16x16x32_bf16(Bt[n][k], At[m][k], acc[ai][bj][m][n], 0, 0, 0); __builtin_amdgcn_s_setprio(0); } while (0)
#define PG8_WAIT_V(n) asm volatile("s_waitcnt vmcnt(" #n ")" ::: "memory")
#define PG8_WAIT_L(n) asm volatile("s_waitcnt lgkmcnt(" #n ")" ::: "memory")
#define PG8_BAR __builtin_amdgcn_s_barrier()
#define PG8_SCHED __builtin_amdgcn_sched_barrier(0)
    Unit cur, nxt; int ui = 0;
    if (!S.next(0, cur)) return;
    f32x4 acc[2][2][4][2];
#pragma unroll
    for (int a = 0; a < 2; ++a)
#pragma unroll
        for (int b = 0; b < 2; ++b)
#pragma unroll
            for (int m = 0; m < 4; ++m)
#pragma unroll
                for (int n = 0; n < 2; ++n) acc[a][b][m][n] = (f32x4){0.f, 0.f, 0.f, 0.f};
    bf16x8 At[4][2], B0[2][2], B1[2][2];
    const char* cA = GATHER ? (const char*)g.A : (const char*)g.A + (size_t)cur.pm * tstep; const char* cB = (const char*)g.Bt + (size_t)cur.pn * tstep;
    S.a_ready(cur);
    if constexpr (GATHER) {
#pragma unroll
        for (int h = 0; h < 2; ++h)
#pragma unroll
            for (int i = 0; i < 2; ++i) oc[h][i] = S.row_off(cur, h * HALF + gR[i]) + gC[i];
    }
    if constexpr (SP2) {
        PG8_STAGE(PG8_SB(0, 0), cB, voffB); PG8_STAGE(PG8_SB(0, 1), cB + hstep, voffB); PG8_STAGE_A(PG8_SA(0, 0), cA, 0, oc); PG8_STAGE_A(PG8_SA(0, 1), cA, 1, oc);
        if (wr == 1) PG8_BAR;
        PG8_WAIT_V(2); PG8_BAR;
        PG8_STAGE(PG8_SB(1, 0), cB + kstep, voffB); PG8_STAGE_A(PG8_SA(1, 0), cA + kstep, 0, oc); PG8_STAGE(PG8_SB(1, 1), cB + hstep + kstep, voffB);
        PG8_WAIT_V(6); PG8_BAR;
    } else {
        PG8_STAGE(PG8_SB(0, 0), cB, voffB); PG8_STAGE_A(PG8_SA(0, 0), cA, 0, oc); PG8_STAGE(PG8_SB(0, 1), cB + hstep, voffB); PG8_STAGE_A(PG8_SA(0, 1), cA, 1, oc);
        if (wr == 1) PG8_BAR;
        PG8_WAIT_V(4); PG8_BAR;
        PG8_STAGE(PG8_SB(1, 0), cB + kstep, voffB); PG8_STAGE_A(PG8_SA(1, 0), cA + kstep, 0, oc); PG8_STAGE(PG8_SB(1, 1), cB + hstep + kstep, voffB);
        PG8_WAIT_V(6); PG8_BAR;
    }
    for (;;) {
        const bool has_next = S.next(ui + 1, nxt);
        const char* nA = GATHER ? (const char*)g.A : (has_next ? (const char*)g.A + (size_t)nxt.pm * tstep : cA); const char* nB = has_next ? (const char*)g.Bt + (size_t)nxt.pn * tstep : cB;
        if constexpr (GATHER) { if (has_next) S.prefetch_rows(nxt); }
        for (int t = 0; t < nt; t += 2) {
            const bool last = (t == nt - 2);
            const char* a1 = cA + (size_t)(t + 1) * kstep;
            const char* a2 = last ? nA : cA + (size_t)(t + 2) * kstep; const char* b2 = last ? nB : cB + (size_t)(t + 2) * kstep;
            const char* a3 = a2 + kstep; const char* b3 = b2 + kstep;
            if constexpr (GATHER) {
                if (last) {
#pragma unroll
                    for (int h = 0; h < 2; ++h)
#pragma unroll
                        for (int i = 0; i < 2; ++i) on[h][i] = has_next ? (S.row_off_lds(nxt, h * HALF + gR[i]) + gC[i]) : oc[h][i];
                }
#pragma unroll
                for (int h = 0; h < 2; ++h)
#pragma unroll
                    for (int i = 0; i < 2; ++i) o2[h][i] = last ? on[h][i] : oc[h][i];
            }
            if (last && has_next) S.a_ready(nxt);
            if constexpr (SP2) {
            PG8_LDB(B0, 0, 0); PG8_LDB(B1, 0, 1); PG8_SCHED; PG8_LDA(At, 0, 0); PG8_STAGE_A(PG8_SA(1, 1), a1, 1, oc);
            PG8_WAIT_V(8); PG8_WAIT_L(0); PG8_BAR; PG8_MMA(0, 0, At, B0); PG8_MMA(0, 1, At, B1); PG8_BAR; PG8_SCHED;
            PG8_LDA(At, 0, 1); PG8_STAGE(PG8_SB(0, 0), b2, voffB); PG8_STAGE(PG8_SB(0, 1), b2 + hstep, voffB); PG8_STAGE_A(PG8_SA(0, 0), a2, 0, o2);
            PG8_WAIT_V(8); PG8_WAIT_L(0); PG8_BAR; PG8_MMA(1, 0, At, B0); PG8_MMA(1, 1, At, B1); PG8_BAR; PG8_SCHED;
            PG8_LDB(B0, 1, 0); PG8_LDB(B1, 1, 1); PG8_SCHED; PG8_LDA(At, 1, 0); PG8_STAGE_A(PG8_SA(0, 1), a2, 1, o2);
            PG8_WAIT_V(8); PG8_WAIT_L(0); PG8_BAR; PG8_MMA(0, 0, At, B0); PG8_MMA(0, 1, At, B1); PG8_BAR; PG8_SCHED;
            PG8_LDA(At, 1, 1); PG8_STAGE(PG8_SB(1, 0), b3, voffB); PG8_STAGE(PG8_SB(1, 1), b3 + hstep, voffB); PG8_STAGE_A(PG8_SA(1, 0), a3, 0, o2);
            PG8_WAIT_V(8); PG8_WAIT_L(0); PG8_BAR; PG8_MMA(1, 0, At, B0); PG8_MMA(1, 1, At, B1); PG8_BAR; PG8_SCHED;
            } else {
            PG8_LDB(B0, 0, 0); PG8_SCHED; PG8_LDA(At, 0, 0); PG8_STAGE_A(PG8_SA(1, 1), a1, 1, oc);
            PG8_WAIT_L(8); PG8_BAR; PG8_WAIT_L(0); PG8_MMA(0, 0, At, B0); PG8_BAR; PG8_SCHED;
            PG8_LDB(B1, 0, 1); PG8_STAGE(PG8_SB(0, 0), b2, voffB);
            PG8_BAR; PG8_WAIT_L(0); PG8_MMA(0, 1, At, B1); PG8_BAR;
            PG8_LDA(At, 0, 1); PG8_STAGE_A(PG8_SA(0, 0), a2, 0, o2);
            PG8_BAR; PG8_WAIT_L(0); PG8_MMA(1, 0, At, B0); PG8_BAR; PG8_SCHED;
            PG8_STAGE(PG8_SB(0, 1), b2 + hstep, voffB);
            PG8_WAIT_V(6); PG8_BAR; PG8_MMA(1, 1, At, B1); PG8_BAR;
            PG8_LDB(B0, 1, 0); PG8_SCHED; PG8_LDA(At, 1, 0); PG8_STAGE_A(PG8_SA(0, 1), a2, 1, o2);
            PG8_WAIT_L(8); PG8_BAR; PG8_WAIT_L(0); PG8_MMA(0, 0, At, B0); PG8_BAR; PG8_SCHED;
            PG8_LDB(B1, 1, 1); PG8_STAGE(PG8_SB(1, 0), b3, voffB);
            PG8_BAR; PG8_WAIT_L(0); PG8_MMA(0, 1, At, B1); PG8_BAR;
            PG8_LDA(At, 1, 1); PG8_STAGE_A(PG8_SA(1, 0), a3, 0, o2);
            PG8_BAR; PG8_WAIT_L(0); PG8_MMA(1, 0, At, B0); PG8_BAR; PG8_SCHED;
            PG8_STAGE(PG8_SB(1, 1), b3 + hstep, voffB);
            PG8_WAIT_V(6); PG8_BAR; PG8_MMA(1, 1, At, B1); PG8_BAR;
            }
        }
        if constexpr (ALIGN_EPI) { if (wr == 0) PG8_BAR; }
        if constexpr (!Epi::AFTER_DRAIN) { E(acc, cur, wr, wc, fr, fq); S.done(cur); }
        if (!has_next) break;
#pragma unroll
        for (int a = 0; a < 2; ++a)
#pragma unroll
            for (int b = 0; b < 2; ++b)
#pragma unroll
                for (int m = 0; m < 4; ++m)
#pragma unroll
                    for (int n = 0; n < 2; ++n) acc[a][b][m][n] = (f32x4){0.f, 0.f, 0.f, 0.f};
        cur = nxt; cA = nA; cB = nB; ++ui;
        if constexpr (GATHER) {
#pragma unroll
            for (int h = 0; h < 2; ++h)
#pragma unroll
                for (int i = 0; i < 2; ++i) oc[h][i] = on[h][i];
        }
        if constexpr (ALIGN_EPI) { if (wr == 1) PG8_BAR; }
    }
    PG8_WAIT_V(0);
    if constexpr (!ALIGN_EPI) { if (wr == 0) PG8_BAR; }
    PG8_BAR;
    if constexpr (Epi::AFTER_DRAIN) { E.fused(acc, cur, wr, wc, fr, fq, lds, wid, lane); S.done(cur); }
#undef PG8_SA
#undef PG8_SB
#undef PG8_STAGE
#undef PG8_STAGE_A
#undef PG8_LDA
#undef PG8_LDB
#undef PG8_MMA
#undef PG8_WAIT_V
#undef PG8_WAIT_L
#undef PG8_BAR
#undef PG8_SCHED
}
}

#define LAS __attribute__((address_space(3)))
typedef unsigned short bf16;
typedef float f32x4 __attribute__((ext_vector_type(4)));
typedef unsigned u32x2 __attribute__((ext_vector_type(2)));
typedef unsigned u32x4 __attribute__((ext_vector_type(4)));
#define LDS_WAIT() asm volatile("s_waitcnt lgkmcnt(0)" ::: "memory")
__device__ __forceinline__ unsigned pk2(float lo, float hi) { return pg8::cvt_pk_bf16(lo, hi); }
__device__ __forceinline__ unsigned f2bf(float f) { return pk2(f, f) & 0xffffu; }
__device__ __forceinline__ float bflo(unsigned w) { return __builtin_bit_cast(float, w << 16); }
__device__ __forceinline__ float bfhi(unsigned w) { return __builtin_bit_cast(float, w & 0xffff0000u); }
__device__ __forceinline__ float wave_sum(float v) {
#pragma unroll
    for (int o = 1; o < 64; o <<= 1) v += __shfl_xor(v, o);
    return v;
}
__device__ __forceinline__ float frcp(float x) { return __builtin_amdgcn_rcpf(x); }
__device__ __forceinline__ float sigm(float x) { return frcp(1.0f + __expf(-x)); }
__device__ __forceinline__ float tanh_fast(float x) { const float e = __expf(2.0f * x); return 1.0f - 2.0f * frcp(e + 1.0f); }

constexpr size_t MiB = 1u << 20;
constexpr size_t RF = (size_t)T * D * 4;
constexpr size_t RB = (size_t)T * D * 2;
constexpr size_t WS_CTL = 0, CTL_ZERO_BYTES = 1 * MiB;
constexpr size_t WS_MODS = 1 * MiB;
constexpr size_t WS_XSA = 2 * MiB, WS_XSB = WS_XSA + RF;
constexpr size_t WS_XL = WS_XSB + RF;
constexpr size_t WS_RKV = WS_XL + 6 * RB;
constexpr size_t WS_L1 = WS_RKV + 3 * RF;
constexpr size_t WS_WDEC = WS_L1 + 50 * MiB;
constexpr size_t WS_AA = WS_WDEC + 2 * RF;
constexpr size_t WS_G = WS_AA + 2 * RF;
constexpr size_t WS_KK = WS_G + RB;
constexpr size_t WS_KD = WS_KK + RF;
constexpr size_t WS_BETA = WS_KD + 2 * RF;
constexpr size_t WS_RKB = WS_BETA + 2 * RF;
constexpr size_t WS_C12 = WS_RKB + 3 * MiB;
constexpr size_t WS_WRT = WS_C12 + 6 * MiB;
constexpr size_t WS_Y = WS_C12 + 9 * MiB;
constexpr size_t WS_Z = WS_Y + 2 * RF;
constexpr size_t WS_H2 = WS_Z + RB;
constexpr size_t WS_SLOTL = WS_H2 + RB;
constexpr size_t WS_GATEL = WS_SLOTL + 5 * MiB;
constexpr size_t WS_WRKV = WS_GATEL + 5 * MiB;
constexpr size_t WS_L2T = WS_WRKV + 15 * MiB;
constexpr size_t WS_WO = WS_L2T + 5 * MiB;
constexpr size_t WS_WIN = WS_WO + 4 * MiB;
constexpr size_t WS_WOUT = WS_WIN + 12 * MiB;
constexpr size_t WS_WGU = WS_WOUT + 4 * MiB;
constexpr size_t WS_WDN = WS_WGU + 512 * MiB;
constexpr size_t WS_END = WS_WDN + 256 * MiB;
constexpr size_t WS_INTER = WS_WDEC;
constexpr size_t WS_YS = WS_KD;
constexpr size_t WS_BG = WS_RKV, WS_CUZ = WS_RKV + RB;
constexpr size_t WS_RAWW = WS_AA, WS_RAWA = WS_AA + RF;
constexpr size_t WS_RH = WS_AA;
constexpr size_t WS_PM = WS_WDEC;
constexpr size_t WS_RKB1 = WS_C12 + 1 * MiB;
constexpr size_t WS_QT = WS_XL;
constexpr size_t WS_HT = WS_XL + RF;
static_assert((size_t)128 * 132 * 4096 * 2 <= RF, "chunk state tensors");
static_assert((size_t)MAXTILES * 256 * 1024 * 2 <= 4 * RF, "INTER overlay");
static_assert((size_t)T * 4 * 1024 * 2 <= 2 * RF, "YS overlay");
static_assert((size_t)3 * T * 256 * 2 <= 50 * MiB, "L1OUT");
constexpr int CW_BAR = 4096;
constexpr int CW_CNT = 16384, CNT_STRIDE = 64;

constexpr int RING_BYTES = 131072;
constexpr int LDSCTL_OFF = RING_BYTES;
constexpr int LDS_BYTES = 147456;

struct Args { const float* in[33]; float* out; unsigned char* ws; int ph_lo, ph_hi; };

__device__ __forceinline__ void transpose_item(const float* W, int N, bf16* WT, int dstK, int drow0, int k0, int n0, LAS float* scr, int lane) {
    float tv[32];
#pragma unroll
    for (int i = 0; i < 32; ++i) { const int kk = 2 * i + (lane >> 5); tv[i] = W[(size_t)(k0 + kk) * N + n0 + (lane & 31)]; }
#pragma unroll
    for (int i = 0; i < 32; ++i) { const int kk = 2 * i + (lane >> 5); scr[kk * 33 + (lane & 31)] = tv[i]; }
    LDS_WAIT(); asm volatile("" ::: "memory");
    const int c = lane & 7;
#pragma unroll
    for (int j = 0; j < 4; ++j) { const int n = (lane >> 3) + 8 * j; const LAS float* s = scr + (8 * c) * 33 + n;
        u32x4 o; o.x = pk2(s[0 * 33], s[1 * 33]); o.y = pk2(s[2 * 33], s[3 * 33]); o.z = pk2(s[4 * 33], s[5 * 33]); o.w = pk2(s[6 * 33], s[7 * 33]);
        *(u32x4*)(WT + (size_t)(drow0 + n) * dstK + k0 + 8 * c) = o; }
    LDS_WAIT(); asm volatile("" ::: "memory");
}
__device__ __forceinline__ int gu_map(int n0) { const int bj = n0 >= 1024 ? 1 : 0, f0 = n0 - bj * 1024; return (f0 >> 7) * 256 + bj * 128 + (f0 & 127); }
__device__ __forceinline__ int conv_map(int n0) { if (n0 < 1024) return n0; const int q = (n0 - 1024) >> 10, f0 = (n0 - 1024) & 1023; return 1024 + (f0 >> 7) * 256 + q * 128 + (f0 & 127); }

__device__ __forceinline__ void p0_prologue(const Args& a, LAS unsigned char* lds, int tid, int lane, int wave, int G) {
    unsigned char* ws = a.ws;
    LAS float* sl = (LAS float*)lds;
    LAS float* red = (LAS float*)(lds + 20480);
    for (int i = tid; i < 5 * 1024; i += 512) { const int r = i >> 10, k = i & 1023; const float cv = r < 4 ? a.in[1][r * 1024 + k] : a.in[3][k]; sl[i] = cv * sigm(cv); }
    __syncthreads();
    float* MODS = (float*)(ws + WS_MODS);
    for (int it = blockIdx.x; it < 4 * 96; it += G) {
        const int l = it / 96, n = (it % 96) * 64 + lane;
        const float* W = a.in[4] + (size_t)l * 1024 * 6144 + n;
        float acc[5] = {0.f, 0.f, 0.f, 0.f, 0.f};
        const int kb = wave * 128;
#pragma unroll 8
        for (int k = 0; k < 128; ++k) { const float wv = W[(size_t)(kb + k) * 6144];
#pragma unroll
            for (int r = 0; r < 5; ++r) acc[r] += sl[r * 1024 + kb + k] * wv; }
#pragma unroll
        for (int r = 0; r < 5; ++r) red[(wave * 5 + r) * 64 + lane] = acc[r];
        __syncthreads();
        if (wave < 5) { float s = a.in[5][l * 6144 + n];
#pragma unroll
            for (int w = 0; w < 8; ++w) s += red[(w * 5 + wave) * 64 + lane];
            MODS[(size_t)(l * 5 + wave) * 6144 + n] = s; }
        __syncthreads();
    }
    LAS float* scr = (LAS float*)(lds + 32768 + wave * 8448);
    const int gw = blockIdx.x * 8 + wave, NGW = G * 8;
    bf16* WRKV = (bf16*)(ws + WS_WRKV); bf16* WOt = (bf16*)(ws + WS_WO); bf16* WINt = (bf16*)(ws + WS_WIN); bf16* WOUTt = (bf16*)(ws + WS_WOUT);
    bf16* WGU = (bf16*)(ws + WS_WGU); bf16* WDN = (bf16*)(ws + WS_WDN);
    constexpr int I_GU = 128 * 1024, I_DN = 128 * 512, I_RKV = 6 * 512, I_WO = 2 * 512, I_WIN = 2 * 1536, I_WOUT = 2 * 512, I_W1 = 4 * 32, I_A1 = 4 * 32, I_G1 = 2 * 64;
    constexpr int NITEMS = I_GU + I_DN + I_RKV + I_WO + I_WIN + I_WOUT + I_W1 + I_A1 + I_G1;
    for (int it = gw; it < NITEMS; it += NGW) {
        int r = it;
        if (r < I_GU) { const int m = r >> 10, q = r & 1023, kb = q >> 6, nb = q & 63;
            transpose_item(a.in[29] + (size_t)m * 1024 * 2048, 2048, WGU + (size_t)m * 2048 * 1024, 1024, gu_map(nb * 32), kb * 64, nb * 32, scr, lane); continue; } r -= I_GU;
        if (r < I_DN) { const int m = r >> 9, q = r & 511, kb = q >> 5, nb = q & 31;
            transpose_item(a.in[31] + (size_t)m * 1024 * 1024, 1024, WDN + (size_t)m * 1024 * 1024, 1024, nb * 32, kb * 64, nb * 32, scr, lane); continue; } r -= I_DN;
        if (r < I_RKV) { const int m = r >> 9, q = r & 511, kb = q >> 5, nb = q & 31, lr = m / 3, j = m % 3;
            transpose_item(a.in[9] + (size_t)m * 1024 * 1024, 1024, WRKV + (size_t)lr * 3840 * 1024, 1024, j * 1024 + nb * 32, kb * 64, nb * 32, scr, lane); continue; } r -= I_RKV;
        if (r < I_WO) { const int m = r >> 9, q = r & 511, kb = q >> 5, nb = q & 31;
            transpose_item(a.in[23] + (size_t)m * 1024 * 1024, 1024, WOt + (size_t)m * 1024 * 1024, 1024, nb * 32, kb * 64, nb * 32, scr, lane); continue; } r -= I_WO;
        if (r < I_WIN) { const int m = r / 1536, q = r % 1536, kb = q / 96, nb = q % 96;
            transpose_item(a.in[24] + (size_t)m * 1024 * 3072, 3072, WINt + (size_t)m * 3072 * 1024, 1024, conv_map(nb * 32), kb * 64, nb * 32, scr, lane); continue; } r -= I_WIN;
        if (r < I_WOUT) { const int m = r >> 9, q = r & 511, kb = q >> 5, nb = q & 31;
            transpose_item(a.in[26] + (size_t)m * 1024 * 1024, 1024, WOUTt + (size_t)m * 1024 * 1024, 1024, nb * 32, kb * 64, nb * 32, scr, lane); continue; } r -= I_WOUT;
        if (r < I_W1) { const int m = r >> 5, q = r & 31, kb = q >> 1, nb = q & 1, lr = m >> 1, e = m & 1;
            transpose_item(a.in[11] + (size_t)m * 1024 * 64, 64, WRKV + (size_t)lr * 3840 * 1024, 1024, 3072 + e * 64 + nb * 32, kb * 64, nb * 32, scr, lane); continue; } r -= I_W1;
        if (r < I_A1) { const int m = r >> 5, q = r & 31, kb = q >> 1, nb = q & 1, lr = m >> 1, e = m & 1;
            transpose_item(a.in[14] + (size_t)m * 1024 * 64, 64, WRKV + (size_t)lr * 3840 * 1024, 1024, 3328 + e * 64 + nb * 32, kb * 64, nb * 32, scr, lane); continue; } r -= I_A1;
        { const int m = r >> 6, q = r & 63, kb = q >> 2, nb = q & 3;
            transpose_item(a.in[16] + (size_t)m * 1024 * 128, 128, WRKV + (size_t)m * 3840 * 1024, 1024, 3584 + nb * 32, kb * 64, nb * 32, scr, lane); }
    }
    const int gt = blockIdx.x * 512 + tid, NGT = G * 512;
    for (int i = gt; i < 2 * 3 * 128 * 128; i += NGT) {
        const int pc = i & 127, rw = (i >> 7) & 127, pd = (i >> 14) % 3, lr = i / (3 * 16384);
        *(u32x4*)(WRKV + ((size_t)lr * 3840 + 3072 + pd * 256 + 128 + rw) * 1024 + pc * 8) = (u32x4){0u, 0u, 0u, 0u}; }
    bf16* L2T = (bf16*)(ws + WS_L2T);
    for (int i = gt; i < 2 * 128 * 5120; i += NGT) {
        const int n = i % 5120, k = (i / 5120) & 127, lr = i / (5120 * 128);
        float v = 0.f;
        if (n < 2048) { const int e = n >> 10, d = n & 1023; if ((k >> 6) == e) v = a.in[12][(((size_t)lr * 2 + e) * 64 + (k & 63)) * 1024 + d]; }
        else if (n < 4096) { const int e = (n - 2048) >> 10, d = n & 1023; if ((k >> 6) == e) v = a.in[15][(((size_t)lr * 2 + e) * 64 + (k & 63)) * 1024 + d]; }
        else { const int d = n - 4096; v = a.in[17][((size_t)lr * 128 + k) * 1024 + d]; }
        L2T[((size_t)lr * 5120 + n) * 128 + k] = (bf16)f2bf(v);
    }
    bf16* WRT = (bf16*)(ws + WS_WRT);
    for (int i = gt; i < 4 * 32 * 1024; i += NGT) { const int k = i & 1023, e = (i >> 10) & 31, l = i >> 15;
        const float w = a.in[27][((size_t)l * 1024 + k) * 32 + e]; const unsigned hi = f2bf(w); const float lo = w - bflo(hi);
        WRT[((size_t)(l * 2 + 0) * 32 + e) * 1024 + k] = (bf16)hi; WRT[((size_t)(l * 2 + 1) * 32 + e) * 1024 + k] = (bf16)f2bf(lo); }
}
#define XB_TMO      128
#define XB_XCNT(j)  (256  + 64 * (j))
#define XB_XSUB(j)  (1280 + 64 * (j))
#define XB_XGEN(j)  (2304 + 64 * (j))
#define XB_TOP      3328
#define XB_TOPGEN   3392
#define XCD_BAR_WORDS 3456
#define XB_SPIN_CAP (1u << 23)

__device__ __forceinline__ unsigned xb_ld(unsigned* p)              { return __hip_atomic_load(p, __ATOMIC_RELAXED, __HIP_MEMORY_SCOPE_AGENT); }
__device__ __forceinline__ unsigned xb_add(unsigned* p, unsigned v) { return __hip_atomic_fetch_add(p, v, __ATOMIC_RELAXED, __HIP_MEMORY_SCOPE_AGENT); }
__device__ __forceinline__ unsigned xb_xcc_id() { return (unsigned)__builtin_amdgcn_s_getreg((3 << 11) | 20) & 0xFu; }
#define XB_SPIN(cond, bar) do { unsigned _sp = 0; while (cond) { __builtin_amdgcn_s_sleep(1); \
    if ((++_sp & 255u) == 0u) { if (xb_ld(&(bar)[XB_TMO])) break; if (_sp > XB_SPIN_CAP) { atomicAdd(&(bar)[XB_TMO], 1u); break; } } } } while (0)

struct XcdBarrier {
    unsigned wv;
    unsigned* bar; unsigned x;
    volatile LAS unsigned* st;
};

__device__ __forceinline__ XcdBarrier xcd_barrier_post(unsigned* bar, volatile LAS unsigned* st) {
    XcdBarrier b; b.wv = (unsigned)__builtin_amdgcn_readfirstlane((int)(threadIdx.x >> 6)); b.bar = bar; b.x = xb_xcc_id(); b.st = st;
    if (threadIdx.x == 0) (void)xb_add(&bar[XB_XCNT(b.x)], 1u);
    return b;
}
__device__ __forceinline__ void xcd_barrier_complete(unsigned* bar, unsigned x, unsigned& nloc, unsigned& nx) {
    const unsigned G = gridDim.x * gridDim.y * gridDim.z;
    unsigned sum, cnt, mine, sp = 0u;
    for (;;) {
        sum = 0u; cnt = 0u; mine = 0u;
#pragma unroll
        for (unsigned j = 0; j < 16; ++j) { const unsigned c = xb_ld(&bar[XB_XCNT(j)]); sum += c; cnt += (c > 0u) ? 1u : 0u; mine = (j == x) ? c : mine; }
        if (sum == G) break;
        __builtin_amdgcn_s_sleep(1);
        if ((++sp & 255u) == 0u) { if (xb_ld(&bar[XB_TMO])) break; if (sp > XB_SPIN_CAP) { atomicAdd(&bar[XB_TMO], 1u); break; } }
    }
    nloc = mine > 0u ? mine : 1u; nx = cnt > 0u ? cnt : 1u;
}

__device__ __forceinline__ void xcd_barrier(const XcdBarrier& b) {
    asm volatile("s_waitcnt vmcnt(0)" ::: "memory");
    __syncthreads();
    if (b.wv == 0u && lane_id() == 0) {
        unsigned* bar = b.bar;
        __builtin_amdgcn_s_waitcnt(0);
        unsigned nloc = b.st[0], nx = b.st[1];
        if (nloc == 0u) { xcd_barrier_complete(bar, b.x, nloc, nx); b.st[0] = nloc; b.st[1] = nx; }
        const unsigned old = xb_add(&bar[XB_XSUB(b.x)], 1u);
        const unsigned gen = old / nloc;
        if (old + 1u == (gen + 1u) * nloc) {
            __builtin_amdgcn_fence(__ATOMIC_RELEASE, "agent");
            asm volatile("s_waitcnt vmcnt(0)" ::: "memory");
            const unsigned og = xb_add(&bar[XB_TOP], 1u);
            const unsigned tg = og / nx;
            if (og + 1u == (tg + 1u) * nx) xb_add(&bar[XB_TOPGEN], 1u);
            else XB_SPIN(xb_ld(&bar[XB_TOPGEN]) == tg, bar);
            __builtin_amdgcn_fence(__ATOMIC_ACQUIRE, "agent");
            xb_add(&bar[XB_XGEN(b.x)], 1u);
            asm volatile("s_waitcnt vmcnt(0)" ::: "memory");
        } else {
            XB_SPIN(xb_ld(&bar[XB_XGEN(b.x)]) == gen, bar);
            __builtin_amdgcn_fence(__ATOMIC_ACQUIRE, "agent");
            asm volatile("s_waitcnt vmcnt(0)" ::: "memory");
        }
    }
    __syncthreads();
}

__device__ __forceinline__ int mod_row(int row) { return row < TL ? (row >> 13) : 4; }

__device__ __forceinline__ void load_x_combined(f32x4 (&x)[4], const float* xrow, bool has_prev, const bf16* YS, int t, const f32x4 (&m5)[4], int lane) {
#pragma unroll
    for (int j = 0; j < 4; ++j) x[j] = *(const f32x4*)(xrow + 256 * j + 4 * lane);
    if (has_prev) {
        f32x4 s[4];
#pragma unroll
        for (int j = 0; j < 4; ++j) s[j] = (f32x4){0.f, 0.f, 0.f, 0.f};
#pragma unroll
        for (int k = 0; k < 4; ++k) { const bf16* yr = YS + ((size_t)t * 4 + k) * 1024;
#pragma unroll
            for (int j = 0; j < 4; ++j) { const u32x2 w = *(const u32x2*)(yr + 256 * j + 4 * lane); s[j] += (f32x4){bflo(w.x), bfhi(w.x), bflo(w.y), bfhi(w.y)}; } }
#pragma unroll
        for (int j = 0; j < 4; ++j) x[j] += m5[j] * s[j];
    }
}
__device__ __forceinline__ float row_rstd(const f32x4 (&x)[4]) {
    float ss = 0.f;
#pragma unroll
    for (int j = 0; j < 4; ++j) ss += (x[j].x * x[j].x + x[j].y * x[j].y) + (x[j].z * x[j].z + x[j].w * x[j].w);
    return rsqrtf(wave_sum(ss) * (1.0f / 1024.0f) + 1e-6f);
}

__device__ __forceinline__ void phase_a_rwkv(const Args& a, int layer, LAS unsigned char* lds, int tid, int gw, int NGW, int lane) {
    unsigned char* ws = a.ws; const int lj = layer >> 1; const bool has_prev = layer > 0;
    const float* xin_lat = layer == 0 ? a.in[0] : (const float*)(ws + WS_XSA);
    const float* xin_ctx = layer == 0 ? a.in[2] : (const float*)(ws + WS_XSA) + (size_t)TL * D;
    float* xout = (float*)(ws + (layer == 0 ? WS_XSA : WS_XSB));
    const float* MODS = (const float*)(ws + WS_MODS); const bf16* YS = (const bf16*)(ws + WS_YS); bf16* XL = (bf16*)(ws + WS_XL);
    const float* mug = a.in[8] + (size_t)lj * 6 * 2 * 1024; const float* ng = a.in[6] + (size_t)(layer * 2 + 0) * 1024;
    LAS float* mu = (LAS float*)lds;
    for (int i = tid; i < 6 * 2 * 1024 / 4; i += 512) ((LAS f32x4*)mu)[i] = ((const f32x4*)mug)[i];
    __syncthreads();
    for (int it = gw; it < TL / 8 + TC / 2; it += NGW) {
        const int ntok = it < TL / 8 ? 8 : 2, t0 = it < TL / 8 ? it * 8 : TL + (it - TL / 8) * 2, mr = mod_row(t0);
        int rs, re; if (t0 < TL) { rs = t0 & ~63; re = rs + 63; } else { const int loc = t0 - TL; rs = TL + (loc & ~255); re = rs + 255; }
        const float* mod = MODS + (size_t)(layer * 5 + mr) * 6144;
        const float* m5p = MODS + (size_t)((has_prev ? layer - 1 : 0) * 5 + mr) * 6144 + 5 * 1024;
        f32x4 hm[4], h0[4], hp[4];
#pragma unroll
        for (int j = 0; j < 4; ++j) { hm[j] = (f32x4){0.f, 0.f, 0.f, 0.f}; h0[j] = hm[j]; hp[j] = hm[j]; }
        f32x4 rx[4], nx[4]; u32x2 ry[4][4], ny[4][4];
#define PA_LOAD(X, Y, tt) do { const int t_ = (tt); if (t_ >= rs && t_ <= re) { \
            const float* xrow_ = t_ < TL ? xin_lat + (size_t)t_ * D : xin_ctx + (size_t)(t_ - TL) * D; \
            _Pragma("unroll") for (int j = 0; j < 4; ++j) X[j] = *(const f32x4*)(xrow_ + 256 * j + 4 * lane); \
            if (has_prev) { _Pragma("unroll") for (int k = 0; k < 4; ++k) _Pragma("unroll") for (int j = 0; j < 4; ++j) Y[k][j] = *(const u32x2*)(YS + ((size_t)t_ * 4 + k) * 1024 + 256 * j + 4 * lane); } } } while (0)
#pragma unroll
        for (int j = 0; j < 4; ++j) { rx[j] = (f32x4){0.f, 0.f, 0.f, 0.f}; nx[j] = rx[j];
#pragma unroll
            for (int k = 0; k < 4; ++k) { ry[k][j] = (u32x2){0u, 0u}; ny[k][j] = ry[k][j]; } }
        PA_LOAD(rx, ry, t0 - 1);
#pragma unroll 1
        for (int i = -1; i <= ntok; ++i) {
            const int t = t0 + i;
            if (i < ntok) PA_LOAD(nx, ny, t + 1);
            f32x4 hn[4];
            if (t >= rs && t <= re) {
                f32x4 x[4];
#pragma unroll
                for (int j = 0; j < 4; ++j) x[j] = rx[j];
                if (has_prev) {
#pragma unroll
                    for (int j = 0; j < 4; ++j) { f32x4 sm = (f32x4){0.f, 0.f, 0.f, 0.f};
#pragma unroll
                        for (int k = 0; k < 4; ++k) sm += (f32x4){bflo(ry[k][j].x), bfhi(ry[k][j].x), bflo(ry[k][j].y), bfhi(ry[k][j].y)};
                        x[j] += *(const f32x4*)(m5p + 256 * j + 4 * lane) * sm; } }
                if (i >= 0 && i < ntok) {
#pragma unroll
                    for (int j = 0; j < 4; ++j) *(f32x4*)(xout + (size_t)t * D + 256 * j + 4 * lane) = x[j]; }
                const float rstd = row_rstd(x);
#pragma unroll
                for (int j = 0; j < 4; ++j) { const int col = 256 * j + 4 * lane; hn[j] = x[j] * rstd * *(const f32x4*)(ng + col) * (*(const f32x4*)(mod + 1024 + col) + 1.0f) + *(const f32x4*)(mod + col); }
            } else {
#pragma unroll
                for (int j = 0; j < 4; ++j) hn[j] = (f32x4){0.f, 0.f, 0.f, 0.f};
            }
#pragma unroll
            for (int j = 0; j < 4; ++j) { hm[j] = h0[j]; h0[j] = hp[j]; hp[j] = hn[j]; rx[j] = nx[j];
#pragma unroll
                for (int k = 0; k < 4; ++k) ry[k][j] = ny[k][j]; }
            if (i >= 1) {
                const int te = t - 1;
#pragma unroll
                for (int q = 0; q < 6; ++q) {
                    bf16* orow = XL + ((size_t)q * T + te) * D;
#pragma unroll
                    for (int j = 0; j < 4; ++j) { const int col = 256 * j + 4 * lane;
                        const f32x4 m0 = *(const LAS f32x4*)(mu + (q * 2 + 0) * 1024 + col), m1 = *(const LAS f32x4*)(mu + (q * 2 + 1) * 1024 + col);
                        const f32x4 o = h0[j] + m0 * (hm[j] - h0[j]) + m1 * (hp[j] - h0[j]);
                        u32x2 w; w.x = pk2(o.x, o.y); w.y = pk2(o.z, o.w); *(u32x2*)(orow + col) = w; }
                }
            }
        }
#undef PA_LOAD
    }
}
__device__ __forceinline__ void phase_a_conv(const Args& a, int layer, int rows, int gw, int NGW, int lane) {
    unsigned char* ws = a.ws;
    float* xs = (float*)(ws + (layer < 2 ? WS_XSA : WS_XSB));
    const float* MODS = (const float*)(ws + WS_MODS); const bf16* YS = (const bf16*)(ws + WS_YS); bf16* H = (bf16*)(ws + WS_XL);
    const float* ng = a.in[6] + (size_t)(layer * 2 + 0) * 1024;
    for (int t = gw; t < rows; t += NGW) {
        const int mr = mod_row(t);
        const float* mod = MODS + (size_t)(layer * 5 + mr) * 6144;
        f32x4 m5[4], x[4];
#pragma unroll
        for (int j = 0; j < 4; ++j) m5[j] = *(const f32x4*)(MODS + (size_t)((layer - 1) * 5 + mr) * 6144 + 5 * 1024 + 256 * j + 4 * lane);
        load_x_combined(x, xs + (size_t)t * D, true, YS, t, m5, lane);
        const float rstd = row_rstd(x);
#pragma unroll
        for (int j = 0; j < 4; ++j) { const int col = 256 * j + 4 * lane;
            *(f32x4*)(xs + (size_t)t * D + col) = x[j];
            const f32x4 h = x[j] * rstd * *(const f32x4*)(ng + col) * (*(const f32x4*)(mod + 1024 + col) + 1.0f) + *(const f32x4*)(mod + col);
            u32x2 w; w.x = pk2(h.x, h.y); w.y = pk2(h.z, h.w); *(u32x2*)(H + (size_t)t * D + col) = w; }
    }
}
#define DPPF(x, ctrl) __builtin_bit_cast(float, __builtin_amdgcn_update_dpp(0, __builtin_bit_cast(int, (x)), (ctrl), 0xf, 0xf, false))
__device__ __forceinline__ float row16_sum(float v) { v += DPPF(v, 0xB1); v += DPPF(v, 0x4E); v += DPPF(v, 0x141); v += DPPF(v, 0x140); return v; }
__device__ __forceinline__ f32x4 bf4(u32x2 w) { return (f32x4){bflo(w.x), bfhi(w.x), bflo(w.y), bfhi(w.y)}; }
__device__ __forceinline__ u32x2 pk4(f32x4 v) { u32x2 w; w.x = pk2(v[0], v[1]); w.y = pk2(v[2], v[3]); return w; }
__device__ __forceinline__ void phase_c_prep(const Args& a, int lj, LAS unsigned char* lds, int tid, int gw, int NGW, int lane) {
    unsigned char* ws = a.ws;
    const bf16* Rr = (const bf16*)(ws + WS_RKV); const bf16* Kk = Rr + (size_t)T * D; const bf16* RA = (const bf16*)(ws + WS_RAWA); const bf16* RW = (const bf16*)(ws + WS_RAWW);
    bf16* KK = (bf16*)(ws + WS_KK); bf16* KD = (bf16*)(ws + WS_KD); bf16* BE = (bf16*)(ws + WS_BETA); float* RKB = (float*)(ws + WS_RKB);
    LAS float* tb = (LAS float*)lds;
    for (int i = tid; i < 7 * 256; i += 512) { const int t7 = i >> 8, q = i & 255;
        const float* src = t7 == 0 ? a.in[18] + lj * 1024 : t7 == 1 ? a.in[19] + lj * 1024 : t7 == 2 ? a.in[20] + lj * 1024 : t7 < 5 ? a.in[10] + lj * 2048 + (t7 - 3) * 1024 : a.in[13] + lj * 2048 + (t7 - 5) * 1024;
        ((LAS f32x4*)tb)[i] = ((const f32x4*)src)[q]; }
    __syncthreads();
    for (int row = gw; row < T; row += NGW) {
#pragma unroll
        for (int j = 0; j < 4; ++j) {
            const int col = 256 * j + 4 * lane; const size_t ro = (size_t)row * D + col;
            const f32x4 k = bf4(*(const u32x2*)(Kk + ro)), r = bf4(*(const u32x2*)(Rr + ro));
            f32x4 a0 = bf4(*(const u32x2*)(RA + ro)) + *(const LAS f32x4*)(tb + 5 * 1024 + col), a1 = bf4(*(const u32x2*)(RA + (size_t)T * D + ro)) + *(const LAS f32x4*)(tb + 6 * 1024 + col);
#pragma unroll
            for (int z = 0; z < 4; ++z) { a0[z] = sigm(a0[z]); a1[z] = sigm(a1[z]); }
            const f32x4 ck = *(const LAS f32x4*)(tb + col), ca = *(const LAS f32x4*)(tb + 1024 + col), cr = *(const LAS f32x4*)(tb + 2048 + col);
            const f32x4 kk = k * ck;
            const float ss = row16_sum((kk.x * kk.x + kk.y * kk.y) + (kk.z * kk.z + kk.w * kk.w));
            const f32x4 kd0 = k * ((a0 - 1.0f) * ca + 1.0f), kd1 = k * ((a1 - 1.0f) * ca + 1.0f);
            *(u32x2*)(KD + ro) = pk4(kd0); *(u32x2*)(KD + (size_t)T * D + ro) = pk4(kd1);
            const f32x4 p = r * (kd0 + kd1) * cr;
            const float rk = row16_sum((p.x + p.y) + (p.z + p.w));
            const f32x4 kkn = kk * fminf(__builtin_amdgcn_rsqf(ss), 1e12f);
            *(u32x2*)(KK + ro) = pk4(kkn); *(u32x2*)(BE + ro) = pk4(kkn * a0); *(u32x2*)(BE + (size_t)T * D + ro) = pk4(kkn * a1);
            if ((lane & 15) == 0) RKB[(size_t)row * 16 + 4 * j + (lane >> 4)] = rk;
        }
    }
}
typedef short bf16x8 __attribute__((ext_vector_type(8)));
__device__ __forceinline__ f32x4 mfma16(bf16x8 a, bf16x8 b, f32x4 c) { return __builtin_amdgcn_mfma_f32_16x16x32_bf16(a, b, c, 0, 0, 0); }
__device__ __forceinline__ bf16x8 as_frag(u32x4 w) { return __builtin_bit_cast(bf16x8, w); }
constexpr int CH_LD = 144;
constexpr int CH_MS = 64 * CH_LD;
constexpr int CH_AB = 0 * CH_MS, CH_KT = 1 * CH_MS, CH_BT = 2 * CH_MS, CH_RB = 3 * CH_MS, CH_VT = 4 * CH_MS, CH_ABT = 5 * CH_MS, CH_KHT = 6 * CH_MS, CH_BHT = 7 * CH_MS,
              CH_LK = 8 * CH_MS, CH_LB = 9 * CH_MS, CH_MK = 10 * CH_MS, CH_MB = 11 * CH_MS, CH_WT = 12 * CH_MS, CH_U0 = 13 * CH_MS, CH_DINV = 14 * CH_MS;
constexpr int CH_GC = LDSCTL_OFF + 2048;
constexpr int CH_PART = LDSCTL_OFF + 4096;
constexpr int NCHUNK = NSTEP / 64;
#ifndef S1_DBL
#define S1_DBL 0
#endif
static_assert(CH_DINV + 2048 <= RING_BYTES, "chunk LDS map");

__device__ __forceinline__ int scan_row(int s, int dir, int b) {
    if (s < CTXL) return TL + b * CTXL + (dir ? CTXL - 1 - s : s);
    const int i = s - CTXL; return b * SEQ + (dir ? SEQ - 1 - i : i);
}
#define CH_FRAG(mat, row, ks, kg) as_frag(*(const LAS u32x4*)(lds + (mat) + (row) * CH_LD + ((ks) * 32 + (kg) * 8) * 2))

__device__ __forceinline__ float s1_treduce16(const float (&a)[16], bool b3, bool b2) {
    float b[8];
#pragma unroll
    for (int i = 0; i < 8; ++i) { float x = a[i], y = a[i + 8];
        asm("s_nop 1\n\tv_permlane32_swap_b32 %0, %1" : "+v"(x), "+v"(y));
        b[i] = x + y; }
    float c[4];
#pragma unroll
    for (int i = 0; i < 4; ++i) { float x = b[i], y = b[i + 4];
        asm("s_nop 1\n\tv_permlane16_swap_b32 %0, %1" : "+v"(x), "+v"(y));
        c[i] = x + y; }
    float d[2];
#pragma unroll
    for (int i = 0; i < 2; ++i) { const float keep = b3 ? c[i + 2] : c[i], send = b3 ? c[i] : c[i + 2]; d[i] = keep + DPPF(send, 0x128); }
    const float keep = b2 ? d[1] : d[0], send = b2 ? d[0] : d[1];
    float e = keep + DPPF(send, 0x141);
    e += DPPF(e, 0xB1);
    e += DPPF(e, 0x4E);
    return e;
}
#define S1_BAR() do { asm volatile("s_waitcnt lgkmcnt(0)" ::: "memory"); __builtin_amdgcn_s_barrier(); asm volatile("" ::: "memory"); } while (0)
__device__ __forceinline__ void phase_s1_chunks(const Args& a, int lj, LAS unsigned char* lds, int tid, int G, int rh_scratch = 0) {
    unsigned char* ws = a.ws; const float* w0l = a.in[10] + lj * 2048; const float* a0l = a.in[13] + lj * 2048;
    const float* pkk = a.in[18] + lj * 1024; const float* pka = a.in[19] + lj * 1024; const float* prk = a.in[20] + lj * 1024;
    const int lane = tid & 63, wave = __builtin_amdgcn_readfirstlane(tid >> 6), l15 = lane & 15, g = lane >> 4;
    LAS float* part = (LAS float*)(lds + CH_PART); LAS float* gammaC = (LAS float*)(lds + CH_GC);
    unsigned nlw[8], nka[8], nkr[8], nrr[8], nvv[8]; float nw0 = 0.f, na0 = 0.f, npkk = 0.f, npka = 0.f, nprk = 0.f;
    typedef const __attribute__((address_space(1))) unsigned short* GUS;
#define S1_LOAD(ctx_) do { unsigned char* wsl = ws; asm volatile("" : "+s"(wsl));     \
        const int chain_ = (ctx_) / NCHUNK, c_ = (ctx_) - chain_ * NCHUNK, dir_ = chain_ >> 6, b_ = (chain_ >> 4) & 3, h_ = chain_ & 15; \
          \
        const long o0 = (long)scan_row(64 * c_ + 8 * wave, dir_, b_) * D + h_ * 64 + lane, od = (long)dir_ * T * D, st = dir_ ? -(long)D : (long)D; \
        const bf16* LWp = (const bf16*)(wsl + WS_RAWW) + od + o0; const bf16* RAp = (const bf16*)(wsl + WS_RAWA) + od + o0; \
        const bf16* Rp = (const bf16*)(wsl + WS_RKV) + o0; const bf16* Kp = Rp + (size_t)T * D; const bf16* Vp = Rp + (size_t)2 * T * D; \
        nw0 = w0l[dir_ * 1024 + h_ * 64 + lane]; na0 = a0l[dir_ * 1024 + h_ * 64 + lane]; npkk = pkk[h_ * 64 + lane]; npka = pka[h_ * 64 + lane]; nprk = prk[h_ * 64 + lane]; \
        _Pragma("unroll") for (int j = 0; j < 8; ++j) { const long oj = st * j; \
            nlw[j] = ((GUS)LWp)[oj]; nka[j] = ((GUS)RAp)[oj]; nkr[j] = ((GUS)Kp)[oj]; nrr[j] = ((GUS)Rp)[oj]; nvv[j] = ((GUS)Vp)[oj]; } } while (0)
    unsigned clw[8], cka_[8], ckr[8], crr[8], cvv[8]; float cw0 = 0.f, ca0 = 0.f, cpkk = 0.f, cpka = 0.f, cprk = 0.f;
#define S1_TAKE() do { _Pragma("unroll") for (int j = 0; j < 8; ++j) { clw[j] = nlw[j]; cka_[j] = nka[j]; ckr[j] = nkr[j]; crr[j] = nrr[j]; cvv[j] = nvv[j]; } \
        cw0 = nw0; ca0 = na0; cpkk = npkk; cpka = npka; cprk = nprk; \
        _Pragma("unroll") for (int j = 0; j < 8; ++j) asm volatile("" : "+v"(clw[j]), "+v"(cka_[j]), "+v"(ckr[j]), "+v"(crr[j]), "+v"(cvv[j]) :: "memory"); \
        asm volatile("" : "+v"(cw0), "+v"(ca0), "+v"(cpkk), "+v"(cpka), "+v"(cprk) :: "memory"); } while (0)
    if ((int)blockIdx.x < 128 * NCHUNK) { S1_LOAD((int)blockIdx.x); S1_TAKE(); if ((int)blockIdx.x + G < 128 * NCHUNK) S1_LOAD((int)blockIdx.x + G); }
    for (int ct = blockIdx.x; ct < 128 * NCHUNK; ct += G) {
        const int chain = ct / NCHUNK, c = ct - chain * NCHUNK, dir = chain >> 6, b = (chain >> 4) & 3, h = chain & 15;
        unsigned zq = 0u; asm volatile("" : "+v"(zq));
        {
            const int k = lane, tq = wave;
            float lw[8], kd[8], be[8], kk[8], rr[8], vv[8];
            {
                const float w0k = cw0, a0k = ca0, ckk = cpkk, cka = cpka, crk = cprk;
                float* RKBd = (float*)(ws + (dir ? WS_RKB1 : WS_RKB));
                const int row0 = scan_row(64 * c + 8 * tq, dir, b), rst = dir ? -1 : 1;
                float av[8], kq[8], red[16];
#pragma unroll
                for (int j = 0; j < 8; ++j) { av[j] = sigm(bflo(cka_[j]) + a0k); const float kr = bflo(ckr[j]);
                    lw[j] = -0.60653066f * sigm(bflo(clw[j]) + w0k);
                    kq[j] = kr * ckk; kd[j] = kr * ((av[j] - 1.0f) * cka + 1.0f); rr[j] = bflo(crr[j]); vv[j] = bflo(cvv[j]);
                    red[2 * j] = kq[j] * kq[j]; red[2 * j + 1] = rr[j] * kd[j] * crk; }
                const float tot = s1_treduce16(red, (lane & 8) != 0, (lane & 4) != 0);
                if ((lane & 7) == 4) RKBd[(size_t)(row0 + rst * (lane >> 3)) * 16 + h] = tot;
#pragma unroll
                for (int j = 0; j < 8; ++j) { const float ss = __builtin_bit_cast(float, __builtin_amdgcn_readlane(__builtin_bit_cast(int, tot), 8 * j));
                    kk[j] = kq[j] * fminf(__builtin_amdgcn_rsqf(ss), 1e12f);     be[j] = kk[j] * av[j]; }
            }
            for (int r0_ = 0; r0_ <= ((S1_DBL >> 3) & 1); ++r0_) { if (r0_) S1_BAR();
            float p[8]; p[0] = lw[0];
#pragma unroll
            for (int j = 1; j < 8; ++j) p[j] = p[j - 1] + lw[j];
            part[tq * 64 + k] = p[7];
            S1_BAR();
            float off = 0.f, tot = 0.f;
#pragma unroll
            for (int q = 0; q < 8; ++q) { const float pv = part[q * 64 + k]; tot += pv; off += q < tq ? pv : 0.f; }
            const float eTot = __expf(tot); float ePrev = __expf(off);
            if (tq == 0) gammaC[k] = eTot;
            unsigned abw[4], khw[4], bhw[4], vw[4];
#pragma unroll
            for (int j = 0; j < 8; j += 2) {
                float ab2[2], kt2[2], bt2[2], rb2[2], kh2[2], bh2[2];
#pragma unroll
                for (int z = 0; z < 2; ++z) { const float cu = off + p[j + z]; const float eP = __expf(cu), eM = __expf(-cu), eC = eTot * eM;
                    ab2[z] = kk[j + z] * ePrev; ePrev = eP; kt2[z] = kd[j + z] * eM; bt2[z] = be[j + z] * eM; rb2[z] = rr[j + z] * eP; kh2[z] = kd[j + z] * eC; bh2[z] = be[j + z] * eC;
                }
                abw[j >> 1] = pk2(ab2[0], ab2[1]); khw[j >> 1] = pk2(kh2[0], kh2[1]); bhw[j >> 1] = pk2(bh2[0], bh2[1]); vw[j >> 1] = pk2(vv[j], vv[j + 1]);
                {
                    const unsigned ktw = pk2(kt2[0], kt2[1]), btw = pk2(bt2[0], bt2[1]), rbw = pk2(rb2[0], rb2[1]), aw = abw[j >> 1];
                    const int t = 8 * tq + j;
                    *(LAS bf16*)(lds + CH_AB + t * CH_LD + k * 2) = (bf16)aw; *(LAS bf16*)(lds + CH_AB + (t + 1) * CH_LD + k * 2) = (bf16)(aw >> 16);
                    *(LAS bf16*)(lds + CH_KT + t * CH_LD + k * 2) = (bf16)ktw; *(LAS bf16*)(lds + CH_KT + (t + 1) * CH_LD + k * 2) = (bf16)(ktw >> 16);
                    *(LAS bf16*)(lds + CH_BT + t * CH_LD + k * 2) = (bf16)btw; *(LAS bf16*)(lds + CH_BT + (t + 1) * CH_LD + k * 2) = (bf16)(btw >> 16);
                    *(LAS bf16*)(lds + CH_RB + t * CH_LD + k * 2) = (bf16)rbw; *(LAS bf16*)(lds + CH_RB + (t + 1) * CH_LD + k * 2) = (bf16)(rbw >> 16); }
            }
            *(LAS u32x4*)(lds + CH_ABT + k * CH_LD + tq * 16) = (u32x4){abw[0], abw[1], abw[2], abw[3]};
            *(LAS u32x4*)(lds + CH_KHT + k * CH_LD + tq * 16) = (u32x4){khw[0], khw[1], khw[2], khw[3]};
            *(LAS u32x4*)(lds + CH_BHT + k * CH_LD + tq * 16) = (u32x4){bhw[0], bhw[1], bhw[2], bhw[3]};
            *(LAS u32x4*)(lds + CH_VT + k * CH_LD + tq * 16) = (u32x4){vw[0], vw[1], vw[2], vw[3]};
            *(LAS u32x4*)(lds + CH_WT + k * CH_LD + tq * 16) = (u32x4){zq, zq, zq, zq}; *(LAS u32x4*)(lds + CH_U0 + k * CH_LD + tq * 16) = (u32x4){zq, zq, zq, zq};
            }
        }
        S1_BAR();
        for (int r1_ = 0; r1_ <= (S1_DBL & 1); ++r1_) { if (r1_) S1_BAR();
            const int mi = wave >> 1, half = wave & 1;
            const int matS = (mi & 1) ? CH_BT : CH_KT, matT = (mi & 2) ? CH_RB : CH_AB, matO = CH_LK + mi * CH_MS;
            const bool incl = (mi & 2) != 0;
            bf16x8 fs[4][2], ft[2][2];
#pragma unroll
            for (int ms = 0; ms < 4; ++ms)
#pragma unroll
                for (int ks = 0; ks < 2; ++ks) fs[ms][ks] = CH_FRAG(matS, 16 * ms + l15, ks, g);
#pragma unroll
            for (int nt = 0; nt < 2; ++nt)
#pragma unroll
                for (int ks = 0; ks < 2; ++ks) ft[nt][ks] = CH_FRAG(matT, 32 * half + 16 * nt + l15, ks, g);
#pragma unroll
            for (int nt = 0; nt < 2; ++nt) { const int t = 32 * half + 16 * nt + l15;
#pragma unroll
                for (int ms = 0; ms < 4; ++ms) { f32x4 d = (f32x4){0.f, 0.f, 0.f, 0.f};
                    d = mfma16(fs[ms][0], ft[nt][0], d); d = mfma16(fs[ms][1], ft[nt][1], d);
                    const int s0 = 16 * ms + 4 * g;
#pragma unroll
                    for (int i = 0; i < 4; ++i) { const bool keep = incl ? (s0 + i <= t) : (s0 + i < t); d[i] = keep ? d[i] : __builtin_bit_cast(float, zq); }
                    u32x2 w; w.x = pk2(d[0], d[1]); w.y = pk2(d[2], d[3]);
                    *(LAS u32x2*)(lds + matO + t * CH_LD + s0 * 2) = w; } }
        }
        S1_BAR();
        f32x4 rhsU[4];
#pragma unroll
        for (int I = 0; I < 4; ++I) rhsU[I] = (f32x4){0.f, 0.f, 0.f, 0.f};
        if (wave >= 4) {
            const int ctv = (wave & 3) * 16;
            const bf16x8 fv0 = CH_FRAG(CH_VT, ctv + l15, 0, g), fv1 = CH_FRAG(CH_VT, ctv + l15, 1, g);
#pragma unroll
            for (int I = 0; I < 4; ++I) { f32x4 d = (f32x4){0.f, 0.f, 0.f, 0.f};
                d = mfma16(CH_FRAG(CH_LK, 16 * I + l15, 0, g), fv0, d); d = mfma16(CH_FRAG(CH_LK, 16 * I + l15, 1, g), fv1, d); rhsU[I] = -d; }
        }
        for (int r2_ = 0; r2_ <= ((S1_DBL >> 1) & 1); ++r2_) if (wave == 0) {
            const int bb = lane >> 4, j = lane & 15;
            float x[16];
#pragma unroll
            for (int t = 0; t < 16; ++t) {
                const u32x4 r0 = *(const LAS u32x4*)(lds + CH_LB + (16 * bb + t) * CH_LD + 32 * bb), r1 = *(const LAS u32x4*)(lds + CH_LB + (16 * bb + t) * CH_LD + 32 * bb + 16);
                const unsigned rw[8] = {r0.x, r0.y, r0.z, r0.w, r1.x, r1.y, r1.z, r1.w};
                float acc = (t == j) ? 1.0f : 0.0f;
#pragma unroll
                for (int s = 0; s < t; ++s) { const float lv = (s & 1) ? bfhi(rw[s >> 1]) : bflo(rw[s >> 1]); acc -= lv * x[s]; }
                x[t] = acc;
                *(LAS bf16*)(lds + CH_DINV + ((bb * 16 + t) * 16 + j) * 2) = (bf16)f2bf(acc);
            }
        }
        S1_BAR();
        {
            const int matZ = wave < 4 ? CH_WT : CH_U0, ct16 = (wave & 3) * 16;
            for (int r4_ = 0; r4_ <= ((S1_DBL >> 4) & 1); ++r4_) { if (r4_) { *(LAS u32x4*)(lds + matZ + (ct16 + l15) * CH_LD + g * 32) = (u32x4){zq, zq, zq, zq}; *(LAS u32x4*)(lds + matZ + (ct16 + l15) * CH_LD + g * 32 + 16) = (u32x4){zq, zq, zq, zq}; LDS_WAIT(); }
#pragma unroll
            for (int I = 0; I < 4; ++I) {
                f32x4 rhs;
                if (wave < 4) { const u32x2 w = *(const LAS u32x2*)(lds + CH_ABT + (ct16 + l15) * CH_LD + (16 * I + 4 * g) * 2); rhs = (f32x4){bflo(w.x), bfhi(w.x), bflo(w.y), bfhi(w.y)}; }
                else rhs = rhsU[I];
                f32x4 d = (f32x4){0.f, 0.f, 0.f, 0.f};
                d = mfma16(CH_FRAG(CH_LB, 16 * I + l15, 0, g), CH_FRAG(matZ, ct16 + l15, 0, g), d); d = mfma16(CH_FRAG(CH_LB, 16 * I + l15, 1, g), CH_FRAG(matZ, ct16 + l15, 1, g), d);
                const f32x4 ac = rhs - d;
                const u32x2 dv = *(const LAS u32x2*)(lds + CH_DINV + ((I * 16 + l15) * 16 + 4 * g) * 2);
                const bf16x8 fa = as_frag((u32x4){dv.x, dv.y, zq, zq}), fb = as_frag((u32x4){pk2(ac[0], ac[1]), pk2(ac[2], ac[3]), zq, zq});
                const f32x4 z = mfma16(fa, fb, (f32x4){0.f, 0.f, 0.f, 0.f});
                u32x2 w; w.x = pk2(z[0], z[1]); w.y = pk2(z[2], z[3]);
                *(LAS u32x2*)(lds + matZ + (ct16 + l15) * CH_LD + (16 * I + 4 * g) * 2) = w;
                LDS_WAIT(); asm volatile("" ::: "memory");
            }
            }
        }
        S1_BAR();
        if (ct + G < 128 * NCHUNK) { S1_TAKE(); if (ct + 2 * G < 128 * NCHUNK) S1_LOAD(ct + 2 * G); }
        for (int r3_ = 0; r3_ <= ((S1_DBL >> 2) & 1); ++r3_) { if (r3_) S1_BAR();
            const int rt = wave >> 1, cp = (wave & 1) * 2;
            unsigned char* wsl = ws; asm volatile("" : "+s"(wsl));
            bf16* YL = (bf16*)(wsl + WS_Y); bf16* RH = (bf16*)(wsl + (rh_scratch ? WS_BETA + RF : WS_RH)); bf16* PM = (bf16*)(wsl + WS_PM); bf16* QT = (bf16*)(wsl + WS_QT);
            const int trow = scan_row(64 * c + 16 * rt + l15, dir, b);
#pragma unroll
            for (int q = 0; q < 2; ++q) { const int vt = cp + q; f32x4 d = (f32x4){0.f, 0.f, 0.f, 0.f};
#pragma unroll
                for (int ks = 0; ks < 2; ++ks) { d = mfma16(CH_FRAG(CH_VT, 16 * vt + l15, ks, g), CH_FRAG(CH_MK, 16 * rt + l15, ks, g), d); d = mfma16(CH_FRAG(CH_U0, 16 * vt + l15, ks, g), CH_FRAG(CH_MB, 16 * rt + l15, ks, g), d); }
                *(u32x2*)(YL + ((size_t)dir * T + trow) * D + h * 64 + 16 * vt + 4 * g) = pk4(d); }
#pragma unroll
            for (int q = 0; q < 2; ++q) { const int kt = cp + q; f32x4 d = (f32x4){0.f, 0.f, 0.f, 0.f};
#pragma unroll
                for (int ks = 0; ks < 2; ++ks) d = mfma16(CH_FRAG(CH_WT, 16 * kt + l15, ks, g), CH_FRAG(CH_MB, 16 * rt + l15, ks, g), d);
                const u32x2 rbw = *(const LAS u32x2*)(lds + CH_RB + (16 * rt + l15) * CH_LD + (16 * kt + 4 * g) * 2);
                u32x2 w; w.x = pk2(bflo(rbw.x) - d[0], bfhi(rbw.x) - d[1]); w.y = pk2(bflo(rbw.y) - d[2], bfhi(rbw.y) - d[3]);
                *(u32x2*)(RH + ((size_t)dir * T + trow) * D + h * 64 + 16 * kt + 4 * g) = w; }
            bf16* Pc = PM + ((size_t)chain * NCHUNK + c) * 4096; bf16* Qc = QT + ((size_t)chain * NCHUNK + c) * 4096;
            { const int krow = 16 * rt + l15; const float gc = gammaC[krow];
#pragma unroll
                for (int q = 0; q < 2; ++q) { const int kt = cp + q; f32x4 d = (f32x4){0.f, 0.f, 0.f, 0.f};
#pragma unroll
                    for (int ks = 0; ks < 2; ++ks) d = mfma16(CH_FRAG(CH_WT, 16 * kt + l15, ks, g), CH_FRAG(CH_BHT, krow, ks, g), d);
                    const int k0 = 16 * kt + 4 * g; f32x4 o;
#pragma unroll
                    for (int i = 0; i < 4; ++i) o[i] = ((k0 + i == krow) ? gc : 0.f) - d[i];
                    u32x2 w; w.x = pk2(o[0], o[1]); w.y = pk2(o[2], o[3]);
                    *(u32x2*)(Pc + krow * 64 + 32 * (kt >> 1) + 8 * g + 4 * (kt & 1)) = w; } }
            { const int vrow = 16 * rt + l15;
#pragma unroll
                for (int q = 0; q < 2; ++q) { const int kt = cp + q; f32x4 d = (f32x4){0.f, 0.f, 0.f, 0.f};
#pragma unroll
                    for (int ks = 0; ks < 2; ++ks) { d = mfma16(CH_FRAG(CH_KHT, 16 * kt + l15, ks, g), CH_FRAG(CH_VT, vrow, ks, g), d); d = mfma16(CH_FRAG(CH_BHT, 16 * kt + l15, ks, g), CH_FRAG(CH_U0, vrow, ks, g), d); }
                    u32x2 w; w.x = pk2(d[0], d[1]); w.y = pk2(d[2], d[3]);
                    *(u32x2*)(Qc + vrow * 64 + 16 * g + 4 * kt) = w; } }
        }
        S1_BAR();
    }
}

struct S2Set { u32x4 p[4][2]; u32x4 q[2]; };
__device__ __forceinline__ void s2_load(S2Set& s, const bf16* Pc, const bf16* Qc, int vt, int l15, int g) {
    s.q[0] = *(const u32x4*)(Qc + (16 * vt + l15) * 64 + 16 * g); s.q[1] = *(const u32x4*)(Qc + (16 * vt + l15) * 64 + 16 * g + 8);
#pragma unroll
    for (int m = 0; m < 4; ++m)
#pragma unroll
        for (int j = 0; j < 2; ++j) s.p[m][j] = *(const u32x4*)(Pc + (16 * m + l15) * 64 + 32 * j + 8 * g);
}
__device__ __forceinline__ void s2_step(f32x4 (&acc)[4], const S2Set& s, bf16* Hc, int g) {
    unsigned hw[4][2];
#pragma unroll
    for (int m = 0; m < 4; ++m) { hw[m][0] = pk2(acc[m][0], acc[m][1]); hw[m][1] = pk2(acc[m][2], acc[m][3]); }
#pragma unroll
    for (int m = 0; m < 4; ++m) *(u32x2*)(Hc + 16 * m + 4 * g) = (u32x2){hw[m][0], hw[m][1]};
    const bf16x8 hb0 = as_frag((u32x4){hw[0][0], hw[0][1], hw[1][0], hw[1][1]}), hb1 = as_frag((u32x4){hw[2][0], hw[2][1], hw[3][0], hw[3][1]});
#pragma unroll
    for (int m = 0; m < 4; ++m) {
        const unsigned q0 = (m & 2) ? ((m & 1) ? s.q[1].z : s.q[1].x) : ((m & 1) ? s.q[0].z : s.q[0].x), q1 = (m & 2) ? ((m & 1) ? s.q[1].w : s.q[1].y) : ((m & 1) ? s.q[0].w : s.q[0].y);
        f32x4 d = (f32x4){bflo(q0), bfhi(q0), bflo(q1), bfhi(q1)};
        d = mfma16(as_frag(s.p[m][0]), hb0, d);
        d = mfma16(as_frag(s.p[m][1]), hb1, d);
        acc[m] = d;
    }
}
__device__ __forceinline__ void phase_s2_chain(const Args& a, int wave, int lane, int G) {
    unsigned char* ws = a.ws;
    const bf16* PM = (const bf16*)(ws + WS_PM); const bf16* QT = (const bf16*)(ws + WS_QT); bf16* HT = (bf16*)(ws + WS_HT);
    const int l15 = lane & 15, g = lane >> 4;
    if (wave >= 2) return;
    static_assert(NCHUNK % 4 == 0, "S2 ring");
    for (int wt = blockIdx.x * 2 + wave; wt < 512; wt += G * 2) {
        const int chain = wt >> 2, vt = wt & 3;
        f32x4 acc[4];
#pragma unroll
        for (int m = 0; m < 4; ++m) acc[m] = (f32x4){0.f, 0.f, 0.f, 0.f};
        const bf16* Pc = PM + (size_t)chain * NCHUNK * 4096; const bf16* Qc = QT + (size_t)chain * NCHUNK * 4096;
        bf16* Hc = HT + (size_t)chain * NCHUNK * 4096 + (16 * vt + l15) * 64;
        S2Set s0, s1, s2, s3;
        s2_load(s0, Pc, Qc, vt, l15, g); s2_load(s1, Pc + 4096, Qc + 4096, vt, l15, g); s2_load(s2, Pc + 2 * 4096, Qc + 2 * 4096, vt, l15, g); s2_load(s3, Pc + 3 * 4096, Qc + 3 * 4096, vt, l15, g);
#pragma unroll 1
        for (int c = 0; c < NCHUNK; c += 4) {
            const int cn = c + 4 < NCHUNK ? c + 4 : c;
            const bf16* Pn = Pc + (size_t)cn * 4096; const bf16* Qn = Qc + (size_t)cn * 4096;
            s2_step(acc, s0, Hc + (size_t)c * 4096, g);       s2_load(s0, Pn, Qn, vt, l15, g);
            s2_step(acc, s1, Hc + (size_t)(c + 1) * 4096, g); s2_load(s1, Pn + 4096, Qn + 4096, vt, l15, g);
            s2_step(acc, s2, Hc + (size_t)(c + 2) * 4096, g); s2_load(s2, Pn + 2 * 4096, Qn + 2 * 4096, vt, l15, g);
            s2_step(acc, s3, Hc + (size_t)(c + 3) * 4096, g); s2_load(s3, Pn + 3 * 4096, Qn + 3 * 4096, vt, l15, g);
        }
    }
}

struct S3In { u32x2 yl[2][4]; u32x4 rh[2][2]; u32x4 hh[2][4][2]; };
__device__ __forceinline__ void s3_issue(S3In& s, const bf16* YL, const bf16* RH, const bf16* HT, int task, int l15, int g) {
    const int tt = task >> 4, h = task & 15, r0 = tt * 16, row = r0 + l15;
    int b, cc[2];
    if (r0 < TL) { b = r0 >> 13; const int tb = (r0 & (SEQ - 1)) >> 6; cc[0] = 4 + tb; cc[1] = 4 + (127 - tb); }
    else { const int loc = r0 - TL; b = loc >> 8; const int tb = (loc & 255) >> 6; cc[0] = tb; cc[1] = 3 - tb; }
    const size_t ro = (size_t)row * D + h * 64 + 4 * g;
#pragma unroll
    for (int dir = 0; dir < 2; ++dir) {
#pragma unroll
        for (int vt = 0; vt < 4; ++vt) s.yl[dir][vt] = *(const u32x2*)(YL + (size_t)dir * T * D + ro + 16 * vt);
        const int chain = dir * 64 + b * 16 + h;
        const bf16* rh = RH + ((size_t)dir * T + row) * D + h * 64 + 8 * g;
        s.rh[dir][0] = *(const u32x4*)(rh); s.rh[dir][1] = *(const u32x4*)(rh + 32);
        const bf16* hc = HT + ((size_t)chain * NCHUNK + cc[dir]) * 4096;
#pragma unroll
        for (int vt = 0; vt < 4; ++vt) { const bf16* hr = hc + (16 * vt + l15) * 64 + 8 * g; s.hh[dir][vt][0] = *(const u32x4*)(hr); s.hh[dir][vt][1] = *(const u32x4*)(hr + 32); }
    }
}
__device__ __forceinline__ void s3_finish(const S3In& s, const bf16* Vv, const float* RKB, const float* RKB1, const bf16* Gg, const float* lng, const float* lnb, bf16* Z, int task, int l15, int g) {
    const int tt = task >> 4, h = task & 15, row = tt * 16 + l15;
    u32x2 vq2[4], gw2[4]; f32x4 lg4[4], lb4[4];
#pragma unroll
    for (int vt = 0; vt < 4; ++vt) { const int col = h * 64 + 16 * vt + 4 * g; const size_t o = (size_t)row * D + col;
        vq2[vt] = *(const u32x2*)(Vv + o); gw2[vt] = *(const u32x2*)(Gg + o); lg4[vt] = *(const f32x4*)(lng + col); lb4[vt] = *(const f32x4*)(lnb + col); }
    const float bon = RKB[(size_t)row * 16 + h] + RKB1[(size_t)row * 16 + h];
    f32x4 acc[4];
#pragma unroll
    for (int vt = 0; vt < 4; ++vt) acc[vt] = bf4(s.yl[0][vt]) + bf4(s.yl[1][vt]);
#pragma unroll
    for (int dir = 0; dir < 2; ++dir) {
        const bf16x8 f0 = as_frag(s.rh[dir][0]), f1 = as_frag(s.rh[dir][1]);
#pragma unroll
        for (int vt = 0; vt < 4; ++vt) { acc[vt] = mfma16(as_frag(s.hh[dir][vt][0]), f0, acc[vt]); acc[vt] = mfma16(as_frag(s.hh[dir][vt][1]), f1, acc[vt]); }
    }
    float sm = 0.f;
#pragma unroll
    for (int vt = 0; vt < 4; ++vt) sm += (acc[vt][0] + acc[vt][1]) + (acc[vt][2] + acc[vt][3]);
    sm += __shfl_xor(sm, 16); sm += __shfl_xor(sm, 32);
    const float mean = sm * (1.0f / 64.0f); float vs = 0.f;
#pragma unroll
    for (int vt = 0; vt < 4; ++vt) { acc[vt] = acc[vt] - mean; vs += (acc[vt][0] * acc[vt][0] + acc[vt][1] * acc[vt][1]) + (acc[vt][2] * acc[vt][2] + acc[vt][3] * acc[vt][3]); }
    vs += __shfl_xor(vs, 16); vs += __shfl_xor(vs, 32);
    const float rstd = rsqrtf(vs * (1.0f / 64.0f) + 64.0f * 1e-5f);
#pragma unroll
    for (int vt = 0; vt < 4; ++vt) { const int col = h * 64 + 16 * vt + 4 * g; const size_t o = (size_t)row * D + col;
        const f32x4 zz = acc[vt] * rstd * lg4[vt] + lb4[vt] + bf4(vq2[vt]) * bon;
        u32x2 w; w.x = pk2(zz[0] * bflo(gw2[vt].x), zz[1] * bfhi(gw2[vt].x)); w.y = pk2(zz[2] * bflo(gw2[vt].y), zz[3] * bfhi(gw2[vt].y));
        *(u32x2*)(Z + o) = w; }
}
__device__ __forceinline__ void phase_s3_readout(const Args& a, int lj, int nrows, int gw, int NGW, int lane) {
    unsigned char* ws = a.ws;
    const bf16* YL = (const bf16*)(ws + WS_Y); const bf16* RH = (const bf16*)(ws + WS_RH); const bf16* HT = (const bf16*)(ws + WS_HT);
    const bf16* Vv = (const bf16*)(ws + WS_RKV) + (size_t)2 * T * D; const float* RKB = (const float*)(ws + WS_RKB); const float* RKB1 = (const float*)(ws + WS_RKB1); const bf16* Gg = (const bf16*)(ws + WS_G); bf16* Z = (bf16*)(ws + WS_Z);
    const float* lng = a.in[21] + lj * 1024; const float* lnb = a.in[22] + lj * 1024;
    const int l15 = lane & 15, g = lane >> 4, ntask = (nrows / 16) * 16;
    for (int task = gw; task < ntask; task += NGW) {
        S3In A;
        s3_issue(A, YL, RH, HT, task, l15, g);
        s3_finish(A, Vv, RKB, RKB1, Gg, lng, lnb, Z, task, l15, g);
    }
}
__device__ __forceinline__ void phase_cv(const Args& a, int lc, int rows, int gw, int NGW, int lane) {
    unsigned char* ws = a.ws;
    const bf16* BG = (const bf16*)(ws + WS_BG); const bf16* CU = (const bf16*)(ws + WS_CUZ); bf16* Z = (bf16*)(ws + WS_Z);
    const float* cw = a.in[25] + (size_t)lc * 3 * 1024;
    for (int t = gw; t < rows; t += NGW) {
        int rs, re; if (t < TL) { rs = t & ~63; re = rs + 63; } else { const int loc = t - TL; rs = TL + (loc & ~255); re = rs + 255; }
        const bool hp = t > rs, hn = t < re;
#pragma unroll
        for (int j = 0; j < 4; ++j) { const int col = 256 * j + 4 * lane; const size_t o = (size_t)t * D + col;
            const u32x2 zc = *(const u32x2*)(CU + o), bg = *(const u32x2*)(BG + o);
            const u32x2 zp = hp ? *(const u32x2*)(CU + o - D) : (u32x2){0u, 0u}, zn = hn ? *(const u32x2*)(CU + o + D) : (u32x2){0u, 0u};
            const f32x4 w0 = *(const f32x4*)(cw + col), w1 = *(const f32x4*)(cw + 1024 + col), w2 = *(const f32x4*)(cw + 2048 + col);
            const f32x4 zv = (f32x4){bflo(zc.x), bfhi(zc.x), bflo(zc.y), bfhi(zc.y)}, pv = (f32x4){bflo(zp.x), bfhi(zp.x), bflo(zp.y), bfhi(zp.y)}, nv = (f32x4){bflo(zn.x), bfhi(zn.x), bflo(zn.y), bfhi(zn.y)};
            const f32x4 bv = (f32x4){bflo(bg.x), bfhi(bg.x), bflo(bg.y), bfhi(bg.y)};
            const f32x4 r = bv * (w0 * pv + w1 * zv + w2 * nv);
            u32x2 w; w.x = pk2(r.x, r.y); w.y = pk2(r.z, r.w); *(u32x2*)(Z + o) = w; }
    }
}
typedef float f32x2v __attribute__((ext_vector_type(2)));
__device__ __forceinline__ float lane_bcast(float v, int srclane) { return __builtin_bit_cast(float, __builtin_amdgcn_readlane(__builtin_bit_cast(int, v), srclane)); }
__device__ __forceinline__ void phase_e_route(const Args& a, int layer, int rows, LAS unsigned char* lds, int tid, int gw, int NGW, int lane, int probe_rep = 0) {
    unsigned char* ws = a.ws;
    const float* xs = (const float*)(ws + (layer < 2 ? WS_XSA : WS_XSB));
    const float* MODS = (const float*)(ws + WS_MODS); bf16* H2 = (bf16*)(ws + WS_H2);
    const float* ng = a.in[6] + (size_t)(layer * 2 + 1) * 1024;
    const float* rw = a.in[27] + (size_t)layer * 1024 * 32; const float* rb = a.in[28] + layer * 32;
    unsigned* cnt = (unsigned*)(ws + WS_CTL) + CW_CNT + (layer + 4 * probe_rep) * 32 * CNT_STRIDE;
    int* SLOTL = (int*)(ws + (probe_rep ? WS_L1 : WS_SLOTL)); float* GATEL = (float*)(ws + (probe_rep ? WS_L1 + 8 * MiB : WS_GATEL));
    LAS float* wt = (LAS float*)lds;
    LAS int* hist = (LAS int*)(lds + LDSCTL_OFF + 3072); LAS int* base = hist + 32; LAS int* lcnt = hist + 64;
    int* TKE = (int*)(ws + WS_C12); float* TKG = (float*)(ws + WS_C12 + 4 * MiB);
    for (int i = tid; i < 32768; i += 512) wt[(i & 31) * 1024 + (i >> 5)] = rw[i];
    if (tid < 32) hist[tid] = 0;
    __syncthreads();
    const int my_e = lane >> 1; const float my_b = rb[my_e];
    const bool b5 = (lane & 32) != 0, b4 = (lane & 16) != 0, b3 = (lane & 8) != 0, b2 = (lane & 4) != 0, b1 = (lane & 2) != 0;
    for (int t = gw; t < rows; t += NGW) {
        const int mr = mod_row(t);
        const float* mod = MODS + (size_t)(layer * 5 + mr) * 6144;
        f32x4 x[4];
#pragma unroll
        for (int j = 0; j < 4; ++j) x[j] = *(const f32x4*)(xs + (size_t)t * D + 256 * j + 4 * lane);
        const float rstd = row_rstd(x);
#pragma unroll
        for (int j = 0; j < 4; ++j) { const int col = 256 * j + 4 * lane;
            x[j] = x[j] * rstd * *(const f32x4*)(ng + col) * (*(const f32x4*)(mod + 4 * 1024 + col) + 1.0f) + *(const f32x4*)(mod + 3 * 1024 + col);
            u32x2 w; w.x = pk2(x[j].x, x[j].y); w.y = pk2(x[j].z, x[j].w); *(u32x2*)(H2 + (size_t)t * D + col) = w; }
        float p[32];
#pragma unroll
        for (int eg = 0; eg < 8; ++eg) {
#pragma unroll
            for (int ee = 0; ee < 4; ++ee) { const int e = eg * 4 + ee; f32x2v s2 = (f32x2v){0.f, 0.f};
#pragma unroll
                for (int j = 0; j < 4; ++j) { const f32x4 wv = *(const LAS f32x4*)(wt + e * 1024 + 256 * j + 4 * lane);
                    s2 = __builtin_elementwise_fma((f32x2v){x[j].x, x[j].y}, (f32x2v){wv.x, wv.y}, s2); s2 = __builtin_elementwise_fma((f32x2v){x[j].z, x[j].w}, (f32x2v){wv.z, wv.w}, s2); }
                p[e] = s2.x + s2.y; }
            asm volatile("" ::: "memory");
        }
        float q16[16];
#pragma unroll
        for (int i = 0; i < 16; ++i) { const float send = b5 ? p[i] : p[i + 16]; const float keep = b5 ? p[i + 16] : p[i]; q16[i] = keep + __shfl_xor(send, 32); }
        float q8[8];
#pragma unroll
        for (int i = 0; i < 8; ++i) { const float send = b4 ? q16[i] : q16[i + 8]; const float keep = b4 ? q16[i + 8] : q16[i]; q8[i] = keep + __shfl_xor(send, 16); }
        float q4[4];
#pragma unroll
        for (int i = 0; i < 4; ++i) { const float send = b3 ? q8[i] : q8[i + 4]; const float keep = b3 ? q8[i + 4] : q8[i]; q4[i] = keep + __shfl_xor(send, 8); }
        float q2[2];
#pragma unroll
        for (int i = 0; i < 2; ++i) { const float send = b2 ? q4[i] : q4[i + 2]; const float keep = b2 ? q4[i + 2] : q4[i]; q2[i] = keep + __shfl_xor(send, 4); }
        float q1; { const float send = b1 ? q2[0] : q2[1]; const float keep = b1 ? q2[1] : q2[0]; q1 = keep + __shfl_xor(send, 2); }
        const float lg = q1 + __shfl_xor(q1, 1) + my_b;
        int rank = 0;
#pragma unroll 1
        for (int e = 0; e < 32; ++e) { const float o = lane_bcast(lg, 2 * e); rank += (o > lg || (o == lg && e < my_e)) ? 1 : 0; }
        const bool sel = rank < 4 && !(lane & 1);
        const unsigned long long m0 = __ballot(sel && rank == 0), m1 = __ballot(sel && rank == 1), m2 = __ballot(sel && rank == 2), m3 = __ballot(sel && rank == 3);
        const float v0 = lane_bcast(lg, (int)__builtin_ctzll(m0)), v1 = lane_bcast(lg, (int)__builtin_ctzll(m1)), v2 = lane_bcast(lg, (int)__builtin_ctzll(m2)), v3 = lane_bcast(lg, (int)__builtin_ctzll(m3));
        const float e1 = __expf(v1 - v0), e2 = __expf(v2 - v0), e3 = __expf(v3 - v0);
        const float inv = frcp(1.0f + e1 + e2 + e3);
        if (sel) {
            TKE[t * 4 + rank] = my_e; TKG[t * 4 + rank] = __expf(lg - v0) * inv;
            __hip_atomic_fetch_add(hist + my_e, 1, __ATOMIC_RELAXED, __HIP_MEMORY_SCOPE_WORKGROUP);
        }
    }
    asm volatile("s_waitcnt vmcnt(0) lgkmcnt(0)" ::: "memory"); __syncthreads();
    if (tid < 32) { base[tid] = (int)atomicAdd(cnt + tid * CNT_STRIDE, (unsigned)hist[tid]); lcnt[tid] = 0; }
    __syncthreads();
    for (int t = gw; t < rows; t += NGW) {
        if (lane < 4) { const int e = TKE[t * 4 + lane]; const float gk = TKG[t * 4 + lane];
            const int pos = base[e] + __hip_atomic_fetch_add(lcnt + e, 1, __ATOMIC_RELAXED, __HIP_MEMORY_SCOPE_WORKGROUP);
            SLOTL[(size_t)e * T + pos] = t * 4 + lane; GATEL[(size_t)e * T + pos] = gk; }
    }
}
__device__ __forceinline__ int okey(float v, int e) { const int i = __builtin_bit_cast(int, v); const int o = i ^ ((i >> 31) & 0x7fffffff); return (o & ~31) | (31 - e); }
__device__ __forceinline__ void phase_e_route_mfma(const Args& a, int layer, int rows, LAS unsigned char* lds, int tid, int wave, int gw, int NGW, int lane, int probe_rep = 0) {
    unsigned char* ws = a.ws;
    const float* xs = (const float*)(ws + (layer < 2 ? WS_XSA : WS_XSB));
    const float* MODS = (const float*)(ws + WS_MODS); bf16* H2 = (bf16*)(ws + WS_H2);
    const float* ng = a.in[6] + (size_t)(layer * 2 + 1) * 1024; const float* rb = a.in[28] + layer * 32;
    const bf16* WRT = (const bf16*)(ws + WS_WRT) + (size_t)layer * 2 * 32 * 1024;
    unsigned* cnt = (unsigned*)(ws + WS_CTL) + CW_CNT + (layer + 4 * probe_rep) * 32 * CNT_STRIDE;
    int* SLOTL = (int*)(ws + (probe_rep ? WS_L1 : WS_SLOTL)); float* GATEL = (float*)(ws + (probe_rep ? WS_L1 + 8 * MiB : WS_GATEL));
    LAS int* hist = (LAS int*)(lds + LDSCTL_OFF + 3072); LAS int* base = hist + 32; LAS int* lcnt = hist + 64;
    int* TKE = (int*)(ws + WS_C12); float* TKG = (float*)(ws + WS_C12 + 4 * MiB);
    LAS unsigned char* tile = lds + wave * 8448;
    if (tid < 32) hist[tid] = 0;
    __syncthreads();
    const int l15 = lane & 15, g = lane >> 4;
    const int nlat = TL / 16, nctx = rows > TL ? TC / 4 : 0, G_ = NGW / 8;
    for (int it = 0;; ++it) {
        int t0, ntok;
        { const int tl = gw + it * NGW; const int xi = (int)blockIdx.x + (it - (nlat + NGW - 1) / NGW) * G_ * 8 + wave * G_;
          if (tl < nlat) { t0 = tl * 16; ntok = 16; } else if (it >= (nlat + NGW - 1) / NGW && xi < nctx) { t0 = TL + xi * 4; ntok = 4; } else if (it >= (nlat + NGW - 1) / NGW) break; else continue; }
        const float* mod = MODS + (size_t)(layer * 5 + mod_row(t0)) * 6144;
        float rstd[16];
#pragma unroll
        for (int t = 0; t < 16; ++t) { f32x4 x[4];
            const int tr = t < ntok ? t0 + t : t0;
#pragma unroll
            for (int j = 0; j < 4; ++j) x[j] = *(const f32x4*)(xs + (size_t)tr * D + 256 * j + 4 * lane);
            rstd[t] = __builtin_bit_cast(float, __builtin_amdgcn_readfirstlane(__builtin_bit_cast(int, row_rstd(x))));
            if ((t & 3) == 3) asm volatile("" ::: "memory"); }
        f32x4 acc[2]; acc[0] = (f32x4){0.f, 0.f, 0.f, 0.f}; acc[1] = acc[0];
#pragma unroll 1
        for (int s = 0; s < 4; ++s) {
            const int col = 256 * s + 4 * lane;
            const f32x4 g4 = *(const f32x4*)(ng + col) * (*(const f32x4*)(mod + 4 * 1024 + col) + 1.0f), s4 = *(const f32x4*)(mod + 3 * 1024 + col);
            f32x4 hv[16];
#pragma unroll
            for (int t = 0; t < 16; ++t) { const int tr = t < ntok ? t0 + t : t0; hv[t] = *(const f32x4*)(xs + (size_t)tr * D + col) * rstd[t] * g4 + s4;
                const u32x2 w = pk4(hv[t]); if (t < ntok) *(u32x2*)(H2 + (size_t)tr * D + col) = w;
                *(LAS u32x2*)(tile + t * 528 + lane * 8) = w; hv[t] = hv[t] - bf4(w); }
            LDS_WAIT(); asm volatile("" ::: "memory");
            const bf16* wh = WRT + (size_t)l15 * 1024 + 256 * s + 8 * g; const bf16* wl = wh + (size_t)32 * 1024;
#pragma unroll
            for (int ks = 0; ks < 8; ++ks) { const bf16x8 fb = as_frag(*(const LAS u32x4*)(tile + l15 * 528 + ks * 64 + g * 16));
#pragma unroll
                for (int et = 0; et < 2; ++et) { acc[et] = mfma16(as_frag(*(const u32x4*)(wh + (size_t)et * 16 * 1024 + 32 * ks)), fb, acc[et]);
                    acc[et] = mfma16(as_frag(*(const u32x4*)(wl + (size_t)et * 16 * 1024 + 32 * ks)), fb, acc[et]); } }
            LDS_WAIT(); asm volatile("" ::: "memory");
#pragma unroll
            for (int t = 0; t < 16; ++t) *(LAS u32x2*)(tile + t * 528 + lane * 8) = pk4(hv[t]);
            LDS_WAIT(); asm volatile("" ::: "memory");
#pragma unroll
            for (int ks = 0; ks < 8; ++ks) { const bf16x8 fb = as_frag(*(const LAS u32x4*)(tile + l15 * 528 + ks * 64 + g * 16));
#pragma unroll
                for (int et = 0; et < 2; ++et) acc[et] = mfma16(as_frag(*(const u32x4*)(wh + (size_t)et * 16 * 1024 + 32 * ks)), fb, acc[et]); }
            LDS_WAIT(); asm volatile("" ::: "memory");
        }
        float v[8]; int key[8];
#pragma unroll
        for (int j = 0; j < 8; ++j) { const int e = (j < 4 ? 0 : 16) + 4 * g + (j & 3); v[j] = acc[j >> 2][j & 3] + rb[e]; key[j] = okey(v[j], e); }
        int kb[8], kc[8], kd2[8];
#pragma unroll
        for (int j = 0; j < 8; ++j) kb[j] = __shfl_xor(key[j], 16);
#pragma unroll
        for (int j = 0; j < 8; ++j) { kc[j] = __shfl_xor(key[j], 32); kd2[j] = __shfl_xor(kb[j], 32); }
        float vmax = fmaxf(fmaxf(fmaxf(v[0], v[1]), fmaxf(v[2], v[3])), fmaxf(fmaxf(v[4], v[5]), fmaxf(v[6], v[7])));
        vmax = fmaxf(vmax, __shfl_xor(vmax, 16)); vmax = fmaxf(vmax, __shfl_xor(vmax, 32));
        int rank[8]; float ex[8], part = 0.f;
#pragma unroll
        for (int j = 0; j < 8; ++j) { int r = 0;
#pragma unroll
            for (int q = 0; q < 8; ++q) r += (key[q] > key[j]) + (kb[q] > key[j]) + (kc[q] > key[j]) + (kd2[q] > key[j]);
            rank[j] = r; ex[j] = __expf(v[j] - vmax); part += r < 4 ? ex[j] : 0.f; }
        part += __shfl_xor(part, 16); part += __shfl_xor(part, 32);
        const float inv = frcp(part); const int t = t0 + l15;
#pragma unroll
        for (int j = 0; j < 8; ++j) if (rank[j] < 4 && l15 < ntok) { const int e = (j < 4 ? 0 : 16) + 4 * g + (j & 3);
            TKE[t * 4 + rank[j]] = e; TKG[t * 4 + rank[j]] = ex[j] * inv;
            __hip_atomic_fetch_add(hist + e, 1, __ATOMIC_RELAXED, __HIP_MEMORY_SCOPE_WORKGROUP); }
    }
    asm volatile("s_waitcnt vmcnt(0) lgkmcnt(0)" ::: "memory"); __syncthreads();
    if (tid < 32) { base[tid] = (int)atomicAdd(cnt + tid * CNT_STRIDE, (unsigned)hist[tid]); lcnt[tid] = 0; }
    __syncthreads();
    for (int it = 0;; ++it) {
        int t0, ntok;
        { const int tl = gw + it * NGW; const int xi = (int)blockIdx.x + (it - (nlat + NGW - 1) / NGW) * G_ * 8 + wave * G_;
          if (tl < nlat) { t0 = tl * 16; ntok = 16; } else if (it >= (nlat + NGW - 1) / NGW && xi < nctx) { t0 = TL + xi * 4; ntok = 4; } else if (it >= (nlat + NGW - 1) / NGW) break; else continue; }
        if ((lane >> 2) < ntok) { const int t = t0 + (lane >> 2), k = lane & 3;
            const int e = TKE[t * 4 + k]; const float gk = TKG[t * 4 + k];
            const int pos = base[e] + __hip_atomic_fetch_add(lcnt + e, 1, __ATOMIC_RELAXED, __HIP_MEMORY_SCOPE_WORKGROUP);
            SLOTL[(size_t)e * T + pos] = t * 4 + k; GATEL[(size_t)e * T + pos] = gk; }
    }
}
__device__ __forceinline__ void phase_final(const Args& a, int gw, int NGW, int lane) {
    unsigned char* ws = a.ws;
    const float* xs = (const float*)(ws + WS_XSB); const float* MODS = (const float*)(ws + WS_MODS); const bf16* YS = (const bf16*)(ws + WS_YS);
    for (int t = gw; t < TL; t += NGW) {
        const int mr = t >> 13;
        f32x4 m5[4], x[4];
#pragma unroll
        for (int j = 0; j < 4; ++j) m5[j] = *(const f32x4*)(MODS + (size_t)(3 * 5 + mr) * 6144 + 5 * 1024 + 256 * j + 4 * lane);
        load_x_combined(x, xs + (size_t)t * D, true, YS, t, m5, lane);
        const float rstd = row_rstd(x);
#pragma unroll
        for (int j = 0; j < 4; ++j) { const int col = 256 * j + 4 * lane; *(f32x4*)(a.out + (size_t)t * D + col) = x[j] * rstd * *(const f32x4*)(a.in[7] + col); }
    }
}

using pg8::Unit; using pg8::tile_map;
struct SchedStd {
    int G, c, nM, nN;
    __device__ __forceinline__ bool next(int i, Unit& u) const { const long L = (long)i * G + c; if (L >= (long)nM * nN) return false; int pm, pn; tile_map((int)L, nM, nN, pm, pn); u.pm = pm; u.pn = pn; u.e = 0; u.nv = pm; u.par = 0; return true; }
    __device__ __forceinline__ void a_ready(const Unit&) const {}
    __device__ __forceinline__ void done(const Unit&) const {}
    __device__ __forceinline__ unsigned row_off(const Unit&, int) const { return 0u; }
    __device__ __forceinline__ unsigned row_off_lds(const Unit&, int) const { return 0u; }
    __device__ __forceinline__ void prefetch_rows(const Unit&) const {}
};
struct SchedB1 {
    int G, c;
    __device__ __forceinline__ bool next(int i, Unit& u) const { const long L = (long)i * G + c; constexpr int n1 = 3 * NMT * 4; if (L >= n1 + 3 * NMT) return false; const int l = (int)L;
        if (l < n1) { const int j = l / (NMT * 4), r = l % (NMT * 4); int pm, pn; tile_map(r, NMT, 4, pm, pn); u.pm = j * NMT + pm; u.pn = j * 4 + pn; u.e = j; u.nv = pm; }
        else { const int r = l - n1, j = r / NMT, pm = r % NMT; u.pm = (3 + j) * NMT + pm; u.pn = 12 + j; u.e = 3 + j; u.nv = pm; }
        u.par = 0; return true; }
    __device__ __forceinline__ void a_ready(const Unit&) const {}
    __device__ __forceinline__ void done(const Unit&) const {}
    __device__ __forceinline__ unsigned row_off(const Unit&, int) const { return 0u; }
    __device__ __forceinline__ unsigned row_off_lds(const Unit&, int) const { return 0u; }
    __device__ __forceinline__ void prefetch_rows(const Unit&) const {}
};
struct SchedB2 {
    int G, c;
    __device__ __forceinline__ bool next(int i, Unit& u) const { const long L = (long)i * G + c; constexpr int n1 = 2 * NMT * 8; if (L >= n1 + NMT * 4) return false; const int l = (int)L;
        if (l < n1) { const int j = l / (NMT * 8), r = l % (NMT * 8); int pm, pn; tile_map(r, NMT, 8, pm, pn); u.pm = j * NMT + pm; u.pn = j * 8 + pn; u.e = j; u.nv = pm; }
        else { const int r = l - n1; int pm, pn; tile_map(r, NMT, 4, pm, pn); u.pm = 2 * NMT + pm; u.pn = 16 + pn; u.e = 2; u.nv = pm; }
        u.par = 0; return true; }
    __device__ __forceinline__ void a_ready(const Unit&) const {}
    __device__ __forceinline__ void done(const Unit&) const {}
    __device__ __forceinline__ unsigned row_off(const Unit&, int) const { return 0u; }
    __device__ __forceinline__ unsigned row_off_lds(const Unit&, int) const { return 0u; }
    __device__ __forceinline__ void prefetch_rows(const Unit&) const {}
};
struct SchedMoe {
    int G, c, nnt, ntiles, P; LAS unsigned char* lds; const int* slotl; const float* gatel; int wave;
    __device__ __forceinline__ bool next(int i, Unit& u) const { const long L = (long)i * G + c; const int ntp = (ntiles + P - 1) / P, ppg = nnt / (8 / P); if (L >= (long)ntp * ppg * 8) return false;
        const LAS int* tpre = (const LAS int*)(lds + LDSCTL_OFF + 64); const LAS int* ecnt = (const LAS int*)(lds + LDSCTL_OFF + 256); const LAS unsigned short* tile_e = (const LAS unsigned short*)(lds + LDSCTL_OFF + 512);
        const int xq = (int)(L >> 3), x8 = (int)(L & 7); int tile = (xq / ppg) * P + (x8 % P); const int pnl = (x8 / P) * ppg + xq % ppg; const bool dead = tile >= ntiles; tile = dead ? 0 : tile;
        const int e = __builtin_amdgcn_readfirstlane((int)tile_e[tile]), r0 = (tile - __builtin_amdgcn_readfirstlane(tpre[e])) * 256; int nv = __builtin_amdgcn_readfirstlane(ecnt[e]) - r0; nv = nv > 256 ? 256 : nv; nv = dead ? 0 : nv;
        u.pm = dead ? MAXTILES : tile; u.pn = e * nnt + pnl; u.e = e; u.nv = nv | (r0 << 9); u.par = i & 1; return true; }
    __device__ __forceinline__ void a_ready(const Unit& u) const {
        if (gatel != nullptr && wave == 0) { const size_t li = (size_t)u.e * T + (u.nv >> 9) + 4 * lane_id();
            __builtin_amdgcn_global_load_lds((const unsigned*)(slotl + li), (LAS unsigned*)(lds + LDSCTL_OFF + 8192 + 2048 * u.par), 16, 0, 0);
            __builtin_amdgcn_global_load_lds((const unsigned*)(gatel + li), (LAS unsigned*)(lds + LDSCTL_OFF + 8192 + 2048 * u.par + 1024), 16, 0, 0); } }
    __device__ __forceinline__ void done(const Unit&) const {}
    __device__ __forceinline__ void prefetch_rows(const Unit& u) const {
        if (wave == 0) __builtin_amdgcn_global_load_lds((const unsigned*)(slotl + (size_t)u.e * T + (u.nv >> 9) + 4 * lane_id()), (LAS unsigned*)(lds + LDSCTL_OFF + 8192 + 2048 * u.par), 16, 0, 0); }
    __device__ __forceinline__ unsigned row_off_lds(const Unit& u, int r) const { const int nv = u.nv & 511; const int sl = ((const LAS int*)(lds + LDSCTL_OFF + 8192 + 2048 * u.par))[r]; const int tok = r < nv ? (sl >> 2) : 0; return (unsigned)tok * 2048u; }
    __device__ __forceinline__ unsigned row_off(const Unit& u, int r) const { const int nv = u.nv & 511, r0 = u.nv >> 9; const int tok = r < nv ? (slotl[(size_t)u.e * T + r0 + r] >> 2) : 0; return (unsigned)tok * 2048u; }
};

using pg8::cvt_pk_bf16;
template <class P> __device__ __forceinline__ P* pin_ptr(P* p) { asm volatile("" : "+v"(p)); return p; }
struct EpiB1 {
    static constexpr bool PERM = true, AFTER_DRAIN = false;
    bf16* RKV; bf16* L1;
    __device__ __forceinline__ void operator()(const f32x4 (&acc)[2][2][4][2], const Unit& u, int wr, int wc, int fr, int fq) const {
        const int seg = u.e, row0 = u.nv * 256 + wr * 64 + fr;
        const int jj = seg - 3, ld = seg < 3 ? D : 128, col0 = (seg < 3 ? (u.pn - seg * 4) * 256 : 0) + wc * 32 + 8 * fq;
        bf16* base = seg < 3 ? RKV + (size_t)seg * T * D : L1 + (size_t)jj * T * 128;
#pragma unroll
        for (int ai = 0; ai < 2; ++ai)
#pragma unroll
            for (int m = 0; m < 4; ++m) { bf16* rowp = base + (size_t)(row0 + ai * 128 + m * 16) * ld + col0;
#pragma unroll
                for (int bj = 0; bj < 2; ++bj) { if (seg >= 3 && bj == 1) continue; f32x4 v0 = acc[ai][bj][m][0], v1 = acc[ai][bj][m][1];
                    if (jj == 0) {
#pragma unroll
                        for (int q = 0; q < 4; ++q) { v0[q] = tanh_fast(v0[q]); v1[q] = tanh_fast(v1[q]); } }
                    else if (jj == 2) {
#pragma unroll
                        for (int q = 0; q < 4; ++q) { v0[q] = sigm(v0[q]); v1[q] = sigm(v1[q]); } }
                    u32x4 w; w.x = cvt_pk_bf16(v0[0], v0[1]); w.y = cvt_pk_bf16(v0[2], v0[3]); w.z = cvt_pk_bf16(v1[0], v1[1]); w.w = cvt_pk_bf16(v1[2], v1[3]);
                    *(u32x4*)(rowp + bj * 128) = w; } }
    }
};
struct EpiB2 {
    static constexpr bool PERM = true, AFTER_DRAIN = false;
    bf16* RW; bf16* RA; bf16* Gg;
    __device__ __forceinline__ void operator()(const f32x4 (&acc)[2][2][4][2], const Unit& u, int wr, int wc, int fr, int fq) const {
        const int jj = u.e, row0 = u.nv * 256 + wr * 64 + fr, pnl = u.pn - jj * 8;
        const int dirn = jj < 2 ? (pnl >> 2) : 0, col0 = (jj < 2 ? (pnl & 3) : pnl) * 256 + wc * 32 + 8 * fq;
        bf16* base = (jj == 0 ? RW : jj == 1 ? RA : Gg) + (size_t)dirn * T * D;
#pragma unroll
        for (int ai = 0; ai < 2; ++ai)
#pragma unroll
            for (int m = 0; m < 4; ++m) { bf16* rowp = base + (size_t)(row0 + ai * 128 + m * 16) * D + col0;
#pragma unroll
                for (int bj = 0; bj < 2; ++bj) { const f32x4 v0 = acc[ai][bj][m][0], v1 = acc[ai][bj][m][1];
                    u32x4 w; w.x = cvt_pk_bf16(v0[0], v0[1]); w.y = cvt_pk_bf16(v0[2], v0[3]); w.z = cvt_pk_bf16(v1[0], v1[1]); w.w = cvt_pk_bf16(v1[2], v1[3]);
                    *(u32x4*)(rowp + bj * 128) = w; } }
    }
};
struct EpiRes {
    static constexpr bool PERM = true, AFTER_DRAIN = false;
    float* X; const float* gate; float* Xo;
    __device__ __forceinline__ void operator()(const f32x4 (&acc)[2][2][4][2], const Unit& u, int wr, int wc, int fr, int fq) const {
        const int row0 = u.pm * 256 + wr * 64 + fr, col0 = u.pn * 256 + wc * 32 + 8 * fq, mr = u.pm < NMT_L ? (u.pm >> 5) : 4;
        const float* gp = pin_ptr(gate + (size_t)mr * 6144 + col0);
        f32x4 gv[2][2];
#pragma unroll
        for (int bj = 0; bj < 2; ++bj)
#pragma unroll
            for (int n = 0; n < 2; ++n) gv[bj][n] = *(const f32x4*)(gp + bj * 128 + 4 * n);
        f32x4 xa[2][2][2], xb[2][2][2];
#define ER_LOAD(dst, b_) do { _Pragma("unroll") for (int m = 0; m < 2; ++m) _Pragma("unroll") for (int bj = 0; bj < 2; ++bj) _Pragma("unroll") for (int n = 0; n < 2; ++n) \
            dst[m][bj][n] = *(const f32x4*)(X + (size_t)(row0 + ((b_) >> 1) * 128 + (((b_) & 1) * 2 + m) * 16) * D + col0 + bj * 128 + 4 * n); } while (0)
#define ER_STORE(src, b_) do { _Pragma("unroll") for (int m = 0; m < 2; ++m) _Pragma("unroll") for (int bj = 0; bj < 2; ++bj) _Pragma("unroll") for (int n = 0; n < 2; ++n) \
            *(f32x4*)(Xo + (size_t)(row0 + ((b_) >> 1) * 128 + (((b_) & 1) * 2 + m) * 16) * D + col0 + bj * 128 + 4 * n) = src[m][bj][n] + gv[bj][n] * acc[(b_) >> 1][bj][((b_) & 1) * 2 + m][n]; } while (0)
        ER_LOAD(xa, 0); ER_LOAD(xb, 1); ER_STORE(xa, 0); ER_LOAD(xa, 2); ER_STORE(xb, 1); ER_LOAD(xb, 3); ER_STORE(xa, 2); ER_STORE(xb, 3);
#undef ER_LOAD
#undef ER_STORE
    }
};
struct EpiWin {
    static constexpr bool PERM = true, AFTER_DRAIN = false;
    bf16* BG; bf16* CU;
    __device__ __forceinline__ void operator()(const f32x4 (&acc)[2][2][4][2], const Unit& u, int wr, int wc, int fr, int fq) const {
        const int row0 = u.pm * 256 + wr * 64 + fr;
        if (u.pn < 4) {
            const int col0 = u.pn * 256 + wc * 32 + 8 * fq;
#pragma unroll
            for (int ai = 0; ai < 2; ++ai)
#pragma unroll
                for (int m = 0; m < 4; ++m) { bf16* rowp = BG + (size_t)(row0 + ai * 128 + m * 16) * D + col0;
#pragma unroll
                    for (int bj = 0; bj < 2; ++bj) { const f32x4 v0 = acc[ai][bj][m][0], v1 = acc[ai][bj][m][1];
                        u32x4 w; w.x = cvt_pk_bf16(v0[0], v0[1]); w.y = cvt_pk_bf16(v0[2], v0[3]); w.z = cvt_pk_bf16(v1[0], v1[1]); w.w = cvt_pk_bf16(v1[2], v1[3]);
                        *(u32x4*)(rowp + bj * 128) = w; } }
        } else {
            const int f0 = (u.pn - 4) * 128 + wc * 32 + 8 * fq;
#pragma unroll
            for (int ai = 0; ai < 2; ++ai)
#pragma unroll
                for (int m = 0; m < 4; ++m) { const f32x4 v0 = acc[ai][0][m][0] * acc[ai][1][m][0], v1 = acc[ai][0][m][1] * acc[ai][1][m][1];
                    u32x4 w; w.x = cvt_pk_bf16(v0[0], v0[1]); w.y = cvt_pk_bf16(v0[2], v0[3]); w.z = cvt_pk_bf16(v1[0], v1[1]); w.w = cvt_pk_bf16(v1[2], v1[3]);
                    *(u32x4*)(CU + (size_t)(row0 + ai * 128 + m * 16) * D + f0) = w; }
        }
    }
};
struct EpiGU {
    static constexpr bool PERM = true, AFTER_DRAIN = false;
    bf16* INTER; const float* bgu;
    __device__ __forceinline__ void operator()(const f32x4 (&acc)[2][2][4][2], const Unit& u, int wr, int wc, int fr, int fq) const {
        const int e = u.e, pnl = u.pn - e * 8, row0 = u.pm * 256 + wr * 64 + fr, f0 = pnl * 128 + wc * 32 + 8 * fq;
        const float* bp = pin_ptr(bgu + (size_t)e * 2048 + f0);
        f32x4 bg[2], bu[2];
#pragma unroll
        for (int n = 0; n < 2; ++n) { bg[n] = *(const f32x4*)(bp + 4 * n); bu[n] = *(const f32x4*)(bp + 1024 + 4 * n); }
#pragma unroll
        for (int ai = 0; ai < 2; ++ai)
#pragma unroll
            for (int m = 0; m < 4; ++m) { f32x4 o[2];
#pragma unroll
                for (int n = 0; n < 2; ++n) { const f32x4 g = acc[ai][0][m][n] + bg[n], uu = acc[ai][1][m][n] + bu[n];
#pragma unroll
                    for (int q = 0; q < 4; ++q) { const float gc = fminf(g[q], 7.0f), uc = fminf(fmaxf(uu[q], -7.0f), 7.0f); o[n][q] = (uc + 1.0f) * gc * sigm(1.702f * gc); } }
                u32x4 w; w.x = cvt_pk_bf16(o[0][0], o[0][1]); w.y = cvt_pk_bf16(o[0][2], o[0][3]); w.z = cvt_pk_bf16(o[1][0], o[1][1]); w.w = cvt_pk_bf16(o[1][2], o[1][3]);
                *(u32x4*)(INTER + (size_t)(row0 + ai * 128 + m * 16) * 1024 + f0) = w; }
    }
};
struct EpiDown {
    static constexpr bool PERM = true, AFTER_DRAIN = false;
    bf16* YS; const float* bdn; LAS unsigned char* lds;
    __device__ __forceinline__ void operator()(const f32x4 (&acc)[2][2][4][2], const Unit& u, int wr, int wc, int fr, int fq) const {
        const int e = u.e, pnl = u.pn - e * 4, col0 = pnl * 256 + wc * 32 + 8 * fq, nv = u.nv & 511;
        const float* bp = pin_ptr(bdn + (size_t)e * 1024 + col0);
        f32x4 bv[2][2];
#pragma unroll
        for (int bj = 0; bj < 2; ++bj)
#pragma unroll
            for (int n = 0; n < 2; ++n) bv[bj][n] = *(const f32x4*)(bp + bj * 128 + 4 * n);
#pragma unroll
        for (int ai = 0; ai < 2; ++ai)
#pragma unroll
            for (int m = 0; m < 4; ++m) { const int r = ai * 128 + wr * 64 + m * 16 + fr;
                if (r < nv) { const LAS int* sl = (const LAS int*)(lds + LDSCTL_OFF + 8192 + 2048 * u.par); const int slot = sl[r]; const float gt = ((const LAS float*)(sl + 256))[r];
                    bf16* rowp = YS + (size_t)slot * 1024 + col0;
#pragma unroll
                    for (int bj = 0; bj < 2; ++bj) { const f32x4 v0 = (acc[ai][bj][m][0] + bv[bj][0]) * gt, v1 = (acc[ai][bj][m][1] + bv[bj][1]) * gt;
                        u32x4 w; w.x = cvt_pk_bf16(v0[0], v0[1]); w.y = cvt_pk_bf16(v0[2], v0[3]); w.z = cvt_pk_bf16(v1[0], v1[1]); w.w = cvt_pk_bf16(v1[2], v1[3]);
                        *(u32x4*)(rowp + bj * 128) = w; } } }
    }
};

__device__ __forceinline__ int moe_tables(const unsigned* cnt, LAS unsigned char* lds, int tid) {
    LAS int* tpre = (LAS int*)(lds + LDSCTL_OFF + 64); LAS int* ecnt = (LAS int*)(lds + LDSCTL_OFF + 256); LAS unsigned short* tile_e = (LAS unsigned short*)(lds + LDSCTL_OFF + 512);
    if (tid == 0) { int p = 0; for (int e = 0; e < 32; ++e) { const int cn = (int)__hip_atomic_load(cnt + e * CNT_STRIDE, __ATOMIC_RELAXED, __HIP_MEMORY_SCOPE_AGENT); ecnt[e] = cn; tpre[e] = p; p += (cn + 255) >> 8; } tpre[32] = p; }
    __syncthreads();
    const int nt = tpre[32];
    for (int t = tid; t < nt; t += 512) { int e = 0; while (e < 31 && t >= tpre[e + 1]) ++e; tile_e[t] = (unsigned short)e; }
    __syncthreads();
    return nt;
}

constexpr int NPHASES = 37;
typedef const Args __attribute__((address_space(4))) CArgs;
__global__ void __attribute__((amdgpu_flat_work_group_size(512, 512), amdgpu_waves_per_eu(2, 2))) fwd_kernel(Args a_) {
    extern __shared__ __attribute__((aligned(16))) unsigned char lds_raw[];
    LAS unsigned char* lds = (LAS unsigned char*)lds_raw;
    const int G = gridDim.x, NGW = G * 8;
    CArgs* ap0 = (CArgs*)__builtin_amdgcn_kernarg_segment_ptr();
    if (threadIdx.x < 4) ((LAS unsigned*)(lds + LDSCTL_OFF))[threadIdx.x] = 0u;
    __syncthreads();
    XcdBarrier bar = xcd_barrier_post((unsigned*)(a_.ws + WS_CTL) + CW_BAR, (volatile LAS unsigned*)(lds + LDSCTL_OFF));
    const int lo = a_.ph_lo, hi = a_.ph_hi;
    int ph = 0;
#ifndef MK_ONLY
#define MK_ONLY -1
#endif
#ifndef MK_DBL
#define MK_DBL 0
#endif
#define PH_BEGIN(id) if ((MK_ONLY < 0 || MK_ONLY == (id)) && ph >= lo && ph < hi) { for (int rep_ = 0; rep_ <= ((MK_DBL >> (id)) & 1); ++rep_) { CArgs* ap = ap0; asm volatile("" : "+s"(ap)); const Args a = *(const Args*)ap; unsigned char* const ws = a.ws; (void)ws; const int wave = (int)bar.wv; int tid = wave * 64 + lane_id(); asm volatile("" : "+v"(tid)); const int lane = tid & 63, gw = blockIdx.x * 8 + wave; (void)lane; (void)gw;
#define PH_END } } if (ph >= lo && ph + 1 < hi) xcd_barrier(bar); ++ph;

    PH_BEGIN(0) p0_prologue(a, lds, tid, lane, wave, G); PH_END

#pragma unroll 1
    for (int layer = 0; layer < DEPTH; ++layer) {
        const int kind = layer & 1, lj = layer >> 1;
        const int rows = layer == 3 ? TL : T, nmt = rows / 256;
        const int rows_moe = layer < 2 ? T : TL;
        if (kind == 0) {
            PH_BEGIN(1) phase_a_rwkv(a, layer, lds, tid, gw, NGW, lane); PH_END
            PH_BEGIN(2) {
                pg8::Gemm g{(const bf16*)(ws + WS_XL), (const bf16*)(ws + WS_WRKV) + (size_t)lj * 3840 * 1024, 6 * T, 3840, 1024};
                SchedB1 S{G, (int)blockIdx.x}; EpiB1 E{(bf16*)(ws + WS_RKV), (bf16*)(ws + WS_L1)};
                pg8::gemm_phase<EpiB1, SchedB1, true, true, false>(lds, g, S, E, tid); } PH_END
            PH_BEGIN(3) {
                pg8::Gemm g{(const bf16*)(ws + WS_L1), (const bf16*)(ws + WS_L2T) + (size_t)lj * 5120 * 128, 3 * T, 5120, 128};
                SchedB2 S{G, (int)blockIdx.x}; EpiB2 E{(bf16*)(ws + WS_RAWW), (bf16*)(ws + WS_RAWA), (bf16*)(ws + WS_G)};
                pg8::gemm_phase<EpiB2, SchedB2, true, true, false>(lds, g, S, E, tid); } PH_END
            PH_BEGIN(5) phase_s1_chunks(a, lj, lds, tid, G, (MK_DBL >> 5) & 1 & (rep_ == 0)); PH_END
            PH_BEGIN(15) phase_s2_chain(a, wave, lane, G); PH_END
            PH_BEGIN(6) phase_s3_readout(a, lj, layer == 2 ? TL : T, gw, NGW, lane); PH_END
        } else {
            PH_BEGIN(7) phase_a_conv(a, layer, rows, gw, NGW, lane); PH_END
            PH_BEGIN(8) {
                pg8::Gemm g{(const bf16*)(ws + WS_XL), (const bf16*)(ws + WS_WIN) + (size_t)lj * 3072 * 1024, rows, 3072, 1024};
                SchedStd S{G, (int)blockIdx.x, nmt, 12}; EpiWin E{(bf16*)(ws + WS_BG), (bf16*)(ws + WS_CUZ)};
                pg8::gemm_phase<EpiWin, SchedStd, true, true, false>(lds, g, S, E, tid); } PH_END
            PH_BEGIN(9) phase_cv(a, lj, rows, gw, NGW, lane); PH_END
        }
        PH_BEGIN(10) {
            const bf16* Wt = kind == 0 ? (const bf16*)(ws + WS_WO) + (size_t)lj * 1024 * 1024 : (const bf16*)(ws + WS_WOUT) + (size_t)lj * 1024 * 1024;
            pg8::Gemm g{(const bf16*)(ws + WS_Z), Wt, rows, 1024, 1024};
            SchedStd S{G, (int)blockIdx.x, layer == 2 ? NMT_L : nmt, 4}; EpiRes E{(float*)(ws + (layer < 2 ? WS_XSA : WS_XSB)), (const float*)(ws + WS_MODS) + (size_t)layer * 5 * 6144 + 2 * 1024, (float*)(ws + (rep_ ? WS_XL : (layer < 2 ? WS_XSA : WS_XSB)))};
            pg8::gemm_phase<EpiRes, SchedStd, true, true, false>(lds, g, S, E, tid); } PH_END
        PH_BEGIN(11) phase_e_route_mfma(a, layer, rows_moe, lds, tid, wave, gw, NGW, lane, rep_); PH_END
        PH_BEGIN(12) {
            const int nt = __builtin_amdgcn_readfirstlane(moe_tables((const unsigned*)(ws + WS_CTL) + CW_CNT + layer * 32 * CNT_STRIDE, lds, tid));
            pg8::Gemm g{(const bf16*)(ws + WS_H2), (const bf16*)(ws + WS_WGU) + (size_t)layer * 32 * 2048 * 1024, 0, 0, 1024};
            SchedMoe S{G, (int)blockIdx.x, 8, nt, 2, lds, (const int*)(ws + WS_SLOTL), nullptr, wave};
            EpiGU E{(bf16*)(ws + WS_INTER), a.in[30] + (size_t)layer * 32 * 2048};
            pg8::gemm_phase<EpiGU, SchedMoe, true, true, true>(lds, g, S, E, tid); } PH_END
        PH_BEGIN(13) {
            const int nt = __builtin_amdgcn_readfirstlane(moe_tables((const unsigned*)(ws + WS_CTL) + CW_CNT + layer * 32 * CNT_STRIDE, lds, tid));
            pg8::Gemm g{(const bf16*)(ws + WS_INTER), (const bf16*)(ws + WS_WDN) + (size_t)layer * 32 * 1024 * 1024, 0, 0, 1024};
            SchedMoe S{G, (int)blockIdx.x, 4, nt, 8, lds, (const int*)(ws + WS_SLOTL), (const float*)(ws + WS_GATEL), wave};
            EpiDown E{(bf16*)(ws + WS_YS), a.in[32] + (size_t)layer * 32 * 1024, lds};
            pg8::gemm_phase<EpiDown, SchedMoe, true, true, false>(lds, g, S, E, tid); } PH_END
    }
    PH_BEGIN(14) phase_final(a, gw, NGW, lane); PH_END
#undef PH_BEGIN
#undef PH_END
}

extern "C" void kernel_launch(void* const* d_in, const int* in_sizes, int n_in, void* d_out, int out_size, void* d_ws, size_t ws_size, hipStream_t stream) {
    static int grid = 0;
    if (grid == 0) {
        if (n_in != 33 || in_sizes[0] != TL * D || out_size != TL * D || ws_size < WS_END) { fprintf(stderr, "kernel_launch: unexpected problem (n_in %d, in0 %d, out %d, ws %zu < %zu)\n", n_in, n_in > 0 ? in_sizes[0] : -1, out_size, ws_size, (size_t)WS_END); grid = -1; return; }
        int dev = 0, cus = 0, per_cu = 0;
        if (hipGetDevice(&dev) != hipSuccess || hipDeviceGetAttribute(&cus, hipDeviceAttributeMultiprocessorCount, dev) != hipSuccess) { grid = -1; return; }
        if (hipFuncSetAttribute((const void*)fwd_kernel, hipFuncAttributeMaxDynamicSharedMemorySize, LDS_BYTES) != hipSuccess) { fprintf(stderr, "kernel_launch: hipFuncSetAttribute failed\n"); grid = -1; return; }
        if (hipOccupancyMaxActiveBlocksPerMultiprocessor(&per_cu, (const void*)fwd_kernel, 512, LDS_BYTES) != hipSuccess || per_cu < 1) fprintf(stderr, "kernel_launch: occupancy query says %d\n", per_cu);
        (void)hipGetLastError();
        grid = cus;
    }
    if (grid < 0) return;
    if (hipMemsetAsync((char*)d_ws + WS_CTL, 0, CTL_ZERO_BYTES, stream) != hipSuccess) return;
    Args a{};
    for (int i = 0; i < 33; ++i) a.in[i] = (const float*)d_in[i];
    a.out = (float*)d_out; a.ws = (unsigned char*)d_ws;
#if MK_PER_PHASE
    for (int p = 0; p < NPHASES; ++p) { a.ph_lo = p; a.ph_hi = p + 1; hipLaunchKernelGGL(fwd_kernel, dim3(grid), dim3(512), LDS_BYTES, stream, a); }
#else
    a.ph_lo = 0; a.ph_hi = NPHASES;
    hipLaunchKernelGGL(fwd_kernel, dim3(grid), dim3(512), LDS_BYTES, stream, a);
#endif
    const hipError_t le = hipPeekAtLastError();
    if (le != hipSuccess) fprintf(stderr, "kernel_launch: launch failed: %s\n", hipGetErrorName(le));
}
```

```cpp
#include <hip/hip_runtime.h>
#include <cstdio>
#include <cstdint>

#ifndef MK_PER_PHASE
#define MK_PER_PHASE 0
#endif

constexpr int D = 1024, NBATCH = 4, SEQ = 8192, TL = NBATCH * SEQ, CTXL = 256, TC = NBATCH * CTXL, T = TL + TC;
constexpr int NH = 16, HS = 64, NE = 32, TOPK = 4, DEPTH = 4;
constexpr int NMT = T / 256;
constexpr int NMT_L = TL / 256;
constexpr int MAXTILES = (T * TOPK) / 256 + NE;
constexpr int NSTEP = CTXL + SEQ;

__device__ __forceinline__ int lane_id() { return (int)__builtin_amdgcn_mbcnt_hi(~0u, __builtin_amdgcn_mbcnt_lo(~0u, 0u)); }
namespace pg8 {
#define PG8_LAS __attribute__((address_space(3)))
typedef unsigned short bf16_t;
typedef short bf16x8 __attribute__((ext_vector_type(8)));
typedef float f32x4 __attribute__((ext_vector_type(4)));
typedef unsigned u32x4 __attribute__((ext_vector_type(4)));
typedef unsigned u32x2 __attribute__((ext_vector_type(2)));
constexpr int BM = 256, BK = 64, HALF = 128, HTB = HALF * BK * 2  , STAGE_BYTES = 8 * HTB, NXCD = 8, WGM = 8;

__host__ __device__ __forceinline__ int lds_byte(int r, int c) { const int st = (r >> 4) * 2 + (c >> 5), rr = r & 15, cc = c & 31, ob = rr * 64 + cc * 2; return st * 1024 + (ob ^ (((ob >> 9) & 1) << 5)); }
__host__ __device__ __forceinline__ void stage_rc(int b, int& R, int& C) { const int st = b / 1024, sb = b % 1024, swz = sb ^ (((sb >> 9) & 1) << 5); R = (st >> 1) * 16 + swz / 64; C = (st & 1) * 32 + (swz % 64) / 2; }
__host__ __device__ __forceinline__ int perm32(int rho) { const int n = rho >> 4, i = rho & 15; return 8 * (i >> 2) + 4 * n + (i & 3); }

struct Unit { int pm, pn, e, nv, par; };
struct Gemm { const bf16_t* A; const bf16_t* Bt; int M, N, K; };

__device__ __forceinline__ void tile_map(int wgid, int nM, int nN, int& pm, int& pn) {
    const int nwg = nM * nN;
    { const int q = nwg / NXCD, r = nwg % NXCD, xcd = wgid % NXCD, off = wgid / NXCD; wgid = (xcd < r ? xcd * (q + 1) : r * (q + 1) + (xcd - r) * q) + off; }
    const int nig = WGM * nN, gid = wgid / nig, fm = gid * WGM, gsz = (nM - fm) < WGM ? (nM - fm) : WGM;
    pm = fm + ((wgid % nig) % gsz); pn = (wgid % nig) / gsz;
}
typedef __bf16 bf16x2_t __attribute__((ext_vector_type(2)));
typedef float f32x2_t __attribute__((ext_vector_type(2)));
__device__ __forceinline__ unsigned cvt_pk_bf16(float lo, float hi) { const f32x2_t v = {lo, hi}; const bf16x2_t b = __builtin_convertvector(v, bf16x2_t); return __builtin_bit_cast(unsigned, b); }

template <class Epi, class Sched, bool ALIGN_EPI = false, bool SP2 = false, bool GATHER = false>
__device__ __forceinline__ void gemm_phase(PG8_LAS unsigned char* lds, const Gemm g, const Sched& S, const Epi& E, int tid_in) {
    int tid_ = tid_in; asm volatile("" : "+v"(tid_));
    const int tid = tid_, wid = __builtin_amdgcn_readfirstlane(tid >> 6), lane = tid & 63, wr = wid >> 2, wc = wid & 3, fr = lane & 15, fq = lane >> 4;
    int K_ = g.K; asm volatile("" : "+s"(K_));
    const int K = K_, nt = K / BK;
    unsigned voffA[2], voffB[2]; int gR[2]; unsigned gC[2];
#pragma unroll
    for (int i = 0; i < 2; ++i) { int R, C; stage_rc(tid * 16 + i * 8192, R, C); const int Rb = Epi::PERM ? ((R & ~31) + perm32(R & 31)) : R;
        voffA[i] = (unsigned)(R * K + C) * 2u; voffB[i] = (unsigned)(Rb * K + C) * 2u; gR[i] = R; gC[i] = (unsigned)C * 2u; }
    unsigned oc[2][2], on[2][2], o2[2][2];
#pragma unroll
    for (int h = 0; h < 2; ++h)
#pragma unroll
        for (int i = 0; i < 2; ++i) { oc[h][i] = 0u; on[h][i] = 0u; o2[h][i] = 0u; }
    const size_t kstep = (size_t)(BK * 2);
    const size_t hstep = (size_t)HALF * K * 2;
    const size_t tstep = 2 * hstep;
    const unsigned ldsw = (unsigned)wid * 1024u;
    const int aoff = lds_byte(wr * 64 + fr, fq * 8), boff = lds_byte(wc * 32 + fr, fq * 8);
#define PG8_SA(b, h) (((b) * 2 + (h)) * HTB)
#define PG8_SB(b, h) ((4 + (b) * 2 + (h)) * HTB)
#define PG8_STAGE(bufoff, gbase, voff) do { _Pragma("unroll") for (int _i = 0; _i < 2; ++_i) \
        __builtin_amdgcn_global_load_lds((const unsigned*)((const char*)(gbase) + (voff)[_i]), (PG8_LAS unsigned*)(lds + (bufoff) + ldsw + _i * 8192), 16, 0, 0); } while (0)
#define PG8_STAGE_A(bufoff, base, h, O) do { if constexpr (GATHER) { PG8_STAGE(bufoff, base, (O)[h]); } else { PG8_STAGE(bufoff, (base) + (h) * hstep, voffA); } } while (0)
#define PG8_LDA(dst, b, h) do { _Pragma("unroll") for (int m = 0; m < 4; ++m) _Pragma("unroll") for (int k = 0; k < 2; ++k) dst[m][k] = *(const PG8_LAS bf16x8*)(lds + PG8_SA(b, h) + aoff + m * 2048 + k * 1024); } while (0)
#define PG8_LDB(dst, b, h) do { _Pragma("unroll") for (int n = 0; n < 2; ++n) _Pragma("unroll") for (int k = 0; k < 2; ++k) dst[n][k] = *(const PG8_LAS bf16x8*)(lds + PG8_SB(b, h) + boff + n * 2048 + k * 1024); } while (0)
#define PG8_MMA(ai, bj, At, Bt) do { __builtin_amdgcn_s_setprio(1); _Pragma("unroll") for (int m = 0; m < 4; ++m) _Pragma("unroll") for (int n = 0; n < 2; ++n) _Pragma("unroll") for (int k = 0; k < 2; ++k) \
        acc[ai][bj][m][n] = __builtin_amdgcn_mfma_f32_16x16x32_bf16(Bt[n][k], At[m][k], acc[ai][bj][m][n], 0, 0, 0); __builtin_amdgcn_s_setprio(0); } while (0)
#define PG8_WAIT_V(n) asm volatile("s_waitcnt vmcnt(" #n ")" ::: "memory")
#define PG8_WAIT_L(n) asm volatile("s_waitcnt lgkmcnt(" #n ")" ::: "memory")
#define PG8_BAR __builtin_amdgcn_s_barrier()
#define PG8_SCHED __builtin_amdgcn_sched_barrier(0)
    Unit cur, nxt; int ui = 0;
    if (!S.next(0, cur)) return;
    f32x4 acc[2][2][4][2];
#pragma unroll
    for (int a = 0; a < 2; ++a)
#pragma unroll
        for (int b = 0; b < 2; ++b)
#pragma unroll
            for (int m = 0; m < 4; ++m)
#pragma unroll
                for (int n = 0; n < 2; ++n) acc[a][b][m][n] = (f32x4){0.f, 0.f, 0.f, 0.f};
    bf16x8 At[4][2], B0[2][2], B1[2][2];
    const char* cA = GATHER ? (const char*)g.A : (const char*)g.A + (size_t)cur.pm * tstep; const char* cB = (const char*)g.Bt + (size_t)cur.pn * tstep;
    S.a_ready(cur);
    if constexpr (GATHER) {
#pragma unroll
        for (int h = 0; h < 2; ++h)
#pragma unroll
            for (int i = 0; i < 2; ++i) oc[h][i] = S.row_off(cur, h * HALF + gR[i]) + gC[i];
    }
    if constexpr (SP2) {
        PG8_STAGE(PG8_SB(0, 0), cB, voffB); PG8_STAGE(PG8_SB(0, 1), cB + hstep, voffB); PG8_STAGE_A(PG8_SA(0, 0), cA, 0, oc); PG8_STAGE_A(PG8_SA(0, 1), cA, 1, oc);
        if (wr == 1) PG8_BAR;
        PG8_WAIT_V(2); PG8_BAR;
        PG8_STAGE(PG8_SB(1, 0), cB + kstep, voffB); PG8_STAGE_A(PG8_SA(1, 0), cA + kstep, 0, oc); PG8_STAGE(PG8_SB(1, 1), cB + hstep + kstep, voffB);
        PG8_WAIT_V(6); PG8_BAR;
    } else {
        PG8_STAGE(PG8_SB(0, 0), cB, voffB); PG8_STAGE_A(PG8_SA(0, 0), cA, 0, oc); PG8_STAGE(PG8_SB(0, 1), cB + hstep, voffB); PG8_STAGE_A(PG8_SA(0, 1), cA, 1, oc);
        if (wr == 1) PG8_BAR;
        PG8_WAIT_V(4); PG8_BAR;
        PG8_STAGE(PG8_SB(1, 0), cB + kstep, voffB); PG8_STAGE_A(PG8_SA(1, 0), cA + kstep, 0, oc); PG8_STAGE(PG8_SB(1, 1), cB + hstep + kstep, voffB);
        PG8_WAIT_V(6); PG8_BAR;
    }
    for (;;) {
        const bool has_next = S.next(ui + 1, nxt);
        const char* nA = GATHER ? (const char*)g.A : (has_next ? (const char*)g.A + (size_t)nxt.pm * tstep : cA); const char* nB = has_next ? (const char*)g.Bt + (size_t)nxt.pn * tstep : cB;
        if constexpr (GATHER) { if (has_next) S.prefetch_rows(nxt); }
        for (int t = 0; t < nt; t += 2) {
            const bool last = (t == nt - 2);
            const char* a1 = cA + (size_t)(t + 1) * kstep;
            const char* a2 = last ? nA : cA + (size_t)(t + 2) * kstep; const char* b2 = last ? nB : cB + (size_t)(t + 2) * kstep;
            const char* a3 = a2 + kstep; const char* b3 = b2 + kstep;
            if constexpr (GATHER) {
                if (last) {
#pragma unroll
                    for (int h = 0; h < 2; ++h)
#pragma unroll
                        for (int i = 0; i < 2; ++i) on[h][i] = has_next ? (S.row_off_lds(nxt, h * HALF + gR[i]) + gC[i]) : oc[h][i];
                }
#pragma unroll
                for (int h = 0; h < 2; ++h)
#pragma unroll
                    for (int i = 0; i < 2; ++i) o2[h][i] = last ? on[h][i] : oc[h][i];
            }
            if (last && has_next) S.a_ready(nxt);
            if constexpr (SP2) {
            PG8_LDB(B0, 0, 0); PG8_LDB(B1, 0, 1); PG8_SCHED; PG8_LDA(At, 0, 0); PG8_STAGE_A(PG8_SA(1, 1), a1, 1, oc);
            PG8_WAIT_V(8); PG8_WAIT_L(0); PG8_BAR; PG8_MMA(0, 0, At, B0); PG8_MMA(0, 1, At, B1); PG8_BAR; PG8_SCHED;
            PG8_LDA(At, 0, 1); PG8_STAGE(PG8_SB(0, 0), b2, voffB); PG8_STAGE(PG8_SB(0, 1), b2 + hstep, voffB); PG8_STAGE_A(PG8_SA(0, 0), a2, 0, o2);
            PG8_WAIT_V(8); PG8_WAIT_L(0); PG8_BAR; PG8_MMA(1, 0, At, B0); PG8_MMA(1, 1, At, B1); PG8_BAR; PG8_SCHED;
            PG8_LDB(B0, 1, 0); PG8_LDB(B1, 1, 1); PG8_SCHED; PG8_LDA(At, 1, 0); PG8_STAGE_A(PG8_SA(0, 1), a2, 1, o2);
            PG8_WAIT_V(8); PG8_WAIT_L(0); PG8_BAR; PG8_MMA(0, 0, At, B0); PG8_MMA(0, 1, At, B1); PG8_BAR; PG8_SCHED;
            PG8_LDA(At, 1, 1); PG8_STAGE(PG8_SB(1, 0), b3, voffB); PG8_STAGE(PG8_SB(1, 1), b3 + hstep, voffB); PG8_STAGE_A(PG8_SA(1, 0), a3, 0, o2);
            PG8_WAIT_V(8); PG8_WAIT_L(0); PG8_BAR; PG8_MMA(1, 0, At, B0); PG8_MMA(1, 1, At, B1); PG8_BAR; PG8_SCHED;
            } else {
            PG8_LDB(B0, 0, 0); PG8_SCHED; PG8_LDA(At, 0, 0); PG8_STAGE_A(PG8_SA(1, 1), a1, 1, oc);
            PG8_WAIT_L(8); PG8_BAR; PG8_WAIT_L(0); PG8_MMA(0, 0, At, B0); PG8_BAR; PG8_SCHED;
            PG8_LDB(B1, 0, 1); PG8_STAGE(PG8_SB(0, 0), b2, voffB);
            PG8_BAR; PG8_WAIT_L(0); PG8_MMA(0, 1, At, B1); PG8_BAR;
            PG8_LDA(At, 0, 1); PG8_STAGE_A(PG8_SA(0, 0), a2, 0, o2);
            PG8_BAR; PG8_WAIT_L(0); PG8_MMA(1, 0, At, B0); PG8_BAR; PG8_SCHED;
            PG8_STAGE(PG8_SB(0, 1), b2 + hstep, voffB);
            PG8_WAIT_V(6); PG8_BAR; PG8_MMA(1, 1, At, B1); PG8_BAR;
            PG8_LDB(B0, 1, 0); PG8_SCHED; PG8_LDA(At, 1, 0); PG8_STAGE_A(PG8_SA(0, 1), a2, 1, o2);
            PG8_WAIT_L(8); PG8_BAR; PG8_WAIT_L(0); PG8_MMA(0, 0, At, B0); PG8_BAR; PG8_SCHED;
            PG8_LDB(B1, 1, 1); PG8_STAGE(PG8_SB(1, 0), b3, voffB);
            PG8_BAR; PG8_WAIT_L(0); PG8_MMA(0, 1, At, B1); PG8_BAR;
            PG8_LDA(At, 1, 1); PG8_STAGE_A(PG8_SA(1, 0), a3, 0, o2);
            PG8_BAR; PG8_WAIT_L(0); PG8_MMA(1, 0, At, B0); PG8_BAR; PG8_SCHED;
            PG8_STAGE(PG8_SB(1, 1), b3 + hstep, voffB);
            PG8_WAIT_V(6); PG8_BAR; PG8_MMA(1, 1, At, B1); PG8_BAR;
            }
        }
        if constexpr (ALIGN_EPI) { if (wr == 0) PG8_BAR; }
        if constexpr (!Epi::AFTER_DRAIN) { E(acc, cur, wr, wc, fr, fq); S.done(cur); }
        if (!has_next) break;
#pragma unroll
        for (int a = 0; a < 2; ++a)
#pragma unroll
            for (int b = 0; b < 2; ++b)
#pragma unroll
                for (int m = 0; m < 4; ++m)
#pragma unroll
                    for (int n = 0; n < 2; ++n) acc[a][b][m][n] = (f32x4){0.f, 0.f, 0.f, 0.f};
        cur = nxt; cA = nA; cB = nB; ++ui;
        if constexpr (GATHER) {
#pragma unroll
            for (int h = 0; h < 2; ++h)
#pragma unroll
                for (int i = 0; i < 2; ++i) oc[h][i] = on[h][i];
        }
        if constexpr (ALIGN_EPI) { if (wr == 1) PG8_BAR; }
    }
    PG8_WAIT_V(0);
    if constexpr (!ALIGN_EPI) { if (wr == 0) PG8_BAR; }
    PG8_BAR;
    if constexpr (Epi::AFTER_DRAIN) { E.fused(acc, cur, wr, wc, fr, fq, lds, wid, lane); S.done(cur); }
#undef PG8_SA
#undef PG8_SB
#undef PG8_STAGE
#undef PG8_STAGE_A
#undef PG8_LDA
#undef PG8_LDB
#undef PG8_MMA
#undef PG8_WAIT_V
#undef PG8_WAIT_L
#undef PG8_BAR
#undef PG8_SCHED
}
}

#define LAS __attribute__((address_space(3)))
typedef unsigned short bf16;
typedef float f32x4 __attribute__((ext_vector_type(4)));
typedef unsigned u32x2 __attribute__((ext_vector_type(2)));
typedef unsigned u32x4 __attribute__((ext_vector_type(4)));
#define LDS_WAIT() asm volatile("s_waitcnt lgkmcnt(0)" ::: "memory")
__device__ __forceinline__ unsigned pk2(float lo, float hi) { return pg8::cvt_pk_bf16(lo, hi); }
__device__ __forceinline__ unsigned f2bf(float f) { return pk2(f, f) & 0xffffu; }
__device__ __forceinline__ float bflo(unsigned w) { return __builtin_bit_cast(float, w << 16); }
__device__ __forceinline__ float bfhi(unsigned w) { return __builtin_bit_cast(float, w & 0xffff0000u); }
__device__ __forceinline__ float wave_sum(float v) {
#pragma unroll
    for (int o = 1; o < 64; o <<= 1) v += __shfl_xor(v, o);
    return v;
}
__device__ __forceinline__ float frcp(float x) { return __builtin_amdgcn_rcpf(x); }
__device__ __forceinline__ float sigm(float x) { return frcp(1.0f + __expf(-x)); }
__device__ __forceinline__ float tanh_fast(float x) { const float e = __expf(2.0f * x); return 1.0f - 2.0f * frcp(e + 1.0f); }

constexpr size_t MiB = 1u << 20;
constexpr size_t RF = (size_t)T * D * 4;
constexpr size_t RB = (size_t)T * D * 2;
constexpr size_t WS_CTL = 0, CTL_ZERO_BYTES = 1 * MiB;
constexpr size_t WS_MODS = 1 * MiB;
constexpr size_t WS_XSA = 2 * MiB, WS_XSB = WS_XSA + RF;
constexpr size_t WS_XL = WS_XSB + RF;
constexpr size_t WS_RKV = WS_XL + 6 * RB;
constexpr size_t WS_L1 = WS_RKV + 3 * RF;
constexpr size_t WS_WDEC = WS_L1 + 50 * MiB;
constexpr size_t WS_AA = WS_WDEC + 2 * RF;
constexpr size_t WS_G = WS_AA + 2 * RF;
constexpr size_t WS_KK = WS_G + RB;
constexpr size_t WS_KD = WS_KK + RF;
constexpr size_t WS_BETA = WS_KD + 2 * RF;
constexpr size_t WS_RKB = WS_BETA + 2 * RF;
constexpr size_t WS_C12 = WS_RKB + 3 * MiB;
constexpr size_t WS_WRT = WS_C12 + 6 * MiB;
constexpr size_t WS_Y = WS_C12 + 9 * MiB;
constexpr size_t WS_Z = WS_Y + 2 * RF;
constexpr size_t WS_H2 = WS_Z + RB;
constexpr size_t WS_SLOTL = WS_H2 + RB;
constexpr size_t WS_GATEL = WS_SLOTL + 5 * MiB;
constexpr size_t WS_WRKV = WS_GATEL + 5 * MiB;
constexpr size_t WS_L2T = WS_WRKV + 15 * MiB;
constexpr size_t WS_WO = WS_L2T + 5 * MiB;
constexpr size_t WS_WIN = WS_WO + 4 * MiB;
constexpr size_t WS_WOUT = WS_WIN + 12 * MiB;
constexpr size_t WS_WGU = WS_WOUT + 4 * MiB;
constexpr size_t WS_WDN = WS_WGU + 512 * MiB;
constexpr size_t WS_END = WS_WDN + 256 * MiB;
constexpr size_t WS_INTER = WS_WDEC;
constexpr size_t WS_YS = WS_KD;
constexpr size_t WS_BG = WS_RKV, WS_CUZ = WS_RKV + RB;
constexpr size_t WS_RAWW = WS_AA, WS_RAWA = WS_AA + RF;
constexpr size_t WS_RH = WS_AA;
constexpr size_t WS_PM = WS_WDEC;
constexpr size_t WS_RKB1 = WS_C12 + 1 * MiB;
constexpr size_t WS_QT = WS_XL;
constexpr size_t WS_HT = WS_XL + RF;
static_assert((size_t)128 * 132 * 4096 * 2 <= RF, "chunk state tensors");
static_assert((size_t)MAXTILES * 256 * 1024 * 2 <= 4 * RF, "INTER overlay");
static_assert((size_t)T * 4 * 1024 * 2 <= 2 * RF, "YS overlay");
static_assert((size_t)3 * T * 256 * 2 <= 50 * MiB, "L1OUT");
constexpr int CW_BAR = 4096;
constexpr int CW_CNT = 16384, CNT_STRIDE = 64;

constexpr int RING_BYTES = 131072;
constexpr int LDSCTL_OFF = RING_BYTES + 4096;
constexpr int LDS_BYTES = LDSCTL_OFF + 16384;

struct Args { const float* in[33]; float* out; unsigned char* ws; int ph_lo, ph_hi; };

__device__ __forceinline__ void transpose_item(const float* W, int N, bf16* WT, int dstK, int drow0, int k0, int n0, LAS float* scr, int lane) {
    float tv[32];
#pragma unroll
    for (int i = 0; i < 32; ++i) { const int kk = 2 * i + (lane >> 5); tv[i] = W[(size_t)(k0 + kk) * N + n0 + (lane & 31)]; }
#pragma unroll
    for (int i = 0; i < 32; ++i) { const int kk = 2 * i + (lane >> 5); scr[kk * 33 + (lane & 31)] = tv[i]; }
    LDS_WAIT(); asm volatile("" ::: "memory");
    const int c = lane & 7;
#pragma unroll
    for (int j = 0; j < 4; ++j) { const int n = (lane >> 3) + 8 * j; const LAS float* s = scr + (8 * c) * 33 + n;
        u32x4 o; o.x = pk2(s[0 * 33], s[1 * 33]); o.y = pk2(s[2 * 33], s[3 * 33]); o.z = pk2(s[4 * 33], s[5 * 33]); o.w = pk2(s[6 * 33], s[7 * 33]);
        *(u32x4*)(WT + (size_t)(drow0 + n) * dstK + k0 + 8 * c) = o; }
    LDS_WAIT(); asm volatile("" ::: "memory");
}
__device__ __forceinline__ int gu_map(int n0) { const int bj = n0 >= 1024 ? 1 : 0, f0 = n0 - bj * 1024; return (f0 >> 7) * 256 + bj * 128 + (f0 & 127); }
__device__ __forceinline__ int conv_map(int n0) { if (n0 < 1024) return n0; const int q = (n0 - 1024) >> 10, f0 = (n0 - 1024) & 1023; return 1024 + (f0 >> 7) * 256 + q * 128 + (f0 & 127); }

__device__ __forceinline__ void p0_prologue(const Args& a, LAS unsigned char* lds, int tid, int lane, int wave, int G) {
    unsigned char* ws = a.ws;
    LAS float* sl = (LAS float*)lds;
    LAS float* red = (LAS float*)(lds + 20480);
    for (int i = tid; i < 5 * 1024; i += 512) { const int r = i >> 10, k = i & 1023; const float cv = r < 4 ? a.in[1][r * 1024 + k] : a.in[3][k]; sl[i] = cv * sigm(cv); }
    __syncthreads();
    float* MODS = (float*)(ws + WS_MODS);
    for (int it = blockIdx.x; it < 4 * 96; it += G) {
        const int l = it / 96, n = (it % 96) * 64 + lane;
        const float* W = a.in[4] + (size_t)l * 1024 * 6144 + n;
        float acc[5] = {0.f, 0.f, 0.f, 0.f, 0.f};
        const int kb = wave * 128;
#pragma unroll 8
        for (int k = 0; k < 128; ++k) { const float wv = W[(size_t)(kb + k) * 6144];
#pragma unroll
            for (int r = 0; r < 5; ++r) acc[r] += sl[r * 1024 + kb + k] * wv; }
#pragma unroll
        for (int r = 0; r < 5; ++r) red[(wave * 5 + r) * 64 + lane] = acc[r];
        __syncthreads();
        if (wave < 5) { float s = a.in[5][l * 6144 + n];
#pragma unroll
            for (int w = 0; w < 8; ++w) s += red[(w * 5 + wave) * 64 + lane];
            MODS[(size_t)(l * 5 + wave) * 6144 + n] = s; }
        __syncthreads();
    }
    LAS float* scr = (LAS float*)(lds + 32768 + wave * 8448);
    const int gw = blockIdx.x * 8 + wave, NGW = G * 8;
    bf16* WRKV = (bf16*)(ws + WS_WRKV); bf16* WOt = (bf16*)(ws + WS_WO); bf16* WINt = (bf16*)(ws + WS_WIN); bf16* WOUTt = (bf16*)(ws + WS_WOUT);
    bf16* WGU = (bf16*)(ws + WS_WGU); bf16* WDN = (bf16*)(ws + WS_WDN);
    constexpr int I_GU = 128 * 1024, I_DN = 128 * 512, I_RKV = 6 * 512, I_WO = 2 * 512, I_WIN = 2 * 1536, I_WOUT = 2 * 512, I_W1 = 4 * 32, I_A1 = 4 * 32, I_G1 = 2 * 64;
    constexpr int NITEMS = I_GU + I_DN + I_RKV + I_WO + I_WIN + I_WOUT + I_W1 + I_A1 + I_G1;
    for (int it = gw; it < NITEMS; it += NGW) {
        int r = it;
        if (r < I_GU) { const int m = r >> 10, q = r & 1023, kb = q >> 6, nb = q & 63;
            transpose_item(a.in[29] + (size_t)m * 1024 * 2048, 2048, WGU + (size_t)m * 2048 * 1024, 1024, gu_map(nb * 32), kb * 64, nb * 32, scr, lane); continue; } r -= I_GU;
        if (r < I_DN) { const int m = r >> 9, q = r & 511, kb = q >> 5, nb = q & 31;
            transpose_item(a.in[31] + (size_t)m * 1024 * 1024, 1024, WDN + (size_t)m * 1024 * 1024, 1024, nb * 32, kb * 64, nb * 32, scr, lane); continue; } r -= I_DN;
        if (r < I_RKV) { const int m = r >> 9, q = r & 511, kb = q >> 5, nb = q & 31, lr = m / 3, j = m % 3;
            transpose_item(a.in[9] + (size_t)m * 1024 * 1024, 1024, WRKV + (size_t)lr * 3840 * 1024, 1024, j * 1024 + nb * 32, kb * 64, nb * 32, scr, lane); continue; } r -= I_RKV;
        if (r < I_WO) { const int m = r >> 9, q = r & 511, kb = q >> 5, nb = q & 31;
            transpose_item(a.in[23] + (size_t)m * 1024 * 1024, 1024, WOt + (size_t)m * 1024 * 1024, 1024, nb * 32, kb * 64, nb * 32, scr, lane); continue; } r -= I_WO;
        if (r < I_WIN) { const int m = r / 1536, q = r % 1536, kb = q / 96, nb = q % 96;
            transpose_item(a.in[24] + (size_t)m * 1024 * 3072, 3072, WINt + (size_t)m * 3072 * 1024, 1024, conv_map(nb * 32), kb * 64, nb * 32, scr, lane); continue; } r -= I_WIN;
        if (r < I_WOUT) { const int m = r >> 9, q = r & 511, kb = q >> 5, nb = q & 31;
            transpose_item(a.in[26] + (size_t)m * 1024 * 1024, 1024, WOUTt + (size_t)m * 1024 * 1024, 1024, nb * 32, kb * 64, nb * 32, scr, lane); continue; } r -= I_WOUT;
        if (r < I_W1) { const int m = r >> 5, q = r & 31, kb = q >> 1, nb = q & 1, lr = m >> 1, e = m & 1;
            transpose_item(a.in[11] + (size_t)m * 1024 * 64, 64, WRKV + (size_t)lr * 3840 * 1024, 1024, 3072 + e * 64 + nb * 32, kb * 64, nb * 32, scr, lane); continue; } r -= I_W1;
        if (r < I_A1) { const int m = r >> 5, q = r & 31, kb = q >> 1, nb = q & 1, lr = m >> 1, e = m & 1;
            transpose_item(a.in[14] + (size_t)m * 1024 * 64, 64, WRKV + (size_t)lr * 3840 * 1024, 1024, 3328 + e * 64 + nb * 32, kb * 64, nb * 32, scr, lane); continue; } r -= I_A1;
        { const int m = r >> 6, q = r & 63, kb = q >> 2, nb = q & 3;
            transpose_item(a.in[16] + (size_t)m * 1024 * 128, 128, WRKV + (size_t)m * 3840 * 1024, 1024, 3584 + nb * 32, kb * 64, nb * 32, scr, lane); }
    }
    const int gt = blockIdx.x * 512 + tid, NGT = G * 512;
    for (int i = gt; i < 2 * 3 * 128 * 128; i += NGT) {
        const int pc = i & 127, rw = (i >> 7) & 127, pd = (i >> 14) % 3, lr = i / (3 * 16384);
        *(u32x4*)(WRKV + ((size_t)lr * 3840 + 3072 + pd * 256 + 128 + rw) * 1024 + pc * 8) = (u32x4){0u, 0u, 0u, 0u}; }
    bf16* L2T = (bf16*)(ws + WS_L2T);
    for (int i = gt; i < 2 * 128 * 5120; i += NGT) {
        const int n = i % 5120, k = (i / 5120) & 127, lr = i / (5120 * 128);
        float v = 0.f;
        if (n < 2048) { const int e = n >> 10, d = n & 1023; if ((k >> 6) == e) v = a.in[12][(((size_t)lr * 2 + e) * 64 + (k & 63)) * 1024 + d]; }
        else if (n < 4096) { const int e = (n - 2048) >> 10, d = n & 1023; if ((k >> 6) == e) v = a.in[15][(((size_t)lr * 2 + e) * 64 + (k & 63)) * 1024 + d]; }
        else { const int d = n - 4096; v = a.in[17][((size_t)lr * 128 + k) * 1024 + d]; }
        L2T[((size_t)lr * 5120 + n) * 128 + k] = (bf16)f2bf(v);
    }
    bf16* WRT = (bf16*)(ws + WS_WRT);
    for (int i = gt; i < 4 * 32 * 1024; i += NGT) { const int k = i & 1023, e = (i >> 10) & 31, l = i >> 15;
        const float w = a.in[27][((size_t)l * 1024 + k) * 32 + e]; const unsigned hi = f2bf(w); const float lo = w - bflo(hi);
        WRT[((size_t)(l * 2 + 0) * 32 + e) * 1024 + k] = (bf16)hi; WRT[((size_t)(l * 2 + 1) * 32 + e) * 1024 + k] = (bf16)f2bf(lo); }
}
#define XB_TMO      128
#define XB_XCNT(j)  (256  + 64 * (j))
#define XB_XSUB(j)  (1280 + 64 * (j))
#define XB_XGEN(j)  (2304 + 64 * (j))
#define XB_TOP      3328
#define XB_TOPGEN   3392
#define XCD_BAR_WORDS 3456
#define XB_SPIN_CAP (1u << 23)

__device__ __forceinline__ unsigned xb_ld(unsigned* p)              { return __hip_atomic_load(p, __ATOMIC_RELAXED, __HIP_MEMORY_SCOPE_AGENT); }
__device__ __forceinline__ unsigned xb_add(unsigned* p, unsigned v) { return __hip_atomic_fetch_add(p, v, __ATOMIC_RELAXED, __HIP_MEMORY_SCOPE_AGENT); }
__device__ __forceinline__ unsigned xb_xcc_id() { return (unsigned)__builtin_amdgcn_s_getreg((3 << 11) | 20) & 0xFu; }
#define XB_SPIN(cond, bar) do { unsigned _sp = 0; while (cond) { __builtin_amdgcn_s_sleep(1); \
    if ((++_sp & 255u) == 0u) { if (xb_ld(&(bar)[XB_TMO])) break; if (_sp > XB_SPIN_CAP) { atomicAdd(&(bar)[XB_TMO], 1u); break; } } } } while (0)

struct XcdBarrier {
    unsigned wv;
    unsigned* bar; unsigned x;
    volatile LAS unsigned* st;
};

__device__ __forceinline__ XcdBarrier xcd_barrier_post(unsigned* bar, volatile LAS unsigned* st) {
    XcdBarrier b; b.wv = (unsigned)__builtin_amdgcn_readfirstlane((int)(threadIdx.x >> 6)); b.bar = bar; b.x = xb_xcc_id(); b.st = st;
    if (threadIdx.x == 0) (void)xb_add(&bar[XB_XCNT(b.x)], 1u);
    return b;
}
__device__ __forceinline__ void xcd_barrier_complete(unsigned* bar, unsigned x, unsigned& nloc, unsigned& nx) {
    const unsigned G = gridDim.x * gridDim.y * gridDim.z;
    unsigned sum, cnt, mine, sp = 0u;
    for (;;) {
        sum = 0u; cnt = 0u; mine = 0u;
#pragma unroll
        for (unsigned j = 0; j < 16; ++j) { const unsigned c = xb_ld(&bar[XB_XCNT(j)]); sum += c; cnt += (c > 0u) ? 1u : 0u; mine = (j == x) ? c : mine; }
        if (sum == G) break;
        __builtin_amdgcn_s_sleep(1);
        if ((++sp & 255u) == 0u) { if (xb_ld(&bar[XB_TMO])) break; if (sp > XB_SPIN_CAP) { atomicAdd(&bar[XB_TMO], 1u); break; } }
    }
    nloc = mine > 0u ? mine : 1u; nx = cnt > 0u ? cnt : 1u;
}

__device__ __forceinline__ void xcd_barrier(const XcdBarrier& b) {
    asm volatile("s_waitcnt vmcnt(0)" ::: "memory");
    __syncthreads();
    if (b.wv == 0u && lane_id() == 0) {
        unsigned* bar = b.bar;
        __builtin_amdgcn_s_waitcnt(0);
        unsigned nloc = b.st[0], nx = b.st[1];
        if (nloc == 0u) { xcd_barrier_complete(bar, b.x, nloc, nx); b.st[0] = nloc; b.st[1] = nx; }
        const unsigned old = xb_add(&bar[XB_XSUB(b.x)], 1u);
        const unsigned gen = old / nloc;
        if (old + 1u == (gen + 1u) * nloc) {
            __builtin_amdgcn_fence(__ATOMIC_RELEASE, "agent");
            asm volatile("s_waitcnt vmcnt(0)" ::: "memory");
            const unsigned og = xb_add(&bar[XB_TOP], 1u);
            const unsigned tg = og / nx;
            if (og + 1u == (tg + 1u) * nx) xb_add(&bar[XB_TOPGEN], 1u);
            else XB_SPIN(xb_ld(&bar[XB_TOPGEN]) == tg, bar);
            __builtin_amdgcn_fence(__ATOMIC_ACQUIRE, "agent");
            xb_add(&bar[XB_XGEN(b.x)], 1u);
            asm volatile("s_waitcnt vmcnt(0)" ::: "memory");
        } else {
            XB_SPIN(xb_ld(&bar[XB_XGEN(b.x)]) == gen, bar);
            __builtin_amdgcn_fence(__ATOMIC_ACQUIRE, "agent");
            asm volatile("s_waitcnt vmcnt(0)" ::: "memory");
        }
    }
    __syncthreads();
}

__device__ __forceinline__ f32x4 bf4(u32x2 w) { return (f32x4){bflo(w.x), bfhi(w.x), bflo(w.y), bfhi(w.y)}; }
__device__ __forceinline__ int mod_row(int row) { return row < TL ? (row >> 13) : 4; }

__device__ __forceinline__ void load_x_combined(f32x4 (&x)[4], const float* xrow, bool has_prev, const bf16* YS, int t, const f32x4 (&m5)[4], int lane) {
#pragma unroll
    for (int j = 0; j < 4; ++j) x[j] = *(const f32x4*)(xrow + 256 * j + 4 * lane);
    if (has_prev) {
        u32x2 y[4][4];
#pragma unroll
        for (int k = 0; k < 4; ++k)
#pragma unroll
            for (int j = 0; j < 4; ++j) y[k][j] = *(const u32x2*)(YS + ((size_t)t * 4 + k) * 1024 + 256 * j + 4 * lane);
#pragma unroll
        for (int j = 0; j < 4; ++j) { const f32x4 s = (bf4(y[0][j]) + bf4(y[1][j])) + (bf4(y[2][j]) + bf4(y[3][j])); x[j] += m5[j] * s; }
    }
}
__device__ __forceinline__ float row_rstd(const f32x4 (&x)[4]) {
    float ss = 0.f;
#pragma unroll
    for (int j = 0; j < 4; ++j) ss += (x[j].x * x[j].x + x[j].y * x[j].y) + (x[j].z * x[j].z + x[j].w * x[j].w);
    return rsqrtf(wave_sum(ss) * (1.0f / 1024.0f) + 1e-6f);
}

__device__ __forceinline__ void phase_a_rwkv(const Args& a, int layer, LAS unsigned char* lds, int tid, int gw, int NGW, int lane) {
    unsigned char* ws = a.ws; const int lj = layer >> 1; const bool has_prev = layer > 0;
    const float* xin_lat = layer == 0 ? a.in[0] : (const float*)(ws + WS_XSA);
    const float* xin_ctx = layer == 0 ? a.in[2] : (const float*)(ws + WS_XSA) + (size_t)TL * D;
    float* xout = (float*)(ws + (layer == 0 ? WS_XSA : WS_XSB));
    const float* MODS = (const float*)(ws + WS_MODS); const bf16* YS = (const bf16*)(ws + WS_YS); bf16* XL = (bf16*)(ws + WS_XL);
    const float* mug = a.in[8] + (size_t)lj * 6 * 2 * 1024; const float* ng = a.in[6] + (size_t)(layer * 2 + 0) * 1024;
    LAS float* mu = (LAS float*)lds;
    for (int i = tid; i < 6 * 2 * 1024 / 4; i += 512) ((LAS f32x4*)mu)[i] = ((const f32x4*)mug)[i];
    __syncthreads();
    for (int it = gw; it < TL / 8 + TC / 2; it += NGW) {
        const int ntok = it < TL / 8 ? 8 : 2, t0 = it < TL / 8 ? it * 8 : TL + (it - TL / 8) * 2, mr = mod_row(t0);
        int rs, re; if (t0 < TL) { rs = t0 & ~63; re = rs + 63; } else { const int loc = t0 - TL; rs = TL + (loc & ~255); re = rs + 255; }
        const float* mod = MODS + (size_t)(layer * 5 + mr) * 6144;
        const float* m5p = MODS + (size_t)((has_prev ? layer - 1 : 0) * 5 + mr) * 6144 + 5 * 1024;
        f32x4 hm[4], h0[4], hp[4];
#pragma unroll
        for (int j = 0; j < 4; ++j) { hm[j] = (f32x4){0.f, 0.f, 0.f, 0.f}; h0[j] = hm[j]; hp[j] = hm[j]; }
        f32x4 rx[4], nx[4]; u32x2 ry[4][4], ny[4][4];
#define PA_LOAD(X, Y, tt) do { const int t_ = (tt); if (t_ >= rs && t_ <= re) { \
            const float* xrow_ = t_ < TL ? xin_lat + (size_t)t_ * D : xin_ctx + (size_t)(t_ - TL) * D; \
            _Pragma("unroll") for (int j = 0; j < 4; ++j) X[j] = *(const f32x4*)(xrow_ + 256 * j + 4 * lane); \
            if (has_prev) { _Pragma("unroll") for (int k = 0; k < 4; ++k) _Pragma("unroll") for (int j = 0; j < 4; ++j) Y[k][j] = *(const u32x2*)(YS + ((size_t)t_ * 4 + k) * 1024 + 256 * j + 4 * lane); } } } while (0)
#pragma unroll
        for (int j = 0; j < 4; ++j) { rx[j] = (f32x4){0.f, 0.f, 0.f, 0.f}; nx[j] = rx[j];
#pragma unroll
            for (int k = 0; k < 4; ++k) { ry[k][j] = (u32x2){0u, 0u}; ny[k][j] = ry[k][j]; } }
        PA_LOAD(rx, ry, t0 - 1);
        f32x4 gsc[4], sh4[4], m5v[4];
#pragma unroll
        for (int j = 0; j < 4; ++j) { const int col = 256 * j + 4 * lane; gsc[j] = *(const f32x4*)(ng + col) * (*(const f32x4*)(mod + 1024 + col) + 1.0f); sh4[j] = *(const f32x4*)(mod + col); m5v[j] = *(const f32x4*)(m5p + col); }
#pragma unroll
        for (int j = 0; j < 4; ++j) asm volatile("" : "+v"(gsc[j]), "+v"(sh4[j]), "+v"(m5v[j]), "+v"(rx[j]));
#pragma unroll 1
        for (int i = -1; i <= ntok; ++i) {
            const int t = t0 + i;
            if (i < ntok) PA_LOAD(nx, ny, t + 1);
            f32x4 hn[4];
            if (t >= rs && t <= re) {
                f32x4 x[4];
#pragma unroll
                for (int j = 0; j < 4; ++j) x[j] = rx[j];
                if (has_prev) {
#pragma unroll
                    for (int j = 0; j < 4; ++j) { f32x4 sm = (f32x4){0.f, 0.f, 0.f, 0.f};
#pragma unroll
                        for (int k = 0; k < 4; ++k) sm += (f32x4){bflo(ry[k][j].x), bfhi(ry[k][j].x), bflo(ry[k][j].y), bfhi(ry[k][j].y)};
                        x[j] += m5v[j] * sm; } }
                if (i >= 0 && i < ntok) {
#pragma unroll
                    for (int j = 0; j < 4; ++j) *(f32x4*)(xout + (size_t)t * D + 256 * j + 4 * lane) = x[j]; }
                const float rstd = row_rstd(x);
#pragma unroll
                for (int j = 0; j < 4; ++j) hn[j] = x[j] * rstd * gsc[j] + sh4[j];
            } else {
#pragma unroll
                for (int j = 0; j < 4; ++j) hn[j] = (f32x4){0.f, 0.f, 0.f, 0.f};
            }
#pragma unroll
            for (int j = 0; j < 4; ++j) { hm[j] = h0[j]; h0[j] = hp[j]; hp[j] = hn[j]; rx[j] = nx[j];
#pragma unroll
                for (int k = 0; k < 4; ++k) ry[k][j] = ny[k][j]; }
            if (i >= 1) {
                const int te = t - 1;
#pragma unroll
                for (int q = 0; q < 6; ++q) {
                    bf16* orow = XL + ((size_t)q * T + te) * D;
#pragma unroll
                    for (int j = 0; j < 4; ++j) { const int col = 256 * j + 4 * lane;
                        const f32x4 m0 = *(const LAS f32x4*)(mu + (q * 2 + 0) * 1024 + col), m1 = *(const LAS f32x4*)(mu + (q * 2 + 1) * 1024 + col);
                        const f32x4 o = h0[j] + m0 * (hm[j] - h0[j]) + m1 * (hp[j] - h0[j]);
                        u32x2 w; w.x = pk2(o.x, o.y); w.y = pk2(o.z, o.w); *(u32x2*)(orow + col) = w; }
                }
            }
        }
#undef PA_LOAD
    }
}
__device__ __forceinline__ void phase_a_conv(const Args& a, int layer, int rows, int gw, int NGW, int lane) {
    unsigned char* ws = a.ws;
    float* xs = (float*)(ws + (layer < 2 ? WS_XSA : WS_XSB));
    const float* MODS = (const float*)(ws + WS_MODS); const bf16* YS = (const bf16*)(ws + WS_YS); bf16* H = (bf16*)(ws + WS_XL);
    const float* ng = a.in[6] + (size_t)(layer * 2 + 0) * 1024;
    for (int t = gw; t < rows; t += NGW) {
        const int mr = mod_row(t);
        const float* mod = MODS + (size_t)(layer * 5 + mr) * 6144;
        f32x4 m5[4], x[4];
#pragma unroll
        for (int j = 0; j < 4; ++j) m5[j] = *(const f32x4*)(MODS + (size_t)((layer - 1) * 5 + mr) * 6144 + 5 * 1024 + 256 * j + 4 * lane);
        f32x4 gsc[4], sh4[4], ngv[4];
#pragma unroll
        for (int j = 0; j < 4; ++j) { const int col = 256 * j + 4 * lane; ngv[j] = *(const f32x4*)(ng + col); gsc[j] = *(const f32x4*)(mod + 1024 + col); sh4[j] = *(const f32x4*)(mod + col); }
        load_x_combined(x, xs + (size_t)t * D, true, YS, t, m5, lane);
#pragma unroll
        for (int j = 0; j < 4; ++j) gsc[j] = ngv[j] * (gsc[j] + 1.0f);
        const float rstd = row_rstd(x);
#pragma unroll
        for (int j = 0; j < 4; ++j) { const int col = 256 * j + 4 * lane;
            *(f32x4*)(xs + (size_t)t * D + col) = x[j];
            const f32x4 h = x[j] * rstd * gsc[j] + sh4[j];
            u32x2 w; w.x = pk2(h.x, h.y); w.y = pk2(h.z, h.w); *(u32x2*)(H + (size_t)t * D + col) = w; }
    }
}
#define DPPF(x, ctrl) __builtin_bit_cast(float, __builtin_amdgcn_update_dpp(0, __builtin_bit_cast(int, (x)), (ctrl), 0xf, 0xf, false))
__device__ __forceinline__ float row16_sum(float v) { v += DPPF(v, 0xB1); v += DPPF(v, 0x4E); v += DPPF(v, 0x141); v += DPPF(v, 0x140); return v; }
__device__ __forceinline__ u32x2 pk4(f32x4 v) { u32x2 w; w.x = pk2(v[0], v[1]); w.y = pk2(v[2], v[3]); return w; }
__device__ __forceinline__ void phase_c_prep(const Args& a, int lj, LAS unsigned char* lds, int tid, int gw, int NGW, int lane) {
    unsigned char* ws = a.ws;
    const bf16* Rr = (const bf16*)(ws + WS_RKV); const bf16* Kk = Rr + (size_t)T * D; const bf16* RA = (const bf16*)(ws + WS_RAWA); const bf16* RW = (const bf16*)(ws + WS_RAWW);
    bf16* KK = (bf16*)(ws + WS_KK); bf16* KD = (bf16*)(ws + WS_KD); bf16* BE = (bf16*)(ws + WS_BETA); float* RKB = (float*)(ws + WS_RKB);
    LAS float* tb = (LAS float*)lds;
    for (int i = tid; i < 7 * 256; i += 512) { const int t7 = i >> 8, q = i & 255;
        const float* src = t7 == 0 ? a.in[18] + lj * 1024 : t7 == 1 ? a.in[19] + lj * 1024 : t7 == 2 ? a.in[20] + lj * 1024 : t7 < 5 ? a.in[10] + lj * 2048 + (t7 - 3) * 1024 : a.in[13] + lj * 2048 + (t7 - 5) * 1024;
        ((LAS f32x4*)tb)[i] = ((const f32x4*)src)[q]; }
    __syncthreads();
    for (int row = gw; row < T; row += NGW) {
#pragma unroll
        for (int j = 0; j < 4; ++j) {
            const int col = 256 * j + 4 * lane; const size_t ro = (size_t)row * D + col;
            const f32x4 k = bf4(*(const u32x2*)(Kk + ro)), r = bf4(*(const u32x2*)(Rr + ro));
            f32x4 a0 = bf4(*(const u32x2*)(RA + ro)) + *(const LAS f32x4*)(tb + 5 * 1024 + col), a1 = bf4(*(const u32x2*)(RA + (size_t)T * D + ro)) + *(const LAS f32x4*)(tb + 6 * 1024 + col);
#pragma unroll
            for (int z = 0; z < 4; ++z) { a0[z] = sigm(a0[z]); a1[z] = sigm(a1[z]); }
            const f32x4 ck = *(const LAS f32x4*)(tb + col), ca = *(const LAS f32x4*)(tb + 1024 + col), cr = *(const LAS f32x4*)(tb + 2048 + col);
            const f32x4 kk = k * ck;
            const float ss = row16_sum((kk.x * kk.x + kk.y * kk.y) + (kk.z * kk.z + kk.w * kk.w));
            const f32x4 kd0 = k * ((a0 - 1.0f) * ca + 1.0f), kd1 = k * ((a1 - 1.0f) * ca + 1.0f);
            *(u32x2*)(KD + ro) = pk4(kd0); *(u32x2*)(KD + (size_t)T * D + ro) = pk4(kd1);
            const f32x4 p = r * (kd0 + kd1) * cr;
            const float rk = row16_sum((p.x + p.y) + (p.z + p.w));
            const f32x4 kkn = kk * fminf(__builtin_amdgcn_rsqf(ss), 1e12f);
            *(u32x2*)(KK + ro) = pk4(kkn); *(u32x2*)(BE + ro) = pk4(kkn * a0); *(u32x2*)(BE + (size_t)T * D + ro) = pk4(kkn * a1);
            if ((lane & 15) == 0) RKB[(size_t)row * 16 + 4 * j + (lane >> 4)] = rk;
        }
    }
}
typedef short bf16x8 __attribute__((ext_vector_type(8)));
__device__ __forceinline__ f32x4 mfma16(bf16x8 a, bf16x8 b, f32x4 c) { return __builtin_amdgcn_mfma_f32_16x16x32_bf16(a, b, c, 0, 0, 0); }
__device__ __forceinline__ bf16x8 as_frag(u32x4 w) { return __builtin_bit_cast(bf16x8, w); }
constexpr int CH_LD = 144;
constexpr int CH_MS = 64 * CH_LD;
constexpr int CH_AB = 0 * CH_MS, CH_KT = 1 * CH_MS, CH_BT = 2 * CH_MS, CH_RB = 3 * CH_MS, CH_VT = 4 * CH_MS, CH_ABT = 5 * CH_MS, CH_KHT = 6 * CH_MS, CH_BHT = 7 * CH_MS,
              CH_LK = 8 * CH_MS, CH_LB = 9 * CH_MS, CH_MK = 10 * CH_MS, CH_MB = 11 * CH_MS, CH_WT = 12 * CH_MS, CH_U0 = 13 * CH_MS, CH_DINV = 14 * CH_MS;
constexpr int CH_GC = LDSCTL_OFF + 2048;
constexpr int CH_PART = LDSCTL_OFF + 4096;
constexpr int NCHUNK = NSTEP / 64;
#ifndef S1_DBL
#define S1_DBL 0
#endif
static_assert(CH_DINV + 2048 <= RING_BYTES, "chunk LDS map");

__device__ __forceinline__ int scan_row(int s, int dir, int b) {
    if (s < CTXL) return TL + b * CTXL + (dir ? CTXL - 1 - s : s);
    const int i = s - CTXL; return b * SEQ + (dir ? SEQ - 1 - i : i);
}
#define CH_FRAG(mat, row, ks, kg) as_frag(*(const LAS u32x4*)(lds + (mat) + (row) * CH_LD + ((ks) * 32 + (kg) * 8) * 2))

__device__ __forceinline__ float s1_treduce16(const float (&a)[16], bool b3, bool b2) {
    float b[8];
#pragma unroll
    for (int i = 0; i < 8; ++i) { float x = a[i], y = a[i + 8];
        asm("s_nop 1\n\tv_permlane32_swap_b32 %0, %1" : "+v"(x), "+v"(y));
        b[i] = x + y; }
    float c[4];
#pragma unroll
    for (int i = 0; i < 4; ++i) { float x = b[i], y = b[i + 4];
        asm("s_nop 1\n\tv_permlane16_swap_b32 %0, %1" : "+v"(x), "+v"(y));
        c[i] = x + y; }
    float d[2];
#pragma unroll
    for (int i = 0; i < 2; ++i) { const float keep = b3 ? c[i + 2] : c[i], send = b3 ? c[i] : c[i + 2]; d[i] = keep + DPPF(send, 0x128); }
    const float keep = b2 ? d[1] : d[0], send = b2 ? d[0] : d[1];
    float e = keep + DPPF(send, 0x141);
    e += DPPF(e, 0xB1);
    e += DPPF(e, 0x4E);
    return e;
}
#define S1_BAR() do { asm volatile("s_waitcnt lgkmcnt(0)" ::: "memory"); __builtin_amdgcn_s_barrier(); asm volatile("" ::: "memory"); } while (0)
__device__ __forceinline__ void phase_s1_chunks(const Args& a, int lj, LAS unsigned char* lds, int tid, int G, int rh_scratch = 0) {
    unsigned char* ws = a.ws; const float* w0l = a.in[10] + lj * 2048; const float* a0l = a.in[13] + lj * 2048;
    const float* pkk = a.in[18] + lj * 1024; const float* pka = a.in[19] + lj * 1024; const float* prk = a.in[20] + lj * 1024;
    const int lane = tid & 63, wave = __builtin_amdgcn_readfirstlane(tid >> 6), l15 = lane & 15, g = lane >> 4;
    LAS float* part = (LAS float*)(lds + CH_PART); LAS float* gammaC = (LAS float*)(lds + CH_GC);
    unsigned nlw[8], nka[8], nkr[8], nrr[8], nvv[8]; float nw0 = 0.f, na0 = 0.f, npkk = 0.f, npka = 0.f, nprk = 0.f;
    typedef const __attribute__((address_space(1))) unsigned short* GUS;
#define S1_LOAD(ctx_) do { unsigned char* wsl = ws; asm volatile("" : "+s"(wsl));     \
        const int chain_ = (ctx_) / NCHUNK, c_ = (ctx_) - chain_ * NCHUNK, dir_ = chain_ >> 6, b_ = (chain_ >> 4) & 3, h_ = chain_ & 15; \
          \
        const long o0 = (long)scan_row(64 * c_ + 8 * wave, dir_, b_) * D + h_ * 64 + lane, od = (long)dir_ * T * D, st = dir_ ? -(long)D : (long)D; \
        const bf16* LWp = (const bf16*)(wsl + WS_RAWW) + od + o0; const bf16* RAp = (const bf16*)(wsl + WS_RAWA) + od + o0; \
        const bf16* Rp = (const bf16*)(wsl + WS_RKV) + o0; const bf16* Kp = Rp + (size_t)T * D; const bf16* Vp = Rp + (size_t)2 * T * D; \
        nw0 = w0l[dir_ * 1024 + h_ * 64 + lane]; na0 = a0l[dir_ * 1024 + h_ * 64 + lane]; npkk = pkk[h_ * 64 + lane]; npka = pka[h_ * 64 + lane]; nprk = prk[h_ * 64 + lane]; \
        _Pragma("unroll") for (int j = 0; j < 8; ++j) { const long oj = st * j; \
            nlw[j] = ((GUS)LWp)[oj]; nka[j] = ((GUS)RAp)[oj]; nkr[j] = ((GUS)Kp)[oj]; nrr[j] = ((GUS)Rp)[oj]; nvv[j] = ((GUS)Vp)[oj]; } } while (0)
    unsigned clw[8], cka_[8], ckr[8], crr[8], cvv[8]; float cw0 = 0.f, ca0 = 0.f, cpkk = 0.f, cpka = 0.f, cprk = 0.f;
#define S1_TAKE() do { _Pragma("unroll") for (int j = 0; j < 8; ++j) { clw[j] = nlw[j]; cka_[j] = nka[j]; ckr[j] = nkr[j]; crr[j] = nrr[j]; cvv[j] = nvv[j]; } \
        cw0 = nw0; ca0 = na0; cpkk = npkk; cpka = npka; cprk = nprk; \
        _Pragma("unroll") for (int j = 0; j < 8; ++j) asm volatile("" : "+v"(clw[j]), "+v"(cka_[j]), "+v"(ckr[j]), "+v"(crr[j]), "+v"(cvv[j]) :: "memory"); \
        asm volatile("" : "+v"(cw0), "+v"(ca0), "+v"(cpkk), "+v"(cpka), "+v"(cprk) :: "memory"); } while (0)
    if ((int)blockIdx.x < 128 * NCHUNK) { S1_LOAD((int)blockIdx.x); S1_TAKE(); if ((int)blockIdx.x + G < 128 * NCHUNK) S1_LOAD((int)blockIdx.x + G); }
    for (int ct = blockIdx.x; ct < 128 * NCHUNK; ct += G) {
        const int chain = ct / NCHUNK, c = ct - chain * NCHUNK, dir = chain >> 6, b = (chain >> 4) & 3, h = chain & 15;
        unsigned zq = 0u; asm volatile("" : "+v"(zq));
        {
            const int k = lane, tq = wave;
            float lw[8], kd[8], be[8], kk[8], rr[8], vv[8];
            {
                const float w0k = cw0, a0k = ca0, ckk = cpkk, cka = cpka, crk = cprk;
                float* RKBd = (float*)(ws + (dir ? WS_RKB1 : WS_RKB));
                const int row0 = scan_row(64 * c + 8 * tq, dir, b), rst = dir ? -1 : 1;
                float av[8], kq[8], red[16];
#pragma unroll
                for (int j = 0; j < 8; ++j) { av[j] = sigm(bflo(cka_[j]) + a0k); const float kr = bflo(ckr[j]);
                    lw[j] = -0.60653066f * sigm(bflo(clw[j]) + w0k);
                    kq[j] = kr * ckk; kd[j] = kr * ((av[j] - 1.0f) * cka + 1.0f); rr[j] = bflo(crr[j]); vv[j] = bflo(cvv[j]);
                    red[2 * j] = kq[j] * kq[j]; red[2 * j + 1] = rr[j] * kd[j] * crk; }
                const float tot = s1_treduce16(red, (lane & 8) != 0, (lane & 4) != 0);
                if ((lane & 7) == 4) RKBd[(size_t)(row0 + rst * (lane >> 3)) * 16 + h] = tot;
#pragma unroll
                for (int j = 0; j < 8; ++j) { const float ss = __builtin_bit_cast(float, __builtin_amdgcn_readlane(__builtin_bit_cast(int, tot), 8 * j));
                    kk[j] = kq[j] * fminf(__builtin_amdgcn_rsqf(ss), 1e12f);     be[j] = kk[j] * av[j]; }
            }
            for (int r0_ = 0; r0_ <= ((S1_DBL >> 3) & 1); ++r0_) { if (r0_) S1_BAR();
            float p[8]; p[0] = lw[0];
#pragma unroll
            for (int j = 1; j < 8; ++j) p[j] = p[j - 1] + lw[j];
            part[tq * 64 + k] = p[7];
            S1_BAR();
            float off = 0.f, tot = 0.f;
#pragma unroll
            for (int q = 0; q < 8; ++q) { const float pv = part[q * 64 + k]; tot += pv; off += q < tq ? pv : 0.f; }
            const float eTot = __expf(tot); float ePrev = __expf(off);
            if (tq == 0) gammaC[k] = eTot;
            unsigned abw[4], khw[4], bhw[4], vw[4];
#pragma unroll
            for (int j = 0; j < 8; j += 2) {
                float ab2[2], kt2[2], bt2[2], rb2[2], kh2[2], bh2[2];
#pragma unroll
                for (int z = 0; z < 2; ++z) { const float cu = off + p[j + z]; const float eP = __expf(cu), eM = __expf(-cu), eC = eTot * eM;
                    ab2[z] = kk[j + z] * ePrev; ePrev = eP; kt2[z] = kd[j + z] * eM; bt2[z] = be[j + z] * eM; rb2[z] = rr[j + z] * eP; kh2[z] = kd[j + z] * eC; bh2[z] = be[j + z] * eC;
                }
                abw[j >> 1] = pk2(ab2[0], ab2[1]); khw[j >> 1] = pk2(kh2[0], kh2[1]); bhw[j >> 1] = pk2(bh2[0], bh2[1]); vw[j >> 1] = pk2(vv[j], vv[j + 1]);
                {
                    const unsigned ktw = pk2(kt2[0], kt2[1]), btw = pk2(bt2[0], bt2[1]), rbw = pk2(rb2[0], rb2[1]), aw = abw[j >> 1];
                    const int t = 8 * tq + j;
                    *(LAS bf16*)(lds + CH_AB + t * CH_LD + k * 2) = (bf16)aw; *(LAS bf16*)(lds + CH_AB + (t + 1) * CH_LD + k * 2) = (bf16)(aw >> 16);
                    *(LAS bf16*)(lds + CH_KT + t * CH_LD + k * 2) = (bf16)ktw; *(LAS bf16*)(lds + CH_KT + (t + 1) * CH_LD + k * 2) = (bf16)(ktw >> 16);
                    *(LAS bf16*)(lds + CH_BT + t * CH_LD + k * 2) = (bf16)btw; *(LAS bf16*)(lds + CH_BT + (t + 1) * CH_LD + k * 2) = (bf16)(btw >> 16);
                    *(LAS bf16*)(lds + CH_RB + t * CH_LD + k * 2) = (bf16)rbw; *(LAS bf16*)(lds + CH_RB + (t + 1) * CH_LD + k * 2) = (bf16)(rbw >> 16); }
            }
            *(LAS u32x4*)(lds + CH_ABT + k * CH_LD + tq * 16) = (u32x4){abw[0], abw[1], abw[2], abw[3]};
            *(LAS u32x4*)(lds + CH_KHT + k * CH_LD + tq * 16) = (u32x4){khw[0], khw[1], khw[2], khw[3]};
            *(LAS u32x4*)(lds + CH_BHT + k * CH_LD + tq * 16) = (u32x4){bhw[0], bhw[1], bhw[2], bhw[3]};
            *(LAS u32x4*)(lds + CH_VT + k * CH_LD + tq * 16) = (u32x4){vw[0], vw[1], vw[2], vw[3]};
            *(LAS u32x4*)(lds + CH_WT + k * CH_LD + tq * 16) = (u32x4){zq, zq, zq, zq}; *(LAS u32x4*)(lds + CH_U0 + k * CH_LD + tq * 16) = (u32x4){zq, zq, zq, zq};
            }
        }
        S1_BAR();
        for (int r1_ = 0; r1_ <= (S1_DBL & 1); ++r1_) { if (r1_) S1_BAR();
            const int mi = wave >> 1, half = wave & 1;
            const int matS = (mi & 1) ? CH_BT : CH_KT, matT = (mi & 2) ? CH_RB : CH_AB, matO = CH_LK + mi * CH_MS;
            const bool incl = (mi & 2) != 0;
            bf16x8 fs[4][2], ft[2][2];
#pragma unroll
            for (int ms = 0; ms < 4; ++ms)
#pragma unroll
                for (int ks = 0; ks < 2; ++ks) fs[ms][ks] = CH_FRAG(matS, 16 * ms + l15, ks, g);
#pragma unroll
            for (int nt = 0; nt < 2; ++nt)
#pragma unroll
                for (int ks = 0; ks < 2; ++ks) ft[nt][ks] = CH_FRAG(matT, 32 * half + 16 * nt + l15, ks, g);
#pragma unroll
            for (int nt = 0; nt < 2; ++nt) { const int t = 32 * half + 16 * nt + l15;
#pragma unroll
                for (int ms = 0; ms < 4; ++ms) { f32x4 d = (f32x4){0.f, 0.f, 0.f, 0.f};
                    d = mfma16(fs[ms][0], ft[nt][0], d); d = mfma16(fs[ms][1], ft[nt][1], d);
                    const int s0 = 16 * ms + 4 * g;
#pragma unroll
                    for (int i = 0; i < 4; ++i) { const bool keep = incl ? (s0 + i <= t) : (s0 + i < t); d[i] = keep ? d[i] : __builtin_bit_cast(float, zq); }
                    u32x2 w; w.x = pk2(d[0], d[1]); w.y = pk2(d[2], d[3]);
                    *(LAS u32x2*)(lds + matO + t * CH_LD + s0 * 2) = w; } }
        }
        S1_BAR();
        f32x4 rhsU[4];
#pragma unroll
        for (int I = 0; I < 4; ++I) rhsU[I] = (f32x4){0.f, 0.f, 0.f, 0.f};
        if (wave >= 4) {
            const int ctv = (wave & 3) * 16;
            const bf16x8 fv0 = CH_FRAG(CH_VT, ctv + l15, 0, g), fv1 = CH_FRAG(CH_VT, ctv + l15, 1, g);
#pragma unroll
            for (int I = 0; I < 4; ++I) { f32x4 d = (f32x4){0.f, 0.f, 0.f, 0.f};
                d = mfma16(CH_FRAG(CH_LK, 16 * I + l15, 0, g), fv0, d); d = mfma16(CH_FRAG(CH_LK, 16 * I + l15, 1, g), fv1, d); rhsU[I] = -d; }
        }
        for (int r2_ = 0; r2_ <= ((S1_DBL >> 1) & 1); ++r2_) if (wave == 0) {
            const int bb = lane >> 4, j = lane & 15;
            float x[16];
#pragma unroll
            for (int t = 0; t < 16; ++t) {
                const u32x4 r0 = *(const LAS u32x4*)(lds + CH_LB + (16 * bb + t) * CH_LD + 32 * bb), r1 = *(const LAS u32x4*)(lds + CH_LB + (16 * bb + t) * CH_LD + 32 * bb + 16);
                const unsigned rw[8] = {r0.x, r0.y, r0.z, r0.w, r1.x, r1.y, r1.z, r1.w};
                float acc = (t == j) ? 1.0f : 0.0f;
#pragma unroll
                for (int s = 0; s < t; ++s) { const float lv = (s & 1) ? bfhi(rw[s >> 1]) : bflo(rw[s >> 1]); acc -= lv * x[s]; }
                x[t] = acc;
                *(LAS bf16*)(lds + CH_DINV + ((bb * 16 + t) * 16 + j) * 2) = (bf16)f2bf(acc);
            }
        }
        S1_BAR();
        {
            const int matZ = wave < 4 ? CH_WT : CH_U0, ct16 = (wave & 3) * 16;
            for (int r4_ = 0; r4_ <= ((S1_DBL >> 4) & 1); ++r4_) { if (r4_) { *(LAS u32x4*)(lds + matZ + (ct16 + l15) * CH_LD + g * 32) = (u32x4){zq, zq, zq, zq}; *(LAS u32x4*)(lds + matZ + (ct16 + l15) * CH_LD + g * 32 + 16) = (u32x4){zq, zq, zq, zq}; LDS_WAIT(); }
#pragma unroll
            for (int I = 0; I < 4; ++I) {
                f32x4 rhs;
                if (wave < 4) { const u32x2 w = *(const LAS u32x2*)(lds + CH_ABT + (ct16 + l15) * CH_LD + (16 * I + 4 * g) * 2); rhs = (f32x4){bflo(w.x), bfhi(w.x), bflo(w.y), bfhi(w.y)}; }
                else rhs = rhsU[I];
                f32x4 d = (f32x4){0.f, 0.f, 0.f, 0.f};
                d = mfma16(CH_FRAG(CH_LB, 16 * I + l15, 0, g), CH_FRAG(matZ, ct16 + l15, 0, g), d); d = mfma16(CH_FRAG(CH_LB, 16 * I + l15, 1, g), CH_FRAG(matZ, ct16 + l15, 1, g), d);
                const f32x4 ac = rhs - d;
                const u32x2 dv = *(const LAS u32x2*)(lds + CH_DINV + ((I * 16 + l15) * 16 + 4 * g) * 2);
                const bf16x8 fa = as_frag((u32x4){dv.x, dv.y, zq, zq}), fb = as_frag((u32x4){pk2(ac[0], ac[1]), pk2(ac[2], ac[3]), zq, zq});
                const f32x4 z = mfma16(fa, fb, (f32x4){0.f, 0.f, 0.f, 0.f});
                u32x2 w; w.x = pk2(z[0], z[1]); w.y = pk2(z[2], z[3]);
                *(LAS u32x2*)(lds + matZ + (ct16 + l15) * CH_LD + (16 * I + 4 * g) * 2) = w;
                LDS_WAIT(); asm volatile("" ::: "memory");
            }
            }
        }
        S1_BAR();
        if (ct + G < 128 * NCHUNK) { S1_TAKE(); if (ct + 2 * G < 128 * NCHUNK) S1_LOAD(ct + 2 * G); }
        for (int r3_ = 0; r3_ <= ((S1_DBL >> 2) & 1); ++r3_) { if (r3_) S1_BAR();
            const int rt = wave >> 1, cp = (wave & 1) * 2;
            unsigned char* wsl = ws; asm volatile("" : "+s"(wsl));
            bf16* YL = (bf16*)(wsl + WS_Y); bf16* RH = (bf16*)(wsl + (rh_scratch ? WS_BETA + RF : WS_RH)); bf16* PM = (bf16*)(wsl + WS_PM); bf16* QT = (bf16*)(wsl + WS_QT);
            const int trow = scan_row(64 * c + 16 * rt + l15, dir, b);
#pragma unroll
            for (int q = 0; q < 2; ++q) { const int vt = cp + q; f32x4 d = (f32x4){0.f, 0.f, 0.f, 0.f};
#pragma unroll
                for (int ks = 0; ks < 2; ++ks) { d = mfma16(CH_FRAG(CH_VT, 16 * vt + l15, ks, g), CH_FRAG(CH_MK, 16 * rt + l15, ks, g), d); d = mfma16(CH_FRAG(CH_U0, 16 * vt + l15, ks, g), CH_FRAG(CH_MB, 16 * rt + l15, ks, g), d); }
                *(u32x2*)(YL + ((size_t)dir * T + trow) * D + h * 64 + 16 * vt + 4 * g) = pk4(d); }
#pragma unroll
            for (int q = 0; q < 2; ++q) { const int kt = cp + q; f32x4 d = (f32x4){0.f, 0.f, 0.f, 0.f};
#pragma unroll
                for (int ks = 0; ks < 2; ++ks) d = mfma16(CH_FRAG(CH_WT, 16 * kt + l15, ks, g), CH_FRAG(CH_MB, 16 * rt + l15, ks, g), d);
                const u32x2 rbw = *(const LAS u32x2*)(lds + CH_RB + (16 * rt + l15) * CH_LD + (16 * kt + 4 * g) * 2);
                u32x2 w; w.x = pk2(bflo(rbw.x) - d[0], bfhi(rbw.x) - d[1]); w.y = pk2(bflo(rbw.y) - d[2], bfhi(rbw.y) - d[3]);
                *(u32x2*)(RH + ((size_t)dir * T + trow) * D + h * 64 + 16 * kt + 4 * g) = w; }
            bf16* Pc = PM + ((size_t)chain * NCHUNK + c) * 4096; bf16* Qc = QT + ((size_t)chain * NCHUNK + c) * 4096;
            { const int krow = 16 * rt + l15; const float gc = gammaC[krow];
#pragma unroll
                for (int q = 0; q < 2; ++q) { const int kt = cp + q; f32x4 d = (f32x4){0.f, 0.f, 0.f, 0.f};
#pragma unroll
                    for (int ks = 0; ks < 2; ++ks) d = mfma16(CH_FRAG(CH_WT, 16 * kt + l15, ks, g), CH_FRAG(CH_BHT, krow, ks, g), d);
                    const int k0 = 16 * kt + 4 * g; f32x4 o;
#pragma unroll
                    for (int i = 0; i < 4; ++i) o[i] = ((k0 + i == krow) ? gc : 0.f) - d[i];
                    u32x2 w; w.x = pk2(o[0], o[1]); w.y = pk2(o[2], o[3]);
                    *(u32x2*)(Pc + krow * 64 + 32 * (kt >> 1) + 8 * g + 4 * (kt & 1)) = w; } }
            { const int vrow = 16 * rt + l15;
#pragma unroll
                for (int q = 0; q < 2; ++q) { const int kt = cp + q; f32x4 d = (f32x4){0.f, 0.f, 0.f, 0.f};
#pragma unroll
                    for (int ks = 0; ks < 2; ++ks) { d = mfma16(CH_FRAG(CH_KHT, 16 * kt + l15, ks, g), CH_FRAG(CH_VT, vrow, ks, g), d); d = mfma16(CH_FRAG(CH_BHT, 16 * kt + l15, ks, g), CH_FRAG(CH_U0, vrow, ks, g), d); }
                    u32x2 w; w.x = pk2(d[0], d[1]); w.y = pk2(d[2], d[3]);
                    *(u32x2*)(Qc + vrow * 64 + 16 * g + 4 * kt) = w; } }
        }
        S1_BAR();
    }
}

struct S2Set { u32x4 p[4][2]; u32x4 q[2]; };
__device__ __forceinline__ void s2_load(S2Set& s, const bf16* Pc, const bf16* Qc, int vt, int l15, int g) {
    s.q[0] = *(const u32x4*)(Qc + (16 * vt + l15) * 64 + 16 * g); s.q[1] = *(const u32x4*)(Qc + (16 * vt + l15) * 64 + 16 * g + 8);
#pragma unroll
    for (int m = 0; m < 4; ++m)
#pragma unroll
        for (int j = 0; j < 2; ++j) s.p[m][j] = *(const u32x4*)(Pc + (16 * m + l15) * 64 + 32 * j + 8 * g);
}
__device__ __forceinline__ void s2_step(f32x4 (&acc)[4], const S2Set& s, bf16* Hc, int g) {
    unsigned hw[4][2];
#pragma unroll
    for (int m = 0; m < 4; ++m) { hw[m][0] = pk2(acc[m][0], acc[m][1]); hw[m][1] = pk2(acc[m][2], acc[m][3]); }
#pragma unroll
    for (int m = 0; m < 4; ++m) *(u32x2*)(Hc + 16 * m + 4 * g) = (u32x2){hw[m][0], hw[m][1]};
    const bf16x8 hb0 = as_frag((u32x4){hw[0][0], hw[0][1], hw[1][0], hw[1][1]}), hb1 = as_frag((u32x4){hw[2][0], hw[2][1], hw[3][0], hw[3][1]});
#pragma unroll
    for (int m = 0; m < 4; ++m) {
        const unsigned q0 = (m & 2) ? ((m & 1) ? s.q[1].z : s.q[1].x) : ((m & 1) ? s.q[0].z : s.q[0].x), q1 = (m & 2) ? ((m & 1) ? s.q[1].w : s.q[1].y) : ((m & 1) ? s.q[0].w : s.q[0].y);
        f32x4 d = (f32x4){bflo(q0), bfhi(q0), bflo(q1), bfhi(q1)};
        d = mfma16(as_frag(s.p[m][0]), hb0, d);
        d = mfma16(as_frag(s.p[m][1]), hb1, d);
        acc[m] = d;
    }
}
__device__ __forceinline__ void phase_s2_chain(const Args& a, int wave, int lane, int G) {
    unsigned char* ws = a.ws;
    const bf16* PM = (const bf16*)(ws + WS_PM); const bf16* QT = (const bf16*)(ws + WS_QT); bf16* HT = (bf16*)(ws + WS_HT);
    const int l15 = lane & 15, g = lane >> 4;
    if (wave >= 2) return;
    static_assert(NCHUNK % 4 == 0, "S2 ring");
    for (int wt = blockIdx.x * 2 + wave; wt < 512; wt += G * 2) {
        const int chain = wt >> 2, vt = wt & 3;
        f32x4 acc[4];
#pragma unroll
        for (int m = 0; m < 4; ++m) acc[m] = (f32x4){0.f, 0.f, 0.f, 0.f};
        const bf16* Pc = PM + (size_t)chain * NCHUNK * 4096; const bf16* Qc = QT + (size_t)chain * NCHUNK * 4096;
        bf16* Hc = HT + (size_t)chain * NCHUNK * 4096 + (16 * vt + l15) * 64;
        S2Set s0, s1, s2, s3;
        s2_load(s0, Pc, Qc, vt, l15, g); s2_load(s1, Pc + 4096, Qc + 4096, vt, l15, g); s2_load(s2, Pc + 2 * 4096, Qc + 2 * 4096, vt, l15, g); s2_load(s3, Pc + 3 * 4096, Qc + 3 * 4096, vt, l15, g);
#pragma unroll 1
        for (int c = 0; c < NCHUNK; c += 4) {
            const int cn = c + 4 < NCHUNK ? c + 4 : c;
            const bf16* Pn = Pc + (size_t)cn * 4096; const bf16* Qn = Qc + (size_t)cn * 4096;
            s2_step(acc, s0, Hc + (size_t)c * 4096, g);       s2_load(s0, Pn, Qn, vt, l15, g);
            s2_step(acc, s1, Hc + (size_t)(c + 1) * 4096, g); s2_load(s1, Pn + 4096, Qn + 4096, vt, l15, g);
            s2_step(acc, s2, Hc + (size_t)(c + 2) * 4096, g); s2_load(s2, Pn + 2 * 4096, Qn + 2 * 4096, vt, l15, g);
            s2_step(acc, s3, Hc + (size_t)(c + 3) * 4096, g); s2_load(s3, Pn + 3 * 4096, Qn + 3 * 4096, vt, l15, g);
        }
    }
}

struct S3In { u32x2 yl[2][4]; u32x4 rh[2][2]; u32x4 hh[2][4][2]; };
__device__ __forceinline__ void s3_issue(S3In& s, const bf16* YL, const bf16* RH, const bf16* HT, int task, int l15, int g) {
    const int tt = task >> 4, h = task & 15, r0 = tt * 16, row = r0 + l15;
    int b, cc[2];
    if (r0 < TL) { b = r0 >> 13; const int tb = (r0 & (SEQ - 1)) >> 6; cc[0] = 4 + tb; cc[1] = 4 + (127 - tb); }
    else { const int loc = r0 - TL; b = loc >> 8; const int tb = (loc & 255) >> 6; cc[0] = tb; cc[1] = 3 - tb; }
    const size_t ro = (size_t)row * D + h * 64 + 4 * g;
#pragma unroll
    for (int dir = 0; dir < 2; ++dir) {
#pragma unroll
        for (int vt = 0; vt < 4; ++vt) s.yl[dir][vt] = *(const u32x2*)(YL + (size_t)dir * T * D + ro + 16 * vt);
        const int chain = dir * 64 + b * 16 + h;
        const bf16* rh = RH + ((size_t)dir * T + row) * D + h * 64 + 8 * g;
        s.rh[dir][0] = *(const u32x4*)(rh); s.rh[dir][1] = *(const u32x4*)(rh + 32);
        const bf16* hc = HT + ((size_t)chain * NCHUNK + cc[dir]) * 4096;
#pragma unroll
        for (int vt = 0; vt < 4; ++vt) { const bf16* hr = hc + (16 * vt + l15) * 64 + 8 * g; s.hh[dir][vt][0] = *(const u32x4*)(hr); s.hh[dir][vt][1] = *(const u32x4*)(hr + 32); }
    }
}
__device__ __forceinline__ void s3_finish(const S3In& s, const bf16* Vv, const float* RKB, const float* RKB1, const bf16* Gg, const float* lng, const float* lnb, bf16* Z, int task, int l15, int g) {
    const int tt = task >> 4, h = task & 15, row = tt * 16 + l15;
    u32x2 vq2[4], gw2[4]; f32x4 lg4[4], lb4[4];
#pragma unroll
    for (int vt = 0; vt < 4; ++vt) { const int col = h * 64 + 16 * vt + 4 * g; const size_t o = (size_t)row * D + col;
        vq2[vt] = *(const u32x2*)(Vv + o); gw2[vt] = *(const u32x2*)(Gg + o); lg4[vt] = *(const f32x4*)(lng + col); lb4[vt] = *(const f32x4*)(lnb + col); }
    const float bon = RKB[(size_t)row * 16 + h] + RKB1[(size_t)row * 16 + h];
    f32x4 acc[4];
#pragma unroll
    for (int vt = 0; vt < 4; ++vt) acc[vt] = bf4(s.yl[0][vt]) + bf4(s.yl[1][vt]);
#pragma unroll
    for (int dir = 0; dir < 2; ++dir) {
        const bf16x8 f0 = as_frag(s.rh[dir][0]), f1 = as_frag(s.rh[dir][1]);
#pragma unroll
        for (int vt = 0; vt < 4; ++vt) { acc[vt] = mfma16(as_frag(s.hh[dir][vt][0]), f0, acc[vt]); acc[vt] = mfma16(as_frag(s.hh[dir][vt][1]), f1, acc[vt]); }
    }
    float sm = 0.f;
#pragma unroll
    for (int vt = 0; vt < 4; ++vt) sm += (acc[vt][0] + acc[vt][1]) + (acc[vt][2] + acc[vt][3]);
    sm += __shfl_xor(sm, 16); sm += __shfl_xor(sm, 32);
    const float mean = sm * (1.0f / 64.0f); float vs = 0.f;
#pragma unroll
    for (int vt = 0; vt < 4; ++vt) { acc[vt] = acc[vt] - mean; vs += (acc[vt][0] * acc[vt][0] + acc[vt][1] * acc[vt][1]) + (acc[vt][2] * acc[vt][2] + acc[vt][3] * acc[vt][3]); }
    vs += __shfl_xor(vs, 16); vs += __shfl_xor(vs, 32);
    const float rstd = rsqrtf(vs * (1.0f / 64.0f) + 64.0f * 1e-5f);
#pragma unroll
    for (int vt = 0; vt < 4; ++vt) { const int col = h * 64 + 16 * vt + 4 * g; const size_t o = (size_t)row * D + col;
        const f32x4 zz = acc[vt] * rstd * lg4[vt] + lb4[vt] + bf4(vq2[vt]) * bon;
        u32x2 w; w.x = pk2(zz[0] * bflo(gw2[vt].x), zz[1] * bfhi(gw2[vt].x)); w.y = pk2(zz[2] * bflo(gw2[vt].y), zz[3] * bfhi(gw2[vt].y));
        *(u32x2*)(Z + o) = w; }
}
__device__ __forceinline__ void phase_s3_readout(const Args& a, int lj, int nrows, int gw, int NGW, int lane) {
    unsigned char* ws = a.ws;
    const bf16* YL = (const bf16*)(ws + WS_Y); const bf16* RH = (const bf16*)(ws + WS_RH); const bf16* HT = (const bf16*)(ws + WS_HT);
    const bf16* Vv = (const bf16*)(ws + WS_RKV) + (size_t)2 * T * D; const float* RKB = (const float*)(ws + WS_RKB); const float* RKB1 = (const float*)(ws + WS_RKB1); const bf16* Gg = (const bf16*)(ws + WS_G); bf16* Z = (bf16*)(ws + WS_Z);
    const float* lng = a.in[21] + lj * 1024; const float* lnb = a.in[22] + lj * 1024;
    const int l15 = lane & 15, g = lane >> 4, ntask = (nrows / 16) * 16;
    for (int task = gw; task < ntask; task += NGW) {
        S3In A;
        s3_issue(A, YL, RH, HT, task, l15, g);
        s3_finish(A, Vv, RKB, RKB1, Gg, lng, lnb, Z, task, l15, g);
    }
}
__device__ __forceinline__ void phase_cv(const Args& a, int lc, int rows, int gw, int NGW, int lane) {
    unsigned char* ws = a.ws;
    const bf16* BG = (const bf16*)(ws + WS_BG); const bf16* CU = (const bf16*)(ws + WS_CUZ); bf16* Z = (bf16*)(ws + WS_Z);
    const float* cw = a.in[25] + (size_t)lc * 3 * 1024;
    for (int t = gw; t < rows; t += NGW) {
        int rs, re; if (t < TL) { rs = t & ~63; re = rs + 63; } else { const int loc = t - TL; rs = TL + (loc & ~255); re = rs + 255; }
        const bool hp = t > rs, hn = t < re;
        u32x2 zc4[4], bg4[4], zp4[4], zn4[4]; f32x4 w04[4], w14[4], w24[4];
#pragma unroll
        for (int j = 0; j < 4; ++j) { const int col = 256 * j + 4 * lane; const size_t o = (size_t)t * D + col;
            zc4[j] = *(const u32x2*)(CU + o); bg4[j] = *(const u32x2*)(BG + o);
            zp4[j] = hp ? *(const u32x2*)(CU + o - D) : (u32x2){0u, 0u}; zn4[j] = hn ? *(const u32x2*)(CU + o + D) : (u32x2){0u, 0u};
            w04[j] = *(const f32x4*)(cw + col); w14[j] = *(const f32x4*)(cw + 1024 + col); w24[j] = *(const f32x4*)(cw + 2048 + col); }
#pragma unroll
        for (int j = 0; j < 4; ++j) { const int col = 256 * j + 4 * lane; const size_t o = (size_t)t * D + col;
            const u32x2 zc = zc4[j], bg = bg4[j], zp = zp4[j], zn = zn4[j];
            const f32x4 w0 = w04[j], w1 = w14[j], w2 = w24[j];
            const f32x4 zv = (f32x4){bflo(zc.x), bfhi(zc.x), bflo(zc.y), bfhi(zc.y)}, pv = (f32x4){bflo(zp.x), bfhi(zp.x), bflo(zp.y), bfhi(zp.y)}, nv = (f32x4){bflo(zn.x), bfhi(zn.x), bflo(zn.y), bfhi(zn.y)};
            const f32x4 bv = (f32x4){bflo(bg.x), bfhi(bg.x), bflo(bg.y), bfhi(bg.y)};
            const f32x4 r = bv * (w0 * pv + w1 * zv + w2 * nv);
            u32x2 w; w.x = pk2(r.x, r.y); w.y = pk2(r.z, r.w); *(u32x2*)(Z + o) = w; }
    }
}
typedef float f32x2v __attribute__((ext_vector_type(2)));
__device__ __forceinline__ float lane_bcast(float v, int srclane) { return __builtin_bit_cast(float, __builtin_amdgcn_readlane(__builtin_bit_cast(int, v), srclane)); }
__device__ __forceinline__ void phase_e_route(const Args& a, int layer, int rows, LAS unsigned char* lds, int tid, int gw, int NGW, int lane, int probe_rep = 0) {
    unsigned char* ws = a.ws;
    const float* xs = (const float*)(ws + (layer < 2 ? WS_XSA : WS_XSB));
    const float* MODS = (const float*)(ws + WS_MODS); bf16* H2 = (bf16*)(ws + WS_H2);
    const float* ng = a.in[6] + (size_t)(layer * 2 + 1) * 1024;
    const float* rw = a.in[27] + (size_t)layer * 1024 * 32; const float* rb = a.in[28] + layer * 32;
    unsigned* cnt = (unsigned*)(ws + WS_CTL) + CW_CNT + (layer + 4 * probe_rep) * 32 * CNT_STRIDE;
    int* SLOTL = (int*)(ws + (probe_rep ? WS_L1 : WS_SLOTL)); float* GATEL = (float*)(ws + (probe_rep ? WS_L1 + 8 * MiB : WS_GATEL));
    LAS float* wt = (LAS float*)lds;
    LAS int* hist = (LAS int*)(lds + LDSCTL_OFF + 3072); LAS int* base = hist + 32; LAS int* lcnt = hist + 64;
    int* TKE = (int*)(ws + WS_C12); float* TKG = (float*)(ws + WS_C12 + 4 * MiB);
    for (int i = tid; i < 32768; i += 512) wt[(i & 31) * 1024 + (i >> 5)] = rw[i];
    if (tid < 32) hist[tid] = 0;
    __syncthreads();
    const int my_e = lane >> 1; const float my_b = rb[my_e];
    const bool b5 = (lane & 32) != 0, b4 = (lane & 16) != 0, b3 = (lane & 8) != 0, b2 = (lane & 4) != 0, b1 = (lane & 2) != 0;
    for (int t = gw; t < rows; t += NGW) {
        const int mr = mod_row(t);
        const float* mod = MODS + (size_t)(layer * 5 + mr) * 6144;
        f32x4 x[4];
#pragma unroll
        for (int j = 0; j < 4; ++j) x[j] = *(const f32x4*)(xs + (size_t)t * D + 256 * j + 4 * lane);
        const float rstd = row_rstd(x);
#pragma unroll
        for (int j = 0; j < 4; ++j) { const int col = 256 * j + 4 * lane;
            x[j] = x[j] * rstd * *(const f32x4*)(ng + col) * (*(const f32x4*)(mod + 4 * 1024 + col) + 1.0f) + *(const f32x4*)(mod + 3 * 1024 + col);
            u32x2 w; w.x = pk2(x[j].x, x[j].y); w.y = pk2(x[j].z, x[j].w); *(u32x2*)(H2 + (size_t)t * D + col) = w; }
        float p[32];
#pragma unroll
        for (int eg = 0; eg < 8; ++eg) {
#pragma unroll
            for (int ee = 0; ee < 4; ++ee) { const int e = eg * 4 + ee; f32x2v s2 = (f32x2v){0.f, 0.f};
#pragma unroll
                for (int j = 0; j < 4; ++j) { const f32x4 wv = *(const LAS f32x4*)(wt + e * 1024 + 256 * j + 4 * lane);
                    s2 = __builtin_elementwise_fma((f32x2v){x[j].x, x[j].y}, (f32x2v){wv.x, wv.y}, s2); s2 = __builtin_elementwise_fma((f32x2v){x[j].z, x[j].w}, (f32x2v){wv.z, wv.w}, s2); }
                p[e] = s2.x + s2.y; }
            asm volatile("" ::: "memory");
        }
        float q16[16];
#pragma unroll
        for (int i = 0; i < 16; ++i) { const float send = b5 ? p[i] : p[i + 16]; const float keep = b5 ? p[i + 16] : p[i]; q16[i] = keep + __shfl_xor(send, 32); }
        float q8[8];
#pragma unroll
        for (int i = 0; i < 8; ++i) { const float send = b4 ? q16[i] : q16[i + 8]; const float keep = b4 ? q16[i + 8] : q16[i]; q8[i] = keep + __shfl_xor(send, 16); }
        float q4[4];
#pragma unroll
        for (int i = 0; i < 4; ++i) { const float send = b3 ? q8[i] : q8[i + 4]; const float keep = b3 ? q8[i + 4] : q8[i]; q4[i] = keep + __shfl_xor(send, 8); }
        float q2[2];
#pragma unroll
        for (int i = 0; i < 2; ++i) { const float send = b2 ? q4[i] : q4[i + 2]; const float keep = b2 ? q4[i + 2] : q4[i]; q2[i] = keep + __shfl_xor(send, 4); }
        float q1; { const float send = b1 ? q2[0] : q2[1]; const float keep = b1 ? q2[1] : q2[0]; q1 = keep + __shfl_xor(send, 2); }
        const float lg = q1 + __shfl_xor(q1, 1) + my_b;
        int rank = 0;
#pragma unroll 1
        for (int e = 0; e < 32; ++e) { const float o = lane_bcast(lg, 2 * e); rank += (o > lg || (o == lg && e < my_e)) ? 1 : 0; }
        const bool sel = rank < 4 && !(lane & 1);
        const unsigned long long m0 = __ballot(sel && rank == 0), m1 = __ballot(sel && rank == 1), m2 = __ballot(sel && rank == 2), m3 = __ballot(sel && rank == 3);
        const float v0 = lane_bcast(lg, (int)__builtin_ctzll(m0)), v1 = lane_bcast(lg, (int)__builtin_ctzll(m1)), v2 = lane_bcast(lg, (int)__builtin_ctzll(m2)), v3 = lane_bcast(lg, (int)__builtin_ctzll(m3));
        const float e1 = __expf(v1 - v0), e2 = __expf(v2 - v0), e3 = __expf(v3 - v0);
        const float inv = frcp(1.0f + e1 + e2 + e3);
        if (sel) {
            TKE[t * 4 + rank] = my_e; TKG[t * 4 + rank] = __expf(lg - v0) * inv;
            __hip_atomic_fetch_add(hist + my_e, 1, __ATOMIC_RELAXED, __HIP_MEMORY_SCOPE_WORKGROUP);
        }
    }
    asm volatile("s_waitcnt vmcnt(0) lgkmcnt(0)" ::: "memory"); __syncthreads();
    if (tid < 32) { base[tid] = (int)atomicAdd(cnt + tid * CNT_STRIDE, (unsigned)hist[tid]); lcnt[tid] = 0; }
    __syncthreads();
    for (int t = gw; t < rows; t += NGW) {
        if (lane < 4) { const int e = TKE[t * 4 + lane]; const float gk = TKG[t * 4 + lane];
            const int pos = base[e] + __hip_atomic_fetch_add(lcnt + e, 1, __ATOMIC_RELAXED, __HIP_MEMORY_SCOPE_WORKGROUP);
            SLOTL[(size_t)e * T + pos] = t * 4 + lane; GATEL[(size_t)e * T + pos] = gk; }
    }
}
__device__ __forceinline__ int okey(float v, int e) { const int i = __builtin_bit_cast(int, v); const int o = i ^ ((i >> 31) & 0x7fffffff); return (o & ~31) | (31 - e); }
__device__ __forceinline__ void phase_e_route_mfma(const Args& a, int layer, int rows, LAS unsigned char* lds, int tid, int wave, int gw, int NGW, int lane, int probe_rep = 0) {
    unsigned char* ws = a.ws;
    const float* xs = (const float*)(ws + (layer < 2 ? WS_XSA : WS_XSB));
    const float* MODS = (const float*)(ws + WS_MODS); bf16* H2 = (bf16*)(ws + WS_H2);
    const float* ng = a.in[6] + (size_t)(layer * 2 + 1) * 1024; const float* rb = a.in[28] + layer * 32;
    const bf16* WRT = (const bf16*)(ws + WS_WRT) + (size_t)layer * 2 * 32 * 1024;
    unsigned* cnt = (unsigned*)(ws + WS_CTL) + CW_CNT + (layer + 4 * probe_rep) * 32 * CNT_STRIDE;
    int* SLOTL = (int*)(ws + (probe_rep ? WS_L1 : WS_SLOTL)); float* GATEL = (float*)(ws + (probe_rep ? WS_L1 + 8 * MiB : WS_GATEL));
    LAS int* hist = (LAS int*)(lds + LDSCTL_OFF + 3072); LAS int* base = hist + 32; LAS int* lcnt = hist + 64;
    int* TKE = (int*)(ws + WS_C12); float* TKG = (float*)(ws + WS_C12 + 4 * MiB);
    LAS unsigned char* tile = lds + wave * 8448;
    if (tid < 32) hist[tid] = 0;
    constexpr int E_TAB = 8 * 8448, E_TP = 2064;
    static_assert(E_TAB + 32 * E_TP <= LDSCTL_OFF, "router table");
    for (int i = tid; i < 32 * 128; i += 512) { const int r = i >> 7, pc = i & 127; *(LAS u32x4*)(lds + E_TAB + r * E_TP + pc * 16) = *(const u32x4*)(WRT + (size_t)r * 1024 + pc * 8); }
    __syncthreads();
    const int l15 = lane & 15, g = lane >> 4;
    const int nlat = TL / 16, nctx = rows > TL ? TC / 4 : 0, G_ = NGW / 8;
    for (int it = 0;; ++it) {
        int t0, ntok;
        { const int tl = gw + it * NGW; const int xi = (int)blockIdx.x + (it - (nlat + NGW - 1) / NGW) * G_ * 8 + wave * G_;
          if (tl < nlat) { t0 = tl * 16; ntok = 16; } else if (it >= (nlat + NGW - 1) / NGW && xi < nctx) { t0 = TL + xi * 4; ntok = 4; } else if (it >= (nlat + NGW - 1) / NGW) break; else continue; }
        const float* mod = MODS + (size_t)(layer * 5 + mod_row(t0)) * 6144;
        float rstd[16];
#pragma unroll
        for (int tb = 0; tb < 16; tb += 8) {
            f32x4 xa[8][4];
#pragma unroll
            for (int t = 0; t < 8; ++t) { const int tr = tb + t < ntok ? t0 + tb + t : t0;
#pragma unroll
                for (int j = 0; j < 4; ++j) xa[t][j] = *(const f32x4*)(xs + (size_t)tr * D + 256 * j + 4 * lane); }
#pragma unroll
            for (int t = 0; t < 8; ++t) rstd[tb + t] = __builtin_bit_cast(float, __builtin_amdgcn_readfirstlane(__builtin_bit_cast(int, row_rstd(xa[t]))));
            asm volatile("" ::: "memory"); }
        f32x4 acc[2]; acc[0] = (f32x4){0.f, 0.f, 0.f, 0.f}; acc[1] = acc[0];
#pragma unroll 1
        for (int s = 0; s < 4; ++s) {
            const int col = 256 * s + 4 * lane;
            int t0s = t0; asm volatile("" : "+s"(t0s));
            const bf16* wl = WRT + (size_t)(32 + l15) * 1024 + 256 * s + 8 * g;
            u32x4 wlf[8][2];
#pragma unroll
            for (int ks = 0; ks < 8; ++ks)
#pragma unroll
                for (int et = 0; et < 2; ++et) wlf[ks][et] = *(const u32x4*)(wl + (size_t)et * 16 * 1024 + 32 * ks);
            const f32x4 g4 = *(const f32x4*)(ng + col) * (*(const f32x4*)(mod + 4 * 1024 + col) + 1.0f), s4 = *(const f32x4*)(mod + 3 * 1024 + col);
            u32x2 lo[16];
#pragma unroll
            for (int tb = 0; tb < 16; tb += 8) {
                f32x4 xr[8];
#pragma unroll
                for (int t = 0; t < 8; ++t) { const int tr = tb + t < ntok ? t0s + tb + t : t0s; xr[t] = *(const f32x4*)(xs + (size_t)tr * D + col); }
#pragma unroll
                for (int t = 0; t < 8; ++t) { const int tr = tb + t < ntok ? t0s + tb + t : t0s; const f32x4 hv = xr[t] * rstd[tb + t] * g4 + s4;
                    const u32x2 w = pk4(hv); if (tb + t < ntok) *(u32x2*)(H2 + (size_t)tr * D + col) = w;
                    *(LAS u32x2*)(tile + (tb + t) * 528 + lane * 8) = w; lo[tb + t] = pk4(hv - bf4(w)); } }
            LDS_WAIT(); asm volatile("" ::: "memory");
            const LAS unsigned char* th = lds + E_TAB + l15 * E_TP + (256 * s + 8 * g) * 2;
#pragma unroll
            for (int ks = 0; ks < 8; ++ks) { const bf16x8 fb = as_frag(*(const LAS u32x4*)(tile + l15 * 528 + ks * 64 + g * 16));
#pragma unroll
                for (int et = 0; et < 2; ++et) { acc[et] = mfma16(as_frag(*(const LAS u32x4*)(th + et * 16 * E_TP + 64 * ks)), fb, acc[et]);
                    acc[et] = mfma16(as_frag(wlf[ks][et]), fb, acc[et]); } }
            LDS_WAIT(); asm volatile("" ::: "memory");
#pragma unroll
            for (int t = 0; t < 16; ++t) *(LAS u32x2*)(tile + t * 528 + lane * 8) = lo[t];
            LDS_WAIT(); asm volatile("" ::: "memory");
#pragma unroll
            for (int ks = 0; ks < 8; ++ks) { const bf16x8 fb = as_frag(*(const LAS u32x4*)(tile + l15 * 528 + ks * 64 + g * 16));
#pragma unroll
                for (int et = 0; et < 2; ++et) acc[et] = mfma16(as_frag(*(const LAS u32x4*)(th + et * 16 * E_TP + 64 * ks)), fb, acc[et]); }
            LDS_WAIT(); asm volatile("" ::: "memory");
        }
        float v[8]; int key[8];
#pragma unroll
        for (int j = 0; j < 8; ++j) { const int e = (j < 4 ? 0 : 16) + 4 * g + (j & 3); v[j] = acc[j >> 2][j & 3] + rb[e]; key[j] = okey(v[j], e); }
        int kb[8], kc[8], kd2[8];
#pragma unroll
        for (int j = 0; j < 8; ++j) kb[j] = __shfl_xor(key[j], 16);
#pragma unroll
        for (int j = 0; j < 8; ++j) { kc[j] = __shfl_xor(key[j], 32); kd2[j] = __shfl_xor(kb[j], 32); }
        float vmax = fmaxf(fmaxf(fmaxf(v[0], v[1]), fmaxf(v[2], v[3])), fmaxf(fmaxf(v[4], v[5]), fmaxf(v[6], v[7])));
        vmax = fmaxf(vmax, __shfl_xor(vmax, 16)); vmax = fmaxf(vmax, __shfl_xor(vmax, 32));
        int rank[8]; float ex[8], part = 0.f;
#pragma unroll
        for (int j = 0; j < 8; ++j) { int r = 0;
#pragma unroll
            for (int q = 0; q < 8; ++q) r += (key[q] > key[j]) + (kb[q] > key[j]) + (kc[q] > key[j]) + (kd2[q] > key[j]);
            rank[j] = r; ex[j] = __expf(v[j] - vmax); part += r < 4 ? ex[j] : 0.f; }
        part += __shfl_xor(part, 16); part += __shfl_xor(part, 32);
        const float inv = frcp(part); const int t = t0 + l15;
#pragma unroll
        for (int j = 0; j < 8; ++j) if (rank[j] < 4 && l15 < ntok) { const int e = (j < 4 ? 0 : 16) + 4 * g + (j & 3);
            TKE[t * 4 + rank[j]] = e; TKG[t * 4 + rank[j]] = ex[j] * inv;
            __hip_atomic_fetch_add(hist + e, 1, __ATOMIC_RELAXED, __HIP_MEMORY_SCOPE_WORKGROUP); }
    }
    asm volatile("s_waitcnt vmcnt(0) lgkmcnt(0)" ::: "memory"); __syncthreads();
    if (tid < 32) { base[tid] = (int)atomicAdd(cnt + tid * CNT_STRIDE, (unsigned)hist[tid]); lcnt[tid] = 0; }
    __syncthreads();
    for (int it = 0;; ++it) {
        int t0, ntok;
        { const int tl = gw + it * NGW; const int xi = (int)blockIdx.x + (it - (nlat + NGW - 1) / NGW) * G_ * 8 + wave * G_;
          if (tl < nlat) { t0 = tl * 16; ntok = 16; } else if (it >= (nlat + NGW - 1) / NGW && xi < nctx) { t0 = TL + xi * 4; ntok = 4; } else if (it >= (nlat + NGW - 1) / NGW) break; else continue; }
        if ((lane >> 2) < ntok) { const int t = t0 + (lane >> 2), k = lane & 3;
            const int e = TKE[t * 4 + k]; const float gk = TKG[t * 4 + k];
            const int pos = base[e] + __hip_atomic_fetch_add(lcnt + e, 1, __ATOMIC_RELAXED, __HIP_MEMORY_SCOPE_WORKGROUP);
            SLOTL[(size_t)e * T + pos] = t * 4 + k; GATEL[(size_t)e * T + pos] = gk; }
    }
}
__device__ __forceinline__ void phase_final(const Args& a, int gw, int NGW, int lane) {
    unsigned char* ws = a.ws;
    const float* xs = (const float*)(ws + WS_XSB); const float* MODS = (const float*)(ws + WS_MODS); const bf16* YS = (const bf16*)(ws + WS_YS);
    for (int t = gw; t < TL; t += NGW) {
        const int mr = t >> 13;
        f32x4 m5[4], x[4];
#pragma unroll
        for (int j = 0; j < 4; ++j) m5[j] = *(const f32x4*)(MODS + (size_t)(3 * 5 + mr) * 6144 + 5 * 1024 + 256 * j + 4 * lane);
        f32x4 fg[4];
#pragma unroll
        for (int j = 0; j < 4; ++j) fg[j] = *(const f32x4*)(a.in[7] + 256 * j + 4 * lane);
        load_x_combined(x, xs + (size_t)t * D, true, YS, t, m5, lane);
        const float rstd = row_rstd(x);
#pragma unroll
        for (int j = 0; j < 4; ++j) { const int col = 256 * j + 4 * lane; *(f32x4*)(a.out + (size_t)t * D + col) = x[j] * rstd * fg[j]; }
    }
}

using pg8::Unit; using pg8::tile_map;
struct SchedStd {
    int G, c, nM, nN;
    __device__ __forceinline__ bool next(int i, Unit& u) const { const long L = (long)i * G + c; if (L >= (long)nM * nN) return false; int pm, pn; tile_map((int)L, nM, nN, pm, pn); u.pm = pm; u.pn = pn; u.e = 0; u.nv = pm; u.par = 0; return true; }
    __device__ __forceinline__ void a_ready(const Unit&) const {}
    __device__ __forceinline__ void done(const Unit&) const {}
    __device__ __forceinline__ unsigned row_off(const Unit&, int) const { return 0u; }
    __device__ __forceinline__ unsigned row_off_lds(const Unit&, int) const { return 0u; }
    __device__ __forceinline__ void prefetch_rows(const Unit&) const {}
};
struct SchedB1 {
    int G, c;
    __device__ __forceinline__ bool next(int i, Unit& u) const { const long L = (long)i * G + c; constexpr int n1 = 3 * NMT * 4; if (L >= n1 + 3 * NMT) return false; const int l = (int)L;
        if (l < n1) { const int j = l / (NMT * 4), r = l % (NMT * 4); int pm, pn; tile_map(r, NMT, 4, pm, pn); u.pm = j * NMT + pm; u.pn = j * 4 + pn; u.e = j; u.nv = pm; }
        else { const int r = l - n1, j = r / NMT, pm = r % NMT; u.pm = (3 + j) * NMT + pm; u.pn = 12 + j; u.e = 3 + j; u.nv = pm; }
        u.par = 0; return true; }
    __device__ __forceinline__ void a_ready(const Unit&) const {}
    __device__ __forceinline__ void done(const Unit&) const {}
    __device__ __forceinline__ unsigned row_off(const Unit&, int) const { return 0u; }
    __device__ __forceinline__ unsigned row_off_lds(const Unit&, int) const { return 0u; }
    __device__ __forceinline__ void prefetch_rows(const Unit&) const {}
};
struct SchedB2 {
    int G, c;
    __device__ __forceinline__ bool next(int i, Unit& u) const { const long L = (long)i * G + c; constexpr int n1 = 2 * NMT * 8; if (L >= n1 + NMT * 4) return false; const int l = (int)L;
        if (l < n1) { const int j = l / (NMT * 8), r = l % (NMT * 8); int pm, pn; tile_map(r, NMT, 8, pm, pn); u.pm = j * NMT + pm; u.pn = j * 8 + pn; u.e = j; u.nv = pm; }
        else { const int r = l - n1; int pm, pn; tile_map(r, NMT, 4, pm, pn); u.pm = 2 * NMT + pm; u.pn = 16 + pn; u.e = 2; u.nv = pm; }
        u.par = 0; return true; }
    __device__ __forceinline__ void a_ready(const Unit&) const {}
    __device__ __forceinline__ void done(const Unit&) const {}
    __device__ __forceinline__ unsigned row_off(const Unit&, int) const { return 0u; }
    __device__ __forceinline__ unsigned row_off_lds(const Unit&, int) const { return 0u; }
    __device__ __forceinline__ void prefetch_rows(const Unit&) const {}
};
struct SchedMoe {
    int G, c, nnt, ntiles, P; LAS unsigned char* lds; const int* slotl; const float* gatel; int wave;
    __device__ __forceinline__ bool next(int i, Unit& u) const { const long L = (long)i * G + c; const int ntp = (ntiles + P - 1) / P, ppg = nnt / (8 / P); if (L >= (long)ntp * ppg * 8) return false;
        const LAS int* tpre = (const LAS int*)(lds + LDSCTL_OFF + 64); const LAS int* ecnt = (const LAS int*)(lds + LDSCTL_OFF + 256); const LAS unsigned short* tile_e = (const LAS unsigned short*)(lds + LDSCTL_OFF + 512);
        const int xq = (int)(L >> 3), x8 = (int)(L & 7); int tile = (xq / ppg) * P + (x8 % P); const int pnl = (x8 / P) * ppg + xq % ppg; const bool dead = tile >= ntiles; tile = dead ? 0 : tile;
        const int e = __builtin_amdgcn_readfirstlane((int)tile_e[tile]), r0 = (tile - __builtin_amdgcn_readfirstlane(tpre[e])) * 256; int nv = __builtin_amdgcn_readfirstlane(ecnt[e]) - r0; nv = nv > 256 ? 256 : nv; nv = dead ? 0 : nv;
        u.pm = dead ? MAXTILES : tile; u.pn = e * nnt + pnl; u.e = e; u.nv = nv | (r0 << 9); u.par = i & 1; return true; }
    __device__ __forceinline__ void a_ready(const Unit& u) const {
        if (gatel != nullptr && wave == 0) { const size_t li = (size_t)u.e * T + (u.nv >> 9) + 4 * lane_id();
            __builtin_amdgcn_global_load_lds((const unsigned*)(slotl + li), (LAS unsigned*)(lds + LDSCTL_OFF + 8192 + 2048 * u.par), 16, 0, 0);
            __builtin_amdgcn_global_load_lds((const unsigned*)(gatel + li), (LAS unsigned*)(lds + LDSCTL_OFF + 8192 + 2048 * u.par + 1024), 16, 0, 0); } }
    __device__ __forceinline__ void done(const Unit&) const {}
    __device__ __forceinline__ void prefetch_rows(const Unit& u) const {
        if (wave == 0) __builtin_amdgcn_global_load_lds((const unsigned*)(slotl + (size_t)u.e * T + (u.nv >> 9) + 4 * lane_id()), (LAS unsigned*)(lds + LDSCTL_OFF + 8192 + 2048 * u.par), 16, 0, 0); }
    __device__ __forceinline__ unsigned row_off_lds(const Unit& u, int r) const { const int nv = u.nv & 511; const int sl = ((const LAS int*)(lds + LDSCTL_OFF + 8192 + 2048 * u.par))[r]; const int tok = r < nv ? (sl >> 2) : 0; return (unsigned)tok * 2048u; }
    __device__ __forceinline__ unsigned row_off(const Unit& u, int r) const { const int nv = u.nv & 511, r0 = u.nv >> 9; const int tok = r < nv ? (slotl[(size_t)u.e * T + r0 + r] >> 2) : 0; return (unsigned)tok * 2048u; }
};

using pg8::cvt_pk_bf16;
template <class P> __device__ __forceinline__ P* pin_ptr(P* p) { asm volatile("" : "+v"(p)); return p; }
struct EpiB1 {
    static constexpr bool PERM = true, AFTER_DRAIN = false;
    bf16* RKV; bf16* L1;
    __device__ __forceinline__ void operator()(const f32x4 (&acc)[2][2][4][2], const Unit& u, int wr, int wc, int fr, int fq) const {
        const int seg = u.e, row0 = u.nv * 256 + wr * 64 + fr;
        const int jj = seg - 3, ld = seg < 3 ? D : 128, col0 = (seg < 3 ? (u.pn - seg * 4) * 256 : 0) + wc * 32 + 8 * fq;
        bf16* base = seg < 3 ? RKV + (size_t)seg * T * D : L1 + (size_t)jj * T * 128;
#pragma unroll
        for (int ai = 0; ai < 2; ++ai)
#pragma unroll
            for (int m = 0; m < 4; ++m) { bf16* rowp = base + (size_t)(row0 + ai * 128 + m * 16) * ld + col0;
#pragma unroll
                for (int bj = 0; bj < 2; ++bj) { if (seg >= 3 && bj == 1) continue; f32x4 v0 = acc[ai][bj][m][0], v1 = acc[ai][bj][m][1];
                    if (jj == 0) {
#pragma unroll
                        for (int q = 0; q < 4; ++q) { v0[q] = tanh_fast(v0[q]); v1[q] = tanh_fast(v1[q]); } }
                    else if (jj == 2) {
#pragma unroll
                        for (int q = 0; q < 4; ++q) { v0[q] = sigm(v0[q]); v1[q] = sigm(v1[q]); } }
                    u32x4 w; w.x = cvt_pk_bf16(v0[0], v0[1]); w.y = cvt_pk_bf16(v0[2], v0[3]); w.z = cvt_pk_bf16(v1[0], v1[1]); w.w = cvt_pk_bf16(v1[2], v1[3]);
                    *(u32x4*)(rowp + bj * 128) = w; } }
    }
};
struct EpiB2 {
    static constexpr bool PERM = true, AFTER_DRAIN = false;
    bf16* RW; bf16* RA; bf16* Gg;
    __device__ __forceinline__ void operator()(const f32x4 (&acc)[2][2][4][2], const Unit& u, int wr, int wc, int fr, int fq) const {
        const int jj = u.e, row0 = u.nv * 256 + wr * 64 + fr, pnl = u.pn - jj * 8;
        const int dirn = jj < 2 ? (pnl >> 2) : 0, col0 = (jj < 2 ? (pnl & 3) : pnl) * 256 + wc * 32 + 8 * fq;
        bf16* base = (jj == 0 ? RW : jj == 1 ? RA : Gg) + (size_t)dirn * T * D;
#pragma unroll
        for (int ai = 0; ai < 2; ++ai)
#pragma unroll
            for (int m = 0; m < 4; ++m) { bf16* rowp = base + (size_t)(row0 + ai * 128 + m * 16) * D + col0;
#pragma unroll
                for (int bj = 0; bj < 2; ++bj) { const f32x4 v0 = acc[ai][bj][m][0], v1 = acc[ai][bj][m][1];
                    u32x4 w; w.x = cvt_pk_bf16(v0[0], v0[1]); w.y = cvt_pk_bf16(v0[2], v0[3]); w.z = cvt_pk_bf16(v1[0], v1[1]); w.w = cvt_pk_bf16(v1[2], v1[3]);
                    *(u32x4*)(rowp + bj * 128) = w; } }
    }
};
struct EpiRes {
    static constexpr bool PERM = true, AFTER_DRAIN = false;
    float* X; const float* gate; float* Xo;
    __device__ __forceinline__ void operator()(const f32x4 (&acc)[2][2][4][2], const Unit& u, int wr, int wc, int fr, int fq) const {
        const int row0 = u.pm * 256 + wr * 64 + fr, col0 = u.pn * 256 + wc * 32 + 8 * fq, mr = u.pm < NMT_L ? (u.pm >> 5) : 4;
        const float* gp = pin_ptr(gate + (size_t)mr * 6144 + col0);
        f32x4 gv[2][2];
#pragma unroll
        for (int bj = 0; bj < 2; ++bj)
#pragma unroll
            for (int n = 0; n < 2; ++n) gv[bj][n] = *(const f32x4*)(gp + bj * 128 + 4 * n);
        f32x4 xa[2][2][2], xb[2][2][2];
#define ER_LOAD(dst, b_) do { _Pragma("unroll") for (int m = 0; m < 2; ++m) _Pragma("unroll") for (int bj = 0; bj < 2; ++bj) _Pragma("unroll") for (int n = 0; n < 2; ++n) \
            dst[m][bj][n] = *(const f32x4*)(X + (size_t)(row0 + ((b_) >> 1) * 128 + (((b_) & 1) * 2 + m) * 16) * D + col0 + bj * 128 + 4 * n); } while (0)
#define ER_STORE(src, b_) do { _Pragma("unroll") for (int m = 0; m < 2; ++m) _Pragma("unroll") for (int bj = 0; bj < 2; ++bj) _Pragma("unroll") for (int n = 0; n < 2; ++n) \
            *(f32x4*)(Xo + (size_t)(row0 + ((b_) >> 1) * 128 + (((b_) & 1) * 2 + m) * 16) * D + col0 + bj * 128 + 4 * n) = src[m][bj][n] + gv[bj][n] * acc[(b_) >> 1][bj][((b_) & 1) * 2 + m][n]; } while (0)
        ER_LOAD(xa, 0); ER_LOAD(xb, 1); ER_STORE(xa, 0); ER_LOAD(xa, 2); ER_STORE(xb, 1); ER_LOAD(xb, 3); ER_STORE(xa, 2); ER_STORE(xb, 3);
#undef ER_LOAD
#undef ER_STORE
    }
};
struct EpiWin {
    static constexpr bool PERM = true, AFTER_DRAIN = false;
    bf16* BG; bf16* CU;
    __device__ __forceinline__ void operator()(const f32x4 (&acc)[2][2][4][2], const Unit& u, int wr, int wc, int fr, int fq) const {
        const int row0 = u.pm * 256 + wr * 64 + fr;
        if (u.pn < 4) {
            const int col0 = u.pn * 256 + wc * 32 + 8 * fq;
#pragma unroll
            for (int ai = 0; ai < 2; ++ai)
#pragma unroll
                for (int m = 0; m < 4; ++m) { bf16* rowp = BG + (size_t)(row0 + ai * 128 + m * 16) * D + col0;
#pragma unroll
                    for (int bj = 0; bj < 2; ++bj) { const f32x4 v0 = acc[ai][bj][m][0], v1 = acc[ai][bj][m][1];
                        u32x4 w; w.x = cvt_pk_bf16(v0[0], v0[1]); w.y = cvt_pk_bf16(v0[2], v0[3]); w.z = cvt_pk_bf16(v1[0], v1[1]); w.w = cvt_pk_bf16(v1[2], v1[3]);
                        *(u32x4*)(rowp + bj * 128) = w; } }
        } else {
            const int f0 = (u.pn - 4) * 128 + wc * 32 + 8 * fq;
#pragma unroll
            for (int ai = 0; ai < 2; ++ai)
#pragma unroll
                for (int m = 0; m < 4; ++m) { const f32x4 v0 = acc[ai][0][m][0] * acc[ai][1][m][0], v1 = acc[ai][0][m][1] * acc[ai][1][m][1];
                    u32x4 w; w.x = cvt_pk_bf16(v0[0], v0[1]); w.y = cvt_pk_bf16(v0[2], v0[3]); w.z = cvt_pk_bf16(v1[0], v1[1]); w.w = cvt_pk_bf16(v1[2], v1[3]);
                    *(u32x4*)(CU + (size_t)(row0 + ai * 128 + m * 16) * D + f0) = w; }
        }
    }
};
struct EpiGU {
    static constexpr bool PERM = true, AFTER_DRAIN = false;
    bf16* INTER; const float* bgu;
    __device__ __forceinline__ void operator()(const f32x4 (&acc)[2][2][4][2], const Unit& u, int wr, int wc, int fr, int fq) const {
        const int e = u.e, pnl = u.pn - e * 8, row0 = u.pm * 256 + wr * 64 + fr, f0 = pnl * 128 + wc * 32 + 8 * fq;
        typedef const __attribute__((address_space(1))) f32x4* GF4;
        const GF4 bp = (GF4)pin_ptr(bgu + (size_t)e * 2048 + f0);
        f32x4 bg[2], bu[2];
#pragma unroll
        for (int n = 0; n < 2; ++n) { bg[n] = bp[n]; bu[n] = bp[256 + n]; }
#pragma unroll
        for (int ai = 0; ai < 2; ++ai)
#pragma unroll
            for (int m = 0; m < 4; ++m) { f32x4 o[2];
#pragma unroll
                for (int n = 0; n < 2; ++n) { const f32x4 g = acc[ai][0][m][n] + bg[n], uu = acc[ai][1][m][n] + bu[n];
#pragma unroll
                    for (int q = 0; q < 4; ++q) { const float gc = fminf(g[q], 7.0f), uc = fminf(fmaxf(uu[q], -7.0f), 7.0f); o[n][q] = (uc + 1.0f) * gc * sigm(1.702f * gc); } }
                u32x4 w; w.x = cvt_pk_bf16(o[0][0], o[0][1]); w.y = cvt_pk_bf16(o[0][2], o[0][3]); w.z = cvt_pk_bf16(o[1][0], o[1][1]); w.w = cvt_pk_bf16(o[1][2], o[1][3]);
                *(u32x4*)(INTER + (size_t)(row0 + ai * 128 + m * 16) * 1024 + f0) = w; }
    }
};
struct EpiDown {
    static constexpr bool PERM = true, AFTER_DRAIN = false;
    bf16* YS; const float* bdn; LAS unsigned char* lds;
    __device__ __forceinline__ void operator()(const f32x4 (&acc)[2][2][4][2], const Unit& u, int wr, int wc, int fr, int fq) const {
        const int e = u.e, pnl = u.pn - e * 4, col0 = pnl * 256 + wc * 32 + 8 * fq, nv = u.nv & 511;
        typedef const __attribute__((address_space(1))) f32x4* GF4;
        const GF4 bp = (GF4)pin_ptr(bdn + (size_t)e * 1024 + col0);
        f32x4 bv[2][2];
#pragma unroll
        for (int bj = 0; bj < 2; ++bj)
#pragma unroll
            for (int n = 0; n < 2; ++n) bv[bj][n] = bp[bj * 32 + n];
        const LAS int* sl = (const LAS int*)(lds + LDSCTL_OFF + 8192 + 2048 * u.par);
        int slot8[2][4]; float gt8[2][4];
#pragma unroll
        for (int ai = 0; ai < 2; ++ai)
#pragma unroll
            for (int m = 0; m < 4; ++m) { const int r = ai * 128 + wr * 64 + m * 16 + fr; slot8[ai][m] = sl[r]; gt8[ai][m] = ((const LAS float*)(sl + 256))[r]; }
#pragma unroll
        for (int ai = 0; ai < 2; ++ai) asm volatile("" : "+v"(slot8[ai][0]), "+v"(slot8[ai][1]), "+v"(slot8[ai][2]), "+v"(slot8[ai][3]), "+v"(gt8[ai][0]), "+v"(gt8[ai][1]), "+v"(gt8[ai][2]), "+v"(gt8[ai][3]));
        asm volatile("" : "+v"(bv[0][0]), "+v"(bv[0][1]), "+v"(bv[1][0]), "+v"(bv[1][1]));
#pragma unroll
        for (int ai = 0; ai < 2; ++ai)
#pragma unroll
            for (int m = 0; m < 4; ++m) { const int r = ai * 128 + wr * 64 + m * 16 + fr;
                if (r < nv) { const int slot = slot8[ai][m]; const float gt = gt8[ai][m];
                    bf16* rowp = YS + (size_t)slot * 1024 + col0;
#pragma unroll
                    for (int bj = 0; bj < 2; ++bj) { const f32x4 v0 = (acc[ai][bj][m][0] + bv[bj][0]) * gt, v1 = (acc[ai][bj][m][1] + bv[bj][1]) * gt;
                        u32x4 w; w.x = cvt_pk_bf16(v0[0], v0[1]); w.y = cvt_pk_bf16(v0[2], v0[3]); w.z = cvt_pk_bf16(v1[0], v1[1]); w.w = cvt_pk_bf16(v1[2], v1[3]);
                        *(u32x4*)(rowp + bj * 128) = w; } } }
    }
};

__device__ __forceinline__ int moe_tables(const unsigned* cnt, LAS unsigned char* lds, int tid) {
    LAS int* tpre = (LAS int*)(lds + LDSCTL_OFF + 64); LAS int* ecnt = (LAS int*)(lds + LDSCTL_OFF + 256); LAS unsigned short* tile_e = (LAS unsigned short*)(lds + LDSCTL_OFF + 512);
    if (tid == 0) { int p = 0; for (int e = 0; e < 32; ++e) { const int cn = (int)__hip_atomic_load(cnt + e * CNT_STRIDE, __ATOMIC_RELAXED, __HIP_MEMORY_SCOPE_AGENT); ecnt[e] = cn; tpre[e] = p; p += (cn + 255) >> 8; } tpre[32] = p; }
    __syncthreads();
    const int nt = tpre[32];
    for (int t = tid; t < nt; t += 512) { int e = 0; while (e < 31 && t >= tpre[e + 1]) ++e; tile_e[t] = (unsigned short)e; }
    __syncthreads();
    return nt;
}

constexpr int NPHASES = 37;
typedef const Args __attribute__((address_space(4))) CArgs;
__global__ void __attribute__((amdgpu_flat_work_group_size(512, 512), amdgpu_waves_per_eu(2, 2))) fwd_kernel(Args a_) {
    extern __shared__ __attribute__((aligned(16))) unsigned char lds_raw[];
    LAS unsigned char* lds = (LAS unsigned char*)lds_raw;
    const int G = gridDim.x, NGW = G * 8;
    CArgs* ap0 = (CArgs*)__builtin_amdgcn_kernarg_segment_ptr();
    if (threadIdx.x < 4) ((LAS unsigned*)(lds + LDSCTL_OFF))[threadIdx.x] = 0u;
    __syncthreads();
    XcdBarrier bar = xcd_barrier_post((unsigned*)(a_.ws + WS_CTL) + CW_BAR, (volatile LAS unsigned*)(lds + LDSCTL_OFF));
    const int lo = a_.ph_lo, hi = a_.ph_hi;
    int ph = 0;
#ifndef MK_ONLY
#define MK_ONLY -1
#endif
#ifndef MK_DBL
#define MK_DBL 0
#endif
#ifdef MK_MARK
#define PH_MARK(s) asm volatile("; ##" s)
#else
#define PH_MARK(s)
#endif
#define PH_BEGIN(id) if ((MK_ONLY < 0 || MK_ONLY == (id)) && ph >= lo && ph < hi) { for (int rep_ = 0; rep_ <= ((MK_DBL >> (id)) & 1); ++rep_) { PH_MARK("PH_BEGIN"); CArgs* ap = ap0; asm volatile("" : "+s"(ap)); const Args a = *(const Args*)ap; unsigned char* const ws = a.ws; (void)ws; const int wave = (int)bar.wv; int tid = wave * 64 + lane_id(); asm volatile("" : "+v"(tid)); const int lane = tid & 63, gw = blockIdx.x * 8 + wave; (void)lane; (void)gw;
#define PH_END PH_MARK("PH_END"); } } if (ph >= lo && ph + 1 < hi) xcd_barrier(bar); ++ph;

    PH_BEGIN(0) p0_prologue(a, lds, tid, lane, wave, G); PH_END

#pragma unroll 1
    for (int layer = 0; layer < DEPTH; ++layer) {
        const int kind = layer & 1, lj = layer >> 1;
        const int rows = layer == 3 ? TL : T, nmt = rows / 256;
        const int rows_moe = layer < 2 ? T : TL;
        if (kind == 0) {
            PH_BEGIN(1) phase_a_rwkv(a, layer, lds, tid, gw, NGW, lane); PH_END
            PH_BEGIN(2) {
                pg8::Gemm g{(const bf16*)(ws + WS_XL), (const bf16*)(ws + WS_WRKV) + (size_t)lj * 3840 * 1024, 6 * T, 3840, 1024};
                SchedB1 S{G, (int)blockIdx.x}; EpiB1 E{(bf16*)(ws + WS_RKV), (bf16*)(ws + WS_L1)};
                pg8::gemm_phase<EpiB1, SchedB1, true, true, false>(lds, g, S, E, tid); } PH_END
            PH_BEGIN(3) {
                pg8::Gemm g{(const bf16*)(ws + WS_L1), (const bf16*)(ws + WS_L2T) + (size_t)lj * 5120 * 128, 3 * T, 5120, 128};
                SchedB2 S{G, (int)blockIdx.x}; EpiB2 E{(bf16*)(ws + WS_RAWW), (bf16*)(ws + WS_RAWA), (bf16*)(ws + WS_G)};
                pg8::gemm_phase<EpiB2, SchedB2, true, true, false>(lds, g, S, E, tid); } PH_END
            PH_BEGIN(5) phase_s1_chunks(a, lj, lds, tid, G, (MK_DBL >> 5) & 1 & (rep_ == 0)); PH_END
            PH_BEGIN(15) phase_s2_chain(a, wave, lane, G); PH_END
            PH_BEGIN(6) phase_s3_readout(a, lj, layer == 2 ? TL : T, gw, NGW, lane); PH_END
        } else {
            PH_BEGIN(7) phase_a_conv(a, layer, rows, gw, NGW, lane); PH_END
            PH_BEGIN(8) {
                pg8::Gemm g{(const bf16*)(ws + WS_XL), (const bf16*)(ws + WS_WIN) + (size_t)lj * 3072 * 1024, rows, 3072, 1024};
                SchedStd S{G, (int)blockIdx.x, nmt, 12}; EpiWin E{(bf16*)(ws + WS_BG), (bf16*)(ws + WS_CUZ)};
                pg8::gemm_phase<EpiWin, SchedStd, true, true, false>(lds, g, S, E, tid); } PH_END
            PH_BEGIN(9) phase_cv(a, lj, rows, gw, NGW, lane); PH_END
        }
        PH_BEGIN(10) {
            const bf16* Wt = kind == 0 ? (const bf16*)(ws + WS_WO) + (size_t)lj * 1024 * 1024 : (const bf16*)(ws + WS_WOUT) + (size_t)lj * 1024 * 1024;
            pg8::Gemm g{(const bf16*)(ws + WS_Z), Wt, rows, 1024, 1024};
            SchedStd S{G, (int)blockIdx.x, layer == 2 ? NMT_L : nmt, 4}; EpiRes E{(float*)(ws + (layer < 2 ? WS_XSA : WS_XSB)), (const float*)(ws + WS_MODS) + (size_t)layer * 5 * 6144 + 2 * 1024, (float*)(ws + (rep_ ? WS_XL : (layer < 2 ? WS_XSA : WS_XSB)))};
            pg8::gemm_phase<EpiRes, SchedStd, true, true, false>(lds, g, S, E, tid); } PH_END
        PH_BEGIN(11) phase_e_route_mfma(a, layer, rows_moe, lds, tid, wave, gw, NGW, lane, rep_); PH_END
        PH_BEGIN(12) {
            const int nt = __builtin_amdgcn_readfirstlane(moe_tables((const unsigned*)(ws + WS_CTL) + CW_CNT + layer * 32 * CNT_STRIDE, lds, tid));
            pg8::Gemm g{(const bf16*)(ws + WS_H2), (const bf16*)(ws + WS_WGU) + (size_t)layer * 32 * 2048 * 1024, 0, 0, 1024};
            SchedMoe S{G, (int)blockIdx.x, 8, nt, 2, lds, (const int*)(ws + WS_SLOTL), nullptr, wave};
            EpiGU E{(bf16*)(ws + WS_INTER), a.in[30] + (size_t)layer * 32 * 2048};
            pg8::gemm_phase<EpiGU, SchedMoe, true, true, true>(lds, g, S, E, tid); } PH_END
        PH_BEGIN(13) {
            const int nt = __builtin_amdgcn_readfirstlane(moe_tables((const unsigned*)(ws + WS_CTL) + CW_CNT + layer * 32 * CNT_STRIDE, lds, tid));
            pg8::Gemm g{(const bf16*)(ws + WS_INTER), (const bf16*)(ws + WS_WDN) + (size_t)layer * 32 * 1024 * 1024, 0, 0, 1024};
            SchedMoe S{G, (int)blockIdx.x, 4, nt, 8, lds, (const int*)(ws + WS_SLOTL), (const float*)(ws + WS_GATEL), wave};
            EpiDown E{(bf16*)(ws + WS_YS), a.in[32] + (size_t)layer * 32 * 1024, lds};
            pg8::gemm_phase<EpiDown, SchedMoe, true, true, false>(lds, g, S, E, tid); } PH_END
    }
    PH_BEGIN(14) phase_final(a, gw, NGW, lane); PH_END
#undef PH_BEGIN
#undef PH_END
}

extern "C" void kernel_launch(void* const* d_in, const int* in_sizes, int n_in, void* d_out, int out_size, void* d_ws, size_t ws_size, hipStream_t stream) {
    static int grid = 0;
    if (grid == 0) {
        if (n_in != 33 || in_sizes[0] != TL * D || out_size != TL * D || ws_size < WS_END) { fprintf(stderr, "kernel_launch: unexpected problem (n_in %d, in0 %d, out %d, ws %zu < %zu)\n", n_in, n_in > 0 ? in_sizes[0] : -1, out_size, ws_size, (size_t)WS_END); grid = -1; return; }
        int dev = 0, cus = 0, per_cu = 0;
        if (hipGetDevice(&dev) != hipSuccess || hipDeviceGetAttribute(&cus, hipDeviceAttributeMultiprocessorCount, dev) != hipSuccess) { grid = -1; return; }
        if (hipFuncSetAttribute((const void*)fwd_kernel, hipFuncAttributeMaxDynamicSharedMemorySize, LDS_BYTES) != hipSuccess) { fprintf(stderr, "kernel_launch: hipFuncSetAttribute failed\n"); grid = -1; return; }
        if (hipOccupancyMaxActiveBlocksPerMultiprocessor(&per_cu, (const void*)fwd_kernel, 512, LDS_BYTES) != hipSuccess || per_cu < 1) fprintf(stderr, "kernel_launch: occupancy query says %d\n", per_cu);
        (void)hipGetLastError();
        grid = cus;
    }
    if (grid < 0) return;
    if (hipMemsetAsync((char*)d_ws + WS_CTL, 0, CTL_ZERO_BYTES, stream) != hipSuccess) return;
    Args a{};
    for (int i = 0; i < 33; ++i) a.in[i] = (const float*)d_in[i];
    a.out = (float*)d_out; a.ws = (unsigned char*)d_ws;
#if MK_PER_PHASE
    for (int p = 0; p < NPHASES; ++p) { a.ph_lo = p; a.ph_hi = p + 1; hipLaunchKernelGGL(fwd_kernel, dim3(grid), dim3(512), LDS_BYTES, stream, a); }
#else
    a.ph_lo = 0; a.ph_hi = NPHASES;
    hipLaunchKernelGGL(fwd_kernel, dim3(grid), dim3(512), LDS_BYTES, stream, a);
#endif
    const hipError_t le = hipPeekAtLastError();
    if (le != hipSuccess) fprintf(stderr, "kernel_launch: launch failed: %s\n", hipGetErrorName(le));
}
```

```cpp
#include <hip/hip_runtime.h>
#include <cstdio>
#include <cstdint>

#ifndef MK_PER_PHASE
#define MK_PER_PHASE 0
#endif

constexpr int D = 1024, NBATCH = 4, SEQ = 8192, TL = NBATCH * SEQ, CTXL = 256, TC = NBATCH * CTXL, T = TL + TC;
constexpr int NH = 16, HS = 64, NE = 32, TOPK = 4, DEPTH = 4;
constexpr int NMT = T / 256;
constexpr int NMT_L = TL / 256;
constexpr int MAXTILES = (T * TOPK) / 256 + NE;
constexpr int NSTEP = CTXL + SEQ;

__device__ __forceinline__ int lane_id() { return (int)__builtin_amdgcn_mbcnt_hi(~0u, __builtin_amdgcn_mbcnt_lo(~0u, 0u)); }
namespace pg8 {
#define PG8_LAS __attribute__((address_space(3)))
typedef unsigned short bf16_t;
typedef short bf16x8 __attribute__((ext_vector_type(8)));
typedef float f32x4 __attribute__((ext_vector_type(4)));
typedef unsigned u32x4 __attribute__((ext_vector_type(4)));
typedef unsigned u32x2 __attribute__((ext_vector_type(2)));
constexpr int BM = 256, BK = 64, HALF = 128, HTB = HALF * BK * 2  , STAGE_BYTES = 8 * HTB, NXCD = 8, WGM = 8;

__host__ __device__ __forceinline__ int lds_byte(int r, int c) { const int st = (r >> 4) * 2 + (c >> 5), rr = r & 15, cc = c & 31, ob = rr * 64 + cc * 2; return st * 1024 + (ob ^ (((ob >> 9) & 1) << 5)); }
__host__ __device__ __forceinline__ void stage_rc(int b, int& R, int& C) { const int st = b / 1024, sb = b % 1024, swz = sb ^ (((sb >> 9) & 1) << 5); R = (st >> 1) * 16 + swz / 64; C = (st & 1) * 32 + (swz % 64) / 2; }
__host__ __device__ __forceinline__ int perm32(int rho) { const int n = rho >> 4, i = rho & 15; return 8 * (i >> 2) + 4 * n + (i & 3); }

struct Unit { int pm, pn, e, nv, par; };
struct Gemm { const bf16_t* A; const bf16_t* Bt; int M, N, K; };

__device__ __forceinline__ void tile_map(int wgid, int nM, int nN, int& pm, int& pn) {
    const int nwg = nM * nN;
    { const int q = nwg / NXCD, r = nwg % NXCD, xcd = wgid % NXCD, off = wgid / NXCD; wgid = (xcd < r ? xcd * (q + 1) : r * (q + 1) + (xcd - r) * q) + off; }
    const int nig = WGM * nN, gid = wgid / nig, fm = gid * WGM, gsz = (nM - fm) < WGM ? (nM - fm) : WGM;
    pm = fm + ((wgid % nig) % gsz); pn = (wgid % nig) / gsz;
}
typedef __bf16 bf16x2_t __attribute__((ext_vector_type(2)));
typedef float f32x2_t __attribute__((ext_vector_type(2)));
__device__ __forceinline__ unsigned cvt_pk_bf16(float lo, float hi) { const f32x2_t v = {lo, hi}; const bf16x2_t b = __builtin_convertvector(v, bf16x2_t); return __builtin_bit_cast(unsigned, b); }

template <class Epi, class Sched, bool ALIGN_EPI = false, bool SP2 = false, bool GATHER = false>
__device__ __forceinline__ void gemm_phase(PG8_LAS unsigned char* lds, const Gemm g, const Sched& S, const Epi& E, int tid_in) {
    int tid_ = tid_in; asm volatile("" : "+v"(tid_));
    const int tid = tid_, wid = __builtin_amdgcn_readfirstlane(tid >> 6), lane = tid & 63, wr = wid >> 2, wc = wid & 3, fr = lane & 15, fq = lane >> 4;
    int K_ = g.K; asm volatile("" : "+s"(K_));
    const int K = K_, nt = K / BK;
    unsigned voffA[2], voffB[2]; int gR[2]; unsigned gC[2];
#pragma unroll
    for (int i = 0; i < 2; ++i) { int R, C; stage_rc(tid * 16 + i * 8192, R, C); const int Rb = Epi::PERM ? ((R & ~31) + perm32(R & 31)) : R;
        voffA[i] = (unsigned)(R * K + C) * 2u; voffB[i] = (unsigned)(Rb * K + C) * 2u; gR[i] = R; gC[i] = (unsigned)C * 2u; }
    unsigned oc[2][2], on[2][2], o2[2][2];
#pragma unroll
    for (int h = 0; h < 2; ++h)
#pragma unroll
        for (int i = 0; i < 2; ++i) { oc[h][i] = 0u; on[h][i] = 0u; o2[h][i] = 0u; }
    const size_t kstep = (size_t)(BK * 2);
    const size_t hstep = (size_t)HALF * K * 2;
    const size_t tstep = 2 * hstep;
    const unsigned ldsw = (unsigned)wid * 1024u;
    const int aoff = lds_byte(wr * 64 + fr, fq * 8), boff = lds_byte(wc * 32 + fr, fq * 8);
#define PG8_SA(b, h) (((b) * 2 + (h)) * HTB)
#define PG8_SB(b, h) ((4 + (b) * 2 + (h)) * HTB)
#define PG8_STAGE(bufoff, gbase, voff) do { _Pragma("unroll") for (int _i = 0; _i < 2; ++_i) \
        __builtin_amdgcn_global_load_lds((const unsigned*)((const char*)(gbase) + (voff)[_i]), (PG8_LAS unsigned*)(lds + (bufoff) + ldsw + _i * 8192), 16, 0, 0); } while (0)
#define PG8_STAGE_A(bufoff, base, h, O) do { if constexpr (GATHER) { PG8_STAGE(bufoff, base, (O)[h]); } else { PG8_STAGE(bufoff, (base) + (h) * hstep, voffA); } } while (0)
#define PG8_LDA(dst, b, h) do { _Pragma("unroll") for (int m = 0; m < 4; ++m) _Pragma("unroll") for (int k = 0; k < 2; ++k) dst[m][k] = *(const PG8_LAS bf16x8*)(lds + PG8_SA(b, h) + aoff + m * 2048 + k * 1024); } while (0)
#define PG8_LDB(dst, b, h) do { _Pragma("unroll") for (int n = 0; n < 2; ++n) _Pragma("unroll") for (int k = 0; k < 2; ++k) dst[n][k] = *(const PG8_LAS bf16x8*)(lds + PG8_SB(b, h) + boff + n * 2048 + k * 1024); } while (0)
#define PG8_MMA(ai, bj, At, Bt) do { __builtin_amdgcn_s_setprio(1); _Pragma("unroll") for (int m = 0; m < 4; ++m) _Pragma("unroll") for (int n = 0; n < 2; ++n) _Pragma("unroll") for (int k = 0; k < 2; ++k) \
        acc[ai][bj][m][n] = __builtin_amdgcn_mfma_f32_16x16x32_bf16(Bt[n][k], At[m][k], acc[ai][bj][m][n], 0, 0, 0); __builtin_amdgcn_s_setprio(0); } while (0)
#define PG8_WAIT_V(n) asm volatile("s_waitcnt vmcnt(" #n ")" ::: "memory")
#define PG8_WAIT_L(n) asm volatile("s_waitcnt lgkmcnt(" #n ")" ::: "memory")
#define PG8_BAR __builtin_amdgcn_s_barrier()
#define PG8_SCHED __builtin_amdgcn_sched_barrier(0)
    Unit cur, nxt; int ui = 0;
    if (!S.next(0, cur)) return;
    f32x4 acc[2][2][4][2];
#pragma unroll
    for (int a = 0; a < 2; ++a)
#pragma unroll
        for (int b = 0; b < 2; ++b)
#pragma unroll
            for (int m = 0; m < 4; ++m)
#pragma unroll
                for (int n = 0; n < 2; ++n) acc[a][b][m][n] = (f32x4){0.f, 0.f, 0.f, 0.f};
    bf16x8 At[4][2], B0[2][2], B1[2][2];
    const char* cA = GATHER ? (const char*)g.A : (const char*)g.A + (size_t)cur.pm * tstep; const char* cB = (const char*)g.Bt + (size_t)cur.pn * tstep;
    S.a_ready(cur);
    if constexpr (GATHER) {
#pragma unroll
        for (int h = 0; h < 2; ++h)
#pragma unroll
            for (int i = 0; i < 2; ++i) oc[h][i] = S.row_off(cur, h * HALF + gR[i]) + gC[i];
    }
    if constexpr (SP2) {
        PG8_STAGE(PG8_SB(0, 0), cB, voffB); PG8_STAGE(PG8_SB(0, 1), cB + hstep, voffB); PG8_STAGE_A(PG8_SA(0, 0), cA, 0, oc); PG8_STAGE_A(PG8_SA(0, 1), cA, 1, oc);
        if (wr == 1) PG8_BAR;
        PG8_WAIT_V(2); PG8_BAR;
        PG8_STAGE(PG8_SB(1, 0), cB + kstep, voffB); PG8_STAGE_A(PG8_SA(1, 0), cA + kstep, 0, oc); PG8_STAGE(PG8_SB(1, 1), cB + hstep + kstep, voffB);
        PG8_WAIT_V(6); PG8_BAR;
    } else {
        PG8_STAGE(PG8_SB(0, 0), cB, voffB); PG8_STAGE_A(PG8_SA(0, 0), cA, 0, oc); PG8_STAGE(PG8_SB(0, 1), cB + hstep, voffB); PG8_STAGE_A(PG8_SA(0, 1), cA, 1, oc);
        if (wr == 1) PG8_BAR;
        PG8_WAIT_V(4); PG8_BAR;
        PG8_STAGE(PG8_SB(1, 0), cB + kstep, voffB); PG8_STAGE_A(PG8_SA(1, 0), cA + kstep, 0, oc); PG8_STAGE(PG8_SB(1, 1), cB + hstep + kstep, voffB);
        PG8_WAIT_V(6); PG8_BAR;
    }
    for (;;) {
        const bool has_next = S.next(ui + 1, nxt);
        const char* nA = GATHER ? (const char*)g.A : (has_next ? (const char*)g.A + (size_t)nxt.pm * tstep : cA); const char* nB = has_next ? (const char*)g.Bt + (size_t)nxt.pn * tstep : cB;
        if constexpr (GATHER) { if (has_next) S.prefetch_rows(nxt); }
        for (int t = 0; t < nt; t += 2) {
            const bool last = (t == nt - 2);
            const char* a1 = cA + (size_t)(t + 1) * kstep;
            const char* a2 = last ? nA : cA + (size_t)(t + 2) * kstep; const char* b2 = last ? nB : cB + (size_t)(t + 2) * kstep;
            const char* a3 = a2 + kstep; const char* b3 = b2 + kstep;
            if constexpr (GATHER) {
                if (last) {
#pragma unroll
                    for (int h = 0; h < 2; ++h)
#pragma unroll
                        for (int i = 0; i < 2; ++i) on[h][i] = has_next ? (S.row_off_lds(nxt, h * HALF + gR[i]) + gC[i]) : oc[h][i];
                }
#pragma unroll
                for (int h = 0; h < 2; ++h)
#pragma unroll
                    for (int i = 0; i < 2; ++i) o2[h][i] = last ? on[h][i] : oc[h][i];
            }
            if (last && has_next) S.a_ready(nxt);
            if constexpr (SP2) {
            PG8_LDB(B0, 0, 0); PG8_LDB(B1, 0, 1); PG8_SCHED; PG8_LDA(At, 0, 0); PG8_STAGE_A(PG8_SA(1, 1), a1, 1, oc);
            PG8_WAIT_V(8); PG8_WAIT_L(0); PG8_BAR; PG8_MMA(0, 0, At, B0); PG8_MMA(0, 1, At, B1); PG8_BAR; PG8_SCHED;
            PG8_LDA(At, 0, 1); PG8_STAGE(PG8_SB(0, 0), b2, voffB); PG8_STAGE(PG8_SB(0, 1), b2 + hstep, voffB); PG8_STAGE_A(PG8_SA(0, 0), a2, 0, o2);
            PG8_WAIT_V(8); PG8_WAIT_L(0); PG8_BAR; PG8_MMA(1, 0, At, B0); PG8_MMA(1, 1, At, B1); PG8_BAR; PG8_SCHED;
            PG8_LDB(B0, 1, 0); PG8_LDB(B1, 1, 1); PG8_SCHED; PG8_LDA(At, 1, 0); PG8_STAGE_A(PG8_SA(0, 1), a2, 1, o2);
            PG8_WAIT_V(8); PG8_WAIT_L(0); PG8_BAR; PG8_MMA(0, 0, At, B0); PG8_MMA(0, 1, At, B1); PG8_BAR; PG8_SCHED;
            PG8_LDA(At, 1, 1); PG8_STAGE(PG8_SB(1, 0), b3, voffB); PG8_STAGE(PG8_SB(1, 1), b3 + hstep, voffB); PG8_STAGE_A(PG8_SA(1, 0), a3, 0, o2);
            PG8_WAIT_V(8); PG8_WAIT_L(0); PG8_BAR; PG8_MMA(1, 0, At, B0); PG8_MMA(1, 1, At, B1); PG8_BAR; PG8_SCHED;
            } else {
            PG8_LDB(B0, 0, 0); PG8_SCHED; PG8_LDA(At, 0, 0); PG8_STAGE_A(PG8_SA(1, 1), a1, 1, oc);
            PG8_WAIT_L(8); PG8_BAR; PG8_WAIT_L(0); PG8_MMA(0, 0, At, B0); PG8_BAR; PG8_SCHED;
            PG8_LDB(B1, 0, 1); PG8_STAGE(PG8_SB(0, 0), b2, voffB);
            PG8_BAR; PG8_WAIT_L(0); PG8_MMA(0, 1, At, B1); PG8_BAR;
            PG8_LDA(At, 0, 1); PG8_STAGE_A(PG8_SA(0, 0), a2, 0, o2);
            PG8_BAR; PG8_WAIT_L(0); PG8_MMA(1, 0, At, B0); PG8_BAR; PG8_SCHED;
            PG8_STAGE(PG8_SB(0, 1), b2 + hstep, voffB);
            PG8_WAIT_V(6); PG8_BAR; PG8_MMA(1, 1, At, B1); PG8_BAR;
            PG8_LDB(B0, 1, 0); PG8_SCHED; PG8_LDA(At, 1, 0); PG8_STAGE_A(PG8_SA(0, 1), a2, 1, o2);
            PG8_WAIT_L(8); PG8_BAR; PG8_WAIT_L(0); PG8_MMA(0, 0, At, B0); PG8_BAR; PG8_SCHED;
            PG8_LDB(B1, 1, 1); PG8_STAGE(PG8_SB(1, 0), b3, voffB);
            PG8_BAR; PG8_WAIT_L(0); PG8_MMA(0, 1, At, B1); PG8_BAR;
            PG8_LDA(At, 1, 1); PG8_STAGE_A(PG8_SA(1, 0), a3, 0, o2);
            PG8_BAR; PG8_WAIT_L(0); PG8_MMA(1, 0, At, B0); PG8_BAR; PG8_SCHED;
            PG8_STAGE(PG8_SB(1, 1), b3 + hstep, voffB);
            PG8_WAIT_V(6); PG8_BAR; PG8_MMA(1, 1, At, B1); PG8_BAR;
            }
        }
        if constexpr (ALIGN_EPI) { if (wr == 0) PG8_BAR; }
        if constexpr (!Epi::AFTER_DRAIN) { E(acc, cur, wr, wc, fr, fq); S.done(cur); }
        if (!has_next) break;
#pragma unroll
        for (int a = 0; a < 2; ++a)
#pragma unroll
            for (int b = 0; b < 2; ++b)
#pragma unroll
                for (int m = 0; m < 4; ++m)
#pragma unroll
                    for (int n = 0; n < 2; ++n) acc[a][b][m][n] = (f32x4){0.f, 0.f, 0.f, 0.f};
        cur = nxt; cA = nA; cB = nB; ++ui;
        if constexpr (GATHER) {
#pragma unroll
            for (int h = 0; h < 2; ++h)
#pragma unroll
                for (int i = 0; i < 2; ++i) oc[h][i] = on[h][i];
        }
        if constexpr (ALIGN_EPI) { if (wr == 1) PG8_BAR; }
    }
    PG8_WAIT_V(0);
    if constexpr (!ALIGN_EPI) { if (wr == 0) PG8_BAR; }
    PG8_BAR;
    if constexpr (Epi::AFTER_DRAIN) { E.fused(acc, cur, wr, wc, fr, fq, lds, wid, lane); S.done(cur); }
#undef PG8_SA
#undef PG8_SB
#undef PG8_STAGE
#undef PG8_STAGE_A
#undef PG8_LDA
#undef PG8_LDB
#undef PG8_MMA
#undef PG8_WAIT_V
#undef PG8_WAIT_L
#undef PG8_BAR
#undef PG8_SCHED
}
}

#define LAS __attribute__((address_space(3)))
typedef unsigned short bf16;
typedef float f32x4 __attribute__((ext_vector_type(4)));
typedef unsigned u32x2 __attribute__((ext_vector_type(2)));
typedef unsigned u32x4 __attribute__((ext_vector_type(4)));
#define LDS_WAIT() asm volatile("s_waitcnt lgkmcnt(0)" ::: "memory")
__device__ __forceinline__ unsigned pk2(float lo, float hi) { return pg8::cvt_pk_bf16(lo, hi); }
__device__ __forceinline__ unsigned f2bf(float f) { return pk2(f, f) & 0xffffu; }
__device__ __forceinline__ float bflo(unsigned w) { return __builtin_bit_cast(float, w << 16); }
__device__ __forceinline__ float bfhi(unsigned w) { return __builtin_bit_cast(float, w & 0xffff0000u); }
__device__ __forceinline__ float wave_sum(float v) {
#pragma unroll
    for (int o = 1; o < 64; o <<= 1) v += __shfl_xor(v, o);
    return v;
}
__device__ __forceinline__ float frcp(float x) { return __builtin_amdgcn_rcpf(x); }
__device__ __forceinline__ float sigm(float x) { return frcp(1.0f + __expf(-x)); }
__device__ __forceinline__ float tanh_fast(float x) { const float e = __expf(2.0f * x); return 1.0f - 2.0f * frcp(e + 1.0f); }

constexpr size_t MiB = 1u << 20;
constexpr size_t RF = (size_t)T * D * 4;
constexpr size_t RB = (size_t)T * D * 2;
constexpr size_t WS_CTL = 0, CTL_ZERO_BYTES = 1 * MiB;
constexpr size_t WS_MODS = 1 * MiB;
constexpr size_t WS_XSA = 2 * MiB, WS_XSB = WS_XSA + RF;
constexpr size_t WS_XL = WS_XSB + RF;
constexpr size_t WS_RKV = WS_XL + 6 * RB;
constexpr size_t WS_L1 = WS_RKV + 3 * RF;
constexpr size_t WS_WDEC = WS_L1 + 50 * MiB;
constexpr size_t WS_AA = WS_WDEC + 2 * RF;
constexpr size_t WS_G = WS_AA + 2 * RF;
constexpr size_t WS_KK = WS_G + RB;
constexpr size_t WS_KD = WS_KK + RF;
constexpr size_t WS_BETA = WS_KD + 2 * RF;
constexpr size_t WS_RKB = WS_BETA + 2 * RF;
constexpr size_t WS_C12 = WS_RKB + 3 * MiB;
constexpr size_t WS_WRT = WS_C12 + 6 * MiB;
constexpr size_t WS_Y = WS_C12 + 9 * MiB;
constexpr size_t WS_Z = WS_Y + 2 * RF;
constexpr size_t WS_H2 = WS_Z + RB;
constexpr size_t WS_SLOTL = WS_H2 + RB;
constexpr size_t WS_GATEL = WS_SLOTL + 5 * MiB;
constexpr size_t WS_WRKV = WS_GATEL + 5 * MiB;
constexpr size_t WS_L2T = WS_WRKV + 15 * MiB;
constexpr size_t WS_WO = WS_L2T + 5 * MiB;
constexpr size_t WS_WIN = WS_WO + 4 * MiB;
constexpr size_t WS_WOUT = WS_WIN + 12 * MiB;
constexpr size_t WS_WGU = WS_WOUT + 4 * MiB;
constexpr size_t WS_WDN = WS_WGU + 512 * MiB;
constexpr size_t WS_END = WS_WDN + 256 * MiB;
constexpr size_t WS_INTER = WS_WDEC;
constexpr size_t WS_YS = WS_KD;
constexpr size_t WS_BG = WS_RKV, WS_CUZ = WS_RKV + RB;
constexpr size_t WS_RAWW = WS_AA, WS_RAWA = WS_AA + RF;
constexpr size_t WS_RH = WS_AA;
constexpr size_t WS_PM = WS_WDEC;
constexpr size_t WS_RKB1 = WS_C12 + 1 * MiB;
constexpr size_t WS_QT = WS_XL;
constexpr size_t WS_HT = WS_XL + RF;
static_assert((size_t)128 * 132 * 4096 * 2 <= RF, "chunk state tensors");
static_assert((size_t)MAXTILES * 256 * 1024 * 2 <= 4 * RF, "INTER overlay");
static_assert((size_t)T * 4 * 1024 * 2 <= 2 * RF, "YS overlay");
static_assert((size_t)3 * T * 256 * 2 <= 50 * MiB, "L1OUT");
constexpr int CW_BAR = 4096;
constexpr int CW_CNT = 16384, CNT_STRIDE = 64;

constexpr int RING_BYTES = 131072;
constexpr int LDSCTL_OFF = RING_BYTES + 4096;
constexpr int LDS_BYTES = LDSCTL_OFF + 16384;

struct Args { const float* in[33]; float* out; unsigned char* ws; int ph_lo, ph_hi; };

__device__ __forceinline__ void transpose_item(const float* W, int N, bf16* WT, int dstK, int drow0, int k0, int n0, LAS float* scr, int lane) {
    float tv[64];
    const float* src = W + (size_t)k0 * N + n0 + lane;
#pragma unroll
    for (int i = 0; i < 64; ++i) tv[i] = src[(size_t)i * N];
#pragma unroll
    for (int i = 0; i < 64; ++i) scr[i * 65 + lane] = tv[i];
    LDS_WAIT(); asm volatile("" ::: "memory");
    const int c = lane & 7;
#pragma unroll
    for (int j = 0; j < 8; ++j) { const int n = (lane >> 3) + 8 * j; const LAS float* s = scr + (8 * c) * 65 + n;
        u32x4 o; o.x = pk2(s[0 * 65], s[1 * 65]); o.y = pk2(s[2 * 65], s[3 * 65]); o.z = pk2(s[4 * 65], s[5 * 65]); o.w = pk2(s[6 * 65], s[7 * 65]);
        *(u32x4*)(WT + (size_t)(drow0 + n) * dstK + k0 + 8 * c) = o; }
    LDS_WAIT(); asm volatile("" ::: "memory");
}
__device__ __forceinline__ int gu_map(int n0) { const int bj = n0 >= 1024 ? 1 : 0, f0 = n0 - bj * 1024; return (f0 >> 7) * 256 + bj * 128 + (f0 & 127); }
__device__ __forceinline__ int conv_map(int n0) { if (n0 < 1024) return n0; const int q = (n0 - 1024) >> 10, f0 = (n0 - 1024) & 1023; return 1024 + (f0 >> 7) * 256 + q * 128 + (f0 & 127); }

__device__ __forceinline__ void p0_prologue(const Args& a, LAS unsigned char* lds, int tid, int lane, int wave, int G) {
    unsigned char* ws = a.ws;
    LAS float* sl = (LAS float*)lds;
    LAS float* red = (LAS float*)(lds + 20480);
    for (int i = tid; i < 5 * 1024; i += 512) { const int r = i >> 10, k = i & 1023; const float cv = r < 4 ? a.in[1][r * 1024 + k] : a.in[3][k]; sl[i] = cv * sigm(cv); }
    __syncthreads();
    float* MODS = (float*)(ws + WS_MODS);
    for (int it = blockIdx.x; it < 4 * 96; it += G) {
        const int l = it / 96, n = (it % 96) * 64 + lane;
        const float* W = a.in[4] + (size_t)l * 1024 * 6144 + n;
        float acc[5] = {0.f, 0.f, 0.f, 0.f, 0.f};
        const int kb = wave * 128;
#pragma unroll 8
        for (int k = 0; k < 128; ++k) { const float wv = W[(size_t)(kb + k) * 6144];
#pragma unroll
            for (int r = 0; r < 5; ++r) acc[r] += sl[r * 1024 + kb + k] * wv; }
#pragma unroll
        for (int r = 0; r < 5; ++r) red[(wave * 5 + r) * 64 + lane] = acc[r];
        __syncthreads();
        if (wave < 5) { float s = a.in[5][l * 6144 + n];
#pragma unroll
            for (int w = 0; w < 8; ++w) s += red[(w * 5 + wave) * 64 + lane];
            MODS[(size_t)(l * 5 + wave) * 6144 + n] = s; }
        __syncthreads();
    }
    LAS float* scr = (LAS float*)(lds + wave * 16640);
    static_assert(8 * 16640 <= LDSCTL_OFF, "P0 scratch");
    const int gw = blockIdx.x * 8 + wave, NGW = G * 8;
    bf16* WRKV = (bf16*)(ws + WS_WRKV); bf16* WOt = (bf16*)(ws + WS_WO); bf16* WINt = (bf16*)(ws + WS_WIN); bf16* WOUTt = (bf16*)(ws + WS_WOUT);
    bf16* WGU = (bf16*)(ws + WS_WGU); bf16* WDN = (bf16*)(ws + WS_WDN);
    constexpr int I_GU = 128 * 512, I_DN = 128 * 256, I_RKV = 6 * 256, I_WO = 2 * 256, I_WIN = 2 * 768, I_WOUT = 2 * 256, I_W1 = 4 * 16, I_A1 = 4 * 16, I_G1 = 2 * 32;
    constexpr int NITEMS = I_GU + I_DN + I_RKV + I_WO + I_WIN + I_WOUT + I_W1 + I_A1 + I_G1;
    for (int it = gw; it < NITEMS; it += NGW) {
        int r = it;
        if (r < I_GU) { const int m = r >> 9, q = r & 511, kb = q >> 5, nb = q & 31;
            transpose_item(a.in[29] + (size_t)m * 1024 * 2048, 2048, WGU + (size_t)m * 2048 * 1024, 1024, gu_map(nb * 64), kb * 64, nb * 64, scr, lane); continue; } r -= I_GU;
        if (r < I_DN) { const int m = r >> 8, q = r & 255, kb = q >> 4, nb = q & 15;
            transpose_item(a.in[31] + (size_t)m * 1024 * 1024, 1024, WDN + (size_t)m * 1024 * 1024, 1024, nb * 64, kb * 64, nb * 64, scr, lane); continue; } r -= I_DN;
        if (r < I_RKV) { const int m = r >> 8, q = r & 255, kb = q >> 4, nb = q & 15, lr = m / 3, j = m % 3;
            transpose_item(a.in[9] + (size_t)m * 1024 * 1024, 1024, WRKV + (size_t)lr * 3840 * 1024, 1024, j * 1024 + nb * 64, kb * 64, nb * 64, scr, lane); continue; } r -= I_RKV;
        if (r < I_WO) { const int m = r >> 8, q = r & 255, kb = q >> 4, nb = q & 15;
            transpose_item(a.in[23] + (size_t)m * 1024 * 1024, 1024, WOt + (size_t)m * 1024 * 1024, 1024, nb * 64, kb * 64, nb * 64, scr, lane); continue; } r -= I_WO;
        if (r < I_WIN) { const int m = r / 768, q = r % 768, kb = q / 48, nb = q % 48;
            transpose_item(a.in[24] + (size_t)m * 1024 * 3072, 3072, WINt + (size_t)m * 3072 * 1024, 1024, conv_map(nb * 64), kb * 64, nb * 64, scr, lane); continue; } r -= I_WIN;
        if (r < I_WOUT) { const int m = r >> 8, q = r & 255, kb = q >> 4, nb = q & 15;
            transpose_item(a.in[26] + (size_t)m * 1024 * 1024, 1024, WOUTt + (size_t)m * 1024 * 1024, 1024, nb * 64, kb * 64, nb * 64, scr, lane); continue; } r -= I_WOUT;
        if (r < I_W1) { const int m = r >> 4, kb = r & 15, lr = m >> 1, e = m & 1;
            transpose_item(a.in[11] + (size_t)m * 1024 * 64, 64, WRKV + (size_t)lr * 3840 * 1024, 1024, 3072 + e * 64, kb * 64, 0, scr, lane); continue; } r -= I_W1;
        if (r < I_A1) { const int m = r >> 4, kb = r & 15, lr = m >> 1, e = m & 1;
            transpose_item(a.in[14] + (size_t)m * 1024 * 64, 64, WRKV + (size_t)lr * 3840 * 1024, 1024, 3328 + e * 64, kb * 64, 0, scr, lane); continue; } r -= I_A1;
        { const int m = r >> 5, q = r & 31, kb = q >> 1, nb = q & 1;
            transpose_item(a.in[16] + (size_t)m * 1024 * 128, 128, WRKV + (size_t)m * 3840 * 1024, 1024, 3584 + nb * 64, kb * 64, nb * 64, scr, lane); }
    }
    const int gt = blockIdx.x * 512 + tid, NGT = G * 512;
    for (int i = gt; i < 2 * 3 * 128 * 128; i += NGT) {
        const int pc = i & 127, rw = (i >> 7) & 127, pd = (i >> 14) % 3, lr = i / (3 * 16384);
        *(u32x4*)(WRKV + ((size_t)lr * 3840 + 3072 + pd * 256 + 128 + rw) * 1024 + pc * 8) = (u32x4){0u, 0u, 0u, 0u}; }
    bf16* L2T = (bf16*)(ws + WS_L2T);
    for (int i = gt; i < 2 * 128 * 5120; i += NGT) {
        const int n = i % 5120, k = (i / 5120) & 127, lr = i / (5120 * 128);
        float v = 0.f;
        if (n < 2048) { const int e = n >> 10, d = n & 1023; if ((k >> 6) == e) v = a.in[12][(((size_t)lr * 2 + e) * 64 + (k & 63)) * 1024 + d]; }
        else if (n < 4096) { const int e = (n - 2048) >> 10, d = n & 1023; if ((k >> 6) == e) v = a.in[15][(((size_t)lr * 2 + e) * 64 + (k & 63)) * 1024 + d]; }
        else { const int d = n - 4096; v = a.in[17][((size_t)lr * 128 + k) * 1024 + d]; }
        L2T[((size_t)lr * 5120 + n) * 128 + k] = (bf16)f2bf(v);
    }
    bf16* WRT = (bf16*)(ws + WS_WRT);
    for (int i = gt; i < 4 * 32 * 1024; i += NGT) { const int k = i & 1023, e = (i >> 10) & 31, l = i >> 15;
        const float w = a.in[27][((size_t)l * 1024 + k) * 32 + e]; const unsigned hi = f2bf(w); const float lo = w - bflo(hi);
        WRT[((size_t)(l * 2 + 0) * 32 + e) * 1024 + k] = (bf16)hi; WRT[((size_t)(l * 2 + 1) * 32 + e) * 1024 + k] = (bf16)f2bf(lo); }
}
#define XB_TMO      128
#define XB_XCNT(j)  (256  + 64 * (j))
#define XB_XSUB(j)  (1280 + 64 * (j))
#define XB_XGEN(j)  (2304 + 64 * (j))
#define XB_TOP      3328
#define XB_TOPGEN   3392
#define XCD_BAR_WORDS 3456
#define XB_SPIN_CAP (1u << 23)

__device__ __forceinline__ unsigned xb_ld(unsigned* p)              { return __hip_atomic_load(p, __ATOMIC_RELAXED, __HIP_MEMORY_SCOPE_AGENT); }
__device__ __forceinline__ unsigned xb_add(unsigned* p, unsigned v) { return __hip_atomic_fetch_add(p, v, __ATOMIC_RELAXED, __HIP_MEMORY_SCOPE_AGENT); }
__device__ __forceinline__ unsigned xb_xcc_id() { return (unsigned)__builtin_amdgcn_s_getreg((3 << 11) | 20) & 0xFu; }
#define XB_SPIN(cond, bar) do { unsigned _sp = 0; while (cond) { __builtin_amdgcn_s_sleep(1); \
    if ((++_sp & 255u) == 0u) { if (xb_ld(&(bar)[XB_TMO])) break; if (_sp > XB_SPIN_CAP) { atomicAdd(&(bar)[XB_TMO], 1u); break; } } } } while (0)

struct XcdBarrier {
    unsigned wv;
    unsigned* bar; unsigned x;
    volatile LAS unsigned* st;
};

__device__ __forceinline__ XcdBarrier xcd_barrier_post(unsigned* bar, volatile LAS unsigned* st) {
    XcdBarrier b; b.wv = (unsigned)__builtin_amdgcn_readfirstlane((int)(threadIdx.x >> 6)); b.bar = bar; b.x = xb_xcc_id(); b.st = st;
    if (threadIdx.x == 0) (void)xb_add(&bar[XB_XCNT(b.x)], 1u);
    return b;
}
__device__ __forceinline__ void xcd_barrier_complete(unsigned* bar, unsigned x, unsigned& nloc, unsigned& nx) {
    const unsigned G = gridDim.x * gridDim.y * gridDim.z;
    unsigned sum, cnt, mine, sp = 0u;
    for (;;) {
        sum = 0u; cnt = 0u; mine = 0u;
#pragma unroll
        for (unsigned j = 0; j < 16; ++j) { const unsigned c = xb_ld(&bar[XB_XCNT(j)]); sum += c; cnt += (c > 0u) ? 1u : 0u; mine = (j == x) ? c : mine; }
        if (sum == G) break;
        __builtin_amdgcn_s_sleep(1);
        if ((++sp & 255u) == 0u) { if (xb_ld(&bar[XB_TMO])) break; if (sp > XB_SPIN_CAP) { atomicAdd(&bar[XB_TMO], 1u); break; } }
    }
    nloc = mine > 0u ? mine : 1u; nx = cnt > 0u ? cnt : 1u;
}

__device__ __forceinline__ void xcd_barrier(const XcdBarrier& b) {
    asm volatile("s_waitcnt vmcnt(0)" ::: "memory");
    __syncthreads();
    if (b.wv == 0u && lane_id() == 0) {
        unsigned* bar = b.bar;
        __builtin_amdgcn_s_waitcnt(0);
        unsigned nloc = b.st[0], nx = b.st[1];
        if (nloc == 0u) { xcd_barrier_complete(bar, b.x, nloc, nx); b.st[0] = nloc; b.st[1] = nx; }
        const unsigned old = xb_add(&bar[XB_XSUB(b.x)], 1u);
        const unsigned gen = old / nloc;
        if (old + 1u == (gen + 1u) * nloc) {
            __builtin_amdgcn_fence(__ATOMIC_RELEASE, "agent");
            asm volatile("s_waitcnt vmcnt(0)" ::: "memory");
            const unsigned og = xb_add(&bar[XB_TOP], 1u);
            const unsigned tg = og / nx;
            if (og + 1u == (tg + 1u) * nx) xb_add(&bar[XB_TOPGEN], 1u);
            else XB_SPIN(xb_ld(&bar[XB_TOPGEN]) == tg, bar);
            __builtin_amdgcn_fence(__ATOMIC_ACQUIRE, "agent");
            xb_add(&bar[XB_XGEN(b.x)], 1u);
            asm volatile("s_waitcnt vmcnt(0)" ::: "memory");
        } else {
            XB_SPIN(xb_ld(&bar[XB_XGEN(b.x)]) == gen, bar);
            __builtin_amdgcn_fence(__ATOMIC_ACQUIRE, "agent");
            asm volatile("s_waitcnt vmcnt(0)" ::: "memory");
        }
    }
    __syncthreads();
}

__device__ __forceinline__ f32x4 bf4(u32x2 w) { return (f32x4){bflo(w.x), bfhi(w.x), bflo(w.y), bfhi(w.y)}; }
__device__ __forceinline__ int mod_row(int row) { return row < TL ? (row >> 13) : 4; }

__device__ __forceinline__ void load_x_combined(f32x4 (&x)[4], const float* xrow, bool has_prev, const bf16* YS, int t, const f32x4 (&m5)[4], int lane) {
#pragma unroll
    for (int j = 0; j < 4; ++j) x[j] = *(const f32x4*)(xrow + 256 * j + 4 * lane);
    if (has_prev) {
        u32x2 y[4][4];
#pragma unroll
        for (int k = 0; k < 4; ++k)
#pragma unroll
            for (int j = 0; j < 4; ++j) y[k][j] = *(const u32x2*)(YS + ((size_t)t * 4 + k) * 1024 + 256 * j + 4 * lane);
#pragma unroll
        for (int j = 0; j < 4; ++j) { const f32x4 s = (bf4(y[0][j]) + bf4(y[1][j])) + (bf4(y[2][j]) + bf4(y[3][j])); x[j] += m5[j] * s; }
    }
}
__device__ __forceinline__ float row_rstd(const f32x4 (&x)[4]) {
    float ss = 0.f;
#pragma unroll
    for (int j = 0; j < 4; ++j) ss += (x[j].x * x[j].x + x[j].y * x[j].y) + (x[j].z * x[j].z + x[j].w * x[j].w);
    return rsqrtf(wave_sum(ss) * (1.0f / 1024.0f) + 1e-6f);
}

__device__ __forceinline__ void phase_a_rwkv(const Args& a, int layer, LAS unsigned char* lds, int tid, int gw, int NGW, int lane) {
    unsigned char* ws = a.ws; const int lj = layer >> 1; const bool has_prev = layer > 0;
    const float* xin_lat = layer == 0 ? a.in[0] : (const float*)(ws + WS_XSA);
    const float* xin_ctx = layer == 0 ? a.in[2] : (const float*)(ws + WS_XSA) + (size_t)TL * D;
    float* xout = (float*)(ws + (layer == 0 ? WS_XSA : WS_XSB));
    const float* MODS = (const float*)(ws + WS_MODS); const bf16* YS = (const bf16*)(ws + WS_YS); bf16* XL = (bf16*)(ws + WS_XL);
    const float* mug = a.in[8] + (size_t)lj * 6 * 2 * 1024; const float* ng = a.in[6] + (size_t)(layer * 2 + 0) * 1024;
    LAS float* mu = (LAS float*)lds;
    for (int i = tid; i < 6 * 2 * 1024 / 4; i += 512) ((LAS f32x4*)mu)[i] = ((const f32x4*)mug)[i];
    __syncthreads();
    for (int it = gw; it < TL / 8 + TC / 2; it += NGW) {
        const int ntok = it < TL / 8 ? 8 : 2, t0 = it < TL / 8 ? it * 8 : TL + (it - TL / 8) * 2, mr = mod_row(t0);
        int rs, re; if (t0 < TL) { rs = t0 & ~63; re = rs + 63; } else { const int loc = t0 - TL; rs = TL + (loc & ~255); re = rs + 255; }
        const float* mod = MODS + (size_t)(layer * 5 + mr) * 6144;
        const float* m5p = MODS + (size_t)((has_prev ? layer - 1 : 0) * 5 + mr) * 6144 + 5 * 1024;
        f32x4 hm[4], h0[4], hp[4];
#pragma unroll
        for (int j = 0; j < 4; ++j) { hm[j] = (f32x4){0.f, 0.f, 0.f, 0.f}; h0[j] = hm[j]; hp[j] = hm[j]; }
        f32x4 rx[4], nx[4]; u32x2 ry[4][4], ny[4][4];
#define PA_LOAD(X, Y, tt) do { const int t_ = (tt); if (t_ >= rs && t_ <= re) { \
            const float* xrow_ = t_ < TL ? xin_lat + (size_t)t_ * D : xin_ctx + (size_t)(t_ - TL) * D; \
            _Pragma("unroll") for (int j = 0; j < 4; ++j) X[j] = *(const f32x4*)(xrow_ + 256 * j + 4 * lane); \
            if (has_prev) { _Pragma("unroll") for (int k = 0; k < 4; ++k) _Pragma("unroll") for (int j = 0; j < 4; ++j) Y[k][j] = *(const u32x2*)(YS + ((size_t)t_ * 4 + k) * 1024 + 256 * j + 4 * lane); } } } while (0)
#pragma unroll
        for (int j = 0; j < 4; ++j) { rx[j] = (f32x4){0.f, 0.f, 0.f, 0.f}; nx[j] = rx[j];
#pragma unroll
            for (int k = 0; k < 4; ++k) { ry[k][j] = (u32x2){0u, 0u}; ny[k][j] = ry[k][j]; } }
        PA_LOAD(rx, ry, t0 - 1);
        f32x4 gsc[4], sh4[4], m5v[4];
#pragma unroll
        for (int j = 0; j < 4; ++j) { const int col = 256 * j + 4 * lane; gsc[j] = *(const f32x4*)(ng + col) * (*(const f32x4*)(mod + 1024 + col) + 1.0f); sh4[j] = *(const f32x4*)(mod + col); m5v[j] = *(const f32x4*)(m5p + col); }
#pragma unroll
        for (int j = 0; j < 4; ++j) asm volatile("" : "+v"(gsc[j]), "+v"(sh4[j]), "+v"(m5v[j]), "+v"(rx[j]));
#pragma unroll 1
        for (int i = -1; i <= ntok; ++i) {
            const int t = t0 + i;
            if (i < ntok) PA_LOAD(nx, ny, t + 1);
            f32x4 hn[4];
            if (t >= rs && t <= re) {
                f32x4 x[4];
#pragma unroll
                for (int j = 0; j < 4; ++j) x[j] = rx[j];
                if (has_prev) {
#pragma unroll
                    for (int j = 0; j < 4; ++j) { f32x4 sm = (f32x4){0.f, 0.f, 0.f, 0.f};
#pragma unroll
                        for (int k = 0; k < 4; ++k) sm += (f32x4){bflo(ry[k][j].x), bfhi(ry[k][j].x), bflo(ry[k][j].y), bfhi(ry[k][j].y)};
                        x[j] += m5v[j] * sm; } }
                if (i >= 0 && i < ntok) {
#pragma unroll
                    for (int j = 0; j < 4; ++j) *(f32x4*)(xout + (size_t)t * D + 256 * j + 4 * lane) = x[j]; }
                const float rstd = row_rstd(x);
#pragma unroll
                for (int j = 0; j < 4; ++j) hn[j] = x[j] * rstd * gsc[j] + sh4[j];
            } else {
#pragma unroll
                for (int j = 0; j < 4; ++j) hn[j] = (f32x4){0.f, 0.f, 0.f, 0.f};
            }
#pragma unroll
            for (int j = 0; j < 4; ++j) { hm[j] = h0[j]; h0[j] = hp[j]; hp[j] = hn[j]; rx[j] = nx[j];
#pragma unroll
                for (int k = 0; k < 4; ++k) ry[k][j] = ny[k][j]; }
            if (i >= 1) {
                const int te = t - 1;
#pragma unroll
                for (int q = 0; q < 6; ++q) {
                    bf16* orow = XL + ((size_t)q * T + te) * D;
#pragma unroll
                    for (int j = 0; j < 4; ++j) { const int col = 256 * j + 4 * lane;
                        const f32x4 m0 = *(const LAS f32x4*)(mu + (q * 2 + 0) * 1024 + col), m1 = *(const LAS f32x4*)(mu + (q * 2 + 1) * 1024 + col);
                        const f32x4 o = h0[j] + m0 * (hm[j] - h0[j]) + m1 * (hp[j] - h0[j]);
                        u32x2 w; w.x = pk2(o.x, o.y); w.y = pk2(o.z, o.w); *(u32x2*)(orow + col) = w; }
                }
            }
        }
#undef PA_LOAD
    }
}
__device__ __forceinline__ void phase_a_conv(const Args& a, int layer, int rows, int gw, int NGW, int lane) {
    unsigned char* ws = a.ws;
    float* xs = (float*)(ws + (layer < 2 ? WS_XSA : WS_XSB));
    const float* MODS = (const float*)(ws + WS_MODS); const bf16* YS = (const bf16*)(ws + WS_YS); bf16* H = (bf16*)(ws + WS_XL);
    const float* ng = a.in[6] + (size_t)(layer * 2 + 0) * 1024;
    for (int t = gw; t < rows; t += NGW) {
        const int mr = mod_row(t);
        const float* mod = MODS + (size_t)(layer * 5 + mr) * 6144;
        f32x4 m5[4], x[4];
#pragma unroll
        for (int j = 0; j < 4; ++j) m5[j] = *(const f32x4*)(MODS + (size_t)((layer - 1) * 5 + mr) * 6144 + 5 * 1024 + 256 * j + 4 * lane);
        f32x4 gsc[4], sh4[4], ngv[4];
#pragma unroll
        for (int j = 0; j < 4; ++j) { const int col = 256 * j + 4 * lane; ngv[j] = *(const f32x4*)(ng + col); gsc[j] = *(const f32x4*)(mod + 1024 + col); sh4[j] = *(const f32x4*)(mod + col); }
        load_x_combined(x, xs + (size_t)t * D, true, YS, t, m5, lane);
#pragma unroll
        for (int j = 0; j < 4; ++j) gsc[j] = ngv[j] * (gsc[j] + 1.0f);
        const float rstd = row_rstd(x);
#pragma unroll
        for (int j = 0; j < 4; ++j) { const int col = 256 * j + 4 * lane;
            *(f32x4*)(xs + (size_t)t * D + col) = x[j];
            const f32x4 h = x[j] * rstd * gsc[j] + sh4[j];
            u32x2 w; w.x = pk2(h.x, h.y); w.y = pk2(h.z, h.w); *(u32x2*)(H + (size_t)t * D + col) = w; }
    }
}
#define DPPF(x, ctrl) __builtin_bit_cast(float, __builtin_amdgcn_update_dpp(0, __builtin_bit_cast(int, (x)), (ctrl), 0xf, 0xf, false))
__device__ __forceinline__ float row16_sum(float v) { v += DPPF(v, 0xB1); v += DPPF(v, 0x4E); v += DPPF(v, 0x141); v += DPPF(v, 0x140); return v; }
__device__ __forceinline__ u32x2 pk4(f32x4 v) { u32x2 w; w.x = pk2(v[0], v[1]); w.y = pk2(v[2], v[3]); return w; }
__device__ __forceinline__ void phase_c_prep(const Args& a, int lj, LAS unsigned char* lds, int tid, int gw, int NGW, int lane) {
    unsigned char* ws = a.ws;
    const bf16* Rr = (const bf16*)(ws + WS_RKV); const bf16* Kk = Rr + (size_t)T * D; const bf16* RA = (const bf16*)(ws + WS_RAWA); const bf16* RW = (const bf16*)(ws + WS_RAWW);
    bf16* KK = (bf16*)(ws + WS_KK); bf16* KD = (bf16*)(ws + WS_KD); bf16* BE = (bf16*)(ws + WS_BETA); float* RKB = (float*)(ws + WS_RKB);
    LAS float* tb = (LAS float*)lds;
    for (int i = tid; i < 7 * 256; i += 512) { const int t7 = i >> 8, q = i & 255;
        const float* src = t7 == 0 ? a.in[18] + lj * 1024 : t7 == 1 ? a.in[19] + lj * 1024 : t7 == 2 ? a.in[20] + lj * 1024 : t7 < 5 ? a.in[10] + lj * 2048 + (t7 - 3) * 1024 : a.in[13] + lj * 2048 + (t7 - 5) * 1024;
        ((LAS f32x4*)tb)[i] = ((const f32x4*)src)[q]; }
    __syncthreads();
    for (int row = gw; row < T; row += NGW) {
#pragma unroll
        for (int j = 0; j < 4; ++j) {
            const int col = 256 * j + 4 * lane; const size_t ro = (size_t)row * D + col;
            const f32x4 k = bf4(*(const u32x2*)(Kk + ro)), r = bf4(*(const u32x2*)(Rr + ro));
            f32x4 a0 = bf4(*(const u32x2*)(RA + ro)) + *(const LAS f32x4*)(tb + 5 * 1024 + col), a1 = bf4(*(const u32x2*)(RA + (size_t)T * D + ro)) + *(const LAS f32x4*)(tb + 6 * 1024 + col);
#pragma unroll
            for (int z = 0; z < 4; ++z) { a0[z] = sigm(a0[z]); a1[z] = sigm(a1[z]); }
            const f32x4 ck = *(const LAS f32x4*)(tb + col), ca = *(const LAS f32x4*)(tb + 1024 + col), cr = *(const LAS f32x4*)(tb + 2048 + col);
            const f32x4 kk = k * ck;
            const float ss = row16_sum((kk.x * kk.x + kk.y * kk.y) + (kk.z * kk.z + kk.w * kk.w));
            const f32x4 kd0 = k * ((a0 - 1.0f) * ca + 1.0f), kd1 = k * ((a1 - 1.0f) * ca + 1.0f);
            *(u32x2*)(KD + ro) = pk4(kd0); *(u32x2*)(KD + (size_t)T * D + ro) = pk4(kd1);
            const f32x4 p = r * (kd0 + kd1) * cr;
            const float rk = row16_sum((p.x + p.y) + (p.z + p.w));
            const f32x4 kkn = kk * fminf(__builtin_amdgcn_rsqf(ss), 1e12f);
            *(u32x2*)(KK + ro) = pk4(kkn); *(u32x2*)(BE + ro) = pk4(kkn * a0); *(u32x2*)(BE + (size_t)T * D + ro) = pk4(kkn * a1);
            if ((lane & 15) == 0) RKB[(size_t)row * 16 + 4 * j + (lane >> 4)] = rk;
        }
    }
}
typedef short bf16x8 __attribute__((ext_vector_type(8)));
__device__ __forceinline__ f32x4 mfma16(bf16x8 a, bf16x8 b, f32x4 c) { return __builtin_amdgcn_mfma_f32_16x16x32_bf16(a, b, c, 0, 0, 0); }
__device__ __forceinline__ bf16x8 as_frag(u32x4 w) { return __builtin_bit_cast(bf16x8, w); }
constexpr int CH_LD = 144;
constexpr int CH_MS = 64 * CH_LD;
constexpr int CH_AB = 0 * CH_MS, CH_KT = 1 * CH_MS, CH_BT = 2 * CH_MS, CH_RB = 3 * CH_MS, CH_VT = 4 * CH_MS, CH_ABT = 5 * CH_MS, CH_KHT = 6 * CH_MS, CH_BHT = 7 * CH_MS,
              CH_LK = 8 * CH_MS, CH_LB = 9 * CH_MS, CH_MK = 10 * CH_MS, CH_MB = 11 * CH_MS, CH_WT = 12 * CH_MS, CH_U0 = 13 * CH_MS, CH_DINV = 14 * CH_MS;
constexpr int CH_GC = LDSCTL_OFF + 2048;
constexpr int CH_PART = LDSCTL_OFF + 4096;
constexpr int NCHUNK = NSTEP / 64;
#ifndef S1_DBL
#define S1_DBL 0
#endif
static_assert(CH_DINV + 2048 <= RING_BYTES, "chunk LDS map");

__device__ __forceinline__ int scan_row(int s, int dir, int b) {
    if (s < CTXL) return TL + b * CTXL + (dir ? CTXL - 1 - s : s);
    const int i = s - CTXL; return b * SEQ + (dir ? SEQ - 1 - i : i);
}
#define CH_FRAG(mat, row, ks, kg) as_frag(*(const LAS u32x4*)(lds + (mat) + (row) * CH_LD + ((ks) * 32 + (kg) * 8) * 2))

__device__ __forceinline__ float s1_treduce16(const float (&a)[16], bool b3, bool b2) {
    float b[8];
#pragma unroll
    for (int i = 0; i < 8; ++i) { float x = a[i], y = a[i + 8];
        asm("s_nop 1\n\tv_permlane32_swap_b32 %0, %1" : "+v"(x), "+v"(y));
        b[i] = x + y; }
    float c[4];
#pragma unroll
    for (int i = 0; i < 4; ++i) { float x = b[i], y = b[i + 4];
        asm("s_nop 1\n\tv_permlane16_swap_b32 %0, %1" : "+v"(x), "+v"(y));
        c[i] = x + y; }
    float d[2];
#pragma unroll
    for (int i = 0; i < 2; ++i) { const float keep = b3 ? c[i + 2] : c[i], send = b3 ? c[i] : c[i + 2]; d[i] = keep + DPPF(send, 0x128); }
    const float keep = b2 ? d[1] : d[0], send = b2 ? d[0] : d[1];
    float e = keep + DPPF(send, 0x141);
    e += DPPF(e, 0xB1);
    e += DPPF(e, 0x4E);
    return e;
}
#define S1_BAR() do { asm volatile("s_waitcnt lgkmcnt(0)" ::: "memory"); __builtin_amdgcn_s_barrier(); asm volatile("" ::: "memory"); } while (0)
__device__ __forceinline__ void phase_s1_chunks(const Args& a, int lj, LAS unsigned char* lds, int tid, int G, int rh_scratch = 0) {
    unsigned char* ws = a.ws; const float* w0l = a.in[10] + lj * 2048; const float* a0l = a.in[13] + lj * 2048;
    const float* pkk = a.in[18] + lj * 1024; const float* pka = a.in[19] + lj * 1024; const float* prk = a.in[20] + lj * 1024;
    const int lane = tid & 63, wave = __builtin_amdgcn_readfirstlane(tid >> 6), l15 = lane & 15, g = lane >> 4;
    LAS float* part = (LAS float*)(lds + CH_PART); LAS float* gammaC = (LAS float*)(lds + CH_GC);
    unsigned nlw[8], nka[8], nkr[8], nrr[8], nvv[8]; float nw0 = 0.f, na0 = 0.f, npkk = 0.f, npka = 0.f, nprk = 0.f;
    typedef const __attribute__((address_space(1))) unsigned short* GUS;
#define S1_LOAD(ctx_) do { unsigned char* wsl = ws; asm volatile("" : "+s"(wsl));     \
        const int chain_ = (ctx_) / NCHUNK, c_ = (ctx_) - chain_ * NCHUNK, dir_ = chain_ >> 6, b_ = (chain_ >> 4) & 3, h_ = chain_ & 15; \
          \
          \
        const long o0 = (long)scan_row(64 * c_ + 8 * wave, dir_, b_) * D + h_ * 64, od = (long)dir_ * T * D, st = dir_ ? -(long)D : (long)D; \
        const bf16* LWp = (const bf16*)(wsl + WS_RAWW) + od + o0; const bf16* RAp = (const bf16*)(wsl + WS_RAWA) + od + o0; \
        const bf16* Rp = (const bf16*)(wsl + WS_RKV) + o0; const bf16* Kp = Rp + (size_t)T * D; const bf16* Vp = Rp + (size_t)2 * T * D; \
        nw0 = w0l[dir_ * 1024 + h_ * 64 + lane]; na0 = a0l[dir_ * 1024 + h_ * 64 + lane]; npkk = pkk[h_ * 64 + lane]; npka = pka[h_ * 64 + lane]; nprk = prk[h_ * 64 + lane]; \
        _Pragma("unroll") for (int j = 0; j < 8; ++j) { const long oj = st * j; \
            nlw[j] = ((GUS)(LWp + oj))[lane]; nka[j] = ((GUS)(RAp + oj))[lane]; nkr[j] = ((GUS)(Kp + oj))[lane]; nrr[j] = ((GUS)(Rp + oj))[lane]; nvv[j] = ((GUS)(Vp + oj))[lane]; } } while (0)
    unsigned clw[8], cka_[8], ckr[8], crr[8], cvv[8]; float cw0 = 0.f, ca0 = 0.f, cpkk = 0.f, cpka = 0.f, cprk = 0.f;
#define S1_TAKE() do { _Pragma("unroll") for (int j = 0; j < 8; ++j) { clw[j] = nlw[j]; cka_[j] = nka[j]; ckr[j] = nkr[j]; crr[j] = nrr[j]; cvv[j] = nvv[j]; } \
        cw0 = nw0; ca0 = na0; cpkk = npkk; cpka = npka; cprk = nprk; \
        _Pragma("unroll") for (int j = 0; j < 8; ++j) asm volatile("" : "+v"(clw[j]), "+v"(cka_[j]), "+v"(ckr[j]), "+v"(crr[j]), "+v"(cvv[j]) :: "memory"); \
        asm volatile("" : "+v"(cw0), "+v"(ca0), "+v"(cpkk), "+v"(cpka), "+v"(cprk) :: "memory"); } while (0)
    if ((int)blockIdx.x < 128 * NCHUNK) { S1_LOAD((int)blockIdx.x); S1_TAKE(); if ((int)blockIdx.x + G < 128 * NCHUNK) S1_LOAD((int)blockIdx.x + G); }
    for (int ct = blockIdx.x; ct < 128 * NCHUNK; ct += G) {
        const int chain = ct / NCHUNK, c = ct - chain * NCHUNK, dir = chain >> 6, b = (chain >> 4) & 3, h = chain & 15;
        unsigned zq = 0u; asm volatile("" : "+v"(zq));
        {
            const int k = lane, tq = wave;
            float lw[8], kd[8], be[8], kk[8], rr[8], vv[8];
            {
                const float w0k = cw0, a0k = ca0, ckk = cpkk, cka = cpka, crk = cprk;
                float* RKBd = (float*)(ws + (dir ? WS_RKB1 : WS_RKB));
                const int row0 = scan_row(64 * c + 8 * tq, dir, b), rst = dir ? -1 : 1;
                float av[8], kq[8], red[16];
#pragma unroll
                for (int j = 0; j < 8; ++j) { av[j] = sigm(bflo(cka_[j]) + a0k); const float kr = bflo(ckr[j]);
                    lw[j] = -0.60653066f * sigm(bflo(clw[j]) + w0k);
                    kq[j] = kr * ckk; kd[j] = kr * ((av[j] - 1.0f) * cka + 1.0f); rr[j] = bflo(crr[j]); vv[j] = bflo(cvv[j]);
                    red[2 * j] = kq[j] * kq[j]; red[2 * j + 1] = rr[j] * kd[j] * crk; }
                const float tot = s1_treduce16(red, (lane & 8) != 0, (lane & 4) != 0);
                if ((lane & 7) == 4) RKBd[(size_t)(row0 + rst * (lane >> 3)) * 16 + h] = tot;
#pragma unroll
                for (int j = 0; j < 8; ++j) { const float ss = __builtin_bit_cast(float, __builtin_amdgcn_readlane(__builtin_bit_cast(int, tot), 8 * j));
                    kk[j] = kq[j] * fminf(__builtin_amdgcn_rsqf(ss), 1e12f);     be[j] = kk[j] * av[j]; }
            }
            for (int r0_ = 0; r0_ <= ((S1_DBL >> 3) & 1); ++r0_) { if (r0_) S1_BAR();
            float p[8]; p[0] = lw[0];
#pragma unroll
            for (int j = 1; j < 8; ++j) p[j] = p[j - 1] + lw[j];
            part[tq * 64 + k] = p[7];
            S1_BAR();
            float off = 0.f, tot = 0.f;
#pragma unroll
            for (int q = 0; q < 8; ++q) { const float pv = part[q * 64 + k]; tot += pv; off += q < tq ? pv : 0.f; }
            const float eTot = __expf(tot); float ePrev = __expf(off);
            if (tq == 0) gammaC[k] = eTot;
            unsigned abw[4], khw[4], bhw[4], vw[4];
#pragma unroll
            for (int j = 0; j < 8; j += 2) {
                float ab2[2], kt2[2], bt2[2], rb2[2], kh2[2], bh2[2];
#pragma unroll
                for (int z = 0; z < 2; ++z) { const float cu = off + p[j + z]; const float eP = __expf(cu), eM = __expf(-cu), eC = eTot * eM;
                    ab2[z] = kk[j + z] * ePrev; ePrev = eP; kt2[z] = kd[j + z] * eM; bt2[z] = be[j + z] * eM; rb2[z] = rr[j + z] * eP; kh2[z] = kd[j + z] * eC; bh2[z] = be[j + z] * eC;
                }
                abw[j >> 1] = pk2(ab2[0], ab2[1]); khw[j >> 1] = pk2(kh2[0], kh2[1]); bhw[j >> 1] = pk2(bh2[0], bh2[1]); vw[j >> 1] = pk2(vv[j], vv[j + 1]);
                {
                    const unsigned ktw = pk2(kt2[0], kt2[1]), btw = pk2(bt2[0], bt2[1]), rbw = pk2(rb2[0], rb2[1]), aw = abw[j >> 1];
                    const int t = 8 * tq + j;
                    *(LAS bf16*)(lds + CH_AB + t * CH_LD + k * 2) = (bf16)aw; *(LAS bf16*)(lds + CH_AB + (t + 1) * CH_LD + k * 2) = (bf16)(aw >> 16);
                    *(LAS bf16*)(lds + CH_KT + t * CH_LD + k * 2) = (bf16)ktw; *(LAS bf16*)(lds + CH_KT + (t + 1) * CH_LD + k * 2) = (bf16)(ktw >> 16);
                    *(LAS bf16*)(lds + CH_BT + t * CH_LD + k * 2) = (bf16)btw; *(LAS bf16*)(lds + CH_BT + (t + 1) * CH_LD + k * 2) = (bf16)(btw >> 16);
                    *(LAS bf16*)(lds + CH_RB + t * CH_LD + k * 2) = (bf16)rbw; *(LAS bf16*)(lds + CH_RB + (t + 1) * CH_LD + k * 2) = (bf16)(rbw >> 16); }
            }
            *(LAS u32x4*)(lds + CH_ABT + k * CH_LD + tq * 16) = (u32x4){abw[0], abw[1], abw[2], abw[3]};
            *(LAS u32x4*)(lds + CH_KHT + k * CH_LD + tq * 16) = (u32x4){khw[0], khw[1], khw[2], khw[3]};
            *(LAS u32x4*)(lds + CH_BHT + k * CH_LD + tq * 16) = (u32x4){bhw[0], bhw[1], bhw[2], bhw[3]};
            *(LAS u32x4*)(lds + CH_VT + k * CH_LD + tq * 16) = (u32x4){vw[0], vw[1], vw[2], vw[3]};
            *(LAS u32x4*)(lds + CH_WT + k * CH_LD + tq * 16) = (u32x4){zq, zq, zq, zq}; *(LAS u32x4*)(lds + CH_U0 + k * CH_LD + tq * 16) = (u32x4){zq, zq, zq, zq};
            }
        }
        S1_BAR();
        for (int r1_ = 0; r1_ <= (S1_DBL & 1); ++r1_) { if (r1_) S1_BAR();
            const int mi = wave >> 1, half = wave & 1;
            const int matS = (mi & 1) ? CH_BT : CH_KT, matT = (mi & 2) ? CH_RB : CH_AB, matO = CH_LK + mi * CH_MS;
            const bool incl = (mi & 2) != 0;
            bf16x8 fs[4][2], ft[2][2];
#pragma unroll
            for (int ms = 0; ms < 4; ++ms)
#pragma unroll
                for (int ks = 0; ks < 2; ++ks) fs[ms][ks] = CH_FRAG(matS, 16 * ms + l15, ks, g);
#pragma unroll
            for (int nt = 0; nt < 2; ++nt)
#pragma unroll
                for (int ks = 0; ks < 2; ++ks) ft[nt][ks] = CH_FRAG(matT, 32 * half + 16 * nt + l15, ks, g);
#pragma unroll
            for (int nt = 0; nt < 2; ++nt) { const int t = 32 * half + 16 * nt + l15;
#pragma unroll
                for (int ms = 0; ms < 4; ++ms) { f32x4 d = (f32x4){0.f, 0.f, 0.f, 0.f};
                    d = mfma16(fs[ms][0], ft[nt][0], d); d = mfma16(fs[ms][1], ft[nt][1], d);
                    const int s0 = 16 * ms + 4 * g;
#pragma unroll
                    for (int i = 0; i < 4; ++i) { const bool keep = incl ? (s0 + i <= t) : (s0 + i < t); d[i] = keep ? d[i] : __builtin_bit_cast(float, zq); }
                    u32x2 w; w.x = pk2(d[0], d[1]); w.y = pk2(d[2], d[3]);
                    *(LAS u32x2*)(lds + matO + t * CH_LD + s0 * 2) = w; } }
        }
        S1_BAR();
        f32x4 rhsU[4];
#pragma unroll
        for (int I = 0; I < 4; ++I) rhsU[I] = (f32x4){0.f, 0.f, 0.f, 0.f};
        if (wave >= 4) {
            const int ctv = (wave & 3) * 16;
            const bf16x8 fv0 = CH_FRAG(CH_VT, ctv + l15, 0, g), fv1 = CH_FRAG(CH_VT, ctv + l15, 1, g);
#pragma unroll
            for (int I = 0; I < 4; ++I) { f32x4 d = (f32x4){0.f, 0.f, 0.f, 0.f};
                d = mfma16(CH_FRAG(CH_LK, 16 * I + l15, 0, g), fv0, d); d = mfma16(CH_FRAG(CH_LK, 16 * I + l15, 1, g), fv1, d); rhsU[I] = -d; }
        }
        for (int r2_ = 0; r2_ <= ((S1_DBL >> 1) & 1); ++r2_) if (wave == 0) {
            const int bb = lane >> 4, j = lane & 15;
            float x[16];
#pragma unroll
            for (int t = 0; t < 16; ++t) {
                const u32x4 r0 = *(const LAS u32x4*)(lds + CH_LB + (16 * bb + t) * CH_LD + 32 * bb), r1 = *(const LAS u32x4*)(lds + CH_LB + (16 * bb + t) * CH_LD + 32 * bb + 16);
                const unsigned rw[8] = {r0.x, r0.y, r0.z, r0.w, r1.x, r1.y, r1.z, r1.w};
                float acc = (t == j) ? 1.0f : 0.0f;
#pragma unroll
                for (int s = 0; s < t; ++s) { const float lv = (s & 1) ? bfhi(rw[s >> 1]) : bflo(rw[s >> 1]); acc -= lv * x[s]; }
                x[t] = acc;
                *(LAS bf16*)(lds + CH_DINV + ((bb * 16 + t) * 16 + j) * 2) = (bf16)f2bf(acc);
            }
        }
        S1_BAR();
        {
            const int matZ = wave < 4 ? CH_WT : CH_U0, ct16 = (wave & 3) * 16;
            for (int r4_ = 0; r4_ <= ((S1_DBL >> 4) & 1); ++r4_) { if (r4_) { *(LAS u32x4*)(lds + matZ + (ct16 + l15) * CH_LD + g * 32) = (u32x4){zq, zq, zq, zq}; *(LAS u32x4*)(lds + matZ + (ct16 + l15) * CH_LD + g * 32 + 16) = (u32x4){zq, zq, zq, zq}; LDS_WAIT(); }
#pragma unroll
            for (int I = 0; I < 4; ++I) {
                f32x4 rhs;
                if (wave < 4) { const u32x2 w = *(const LAS u32x2*)(lds + CH_ABT + (ct16 + l15) * CH_LD + (16 * I + 4 * g) * 2); rhs = (f32x4){bflo(w.x), bfhi(w.x), bflo(w.y), bfhi(w.y)}; }
                else rhs = rhsU[I];
                f32x4 d = (f32x4){0.f, 0.f, 0.f, 0.f};
                d = mfma16(CH_FRAG(CH_LB, 16 * I + l15, 0, g), CH_FRAG(matZ, ct16 + l15, 0, g), d); d = mfma16(CH_FRAG(CH_LB, 16 * I + l15, 1, g), CH_FRAG(matZ, ct16 + l15, 1, g), d);
                const f32x4 ac = rhs - d;
                const u32x2 dv = *(const LAS u32x2*)(lds + CH_DINV + ((I * 16 + l15) * 16 + 4 * g) * 2);
                const bf16x8 fa = as_frag((u32x4){dv.x, dv.y, zq, zq}), fb = as_frag((u32x4){pk2(ac[0], ac[1]), pk2(ac[2], ac[3]), zq, zq});
                const f32x4 z = mfma16(fa, fb, (f32x4){0.f, 0.f, 0.f, 0.f});
                u32x2 w; w.x = pk2(z[0], z[1]); w.y = pk2(z[2], z[3]);
                *(LAS u32x2*)(lds + matZ + (ct16 + l15) * CH_LD + (16 * I + 4 * g) * 2) = w;
                LDS_WAIT(); asm volatile("" ::: "memory");
            }
            }
        }
        S1_BAR();
        if (ct + G < 128 * NCHUNK) { S1_TAKE(); if (ct + 2 * G < 128 * NCHUNK) S1_LOAD(ct + 2 * G); }
        for (int r3_ = 0; r3_ <= ((S1_DBL >> 2) & 1); ++r3_) { if (r3_) S1_BAR();
            const int rt = wave >> 1, cp = (wave & 1) * 2;
            unsigned char* wsl = ws; asm volatile("" : "+s"(wsl));
            bf16* YL = (bf16*)(wsl + WS_Y); bf16* RH = (bf16*)(wsl + (rh_scratch ? WS_BETA + RF : WS_RH)); bf16* PM = (bf16*)(wsl + WS_PM); bf16* QT = (bf16*)(wsl + WS_QT);
            const int trow = scan_row(64 * c + 16 * rt + l15, dir, b);
#pragma unroll
            for (int q = 0; q < 2; ++q) { const int vt = cp + q; f32x4 d = (f32x4){0.f, 0.f, 0.f, 0.f};
#pragma unroll
                for (int ks = 0; ks < 2; ++ks) { d = mfma16(CH_FRAG(CH_VT, 16 * vt + l15, ks, g), CH_FRAG(CH_MK, 16 * rt + l15, ks, g), d); d = mfma16(CH_FRAG(CH_U0, 16 * vt + l15, ks, g), CH_FRAG(CH_MB, 16 * rt + l15, ks, g), d); }
                *(u32x2*)(YL + ((size_t)dir * T + trow) * D + h * 64 + 16 * vt + 4 * g) = pk4(d); }
#pragma unroll
            for (int q = 0; q < 2; ++q) { const int kt = cp + q; f32x4 d = (f32x4){0.f, 0.f, 0.f, 0.f};
#pragma unroll
                for (int ks = 0; ks < 2; ++ks) d = mfma16(CH_FRAG(CH_WT, 16 * kt + l15, ks, g), CH_FRAG(CH_MB, 16 * rt + l15, ks, g), d);
                const u32x2 rbw = *(const LAS u32x2*)(lds + CH_RB + (16 * rt + l15) * CH_LD + (16 * kt + 4 * g) * 2);
                u32x2 w; w.x = pk2(bflo(rbw.x) - d[0], bfhi(rbw.x) - d[1]); w.y = pk2(bflo(rbw.y) - d[2], bfhi(rbw.y) - d[3]);
                *(u32x2*)(RH + ((size_t)dir * T + trow) * D + h * 64 + 16 * kt + 4 * g) = w; }
            bf16* Pc = PM + ((size_t)chain * NCHUNK + c) * 4096; bf16* Qc = QT + ((size_t)chain * NCHUNK + c) * 4096;
            { const int krow = 16 * rt + l15; const float gc = gammaC[krow];
#pragma unroll
                for (int q = 0; q < 2; ++q) { const int kt = cp + q; f32x4 d = (f32x4){0.f, 0.f, 0.f, 0.f};
#pragma unroll
                    for (int ks = 0; ks < 2; ++ks) d = mfma16(CH_FRAG(CH_WT, 16 * kt + l15, ks, g), CH_FRAG(CH_BHT, krow, ks, g), d);
                    const int k0 = 16 * kt + 4 * g; f32x4 o;
#pragma unroll
                    for (int i = 0; i < 4; ++i) o[i] = ((k0 + i == krow) ? gc : 0.f) - d[i];
                    u32x2 w; w.x = pk2(o[0], o[1]); w.y = pk2(o[2], o[3]);
                    *(u32x2*)(Pc + ((rt * 2 + (kt >> 1)) * 64 + g * 16 + l15) * 8 + 4 * (kt & 1)) = w; } }
            { const int vrow = 16 * rt + l15;
#pragma unroll
                for (int q = 0; q < 2; ++q) { const int kt = cp + q; f32x4 d = (f32x4){0.f, 0.f, 0.f, 0.f};
#pragma unroll
                    for (int ks = 0; ks < 2; ++ks) { d = mfma16(CH_FRAG(CH_KHT, 16 * kt + l15, ks, g), CH_FRAG(CH_VT, vrow, ks, g), d); d = mfma16(CH_FRAG(CH_BHT, 16 * kt + l15, ks, g), CH_FRAG(CH_U0, vrow, ks, g), d); }
                    u32x2 w; w.x = pk2(d[0], d[1]); w.y = pk2(d[2], d[3]);
                    *(u32x2*)(Qc + ((rt * 2 + (kt >> 1)) * 64 + g * 16 + l15) * 8 + 4 * (kt & 1)) = w; } }
        }
        S1_BAR();
    }
}

struct S2Set { u32x4 p[4][2]; u32x4 q[2]; };
__device__ __forceinline__ void s2_load(S2Set& s, const bf16* Pc, const bf16* Qc, int vt, int l15, int g) {
    const int ln = g * 16 + l15;
    s.q[0] = *(const u32x4*)(Qc + ((vt * 2 + 0) * 64 + ln) * 8); s.q[1] = *(const u32x4*)(Qc + ((vt * 2 + 1) * 64 + ln) * 8);
#pragma unroll
    for (int m = 0; m < 4; ++m)
#pragma unroll
        for (int j = 0; j < 2; ++j) s.p[m][j] = *(const u32x4*)(Pc + ((m * 2 + j) * 64 + ln) * 8);
}
__device__ __forceinline__ void s2_step(f32x4 (&acc)[4], const S2Set& s, bf16* Hc, int g) {
    unsigned hw[4][2];
#pragma unroll
    for (int m = 0; m < 4; ++m) { hw[m][0] = pk2(acc[m][0], acc[m][1]); hw[m][1] = pk2(acc[m][2], acc[m][3]); }
#pragma unroll
    for (int m = 0; m < 4; ++m) *(u32x2*)(Hc + (m >> 1) * 512 + (m & 1) * 256) = (u32x2){hw[m][0], hw[m][1]};
    const bf16x8 hb0 = as_frag((u32x4){hw[0][0], hw[0][1], hw[1][0], hw[1][1]}), hb1 = as_frag((u32x4){hw[2][0], hw[2][1], hw[3][0], hw[3][1]});
#pragma unroll
    for (int m = 0; m < 4; ++m) {
        const unsigned q0 = (m & 2) ? ((m & 1) ? s.q[1].z : s.q[1].x) : ((m & 1) ? s.q[0].z : s.q[0].x), q1 = (m & 2) ? ((m & 1) ? s.q[1].w : s.q[1].y) : ((m & 1) ? s.q[0].w : s.q[0].y);
        f32x4 d = (f32x4){bflo(q0), bfhi(q0), bflo(q1), bfhi(q1)};
        d = mfma16(as_frag(s.p[m][0]), hb0, d);
        d = mfma16(as_frag(s.p[m][1]), hb1, d);
        acc[m] = d;
    }
}
__device__ __forceinline__ void phase_s2_chain(const Args& a, int wave, int lane, int G) {
    unsigned char* ws = a.ws;
    const bf16* PM = (const bf16*)(ws + WS_PM); const bf16* QT = (const bf16*)(ws + WS_QT); bf16* HT = (bf16*)(ws + WS_HT);
    const int l15 = lane & 15, g = lane >> 4;
    if (wave >= 2) return;
    static_assert(NCHUNK % 4 == 0, "S2 ring");
    for (int wt = blockIdx.x * 2 + wave; wt < 512; wt += G * 2) {
        const int chain = wt >> 2, vt = wt & 3;
        f32x4 acc[4];
#pragma unroll
        for (int m = 0; m < 4; ++m) acc[m] = (f32x4){0.f, 0.f, 0.f, 0.f};
        const bf16* Pc = PM + (size_t)chain * NCHUNK * 4096; const bf16* Qc = QT + (size_t)chain * NCHUNK * 4096;
        bf16* Hc = HT + (size_t)chain * NCHUNK * 4096 + ((vt * 2) * 64 + (g >> 1) * 16 + l15) * 8 + 4 * (g & 1);
        S2Set s0, s1, s2, s3;
        s2_load(s0, Pc, Qc, vt, l15, g); s2_load(s1, Pc + 4096, Qc + 4096, vt, l15, g); s2_load(s2, Pc + 2 * 4096, Qc + 2 * 4096, vt, l15, g); s2_load(s3, Pc + 3 * 4096, Qc + 3 * 4096, vt, l15, g);
#pragma unroll 1
        for (int c = 0; c < NCHUNK; c += 4) {
            const int cn = c + 4 < NCHUNK ? c + 4 : c;
            const bf16* Pn = Pc + (size_t)cn * 4096; const bf16* Qn = Qc + (size_t)cn * 4096;
            s2_step(acc, s0, Hc + (size_t)c * 4096, g);       s2_load(s0, Pn, Qn, vt, l15, g);
            s2_step(acc, s1, Hc + (size_t)(c + 1) * 4096, g); s2_load(s1, Pn + 4096, Qn + 4096, vt, l15, g);
            s2_step(acc, s2, Hc + (size_t)(c + 2) * 4096, g); s2_load(s2, Pn + 2 * 4096, Qn + 2 * 4096, vt, l15, g);
            s2_step(acc, s3, Hc + (size_t)(c + 3) * 4096, g); s2_load(s3, Pn + 3 * 4096, Qn + 3 * 4096, vt, l15, g);
        }
    }
}

struct S3In { u32x2 yl[2][4]; u32x4 rh[2][2]; u32x4 hh[2][4][2]; };
__device__ __forceinline__ void s3_issue(S3In& s, const bf16* YL, const bf16* RH, const bf16* HT, int task, int l15, int g) {
    const int tt = task >> 4, h = task & 15, r0 = tt * 16, row = r0 + l15;
    int b, cc[2];
    if (r0 < TL) { b = r0 >> 13; const int tb = (r0 & (SEQ - 1)) >> 6; cc[0] = 4 + tb; cc[1] = 4 + (127 - tb); }
    else { const int loc = r0 - TL; b = loc >> 8; const int tb = (loc & 255) >> 6; cc[0] = tb; cc[1] = 3 - tb; }
    const size_t ro = (size_t)row * D + h * 64 + 4 * g;
#pragma unroll
    for (int dir = 0; dir < 2; ++dir) {
#pragma unroll
        for (int vt = 0; vt < 4; ++vt) s.yl[dir][vt] = *(const u32x2*)(YL + (size_t)dir * T * D + ro + 16 * vt);
        const int chain = dir * 64 + b * 16 + h;
        const bf16* rh = RH + ((size_t)dir * T + row) * D + h * 64 + 8 * g;
        s.rh[dir][0] = *(const u32x4*)(rh); s.rh[dir][1] = *(const u32x4*)(rh + 32);
        const bf16* hc = HT + ((size_t)chain * NCHUNK + cc[dir]) * 4096;
#pragma unroll
        for (int vt = 0; vt < 4; ++vt) { const bf16* hr = hc + ((vt * 2) * 64 + g * 16 + l15) * 8; s.hh[dir][vt][0] = *(const u32x4*)(hr); s.hh[dir][vt][1] = *(const u32x4*)(hr + 512); }
    }
}
__device__ __forceinline__ void s3_finish(const S3In& s, const bf16* Vv, const float* RKB, const float* RKB1, const bf16* Gg, const float* lng, const float* lnb, bf16* Z, int task, int l15, int g) {
    const int tt = task >> 4, h = task & 15, row = tt * 16 + l15;
    u32x2 vq2[4], gw2[4]; f32x4 lg4[4], lb4[4];
#pragma unroll
    for (int vt = 0; vt < 4; ++vt) { const int col = h * 64 + 16 * vt + 4 * g; const size_t o = (size_t)row * D + col;
        vq2[vt] = *(const u32x2*)(Vv + o); gw2[vt] = *(const u32x2*)(Gg + o); lg4[vt] = *(const f32x4*)(lng + col); lb4[vt] = *(const f32x4*)(lnb + col); }
    const float bon = RKB[(size_t)row * 16 + h] + RKB1[(size_t)row * 16 + h];
    f32x4 acc[4];
#pragma unroll
    for (int vt = 0; vt < 4; ++vt) acc[vt] = bf4(s.yl[0][vt]) + bf4(s.yl[1][vt]);
#pragma unroll
    for (int dir = 0; dir < 2; ++dir) {
        const bf16x8 f0 = as_frag(s.rh[dir][0]), f1 = as_frag(s.rh[dir][1]);
#pragma unroll
        for (int vt = 0; vt < 4; ++vt) { acc[vt] = mfma16(as_frag(s.hh[dir][vt][0]), f0, acc[vt]); acc[vt] = mfma16(as_frag(s.hh[dir][vt][1]), f1, acc[vt]); }
    }
    float sm = 0.f;
#pragma unroll
    for (int vt = 0; vt < 4; ++vt) sm += (acc[vt][0] + acc[vt][1]) + (acc[vt][2] + acc[vt][3]);
    sm += __shfl_xor(sm, 16); sm += __shfl_xor(sm, 32);
    const float mean = sm * (1.0f / 64.0f); float vs = 0.f;
#pragma unroll
    for (int vt = 0; vt < 4; ++vt) { acc[vt] = acc[vt] - mean; vs += (acc[vt][0] * acc[vt][0] + acc[vt][1] * acc[vt][1]) + (acc[vt][2] * acc[vt][2] + acc[vt][3] * acc[vt][3]); }
    vs += __shfl_xor(vs, 16); vs += __shfl_xor(vs, 32);
    const float rstd = rsqrtf(vs * (1.0f / 64.0f) + 64.0f * 1e-5f);
#pragma unroll
    for (int vt = 0; vt < 4; ++vt) { const int col = h * 64 + 16 * vt + 4 * g; const size_t o = (size_t)row * D + col;
        const f32x4 zz = acc[vt] * rstd * lg4[vt] + lb4[vt] + bf4(vq2[vt]) * bon;
        u32x2 w; w.x = pk2(zz[0] * bflo(gw2[vt].x), zz[1] * bfhi(gw2[vt].x)); w.y = pk2(zz[2] * bflo(gw2[vt].y), zz[3] * bfhi(gw2[vt].y));
        *(u32x2*)(Z + o) = w; }
}
__device__ __forceinline__ void phase_s3_readout(const Args& a, int lj, int nrows, int gw, int NGW, int lane) {
    unsigned char* ws = a.ws;
    const bf16* YL = (const bf16*)(ws + WS_Y); const bf16* RH = (const bf16*)(ws + WS_RH); const bf16* HT = (const bf16*)(ws + WS_HT);
    const bf16* Vv = (const bf16*)(ws + WS_RKV) + (size_t)2 * T * D; const float* RKB = (const float*)(ws + WS_RKB); const float* RKB1 = (const float*)(ws + WS_RKB1); const bf16* Gg = (const bf16*)(ws + WS_G); bf16* Z = (bf16*)(ws + WS_Z);
    const float* lng = a.in[21] + lj * 1024; const float* lnb = a.in[22] + lj * 1024;
    const int l15 = lane & 15, g = lane >> 4, ntask = (nrows / 16) * 16;
    for (int task = gw; task < ntask; task += NGW) {
        S3In A;
        s3_issue(A, YL, RH, HT, task, l15, g);
        s3_finish(A, Vv, RKB, RKB1, Gg, lng, lnb, Z, task, l15, g);
    }
}
__device__ __forceinline__ void phase_cv(const Args& a, int lc, int rows, int gw, int NGW, int lane) {
    unsigned char* ws = a.ws;
    const bf16* BG = (const bf16*)(ws + WS_BG); const bf16* CU = (const bf16*)(ws + WS_CUZ); bf16* Z = (bf16*)(ws + WS_Z);
    const float* cw = a.in[25] + (size_t)lc * 3 * 1024;
    for (int t = gw; t < rows; t += NGW) {
        int rs, re; if (t < TL) { rs = t & ~63; re = rs + 63; } else { const int loc = t - TL; rs = TL + (loc & ~255); re = rs + 255; }
        const bool hp = t > rs, hn = t < re;
        u32x2 zc4[4], bg4[4], zp4[4], zn4[4]; f32x4 w04[4], w14[4], w24[4];
#pragma unroll
        for (int j = 0; j < 4; ++j) { const int col = 256 * j + 4 * lane; const size_t o = (size_t)t * D + col;
            zc4[j] = *(const u32x2*)(CU + o); bg4[j] = *(const u32x2*)(BG + o);
            zp4[j] = hp ? *(const u32x2*)(CU + o - D) : (u32x2){0u, 0u}; zn4[j] = hn ? *(const u32x2*)(CU + o + D) : (u32x2){0u, 0u};
            w04[j] = *(const f32x4*)(cw + col); w14[j] = *(const f32x4*)(cw + 1024 + col); w24[j] = *(const f32x4*)(cw + 2048 + col); }
#pragma unroll
        for (int j = 0; j < 4; ++j) { const int col = 256 * j + 4 * lane; const size_t o = (size_t)t * D + col;
            const u32x2 zc = zc4[j], bg = bg4[j], zp = zp4[j], zn = zn4[j];
            const f32x4 w0 = w04[j], w1 = w14[j], w2 = w24[j];
            const f32x4 zv = (f32x4){bflo(zc.x), bfhi(zc.x), bflo(zc.y), bfhi(zc.y)}, pv = (f32x4){bflo(zp.x), bfhi(zp.x), bflo(zp.y), bfhi(zp.y)}, nv = (f32x4){bflo(zn.x), bfhi(zn.x), bflo(zn.y), bfhi(zn.y)};
            const f32x4 bv = (f32x4){bflo(bg.x), bfhi(bg.x), bflo(bg.y), bfhi(bg.y)};
            const f32x4 r = bv * (w0 * pv + w1 * zv + w2 * nv);
            u32x2 w; w.x = pk2(r.x, r.y); w.y = pk2(r.z, r.w); *(u32x2*)(Z + o) = w; }
    }
}
typedef float f32x2v __attribute__((ext_vector_type(2)));
__device__ __forceinline__ float lane_bcast(float v, int srclane) { return __builtin_bit_cast(float, __builtin_amdgcn_readlane(__builtin_bit_cast(int, v), srclane)); }
__device__ __forceinline__ void phase_e_route(const Args& a, int layer, int rows, LAS unsigned char* lds, int tid, int gw, int NGW, int lane, int probe_rep = 0) {
    unsigned char* ws = a.ws;
    const float* xs = (const float*)(ws + (layer < 2 ? WS_XSA : WS_XSB));
    const float* MODS = (const float*)(ws + WS_MODS); bf16* H2 = (bf16*)(ws + WS_H2);
    const float* ng = a.in[6] + (size_t)(layer * 2 + 1) * 1024;
    const float* rw = a.in[27] + (size_t)layer * 1024 * 32; const float* rb = a.in[28] + layer * 32;
    unsigned* cnt = (unsigned*)(ws + WS_CTL) + CW_CNT + (layer + 4 * probe_rep) * 32 * CNT_STRIDE;
    int* SLOTL = (int*)(ws + (probe_rep ? WS_L1 : WS_SLOTL)); float* GATEL = (float*)(ws + (probe_rep ? WS_L1 + 8 * MiB : WS_GATEL));
    LAS float* wt = (LAS float*)lds;
    LAS int* hist = (LAS int*)(lds + LDSCTL_OFF + 3072); LAS int* base = hist + 32; LAS int* lcnt = hist + 64;
    int* TKE = (int*)(ws + WS_C12); float* TKG = (float*)(ws + WS_C12 + 4 * MiB);
    for (int i = tid; i < 32768; i += 512) wt[(i & 31) * 1024 + (i >> 5)] = rw[i];
    if (tid < 32) hist[tid] = 0;
    __syncthreads();
    const int my_e = lane >> 1; const float my_b = rb[my_e];
    const bool b5 = (lane & 32) != 0, b4 = (lane & 16) != 0, b3 = (lane & 8) != 0, b2 = (lane & 4) != 0, b1 = (lane & 2) != 0;
    for (int t = gw; t < rows; t += NGW) {
        const int mr = mod_row(t);
        const float* mod = MODS + (size_t)(layer * 5 + mr) * 6144;
        f32x4 x[4];
#pragma unroll
        for (int j = 0; j < 4; ++j) x[j] = *(const f32x4*)(xs + (size_t)t * D + 256 * j + 4 * lane);
        const float rstd = row_rstd(x);
#pragma unroll
        for (int j = 0; j < 4; ++j) { const int col = 256 * j + 4 * lane;
            x[j] = x[j] * rstd * *(const f32x4*)(ng + col) * (*(const f32x4*)(mod + 4 * 1024 + col) + 1.0f) + *(const f32x4*)(mod + 3 * 1024 + col);
            u32x2 w; w.x = pk2(x[j].x, x[j].y); w.y = pk2(x[j].z, x[j].w); *(u32x2*)(H2 + (size_t)t * D + col) = w; }
        float p[32];
#pragma unroll
        for (int eg = 0; eg < 8; ++eg) {
#pragma unroll
            for (int ee = 0; ee < 4; ++ee) { const int e = eg * 4 + ee; f32x2v s2 = (f32x2v){0.f, 0.f};
#pragma unroll
                for (int j = 0; j < 4; ++j) { const f32x4 wv = *(const LAS f32x4*)(wt + e * 1024 + 256 * j + 4 * lane);
                    s2 = __builtin_elementwise_fma((f32x2v){x[j].x, x[j].y}, (f32x2v){wv.x, wv.y}, s2); s2 = __builtin_elementwise_fma((f32x2v){x[j].z, x[j].w}, (f32x2v){wv.z, wv.w}, s2); }
                p[e] = s2.x + s2.y; }
            asm volatile("" ::: "memory");
        }
        float q16[16];
#pragma unroll
        for (int i = 0; i < 16; ++i) { const float send = b5 ? p[i] : p[i + 16]; const float keep = b5 ? p[i + 16] : p[i]; q16[i] = keep + __shfl_xor(send, 32); }
        float q8[8];
#pragma unroll
        for (int i = 0; i < 8; ++i) { const float send = b4 ? q16[i] : q16[i + 8]; const float keep = b4 ? q16[i + 8] : q16[i]; q8[i] = keep + __shfl_xor(send, 16); }
        float q4[4];
#pragma unroll
        for (int i = 0; i < 4; ++i) { const float send = b3 ? q8[i] : q8[i + 4]; const float keep = b3 ? q8[i + 4] : q8[i]; q4[i] = keep + __shfl_xor(send, 8); }
        float q2[2];
#pragma unroll
        for (int i = 0; i < 2; ++i) { const float send = b2 ? q4[i] : q4[i + 2]; const float keep = b2 ? q4[i + 2] : q4[i]; q2[i] = keep + __shfl_xor(send, 4); }
        float q1; { const float send = b1 ? q2[0] : q2[1]; const float keep = b1 ? q2[1] : q2[0]; q1 = keep + __shfl_xor(send, 2); }
        const float lg = q1 + __shfl_xor(q1, 1) + my_b;
        int rank = 0;
#pragma unroll 1
        for (int e = 0; e < 32; ++e) { const float o = lane_bcast(lg, 2 * e); rank += (o > lg || (o == lg && e < my_e)) ? 1 : 0; }
        const bool sel = rank < 4 && !(lane & 1);
        const unsigned long long m0 = __ballot(sel && rank == 0), m1 = __ballot(sel && rank == 1), m2 = __ballot(sel && rank == 2), m3 = __ballot(sel && rank == 3);
        const float v0 = lane_bcast(lg, (int)__builtin_ctzll(m0)), v1 = lane_bcast(lg, (int)__builtin_ctzll(m1)), v2 = lane_bcast(lg, (int)__builtin_ctzll(m2)), v3 = lane_bcast(lg, (int)__builtin_ctzll(m3));
        const float e1 = __expf(v1 - v0), e2 = __expf(v2 - v0), e3 = __expf(v3 - v0);
        const float inv = frcp(1.0f + e1 + e2 + e3);
        if (sel) {
            TKE[t * 4 + rank] = my_e; TKG[t * 4 + rank] = __expf(lg - v0) * inv;
            __hip_atomic_fetch_add(hist + my_e, 1, __ATOMIC_RELAXED, __HIP_MEMORY_SCOPE_WORKGROUP);
        }
    }
    asm volatile("s_waitcnt vmcnt(0) lgkmcnt(0)" ::: "memory"); __syncthreads();
    if (tid < 32) { base[tid] = (int)atomicAdd(cnt + tid * CNT_STRIDE, (unsigned)hist[tid]); lcnt[tid] = 0; }
    __syncthreads();
    for (int t = gw; t < rows; t += NGW) {
        if (lane < 4) { const int e = TKE[t * 4 + lane]; const float gk = TKG[t * 4 + lane];
            const int pos = base[e] + __hip_atomic_fetch_add(lcnt + e, 1, __ATOMIC_RELAXED, __HIP_MEMORY_SCOPE_WORKGROUP);
            SLOTL[(size_t)e * T + pos] = t * 4 + lane; GATEL[(size_t)e * T + pos] = gk; }
    }
}
__device__ __forceinline__ int okey(float v, int e) { const int i = __builtin_bit_cast(int, v); const int o = i ^ ((i >> 31) & 0x7fffffff); return (o & ~31) | (31 - e); }
__device__ __forceinline__ void phase_e_route_mfma(const Args& a, int layer, int rows, LAS unsigned char* lds, int tid, int wave, int gw, int NGW, int lane, int probe_rep = 0) {
    unsigned char* ws = a.ws;
    const float* xs = (const float*)(ws + (layer < 2 ? WS_XSA : WS_XSB));
    const float* MODS = (const float*)(ws + WS_MODS); bf16* H2 = (bf16*)(ws + WS_H2);
    const float* ng = a.in[6] + (size_t)(layer * 2 + 1) * 1024; const float* rb = a.in[28] + layer * 32;
    const bf16* WRT = (const bf16*)(ws + WS_WRT) + (size_t)layer * 2 * 32 * 1024;
    unsigned* cnt = (unsigned*)(ws + WS_CTL) + CW_CNT + (layer + 4 * probe_rep) * 32 * CNT_STRIDE;
    int* SLOTL = (int*)(ws + (probe_rep ? WS_L1 : WS_SLOTL)); float* GATEL = (float*)(ws + (probe_rep ? WS_L1 + 8 * MiB : WS_GATEL));
    LAS int* hist = (LAS int*)(lds + LDSCTL_OFF + 3072); LAS int* base = hist + 32; LAS int* lcnt = hist + 64;
    int* TKE = (int*)(ws + WS_C12); float* TKG = (float*)(ws + WS_C12 + 4 * MiB);
    LAS unsigned char* tile = lds + wave * 8448;
    if (tid < 32) hist[tid] = 0;
    constexpr int E_TAB = 8 * 8448, E_TP = 2064;
    static_assert(E_TAB + 32 * E_TP <= LDSCTL_OFF, "router table");
    for (int i = tid; i < 32 * 128; i += 512) { const int r = i >> 7, pc = i & 127; *(LAS u32x4*)(lds + E_TAB + r * E_TP + pc * 16) = *(const u32x4*)(WRT + (size_t)r * 1024 + pc * 8); }
    __syncthreads();
    const int l15 = lane & 15, g = lane >> 4;
    const int nlat = TL / 16, nctx = rows > TL ? TC / 4 : 0, G_ = NGW / 8;
    for (int it = 0;; ++it) {
        int t0, ntok;
        { const int tl = gw + it * NGW; const int xi = (int)blockIdx.x + (it - (nlat + NGW - 1) / NGW) * G_ * 8 + wave * G_;
          if (tl < nlat) { t0 = tl * 16; ntok = 16; } else if (it >= (nlat + NGW - 1) / NGW && xi < nctx) { t0 = TL + xi * 4; ntok = 4; } else if (it >= (nlat + NGW - 1) / NGW) break; else continue; }
        const float* mod = MODS + (size_t)(layer * 5 + mod_row(t0)) * 6144;
        float rstd[16];
#pragma unroll
        for (int tb = 0; tb < 16; tb += 8) {
            f32x4 xa[8][4];
#pragma unroll
            for (int t = 0; t < 8; ++t) { const int tr = tb + t < ntok ? t0 + tb + t : t0;
#pragma unroll
                for (int j = 0; j < 4; ++j) xa[t][j] = *(const f32x4*)(xs + (size_t)tr * D + 256 * j + 4 * lane); }
#pragma unroll
            for (int t = 0; t < 8; ++t) rstd[tb + t] = __builtin_bit_cast(float, __builtin_amdgcn_readfirstlane(__builtin_bit_cast(int, row_rstd(xa[t]))));
            asm volatile("" ::: "memory"); }
        f32x4 acc[2]; acc[0] = (f32x4){0.f, 0.f, 0.f, 0.f}; acc[1] = acc[0];
#pragma unroll 1
        for (int s = 0; s < 4; ++s) {
            const int col = 256 * s + 4 * lane;
            int t0s = t0; asm volatile("" : "+s"(t0s));
            const bf16* wl = WRT + (size_t)(32 + l15) * 1024 + 256 * s + 8 * g;
            u32x4 wlf[8][2];
#pragma unroll
            for (int ks = 0; ks < 8; ++ks)
#pragma unroll
                for (int et = 0; et < 2; ++et) wlf[ks][et] = *(const u32x4*)(wl + (size_t)et * 16 * 1024 + 32 * ks);
            const f32x4 g4 = *(const f32x4*)(ng + col) * (*(const f32x4*)(mod + 4 * 1024 + col) + 1.0f), s4 = *(const f32x4*)(mod + 3 * 1024 + col);
            u32x2 lo[16];
#pragma unroll
            for (int tb = 0; tb < 16; tb += 8) {
                f32x4 xr[8];
#pragma unroll
                for (int t = 0; t < 8; ++t) { const int tr = tb + t < ntok ? t0s + tb + t : t0s; xr[t] = *(const f32x4*)(xs + (size_t)tr * D + col); }
#pragma unroll
                for (int t = 0; t < 8; ++t) { const int tr = tb + t < ntok ? t0s + tb + t : t0s; const f32x4 hv = xr[t] * rstd[tb + t] * g4 + s4;
                    const u32x2 w = pk4(hv); if (tb + t < ntok) *(u32x2*)(H2 + (size_t)tr * D + col) = w;
                    *(LAS u32x2*)(tile + (tb + t) * 528 + lane * 8) = w; lo[tb + t] = pk4(hv - bf4(w)); } }
            LDS_WAIT(); asm volatile("" ::: "memory");
            const LAS unsigned char* th = lds + E_TAB + l15 * E_TP + (256 * s + 8 * g) * 2;
#pragma unroll
            for (int ks = 0; ks < 8; ++ks) { const bf16x8 fb = as_frag(*(const LAS u32x4*)(tile + l15 * 528 + ks * 64 + g * 16));
#pragma unroll
                for (int et = 0; et < 2; ++et) { acc[et] = mfma16(as_frag(*(const LAS u32x4*)(th + et * 16 * E_TP + 64 * ks)), fb, acc[et]);
                    acc[et] = mfma16(as_frag(wlf[ks][et]), fb, acc[et]); } }
            LDS_WAIT(); asm volatile("" ::: "memory");
#pragma unroll
            for (int t = 0; t < 16; ++t) *(LAS u32x2*)(tile + t * 528 + lane * 8) = lo[t];
            LDS_WAIT(); asm volatile("" ::: "memory");
#pragma unroll
            for (int ks = 0; ks < 8; ++ks) { const bf16x8 fb = as_frag(*(const LAS u32x4*)(tile + l15 * 528 + ks * 64 + g * 16));
#pragma unroll
                for (int et = 0; et < 2; ++et) acc[et] = mfma16(as_frag(*(const LAS u32x4*)(th + et * 16 * E_TP + 64 * ks)), fb, acc[et]); }
            LDS_WAIT(); asm volatile("" ::: "memory");
        }
        float v[8]; int key[8];
#pragma unroll
        for (int j = 0; j < 8; ++j) { const int e = (j < 4 ? 0 : 16) + 4 * g + (j & 3); v[j] = acc[j >> 2][j & 3] + rb[e]; key[j] = okey(v[j], e); }
        int kb[8], kc[8], kd2[8];
#pragma unroll
        for (int j = 0; j < 8; ++j) kb[j] = __shfl_xor(key[j], 16);
#pragma unroll
        for (int j = 0; j < 8; ++j) { kc[j] = __shfl_xor(key[j], 32); kd2[j] = __shfl_xor(kb[j], 32); }
        float vmax = fmaxf(fmaxf(fmaxf(v[0], v[1]), fmaxf(v[2], v[3])), fmaxf(fmaxf(v[4], v[5]), fmaxf(v[6], v[7])));
        vmax = fmaxf(vmax, __shfl_xor(vmax, 16)); vmax = fmaxf(vmax, __shfl_xor(vmax, 32));
        int rank[8]; float ex[8], part = 0.f;
#pragma unroll
        for (int j = 0; j < 8; ++j) { int r = 0;
#pragma unroll
            for (int q = 0; q < 8; ++q) r += (key[q] > key[j]) + (kb[q] > key[j]) + (kc[q] > key[j]) + (kd2[q] > key[j]);
            rank[j] = r; ex[j] = __expf(v[j] - vmax); part += r < 4 ? ex[j] : 0.f; }
        part += __shfl_xor(part, 16); part += __shfl_xor(part, 32);
        const float inv = frcp(part); const int t = t0 + l15;
#pragma unroll
        for (int j = 0; j < 8; ++j) if (rank[j] < 4 && l15 < ntok) { const int e = (j < 4 ? 0 : 16) + 4 * g + (j & 3);
            TKE[t * 4 + rank[j]] = e; TKG[t * 4 + rank[j]] = ex[j] * inv;
            __hip_atomic_fetch_add(hist + e, 1, __ATOMIC_RELAXED, __HIP_MEMORY_SCOPE_WORKGROUP); }
    }
    asm volatile("s_waitcnt vmcnt(0) lgkmcnt(0)" ::: "memory"); __syncthreads();
    if (tid < 32) { base[tid] = (int)atomicAdd(cnt + tid * CNT_STRIDE, (unsigned)hist[tid]); lcnt[tid] = 0; }
    __syncthreads();
    for (int it = 0;; ++it) {
        int t0, ntok;
        { const int tl = gw + it * NGW; const int xi = (int)blockIdx.x + (it - (nlat + NGW - 1) / NGW) * G_ * 8 + wave * G_;
          if (tl < nlat) { t0 = tl * 16; ntok = 16; } else if (it >= (nlat + NGW - 1) / NGW && xi < nctx) { t0 = TL + xi * 4; ntok = 4; } else if (it >= (nlat + NGW - 1) / NGW) break; else continue; }
        if ((lane >> 2) < ntok) { const int t = t0 + (lane >> 2), k = lane & 3;
            const int e = TKE[t * 4 + k]; const float gk = TKG[t * 4 + k];
            const int pos = base[e] + __hip_atomic_fetch_add(lcnt + e, 1, __ATOMIC_RELAXED, __HIP_MEMORY_SCOPE_WORKGROUP);
            SLOTL[(size_t)e * T + pos] = t * 4 + k; GATEL[(size_t)e * T + pos] = gk; }
    }
}
__device__ __forceinline__ void phase_final(const Args& a, int gw, int NGW, int lane) {
    unsigned char* ws = a.ws;
    const float* xs = (const float*)(ws + WS_XSB); const float* MODS = (const float*)(ws + WS_MODS); const bf16* YS = (const bf16*)(ws + WS_YS);
    for (int t = gw; t < TL; t += NGW) {
        const int mr = t >> 13;
        f32x4 m5[4], x[4];
#pragma unroll
        for (int j = 0; j < 4; ++j) m5[j] = *(const f32x4*)(MODS + (size_t)(3 * 5 + mr) * 6144 + 5 * 1024 + 256 * j + 4 * lane);
        f32x4 fg[4];
#pragma unroll
        for (int j = 0; j < 4; ++j) fg[j] = *(const f32x4*)(a.in[7] + 256 * j + 4 * lane);
        load_x_combined(x, xs + (size_t)t * D, true, YS, t, m5, lane);
        const float rstd = row_rstd(x);
#pragma unroll
        for (int j = 0; j < 4; ++j) { const int col = 256 * j + 4 * lane; *(f32x4*)(a.out + (size_t)t * D + col) = x[j] * rstd * fg[j]; }
    }
}

using pg8::Unit; using pg8::tile_map;
struct SchedStd {
    int G, c, nM, nN;
    __device__ __forceinline__ bool next(int i, Unit& u) const { const long L = (long)i * G + c; if (L >= (long)nM * nN) return false; int pm, pn; tile_map((int)L, nM, nN, pm, pn); u.pm = pm; u.pn = pn; u.e = 0; u.nv = pm; u.par = 0; return true; }
    __device__ __forceinline__ void a_ready(const Unit&) const {}
    __device__ __forceinline__ void done(const Unit&) const {}
    __device__ __forceinline__ unsigned row_off(const Unit&, int) const { return 0u; }
    __device__ __forceinline__ unsigned row_off_lds(const Unit&, int) const { return 0u; }
    __device__ __forceinline__ void prefetch_rows(const Unit&) const {}
};
struct SchedB1 {
    int G, c;
    __device__ __forceinline__ bool next(int i, Unit& u) const { const long L = (long)i * G + c; constexpr int n1 = 3 * NMT * 4; if (L >= n1 + 3 * NMT) return false; const int l = (int)L;
        if (l < n1) { const int j = l / (NMT * 4), r = l % (NMT * 4); int pm, pn; tile_map(r, NMT, 4, pm, pn); u.pm = j * NMT + pm; u.pn = j * 4 + pn; u.e = j; u.nv = pm; }
        else { const int r = l - n1, j = r / NMT, pm = r % NMT; u.pm = (3 + j) * NMT + pm; u.pn = 12 + j; u.e = 3 + j; u.nv = pm; }
        u.par = 0; return true; }
    __device__ __forceinline__ void a_ready(const Unit&) const {}
    __device__ __forceinline__ void done(const Unit&) const {}
    __device__ __forceinline__ unsigned row_off(const Unit&, int) const { return 0u; }
    __device__ __forceinline__ unsigned row_off_lds(const Unit&, int) const { return 0u; }
    __device__ __forceinline__ void prefetch_rows(const Unit&) const {}
};
struct SchedB2 {
    int G, c;
    __device__ __forceinline__ bool next(int i, Unit& u) const { const long L = (long)i * G + c; constexpr int n1 = 2 * NMT * 8; if (L >= n1 + NMT * 4) return false; const int l = (int)L;
        if (l < n1) { const int j = l / (NMT * 8), r = l % (NMT * 8); int pm, pn; tile_map(r, NMT, 8, pm, pn); u.pm = j * NMT + pm; u.pn = j * 8 + pn; u.e = j; u.nv = pm; }
        else { const int r = l - n1; int pm, pn; tile_map(r, NMT, 4, pm, pn); u.pm = 2 * NMT + pm; u.pn = 16 + pn; u.e = 2; u.nv = pm; }
        u.par = 0; return true; }
    __device__ __forceinline__ void a_ready(const Unit&) const {}
    __device__ __forceinline__ void done(const Unit&) const {}
    __device__ __forceinline__ unsigned row_off(const Unit&, int) const { return 0u; }
    __device__ __forceinline__ unsigned row_off_lds(const Unit&, int) const { return 0u; }
    __device__ __forceinline__ void prefetch_rows(const Unit&) const {}
};
struct SchedMoe {
    int G, c, nnt, ntiles, P; LAS unsigned char* lds; const int* slotl; const float* gatel; int wave;
    __device__ __forceinline__ bool next(int i, Unit& u) const { const long L = (long)i * G + c; const int ntp = (ntiles + P - 1) / P, ppg = nnt / (8 / P); if (L >= (long)ntp * ppg * 8) return false;
        const LAS int* tpre = (const LAS int*)(lds + LDSCTL_OFF + 64); const LAS int* ecnt = (const LAS int*)(lds + LDSCTL_OFF + 256); const LAS unsigned short* tile_e = (const LAS unsigned short*)(lds + LDSCTL_OFF + 512);
        const int xq = (int)(L >> 3), x8 = (int)(L & 7); int tile = (xq / ppg) * P + (x8 % P); const int pnl = (x8 / P) * ppg + xq % ppg; const bool dead = tile >= ntiles; tile = dead ? 0 : tile;
        const int e = __builtin_amdgcn_readfirstlane((int)tile_e[tile]), r0 = (tile - __builtin_amdgcn_readfirstlane(tpre[e])) * 256; int nv = __builtin_amdgcn_readfirstlane(ecnt[e]) - r0; nv = nv > 256 ? 256 : nv; nv = dead ? 0 : nv;
        u.pm = dead ? MAXTILES : tile; u.pn = e * nnt + pnl; u.e = e; u.nv = nv | (r0 << 9); u.par = i & 1; return true; }
    __device__ __forceinline__ void a_ready(const Unit& u) const {
        if (gatel != nullptr && wave == 0) { const size_t li = (size_t)u.e * T + (u.nv >> 9) + 4 * lane_id();
            __builtin_amdgcn_global_load_lds((const unsigned*)(slotl + li), (LAS unsigned*)(lds + LDSCTL_OFF + 8192 + 2048 * u.par), 16, 0, 0);
            __builtin_amdgcn_global_load_lds((const unsigned*)(gatel + li), (LAS unsigned*)(lds + LDSCTL_OFF + 8192 + 2048 * u.par + 1024), 16, 0, 0); } }
    __device__ __forceinline__ void done(const Unit&) const {}
    __device__ __forceinline__ void prefetch_rows(const Unit& u) const {
        if (wave == 0) __builtin_amdgcn_global_load_lds((const unsigned*)(slotl + (size_t)u.e * T + (u.nv >> 9) + 4 * lane_id()), (LAS unsigned*)(lds + LDSCTL_OFF + 8192 + 2048 * u.par), 16, 0, 0); }
    __device__ __forceinline__ unsigned row_off_lds(const Unit& u, int r) const { const int nv = u.nv & 511; const int sl = ((const LAS int*)(lds + LDSCTL_OFF + 8192 + 2048 * u.par))[r]; const int tok = r < nv ? (sl >> 2) : 0; return (unsigned)tok * 2048u; }
    __device__ __forceinline__ unsigned row_off(const Unit& u, int r) const { const int nv = u.nv & 511, r0 = u.nv >> 9; const int tok = r < nv ? (slotl[(size_t)u.e * T + r0 + r] >> 2) : 0; return (unsigned)tok * 2048u; }
};

using pg8::cvt_pk_bf16;
template <class P> __device__ __forceinline__ P* pin_ptr(P* p) { asm volatile("" : "+v"(p)); return p; }
struct EpiB1 {
    static constexpr bool PERM = true, AFTER_DRAIN = false;
    bf16* RKV; bf16* L1;
    __device__ __forceinline__ void operator()(const f32x4 (&acc)[2][2][4][2], const Unit& u, int wr, int wc, int fr, int fq) const {
        const int seg = u.e, row0 = u.nv * 256 + wr * 64 + fr;
        const int jj = seg - 3, ld = seg < 3 ? D : 128, col0 = (seg < 3 ? (u.pn - seg * 4) * 256 : 0) + wc * 32 + 8 * fq;
        bf16* base = seg < 3 ? RKV + (size_t)seg * T * D : L1 + (size_t)jj * T * 128;
#pragma unroll
        for (int ai = 0; ai < 2; ++ai)
#pragma unroll
            for (int m = 0; m < 4; ++m) { bf16* rowp = base + (size_t)(row0 + ai * 128 + m * 16) * ld + col0;
#pragma unroll
                for (int bj = 0; bj < 2; ++bj) { if (seg >= 3 && bj == 1) continue; f32x4 v0 = acc[ai][bj][m][0], v1 = acc[ai][bj][m][1];
                    if (jj == 0) {
#pragma unroll
                        for (int q = 0; q < 4; ++q) { v0[q] = tanh_fast(v0[q]); v1[q] = tanh_fast(v1[q]); } }
                    else if (jj == 2) {
#pragma unroll
                        for (int q = 0; q < 4; ++q) { v0[q] = sigm(v0[q]); v1[q] = sigm(v1[q]); } }
                    u32x4 w; w.x = cvt_pk_bf16(v0[0], v0[1]); w.y = cvt_pk_bf16(v0[2], v0[3]); w.z = cvt_pk_bf16(v1[0], v1[1]); w.w = cvt_pk_bf16(v1[2], v1[3]);
                    *(u32x4*)(rowp + bj * 128) = w; } }
    }
};
struct EpiB2 {
    static constexpr bool PERM = true, AFTER_DRAIN = false;
    bf16* RW; bf16* RA; bf16* Gg;
    __device__ __forceinline__ void operator()(const f32x4 (&acc)[2][2][4][2], const Unit& u, int wr, int wc, int fr, int fq) const {
        const int jj = u.e, row0 = u.nv * 256 + wr * 64 + fr, pnl = u.pn - jj * 8;
        const int dirn = jj < 2 ? (pnl >> 2) : 0, col0 = (jj < 2 ? (pnl & 3) : pnl) * 256 + wc * 32 + 8 * fq;
        bf16* base = (jj == 0 ? RW : jj == 1 ? RA : Gg) + (size_t)dirn * T * D;
#pragma unroll
        for (int ai = 0; ai < 2; ++ai)
#pragma unroll
            for (int m = 0; m < 4; ++m) { bf16* rowp = base + (size_t)(row0 + ai * 128 + m * 16) * D + col0;
#pragma unroll
                for (int bj = 0; bj < 2; ++bj) { const f32x4 v0 = acc[ai][bj][m][0], v1 = acc[ai][bj][m][1];
                    u32x4 w; w.x = cvt_pk_bf16(v0[0], v0[1]); w.y = cvt_pk_bf16(v0[2], v0[3]); w.z = cvt_pk_bf16(v1[0], v1[1]); w.w = cvt_pk_bf16(v1[2], v1[3]);
                    *(u32x4*)(rowp + bj * 128) = w; } }
    }
};
struct EpiRes {
    static constexpr bool PERM = true, AFTER_DRAIN = false;
    float* X; const float* gate; float* Xo;
    __device__ __forceinline__ void operator()(const f32x4 (&acc)[2][2][4][2], const Unit& u, int wr, int wc, int fr, int fq) const {
        const int row0 = u.pm * 256 + wr * 64 + fr, col0 = u.pn * 256 + wc * 32 + 8 * fq, mr = u.pm < NMT_L ? (u.pm >> 5) : 4;
        const float* gp = pin_ptr(gate + (size_t)mr * 6144 + col0);
        f32x4 gv[2][2];
#pragma unroll
        for (int bj = 0; bj < 2; ++bj)
#pragma unroll
            for (int n = 0; n < 2; ++n) gv[bj][n] = *(const f32x4*)(gp + bj * 128 + 4 * n);
        f32x4 xa[2][2][2], xb[2][2][2];
#define ER_LOAD(dst, b_) do { _Pragma("unroll") for (int m = 0; m < 2; ++m) _Pragma("unroll") for (int bj = 0; bj < 2; ++bj) _Pragma("unroll") for (int n = 0; n < 2; ++n) \
            dst[m][bj][n] = *(const f32x4*)(X + (size_t)(row0 + ((b_) >> 1) * 128 + (((b_) & 1) * 2 + m) * 16) * D + col0 + bj * 128 + 4 * n); } while (0)
#define ER_STORE(src, b_) do { _Pragma("unroll") for (int m = 0; m < 2; ++m) _Pragma("unroll") for (int bj = 0; bj < 2; ++bj) _Pragma("unroll") for (int n = 0; n < 2; ++n) \
            *(f32x4*)(Xo + (size_t)(row0 + ((b_) >> 1) * 128 + (((b_) & 1) * 2 + m) * 16) * D + col0 + bj * 128 + 4 * n) = src[m][bj][n] + gv[bj][n] * acc[(b_) >> 1][bj][((b_) & 1) * 2 + m][n]; } while (0)
        ER_LOAD(xa, 0); ER_LOAD(xb, 1); ER_STORE(xa, 0); ER_LOAD(xa, 2); ER_STORE(xb, 1); ER_LOAD(xb, 3); ER_STORE(xa, 2); ER_STORE(xb, 3);
#undef ER_LOAD
#undef ER_STORE
    }
};
struct EpiWin {
    static constexpr bool PERM = true, AFTER_DRAIN = false;
    bf16* BG; bf16* CU;
    __device__ __forceinline__ void operator()(const f32x4 (&acc)[2][2][4][2], const Unit& u, int wr, int wc, int fr, int fq) const {
        const int row0 = u.pm * 256 + wr * 64 + fr;
        if (u.pn < 4) {
            const int col0 = u.pn * 256 + wc * 32 + 8 * fq;
#pragma unroll
            for (int ai = 0; ai < 2; ++ai)
#pragma unroll
                for (int m = 0; m < 4; ++m) { bf16* rowp = BG + (size_t)(row0 + ai * 128 + m * 16) * D + col0;
#pragma unroll
                    for (int bj = 0; bj < 2; ++bj) { const f32x4 v0 = acc[ai][bj][m][0], v1 = acc[ai][bj][m][1];
                        u32x4 w; w.x = cvt_pk_bf16(v0[0], v0[1]); w.y = cvt_pk_bf16(v0[2], v0[3]); w.z = cvt_pk_bf16(v1[0], v1[1]); w.w = cvt_pk_bf16(v1[2], v1[3]);
                        *(u32x4*)(rowp + bj * 128) = w; } }
        } else {
            const int f0 = (u.pn - 4) * 128 + wc * 32 + 8 * fq;
#pragma unroll
            for (int ai = 0; ai < 2; ++ai)
#pragma unroll
                for (int m = 0; m < 4; ++m) { const f32x4 v0 = acc[ai][0][m][0] * acc[ai][1][m][0], v1 = acc[ai][0][m][1] * acc[ai][1][m][1];
                    u32x4 w; w.x = cvt_pk_bf16(v0[0], v0[1]); w.y = cvt_pk_bf16(v0[2], v0[3]); w.z = cvt_pk_bf16(v1[0], v1[1]); w.w = cvt_pk_bf16(v1[2], v1[3]);
                    *(u32x4*)(CU + (size_t)(row0 + ai * 128 + m * 16) * D + f0) = w; }
        }
    }
};
struct EpiGU {
    static constexpr bool PERM = true, AFTER_DRAIN = false;
    bf16* INTER; const float* bgu;
    __device__ __forceinline__ void operator()(const f32x4 (&acc)[2][2][4][2], const Unit& u, int wr, int wc, int fr, int fq) const {
        const int e = u.e, pnl = u.pn - e * 8, row0 = u.pm * 256 + wr * 64 + fr, f0 = pnl * 128 + wc * 32 + 8 * fq;
        typedef const __attribute__((address_space(1))) f32x4* GF4;
        const GF4 bp = (GF4)pin_ptr(bgu + (size_t)e * 2048 + f0);
        f32x4 bg[2], bu[2];
#pragma unroll
        for (int n = 0; n < 2; ++n) { bg[n] = bp[n]; bu[n] = bp[256 + n]; }
#pragma unroll
        for (int ai = 0; ai < 2; ++ai)
#pragma unroll
            for (int m = 0; m < 4; ++m) { f32x4 o[2];
#pragma unroll
                for (int n = 0; n < 2; ++n) { const f32x4 g = acc[ai][0][m][n] + bg[n], uu = acc[ai][1][m][n] + bu[n];
#pragma unroll
                    for (int q = 0; q < 4; ++q) { const float gc = fminf(g[q], 7.0f), uc = fminf(fmaxf(uu[q], -7.0f), 7.0f); o[n][q] = (uc + 1.0f) * gc * sigm(1.702f * gc); } }
                u32x4 w; w.x = cvt_pk_bf16(o[0][0], o[0][1]); w.y = cvt_pk_bf16(o[0][2], o[0][3]); w.z = cvt_pk_bf16(o[1][0], o[1][1]); w.w = cvt_pk_bf16(o[1][2], o[1][3]);
                *(u32x4*)(INTER + (size_t)(row0 + ai * 128 + m * 16) * 1024 + f0) = w; }
    }
};
struct EpiDown {
    static constexpr bool PERM = true, AFTER_DRAIN = false;
    bf16* YS; const float* bdn; LAS unsigned char* lds;
    __device__ __forceinline__ void operator()(const f32x4 (&acc)[2][2][4][2], const Unit& u, int wr, int wc, int fr, int fq) const {
        const int e = u.e, pnl = u.pn - e * 4, col0 = pnl * 256 + wc * 32 + 8 * fq, nv = u.nv & 511;
        typedef const __attribute__((address_space(1))) f32x4* GF4;
        const GF4 bp = (GF4)pin_ptr(bdn + (size_t)e * 1024 + col0);
        f32x4 bv[2][2];
#pragma unroll
        for (int bj = 0; bj < 2; ++bj)
#pragma unroll
            for (int n = 0; n < 2; ++n) bv[bj][n] = bp[bj * 32 + n];
        const LAS int* sl = (const LAS int*)(lds + LDSCTL_OFF + 8192 + 2048 * u.par);
        int slot8[2][4]; float gt8[2][4];
#pragma unroll
        for (int ai = 0; ai < 2; ++ai)
#pragma unroll
            for (int m = 0; m < 4; ++m) { const int r = ai * 128 + wr * 64 + m * 16 + fr; slot8[ai][m] = sl[r]; gt8[ai][m] = ((const LAS float*)(sl + 256))[r]; }
#pragma unroll
        for (int ai = 0; ai < 2; ++ai) asm volatile("" : "+v"(slot8[ai][0]), "+v"(slot8[ai][1]), "+v"(slot8[ai][2]), "+v"(slot8[ai][3]), "+v"(gt8[ai][0]), "+v"(gt8[ai][1]), "+v"(gt8[ai][2]), "+v"(gt8[ai][3]));
        asm volatile("" : "+v"(bv[0][0]), "+v"(bv[0][1]), "+v"(bv[1][0]), "+v"(bv[1][1]));
#pragma unroll
        for (int ai = 0; ai < 2; ++ai)
#pragma unroll
            for (int m = 0; m < 4; ++m) { const int r = ai * 128 + wr * 64 + m * 16 + fr;
                if (r < nv) { const int slot = slot8[ai][m]; const float gt = gt8[ai][m];
                    bf16* rowp = YS + (size_t)slot * 1024 + col0;
#pragma unroll
                    for (int bj = 0; bj < 2; ++bj) { const f32x4 v0 = (acc[ai][bj][m][0] + bv[bj][0]) * gt, v1 = (acc[ai][bj][m][1] + bv[bj][1]) * gt;
                        u32x4 w; w.x = cvt_pk_bf16(v0[0], v0[1]); w.y = cvt_pk_bf16(v0[2], v0[3]); w.z = cvt_pk_bf16(v1[0], v1[1]); w.w = cvt_pk_bf16(v1[2], v1[3]);
                        *(u32x4*)(rowp + bj * 128) = w; } } }
    }
};

__device__ __forceinline__ int moe_tables(const unsigned* cnt, LAS unsigned char* lds, int tid) {
    LAS int* tpre = (LAS int*)(lds + LDSCTL_OFF + 64); LAS int* ecnt = (LAS int*)(lds + LDSCTL_OFF + 256); LAS unsigned short* tile_e = (LAS unsigned short*)(lds + LDSCTL_OFF + 512);
    if (tid == 0) { int p = 0; for (int e = 0; e < 32; ++e) { const int cn = (int)__hip_atomic_load(cnt + e * CNT_STRIDE, __ATOMIC_RELAXED, __HIP_MEMORY_SCOPE_AGENT); ecnt[e] = cn; tpre[e] = p; p += (cn + 255) >> 8; } tpre[32] = p; }
    __syncthreads();
    const int nt = tpre[32];
    for (int t = tid; t < nt; t += 512) { int e = 0; while (e < 31 && t >= tpre[e + 1]) ++e; tile_e[t] = (unsigned short)e; }
    __syncthreads();
    return nt;
}

constexpr int NPHASES = 37;
typedef const Args __attribute__((address_space(4))) CArgs;
__global__ void __attribute__((amdgpu_flat_work_group_size(512, 512), amdgpu_waves_per_eu(2, 2))) fwd_kernel(Args a_) {
    extern __shared__ __attribute__((aligned(16))) unsigned char lds_raw[];
    LAS unsigned char* lds = (LAS unsigned char*)lds_raw;
    const int G = gridDim.x, NGW = G * 8;
    CArgs* ap0 = (CArgs*)__builtin_amdgcn_kernarg_segment_ptr();
    if (threadIdx.x < 4) ((LAS unsigned*)(lds + LDSCTL_OFF))[threadIdx.x] = 0u;
    __syncthreads();
    XcdBarrier bar = xcd_barrier_post((unsigned*)(a_.ws + WS_CTL) + CW_BAR, (volatile LAS unsigned*)(lds + LDSCTL_OFF));
    const int lo = a_.ph_lo, hi = a_.ph_hi;
    int ph = 0;
#ifndef MK_ONLY
#define MK_ONLY -1
#endif
#ifndef MK_DBL
#define MK_DBL 0
#endif
#ifdef MK_MARK
#define PH_MARK(s) asm volatile("; ##" s)
#else
#define PH_MARK(s)
#endif
#define PH_BEGIN(id) if ((MK_ONLY < 0 || MK_ONLY == (id)) && ph >= lo && ph < hi) { for (int rep_ = 0; rep_ <= ((MK_DBL >> (id)) & 1); ++rep_) { PH_MARK("PH_BEGIN"); CArgs* ap = ap0; asm volatile("" : "+s"(ap)); const Args a = *(const Args*)ap; unsigned char* const ws = a.ws; (void)ws; const int wave = (int)bar.wv; int tid = wave * 64 + lane_id(); asm volatile("" : "+v"(tid)); const int lane = tid & 63, gw = blockIdx.x * 8 + wave; (void)lane; (void)gw;
#define PH_END PH_MARK("PH_END"); } } if (ph >= lo && ph + 1 < hi) xcd_barrier(bar); ++ph;

    PH_BEGIN(0) p0_prologue(a, lds, tid, lane, wave, G); PH_END

#pragma unroll 1
    for (int layer = 0; layer < DEPTH; ++layer) {
        const int kind = layer & 1, lj = layer >> 1;
        const int rows = layer == 3 ? TL : T, nmt = rows / 256;
        const int rows_moe = layer < 2 ? T : TL;
        if (kind == 0) {
            PH_BEGIN(1) phase_a_rwkv(a, layer, lds, tid, gw, NGW, lane); PH_END
            PH_BEGIN(2) {
                pg8::Gemm g{(const bf16*)(ws + WS_XL), (const bf16*)(ws + WS_WRKV) + (size_t)lj * 3840 * 1024, 6 * T, 3840, 1024};
                SchedB1 S{G, (int)blockIdx.x}; EpiB1 E{(bf16*)(ws + WS_RKV), (bf16*)(ws + WS_L1)};
                pg8::gemm_phase<EpiB1, SchedB1, true, true, false>(lds, g, S, E, tid); } PH_END
            PH_BEGIN(3) {
                pg8::Gemm g{(const bf16*)(ws + WS_L1), (const bf16*)(ws + WS_L2T) + (size_t)lj * 5120 * 128, 3 * T, 5120, 128};
                SchedB2 S{G, (int)blockIdx.x}; EpiB2 E{(bf16*)(ws + WS_RAWW), (bf16*)(ws + WS_RAWA), (bf16*)(ws + WS_G)};
                pg8::gemm_phase<EpiB2, SchedB2, true, true, false>(lds, g, S, E, tid); } PH_END
            PH_BEGIN(5) phase_s1_chunks(a, lj, lds, tid, G, (MK_DBL >> 5) & 1 & (rep_ == 0)); PH_END
            PH_BEGIN(15) phase_s2_chain(a, wave, lane, G); PH_END
            PH_BEGIN(6) phase_s3_readout(a, lj, layer == 2 ? TL : T, gw, NGW, lane); PH_END
        } else {
            PH_BEGIN(7) phase_a_conv(a, layer, rows, gw, NGW, lane); PH_END
            PH_BEGIN(8) {
                pg8::Gemm g{(const bf16*)(ws + WS_XL), (const bf16*)(ws + WS_WIN) + (size_t)lj * 3072 * 1024, rows, 3072, 1024};
                SchedStd S{G, (int)blockIdx.x, nmt, 12}; EpiWin E{(bf16*)(ws + WS_BG), (bf16*)(ws + WS_CUZ)};
                pg8::gemm_phase<EpiWin, SchedStd, true, true, false>(lds, g, S, E, tid); } PH_END
            PH_BEGIN(9) phase_cv(a, lj, rows, gw, NGW, lane); PH_END
        }
        PH_BEGIN(10) {
            const bf16* Wt = kind == 0 ? (const bf16*)(ws + WS_WO) + (size_t)lj * 1024 * 1024 : (const bf16*)(ws + WS_WOUT) + (size_t)lj * 1024 * 1024;
            pg8::Gemm g{(const bf16*)(ws + WS_Z), Wt, rows, 1024, 1024};
            SchedStd S{G, (int)blockIdx.x, layer == 2 ? NMT_L : nmt, 4}; EpiRes E{(float*)(ws + (layer < 2 ? WS_XSA : WS_XSB)), (const float*)(ws + WS_MODS) + (size_t)layer * 5 * 6144 + 2 * 1024, (float*)(ws + (rep_ ? WS_XL : (layer < 2 ? WS_XSA : WS_XSB)))};
            pg8::gemm_phase<EpiRes, SchedStd, true, true, false>(lds, g, S, E, tid); } PH_END
        PH_BEGIN(11) phase_e_route_mfma(a, layer, rows_moe, lds, tid, wave, gw, NGW, lane, rep_); PH_END
        PH_BEGIN(12) {
            const int nt = __builtin_amdgcn_readfirstlane(moe_tables((const unsigned*)(ws + WS_CTL) + CW_CNT + layer * 32 * CNT_STRIDE, lds, tid));
            pg8::Gemm g{(const bf16*)(ws + WS_H2), (const bf16*)(ws + WS_WGU) + (size_t)layer * 32 * 2048 * 1024, 0, 0, 1024};
            SchedMoe S{G, (int)blockIdx.x, 8, nt, 2, lds, (const int*)(ws + WS_SLOTL), nullptr, wave};
            EpiGU E{(bf16*)(ws + WS_INTER), a.in[30] + (size_t)layer * 32 * 2048};
            pg8::gemm_phase<EpiGU, SchedMoe, true, true, true>(lds, g, S, E, tid); } PH_END
        PH_BEGIN(13) {
            const int nt = __builtin_amdgcn_readfirstlane(moe_tables((const unsigned*)(ws + WS_CTL) + CW_CNT + layer * 32 * CNT_STRIDE, lds, tid));
            pg8::Gemm g{(const bf16*)(ws + WS_INTER), (const bf16*)(ws + WS_WDN) + (size_t)layer * 32 * 1024 * 1024, 0, 0, 1024};
            SchedMoe S{G, (int)blockIdx.x, 4, nt, 8, lds, (const int*)(ws + WS_SLOTL), (const float*)(ws + WS_GATEL), wave};
            EpiDown E{(bf16*)(ws + WS_YS), a.in[32] + (size_t)layer * 32 * 1024, lds};
            pg8::gemm_phase<EpiDown, SchedMoe, true, true, false>(lds, g, S, E, tid); } PH_END
    }
    PH_BEGIN(14) phase_final(a, gw, NGW, lane); PH_END
#undef PH_BEGIN
#undef PH_END
}

extern "C" void kernel_launch(void* const* d_in, const int* in_sizes, int n_in, void* d_out, int out_size, void* d_ws, size_t ws_size, hipStream_t stream) {
    static int grid = 0;
    if (grid == 0) {
        if (n_in != 33 || in_sizes[0] != TL * D || out_size != TL * D || ws_size < WS_END) { fprintf(stderr, "kernel_launch: unexpected problem (n_in %d, in0 %d, out %d, ws %zu < %zu)\n", n_in, n_in > 0 ? in_sizes[0] : -1, out_size, ws_size, (size_t)WS_END); grid = -1; return; }
        int dev = 0, cus = 0, per_cu = 0;
        if (hipGetDevice(&dev) != hipSuccess || hipDeviceGetAttribute(&cus, hipDeviceAttributeMultiprocessorCount, dev) != hipSuccess) { grid = -1; return; }
        if (hipFuncSetAttribute((const void*)fwd_kernel, hipFuncAttributeMaxDynamicSharedMemorySize, LDS_BYTES) != hipSuccess) { fprintf(stderr, "kernel_launch: hipFuncSetAttribute failed\n"); grid = -1; return; }
        if (hipOccupancyMaxActiveBlocksPerMultiprocessor(&per_cu, (const void*)fwd_kernel, 512, LDS_BYTES) != hipSuccess || per_cu < 1) fprintf(stderr, "kernel_launch: occupancy query says %d\n", per_cu);
        (void)hipGetLastError();
        grid = cus;
    }
    if (grid < 0) return;
    if (hipMemsetAsync((char*)d_ws + WS_CTL, 0, CTL_ZERO_BYTES, stream) != hipSuccess) return;
    Args a{};
    for (int i = 0; i < 33; ++i) a.in[i] = (const float*)d_in[i];
    a.out = (float*)d_out; a.ws = (unsigned char*)d_ws;
#if MK_PER_PHASE
    for (int p = 0; p < NPHASES; ++p) { a.ph_lo = p; a.ph_hi = p + 1; hipLaunchKernelGGL(fwd_kernel, dim3(grid), dim3(512), LDS_BYTES, stream, a); }
#else
    a.ph_lo = 0; a.ph_hi = NPHASES;
    hipLaunchKernelGGL(fwd_kernel, dim3(grid), dim3(512), LDS_BYTES, stream, a);
#endif
    const hipError_t le = hipPeekAtLastError();
    if (le != hipSuccess) fprintf(stderr, "kernel_launch: launch failed: %s\n", hipGetErrorName(le));
}
```

```cpp
#include <hip/hip_runtime.h>
#include <cstdio>
#include <cstdint>

#ifndef MK_PER_PHASE
#define MK_PER_PHASE 0
#endif

constexpr int D = 1024, NBATCH = 4, SEQ = 8192, TL = NBATCH * SEQ, CTXL = 256, TC = NBATCH * CTXL, T = TL + TC;
constexpr int NH = 16, HS = 64, NE = 32, TOPK = 4, DEPTH = 4;
constexpr int NMT = T / 256;
constexpr int NMT_L = TL / 256;
constexpr int MAXTILES = (T * TOPK) / 256 + NE;
constexpr int NSTEP = CTXL + SEQ;

__device__ __forceinline__ int lane_id() { return (int)__builtin_amdgcn_mbcnt_hi(~0u, __builtin_amdgcn_mbcnt_lo(~0u, 0u)); }
namespace pg8 {
#define PG8_LAS __attribute__((address_space(3)))
typedef unsigned short bf16_t;
typedef short bf16x8 __attribute__((ext_vector_type(8)));
typedef float f32x4 __attribute__((ext_vector_type(4)));
typedef unsigned u32x4 __attribute__((ext_vector_type(4)));
typedef unsigned u32x2 __attribute__((ext_vector_type(2)));
constexpr int BM = 256, BK = 64, HALF = 128, HTB = HALF * BK * 2  , STAGE_BYTES = 8 * HTB, NXCD = 8, WGM = 8;

__host__ __device__ __forceinline__ int lds_byte(int r, int c) { const int st = (r >> 4) * 2 + (c >> 5), rr = r & 15, cc = c & 31, ob = rr * 64 + cc * 2; return st * 1024 + (ob ^ (((ob >> 9) & 1) << 5)); }
__host__ __device__ __forceinline__ void stage_rc(int b, int& R, int& C) { const int st = b / 1024, sb = b % 1024, swz = sb ^ (((sb >> 9) & 1) << 5); R = (st >> 1) * 16 + swz / 64; C = (st & 1) * 32 + (swz % 64) / 2; }
__host__ __device__ __forceinline__ int perm32(int rho) { const int n = rho >> 4, i = rho & 15; return 8 * (i >> 2) + 4 * n + (i & 3); }

struct Unit { int pm, pn, e, nv, par; };
struct Gemm { const bf16_t* A; const bf16_t* Bt; int M, N, K; };

__device__ __forceinline__ void tile_map(int wgid, int nM, int nN, int& pm, int& pn) {
    const int nwg = nM * nN;
    { const int q = nwg / NXCD, r = nwg % NXCD, xcd = wgid % NXCD, off = wgid / NXCD; wgid = (xcd < r ? xcd * (q + 1) : r * (q + 1) + (xcd - r) * q) + off; }
    const int nig = WGM * nN, gid = wgid / nig, fm = gid * WGM, gsz = (nM - fm) < WGM ? (nM - fm) : WGM;
    pm = fm + ((wgid % nig) % gsz); pn = (wgid % nig) / gsz;
}
typedef __bf16 bf16x2_t __attribute__((ext_vector_type(2)));
typedef float f32x2_t __attribute__((ext_vector_type(2)));
__device__ __forceinline__ unsigned cvt_pk_bf16(float lo, float hi) { const f32x2_t v = {lo, hi}; const bf16x2_t b = __builtin_convertvector(v, bf16x2_t); return __builtin_bit_cast(unsigned, b); }

template <class Epi, class Sched, bool ALIGN_EPI = false, bool SP2 = false, bool GATHER = false>
__device__ __forceinline__ void gemm_phase(PG8_LAS unsigned char* lds, const Gemm g, const Sched& S, const Epi& E, int tid_in) {
    int tid_ = tid_in; asm volatile("" : "+v"(tid_));
    const int tid = tid_, wid = __builtin_amdgcn_readfirstlane(tid >> 6), lane = tid & 63, wr = wid >> 2, wc = wid & 3, fr = lane & 15, fq = lane >> 4;
    int K_ = g.K; asm volatile("" : "+s"(K_));
    const int K = K_, nt = K / BK;
    unsigned voffA[2], voffB[2]; int gR[2]; unsigned gC[2];
#pragma unroll
    for (int i = 0; i < 2; ++i) { int R, C; stage_rc(tid * 16 + i * 8192, R, C); const int Rb = Epi::PERM ? ((R & ~31) + perm32(R & 31)) : R;
        voffA[i] = (unsigned)(R * K + C) * 2u; voffB[i] = (unsigned)(Rb * K + C) * 2u; gR[i] = R; gC[i] = (unsigned)C * 2u; }
    unsigned oc[2][2], on[2][2], o2[2][2];
#pragma unroll
    for (int h = 0; h < 2; ++h)
#pragma unroll
        for (int i = 0; i < 2; ++i) { oc[h][i] = 0u; on[h][i] = 0u; o2[h][i] = 0u; }
    const size_t kstep = (size_t)(BK * 2);
    const size_t hstep = (size_t)HALF * K * 2;
    const size_t tstep = 2 * hstep;
    const unsigned ldsw = (unsigned)wid * 1024u;
    const int aoff = lds_byte(wr * 64 + fr, fq * 8), boff = lds_byte(wc * 32 + fr, fq * 8);
#define PG8_SA(b, h) (((b) * 2 + (h)) * HTB)
#define PG8_SB(b, h) ((4 + (b) * 2 + (h)) * HTB)
#define PG8_STAGE(bufoff, gbase, voff) do { _Pragma("unroll") for (int _i = 0; _i < 2; ++_i) \
        __builtin_amdgcn_global_load_lds((const unsigned*)((const char*)(gbase) + (voff)[_i]), (PG8_LAS unsigned*)(lds + (bufoff) + ldsw + _i * 8192), 16, 0, 0); } while (0)
#define PG8_STAGE_A(bufoff, base, h, O) do { if constexpr (GATHER) { PG8_STAGE(bufoff, base, (O)[h]); } else { PG8_STAGE(bufoff, (base) + (h) * hstep, voffA); } } while (0)
#define PG8_LDA(dst, b, h) do { _Pragma("unroll") for (int m = 0; m < 4; ++m) _Pragma("unroll") for (int k = 0; k < 2; ++k) dst[m][k] = *(const PG8_LAS bf16x8*)(lds + PG8_SA(b, h) + aoff + m * 2048 + k * 1024); } while (0)
#define PG8_LDB(dst, b, h) do { _Pragma("unroll") for (int n = 0; n < 2; ++n) _Pragma("unroll") for (int k = 0; k < 2; ++k) dst[n][k] = *(const PG8_LAS bf16x8*)(lds + PG8_SB(b, h) + boff + n * 2048 + k * 1024); } while (0)
#define PG8_MMA(ai, bj, At, Bt) do { __builtin_amdgcn_s_setprio(1); _Pragma("unroll") for (int m = 0; m < 4; ++m) _Pragma("unroll") for (int n = 0; n < 2; ++n) _Pragma("unroll") for (int k = 0; k < 2; ++k) \
        acc[ai][bj][m][n] = __builtin_amdgcn_mfma_f32_16x16x32_bf16(Bt[n][k], At[m][k], acc[ai][bj][m][n], 0, 0, 0); __builtin_amdgcn_s_setprio(0); } while (0)
#define PG8_WAIT_V(n) asm volatile("s_waitcnt vmcnt(" #n ")" ::: "memory")
#define PG8_WAIT_L(n) asm volatile("s_waitcnt lgkmcnt(" #n ")" ::: "memory")
#define PG8_BAR __builtin_amdgcn_s_barrier()
#define PG8_SCHED __builtin_amdgcn_sched_barrier(0)
    Unit cur, nxt; int ui = 0;
    if (!S.next(0, cur)) return;
    f32x4 acc[2][2][4][2];
#pragma unroll
    for (int a = 0; a < 2; ++a)
#pragma unroll
        for (int b = 0; b < 2; ++b)
#pragma unroll
            for (int m = 0; m < 4; ++m)
#pragma unroll
                for (int n = 0; n < 2; ++n) acc[a][b][m][n] = (f32x4){0.f, 0.f, 0.f, 0.f};
    bf16x8 At[4][2], B0[2][2], B1[2][2];
    const char* cA = GATHER ? (const char*)g.A : (const char*)g.A + (size_t)cur.pm * tstep; const char* cB = (const char*)g.Bt + (size_t)cur.pn * tstep;
    S.a_ready(cur);
    if constexpr (GATHER) {
#pragma unroll
        for (int h = 0; h < 2; ++h)
#pragma unroll
            for (int i = 0; i < 2; ++i) oc[h][i] = S.row_off(cur, h * HALF + gR[i]) + gC[i];
    }
    if constexpr (SP2) {
        PG8_STAGE(PG8_SB(0, 0), cB, voffB); PG8_STAGE(PG8_SB(0, 1), cB + hstep, voffB); PG8_STAGE_A(PG8_SA(0, 0), cA, 0, oc); PG8_STAGE_A(PG8_SA(0, 1), cA, 1, oc);
        if (wr == 1) PG8_BAR;
        PG8_WAIT_V(2); PG8_BAR;
        PG8_STAGE(PG8_SB(1, 0), cB + kstep, voffB); PG8_STAGE_A(PG8_SA(1, 0), cA + kstep, 0, oc); PG8_STAGE(PG8_SB(1, 1), cB + hstep + kstep, voffB);
        PG8_WAIT_V(6); PG8_BAR;
    } else {
        PG8_STAGE(PG8_SB(0, 0), cB, voffB); PG8_STAGE_A(PG8_SA(0, 0), cA, 0, oc); PG8_STAGE(PG8_SB(0, 1), cB + hstep, voffB); PG8_STAGE_A(PG8_SA(0, 1), cA, 1, oc);
        if (wr == 1) PG8_BAR;
        PG8_WAIT_V(4); PG8_BAR;
        PG8_STAGE(PG8_SB(1, 0), cB + kstep, voffB); PG8_STAGE_A(PG8_SA(1, 0), cA + kstep, 0, oc); PG8_STAGE(PG8_SB(1, 1), cB + hstep + kstep, voffB);
        PG8_WAIT_V(6); PG8_BAR;
    }
    for (;;) {
        const bool has_next = S.next(ui + 1, nxt);
        const char* nA = GATHER ? (const char*)g.A : (has_next ? (const char*)g.A + (size_t)nxt.pm * tstep : cA); const char* nB = has_next ? (const char*)g.Bt + (size_t)nxt.pn * tstep : cB;
        if constexpr (GATHER) { if (has_next) S.prefetch_rows(nxt); }
        for (int t = 0; t < nt; t += 2) {
            const bool last = (t == nt - 2);
            const char* a1 = cA + (size_t)(t + 1) * kstep;
            const char* a2 = last ? nA : cA + (size_t)(t + 2) * kstep; const char* b2 = last ? nB : cB + (size_t)(t + 2) * kstep;
            const char* a3 = a2 + kstep; const char* b3 = b2 + kstep;
            if constexpr (GATHER) {
                if (last) {
#pragma unroll
                    for (int h = 0; h < 2; ++h)
#pragma unroll
                        for (int i = 0; i < 2; ++i) on[h][i] = has_next ? (S.row_off_lds(nxt, h * HALF + gR[i]) + gC[i]) : oc[h][i];
                }
#pragma unroll
                for (int h = 0; h < 2; ++h)
#pragma unroll
                    for (int i = 0; i < 2; ++i) o2[h][i] = last ? on[h][i] : oc[h][i];
            }
            if (last && has_next) S.a_ready(nxt);
            if constexpr (SP2) {
            PG8_LDB(B0, 0, 0); PG8_LDB(B1, 0, 1); PG8_SCHED; PG8_LDA(At, 0, 0); PG8_STAGE_A(PG8_SA(1, 1), a1, 1, oc);
            PG8_WAIT_V(8); PG8_WAIT_L(0); PG8_BAR; PG8_MMA(0, 0, At, B0); PG8_MMA(0, 1, At, B1); PG8_BAR; PG8_SCHED;
            PG8_LDA(At, 0, 1); PG8_STAGE(PG8_SB(0, 0), b2, voffB); PG8_STAGE(PG8_SB(0, 1), b2 + hstep, voffB); PG8_STAGE_A(PG8_SA(0, 0), a2, 0, o2);
            PG8_WAIT_V(8); PG8_WAIT_L(0); PG8_BAR; PG8_MMA(1, 0, At, B0); PG8_MMA(1, 1, At, B1); PG8_BAR; PG8_SCHED;
            PG8_LDB(B0, 1, 0); PG8_LDB(B1, 1, 1); PG8_SCHED; PG8_LDA(At, 1, 0); PG8_STAGE_A(PG8_SA(0, 1), a2, 1, o2);
            PG8_WAIT_V(8); PG8_WAIT_L(0); PG8_BAR; PG8_MMA(0, 0, At, B0); PG8_MMA(0, 1, At, B1); PG8_BAR; PG8_SCHED;
            PG8_LDA(At, 1, 1); PG8_STAGE(PG8_SB(1, 0), b3, voffB); PG8_STAGE(PG8_SB(1, 1), b3 + hstep, voffB); PG8_STAGE_A(PG8_SA(1, 0), a3, 0, o2);
            PG8_WAIT_V(8); PG8_WAIT_L(0); PG8_BAR; PG8_MMA(1, 0, At, B0); PG8_MMA(1, 1, At, B1); PG8_BAR; PG8_SCHED;
            } else {
            PG8_LDB(B0, 0, 0); PG8_SCHED; PG8_LDA(At, 0, 0); PG8_STAGE_A(PG8_SA(1, 1), a1, 1, oc);
            PG8_WAIT_L(8); PG8_BAR; PG8_WAIT_L(0); PG8_MMA(0, 0, At, B0); PG8_BAR; PG8_SCHED;
            PG8_LDB(B1, 0, 1); PG8_STAGE(PG8_SB(0, 0), b2, voffB);
            PG8_BAR; PG8_WAIT_L(0); PG8_MMA(0, 1, At, B1); PG8_BAR;
            PG8_LDA(At, 0, 1); PG8_STAGE_A(PG8_SA(0, 0), a2, 0, o2);
            PG8_BAR; PG8_WAIT_L(0); PG8_MMA(1, 0, At, B0); PG8_BAR; PG8_SCHED;
            PG8_STAGE(PG8_SB(0, 1), b2 + hstep, voffB);
            PG8_WAIT_V(6); PG8_BAR; PG8_MMA(1, 1, At, B1); PG8_BAR;
            PG8_LDB(B0, 1, 0); PG8_SCHED; PG8_LDA(At, 1, 0); PG8_STAGE_A(PG8_SA(0, 1), a2, 1, o2);
            PG8_WAIT_L(8); PG8_BAR; PG8_WAIT_L(0); PG8_MMA(0, 0, At, B0); PG8_BAR; PG8_SCHED;
            PG8_LDB(B1, 1, 1); PG8_STAGE(PG8_SB(1, 0), b3, voffB);
            PG8_BAR; PG8_WAIT_L(0); PG8_MMA(0, 1, At, B1); PG8_BAR;
            PG8_LDA(At, 1, 1); PG8_STAGE_A(PG8_SA(1, 0), a3, 0, o2);
            PG8_BAR; PG8_WAIT_L(0); PG8_MMA(1, 0, At, B0); PG8_BAR; PG8_SCHED;
            PG8_STAGE(PG8_SB(1, 1), b3 + hstep, voffB);
            PG8_WAIT_V(6); PG8_BAR; PG8_MMA(1, 1, At, B1); PG8_BAR;
            }
        }
        if constexpr (ALIGN_EPI) { if (wr == 0) PG8_BAR; }
        if constexpr (!Epi::AFTER_DRAIN) { E(acc, cur, wr, wc, fr, fq); S.done(cur); }
        if (!has_next) break;
#pragma unroll
        for (int a = 0; a < 2; ++a)
#pragma unroll
            for (int b = 0; b < 2; ++b)
#pragma unroll
                for (int m = 0; m < 4; ++m)
#pragma unroll
                    for (int n = 0; n < 2; ++n) acc[a][b][m][n] = (f32x4){0.f, 0.f, 0.f, 0.f};
        cur = nxt; cA = nA; cB = nB; ++ui;
        if constexpr (GATHER) {
#pragma unroll
            for (int h = 0; h < 2; ++h)
#pragma unroll
                for (int i = 0; i < 2; ++i) oc[h][i] = on[h][i];
        }
        if constexpr (ALIGN_EPI) { if (wr == 1) PG8_BAR; }
    }
    PG8_WAIT_V(0);
    if constexpr (!ALIGN_EPI) { if (wr == 0) PG8_BAR; }
    PG8_BAR;
    if constexpr (Epi::AFTER_DRAIN) { E.fused(acc, cur, wr, wc, fr, fq, lds, wid, lane); S.done(cur); }
#undef PG8_SA
#undef PG8_SB
#undef PG8_STAGE
#undef PG8_STAGE_A
#undef PG8_LDA
#undef PG8_LDB
#undef PG8_MMA
#undef PG8_WAIT_V
#undef PG8_WAIT_L
#undef PG8_BAR
#undef PG8_SCHED
}
}

#define LAS __attribute__((address_space(3)))
typedef unsigned short bf16;
typedef float f32x4 __attribute__((ext_vector_type(4)));
typedef unsigned u32x2 __attribute__((ext_vector_type(2)));
typedef unsigned u32x4 __attribute__((ext_vector_type(4)));
#define LDS_WAIT() asm volatile("s_waitcnt lgkmcnt(0)" ::: "memory")
__device__ __forceinline__ unsigned pk2(float lo, float hi) { return pg8::cvt_pk_bf16(lo, hi); }
__device__ __forceinline__ unsigned f2bf(float f) { return pk2(f, f) & 0xffffu; }
__device__ __forceinline__ float bflo(unsigned w) { return __builtin_bit_cast(float, w << 16); }
__device__ __forceinline__ float bfhi(unsigned w) { return __builtin_bit_cast(float, w & 0xffff0000u); }
__device__ __forceinline__ float wave_sum(float v) {
#pragma unroll
    for (int o = 1; o < 64; o <<= 1) v += __shfl_xor(v, o);
    return v;
}
__device__ __forceinline__ float frcp(float x) { return __builtin_amdgcn_rcpf(x); }
__device__ __forceinline__ float sigm(float x) { return frcp(1.0f + __expf(-x)); }
__device__ __forceinline__ float tanh_fast(float x) { const float e = __expf(2.0f * x); return 1.0f - 2.0f * frcp(e + 1.0f); }

constexpr size_t MiB = 1u << 20;
constexpr size_t RF = (size_t)T * D * 4;
constexpr size_t RB = (size_t)T * D * 2;
constexpr size_t WS_CTL = 0, CTL_ZERO_BYTES = 1 * MiB;
constexpr size_t WS_MODS = 1 * MiB;
constexpr size_t WS_XSA = 2 * MiB, WS_XSB = WS_XSA + RF;
constexpr size_t WS_XL = WS_XSB + RF;
constexpr size_t WS_RKV = WS_XL + 6 * RB;
constexpr size_t WS_L1 = WS_RKV + 3 * RF;
constexpr size_t WS_WDEC = WS_L1 + 50 * MiB;
constexpr size_t WS_AA = WS_WDEC + 2 * RF;
constexpr size_t WS_G = WS_AA + 2 * RF;
constexpr size_t WS_KK = WS_G + RB;
constexpr size_t WS_KD = WS_KK + RF;
constexpr size_t WS_BETA = WS_KD + 2 * RF;
constexpr size_t WS_RKB = WS_BETA + 2 * RF;
constexpr size_t WS_C12 = WS_RKB + 3 * MiB;
constexpr size_t WS_WRT = WS_C12 + 6 * MiB;
constexpr size_t WS_Y = WS_C12 + 9 * MiB;
constexpr size_t WS_Z = WS_Y + 2 * RF;
constexpr size_t WS_H2 = WS_Z + RB;
constexpr size_t WS_SLOTL = WS_H2 + RB;
constexpr size_t WS_GATEL = WS_SLOTL + 5 * MiB;
constexpr size_t WS_WRKV = WS_GATEL + 5 * MiB;
constexpr size_t WS_L2T = WS_WRKV + 15 * MiB;
constexpr size_t WS_WO = WS_L2T + 5 * MiB;
constexpr size_t WS_WIN = WS_WO + 4 * MiB;
constexpr size_t WS_WOUT = WS_WIN + 12 * MiB;
constexpr size_t WS_WGU = WS_WOUT + 4 * MiB;
constexpr size_t WS_WDN = WS_WGU + 512 * MiB;
constexpr size_t WS_END = WS_WDN + 256 * MiB;
constexpr size_t WS_INTER = WS_WDEC;
constexpr size_t WS_YS = WS_KD;
constexpr size_t WS_BG = WS_RKV, WS_CUZ = WS_RKV + RB;
constexpr size_t WS_RAWW = WS_AA, WS_RAWA = WS_AA + RF;
constexpr size_t WS_RH = WS_AA;
constexpr size_t WS_PM = WS_WDEC;
constexpr size_t WS_RKB1 = WS_C12 + 1 * MiB;
constexpr size_t WS_QT = WS_XL;
constexpr size_t WS_HT = WS_XL + RF;
static_assert((size_t)128 * 132 * 4096 * 2 <= RF, "chunk state tensors");
static_assert((size_t)MAXTILES * 256 * 1024 * 2 <= 4 * RF, "INTER overlay");
static_assert((size_t)T * 4 * 1024 * 2 <= 2 * RF, "YS overlay");
static_assert((size_t)3 * T * 256 * 2 <= 50 * MiB, "L1OUT");
constexpr int CW_BAR = 4096;
constexpr int CW_CNT = 16384, CNT_STRIDE = 64;

constexpr int RING_BYTES = 131072;
constexpr int LDSCTL_OFF = RING_BYTES + 4096;
constexpr int LDS_BYTES = LDSCTL_OFF + 16384;

struct Args { const float* in[33]; float* out; unsigned char* ws; int ph_lo, ph_hi; };

__device__ __forceinline__ void transpose_item(const float* W, int N, bf16* WT, int dstK, int drow0, int k0, int n0, LAS float* scr, int lane) {
    float tv[64];
    const float* src = W + (size_t)k0 * N + n0 + lane;
#pragma unroll
    for (int i = 0; i < 64; ++i) tv[i] = src[(size_t)i * N];
#pragma unroll
    for (int i = 0; i < 64; ++i) scr[i * 65 + lane] = tv[i];
    LDS_WAIT(); asm volatile("" ::: "memory");
    const int c = lane & 7;
#pragma unroll
    for (int j = 0; j < 8; ++j) { const int n = (lane >> 3) + 8 * j; const LAS float* s = scr + (8 * c) * 65 + n;
        u32x4 o; o.x = pk2(s[0 * 65], s[1 * 65]); o.y = pk2(s[2 * 65], s[3 * 65]); o.z = pk2(s[4 * 65], s[5 * 65]); o.w = pk2(s[6 * 65], s[7 * 65]);
        *(u32x4*)(WT + (size_t)(drow0 + n) * dstK + k0 + 8 * c) = o; }
    LDS_WAIT(); asm volatile("" ::: "memory");
}
__device__ __forceinline__ int gu_map(int n0) { const int bj = n0 >= 1024 ? 1 : 0, f0 = n0 - bj * 1024; return (f0 >> 7) * 256 + bj * 128 + (f0 & 127); }
__device__ __forceinline__ int conv_map(int n0) { if (n0 < 1024) return n0; const int q = (n0 - 1024) >> 10, f0 = (n0 - 1024) & 1023; return 1024 + (f0 >> 7) * 256 + q * 128 + (f0 & 127); }

__device__ __forceinline__ void p0_prologue(const Args& a, LAS unsigned char* lds, int tid, int lane, int wave, int G) {
    unsigned char* ws = a.ws;
    LAS float* sl = (LAS float*)lds;
    LAS float* red = (LAS float*)(lds + 20480);
    for (int i = tid; i < 5 * 1024; i += 512) { const int r = i >> 10, k = i & 1023; const float cv = r < 4 ? a.in[1][r * 1024 + k] : a.in[3][k]; sl[i] = cv * sigm(cv); }
    __syncthreads();
    float* MODS = (float*)(ws + WS_MODS);
    for (int it = blockIdx.x; it < 4 * 96; it += G) {
        const int l = it / 96, n = (it % 96) * 64 + lane;
        const float* W = a.in[4] + (size_t)l * 1024 * 6144 + n;
        float acc[5] = {0.f, 0.f, 0.f, 0.f, 0.f};
        const int kb = wave * 128;
#pragma unroll 8
        for (int k = 0; k < 128; ++k) { const float wv = W[(size_t)(kb + k) * 6144];
#pragma unroll
            for (int r = 0; r < 5; ++r) acc[r] += sl[r * 1024 + kb + k] * wv; }
#pragma unroll
        for (int r = 0; r < 5; ++r) red[(wave * 5 + r) * 64 + lane] = acc[r];
        __syncthreads();
        if (wave < 5) { float s = a.in[5][l * 6144 + n];
#pragma unroll
            for (int w = 0; w < 8; ++w) s += red[(w * 5 + wave) * 64 + lane];
            MODS[(size_t)(l * 5 + wave) * 6144 + n] = s; }
        __syncthreads();
    }
    LAS float* scr = (LAS float*)(lds + wave * 16640);
    static_assert(8 * 16640 <= LDSCTL_OFF, "P0 scratch");
    const int gw = blockIdx.x * 8 + wave, NGW = G * 8;
    bf16* WRKV = (bf16*)(ws + WS_WRKV); bf16* WOt = (bf16*)(ws + WS_WO); bf16* WINt = (bf16*)(ws + WS_WIN); bf16* WOUTt = (bf16*)(ws + WS_WOUT);
    bf16* WGU = (bf16*)(ws + WS_WGU); bf16* WDN = (bf16*)(ws + WS_WDN);
    constexpr int I_GU = 128 * 512, I_DN = 128 * 256, I_RKV = 6 * 256, I_WO = 2 * 256, I_WIN = 2 * 768, I_WOUT = 2 * 256, I_W1 = 4 * 16, I_A1 = 4 * 16, I_G1 = 2 * 32;
    constexpr int NITEMS = I_GU + I_DN + I_RKV + I_WO + I_WIN + I_WOUT + I_W1 + I_A1 + I_G1;
    for (int it = gw; it < NITEMS; it += NGW) {
        int r = it;
        if (r < I_GU) { const int m = r >> 9, q = r & 511, kb = q >> 5, nb = q & 31;
            transpose_item(a.in[29] + (size_t)m * 1024 * 2048, 2048, WGU + (size_t)m * 2048 * 1024, 1024, gu_map(nb * 64), kb * 64, nb * 64, scr, lane); continue; } r -= I_GU;
        if (r < I_DN) { const int m = r >> 8, q = r & 255, kb = q >> 4, nb = q & 15;
            transpose_item(a.in[31] + (size_t)m * 1024 * 1024, 1024, WDN + (size_t)m * 1024 * 1024, 1024, nb * 64, kb * 64, nb * 64, scr, lane); continue; } r -= I_DN;
        if (r < I_RKV) { const int m = r >> 8, q = r & 255, kb = q >> 4, nb = q & 15, lr = m / 3, j = m % 3;
            transpose_item(a.in[9] + (size_t)m * 1024 * 1024, 1024, WRKV + (size_t)lr * 3840 * 1024, 1024, j * 1024 + nb * 64, kb * 64, nb * 64, scr, lane); continue; } r -= I_RKV;
        if (r < I_WO) { const int m = r >> 8, q = r & 255, kb = q >> 4, nb = q & 15;
            transpose_item(a.in[23] + (size_t)m * 1024 * 1024, 1024, WOt + (size_t)m * 1024 * 1024, 1024, nb * 64, kb * 64, nb * 64, scr, lane); continue; } r -= I_WO;
        if (r < I_WIN) { const int m = r / 768, q = r % 768, kb = q / 48, nb = q % 48;
            transpose_item(a.in[24] + (size_t)m * 1024 * 3072, 3072, WINt + (size_t)m * 3072 * 1024, 1024, conv_map(nb * 64), kb * 64, nb * 64, scr, lane); continue; } r -= I_WIN;
        if (r < I_WOUT) { const int m = r >> 8, q = r & 255, kb = q >> 4, nb = q & 15;
            transpose_item(a.in[26] + (size_t)m * 1024 * 1024, 1024, WOUTt + (size_t)m * 1024 * 1024, 1024, nb * 64, kb * 64, nb * 64, scr, lane); continue; } r -= I_WOUT;
        if (r < I_W1) { const int m = r >> 4, kb = r & 15, lr = m >> 1, e = m & 1;
            transpose_item(a.in[11] + (size_t)m * 1024 * 64, 64, WRKV + (size_t)lr * 3840 * 1024, 1024, 3072 + e * 64, kb * 64, 0, scr, lane); continue; } r -= I_W1;
        if (r < I_A1) { const int m = r >> 4, kb = r & 15, lr = m >> 1, e = m & 1;
            transpose_item(a.in[14] + (size_t)m * 1024 * 64, 64, WRKV + (size_t)lr * 3840 * 1024, 1024, 3328 + e * 64, kb * 64, 0, scr, lane); continue; } r -= I_A1;
        { const int m = r >> 5, q = r & 31, kb = q >> 1, nb = q & 1;
            transpose_item(a.in[16] + (size_t)m * 1024 * 128, 128, WRKV + (size_t)m * 3840 * 1024, 1024, 3584 + nb * 64, kb * 64, nb * 64, scr, lane); }
    }
    const int gt = blockIdx.x * 512 + tid, NGT = G * 512;
    for (int i = gt; i < 2 * 3 * 128 * 128; i += NGT) {
        const int pc = i & 127, rw = (i >> 7) & 127, pd = (i >> 14) % 3, lr = i / (3 * 16384);
        *(u32x4*)(WRKV + ((size_t)lr * 3840 + 3072 + pd * 256 + 128 + rw) * 1024 + pc * 8) = (u32x4){0u, 0u, 0u, 0u}; }
    bf16* L2T = (bf16*)(ws + WS_L2T);
    for (int i = gt; i < 2 * 128 * 5120; i += NGT) {
        const int n = i % 5120, k = (i / 5120) & 127, lr = i / (5120 * 128);
        float v = 0.f;
        if (n < 2048) { const int e = n >> 10, d = n & 1023; if ((k >> 6) == e) v = a.in[12][(((size_t)lr * 2 + e) * 64 + (k & 63)) * 1024 + d]; }
        else if (n < 4096) { const int e = (n - 2048) >> 10, d = n & 1023; if ((k >> 6) == e) v = a.in[15][(((size_t)lr * 2 + e) * 64 + (k & 63)) * 1024 + d]; }
        else { const int d = n - 4096; v = a.in[17][((size_t)lr * 128 + k) * 1024 + d]; }
        L2T[((size_t)lr * 5120 + n) * 128 + k] = (bf16)f2bf(v);
    }
    bf16* WRT = (bf16*)(ws + WS_WRT);
    for (int i = gt; i < 4 * 32 * 1024; i += NGT) { const int k = i & 1023, e = (i >> 10) & 31, l = i >> 15;
        const float w = a.in[27][((size_t)l * 1024 + k) * 32 + e]; const unsigned hi = f2bf(w); const float lo = w - bflo(hi);
        WRT[((size_t)(l * 2 + 0) * 32 + e) * 1024 + k] = (bf16)hi; WRT[((size_t)(l * 2 + 1) * 32 + e) * 1024 + k] = (bf16)f2bf(lo); }
}
#define XB_TMO      128
#define XB_XCNT(j)  (256  + 64 * (j))
#define XB_XSUB(j)  (1280 + 64 * (j))
#define XB_XGEN(j)  (2304 + 64 * (j))
#define XB_TOP      3328
#define XB_TOPGEN   3392
#define XCD_BAR_WORDS 3456
#define XB_SPIN_CAP (1u << 23)

__device__ __forceinline__ unsigned xb_ld(unsigned* p)              { return __hip_atomic_load(p, __ATOMIC_RELAXED, __HIP_MEMORY_SCOPE_AGENT); }
__device__ __forceinline__ unsigned xb_add(unsigned* p, unsigned v) { return __hip_atomic_fetch_add(p, v, __ATOMIC_RELAXED, __HIP_MEMORY_SCOPE_AGENT); }
__device__ __forceinline__ unsigned xb_xcc_id() { return (unsigned)__builtin_amdgcn_s_getreg((3 << 11) | 20) & 0xFu; }
#define XB_SPIN(cond, bar) do { unsigned _sp = 0; while (cond) { __builtin_amdgcn_s_sleep(1); \
    if ((++_sp & 255u) == 0u) { if (xb_ld(&(bar)[XB_TMO])) break; if (_sp > XB_SPIN_CAP) { atomicAdd(&(bar)[XB_TMO], 1u); break; } } } } while (0)

struct XcdBarrier {
    unsigned wv;
    unsigned* bar; unsigned x;
    volatile LAS unsigned* st;
};

__device__ __forceinline__ XcdBarrier xcd_barrier_post(unsigned* bar, volatile LAS unsigned* st) {
    XcdBarrier b; b.wv = (unsigned)__builtin_amdgcn_readfirstlane((int)(threadIdx.x >> 6)); b.bar = bar; b.x = xb_xcc_id(); b.st = st;
    if (threadIdx.x == 0) (void)xb_add(&bar[XB_XCNT(b.x)], 1u);
    return b;
}
__device__ __forceinline__ void xcd_barrier_complete(unsigned* bar, unsigned x, unsigned& nloc, unsigned& nx) {
    const unsigned G = gridDim.x * gridDim.y * gridDim.z;
    unsigned sum, cnt, mine, sp = 0u;
    for (;;) {
        sum = 0u; cnt = 0u; mine = 0u;
#pragma unroll
        for (unsigned j = 0; j < 16; ++j) { const unsigned c = xb_ld(&bar[XB_XCNT(j)]); sum += c; cnt += (c > 0u) ? 1u : 0u; mine = (j == x) ? c : mine; }
        if (sum == G) break;
        __builtin_amdgcn_s_sleep(1);
        if ((++sp & 255u) == 0u) { if (xb_ld(&bar[XB_TMO])) break; if (sp > XB_SPIN_CAP) { atomicAdd(&bar[XB_TMO], 1u); break; } }
    }
    nloc = mine > 0u ? mine : 1u; nx = cnt > 0u ? cnt : 1u;
}

__device__ __forceinline__ void xcd_barrier(const XcdBarrier& b) {
    asm volatile("s_waitcnt vmcnt(0)" ::: "memory");
    __syncthreads();
    if (b.wv == 0u && lane_id() == 0) {
        unsigned* bar = b.bar;
        __builtin_amdgcn_s_waitcnt(0);
        unsigned nloc = b.st[0], nx = b.st[1];
        if (nloc == 0u) { xcd_barrier_complete(bar, b.x, nloc, nx); b.st[0] = nloc; b.st[1] = nx; }
        const unsigned old = xb_add(&bar[XB_XSUB(b.x)], 1u);
        const unsigned gen = old / nloc;
        if (old + 1u == (gen + 1u) * nloc) {
            __builtin_amdgcn_fence(__ATOMIC_RELEASE, "agent");
            asm volatile("s_waitcnt vmcnt(0)" ::: "memory");
            const unsigned og = xb_add(&bar[XB_TOP], 1u);
            const unsigned tg = og / nx;
            if (og + 1u == (tg + 1u) * nx) xb_add(&bar[XB_TOPGEN], 1u);
            else XB_SPIN(xb_ld(&bar[XB_TOPGEN]) == tg, bar);
            __builtin_amdgcn_fence(__ATOMIC_ACQUIRE, "agent");
            xb_add(&bar[XB_XGEN(b.x)], 1u);
            asm volatile("s_waitcnt vmcnt(0)" ::: "memory");
        } else {
            XB_SPIN(xb_ld(&bar[XB_XGEN(b.x)]) == gen, bar);
            __builtin_amdgcn_fence(__ATOMIC_ACQUIRE, "agent");
            asm volatile("s_waitcnt vmcnt(0)" ::: "memory");
        }
    }
    __syncthreads();
}

__device__ __forceinline__ f32x4 bf4(u32x2 w) { return (f32x4){bflo(w.x), bfhi(w.x), bflo(w.y), bfhi(w.y)}; }
__device__ __forceinline__ int mod_row(int row) { return row < TL ? (row >> 13) : 4; }

__device__ __forceinline__ void load_x_combined(f32x4 (&x)[4], const float* xrow, bool has_prev, const bf16* YS, int t, const f32x4 (&m5)[4], int lane) {
#pragma unroll
    for (int j = 0; j < 4; ++j) x[j] = *(const f32x4*)(xrow + 256 * j + 4 * lane);
    if (has_prev) {
        u32x2 y[4][4];
#pragma unroll
        for (int k = 0; k < 4; ++k)
#pragma unroll
            for (int j = 0; j < 4; ++j) y[k][j] = *(const u32x2*)(YS + ((size_t)t * 4 + k) * 1024 + 256 * j + 4 * lane);
#pragma unroll
        for (int j = 0; j < 4; ++j) { const f32x4 s = (bf4(y[0][j]) + bf4(y[1][j])) + (bf4(y[2][j]) + bf4(y[3][j])); x[j] += m5[j] * s; }
    }
}
__device__ __forceinline__ float row_rstd(const f32x4 (&x)[4]) {
    float ss = 0.f;
#pragma unroll
    for (int j = 0; j < 4; ++j) ss += (x[j].x * x[j].x + x[j].y * x[j].y) + (x[j].z * x[j].z + x[j].w * x[j].w);
    return rsqrtf(wave_sum(ss) * (1.0f / 1024.0f) + 1e-6f);
}

__device__ __forceinline__ void phase_a_rwkv(const Args& a, int layer, LAS unsigned char* lds, int tid, int gw, int NGW, int lane) {
    unsigned char* ws = a.ws; const int lj = layer >> 1; const bool has_prev = layer > 0;
    const float* xin_lat = layer == 0 ? a.in[0] : (const float*)(ws + WS_XSA);
    const float* xin_ctx = layer == 0 ? a.in[2] : (const float*)(ws + WS_XSA) + (size_t)TL * D;
    float* xout = (float*)(ws + (layer == 0 ? WS_XSA : WS_XSB));
    const float* MODS = (const float*)(ws + WS_MODS); const bf16* YS = (const bf16*)(ws + WS_YS); bf16* XL = (bf16*)(ws + WS_XL);
    const float* mug = a.in[8] + (size_t)lj * 6 * 2 * 1024; const float* ng = a.in[6] + (size_t)(layer * 2 + 0) * 1024;
    LAS float* mu = (LAS float*)lds;
    for (int i = tid; i < 6 * 2 * 1024 / 4; i += 512) ((LAS f32x4*)mu)[i] = ((const f32x4*)mug)[i];
    __syncthreads();
    for (int it = gw; it < TL / 8 + TC / 2; it += NGW) {
        const int ntok = it < TL / 8 ? 8 : 2, t0 = it < TL / 8 ? it * 8 : TL + (it - TL / 8) * 2, mr = mod_row(t0);
        int rs, re; if (t0 < TL) { rs = t0 & ~63; re = rs + 63; } else { const int loc = t0 - TL; rs = TL + (loc & ~255); re = rs + 255; }
        const float* mod = MODS + (size_t)(layer * 5 + mr) * 6144;
        const float* m5p = MODS + (size_t)((has_prev ? layer - 1 : 0) * 5 + mr) * 6144 + 5 * 1024;
        f32x4 hm[4], h0[4], hp[4];
#pragma unroll
        for (int j = 0; j < 4; ++j) { hm[j] = (f32x4){0.f, 0.f, 0.f, 0.f}; h0[j] = hm[j]; hp[j] = hm[j]; }
        f32x4 rx[4], nx[4]; u32x2 ry[4][4], ny[4][4];
#define PA_LOAD(X, Y, tt) do { const int t_ = (tt); if (t_ >= rs && t_ <= re) { \
            const float* xrow_ = t_ < TL ? xin_lat + (size_t)t_ * D : xin_ctx + (size_t)(t_ - TL) * D; \
            _Pragma("unroll") for (int j = 0; j < 4; ++j) X[j] = *(const f32x4*)(xrow_ + 256 * j + 4 * lane); \
            if (has_prev) { _Pragma("unroll") for (int k = 0; k < 4; ++k) _Pragma("unroll") for (int j = 0; j < 4; ++j) Y[k][j] = *(const u32x2*)(YS + ((size_t)t_ * 4 + k) * 1024 + 256 * j + 4 * lane); } } } while (0)
#pragma unroll
        for (int j = 0; j < 4; ++j) { rx[j] = (f32x4){0.f, 0.f, 0.f, 0.f}; nx[j] = rx[j];
#pragma unroll
            for (int k = 0; k < 4; ++k) { ry[k][j] = (u32x2){0u, 0u}; ny[k][j] = ry[k][j]; } }
        PA_LOAD(rx, ry, t0 - 1);
        f32x4 gsc[4], sh4[4], m5v[4];
#pragma unroll
        for (int j = 0; j < 4; ++j) { const int col = 256 * j + 4 * lane; gsc[j] = *(const f32x4*)(ng + col) * (*(const f32x4*)(mod + 1024 + col) + 1.0f); sh4[j] = *(const f32x4*)(mod + col); m5v[j] = *(const f32x4*)(m5p + col); }
#pragma unroll
        for (int j = 0; j < 4; ++j) asm volatile("" : "+v"(gsc[j]), "+v"(sh4[j]), "+v"(m5v[j]), "+v"(rx[j]));
#pragma unroll 1
        for (int i = -1; i <= ntok; ++i) {
            const int t = t0 + i;
            if (i < ntok) PA_LOAD(nx, ny, t + 1);
            f32x4 hn[4];
            if (t >= rs && t <= re) {
                f32x4 x[4];
#pragma unroll
                for (int j = 0; j < 4; ++j) x[j] = rx[j];
                if (has_prev) {
#pragma unroll
                    for (int j = 0; j < 4; ++j) { f32x4 sm = (f32x4){0.f, 0.f, 0.f, 0.f};
#pragma unroll
                        for (int k = 0; k < 4; ++k) sm += (f32x4){bflo(ry[k][j].x), bfhi(ry[k][j].x), bflo(ry[k][j].y), bfhi(ry[k][j].y)};
                        x[j] += m5v[j] * sm; } }
                if (i >= 0 && i < ntok) {
#pragma unroll
                    for (int j = 0; j < 4; ++j) *(f32x4*)(xout + (size_t)t * D + 256 * j + 4 * lane) = x[j]; }
                const float rstd = row_rstd(x);
#pragma unroll
                for (int j = 0; j < 4; ++j) hn[j] = x[j] * rstd * gsc[j] + sh4[j];
            } else {
#pragma unroll
                for (int j = 0; j < 4; ++j) hn[j] = (f32x4){0.f, 0.f, 0.f, 0.f};
            }
#pragma unroll
            for (int j = 0; j < 4; ++j) { hm[j] = h0[j]; h0[j] = hp[j]; hp[j] = hn[j]; rx[j] = nx[j];
#pragma unroll
                for (int k = 0; k < 4; ++k) ry[k][j] = ny[k][j]; }
            if (i >= 1) {
                const int te = t - 1;
#pragma unroll
                for (int q = 0; q < 6; ++q) {
                    bf16* orow = XL + ((size_t)q * T + te) * D;
#pragma unroll
                    for (int j = 0; j < 4; ++j) { const int col = 256 * j + 4 * lane;
                        const f32x4 m0 = *(const LAS f32x4*)(mu + (q * 2 + 0) * 1024 + col), m1 = *(const LAS f32x4*)(mu + (q * 2 + 1) * 1024 + col);
                        const f32x4 o = h0[j] + m0 * (hm[j] - h0[j]) + m1 * (hp[j] - h0[j]);
                        u32x2 w; w.x = pk2(o.x, o.y); w.y = pk2(o.z, o.w); *(u32x2*)(orow + col) = w; }
                }
            }
        }
#undef PA_LOAD
    }
}
__device__ __forceinline__ void phase_a_conv(const Args& a, int layer, int rows, int gw, int NGW, int lane) {
    unsigned char* ws = a.ws;
    float* xs = (float*)(ws + (layer < 2 ? WS_XSA : WS_XSB));
    const float* MODS = (const float*)(ws + WS_MODS); const bf16* YS = (const bf16*)(ws + WS_YS); bf16* H = (bf16*)(ws + WS_XL);
    const float* ng = a.in[6] + (size_t)(layer * 2 + 0) * 1024;
    for (int t = gw; t < rows; t += NGW) {
        const int mr = mod_row(t);
        const float* mod = MODS + (size_t)(layer * 5 + mr) * 6144;
        f32x4 m5[4], x[4];
#pragma unroll
        for (int j = 0; j < 4; ++j) m5[j] = *(const f32x4*)(MODS + (size_t)((layer - 1) * 5 + mr) * 6144 + 5 * 1024 + 256 * j + 4 * lane);
        f32x4 gsc[4], sh4[4], ngv[4];
#pragma unroll
        for (int j = 0; j < 4; ++j) { const int col = 256 * j + 4 * lane; ngv[j] = *(const f32x4*)(ng + col); gsc[j] = *(const f32x4*)(mod + 1024 + col); sh4[j] = *(const f32x4*)(mod + col); }
        load_x_combined(x, xs + (size_t)t * D, true, YS, t, m5, lane);
#pragma unroll
        for (int j = 0; j < 4; ++j) gsc[j] = ngv[j] * (gsc[j] + 1.0f);
        const float rstd = row_rstd(x);
#pragma unroll
        for (int j = 0; j < 4; ++j) { const int col = 256 * j + 4 * lane;
            *(f32x4*)(xs + (size_t)t * D + col) = x[j];
            const f32x4 h = x[j] * rstd * gsc[j] + sh4[j];
            u32x2 w; w.x = pk2(h.x, h.y); w.y = pk2(h.z, h.w); *(u32x2*)(H + (size_t)t * D + col) = w; }
    }
}
#define DPPF(x, ctrl) __builtin_bit_cast(float, __builtin_amdgcn_update_dpp(0, __builtin_bit_cast(int, (x)), (ctrl), 0xf, 0xf, false))
__device__ __forceinline__ float row16_sum(float v) { v += DPPF(v, 0xB1); v += DPPF(v, 0x4E); v += DPPF(v, 0x141); v += DPPF(v, 0x140); return v; }
__device__ __forceinline__ u32x2 pk4(f32x4 v) { u32x2 w; w.x = pk2(v[0], v[1]); w.y = pk2(v[2], v[3]); return w; }
__device__ __forceinline__ void phase_c_prep(const Args& a, int lj, LAS unsigned char* lds, int tid, int gw, int NGW, int lane) {
    unsigned char* ws = a.ws;
    const bf16* Rr = (const bf16*)(ws + WS_RKV); const bf16* Kk = Rr + (size_t)T * D; const bf16* RA = (const bf16*)(ws + WS_RAWA); const bf16* RW = (const bf16*)(ws + WS_RAWW);
    bf16* KK = (bf16*)(ws + WS_KK); bf16* KD = (bf16*)(ws + WS_KD); bf16* BE = (bf16*)(ws + WS_BETA); float* RKB = (float*)(ws + WS_RKB);
    LAS float* tb = (LAS float*)lds;
    for (int i = tid; i < 7 * 256; i += 512) { const int t7 = i >> 8, q = i & 255;
        const float* src = t7 == 0 ? a.in[18] + lj * 1024 : t7 == 1 ? a.in[19] + lj * 1024 : t7 == 2 ? a.in[20] + lj * 1024 : t7 < 5 ? a.in[10] + lj * 2048 + (t7 - 3) * 1024 : a.in[13] + lj * 2048 + (t7 - 5) * 1024;
        ((LAS f32x4*)tb)[i] = ((const f32x4*)src)[q]; }
    __syncthreads();
    for (int row = gw; row < T; row += NGW) {
#pragma unroll
        for (int j = 0; j < 4; ++j) {
            const int col = 256 * j + 4 * lane; const size_t ro = (size_t)row * D + col;
            const f32x4 k = bf4(*(const u32x2*)(Kk + ro)), r = bf4(*(const u32x2*)(Rr + ro));
            f32x4 a0 = bf4(*(const u32x2*)(RA + ro)) + *(const LAS f32x4*)(tb + 5 * 1024 + col), a1 = bf4(*(const u32x2*)(RA + (size_t)T * D + ro)) + *(const LAS f32x4*)(tb + 6 * 1024 + col);
#pragma unroll
            for (int z = 0; z < 4; ++z) { a0[z] = sigm(a0[z]); a1[z] = sigm(a1[z]); }
            const f32x4 ck = *(const LAS f32x4*)(tb + col), ca = *(const LAS f32x4*)(tb + 1024 + col), cr = *(const LAS f32x4*)(tb + 2048 + col);
            const f32x4 kk = k * ck;
            const float ss = row16_sum((kk.x * kk.x + kk.y * kk.y) + (kk.z * kk.z + kk.w * kk.w));
            const f32x4 kd0 = k * ((a0 - 1.0f) * ca + 1.0f), kd1 = k * ((a1 - 1.0f) * ca + 1.0f);
            *(u32x2*)(KD + ro) = pk4(kd0); *(u32x2*)(KD + (size_t)T * D + ro) = pk4(kd1);
            const f32x4 p = r * (kd0 + kd1) * cr;
            const float rk = row16_sum((p.x + p.y) + (p.z + p.w));
            const f32x4 kkn = kk * fminf(__builtin_amdgcn_rsqf(ss), 1e12f);
            *(u32x2*)(KK + ro) = pk4(kkn); *(u32x2*)(BE + ro) = pk4(kkn * a0); *(u32x2*)(BE + (size_t)T * D + ro) = pk4(kkn * a1);
            if ((lane & 15) == 0) RKB[(size_t)row * 16 + 4 * j + (lane >> 4)] = rk;
        }
    }
}
typedef short bf16x8 __attribute__((ext_vector_type(8)));
__device__ __forceinline__ f32x4 mfma16(bf16x8 a, bf16x8 b, f32x4 c) { return __builtin_amdgcn_mfma_f32_16x16x32_bf16(a, b, c, 0, 0, 0); }
__device__ __forceinline__ bf16x8 as_frag(u32x4 w) { return __builtin_bit_cast(bf16x8, w); }
constexpr int CH_LD = 144;
constexpr int CH_MS = 64 * CH_LD;
constexpr int CH_AB = 0 * CH_MS, CH_KT = 1 * CH_MS, CH_BT = 2 * CH_MS, CH_RB = 3 * CH_MS, CH_VT = 4 * CH_MS, CH_ABT = 5 * CH_MS, CH_KHT = 6 * CH_MS, CH_BHT = 7 * CH_MS,
              CH_LK = 8 * CH_MS, CH_LB = 9 * CH_MS, CH_MK = 10 * CH_MS, CH_MB = 11 * CH_MS, CH_WT = 12 * CH_MS, CH_U0 = 13 * CH_MS, CH_DINV = 14 * CH_MS;
constexpr int CH_GC = LDSCTL_OFF + 2048;
constexpr int CH_PART = LDSCTL_OFF + 4096;
constexpr int NCHUNK = NSTEP / 64;
#ifndef S1_DBL
#define S1_DBL 0
#endif
static_assert(CH_DINV + 2048 <= RING_BYTES, "chunk LDS map");

__device__ __forceinline__ int scan_row(int s, int dir, int b) {
    if (s < CTXL) return TL + b * CTXL + (dir ? CTXL - 1 - s : s);
    const int i = s - CTXL; return b * SEQ + (dir ? SEQ - 1 - i : i);
}
#define CH_FRAG(mat, row, ks, kg) as_frag(*(const LAS u32x4*)(lds + (mat) + (row) * CH_LD + ((ks) * 32 + (kg) * 8) * 2))

__device__ __forceinline__ float s1_treduce16(const float (&a)[16], bool b3, bool b2) {
    float b[8];
#pragma unroll
    for (int i = 0; i < 8; ++i) { float x = a[i], y = a[i + 8];
        asm("s_nop 1\n\tv_permlane32_swap_b32 %0, %1" : "+v"(x), "+v"(y));
        b[i] = x + y; }
    float c[4];
#pragma unroll
    for (int i = 0; i < 4; ++i) { float x = b[i], y = b[i + 4];
        asm("s_nop 1\n\tv_permlane16_swap_b32 %0, %1" : "+v"(x), "+v"(y));
        c[i] = x + y; }
    float d[2];
#pragma unroll
    for (int i = 0; i < 2; ++i) { const float keep = b3 ? c[i + 2] : c[i], send = b3 ? c[i] : c[i + 2]; d[i] = keep + DPPF(send, 0x128); }
    const float keep = b2 ? d[1] : d[0], send = b2 ? d[0] : d[1];
    float e = keep + DPPF(send, 0x141);
    e += DPPF(e, 0xB1);
    e += DPPF(e, 0x4E);
    return e;
}
#define S1_BAR() do { asm volatile("s_waitcnt lgkmcnt(0)" ::: "memory"); __builtin_amdgcn_s_barrier(); asm volatile("" ::: "memory"); } while (0)
__device__ __forceinline__ void phase_s1_chunks(const Args& a, int lj, LAS unsigned char* lds, int tid, int G, int rh_scratch = 0) {
    unsigned char* ws = a.ws; const float* w0l = a.in[10] + lj * 2048; const float* a0l = a.in[13] + lj * 2048;
    const float* pkk = a.in[18] + lj * 1024; const float* pka = a.in[19] + lj * 1024; const float* prk = a.in[20] + lj * 1024;
    const int lane = tid & 63, wave = __builtin_amdgcn_readfirstlane(tid >> 6), l15 = lane & 15, g = lane >> 4;
    LAS float* part = (LAS float*)(lds + CH_PART); LAS float* gammaC = (LAS float*)(lds + CH_GC);
    unsigned nlw[8], nka[8], nkr[8], nrr[8], nvv[8]; float nw0 = 0.f, na0 = 0.f, npkk = 0.f, npka = 0.f, nprk = 0.f;
    typedef const __attribute__((address_space(1))) unsigned short* GUS;
#define S1_LOAD(ctx_) do { unsigned char* wsl = ws; asm volatile("" : "+s"(wsl));     \
        const int chain_ = (ctx_) / NCHUNK, c_ = (ctx_) - chain_ * NCHUNK, dir_ = chain_ >> 6, b_ = (chain_ >> 4) & 3, h_ = chain_ & 15; \
          \
          \
        const long o0 = (long)scan_row(64 * c_ + 8 * wave, dir_, b_) * D + h_ * 64, od = (long)dir_ * T * D, st = dir_ ? -(long)D : (long)D; \
        const bf16* LWp = (const bf16*)(wsl + WS_RAWW) + od + o0; const bf16* RAp = (const bf16*)(wsl + WS_RAWA) + od + o0; \
        const bf16* Rp = (const bf16*)(wsl + WS_RKV) + o0; const bf16* Kp = Rp + (size_t)T * D; const bf16* Vp = Rp + (size_t)2 * T * D; \
        nw0 = w0l[dir_ * 1024 + h_ * 64 + lane]; na0 = a0l[dir_ * 1024 + h_ * 64 + lane]; npkk = pkk[h_ * 64 + lane]; npka = pka[h_ * 64 + lane]; nprk = prk[h_ * 64 + lane]; \
        _Pragma("unroll") for (int j = 0; j < 8; ++j) { const long oj = st * j; \
            nlw[j] = ((GUS)(LWp + oj))[lane]; nka[j] = ((GUS)(RAp + oj))[lane]; nkr[j] = ((GUS)(Kp + oj))[lane]; nrr[j] = ((GUS)(Rp + oj))[lane]; nvv[j] = ((GUS)(Vp + oj))[lane]; } } while (0)
    unsigned clw[8], cka_[8], ckr[8], crr[8], cvv[8]; float cw0 = 0.f, ca0 = 0.f, cpkk = 0.f, cpka = 0.f, cprk = 0.f;
#define S1_TAKE() do { _Pragma("unroll") for (int j = 0; j < 8; ++j) { clw[j] = nlw[j]; cka_[j] = nka[j]; ckr[j] = nkr[j]; crr[j] = nrr[j]; cvv[j] = nvv[j]; } \
        cw0 = nw0; ca0 = na0; cpkk = npkk; cpka = npka; cprk = nprk; \
        _Pragma("unroll") for (int j = 0; j < 8; ++j) asm volatile("" : "+v"(clw[j]), "+v"(cka_[j]), "+v"(ckr[j]), "+v"(crr[j]), "+v"(cvv[j]) :: "memory"); \
        asm volatile("" : "+v"(cw0), "+v"(ca0), "+v"(cpkk), "+v"(cpka), "+v"(cprk) :: "memory"); } while (0)
    if ((int)blockIdx.x < 128 * NCHUNK) { S1_LOAD((int)blockIdx.x); S1_TAKE(); if ((int)blockIdx.x + G < 128 * NCHUNK) S1_LOAD((int)blockIdx.x + G); }
    for (int ct = blockIdx.x; ct < 128 * NCHUNK; ct += G) {
        const int chain = ct / NCHUNK, c = ct - chain * NCHUNK, dir = chain >> 6, b = (chain >> 4) & 3, h = chain & 15;
        unsigned zq = 0u; asm volatile("" : "+v"(zq));
        {
            const int k = lane, tq = wave;
            float lw[8], kd[8], be[8], kk[8], rr[8], vv[8];
            {
                const float w0k = cw0, a0k = ca0, ckk = cpkk, cka = cpka, crk = cprk;
                float* RKBd = (float*)(ws + (dir ? WS_RKB1 : WS_RKB));
                const int row0 = scan_row(64 * c + 8 * tq, dir, b), rst = dir ? -1 : 1;
                float av[8], kq[8], red[16];
#pragma unroll
                for (int j = 0; j < 8; ++j) { av[j] = sigm(bflo(cka_[j]) + a0k); const float kr = bflo(ckr[j]);
                    lw[j] = -0.60653066f * sigm(bflo(clw[j]) + w0k);
                    kq[j] = kr * ckk; kd[j] = kr * ((av[j] - 1.0f) * cka + 1.0f); rr[j] = bflo(crr[j]); vv[j] = bflo(cvv[j]);
                    red[2 * j] = kq[j] * kq[j]; red[2 * j + 1] = rr[j] * kd[j] * crk; }
                const float tot = s1_treduce16(red, (lane & 8) != 0, (lane & 4) != 0);
                if ((lane & 7) == 4) RKBd[(size_t)(row0 + rst * (lane >> 3)) * 16 + h] = tot;
#pragma unroll
                for (int j = 0; j < 8; ++j) { const float ss = __builtin_bit_cast(float, __builtin_amdgcn_readlane(__builtin_bit_cast(int, tot), 8 * j));
                    kk[j] = kq[j] * fminf(__builtin_amdgcn_rsqf(ss), 1e12f);     be[j] = kk[j] * av[j]; }
            }
            for (int r0_ = 0; r0_ <= ((S1_DBL >> 3) & 1); ++r0_) { if (r0_) S1_BAR();
            float p[8]; p[0] = lw[0];
#pragma unroll
            for (int j = 1; j < 8; ++j) p[j] = p[j - 1] + lw[j];
            part[tq * 64 + k] = p[7];
            S1_BAR();
            float off = 0.f, tot = 0.f;
#pragma unroll
            for (int q = 0; q < 8; ++q) { const float pv = part[q * 64 + k]; tot += pv; off += q < tq ? pv : 0.f; }
            const float eTot = __expf(tot); float ePrev = __expf(off);
            if (tq == 0) gammaC[k] = eTot;
            unsigned abw[4], khw[4], bhw[4], vw[4];
#pragma unroll
            for (int j = 0; j < 8; j += 2) {
                float ab2[2], kt2[2], bt2[2], rb2[2], kh2[2], bh2[2];
#pragma unroll
                for (int z = 0; z < 2; ++z) { const float cu = off + p[j + z]; const float eP = __expf(cu), eM = __expf(-cu), eC = eTot * eM;
                    ab2[z] = kk[j + z] * ePrev; ePrev = eP; kt2[z] = kd[j + z] * eM; bt2[z] = be[j + z] * eM; rb2[z] = rr[j + z] * eP; kh2[z] = kd[j + z] * eC; bh2[z] = be[j + z] * eC;
                }
                abw[j >> 1] = pk2(ab2[0], ab2[1]); khw[j >> 1] = pk2(kh2[0], kh2[1]); bhw[j >> 1] = pk2(bh2[0], bh2[1]); vw[j >> 1] = pk2(vv[j], vv[j + 1]);
                {
                    const unsigned ktw = pk2(kt2[0], kt2[1]), btw = pk2(bt2[0], bt2[1]), rbw = pk2(rb2[0], rb2[1]), aw = abw[j >> 1];
                    const int t = 8 * tq + j;
                    *(LAS bf16*)(lds + CH_AB + t * CH_LD + k * 2) = (bf16)aw; *(LAS bf16*)(lds + CH_AB + (t + 1) * CH_LD + k * 2) = (bf16)(aw >> 16);
                    *(LAS bf16*)(lds + CH_KT + t * CH_LD + k * 2) = (bf16)ktw; *(LAS bf16*)(lds + CH_KT + (t + 1) * CH_LD + k * 2) = (bf16)(ktw >> 16);
                    *(LAS bf16*)(lds + CH_BT + t * CH_LD + k * 2) = (bf16)btw; *(LAS bf16*)(lds + CH_BT + (t + 1) * CH_LD + k * 2) = (bf16)(btw >> 16);
                    *(LAS bf16*)(lds + CH_RB + t * CH_LD + k * 2) = (bf16)rbw; *(LAS bf16*)(lds + CH_RB + (t + 1) * CH_LD + k * 2) = (bf16)(rbw >> 16); }
            }
            *(LAS u32x4*)(lds + CH_ABT + k * CH_LD + tq * 16) = (u32x4){abw[0], abw[1], abw[2], abw[3]};
            *(LAS u32x4*)(lds + CH_KHT + k * CH_LD + tq * 16) = (u32x4){khw[0], khw[1], khw[2], khw[3]};
            *(LAS u32x4*)(lds + CH_BHT + k * CH_LD + tq * 16) = (u32x4){bhw[0], bhw[1], bhw[2], bhw[3]};
            *(LAS u32x4*)(lds + CH_VT + k * CH_LD + tq * 16) = (u32x4){vw[0], vw[1], vw[2], vw[3]};
            *(LAS u32x4*)(lds + CH_WT + k * CH_LD + tq * 16) = (u32x4){zq, zq, zq, zq}; *(LAS u32x4*)(lds + CH_U0 + k * CH_LD + tq * 16) = (u32x4){zq, zq, zq, zq};
            }
        }
        S1_BAR();
        for (int r1_ = 0; r1_ <= (S1_DBL & 1); ++r1_) { if (r1_) S1_BAR();
            const int mi = wave >> 1, half = wave & 1;
            const int matS = (mi & 1) ? CH_BT : CH_KT, matT = (mi & 2) ? CH_RB : CH_AB, matO = CH_LK + mi * CH_MS;
            const bool incl = (mi & 2) != 0;
            bf16x8 fs[4][2], ft[2][2];
#pragma unroll
            for (int ms = 0; ms < 4; ++ms)
#pragma unroll
                for (int ks = 0; ks < 2; ++ks) fs[ms][ks] = CH_FRAG(matS, 16 * ms + l15, ks, g);
#pragma unroll
            for (int nt = 0; nt < 2; ++nt)
#pragma unroll
                for (int ks = 0; ks < 2; ++ks) ft[nt][ks] = CH_FRAG(matT, 32 * half + 16 * nt + l15, ks, g);
#pragma unroll
            for (int nt = 0; nt < 2; ++nt) { const int t = 32 * half + 16 * nt + l15;
#pragma unroll
                for (int ms = 0; ms < 4; ++ms) { f32x4 d = (f32x4){0.f, 0.f, 0.f, 0.f};
                    d = mfma16(fs[ms][0], ft[nt][0], d); d = mfma16(fs[ms][1], ft[nt][1], d);
                    const int s0 = 16 * ms + 4 * g;
#pragma unroll
                    for (int i = 0; i < 4; ++i) { const bool keep = incl ? (s0 + i <= t) : (s0 + i < t); d[i] = keep ? d[i] : __builtin_bit_cast(float, zq); }
                    u32x2 w; w.x = pk2(d[0], d[1]); w.y = pk2(d[2], d[3]);
                    *(LAS u32x2*)(lds + matO + t * CH_LD + s0 * 2) = w; } }
        }
        S1_BAR();
        f32x4 rhsU[4];
#pragma unroll
        for (int I = 0; I < 4; ++I) rhsU[I] = (f32x4){0.f, 0.f, 0.f, 0.f};
        if (wave >= 4) {
            const int ctv = (wave & 3) * 16;
            const bf16x8 fv0 = CH_FRAG(CH_VT, ctv + l15, 0, g), fv1 = CH_FRAG(CH_VT, ctv + l15, 1, g);
#pragma unroll
            for (int I = 0; I < 4; ++I) { f32x4 d = (f32x4){0.f, 0.f, 0.f, 0.f};
                d = mfma16(CH_FRAG(CH_LK, 16 * I + l15, 0, g), fv0, d); d = mfma16(CH_FRAG(CH_LK, 16 * I + l15, 1, g), fv1, d); rhsU[I] = -d; }
        }
        for (int r2_ = 0; r2_ <= ((S1_DBL >> 1) & 1); ++r2_) if (wave == 0) {
            const int bb = lane >> 4, j = lane & 15;
            float x[16];
#pragma unroll
            for (int t = 0; t < 16; ++t) {
                const u32x4 r0 = *(const LAS u32x4*)(lds + CH_LB + (16 * bb + t) * CH_LD + 32 * bb), r1 = *(const LAS u32x4*)(lds + CH_LB + (16 * bb + t) * CH_LD + 32 * bb + 16);
                const unsigned rw[8] = {r0.x, r0.y, r0.z, r0.w, r1.x, r1.y, r1.z, r1.w};
                float acc = (t == j) ? 1.0f : 0.0f;
#pragma unroll
                for (int s = 0; s < t; ++s) { const float lv = (s & 1) ? bfhi(rw[s >> 1]) : bflo(rw[s >> 1]); acc -= lv * x[s]; }
                x[t] = acc;
                *(LAS bf16*)(lds + CH_DINV + ((bb * 16 + t) * 16 + j) * 2) = (bf16)f2bf(acc);
            }
        }
        S1_BAR();
        {
            const int matZ = wave < 4 ? CH_WT : CH_U0, ct16 = (wave & 3) * 16;
            for (int r4_ = 0; r4_ <= ((S1_DBL >> 4) & 1); ++r4_) { if (r4_) { *(LAS u32x4*)(lds + matZ + (ct16 + l15) * CH_LD + g * 32) = (u32x4){zq, zq, zq, zq}; *(LAS u32x4*)(lds + matZ + (ct16 + l15) * CH_LD + g * 32 + 16) = (u32x4){zq, zq, zq, zq}; LDS_WAIT(); }
#pragma unroll
            for (int I = 0; I < 4; ++I) {
                f32x4 rhs;
                if (wave < 4) { const u32x2 w = *(const LAS u32x2*)(lds + CH_ABT + (ct16 + l15) * CH_LD + (16 * I + 4 * g) * 2); rhs = (f32x4){bflo(w.x), bfhi(w.x), bflo(w.y), bfhi(w.y)}; }
                else rhs = rhsU[I];
                f32x4 d = (f32x4){0.f, 0.f, 0.f, 0.f};
                d = mfma16(CH_FRAG(CH_LB, 16 * I + l15, 0, g), CH_FRAG(matZ, ct16 + l15, 0, g), d); d = mfma16(CH_FRAG(CH_LB, 16 * I + l15, 1, g), CH_FRAG(matZ, ct16 + l15, 1, g), d);
                const f32x4 ac = rhs - d;
                const u32x2 dv = *(const LAS u32x2*)(lds + CH_DINV + ((I * 16 + l15) * 16 + 4 * g) * 2);
                const bf16x8 fa = as_frag((u32x4){dv.x, dv.y, zq, zq}), fb = as_frag((u32x4){pk2(ac[0], ac[1]), pk2(ac[2], ac[3]), zq, zq});
                const f32x4 z = mfma16(fa, fb, (f32x4){0.f, 0.f, 0.f, 0.f});
                u32x2 w; w.x = pk2(z[0], z[1]); w.y = pk2(z[2], z[3]);
                *(LAS u32x2*)(lds + matZ + (ct16 + l15) * CH_LD + (16 * I + 4 * g) * 2) = w;
                LDS_WAIT(); asm volatile("" ::: "memory");
            }
            }
        }
        S1_BAR();
        if (ct + G < 128 * NCHUNK) { S1_TAKE(); if (ct + 2 * G < 128 * NCHUNK) S1_LOAD(ct + 2 * G); }
        for (int r3_ = 0; r3_ <= ((S1_DBL >> 2) & 1); ++r3_) { if (r3_) S1_BAR();
            const int rt = wave >> 1, cp = (wave & 1) * 2;
            unsigned char* wsl = ws; asm volatile("" : "+s"(wsl));
            bf16* YL = (bf16*)(wsl + WS_Y); bf16* RH = (bf16*)(wsl + (rh_scratch ? WS_BETA + RF : WS_RH)); bf16* PM = (bf16*)(wsl + WS_PM); bf16* QT = (bf16*)(wsl + WS_QT);
            const int trow = scan_row(64 * c + 16 * rt + l15, dir, b);
#pragma unroll
            for (int q = 0; q < 2; ++q) { const int vt = cp + q; f32x4 d = (f32x4){0.f, 0.f, 0.f, 0.f};
#pragma unroll
                for (int ks = 0; ks < 2; ++ks) { d = mfma16(CH_FRAG(CH_VT, 16 * vt + l15, ks, g), CH_FRAG(CH_MK, 16 * rt + l15, ks, g), d); d = mfma16(CH_FRAG(CH_U0, 16 * vt + l15, ks, g), CH_FRAG(CH_MB, 16 * rt + l15, ks, g), d); }
                *(u32x2*)(YL + ((size_t)dir * T + trow) * D + h * 64 + 16 * vt + 4 * g) = pk4(d); }
#pragma unroll
            for (int q = 0; q < 2; ++q) { const int kt = cp + q; f32x4 d = (f32x4){0.f, 0.f, 0.f, 0.f};
#pragma unroll
                for (int ks = 0; ks < 2; ++ks) d = mfma16(CH_FRAG(CH_WT, 16 * kt + l15, ks, g), CH_FRAG(CH_MB, 16 * rt + l15, ks, g), d);
                const u32x2 rbw = *(const LAS u32x2*)(lds + CH_RB + (16 * rt + l15) * CH_LD + (16 * kt + 4 * g) * 2);
                u32x2 w; w.x = pk2(bflo(rbw.x) - d[0], bfhi(rbw.x) - d[1]); w.y = pk2(bflo(rbw.y) - d[2], bfhi(rbw.y) - d[3]);
                *(u32x2*)(RH + ((size_t)dir * T + trow) * D + h * 64 + 16 * kt + 4 * g) = w; }
            bf16* Pc = PM + ((size_t)chain * NCHUNK + c) * 4096; bf16* Qc = QT + ((size_t)chain * NCHUNK + c) * 4096;
            { const int krow = 16 * rt + l15; const float gc = gammaC[krow];
#pragma unroll
                for (int q = 0; q < 2; ++q) { const int kt = cp + q; f32x4 d = (f32x4){0.f, 0.f, 0.f, 0.f};
#pragma unroll
                    for (int ks = 0; ks < 2; ++ks) d = mfma16(CH_FRAG(CH_WT, 16 * kt + l15, ks, g), CH_FRAG(CH_BHT, krow, ks, g), d);
                    const int k0 = 16 * kt + 4 * g; f32x4 o;
#pragma unroll
                    for (int i = 0; i < 4; ++i) o[i] = ((k0 + i == krow) ? gc : 0.f) - d[i];
                    u32x2 w; w.x = pk2(o[0], o[1]); w.y = pk2(o[2], o[3]);
                    *(u32x2*)(Pc + ((rt * 2 + (kt >> 1)) * 64 + g * 16 + l15) * 8 + 4 * (kt & 1)) = w; } }
            { const int vrow = 16 * rt + l15;
#pragma unroll
                for (int q = 0; q < 2; ++q) { const int kt = cp + q; f32x4 d = (f32x4){0.f, 0.f, 0.f, 0.f};
#pragma unroll
                    for (int ks = 0; ks < 2; ++ks) { d = mfma16(CH_FRAG(CH_KHT, 16 * kt + l15, ks, g), CH_FRAG(CH_VT, vrow, ks, g), d); d = mfma16(CH_FRAG(CH_BHT, 16 * kt + l15, ks, g), CH_FRAG(CH_U0, vrow, ks, g), d); }
                    u32x2 w; w.x = pk2(d[0], d[1]); w.y = pk2(d[2], d[3]);
                    *(u32x2*)(Qc + ((rt * 2 + (kt >> 1)) * 64 + g * 16 + l15) * 8 + 4 * (kt & 1)) = w; } }
        }
        S1_BAR();
    }
}

struct S2Set { u32x4 p[4][2]; u32x4 q[2]; };
__device__ __forceinline__ void s2_load(S2Set& s, const bf16* Pc, const bf16* Qc, int vt, int l15, int g) {
    const int ln = g * 16 + l15;
    s.q[0] = *(const u32x4*)(Qc + ((vt * 2 + 0) * 64 + ln) * 8); s.q[1] = *(const u32x4*)(Qc + ((vt * 2 + 1) * 64 + ln) * 8);
#pragma unroll
    for (int m = 0; m < 4; ++m)
#pragma unroll
        for (int j = 0; j < 2; ++j) s.p[m][j] = *(const u32x4*)(Pc + ((m * 2 + j) * 64 + ln) * 8);
}
__device__ __forceinline__ void s2_step(f32x4 (&acc)[4], const S2Set& s, bf16* Hc, int g) {
    unsigned hw[4][2];
#pragma unroll
    for (int m = 0; m < 4; ++m) { hw[m][0] = pk2(acc[m][0], acc[m][1]); hw[m][1] = pk2(acc[m][2], acc[m][3]); }
#pragma unroll
    for (int m = 0; m < 4; ++m) *(u32x2*)(Hc + (m >> 1) * 512 + (m & 1) * 256) = (u32x2){hw[m][0], hw[m][1]};
    const bf16x8 hb0 = as_frag((u32x4){hw[0][0], hw[0][1], hw[1][0], hw[1][1]}), hb1 = as_frag((u32x4){hw[2][0], hw[2][1], hw[3][0], hw[3][1]});
#pragma unroll
    for (int m = 0; m < 4; ++m) {
        const unsigned q0 = (m & 2) ? ((m & 1) ? s.q[1].z : s.q[1].x) : ((m & 1) ? s.q[0].z : s.q[0].x), q1 = (m & 2) ? ((m & 1) ? s.q[1].w : s.q[1].y) : ((m & 1) ? s.q[0].w : s.q[0].y);
        f32x4 d = (f32x4){bflo(q0), bfhi(q0), bflo(q1), bfhi(q1)};
        d = mfma16(as_frag(s.p[m][0]), hb0, d);
        d = mfma16(as_frag(s.p[m][1]), hb1, d);
        acc[m] = d;
    }
}
__device__ __forceinline__ void phase_s2_chain(const Args& a, int wave, int lane, int G) {
    unsigned char* ws = a.ws;
    const bf16* PM = (const bf16*)(ws + WS_PM); const bf16* QT = (const bf16*)(ws + WS_QT); bf16* HT = (bf16*)(ws + WS_HT);
    const int l15 = lane & 15, g = lane >> 4;
    if (wave >= 2) return;
    static_assert(NCHUNK % 4 == 0, "S2 ring");
    for (int wt = blockIdx.x * 2 + wave; wt < 512; wt += G * 2) {
        const int chain = wt >> 2, vt = wt & 3;
        f32x4 acc[4];
#pragma unroll
        for (int m = 0; m < 4; ++m) acc[m] = (f32x4){0.f, 0.f, 0.f, 0.f};
        const bf16* Pc = PM + (size_t)chain * NCHUNK * 4096; const bf16* Qc = QT + (size_t)chain * NCHUNK * 4096;
        bf16* Hc = HT + (size_t)chain * NCHUNK * 4096 + ((vt * 2) * 64 + (g >> 1) * 16 + l15) * 8 + 4 * (g & 1);
        S2Set s0, s1, s2, s3;
        s2_load(s0, Pc, Qc, vt, l15, g); s2_load(s1, Pc + 4096, Qc + 4096, vt, l15, g); s2_load(s2, Pc + 2 * 4096, Qc + 2 * 4096, vt, l15, g); s2_load(s3, Pc + 3 * 4096, Qc + 3 * 4096, vt, l15, g);
#pragma unroll 1
        for (int c = 0; c < NCHUNK; c += 4) {
            const int cn = c + 4 < NCHUNK ? c + 4 : c;
            const bf16* Pn = Pc + (size_t)cn * 4096; const bf16* Qn = Qc + (size_t)cn * 4096;
            s2_step(acc, s0, Hc + (size_t)c * 4096, g);       s2_load(s0, Pn, Qn, vt, l15, g);
            s2_step(acc, s1, Hc + (size_t)(c + 1) * 4096, g); s2_load(s1, Pn + 4096, Qn + 4096, vt, l15, g);
            s2_step(acc, s2, Hc + (size_t)(c + 2) * 4096, g); s2_load(s2, Pn + 2 * 4096, Qn + 2 * 4096, vt, l15, g);
            s2_step(acc, s3, Hc + (size_t)(c + 3) * 4096, g); s2_load(s3, Pn + 3 * 4096, Qn + 3 * 4096, vt, l15, g);
        }
    }
}

struct S3In { u32x2 yl[2][4]; u32x4 rh[2][2]; u32x4 hh[2][4][2]; };
__device__ __forceinline__ void s3_issue(S3In& s, const bf16* YL, const bf16* RH, const bf16* HT, int task, int l15, int g) {
    const int tt = task >> 4, h = task & 15, r0 = tt * 16, row = r0 + l15;
    int b, cc[2];
    if (r0 < TL) { b = r0 >> 13; const int tb = (r0 & (SEQ - 1)) >> 6; cc[0] = 4 + tb; cc[1] = 4 + (127 - tb); }
    else { const int loc = r0 - TL; b = loc >> 8; const int tb = (loc & 255) >> 6; cc[0] = tb; cc[1] = 3 - tb; }
    const size_t ro = (size_t)row * D + h * 64 + 4 * g;
#pragma unroll
    for (int dir = 0; dir < 2; ++dir) {
#pragma unroll
        for (int vt = 0; vt < 4; ++vt) s.yl[dir][vt] = *(const u32x2*)(YL + (size_t)dir * T * D + ro + 16 * vt);
        const int chain = dir * 64 + b * 16 + h;
        const bf16* rh = RH + ((size_t)dir * T + row) * D + h * 64 + 8 * g;
        s.rh[dir][0] = *(const u32x4*)(rh); s.rh[dir][1] = *(const u32x4*)(rh + 32);
        const bf16* hc = HT + ((size_t)chain * NCHUNK + cc[dir]) * 4096;
#pragma unroll
        for (int vt = 0; vt < 4; ++vt) { const bf16* hr = hc + ((vt * 2) * 64 + g * 16 + l15) * 8; s.hh[dir][vt][0] = *(const u32x4*)(hr); s.hh[dir][vt][1] = *(const u32x4*)(hr + 512); }
    }
}
__device__ __forceinline__ void s3_finish(const S3In& s, const bf16* Vv, const float* RKB, const float* RKB1, const bf16* Gg, const float* lng, const float* lnb, bf16* Z, int task, int l15, int g) {
    const int tt = task >> 4, h = task & 15, row = tt * 16 + l15;
    u32x2 vq2[4], gw2[4]; f32x4 lg4[4], lb4[4];
#pragma unroll
    for (int vt = 0; vt < 4; ++vt) { const int col = h * 64 + 16 * vt + 4 * g; const size_t o = (size_t)row * D + col;
        vq2[vt] = *(const u32x2*)(Vv + o); gw2[vt] = *(const u32x2*)(Gg + o); lg4[vt] = *(const f32x4*)(lng + col); lb4[vt] = *(const f32x4*)(lnb + col); }
    const float bon = RKB[(size_t)row * 16 + h] + RKB1[(size_t)row * 16 + h];
    f32x4 acc[4];
#pragma unroll
    for (int vt = 0; vt < 4; ++vt) acc[vt] = bf4(s.yl[0][vt]) + bf4(s.yl[1][vt]);
#pragma unroll
    for (int dir = 0; dir < 2; ++dir) {
        const bf16x8 f0 = as_frag(s.rh[dir][0]), f1 = as_frag(s.rh[dir][1]);
#pragma unroll
        for (int vt = 0; vt < 4; ++vt) { acc[vt] = mfma16(as_frag(s.hh[dir][vt][0]), f0, acc[vt]); acc[vt] = mfma16(as_frag(s.hh[dir][vt][1]), f1, acc[vt]); }
    }
    float sm = 0.f;
#pragma unroll
    for (int vt = 0; vt < 4; ++vt) sm += (acc[vt][0] + acc[vt][1]) + (acc[vt][2] + acc[vt][3]);
    sm += __shfl_xor(sm, 16); sm += __shfl_xor(sm, 32);
    const float mean = sm * (1.0f / 64.0f); float vs = 0.f;
#pragma unroll
    for (int vt = 0; vt < 4; ++vt) { acc[vt] = acc[vt] - mean; vs += (acc[vt][0] * acc[vt][0] + acc[vt][1] * acc[vt][1]) + (acc[vt][2] * acc[vt][2] + acc[vt][3] * acc[vt][3]); }
    vs += __shfl_xor(vs, 16); vs += __shfl_xor(vs, 32);
    const float rstd = rsqrtf(vs * (1.0f / 64.0f) + 64.0f * 1e-5f);
#pragma unroll
    for (int vt = 0; vt < 4; ++vt) { const int col = h * 64 + 16 * vt + 4 * g; const size_t o = (size_t)row * D + col;
        const f32x4 zz = acc[vt] * rstd * lg4[vt] + lb4[vt] + bf4(vq2[vt]) * bon;
        u32x2 w; w.x = pk2(zz[0] * bflo(gw2[vt].x), zz[1] * bfhi(gw2[vt].x)); w.y = pk2(zz[2] * bflo(gw2[vt].y), zz[3] * bfhi(gw2[vt].y));
        *(u32x2*)(Z + o) = w; }
}
__device__ __forceinline__ void phase_s3_readout(const Args& a, int lj, int nrows, int gw, int NGW, int lane) {
    unsigned char* ws = a.ws;
    const bf16* YL = (const bf16*)(ws + WS_Y); const bf16* RH = (const bf16*)(ws + WS_RH); const bf16* HT = (const bf16*)(ws + WS_HT);
    const bf16* Vv = (const bf16*)(ws + WS_RKV) + (size_t)2 * T * D; const float* RKB = (const float*)(ws + WS_RKB); const float* RKB1 = (const float*)(ws + WS_RKB1); const bf16* Gg = (const bf16*)(ws + WS_G); bf16* Z = (bf16*)(ws + WS_Z);
    const float* lng = a.in[21] + lj * 1024; const float* lnb = a.in[22] + lj * 1024;
    const int l15 = lane & 15, g = lane >> 4, ntask = (nrows / 16) * 16;
    for (int task = gw; task < ntask; task += NGW) {
        S3In A;
        s3_issue(A, YL, RH, HT, task, l15, g);
        s3_finish(A, Vv, RKB, RKB1, Gg, lng, lnb, Z, task, l15, g);
    }
}
__device__ __forceinline__ void phase_cv(const Args& a, int lc, int rows, int gw, int NGW, int lane) {
    unsigned char* ws = a.ws;
    const bf16* BG = (const bf16*)(ws + WS_BG); const bf16* CU = (const bf16*)(ws + WS_CUZ); bf16* Z = (bf16*)(ws + WS_Z);
    const float* cw = a.in[25] + (size_t)lc * 3 * 1024;
    for (int t = gw; t < rows; t += NGW) {
        int rs, re; if (t < TL) { rs = t & ~63; re = rs + 63; } else { const int loc = t - TL; rs = TL + (loc & ~255); re = rs + 255; }
        const bool hp = t > rs, hn = t < re;
        u32x2 zc4[4], bg4[4], zp4[4], zn4[4]; f32x4 w04[4], w14[4], w24[4];
#pragma unroll
        for (int j = 0; j < 4; ++j) { const int col = 256 * j + 4 * lane; const size_t o = (size_t)t * D + col;
            zc4[j] = *(const u32x2*)(CU + o); bg4[j] = *(const u32x2*)(BG + o);
            zp4[j] = hp ? *(const u32x2*)(CU + o - D) : (u32x2){0u, 0u}; zn4[j] = hn ? *(const u32x2*)(CU + o + D) : (u32x2){0u, 0u};
            w04[j] = *(const f32x4*)(cw + col); w14[j] = *(const f32x4*)(cw + 1024 + col); w24[j] = *(const f32x4*)(cw + 2048 + col); }
#pragma unroll
        for (int j = 0; j < 4; ++j) { const int col = 256 * j + 4 * lane; const size_t o = (size_t)t * D + col;
            const u32x2 zc = zc4[j], bg = bg4[j], zp = zp4[j], zn = zn4[j];
            const f32x4 w0 = w04[j], w1 = w14[j], w2 = w24[j];
            const f32x4 zv = (f32x4){bflo(zc.x), bfhi(zc.x), bflo(zc.y), bfhi(zc.y)}, pv = (f32x4){bflo(zp.x), bfhi(zp.x), bflo(zp.y), bfhi(zp.y)}, nv = (f32x4){bflo(zn.x), bfhi(zn.x), bflo(zn.y), bfhi(zn.y)};
            const f32x4 bv = (f32x4){bflo(bg.x), bfhi(bg.x), bflo(bg.y), bfhi(bg.y)};
            const f32x4 r = bv * (w0 * pv + w1 * zv + w2 * nv);
            u32x2 w; w.x = pk2(r.x, r.y); w.y = pk2(r.z, r.w); *(u32x2*)(Z + o) = w; }
    }
}
typedef float f32x2v __attribute__((ext_vector_type(2)));
__device__ __forceinline__ float lane_bcast(float v, int srclane) { return __builtin_bit_cast(float, __builtin_amdgcn_readlane(__builtin_bit_cast(int, v), srclane)); }
__device__ __forceinline__ void phase_e_route(const Args& a, int layer, int rows, LAS unsigned char* lds, int tid, int gw, int NGW, int lane, int probe_rep = 0) {
    unsigned char* ws = a.ws;
    const float* xs = (const float*)(ws + (layer < 2 ? WS_XSA : WS_XSB));
    const float* MODS = (const float*)(ws + WS_MODS); bf16* H2 = (bf16*)(ws + WS_H2);
    const float* ng = a.in[6] + (size_t)(layer * 2 + 1) * 1024;
    const float* rw = a.in[27] + (size_t)layer * 1024 * 32; const float* rb = a.in[28] + layer * 32;
    unsigned* cnt = (unsigned*)(ws + WS_CTL) + CW_CNT + (layer + 4 * probe_rep) * 32 * CNT_STRIDE;
    int* SLOTL = (int*)(ws + (probe_rep ? WS_L1 : WS_SLOTL)); float* GATEL = (float*)(ws + (probe_rep ? WS_L1 + 8 * MiB : WS_GATEL));
    LAS float* wt = (LAS float*)lds;
    LAS int* hist = (LAS int*)(lds + LDSCTL_OFF + 3072); LAS int* base = hist + 32; LAS int* lcnt = hist + 64;
    int* TKE = (int*)(ws + WS_C12); float* TKG = (float*)(ws + WS_C12 + 4 * MiB);
    for (int i = tid; i < 32768; i += 512) wt[(i & 31) * 1024 + (i >> 5)] = rw[i];
    if (tid < 32) hist[tid] = 0;
    __syncthreads();
    const int my_e = lane >> 1; const float my_b = rb[my_e];
    const bool b5 = (lane & 32) != 0, b4 = (lane & 16) != 0, b3 = (lane & 8) != 0, b2 = (lane & 4) != 0, b1 = (lane & 2) != 0;
    for (int t = gw; t < rows; t += NGW) {
        const int mr = mod_row(t);
        const float* mod = MODS + (size_t)(layer * 5 + mr) * 6144;
        f32x4 x[4];
#pragma unroll
        for (int j = 0; j < 4; ++j) x[j] = *(const f32x4*)(xs + (size_t)t * D + 256 * j + 4 * lane);
        const float rstd = row_rstd(x);
#pragma unroll
        for (int j = 0; j < 4; ++j) { const int col = 256 * j + 4 * lane;
            x[j] = x[j] * rstd * *(const f32x4*)(ng + col) * (*(const f32x4*)(mod + 4 * 1024 + col) + 1.0f) + *(const f32x4*)(mod + 3 * 1024 + col);
            u32x2 w; w.x = pk2(x[j].x, x[j].y); w.y = pk2(x[j].z, x[j].w); *(u32x2*)(H2 + (size_t)t * D + col) = w; }
        float p[32];
#pragma unroll
        for (int eg = 0; eg < 8; ++eg) {
#pragma unroll
            for (int ee = 0; ee < 4; ++ee) { const int e = eg * 4 + ee; f32x2v s2 = (f32x2v){0.f, 0.f};
#pragma unroll
                for (int j = 0; j < 4; ++j) { const f32x4 wv = *(const LAS f32x4*)(wt + e * 1024 + 256 * j + 4 * lane);
                    s2 = __builtin_elementwise_fma((f32x2v){x[j].x, x[j].y}, (f32x2v){wv.x, wv.y}, s2); s2 = __builtin_elementwise_fma((f32x2v){x[j].z, x[j].w}, (f32x2v){wv.z, wv.w}, s2); }
                p[e] = s2.x + s2.y; }
            asm volatile("" ::: "memory");
        }
        float q16[16];
#pragma unroll
        for (int i = 0; i < 16; ++i) { const float send = b5 ? p[i] : p[i + 16]; const float keep = b5 ? p[i + 16] : p[i]; q16[i] = keep + __shfl_xor(send, 32); }
        float q8[8];
#pragma unroll
        for (int i = 0; i < 8; ++i) { const float send = b4 ? q16[i] : q16[i + 8]; const float keep = b4 ? q16[i + 8] : q16[i]; q8[i] = keep + __shfl_xor(send, 16); }
        float q4[4];
#pragma unroll
        for (int i = 0; i < 4; ++i) { const float send = b3 ? q8[i] : q8[i + 4]; const float keep = b3 ? q8[i + 4] : q8[i]; q4[i] = keep + __shfl_xor(send, 8); }
        float q2[2];
#pragma unroll
        for (int i = 0; i < 2; ++i) { const float send = b2 ? q4[i] : q4[i + 2]; const float keep = b2 ? q4[i + 2] : q4[i]; q2[i] = keep + __shfl_xor(send, 4); }
        float q1; { const float send = b1 ? q2[0] : q2[1]; const float keep = b1 ? q2[1] : q2[0]; q1 = keep + __shfl_xor(send, 2); }
        const float lg = q1 + __shfl_xor(q1, 1) + my_b;
        int rank = 0;
#pragma unroll 1
        for (int e = 0; e < 32; ++e) { const float o = lane_bcast(lg, 2 * e); rank += (o > lg || (o == lg && e < my_e)) ? 1 : 0; }
        const bool sel = rank < 4 && !(lane & 1);
        const unsigned long long m0 = __ballot(sel && rank == 0), m1 = __ballot(sel && rank == 1), m2 = __ballot(sel && rank == 2), m3 = __ballot(sel && rank == 3);
        const float v0 = lane_bcast(lg, (int)__builtin_ctzll(m0)), v1 = lane_bcast(lg, (int)__builtin_ctzll(m1)), v2 = lane_bcast(lg, (int)__builtin_ctzll(m2)), v3 = lane_bcast(lg, (int)__builtin_ctzll(m3));
        const float e1 = __expf(v1 - v0), e2 = __expf(v2 - v0), e3 = __expf(v3 - v0);
        const float inv = frcp(1.0f + e1 + e2 + e3);
        if (sel) {
            TKE[t * 4 + rank] = my_e; TKG[t * 4 + rank] = __expf(lg - v0) * inv;
            __hip_atomic_fetch_add(hist + my_e, 1, __ATOMIC_RELAXED, __HIP_MEMORY_SCOPE_WORKGROUP);
        }
    }
    asm volatile("s_waitcnt vmcnt(0) lgkmcnt(0)" ::: "memory"); __syncthreads();
    if (tid < 32) { base[tid] = (int)atomicAdd(cnt + tid * CNT_STRIDE, (unsigned)hist[tid]); lcnt[tid] = 0; }
    __syncthreads();
    for (int t = gw; t < rows; t += NGW) {
        if (lane < 4) { const int e = TKE[t * 4 + lane]; const float gk = TKG[t * 4 + lane];
            const int pos = base[e] + __hip_atomic_fetch_add(lcnt + e, 1, __ATOMIC_RELAXED, __HIP_MEMORY_SCOPE_WORKGROUP);
            SLOTL[(size_t)e * T + pos] = t * 4 + lane; GATEL[(size_t)e * T + pos] = gk; }
    }
}
__device__ __forceinline__ int okey(float v, int e) { const int i = __builtin_bit_cast(int, v); const int o = i ^ ((i >> 31) & 0x7fffffff); return (o & ~31) | (31 - e); }
__device__ __forceinline__ void phase_e_route_mfma(const Args& a, int layer, int rows, LAS unsigned char* lds, int tid, int wave, int gw, int NGW, int lane, int probe_rep = 0) {
    unsigned char* ws = a.ws;
    const float* xs = (const float*)(ws + (layer < 2 ? WS_XSA : WS_XSB));
    const float* MODS = (const float*)(ws + WS_MODS); bf16* H2 = (bf16*)(ws + WS_H2);
    const float* ng = a.in[6] + (size_t)(layer * 2 + 1) * 1024; const float* rb = a.in[28] + layer * 32;
    const bf16* WRT = (const bf16*)(ws + WS_WRT) + (size_t)layer * 2 * 32 * 1024;
    unsigned* cnt = (unsigned*)(ws + WS_CTL) + CW_CNT + (layer + 4 * probe_rep) * 32 * CNT_STRIDE;
    int* SLOTL = (int*)(ws + (probe_rep ? WS_L1 : WS_SLOTL)); float* GATEL = (float*)(ws + (probe_rep ? WS_L1 + 8 * MiB : WS_GATEL));
    LAS int* hist = (LAS int*)(lds + LDSCTL_OFF + 3072); LAS int* base = hist + 32; LAS int* lcnt = hist + 64;
    int* TKE = (int*)(ws + WS_C12); float* TKG = (float*)(ws + WS_C12 + 4 * MiB);
    LAS unsigned char* tile = lds + wave * 8448;
    if (tid < 32) hist[tid] = 0;
    constexpr int E_TAB = 8 * 8448, E_TP = 2064;
    static_assert(E_TAB + 32 * E_TP <= LDSCTL_OFF, "router table");
    for (int i = tid; i < 32 * 128; i += 512) { const int r = i >> 7, pc = i & 127; *(LAS u32x4*)(lds + E_TAB + r * E_TP + pc * 16) = *(const u32x4*)(WRT + (size_t)r * 1024 + pc * 8); }
    __syncthreads();
    const int l15 = lane & 15, g = lane >> 4;
    const int nlat = TL / 16, nctx = rows > TL ? TC / 4 : 0, G_ = NGW / 8;
    for (int it = 0;; ++it) {
        int t0, ntok;
        { const int tl = gw + it * NGW; const int xi = (int)blockIdx.x + (it - (nlat + NGW - 1) / NGW) * G_ * 8 + wave * G_;
          if (tl < nlat) { t0 = tl * 16; ntok = 16; } else if (it >= (nlat + NGW - 1) / NGW && xi < nctx) { t0 = TL + xi * 4; ntok = 4; } else if (it >= (nlat + NGW - 1) / NGW) break; else continue; }
        const float* mod = MODS + (size_t)(layer * 5 + mod_row(t0)) * 6144;
        float rstd[16];
#pragma unroll
        for (int tb = 0; tb < 16; tb += 8) {
            f32x4 xa[8][4];
#pragma unroll
            for (int t = 0; t < 8; ++t) { const int tr = tb + t < ntok ? t0 + tb + t : t0;
#pragma unroll
                for (int j = 0; j < 4; ++j) xa[t][j] = *(const f32x4*)(xs + (size_t)tr * D + 256 * j + 4 * lane); }
#pragma unroll
            for (int t = 0; t < 8; ++t) rstd[tb + t] = __builtin_bit_cast(float, __builtin_amdgcn_readfirstlane(__builtin_bit_cast(int, row_rstd(xa[t]))));
            asm volatile("" ::: "memory"); }
        f32x4 acc[2]; acc[0] = (f32x4){0.f, 0.f, 0.f, 0.f}; acc[1] = acc[0];
#pragma unroll 1
        for (int s = 0; s < 4; ++s) {
            const int col = 256 * s + 4 * lane;
            int t0s = t0; asm volatile("" : "+s"(t0s));
            const bf16* wl = WRT + (size_t)(32 + l15) * 1024 + 256 * s + 8 * g;
            u32x4 wlf[8][2];
#pragma unroll
            for (int ks = 0; ks < 8; ++ks)
#pragma unroll
                for (int et = 0; et < 2; ++et) wlf[ks][et] = *(const u32x4*)(wl + (size_t)et * 16 * 1024 + 32 * ks);
            const f32x4 g4 = *(const f32x4*)(ng + col) * (*(const f32x4*)(mod + 4 * 1024 + col) + 1.0f), s4 = *(const f32x4*)(mod + 3 * 1024 + col);
            u32x2 lo[16];
#pragma unroll
            for (int tb = 0; tb < 16; tb += 8) {
                f32x4 xr[8];
#pragma unroll
                for (int t = 0; t < 8; ++t) { const int tr = tb + t < ntok ? t0s + tb + t : t0s; xr[t] = *(const f32x4*)(xs + (size_t)tr * D + col); }
#pragma unroll
                for (int t = 0; t < 8; ++t) { const int tr = tb + t < ntok ? t0s + tb + t : t0s; const f32x4 hv = xr[t] * rstd[tb + t] * g4 + s4;
                    const u32x2 w = pk4(hv); if (tb + t < ntok) *(u32x2*)(H2 + (size_t)tr * D + col) = w;
                    *(LAS u32x2*)(tile + (tb + t) * 528 + lane * 8) = w; lo[tb + t] = pk4(hv - bf4(w)); } }
            LDS_WAIT(); asm volatile("" ::: "memory");
            const LAS unsigned char* th = lds + E_TAB + l15 * E_TP + (256 * s + 8 * g) * 2;
#pragma unroll
            for (int ks = 0; ks < 8; ++ks) { const bf16x8 fb = as_frag(*(const LAS u32x4*)(tile + l15 * 528 + ks * 64 + g * 16));
#pragma unroll
                for (int et = 0; et < 2; ++et) { acc[et] = mfma16(as_frag(*(const LAS u32x4*)(th + et * 16 * E_TP + 64 * ks)), fb, acc[et]);
                    acc[et] = mfma16(as_frag(wlf[ks][et]), fb, acc[et]); } }
            LDS_WAIT(); asm volatile("" ::: "memory");
#pragma unroll
            for (int t = 0; t < 16; ++t) *(LAS u32x2*)(tile + t * 528 + lane * 8) = lo[t];
            LDS_WAIT(); asm volatile("" ::: "memory");
#pragma unroll
            for (int ks = 0; ks < 8; ++ks) { const bf16x8 fb = as_frag(*(const LAS u32x4*)(tile + l15 * 528 + ks * 64 + g * 16));
#pragma unroll
                for (int et = 0; et < 2; ++et) acc[et] = mfma16(as_frag(*(const LAS u32x4*)(th + et * 16 * E_TP + 64 * ks)), fb, acc[et]); }
            LDS_WAIT(); asm volatile("" ::: "memory");
        }
        float v[8]; int key[8];
#pragma unroll
        for (int j = 0; j < 8; ++j) { const int e = (j < 4 ? 0 : 16) + 4 * g + (j & 3); v[j] = acc[j >> 2][j & 3] + rb[e]; key[j] = okey(v[j], e); }
        int kb[8], kc[8], kd2[8];
#pragma unroll
        for (int j = 0; j < 8; ++j) kb[j] = __shfl_xor(key[j], 16);
#pragma unroll
        for (int j = 0; j < 8; ++j) { kc[j] = __shfl_xor(key[j], 32); kd2[j] = __shfl_xor(kb[j], 32); }
        float vmax = fmaxf(fmaxf(fmaxf(v[0], v[1]), fmaxf(v[2], v[3])), fmaxf(fmaxf(v[4], v[5]), fmaxf(v[6], v[7])));
        vmax = fmaxf(vmax, __shfl_xor(vmax, 16)); vmax = fmaxf(vmax, __shfl_xor(vmax, 32));
        int rank[8]; float ex[8], part = 0.f;
#pragma unroll
        for (int j = 0; j < 8; ++j) { int r = 0;
#pragma unroll
            for (int q = 0; q < 8; ++q) r += (key[q] > key[j]) + (kb[q] > key[j]) + (kc[q] > key[j]) + (kd2[q] > key[j]);
            rank[j] = r; ex[j] = __expf(v[j] - vmax); part += r < 4 ? ex[j] : 0.f; }
        part += __shfl_xor(part, 16); part += __shfl_xor(part, 32);
        const float inv = frcp(part); const int t = t0 + l15;
#pragma unroll
        for (int j = 0; j < 8; ++j) if (rank[j] < 4 && l15 < ntok) { const int e = (j < 4 ? 0 : 16) + 4 * g + (j & 3);
            TKE[t * 4 + rank[j]] = e; TKG[t * 4 + rank[j]] = ex[j] * inv;
            __hip_atomic_fetch_add(hist + e, 1, __ATOMIC_RELAXED, __HIP_MEMORY_SCOPE_WORKGROUP); }
    }
    asm volatile("s_waitcnt vmcnt(0) lgkmcnt(0)" ::: "memory"); __syncthreads();
    if (tid < 32) { base[tid] = (int)atomicAdd(cnt + tid * CNT_STRIDE, (unsigned)hist[tid]); lcnt[tid] = 0; }
    __syncthreads();
    for (int it = 0;; ++it) {
        int t0, ntok;
        { const int tl = gw + it * NGW; const int xi = (int)blockIdx.x + (it - (nlat + NGW - 1) / NGW) * G_ * 8 + wave * G_;
          if (tl < nlat) { t0 = tl * 16; ntok = 16; } else if (it >= (nlat + NGW - 1) / NGW && xi < nctx) { t0 = TL + xi * 4; ntok = 4; } else if (it >= (nlat + NGW - 1) / NGW) break; else continue; }
        if ((lane >> 2) < ntok) { const int t = t0 + (lane >> 2), k = lane & 3;
            const int e = TKE[t * 4 + k]; const float gk = TKG[t * 4 + k];
            const int pos = base[e] + __hip_atomic_fetch_add(lcnt + e, 1, __ATOMIC_RELAXED, __HIP_MEMORY_SCOPE_WORKGROUP);
            SLOTL[(size_t)e * T + pos] = t * 4 + k; GATEL[(size_t)e * T + pos] = gk; }
    }
}
__device__ __forceinline__ void phase_final(const Args& a, int gw, int NGW, int lane) {
    unsigned char* ws = a.ws;
    const float* xs = (const float*)(ws + WS_XSB); const float* MODS = (const float*)(ws + WS_MODS); const bf16* YS = (const bf16*)(ws + WS_YS);
    for (int t = gw; t < TL; t += NGW) {
        const int mr = t >> 13;
        f32x4 m5[4], x[4];
#pragma unroll
        for (int j = 0; j < 4; ++j) m5[j] = *(const f32x4*)(MODS + (size_t)(3 * 5 + mr) * 6144 + 5 * 1024 + 256 * j + 4 * lane);
        f32x4 fg[4];
#pragma unroll
        for (int j = 0; j < 4; ++j) fg[j] = *(const f32x4*)(a.in[7] + 256 * j + 4 * lane);
        load_x_combined(x, xs + (size_t)t * D, true, YS, t, m5, lane);
        const float rstd = row_rstd(x);
#pragma unroll
        for (int j = 0; j < 4; ++j) { const int col = 256 * j + 4 * lane; *(f32x4*)(a.out + (size_t)t * D + col) = x[j] * rstd * fg[j]; }
    }
}

using pg8::Unit; using pg8::tile_map;
struct SchedStd {
    int G, c, nM, nN;
    __device__ __forceinline__ bool next(int i, Unit& u) const { const long L = (long)i * G + c; if (L >= (long)nM * nN) return false; int pm, pn; tile_map((int)L, nM, nN, pm, pn); u.pm = pm; u.pn = pn; u.e = 0; u.nv = pm; u.par = 0; return true; }
    __device__ __forceinline__ void a_ready(const Unit&) const {}
    __device__ __forceinline__ void done(const Unit&) const {}
    __device__ __forceinline__ unsigned row_off(const Unit&, int) const { return 0u; }
    __device__ __forceinline__ unsigned row_off_lds(const Unit&, int) const { return 0u; }
    __device__ __forceinline__ void prefetch_rows(const Unit&) const {}
};
struct SchedB1 {
    int G, c;
    __device__ __forceinline__ bool next(int i, Unit& u) const { const long L = (long)i * G + c; constexpr int n1 = 3 * NMT * 4; if (L >= n1 + 3 * NMT) return false; const int l = (int)L;
        if (l < n1) { const int j = l / (NMT * 4), r = l % (NMT * 4); int pm, pn; tile_map(r, NMT, 4, pm, pn); u.pm = j * NMT + pm; u.pn = j * 4 + pn; u.e = j; u.nv = pm; }
        else { const int r = l - n1, j = r / NMT, pm = r % NMT; u.pm = (3 + j) * NMT + pm; u.pn = 12 + j; u.e = 3 + j; u.nv = pm; }
        u.par = 0; return true; }
    __device__ __forceinline__ void a_ready(const Unit&) const {}
    __device__ __forceinline__ void done(const Unit&) const {}
    __device__ __forceinline__ unsigned row_off(const Unit&, int) const { return 0u; }
    __device__ __forceinline__ unsigned row_off_lds(const Unit&, int) const { return 0u; }
    __device__ __forceinline__ void prefetch_rows(const Unit&) const {}
};
struct SchedB2 {
    int G, c;
    __device__ __forceinline__ bool next(int i, Unit& u) const { const long L = (long)i * G + c; constexpr int n1 = 2 * NMT * 8; if (L >= n1 + NMT * 4) return false; const int l = (int)L;
        if (l < n1) { const int j = l / (NMT * 8), r = l % (NMT * 8); int pm, pn; tile_map(r, NMT, 8, pm, pn); u.pm = j * NMT + pm; u.pn = j * 8 + pn; u.e = j; u.nv = pm; }
        else { const int r = l - n1; int pm, pn; tile_map(r, NMT, 4, pm, pn); u.pm = 2 * NMT + pm; u.pn = 16 + pn; u.e = 2; u.nv = pm; }
        u.par = 0; return true; }
    __device__ __forceinline__ void a_ready(const Unit&) const {}
    __device__ __forceinline__ void done(const Unit&) const {}
    __device__ __forceinline__ unsigned row_off(const Unit&, int) const { return 0u; }
    __device__ __forceinline__ unsigned row_off_lds(const Unit&, int) const { return 0u; }
    __device__ __forceinline__ void prefetch_rows(const Unit&) const {}
};
struct SchedMoe {
    int G, c, nnt, ntiles, P; LAS unsigned char* lds; const int* slotl; const float* gatel; int wave;
    __device__ __forceinline__ bool next(int i, Unit& u) const { const long L = (long)i * G + c; const int ntp = (ntiles + P - 1) / P, ppg = nnt / (8 / P); if (L >= (long)ntp * ppg * 8) return false;
        const LAS int* tpre = (const LAS int*)(lds + LDSCTL_OFF + 64); const LAS int* ecnt = (const LAS int*)(lds + LDSCTL_OFF + 256); const LAS unsigned short* tile_e = (const LAS unsigned short*)(lds + LDSCTL_OFF + 512);
        const int xq = (int)(L >> 3), x8 = (int)(L & 7); int tile = (xq / ppg) * P + (x8 % P); const int pnl = (x8 / P) * ppg + xq % ppg; const bool dead = tile >= ntiles; tile = dead ? 0 : tile;
        const int e = __builtin_amdgcn_readfirstlane((int)tile_e[tile]), r0 = (tile - __builtin_amdgcn_readfirstlane(tpre[e])) * 256; int nv = __builtin_amdgcn_readfirstlane(ecnt[e]) - r0; nv = nv > 256 ? 256 : nv; nv = dead ? 0 : nv;
        u.pm = dead ? MAXTILES : tile; u.pn = e * nnt + pnl; u.e = e; u.nv = nv | (r0 << 9); u.par = i & 1; return true; }
    __device__ __forceinline__ void a_ready(const Unit& u) const {
        if (gatel != nullptr && wave == 0) { const size_t li = (size_t)u.e * T + (u.nv >> 9) + 4 * lane_id();
            __builtin_amdgcn_global_load_lds((const unsigned*)(slotl + li), (LAS unsigned*)(lds + LDSCTL_OFF + 8192 + 2048 * u.par), 16, 0, 0);
            __builtin_amdgcn_global_load_lds((const unsigned*)(gatel + li), (LAS unsigned*)(lds + LDSCTL_OFF + 8192 + 2048 * u.par + 1024), 16, 0, 0); } }
    __device__ __forceinline__ void done(const Unit&) const {}
    __device__ __forceinline__ void prefetch_rows(const Unit& u) const {
        if (wave == 0) __builtin_amdgcn_global_load_lds((const unsigned*)(slotl + (size_t)u.e * T + (u.nv >> 9) + 4 * lane_id()), (LAS unsigned*)(lds + LDSCTL_OFF + 8192 + 2048 * u.par), 16, 0, 0); }
    __device__ __forceinline__ unsigned row_off_lds(const Unit& u, int r) const { const int nv = u.nv & 511; const int sl = ((const LAS int*)(lds + LDSCTL_OFF + 8192 + 2048 * u.par))[r]; const int tok = r < nv ? (sl >> 2) : 0; return (unsigned)tok * 2048u; }
    __device__ __forceinline__ unsigned row_off(const Unit& u, int r) const { const int nv = u.nv & 511, r0 = u.nv >> 9; const int tok = r < nv ? (slotl[(size_t)u.e * T + r0 + r] >> 2) : 0; return (unsigned)tok * 2048u; }
};

using pg8::cvt_pk_bf16;
template <class P> __device__ __forceinline__ P* pin_ptr(P* p) { asm volatile("" : "+v"(p)); return p; }
struct EpiB1 {
    static constexpr bool PERM = true, AFTER_DRAIN = false;
    bf16* RKV; bf16* L1;
    __device__ __forceinline__ void operator()(const f32x4 (&acc)[2][2][4][2], const Unit& u, int wr, int wc, int fr, int fq) const {
        const int seg = u.e, row0 = u.nv * 256 + wr * 64 + fr;
        const int jj = seg - 3, ld = seg < 3 ? D : 128, col0 = (seg < 3 ? (u.pn - seg * 4) * 256 : 0) + wc * 32 + 8 * fq;
        bf16* base = seg < 3 ? RKV + (size_t)seg * T * D : L1 + (size_t)jj * T * 128;
#pragma unroll
        for (int ai = 0; ai < 2; ++ai)
#pragma unroll
            for (int m = 0; m < 4; ++m) { bf16* rowp = base + (size_t)(row0 + ai * 128 + m * 16) * ld + col0;
#pragma unroll
                for (int bj = 0; bj < 2; ++bj) { if (seg >= 3 && bj == 1) continue; f32x4 v0 = acc[ai][bj][m][0], v1 = acc[ai][bj][m][1];
                    if (jj == 0) {
#pragma unroll
                        for (int q = 0; q < 4; ++q) { v0[q] = tanh_fast(v0[q]); v1[q] = tanh_fast(v1[q]); } }
                    else if (jj == 2) {
#pragma unroll
                        for (int q = 0; q < 4; ++q) { v0[q] = sigm(v0[q]); v1[q] = sigm(v1[q]); } }
                    u32x4 w; w.x = cvt_pk_bf16(v0[0], v0[1]); w.y = cvt_pk_bf16(v0[2], v0[3]); w.z = cvt_pk_bf16(v1[0], v1[1]); w.w = cvt_pk_bf16(v1[2], v1[3]);
                    *(u32x4*)(rowp + bj * 128) = w; } }
    }
};
struct EpiB2 {
    static constexpr bool PERM = true, AFTER_DRAIN = false;
    bf16* RW; bf16* RA; bf16* Gg;
    __device__ __forceinline__ void operator()(const f32x4 (&acc)[2][2][4][2], const Unit& u, int wr, int wc, int fr, int fq) const {
        const int jj = u.e, row0 = u.nv * 256 + wr * 64 + fr, pnl = u.pn - jj * 8;
        const int dirn = jj < 2 ? (pnl >> 2) : 0, col0 = (jj < 2 ? (pnl & 3) : pnl) * 256 + wc * 32 + 8 * fq;
        bf16* base = (jj == 0 ? RW : jj == 1 ? RA : Gg) + (size_t)dirn * T * D;
#pragma unroll
        for (int ai = 0; ai < 2; ++ai)
#pragma unroll
            for (int m = 0; m < 4; ++m) { bf16* rowp = base + (size_t)(row0 + ai * 128 + m * 16) * D + col0;
#pragma unroll
                for (int bj = 0; bj < 2; ++bj) { const f32x4 v0 = acc[ai][bj][m][0], v1 = acc[ai][bj][m][1];
                    u32x4 w; w.x = cvt_pk_bf16(v0[0], v0[1]); w.y = cvt_pk_bf16(v0[2], v0[3]); w.z = cvt_pk_bf16(v1[0], v1[1]); w.w = cvt_pk_bf16(v1[2], v1[3]);
                    *(u32x4*)(rowp + bj * 128) = w; } }
    }
};
struct EpiRes {
    static constexpr bool PERM = true, AFTER_DRAIN = false;
    float* X; const float* gate; float* Xo;
    __device__ __forceinline__ void operator()(const f32x4 (&acc)[2][2][4][2], const Unit& u, int wr, int wc, int fr, int fq) const {
        const int row0 = u.pm * 256 + wr * 64 + fr, col0 = u.pn * 256 + wc * 32 + 8 * fq, mr = u.pm < NMT_L ? (u.pm >> 5) : 4;
        const float* gp = pin_ptr(gate + (size_t)mr * 6144 + col0);
        f32x4 gv[2][2];
#pragma unroll
        for (int bj = 0; bj < 2; ++bj)
#pragma unroll
            for (int n = 0; n < 2; ++n) gv[bj][n] = *(const f32x4*)(gp + bj * 128 + 4 * n);
        f32x4 xa[2][2][2], xb[2][2][2];
#define ER_LOAD(dst, b_) do { _Pragma("unroll") for (int m = 0; m < 2; ++m) _Pragma("unroll") for (int bj = 0; bj < 2; ++bj) _Pragma("unroll") for (int n = 0; n < 2; ++n) \
            dst[m][bj][n] = *(const f32x4*)(X + (size_t)(row0 + ((b_) >> 1) * 128 + (((b_) & 1) * 2 + m) * 16) * D + col0 + bj * 128 + 4 * n); } while (0)
#define ER_STORE(src, b_) do { _Pragma("unroll") for (int m = 0; m < 2; ++m) _Pragma("unroll") for (int bj = 0; bj < 2; ++bj) _Pragma("unroll") for (int n = 0; n < 2; ++n) \
            *(f32x4*)(Xo + (size_t)(row0 + ((b_) >> 1) * 128 + (((b_) & 1) * 2 + m) * 16) * D + col0 + bj * 128 + 4 * n) = src[m][bj][n] + gv[bj][n] * acc[(b_) >> 1][bj][((b_) & 1) * 2 + m][n]; } while (0)
        ER_LOAD(xa, 0); ER_LOAD(xb, 1); ER_STORE(xa, 0); ER_LOAD(xa, 2); ER_STORE(xb, 1); ER_LOAD(xb, 3); ER_STORE(xa, 2); ER_STORE(xb, 3);
#undef ER_LOAD
#undef ER_STORE
    }
};
struct EpiWin {
    static constexpr bool PERM = true, AFTER_DRAIN = false;
    bf16* BG; bf16* CU;
    __device__ __forceinline__ void operator()(const f32x4 (&acc)[2][2][4][2], const Unit& u, int wr, int wc, int fr, int fq) const {
        const int row0 = u.pm * 256 + wr * 64 + fr;
        if (u.pn < 4) {
            const int col0 = u.pn * 256 + wc * 32 + 8 * fq;
#pragma unroll
            for (int ai = 0; ai < 2; ++ai)
#pragma unroll
                for (int m = 0; m < 4; ++m) { bf16* rowp = BG + (size_t)(row0 + ai * 128 + m * 16) * D + col0;
#pragma unroll
                    for (int bj = 0; bj < 2; ++bj) { const f32x4 v0 = acc[ai][bj][m][0], v1 = acc[ai][bj][m][1];
                        u32x4 w; w.x = cvt_pk_bf16(v0[0], v0[1]); w.y = cvt_pk_bf16(v0[2], v0[3]); w.z = cvt_pk_bf16(v1[0], v1[1]); w.w = cvt_pk_bf16(v1[2], v1[3]);
                        *(u32x4*)(rowp + bj * 128) = w; } }
        } else {
            const int f0 = (u.pn - 4) * 128 + wc * 32 + 8 * fq;
#pragma unroll
            for (int ai = 0; ai < 2; ++ai)
#pragma unroll
                for (int m = 0; m < 4; ++m) { const f32x4 v0 = acc[ai][0][m][0] * acc[ai][1][m][0], v1 = acc[ai][0][m][1] * acc[ai][1][m][1];
                    u32x4 w; w.x = cvt_pk_bf16(v0[0], v0[1]); w.y = cvt_pk_bf16(v0[2], v0[3]); w.z = cvt_pk_bf16(v1[0], v1[1]); w.w = cvt_pk_bf16(v1[2], v1[3]);
                    *(u32x4*)(CU + (size_t)(row0 + ai * 128 + m * 16) * D + f0) = w; }
        }
    }
};
struct EpiGU {
    static constexpr bool PERM = true, AFTER_DRAIN = false;
    bf16* INTER; const float* bgu;
    __device__ __forceinline__ void operator()(const f32x4 (&acc)[2][2][4][2], const Unit& u, int wr, int wc, int fr, int fq) const {
        const int e = u.e, pnl = u.pn - e * 8, row0 = u.pm * 256 + wr * 64 + fr, f0 = pnl * 128 + wc * 32 + 8 * fq;
        typedef const __attribute__((address_space(1))) f32x4* GF4;
        const GF4 bp = (GF4)pin_ptr(bgu + (size_t)e * 2048 + f0);
        f32x4 bg[2], bu[2];
#pragma unroll
        for (int n = 0; n < 2; ++n) { bg[n] = bp[n]; bu[n] = bp[256 + n] + 1.0f; }
#pragma unroll
        for (int ai = 0; ai < 2; ++ai)
#pragma unroll
            for (int m = 0; m < 4; ++m) { f32x4 o[2];
#pragma unroll
                for (int n = 0; n < 2; ++n) { const f32x4 g = acc[ai][0][m][n] + bg[n], uu = acc[ai][1][m][n] + bu[n];
#pragma unroll
                    for (int q = 0; q < 4; ++q) { const float gc = fminf(g[q], 7.0f), uc1 = fminf(fmaxf(uu[q], -6.0f), 8.0f);
                        o[n][q] = uc1 * gc * frcp(1.0f + __builtin_amdgcn_exp2f(gc * (-1.702f * 1.44269504f))); } }
                u32x4 w; w.x = cvt_pk_bf16(o[0][0], o[0][1]); w.y = cvt_pk_bf16(o[0][2], o[0][3]); w.z = cvt_pk_bf16(o[1][0], o[1][1]); w.w = cvt_pk_bf16(o[1][2], o[1][3]);
                *(u32x4*)(INTER + (size_t)(row0 + ai * 128 + m * 16) * 1024 + f0) = w; }
    }
};
struct EpiDown {
    static constexpr bool PERM = true, AFTER_DRAIN = false;
    bf16* YS; const float* bdn; LAS unsigned char* lds;
    __device__ __forceinline__ void operator()(const f32x4 (&acc)[2][2][4][2], const Unit& u, int wr, int wc, int fr, int fq) const {
        const int e = u.e, pnl = u.pn - e * 4, col0 = pnl * 256 + wc * 32 + 8 * fq, nv = u.nv & 511;
        typedef const __attribute__((address_space(1))) f32x4* GF4;
        const GF4 bp = (GF4)pin_ptr(bdn + (size_t)e * 1024 + col0);
        f32x4 bv[2][2];
#pragma unroll
        for (int bj = 0; bj < 2; ++bj)
#pragma unroll
            for (int n = 0; n < 2; ++n) bv[bj][n] = bp[bj * 32 + n];
        const LAS int* sl = (const LAS int*)(lds + LDSCTL_OFF + 8192 + 2048 * u.par);
        int slot8[2][4]; float gt8[2][4];
#pragma unroll
        for (int ai = 0; ai < 2; ++ai)
#pragma unroll
            for (int m = 0; m < 4; ++m) { const int r = ai * 128 + wr * 64 + m * 16 + fr; slot8[ai][m] = sl[r]; gt8[ai][m] = ((const LAS float*)(sl + 256))[r]; }
#pragma unroll
        for (int ai = 0; ai < 2; ++ai) asm volatile("" : "+v"(slot8[ai][0]), "+v"(slot8[ai][1]), "+v"(slot8[ai][2]), "+v"(slot8[ai][3]), "+v"(gt8[ai][0]), "+v"(gt8[ai][1]), "+v"(gt8[ai][2]), "+v"(gt8[ai][3]));
        asm volatile("" : "+v"(bv[0][0]), "+v"(bv[0][1]), "+v"(bv[1][0]), "+v"(bv[1][1]));
#pragma unroll
        for (int ai = 0; ai < 2; ++ai)
#pragma unroll
            for (int m = 0; m < 4; ++m) { const int r = ai * 128 + wr * 64 + m * 16 + fr;
                if (r < nv) { const int slot = slot8[ai][m]; const float gt = gt8[ai][m];
                    bf16* rowp = YS + (size_t)slot * 1024 + col0;
#pragma unroll
                    for (int bj = 0; bj < 2; ++bj) { const f32x4 v0 = (acc[ai][bj][m][0] + bv[bj][0]) * gt, v1 = (acc[ai][bj][m][1] + bv[bj][1]) * gt;
                        u32x4 w; w.x = cvt_pk_bf16(v0[0], v0[1]); w.y = cvt_pk_bf16(v0[2], v0[3]); w.z = cvt_pk_bf16(v1[0], v1[1]); w.w = cvt_pk_bf16(v1[2], v1[3]);
                        *(u32x4*)(rowp + bj * 128) = w; } } }
    }
};

__device__ __forceinline__ int moe_tables(const unsigned* cnt, LAS unsigned char* lds, int tid) {
    LAS int* tpre = (LAS int*)(lds + LDSCTL_OFF + 64); LAS int* ecnt = (LAS int*)(lds + LDSCTL_OFF + 256); LAS unsigned short* tile_e = (LAS unsigned short*)(lds + LDSCTL_OFF + 512);
    if (tid == 0) { int p = 0; for (int e = 0; e < 32; ++e) { const int cn = (int)__hip_atomic_load(cnt + e * CNT_STRIDE, __ATOMIC_RELAXED, __HIP_MEMORY_SCOPE_AGENT); ecnt[e] = cn; tpre[e] = p; p += (cn + 255) >> 8; } tpre[32] = p; }
    __syncthreads();
    const int nt = tpre[32];
    for (int t = tid; t < nt; t += 512) { int e = 0; while (e < 31 && t >= tpre[e + 1]) ++e; tile_e[t] = (unsigned short)e; }
    __syncthreads();
    return nt;
}

constexpr int NPHASES = 37;
typedef const Args __attribute__((address_space(4))) CArgs;
__global__ void __attribute__((amdgpu_flat_work_group_size(512, 512), amdgpu_waves_per_eu(2, 2))) fwd_kernel(Args a_) {
    extern __shared__ __attribute__((aligned(16))) unsigned char lds_raw[];
    LAS unsigned char* lds = (LAS unsigned char*)lds_raw;
    const int G = gridDim.x, NGW = G * 8;
    CArgs* ap0 = (CArgs*)__builtin_amdgcn_kernarg_segment_ptr();
    if (threadIdx.x < 4) ((LAS unsigned*)(lds + LDSCTL_OFF))[threadIdx.x] = 0u;
    __syncthreads();
    XcdBarrier bar = xcd_barrier_post((unsigned*)(a_.ws + WS_CTL) + CW_BAR, (volatile LAS unsigned*)(lds + LDSCTL_OFF));
    const int lo = a_.ph_lo, hi = a_.ph_hi;
    int ph = 0;
#ifndef MK_ONLY
#define MK_ONLY -1
#endif
#ifndef MK_DBL
#define MK_DBL 0
#endif
#ifdef MK_MARK
#define PH_MARK(s) asm volatile("; ##" s)
#else
#define PH_MARK(s)
#endif
#define PH_BEGIN(id) if ((MK_ONLY < 0 || MK_ONLY == (id)) && ph >= lo && ph < hi) { for (int rep_ = 0; rep_ <= ((MK_DBL >> (id)) & 1); ++rep_) { PH_MARK("PH_BEGIN"); CArgs* ap = ap0; asm volatile("" : "+s"(ap)); const Args a = *(const Args*)ap; unsigned char* const ws = a.ws; (void)ws; const int wave = (int)bar.wv; int tid = wave * 64 + lane_id(); asm volatile("" : "+v"(tid)); const int lane = tid & 63, gw = blockIdx.x * 8 + wave; (void)lane; (void)gw;
#define PH_END PH_MARK("PH_END"); } } if (ph >= lo && ph + 1 < hi) xcd_barrier(bar); ++ph;

    PH_BEGIN(0) p0_prologue(a, lds, tid, lane, wave, G); PH_END

#pragma unroll 1
    for (int layer = 0; layer < DEPTH; ++layer) {
        const int kind = layer & 1, lj = layer >> 1;
        const int rows = layer == 3 ? TL : T, nmt = rows / 256;
        const int rows_moe = layer < 2 ? T : TL;
        if (kind == 0) {
            PH_BEGIN(1) phase_a_rwkv(a, layer, lds, tid, gw, NGW, lane); PH_END
            PH_BEGIN(2) {
                pg8::Gemm g{(const bf16*)(ws + WS_XL), (const bf16*)(ws + WS_WRKV) + (size_t)lj * 3840 * 1024, 6 * T, 3840, 1024};
                SchedB1 S{G, (int)blockIdx.x}; EpiB1 E{(bf16*)(ws + WS_RKV), (bf16*)(ws + WS_L1)};
                pg8::gemm_phase<EpiB1, SchedB1, true, true, false>(lds, g, S, E, tid); } PH_END
            PH_BEGIN(3) {
                pg8::Gemm g{(const bf16*)(ws + WS_L1), (const bf16*)(ws + WS_L2T) + (size_t)lj * 5120 * 128, 3 * T, 5120, 128};
                SchedB2 S{G, (int)blockIdx.x}; EpiB2 E{(bf16*)(ws + WS_RAWW), (bf16*)(ws + WS_RAWA), (bf16*)(ws + WS_G)};
                pg8::gemm_phase<EpiB2, SchedB2, true, true, false>(lds, g, S, E, tid); } PH_END
            PH_BEGIN(5) phase_s1_chunks(a, lj, lds, tid, G, (MK_DBL >> 5) & 1 & (rep_ == 0)); PH_END
            PH_BEGIN(15) phase_s2_chain(a, wave, lane, G); PH_END
            PH_BEGIN(6) phase_s3_readout(a, lj, layer == 2 ? TL : T, gw, NGW, lane); PH_END
        } else {
            PH_BEGIN(7) phase_a_conv(a, layer, rows, gw, NGW, lane); PH_END
            PH_BEGIN(8) {
                pg8::Gemm g{(const bf16*)(ws + WS_XL), (const bf16*)(ws + WS_WIN) + (size_t)lj * 3072 * 1024, rows, 3072, 1024};
                SchedStd S{G, (int)blockIdx.x, nmt, 12}; EpiWin E{(bf16*)(ws + WS_BG), (bf16*)(ws + WS_CUZ)};
                pg8::gemm_phase<EpiWin, SchedStd, true, true, false>(lds, g, S, E, tid); } PH_END
            PH_BEGIN(9) phase_cv(a, lj, rows, gw, NGW, lane); PH_END
        }
        PH_BEGIN(10) {
            const bf16* Wt = kind == 0 ? (const bf16*)(ws + WS_WO) + (size_t)lj * 1024 * 1024 : (const bf16*)(ws + WS_WOUT) + (size_t)lj * 1024 * 1024;
            pg8::Gemm g{(const bf16*)(ws + WS_Z), Wt, rows, 1024, 1024};
            SchedStd S{G, (int)blockIdx.x, layer == 2 ? NMT_L : nmt, 4}; EpiRes E{(float*)(ws + (layer < 2 ? WS_XSA : WS_XSB)), (const float*)(ws + WS_MODS) + (size_t)layer * 5 * 6144 + 2 * 1024, (float*)(ws + (rep_ ? WS_XL : (layer < 2 ? WS_XSA : WS_XSB)))};
            pg8::gemm_phase<EpiRes, SchedStd, true, true, false>(lds, g, S, E, tid); } PH_END
        PH_BEGIN(11) phase_e_route_mfma(a, layer, rows_moe, lds, tid, wave, gw, NGW, lane, rep_); PH_END
        PH_BEGIN(12) {
            const int nt = __builtin_amdgcn_readfirstlane(moe_tables((const unsigned*)(ws + WS_CTL) + CW_CNT + layer * 32 * CNT_STRIDE, lds, tid));
            pg8::Gemm g{(const bf16*)(ws + WS_H2), (const bf16*)(ws + WS_WGU) + (size_t)layer * 32 * 2048 * 1024, 0, 0, 1024};
            SchedMoe S{G, (int)blockIdx.x, 8, nt, 2, lds, (const int*)(ws + WS_SLOTL), nullptr, wave};
            EpiGU E{(bf16*)(ws + WS_INTER), a.in[30] + (size_t)layer * 32 * 2048};
            pg8::gemm_phase<EpiGU, SchedMoe, true, true, true>(lds, g, S, E, tid); } PH_END
        PH_BEGIN(13) {
            const int nt = __builtin_amdgcn_readfirstlane(moe_tables((const unsigned*)(ws + WS_CTL) + CW_CNT + layer * 32 * CNT_STRIDE, lds, tid));
            pg8::Gemm g{(const bf16*)(ws + WS_INTER), (const bf16*)(ws + WS_WDN) + (size_t)layer * 32 * 1024 * 1024, 0, 0, 1024};
            SchedMoe S{G, (int)blockIdx.x, 4, nt, 8, lds, (const int*)(ws + WS_SLOTL), (const float*)(ws + WS_GATEL), wave};
            EpiDown E{(bf16*)(ws + WS_YS), a.in[32] + (size_t)layer * 32 * 1024, lds};
            pg8::gemm_phase<EpiDown, SchedMoe, true, true, false>(lds, g, S, E, tid); } PH_END
    }
    PH_BEGIN(14) phase_final(a, gw, NGW, lane); PH_END
#undef PH_BEGIN
#undef PH_END
}

extern "C" void kernel_launch(void* const* d_in, const int* in_sizes, int n_in, void* d_out, int out_size, void* d_ws, size_t ws_size, hipStream_t stream) {
    static int grid = 0;
    if (grid == 0) {
        if (n_in != 33 || in_sizes[0] != TL * D || out_size != TL * D || ws_size < WS_END) { fprintf(stderr, "kernel_launch: unexpected problem (n_in %d, in0 %d, out %d, ws %zu < %zu)\n", n_in, n_in > 0 ? in_sizes[0] : -1, out_size, ws_size, (size_t)WS_END); grid = -1; return; }
        int dev = 0, cus = 0, per_cu = 0;
        if (hipGetDevice(&dev) != hipSuccess || hipDeviceGetAttribute(&cus, hipDeviceAttributeMultiprocessorCount, dev) != hipSuccess) { grid = -1; return; }
        if (hipFuncSetAttribute((const void*)fwd_kernel, hipFuncAttributeMaxDynamicSharedMemorySize, LDS_BYTES) != hipSuccess) { fprintf(stderr, "kernel_launch: hipFuncSetAttribute failed\n"); grid = -1; return; }
        if (hipOccupancyMaxActiveBlocksPerMultiprocessor(&per_cu, (const void*)fwd_kernel, 512, LDS_BYTES) != hipSuccess || per_cu < 1) fprintf(stderr, "kernel_launch: occupancy query says %d\n", per_cu);
        (void)hipGetLastError();
        grid = cus;
    }
    if (grid < 0) return;
    if (hipMemsetAsync((char*)d_ws + WS_CTL, 0, CTL_ZERO_BYTES, stream) != hipSuccess) return;
    Args a{};
    for (int i = 0; i < 33; ++i) a.in[i] = (const float*)d_in[i];
    a.out = (float*)d_out; a.ws = (unsigned char*)d_ws;
#if MK_PER_PHASE
    for (int p = 0; p < NPHASES; ++p) { a.ph_lo = p; a.ph_hi = p + 1; hipLaunchKernelGGL(fwd_kernel, dim3(grid), dim3(512), LDS_BYTES, stream, a); }
#else
    a.ph_lo = 0; a.ph_hi = NPHASES;
    hipLaunchKernelGGL(fwd_kernel, dim3(grid), dim3(512), LDS_BYTES, stream, a);
#endif
    const hipError_t le = hipPeekAtLastError();
    if (le != hipSuccess) fprintf(stderr, "kernel_launch: launch failed: %s\n", hipGetErrorName(le));
}
```

```cpp
#include <hip/hip_runtime.h>
#include <cstdio>
#include <cstdint>

#ifndef MK_PER_PHASE
#define MK_PER_PHASE 0
#endif

constexpr int D = 1024, NBATCH = 4, SEQ = 8192, TL = NBATCH * SEQ, CTXL = 256, TC = NBATCH * CTXL, T = TL + TC;
constexpr int NH = 16, HS = 64, NE = 32, TOPK = 4, DEPTH = 4;
constexpr int NMT = T / 256;
constexpr int NMT_L = TL / 256;
constexpr int MAXTILES = (T * TOPK) / 256 + NE;
constexpr int NSTEP = CTXL + SEQ;

__device__ __forceinline__ int lane_id() { return (int)__builtin_amdgcn_mbcnt_hi(~0u, __builtin_amdgcn_mbcnt_lo(~0u, 0u)); }
namespace pg8 {
#define PG8_LAS __attribute__((address_space(3)))
typedef unsigned short bf16_t;
typedef short bf16x8 __attribute__((ext_vector_type(8)));
typedef float f32x4 __attribute__((ext_vector_type(4)));
typedef unsigned u32x4 __attribute__((ext_vector_type(4)));
typedef unsigned u32x2 __attribute__((ext_vector_type(2)));
constexpr int BM = 256, BK = 64, HALF = 128, HTB = HALF * BK * 2  , STAGE_BYTES = 8 * HTB, NXCD = 8, WGM = 8;

__host__ __device__ __forceinline__ int lds_byte(int r, int c) { const int st = (r >> 4) * 2 + (c >> 5), rr = r & 15, cc = c & 31, ob = rr * 64 + cc * 2; return st * 1024 + (ob ^ (((ob >> 9) & 1) << 5)); }
__host__ __device__ __forceinline__ void stage_rc(int b, int& R, int& C) { const int st = b / 1024, sb = b % 1024, swz = sb ^ (((sb >> 9) & 1) << 5); R = (st >> 1) * 16 + swz / 64; C = (st & 1) * 32 + (swz % 64) / 2; }
__host__ __device__ __forceinline__ int perm32(int rho) { const int n = rho >> 4, i = rho & 15; return 8 * (i >> 2) + 4 * n + (i & 3); }

struct Unit { int pm, pn, e, nv, par; };
struct Gemm { const bf16_t* A; const bf16_t* Bt; int M, N, K; };

__device__ __forceinline__ void tile_map(int wgid, int nM, int nN, int& pm, int& pn) {
    const int nwg = nM * nN;
    { const int q = nwg / NXCD, r = nwg % NXCD, xcd = wgid % NXCD, off = wgid / NXCD; wgid = (xcd < r ? xcd * (q + 1) : r * (q + 1) + (xcd - r) * q) + off; }
    const int nig = WGM * nN, gid = wgid / nig, fm = gid * WGM, gsz = (nM - fm) < WGM ? (nM - fm) : WGM;
    pm = fm + ((wgid % nig) % gsz); pn = (wgid % nig) / gsz;
}
typedef __bf16 bf16x2_t __attribute__((ext_vector_type(2)));
typedef float f32x2_t __attribute__((ext_vector_type(2)));
__device__ __forceinline__ unsigned cvt_pk_bf16(float lo, float hi) { const f32x2_t v = {lo, hi}; const bf16x2_t b = __builtin_convertvector(v, bf16x2_t); return __builtin_bit_cast(unsigned, b); }

template <class Epi, class Sched, bool ALIGN_EPI = false, bool SP2 = false, bool GATHER = false>
__device__ __forceinline__ void gemm_phase(PG8_LAS unsigned char* lds, const Gemm g, const Sched& S, const Epi& E, int tid_in) {
    int tid_ = tid_in; asm volatile("" : "+v"(tid_));
    const int tid = tid_, wid = __builtin_amdgcn_readfirstlane(tid >> 6), lane = tid & 63, wr = wid >> 2, wc = wid & 3, fr = lane & 15, fq = lane >> 4;
    int K_ = g.K; asm volatile("" : "+s"(K_));
    const int K = K_, nt = K / BK;
    unsigned voffA[2], voffB[2]; int gR[2]; unsigned gC[2];
#pragma unroll
    for (int i = 0; i < 2; ++i) { int R, C; stage_rc(tid * 16 + i * 8192, R, C); const int Rb = Epi::PERM ? ((R & ~31) + perm32(R & 31)) : R;
        voffA[i] = (unsigned)(R * K + C) * 2u; voffB[i] = (unsigned)(Rb * K + C) * 2u; gR[i] = R; gC[i] = (unsigned)C * 2u; }
    unsigned oc[2][2], on[2][2], o2[2][2];
#pragma unroll
    for (int h = 0; h < 2; ++h)
#pragma unroll
        for (int i = 0; i < 2; ++i) { oc[h][i] = 0u; on[h][i] = 0u; o2[h][i] = 0u; }
    const size_t kstep = (size_t)(BK * 2);
    const size_t hstep = (size_t)HALF * K * 2;
    const size_t tstep = 2 * hstep;
    const unsigned ldsw = (unsigned)wid * 1024u;
    const int aoff = lds_byte(wr * 64 + fr, fq * 8), boff = lds_byte(wc * 32 + fr, fq * 8);
#define PG8_SA(b, h) (((b) * 2 + (h)) * HTB)
#define PG8_SB(b, h) ((4 + (b) * 2 + (h)) * HTB)
#define PG8_STAGE(bufoff, gbase, voff) do { _Pragma("unroll") for (int _i = 0; _i < 2; ++_i) \
        __builtin_amdgcn_global_load_lds((const unsigned*)((const char*)(gbase) + (voff)[_i]), (PG8_LAS unsigned*)(lds + (bufoff) + ldsw + _i * 8192), 16, 0, 0); } while (0)
#define PG8_STAGE_A(bufoff, base, h, O) do { if constexpr (GATHER) { PG8_STAGE(bufoff, base, (O)[h]); } else { PG8_STAGE(bufoff, (base) + (h) * hstep, voffA); } } while (0)
#define PG8_LDA(dst, b, h) do { _Pragma("unroll") for (int m = 0; m < 4; ++m) _Pragma("unroll") for (int k = 0; k < 2; ++k) dst[m][k] = *(const PG8_LAS bf16x8*)(lds + PG8_SA(b, h) + aoff + m * 2048 + k * 1024); } while (0)
#define PG8_LDB(dst, b, h) do { _Pragma("unroll") for (int n = 0; n < 2; ++n) _Pragma("unroll") for (int k = 0; k < 2; ++k) dst[n][k] = *(const PG8_LAS bf16x8*)(lds + PG8_SB(b, h) + boff + n * 2048 + k * 1024); } while (0)
#define PG8_MMA(ai, bj, At, Bt) do { __builtin_amdgcn_s_setprio(1); _Pragma("unroll") for (int m = 0; m < 4; ++m) _Pragma("unroll") for (int n = 0; n < 2; ++n) _Pragma("unroll") for (int k = 0; k < 2; ++k) \
        acc[ai][bj][m][n] = __builtin_amdgcn_mfma_f32_16x16x32_bf16(Bt[n][k], At[m][k], acc[ai][bj][m][n], 0, 0, 0); __builtin_amdgcn_s_setprio(0); } while (0)
#define PG8_WAIT_V(n) asm volatile("s_waitcnt vmcnt(" #n ")" ::: "memory")
#define PG8_WAIT_L(n) asm volatile("s_waitcnt lgkmcnt(" #n ")" ::: "memory")
#define PG8_BAR __builtin_amdgcn_s_barrier()
#define PG8_SCHED __builtin_amdgcn_sched_barrier(0)
    Unit cur, nxt; int ui = 0;
    if (!S.next(0, cur)) return;
    f32x4 acc[2][2][4][2];
#pragma unroll
    for (int a = 0; a < 2; ++a)
#pragma unroll
        for (int b = 0; b < 2; ++b)
#pragma unroll
            for (int m = 0; m < 4; ++m)
#pragma unroll
                for (int n = 0; n < 2; ++n) acc[a][b][m][n] = (f32x4){0.f, 0.f, 0.f, 0.f};
    bf16x8 At[4][2], B0[2][2], B1[2][2];
    const char* cA = GATHER ? (const char*)g.A : (const char*)g.A + (size_t)cur.pm * tstep; const char* cB = (const char*)g.Bt + (size_t)cur.pn * tstep;
    S.a_ready(cur);
    if constexpr (GATHER) {
#pragma unroll
        for (int h = 0; h < 2; ++h)
#pragma unroll
            for (int i = 0; i < 2; ++i) oc[h][i] = S.row_off(cur, h * HALF + gR[i]) + gC[i];
    }
    if constexpr (SP2) {
        PG8_STAGE(PG8_SB(0, 0), cB, voffB); PG8_STAGE(PG8_SB(0, 1), cB + hstep, voffB); PG8_STAGE_A(PG8_SA(0, 0), cA, 0, oc); PG8_STAGE_A(PG8_SA(0, 1), cA, 1, oc);
        if (wr == 1) PG8_BAR;
        PG8_WAIT_V(2); PG8_BAR;
        PG8_STAGE(PG8_SB(1, 0), cB + kstep, voffB); PG8_STAGE_A(PG8_SA(1, 0), cA + kstep, 0, oc); PG8_STAGE(PG8_SB(1, 1), cB + hstep + kstep, voffB);
        PG8_WAIT_V(6); PG8_BAR;
    } else {
        PG8_STAGE(PG8_SB(0, 0), cB, voffB); PG8_STAGE_A(PG8_SA(0, 0), cA, 0, oc); PG8_STAGE(PG8_SB(0, 1), cB + hstep, voffB); PG8_STAGE_A(PG8_SA(0, 1), cA, 1, oc);
        if (wr == 1) PG8_BAR;
        PG8_WAIT_V(4); PG8_BAR;
        PG8_STAGE(PG8_SB(1, 0), cB + kstep, voffB); PG8_STAGE_A(PG8_SA(1, 0), cA + kstep, 0, oc); PG8_STAGE(PG8_SB(1, 1), cB + hstep + kstep, voffB);
        PG8_WAIT_V(6); PG8_BAR;
    }
    for (;;) {
        const bool has_next = S.next(ui + 1, nxt);
        const char* nA = GATHER ? (const char*)g.A : (has_next ? (const char*)g.A + (size_t)nxt.pm * tstep : cA); const char* nB = has_next ? (const char*)g.Bt + (size_t)nxt.pn * tstep : cB;
        if constexpr (GATHER) { if (has_next) S.prefetch_rows(nxt); }
        for (int t = 0; t < nt; t += 2) {
            const bool last = (t == nt - 2);
            const char* a1 = cA + (size_t)(t + 1) * kstep;
            const char* a2 = last ? nA : cA + (size_t)(t + 2) * kstep; const char* b2 = last ? nB : cB + (size_t)(t + 2) * kstep;
            const char* a3 = a2 + kstep; const char* b3 = b2 + kstep;
            if constexpr (GATHER) {
                if (last) {
#pragma unroll
                    for (int h = 0; h < 2; ++h)
#pragma unroll
                        for (int i = 0; i < 2; ++i) on[h][i] = has_next ? (S.row_off_lds(nxt, h * HALF + gR[i]) + gC[i]) : oc[h][i];
                }
#pragma unroll
                for (int h = 0; h < 2; ++h)
#pragma unroll
                    for (int i = 0; i < 2; ++i) o2[h][i] = last ? on[h][i] : oc[h][i];
            }
            if (last && has_next) S.a_ready(nxt);
            if constexpr (SP2) {
            PG8_LDB(B0, 0, 0); PG8_LDB(B1, 0, 1); PG8_SCHED; PG8_LDA(At, 0, 0); PG8_STAGE_A(PG8_SA(1, 1), a1, 1, oc);
            PG8_WAIT_V(8); PG8_WAIT_L(0); PG8_BAR; PG8_MMA(0, 0, At, B0); PG8_MMA(0, 1, At, B1); PG8_BAR; PG8_SCHED;
            PG8_LDA(At, 0, 1); PG8_STAGE(PG8_SB(0, 0), b2, voffB); PG8_STAGE(PG8_SB(0, 1), b2 + hstep, voffB); PG8_STAGE_A(PG8_SA(0, 0), a2, 0, o2);
            PG8_WAIT_V(8); PG8_WAIT_L(0); PG8_BAR; PG8_MMA(1, 0, At, B0); PG8_MMA(1, 1, At, B1); PG8_BAR; PG8_SCHED;
            PG8_LDB(B0, 1, 0); PG8_LDB(B1, 1, 1); PG8_SCHED; PG8_LDA(At, 1, 0); PG8_STAGE_A(PG8_SA(0, 1), a2, 1, o2);
            PG8_WAIT_V(8); PG8_WAIT_L(0); PG8_BAR; PG8_MMA(0, 0, At, B0); PG8_MMA(0, 1, At, B1); PG8_BAR; PG8_SCHED;
            PG8_LDA(At, 1, 1); PG8_STAGE(PG8_SB(1, 0), b3, voffB); PG8_STAGE(PG8_SB(1, 1), b3 + hstep, voffB); PG8_STAGE_A(PG8_SA(1, 0), a3, 0, o2);
            PG8_WAIT_V(8); PG8_WAIT_L(0); PG8_BAR; PG8_MMA(1, 0, At, B0); PG8_MMA(1, 1, At, B1); PG8_BAR; PG8_SCHED;
            } else {
            PG8_LDB(B0, 0, 0); PG8_SCHED; PG8_LDA(At, 0, 0); PG8_STAGE_A(PG8_SA(1, 1), a1, 1, oc);
            PG8_WAIT_L(8); PG8_BAR; PG8_WAIT_L(0); PG8_MMA(0, 0, At, B0); PG8_BAR; PG8_SCHED;
            PG8_LDB(B1, 0, 1); PG8_STAGE(PG8_SB(0, 0), b2, voffB);
            PG8_BAR; PG8_WAIT_L(0); PG8_MMA(0, 1, At, B1); PG8_BAR;
            PG8_LDA(At, 0, 1); PG8_STAGE_A(PG8_SA(0, 0), a2, 0, o2);
            PG8_BAR; PG8_WAIT_L(0); PG8_MMA(1, 0, At, B0); PG8_BAR; PG8_SCHED;
            PG8_STAGE(PG8_SB(0, 1), b2 + hstep, voffB);
            PG8_WAIT_V(6); PG8_BAR; PG8_MMA(1, 1, At, B1); PG8_BAR;
            PG8_LDB(B0, 1, 0); PG8_SCHED; PG8_LDA(At, 1, 0); PG8_STAGE_A(PG8_SA(0, 1), a2, 1, o2);
            PG8_WAIT_L(8); PG8_BAR; PG8_WAIT_L(0); PG8_MMA(0, 0, At, B0); PG8_BAR; PG8_SCHED;
            PG8_LDB(B1, 1, 1); PG8_STAGE(PG8_SB(1, 0), b3, voffB);
            PG8_BAR; PG8_WAIT_L(0); PG8_MMA(0, 1, At, B1); PG8_BAR;
            PG8_LDA(At, 1, 1); PG8_STAGE_A(PG8_SA(1, 0), a3, 0, o2);
            PG8_BAR; PG8_WAIT_L(0); PG8_MMA(1, 0, At, B0); PG8_BAR; PG8_SCHED;
            PG8_STAGE(PG8_SB(1, 1), b3 + hstep, voffB);
            PG8_WAIT_V(6); PG8_BAR; PG8_MMA(1, 1, At, B1); PG8_BAR;
            }
        }
        if constexpr (ALIGN_EPI) { if (wr == 0) PG8_BAR; }
        if constexpr (!Epi::AFTER_DRAIN) { E(acc, cur, wr, wc, fr, fq); S.done(cur); }
        if (!has_next) break;
#pragma unroll
        for (int a = 0; a < 2; ++a)
#pragma unroll
            for (int b = 0; b < 2; ++b)
#pragma unroll
                for (int m = 0; m < 4; ++m)
#pragma unroll
                    for (int n = 0; n < 2; ++n) acc[a][b][m][n] = (f32x4){0.f, 0.f, 0.f, 0.f};
        cur = nxt; cA = nA; cB = nB; ++ui;
        if constexpr (GATHER) {
#pragma unroll
            for (int h = 0; h < 2; ++h)
#pragma unroll
                for (int i = 0; i < 2; ++i) oc[h][i] = on[h][i];
        }
        if constexpr (ALIGN_EPI) { if (wr == 1) PG8_BAR; }
    }
    PG8_WAIT_V(0);
    if constexpr (!ALIGN_EPI) { if (wr == 0) PG8_BAR; }
    PG8_BAR;
    if constexpr (Epi::AFTER_DRAIN) { E.fused(acc, cur, wr, wc, fr, fq, lds, wid, lane); S.done(cur); }
#undef PG8_SA
#undef PG8_SB
#undef PG8_STAGE
#undef PG8_STAGE_A
#undef PG8_LDA
#undef PG8_LDB
#undef PG8_MMA
#undef PG8_WAIT_V
#undef PG8_WAIT_L
#undef PG8_BAR
#undef PG8_SCHED
}
}

#define LAS __attribute__((address_space(3)))
typedef unsigned short bf16;
typedef float f32x4 __attribute__((ext_vector_type(4)));
typedef unsigned u32x2 __attribute__((ext_vector_type(2)));
typedef unsigned u32x4 __attribute__((ext_vector_type(4)));
#define LDS_WAIT() asm volatile("s_waitcnt lgkmcnt(0)" ::: "memory")
__device__ __forceinline__ unsigned pk2(float lo, float hi) { return pg8::cvt_pk_bf16(lo, hi); }
__device__ __forceinline__ unsigned f2bf(float f) { return pk2(f, f) & 0xffffu; }
__device__ __forceinline__ float bflo(unsigned w) { return __builtin_bit_cast(float, w << 16); }
__device__ __forceinline__ float bfhi(unsigned w) { return __builtin_bit_cast(float, w & 0xffff0000u); }
__device__ __forceinline__ float wave_sum(float v) {
#pragma unroll
    for (int o = 1; o < 64; o <<= 1) v += __shfl_xor(v, o);
    return v;
}
__device__ __forceinline__ float frcp(float x) { return __builtin_amdgcn_rcpf(x); }
__device__ __forceinline__ float sigm(float x) { return frcp(1.0f + __expf(-x)); }
__device__ __forceinline__ float tanh_fast(float x) { const float e = __expf(2.0f * x); return 1.0f - 2.0f * frcp(e + 1.0f); }

constexpr size_t MiB = 1u << 20;
constexpr size_t RF = (size_t)T * D * 4;
constexpr size_t RB = (size_t)T * D * 2;
constexpr size_t WS_CTL = 0, CTL_ZERO_BYTES = 1 * MiB;
constexpr size_t WS_MODS = 1 * MiB;
constexpr size_t WS_XSA = 2 * MiB, WS_XSB = WS_XSA + RF;
constexpr size_t WS_XL = WS_XSB + RF;
constexpr size_t WS_RKV = WS_XL + 6 * RB;
constexpr size_t WS_L1 = WS_RKV + 3 * RF;
constexpr size_t WS_WDEC = WS_L1 + 50 * MiB;
constexpr size_t WS_AA = WS_WDEC + 2 * RF;
constexpr size_t WS_G = WS_AA + 2 * RF;
constexpr size_t WS_KK = WS_G + RB;
constexpr size_t WS_KD = WS_KK + RF;
constexpr size_t WS_BETA = WS_KD + 2 * RF;
constexpr size_t WS_RKB = WS_BETA + 2 * RF;
constexpr size_t WS_C12 = WS_RKB + 3 * MiB;
constexpr size_t WS_WRT = WS_C12 + 6 * MiB;
constexpr size_t WS_Y = WS_C12 + 9 * MiB;
constexpr size_t WS_Z = WS_Y + 2 * RF;
constexpr size_t WS_H2 = WS_Z + RB;
constexpr size_t WS_SLOTL = WS_H2 + RB;
constexpr size_t WS_GATEL = WS_SLOTL + 5 * MiB;
constexpr size_t WS_WRKV = WS_GATEL + 5 * MiB;
constexpr size_t WS_L2T = WS_WRKV + 15 * MiB;
constexpr size_t WS_WO = WS_L2T + 5 * MiB;
constexpr size_t WS_WIN = WS_WO + 4 * MiB;
constexpr size_t WS_WOUT = WS_WIN + 12 * MiB;
constexpr size_t WS_WGU = WS_WOUT + 4 * MiB;
constexpr size_t WS_WDN = WS_WGU + 512 * MiB;
constexpr size_t WS_END = WS_WDN + 256 * MiB;
constexpr size_t WS_INTER = WS_WDEC;
constexpr size_t WS_YS = WS_KD;
constexpr size_t WS_BG = WS_RKV, WS_CUZ = WS_RKV + RB;
constexpr size_t WS_RAWW = WS_AA, WS_RAWA = WS_AA + RF;
constexpr size_t WS_RH = WS_AA;
constexpr size_t WS_PM = WS_WDEC;
constexpr size_t WS_RKB1 = WS_C12 + 1 * MiB;
constexpr size_t WS_QT = WS_XL;
constexpr size_t WS_HT = WS_XL + RF;
static_assert((size_t)128 * 132 * 4096 * 2 <= RF, "chunk state tensors");
static_assert((size_t)MAXTILES * 256 * 1024 * 2 <= 4 * RF, "INTER overlay");
static_assert((size_t)T * 4 * 1024 * 2 <= 2 * RF, "YS overlay");
static_assert((size_t)3 * T * 256 * 2 <= 50 * MiB, "L1OUT");
constexpr int CW_BAR = 4096;
constexpr int CW_CNT = 16384, CNT_STRIDE = 64;

constexpr int RING_BYTES = 131072;
constexpr int LDSCTL_OFF = RING_BYTES + 4096;
constexpr int LDS_BYTES = LDSCTL_OFF + 16384;

struct Args { const float* in[33]; float* out; unsigned char* ws; int ph_lo, ph_hi; };

__device__ __forceinline__ void transpose_item(const float* W, int N, bf16* WT, int dstK, int drow0, int k0, int n0, LAS float* scr, int lane) {
    float tv[64];
    const float* src = W + (size_t)k0 * N + n0 + lane;
#pragma unroll
    for (int i = 0; i < 64; ++i) tv[i] = src[(size_t)i * N];
#pragma unroll
    for (int i = 0; i < 64; ++i) scr[i * 65 + lane] = tv[i];
    LDS_WAIT(); asm volatile("" ::: "memory");
    const int c = lane & 7;
#pragma unroll
    for (int j = 0; j < 8; ++j) { const int n = (lane >> 3) + 8 * j; const LAS float* s = scr + (8 * c) * 65 + n;
        u32x4 o; o.x = pk2(s[0 * 65], s[1 * 65]); o.y = pk2(s[2 * 65], s[3 * 65]); o.z = pk2(s[4 * 65], s[5 * 65]); o.w = pk2(s[6 * 65], s[7 * 65]);
        *(u32x4*)(WT + (size_t)(drow0 + n) * dstK + k0 + 8 * c) = o; }
    LDS_WAIT(); asm volatile("" ::: "memory");
}
__device__ __forceinline__ int gu_map(int n0) { const int bj = n0 >= 1024 ? 1 : 0, f0 = n0 - bj * 1024; return (f0 >> 7) * 256 + bj * 128 + (f0 & 127); }
__device__ __forceinline__ int conv_map(int n0) { if (n0 < 1024) return n0; const int q = (n0 - 1024) >> 10, f0 = (n0 - 1024) & 1023; return 1024 + (f0 >> 7) * 256 + q * 128 + (f0 & 127); }

__device__ __forceinline__ void p0_prologue(const Args& a, LAS unsigned char* lds, int tid, int lane, int wave, int G) {
    unsigned char* ws = a.ws;
    LAS float* sl = (LAS float*)lds;
    LAS float* red = (LAS float*)(lds + 20480);
    for (int i = tid; i < 5 * 1024; i += 512) { const int r = i >> 10, k = i & 1023; const float cv = r < 4 ? a.in[1][r * 1024 + k] : a.in[3][k]; sl[i] = cv * sigm(cv); }
    __syncthreads();
    float* MODS = (float*)(ws + WS_MODS);
    for (int it = blockIdx.x; it < 4 * 96; it += G) {
        const int l = it / 96, n = (it % 96) * 64 + lane;
        const float* W = a.in[4] + (size_t)l * 1024 * 6144 + n;
        float acc[5] = {0.f, 0.f, 0.f, 0.f, 0.f};
        const int kb = wave * 128;
#pragma unroll 8
        for (int k = 0; k < 128; ++k) { const float wv = W[(size_t)(kb + k) * 6144];
#pragma unroll
            for (int r = 0; r < 5; ++r) acc[r] += sl[r * 1024 + kb + k] * wv; }
#pragma unroll
        for (int r = 0; r < 5; ++r) red[(wave * 5 + r) * 64 + lane] = acc[r];
        __syncthreads();
        if (wave < 5) { float s = a.in[5][l * 6144 + n];
#pragma unroll
            for (int w = 0; w < 8; ++w) s += red[(w * 5 + wave) * 64 + lane];
            MODS[(size_t)(l * 5 + wave) * 6144 + n] = s; }
        __syncthreads();
    }
    LAS float* scr = (LAS float*)(lds + wave * 16640);
    static_assert(8 * 16640 <= LDSCTL_OFF, "P0 scratch");
    const int gw = blockIdx.x * 8 + wave, NGW = G * 8;
    bf16* WRKV = (bf16*)(ws + WS_WRKV); bf16* WOt = (bf16*)(ws + WS_WO); bf16* WINt = (bf16*)(ws + WS_WIN); bf16* WOUTt = (bf16*)(ws + WS_WOUT);
    bf16* WGU = (bf16*)(ws + WS_WGU); bf16* WDN = (bf16*)(ws + WS_WDN);
    constexpr int I_GU = 128 * 512, I_DN = 128 * 256, I_RKV = 6 * 256, I_WO = 2 * 256, I_WIN = 2 * 768, I_WOUT = 2 * 256, I_W1 = 4 * 16, I_A1 = 4 * 16, I_G1 = 2 * 32;
    constexpr int NITEMS = I_GU + I_DN + I_RKV + I_WO + I_WIN + I_WOUT + I_W1 + I_A1 + I_G1;
    for (int it = gw; it < NITEMS; it += NGW) {
        int r = it;
        if (r < I_GU) { const int m = r >> 9, q = r & 511, kb = q >> 5, nb = q & 31;
            transpose_item(a.in[29] + (size_t)m * 1024 * 2048, 2048, WGU + (size_t)m * 2048 * 1024, 1024, gu_map(nb * 64), kb * 64, nb * 64, scr, lane); continue; } r -= I_GU;
        if (r < I_DN) { const int m = r >> 8, q = r & 255, kb = q >> 4, nb = q & 15;
            transpose_item(a.in[31] + (size_t)m * 1024 * 1024, 1024, WDN + (size_t)m * 1024 * 1024, 1024, nb * 64, kb * 64, nb * 64, scr, lane); continue; } r -= I_DN;
        if (r < I_RKV) { const int m = r >> 8, q = r & 255, kb = q >> 4, nb = q & 15, lr = m / 3, j = m % 3;
            transpose_item(a.in[9] + (size_t)m * 1024 * 1024, 1024, WRKV + (size_t)lr * 3840 * 1024, 1024, j * 1024 + nb * 64, kb * 64, nb * 64, scr, lane); continue; } r -= I_RKV;
        if (r < I_WO) { const int m = r >> 8, q = r & 255, kb = q >> 4, nb = q & 15;
            transpose_item(a.in[23] + (size_t)m * 1024 * 1024, 1024, WOt + (size_t)m * 1024 * 1024, 1024, nb * 64, kb * 64, nb * 64, scr, lane); continue; } r -= I_WO;
        if (r < I_WIN) { const int m = r / 768, q = r % 768, kb = q / 48, nb = q % 48;
            transpose_item(a.in[24] + (size_t)m * 1024 * 3072, 3072, WINt + (size_t)m * 3072 * 1024, 1024, conv_map(nb * 64), kb * 64, nb * 64, scr, lane); continue; } r -= I_WIN;
        if (r < I_WOUT) { const int m = r >> 8, q = r & 255, kb = q >> 4, nb = q & 15;
            transpose_item(a.in[26] + (size_t)m * 1024 * 1024, 1024, WOUTt + (size_t)m * 1024 * 1024, 1024, nb * 64, kb * 64, nb * 64, scr, lane); continue; } r -= I_WOUT;
        if (r < I_W1) { const int m = r >> 4, kb = r & 15, lr = m >> 1, e = m & 1;
            transpose_item(a.in[11] + (size_t)m * 1024 * 64, 64, WRKV + (size_t)lr * 3840 * 1024, 1024, 3072 + e * 64, kb * 64, 0, scr, lane); continue; } r -= I_W1;
        if (r < I_A1) { const int m = r >> 4, kb = r & 15, lr = m >> 1, e = m & 1;
            transpose_item(a.in[14] + (size_t)m * 1024 * 64, 64, WRKV + (size_t)lr * 3840 * 1024, 1024, 3328 + e * 64, kb * 64, 0, scr, lane); continue; } r -= I_A1;
        { const int m = r >> 5, q = r & 31, kb = q >> 1, nb = q & 1;
            transpose_item(a.in[16] + (size_t)m * 1024 * 128, 128, WRKV + (size_t)m * 3840 * 1024, 1024, 3584 + nb * 64, kb * 64, nb * 64, scr, lane); }
    }
    const int gt = blockIdx.x * 512 + tid, NGT = G * 512;
    for (int i = gt; i < 2 * 3 * 128 * 128; i += NGT) {
        const int pc = i & 127, rw = (i >> 7) & 127, pd = (i >> 14) % 3, lr = i / (3 * 16384);
        *(u32x4*)(WRKV + ((size_t)lr * 3840 + 3072 + pd * 256 + 128 + rw) * 1024 + pc * 8) = (u32x4){0u, 0u, 0u, 0u}; }
    bf16* L2T = (bf16*)(ws + WS_L2T);
    for (int i = gt; i < 2 * 128 * 5120; i += NGT) {
        const int n = i % 5120, k = (i / 5120) & 127, lr = i / (5120 * 128);
        float v = 0.f;
        if (n < 2048) { const int e = n >> 10, d = n & 1023; if ((k >> 6) == e) v = a.in[12][(((size_t)lr * 2 + e) * 64 + (k & 63)) * 1024 + d]; }
        else if (n < 4096) { const int e = (n - 2048) >> 10, d = n & 1023; if ((k >> 6) == e) v = a.in[15][(((size_t)lr * 2 + e) * 64 + (k & 63)) * 1024 + d]; }
        else { const int d = n - 4096; v = a.in[17][((size_t)lr * 128 + k) * 1024 + d]; }
        L2T[((size_t)lr * 5120 + n) * 128 + k] = (bf16)f2bf(v);
    }
    bf16* WRT = (bf16*)(ws + WS_WRT);
    for (int i = gt; i < 4 * 32 * 1024; i += NGT) { const int k = i & 1023, e = (i >> 10) & 31, l = i >> 15;
        const float w = a.in[27][((size_t)l * 1024 + k) * 32 + e]; const unsigned hi = f2bf(w); const float lo = w - bflo(hi);
        WRT[((size_t)(l * 2 + 0) * 32 + e) * 1024 + k] = (bf16)hi; WRT[((size_t)(l * 2 + 1) * 32 + e) * 1024 + k] = (bf16)f2bf(lo); }
}
#define XB_TMO      128
#define XB_XCNT(j)  (256  + 64 * (j))
#define XB_XSUB(j)  (1280 + 64 * (j))
#define XB_XGEN(j)  (2304 + 64 * (j))
#define XB_TOP      3328
#define XB_TOPGEN   3392
#define XCD_BAR_WORDS 3456
#define XB_SPIN_CAP (1u << 23)

__device__ __forceinline__ unsigned xb_ld(unsigned* p)              { return __hip_atomic_load(p, __ATOMIC_RELAXED, __HIP_MEMORY_SCOPE_AGENT); }
__device__ __forceinline__ unsigned xb_add(unsigned* p, unsigned v) { return __hip_atomic_fetch_add(p, v, __ATOMIC_RELAXED, __HIP_MEMORY_SCOPE_AGENT); }
__device__ __forceinline__ unsigned xb_xcc_id() { return (unsigned)__builtin_amdgcn_s_getreg((3 << 11) | 20) & 0xFu; }
#define XB_SPIN(cond, bar) do { unsigned _sp = 0; while (cond) { __builtin_amdgcn_s_sleep(1); \
    if ((++_sp & 255u) == 0u) { if (xb_ld(&(bar)[XB_TMO])) break; if (_sp > XB_SPIN_CAP) { atomicAdd(&(bar)[XB_TMO], 1u); break; } } } } while (0)

struct XcdBarrier {
    unsigned wv;
    unsigned* bar; unsigned x;
    volatile LAS unsigned* st;
};

__device__ __forceinline__ XcdBarrier xcd_barrier_post(unsigned* bar, volatile LAS unsigned* st) {
    XcdBarrier b; b.wv = (unsigned)__builtin_amdgcn_readfirstlane((int)(threadIdx.x >> 6)); b.bar = bar; b.x = xb_xcc_id(); b.st = st;
    if (threadIdx.x == 0) (void)xb_add(&bar[XB_XCNT(b.x)], 1u);
    return b;
}
__device__ __forceinline__ void xcd_barrier_complete(unsigned* bar, unsigned x, unsigned& nloc, unsigned& nx) {
    const unsigned G = gridDim.x * gridDim.y * gridDim.z;
    unsigned sum, cnt, mine, sp = 0u;
    for (;;) {
        sum = 0u; cnt = 0u; mine = 0u;
#pragma unroll
        for (unsigned j = 0; j < 16; ++j) { const unsigned c = xb_ld(&bar[XB_XCNT(j)]); sum += c; cnt += (c > 0u) ? 1u : 0u; mine = (j == x) ? c : mine; }
        if (sum == G) break;
        __builtin_amdgcn_s_sleep(1);
        if ((++sp & 255u) == 0u) { if (xb_ld(&bar[XB_TMO])) break; if (sp > XB_SPIN_CAP) { atomicAdd(&bar[XB_TMO], 1u); break; } }
    }
    nloc = mine > 0u ? mine : 1u; nx = cnt > 0u ? cnt : 1u;
}

__device__ __forceinline__ void xcd_barrier(const XcdBarrier& b) {
    asm volatile("s_waitcnt vmcnt(0)" ::: "memory");
    __syncthreads();
    if (b.wv == 0u && lane_id() == 0) {
        unsigned* bar = b.bar;
        __builtin_amdgcn_s_waitcnt(0);
        unsigned nloc = b.st[0], nx = b.st[1];
        if (nloc == 0u) { xcd_barrier_complete(bar, b.x, nloc, nx); b.st[0] = nloc; b.st[1] = nx; }
        const unsigned old = xb_add(&bar[XB_XSUB(b.x)], 1u);
        const unsigned gen = old / nloc;
        if (old + 1u == (gen + 1u) * nloc) {
            __builtin_amdgcn_fence(__ATOMIC_RELEASE, "agent");
            asm volatile("s_waitcnt vmcnt(0)" ::: "memory");
            const unsigned og = xb_add(&bar[XB_TOP], 1u);
            const unsigned tg = og / nx;
            if (og + 1u == (tg + 1u) * nx) xb_add(&bar[XB_TOPGEN], 1u);
            else XB_SPIN(xb_ld(&bar[XB_TOPGEN]) == tg, bar);
            __builtin_amdgcn_fence(__ATOMIC_ACQUIRE, "agent");
            xb_add(&bar[XB_XGEN(b.x)], 1u);
            asm volatile("s_waitcnt vmcnt(0)" ::: "memory");
        } else {
            XB_SPIN(xb_ld(&bar[XB_XGEN(b.x)]) == gen, bar);
            __builtin_amdgcn_fence(__ATOMIC_ACQUIRE, "agent");
            asm volatile("s_waitcnt vmcnt(0)" ::: "memory");
        }
    }
    __syncthreads();
}

__device__ __forceinline__ f32x4 bf4(u32x2 w) { return (f32x4){bflo(w.x), bfhi(w.x), bflo(w.y), bfhi(w.y)}; }
__device__ __forceinline__ int mod_row(int row) { return row < TL ? (row >> 13) : 4; }

__device__ __forceinline__ void load_x_combined(f32x4 (&x)[4], const float* xrow, bool has_prev, const bf16* YS, int t, const f32x4 (&m5)[4], int lane) {
#pragma unroll
    for (int j = 0; j < 4; ++j) x[j] = *(const f32x4*)(xrow + 256 * j + 4 * lane);
    if (has_prev) {
        u32x2 y[4][4];
#pragma unroll
        for (int k = 0; k < 4; ++k)
#pragma unroll
            for (int j = 0; j < 4; ++j) y[k][j] = *(const u32x2*)(YS + ((size_t)t * 4 + k) * 1024 + 256 * j + 4 * lane);
#pragma unroll
        for (int j = 0; j < 4; ++j) { const f32x4 s = (bf4(y[0][j]) + bf4(y[1][j])) + (bf4(y[2][j]) + bf4(y[3][j])); x[j] += m5[j] * s; }
    }
}
__device__ __forceinline__ float row_rstd(const f32x4 (&x)[4]) {
    float ss = 0.f;
#pragma unroll
    for (int j = 0; j < 4; ++j) ss += (x[j].x * x[j].x + x[j].y * x[j].y) + (x[j].z * x[j].z + x[j].w * x[j].w);
    return rsqrtf(wave_sum(ss) * (1.0f / 1024.0f) + 1e-6f);
}

__device__ __forceinline__ void phase_a_rwkv(const Args& a, int layer, LAS unsigned char* lds, int tid, int gw, int NGW, int lane) {
    unsigned char* ws = a.ws; const int lj = layer >> 1; const bool has_prev = layer > 0;
    const float* xin_lat = layer == 0 ? a.in[0] : (const float*)(ws + WS_XSA);
    const float* xin_ctx = layer == 0 ? a.in[2] : (const float*)(ws + WS_XSA) + (size_t)TL * D;
    float* xout = (float*)(ws + (layer == 0 ? WS_XSA : WS_XSB));
    const float* MODS = (const float*)(ws + WS_MODS); const bf16* YS = (const bf16*)(ws + WS_YS); bf16* XL = (bf16*)(ws + WS_XL);
    const float* mug = a.in[8] + (size_t)lj * 6 * 2 * 1024; const float* ng = a.in[6] + (size_t)(layer * 2 + 0) * 1024;
    LAS float* mu = (LAS float*)lds;
    for (int i = tid; i < 6 * 2 * 1024 / 4; i += 512) ((LAS f32x4*)mu)[i] = ((const f32x4*)mug)[i];
    __syncthreads();
    for (int it = gw; it < TL / 8 + TC / 2; it += NGW) {
        const int ntok = it < TL / 8 ? 8 : 2, t0 = it < TL / 8 ? it * 8 : TL + (it - TL / 8) * 2, mr = mod_row(t0);
        int rs, re; if (t0 < TL) { rs = t0 & ~63; re = rs + 63; } else { const int loc = t0 - TL; rs = TL + (loc & ~255); re = rs + 255; }
        const float* mod = MODS + (size_t)(layer * 5 + mr) * 6144;
        const float* m5p = MODS + (size_t)((has_prev ? layer - 1 : 0) * 5 + mr) * 6144 + 5 * 1024;
        f32x4 hm[4], h0[4], hp[4];
#pragma unroll
        for (int j = 0; j < 4; ++j) { hm[j] = (f32x4){0.f, 0.f, 0.f, 0.f}; h0[j] = hm[j]; hp[j] = hm[j]; }
        f32x4 rx[4], nx[4]; u32x2 ry[4][4], ny[4][4];
#define PA_LOAD(X, Y, tt) do { const int t_ = (tt); if (t_ >= rs && t_ <= re) { \
            const float* xrow_ = t_ < TL ? xin_lat + (size_t)t_ * D : xin_ctx + (size_t)(t_ - TL) * D; \
            _Pragma("unroll") for (int j = 0; j < 4; ++j) X[j] = *(const f32x4*)(xrow_ + 256 * j + 4 * lane); \
            if (has_prev) { _Pragma("unroll") for (int k = 0; k < 4; ++k) _Pragma("unroll") for (int j = 0; j < 4; ++j) Y[k][j] = *(const u32x2*)(YS + ((size_t)t_ * 4 + k) * 1024 + 256 * j + 4 * lane); } } } while (0)
#pragma unroll
        for (int j = 0; j < 4; ++j) { rx[j] = (f32x4){0.f, 0.f, 0.f, 0.f}; nx[j] = rx[j];
#pragma unroll
            for (int k = 0; k < 4; ++k) { ry[k][j] = (u32x2){0u, 0u}; ny[k][j] = ry[k][j]; } }
        PA_LOAD(rx, ry, t0 - 1);
        f32x4 gsc[4], sh4[4], m5v[4];
#pragma unroll
        for (int j = 0; j < 4; ++j) { const int col = 256 * j + 4 * lane; gsc[j] = *(const f32x4*)(ng + col) * (*(const f32x4*)(mod + 1024 + col) + 1.0f); sh4[j] = *(const f32x4*)(mod + col); m5v[j] = *(const f32x4*)(m5p + col); }
#pragma unroll
        for (int j = 0; j < 4; ++j) asm volatile("" : "+v"(gsc[j]), "+v"(sh4[j]), "+v"(m5v[j]), "+v"(rx[j]));
#pragma unroll 1
        for (int i = -1; i <= ntok; ++i) {
            const int t = t0 + i;
            if (i < ntok) PA_LOAD(nx, ny, t + 1);
            f32x4 hn[4];
            if (t >= rs && t <= re) {
                f32x4 x[4];
#pragma unroll
                for (int j = 0; j < 4; ++j) x[j] = rx[j];
                if (has_prev) {
#pragma unroll
                    for (int j = 0; j < 4; ++j) { f32x4 sm = (f32x4){0.f, 0.f, 0.f, 0.f};
#pragma unroll
                        for (int k = 0; k < 4; ++k) sm += (f32x4){bflo(ry[k][j].x), bfhi(ry[k][j].x), bflo(ry[k][j].y), bfhi(ry[k][j].y)};
                        x[j] += m5v[j] * sm; } }
                if (i >= 0 && i < ntok) {
#pragma unroll
                    for (int j = 0; j < 4; ++j) *(f32x4*)(xout + (size_t)t * D + 256 * j + 4 * lane) = x[j]; }
                const float rstd = row_rstd(x);
#pragma unroll
                for (int j = 0; j < 4; ++j) hn[j] = x[j] * rstd * gsc[j] + sh4[j];
            } else {
#pragma unroll
                for (int j = 0; j < 4; ++j) hn[j] = (f32x4){0.f, 0.f, 0.f, 0.f};
            }
#pragma unroll
            for (int j = 0; j < 4; ++j) { hm[j] = h0[j]; h0[j] = hp[j]; hp[j] = hn[j]; rx[j] = nx[j];
#pragma unroll
                for (int k = 0; k < 4; ++k) ry[k][j] = ny[k][j]; }
            if (i >= 1) {
                const int te = t - 1;
#pragma unroll
                for (int q = 0; q < 6; ++q) {
                    bf16* orow = XL + ((size_t)q * T + te) * D;
#pragma unroll
                    for (int j = 0; j < 4; ++j) { const int col = 256 * j + 4 * lane;
                        const f32x4 m0 = *(const LAS f32x4*)(mu + (q * 2 + 0) * 1024 + col), m1 = *(const LAS f32x4*)(mu + (q * 2 + 1) * 1024 + col);
                        const f32x4 o = h0[j] + m0 * (hm[j] - h0[j]) + m1 * (hp[j] - h0[j]);
                        u32x2 w; w.x = pk2(o.x, o.y); w.y = pk2(o.z, o.w); *(u32x2*)(orow + col) = w; }
                }
            }
        }
#undef PA_LOAD
    }
}
__device__ __forceinline__ void phase_a_conv(const Args& a, int layer, int rows, int gw, int NGW, int lane) {
    unsigned char* ws = a.ws;
    float* xs = (float*)(ws + (layer < 2 ? WS_XSA : WS_XSB));
    const float* MODS = (const float*)(ws + WS_MODS); const bf16* YS = (const bf16*)(ws + WS_YS); bf16* H = (bf16*)(ws + WS_XL);
    const float* ng = a.in[6] + (size_t)(layer * 2 + 0) * 1024;
    for (int t = gw; t < rows; t += NGW) {
        const int mr = mod_row(t);
        const float* mod = MODS + (size_t)(layer * 5 + mr) * 6144;
        f32x4 m5[4], x[4];
#pragma unroll
        for (int j = 0; j < 4; ++j) m5[j] = *(const f32x4*)(MODS + (size_t)((layer - 1) * 5 + mr) * 6144 + 5 * 1024 + 256 * j + 4 * lane);
        f32x4 gsc[4], sh4[4], ngv[4];
#pragma unroll
        for (int j = 0; j < 4; ++j) { const int col = 256 * j + 4 * lane; ngv[j] = *(const f32x4*)(ng + col); gsc[j] = *(const f32x4*)(mod + 1024 + col); sh4[j] = *(const f32x4*)(mod + col); }
        load_x_combined(x, xs + (size_t)t * D, true, YS, t, m5, lane);
#pragma unroll
        for (int j = 0; j < 4; ++j) gsc[j] = ngv[j] * (gsc[j] + 1.0f);
        const float rstd = row_rstd(x);
#pragma unroll
        for (int j = 0; j < 4; ++j) { const int col = 256 * j + 4 * lane;
            *(f32x4*)(xs + (size_t)t * D + col) = x[j];
            const f32x4 h = x[j] * rstd * gsc[j] + sh4[j];
            u32x2 w; w.x = pk2(h.x, h.y); w.y = pk2(h.z, h.w); *(u32x2*)(H + (size_t)t * D + col) = w; }
    }
}
#define DPPF(x, ctrl) __builtin_bit_cast(float, __builtin_amdgcn_update_dpp(0, __builtin_bit_cast(int, (x)), (ctrl), 0xf, 0xf, false))
__device__ __forceinline__ float row16_sum(float v) { v += DPPF(v, 0xB1); v += DPPF(v, 0x4E); v += DPPF(v, 0x141); v += DPPF(v, 0x140); return v; }
__device__ __forceinline__ u32x2 pk4(f32x4 v) { u32x2 w; w.x = pk2(v[0], v[1]); w.y = pk2(v[2], v[3]); return w; }
__device__ __forceinline__ void phase_c_prep(const Args& a, int lj, LAS unsigned char* lds, int tid, int gw, int NGW, int lane) {
    unsigned char* ws = a.ws;
    const bf16* Rr = (const bf16*)(ws + WS_RKV); const bf16* Kk = Rr + (size_t)T * D; const bf16* RA = (const bf16*)(ws + WS_RAWA); const bf16* RW = (const bf16*)(ws + WS_RAWW);
    bf16* KK = (bf16*)(ws + WS_KK); bf16* KD = (bf16*)(ws + WS_KD); bf16* BE = (bf16*)(ws + WS_BETA); float* RKB = (float*)(ws + WS_RKB);
    LAS float* tb = (LAS float*)lds;
    for (int i = tid; i < 7 * 256; i += 512) { const int t7 = i >> 8, q = i & 255;
        const float* src = t7 == 0 ? a.in[18] + lj * 1024 : t7 == 1 ? a.in[19] + lj * 1024 : t7 == 2 ? a.in[20] + lj * 1024 : t7 < 5 ? a.in[10] + lj * 2048 + (t7 - 3) * 1024 : a.in[13] + lj * 2048 + (t7 - 5) * 1024;
        ((LAS f32x4*)tb)[i] = ((const f32x4*)src)[q]; }
    __syncthreads();
    for (int row = gw; row < T; row += NGW) {
#pragma unroll
        for (int j = 0; j < 4; ++j) {
            const int col = 256 * j + 4 * lane; const size_t ro = (size_t)row * D + col;
            const f32x4 k = bf4(*(const u32x2*)(Kk + ro)), r = bf4(*(const u32x2*)(Rr + ro));
            f32x4 a0 = bf4(*(const u32x2*)(RA + ro)) + *(const LAS f32x4*)(tb + 5 * 1024 + col), a1 = bf4(*(const u32x2*)(RA + (size_t)T * D + ro)) + *(const LAS f32x4*)(tb + 6 * 1024 + col);
#pragma unroll
            for (int z = 0; z < 4; ++z) { a0[z] = sigm(a0[z]); a1[z] = sigm(a1[z]); }
            const f32x4 ck = *(const LAS f32x4*)(tb + col), ca = *(const LAS f32x4*)(tb + 1024 + col), cr = *(const LAS f32x4*)(tb + 2048 + col);
            const f32x4 kk = k * ck;
            const float ss = row16_sum((kk.x * kk.x + kk.y * kk.y) + (kk.z * kk.z + kk.w * kk.w));
            const f32x4 kd0 = k * ((a0 - 1.0f) * ca + 1.0f), kd1 = k * ((a1 - 1.0f) * ca + 1.0f);
            *(u32x2*)(KD + ro) = pk4(kd0); *(u32x2*)(KD + (size_t)T * D + ro) = pk4(kd1);
            const f32x4 p = r * (kd0 + kd1) * cr;
            const float rk = row16_sum((p.x + p.y) + (p.z + p.w));
            const f32x4 kkn = kk * fminf(__builtin_amdgcn_rsqf(ss), 1e12f);
            *(u32x2*)(KK + ro) = pk4(kkn); *(u32x2*)(BE + ro) = pk4(kkn * a0); *(u32x2*)(BE + (size_t)T * D + ro) = pk4(kkn * a1);
            if ((lane & 15) == 0) RKB[(size_t)row * 16 + 4 * j + (lane >> 4)] = rk;
        }
    }
}
typedef short bf16x8 __attribute__((ext_vector_type(8)));
__device__ __forceinline__ f32x4 mfma16(bf16x8 a, bf16x8 b, f32x4 c) { return __builtin_amdgcn_mfma_f32_16x16x32_bf16(a, b, c, 0, 0, 0); }
__device__ __forceinline__ bf16x8 as_frag(u32x4 w) { return __builtin_bit_cast(bf16x8, w); }
constexpr int CH_LD = 144;
constexpr int CH_MS = 64 * CH_LD;
constexpr int CH_AB = 0 * CH_MS, CH_KT = 1 * CH_MS, CH_BT = 2 * CH_MS, CH_RB = 3 * CH_MS, CH_VT = 4 * CH_MS, CH_ABT = 5 * CH_MS, CH_KHT = 6 * CH_MS, CH_BHT = 7 * CH_MS,
              CH_LK = 8 * CH_MS, CH_LB = 9 * CH_MS, CH_MK = 10 * CH_MS, CH_MB = 11 * CH_MS, CH_WT = 12 * CH_MS, CH_U0 = 13 * CH_MS, CH_DINV = 14 * CH_MS;
constexpr int CH_GC = LDSCTL_OFF + 2048;
constexpr int CH_PART = LDSCTL_OFF + 4096;
constexpr int NCHUNK = NSTEP / 64;
#ifndef S1_DBL
#define S1_DBL 0
#endif
static_assert(CH_DINV + 2048 <= RING_BYTES, "chunk LDS map");

__device__ __forceinline__ int scan_row(int s, int dir, int b) {
    if (s < CTXL) return TL + b * CTXL + (dir ? CTXL - 1 - s : s);
    const int i = s - CTXL; return b * SEQ + (dir ? SEQ - 1 - i : i);
}
#define CH_FRAG(mat, row, ks, kg) as_frag(*(const LAS u32x4*)(lds + (mat) + (row) * CH_LD + ((ks) * 32 + (kg) * 8) * 2))

__device__ __forceinline__ float s1_treduce16(const float (&a)[16], bool b3, bool b2) {
    float b[8];
#pragma unroll
    for (int i = 0; i < 8; ++i) { float x = a[i], y = a[i + 8];
        asm("s_nop 1\n\tv_permlane32_swap_b32 %0, %1" : "+v"(x), "+v"(y));
        b[i] = x + y; }
    float c[4];
#pragma unroll
    for (int i = 0; i < 4; ++i) { float x = b[i], y = b[i + 4];
        asm("s_nop 1\n\tv_permlane16_swap_b32 %0, %1" : "+v"(x), "+v"(y));
        c[i] = x + y; }
    float d[2];
#pragma unroll
    for (int i = 0; i < 2; ++i) { const float keep = b3 ? c[i + 2] : c[i], send = b3 ? c[i] : c[i + 2]; d[i] = keep + DPPF(send, 0x128); }
    const float keep = b2 ? d[1] : d[0], send = b2 ? d[0] : d[1];
    float e = keep + DPPF(send, 0x141);
    e += DPPF(e, 0xB1);
    e += DPPF(e, 0x4E);
    return e;
}
#define S1_BAR() do { asm volatile("s_waitcnt lgkmcnt(0)" ::: "memory"); __builtin_amdgcn_s_barrier(); asm volatile("" ::: "memory"); } while (0)
__device__ __forceinline__ void phase_s1_chunks(const Args& a, int lj, LAS unsigned char* lds, int tid, int G, int rh_scratch = 0) {
    unsigned char* ws = a.ws; const float* w0l = a.in[10] + lj * 2048; const float* a0l = a.in[13] + lj * 2048;
    const float* pkk = a.in[18] + lj * 1024; const float* pka = a.in[19] + lj * 1024; const float* prk = a.in[20] + lj * 1024;
    const int lane = tid & 63, wave = __builtin_amdgcn_readfirstlane(tid >> 6), l15 = lane & 15, g = lane >> 4;
    LAS float* part = (LAS float*)(lds + CH_PART); LAS float* gammaC = (LAS float*)(lds + CH_GC);
    unsigned nlw[8], nka[8], nkr[8], nrr[8], nvv[8]; float nw0 = 0.f, na0 = 0.f, npkk = 0.f, npka = 0.f, nprk = 0.f;
    typedef const __attribute__((address_space(1))) unsigned short* GUS;
#define S1_LOAD(ctx_) do { unsigned char* wsl = ws; asm volatile("" : "+s"(wsl));     \
        const int chain_ = (ctx_) / NCHUNK, c_ = (ctx_) - chain_ * NCHUNK, dir_ = chain_ >> 6, b_ = (chain_ >> 4) & 3, h_ = chain_ & 15; \
          \
          \
        const long o0 = (long)scan_row(64 * c_ + 8 * wave, dir_, b_) * D + h_ * 64, od = (long)dir_ * T * D, st = dir_ ? -(long)D : (long)D; \
        const bf16* LWp = (const bf16*)(wsl + WS_RAWW) + od + o0; const bf16* RAp = (const bf16*)(wsl + WS_RAWA) + od + o0; \
        const bf16* Rp = (const bf16*)(wsl + WS_RKV) + o0; const bf16* Kp = Rp + (size_t)T * D; const bf16* Vp = Rp + (size_t)2 * T * D; \
        nw0 = w0l[dir_ * 1024 + h_ * 64 + lane]; na0 = a0l[dir_ * 1024 + h_ * 64 + lane]; npkk = pkk[h_ * 64 + lane]; npka = pka[h_ * 64 + lane]; nprk = prk[h_ * 64 + lane]; \
        _Pragma("unroll") for (int j = 0; j < 8; ++j) { const long oj = st * j; \
            nlw[j] = ((GUS)(LWp + oj))[lane]; nka[j] = ((GUS)(RAp + oj))[lane]; nkr[j] = ((GUS)(Kp + oj))[lane]; nrr[j] = ((GUS)(Rp + oj))[lane]; nvv[j] = ((GUS)(Vp + oj))[lane]; } } while (0)
    unsigned clw[8], cka_[8], ckr[8], crr[8], cvv[8]; float cw0 = 0.f, ca0 = 0.f, cpkk = 0.f, cpka = 0.f, cprk = 0.f;
#define S1_TAKE() do { _Pragma("unroll") for (int j = 0; j < 8; ++j) { clw[j] = nlw[j]; cka_[j] = nka[j]; ckr[j] = nkr[j]; crr[j] = nrr[j]; cvv[j] = nvv[j]; } \
        cw0 = nw0; ca0 = na0; cpkk = npkk; cpka = npka; cprk = nprk; \
        _Pragma("unroll") for (int j = 0; j < 8; ++j) asm volatile("" : "+v"(clw[j]), "+v"(cka_[j]), "+v"(ckr[j]), "+v"(crr[j]), "+v"(cvv[j]) :: "memory"); \
        asm volatile("" : "+v"(cw0), "+v"(ca0), "+v"(cpkk), "+v"(cpka), "+v"(cprk) :: "memory"); } while (0)
    if ((int)blockIdx.x < 128 * NCHUNK) { S1_LOAD((int)blockIdx.x); S1_TAKE(); if ((int)blockIdx.x + G < 128 * NCHUNK) S1_LOAD((int)blockIdx.x + G); }
    for (int ct = blockIdx.x; ct < 128 * NCHUNK; ct += G) {
        const int chain = ct / NCHUNK, c = ct - chain * NCHUNK, dir = chain >> 6, b = (chain >> 4) & 3, h = chain & 15;
        unsigned zq = 0u; asm volatile("" : "+v"(zq));
        {
            const int k = lane, tq = wave;
            float lw[8], kd[8], be[8], kk[8], rr[8], vv[8];
            {
                const float w0k = cw0, a0k = ca0, ckk = cpkk, cka = cpka, crk = cprk;
                float* RKBd = (float*)(ws + (dir ? WS_RKB1 : WS_RKB));
                const int row0 = scan_row(64 * c + 8 * tq, dir, b), rst = dir ? -1 : 1;
                float av[8], kq[8], red[16];
                const float a0n = a0k * -1.44269504f, w0n = w0k * -1.44269504f;
#pragma unroll
                for (int j = 0; j < 8; ++j) { av[j] = frcp(1.0f + __builtin_amdgcn_exp2f(__builtin_fmaf(bflo(cka_[j]), -1.44269504f, a0n))); const float kr = bflo(ckr[j]);
                    lw[j] = -0.60653066f * frcp(1.0f + __builtin_amdgcn_exp2f(__builtin_fmaf(bflo(clw[j]), -1.44269504f, w0n)));
                    kq[j] = kr * ckk; kd[j] = kr * ((av[j] - 1.0f) * cka + 1.0f); rr[j] = bflo(crr[j]); vv[j] = bflo(cvv[j]);
                    red[2 * j] = kq[j] * kq[j]; red[2 * j + 1] = rr[j] * kd[j] * crk; }
                const float tot = s1_treduce16(red, (lane & 8) != 0, (lane & 4) != 0);
                if ((lane & 7) == 4) RKBd[(size_t)(row0 + rst * (lane >> 3)) * 16 + h] = tot;
#pragma unroll
                for (int j = 0; j < 8; ++j) { const float ss = __builtin_bit_cast(float, __builtin_amdgcn_readlane(__builtin_bit_cast(int, tot), 8 * j));
                    kk[j] = kq[j] * fminf(__builtin_amdgcn_rsqf(ss), 1e12f);     be[j] = kk[j] * av[j]; }
            }
            for (int r0_ = 0; r0_ <= ((S1_DBL >> 3) & 1); ++r0_) { if (r0_) S1_BAR();
            float p[8]; p[0] = lw[0];
#pragma unroll
            for (int j = 1; j < 8; ++j) p[j] = p[j - 1] + lw[j];
            part[tq * 64 + k] = p[7];
            S1_BAR();
            float off = 0.f, tot = 0.f;
#pragma unroll
            for (int q = 0; q < 8; ++q) { const float pv = part[q * 64 + k]; tot += pv; off += q < tq ? pv : 0.f; }
            const float eTot = __expf(tot); float ePrev = __expf(off);
            if (tq == 0) gammaC[k] = eTot;
            unsigned abw[4], khw[4], bhw[4], vw[4];
#pragma unroll
            for (int j = 0; j < 8; j += 2) {
                float ab2[2], kt2[2], bt2[2], rb2[2], kh2[2], bh2[2];
#pragma unroll
                for (int z = 0; z < 2; ++z) { const float cu = (off + p[j + z]) * 1.44269504f; const float eP = __builtin_amdgcn_exp2f(cu), eM = __builtin_amdgcn_exp2f(-cu), eC = eTot * eM;
                    ab2[z] = kk[j + z] * ePrev; ePrev = eP; kt2[z] = kd[j + z] * eM; bt2[z] = be[j + z] * eM; rb2[z] = rr[j + z] * eP; kh2[z] = kd[j + z] * eC; bh2[z] = be[j + z] * eC;
                }
                abw[j >> 1] = pk2(ab2[0], ab2[1]); khw[j >> 1] = pk2(kh2[0], kh2[1]); bhw[j >> 1] = pk2(bh2[0], bh2[1]); vw[j >> 1] = pk2(vv[j], vv[j + 1]);
                {
                    const unsigned ktw = pk2(kt2[0], kt2[1]), btw = pk2(bt2[0], bt2[1]), rbw = pk2(rb2[0], rb2[1]), aw = abw[j >> 1];
                    const int t = 8 * tq + j;
                    *(LAS bf16*)(lds + CH_AB + t * CH_LD + k * 2) = (bf16)aw; *(LAS bf16*)(lds + CH_AB + (t + 1) * CH_LD + k * 2) = (bf16)(aw >> 16);
                    *(LAS bf16*)(lds + CH_KT + t * CH_LD + k * 2) = (bf16)ktw; *(LAS bf16*)(lds + CH_KT + (t + 1) * CH_LD + k * 2) = (bf16)(ktw >> 16);
                    *(LAS bf16*)(lds + CH_BT + t * CH_LD + k * 2) = (bf16)btw; *(LAS bf16*)(lds + CH_BT + (t + 1) * CH_LD + k * 2) = (bf16)(btw >> 16);
                    *(LAS bf16*)(lds + CH_RB + t * CH_LD + k * 2) = (bf16)rbw; *(LAS bf16*)(lds + CH_RB + (t + 1) * CH_LD + k * 2) = (bf16)(rbw >> 16); }
            }
            *(LAS u32x4*)(lds + CH_ABT + k * CH_LD + tq * 16) = (u32x4){abw[0], abw[1], abw[2], abw[3]};
            *(LAS u32x4*)(lds + CH_KHT + k * CH_LD + tq * 16) = (u32x4){khw[0], khw[1], khw[2], khw[3]};
            *(LAS u32x4*)(lds + CH_BHT + k * CH_LD + tq * 16) = (u32x4){bhw[0], bhw[1], bhw[2], bhw[3]};
            *(LAS u32x4*)(lds + CH_VT + k * CH_LD + tq * 16) = (u32x4){vw[0], vw[1], vw[2], vw[3]};
            *(LAS u32x4*)(lds + CH_WT + k * CH_LD + tq * 16) = (u32x4){zq, zq, zq, zq}; *(LAS u32x4*)(lds + CH_U0 + k * CH_LD + tq * 16) = (u32x4){zq, zq, zq, zq};
            }
        }
        S1_BAR();
        for (int r1_ = 0; r1_ <= (S1_DBL & 1); ++r1_) { if (r1_) S1_BAR();
            const int mi = wave >> 1, half = wave & 1;
            const int matS = (mi & 1) ? CH_BT : CH_KT, matT = (mi & 2) ? CH_RB : CH_AB, matO = CH_LK + mi * CH_MS;
            const bool incl = (mi & 2) != 0;
            bf16x8 fs[4][2], ft[2][2];
#pragma unroll
            for (int ms = 0; ms < 4; ++ms)
#pragma unroll
                for (int ks = 0; ks < 2; ++ks) fs[ms][ks] = CH_FRAG(matS, 16 * ms + l15, ks, g);
#pragma unroll
            for (int nt = 0; nt < 2; ++nt)
#pragma unroll
                for (int ks = 0; ks < 2; ++ks) ft[nt][ks] = CH_FRAG(matT, 32 * half + 16 * nt + l15, ks, g);
#pragma unroll
            for (int nt = 0; nt < 2; ++nt) { const int t = 32 * half + 16 * nt + l15;
#pragma unroll
                for (int ms = 0; ms < 4; ++ms) { f32x4 d = (f32x4){0.f, 0.f, 0.f, 0.f};
                    d = mfma16(fs[ms][0], ft[nt][0], d); d = mfma16(fs[ms][1], ft[nt][1], d);
                    const int s0 = 16 * ms + 4 * g;
#pragma unroll
                    for (int i = 0; i < 4; ++i) { const bool keep = incl ? (s0 + i <= t) : (s0 + i < t); d[i] = keep ? d[i] : __builtin_bit_cast(float, zq); }
                    u32x2 w; w.x = pk2(d[0], d[1]); w.y = pk2(d[2], d[3]);
                    *(LAS u32x2*)(lds + matO + t * CH_LD + s0 * 2) = w; } }
        }
        S1_BAR();
        f32x4 rhsU[4];
#pragma unroll
        for (int I = 0; I < 4; ++I) rhsU[I] = (f32x4){0.f, 0.f, 0.f, 0.f};
        if (wave >= 4) {
            const int ctv = (wave & 3) * 16;
            const bf16x8 fv0 = CH_FRAG(CH_VT, ctv + l15, 0, g), fv1 = CH_FRAG(CH_VT, ctv + l15, 1, g);
#pragma unroll
            for (int I = 0; I < 4; ++I) { f32x4 d = (f32x4){0.f, 0.f, 0.f, 0.f};
                d = mfma16(CH_FRAG(CH_LK, 16 * I + l15, 0, g), fv0, d); d = mfma16(CH_FRAG(CH_LK, 16 * I + l15, 1, g), fv1, d); rhsU[I] = -d; }
        }
        for (int r2_ = 0; r2_ <= ((S1_DBL >> 1) & 1); ++r2_) if (wave == 0) {
            const int bb = lane >> 4, j = lane & 15;
            float x[16];
#pragma unroll
            for (int t = 0; t < 16; ++t) {
                const u32x4 r0 = *(const LAS u32x4*)(lds + CH_LB + (16 * bb + t) * CH_LD + 32 * bb), r1 = *(const LAS u32x4*)(lds + CH_LB + (16 * bb + t) * CH_LD + 32 * bb + 16);
                const unsigned rw[8] = {r0.x, r0.y, r0.z, r0.w, r1.x, r1.y, r1.z, r1.w};
                float acc = (t == j) ? 1.0f : 0.0f;
#pragma unroll
                for (int s = 0; s < t; ++s) { const float lv = (s & 1) ? bfhi(rw[s >> 1]) : bflo(rw[s >> 1]); acc -= lv * x[s]; }
                x[t] = acc;
                *(LAS bf16*)(lds + CH_DINV + ((bb * 16 + t) * 16 + j) * 2) = (bf16)f2bf(acc);
            }
        }
        S1_BAR();
        {
            const int matZ = wave < 4 ? CH_WT : CH_U0, ct16 = (wave & 3) * 16;
            for (int r4_ = 0; r4_ <= ((S1_DBL >> 4) & 1); ++r4_) { if (r4_) { *(LAS u32x4*)(lds + matZ + (ct16 + l15) * CH_LD + g * 32) = (u32x4){zq, zq, zq, zq}; *(LAS u32x4*)(lds + matZ + (ct16 + l15) * CH_LD + g * 32 + 16) = (u32x4){zq, zq, zq, zq}; LDS_WAIT(); }
#pragma unroll
            for (int I = 0; I < 4; ++I) {
                f32x4 rhs;
                if (wave < 4) { const u32x2 w = *(const LAS u32x2*)(lds + CH_ABT + (ct16 + l15) * CH_LD + (16 * I + 4 * g) * 2); rhs = (f32x4){bflo(w.x), bfhi(w.x), bflo(w.y), bfhi(w.y)}; }
                else rhs = rhsU[I];
                f32x4 d = (f32x4){0.f, 0.f, 0.f, 0.f};
                d = mfma16(CH_FRAG(CH_LB, 16 * I + l15, 0, g), CH_FRAG(matZ, ct16 + l15, 0, g), d); d = mfma16(CH_FRAG(CH_LB, 16 * I + l15, 1, g), CH_FRAG(matZ, ct16 + l15, 1, g), d);
                const f32x4 ac = rhs - d;
                const u32x2 dv = *(const LAS u32x2*)(lds + CH_DINV + ((I * 16 + l15) * 16 + 4 * g) * 2);
                const bf16x8 fa = as_frag((u32x4){dv.x, dv.y, zq, zq}), fb = as_frag((u32x4){pk2(ac[0], ac[1]), pk2(ac[2], ac[3]), zq, zq});
                const f32x4 z = mfma16(fa, fb, (f32x4){0.f, 0.f, 0.f, 0.f});
                u32x2 w; w.x = pk2(z[0], z[1]); w.y = pk2(z[2], z[3]);
                *(LAS u32x2*)(lds + matZ + (ct16 + l15) * CH_LD + (16 * I + 4 * g) * 2) = w;
                LDS_WAIT(); asm volatile("" ::: "memory");
            }
            }
        }
        S1_BAR();
        if (ct + G < 128 * NCHUNK) { S1_TAKE(); if (ct + 2 * G < 128 * NCHUNK) S1_LOAD(ct + 2 * G); }
        for (int r3_ = 0; r3_ <= ((S1_DBL >> 2) & 1); ++r3_) { if (r3_) S1_BAR();
            const int rt = wave >> 1, cp = (wave & 1) * 2;
            unsigned char* wsl = ws; asm volatile("" : "+s"(wsl));
            bf16* YL = (bf16*)(wsl + WS_Y); bf16* RH = (bf16*)(wsl + (rh_scratch ? WS_BETA + RF : WS_RH)); bf16* PM = (bf16*)(wsl + WS_PM); bf16* QT = (bf16*)(wsl + WS_QT);
            const int trow = scan_row(64 * c + 16 * rt + l15, dir, b);
#pragma unroll
            for (int q = 0; q < 2; ++q) { const int vt = cp + q; f32x4 d = (f32x4){0.f, 0.f, 0.f, 0.f};
#pragma unroll
                for (int ks = 0; ks < 2; ++ks) { d = mfma16(CH_FRAG(CH_VT, 16 * vt + l15, ks, g), CH_FRAG(CH_MK, 16 * rt + l15, ks, g), d); d = mfma16(CH_FRAG(CH_U0, 16 * vt + l15, ks, g), CH_FRAG(CH_MB, 16 * rt + l15, ks, g), d); }
                *(u32x2*)(YL + ((size_t)dir * T + trow) * D + h * 64 + 16 * vt + 4 * g) = pk4(d); }
#pragma unroll
            for (int q = 0; q < 2; ++q) { const int kt = cp + q; f32x4 d = (f32x4){0.f, 0.f, 0.f, 0.f};
#pragma unroll
                for (int ks = 0; ks < 2; ++ks) d = mfma16(CH_FRAG(CH_WT, 16 * kt + l15, ks, g), CH_FRAG(CH_MB, 16 * rt + l15, ks, g), d);
                const u32x2 rbw = *(const LAS u32x2*)(lds + CH_RB + (16 * rt + l15) * CH_LD + (16 * kt + 4 * g) * 2);
                u32x2 w; w.x = pk2(bflo(rbw.x) - d[0], bfhi(rbw.x) - d[1]); w.y = pk2(bflo(rbw.y) - d[2], bfhi(rbw.y) - d[3]);
                *(u32x2*)(RH + ((size_t)dir * T + trow) * D + h * 64 + 16 * kt + 4 * g) = w; }
            bf16* Pc = PM + ((size_t)chain * NCHUNK + c) * 4096; bf16* Qc = QT + ((size_t)chain * NCHUNK + c) * 4096;
            { const int krow = 16 * rt + l15; const float gc = gammaC[krow];
#pragma unroll
                for (int q = 0; q < 2; ++q) { const int kt = cp + q; f32x4 d = (f32x4){0.f, 0.f, 0.f, 0.f};
#pragma unroll
                    for (int ks = 0; ks < 2; ++ks) d = mfma16(CH_FRAG(CH_WT, 16 * kt + l15, ks, g), CH_FRAG(CH_BHT, krow, ks, g), d);
                    const int k0 = 16 * kt + 4 * g; f32x4 o;
#pragma unroll
                    for (int i = 0; i < 4; ++i) o[i] = ((k0 + i == krow) ? gc : 0.f) - d[i];
                    u32x2 w; w.x = pk2(o[0], o[1]); w.y = pk2(o[2], o[3]);
                    *(u32x2*)(Pc + ((rt * 2 + (kt >> 1)) * 64 + g * 16 + l15) * 8 + 4 * (kt & 1)) = w; } }
            { const int vrow = 16 * rt + l15;
#pragma unroll
                for (int q = 0; q < 2; ++q) { const int kt = cp + q; f32x4 d = (f32x4){0.f, 0.f, 0.f, 0.f};
#pragma unroll
                    for (int ks = 0; ks < 2; ++ks) { d = mfma16(CH_FRAG(CH_KHT, 16 * kt + l15, ks, g), CH_FRAG(CH_VT, vrow, ks, g), d); d = mfma16(CH_FRAG(CH_BHT, 16 * kt + l15, ks, g), CH_FRAG(CH_U0, vrow, ks, g), d); }
                    u32x2 w; w.x = pk2(d[0], d[1]); w.y = pk2(d[2], d[3]);
                    *(u32x2*)(Qc + ((rt * 2 + (kt >> 1)) * 64 + g * 16 + l15) * 8 + 4 * (kt & 1)) = w; } }
        }
        S1_BAR();
    }
}

struct S2Set { u32x4 p[4][2]; u32x4 q[2]; };
__device__ __forceinline__ void s2_load(S2Set& s, const bf16* Pc, const bf16* Qc, int vt, int l15, int g) {
    const int ln = g * 16 + l15;
    s.q[0] = *(const u32x4*)(Qc + ((vt * 2 + 0) * 64 + ln) * 8); s.q[1] = *(const u32x4*)(Qc + ((vt * 2 + 1) * 64 + ln) * 8);
#pragma unroll
    for (int m = 0; m < 4; ++m)
#pragma unroll
        for (int j = 0; j < 2; ++j) s.p[m][j] = *(const u32x4*)(Pc + ((m * 2 + j) * 64 + ln) * 8);
}
__device__ __forceinline__ void s2_step(f32x4 (&acc)[4], const S2Set& s, bf16* Hc, int g) {
    unsigned hw[4][2];
#pragma unroll
    for (int m = 0; m < 4; ++m) { hw[m][0] = pk2(acc[m][0], acc[m][1]); hw[m][1] = pk2(acc[m][2], acc[m][3]); }
#pragma unroll
    for (int m = 0; m < 4; ++m) *(u32x2*)(Hc + (m >> 1) * 512 + (m & 1) * 256) = (u32x2){hw[m][0], hw[m][1]};
    const bf16x8 hb0 = as_frag((u32x4){hw[0][0], hw[0][1], hw[1][0], hw[1][1]}), hb1 = as_frag((u32x4){hw[2][0], hw[2][1], hw[3][0], hw[3][1]});
#pragma unroll
    for (int m = 0; m < 4; ++m) {
        const unsigned q0 = (m & 2) ? ((m & 1) ? s.q[1].z : s.q[1].x) : ((m & 1) ? s.q[0].z : s.q[0].x), q1 = (m & 2) ? ((m & 1) ? s.q[1].w : s.q[1].y) : ((m & 1) ? s.q[0].w : s.q[0].y);
        f32x4 d = (f32x4){bflo(q0), bfhi(q0), bflo(q1), bfhi(q1)};
        d = mfma16(as_frag(s.p[m][0]), hb0, d);
        d = mfma16(as_frag(s.p[m][1]), hb1, d);
        acc[m] = d;
    }
}
__device__ __forceinline__ void phase_s2_chain(const Args& a, int wave, int lane, int G) {
    unsigned char* ws = a.ws;
    const bf16* PM = (const bf16*)(ws + WS_PM); const bf16* QT = (const bf16*)(ws + WS_QT); bf16* HT = (bf16*)(ws + WS_HT);
    const int l15 = lane & 15, g = lane >> 4;
    if (wave >= 2) return;
    static_assert(NCHUNK % 4 == 0, "S2 ring");
    for (int wt = blockIdx.x * 2 + wave; wt < 512; wt += G * 2) {
        const int chain = wt >> 2, vt = wt & 3;
        f32x4 acc[4];
#pragma unroll
        for (int m = 0; m < 4; ++m) acc[m] = (f32x4){0.f, 0.f, 0.f, 0.f};
        const bf16* Pc = PM + (size_t)chain * NCHUNK * 4096; const bf16* Qc = QT + (size_t)chain * NCHUNK * 4096;
        bf16* Hc = HT + (size_t)chain * NCHUNK * 4096 + ((vt * 2) * 64 + (g >> 1) * 16 + l15) * 8 + 4 * (g & 1);
        S2Set s0, s1, s2, s3;
        s2_load(s0, Pc, Qc, vt, l15, g); s2_load(s1, Pc + 4096, Qc + 4096, vt, l15, g); s2_load(s2, Pc + 2 * 4096, Qc + 2 * 4096, vt, l15, g); s2_load(s3, Pc + 3 * 4096, Qc + 3 * 4096, vt, l15, g);
#pragma unroll 1
        for (int c = 0; c < NCHUNK; c += 4) {
            const int cn = c + 4 < NCHUNK ? c + 4 : c;
            const bf16* Pn = Pc + (size_t)cn * 4096; const bf16* Qn = Qc + (size_t)cn * 4096;
            s2_step(acc, s0, Hc + (size_t)c * 4096, g);       s2_load(s0, Pn, Qn, vt, l15, g);
            s2_step(acc, s1, Hc + (size_t)(c + 1) * 4096, g); s2_load(s1, Pn + 4096, Qn + 4096, vt, l15, g);
            s2_step(acc, s2, Hc + (size_t)(c + 2) * 4096, g); s2_load(s2, Pn + 2 * 4096, Qn + 2 * 4096, vt, l15, g);
            s2_step(acc, s3, Hc + (size_t)(c + 3) * 4096, g); s2_load(s3, Pn + 3 * 4096, Qn + 3 * 4096, vt, l15, g);
        }
    }
}

struct S3In { u32x2 yl[2][4]; u32x4 rh[2][2]; u32x4 hh[2][4][2]; };
__device__ __forceinline__ void s3_issue(S3In& s, const bf16* YL, const bf16* RH, const bf16* HT, int task, int l15, int g) {
    const int tt = task >> 4, h = task & 15, r0 = tt * 16, row = r0 + l15;
    int b, cc[2];
    if (r0 < TL) { b = r0 >> 13; const int tb = (r0 & (SEQ - 1)) >> 6; cc[0] = 4 + tb; cc[1] = 4 + (127 - tb); }
    else { const int loc = r0 - TL; b = loc >> 8; const int tb = (loc & 255) >> 6; cc[0] = tb; cc[1] = 3 - tb; }
    const size_t ro = (size_t)row * D + h * 64 + 4 * g;
#pragma unroll
    for (int dir = 0; dir < 2; ++dir) {
#pragma unroll
        for (int vt = 0; vt < 4; ++vt) s.yl[dir][vt] = *(const u32x2*)(YL + (size_t)dir * T * D + ro + 16 * vt);
        const int chain = dir * 64 + b * 16 + h;
        const bf16* rh = RH + ((size_t)dir * T + row) * D + h * 64 + 8 * g;
        s.rh[dir][0] = *(const u32x4*)(rh); s.rh[dir][1] = *(const u32x4*)(rh + 32);
        const bf16* hc = HT + ((size_t)chain * NCHUNK + cc[dir]) * 4096;
#pragma unroll
        for (int vt = 0; vt < 4; ++vt) { const bf16* hr = hc + ((vt * 2) * 64 + g * 16 + l15) * 8; s.hh[dir][vt][0] = *(const u32x4*)(hr); s.hh[dir][vt][1] = *(const u32x4*)(hr + 512); }
    }
}
__device__ __forceinline__ void s3_finish(const S3In& s, const bf16* Vv, const float* RKB, const float* RKB1, const bf16* Gg, const float* lng, const float* lnb, bf16* Z, int task, int l15, int g) {
    const int tt = task >> 4, h = task & 15, row = tt * 16 + l15;
    u32x2 vq2[4], gw2[4]; f32x4 lg4[4], lb4[4];
#pragma unroll
    for (int vt = 0; vt < 4; ++vt) { const int col = h * 64 + 16 * vt + 4 * g; const size_t o = (size_t)row * D + col;
        vq2[vt] = *(const u32x2*)(Vv + o); gw2[vt] = *(const u32x2*)(Gg + o); lg4[vt] = *(const f32x4*)(lng + col); lb4[vt] = *(const f32x4*)(lnb + col); }
    const float bon = RKB[(size_t)row * 16 + h] + RKB1[(size_t)row * 16 + h];
    f32x4 acc[4];
#pragma unroll
    for (int vt = 0; vt < 4; ++vt) acc[vt] = bf4(s.yl[0][vt]) + bf4(s.yl[1][vt]);
#pragma unroll
    for (int dir = 0; dir < 2; ++dir) {
        const bf16x8 f0 = as_frag(s.rh[dir][0]), f1 = as_frag(s.rh[dir][1]);
#pragma unroll
        for (int vt = 0; vt < 4; ++vt) { acc[vt] = mfma16(as_frag(s.hh[dir][vt][0]), f0, acc[vt]); acc[vt] = mfma16(as_frag(s.hh[dir][vt][1]), f1, acc[vt]); }
    }
    float sm = 0.f;
#pragma unroll
    for (int vt = 0; vt < 4; ++vt) sm += (acc[vt][0] + acc[vt][1]) + (acc[vt][2] + acc[vt][3]);
    sm += __shfl_xor(sm, 16); sm += __shfl_xor(sm, 32);
    const float mean = sm * (1.0f / 64.0f); float vs = 0.f;
#pragma unroll
    for (int vt = 0; vt < 4; ++vt) { acc[vt] = acc[vt] - mean; vs += (acc[vt][0] * acc[vt][0] + acc[vt][1] * acc[vt][1]) + (acc[vt][2] * acc[vt][2] + acc[vt][3] * acc[vt][3]); }
    vs += __shfl_xor(vs, 16); vs += __shfl_xor(vs, 32);
    const float rstd = rsqrtf(vs * (1.0f / 64.0f) + 64.0f * 1e-5f);
#pragma unroll
    for (int vt = 0; vt < 4; ++vt) { const int col = h * 64 + 16 * vt + 4 * g; const size_t o = (size_t)row * D + col;
        const f32x4 zz = acc[vt] * rstd * lg4[vt] + lb4[vt] + bf4(vq2[vt]) * bon;
        u32x2 w; w.x = pk2(zz[0] * bflo(gw2[vt].x), zz[1] * bfhi(gw2[vt].x)); w.y = pk2(zz[2] * bflo(gw2[vt].y), zz[3] * bfhi(gw2[vt].y));
        *(u32x2*)(Z + o) = w; }
}
__device__ __forceinline__ void phase_s3_readout(const Args& a, int lj, int nrows, int gw, int NGW, int lane) {
    unsigned char* ws = a.ws;
    const bf16* YL = (const bf16*)(ws + WS_Y); const bf16* RH = (const bf16*)(ws + WS_RH); const bf16* HT = (const bf16*)(ws + WS_HT);
    const bf16* Vv = (const bf16*)(ws + WS_RKV) + (size_t)2 * T * D; const float* RKB = (const float*)(ws + WS_RKB); const float* RKB1 = (const float*)(ws + WS_RKB1); const bf16* Gg = (const bf16*)(ws + WS_G); bf16* Z = (bf16*)(ws + WS_Z);
    const float* lng = a.in[21] + lj * 1024; const float* lnb = a.in[22] + lj * 1024;
    const int l15 = lane & 15, g = lane >> 4, ntask = (nrows / 16) * 16;
    for (int task = gw; task < ntask; task += NGW) {
        S3In A;
        s3_issue(A, YL, RH, HT, task, l15, g);
        s3_finish(A, Vv, RKB, RKB1, Gg, lng, lnb, Z, task, l15, g);
    }
}
__device__ __forceinline__ void phase_cv(const Args& a, int lc, int rows, int gw, int NGW, int lane) {
    unsigned char* ws = a.ws;
    const bf16* BG = (const bf16*)(ws + WS_BG); const bf16* CU = (const bf16*)(ws + WS_CUZ); bf16* Z = (bf16*)(ws + WS_Z);
    const float* cw = a.in[25] + (size_t)lc * 3 * 1024;
    for (int t = gw; t < rows; t += NGW) {
        int rs, re; if (t < TL) { rs = t & ~63; re = rs + 63; } else { const int loc = t - TL; rs = TL + (loc & ~255); re = rs + 255; }
        const bool hp = t > rs, hn = t < re;
        u32x2 zc4[4], bg4[4], zp4[4], zn4[4]; f32x4 w04[4], w14[4], w24[4];
#pragma unroll
        for (int j = 0; j < 4; ++j) { const int col = 256 * j + 4 * lane; const size_t o = (size_t)t * D + col;
            zc4[j] = *(const u32x2*)(CU + o); bg4[j] = *(const u32x2*)(BG + o);
            zp4[j] = hp ? *(const u32x2*)(CU + o - D) : (u32x2){0u, 0u}; zn4[j] = hn ? *(const u32x2*)(CU + o + D) : (u32x2){0u, 0u};
            w04[j] = *(const f32x4*)(cw + col); w14[j] = *(const f32x4*)(cw + 1024 + col); w24[j] = *(const f32x4*)(cw + 2048 + col); }
#pragma unroll
        for (int j = 0; j < 4; ++j) { const int col = 256 * j + 4 * lane; const size_t o = (size_t)t * D + col;
            const u32x2 zc = zc4[j], bg = bg4[j], zp = zp4[j], zn = zn4[j];
            const f32x4 w0 = w04[j], w1 = w14[j], w2 = w24[j];
            const f32x4 zv = (f32x4){bflo(zc.x), bfhi(zc.x), bflo(zc.y), bfhi(zc.y)}, pv = (f32x4){bflo(zp.x), bfhi(zp.x), bflo(zp.y), bfhi(zp.y)}, nv = (f32x4){bflo(zn.x), bfhi(zn.x), bflo(zn.y), bfhi(zn.y)};
            const f32x4 bv = (f32x4){bflo(bg.x), bfhi(bg.x), bflo(bg.y), bfhi(bg.y)};
            const f32x4 r = bv * (w0 * pv + w1 * zv + w2 * nv);
            u32x2 w; w.x = pk2(r.x, r.y); w.y = pk2(r.z, r.w); *(u32x2*)(Z + o) = w; }
    }
}
typedef float f32x2v __attribute__((ext_vector_type(2)));
__device__ __forceinline__ float lane_bcast(float v, int srclane) { return __builtin_bit_cast(float, __builtin_amdgcn_readlane(__builtin_bit_cast(int, v), srclane)); }
__device__ __forceinline__ void phase_e_route(const Args& a, int layer, int rows, LAS unsigned char* lds, int tid, int gw, int NGW, int lane, int probe_rep = 0) {
    unsigned char* ws = a.ws;
    const float* xs = (const float*)(ws + (layer < 2 ? WS_XSA : WS_XSB));
    const float* MODS = (const float*)(ws + WS_MODS); bf16* H2 = (bf16*)(ws + WS_H2);
    const float* ng = a.in[6] + (size_t)(layer * 2 + 1) * 1024;
    const float* rw = a.in[27] + (size_t)layer * 1024 * 32; const float* rb = a.in[28] + layer * 32;
    unsigned* cnt = (unsigned*)(ws + WS_CTL) + CW_CNT + (layer + 4 * probe_rep) * 32 * CNT_STRIDE;
    int* SLOTL = (int*)(ws + (probe_rep ? WS_L1 : WS_SLOTL)); float* GATEL = (float*)(ws + (probe_rep ? WS_L1 + 8 * MiB : WS_GATEL));
    LAS float* wt = (LAS float*)lds;
    LAS int* hist = (LAS int*)(lds + LDSCTL_OFF + 3072); LAS int* base = hist + 32; LAS int* lcnt = hist + 64;
    int* TKE = (int*)(ws + WS_C12); float* TKG = (float*)(ws + WS_C12 + 4 * MiB);
    for (int i = tid; i < 32768; i += 512) wt[(i & 31) * 1024 + (i >> 5)] = rw[i];
    if (tid < 32) hist[tid] = 0;
    __syncthreads();
    const int my_e = lane >> 1; const float my_b = rb[my_e];
    const bool b5 = (lane & 32) != 0, b4 = (lane & 16) != 0, b3 = (lane & 8) != 0, b2 = (lane & 4) != 0, b1 = (lane & 2) != 0;
    for (int t = gw; t < rows; t += NGW) {
        const int mr = mod_row(t);
        const float* mod = MODS + (size_t)(layer * 5 + mr) * 6144;
        f32x4 x[4];
#pragma unroll
        for (int j = 0; j < 4; ++j) x[j] = *(const f32x4*)(xs + (size_t)t * D + 256 * j + 4 * lane);
        const float rstd = row_rstd(x);
#pragma unroll
        for (int j = 0; j < 4; ++j) { const int col = 256 * j + 4 * lane;
            x[j] = x[j] * rstd * *(const f32x4*)(ng + col) * (*(const f32x4*)(mod + 4 * 1024 + col) + 1.0f) + *(const f32x4*)(mod + 3 * 1024 + col);
            u32x2 w; w.x = pk2(x[j].x, x[j].y); w.y = pk2(x[j].z, x[j].w); *(u32x2*)(H2 + (size_t)t * D + col) = w; }
        float p[32];
#pragma unroll
        for (int eg = 0; eg < 8; ++eg) {
#pragma unroll
            for (int ee = 0; ee < 4; ++ee) { const int e = eg * 4 + ee; f32x2v s2 = (f32x2v){0.f, 0.f};
#pragma unroll
                for (int j = 0; j < 4; ++j) { const f32x4 wv = *(const LAS f32x4*)(wt + e * 1024 + 256 * j + 4 * lane);
                    s2 = __builtin_elementwise_fma((f32x2v){x[j].x, x[j].y}, (f32x2v){wv.x, wv.y}, s2); s2 = __builtin_elementwise_fma((f32x2v){x[j].z, x[j].w}, (f32x2v){wv.z, wv.w}, s2); }
                p[e] = s2.x + s2.y; }
            asm volatile("" ::: "memory");
        }
        float q16[16];
#pragma unroll
        for (int i = 0; i < 16; ++i) { const float send = b5 ? p[i] : p[i + 16]; const float keep = b5 ? p[i + 16] : p[i]; q16[i] = keep + __shfl_xor(send, 32); }
        float q8[8];
#pragma unroll
        for (int i = 0; i < 8; ++i) { const float send = b4 ? q16[i] : q16[i + 8]; const float keep = b4 ? q16[i + 8] : q16[i]; q8[i] = keep + __shfl_xor(send, 16); }
        float q4[4];
#pragma unroll
        for (int i = 0; i < 4; ++i) { const float send = b3 ? q8[i] : q8[i + 4]; const float keep = b3 ? q8[i + 4] : q8[i]; q4[i] = keep + __shfl_xor(send, 8); }
        float q2[2];
#pragma unroll
        for (int i = 0; i < 2; ++i) { const float send = b2 ? q4[i] : q4[i + 2]; const float keep = b2 ? q4[i + 2] : q4[i]; q2[i] = keep + __shfl_xor(send, 4); }
        float q1; { const float send = b1 ? q2[0] : q2[1]; const float keep = b1 ? q2[1] : q2[0]; q1 = keep + __shfl_xor(send, 2); }
        const float lg = q1 + __shfl_xor(q1, 1) + my_b;
        int rank = 0;
#pragma unroll 1
        for (int e = 0; e < 32; ++e) { const float o = lane_bcast(lg, 2 * e); rank += (o > lg || (o == lg && e < my_e)) ? 1 : 0; }
        const bool sel = rank < 4 && !(lane & 1);
        const unsigned long long m0 = __ballot(sel && rank == 0), m1 = __ballot(sel && rank == 1), m2 = __ballot(sel && rank == 2), m3 = __ballot(sel && rank == 3);
        const float v0 = lane_bcast(lg, (int)__builtin_ctzll(m0)), v1 = lane_bcast(lg, (int)__builtin_ctzll(m1)), v2 = lane_bcast(lg, (int)__builtin_ctzll(m2)), v3 = lane_bcast(lg, (int)__builtin_ctzll(m3));
        const float e1 = __expf(v1 - v0), e2 = __expf(v2 - v0), e3 = __expf(v3 - v0);
        const float inv = frcp(1.0f + e1 + e2 + e3);
        if (sel) {
            TKE[t * 4 + rank] = my_e; TKG[t * 4 + rank] = __expf(lg - v0) * inv;
            __hip_atomic_fetch_add(hist + my_e, 1, __ATOMIC_RELAXED, __HIP_MEMORY_SCOPE_WORKGROUP);
        }
    }
    asm volatile("s_waitcnt vmcnt(0) lgkmcnt(0)" ::: "memory"); __syncthreads();
    if (tid < 32) { base[tid] = (int)atomicAdd(cnt + tid * CNT_STRIDE, (unsigned)hist[tid]); lcnt[tid] = 0; }
    __syncthreads();
    for (int t = gw; t < rows; t += NGW) {
        if (lane < 4) { const int e = TKE[t * 4 + lane]; const float gk = TKG[t * 4 + lane];
            const int pos = base[e] + __hip_atomic_fetch_add(lcnt + e, 1, __ATOMIC_RELAXED, __HIP_MEMORY_SCOPE_WORKGROUP);
            SLOTL[(size_t)e * T + pos] = t * 4 + lane; GATEL[(size_t)e * T + pos] = gk; }
    }
}
__device__ __forceinline__ int okey(float v, int e) { const int i = __builtin_bit_cast(int, v); const int o = i ^ ((i >> 31) & 0x7fffffff); return (o & ~31) | (31 - e); }
__device__ __forceinline__ void phase_e_route_mfma(const Args& a, int layer, int rows, LAS unsigned char* lds, int tid, int wave, int gw, int NGW, int lane, int probe_rep = 0) {
    unsigned char* ws = a.ws;
    const float* xs = (const float*)(ws + (layer < 2 ? WS_XSA : WS_XSB));
    const float* MODS = (const float*)(ws + WS_MODS); bf16* H2 = (bf16*)(ws + WS_H2);
    const float* ng = a.in[6] + (size_t)(layer * 2 + 1) * 1024; const float* rb = a.in[28] + layer * 32;
    const bf16* WRT = (const bf16*)(ws + WS_WRT) + (size_t)layer * 2 * 32 * 1024;
    unsigned* cnt = (unsigned*)(ws + WS_CTL) + CW_CNT + (layer + 4 * probe_rep) * 32 * CNT_STRIDE;
    int* SLOTL = (int*)(ws + (probe_rep ? WS_L1 : WS_SLOTL)); float* GATEL = (float*)(ws + (probe_rep ? WS_L1 + 8 * MiB : WS_GATEL));
    LAS int* hist = (LAS int*)(lds + LDSCTL_OFF + 3072); LAS int* base = hist + 32; LAS int* lcnt = hist + 64;
    int* TKE = (int*)(ws + WS_C12); float* TKG = (float*)(ws + WS_C12 + 4 * MiB);
    LAS unsigned char* tile = lds + wave * 8448;
    if (tid < 32) hist[tid] = 0;
    constexpr int E_TAB = 8 * 8448, E_TP = 2064;
    static_assert(E_TAB + 32 * E_TP <= LDSCTL_OFF, "router table");
    for (int i = tid; i < 32 * 128; i += 512) { const int r = i >> 7, pc = i & 127; *(LAS u32x4*)(lds + E_TAB + r * E_TP + pc * 16) = *(const u32x4*)(WRT + (size_t)r * 1024 + pc * 8); }
    __syncthreads();
    const int l15 = lane & 15, g = lane >> 4;
    const int nlat = TL / 16, nctx = rows > TL ? TC / 4 : 0, G_ = NGW / 8;
    for (int it = 0;; ++it) {
        int t0, ntok;
        { const int tl = gw + it * NGW; const int xi = (int)blockIdx.x + (it - (nlat + NGW - 1) / NGW) * G_ * 8 + wave * G_;
          if (tl < nlat) { t0 = tl * 16; ntok = 16; } else if (it >= (nlat + NGW - 1) / NGW && xi < nctx) { t0 = TL + xi * 4; ntok = 4; } else if (it >= (nlat + NGW - 1) / NGW) break; else continue; }
        const float* mod = MODS + (size_t)(layer * 5 + mod_row(t0)) * 6144;
        float rstd[16];
#pragma unroll
        for (int tb = 0; tb < 16; tb += 8) {
            f32x4 xa[8][4];
#pragma unroll
            for (int t = 0; t < 8; ++t) { const int tr = tb + t < ntok ? t0 + tb + t : t0;
#pragma unroll
                for (int j = 0; j < 4; ++j) xa[t][j] = *(const f32x4*)(xs + (size_t)tr * D + 256 * j + 4 * lane); }
#pragma unroll
            for (int t = 0; t < 8; ++t) rstd[tb + t] = __builtin_bit_cast(float, __builtin_amdgcn_readfirstlane(__builtin_bit_cast(int, row_rstd(xa[t]))));
            asm volatile("" ::: "memory"); }
        f32x4 acc[2]; acc[0] = (f32x4){0.f, 0.f, 0.f, 0.f}; acc[1] = acc[0];
#pragma unroll 1
        for (int s = 0; s < 4; ++s) {
            const int col = 256 * s + 4 * lane;
            int t0s = t0; asm volatile("" : "+s"(t0s));
            const bf16* wl = WRT + (size_t)(32 + l15) * 1024 + 256 * s + 8 * g;
            u32x4 wlf[8][2];
#pragma unroll
            for (int ks = 0; ks < 8; ++ks)
#pragma unroll
                for (int et = 0; et < 2; ++et) wlf[ks][et] = *(const u32x4*)(wl + (size_t)et * 16 * 1024 + 32 * ks);
            const f32x4 g4 = *(const f32x4*)(ng + col) * (*(const f32x4*)(mod + 4 * 1024 + col) + 1.0f), s4 = *(const f32x4*)(mod + 3 * 1024 + col);
            u32x2 lo[16];
#pragma unroll
            for (int tb = 0; tb < 16; tb += 8) {
                f32x4 xr[8];
#pragma unroll
                for (int t = 0; t < 8; ++t) { const int tr = tb + t < ntok ? t0s + tb + t : t0s; xr[t] = *(const f32x4*)(xs + (size_t)tr * D + col); }
#pragma unroll
                for (int t = 0; t < 8; ++t) { const int tr = tb + t < ntok ? t0s + tb + t : t0s; const f32x4 hv = xr[t] * rstd[tb + t] * g4 + s4;
                    const u32x2 w = pk4(hv); if (tb + t < ntok) *(u32x2*)(H2 + (size_t)tr * D + col) = w;
                    *(LAS u32x2*)(tile + (tb + t) * 528 + lane * 8) = w; lo[tb + t] = pk4(hv - bf4(w)); } }
            LDS_WAIT(); asm volatile("" ::: "memory");
            const LAS unsigned char* th = lds + E_TAB + l15 * E_TP + (256 * s + 8 * g) * 2;
#pragma unroll
            for (int ks = 0; ks < 8; ++ks) { const bf16x8 fb = as_frag(*(const LAS u32x4*)(tile + l15 * 528 + ks * 64 + g * 16));
#pragma unroll
                for (int et = 0; et < 2; ++et) { acc[et] = mfma16(as_frag(*(const LAS u32x4*)(th + et * 16 * E_TP + 64 * ks)), fb, acc[et]);
                    acc[et] = mfma16(as_frag(wlf[ks][et]), fb, acc[et]); } }
            LDS_WAIT(); asm volatile("" ::: "memory");
#pragma unroll
            for (int t = 0; t < 16; ++t) *(LAS u32x2*)(tile + t * 528 + lane * 8) = lo[t];
            LDS_WAIT(); asm volatile("" ::: "memory");
#pragma unroll
            for (int ks = 0; ks < 8; ++ks) { const bf16x8 fb = as_frag(*(const LAS u32x4*)(tile + l15 * 528 + ks * 64 + g * 16));
#pragma unroll
                for (int et = 0; et < 2; ++et) acc[et] = mfma16(as_frag(*(const LAS u32x4*)(th + et * 16 * E_TP + 64 * ks)), fb, acc[et]); }
            LDS_WAIT(); asm volatile("" ::: "memory");
        }
        float v[8]; int key[8];
#pragma unroll
        for (int j = 0; j < 8; ++j) { const int e = (j < 4 ? 0 : 16) + 4 * g + (j & 3); v[j] = acc[j >> 2][j & 3] + rb[e]; key[j] = okey(v[j], e); }
        int kb[8], kc[8], kd2[8];
#pragma unroll
        for (int j = 0; j < 8; ++j) kb[j] = __shfl_xor(key[j], 16);
#pragma unroll
        for (int j = 0; j < 8; ++j) { kc[j] = __shfl_xor(key[j], 32); kd2[j] = __shfl_xor(kb[j], 32); }
        float vmax = fmaxf(fmaxf(fmaxf(v[0], v[1]), fmaxf(v[2], v[3])), fmaxf(fmaxf(v[4], v[5]), fmaxf(v[6], v[7])));
        vmax = fmaxf(vmax, __shfl_xor(vmax, 16)); vmax = fmaxf(vmax, __shfl_xor(vmax, 32));
        int rank[8]; float ex[8], part = 0.f;
#pragma unroll
        for (int j = 0; j < 8; ++j) { int r = 0;
#pragma unroll
            for (int q = 0; q < 8; ++q) r += (key[q] > key[j]) + (kb[q] > key[j]) + (kc[q] > key[j]) + (kd2[q] > key[j]);
            rank[j] = r; ex[j] = __expf(v[j] - vmax); part += r < 4 ? ex[j] : 0.f; }
        part += __shfl_xor(part, 16); part += __shfl_xor(part, 32);
        const float inv = frcp(part); const int t = t0 + l15;
#pragma unroll
        for (int j = 0; j < 8; ++j) if (rank[j] < 4 && l15 < ntok) { const int e = (j < 4 ? 0 : 16) + 4 * g + (j & 3);
            TKE[t * 4 + rank[j]] = e; TKG[t * 4 + rank[j]] = ex[j] * inv;
            __hip_atomic_fetch_add(hist + e, 1, __ATOMIC_RELAXED, __HIP_MEMORY_SCOPE_WORKGROUP); }
    }
    asm volatile("s_waitcnt vmcnt(0) lgkmcnt(0)" ::: "memory"); __syncthreads();
    if (tid < 32) { base[tid] = (int)atomicAdd(cnt + tid * CNT_STRIDE, (unsigned)hist[tid]); lcnt[tid] = 0; }
    __syncthreads();
    for (int it = 0;; ++it) {
        int t0, ntok;
        { const int tl = gw + it * NGW; const int xi = (int)blockIdx.x + (it - (nlat + NGW - 1) / NGW) * G_ * 8 + wave * G_;
          if (tl < nlat) { t0 = tl * 16; ntok = 16; } else if (it >= (nlat + NGW - 1) / NGW && xi < nctx) { t0 = TL + xi * 4; ntok = 4; } else if (it >= (nlat + NGW - 1) / NGW) break; else continue; }
        if ((lane >> 2) < ntok) { const int t = t0 + (lane >> 2), k = lane & 3;
            const int e = TKE[t * 4 + k]; const float gk = TKG[t * 4 + k];
            const int pos = base[e] + __hip_atomic_fetch_add(lcnt + e, 1, __ATOMIC_RELAXED, __HIP_MEMORY_SCOPE_WORKGROUP);
            SLOTL[(size_t)e * T + pos] = t * 4 + k; GATEL[(size_t)e * T + pos] = gk; }
    }
}
__device__ __forceinline__ void phase_final(const Args& a, int gw, int NGW, int lane) {
    unsigned char* ws = a.ws;
    const float* xs = (const float*)(ws + WS_XSB); const float* MODS = (const float*)(ws + WS_MODS); const bf16* YS = (const bf16*)(ws + WS_YS);
    for (int t = gw; t < TL; t += NGW) {
        const int mr = t >> 13;
        f32x4 m5[4], x[4];
#pragma unroll
        for (int j = 0; j < 4; ++j) m5[j] = *(const f32x4*)(MODS + (size_t)(3 * 5 + mr) * 6144 + 5 * 1024 + 256 * j + 4 * lane);
        f32x4 fg[4];
#pragma unroll
        for (int j = 0; j < 4; ++j) fg[j] = *(const f32x4*)(a.in[7] + 256 * j + 4 * lane);
        load_x_combined(x, xs + (size_t)t * D, true, YS, t, m5, lane);
        const float rstd = row_rstd(x);
#pragma unroll
        for (int j = 0; j < 4; ++j) { const int col = 256 * j + 4 * lane; *(f32x4*)(a.out + (size_t)t * D + col) = x[j] * rstd * fg[j]; }
    }
}

using pg8::Unit; using pg8::tile_map;
struct SchedStd {
    int G, c, nM, nN;
    __device__ __forceinline__ bool next(int i, Unit& u) const { const long L = (long)i * G + c; if (L >= (long)nM * nN) return false; int pm, pn; tile_map((int)L, nM, nN, pm, pn); u.pm = pm; u.pn = pn; u.e = 0; u.nv = pm; u.par = 0; return true; }
    __device__ __forceinline__ void a_ready(const Unit&) const {}
    __device__ __forceinline__ void done(const Unit&) const {}
    __device__ __forceinline__ unsigned row_off(const Unit&, int) const { return 0u; }
    __device__ __forceinline__ unsigned row_off_lds(const Unit&, int) const { return 0u; }
    __device__ __forceinline__ void prefetch_rows(const Unit&) const {}
};
struct SchedB1 {
    int G, c;
    __device__ __forceinline__ bool next(int i, Unit& u) const { const long L = (long)i * G + c; constexpr int n1 = 3 * NMT * 4; if (L >= n1 + 3 * NMT) return false; const int l = (int)L;
        if (l < n1) { const int j = l / (NMT * 4), r = l % (NMT * 4); int pm, pn; tile_map(r, NMT, 4, pm, pn); u.pm = j * NMT + pm; u.pn = j * 4 + pn; u.e = j; u.nv = pm; }
        else { const int r = l - n1, j = r / NMT, pm = r % NMT; u.pm = (3 + j) * NMT + pm; u.pn = 12 + j; u.e = 3 + j; u.nv = pm; }
        u.par = 0; return true; }
    __device__ __forceinline__ void a_ready(const Unit&) const {}
    __device__ __forceinline__ void done(const Unit&) const {}
    __device__ __forceinline__ unsigned row_off(const Unit&, int) const { return 0u; }
    __device__ __forceinline__ unsigned row_off_lds(const Unit&, int) const { return 0u; }
    __device__ __forceinline__ void prefetch_rows(const Unit&) const {}
};
struct SchedB2 {
    int G, c;
    __device__ __forceinline__ bool next(int i, Unit& u) const { const long L = (long)i * G + c; constexpr int n1 = 2 * NMT * 8; if (L >= n1 + NMT * 4) return false; const int l = (int)L;
        if (l < n1) { const int j = l / (NMT * 8), r = l % (NMT * 8); int pm, pn; tile_map(r, NMT, 8, pm, pn); u.pm = j * NMT + pm; u.pn = j * 8 + pn; u.e = j; u.nv = pm; }
        else { const int r = l - n1; int pm, pn; tile_map(r, NMT, 4, pm, pn); u.pm = 2 * NMT + pm; u.pn = 16 + pn; u.e = 2; u.nv = pm; }
        u.par = 0; return true; }
    __device__ __forceinline__ void a_ready(const Unit&) const {}
    __device__ __forceinline__ void done(const Unit&) const {}
    __device__ __forceinline__ unsigned row_off(const Unit&, int) const { return 0u; }
    __device__ __forceinline__ unsigned row_off_lds(const Unit&, int) const { return 0u; }
    __device__ __forceinline__ void prefetch_rows(const Unit&) const {}
};
struct SchedMoe {
    int G, c, nnt, ntiles, P; LAS unsigned char* lds; const int* slotl; const float* gatel; int wave;
    __device__ __forceinline__ bool next(int i, Unit& u) const { const long L = (long)i * G + c; const int ntp = (ntiles + P - 1) / P, ppg = nnt / (8 / P); if (L >= (long)ntp * ppg * 8) return false;
        const LAS int* tpre = (const LAS int*)(lds + LDSCTL_OFF + 64); const LAS int* ecnt = (const LAS int*)(lds + LDSCTL_OFF + 256); const LAS unsigned short* tile_e = (const LAS unsigned short*)(lds + LDSCTL_OFF + 512);
        const int xq = (int)(L >> 3), x8 = (int)(L & 7); int tile = (xq / ppg) * P + (x8 % P); const int pnl = (x8 / P) * ppg + xq % ppg; const bool dead = tile >= ntiles; tile = dead ? 0 : tile;
        const int e = __builtin_amdgcn_readfirstlane((int)tile_e[tile]), r0 = (tile - __builtin_amdgcn_readfirstlane(tpre[e])) * 256; int nv = __builtin_amdgcn_readfirstlane(ecnt[e]) - r0; nv = nv > 256 ? 256 : nv; nv = dead ? 0 : nv;
        u.pm = dead ? MAXTILES : tile; u.pn = e * nnt + pnl; u.e = e; u.nv = nv | (r0 << 9); u.par = i & 1; return true; }
    __device__ __forceinline__ void a_ready(const Unit& u) const {
        if (gatel != nullptr && wave == 0) { const size_t li = (size_t)u.e * T + (u.nv >> 9) + 4 * lane_id();
            __builtin_amdgcn_global_load_lds((const unsigned*)(slotl + li), (LAS unsigned*)(lds + LDSCTL_OFF + 8192 + 2048 * u.par), 16, 0, 0);
            __builtin_amdgcn_global_load_lds((const unsigned*)(gatel + li), (LAS unsigned*)(lds + LDSCTL_OFF + 8192 + 2048 * u.par + 1024), 16, 0, 0); } }
    __device__ __forceinline__ void done(const Unit&) const {}
    __device__ __forceinline__ void prefetch_rows(const Unit& u) const {
        if (wave == 0) __builtin_amdgcn_global_load_lds((const unsigned*)(slotl + (size_t)u.e * T + (u.nv >> 9) + 4 * lane_id()), (LAS unsigned*)(lds + LDSCTL_OFF + 8192 + 2048 * u.par), 16, 0, 0); }
    __device__ __forceinline__ unsigned row_off_lds(const Unit& u, int r) const { const int nv = u.nv & 511; const int sl = ((const LAS int*)(lds + LDSCTL_OFF + 8192 + 2048 * u.par))[r]; const int tok = r < nv ? (sl >> 2) : 0; return (unsigned)tok * 2048u; }
    __device__ __forceinline__ unsigned row_off(const Unit& u, int r) const { const int nv = u.nv & 511, r0 = u.nv >> 9; const int tok = r < nv ? (slotl[(size_t)u.e * T + r0 + r] >> 2) : 0; return (unsigned)tok * 2048u; }
};

using pg8::cvt_pk_bf16;
template <class P> __device__ __forceinline__ P* pin_ptr(P* p) { asm volatile("" : "+v"(p)); return p; }
struct EpiB1 {
    static constexpr bool PERM = true, AFTER_DRAIN = false;
    bf16* RKV; bf16* L1;
    __device__ __forceinline__ void operator()(const f32x4 (&acc)[2][2][4][2], const Unit& u, int wr, int wc, int fr, int fq) const {
        const int seg = u.e, row0 = u.nv * 256 + wr * 64 + fr;
        const int jj = seg - 3, ld = seg < 3 ? D : 128, col0 = (seg < 3 ? (u.pn - seg * 4) * 256 : 0) + wc * 32 + 8 * fq;
        bf16* base = seg < 3 ? RKV + (size_t)seg * T * D : L1 + (size_t)jj * T * 128;
#pragma unroll
        for (int ai = 0; ai < 2; ++ai)
#pragma unroll
            for (int m = 0; m < 4; ++m) { bf16* rowp = base + (size_t)(row0 + ai * 128 + m * 16) * ld + col0;
#pragma unroll
                for (int bj = 0; bj < 2; ++bj) { if (seg >= 3 && bj == 1) continue; f32x4 v0 = acc[ai][bj][m][0], v1 = acc[ai][bj][m][1];
                    if (jj == 0) {
#pragma unroll
                        for (int q = 0; q < 4; ++q) { v0[q] = tanh_fast(v0[q]); v1[q] = tanh_fast(v1[q]); } }
                    else if (jj == 2) {
#pragma unroll
                        for (int q = 0; q < 4; ++q) { v0[q] = sigm(v0[q]); v1[q] = sigm(v1[q]); } }
                    u32x4 w; w.x = cvt_pk_bf16(v0[0], v0[1]); w.y = cvt_pk_bf16(v0[2], v0[3]); w.z = cvt_pk_bf16(v1[0], v1[1]); w.w = cvt_pk_bf16(v1[2], v1[3]);
                    *(u32x4*)(rowp + bj * 128) = w; } }
    }
};
struct EpiB2 {
    static constexpr bool PERM = true, AFTER_DRAIN = false;
    bf16* RW; bf16* RA; bf16* Gg;
    __device__ __forceinline__ void operator()(const f32x4 (&acc)[2][2][4][2], const Unit& u, int wr, int wc, int fr, int fq) const {
        const int jj = u.e, row0 = u.nv * 256 + wr * 64 + fr, pnl = u.pn - jj * 8;
        const int dirn = jj < 2 ? (pnl >> 2) : 0, col0 = (jj < 2 ? (pnl & 3) : pnl) * 256 + wc * 32 + 8 * fq;
        bf16* base = (jj == 0 ? RW : jj == 1 ? RA : Gg) + (size_t)dirn * T * D;
#pragma unroll
        for (int ai = 0; ai < 2; ++ai)
#pragma unroll
            for (int m = 0; m < 4; ++m) { bf16* rowp = base + (size_t)(row0 + ai * 128 + m * 16) * D + col0;
#pragma unroll
                for (int bj = 0; bj < 2; ++bj) { const f32x4 v0 = acc[ai][bj][m][0], v1 = acc[ai][bj][m][1];
                    u32x4 w; w.x = cvt_pk_bf16(v0[0], v0[1]); w.y = cvt_pk_bf16(v0[2], v0[3]); w.z = cvt_pk_bf16(v1[0], v1[1]); w.w = cvt_pk_bf16(v1[2], v1[3]);
                    *(u32x4*)(rowp + bj * 128) = w; } }
    }
};
struct EpiRes {
    static constexpr bool PERM = true, AFTER_DRAIN = false;
    float* X; const float* gate; float* Xo;
    __device__ __forceinline__ void operator()(const f32x4 (&acc)[2][2][4][2], const Unit& u, int wr, int wc, int fr, int fq) const {
        const int row0 = u.pm * 256 + wr * 64 + fr, col0 = u.pn * 256 + wc * 32 + 8 * fq, mr = u.pm < NMT_L ? (u.pm >> 5) : 4;
        const float* gp = pin_ptr(gate + (size_t)mr * 6144 + col0);
        f32x4 gv[2][2];
#pragma unroll
        for (int bj = 0; bj < 2; ++bj)
#pragma unroll
            for (int n = 0; n < 2; ++n) gv[bj][n] = *(const f32x4*)(gp + bj * 128 + 4 * n);
        f32x4 xa[2][2][2], xb[2][2][2];
#define ER_LOAD(dst, b_) do { _Pragma("unroll") for (int m = 0; m < 2; ++m) _Pragma("unroll") for (int bj = 0; bj < 2; ++bj) _Pragma("unroll") for (int n = 0; n < 2; ++n) \
            dst[m][bj][n] = *(const f32x4*)(X + (size_t)(row0 + ((b_) >> 1) * 128 + (((b_) & 1) * 2 + m) * 16) * D + col0 + bj * 128 + 4 * n); } while (0)
#define ER_STORE(src, b_) do { _Pragma("unroll") for (int m = 0; m < 2; ++m) _Pragma("unroll") for (int bj = 0; bj < 2; ++bj) _Pragma("unroll") for (int n = 0; n < 2; ++n) \
            *(f32x4*)(Xo + (size_t)(row0 + ((b_) >> 1) * 128 + (((b_) & 1) * 2 + m) * 16) * D + col0 + bj * 128 + 4 * n) = src[m][bj][n] + gv[bj][n] * acc[(b_) >> 1][bj][((b_) & 1) * 2 + m][n]; } while (0)
        ER_LOAD(xa, 0); ER_LOAD(xb, 1); ER_STORE(xa, 0); ER_LOAD(xa, 2); ER_STORE(xb, 1); ER_LOAD(xb, 3); ER_STORE(xa, 2); ER_STORE(xb, 3);
#undef ER_LOAD
#undef ER_STORE
    }
};
struct EpiWin {
    static constexpr bool PERM = true, AFTER_DRAIN = false;
    bf16* BG; bf16* CU;
    __device__ __forceinline__ void operator()(const f32x4 (&acc)[2][2][4][2], const Unit& u, int wr, int wc, int fr, int fq) const {
        const int row0 = u.pm * 256 + wr * 64 + fr;
        if (u.pn < 4) {
            const int col0 = u.pn * 256 + wc * 32 + 8 * fq;
#pragma unroll
            for (int ai = 0; ai < 2; ++ai)
#pragma unroll
                for (int m = 0; m < 4; ++m) { bf16* rowp = BG + (size_t)(row0 + ai * 128 + m * 16) * D + col0;
#pragma unroll
                    for (int bj = 0; bj < 2; ++bj) { const f32x4 v0 = acc[ai][bj][m][0], v1 = acc[ai][bj][m][1];
                        u32x4 w; w.x = cvt_pk_bf16(v0[0], v0[1]); w.y = cvt_pk_bf16(v0[2], v0[3]); w.z = cvt_pk_bf16(v1[0], v1[1]); w.w = cvt_pk_bf16(v1[2], v1[3]);
                        *(u32x4*)(rowp + bj * 128) = w; } }
        } else {
            const int f0 = (u.pn - 4) * 128 + wc * 32 + 8 * fq;
#pragma unroll
            for (int ai = 0; ai < 2; ++ai)
#pragma unroll
                for (int m = 0; m < 4; ++m) { const f32x4 v0 = acc[ai][0][m][0] * acc[ai][1][m][0], v1 = acc[ai][0][m][1] * acc[ai][1][m][1];
                    u32x4 w; w.x = cvt_pk_bf16(v0[0], v0[1]); w.y = cvt_pk_bf16(v0[2], v0[3]); w.z = cvt_pk_bf16(v1[0], v1[1]); w.w = cvt_pk_bf16(v1[2], v1[3]);
                    *(u32x4*)(CU + (size_t)(row0 + ai * 128 + m * 16) * D + f0) = w; }
        }
    }
};
struct EpiGU {
    static constexpr bool PERM = true, AFTER_DRAIN = false;
    bf16* INTER; const float* bgu;
    __device__ __forceinline__ void operator()(const f32x4 (&acc)[2][2][4][2], const Unit& u, int wr, int wc, int fr, int fq) const {
        const int e = u.e, pnl = u.pn - e * 8, row0 = u.pm * 256 + wr * 64 + fr, f0 = pnl * 128 + wc * 32 + 8 * fq;
        typedef const __attribute__((address_space(1))) f32x4* GF4;
        const GF4 bp = (GF4)pin_ptr(bgu + (size_t)e * 2048 + f0);
        f32x4 bg[2], bu[2];
#pragma unroll
        for (int n = 0; n < 2; ++n) { bg[n] = bp[n]; bu[n] = bp[256 + n] + 1.0f; }
#pragma unroll
        for (int ai = 0; ai < 2; ++ai)
#pragma unroll
            for (int m = 0; m < 4; ++m) { f32x4 o[2];
#pragma unroll
                for (int n = 0; n < 2; ++n) { const f32x4 g = acc[ai][0][m][n] + bg[n], uu = acc[ai][1][m][n] + bu[n];
#pragma unroll
                    for (int q = 0; q < 4; ++q) { const float gc = fminf(g[q], 7.0f), uc1 = fminf(fmaxf(uu[q], -6.0f), 8.0f);
                        o[n][q] = uc1 * gc * frcp(1.0f + __builtin_amdgcn_exp2f(gc * (-1.702f * 1.44269504f))); } }
                u32x4 w; w.x = cvt_pk_bf16(o[0][0], o[0][1]); w.y = cvt_pk_bf16(o[0][2], o[0][3]); w.z = cvt_pk_bf16(o[1][0], o[1][1]); w.w = cvt_pk_bf16(o[1][2], o[1][3]);
                *(u32x4*)(INTER + (size_t)(row0 + ai * 128 + m * 16) * 1024 + f0) = w; }
    }
};
struct EpiDown {
    static constexpr bool PERM = true, AFTER_DRAIN = false;
    bf16* YS; const float* bdn; LAS unsigned char* lds;
    __device__ __forceinline__ void operator()(const f32x4 (&acc)[2][2][4][2], const Unit& u, int wr, int wc, int fr, int fq) const {
        const int e = u.e, pnl = u.pn - e * 4, col0 = pnl * 256 + wc * 32 + 8 * fq, nv = u.nv & 511;
        typedef const __attribute__((address_space(1))) f32x4* GF4;
        const GF4 bp = (GF4)pin_ptr(bdn + (size_t)e * 1024 + col0);
        f32x4 bv[2][2];
#pragma unroll
        for (int bj = 0; bj < 2; ++bj)
#pragma unroll
            for (int n = 0; n < 2; ++n) bv[bj][n] = bp[bj * 32 + n];
        const LAS int* sl = (const LAS int*)(lds + LDSCTL_OFF + 8192 + 2048 * u.par);
        int slot8[2][4]; float gt8[2][4];
#pragma unroll
        for (int ai = 0; ai < 2; ++ai)
#pragma unroll
            for (int m = 0; m < 4; ++m) { const int r = ai * 128 + wr * 64 + m * 16 + fr; slot8[ai][m] = sl[r]; gt8[ai][m] = ((const LAS float*)(sl + 256))[r]; }
#pragma unroll
        for (int ai = 0; ai < 2; ++ai) asm volatile("" : "+v"(slot8[ai][0]), "+v"(slot8[ai][1]), "+v"(slot8[ai][2]), "+v"(slot8[ai][3]), "+v"(gt8[ai][0]), "+v"(gt8[ai][1]), "+v"(gt8[ai][2]), "+v"(gt8[ai][3]));
        asm volatile("" : "+v"(bv[0][0]), "+v"(bv[0][1]), "+v"(bv[1][0]), "+v"(bv[1][1]));
#pragma unroll
        for (int ai = 0; ai < 2; ++ai)
#pragma unroll
            for (int m = 0; m < 4; ++m) { const int r = ai * 128 + wr * 64 + m * 16 + fr;
                if (r < nv) { const int slot = slot8[ai][m]; const float gt = gt8[ai][m];
                    bf16* rowp = YS + (size_t)slot * 1024 + col0;
#pragma unroll
                    for (int bj = 0; bj < 2; ++bj) { const f32x4 v0 = (acc[ai][bj][m][0] + bv[bj][0]) * gt, v1 = (acc[ai][bj][m][1] + bv[bj][1]) * gt;
                        u32x4 w; w.x = cvt_pk_bf16(v0[0], v0[1]); w.y = cvt_pk_bf16(v0[2], v0[3]); w.z = cvt_pk_bf16(v1[0], v1[1]); w.w = cvt_pk_bf16(v1[2], v1[3]);
                        *(u32x4*)(rowp + bj * 128) = w; } } }
    }
};

__device__ __forceinline__ int moe_tables(const unsigned* cnt, LAS unsigned char* lds, int tid) {
    LAS int* tpre = (LAS int*)(lds + LDSCTL_OFF + 64); LAS int* ecnt = (LAS int*)(lds + LDSCTL_OFF + 256); LAS unsigned short* tile_e = (LAS unsigned short*)(lds + LDSCTL_OFF + 512);
    if (tid < 64) { const int e = tid & 31;
        const int cn = tid < 32 ? (int)__hip_atomic_load(cnt + e * CNT_STRIDE, __ATOMIC_RELAXED, __HIP_MEMORY_SCOPE_AGENT) : 0;
        const int tl = (cn + 255) >> 8; int incl = tl;
#pragma unroll
        for (int d = 1; d < 32; d <<= 1) { const int o = __shfl_up(incl, d); if (tid >= d) incl += o; }
        if (tid < 32) { ecnt[e] = cn; tpre[e] = incl - tl; }
        if (tid == 31) tpre[32] = incl; }
    __syncthreads();
    const int nt = tpre[32];
    { const int e = tid >> 4, sub = tid & 15, t1 = tpre[e + 1]; for (int t = tpre[e] + sub; t < t1; t += 16) tile_e[t] = (unsigned short)e; }
    __syncthreads();
    return nt;
}

constexpr int NPHASES = 37;
typedef const Args __attribute__((address_space(4))) CArgs;
__global__ void __attribute__((amdgpu_flat_work_group_size(512, 512), amdgpu_waves_per_eu(2, 2))) fwd_kernel(Args a_) {
    extern __shared__ __attribute__((aligned(16))) unsigned char lds_raw[];
    LAS unsigned char* lds = (LAS unsigned char*)lds_raw;
    const int G = gridDim.x, NGW = G * 8;
    CArgs* ap0 = (CArgs*)__builtin_amdgcn_kernarg_segment_ptr();
    if (threadIdx.x < 4) ((LAS unsigned*)(lds + LDSCTL_OFF))[threadIdx.x] = 0u;
    __syncthreads();
    XcdBarrier bar = xcd_barrier_post((unsigned*)(a_.ws + WS_CTL) + CW_BAR, (volatile LAS unsigned*)(lds + LDSCTL_OFF));
    const int lo = a_.ph_lo, hi = a_.ph_hi;
    int ph = 0;
#ifndef MK_ONLY
#define MK_ONLY -1
#endif
#ifndef MK_DBL
#define MK_DBL 0
#endif
#ifdef MK_MARK
#define PH_MARK(s) asm volatile("; ##" s)
#else
#define PH_MARK(s)
#endif
#define PH_BEGIN(id) if ((MK_ONLY < 0 || MK_ONLY == (id)) && ph >= lo && ph < hi) { for (int rep_ = 0; rep_ <= ((MK_DBL >> (id)) & 1); ++rep_) { PH_MARK("PH_BEGIN"); CArgs* ap = ap0; asm volatile("" : "+s"(ap)); const Args a = *(const Args*)ap; unsigned char* const ws = a.ws; (void)ws; const int wave = (int)bar.wv; int tid = wave * 64 + lane_id(); asm volatile("" : "+v"(tid)); const int lane = tid & 63, gw = blockIdx.x * 8 + wave; (void)lane; (void)gw;
#define PH_END PH_MARK("PH_END"); } } if (ph >= lo && ph + 1 < hi) xcd_barrier(bar); ++ph;

    PH_BEGIN(0) p0_prologue(a, lds, tid, lane, wave, G); PH_END

#pragma unroll 1
    for (int layer = 0; layer < DEPTH; ++layer) {
        const int kind = layer & 1, lj = layer >> 1;
        const int rows = layer == 3 ? TL : T, nmt = rows / 256;
        const int rows_moe = layer < 2 ? T : TL;
        if (kind == 0) {
            PH_BEGIN(1) phase_a_rwkv(a, layer, lds, tid, gw, NGW, lane); PH_END
            PH_BEGIN(2) {
                pg8::Gemm g{(const bf16*)(ws + WS_XL), (const bf16*)(ws + WS_WRKV) + (size_t)lj * 3840 * 1024, 6 * T, 3840, 1024};
                SchedB1 S{G, (int)blockIdx.x}; EpiB1 E{(bf16*)(ws + WS_RKV), (bf16*)(ws + WS_L1)};
                pg8::gemm_phase<EpiB1, SchedB1, true, true, false>(lds, g, S, E, tid); } PH_END
            PH_BEGIN(3) {
                pg8::Gemm g{(const bf16*)(ws + WS_L1), (const bf16*)(ws + WS_L2T) + (size_t)lj * 5120 * 128, 3 * T, 5120, 128};
                SchedB2 S{G, (int)blockIdx.x}; EpiB2 E{(bf16*)(ws + WS_RAWW), (bf16*)(ws + WS_RAWA), (bf16*)(ws + WS_G)};
                pg8::gemm_phase<EpiB2, SchedB2, true, true, false>(lds, g, S, E, tid); } PH_END
            PH_BEGIN(5) phase_s1_chunks(a, lj, lds, tid, G, (MK_DBL >> 5) & 1 & (rep_ == 0)); PH_END
            PH_BEGIN(15) phase_s2_chain(a, wave, lane, G); PH_END
            PH_BEGIN(6) phase_s3_readout(a, lj, layer == 2 ? TL : T, gw, NGW, lane); PH_END
        } else {
            PH_BEGIN(7) phase_a_conv(a, layer, rows, gw, NGW, lane); PH_END
            PH_BEGIN(8) {
                pg8::Gemm g{(const bf16*)(ws + WS_XL), (const bf16*)(ws + WS_WIN) + (size_t)lj * 3072 * 1024, rows, 3072, 1024};
                SchedStd S{G, (int)blockIdx.x, nmt, 12}; EpiWin E{(bf16*)(ws + WS_BG), (bf16*)(ws + WS_CUZ)};
                pg8::gemm_phase<EpiWin, SchedStd, true, true, false>(lds, g, S, E, tid); } PH_END
            PH_BEGIN(9) phase_cv(a, lj, rows, gw, NGW, lane); PH_END
        }
        PH_BEGIN(10) {
            const bf16* Wt = kind == 0 ? (const bf16*)(ws + WS_WO) + (size_t)lj * 1024 * 1024 : (const bf16*)(ws + WS_WOUT) + (size_t)lj * 1024 * 1024;
            pg8::Gemm g{(const bf16*)(ws + WS_Z), Wt, rows, 1024, 1024};
            SchedStd S{G, (int)blockIdx.x, layer == 2 ? NMT_L : nmt, 4}; EpiRes E{(float*)(ws + (layer < 2 ? WS_XSA : WS_XSB)), (const float*)(ws + WS_MODS) + (size_t)layer * 5 * 6144 + 2 * 1024, (float*)(ws + (rep_ ? WS_XL : (layer < 2 ? WS_XSA : WS_XSB)))};
            pg8::gemm_phase<EpiRes, SchedStd, true, true, false>(lds, g, S, E, tid); } PH_END
        PH_BEGIN(11) phase_e_route_mfma(a, layer, rows_moe, lds, tid, wave, gw, NGW, lane, rep_); PH_END
        PH_BEGIN(12) {
            const int nt = __builtin_amdgcn_readfirstlane(moe_tables((const unsigned*)(ws + WS_CTL) + CW_CNT + layer * 32 * CNT_STRIDE, lds, tid));
            pg8::Gemm g{(const bf16*)(ws + WS_H2), (const bf16*)(ws + WS_WGU) + (size_t)layer * 32 * 2048 * 1024, 0, 0, 1024};
            SchedMoe S{G, (int)blockIdx.x, 8, nt, 2, lds, (const int*)(ws + WS_SLOTL), nullptr, wave};
            EpiGU E{(bf16*)(ws + WS_INTER), a.in[30] + (size_t)layer * 32 * 2048};
            pg8::gemm_phase<EpiGU, SchedMoe, true, true, true>(lds, g, S, E, tid); } PH_END
        PH_BEGIN(13) {
            const int nt = __builtin_amdgcn_readfirstlane(moe_tables((const unsigned*)(ws + WS_CTL) + CW_CNT + layer * 32 * CNT_STRIDE, lds, tid));
            pg8::Gemm g{(const bf16*)(ws + WS_INTER), (const bf16*)(ws + WS_WDN) + (size_t)layer * 32 * 1024 * 1024, 0, 0, 1024};
            SchedMoe S{G, (int)blockIdx.x, 4, nt, 8, lds, (const int*)(ws + WS_SLOTL), (const float*)(ws + WS_GATEL), wave};
            EpiDown E{(bf16*)(ws + WS_YS), a.in[32] + (size_t)layer * 32 * 1024, lds};
            pg8::gemm_phase<EpiDown, SchedMoe, true, true, false>(lds, g, S, E, tid); } PH_END
    }
    PH_BEGIN(14) phase_final(a, gw, NGW, lane); PH_END
#undef PH_BEGIN
#undef PH_END
}

extern "C" void kernel_launch(void* const* d_in, const int* in_sizes, int n_in, void* d_out, int out_size, void* d_ws, size_t ws_size, hipStream_t stream) {
    static int grid = 0;
    if (grid == 0) {
        if (n_in != 33 || in_sizes[0] != TL * D || out_size != TL * D || ws_size < WS_END) { fprintf(stderr, "kernel_launch: unexpected problem (n_in %d, in0 %d, out %d, ws %zu < %zu)\n", n_in, n_in > 0 ? in_sizes[0] : -1, out_size, ws_size, (size_t)WS_END); grid = -1; return; }
        int dev = 0, cus = 0, per_cu = 0;
        if (hipGetDevice(&dev) != hipSuccess || hipDeviceGetAttribute(&cus, hipDeviceAttributeMultiprocessorCount, dev) != hipSuccess) { grid = -1; return; }
        if (hipFuncSetAttribute((const void*)fwd_kernel, hipFuncAttributeMaxDynamicSharedMemorySize, LDS_BYTES) != hipSuccess) { fprintf(stderr, "kernel_launch: hipFuncSetAttribute failed\n"); grid = -1; return; }
        if (hipOccupancyMaxActiveBlocksPerMultiprocessor(&per_cu, (const void*)fwd_kernel, 512, LDS_BYTES) != hipSuccess || per_cu < 1) fprintf(stderr, "kernel_launch: occupancy query says %d\n", per_cu);
        (void)hipGetLastError();
        grid = cus;
    }
    if (grid < 0) return;
    if (hipMemsetAsync((char*)d_ws + WS_CTL, 0, CTL_ZERO_BYTES, stream) != hipSuccess) return;
    Args a{};
    for (int i = 0; i < 33; ++i) a.in[i] = (const float*)d_in[i];
    a.out = (float*)d_out; a.ws = (unsigned char*)d_ws;
#if MK_PER_PHASE
    for (int p = 0; p < NPHASES; ++p) { a.ph_lo = p; a.ph_hi = p + 1; hipLaunchKernelGGL(fwd_kernel, dim3(grid), dim3(512), LDS_BYTES, stream, a); }
#else
    a.ph_lo = 0; a.ph_hi = NPHASES;
    hipLaunchKernelGGL(fwd_kernel, dim3(grid), dim3(512), LDS_BYTES, stream, a);
#endif
    const hipError_t le = hipPeekAtLastError();
    if (le != hipSuccess) fprintf(stderr, "kernel_launch: launch failed: %s\n", hipGetErrorName(le));
}
```

```cpp
#include <hip/hip_runtime.h>
#include <cstdio>
#include <cstdint>

#ifndef MK_PER_PHASE
#define MK_PER_PHASE 0
#endif

constexpr int D = 1024, NBATCH = 4, SEQ = 8192, TL = NBATCH * SEQ, CTXL = 256, TC = NBATCH * CTXL, T = TL + TC;
constexpr int NH = 16, HS = 64, NE = 32, TOPK = 4, DEPTH = 4;
constexpr int NMT = T / 256;
constexpr int NMT_L = TL / 256;
constexpr int MAXTILES = (T * TOPK) / 256 + NE;
constexpr int NSTEP = CTXL + SEQ;

__device__ __forceinline__ int lane_id() { return (int)__builtin_amdgcn_mbcnt_hi(~0u, __builtin_amdgcn_mbcnt_lo(~0u, 0u)); }
namespace pg8 {
#define PG8_LAS __attribute__((address_space(3)))
typedef unsigned short bf16_t;
typedef short bf16x8 __attribute__((ext_vector_type(8)));
typedef float f32x4 __attribute__((ext_vector_type(4)));
typedef unsigned u32x4 __attribute__((ext_vector_type(4)));
typedef unsigned u32x2 __attribute__((ext_vector_type(2)));
constexpr int BM = 256, BK = 64, HALF = 128, HTB = HALF * BK * 2  , STAGE_BYTES = 8 * HTB, NXCD = 8, WGM = 8;

__host__ __device__ __forceinline__ int lds_byte(int r, int c) { const int st = (r >> 4) * 2 + (c >> 5), rr = r & 15, cc = c & 31, ob = rr * 64 + cc * 2; return st * 1024 + (ob ^ (((ob >> 9) & 1) << 5)); }
__host__ __device__ __forceinline__ void stage_rc(int b, int& R, int& C) { const int st = b / 1024, sb = b % 1024, swz = sb ^ (((sb >> 9) & 1) << 5); R = (st >> 1) * 16 + swz / 64; C = (st & 1) * 32 + (swz % 64) / 2; }
__host__ __device__ __forceinline__ int perm32(int rho) { const int n = rho >> 4, i = rho & 15; return 8 * (i >> 2) + 4 * n + (i & 3); }

struct Unit { int pm, pn, e, nv, par; };
struct Gemm { const bf16_t* A; const bf16_t* Bt; int M, N, K; };

__device__ __forceinline__ void tile_map(int wgid, int nM, int nN, int& pm, int& pn) {
    const int nwg = nM * nN;
    { const int q = nwg / NXCD, r = nwg % NXCD, xcd = wgid % NXCD, off = wgid / NXCD; wgid = (xcd < r ? xcd * (q + 1) : r * (q + 1) + (xcd - r) * q) + off; }
    const int nig = WGM * nN, gid = wgid / nig, fm = gid * WGM, gsz = (nM - fm) < WGM ? (nM - fm) : WGM;
    pm = fm + ((wgid % nig) % gsz); pn = (wgid % nig) / gsz;
}
typedef __bf16 bf16x2_t __attribute__((ext_vector_type(2)));
typedef float f32x2_t __attribute__((ext_vector_type(2)));
__device__ __forceinline__ unsigned cvt_pk_bf16(float lo, float hi) { const f32x2_t v = {lo, hi}; const bf16x2_t b = __builtin_convertvector(v, bf16x2_t); return __builtin_bit_cast(unsigned, b); }

template <class Epi, class Sched, bool ALIGN_EPI = false, bool SP2 = false, bool GATHER = false>
__device__ __forceinline__ void gemm_phase(PG8_LAS unsigned char* lds, const Gemm g, const Sched& S, const Epi& E, int tid_in) {
    int tid_ = tid_in; asm volatile("" : "+v"(tid_));
    const int tid = tid_, wid = __builtin_amdgcn_readfirstlane(tid >> 6), lane = tid & 63, wr = wid >> 2, wc = wid & 3, fr = lane & 15, fq = lane >> 4;
    int K_ = g.K; asm volatile("" : "+s"(K_));
    const int K = K_, nt = K / BK;
    unsigned voffA[2], voffB[2]; int gR[2]; unsigned gC[2];
#pragma unroll
    for (int i = 0; i < 2; ++i) { int R, C; stage_rc(tid * 16 + i * 8192, R, C); const int Rb = Epi::PERM ? ((R & ~31) + perm32(R & 31)) : R;
        voffA[i] = (unsigned)(R * K + C) * 2u; voffB[i] = (unsigned)(Rb * K + C) * 2u; gR[i] = R; gC[i] = (unsigned)C * 2u; }
    unsigned oc[2][2], on[2][2], o2[2][2];
#pragma unroll
    for (int h = 0; h < 2; ++h)
#pragma unroll
        for (int i = 0; i < 2; ++i) { oc[h][i] = 0u; on[h][i] = 0u; o2[h][i] = 0u; }
    const size_t kstep = (size_t)(BK * 2);
    const size_t hstep = (size_t)HALF * K * 2;
    const size_t tstep = 2 * hstep;
    const unsigned ldsw = (unsigned)wid * 1024u;
    const int aoff = lds_byte(wr * 64 + fr, fq * 8), boff = lds_byte(wc * 32 + fr, fq * 8);
#define PG8_SA(b, h) (((b) * 2 + (h)) * HTB)
#define PG8_SB(b, h) ((4 + (b) * 2 + (h)) * HTB)
#define PG8_STAGE(bufoff, gbase, voff) do { _Pragma("unroll") for (int _i = 0; _i < 2; ++_i) \
        __builtin_amdgcn_global_load_lds((const unsigned*)((const char*)(gbase) + (voff)[_i]), (PG8_LAS unsigned*)(lds + (bufoff) + ldsw + _i * 8192), 16, 0, 0); } while (0)
#define PG8_STAGE_A(bufoff, base, h, O) do { if constexpr (GATHER) { PG8_STAGE(bufoff, base, (O)[h]); } else { PG8_STAGE(bufoff, (base) + (h) * hstep, voffA); } } while (0)
#define PG8_LDA(dst, b, h) do { _Pragma("unroll") for (int m = 0; m < 4; ++m) _Pragma("unroll") for (int k = 0; k < 2; ++k) dst[m][k] = *(const PG8_LAS bf16x8*)(lds + PG8_SA(b, h) + aoff + m * 2048 + k * 1024); } while (0)
#define PG8_LDB(dst, b, h) do { _Pragma("unroll") for (int n = 0; n < 2; ++n) _Pragma("unroll") for (int k = 0; k < 2; ++k) dst[n][k] = *(const PG8_LAS bf16x8*)(lds + PG8_SB(b, h) + boff + n * 2048 + k * 1024); } while (0)
#define PG8_MMA(ai, bj, At, Bt) do { __builtin_amdgcn_s_setprio(1); _Pragma("unroll") for (int m = 0; m < 4; ++m) _Pragma("unroll") for (int n = 0; n < 2; ++n) _Pragma("unroll") for (int k = 0; k < 2; ++k) \
        acc[ai][bj][m][n] = __builtin_amdgcn_mfma_f32_16x16x32_bf16(Bt[n][k], At[m][k], acc[ai][bj][m][n], 0, 0, 0); __builtin_amdgcn_s_setprio(0); } while (0)
#define PG8_WAIT_V(n) asm volatile("s_waitcnt vmcnt(" #n ")" ::: "memory")
#define PG8_WAIT_L(n) asm volatile("s_waitcnt lgkmcnt(" #n ")" ::: "memory")
#define PG8_BAR __builtin_amdgcn_s_barrier()
#define PG8_SCHED __builtin_amdgcn_sched_barrier(0)
    Unit cur, nxt; int ui = 0;
    if (!S.next(0, cur)) return;
    f32x4 acc[2][2][4][2];
#pragma unroll
    for (int a = 0; a < 2; ++a)
#pragma unroll
        for (int b = 0; b < 2; ++b)
#pragma unroll
            for (int m = 0; m < 4; ++m)
#pragma unroll
                for (int n = 0; n < 2; ++n) acc[a][b][m][n] = (f32x4){0.f, 0.f, 0.f, 0.f};
    bf16x8 At[4][2], B0[2][2], B1[2][2];
    const char* cA = GATHER ? (const char*)g.A : (const char*)g.A + (size_t)cur.pm * tstep; const char* cB = (const char*)g.Bt + (size_t)cur.pn * tstep;
    S.a_ready(cur);
    if constexpr (GATHER) {
#pragma unroll
        for (int h = 0; h < 2; ++h)
#pragma unroll
            for (int i = 0; i < 2; ++i) oc[h][i] = S.row_off(cur, h * HALF + gR[i]) + gC[i];
    }
    if constexpr (SP2) {
        PG8_STAGE(PG8_SB(0, 0), cB, voffB); PG8_STAGE(PG8_SB(0, 1), cB + hstep, voffB); PG8_STAGE_A(PG8_SA(0, 0), cA, 0, oc); PG8_STAGE_A(PG8_SA(0, 1), cA, 1, oc);
        if (wr == 1) PG8_BAR;
        PG8_WAIT_V(2); PG8_BAR;
        PG8_STAGE(PG8_SB(1, 0), cB + kstep, voffB); PG8_STAGE_A(PG8_SA(1, 0), cA + kstep, 0, oc); PG8_STAGE(PG8_SB(1, 1), cB + hstep + kstep, voffB);
        PG8_WAIT_V(6); PG8_BAR;
    } else {
        PG8_STAGE(PG8_SB(0, 0), cB, voffB); PG8_STAGE_A(PG8_SA(0, 0), cA, 0, oc); PG8_STAGE(PG8_SB(0, 1), cB + hstep, voffB); PG8_STAGE_A(PG8_SA(0, 1), cA, 1, oc);
        if (wr == 1) PG8_BAR;
        PG8_WAIT_V(4); PG8_BAR;
        PG8_STAGE(PG8_SB(1, 0), cB + kstep, voffB); PG8_STAGE_A(PG8_SA(1, 0), cA + kstep, 0, oc); PG8_STAGE(PG8_SB(1, 1), cB + hstep + kstep, voffB);
        PG8_WAIT_V(6); PG8_BAR;
    }
    for (;;) {
        const bool has_next = S.next(ui + 1, nxt);
        const char* nA = GATHER ? (const char*)g.A : (has_next ? (const char*)g.A + (size_t)nxt.pm * tstep : cA); const char* nB = has_next ? (const char*)g.Bt + (size_t)nxt.pn * tstep : cB;
        if constexpr (GATHER) { if (has_next) S.prefetch_rows(nxt); }
        for (int t = 0; t < nt; t += 2) {
            const bool last = (t == nt - 2);
            const char* a1 = cA + (size_t)(t + 1) * kstep;
            const char* a2 = last ? nA : cA + (size_t)(t + 2) * kstep; const char* b2 = last ? nB : cB + (size_t)(t + 2) * kstep;
            const char* a3 = a2 + kstep; const char* b3 = b2 + kstep;
            if constexpr (GATHER) {
                if (last) {
#pragma unroll
                    for (int h = 0; h < 2; ++h)
#pragma unroll
                        for (int i = 0; i < 2; ++i) on[h][i] = has_next ? (S.row_off_lds(nxt, h * HALF + gR[i]) + gC[i]) : oc[h][i];
                }
#pragma unroll
                for (int h = 0; h < 2; ++h)
#pragma unroll
                    for (int i = 0; i < 2; ++i) o2[h][i] = last ? on[h][i] : oc[h][i];
            }
            if (last && has_next) S.a_ready(nxt);
            if constexpr (SP2) {
            PG8_LDB(B0, 0, 0); PG8_LDB(B1, 0, 1); PG8_SCHED; PG8_LDA(At, 0, 0); PG8_STAGE_A(PG8_SA(1, 1), a1, 1, oc);
            PG8_WAIT_V(8); PG8_WAIT_L(0); PG8_BAR; PG8_MMA(0, 0, At, B0); PG8_MMA(0, 1, At, B1); PG8_BAR; PG8_SCHED;
            PG8_LDA(At, 0, 1); PG8_STAGE(PG8_SB(0, 0), b2, voffB); PG8_STAGE(PG8_SB(0, 1), b2 + hstep, voffB); PG8_STAGE_A(PG8_SA(0, 0), a2, 0, o2);
            PG8_WAIT_V(8); PG8_WAIT_L(0); PG8_BAR; PG8_MMA(1, 0, At, B0); PG8_MMA(1, 1, At, B1); PG8_BAR; PG8_SCHED;
            PG8_LDB(B0, 1, 0); PG8_LDB(B1, 1, 1); PG8_SCHED; PG8_LDA(At, 1, 0); PG8_STAGE_A(PG8_SA(0, 1), a2, 1, o2);
            PG8_WAIT_V(8); PG8_WAIT_L(0); PG8_BAR; PG8_MMA(0, 0, At, B0); PG8_MMA(0, 1, At, B1); PG8_BAR; PG8_SCHED;
            PG8_LDA(At, 1, 1); PG8_STAGE(PG8_SB(1, 0), b3, voffB); PG8_STAGE(PG8_SB(1, 1), b3 + hstep, voffB); PG8_STAGE_A(PG8_SA(1, 0), a3, 0, o2);
            PG8_WAIT_V(8); PG8_WAIT_L(0); PG8_BAR; PG8_MMA(1, 0, At, B0); PG8_MMA(1, 1, At, B1); PG8_BAR; PG8_SCHED;
            } else {
            PG8_LDB(B0, 0, 0); PG8_SCHED; PG8_LDA(At, 0, 0); PG8_STAGE_A(PG8_SA(1, 1), a1, 1, oc);
            PG8_WAIT_L(8); PG8_BAR; PG8_WAIT_L(0); PG8_MMA(0, 0, At, B0); PG8_BAR; PG8_SCHED;
            PG8_LDB(B1, 0, 1); PG8_STAGE(PG8_SB(0, 0), b2, voffB);
            PG8_BAR; PG8_WAIT_L(0); PG8_MMA(0, 1, At, B1); PG8_BAR;
            PG8_LDA(At, 0, 1); PG8_STAGE_A(PG8_SA(0, 0), a2, 0, o2);
            PG8_BAR; PG8_WAIT_L(0); PG8_MMA(1, 0, At, B0); PG8_BAR; PG8_SCHED;
            PG8_STAGE(PG8_SB(0, 1), b2 + hstep, voffB);
            PG8_WAIT_V(6); PG8_BAR; PG8_MMA(1, 1, At, B1); PG8_BAR;
            PG8_LDB(B0, 1, 0); PG8_SCHED; PG8_LDA(At, 1, 0); PG8_STAGE_A(PG8_SA(0, 1), a2, 1, o2);
            PG8_WAIT_L(8); PG8_BAR; PG8_WAIT_L(0); PG8_MMA(0, 0, At, B0); PG8_BAR; PG8_SCHED;
            PG8_LDB(B1, 1, 1); PG8_STAGE(PG8_SB(1, 0), b3, voffB);
            PG8_BAR; PG8_WAIT_L(0); PG8_MMA(0, 1, At, B1); PG8_BAR;
            PG8_LDA(At, 1, 1); PG8_STAGE_A(PG8_SA(1, 0), a3, 0, o2);
            PG8_BAR; PG8_WAIT_L(0); PG8_MMA(1, 0, At, B0); PG8_BAR; PG8_SCHED;
            PG8_STAGE(PG8_SB(1, 1), b3 + hstep, voffB);
            PG8_WAIT_V(6); PG8_BAR; PG8_MMA(1, 1, At, B1); PG8_BAR;
            }
        }
        if constexpr (ALIGN_EPI) { if (wr == 0) PG8_BAR; }
        if constexpr (!Epi::AFTER_DRAIN) { E(acc, cur, wr, wc, fr, fq); S.done(cur); }
        if (!has_next) break;
#pragma unroll
        for (int a = 0; a < 2; ++a)
#pragma unroll
            for (int b = 0; b < 2; ++b)
#pragma unroll
                for (int m = 0; m < 4; ++m)
#pragma unroll
                    for (int n = 0; n < 2; ++n) acc[a][b][m][n] = (f32x4){0.f, 0.f, 0.f, 0.f};
        cur = nxt; cA = nA; cB = nB; ++ui;
        if constexpr (GATHER) {
#pragma unroll
            for (int h = 0; h < 2; ++h)
#pragma unroll
                for (int i = 0; i < 2; ++i) oc[h][i] = on[h][i];
        }
        if constexpr (ALIGN_EPI) { if (wr == 1) PG8_BAR; }
    }
    PG8_WAIT_V(0);
    if constexpr (!ALIGN_EPI) { if (wr == 0) PG8_BAR; }
    PG8_BAR;
    if constexpr (Epi::AFTER_DRAIN) { E.fused(acc, cur, wr, wc, fr, fq, lds, wid, lane); S.done(cur); }
#undef PG8_SA
#undef PG8_SB
#undef PG8_STAGE
#undef PG8_STAGE_A
#undef PG8_LDA
#undef PG8_LDB
#undef PG8_MMA
#undef PG8_WAIT_V
#undef PG8_WAIT_L
#undef PG8_BAR
#undef PG8_SCHED
}
}

#define LAS __attribute__((address_space(3)))
typedef unsigned short bf16;
typedef float f32x4 __attribute__((ext_vector_type(4)));
typedef unsigned u32x2 __attribute__((ext_vector_type(2)));
typedef unsigned u32x4 __attribute__((ext_vector_type(4)));
#define LDS_WAIT() asm volatile("s_waitcnt lgkmcnt(0)" ::: "memory")
__device__ __forceinline__ unsigned pk2(float lo, float hi) { return pg8::cvt_pk_bf16(lo, hi); }
__device__ __forceinline__ unsigned f2bf(float f) { return pk2(f, f) & 0xffffu; }
__device__ __forceinline__ float bflo(unsigned w) { return __builtin_bit_cast(float, w << 16); }
__device__ __forceinline__ float bfhi(unsigned w) { return __builtin_bit_cast(float, w & 0xffff0000u); }
__device__ __forceinline__ float wave_sum(float v) {
#pragma unroll
    for (int o = 1; o < 64; o <<= 1) v += __shfl_xor(v, o);
    return v;
}
__device__ __forceinline__ float frcp(float x) { return __builtin_amdgcn_rcpf(x); }
__device__ __forceinline__ float sigm(float x) { return frcp(1.0f + __expf(-x)); }
__device__ __forceinline__ float tanh_fast(float x) { const float e = __expf(2.0f * x); return 1.0f - 2.0f * frcp(e + 1.0f); }

constexpr size_t MiB = 1u << 20;
constexpr size_t RF = (size_t)T * D * 4;
constexpr size_t RB = (size_t)T * D * 2;
constexpr size_t WS_CTL = 0, CTL_ZERO_BYTES = 1 * MiB;
constexpr size_t WS_MODS = 1 * MiB;
constexpr size_t WS_XSA = 2 * MiB, WS_XSB = WS_XSA + RF;
constexpr size_t WS_XL = WS_XSB + RF;
constexpr size_t WS_RKV = WS_XL + 6 * RB;
constexpr size_t WS_L1 = WS_RKV + 3 * RF;
constexpr size_t WS_WDEC = WS_L1 + 50 * MiB;
constexpr size_t WS_AA = WS_WDEC + 2 * RF;
constexpr size_t WS_G = WS_AA + 2 * RF;
constexpr size_t WS_KK = WS_G + RB;
constexpr size_t WS_KD = WS_KK + RF;
constexpr size_t WS_BETA = WS_KD + 2 * RF;
constexpr size_t WS_RKB = WS_BETA + 2 * RF;
constexpr size_t WS_C12 = WS_RKB + 3 * MiB;
constexpr size_t WS_WRT = WS_C12 + 6 * MiB;
constexpr size_t WS_Y = WS_C12 + 9 * MiB;
constexpr size_t WS_Z = WS_Y + 2 * RF;
constexpr size_t WS_H2 = WS_Z + RB;
constexpr size_t WS_SLOTL = WS_H2 + RB;
constexpr size_t WS_GATEL = WS_SLOTL + 5 * MiB;
constexpr size_t WS_WRKV = WS_GATEL + 5 * MiB;
constexpr size_t WS_L2T = WS_WRKV + 15 * MiB;
constexpr size_t WS_WO = WS_L2T + 5 * MiB;
constexpr size_t WS_WIN = WS_WO + 4 * MiB;
constexpr size_t WS_WOUT = WS_WIN + 12 * MiB;
constexpr size_t WS_WGU = WS_WOUT + 4 * MiB;
constexpr size_t WS_WDN = WS_WGU + 512 * MiB;
constexpr size_t WS_END = WS_WDN + 256 * MiB;
constexpr size_t WS_INTER = WS_WDEC;
constexpr size_t WS_YS = WS_KD;
constexpr size_t WS_BG = WS_RKV, WS_CUZ = WS_RKV + RB;
constexpr size_t WS_RAWW = WS_AA, WS_RAWA = WS_AA + RF;
constexpr size_t WS_RH = WS_AA;
constexpr size_t WS_PM = WS_WDEC;
constexpr size_t WS_RKB1 = WS_C12 + 1 * MiB;
constexpr size_t WS_QT = WS_XL;
constexpr size_t WS_HT = WS_XL + RF;
static_assert((size_t)128 * 132 * 4096 * 2 <= RF, "chunk state tensors");
static_assert((size_t)MAXTILES * 256 * 1024 * 2 <= 4 * RF, "INTER overlay");
static_assert((size_t)T * 4 * 1024 * 2 <= 2 * RF, "YS overlay");
static_assert((size_t)3 * T * 256 * 2 <= 50 * MiB, "L1OUT");
constexpr int CW_BAR = 4096;
constexpr int CW_CNT = 16384, CNT_STRIDE = 64;

constexpr int RING_BYTES = 131072;
constexpr int LDSCTL_OFF = RING_BYTES + 4096;
constexpr int LDS_BYTES = LDSCTL_OFF + 16384;

struct Args { const float* in[33]; float* out; unsigned char* ws; int ph_lo, ph_hi; };

__device__ __forceinline__ void transpose_item(const float* W, int N, bf16* WT, int dstK, int drow0, int k0, int n0, LAS float* scr, int lane) {
    float tv[64];
    const float* src = W + (size_t)k0 * N + n0 + lane;
#pragma unroll
    for (int i = 0; i < 64; ++i) tv[i] = src[(size_t)i * N];
#pragma unroll
    for (int i = 0; i < 64; ++i) scr[i * 65 + lane] = tv[i];
    LDS_WAIT(); asm volatile("" ::: "memory");
    const int c = lane & 7;
#pragma unroll
    for (int j = 0; j < 8; ++j) { const int n = (lane >> 3) + 8 * j; const LAS float* s = scr + (8 * c) * 65 + n;
        u32x4 o; o.x = pk2(s[0 * 65], s[1 * 65]); o.y = pk2(s[2 * 65], s[3 * 65]); o.z = pk2(s[4 * 65], s[5 * 65]); o.w = pk2(s[6 * 65], s[7 * 65]);
        *(u32x4*)(WT + (size_t)(drow0 + n) * dstK + k0 + 8 * c) = o; }
    LDS_WAIT(); asm volatile("" ::: "memory");
}
__device__ __forceinline__ int gu_map(int n0) { const int bj = n0 >= 1024 ? 1 : 0, f0 = n0 - bj * 1024; return (f0 >> 7) * 256 + bj * 128 + (f0 & 127); }
__device__ __forceinline__ int conv_map(int n0) { if (n0 < 1024) return n0; const int q = (n0 - 1024) >> 10, f0 = (n0 - 1024) & 1023; return 1024 + (f0 >> 7) * 256 + q * 128 + (f0 & 127); }

__device__ __forceinline__ void p0_prologue(const Args& a, LAS unsigned char* lds, int tid, int lane, int wave, int G) {
    unsigned char* ws = a.ws;
    LAS float* sl = (LAS float*)lds;
    LAS float* red = (LAS float*)(lds + 20480);
    for (int i = tid; i < 5 * 1024; i += 512) { const int r = i >> 10, k = i & 1023; const float cv = r < 4 ? a.in[1][r * 1024 + k] : a.in[3][k]; sl[i] = cv * sigm(cv); }
    __syncthreads();
    float* MODS = (float*)(ws + WS_MODS);
    for (int it = blockIdx.x; it < 4 * 96; it += G) {
        const int l = it / 96, n = (it % 96) * 64 + lane;
        const float* W = a.in[4] + (size_t)l * 1024 * 6144 + n;
        float acc[5] = {0.f, 0.f, 0.f, 0.f, 0.f};
        const int kb = wave * 128;
#pragma unroll 32
        for (int k = 0; k < 128; ++k) { const float wv = W[(size_t)(kb + k) * 6144];
#pragma unroll
            for (int r = 0; r < 5; ++r) acc[r] += sl[r * 1024 + kb + k] * wv; }
#pragma unroll
        for (int r = 0; r < 5; ++r) red[(wave * 5 + r) * 64 + lane] = acc[r];
        __syncthreads();
        if (wave < 5) { float s = a.in[5][l * 6144 + n];
#pragma unroll
            for (int w = 0; w < 8; ++w) s += red[(w * 5 + wave) * 64 + lane];
            MODS[(size_t)(l * 5 + wave) * 6144 + n] = s; }
        __syncthreads();
    }
    LAS float* scr = (LAS float*)(lds + wave * 16640);
    static_assert(8 * 16640 <= LDSCTL_OFF, "P0 scratch");
    const int gw = blockIdx.x * 8 + wave, NGW = G * 8;
    bf16* WRKV = (bf16*)(ws + WS_WRKV); bf16* WOt = (bf16*)(ws + WS_WO); bf16* WINt = (bf16*)(ws + WS_WIN); bf16* WOUTt = (bf16*)(ws + WS_WOUT);
    bf16* WGU = (bf16*)(ws + WS_WGU); bf16* WDN = (bf16*)(ws + WS_WDN);
    constexpr int I_GU = 128 * 512, I_DN = 128 * 256, I_RKV = 6 * 256, I_WO = 2 * 256, I_WIN = 2 * 768, I_WOUT = 2 * 256, I_W1 = 4 * 16, I_A1 = 4 * 16, I_G1 = 2 * 32;
    constexpr int NITEMS = I_GU + I_DN + I_RKV + I_WO + I_WIN + I_WOUT + I_W1 + I_A1 + I_G1;
    for (int it = NGW - 1 - gw; it < NITEMS; it += NGW) {
        int r = it;
        if (r < I_GU) { const int m = r >> 9, q = r & 511, kb = q >> 5, nb = q & 31;
            transpose_item(a.in[29] + (size_t)m * 1024 * 2048, 2048, WGU + (size_t)m * 2048 * 1024, 1024, gu_map(nb * 64), kb * 64, nb * 64, scr, lane); continue; } r -= I_GU;
        if (r < I_DN) { const int m = r >> 8, q = r & 255, kb = q >> 4, nb = q & 15;
            transpose_item(a.in[31] + (size_t)m * 1024 * 1024, 1024, WDN + (size_t)m * 1024 * 1024, 1024, nb * 64, kb * 64, nb * 64, scr, lane); continue; } r -= I_DN;
        if (r < I_RKV) { const int m = r >> 8, q = r & 255, kb = q >> 4, nb = q & 15, lr = m / 3, j = m % 3;
            transpose_item(a.in[9] + (size_t)m * 1024 * 1024, 1024, WRKV + (size_t)lr * 3840 * 1024, 1024, j * 1024 + nb * 64, kb * 64, nb * 64, scr, lane); continue; } r -= I_RKV;
        if (r < I_WO) { const int m = r >> 8, q = r & 255, kb = q >> 4, nb = q & 15;
            transpose_item(a.in[23] + (size_t)m * 1024 * 1024, 1024, WOt + (size_t)m * 1024 * 1024, 1024, nb * 64, kb * 64, nb * 64, scr, lane); continue; } r -= I_WO;
        if (r < I_WIN) { const int m = r / 768, q = r % 768, kb = q / 48, nb = q % 48;
            transpose_item(a.in[24] + (size_t)m * 1024 * 3072, 3072, WINt + (size_t)m * 3072 * 1024, 1024, conv_map(nb * 64), kb * 64, nb * 64, scr, lane); continue; } r -= I_WIN;
        if (r < I_WOUT) { const int m = r >> 8, q = r & 255, kb = q >> 4, nb = q & 15;
            transpose_item(a.in[26] + (size_t)m * 1024 * 1024, 1024, WOUTt + (size_t)m * 1024 * 1024, 1024, nb * 64, kb * 64, nb * 64, scr, lane); continue; } r -= I_WOUT;
        if (r < I_W1) { const int m = r >> 4, kb = r & 15, lr = m >> 1, e = m & 1;
            transpose_item(a.in[11] + (size_t)m * 1024 * 64, 64, WRKV + (size_t)lr * 3840 * 1024, 1024, 3072 + e * 64, kb * 64, 0, scr, lane); continue; } r -= I_W1;
        if (r < I_A1) { const int m = r >> 4, kb = r & 15, lr = m >> 1, e = m & 1;
            transpose_item(a.in[14] + (size_t)m * 1024 * 64, 64, WRKV + (size_t)lr * 3840 * 1024, 1024, 3328 + e * 64, kb * 64, 0, scr, lane); continue; } r -= I_A1;
        { const int m = r >> 5, q = r & 31, kb = q >> 1, nb = q & 1;
            transpose_item(a.in[16] + (size_t)m * 1024 * 128, 128, WRKV + (size_t)m * 3840 * 1024, 1024, 3584 + nb * 64, kb * 64, nb * 64, scr, lane); }
    }
    const int gt = blockIdx.x * 512 + tid, NGT = G * 512;
    for (int i = gt; i < 2 * 3 * 128 * 128; i += NGT) {
        const int pc = i & 127, rw = (i >> 7) & 127, pd = (i >> 14) % 3, lr = i / (3 * 16384);
        *(u32x4*)(WRKV + ((size_t)lr * 3840 + 3072 + pd * 256 + 128 + rw) * 1024 + pc * 8) = (u32x4){0u, 0u, 0u, 0u}; }
    bf16* L2T = (bf16*)(ws + WS_L2T);
    static_assert((2 * 128 * 5120) % (256 * 512) == 0, "L2T deal");
    for (int i0 = gt; i0 < 2 * 128 * 5120; i0 += 5 * NGT) {
        float v5[5]; bool ok5[5];
#pragma unroll
        for (int q = 0; q < 5; ++q) { const int i = i0 + q * NGT; const int n = i % 5120, k = (i / 5120) & 127, lr = i / (5120 * 128);
            const float* p; bool ok = true;
            if (n < 2048) { const int e = n >> 10, d = n & 1023; ok = (k >> 6) == e; p = a.in[12] + (((size_t)lr * 2 + e) * 64 + (k & 63)) * 1024 + d; }
            else if (n < 4096) { const int e = (n - 2048) >> 10, d = n & 1023; ok = (k >> 6) == e; p = a.in[15] + (((size_t)lr * 2 + e) * 64 + (k & 63)) * 1024 + d; }
            else { const int d = n - 4096; p = a.in[17] + ((size_t)lr * 128 + k) * 1024 + d; }
            v5[q] = *p; ok5[q] = ok; }
#pragma unroll
        for (int q = 0; q < 5; ++q) { const int i = i0 + q * NGT; const int n = i % 5120, k = (i / 5120) & 127, lr = i / (5120 * 128);
            L2T[((size_t)lr * 5120 + n) * 128 + k] = (bf16)f2bf(ok5[q] ? v5[q] : 0.f); }
    }
    bf16* WRT = (bf16*)(ws + WS_WRT);
    for (int i = gt; i < 4 * 32 * 1024; i += NGT) { const int k = i & 1023, e = (i >> 10) & 31, l = i >> 15;
        const float w = a.in[27][((size_t)l * 1024 + k) * 32 + e]; const unsigned hi = f2bf(w); const float lo = w - bflo(hi);
        WRT[((size_t)(l * 2 + 0) * 32 + e) * 1024 + k] = (bf16)hi; WRT[((size_t)(l * 2 + 1) * 32 + e) * 1024 + k] = (bf16)f2bf(lo); }
}
#define XB_TMO      128
#define XB_XCNT(j)  (256  + 64 * (j))
#define XB_XSUB(j)  (1280 + 64 * (j))
#define XB_XGEN(j)  (2304 + 64 * (j))
#define XB_TOP      3328
#define XB_TOPGEN   3392
#define XCD_BAR_WORDS 3456
#define XB_SPIN_CAP (1u << 23)

__device__ __forceinline__ unsigned xb_ld(unsigned* p)              { return __hip_atomic_load(p, __ATOMIC_RELAXED, __HIP_MEMORY_SCOPE_AGENT); }
__device__ __forceinline__ unsigned xb_add(unsigned* p, unsigned v) { return __hip_atomic_fetch_add(p, v, __ATOMIC_RELAXED, __HIP_MEMORY_SCOPE_AGENT); }
__device__ __forceinline__ unsigned xb_xcc_id() { return (unsigned)__builtin_amdgcn_s_getreg((3 << 11) | 20) & 0xFu; }
#define XB_SPIN(cond, bar) do { unsigned _sp = 0; while (cond) { __builtin_amdgcn_s_sleep(1); \
    if ((++_sp & 255u) == 0u) { if (xb_ld(&(bar)[XB_TMO])) break; if (_sp > XB_SPIN_CAP) { atomicAdd(&(bar)[XB_TMO], 1u); break; } } } } while (0)

struct XcdBarrier {
    unsigned wv;
    unsigned* bar; unsigned x;
    volatile LAS unsigned* st;
};

__device__ __forceinline__ XcdBarrier xcd_barrier_post(unsigned* bar, volatile LAS unsigned* st) {
    XcdBarrier b; b.wv = (unsigned)__builtin_amdgcn_readfirstlane((int)(threadIdx.x >> 6)); b.bar = bar; b.x = xb_xcc_id(); b.st = st;
    if (threadIdx.x == 0) (void)xb_add(&bar[XB_XCNT(b.x)], 1u);
    return b;
}
__device__ __forceinline__ void xcd_barrier_complete(unsigned* bar, unsigned x, unsigned& nloc, unsigned& nx) {
    const unsigned G = gridDim.x * gridDim.y * gridDim.z;
    unsigned sum, cnt, mine, sp = 0u;
    for (;;) {
        sum = 0u; cnt = 0u; mine = 0u;
#pragma unroll
        for (unsigned j = 0; j < 16; ++j) { const unsigned c = xb_ld(&bar[XB_XCNT(j)]); sum += c; cnt += (c > 0u) ? 1u : 0u; mine = (j == x) ? c : mine; }
        if (sum == G) break;
        __builtin_amdgcn_s_sleep(1);
        if ((++sp & 255u) == 0u) { if (xb_ld(&bar[XB_TMO])) break; if (sp > XB_SPIN_CAP) { atomicAdd(&bar[XB_TMO], 1u); break; } }
    }
    nloc = mine > 0u ? mine : 1u; nx = cnt > 0u ? cnt : 1u;
}

__device__ __forceinline__ void xcd_barrier(const XcdBarrier& b) {
    asm volatile("s_waitcnt vmcnt(0)" ::: "memory");
    __syncthreads();
    if (b.wv == 0u && lane_id() == 0) {
        unsigned* bar = b.bar;
        __builtin_amdgcn_s_waitcnt(0);
        unsigned nloc = b.st[0], nx = b.st[1];
        if (nloc == 0u) { xcd_barrier_complete(bar, b.x, nloc, nx); b.st[0] = nloc; b.st[1] = nx; }
        const unsigned old = xb_add(&bar[XB_XSUB(b.x)], 1u);
        const unsigned gen = old / nloc;
        if (old + 1u == (gen + 1u) * nloc) {
            __builtin_amdgcn_fence(__ATOMIC_RELEASE, "agent");
            asm volatile("s_waitcnt vmcnt(0)" ::: "memory");
            const unsigned og = xb_add(&bar[XB_TOP], 1u);
            const unsigned tg = og / nx;
            if (og + 1u == (tg + 1u) * nx) xb_add(&bar[XB_TOPGEN], 1u);
            else XB_SPIN(xb_ld(&bar[XB_TOPGEN]) == tg, bar);
            __builtin_amdgcn_fence(__ATOMIC_ACQUIRE, "agent");
            xb_add(&bar[XB_XGEN(b.x)], 1u);
            asm volatile("s_waitcnt vmcnt(0)" ::: "memory");
        } else {
            XB_SPIN(xb_ld(&bar[XB_XGEN(b.x)]) == gen, bar);
            __builtin_amdgcn_fence(__ATOMIC_ACQUIRE, "agent");
            asm volatile("s_waitcnt vmcnt(0)" ::: "memory");
        }
    }
    __syncthreads();
}

__device__ __forceinline__ f32x4 bf4(u32x2 w) { return (f32x4){bflo(w.x), bfhi(w.x), bflo(w.y), bfhi(w.y)}; }
__device__ __forceinline__ int mod_row(int row) { return row < TL ? (row >> 13) : 4; }

__device__ __forceinline__ void load_x_combined(f32x4 (&x)[4], const float* xrow, bool has_prev, const bf16* YS, int t, const f32x4 (&m5)[4], int lane) {
#pragma unroll
    for (int j = 0; j < 4; ++j) x[j] = *(const f32x4*)(xrow + 256 * j + 4 * lane);
    if (has_prev) {
        u32x2 y[4][4];
#pragma unroll
        for (int k = 0; k < 4; ++k)
#pragma unroll
            for (int j = 0; j < 4; ++j) y[k][j] = *(const u32x2*)(YS + ((size_t)t * 4 + k) * 1024 + 256 * j + 4 * lane);
#pragma unroll
        for (int j = 0; j < 4; ++j) { const f32x4 s = (bf4(y[0][j]) + bf4(y[1][j])) + (bf4(y[2][j]) + bf4(y[3][j])); x[j] += m5[j] * s; }
    }
}
__device__ __forceinline__ float row_rstd(const f32x4 (&x)[4]) {
    float ss = 0.f;
#pragma unroll
    for (int j = 0; j < 4; ++j) ss += (x[j].x * x[j].x + x[j].y * x[j].y) + (x[j].z * x[j].z + x[j].w * x[j].w);
    return rsqrtf(wave_sum(ss) * (1.0f / 1024.0f) + 1e-6f);
}

__device__ __forceinline__ void phase_a_rwkv(const Args& a, int layer, LAS unsigned char* lds, int tid, int gw, int NGW, int lane) {
    unsigned char* ws = a.ws; const int lj = layer >> 1; const bool has_prev = layer > 0;
    const float* xin_lat = layer == 0 ? a.in[0] : (const float*)(ws + WS_XSA);
    const float* xin_ctx = layer == 0 ? a.in[2] : (const float*)(ws + WS_XSA) + (size_t)TL * D;
    float* xout = (float*)(ws + (layer == 0 ? WS_XSA : WS_XSB));
    const float* MODS = (const float*)(ws + WS_MODS); const bf16* YS = (const bf16*)(ws + WS_YS); bf16* XL = (bf16*)(ws + WS_XL);
    const float* mug = a.in[8] + (size_t)lj * 6 * 2 * 1024; const float* ng = a.in[6] + (size_t)(layer * 2 + 0) * 1024;
    LAS float* mu = (LAS float*)lds;
    { f32x4 tm[6];
#pragma unroll
      for (int q = 0; q < 6; ++q) tm[q] = ((const f32x4*)mug)[tid + q * 512];
#pragma unroll
      for (int q = 0; q < 6; ++q) ((LAS f32x4*)mu)[tid + q * 512] = tm[q]; }
    __syncthreads();
    for (int it = gw; it < TL / 8 + TC / 2; it += NGW) {
        const int ntok = it < TL / 8 ? 8 : 2, t0 = it < TL / 8 ? it * 8 : TL + (it - TL / 8) * 2, mr = mod_row(t0);
        int rs, re; if (t0 < TL) { rs = t0 & ~63; re = rs + 63; } else { const int loc = t0 - TL; rs = TL + (loc & ~255); re = rs + 255; }
        const float* mod = MODS + (size_t)(layer * 5 + mr) * 6144;
        const float* m5p = MODS + (size_t)((has_prev ? layer - 1 : 0) * 5 + mr) * 6144 + 5 * 1024;
        f32x4 hm[4], h0[4], hp[4];
#pragma unroll
        for (int j = 0; j < 4; ++j) { hm[j] = (f32x4){0.f, 0.f, 0.f, 0.f}; h0[j] = hm[j]; hp[j] = hm[j]; }
        f32x4 rx[4], nx[4]; u32x2 ry[4][4], ny[4][4];
#define PA_LOAD(X, Y, tt) do { const int t_ = (tt); if (t_ >= rs && t_ <= re) { \
            const float* xrow_ = t_ < TL ? xin_lat + (size_t)t_ * D : xin_ctx + (size_t)(t_ - TL) * D; \
            _Pragma("unroll") for (int j = 0; j < 4; ++j) X[j] = *(const f32x4*)(xrow_ + 256 * j + 4 * lane); \
            if (has_prev) { _Pragma("unroll") for (int k = 0; k < 4; ++k) _Pragma("unroll") for (int j = 0; j < 4; ++j) Y[k][j] = *(const u32x2*)(YS + ((size_t)t_ * 4 + k) * 1024 + 256 * j + 4 * lane); } } } while (0)
#pragma unroll
        for (int j = 0; j < 4; ++j) { rx[j] = (f32x4){0.f, 0.f, 0.f, 0.f}; nx[j] = rx[j];
#pragma unroll
            for (int k = 0; k < 4; ++k) { ry[k][j] = (u32x2){0u, 0u}; ny[k][j] = ry[k][j]; } }
        PA_LOAD(rx, ry, t0 - 1);
        f32x4 gsc[4], sh4[4], m5v[4];
#pragma unroll
        for (int j = 0; j < 4; ++j) { const int col = 256 * j + 4 * lane; gsc[j] = *(const f32x4*)(ng + col) * (*(const f32x4*)(mod + 1024 + col) + 1.0f); sh4[j] = *(const f32x4*)(mod + col); m5v[j] = *(const f32x4*)(m5p + col); }
#pragma unroll
        for (int j = 0; j < 4; ++j) asm volatile("" : "+v"(gsc[j]), "+v"(sh4[j]), "+v"(m5v[j]), "+v"(rx[j]));
#pragma unroll 1
        for (int i = -1; i <= ntok; ++i) {
            const int t = t0 + i;
            if (i < ntok) PA_LOAD(nx, ny, t + 1);
            f32x4 hn[4];
            if (t >= rs && t <= re) {
                f32x4 x[4];
#pragma unroll
                for (int j = 0; j < 4; ++j) x[j] = rx[j];
                if (has_prev) {
#pragma unroll
                    for (int j = 0; j < 4; ++j) { f32x4 sm = (f32x4){0.f, 0.f, 0.f, 0.f};
#pragma unroll
                        for (int k = 0; k < 4; ++k) sm += (f32x4){bflo(ry[k][j].x), bfhi(ry[k][j].x), bflo(ry[k][j].y), bfhi(ry[k][j].y)};
                        x[j] += m5v[j] * sm; } }
                if (i >= 0 && i < ntok) {
#pragma unroll
                    for (int j = 0; j < 4; ++j) *(f32x4*)(xout + (size_t)t * D + 256 * j + 4 * lane) = x[j]; }
                const float rstd = row_rstd(x);
#pragma unroll
                for (int j = 0; j < 4; ++j) hn[j] = x[j] * rstd * gsc[j] + sh4[j];
            } else {
#pragma unroll
                for (int j = 0; j < 4; ++j) hn[j] = (f32x4){0.f, 0.f, 0.f, 0.f};
            }
#pragma unroll
            for (int j = 0; j < 4; ++j) { hm[j] = h0[j]; h0[j] = hp[j]; hp[j] = hn[j]; rx[j] = nx[j];
#pragma unroll
                for (int k = 0; k < 4; ++k) ry[k][j] = ny[k][j]; }
            if (i >= 1) {
                const int te = t - 1;
#pragma unroll
                for (int q = 0; q < 6; ++q) {
                    bf16* orow = XL + ((size_t)q * T + te) * D;
#pragma unroll
                    for (int j = 0; j < 4; ++j) { const int col = 256 * j + 4 * lane;
                        const f32x4 m0 = *(const LAS f32x4*)(mu + (q * 2 + 0) * 1024 + col), m1 = *(const LAS f32x4*)(mu + (q * 2 + 1) * 1024 + col);
                        const f32x4 o = h0[j] + m0 * (hm[j] - h0[j]) + m1 * (hp[j] - h0[j]);
                        u32x2 w; w.x = pk2(o.x, o.y); w.y = pk2(o.z, o.w); *(u32x2*)(orow + col) = w; }
                }
            }
        }
#undef PA_LOAD
    }
}
__device__ __forceinline__ void phase_a_conv(const Args& a, int layer, int rows, int gw, int NGW, int lane) {
    unsigned char* ws = a.ws;
    float* xs = (float*)(ws + (layer < 2 ? WS_XSA : WS_XSB));
    const float* MODS = (const float*)(ws + WS_MODS); const bf16* YS = (const bf16*)(ws + WS_YS); bf16* H = (bf16*)(ws + WS_XL);
    const float* ng = a.in[6] + (size_t)(layer * 2 + 0) * 1024;
    for (int t = gw; t < rows; t += NGW) {
        const int mr = mod_row(t);
        const float* mod = MODS + (size_t)(layer * 5 + mr) * 6144;
        f32x4 m5[4], x[4];
#pragma unroll
        for (int j = 0; j < 4; ++j) m5[j] = *(const f32x4*)(MODS + (size_t)((layer - 1) * 5 + mr) * 6144 + 5 * 1024 + 256 * j + 4 * lane);
        f32x4 gsc[4], sh4[4], ngv[4];
#pragma unroll
        for (int j = 0; j < 4; ++j) { const int col = 256 * j + 4 * lane; ngv[j] = *(const f32x4*)(ng + col); gsc[j] = *(const f32x4*)(mod + 1024 + col); sh4[j] = *(const f32x4*)(mod + col); }
        load_x_combined(x, xs + (size_t)t * D, true, YS, t, m5, lane);
#pragma unroll
        for (int j = 0; j < 4; ++j) gsc[j] = ngv[j] * (gsc[j] + 1.0f);
        const float rstd = row_rstd(x);
#pragma unroll
        for (int j = 0; j < 4; ++j) { const int col = 256 * j + 4 * lane;
            *(f32x4*)(xs + (size_t)t * D + col) = x[j];
            const f32x4 h = x[j] * rstd * gsc[j] + sh4[j];
            u32x2 w; w.x = pk2(h.x, h.y); w.y = pk2(h.z, h.w); *(u32x2*)(H + (size_t)t * D + col) = w; }
    }
}
#define DPPF(x, ctrl) __builtin_bit_cast(float, __builtin_amdgcn_update_dpp(0, __builtin_bit_cast(int, (x)), (ctrl), 0xf, 0xf, false))
__device__ __forceinline__ float row16_sum(float v) { v += DPPF(v, 0xB1); v += DPPF(v, 0x4E); v += DPPF(v, 0x141); v += DPPF(v, 0x140); return v; }
__device__ __forceinline__ u32x2 pk4(f32x4 v) { u32x2 w; w.x = pk2(v[0], v[1]); w.y = pk2(v[2], v[3]); return w; }
__device__ __forceinline__ void phase_c_prep(const Args& a, int lj, LAS unsigned char* lds, int tid, int gw, int NGW, int lane) {
    unsigned char* ws = a.ws;
    const bf16* Rr = (const bf16*)(ws + WS_RKV); const bf16* Kk = Rr + (size_t)T * D; const bf16* RA = (const bf16*)(ws + WS_RAWA); const bf16* RW = (const bf16*)(ws + WS_RAWW);
    bf16* KK = (bf16*)(ws + WS_KK); bf16* KD = (bf16*)(ws + WS_KD); bf16* BE = (bf16*)(ws + WS_BETA); float* RKB = (float*)(ws + WS_RKB);
    LAS float* tb = (LAS float*)lds;
    for (int i = tid; i < 7 * 256; i += 512) { const int t7 = i >> 8, q = i & 255;
        const float* src = t7 == 0 ? a.in[18] + lj * 1024 : t7 == 1 ? a.in[19] + lj * 1024 : t7 == 2 ? a.in[20] + lj * 1024 : t7 < 5 ? a.in[10] + lj * 2048 + (t7 - 3) * 1024 : a.in[13] + lj * 2048 + (t7 - 5) * 1024;
        ((LAS f32x4*)tb)[i] = ((const f32x4*)src)[q]; }
    __syncthreads();
    for (int row = gw; row < T; row += NGW) {
#pragma unroll
        for (int j = 0; j < 4; ++j) {
            const int col = 256 * j + 4 * lane; const size_t ro = (size_t)row * D + col;
            const f32x4 k = bf4(*(const u32x2*)(Kk + ro)), r = bf4(*(const u32x2*)(Rr + ro));
            f32x4 a0 = bf4(*(const u32x2*)(RA + ro)) + *(const LAS f32x4*)(tb + 5 * 1024 + col), a1 = bf4(*(const u32x2*)(RA + (size_t)T * D + ro)) + *(const LAS f32x4*)(tb + 6 * 1024 + col);
#pragma unroll
            for (int z = 0; z < 4; ++z) { a0[z] = sigm(a0[z]); a1[z] = sigm(a1[z]); }
            const f32x4 ck = *(const LAS f32x4*)(tb + col), ca = *(const LAS f32x4*)(tb + 1024 + col), cr = *(const LAS f32x4*)(tb + 2048 + col);
            const f32x4 kk = k * ck;
            const float ss = row16_sum((kk.x * kk.x + kk.y * kk.y) + (kk.z * kk.z + kk.w * kk.w));
            const f32x4 kd0 = k * ((a0 - 1.0f) * ca + 1.0f), kd1 = k * ((a1 - 1.0f) * ca + 1.0f);
            *(u32x2*)(KD + ro) = pk4(kd0); *(u32x2*)(KD + (size_t)T * D + ro) = pk4(kd1);
            const f32x4 p = r * (kd0 + kd1) * cr;
            const float rk = row16_sum((p.x + p.y) + (p.z + p.w));
            const f32x4 kkn = kk * fminf(__builtin_amdgcn_rsqf(ss), 1e12f);
            *(u32x2*)(KK + ro) = pk4(kkn); *(u32x2*)(BE + ro) = pk4(kkn * a0); *(u32x2*)(BE + (size_t)T * D + ro) = pk4(kkn * a1);
            if ((lane & 15) == 0) RKB[(size_t)row * 16 + 4 * j + (lane >> 4)] = rk;
        }
    }
}
typedef short bf16x8 __attribute__((ext_vector_type(8)));
__device__ __forceinline__ f32x4 mfma16(bf16x8 a, bf16x8 b, f32x4 c) { return __builtin_amdgcn_mfma_f32_16x16x32_bf16(a, b, c, 0, 0, 0); }
__device__ __forceinline__ bf16x8 as_frag(u32x4 w) { return __builtin_bit_cast(bf16x8, w); }
constexpr int CH_LD = 144;
constexpr int CH_MS = 64 * CH_LD;
constexpr int CH_AB = 0 * CH_MS, CH_KT = 1 * CH_MS, CH_BT = 2 * CH_MS, CH_RB = 3 * CH_MS, CH_VT = 4 * CH_MS, CH_ABT = 5 * CH_MS, CH_KHT = 6 * CH_MS, CH_BHT = 7 * CH_MS,
              CH_LK = 8 * CH_MS, CH_LB = 9 * CH_MS, CH_MK = 10 * CH_MS, CH_MB = 11 * CH_MS, CH_WT = 12 * CH_MS, CH_U0 = 13 * CH_MS, CH_DINV = 14 * CH_MS;
constexpr int CH_GC = LDSCTL_OFF + 2048;
constexpr int CH_PART = LDSCTL_OFF + 4096;
constexpr int NCHUNK = NSTEP / 64;
#ifndef S1_DBL
#define S1_DBL 0
#endif
static_assert(CH_DINV + 2048 <= RING_BYTES, "chunk LDS map");

__device__ __forceinline__ int scan_row(int s, int dir, int b) {
    if (s < CTXL) return TL + b * CTXL + (dir ? CTXL - 1 - s : s);
    const int i = s - CTXL; return b * SEQ + (dir ? SEQ - 1 - i : i);
}
#define CH_FRAG(mat, row, ks, kg) as_frag(*(const LAS u32x4*)(lds + (mat) + (row) * CH_LD + ((ks) * 32 + (kg) * 8) * 2))

__device__ __forceinline__ float s1_treduce16(const float (&a)[16], bool b3, bool b2) {
    float b[8];
#pragma unroll
    for (int i = 0; i < 8; ++i) { float x = a[i], y = a[i + 8];
        asm("s_nop 1\n\tv_permlane32_swap_b32 %0, %1" : "+v"(x), "+v"(y));
        b[i] = x + y; }
    float c[4];
#pragma unroll
    for (int i = 0; i < 4; ++i) { float x = b[i], y = b[i + 4];
        asm("s_nop 1\n\tv_permlane16_swap_b32 %0, %1" : "+v"(x), "+v"(y));
        c[i] = x + y; }
    float d[2];
#pragma unroll
    for (int i = 0; i < 2; ++i) { const float keep = b3 ? c[i + 2] : c[i], send = b3 ? c[i] : c[i + 2]; d[i] = keep + DPPF(send, 0x128); }
    const float keep = b2 ? d[1] : d[0], send = b2 ? d[0] : d[1];
    float e = keep + DPPF(send, 0x141);
    e += DPPF(e, 0xB1);
    e += DPPF(e, 0x4E);
    return e;
}
#define S1_BAR() do { asm volatile("s_waitcnt lgkmcnt(0)" ::: "memory"); __builtin_amdgcn_s_barrier(); asm volatile("" ::: "memory"); } while (0)
__device__ __forceinline__ void phase_s1_chunks(const Args& a, int lj, LAS unsigned char* lds, int tid, int G, int rh_scratch = 0) {
    unsigned char* ws = a.ws; const float* w0l = a.in[10] + lj * 2048; const float* a0l = a.in[13] + lj * 2048;
    const float* pkk = a.in[18] + lj * 1024; const float* pka = a.in[19] + lj * 1024; const float* prk = a.in[20] + lj * 1024;
    const int lane = tid & 63, wave = __builtin_amdgcn_readfirstlane(tid >> 6), l15 = lane & 15, g = lane >> 4;
    LAS float* part = (LAS float*)(lds + CH_PART); LAS float* gammaC = (LAS float*)(lds + CH_GC);
    unsigned nlw[8], nka[8], nkr[8], nrr[8], nvv[8]; float nw0 = 0.f, na0 = 0.f, npkk = 0.f, npka = 0.f, nprk = 0.f;
    typedef const __attribute__((address_space(1))) unsigned short* GUS;
#define S1_LOAD(ctx_) do { unsigned char* wsl = ws; asm volatile("" : "+s"(wsl));     \
        const int chain_ = (ctx_) / NCHUNK, c_ = (ctx_) - chain_ * NCHUNK, dir_ = chain_ >> 6, b_ = (chain_ >> 4) & 3, h_ = chain_ & 15; \
          \
          \
        const long o0 = (long)scan_row(64 * c_ + 8 * wave, dir_, b_) * D + h_ * 64, od = (long)dir_ * T * D, st = dir_ ? -(long)D : (long)D; \
        const bf16* LWp = (const bf16*)(wsl + WS_RAWW) + od + o0; const bf16* RAp = (const bf16*)(wsl + WS_RAWA) + od + o0; \
        const bf16* Rp = (const bf16*)(wsl + WS_RKV) + o0; const bf16* Kp = Rp + (size_t)T * D; const bf16* Vp = Rp + (size_t)2 * T * D; \
        nw0 = w0l[dir_ * 1024 + h_ * 64 + lane]; na0 = a0l[dir_ * 1024 + h_ * 64 + lane]; npkk = pkk[h_ * 64 + lane]; npka = pka[h_ * 64 + lane]; nprk = prk[h_ * 64 + lane]; \
        _Pragma("unroll") for (int j = 0; j < 8; ++j) { const long oj = st * j; \
            nlw[j] = ((GUS)(LWp + oj))[lane]; nka[j] = ((GUS)(RAp + oj))[lane]; nkr[j] = ((GUS)(Kp + oj))[lane]; nrr[j] = ((GUS)(Rp + oj))[lane]; nvv[j] = ((GUS)(Vp + oj))[lane]; } } while (0)
    unsigned clw[8], cka_[8], ckr[8], crr[8], cvv[8]; float cw0 = 0.f, ca0 = 0.f, cpkk = 0.f, cpka = 0.f, cprk = 0.f;
#define S1_TAKE() do { _Pragma("unroll") for (int j = 0; j < 8; ++j) { clw[j] = nlw[j]; cka_[j] = nka[j]; ckr[j] = nkr[j]; crr[j] = nrr[j]; cvv[j] = nvv[j]; } \
        cw0 = nw0; ca0 = na0; cpkk = npkk; cpka = npka; cprk = nprk; \
        _Pragma("unroll") for (int j = 0; j < 8; ++j) asm volatile("" : "+v"(clw[j]), "+v"(cka_[j]), "+v"(ckr[j]), "+v"(crr[j]), "+v"(cvv[j]) :: "memory"); \
        asm volatile("" : "+v"(cw0), "+v"(ca0), "+v"(cpkk), "+v"(cpka), "+v"(cprk) :: "memory"); } while (0)
    if ((int)blockIdx.x < 128 * NCHUNK) { S1_LOAD((int)blockIdx.x); S1_TAKE(); if ((int)blockIdx.x + G < 128 * NCHUNK) S1_LOAD((int)blockIdx.x + G); }
    for (int ct = blockIdx.x; ct < 128 * NCHUNK; ct += G) {
        const int chain = ct / NCHUNK, c = ct - chain * NCHUNK, dir = chain >> 6, b = (chain >> 4) & 3, h = chain & 15;
        unsigned zq = 0u; asm volatile("" : "+v"(zq));
        {
            const int k = lane, tq = wave;
            float lw[8], kd[8], be[8], kk[8], rr[8], vv[8];
            {
                const float w0k = cw0, a0k = ca0, ckk = cpkk, cka = cpka, crk = cprk;
                float* RKBd = (float*)(ws + (dir ? WS_RKB1 : WS_RKB));
                const int row0 = scan_row(64 * c + 8 * tq, dir, b), rst = dir ? -1 : 1;
                float av[8], kq[8], red[16];
                const float a0n = a0k * -1.44269504f, w0n = w0k * -1.44269504f;
#pragma unroll
                for (int j = 0; j < 8; ++j) { av[j] = frcp(1.0f + __builtin_amdgcn_exp2f(__builtin_fmaf(bflo(cka_[j]), -1.44269504f, a0n))); const float kr = bflo(ckr[j]);
                    lw[j] = -0.60653066f * frcp(1.0f + __builtin_amdgcn_exp2f(__builtin_fmaf(bflo(clw[j]), -1.44269504f, w0n)));
                    kq[j] = kr * ckk; kd[j] = kr * ((av[j] - 1.0f) * cka + 1.0f); rr[j] = bflo(crr[j]); vv[j] = bflo(cvv[j]);
                    red[2 * j] = kq[j] * kq[j]; red[2 * j + 1] = rr[j] * kd[j] * crk; }
                const float tot = s1_treduce16(red, (lane & 8) != 0, (lane & 4) != 0);
                if ((lane & 7) == 4) RKBd[(size_t)(row0 + rst * (lane >> 3)) * 16 + h] = tot;
#pragma unroll
                for (int j = 0; j < 8; ++j) { const float ss = __builtin_bit_cast(float, __builtin_amdgcn_readlane(__builtin_bit_cast(int, tot), 8 * j));
                    kk[j] = kq[j] * fminf(__builtin_amdgcn_rsqf(ss), 1e12f);     be[j] = kk[j] * av[j]; }
            }
            for (int r0_ = 0; r0_ <= ((S1_DBL >> 3) & 1); ++r0_) { if (r0_) S1_BAR();
            float p[8]; p[0] = lw[0];
#pragma unroll
            for (int j = 1; j < 8; ++j) p[j] = p[j - 1] + lw[j];
            part[tq * 64 + k] = p[7];
            S1_BAR();
            float off = 0.f, tot = 0.f;
#pragma unroll
            for (int q = 0; q < 8; ++q) { const float pv = part[q * 64 + k]; tot += pv; off += q < tq ? pv : 0.f; }
            const float eTot = __expf(tot); float ePrev = __expf(off);
            if (tq == 0) gammaC[k] = eTot;
            unsigned abw[4], khw[4], bhw[4], vw[4];
#pragma unroll
            for (int j = 0; j < 8; j += 2) {
                float ab2[2], kt2[2], bt2[2], rb2[2], kh2[2], bh2[2];
#pragma unroll
                for (int z = 0; z < 2; ++z) { const float cu = (off + p[j + z]) * 1.44269504f; const float eP = __builtin_amdgcn_exp2f(cu), eM = __builtin_amdgcn_exp2f(-cu), eC = eTot * eM;
                    ab2[z] = kk[j + z] * ePrev; ePrev = eP; kt2[z] = kd[j + z] * eM; bt2[z] = be[j + z] * eM; rb2[z] = rr[j + z] * eP; kh2[z] = kd[j + z] * eC; bh2[z] = be[j + z] * eC;
                }
                abw[j >> 1] = pk2(ab2[0], ab2[1]); khw[j >> 1] = pk2(kh2[0], kh2[1]); bhw[j >> 1] = pk2(bh2[0], bh2[1]); vw[j >> 1] = pk2(vv[j], vv[j + 1]);
                {
                    const unsigned ktw = pk2(kt2[0], kt2[1]), btw = pk2(bt2[0], bt2[1]), rbw = pk2(rb2[0], rb2[1]), aw = abw[j >> 1];
                    const int t = 8 * tq + j;
                    *(LAS bf16*)(lds + CH_AB + t * CH_LD + k * 2) = (bf16)aw; *(LAS bf16*)(lds + CH_AB + (t + 1) * CH_LD + k * 2) = (bf16)(aw >> 16);
                    *(LAS bf16*)(lds + CH_KT + t * CH_LD + k * 2) = (bf16)ktw; *(LAS bf16*)(lds + CH_KT + (t + 1) * CH_LD + k * 2) = (bf16)(ktw >> 16);
                    *(LAS bf16*)(lds + CH_BT + t * CH_LD + k * 2) = (bf16)btw; *(LAS bf16*)(lds + CH_BT + (t + 1) * CH_LD + k * 2) = (bf16)(btw >> 16);
                    *(LAS bf16*)(lds + CH_RB + t * CH_LD + k * 2) = (bf16)rbw; *(LAS bf16*)(lds + CH_RB + (t + 1) * CH_LD + k * 2) = (bf16)(rbw >> 16); }
            }
            *(LAS u32x4*)(lds + CH_ABT + k * CH_LD + tq * 16) = (u32x4){abw[0], abw[1], abw[2], abw[3]};
            *(LAS u32x4*)(lds + CH_KHT + k * CH_LD + tq * 16) = (u32x4){khw[0], khw[1], khw[2], khw[3]};
            *(LAS u32x4*)(lds + CH_BHT + k * CH_LD + tq * 16) = (u32x4){bhw[0], bhw[1], bhw[2], bhw[3]};
            *(LAS u32x4*)(lds + CH_VT + k * CH_LD + tq * 16) = (u32x4){vw[0], vw[1], vw[2], vw[3]};
            *(LAS u32x4*)(lds + CH_WT + k * CH_LD + tq * 16) = (u32x4){zq, zq, zq, zq}; *(LAS u32x4*)(lds + CH_U0 + k * CH_LD + tq * 16) = (u32x4){zq, zq, zq, zq};
            }
        }
        S1_BAR();
        for (int r1_ = 0; r1_ <= (S1_DBL & 1); ++r1_) { if (r1_) S1_BAR();
            const int mi = wave >> 1, half = wave & 1;
            const int matS = (mi & 1) ? CH_BT : CH_KT, matT = (mi & 2) ? CH_RB : CH_AB, matO = CH_LK + mi * CH_MS;
            const bool incl = (mi & 2) != 0;
            bf16x8 fs[4][2], ft[2][2];
#pragma unroll
            for (int ms = 0; ms < 4; ++ms)
#pragma unroll
                for (int ks = 0; ks < 2; ++ks) fs[ms][ks] = CH_FRAG(matS, 16 * ms + l15, ks, g);
#pragma unroll
            for (int nt = 0; nt < 2; ++nt)
#pragma unroll
                for (int ks = 0; ks < 2; ++ks) ft[nt][ks] = CH_FRAG(matT, 32 * half + 16 * nt + l15, ks, g);
#pragma unroll
            for (int nt = 0; nt < 2; ++nt) { const int t = 32 * half + 16 * nt + l15;
#pragma unroll
                for (int ms = 0; ms < 4; ++ms) { f32x4 d = (f32x4){0.f, 0.f, 0.f, 0.f};
                    d = mfma16(fs[ms][0], ft[nt][0], d); d = mfma16(fs[ms][1], ft[nt][1], d);
                    const int s0 = 16 * ms + 4 * g;
#pragma unroll
                    for (int i = 0; i < 4; ++i) { const bool keep = incl ? (s0 + i <= t) : (s0 + i < t); d[i] = keep ? d[i] : __builtin_bit_cast(float, zq); }
                    u32x2 w; w.x = pk2(d[0], d[1]); w.y = pk2(d[2], d[3]);
                    *(LAS u32x2*)(lds + matO + t * CH_LD + s0 * 2) = w; } }
        }
        S1_BAR();
        f32x4 rhsU[4];
#pragma unroll
        for (int I = 0; I < 4; ++I) rhsU[I] = (f32x4){0.f, 0.f, 0.f, 0.f};
        if (wave >= 4) {
            const int ctv = (wave & 3) * 16;
            const bf16x8 fv0 = CH_FRAG(CH_VT, ctv + l15, 0, g), fv1 = CH_FRAG(CH_VT, ctv + l15, 1, g);
#pragma unroll
            for (int I = 0; I < 4; ++I) { f32x4 d = (f32x4){0.f, 0.f, 0.f, 0.f};
                d = mfma16(CH_FRAG(CH_LK, 16 * I + l15, 0, g), fv0, d); d = mfma16(CH_FRAG(CH_LK, 16 * I + l15, 1, g), fv1, d); rhsU[I] = -d; }
        }
        for (int r2_ = 0; r2_ <= ((S1_DBL >> 1) & 1); ++r2_) if (wave == 0) {
            const int bb = lane >> 4, j = lane & 15;
            float x[16];
#pragma unroll
            for (int t = 0; t < 16; ++t) {
                const u32x4 r0 = *(const LAS u32x4*)(lds + CH_LB + (16 * bb + t) * CH_LD + 32 * bb), r1 = *(const LAS u32x4*)(lds + CH_LB + (16 * bb + t) * CH_LD + 32 * bb + 16);
                const unsigned rw[8] = {r0.x, r0.y, r0.z, r0.w, r1.x, r1.y, r1.z, r1.w};
                float acc = (t == j) ? 1.0f : 0.0f;
#pragma unroll
                for (int s = 0; s < t; ++s) { const float lv = (s & 1) ? bfhi(rw[s >> 1]) : bflo(rw[s >> 1]); acc -= lv * x[s]; }
                x[t] = acc;
                *(LAS bf16*)(lds + CH_DINV + ((bb * 16 + t) * 16 + j) * 2) = (bf16)f2bf(acc);
            }
        }
        S1_BAR();
        {
            const int matZ = wave < 4 ? CH_WT : CH_U0, ct16 = (wave & 3) * 16;
            for (int r4_ = 0; r4_ <= ((S1_DBL >> 4) & 1); ++r4_) { if (r4_) { *(LAS u32x4*)(lds + matZ + (ct16 + l15) * CH_LD + g * 32) = (u32x4){zq, zq, zq, zq}; *(LAS u32x4*)(lds + matZ + (ct16 + l15) * CH_LD + g * 32 + 16) = (u32x4){zq, zq, zq, zq}; LDS_WAIT(); }
#pragma unroll
            for (int I = 0; I < 4; ++I) {
                f32x4 rhs;
                if (wave < 4) { const u32x2 w = *(const LAS u32x2*)(lds + CH_ABT + (ct16 + l15) * CH_LD + (16 * I + 4 * g) * 2); rhs = (f32x4){bflo(w.x), bfhi(w.x), bflo(w.y), bfhi(w.y)}; }
                else rhs = rhsU[I];
                f32x4 d = (f32x4){0.f, 0.f, 0.f, 0.f};
                d = mfma16(CH_FRAG(CH_LB, 16 * I + l15, 0, g), CH_FRAG(matZ, ct16 + l15, 0, g), d); d = mfma16(CH_FRAG(CH_LB, 16 * I + l15, 1, g), CH_FRAG(matZ, ct16 + l15, 1, g), d);
                const f32x4 ac = rhs - d;
                const u32x2 dv = *(const LAS u32x2*)(lds + CH_DINV + ((I * 16 + l15) * 16 + 4 * g) * 2);
                const bf16x8 fa = as_frag((u32x4){dv.x, dv.y, zq, zq}), fb = as_frag((u32x4){pk2(ac[0], ac[1]), pk2(ac[2], ac[3]), zq, zq});
                const f32x4 z = mfma16(fa, fb, (f32x4){0.f, 0.f, 0.f, 0.f});
                u32x2 w; w.x = pk2(z[0], z[1]); w.y = pk2(z[2], z[3]);
                *(LAS u32x2*)(lds + matZ + (ct16 + l15) * CH_LD + (16 * I + 4 * g) * 2) = w;
                LDS_WAIT(); asm volatile("" ::: "memory");
            }
            }
        }
        S1_BAR();
        if (ct + G < 128 * NCHUNK) { S1_TAKE(); if (ct + 2 * G < 128 * NCHUNK) S1_LOAD(ct + 2 * G); }
        for (int r3_ = 0; r3_ <= ((S1_DBL >> 2) & 1); ++r3_) { if (r3_) S1_BAR();
            const int rt = wave >> 1, cp = (wave & 1) * 2;
            unsigned char* wsl = ws; asm volatile("" : "+s"(wsl));
            bf16* YL = (bf16*)(wsl + WS_Y); bf16* RH = (bf16*)(wsl + (rh_scratch ? WS_BETA + RF : WS_RH)); bf16* PM = (bf16*)(wsl + WS_PM); bf16* QT = (bf16*)(wsl + WS_QT);
            const int trow = scan_row(64 * c + 16 * rt + l15, dir, b);
#pragma unroll
            for (int q = 0; q < 2; ++q) { const int vt = cp + q; f32x4 d = (f32x4){0.f, 0.f, 0.f, 0.f};
#pragma unroll
                for (int ks = 0; ks < 2; ++ks) { d = mfma16(CH_FRAG(CH_VT, 16 * vt + l15, ks, g), CH_FRAG(CH_MK, 16 * rt + l15, ks, g), d); d = mfma16(CH_FRAG(CH_U0, 16 * vt + l15, ks, g), CH_FRAG(CH_MB, 16 * rt + l15, ks, g), d); }
                *(u32x2*)(YL + ((size_t)dir * T + trow) * D + h * 64 + 16 * vt + 4 * g) = pk4(d); }
#pragma unroll
            for (int q = 0; q < 2; ++q) { const int kt = cp + q; f32x4 d = (f32x4){0.f, 0.f, 0.f, 0.f};
#pragma unroll
                for (int ks = 0; ks < 2; ++ks) d = mfma16(CH_FRAG(CH_WT, 16 * kt + l15, ks, g), CH_FRAG(CH_MB, 16 * rt + l15, ks, g), d);
                const u32x2 rbw = *(const LAS u32x2*)(lds + CH_RB + (16 * rt + l15) * CH_LD + (16 * kt + 4 * g) * 2);
                u32x2 w; w.x = pk2(bflo(rbw.x) - d[0], bfhi(rbw.x) - d[1]); w.y = pk2(bflo(rbw.y) - d[2], bfhi(rbw.y) - d[3]);
                *(u32x2*)(RH + ((size_t)dir * T + trow) * D + h * 64 + 16 * kt + 4 * g) = w; }
            bf16* Pc = PM + ((size_t)chain * NCHUNK + c) * 4096; bf16* Qc = QT + ((size_t)chain * NCHUNK + c) * 4096;
            { const int krow = 16 * rt + l15; const float gc = gammaC[krow];
#pragma unroll
                for (int q = 0; q < 2; ++q) { const int kt = cp + q; f32x4 d = (f32x4){0.f, 0.f, 0.f, 0.f};
#pragma unroll
                    for (int ks = 0; ks < 2; ++ks) d = mfma16(CH_FRAG(CH_WT, 16 * kt + l15, ks, g), CH_FRAG(CH_BHT, krow, ks, g), d);
                    const int k0 = 16 * kt + 4 * g; f32x4 o;
#pragma unroll
                    for (int i = 0; i < 4; ++i) o[i] = ((k0 + i == krow) ? gc : 0.f) - d[i];
                    u32x2 w; w.x = pk2(o[0], o[1]); w.y = pk2(o[2], o[3]);
                    *(u32x2*)(Pc + ((rt * 2 + (kt >> 1)) * 64 + g * 16 + l15) * 8 + 4 * (kt & 1)) = w; } }
            { const int vrow = 16 * rt + l15;
#pragma unroll
                for (int q = 0; q < 2; ++q) { const int kt = cp + q; f32x4 d = (f32x4){0.f, 0.f, 0.f, 0.f};
#pragma unroll
                    for (int ks = 0; ks < 2; ++ks) { d = mfma16(CH_FRAG(CH_KHT, 16 * kt + l15, ks, g), CH_FRAG(CH_VT, vrow, ks, g), d); d = mfma16(CH_FRAG(CH_BHT, 16 * kt + l15, ks, g), CH_FRAG(CH_U0, vrow, ks, g), d); }
                    u32x2 w; w.x = pk2(d[0], d[1]); w.y = pk2(d[2], d[3]);
                    *(u32x2*)(Qc + ((rt * 2 + (kt >> 1)) * 64 + g * 16 + l15) * 8 + 4 * (kt & 1)) = w; } }
        }
        S1_BAR();
    }
}

template <int NG, int NKS>
__device__ __forceinline__ void b2_stream(const bf16* L1s, const bf16* W2s, bf16* outp, int cbase, int koff, int sub, int nsub, int l15, int g) {
    static_assert(NG * NKS == 4, "sixteen fragments");
    u32x4 wf[NG][4][NKS];
#pragma unroll
    for (int gr = 0; gr < NG; ++gr)
#pragma unroll
        for (int b = 0; b < 4; ++b)
#pragma unroll
            for (int ks = 0; ks < NKS; ++ks) wf[gr][b][ks] = *(const u32x4*)(W2s + (size_t)(cbase + 64 * gr + 16 * (l15 >> 2) + 4 * b + (l15 & 3)) * 128 + koff + 32 * ks + 8 * g);
    constexpr int NT = T / 16;
    u32x4 cf[NKS], nf[NKS];
#pragma unroll
    for (int ks = 0; ks < NKS; ++ks) { cf[ks] = *(const u32x4*)(L1s + (size_t)(sub * 16 + l15) * 128 + koff + 32 * ks + 8 * g); nf[ks] = cf[ks]; }
    for (int tile = sub; tile < NT; tile += nsub) {
        const int tn = tile + nsub < NT ? tile + nsub : tile;
#pragma unroll
        for (int ks = 0; ks < NKS; ++ks) nf[ks] = *(const u32x4*)(L1s + (size_t)(tn * 16 + l15) * 128 + koff + 32 * ks + 8 * g);
        bf16* orow = outp + (size_t)(tile * 16 + l15) * D + cbase + 16 * g;
#pragma unroll
        for (int gr = 0; gr < NG; ++gr) { unsigned w[8];
#pragma unroll
            for (int b = 0; b < 4; ++b) { f32x4 d = (f32x4){0.f, 0.f, 0.f, 0.f};
#pragma unroll
                for (int ks = 0; ks < NKS; ++ks) d = mfma16(as_frag(wf[gr][b][ks]), as_frag(cf[ks]), d);
                w[2 * b] = pk2(d[0], d[1]); w[2 * b + 1] = pk2(d[2], d[3]); }
            *(u32x4*)(orow + 64 * gr) = (u32x4){w[0], w[1], w[2], w[3]}; *(u32x4*)(orow + 64 * gr + 8) = (u32x4){w[4], w[5], w[6], w[7]}; }
#pragma unroll
        for (int ks = 0; ks < NKS; ++ks) cf[ks] = nf[ks];
    }
}
__device__ __forceinline__ void phase_b2_direct(const Args& a, int lj, int gw, int NGW, int lane) {
    unsigned char* ws = a.ws;
    const bf16* L1 = (const bf16*)(ws + WS_L1); const bf16* W2 = (const bf16*)(ws + WS_L2T) + (size_t)lj * 5120 * 128;
    const int l15 = lane & 15, g = lane >> 4;
    for (int vw = gw; vw < 2048; vw += NGW)
    if (vw < 32 * 43) { const int item = vw / 43, sub = vw - item * 43, set = item >> 3, lora = set >> 1, dirn = set & 1;
        bf16* outp = (bf16*)(ws + (lora == 0 ? WS_RAWW : WS_RAWA)) + (size_t)dirn * T * D;
        b2_stream<2, 2>(L1 + (size_t)lora * T * 128, W2 + (size_t)(lora * 2048 + dirn * 1024) * 128, outp, (item & 7) * 128, 64 * dirn, sub, 43, l15, g); }
    else { const int r = vw - 32 * 43, item = r / 42, sub = r - item * 42;
        if (item < 16) b2_stream<1, 4>(L1 + (size_t)2 * T * 128, W2 + (size_t)4096 * 128, (bf16*)(ws + WS_G), item * 64, 0, sub, 42, l15, g); }
}

struct S2Set { u32x4 p[4][2]; u32x4 q[2]; };
__device__ __forceinline__ void s2_load(S2Set& s, const bf16* Pc, const bf16* Qc, int vt, int l15, int g) {
    const int ln = g * 16 + l15;
    s.q[0] = *(const u32x4*)(Qc + ((vt * 2 + 0) * 64 + ln) * 8); s.q[1] = *(const u32x4*)(Qc + ((vt * 2 + 1) * 64 + ln) * 8);
#pragma unroll
    for (int m = 0; m < 4; ++m)
#pragma unroll
        for (int j = 0; j < 2; ++j) s.p[m][j] = *(const u32x4*)(Pc + ((m * 2 + j) * 64 + ln) * 8);
}
__device__ __forceinline__ void s2_step(f32x4 (&acc)[4], const S2Set& s, bf16* Hc, int g) {
    unsigned hw[4][2];
#pragma unroll
    for (int m = 0; m < 4; ++m) { hw[m][0] = pk2(acc[m][0], acc[m][1]); hw[m][1] = pk2(acc[m][2], acc[m][3]); }
#pragma unroll
    for (int m = 0; m < 4; ++m) *(u32x2*)(Hc + (m >> 1) * 512 + (m & 1) * 256) = (u32x2){hw[m][0], hw[m][1]};
    const bf16x8 hb0 = as_frag((u32x4){hw[0][0], hw[0][1], hw[1][0], hw[1][1]}), hb1 = as_frag((u32x4){hw[2][0], hw[2][1], hw[3][0], hw[3][1]});
#pragma unroll
    for (int m = 0; m < 4; ++m) {
        const unsigned q0 = (m & 2) ? ((m & 1) ? s.q[1].z : s.q[1].x) : ((m & 1) ? s.q[0].z : s.q[0].x), q1 = (m & 2) ? ((m & 1) ? s.q[1].w : s.q[1].y) : ((m & 1) ? s.q[0].w : s.q[0].y);
        f32x4 d = (f32x4){bflo(q0), bfhi(q0), bflo(q1), bfhi(q1)};
        d = mfma16(as_frag(s.p[m][0]), hb0, d);
        d = mfma16(as_frag(s.p[m][1]), hb1, d);
        acc[m] = d;
    }
}
__device__ __forceinline__ void phase_s2_chain(const Args& a, int wave, int lane, int G) {
    unsigned char* ws = a.ws;
    const bf16* PM = (const bf16*)(ws + WS_PM); const bf16* QT = (const bf16*)(ws + WS_QT); bf16* HT = (bf16*)(ws + WS_HT);
    const int l15 = lane & 15, g = lane >> 4;
    if (wave >= 2) return;
    static_assert(NCHUNK % 4 == 0, "S2 ring");
    for (int wt = blockIdx.x * 2 + wave; wt < 512; wt += G * 2) {
        const int chain = wt >> 2, vt = wt & 3;
        f32x4 acc[4];
#pragma unroll
        for (int m = 0; m < 4; ++m) acc[m] = (f32x4){0.f, 0.f, 0.f, 0.f};
        const bf16* Pc = PM + (size_t)chain * NCHUNK * 4096; const bf16* Qc = QT + (size_t)chain * NCHUNK * 4096;
        bf16* Hc = HT + (size_t)chain * NCHUNK * 4096 + ((vt * 2) * 64 + (g >> 1) * 16 + l15) * 8 + 4 * (g & 1);
        S2Set s0, s1, s2, s3;
        s2_load(s0, Pc, Qc, vt, l15, g); s2_load(s1, Pc + 4096, Qc + 4096, vt, l15, g); s2_load(s2, Pc + 2 * 4096, Qc + 2 * 4096, vt, l15, g); s2_load(s3, Pc + 3 * 4096, Qc + 3 * 4096, vt, l15, g);
#pragma unroll 1
        for (int c = 0; c < NCHUNK; c += 4) {
            const int cn = c + 4 < NCHUNK ? c + 4 : c;
            const bf16* Pn = Pc + (size_t)cn * 4096; const bf16* Qn = Qc + (size_t)cn * 4096;
            s2_step(acc, s0, Hc + (size_t)c * 4096, g);       s2_load(s0, Pn, Qn, vt, l15, g);
            s2_step(acc, s1, Hc + (size_t)(c + 1) * 4096, g); s2_load(s1, Pn + 4096, Qn + 4096, vt, l15, g);
            s2_step(acc, s2, Hc + (size_t)(c + 2) * 4096, g); s2_load(s2, Pn + 2 * 4096, Qn + 2 * 4096, vt, l15, g);
            s2_step(acc, s3, Hc + (size_t)(c + 3) * 4096, g); s2_load(s3, Pn + 3 * 4096, Qn + 3 * 4096, vt, l15, g);
        }
    }
}

struct S3In { u32x2 yl[2][4]; u32x4 rh[2][2]; u32x4 hh[2][4][2]; };
__device__ __forceinline__ void s3_issue(S3In& s, const bf16* YL, const bf16* RH, const bf16* HT, int task, int l15, int g) {
    const int tt = task >> 4, h = task & 15, r0 = tt * 16, row = r0 + l15;
    int b, cc[2];
    if (r0 < TL) { b = r0 >> 13; const int tb = (r0 & (SEQ - 1)) >> 6; cc[0] = 4 + tb; cc[1] = 4 + (127 - tb); }
    else { const int loc = r0 - TL; b = loc >> 8; const int tb = (loc & 255) >> 6; cc[0] = tb; cc[1] = 3 - tb; }
    const size_t ro = (size_t)row * D + h * 64 + 4 * g;
#pragma unroll
    for (int dir = 0; dir < 2; ++dir) {
#pragma unroll
        for (int vt = 0; vt < 4; ++vt) s.yl[dir][vt] = *(const u32x2*)(YL + (size_t)dir * T * D + ro + 16 * vt);
        const int chain = dir * 64 + b * 16 + h;
        const bf16* rh = RH + ((size_t)dir * T + row) * D + h * 64 + 8 * g;
        s.rh[dir][0] = *(const u32x4*)(rh); s.rh[dir][1] = *(const u32x4*)(rh + 32);
        const bf16* hc = HT + ((size_t)chain * NCHUNK + cc[dir]) * 4096;
#pragma unroll
        for (int vt = 0; vt < 4; ++vt) { const bf16* hr = hc + ((vt * 2) * 64 + g * 16 + l15) * 8; s.hh[dir][vt][0] = *(const u32x4*)(hr); s.hh[dir][vt][1] = *(const u32x4*)(hr + 512); }
    }
}
__device__ __forceinline__ void s3_finish(const S3In& s, const bf16* Vv, const float* RKB, const float* RKB1, const bf16* Gg, const float* lng, const float* lnb, bf16* Z, int task, int l15, int g) {
    const int tt = task >> 4, h = task & 15, row = tt * 16 + l15;
    u32x2 vq2[4], gw2[4]; f32x4 lg4[4], lb4[4];
#pragma unroll
    for (int vt = 0; vt < 4; ++vt) { const int col = h * 64 + 16 * vt + 4 * g; const size_t o = (size_t)row * D + col;
        vq2[vt] = *(const u32x2*)(Vv + o); gw2[vt] = *(const u32x2*)(Gg + o); lg4[vt] = *(const f32x4*)(lng + col); lb4[vt] = *(const f32x4*)(lnb + col); }
    const float bon = RKB[(size_t)row * 16 + h] + RKB1[(size_t)row * 16 + h];
    f32x4 acc[4];
#pragma unroll
    for (int vt = 0; vt < 4; ++vt) acc[vt] = bf4(s.yl[0][vt]) + bf4(s.yl[1][vt]);
#pragma unroll
    for (int dir = 0; dir < 2; ++dir) {
        const bf16x8 f0 = as_frag(s.rh[dir][0]), f1 = as_frag(s.rh[dir][1]);
#pragma unroll
        for (int vt = 0; vt < 4; ++vt) { acc[vt] = mfma16(as_frag(s.hh[dir][vt][0]), f0, acc[vt]); acc[vt] = mfma16(as_frag(s.hh[dir][vt][1]), f1, acc[vt]); }
    }
    float sm = 0.f;
#pragma unroll
    for (int vt = 0; vt < 4; ++vt) sm += (acc[vt][0] + acc[vt][1]) + (acc[vt][2] + acc[vt][3]);
    sm += __shfl_xor(sm, 16); sm += __shfl_xor(sm, 32);
    const float mean = sm * (1.0f / 64.0f); float vs = 0.f;
#pragma unroll
    for (int vt = 0; vt < 4; ++vt) { acc[vt] = acc[vt] - mean; vs += (acc[vt][0] * acc[vt][0] + acc[vt][1] * acc[vt][1]) + (acc[vt][2] * acc[vt][2] + acc[vt][3] * acc[vt][3]); }
    vs += __shfl_xor(vs, 16); vs += __shfl_xor(vs, 32);
    const float rstd = rsqrtf(vs * (1.0f / 64.0f) + 64.0f * 1e-5f);
#pragma unroll
    for (int vt = 0; vt < 4; ++vt) { const int col = h * 64 + 16 * vt + 4 * g; const size_t o = (size_t)row * D + col;
        const f32x4 zz = acc[vt] * rstd * lg4[vt] + lb4[vt] + bf4(vq2[vt]) * bon;
        u32x2 w; w.x = pk2(zz[0] * bflo(gw2[vt].x), zz[1] * bfhi(gw2[vt].x)); w.y = pk2(zz[2] * bflo(gw2[vt].y), zz[3] * bfhi(gw2[vt].y));
        *(u32x2*)(Z + o) = w; }
}
__device__ __forceinline__ void phase_s3_readout(const Args& a, int lj, int nrows, int gw, int NGW, int lane) {
    unsigned char* ws = a.ws;
    const bf16* YL = (const bf16*)(ws + WS_Y); const bf16* RH = (const bf16*)(ws + WS_RH); const bf16* HT = (const bf16*)(ws + WS_HT);
    const bf16* Vv = (const bf16*)(ws + WS_RKV) + (size_t)2 * T * D; const float* RKB = (const float*)(ws + WS_RKB); const float* RKB1 = (const float*)(ws + WS_RKB1); const bf16* Gg = (const bf16*)(ws + WS_G); bf16* Z = (bf16*)(ws + WS_Z);
    const float* lng = a.in[21] + lj * 1024; const float* lnb = a.in[22] + lj * 1024;
    const int l15 = lane & 15, g = lane >> 4, ntask = (nrows / 16) * 16;
    for (int task = gw; task < ntask; task += NGW) {
        S3In A;
        s3_issue(A, YL, RH, HT, task, l15, g);
        s3_finish(A, Vv, RKB, RKB1, Gg, lng, lnb, Z, task, l15, g);
    }
}
__device__ __forceinline__ void phase_cv(const Args& a, int lc, int rows, int gw, int NGW, int lane) {
    unsigned char* ws = a.ws;
    const bf16* BG = (const bf16*)(ws + WS_BG); const bf16* CU = (const bf16*)(ws + WS_CUZ); bf16* Z = (bf16*)(ws + WS_Z);
    const float* cw = a.in[25] + (size_t)lc * 3 * 1024;
    for (int t = gw; t < rows; t += NGW) {
        int rs, re; if (t < TL) { rs = t & ~63; re = rs + 63; } else { const int loc = t - TL; rs = TL + (loc & ~255); re = rs + 255; }
        const bool hp = t > rs, hn = t < re;
        u32x2 zc4[4], bg4[4], zp4[4], zn4[4]; f32x4 w04[4], w14[4], w24[4];
#pragma unroll
        for (int j = 0; j < 4; ++j) { const int col = 256 * j + 4 * lane; const size_t o = (size_t)t * D + col;
            zc4[j] = *(const u32x2*)(CU + o); bg4[j] = *(const u32x2*)(BG + o);
            zp4[j] = hp ? *(const u32x2*)(CU + o - D) : (u32x2){0u, 0u}; zn4[j] = hn ? *(const u32x2*)(CU + o + D) : (u32x2){0u, 0u};
            w04[j] = *(const f32x4*)(cw + col); w14[j] = *(const f32x4*)(cw + 1024 + col); w24[j] = *(const f32x4*)(cw + 2048 + col); }
#pragma unroll
        for (int j = 0; j < 4; ++j) { const int col = 256 * j + 4 * lane; const size_t o = (size_t)t * D + col;
            const u32x2 zc = zc4[j], bg = bg4[j], zp = zp4[j], zn = zn4[j];
            const f32x4 w0 = w04[j], w1 = w14[j], w2 = w24[j];
            const f32x4 zv = (f32x4){bflo(zc.x), bfhi(zc.x), bflo(zc.y), bfhi(zc.y)}, pv = (f32x4){bflo(zp.x), bfhi(zp.x), bflo(zp.y), bfhi(zp.y)}, nv = (f32x4){bflo(zn.x), bfhi(zn.x), bflo(zn.y), bfhi(zn.y)};
            const f32x4 bv = (f32x4){bflo(bg.x), bfhi(bg.x), bflo(bg.y), bfhi(bg.y)};
            const f32x4 r = bv * (w0 * pv + w1 * zv + w2 * nv);
            u32x2 w; w.x = pk2(r.x, r.y); w.y = pk2(r.z, r.w); *(u32x2*)(Z + o) = w; }
    }
}
typedef float f32x2v __attribute__((ext_vector_type(2)));
__device__ __forceinline__ float lane_bcast(float v, int srclane) { return __builtin_bit_cast(float, __builtin_amdgcn_readlane(__builtin_bit_cast(int, v), srclane)); }
__device__ __forceinline__ void phase_e_route(const Args& a, int layer, int rows, LAS unsigned char* lds, int tid, int gw, int NGW, int lane, int probe_rep = 0) {
    unsigned char* ws = a.ws;
    const float* xs = (const float*)(ws + (layer < 2 ? WS_XSA : WS_XSB));
    const float* MODS = (const float*)(ws + WS_MODS); bf16* H2 = (bf16*)(ws + WS_H2);
    const float* ng = a.in[6] + (size_t)(layer * 2 + 1) * 1024;
    const float* rw = a.in[27] + (size_t)layer * 1024 * 32; const float* rb = a.in[28] + layer * 32;
    unsigned* cnt = (unsigned*)(ws + WS_CTL) + CW_CNT + (layer + 4 * probe_rep) * 32 * CNT_STRIDE;
    int* SLOTL = (int*)(ws + (probe_rep ? WS_L1 : WS_SLOTL)); float* GATEL = (float*)(ws + (probe_rep ? WS_L1 + 8 * MiB : WS_GATEL));
    LAS float* wt = (LAS float*)lds;
    LAS int* hist = (LAS int*)(lds + LDSCTL_OFF + 3072); LAS int* base = hist + 32; LAS int* lcnt = hist + 64;
    int* TKE = (int*)(ws + WS_C12); float* TKG = (float*)(ws + WS_C12 + 4 * MiB);
    for (int i = tid; i < 32768; i += 512) wt[(i & 31) * 1024 + (i >> 5)] = rw[i];
    if (tid < 32) hist[tid] = 0;
    __syncthreads();
    const int my_e = lane >> 1; const float my_b = rb[my_e];
    const bool b5 = (lane & 32) != 0, b4 = (lane & 16) != 0, b3 = (lane & 8) != 0, b2 = (lane & 4) != 0, b1 = (lane & 2) != 0;
    for (int t = gw; t < rows; t += NGW) {
        const int mr = mod_row(t);
        const float* mod = MODS + (size_t)(layer * 5 + mr) * 6144;
        f32x4 x[4];
#pragma unroll
        for (int j = 0; j < 4; ++j) x[j] = *(const f32x4*)(xs + (size_t)t * D + 256 * j + 4 * lane);
        const float rstd = row_rstd(x);
#pragma unroll
        for (int j = 0; j < 4; ++j) { const int col = 256 * j + 4 * lane;
            x[j] = x[j] * rstd * *(const f32x4*)(ng + col) * (*(const f32x4*)(mod + 4 * 1024 + col) + 1.0f) + *(const f32x4*)(mod + 3 * 1024 + col);
            u32x2 w; w.x = pk2(x[j].x, x[j].y); w.y = pk2(x[j].z, x[j].w); *(u32x2*)(H2 + (size_t)t * D + col) = w; }
        float p[32];
#pragma unroll
        for (int eg = 0; eg < 8; ++eg) {
#pragma unroll
            for (int ee = 0; ee < 4; ++ee) { const int e = eg * 4 + ee; f32x2v s2 = (f32x2v){0.f, 0.f};
#pragma unroll
                for (int j = 0; j < 4; ++j) { const f32x4 wv = *(const LAS f32x4*)(wt + e * 1024 + 256 * j + 4 * lane);
                    s2 = __builtin_elementwise_fma((f32x2v){x[j].x, x[j].y}, (f32x2v){wv.x, wv.y}, s2); s2 = __builtin_elementwise_fma((f32x2v){x[j].z, x[j].w}, (f32x2v){wv.z, wv.w}, s2); }
                p[e] = s2.x + s2.y; }
            asm volatile("" ::: "memory");
        }
        float q16[16];
#pragma unroll
        for (int i = 0; i < 16; ++i) { const float send = b5 ? p[i] : p[i + 16]; const float keep = b5 ? p[i + 16] : p[i]; q16[i] = keep + __shfl_xor(send, 32); }
        float q8[8];
#pragma unroll
        for (int i = 0; i < 8; ++i) { const float send = b4 ? q16[i] : q16[i + 8]; const float keep = b4 ? q16[i + 8] : q16[i]; q8[i] = keep + __shfl_xor(send, 16); }
        float q4[4];
#pragma unroll
        for (int i = 0; i < 4; ++i) { const float send = b3 ? q8[i] : q8[i + 4]; const float keep = b3 ? q8[i + 4] : q8[i]; q4[i] = keep + __shfl_xor(send, 8); }
        float q2[2];
#pragma unroll
        for (int i = 0; i < 2; ++i) { const float send = b2 ? q4[i] : q4[i + 2]; const float keep = b2 ? q4[i + 2] : q4[i]; q2[i] = keep + __shfl_xor(send, 4); }
        float q1; { const float send = b1 ? q2[0] : q2[1]; const float keep = b1 ? q2[1] : q2[0]; q1 = keep + __shfl_xor(send, 2); }
        const float lg = q1 + __shfl_xor(q1, 1) + my_b;
        int rank = 0;
#pragma unroll 1
        for (int e = 0; e < 32; ++e) { const float o = lane_bcast(lg, 2 * e); rank += (o > lg || (o == lg && e < my_e)) ? 1 : 0; }
        const bool sel = rank < 4 && !(lane & 1);
        const unsigned long long m0 = __ballot(sel && rank == 0), m1 = __ballot(sel && rank == 1), m2 = __ballot(sel && rank == 2), m3 = __ballot(sel && rank == 3);
        const float v0 = lane_bcast(lg, (int)__builtin_ctzll(m0)), v1 = lane_bcast(lg, (int)__builtin_ctzll(m1)), v2 = lane_bcast(lg, (int)__builtin_ctzll(m2)), v3 = lane_bcast(lg, (int)__builtin_ctzll(m3));
        const float e1 = __expf(v1 - v0), e2 = __expf(v2 - v0), e3 = __expf(v3 - v0);
        const float inv = frcp(1.0f + e1 + e2 + e3);
        if (sel) {
            TKE[t * 4 + rank] = my_e; TKG[t * 4 + rank] = __expf(lg - v0) * inv;
            __hip_atomic_fetch_add(hist + my_e, 1, __ATOMIC_RELAXED, __HIP_MEMORY_SCOPE_WORKGROUP);
        }
    }
    asm volatile("s_waitcnt vmcnt(0) lgkmcnt(0)" ::: "memory"); __syncthreads();
    if (tid < 32) { base[tid] = (int)atomicAdd(cnt + tid * CNT_STRIDE, (unsigned)hist[tid]); lcnt[tid] = 0; }
    __syncthreads();
    for (int t = gw; t < rows; t += NGW) {
        if (lane < 4) { const int e = TKE[t * 4 + lane]; const float gk = TKG[t * 4 + lane];
            const int pos = base[e] + __hip_atomic_fetch_add(lcnt + e, 1, __ATOMIC_RELAXED, __HIP_MEMORY_SCOPE_WORKGROUP);
            SLOTL[(size_t)e * T + pos] = t * 4 + lane; GATEL[(size_t)e * T + pos] = gk; }
    }
}
__device__ __forceinline__ int okey(float v, int e) { const int i = __builtin_bit_cast(int, v); const int o = i ^ ((i >> 31) & 0x7fffffff); return (o & ~31) | (31 - e); }
__device__ __forceinline__ void phase_e_route_mfma(const Args& a, int layer, int rows, LAS unsigned char* lds, int tid, int wave, int gw, int NGW, int lane, int probe_rep = 0) {
    unsigned char* ws = a.ws;
    const float* xs = (const float*)(ws + (layer < 2 ? WS_XSA : WS_XSB));
    const float* MODS = (const float*)(ws + WS_MODS); bf16* H2 = (bf16*)(ws + WS_H2);
    const float* ng = a.in[6] + (size_t)(layer * 2 + 1) * 1024; const float* rb = a.in[28] + layer * 32;
    const bf16* WRT = (const bf16*)(ws + WS_WRT) + (size_t)layer * 2 * 32 * 1024;
    unsigned* cnt = (unsigned*)(ws + WS_CTL) + CW_CNT + (layer + 4 * probe_rep) * 32 * CNT_STRIDE;
    int* SLOTL = (int*)(ws + (probe_rep ? WS_L1 : WS_SLOTL)); float* GATEL = (float*)(ws + (probe_rep ? WS_L1 + 8 * MiB : WS_GATEL));
    LAS int* hist = (LAS int*)(lds + LDSCTL_OFF + 3072); LAS int* base = hist + 32; LAS int* lcnt = hist + 64;
    int* TKE = (int*)(ws + WS_C12); float* TKG = (float*)(ws + WS_C12 + 4 * MiB);
    LAS unsigned char* tile = lds + wave * 8448;
    if (tid < 32) hist[tid] = 0;
    constexpr int E_TAB = 8 * 8448, E_TP = 2064;
    static_assert(E_TAB + 32 * E_TP <= LDSCTL_OFF, "router table");
    { u32x4 tw[8];
#pragma unroll
      for (int q = 0; q < 8; ++q) { const int i = tid + q * 512, r = i >> 7, pc = i & 127; tw[q] = *(const u32x4*)(WRT + (size_t)r * 1024 + pc * 8); }
#pragma unroll
      for (int q = 0; q < 8; ++q) { const int i = tid + q * 512, r = i >> 7, pc = i & 127; *(LAS u32x4*)(lds + E_TAB + r * E_TP + pc * 16) = tw[q]; } }
    __syncthreads();
    const int l15 = lane & 15, g = lane >> 4;
    const int nlat = TL / 16, nctx = rows > TL ? TC / 4 : 0, G_ = NGW / 8;
    for (int it = 0;; ++it) {
        int t0, ntok;
        { const int tl = gw + it * NGW; const int xi = (int)blockIdx.x + (it - (nlat + NGW - 1) / NGW) * G_ * 8 + wave * G_;
          if (tl < nlat) { t0 = tl * 16; ntok = 16; } else if (it >= (nlat + NGW - 1) / NGW && xi < nctx) { t0 = TL + xi * 4; ntok = 4; } else if (it >= (nlat + NGW - 1) / NGW) break; else continue; }
        const float* mod = MODS + (size_t)(layer * 5 + mod_row(t0)) * 6144;
        float rstd[16];
#pragma unroll
        for (int tb = 0; tb < 16; tb += 8) {
            f32x4 xa[8][4];
#pragma unroll
            for (int t = 0; t < 8; ++t) { const int tr = tb + t < ntok ? t0 + tb + t : t0;
#pragma unroll
                for (int j = 0; j < 4; ++j) xa[t][j] = *(const f32x4*)(xs + (size_t)tr * D + 256 * j + 4 * lane); }
#pragma unroll
            for (int t = 0; t < 8; ++t) rstd[tb + t] = __builtin_bit_cast(float, __builtin_amdgcn_readfirstlane(__builtin_bit_cast(int, row_rstd(xa[t]))));
            asm volatile("" ::: "memory"); }
        f32x4 acc[2]; acc[0] = (f32x4){0.f, 0.f, 0.f, 0.f}; acc[1] = acc[0];
#pragma unroll 1
        for (int s = 0; s < 4; ++s) {
            const int col = 256 * s + 4 * lane;
            int t0s = t0; asm volatile("" : "+s"(t0s));
            const bf16* wl = WRT + (size_t)(32 + l15) * 1024 + 256 * s + 8 * g;
            u32x4 wlf[8][2];
#pragma unroll
            for (int ks = 0; ks < 8; ++ks)
#pragma unroll
                for (int et = 0; et < 2; ++et) wlf[ks][et] = *(const u32x4*)(wl + (size_t)et * 16 * 1024 + 32 * ks);
            const f32x4 g4 = *(const f32x4*)(ng + col) * (*(const f32x4*)(mod + 4 * 1024 + col) + 1.0f), s4 = *(const f32x4*)(mod + 3 * 1024 + col);
            u32x2 lo[16];
#pragma unroll
            for (int tb = 0; tb < 16; tb += 8) {
                f32x4 xr[8];
#pragma unroll
                for (int t = 0; t < 8; ++t) { const int tr = tb + t < ntok ? t0s + tb + t : t0s; xr[t] = *(const f32x4*)(xs + (size_t)tr * D + col); }
#pragma unroll
                for (int t = 0; t < 8; ++t) { const int tr = tb + t < ntok ? t0s + tb + t : t0s; const f32x4 hv = xr[t] * rstd[tb + t] * g4 + s4;
                    const u32x2 w = pk4(hv); if (tb + t < ntok) *(u32x2*)(H2 + (size_t)tr * D + col) = w;
                    *(LAS u32x2*)(tile + (tb + t) * 528 + lane * 8) = w; lo[tb + t] = pk4(hv - bf4(w)); } }
            LDS_WAIT(); asm volatile("" ::: "memory");
            const LAS unsigned char* th = lds + E_TAB + l15 * E_TP + (256 * s + 8 * g) * 2;
#pragma unroll
            for (int ks = 0; ks < 8; ++ks) { const bf16x8 fb = as_frag(*(const LAS u32x4*)(tile + l15 * 528 + ks * 64 + g * 16));
#pragma unroll
                for (int et = 0; et < 2; ++et) { acc[et] = mfma16(as_frag(*(const LAS u32x4*)(th + et * 16 * E_TP + 64 * ks)), fb, acc[et]);
                    acc[et] = mfma16(as_frag(wlf[ks][et]), fb, acc[et]); } }
            LDS_WAIT(); asm volatile("" ::: "memory");
#pragma unroll
            for (int t = 0; t < 16; ++t) *(LAS u32x2*)(tile + t * 528 + lane * 8) = lo[t];
            LDS_WAIT(); asm volatile("" ::: "memory");
#pragma unroll
            for (int ks = 0; ks < 8; ++ks) { const bf16x8 fb = as_frag(*(const LAS u32x4*)(tile + l15 * 528 + ks * 64 + g * 16));
#pragma unroll
                for (int et = 0; et < 2; ++et) acc[et] = mfma16(as_frag(*(const LAS u32x4*)(th + et * 16 * E_TP + 64 * ks)), fb, acc[et]); }
            LDS_WAIT(); asm volatile("" ::: "memory");
        }
        float v[8]; int key[8];
#pragma unroll
        for (int j = 0; j < 8; ++j) { const int e = (j < 4 ? 0 : 16) + 4 * g + (j & 3); v[j] = acc[j >> 2][j & 3] + rb[e]; key[j] = okey(v[j], e); }
        int kb[8], kc[8], kd2[8];
#pragma unroll
        for (int j = 0; j < 8; ++j) kb[j] = __shfl_xor(key[j], 16);
#pragma unroll
        for (int j = 0; j < 8; ++j) { kc[j] = __shfl_xor(key[j], 32); kd2[j] = __shfl_xor(kb[j], 32); }
        float vmax = fmaxf(fmaxf(fmaxf(v[0], v[1]), fmaxf(v[2], v[3])), fmaxf(fmaxf(v[4], v[5]), fmaxf(v[6], v[7])));
        vmax = fmaxf(vmax, __shfl_xor(vmax, 16)); vmax = fmaxf(vmax, __shfl_xor(vmax, 32));
        int rank[8]; float ex[8], part = 0.f;
#pragma unroll
        for (int j = 0; j < 8; ++j) { int r = 0;
#pragma unroll
            for (int q = 0; q < 8; ++q) r += (key[q] > key[j]) + (kb[q] > key[j]) + (kc[q] > key[j]) + (kd2[q] > key[j]);
            rank[j] = r; ex[j] = __expf(v[j] - vmax); part += r < 4 ? ex[j] : 0.f; }
        part += __shfl_xor(part, 16); part += __shfl_xor(part, 32);
        const float inv = frcp(part); const int t = t0 + l15;
#pragma unroll
        for (int j = 0; j < 8; ++j) if (rank[j] < 4 && l15 < ntok) { const int e = (j < 4 ? 0 : 16) + 4 * g + (j & 3);
            TKE[t * 4 + rank[j]] = e; TKG[t * 4 + rank[j]] = ex[j] * inv;
            __hip_atomic_fetch_add(hist + e, 1, __ATOMIC_RELAXED, __HIP_MEMORY_SCOPE_WORKGROUP); }
    }
    asm volatile("s_waitcnt vmcnt(0) lgkmcnt(0)" ::: "memory"); __syncthreads();
    if (tid < 32) { base[tid] = (int)atomicAdd(cnt + tid * CNT_STRIDE, (unsigned)hist[tid]); lcnt[tid] = 0; }
    __syncthreads();
    for (int it = 0;; ++it) {
        int t0, ntok;
        { const int tl = gw + it * NGW; const int xi = (int)blockIdx.x + (it - (nlat + NGW - 1) / NGW) * G_ * 8 + wave * G_;
          if (tl < nlat) { t0 = tl * 16; ntok = 16; } else if (it >= (nlat + NGW - 1) / NGW && xi < nctx) { t0 = TL + xi * 4; ntok = 4; } else if (it >= (nlat + NGW - 1) / NGW) break; else continue; }
        if ((lane >> 2) < ntok) { const int t = t0 + (lane >> 2), k = lane & 3;
            const int e = TKE[t * 4 + k]; const float gk = TKG[t * 4 + k];
            const int pos = base[e] + __hip_atomic_fetch_add(lcnt + e, 1, __ATOMIC_RELAXED, __HIP_MEMORY_SCOPE_WORKGROUP);
            SLOTL[(size_t)e * T + pos] = t * 4 + k; GATEL[(size_t)e * T + pos] = gk; }
    }
}
__device__ __forceinline__ void phase_final(const Args& a, int gw, int NGW, int lane) {
    unsigned char* ws = a.ws;
    const float* xs = (const float*)(ws + WS_XSB); const float* MODS = (const float*)(ws + WS_MODS); const bf16* YS = (const bf16*)(ws + WS_YS);
    for (int t = gw; t < TL; t += NGW) {
        const int mr = t >> 13;
        f32x4 m5[4], x[4];
#pragma unroll
        for (int j = 0; j < 4; ++j) m5[j] = *(const f32x4*)(MODS + (size_t)(3 * 5 + mr) * 6144 + 5 * 1024 + 256 * j + 4 * lane);
        f32x4 fg[4];
#pragma unroll
        for (int j = 0; j < 4; ++j) fg[j] = *(const f32x4*)(a.in[7] + 256 * j + 4 * lane);
        load_x_combined(x, xs + (size_t)t * D, true, YS, t, m5, lane);
        const float rstd = row_rstd(x);
#pragma unroll
        for (int j = 0; j < 4; ++j) { const int col = 256 * j + 4 * lane; *(f32x4*)(a.out + (size_t)t * D + col) = x[j] * rstd * fg[j]; }
    }
}

using pg8::Unit; using pg8::tile_map;
struct SchedStd {
    int G, c, nM, nN;
    __device__ __forceinline__ bool next(int i, Unit& u) const { const long L = (long)i * G + c; if (L >= (long)nM * nN) return false; int pm, pn; tile_map((int)L, nM, nN, pm, pn); u.pm = pm; u.pn = pn; u.e = 0; u.nv = pm; u.par = 0; return true; }
    __device__ __forceinline__ void a_ready(const Unit&) const {}
    __device__ __forceinline__ void done(const Unit&) const {}
    __device__ __forceinline__ unsigned row_off(const Unit&, int) const { return 0u; }
    __device__ __forceinline__ unsigned row_off_lds(const Unit&, int) const { return 0u; }
    __device__ __forceinline__ void prefetch_rows(const Unit&) const {}
};
struct SchedB1 {
    int G, c;
    __device__ __forceinline__ bool next(int i, Unit& u) const { const long L = (long)i * G + c; constexpr int n1 = 3 * NMT * 4; if (L >= n1 + 3 * NMT) return false; const int l = (int)L;
        if (l < n1) { const int j = l / (NMT * 4), r = l % (NMT * 4); int pm, pn; tile_map(r, NMT, 4, pm, pn); u.pm = j * NMT + pm; u.pn = j * 4 + pn; u.e = j; u.nv = pm; }
        else { const int r = l - n1, j = r / NMT, pm = r % NMT; u.pm = (3 + j) * NMT + pm; u.pn = 12 + j; u.e = 3 + j; u.nv = pm; }
        u.par = 0; return true; }
    __device__ __forceinline__ void a_ready(const Unit&) const {}
    __device__ __forceinline__ void done(const Unit&) const {}
    __device__ __forceinline__ unsigned row_off(const Unit&, int) const { return 0u; }
    __device__ __forceinline__ unsigned row_off_lds(const Unit&, int) const { return 0u; }
    __device__ __forceinline__ void prefetch_rows(const Unit&) const {}
};
struct SchedB2 {
    int G, c;
    __device__ __forceinline__ bool next(int i, Unit& u) const { const long L = (long)i * G + c; constexpr int n1 = 2 * NMT * 8; if (L >= n1 + NMT * 4) return false; const int l = (int)L;
        if (l < n1) { const int j = l / (NMT * 8), r = l % (NMT * 8); int pm, pn; tile_map(r, NMT, 8, pm, pn); u.pm = j * NMT + pm; u.pn = j * 8 + pn; u.e = j; u.nv = pm; }
        else { const int r = l - n1; int pm, pn; tile_map(r, NMT, 4, pm, pn); u.pm = 2 * NMT + pm; u.pn = 16 + pn; u.e = 2; u.nv = pm; }
        u.par = 0; return true; }
    __device__ __forceinline__ void a_ready(const Unit&) const {}
    __device__ __forceinline__ void done(const Unit&) const {}
    __device__ __forceinline__ unsigned row_off(const Unit&, int) const { return 0u; }
    __device__ __forceinline__ unsigned row_off_lds(const Unit&, int) const { return 0u; }
    __device__ __forceinline__ void prefetch_rows(const Unit&) const {}
};
struct SchedMoe {
    int G, c, nnt, ntiles, P; LAS unsigned char* lds; const int* slotl; const float* gatel; int wave;
    __device__ __forceinline__ bool next(int i, Unit& u) const { const long L = (long)i * G + c; const int ntp = (ntiles + P - 1) / P, ppg = nnt / (8 / P); if (L >= (long)ntp * ppg * 8) return false;
        const LAS int* tpre = (const LAS int*)(lds + LDSCTL_OFF + 64); const LAS int* ecnt = (const LAS int*)(lds + LDSCTL_OFF + 256); const LAS unsigned short* tile_e = (const LAS unsigned short*)(lds + LDSCTL_OFF + 512);
        const int xq = (int)(L >> 3), x8 = (int)(L & 7); int tile = (xq / ppg) * P + (x8 % P); const int pnl = (x8 / P) * ppg + xq % ppg; const bool dead = tile >= ntiles; tile = dead ? 0 : tile;
        const int e = __builtin_amdgcn_readfirstlane((int)tile_e[tile]), r0 = (tile - __builtin_amdgcn_readfirstlane(tpre[e])) * 256; int nv = __builtin_amdgcn_readfirstlane(ecnt[e]) - r0; nv = nv > 256 ? 256 : nv; nv = dead ? 0 : nv;
        u.pm = dead ? MAXTILES : tile; u.pn = e * nnt + pnl; u.e = e; u.nv = nv | (r0 << 9); u.par = i & 1; return true; }
    __device__ __forceinline__ void a_ready(const Unit& u) const {
        if (gatel != nullptr && wave == 0) { const size_t li = (size_t)u.e * T + (u.nv >> 9) + 4 * lane_id();
            __builtin_amdgcn_global_load_lds((const unsigned*)(slotl + li), (LAS unsigned*)(lds + LDSCTL_OFF + 8192 + 2048 * u.par), 16, 0, 0);
            __builtin_amdgcn_global_load_lds((const unsigned*)(gatel + li), (LAS unsigned*)(lds + LDSCTL_OFF + 8192 + 2048 * u.par + 1024), 16, 0, 0); } }
    __device__ __forceinline__ void done(const Unit&) const {}
    __device__ __forceinline__ void prefetch_rows(const Unit& u) const {
        if (wave == 0) __builtin_amdgcn_global_load_lds((const unsigned*)(slotl + (size_t)u.e * T + (u.nv >> 9) + 4 * lane_id()), (LAS unsigned*)(lds + LDSCTL_OFF + 8192 + 2048 * u.par), 16, 0, 0); }
    __device__ __forceinline__ unsigned row_off_lds(const Unit& u, int r) const { const int nv = u.nv & 511; const int sl = ((const LAS int*)(lds + LDSCTL_OFF + 8192 + 2048 * u.par))[r]; const int tok = r < nv ? (sl >> 2) : 0; return (unsigned)tok * 2048u; }
    __device__ __forceinline__ unsigned row_off(const Unit& u, int r) const { const int nv = u.nv & 511, r0 = u.nv >> 9; const int tok = r < nv ? (slotl[(size_t)u.e * T + r0 + r] >> 2) : 0; return (unsigned)tok * 2048u; }
};

using pg8::cvt_pk_bf16;
template <class P> __device__ __forceinline__ P* pin_ptr(P* p) { asm volatile("" : "+v"(p)); return p; }
struct EpiB1 {
    static constexpr bool PERM = true, AFTER_DRAIN = false;
    bf16* RKV; bf16* L1;
    __device__ __forceinline__ void operator()(const f32x4 (&acc)[2][2][4][2], const Unit& u, int wr, int wc, int fr, int fq) const {
        const int seg = u.e, row0 = u.nv * 256 + wr * 64 + fr;
        const int jj = seg - 3, ld = seg < 3 ? D : 128, col0 = (seg < 3 ? (u.pn - seg * 4) * 256 : 0) + wc * 32 + 8 * fq;
        bf16* base = seg < 3 ? RKV + (size_t)seg * T * D : L1 + (size_t)jj * T * 128;
#pragma unroll
        for (int ai = 0; ai < 2; ++ai)
#pragma unroll
            for (int m = 0; m < 4; ++m) { bf16* rowp = base + (size_t)(row0 + ai * 128 + m * 16) * ld + col0;
#pragma unroll
                for (int bj = 0; bj < 2; ++bj) { if (seg >= 3 && bj == 1) continue; f32x4 v0 = acc[ai][bj][m][0], v1 = acc[ai][bj][m][1];
                    if (jj == 0) {
#pragma unroll
                        for (int q = 0; q < 4; ++q) { v0[q] = tanh_fast(v0[q]); v1[q] = tanh_fast(v1[q]); } }
                    else if (jj == 2) {
#pragma unroll
                        for (int q = 0; q < 4; ++q) { v0[q] = sigm(v0[q]); v1[q] = sigm(v1[q]); } }
                    u32x4 w; w.x = cvt_pk_bf16(v0[0], v0[1]); w.y = cvt_pk_bf16(v0[2], v0[3]); w.z = cvt_pk_bf16(v1[0], v1[1]); w.w = cvt_pk_bf16(v1[2], v1[3]);
                    *(u32x4*)(rowp + bj * 128) = w; } }
    }
};
struct EpiB2 {
    static constexpr bool PERM = true, AFTER_DRAIN = false;
    bf16* RW; bf16* RA; bf16* Gg;
    __device__ __forceinline__ void operator()(const f32x4 (&acc)[2][2][4][2], const Unit& u, int wr, int wc, int fr, int fq) const {
        const int jj = u.e, row0 = u.nv * 256 + wr * 64 + fr, pnl = u.pn - jj * 8;
        const int dirn = jj < 2 ? (pnl >> 2) : 0, col0 = (jj < 2 ? (pnl & 3) : pnl) * 256 + wc * 32 + 8 * fq;
        bf16* base = (jj == 0 ? RW : jj == 1 ? RA : Gg) + (size_t)dirn * T * D;
#pragma unroll
        for (int ai = 0; ai < 2; ++ai)
#pragma unroll
            for (int m = 0; m < 4; ++m) { bf16* rowp = base + (size_t)(row0 + ai * 128 + m * 16) * D + col0;
#pragma unroll
                for (int bj = 0; bj < 2; ++bj) { const f32x4 v0 = acc[ai][bj][m][0], v1 = acc[ai][bj][m][1];
                    u32x4 w; w.x = cvt_pk_bf16(v0[0], v0[1]); w.y = cvt_pk_bf16(v0[2], v0[3]); w.z = cvt_pk_bf16(v1[0], v1[1]); w.w = cvt_pk_bf16(v1[2], v1[3]);
                    *(u32x4*)(rowp + bj * 128) = w; } }
    }
};
struct EpiRes {
    static constexpr bool PERM = true, AFTER_DRAIN = false;
    float* X; const float* gate; float* Xo;
    __device__ __forceinline__ void operator()(const f32x4 (&acc)[2][2][4][2], const Unit& u, int wr, int wc, int fr, int fq) const {
        const int row0 = u.pm * 256 + wr * 64 + fr, col0 = u.pn * 256 + wc * 32 + 8 * fq, mr = u.pm < NMT_L ? (u.pm >> 5) : 4;
        const float* gp = pin_ptr(gate + (size_t)mr * 6144 + col0);
        f32x4 gv[2][2];
#pragma unroll
        for (int bj = 0; bj < 2; ++bj)
#pragma unroll
            for (int n = 0; n < 2; ++n) gv[bj][n] = *(const f32x4*)(gp + bj * 128 + 4 * n);
        f32x4 xa[2][2][2], xb[2][2][2];
#define ER_LOAD(dst, b_) do { _Pragma("unroll") for (int m = 0; m < 2; ++m) _Pragma("unroll") for (int bj = 0; bj < 2; ++bj) _Pragma("unroll") for (int n = 0; n < 2; ++n) \
            dst[m][bj][n] = *(const f32x4*)(X + (size_t)(row0 + ((b_) >> 1) * 128 + (((b_) & 1) * 2 + m) * 16) * D + col0 + bj * 128 + 4 * n); } while (0)
#define ER_STORE(src, b_) do { _Pragma("unroll") for (int m = 0; m < 2; ++m) _Pragma("unroll") for (int bj = 0; bj < 2; ++bj) _Pragma("unroll") for (int n = 0; n < 2; ++n) \
            *(f32x4*)(Xo + (size_t)(row0 + ((b_) >> 1) * 128 + (((b_) & 1) * 2 + m) * 16) * D + col0 + bj * 128 + 4 * n) = src[m][bj][n] + gv[bj][n] * acc[(b_) >> 1][bj][((b_) & 1) * 2 + m][n]; } while (0)
        ER_LOAD(xa, 0); ER_LOAD(xb, 1); ER_STORE(xa, 0); ER_LOAD(xa, 2); ER_STORE(xb, 1); ER_LOAD(xb, 3); ER_STORE(xa, 2); ER_STORE(xb, 3);
#undef ER_LOAD
#undef ER_STORE
    }
};
struct EpiWin {
    static constexpr bool PERM = true, AFTER_DRAIN = false;
    bf16* BG; bf16* CU;
    __device__ __forceinline__ void operator()(const f32x4 (&acc)[2][2][4][2], const Unit& u, int wr, int wc, int fr, int fq) const {
        const int row0 = u.pm * 256 + wr * 64 + fr;
        if (u.pn < 4) {
            const int col0 = u.pn * 256 + wc * 32 + 8 * fq;
#pragma unroll
            for (int ai = 0; ai < 2; ++ai)
#pragma unroll
                for (int m = 0; m < 4; ++m) { bf16* rowp = BG + (size_t)(row0 + ai * 128 + m * 16) * D + col0;
#pragma unroll
                    for (int bj = 0; bj < 2; ++bj) { const f32x4 v0 = acc[ai][bj][m][0], v1 = acc[ai][bj][m][1];
                        u32x4 w; w.x = cvt_pk_bf16(v0[0], v0[1]); w.y = cvt_pk_bf16(v0[2], v0[3]); w.z = cvt_pk_bf16(v1[0], v1[1]); w.w = cvt_pk_bf16(v1[2], v1[3]);
                        *(u32x4*)(rowp + bj * 128) = w; } }
        } else {
            const int f0 = (u.pn - 4) * 128 + wc * 32 + 8 * fq;
#pragma unroll
            for (int ai = 0; ai < 2; ++ai)
#pragma unroll
                for (int m = 0; m < 4; ++m) { const f32x4 v0 = acc[ai][0][m][0] * acc[ai][1][m][0], v1 = acc[ai][0][m][1] * acc[ai][1][m][1];
                    u32x4 w; w.x = cvt_pk_bf16(v0[0], v0[1]); w.y = cvt_pk_bf16(v0[2], v0[3]); w.z = cvt_pk_bf16(v1[0], v1[1]); w.w = cvt_pk_bf16(v1[2], v1[3]);
                    *(u32x4*)(CU + (size_t)(row0 + ai * 128 + m * 16) * D + f0) = w; }
        }
    }
};
struct EpiGU {
    static constexpr bool PERM = true, AFTER_DRAIN = false;
    bf16* INTER; const float* bgu;
    __device__ __forceinline__ void operator()(const f32x4 (&acc)[2][2][4][2], const Unit& u, int wr, int wc, int fr, int fq) const {
        const int e = u.e, pnl = u.pn - e * 8, row0 = u.pm * 256 + wr * 64 + fr, f0 = pnl * 128 + wc * 32 + 8 * fq;
        typedef const __attribute__((address_space(1))) f32x4* GF4;
        const GF4 bp = (GF4)pin_ptr(bgu + (size_t)e * 2048 + f0);
        f32x4 bg[2], bu[2];
#pragma unroll
        for (int n = 0; n < 2; ++n) { bg[n] = bp[n]; bu[n] = bp[256 + n] + 1.0f; }
#pragma unroll
        for (int ai = 0; ai < 2; ++ai)
#pragma unroll
            for (int m = 0; m < 4; ++m) { f32x4 o[2];
#pragma unroll
                for (int n = 0; n < 2; ++n) { const f32x4 g = acc[ai][0][m][n] + bg[n], uu = acc[ai][1][m][n] + bu[n];
#pragma unroll
                    for (int q = 0; q < 4; ++q) { const float gc = fminf(g[q], 7.0f), uc1 = fminf(fmaxf(uu[q], -6.0f), 8.0f);
                        o[n][q] = uc1 * gc * frcp(1.0f + __builtin_amdgcn_exp2f(gc * (-1.702f * 1.44269504f))); } }
                u32x4 w; w.x = cvt_pk_bf16(o[0][0], o[0][1]); w.y = cvt_pk_bf16(o[0][2], o[0][3]); w.z = cvt_pk_bf16(o[1][0], o[1][1]); w.w = cvt_pk_bf16(o[1][2], o[1][3]);
                *(u32x4*)(INTER + (size_t)(row0 + ai * 128 + m * 16) * 1024 + f0) = w; }
    }
};
struct EpiDown {
    static constexpr bool PERM = true, AFTER_DRAIN = false;
    bf16* YS; const float* bdn; LAS unsigned char* lds;
    __device__ __forceinline__ void operator()(const f32x4 (&acc)[2][2][4][2], const Unit& u, int wr, int wc, int fr, int fq) const {
        const int e = u.e, pnl = u.pn - e * 4, col0 = pnl * 256 + wc * 32 + 8 * fq, nv = u.nv & 511;
        typedef const __attribute__((address_space(1))) f32x4* GF4;
        const GF4 bp = (GF4)pin_ptr(bdn + (size_t)e * 1024 + col0);
        f32x4 bv[2][2];
#pragma unroll
        for (int bj = 0; bj < 2; ++bj)
#pragma unroll
            for (int n = 0; n < 2; ++n) bv[bj][n] = bp[bj * 32 + n];
        const LAS int* sl = (const LAS int*)(lds + LDSCTL_OFF + 8192 + 2048 * u.par);
        int slot8[2][4]; float gt8[2][4];
#pragma unroll
        for (int ai = 0; ai < 2; ++ai)
#pragma unroll
            for (int m = 0; m < 4; ++m) { const int r = ai * 128 + wr * 64 + m * 16 + fr; slot8[ai][m] = sl[r]; gt8[ai][m] = ((const LAS float*)(sl + 256))[r]; }
#pragma unroll
        for (int ai = 0; ai < 2; ++ai) asm volatile("" : "+v"(slot8[ai][0]), "+v"(slot8[ai][1]), "+v"(slot8[ai][2]), "+v"(slot8[ai][3]), "+v"(gt8[ai][0]), "+v"(gt8[ai][1]), "+v"(gt8[ai][2]), "+v"(gt8[ai][3]));
        asm volatile("" : "+v"(bv[0][0]), "+v"(bv[0][1]), "+v"(bv[1][0]), "+v"(bv[1][1]));
#pragma unroll
        for (int ai = 0; ai < 2; ++ai)
#pragma unroll
            for (int m = 0; m < 4; ++m) { const int r = ai * 128 + wr * 64 + m * 16 + fr;
                if (r < nv) { const int slot = slot8[ai][m]; const float gt = gt8[ai][m];
                    bf16* rowp = YS + (size_t)slot * 1024 + col0;
#pragma unroll
                    for (int bj = 0; bj < 2; ++bj) { const f32x4 v0 = (acc[ai][bj][m][0] + bv[bj][0]) * gt, v1 = (acc[ai][bj][m][1] + bv[bj][1]) * gt;
                        u32x4 w; w.x = cvt_pk_bf16(v0[0], v0[1]); w.y = cvt_pk_bf16(v0[2], v0[3]); w.z = cvt_pk_bf16(v1[0], v1[1]); w.w = cvt_pk_bf16(v1[2], v1[3]);
                        *(u32x4*)(rowp + bj * 128) = w; } } }
    }
};

__device__ __forceinline__ int moe_tables(const unsigned* cnt, LAS unsigned char* lds, int tid) {
    LAS int* tpre = (LAS int*)(lds + LDSCTL_OFF + 64); LAS int* ecnt = (LAS int*)(lds + LDSCTL_OFF + 256); LAS unsigned short* tile_e = (LAS unsigned short*)(lds + LDSCTL_OFF + 512);
    if (tid < 64) { const int e = tid & 31;
        const int cn = tid < 32 ? (int)__hip_atomic_load(cnt + e * CNT_STRIDE, __ATOMIC_RELAXED, __HIP_MEMORY_SCOPE_AGENT) : 0;
        const int tl = (cn + 255) >> 8; int incl = tl;
#pragma unroll
        for (int d = 1; d < 32; d <<= 1) { const int o = __shfl_up(incl, d); if (tid >= d) incl += o; }
        if (tid < 32) { ecnt[e] = cn; tpre[e] = incl - tl; }
        if (tid == 31) tpre[32] = incl; }
    __syncthreads();
    const int nt = tpre[32];
    { const int e = tid >> 4, sub = tid & 15, t1 = tpre[e + 1]; for (int t = tpre[e] + sub; t < t1; t += 16) tile_e[t] = (unsigned short)e; }
    __syncthreads();
    return nt;
}

constexpr int NPHASES = 37;
typedef const Args __attribute__((address_space(4))) CArgs;
__global__ void __attribute__((amdgpu_flat_work_group_size(512, 512), amdgpu_waves_per_eu(2, 2))) fwd_kernel(Args a_) {
    extern __shared__ __attribute__((aligned(16))) unsigned char lds_raw[];
    LAS unsigned char* lds = (LAS unsigned char*)lds_raw;
    const int G = gridDim.x, NGW = G * 8;
    CArgs* ap0 = (CArgs*)__builtin_amdgcn_kernarg_segment_ptr();
    if (threadIdx.x < 4) ((LAS unsigned*)(lds + LDSCTL_OFF))[threadIdx.x] = 0u;
    __syncthreads();
    XcdBarrier bar = xcd_barrier_post((unsigned*)(a_.ws + WS_CTL) + CW_BAR, (volatile LAS unsigned*)(lds + LDSCTL_OFF));
    const int lo = a_.ph_lo, hi = a_.ph_hi;
    int ph = 0;
#ifndef MK_ONLY
#define MK_ONLY -1
#endif
#ifndef MK_DBL
#define MK_DBL 0
#endif
#ifdef MK_MARK
#define PH_MARK(s) asm volatile("; ##" s)
#else
#define PH_MARK(s)
#endif
#define PH_BEGIN(id) if ((MK_ONLY < 0 || MK_ONLY == (id)) && ph >= lo && ph < hi) { for (int rep_ = 0; rep_ <= ((MK_DBL >> (id)) & 1); ++rep_) { PH_MARK("PH_BEGIN"); CArgs* ap = ap0; asm volatile("" : "+s"(ap)); const Args a = *(const Args*)ap; unsigned char* const ws = a.ws; (void)ws; const int wave = (int)bar.wv; int tid = wave * 64 + lane_id(); asm volatile("" : "+v"(tid)); const int lane = tid & 63, gw = blockIdx.x * 8 + wave; (void)lane; (void)gw;
#define PH_END PH_MARK("PH_END"); } } if (ph >= lo && ph + 1 < hi) xcd_barrier(bar); ++ph;

    PH_BEGIN(0) p0_prologue(a, lds, tid, lane, wave, G); PH_END

#pragma unroll 1
    for (int layer = 0; layer < DEPTH; ++layer) {
        const int kind = layer & 1, lj = layer >> 1;
        const int rows = layer == 3 ? TL : T, nmt = rows / 256;
        const int rows_moe = layer < 2 ? T : TL;
        if (kind == 0) {
            PH_BEGIN(1) phase_a_rwkv(a, layer, lds, tid, gw, NGW, lane); PH_END
            PH_BEGIN(2) {
                pg8::Gemm g{(const bf16*)(ws + WS_XL), (const bf16*)(ws + WS_WRKV) + (size_t)lj * 3840 * 1024, 6 * T, 3840, 1024};
                SchedB1 S{G, (int)blockIdx.x}; EpiB1 E{(bf16*)(ws + WS_RKV), (bf16*)(ws + WS_L1)};
                pg8::gemm_phase<EpiB1, SchedB1, true, true, false>(lds, g, S, E, tid); } PH_END
            PH_BEGIN(3) phase_b2_direct(a, lj, gw, NGW, lane); PH_END
            PH_BEGIN(5) phase_s1_chunks(a, lj, lds, tid, G, (MK_DBL >> 5) & 1 & (rep_ == 0)); PH_END
            PH_BEGIN(15) phase_s2_chain(a, wave, lane, G); PH_END
            PH_BEGIN(6) phase_s3_readout(a, lj, layer == 2 ? TL : T, gw, NGW, lane); PH_END
        } else {
            PH_BEGIN(7) phase_a_conv(a, layer, rows, gw, NGW, lane); PH_END
            PH_BEGIN(8) {
                pg8::Gemm g{(const bf16*)(ws + WS_XL), (const bf16*)(ws + WS_WIN) + (size_t)lj * 3072 * 1024, rows, 3072, 1024};
                SchedStd S{G, (int)blockIdx.x, nmt, 12}; EpiWin E{(bf16*)(ws + WS_BG), (bf16*)(ws + WS_CUZ)};
                pg8::gemm_phase<EpiWin, SchedStd, true, true, false>(lds, g, S, E, tid); } PH_END
            PH_BEGIN(9) phase_cv(a, lj, rows, gw, NGW, lane); PH_END
        }
        PH_BEGIN(10) {
            const bf16* Wt = kind == 0 ? (const bf16*)(ws + WS_WO) + (size_t)lj * 1024 * 1024 : (const bf16*)(ws + WS_WOUT) + (size_t)lj * 1024 * 1024;
            pg8::Gemm g{(const bf16*)(ws + WS_Z), Wt, rows, 1024, 1024};
            SchedStd S{G, (int)blockIdx.x, layer == 2 ? NMT_L : nmt, 4}; EpiRes E{(float*)(ws + (layer < 2 ? WS_XSA : WS_XSB)), (const float*)(ws + WS_MODS) + (size_t)layer * 5 * 6144 + 2 * 1024, (float*)(ws + (rep_ ? WS_XL : (layer < 2 ? WS_XSA : WS_XSB)))};
            pg8::gemm_phase<EpiRes, SchedStd, true, true, false>(lds, g, S, E, tid); } PH_END
        PH_BEGIN(11) phase_e_route_mfma(a, layer, rows_moe, lds, tid, wave, gw, NGW, lane, rep_); PH_END
        PH_BEGIN(12) {
            const int nt = __builtin_amdgcn_readfirstlane(moe_tables((const unsigned*)(ws + WS_CTL) + CW_CNT + layer * 32 * CNT_STRIDE, lds, tid));
            pg8::Gemm g{(const bf16*)(ws + WS_H2), (const bf16*)(ws + WS_WGU) + (size_t)layer * 32 * 2048 * 1024, 0, 0, 1024};
            SchedMoe S{G, (int)blockIdx.x, 8, nt, 2, lds, (const int*)(ws + WS_SLOTL), nullptr, wave};
            EpiGU E{(bf16*)(ws + WS_INTER), a.in[30] + (size_t)layer * 32 * 2048};
            pg8::gemm_phase<EpiGU, SchedMoe, true, true, true>(lds, g, S, E, tid); } PH_END
        PH_BEGIN(13) {
            const int nt = __builtin_amdgcn_readfirstlane(moe_tables((const unsigned*)(ws + WS_CTL) + CW_CNT + layer * 32 * CNT_STRIDE, lds, tid));
            pg8::Gemm g{(const bf16*)(ws + WS_INTER), (const bf16*)(ws + WS_WDN) + (size_t)layer * 32 * 1024 * 1024, 0, 0, 1024};
            SchedMoe S{G, (int)blockIdx.x, 4, nt, 8, lds, (const int*)(ws + WS_SLOTL), (const float*)(ws + WS_GATEL), wave};
            EpiDown E{(bf16*)(ws + WS_YS), a.in[32] + (size_t)layer * 32 * 1024, lds};
            pg8::gemm_phase<EpiDown, SchedMoe, true, true, false>(lds, g, S, E, tid); } PH_END
    }
    PH_BEGIN(14) phase_final(a, gw, NGW, lane); PH_END
#undef PH_BEGIN
#undef PH_END
}

extern "C" void kernel_launch(void* const* d_in, const int* in_sizes, int n_in, void* d_out, int out_size, void* d_ws, size_t ws_size, hipStream_t stream) {
    static int grid = 0;
    if (grid == 0) {
        if (n_in != 33 || in_sizes[0] != TL * D || out_size != TL * D || ws_size < WS_END) { fprintf(stderr, "kernel_launch: unexpected problem (n_in %d, in0 %d, out %d, ws %zu < %zu)\n", n_in, n_in > 0 ? in_sizes[0] : -1, out_size, ws_size, (size_t)WS_END); grid = -1; return; }
        int dev = 0, cus = 0, per_cu = 0;
        if (hipGetDevice(&dev) != hipSuccess || hipDeviceGetAttribute(&cus, hipDeviceAttributeMultiprocessorCount, dev) != hipSuccess) { grid = -1; return; }
        if (hipFuncSetAttribute((const void*)fwd_kernel, hipFuncAttributeMaxDynamicSharedMemorySize, LDS_BYTES) != hipSuccess) { fprintf(stderr, "kernel_launch: hipFuncSetAttribute failed\n"); grid = -1; return; }
        if (hipOccupancyMaxActiveBlocksPerMultiprocessor(&per_cu, (const void*)fwd_kernel, 512, LDS_BYTES) != hipSuccess || per_cu < 1) fprintf(stderr, "kernel_launch: occupancy query says %d\n", per_cu);
        (void)hipGetLastError();
        grid = cus;
    }
    if (grid < 0) return;
    if (hipMemsetAsync((char*)d_ws + WS_CTL, 0, CTL_ZERO_BYTES, stream) != hipSuccess) return;
    Args a{};
    for (int i = 0; i < 33; ++i) a.in[i] = (const float*)d_in[i];
    a.out = (float*)d_out; a.ws = (unsigned char*)d_ws;
#if MK_PER_PHASE
    for (int p = 0; p < NPHASES; ++p) { a.ph_lo = p; a.ph_hi = p + 1; hipLaunchKernelGGL(fwd_kernel, dim3(grid), dim3(512), LDS_BYTES, stream, a); }
#else
    a.ph_lo = 0; a.ph_hi = NPHASES;
    hipLaunchKernelGGL(fwd_kernel, dim3(grid), dim3(512), LDS_BYTES, stream, a);
#endif
    const hipError_t le = hipPeekAtLastError();
    if (le != hipSuccess) fprintf(stderr, "kernel_launch: launch failed: %s\n", hipGetErrorName(le));
}
```

```cpp
#include <hip/hip_runtime.h>
#include <cstdio>
#include <cstdint>

#ifndef MK_PER_PHASE
#define MK_PER_PHASE 0
#endif

constexpr int D = 1024, NBATCH = 4, SEQ = 8192, TL = NBATCH * SEQ, CTXL = 256, TC = NBATCH * CTXL, T = TL + TC;
constexpr int NH = 16, HS = 64, NE = 32, TOPK = 4, DEPTH = 4;
constexpr int NMT = T / 256;
constexpr int NMT_L = TL / 256;
constexpr int MAXTILES = (T * TOPK) / 256 + NE;
constexpr int NSTEP = CTXL + SEQ;

__device__ __forceinline__ int lane_id() { return (int)__builtin_amdgcn_mbcnt_hi(~0u, __builtin_amdgcn_mbcnt_lo(~0u, 0u)); }
namespace pg8 {
#define PG8_LAS __attribute__((address_space(3)))
typedef unsigned short bf16_t;
typedef short bf16x8 __attribute__((ext_vector_type(8)));
typedef float f32x4 __attribute__((ext_vector_type(4)));
typedef unsigned u32x4 __attribute__((ext_vector_type(4)));
typedef unsigned u32x2 __attribute__((ext_vector_type(2)));
constexpr int BM = 256, BK = 64, HALF = 128, HTB = HALF * BK * 2  , STAGE_BYTES = 8 * HTB, NXCD = 8, WGM = 8;

__host__ __device__ __forceinline__ int lds_byte(int r, int c) { const int st = (r >> 4) * 2 + (c >> 5), rr = r & 15, cc = c & 31, ob = rr * 64 + cc * 2; return st * 1024 + (ob ^ (((ob >> 9) & 1) << 5)); }
__host__ __device__ __forceinline__ void stage_rc(int b, int& R, int& C) { const int st = b / 1024, sb = b % 1024, swz = sb ^ (((sb >> 9) & 1) << 5); R = (st >> 1) * 16 + swz / 64; C = (st & 1) * 32 + (swz % 64) / 2; }
__host__ __device__ __forceinline__ int perm32(int rho) { const int n = rho >> 4, i = rho & 15; return 8 * (i >> 2) + 4 * n + (i & 3); }

struct Unit { int pm, pn, e, nv, par; };
struct Gemm { const bf16_t* A; const bf16_t* Bt; int M, N, K; };

__device__ __forceinline__ void tile_map(int wgid, int nM, int nN, int& pm, int& pn) {
    const int nwg = nM * nN;
    { const int q = nwg / NXCD, r = nwg % NXCD, xcd = wgid % NXCD, off = wgid / NXCD; wgid = (xcd < r ? xcd * (q + 1) : r * (q + 1) + (xcd - r) * q) + off; }
    const int nig = WGM * nN, gid = wgid / nig, fm = gid * WGM, gsz = (nM - fm) < WGM ? (nM - fm) : WGM;
    pm = fm + ((wgid % nig) % gsz); pn = (wgid % nig) / gsz;
}
typedef __bf16 bf16x2_t __attribute__((ext_vector_type(2)));
typedef float f32x2_t __attribute__((ext_vector_type(2)));
__device__ __forceinline__ unsigned cvt_pk_bf16(float lo, float hi) { const f32x2_t v = {lo, hi}; const bf16x2_t b = __builtin_convertvector(v, bf16x2_t); return __builtin_bit_cast(unsigned, b); }

template <class Epi, class Sched, bool ALIGN_EPI = false, bool SP2 = false, bool GATHER = false>
__device__ __forceinline__ void gemm_phase(PG8_LAS unsigned char* lds, const Gemm g, const Sched& S, const Epi& E, int tid_in) {
    int tid_ = tid_in; asm volatile("" : "+v"(tid_));
    const int tid = tid_, wid = __builtin_amdgcn_readfirstlane(tid >> 6), lane = tid & 63, wr = wid >> 2, wc = wid & 3, fr = lane & 15, fq = lane >> 4;
    int K_ = g.K; asm volatile("" : "+s"(K_));
    const int K = K_, nt = K / BK;
    unsigned voffA[2], voffB[2]; int gR[2]; unsigned gC[2];
#pragma unroll
    for (int i = 0; i < 2; ++i) { int R, C; stage_rc(tid * 16 + i * 8192, R, C); const int Rb = Epi::PERM ? ((R & ~31) + perm32(R & 31)) : R;
        voffA[i] = (unsigned)(R * K + C) * 2u; voffB[i] = (unsigned)(Rb * K + C) * 2u; gR[i] = R; gC[i] = (unsigned)C * 2u; }
    unsigned oc[2][2], on[2][2], o2[2][2];
#pragma unroll
    for (int h = 0; h < 2; ++h)
#pragma unroll
        for (int i = 0; i < 2; ++i) { oc[h][i] = 0u; on[h][i] = 0u; o2[h][i] = 0u; }
    const size_t kstep = (size_t)(BK * 2);
    const size_t hstep = (size_t)HALF * K * 2;
    const size_t tstep = 2 * hstep;
    const unsigned ldsw = (unsigned)wid * 1024u;
    const int aoff = lds_byte(wr * 64 + fr, fq * 8), boff = lds_byte(wc * 32 + fr, fq * 8);
#define PG8_SA(b, h) (((b) * 2 + (h)) * HTB)
#define PG8_SB(b, h) ((4 + (b) * 2 + (h)) * HTB)
#define PG8_STAGE(bufoff, gbase, voff) do { _Pragma("unroll") for (int _i = 0; _i < 2; ++_i) \
        __builtin_amdgcn_global_load_lds((const unsigned*)((const char*)(gbase) + (voff)[_i]), (PG8_LAS unsigned*)(lds + (bufoff) + ldsw + _i * 8192), 16, 0, 0); } while (0)
#define PG8_STAGE_A(bufoff, base, h, O) do { if constexpr (GATHER) { PG8_STAGE(bufoff, base, (O)[h]); } else { PG8_STAGE(bufoff, (base) + (h) * hstep, voffA); } } while (0)
#define PG8_LDA(dst, b, h) do { _Pragma("unroll") for (int m = 0; m < 4; ++m) _Pragma("unroll") for (int k = 0; k < 2; ++k) dst[m][k] = *(const PG8_LAS bf16x8*)(lds + PG8_SA(b, h) + aoff + m * 2048 + k * 1024); } while (0)
#define PG8_LDB(dst, b, h) do { _Pragma("unroll") for (int n = 0; n < 2; ++n) _Pragma("unroll") for (int k = 0; k < 2; ++k) dst[n][k] = *(const PG8_LAS bf16x8*)(lds + PG8_SB(b, h) + boff + n * 2048 + k * 1024); } while (0)
#define PG8_MMA(ai, bj, At, Bt) do { __builtin_amdgcn_s_setprio(1); _Pragma("unroll") for (int m = 0; m < 4; ++m) _Pragma("unroll") for (int n = 0; n < 2; ++n) _Pragma("unroll") for (int k = 0; k < 2; ++k) \
        acc[ai][bj][m][n] = __builtin_amdgcn_mfma_f32_16x16x32_bf16(Bt[n][k], At[m][k], acc[ai][bj][m][n], 0, 0, 0); __builtin_amdgcn_s_setprio(0); } while (0)
#define PG8_WAIT_V(n) asm volatile("s_waitcnt vmcnt(" #n ")" ::: "memory")
#define PG8_WAIT_L(n) asm volatile("s_waitcnt lgkmcnt(" #n ")" ::: "memory")
#define PG8_BAR __builtin_amdgcn_s_barrier()
#define PG8_SCHED __builtin_amdgcn_sched_barrier(0)
    Unit cur, nxt; int ui = 0;
    if (!S.next(0, cur)) return;
    f32x4 acc[2][2][4][2];
#pragma unroll
    for (int a = 0; a < 2; ++a)
#pragma unroll
        for (int b = 0; b < 2; ++b)
#pragma unroll
            for (int m = 0; m < 4; ++m)
#pragma unroll
                for (int n = 0; n < 2; ++n) acc[a][b][m][n] = (f32x4){0.f, 0.f, 0.f, 0.f};
    bf16x8 At[4][2], B0[2][2], B1[2][2];
    const char* cA = GATHER ? (const char*)g.A : (const char*)g.A + (size_t)cur.pm * tstep; const char* cB = (const char*)g.Bt + (size_t)cur.pn * tstep;
    S.a_ready(cur);
    if constexpr (GATHER) {
#pragma unroll
        for (int h = 0; h < 2; ++h)
#pragma unroll
            for (int i = 0; i < 2; ++i) oc[h][i] = S.row_off(cur, h * HALF + gR[i]) + gC[i];
    }
    if constexpr (SP2) {
        PG8_STAGE(PG8_SB(0, 0), cB, voffB); PG8_STAGE(PG8_SB(0, 1), cB + hstep, voffB); PG8_STAGE_A(PG8_SA(0, 0), cA, 0, oc); PG8_STAGE_A(PG8_SA(0, 1), cA, 1, oc);
        if (wr == 1) PG8_BAR;
        PG8_WAIT_V(2); PG8_BAR;
        PG8_STAGE(PG8_SB(1, 0), cB + kstep, voffB); PG8_STAGE_A(PG8_SA(1, 0), cA + kstep, 0, oc); PG8_STAGE(PG8_SB(1, 1), cB + hstep + kstep, voffB);
        PG8_WAIT_V(6); PG8_BAR;
    } else {
        PG8_STAGE(PG8_SB(0, 0), cB, voffB); PG8_STAGE_A(PG8_SA(0, 0), cA, 0, oc); PG8_STAGE(PG8_SB(0, 1), cB + hstep, voffB); PG8_STAGE_A(PG8_SA(0, 1), cA, 1, oc);
        if (wr == 1) PG8_BAR;
        PG8_WAIT_V(4); PG8_BAR;
        PG8_STAGE(PG8_SB(1, 0), cB + kstep, voffB); PG8_STAGE_A(PG8_SA(1, 0), cA + kstep, 0, oc); PG8_STAGE(PG8_SB(1, 1), cB + hstep + kstep, voffB);
        PG8_WAIT_V(6); PG8_BAR;
    }
    for (;;) {
        const bool has_next = S.next(ui + 1, nxt);
        const char* nA = GATHER ? (const char*)g.A : (has_next ? (const char*)g.A + (size_t)nxt.pm * tstep : cA); const char* nB = has_next ? (const char*)g.Bt + (size_t)nxt.pn * tstep : cB;
        if constexpr (GATHER) { if (has_next) S.prefetch_rows(nxt); }
        for (int t = 0; t < nt; t += 2) {
            const bool last = (t == nt - 2);
            const char* a1 = cA + (size_t)(t + 1) * kstep;
            const char* a2 = last ? nA : cA + (size_t)(t + 2) * kstep; const char* b2 = last ? nB : cB + (size_t)(t + 2) * kstep;
            const char* a3 = a2 + kstep; const char* b3 = b2 + kstep;
            if constexpr (GATHER) {
                if (last) {
#pragma unroll
                    for (int h = 0; h < 2; ++h)
#pragma unroll
                        for (int i = 0; i < 2; ++i) on[h][i] = has_next ? (S.row_off_lds(nxt, h * HALF + gR[i]) + gC[i]) : oc[h][i];
                }
#pragma unroll
                for (int h = 0; h < 2; ++h)
#pragma unroll
                    for (int i = 0; i < 2; ++i) o2[h][i] = last ? on[h][i] : oc[h][i];
            }
            if (last && has_next) S.a_ready(nxt);
            if constexpr (SP2) {
            PG8_LDB(B0, 0, 0); PG8_LDB(B1, 0, 1); PG8_SCHED; PG8_LDA(At, 0, 0); PG8_STAGE_A(PG8_SA(1, 1), a1, 1, oc);
            PG8_WAIT_V(8); PG8_WAIT_L(0); PG8_BAR; PG8_MMA(0, 0, At, B0); PG8_MMA(0, 1, At, B1); PG8_BAR; PG8_SCHED;
            PG8_LDA(At, 0, 1); PG8_STAGE(PG8_SB(0, 0), b2, voffB); PG8_STAGE(PG8_SB(0, 1), b2 + hstep, voffB); PG8_STAGE_A(PG8_SA(0, 0), a2, 0, o2);
            PG8_WAIT_V(8); PG8_WAIT_L(0); PG8_BAR; PG8_MMA(1, 0, At, B0); PG8_MMA(1, 1, At, B1); PG8_BAR; PG8_SCHED;
            PG8_LDB(B0, 1, 0); PG8_LDB(B1, 1, 1); PG8_SCHED; PG8_LDA(At, 1, 0); PG8_STAGE_A(PG8_SA(0, 1), a2, 1, o2);
            PG8_WAIT_V(8); PG8_WAIT_L(0); PG8_BAR; PG8_MMA(0, 0, At, B0); PG8_MMA(0, 1, At, B1); PG8_BAR; PG8_SCHED;
            PG8_LDA(At, 1, 1); PG8_STAGE(PG8_SB(1, 0), b3, voffB); PG8_STAGE(PG8_SB(1, 1), b3 + hstep, voffB); PG8_STAGE_A(PG8_SA(1, 0), a3, 0, o2);
            PG8_WAIT_V(8); PG8_WAIT_L(0); PG8_BAR; PG8_MMA(1, 0, At, B0); PG8_MMA(1, 1, At, B1); PG8_BAR; PG8_SCHED;
            } else {
            PG8_LDB(B0, 0, 0); PG8_SCHED; PG8_LDA(At, 0, 0); PG8_STAGE_A(PG8_SA(1, 1), a1, 1, oc);
            PG8_WAIT_L(8); PG8_BAR; PG8_WAIT_L(0); PG8_MMA(0, 0, At, B0); PG8_BAR; PG8_SCHED;
            PG8_LDB(B1, 0, 1); PG8_STAGE(PG8_SB(0, 0), b2, voffB);
            PG8_BAR; PG8_WAIT_L(0); PG8_MMA(0, 1, At, B1); PG8_BAR;
            PG8_LDA(At, 0, 1); PG8_STAGE_A(PG8_SA(0, 0), a2, 0, o2);
            PG8_BAR; PG8_WAIT_L(0); PG8_MMA(1, 0, At, B0); PG8_BAR; PG8_SCHED;
            PG8_STAGE(PG8_SB(0, 1), b2 + hstep, voffB);
            PG8_WAIT_V(6); PG8_BAR; PG8_MMA(1, 1, At, B1); PG8_BAR;
            PG8_LDB(B0, 1, 0); PG8_SCHED; PG8_LDA(At, 1, 0); PG8_STAGE_A(PG8_SA(0, 1), a2, 1, o2);
            PG8_WAIT_L(8); PG8_BAR; PG8_WAIT_L(0); PG8_MMA(0, 0, At, B0); PG8_BAR; PG8_SCHED;
            PG8_LDB(B1, 1, 1); PG8_STAGE(PG8_SB(1, 0), b3, voffB);
            PG8_BAR; PG8_WAIT_L(0); PG8_MMA(0, 1, At, B1); PG8_BAR;
            PG8_LDA(At, 1, 1); PG8_STAGE_A(PG8_SA(1, 0), a3, 0, o2);
            PG8_BAR; PG8_WAIT_L(0); PG8_MMA(1, 0, At, B0); PG8_BAR; PG8_SCHED;
            PG8_STAGE(PG8_SB(1, 1), b3 + hstep, voffB);
            PG8_WAIT_V(6); PG8_BAR; PG8_MMA(1, 1, At, B1); PG8_BAR;
            }
        }
        if constexpr (ALIGN_EPI) { if (wr == 0) PG8_BAR; }
        if constexpr (!Epi::AFTER_DRAIN) { E(acc, cur, wr, wc, fr, fq); S.done(cur); }
        if (!has_next) break;
#pragma unroll
        for (int a = 0; a < 2; ++a)
#pragma unroll
            for (int b = 0; b < 2; ++b)
#pragma unroll
                for (int m = 0; m < 4; ++m)
#pragma unroll
                    for (int n = 0; n < 2; ++n) acc[a][b][m][n] = (f32x4){0.f, 0.f, 0.f, 0.f};
        cur = nxt; cA = nA; cB = nB; ++ui;
        if constexpr (GATHER) {
#pragma unroll
            for (int h = 0; h < 2; ++h)
#pragma unroll
                for (int i = 0; i < 2; ++i) oc[h][i] = on[h][i];
        }
        if constexpr (ALIGN_EPI) { if (wr == 1) PG8_BAR; }
    }
    PG8_WAIT_V(0);
    if constexpr (!ALIGN_EPI) { if (wr == 0) PG8_BAR; }
    PG8_BAR;
    if constexpr (Epi::AFTER_DRAIN) { E.fused(acc, cur, wr, wc, fr, fq, lds, wid, lane); S.done(cur); }
#undef PG8_SA
#undef PG8_SB
#undef PG8_STAGE
#undef PG8_STAGE_A
#undef PG8_LDA
#undef PG8_LDB
#undef PG8_MMA
#undef PG8_WAIT_V
#undef PG8_WAIT_L
#undef PG8_BAR
#undef PG8_SCHED
}
}

#define LAS __attribute__((address_space(3)))
typedef unsigned short bf16;
typedef float f32x4 __attribute__((ext_vector_type(4)));
typedef unsigned u32x2 __attribute__((ext_vector_type(2)));
typedef unsigned u32x4 __attribute__((ext_vector_type(4)));
#define LDS_WAIT() asm volatile("s_waitcnt lgkmcnt(0)" ::: "memory")
__device__ __forceinline__ unsigned pk2(float lo, float hi) { return pg8::cvt_pk_bf16(lo, hi); }
__device__ __forceinline__ unsigned f2bf(float f) { return pk2(f, f) & 0xffffu; }
__device__ __forceinline__ float bflo(unsigned w) { return __builtin_bit_cast(float, w << 16); }
__device__ __forceinline__ float bfhi(unsigned w) { return __builtin_bit_cast(float, w & 0xffff0000u); }
__device__ __forceinline__ float wave_sum(float v) {
#pragma unroll
    for (int o = 1; o < 64; o <<= 1) v += __shfl_xor(v, o);
    return v;
}
__device__ __forceinline__ float frcp(float x) { return __builtin_amdgcn_rcpf(x); }
__device__ __forceinline__ float sigm(float x) { return frcp(1.0f + __expf(-x)); }
__device__ __forceinline__ float tanh_fast(float x) { const float e = __expf(2.0f * x); return 1.0f - 2.0f * frcp(e + 1.0f); }

constexpr size_t MiB = 1u << 20;
constexpr size_t RF = (size_t)T * D * 4;
constexpr size_t RB = (size_t)T * D * 2;
constexpr size_t WS_CTL = 0, CTL_ZERO_BYTES = 1 * MiB;
constexpr size_t WS_MODS = 1 * MiB;
constexpr size_t WS_XSA = 2 * MiB, WS_XSB = WS_XSA + RF;
constexpr size_t WS_XL = WS_XSB + RF;
constexpr size_t WS_RKV = WS_XL + 6 * RB;
constexpr size_t WS_L1 = WS_RKV + 3 * RF;
constexpr size_t WS_WDEC = WS_L1 + 50 * MiB;
constexpr size_t WS_AA = WS_WDEC + 2 * RF;
constexpr size_t WS_G = WS_AA + 2 * RF;
constexpr size_t WS_KK = WS_G + RB;
constexpr size_t WS_KD = WS_KK + RF;
constexpr size_t WS_BETA = WS_KD + 2 * RF;
constexpr size_t WS_RKB = WS_BETA + 2 * RF;
constexpr size_t WS_C12 = WS_RKB + 3 * MiB;
constexpr size_t WS_WRT = WS_C12 + 6 * MiB;
constexpr size_t WS_Y = WS_C12 + 9 * MiB;
constexpr size_t WS_Z = WS_Y + 2 * RF;
constexpr size_t WS_H2 = WS_Z + RB;
constexpr size_t WS_SLOTL = WS_H2 + RB;
constexpr size_t WS_GATEL = WS_SLOTL + 5 * MiB;
constexpr size_t WS_WRKV = WS_GATEL + 5 * MiB;
constexpr size_t WS_L2T = WS_WRKV + 15 * MiB;
constexpr size_t WS_WO = WS_L2T + 5 * MiB;
constexpr size_t WS_WIN = WS_WO + 4 * MiB;
constexpr size_t WS_WOUT = WS_WIN + 12 * MiB;
constexpr size_t WS_WGU = WS_WOUT + 4 * MiB;
constexpr size_t WS_WDN = WS_WGU + 512 * MiB;
constexpr size_t WS_END = WS_WDN + 256 * MiB;
constexpr size_t WS_INTER = WS_WDEC;
constexpr size_t WS_YS = WS_KD;
constexpr size_t WS_BG = WS_RKV, WS_CUZ = WS_RKV + RB;
constexpr size_t WS_RAWW = WS_AA, WS_RAWA = WS_AA + RF;
constexpr size_t WS_RH = WS_AA;
constexpr size_t WS_PM = WS_WDEC;
constexpr size_t WS_RKB1 = WS_C12 + 1 * MiB;
constexpr size_t WS_QT = WS_XL;
constexpr size_t WS_HT = WS_XL + RF;
static_assert((size_t)128 * 132 * 4096 * 2 <= RF, "chunk state tensors");
static_assert((size_t)MAXTILES * 256 * 1024 * 2 <= 4 * RF, "INTER overlay");
static_assert((size_t)T * 4 * 1024 * 2 <= 2 * RF, "YS overlay");
static_assert((size_t)3 * T * 256 * 2 <= 50 * MiB, "L1OUT");
constexpr int CW_BAR = 4096;
constexpr int CW_CNT = 16384, CNT_STRIDE = 64;

constexpr int RING_BYTES = 131072;
constexpr int LDSCTL_OFF = RING_BYTES + 4096;
constexpr int LDS_BYTES = LDSCTL_OFF + 16384;

struct Args { const float* in[33]; float* out; unsigned char* ws; int ph_lo, ph_hi; };

__device__ __forceinline__ void transpose_item(const float* W, int N, bf16* WT, int dstK, int drow0, int k0, int n0, LAS float* scr, int lane) {
    float tv[64];
    const float* src = W + (size_t)k0 * N + n0 + lane;
#pragma unroll
    for (int i = 0; i < 64; ++i) tv[i] = src[(size_t)i * N];
#pragma unroll
    for (int i = 0; i < 64; ++i) scr[i * 65 + lane] = tv[i];
    LDS_WAIT(); asm volatile("" ::: "memory");
    const int c = lane & 7;
#pragma unroll
    for (int j = 0; j < 8; ++j) { const int n = (lane >> 3) + 8 * j; const LAS float* s = scr + (8 * c) * 65 + n;
        u32x4 o; o.x = pk2(s[0 * 65], s[1 * 65]); o.y = pk2(s[2 * 65], s[3 * 65]); o.z = pk2(s[4 * 65], s[5 * 65]); o.w = pk2(s[6 * 65], s[7 * 65]);
        *(u32x4*)(WT + (size_t)(drow0 + n) * dstK + k0 + 8 * c) = o; }
    LDS_WAIT(); asm volatile("" ::: "memory");
}
__device__ __forceinline__ int gu_map(int n0) { const int bj = n0 >= 1024 ? 1 : 0, f0 = n0 - bj * 1024; return (f0 >> 7) * 256 + bj * 128 + (f0 & 127); }
__device__ __forceinline__ int conv_map(int n0) { if (n0 < 1024) return n0; const int q = (n0 - 1024) >> 10, f0 = (n0 - 1024) & 1023; return 1024 + (f0 >> 7) * 256 + q * 128 + (f0 & 127); }

__device__ __forceinline__ void p0_prologue(const Args& a, LAS unsigned char* lds, int tid, int lane, int wave, int G) {
    unsigned char* ws = a.ws;
    LAS float* sl = (LAS float*)lds;
    LAS float* red = (LAS float*)(lds + 20480);
    for (int i = tid; i < 5 * 1024; i += 512) { const int r = i >> 10, k = i & 1023; const float cv = r < 4 ? a.in[1][r * 1024 + k] : a.in[3][k]; sl[i] = cv * sigm(cv); }
    __syncthreads();
    float* MODS = (float*)(ws + WS_MODS);
    for (int it = blockIdx.x; it < 4 * 96; it += G) {
        const int l = it / 96, n = (it % 96) * 64 + lane;
        const float* W = a.in[4] + (size_t)l * 1024 * 6144 + n;
        float acc[5] = {0.f, 0.f, 0.f, 0.f, 0.f};
        const int kb = wave * 128;
#pragma unroll 32
        for (int k = 0; k < 128; ++k) { const float wv = W[(size_t)(kb + k) * 6144];
#pragma unroll
            for (int r = 0; r < 5; ++r) acc[r] += sl[r * 1024 + kb + k] * wv; }
#pragma unroll
        for (int r = 0; r < 5; ++r) red[(wave * 5 + r) * 64 + lane] = acc[r];
        __syncthreads();
        if (wave < 5) { float s = a.in[5][l * 6144 + n];
#pragma unroll
            for (int w = 0; w < 8; ++w) s += red[(w * 5 + wave) * 64 + lane];
            MODS[(size_t)(l * 5 + wave) * 6144 + n] = s; }
        __syncthreads();
    }
    LAS float* scr = (LAS float*)(lds + wave * 16640);
    static_assert(8 * 16640 <= LDSCTL_OFF, "P0 scratch");
    const int gw = blockIdx.x * 8 + wave, NGW = G * 8;
    bf16* WRKV = (bf16*)(ws + WS_WRKV); bf16* WOt = (bf16*)(ws + WS_WO); bf16* WINt = (bf16*)(ws + WS_WIN); bf16* WOUTt = (bf16*)(ws + WS_WOUT);
    bf16* WGU = (bf16*)(ws + WS_WGU); bf16* WDN = (bf16*)(ws + WS_WDN);
    constexpr int I_GU = 128 * 512, I_DN = 128 * 256, I_RKV = 6 * 256, I_WO = 2 * 256, I_WIN = 2 * 768, I_WOUT = 2 * 256, I_W1 = 4 * 16, I_A1 = 4 * 16, I_G1 = 2 * 32;
    constexpr int NITEMS = I_GU + I_DN + I_RKV + I_WO + I_WIN + I_WOUT + I_W1 + I_A1 + I_G1;
    for (int it = NGW - 1 - gw; it < NITEMS; it += NGW) {
        int r = it;
        if (r < I_GU) { const int m = r >> 9, q = r & 511, kb = q >> 5, nb = q & 31;
            transpose_item(a.in[29] + (size_t)m * 1024 * 2048, 2048, WGU + (size_t)m * 2048 * 1024, 1024, gu_map(nb * 64), kb * 64, nb * 64, scr, lane); continue; } r -= I_GU;
        if (r < I_DN) { const int m = r >> 8, q = r & 255, kb = q >> 4, nb = q & 15;
            transpose_item(a.in[31] + (size_t)m * 1024 * 1024, 1024, WDN + (size_t)m * 1024 * 1024, 1024, nb * 64, kb * 64, nb * 64, scr, lane); continue; } r -= I_DN;
        if (r < I_RKV) { const int m = r >> 8, q = r & 255, kb = q >> 4, nb = q & 15, lr = m / 3, j = m % 3;
            transpose_item(a.in[9] + (size_t)m * 1024 * 1024, 1024, WRKV + (size_t)lr * 3840 * 1024, 1024, j * 1024 + nb * 64, kb * 64, nb * 64, scr, lane); continue; } r -= I_RKV;
        if (r < I_WO) { const int m = r >> 8, q = r & 255, kb = q >> 4, nb = q & 15;
            transpose_item(a.in[23] + (size_t)m * 1024 * 1024, 1024, WOt + (size_t)m * 1024 * 1024, 1024, nb * 64, kb * 64, nb * 64, scr, lane); continue; } r -= I_WO;
        if (r < I_WIN) { const int m = r / 768, q = r % 768, kb = q / 48, nb = q % 48;
            transpose_item(a.in[24] + (size_t)m * 1024 * 3072, 3072, WINt + (size_t)m * 3072 * 1024, 1024, conv_map(nb * 64), kb * 64, nb * 64, scr, lane); continue; } r -= I_WIN;
        if (r < I_WOUT) { const int m = r >> 8, q = r & 255, kb = q >> 4, nb = q & 15;
            transpose_item(a.in[26] + (size_t)m * 1024 * 1024, 1024, WOUTt + (size_t)m * 1024 * 1024, 1024, nb * 64, kb * 64, nb * 64, scr, lane); continue; } r -= I_WOUT;
        if (r < I_W1) { const int m = r >> 4, kb = r & 15, lr = m >> 1, e = m & 1;
            transpose_item(a.in[11] + (size_t)m * 1024 * 64, 64, WRKV + (size_t)lr * 3840 * 1024, 1024, 3072 + e * 64, kb * 64, 0, scr, lane); continue; } r -= I_W1;
        if (r < I_A1) { const int m = r >> 4, kb = r & 15, lr = m >> 1, e = m & 1;
            transpose_item(a.in[14] + (size_t)m * 1024 * 64, 64, WRKV + (size_t)lr * 3840 * 1024, 1024, 3328 + e * 64, kb * 64, 0, scr, lane); continue; } r -= I_A1;
        { const int m = r >> 5, q = r & 31, kb = q >> 1, nb = q & 1;
            transpose_item(a.in[16] + (size_t)m * 1024 * 128, 128, WRKV + (size_t)m * 3840 * 1024, 1024, 3584 + nb * 64, kb * 64, nb * 64, scr, lane); }
    }
    const int gt = blockIdx.x * 512 + tid, NGT = G * 512;
    for (int i = gt; i < 2 * 3 * 128 * 128; i += NGT) {
        const int pc = i & 127, rw = (i >> 7) & 127, pd = (i >> 14) % 3, lr = i / (3 * 16384);
        *(u32x4*)(WRKV + ((size_t)lr * 3840 + 3072 + pd * 256 + 128 + rw) * 1024 + pc * 8) = (u32x4){0u, 0u, 0u, 0u}; }
    bf16* L2T = (bf16*)(ws + WS_L2T);
    static_assert((2 * 128 * 5120) % (256 * 512) == 0, "L2T deal");
    for (int i0 = gt; i0 < 2 * 128 * 5120; i0 += 5 * NGT) {
        float v5[5]; bool ok5[5];
#pragma unroll
        for (int q = 0; q < 5; ++q) { const int i = i0 + q * NGT; const int n = i % 5120, k = (i / 5120) & 127, lr = i / (5120 * 128);
            const float* p; bool ok = true;
            if (n < 2048) { const int e = n >> 10, d = n & 1023; ok = (k >> 6) == e; p = a.in[12] + (((size_t)lr * 2 + e) * 64 + (k & 63)) * 1024 + d; }
            else if (n < 4096) { const int e = (n - 2048) >> 10, d = n & 1023; ok = (k >> 6) == e; p = a.in[15] + (((size_t)lr * 2 + e) * 64 + (k & 63)) * 1024 + d; }
            else { const int d = n - 4096; p = a.in[17] + ((size_t)lr * 128 + k) * 1024 + d; }
            v5[q] = *p; ok5[q] = ok; }
#pragma unroll
        for (int q = 0; q < 5; ++q) { const int i = i0 + q * NGT; const int n = i % 5120, k = (i / 5120) & 127, lr = i / (5120 * 128);
            L2T[((size_t)lr * 5120 + n) * 128 + k] = (bf16)f2bf(ok5[q] ? v5[q] : 0.f); }
    }
    bf16* WRT = (bf16*)(ws + WS_WRT);
    for (int i = gt; i < 4 * 32 * 1024; i += NGT) { const int k = i & 1023, e = (i >> 10) & 31, l = i >> 15;
        const float w = a.in[27][((size_t)l * 1024 + k) * 32 + e]; const unsigned hi = f2bf(w); const float lo = w - bflo(hi);
        WRT[((size_t)(l * 2 + 0) * 32 + e) * 1024 + k] = (bf16)hi; WRT[((size_t)(l * 2 + 1) * 32 + e) * 1024 + k] = (bf16)f2bf(lo); }
}
#define XB_TMO      128
#define XB_XCNT(j)  (256  + 64 * (j))
#define XB_XSUB(j)  (1280 + 64 * (j))
#define XB_XGEN(j)  (2304 + 64 * (j))
#define XB_TOP      3328
#define XB_TOPGEN   3392
#define XCD_BAR_WORDS 3456
#define XB_SPIN_CAP (1u << 23)

__device__ __forceinline__ unsigned xb_ld(unsigned* p)              { return __hip_atomic_load(p, __ATOMIC_RELAXED, __HIP_MEMORY_SCOPE_AGENT); }
__device__ __forceinline__ unsigned xb_add(unsigned* p, unsigned v) { return __hip_atomic_fetch_add(p, v, __ATOMIC_RELAXED, __HIP_MEMORY_SCOPE_AGENT); }
__device__ __forceinline__ unsigned xb_xcc_id() { return (unsigned)__builtin_amdgcn_s_getreg((3 << 11) | 20) & 0xFu; }
#define XB_SPIN(cond, bar) do { unsigned _sp = 0; while (cond) { __builtin_amdgcn_s_sleep(1); \
    if ((++_sp & 255u) == 0u) { if (xb_ld(&(bar)[XB_TMO])) break; if (_sp > XB_SPIN_CAP) { atomicAdd(&(bar)[XB_TMO], 1u); break; } } } } while (0)

struct XcdBarrier {
    unsigned wv;
    unsigned* bar; unsigned x;
    volatile LAS unsigned* st;
};

__device__ __forceinline__ XcdBarrier xcd_barrier_post(unsigned* bar, volatile LAS unsigned* st) {
    XcdBarrier b; b.wv = (unsigned)__builtin_amdgcn_readfirstlane((int)(threadIdx.x >> 6)); b.bar = bar; b.x = xb_xcc_id(); b.st = st;
    if (threadIdx.x == 0) (void)xb_add(&bar[XB_XCNT(b.x)], 1u);
    return b;
}
__device__ __forceinline__ void xcd_barrier_complete(unsigned* bar, unsigned x, unsigned& nloc, unsigned& nx) {
    const unsigned G = gridDim.x * gridDim.y * gridDim.z;
    unsigned sum, cnt, mine, sp = 0u;
    for (;;) {
        sum = 0u; cnt = 0u; mine = 0u;
#pragma unroll
        for (unsigned j = 0; j < 16; ++j) { const unsigned c = xb_ld(&bar[XB_XCNT(j)]); sum += c; cnt += (c > 0u) ? 1u : 0u; mine = (j == x) ? c : mine; }
        if (sum == G) break;
        __builtin_amdgcn_s_sleep(1);
        if ((++sp & 255u) == 0u) { if (xb_ld(&bar[XB_TMO])) break; if (sp > XB_SPIN_CAP) { atomicAdd(&bar[XB_TMO], 1u); break; } }
    }
    nloc = mine > 0u ? mine : 1u; nx = cnt > 0u ? cnt : 1u;
}

__device__ __forceinline__ void xcd_barrier(const XcdBarrier& b) {
    asm volatile("s_waitcnt vmcnt(0)" ::: "memory");
    __syncthreads();
    if (b.wv == 0u && lane_id() == 0) {
        unsigned* bar = b.bar;
        __builtin_amdgcn_s_waitcnt(0);
        unsigned nloc = b.st[0], nx = b.st[1];
        if (nloc == 0u) { xcd_barrier_complete(bar, b.x, nloc, nx); b.st[0] = nloc; b.st[1] = nx; }
        const unsigned old = xb_add(&bar[XB_XSUB(b.x)], 1u);
        const unsigned gen = old / nloc;
        if (old + 1u == (gen + 1u) * nloc) {
            __builtin_amdgcn_fence(__ATOMIC_RELEASE, "agent");
            asm volatile("s_waitcnt vmcnt(0)" ::: "memory");
            const unsigned og = xb_add(&bar[XB_TOP], 1u);
            const unsigned tg = og / nx;
            if (og + 1u == (tg + 1u) * nx) xb_add(&bar[XB_TOPGEN], 1u);
            else XB_SPIN(xb_ld(&bar[XB_TOPGEN]) == tg, bar);
            __builtin_amdgcn_fence(__ATOMIC_ACQUIRE, "agent");
            xb_add(&bar[XB_XGEN(b.x)], 1u);
            asm volatile("s_waitcnt vmcnt(0)" ::: "memory");
        } else {
            XB_SPIN(xb_ld(&bar[XB_XGEN(b.x)]) == gen, bar);
            __builtin_amdgcn_fence(__ATOMIC_ACQUIRE, "agent");
            asm volatile("s_waitcnt vmcnt(0)" ::: "memory");
        }
    }
    __syncthreads();
}

__device__ __forceinline__ f32x4 bf4(u32x2 w) { return (f32x4){bflo(w.x), bfhi(w.x), bflo(w.y), bfhi(w.y)}; }
__device__ __forceinline__ int mod_row(int row) { return row < TL ? (row >> 13) : 4; }

__device__ __forceinline__ void load_x_combined(f32x4 (&x)[4], const float* xrow, bool has_prev, const bf16* YS, int t, const f32x4 (&m5)[4], int lane) {
#pragma unroll
    for (int j = 0; j < 4; ++j) x[j] = *(const f32x4*)(xrow + 256 * j + 4 * lane);
    if (has_prev) {
        u32x2 y[4][4];
#pragma unroll
        for (int k = 0; k < 4; ++k)
#pragma unroll
            for (int j = 0; j < 4; ++j) y[k][j] = *(const u32x2*)(YS + ((size_t)t * 4 + k) * 1024 + 256 * j + 4 * lane);
#pragma unroll
        for (int j = 0; j < 4; ++j) { const f32x4 s = (bf4(y[0][j]) + bf4(y[1][j])) + (bf4(y[2][j]) + bf4(y[3][j])); x[j] += m5[j] * s; }
    }
}
__device__ __forceinline__ float row_rstd(const f32x4 (&x)[4]) {
    float ss = 0.f;
#pragma unroll
    for (int j = 0; j < 4; ++j) ss += (x[j].x * x[j].x + x[j].y * x[j].y) + (x[j].z * x[j].z + x[j].w * x[j].w);
    return rsqrtf(wave_sum(ss) * (1.0f / 1024.0f) + 1e-6f);
}

__device__ __forceinline__ void phase_a_rwkv(const Args& a, int layer, LAS unsigned char* lds, int tid, int gw, int NGW, int lane) {
    unsigned char* ws = a.ws; const int lj = layer >> 1; const bool has_prev = layer > 0;
    const float* xin_lat = layer == 0 ? a.in[0] : (const float*)(ws + WS_XSA);
    const float* xin_ctx = layer == 0 ? a.in[2] : (const float*)(ws + WS_XSA) + (size_t)TL * D;
    float* xout = (float*)(ws + (layer == 0 ? WS_XSA : WS_XSB));
    const float* MODS = (const float*)(ws + WS_MODS); const bf16* YS = (const bf16*)(ws + WS_YS); bf16* XL = (bf16*)(ws + WS_XL);
    const float* mug = a.in[8] + (size_t)lj * 6 * 2 * 1024; const float* ng = a.in[6] + (size_t)(layer * 2 + 0) * 1024;
    LAS float* mu = (LAS float*)lds;
    { f32x4 tm[6];
#pragma unroll
      for (int q = 0; q < 6; ++q) tm[q] = ((const f32x4*)mug)[tid + q * 512];
#pragma unroll
      for (int q = 0; q < 6; ++q) ((LAS f32x4*)mu)[tid + q * 512] = tm[q]; }
    __syncthreads();
    for (int it = gw; it < TL / 8 + TC / 2; it += NGW) {
        const int ntok = it < TL / 8 ? 8 : 2, t0 = it < TL / 8 ? it * 8 : TL + (it - TL / 8) * 2, mr = mod_row(t0);
        int rs, re; if (t0 < TL) { rs = t0 & ~63; re = rs + 63; } else { const int loc = t0 - TL; rs = TL + (loc & ~255); re = rs + 255; }
        const float* mod = MODS + (size_t)(layer * 5 + mr) * 6144;
        const float* m5p = MODS + (size_t)((has_prev ? layer - 1 : 0) * 5 + mr) * 6144 + 5 * 1024;
        f32x4 hm[4], h0[4], hp[4];
#pragma unroll
        for (int j = 0; j < 4; ++j) { hm[j] = (f32x4){0.f, 0.f, 0.f, 0.f}; h0[j] = hm[j]; hp[j] = hm[j]; }
        f32x4 rx[4], nx[4]; u32x2 ry[4][4], ny[4][4];
#define PA_LOAD(X, Y, tt) do { const int t_ = (tt); if (t_ >= rs && t_ <= re) { \
            const float* xrow_ = t_ < TL ? xin_lat + (size_t)t_ * D : xin_ctx + (size_t)(t_ - TL) * D; \
            _Pragma("unroll") for (int j = 0; j < 4; ++j) X[j] = *(const f32x4*)(xrow_ + 256 * j + 4 * lane); \
            if (has_prev) { _Pragma("unroll") for (int k = 0; k < 4; ++k) _Pragma("unroll") for (int j = 0; j < 4; ++j) Y[k][j] = *(const u32x2*)(YS + ((size_t)t_ * 4 + k) * 1024 + 256 * j + 4 * lane); } } } while (0)
#pragma unroll
        for (int j = 0; j < 4; ++j) { rx[j] = (f32x4){0.f, 0.f, 0.f, 0.f}; nx[j] = rx[j];
#pragma unroll
            for (int k = 0; k < 4; ++k) { ry[k][j] = (u32x2){0u, 0u}; ny[k][j] = ry[k][j]; } }
        PA_LOAD(rx, ry, t0 - 1);
        f32x4 gsc[4], sh4[4], m5v[4];
#pragma unroll
        for (int j = 0; j < 4; ++j) { const int col = 256 * j + 4 * lane; gsc[j] = *(const f32x4*)(ng + col) * (*(const f32x4*)(mod + 1024 + col) + 1.0f); sh4[j] = *(const f32x4*)(mod + col); m5v[j] = *(const f32x4*)(m5p + col); }
#pragma unroll
        for (int j = 0; j < 4; ++j) asm volatile("" : "+v"(gsc[j]), "+v"(sh4[j]), "+v"(m5v[j]), "+v"(rx[j]));
#pragma unroll 1
        for (int i = -1; i <= ntok; ++i) {
            const int t = t0 + i;
            if (i < ntok) PA_LOAD(nx, ny, t + 1);
            f32x4 hn[4];
            if (t >= rs && t <= re) {
                f32x4 x[4];
#pragma unroll
                for (int j = 0; j < 4; ++j) x[j] = rx[j];
                if (has_prev) {
#pragma unroll
                    for (int j = 0; j < 4; ++j) { f32x4 sm = (f32x4){0.f, 0.f, 0.f, 0.f};
#pragma unroll
                        for (int k = 0; k < 4; ++k) sm += (f32x4){bflo(ry[k][j].x), bfhi(ry[k][j].x), bflo(ry[k][j].y), bfhi(ry[k][j].y)};
                        x[j] += m5v[j] * sm; } }
                if (i >= 0 && i < ntok) {
#pragma unroll
                    for (int j = 0; j < 4; ++j) *(f32x4*)(xout + (size_t)t * D + 256 * j + 4 * lane) = x[j]; }
                const float rstd = row_rstd(x);
#pragma unroll
                for (int j = 0; j < 4; ++j) hn[j] = x[j] * rstd * gsc[j] + sh4[j];
            } else {
#pragma unroll
                for (int j = 0; j < 4; ++j) hn[j] = (f32x4){0.f, 0.f, 0.f, 0.f};
            }
#pragma unroll
            for (int j = 0; j < 4; ++j) { hm[j] = h0[j]; h0[j] = hp[j]; hp[j] = hn[j]; rx[j] = nx[j];
#pragma unroll
                for (int k = 0; k < 4; ++k) ry[k][j] = ny[k][j]; }
            if (i >= 1) {
                const int te = t - 1;
#pragma unroll
                for (int q = 0; q < 6; ++q) {
                    bf16* orow = XL + ((size_t)q * T + te) * D;
#pragma unroll
                    for (int j = 0; j < 4; ++j) { const int col = 256 * j + 4 * lane;
                        const f32x4 m0 = *(const LAS f32x4*)(mu + (q * 2 + 0) * 1024 + col), m1 = *(const LAS f32x4*)(mu + (q * 2 + 1) * 1024 + col);
                        const f32x4 o = h0[j] + m0 * (hm[j] - h0[j]) + m1 * (hp[j] - h0[j]);
                        u32x2 w; w.x = pk2(o.x, o.y); w.y = pk2(o.z, o.w); *(u32x2*)(orow + col) = w; }
                }
            }
        }
#undef PA_LOAD
    }
}
__device__ __forceinline__ void phase_a_conv(const Args& a, int layer, int rows, int gw, int NGW, int lane) {
    unsigned char* ws = a.ws;
    float* xs = (float*)(ws + (layer < 2 ? WS_XSA : WS_XSB));
    const float* MODS = (const float*)(ws + WS_MODS); const bf16* YS = (const bf16*)(ws + WS_YS); bf16* H = (bf16*)(ws + WS_XL);
    const float* ng = a.in[6] + (size_t)(layer * 2 + 0) * 1024;
    for (int t = gw; t < rows; t += NGW) {
        const int mr = mod_row(t);
        const float* mod = MODS + (size_t)(layer * 5 + mr) * 6144;
        f32x4 m5[4], x[4];
#pragma unroll
        for (int j = 0; j < 4; ++j) m5[j] = *(const f32x4*)(MODS + (size_t)((layer - 1) * 5 + mr) * 6144 + 5 * 1024 + 256 * j + 4 * lane);
        f32x4 gsc[4], sh4[4], ngv[4];
#pragma unroll
        for (int j = 0; j < 4; ++j) { const int col = 256 * j + 4 * lane; ngv[j] = *(const f32x4*)(ng + col); gsc[j] = *(const f32x4*)(mod + 1024 + col); sh4[j] = *(const f32x4*)(mod + col); }
        load_x_combined(x, xs + (size_t)t * D, true, YS, t, m5, lane);
#pragma unroll
        for (int j = 0; j < 4; ++j) gsc[j] = ngv[j] * (gsc[j] + 1.0f);
        const float rstd = row_rstd(x);
#pragma unroll
        for (int j = 0; j < 4; ++j) { const int col = 256 * j + 4 * lane;
            *(f32x4*)(xs + (size_t)t * D + col) = x[j];
            const f32x4 h = x[j] * rstd * gsc[j] + sh4[j];
            u32x2 w; w.x = pk2(h.x, h.y); w.y = pk2(h.z, h.w); *(u32x2*)(H + (size_t)t * D + col) = w; }
    }
}
#define DPPF(x, ctrl) __builtin_bit_cast(float, __builtin_amdgcn_update_dpp(0, __builtin_bit_cast(int, (x)), (ctrl), 0xf, 0xf, false))
__device__ __forceinline__ float row16_sum(float v) { v += DPPF(v, 0xB1); v += DPPF(v, 0x4E); v += DPPF(v, 0x141); v += DPPF(v, 0x140); return v; }
__device__ __forceinline__ u32x2 pk4(f32x4 v) { u32x2 w; w.x = pk2(v[0], v[1]); w.y = pk2(v[2], v[3]); return w; }
__device__ __forceinline__ void phase_c_prep(const Args& a, int lj, LAS unsigned char* lds, int tid, int gw, int NGW, int lane) {
    unsigned char* ws = a.ws;
    const bf16* Rr = (const bf16*)(ws + WS_RKV); const bf16* Kk = Rr + (size_t)T * D; const bf16* RA = (const bf16*)(ws + WS_RAWA); const bf16* RW = (const bf16*)(ws + WS_RAWW);
    bf16* KK = (bf16*)(ws + WS_KK); bf16* KD = (bf16*)(ws + WS_KD); bf16* BE = (bf16*)(ws + WS_BETA); float* RKB = (float*)(ws + WS_RKB);
    LAS float* tb = (LAS float*)lds;
    for (int i = tid; i < 7 * 256; i += 512) { const int t7 = i >> 8, q = i & 255;
        const float* src = t7 == 0 ? a.in[18] + lj * 1024 : t7 == 1 ? a.in[19] + lj * 1024 : t7 == 2 ? a.in[20] + lj * 1024 : t7 < 5 ? a.in[10] + lj * 2048 + (t7 - 3) * 1024 : a.in[13] + lj * 2048 + (t7 - 5) * 1024;
        ((LAS f32x4*)tb)[i] = ((const f32x4*)src)[q]; }
    __syncthreads();
    for (int row = gw; row < T; row += NGW) {
#pragma unroll
        for (int j = 0; j < 4; ++j) {
            const int col = 256 * j + 4 * lane; const size_t ro = (size_t)row * D + col;
            const f32x4 k = bf4(*(const u32x2*)(Kk + ro)), r = bf4(*(const u32x2*)(Rr + ro));
            f32x4 a0 = bf4(*(const u32x2*)(RA + ro)) + *(const LAS f32x4*)(tb + 5 * 1024 + col), a1 = bf4(*(const u32x2*)(RA + (size_t)T * D + ro)) + *(const LAS f32x4*)(tb + 6 * 1024 + col);
#pragma unroll
            for (int z = 0; z < 4; ++z) { a0[z] = sigm(a0[z]); a1[z] = sigm(a1[z]); }
            const f32x4 ck = *(const LAS f32x4*)(tb + col), ca = *(const LAS f32x4*)(tb + 1024 + col), cr = *(const LAS f32x4*)(tb + 2048 + col);
            const f32x4 kk = k * ck;
            const float ss = row16_sum((kk.x * kk.x + kk.y * kk.y) + (kk.z * kk.z + kk.w * kk.w));
            const f32x4 kd0 = k * ((a0 - 1.0f) * ca + 1.0f), kd1 = k * ((a1 - 1.0f) * ca + 1.0f);
            *(u32x2*)(KD + ro) = pk4(kd0); *(u32x2*)(KD + (size_t)T * D + ro) = pk4(kd1);
            const f32x4 p = r * (kd0 + kd1) * cr;
            const float rk = row16_sum((p.x + p.y) + (p.z + p.w));
            const f32x4 kkn = kk * fminf(__builtin_amdgcn_rsqf(ss), 1e12f);
            *(u32x2*)(KK + ro) = pk4(kkn); *(u32x2*)(BE + ro) = pk4(kkn * a0); *(u32x2*)(BE + (size_t)T * D + ro) = pk4(kkn * a1);
            if ((lane & 15) == 0) RKB[(size_t)row * 16 + 4 * j + (lane >> 4)] = rk;
        }
    }
}
typedef short bf16x8 __attribute__((ext_vector_type(8)));
__device__ __forceinline__ f32x4 mfma16(bf16x8 a, bf16x8 b, f32x4 c) { return __builtin_amdgcn_mfma_f32_16x16x32_bf16(a, b, c, 0, 0, 0); }
__device__ __forceinline__ bf16x8 as_frag(u32x4 w) { return __builtin_bit_cast(bf16x8, w); }
constexpr int CH_LD = 144;
constexpr int CH_MS = 64 * CH_LD;
constexpr int CH_AB = 0 * CH_MS, CH_KT = 1 * CH_MS, CH_BT = 2 * CH_MS, CH_RB = 3 * CH_MS, CH_VT = 4 * CH_MS, CH_ABT = 5 * CH_MS, CH_KHT = 6 * CH_MS, CH_BHT = 7 * CH_MS,
              CH_LK = 8 * CH_MS, CH_LB = 9 * CH_MS, CH_MK = 10 * CH_MS, CH_MB = 11 * CH_MS, CH_WT = 12 * CH_MS, CH_U0 = 13 * CH_MS, CH_DINV = 14 * CH_MS;
constexpr int CH_GC = LDSCTL_OFF + 2048;
constexpr int CH_PART = LDSCTL_OFF + 4096;
constexpr int NCHUNK = NSTEP / 64;
#ifndef S1_DBL
#define S1_DBL 0
#endif
static_assert(CH_DINV + 2048 <= RING_BYTES, "chunk LDS map");

__device__ __forceinline__ int scan_row(int s, int dir, int b) {
    if (s < CTXL) return TL + b * CTXL + (dir ? CTXL - 1 - s : s);
    const int i = s - CTXL; return b * SEQ + (dir ? SEQ - 1 - i : i);
}
#define CH_FRAG(mat, row, ks, kg) as_frag(*(const LAS u32x4*)(lds + (mat) + (row) * CH_LD + ((ks) * 32 + (kg) * 8) * 2))

__device__ __forceinline__ float s1_treduce16(const float (&a)[16], bool b3, bool b2) {
    float b[8];
#pragma unroll
    for (int i = 0; i < 8; ++i) { float x = a[i], y = a[i + 8];
        asm("s_nop 1\n\tv_permlane32_swap_b32 %0, %1" : "+v"(x), "+v"(y));
        b[i] = x + y; }
    float c[4];
#pragma unroll
    for (int i = 0; i < 4; ++i) { float x = b[i], y = b[i + 4];
        asm("s_nop 1\n\tv_permlane16_swap_b32 %0, %1" : "+v"(x), "+v"(y));
        c[i] = x + y; }
    float d[2];
#pragma unroll
    for (int i = 0; i < 2; ++i) { const float keep = b3 ? c[i + 2] : c[i], send = b3 ? c[i] : c[i + 2]; d[i] = keep + DPPF(send, 0x128); }
    const float keep = b2 ? d[1] : d[0], send = b2 ? d[0] : d[1];
    float e = keep + DPPF(send, 0x141);
    e += DPPF(e, 0xB1);
    e += DPPF(e, 0x4E);
    return e;
}
#define S1_BAR() do { asm volatile("s_waitcnt lgkmcnt(0)" ::: "memory"); __builtin_amdgcn_s_barrier(); asm volatile("" ::: "memory"); } while (0)
__device__ __forceinline__ void phase_s1_chunks(const Args& a, int lj, LAS unsigned char* lds, int tid, int G, int rh_scratch = 0) {
    unsigned char* ws = a.ws; const float* w0l = a.in[10] + lj * 2048; const float* a0l = a.in[13] + lj * 2048;
    const float* pkk = a.in[18] + lj * 1024; const float* pka = a.in[19] + lj * 1024; const float* prk = a.in[20] + lj * 1024;
    const int lane = tid & 63, wave = __builtin_amdgcn_readfirstlane(tid >> 6), l15 = lane & 15, g = lane >> 4;
    LAS float* part = (LAS float*)(lds + CH_PART); LAS float* gammaC = (LAS float*)(lds + CH_GC);
    unsigned nlw[8], nka[8], nkr[8], nrr[8], nvv[8]; float nw0 = 0.f, na0 = 0.f, npkk = 0.f, npka = 0.f, nprk = 0.f;
    typedef const __attribute__((address_space(1))) unsigned short* GUS;
#define S1_LOAD(ctx_) do { unsigned char* wsl = ws; asm volatile("" : "+s"(wsl));     \
        const int chain_ = (ctx_) / NCHUNK, c_ = (ctx_) - chain_ * NCHUNK, dir_ = chain_ >> 6, b_ = (chain_ >> 4) & 3, h_ = chain_ & 15; \
          \
          \
        const long o0 = (long)scan_row(64 * c_ + 8 * wave, dir_, b_) * D + h_ * 64, od = (long)dir_ * T * D, st = dir_ ? -(long)D : (long)D; \
        const bf16* LWp = (const bf16*)(wsl + WS_RAWW) + od + o0; const bf16* RAp = (const bf16*)(wsl + WS_RAWA) + od + o0; \
        const bf16* Rp = (const bf16*)(wsl + WS_RKV) + o0; const bf16* Kp = Rp + (size_t)T * D; const bf16* Vp = Rp + (size_t)2 * T * D; \
        nw0 = w0l[dir_ * 1024 + h_ * 64 + lane]; na0 = a0l[dir_ * 1024 + h_ * 64 + lane]; npkk = pkk[h_ * 64 + lane]; npka = pka[h_ * 64 + lane]; nprk = prk[h_ * 64 + lane]; \
        _Pragma("unroll") for (int j = 0; j < 8; ++j) { const long oj = st * j; \
            nlw[j] = ((GUS)(LWp + oj))[lane]; nka[j] = ((GUS)(RAp + oj))[lane]; nkr[j] = ((GUS)(Kp + oj))[lane]; nrr[j] = ((GUS)(Rp + oj))[lane]; nvv[j] = ((GUS)(Vp + oj))[lane]; } } while (0)
    unsigned clw[8], cka_[8], ckr[8], crr[8], cvv[8]; float cw0 = 0.f, ca0 = 0.f, cpkk = 0.f, cpka = 0.f, cprk = 0.f;
#define S1_TAKE() do { _Pragma("unroll") for (int j = 0; j < 8; ++j) { clw[j] = nlw[j]; cka_[j] = nka[j]; ckr[j] = nkr[j]; crr[j] = nrr[j]; cvv[j] = nvv[j]; } \
        cw0 = nw0; ca0 = na0; cpkk = npkk; cpka = npka; cprk = nprk; \
        _Pragma("unroll") for (int j = 0; j < 8; ++j) asm volatile("" : "+v"(clw[j]), "+v"(cka_[j]), "+v"(ckr[j]), "+v"(crr[j]), "+v"(cvv[j]) :: "memory"); \
        asm volatile("" : "+v"(cw0), "+v"(ca0), "+v"(cpkk), "+v"(cpka), "+v"(cprk) :: "memory"); } while (0)
    if ((int)blockIdx.x < 128 * NCHUNK) { S1_LOAD((int)blockIdx.x); S1_TAKE(); if ((int)blockIdx.x + G < 128 * NCHUNK) S1_LOAD((int)blockIdx.x + G); }
    for (int ct = blockIdx.x; ct < 128 * NCHUNK; ct += G) {
        const int chain = ct / NCHUNK, c = ct - chain * NCHUNK, dir = chain >> 6, b = (chain >> 4) & 3, h = chain & 15;
        unsigned zq = 0u; asm volatile("" : "+v"(zq));
        {
            const int k = lane, tq = wave;
            float lw[8], kd[8], be[8], kk[8], rr[8], vv[8];
            {
                const float w0k = cw0, a0k = ca0, ckk = cpkk, cka = cpka, crk = cprk;
                float* RKBd = (float*)(ws + (dir ? WS_RKB1 : WS_RKB));
                const int row0 = scan_row(64 * c + 8 * tq, dir, b), rst = dir ? -1 : 1;
                float av[8], kq[8], red[16];
                const float a0n = a0k * -1.44269504f, w0n = w0k * -1.44269504f;
#pragma unroll
                for (int j = 0; j < 8; ++j) { av[j] = frcp(1.0f + __builtin_amdgcn_exp2f(__builtin_fmaf(bflo(cka_[j]), -1.44269504f, a0n))); const float kr = bflo(ckr[j]);
                    lw[j] = -0.60653066f * frcp(1.0f + __builtin_amdgcn_exp2f(__builtin_fmaf(bflo(clw[j]), -1.44269504f, w0n)));
                    kq[j] = kr * ckk; kd[j] = kr * ((av[j] - 1.0f) * cka + 1.0f); rr[j] = bflo(crr[j]); vv[j] = bflo(cvv[j]);
                    red[2 * j] = kq[j] * kq[j]; red[2 * j + 1] = rr[j] * kd[j] * crk; }
                const float tot = s1_treduce16(red, (lane & 8) != 0, (lane & 4) != 0);
                if ((lane & 7) == 4) RKBd[(size_t)(row0 + rst * (lane >> 3)) * 16 + h] = tot;
#pragma unroll
                for (int j = 0; j < 8; ++j) { const float ss = __builtin_bit_cast(float, __builtin_amdgcn_readlane(__builtin_bit_cast(int, tot), 8 * j));
                    kk[j] = kq[j] * fminf(__builtin_amdgcn_rsqf(ss), 1e12f);     be[j] = kk[j] * av[j]; }
            }
            for (int r0_ = 0; r0_ <= ((S1_DBL >> 3) & 1); ++r0_) { if (r0_) S1_BAR();
            float p[8]; p[0] = lw[0];
#pragma unroll
            for (int j = 1; j < 8; ++j) p[j] = p[j - 1] + lw[j];
            part[tq * 64 + k] = p[7];
            S1_BAR();
            float off = 0.f, tot = 0.f;
#pragma unroll
            for (int q = 0; q < 8; ++q) { const float pv = part[q * 64 + k]; tot += pv; off += q < tq ? pv : 0.f; }
            const float eTot = __expf(tot); float ePrev = __expf(off);
            if (tq == 0) gammaC[k] = eTot;
            unsigned abw[4], khw[4], bhw[4], vw[4];
#pragma unroll
            for (int j = 0; j < 8; j += 2) {
                float ab2[2], kt2[2], bt2[2], rb2[2], kh2[2], bh2[2];
#pragma unroll
                for (int z = 0; z < 2; ++z) { const float cu = (off + p[j + z]) * 1.44269504f; const float eP = __builtin_amdgcn_exp2f(cu), eM = __builtin_amdgcn_exp2f(-cu), eC = eTot * eM;
                    ab2[z] = kk[j + z] * ePrev; ePrev = eP; kt2[z] = kd[j + z] * eM; bt2[z] = be[j + z] * eM; rb2[z] = rr[j + z] * eP; kh2[z] = kd[j + z] * eC; bh2[z] = be[j + z] * eC;
                }
                abw[j >> 1] = pk2(ab2[0], ab2[1]); khw[j >> 1] = pk2(kh2[0], kh2[1]); bhw[j >> 1] = pk2(bh2[0], bh2[1]); vw[j >> 1] = pk2(vv[j], vv[j + 1]);
                {
                    const unsigned ktw = pk2(kt2[0], kt2[1]), btw = pk2(bt2[0], bt2[1]), rbw = pk2(rb2[0], rb2[1]), aw = abw[j >> 1];
                    const int t = 8 * tq + j;
                    *(LAS bf16*)(lds + CH_AB + t * CH_LD + k * 2) = (bf16)aw; *(LAS bf16*)(lds + CH_AB + (t + 1) * CH_LD + k * 2) = (bf16)(aw >> 16);
                    *(LAS bf16*)(lds + CH_KT + t * CH_LD + k * 2) = (bf16)ktw; *(LAS bf16*)(lds + CH_KT + (t + 1) * CH_LD + k * 2) = (bf16)(ktw >> 16);
                    *(LAS bf16*)(lds + CH_BT + t * CH_LD + k * 2) = (bf16)btw; *(LAS bf16*)(lds + CH_BT + (t + 1) * CH_LD + k * 2) = (bf16)(btw >> 16);
                    *(LAS bf16*)(lds + CH_RB + t * CH_LD + k * 2) = (bf16)rbw; *(LAS bf16*)(lds + CH_RB + (t + 1) * CH_LD + k * 2) = (bf16)(rbw >> 16); }
            }
            *(LAS u32x4*)(lds + CH_ABT + k * CH_LD + tq * 16) = (u32x4){abw[0], abw[1], abw[2], abw[3]};
            *(LAS u32x4*)(lds + CH_KHT + k * CH_LD + tq * 16) = (u32x4){khw[0], khw[1], khw[2], khw[3]};
            *(LAS u32x4*)(lds + CH_BHT + k * CH_LD + tq * 16) = (u32x4){bhw[0], bhw[1], bhw[2], bhw[3]};
            *(LAS u32x4*)(lds + CH_VT + k * CH_LD + tq * 16) = (u32x4){vw[0], vw[1], vw[2], vw[3]};
            *(LAS u32x4*)(lds + CH_WT + k * CH_LD + tq * 16) = (u32x4){zq, zq, zq, zq}; *(LAS u32x4*)(lds + CH_U0 + k * CH_LD + tq * 16) = (u32x4){zq, zq, zq, zq};
            }
        }
        S1_BAR();
        for (int r1_ = 0; r1_ <= (S1_DBL & 1); ++r1_) { if (r1_) S1_BAR();
            const int mi = wave >> 1, half = wave & 1;
            const int matS = (mi & 1) ? CH_BT : CH_KT, matT = (mi & 2) ? CH_RB : CH_AB, matO = CH_LK + mi * CH_MS;
            const bool incl = (mi & 2) != 0;
            bf16x8 fs[4][2], ft[2][2];
#pragma unroll
            for (int ms = 0; ms < 4; ++ms)
#pragma unroll
                for (int ks = 0; ks < 2; ++ks) fs[ms][ks] = CH_FRAG(matS, 16 * ms + l15, ks, g);
#pragma unroll
            for (int nt = 0; nt < 2; ++nt)
#pragma unroll
                for (int ks = 0; ks < 2; ++ks) ft[nt][ks] = CH_FRAG(matT, 32 * half + 16 * nt + l15, ks, g);
#pragma unroll
            for (int nt = 0; nt < 2; ++nt) { const int t = 32 * half + 16 * nt + l15;
#pragma unroll
                for (int ms = 0; ms < 4; ++ms) { f32x4 d = (f32x4){0.f, 0.f, 0.f, 0.f};
                    d = mfma16(fs[ms][0], ft[nt][0], d); d = mfma16(fs[ms][1], ft[nt][1], d);
                    const int s0 = 16 * ms + 4 * g;
#pragma unroll
                    for (int i = 0; i < 4; ++i) { const bool keep = incl ? (s0 + i <= t) : (s0 + i < t); d[i] = keep ? d[i] : __builtin_bit_cast(float, zq); }
                    u32x2 w; w.x = pk2(d[0], d[1]); w.y = pk2(d[2], d[3]);
                    *(LAS u32x2*)(lds + matO + t * CH_LD + s0 * 2) = w; } }
        }
        S1_BAR();
        f32x4 rhsU[4];
#pragma unroll
        for (int I = 0; I < 4; ++I) rhsU[I] = (f32x4){0.f, 0.f, 0.f, 0.f};
        if (wave >= 4) {
            const int ctv = (wave & 3) * 16;
            const bf16x8 fv0 = CH_FRAG(CH_VT, ctv + l15, 0, g), fv1 = CH_FRAG(CH_VT, ctv + l15, 1, g);
#pragma unroll
            for (int I = 0; I < 4; ++I) { f32x4 d = (f32x4){0.f, 0.f, 0.f, 0.f};
                d = mfma16(CH_FRAG(CH_LK, 16 * I + l15, 0, g), fv0, d); d = mfma16(CH_FRAG(CH_LK, 16 * I + l15, 1, g), fv1, d); rhsU[I] = -d; }
        }
        for (int r2_ = 0; r2_ <= ((S1_DBL >> 1) & 1); ++r2_) if (wave == 0) {
            const int bb = lane >> 4, j = lane & 15;
            float x[16];
#pragma unroll
            for (int t = 0; t < 16; ++t) {
                const u32x4 r0 = *(const LAS u32x4*)(lds + CH_LB + (16 * bb + t) * CH_LD + 32 * bb), r1 = *(const LAS u32x4*)(lds + CH_LB + (16 * bb + t) * CH_LD + 32 * bb + 16);
                const unsigned rw[8] = {r0.x, r0.y, r0.z, r0.w, r1.x, r1.y, r1.z, r1.w};
                float acc = (t == j) ? 1.0f : 0.0f;
#pragma unroll
                for (int s = 0; s < t; ++s) { const float lv = (s & 1) ? bfhi(rw[s >> 1]) : bflo(rw[s >> 1]); acc -= lv * x[s]; }
                x[t] = acc;
                *(LAS bf16*)(lds + CH_DINV + ((bb * 16 + t) * 16 + j) * 2) = (bf16)f2bf(acc);
            }
        }
        S1_BAR();
        {
            const int matZ = wave < 4 ? CH_WT : CH_U0, ct16 = (wave & 3) * 16;
            for (int r4_ = 0; r4_ <= ((S1_DBL >> 4) & 1); ++r4_) { if (r4_) { *(LAS u32x4*)(lds + matZ + (ct16 + l15) * CH_LD + g * 32) = (u32x4){zq, zq, zq, zq}; *(LAS u32x4*)(lds + matZ + (ct16 + l15) * CH_LD + g * 32 + 16) = (u32x4){zq, zq, zq, zq}; LDS_WAIT(); }
#pragma unroll
            for (int I = 0; I < 4; ++I) {
                f32x4 rhs;
                if (wave < 4) { const u32x2 w = *(const LAS u32x2*)(lds + CH_ABT + (ct16 + l15) * CH_LD + (16 * I + 4 * g) * 2); rhs = (f32x4){bflo(w.x), bfhi(w.x), bflo(w.y), bfhi(w.y)}; }
                else rhs = rhsU[I];
                f32x4 d = (f32x4){0.f, 0.f, 0.f, 0.f};
                d = mfma16(CH_FRAG(CH_LB, 16 * I + l15, 0, g), CH_FRAG(matZ, ct16 + l15, 0, g), d); d = mfma16(CH_FRAG(CH_LB, 16 * I + l15, 1, g), CH_FRAG(matZ, ct16 + l15, 1, g), d);
                const f32x4 ac = rhs - d;
                const u32x2 dv = *(const LAS u32x2*)(lds + CH_DINV + ((I * 16 + l15) * 16 + 4 * g) * 2);
                const bf16x8 fa = as_frag((u32x4){dv.x, dv.y, zq, zq}), fb = as_frag((u32x4){pk2(ac[0], ac[1]), pk2(ac[2], ac[3]), zq, zq});
                const f32x4 z = mfma16(fa, fb, (f32x4){0.f, 0.f, 0.f, 0.f});
                u32x2 w; w.x = pk2(z[0], z[1]); w.y = pk2(z[2], z[3]);
                *(LAS u32x2*)(lds + matZ + (ct16 + l15) * CH_LD + (16 * I + 4 * g) * 2) = w;
                LDS_WAIT(); asm volatile("" ::: "memory");
            }
            }
        }
        S1_BAR();
        if (ct + G < 128 * NCHUNK) { S1_TAKE(); if (ct + 2 * G < 128 * NCHUNK) S1_LOAD(ct + 2 * G); }
        for (int r3_ = 0; r3_ <= ((S1_DBL >> 2) & 1); ++r3_) { if (r3_) S1_BAR();
            const int rt = wave >> 1, cp = (wave & 1) * 2;
            unsigned char* wsl = ws; asm volatile("" : "+s"(wsl));
            bf16* YL = (bf16*)(wsl + WS_Y); bf16* RH = (bf16*)(wsl + (rh_scratch ? WS_BETA + RF : WS_RH)); bf16* PM = (bf16*)(wsl + WS_PM); bf16* QT = (bf16*)(wsl + WS_QT);
            const int trow = scan_row(64 * c + 16 * rt + l15, dir, b);
#pragma unroll
            for (int q = 0; q < 2; ++q) { const int vt = cp + q; f32x4 d = (f32x4){0.f, 0.f, 0.f, 0.f};
#pragma unroll
                for (int ks = 0; ks < 2; ++ks) { d = mfma16(CH_FRAG(CH_VT, 16 * vt + l15, ks, g), CH_FRAG(CH_MK, 16 * rt + l15, ks, g), d); d = mfma16(CH_FRAG(CH_U0, 16 * vt + l15, ks, g), CH_FRAG(CH_MB, 16 * rt + l15, ks, g), d); }
                *(u32x2*)(YL + ((size_t)dir * T + trow) * D + h * 64 + 16 * vt + 4 * g) = pk4(d); }
#pragma unroll
            for (int q = 0; q < 2; ++q) { const int kt = cp + q; f32x4 d = (f32x4){0.f, 0.f, 0.f, 0.f};
#pragma unroll
                for (int ks = 0; ks < 2; ++ks) d = mfma16(CH_FRAG(CH_WT, 16 * kt + l15, ks, g), CH_FRAG(CH_MB, 16 * rt + l15, ks, g), d);
                const u32x2 rbw = *(const LAS u32x2*)(lds + CH_RB + (16 * rt + l15) * CH_LD + (16 * kt + 4 * g) * 2);
                u32x2 w; w.x = pk2(bflo(rbw.x) - d[0], bfhi(rbw.x) - d[1]); w.y = pk2(bflo(rbw.y) - d[2], bfhi(rbw.y) - d[3]);
                *(u32x2*)(RH + ((size_t)dir * T + trow) * D + h * 64 + 16 * kt + 4 * g) = w; }
            bf16* Pc = PM + ((size_t)chain * NCHUNK + c) * 4096; bf16* Qc = QT + ((size_t)chain * NCHUNK + c) * 4096;
            { const int krow = 16 * rt + l15; const float gc = gammaC[krow];
#pragma unroll
                for (int q = 0; q < 2; ++q) { const int kt = cp + q; f32x4 d = (f32x4){0.f, 0.f, 0.f, 0.f};
#pragma unroll
                    for (int ks = 0; ks < 2; ++ks) d = mfma16(CH_FRAG(CH_WT, 16 * kt + l15, ks, g), CH_FRAG(CH_BHT, krow, ks, g), d);
                    const int k0 = 16 * kt + 4 * g; f32x4 o;
#pragma unroll
                    for (int i = 0; i < 4; ++i) o[i] = ((k0 + i == krow) ? gc : 0.f) - d[i];
                    u32x2 w; w.x = pk2(o[0], o[1]); w.y = pk2(o[2], o[3]);
                    *(u32x2*)(Pc + ((rt * 2 + (kt >> 1)) * 64 + g * 16 + l15) * 8 + 4 * (kt & 1)) = w; } }
            { const int vrow = 16 * rt + l15;
#pragma unroll
                for (int q = 0; q < 2; ++q) { const int kt = cp + q; f32x4 d = (f32x4){0.f, 0.f, 0.f, 0.f};
#pragma unroll
                    for (int ks = 0; ks < 2; ++ks) { d = mfma16(CH_FRAG(CH_KHT, 16 * kt + l15, ks, g), CH_FRAG(CH_VT, vrow, ks, g), d); d = mfma16(CH_FRAG(CH_BHT, 16 * kt + l15, ks, g), CH_FRAG(CH_U0, vrow, ks, g), d); }
                    u32x2 w; w.x = pk2(d[0], d[1]); w.y = pk2(d[2], d[3]);
                    *(u32x2*)(Qc + ((rt * 2 + (kt >> 1)) * 64 + g * 16 + l15) * 8 + 4 * (kt & 1)) = w; } }
        }
        S1_BAR();
    }
}

template <int NG, int NKS>
__device__ __forceinline__ void b2_stream(const bf16* L1s, const bf16* W2s, bf16* outp, int cbase, int koff, int sub, int nsub, int l15, int g) {
    static_assert(NG * NKS == 4, "sixteen fragments");
    u32x4 wf[NG][4][NKS];
#pragma unroll
    for (int gr = 0; gr < NG; ++gr)
#pragma unroll
        for (int b = 0; b < 4; ++b)
#pragma unroll
            for (int ks = 0; ks < NKS; ++ks) wf[gr][b][ks] = *(const u32x4*)(W2s + (size_t)(cbase + 64 * gr + 16 * (l15 >> 2) + 4 * b + (l15 & 3)) * 128 + koff + 32 * ks + 8 * g);
    constexpr int NT = T / 16;
    u32x4 cf[NKS], nf[NKS];
#pragma unroll
    for (int ks = 0; ks < NKS; ++ks) { cf[ks] = *(const u32x4*)(L1s + (size_t)(sub * 16 + l15) * 128 + koff + 32 * ks + 8 * g); nf[ks] = cf[ks]; }
    for (int tile = sub; tile < NT; tile += nsub) {
        const int tn = tile + nsub < NT ? tile + nsub : tile;
#pragma unroll
        for (int ks = 0; ks < NKS; ++ks) nf[ks] = *(const u32x4*)(L1s + (size_t)(tn * 16 + l15) * 128 + koff + 32 * ks + 8 * g);
        bf16* orow = outp + (size_t)(tile * 16 + l15) * D + cbase + 16 * g;
#pragma unroll
        for (int gr = 0; gr < NG; ++gr) { unsigned w[8];
#pragma unroll
            for (int b = 0; b < 4; ++b) { f32x4 d = (f32x4){0.f, 0.f, 0.f, 0.f};
#pragma unroll
                for (int ks = 0; ks < NKS; ++ks) d = mfma16(as_frag(wf[gr][b][ks]), as_frag(cf[ks]), d);
                w[2 * b] = pk2(d[0], d[1]); w[2 * b + 1] = pk2(d[2], d[3]); }
            *(u32x4*)(orow + 64 * gr) = (u32x4){w[0], w[1], w[2], w[3]}; *(u32x4*)(orow + 64 * gr + 8) = (u32x4){w[4], w[5], w[6], w[7]}; }
#pragma unroll
        for (int ks = 0; ks < NKS; ++ks) cf[ks] = nf[ks];
    }
}
__device__ __forceinline__ void phase_b2_direct(const Args& a, int lj, int gw, int NGW, int lane) {
    unsigned char* ws = a.ws;
    const bf16* L1 = (const bf16*)(ws + WS_L1); const bf16* W2 = (const bf16*)(ws + WS_L2T) + (size_t)lj * 5120 * 128;
    const int l15 = lane & 15, g = lane >> 4;
    for (int vw = gw; vw < 2048; vw += NGW)
    if (vw < 32 * 43) { const int item = vw / 43, sub = vw - item * 43, set = item >> 3, lora = set >> 1, dirn = set & 1;
        bf16* outp = (bf16*)(ws + (lora == 0 ? WS_RAWW : WS_RAWA)) + (size_t)dirn * T * D;
        b2_stream<2, 2>(L1 + (size_t)lora * T * 128, W2 + (size_t)(lora * 2048 + dirn * 1024) * 128, outp, (item & 7) * 128, 64 * dirn, sub, 43, l15, g); }
    else { const int r = vw - 32 * 43, item = r / 42, sub = r - item * 42;
        if (item < 16) b2_stream<1, 4>(L1 + (size_t)2 * T * 128, W2 + (size_t)4096 * 128, (bf16*)(ws + WS_G), item * 64, 0, sub, 42, l15, g); }
}

struct S2Set { u32x4 p[4][2]; u32x4 q[2]; };
__device__ __forceinline__ void s2_load(S2Set& s, const bf16* Pc, const bf16* Qc, int vt, int l15, int g) {
    const int ln = g * 16 + l15;
    s.q[0] = *(const u32x4*)(Qc + ((vt * 2 + 0) * 64 + ln) * 8); s.q[1] = *(const u32x4*)(Qc + ((vt * 2 + 1) * 64 + ln) * 8);
#pragma unroll
    for (int m = 0; m < 4; ++m)
#pragma unroll
        for (int j = 0; j < 2; ++j) s.p[m][j] = *(const u32x4*)(Pc + ((m * 2 + j) * 64 + ln) * 8);
}
__device__ __forceinline__ void s2_step(f32x4 (&acc)[4], const S2Set& s, bf16* Hc, int g) {
    unsigned hw[4][2];
#pragma unroll
    for (int m = 0; m < 4; ++m) { hw[m][0] = pk2(acc[m][0], acc[m][1]); hw[m][1] = pk2(acc[m][2], acc[m][3]); }
#pragma unroll
    for (int m = 0; m < 4; ++m) *(u32x2*)(Hc + (m >> 1) * 512 + (m & 1) * 256) = (u32x2){hw[m][0], hw[m][1]};
    const bf16x8 hb0 = as_frag((u32x4){hw[0][0], hw[0][1], hw[1][0], hw[1][1]}), hb1 = as_frag((u32x4){hw[2][0], hw[2][1], hw[3][0], hw[3][1]});
#pragma unroll
    for (int m = 0; m < 4; ++m) {
        const unsigned q0 = (m & 2) ? ((m & 1) ? s.q[1].z : s.q[1].x) : ((m & 1) ? s.q[0].z : s.q[0].x), q1 = (m & 2) ? ((m & 1) ? s.q[1].w : s.q[1].y) : ((m & 1) ? s.q[0].w : s.q[0].y);
        f32x4 d = (f32x4){bflo(q0), bfhi(q0), bflo(q1), bfhi(q1)};
        d = mfma16(as_frag(s.p[m][0]), hb0, d);
        d = mfma16(as_frag(s.p[m][1]), hb1, d);
        acc[m] = d;
    }
}
__device__ __forceinline__ void phase_s2_chain(const Args& a, int wave, int lane, int G) {
    unsigned char* ws = a.ws;
    const bf16* PM = (const bf16*)(ws + WS_PM); const bf16* QT = (const bf16*)(ws + WS_QT); bf16* HT = (bf16*)(ws + WS_HT);
    const int l15 = lane & 15, g = lane >> 4;
    if (wave >= 2) return;
    static_assert(NCHUNK % 4 == 0, "S2 ring");
    for (int wt = blockIdx.x * 2 + wave; wt < 512; wt += G * 2) {
        const int chain = wt >> 2, vt = wt & 3;
        f32x4 acc[4];
#pragma unroll
        for (int m = 0; m < 4; ++m) acc[m] = (f32x4){0.f, 0.f, 0.f, 0.f};
        const bf16* Pc = PM + (size_t)chain * NCHUNK * 4096; const bf16* Qc = QT + (size_t)chain * NCHUNK * 4096;
        bf16* Hc = HT + (size_t)chain * NCHUNK * 4096 + ((vt * 2) * 64 + (g >> 1) * 16 + l15) * 8 + 4 * (g & 1);
        S2Set s0, s1, s2, s3;
        s2_load(s0, Pc, Qc, vt, l15, g); s2_load(s1, Pc + 4096, Qc + 4096, vt, l15, g); s2_load(s2, Pc + 2 * 4096, Qc + 2 * 4096, vt, l15, g); s2_load(s3, Pc + 3 * 4096, Qc + 3 * 4096, vt, l15, g);
#pragma unroll 1
        for (int c = 0; c < NCHUNK; c += 4) {
            const int cn = c + 4 < NCHUNK ? c + 4 : c;
            const bf16* Pn = Pc + (size_t)cn * 4096; const bf16* Qn = Qc + (size_t)cn * 4096;
            s2_step(acc, s0, Hc + (size_t)c * 4096, g);       s2_load(s0, Pn, Qn, vt, l15, g);
            s2_step(acc, s1, Hc + (size_t)(c + 1) * 4096, g); s2_load(s1, Pn + 4096, Qn + 4096, vt, l15, g);
            s2_step(acc, s2, Hc + (size_t)(c + 2) * 4096, g); s2_load(s2, Pn + 2 * 4096, Qn + 2 * 4096, vt, l15, g);
            s2_step(acc, s3, Hc + (size_t)(c + 3) * 4096, g); s2_load(s3, Pn + 3 * 4096, Qn + 3 * 4096, vt, l15, g);
        }
    }
}

struct S3T { u32x2 yl[2][4]; u32x4 rh[2][2]; u32x2 vq2[4], gw2[4]; float bon0, bon1; };
__device__ __forceinline__ void s3_tile_load(S3T& s, const bf16* YL, const bf16* RH, const bf16* Vv, const bf16* Gg, const float* RKB, const float* RKB1, int row, int h, int g) {
    const size_t ro = (size_t)row * D + h * 64 + 4 * g;
#pragma unroll
    for (int dir = 0; dir < 2; ++dir) {
#pragma unroll
        for (int vt = 0; vt < 4; ++vt) s.yl[dir][vt] = *(const u32x2*)(YL + (size_t)dir * T * D + ro + 16 * vt);
        const bf16* rh = RH + ((size_t)dir * T + row) * D + h * 64 + 8 * g;
        s.rh[dir][0] = *(const u32x4*)(rh); s.rh[dir][1] = *(const u32x4*)(rh + 32); }
#pragma unroll
    for (int vt = 0; vt < 4; ++vt) { s.vq2[vt] = *(const u32x2*)(Vv + ro + 16 * vt); s.gw2[vt] = *(const u32x2*)(Gg + ro + 16 * vt); }
    s.bon0 = RKB[(size_t)row * 16 + h]; s.bon1 = RKB1[(size_t)row * 16 + h];
}
__device__ __forceinline__ void s3_tile_finish(const S3T& s, const u32x4 (&hh)[2][4][2], const LAS float* lnt, bf16* Z, int row, int h, int g) {
    const float bon = s.bon0 + s.bon1;
    f32x4 acc[4];
#pragma unroll
    for (int vt = 0; vt < 4; ++vt) acc[vt] = bf4(s.yl[0][vt]) + bf4(s.yl[1][vt]);
#pragma unroll
    for (int dir = 0; dir < 2; ++dir) {
        const bf16x8 f0 = as_frag(s.rh[dir][0]), f1 = as_frag(s.rh[dir][1]);
#pragma unroll
        for (int vt = 0; vt < 4; ++vt) { acc[vt] = mfma16(as_frag(hh[dir][vt][0]), f0, acc[vt]); acc[vt] = mfma16(as_frag(hh[dir][vt][1]), f1, acc[vt]); }
    }
    float sm = 0.f;
#pragma unroll
    for (int vt = 0; vt < 4; ++vt) sm += (acc[vt][0] + acc[vt][1]) + (acc[vt][2] + acc[vt][3]);
    sm += __shfl_xor(sm, 16); sm += __shfl_xor(sm, 32);
    const float mean = sm * (1.0f / 64.0f); float vs = 0.f;
#pragma unroll
    for (int vt = 0; vt < 4; ++vt) { acc[vt] = acc[vt] - mean; vs += (acc[vt][0] * acc[vt][0] + acc[vt][1] * acc[vt][1]) + (acc[vt][2] * acc[vt][2] + acc[vt][3] * acc[vt][3]); }
    vs += __shfl_xor(vs, 16); vs += __shfl_xor(vs, 32);
    const float rstd = rsqrtf(vs * (1.0f / 64.0f) + 64.0f * 1e-5f);
#pragma unroll
    for (int vt = 0; vt < 4; ++vt) { const size_t o = (size_t)row * D + h * 64 + 16 * vt + 4 * g;
        const int col = h * 64 + 16 * vt + 4 * g; const f32x4 zz = acc[vt] * rstd * *(const LAS f32x4*)(lnt + col) + *(const LAS f32x4*)(lnt + 1024 + col) + bf4(s.vq2[vt]) * bon;
        u32x2 w; w.x = pk2(zz[0] * bflo(s.gw2[vt].x), zz[1] * bfhi(s.gw2[vt].x)); w.y = pk2(zz[2] * bflo(s.gw2[vt].y), zz[3] * bfhi(s.gw2[vt].y));
        *(u32x2*)(Z + o) = w; }
}
__device__ __forceinline__ void phase_s3_readout(const Args& a, int lj, int nrows, LAS unsigned char* lds, int tid, int gw, int NGW, int lane) {
    unsigned char* ws = a.ws;
    const bf16* YL = (const bf16*)(ws + WS_Y); const bf16* RH = (const bf16*)(ws + WS_RH); const bf16* HT = (const bf16*)(ws + WS_HT);
    const bf16* Vv = (const bf16*)(ws + WS_RKV) + (size_t)2 * T * D; const float* RKB = (const float*)(ws + WS_RKB); const float* RKB1 = (const float*)(ws + WS_RKB1); const bf16* Gg = (const bf16*)(ws + WS_G); bf16* Z = (bf16*)(ws + WS_Z);
    const float* lng = a.in[21] + lj * 1024; const float* lnb = a.in[22] + lj * 1024;
    LAS float* lnt = (LAS float*)lds;
    ((LAS f32x4*)lnt)[tid] = tid < 256 ? ((const f32x4*)lng)[tid] : ((const f32x4*)lnb)[tid - 256];
    __syncthreads();
    const int l15 = lane & 15, g = lane >> 4, ntask = (TL / 64) * 16;
    for (int task = gw; task < ntask; task += NGW) {
        const int blk = task >> 4, h = task & 15, r0 = blk * 64;
        int b, cc[2];
        if (r0 < TL) { b = r0 >> 13; const int tb = (r0 & (SEQ - 1)) >> 6; cc[0] = 4 + tb; cc[1] = 4 + (127 - tb); }
        else { const int loc = r0 - TL; b = loc >> 8; const int tb = (loc & 255) >> 6; cc[0] = tb; cc[1] = 3 - tb; }
        S3T A, B;
        s3_tile_load(A, YL, RH, Vv, Gg, RKB, RKB1, r0 + l15, h, g);
        u32x4 hh[2][4][2];
#pragma unroll
        for (int dir = 0; dir < 2; ++dir) { const bf16* hc = HT + ((size_t)(dir * 64 + b * 16 + h) * NCHUNK + cc[dir]) * 4096;
#pragma unroll
            for (int vt = 0; vt < 4; ++vt) { const bf16* hr = hc + ((vt * 2) * 64 + g * 16 + l15) * 8; hh[dir][vt][0] = *(const u32x4*)(hr); hh[dir][vt][1] = *(const u32x4*)(hr + 512); } }
        s3_tile_load(B, YL, RH, Vv, Gg, RKB, RKB1, r0 + 16 + l15, h, g);
        __builtin_amdgcn_sched_barrier(0);
        s3_tile_finish(A, hh, lnt, Z, r0 + l15, h, g);
        __builtin_amdgcn_sched_barrier(0);
        s3_tile_load(A, YL, RH, Vv, Gg, RKB, RKB1, r0 + 32 + l15, h, g);
        __builtin_amdgcn_sched_barrier(0);
        s3_tile_finish(B, hh, lnt, Z, r0 + 16 + l15, h, g);
        __builtin_amdgcn_sched_barrier(0);
        s3_tile_load(B, YL, RH, Vv, Gg, RKB, RKB1, r0 + 48 + l15, h, g);
        __builtin_amdgcn_sched_barrier(0);
        s3_tile_finish(A, hh, lnt, Z, r0 + 32 + l15, h, g);
        __builtin_amdgcn_sched_barrier(0);
        s3_tile_finish(B, hh, lnt, Z, r0 + 48 + l15, h, g);
    }
    if (nrows > TL) for (int c = gw; c < (TC / 16) * 16; c += NGW) {
        const int tt = c >> 4, h = c & 15, r0 = TL + tt * 16, loc = tt * 16, b = loc >> 8, tb = (loc & 255) >> 6;
        const int cc[2] = {tb, 3 - tb};
        S3T A;
        s3_tile_load(A, YL, RH, Vv, Gg, RKB, RKB1, r0 + l15, h, g);
        u32x4 hh[2][4][2];
#pragma unroll
        for (int dir = 0; dir < 2; ++dir) { const bf16* hc = HT + ((size_t)(dir * 64 + b * 16 + h) * NCHUNK + cc[dir]) * 4096;
#pragma unroll
            for (int vt = 0; vt < 4; ++vt) { const bf16* hr = hc + ((vt * 2) * 64 + g * 16 + l15) * 8; hh[dir][vt][0] = *(const u32x4*)(hr); hh[dir][vt][1] = *(const u32x4*)(hr + 512); } }
        s3_tile_finish(A, hh, lnt, Z, r0 + l15, h, g);
    }
}
__device__ __forceinline__ void phase_cv(const Args& a, int lc, int rows, int gw, int NGW, int lane) {
    unsigned char* ws = a.ws;
    const bf16* BG = (const bf16*)(ws + WS_BG); const bf16* CU = (const bf16*)(ws + WS_CUZ); bf16* Z = (bf16*)(ws + WS_Z);
    const float* cw = a.in[25] + (size_t)lc * 3 * 1024;
    for (int t = gw; t < rows; t += NGW) {
        int rs, re; if (t < TL) { rs = t & ~63; re = rs + 63; } else { const int loc = t - TL; rs = TL + (loc & ~255); re = rs + 255; }
        const bool hp = t > rs, hn = t < re;
        u32x2 zc4[4], bg4[4], zp4[4], zn4[4]; f32x4 w04[4], w14[4], w24[4];
#pragma unroll
        for (int j = 0; j < 4; ++j) { const int col = 256 * j + 4 * lane; const size_t o = (size_t)t * D + col;
            zc4[j] = *(const u32x2*)(CU + o); bg4[j] = *(const u32x2*)(BG + o);
            zp4[j] = hp ? *(const u32x2*)(CU + o - D) : (u32x2){0u, 0u}; zn4[j] = hn ? *(const u32x2*)(CU + o + D) : (u32x2){0u, 0u};
            w04[j] = *(const f32x4*)(cw + col); w14[j] = *(const f32x4*)(cw + 1024 + col); w24[j] = *(const f32x4*)(cw + 2048 + col); }
#pragma unroll
        for (int j = 0; j < 4; ++j) { const int col = 256 * j + 4 * lane; const size_t o = (size_t)t * D + col;
            const u32x2 zc = zc4[j], bg = bg4[j], zp = zp4[j], zn = zn4[j];
            const f32x4 w0 = w04[j], w1 = w14[j], w2 = w24[j];
            const f32x4 zv = (f32x4){bflo(zc.x), bfhi(zc.x), bflo(zc.y), bfhi(zc.y)}, pv = (f32x4){bflo(zp.x), bfhi(zp.x), bflo(zp.y), bfhi(zp.y)}, nv = (f32x4){bflo(zn.x), bfhi(zn.x), bflo(zn.y), bfhi(zn.y)};
            const f32x4 bv = (f32x4){bflo(bg.x), bfhi(bg.x), bflo(bg.y), bfhi(bg.y)};
            const f32x4 r = bv * (w0 * pv + w1 * zv + w2 * nv);
            u32x2 w; w.x = pk2(r.x, r.y); w.y = pk2(r.z, r.w); *(u32x2*)(Z + o) = w; }
    }
}
typedef float f32x2v __attribute__((ext_vector_type(2)));
__device__ __forceinline__ float lane_bcast(float v, int srclane) { return __builtin_bit_cast(float, __builtin_amdgcn_readlane(__builtin_bit_cast(int, v), srclane)); }
__device__ __forceinline__ void phase_e_route(const Args& a, int layer, int rows, LAS unsigned char* lds, int tid, int gw, int NGW, int lane, int probe_rep = 0) {
    unsigned char* ws = a.ws;
    const float* xs = (const float*)(ws + (layer < 2 ? WS_XSA : WS_XSB));
    const float* MODS = (const float*)(ws + WS_MODS); bf16* H2 = (bf16*)(ws + WS_H2);
    const float* ng = a.in[6] + (size_t)(layer * 2 + 1) * 1024;
    const float* rw = a.in[27] + (size_t)layer * 1024 * 32; const float* rb = a.in[28] + layer * 32;
    unsigned* cnt = (unsigned*)(ws + WS_CTL) + CW_CNT + (layer + 4 * probe_rep) * 32 * CNT_STRIDE;
    int* SLOTL = (int*)(ws + (probe_rep ? WS_L1 : WS_SLOTL)); float* GATEL = (float*)(ws + (probe_rep ? WS_L1 + 8 * MiB : WS_GATEL));
    LAS float* wt = (LAS float*)lds;
    LAS int* hist = (LAS int*)(lds + LDSCTL_OFF + 3072); LAS int* base = hist + 32; LAS int* lcnt = hist + 64;
    int* TKE = (int*)(ws + WS_C12); float* TKG = (float*)(ws + WS_C12 + 4 * MiB);
    for (int i = tid; i < 32768; i += 512) wt[(i & 31) * 1024 + (i >> 5)] = rw[i];
    if (tid < 32) hist[tid] = 0;
    __syncthreads();
    const int my_e = lane >> 1; const float my_b = rb[my_e];
    const bool b5 = (lane & 32) != 0, b4 = (lane & 16) != 0, b3 = (lane & 8) != 0, b2 = (lane & 4) != 0, b1 = (lane & 2) != 0;
    for (int t = gw; t < rows; t += NGW) {
        const int mr = mod_row(t);
        const float* mod = MODS + (size_t)(layer * 5 + mr) * 6144;
        f32x4 x[4];
#pragma unroll
        for (int j = 0; j < 4; ++j) x[j] = *(const f32x4*)(xs + (size_t)t * D + 256 * j + 4 * lane);
        const float rstd = row_rstd(x);
#pragma unroll
        for (int j = 0; j < 4; ++j) { const int col = 256 * j + 4 * lane;
            x[j] = x[j] * rstd * *(const f32x4*)(ng + col) * (*(const f32x4*)(mod + 4 * 1024 + col) + 1.0f) + *(const f32x4*)(mod + 3 * 1024 + col);
            u32x2 w; w.x = pk2(x[j].x, x[j].y); w.y = pk2(x[j].z, x[j].w); *(u32x2*)(H2 + (size_t)t * D + col) = w; }
        float p[32];
#pragma unroll
        for (int eg = 0; eg < 8; ++eg) {
#pragma unroll
            for (int ee = 0; ee < 4; ++ee) { const int e = eg * 4 + ee; f32x2v s2 = (f32x2v){0.f, 0.f};
#pragma unroll
                for (int j = 0; j < 4; ++j) { const f32x4 wv = *(const LAS f32x4*)(wt + e * 1024 + 256 * j + 4 * lane);
                    s2 = __builtin_elementwise_fma((f32x2v){x[j].x, x[j].y}, (f32x2v){wv.x, wv.y}, s2); s2 = __builtin_elementwise_fma((f32x2v){x[j].z, x[j].w}, (f32x2v){wv.z, wv.w}, s2); }
                p[e] = s2.x + s2.y; }
            asm volatile("" ::: "memory");
        }
        float q16[16];
#pragma unroll
        for (int i = 0; i < 16; ++i) { const float send = b5 ? p[i] : p[i + 16]; const float keep = b5 ? p[i + 16] : p[i]; q16[i] = keep + __shfl_xor(send, 32); }
        float q8[8];
#pragma unroll
        for (int i = 0; i < 8; ++i) { const float send = b4 ? q16[i] : q16[i + 8]; const float keep = b4 ? q16[i + 8] : q16[i]; q8[i] = keep + __shfl_xor(send, 16); }
        float q4[4];
#pragma unroll
        for (int i = 0; i < 4; ++i) { const float send = b3 ? q8[i] : q8[i + 4]; const float keep = b3 ? q8[i + 4] : q8[i]; q4[i] = keep + __shfl_xor(send, 8); }
        float q2[2];
#pragma unroll
        for (int i = 0; i < 2; ++i) { const float send = b2 ? q4[i] : q4[i + 2]; const float keep = b2 ? q4[i + 2] : q4[i]; q2[i] = keep + __shfl_xor(send, 4); }
        float q1; { const float send = b1 ? q2[0] : q2[1]; const float keep = b1 ? q2[1] : q2[0]; q1 = keep + __shfl_xor(send, 2); }
        const float lg = q1 + __shfl_xor(q1, 1) + my_b;
        int rank = 0;
#pragma unroll 1
        for (int e = 0; e < 32; ++e) { const float o = lane_bcast(lg, 2 * e); rank += (o > lg || (o == lg && e < my_e)) ? 1 : 0; }
        const bool sel = rank < 4 && !(lane & 1);
        const unsigned long long m0 = __ballot(sel && rank == 0), m1 = __ballot(sel && rank == 1), m2 = __ballot(sel && rank == 2), m3 = __ballot(sel && rank == 3);
        const float v0 = lane_bcast(lg, (int)__builtin_ctzll(m0)), v1 = lane_bcast(lg, (int)__builtin_ctzll(m1)), v2 = lane_bcast(lg, (int)__builtin_ctzll(m2)), v3 = lane_bcast(lg, (int)__builtin_ctzll(m3));
        const float e1 = __expf(v1 - v0), e2 = __expf(v2 - v0), e3 = __expf(v3 - v0);
        const float inv = frcp(1.0f + e1 + e2 + e3);
        if (sel) {
            TKE[t * 4 + rank] = my_e; TKG[t * 4 + rank] = __expf(lg - v0) * inv;
            __hip_atomic_fetch_add(hist + my_e, 1, __ATOMIC_RELAXED, __HIP_MEMORY_SCOPE_WORKGROUP);
        }
    }
    asm volatile("s_waitcnt vmcnt(0) lgkmcnt(0)" ::: "memory"); __syncthreads();
    if (tid < 32) { base[tid] = (int)atomicAdd(cnt + tid * CNT_STRIDE, (unsigned)hist[tid]); lcnt[tid] = 0; }
    __syncthreads();
    for (int t = gw; t < rows; t += NGW) {
        if (lane < 4) { const int e = TKE[t * 4 + lane]; const float gk = TKG[t * 4 + lane];
            const int pos = base[e] + __hip_atomic_fetch_add(lcnt + e, 1, __ATOMIC_RELAXED, __HIP_MEMORY_SCOPE_WORKGROUP);
            SLOTL[(size_t)e * T + pos] = t * 4 + lane; GATEL[(size_t)e * T + pos] = gk; }
    }
}
__device__ __forceinline__ int okey(float v, int e) { const int i = __builtin_bit_cast(int, v); const int o = i ^ ((i >> 31) & 0x7fffffff); return (o & ~31) | (31 - e); }
__device__ __forceinline__ void phase_e_route_mfma(const Args& a, int layer, int rows, LAS unsigned char* lds, int tid, int wave, int gw, int NGW, int lane, int probe_rep = 0) {
    unsigned char* ws = a.ws;
    const float* xs = (const float*)(ws + (layer < 2 ? WS_XSA : WS_XSB));
    const float* MODS = (const float*)(ws + WS_MODS); bf16* H2 = (bf16*)(ws + WS_H2);
    const float* ng = a.in[6] + (size_t)(layer * 2 + 1) * 1024; const float* rb = a.in[28] + layer * 32;
    const bf16* WRT = (const bf16*)(ws + WS_WRT) + (size_t)layer * 2 * 32 * 1024;
    unsigned* cnt = (unsigned*)(ws + WS_CTL) + CW_CNT + (layer + 4 * probe_rep) * 32 * CNT_STRIDE;
    int* SLOTL = (int*)(ws + (probe_rep ? WS_L1 : WS_SLOTL)); float* GATEL = (float*)(ws + (probe_rep ? WS_L1 + 8 * MiB : WS_GATEL));
    LAS int* hist = (LAS int*)(lds + LDSCTL_OFF + 3072); LAS int* base = hist + 32; LAS int* lcnt = hist + 64;
    int* TKE = (int*)(ws + WS_C12); float* TKG = (float*)(ws + WS_C12 + 4 * MiB);
    LAS unsigned char* tile = lds + wave * 8448;
    if (tid < 32) hist[tid] = 0;
    constexpr int E_TAB = 8 * 8448, E_TP = 2064;
    static_assert(E_TAB + 32 * E_TP <= LDSCTL_OFF, "router table");
    { u32x4 tw[8];
#pragma unroll
      for (int q = 0; q < 8; ++q) { const int i = tid + q * 512, r = i >> 7, pc = i & 127; tw[q] = *(const u32x4*)(WRT + (size_t)r * 1024 + pc * 8); }
#pragma unroll
      for (int q = 0; q < 8; ++q) { const int i = tid + q * 512, r = i >> 7, pc = i & 127; *(LAS u32x4*)(lds + E_TAB + r * E_TP + pc * 16) = tw[q]; } }
    __syncthreads();
    const int l15 = lane & 15, g = lane >> 4;
    const int nlat = TL / 16, nctx = rows > TL ? TC / 4 : 0, G_ = NGW / 8;
    for (int it = 0;; ++it) {
        int t0, ntok;
        { const int tl = gw + it * NGW; const int xi = (int)blockIdx.x + (it - (nlat + NGW - 1) / NGW) * G_ * 8 + wave * G_;
          if (tl < nlat) { t0 = tl * 16; ntok = 16; } else if (it >= (nlat + NGW - 1) / NGW && xi < nctx) { t0 = TL + xi * 4; ntok = 4; } else if (it >= (nlat + NGW - 1) / NGW) break; else continue; }
        const float* mod = MODS + (size_t)(layer * 5 + mod_row(t0)) * 6144;
        float rstd[16];
#pragma unroll
        for (int tb = 0; tb < 16; tb += 8) {
            f32x4 xa[8][4];
#pragma unroll
            for (int t = 0; t < 8; ++t) { const int tr = tb + t < ntok ? t0 + tb + t : t0;
#pragma unroll
                for (int j = 0; j < 4; ++j) xa[t][j] = *(const f32x4*)(xs + (size_t)tr * D + 256 * j + 4 * lane); }
#pragma unroll
            for (int t = 0; t < 8; ++t) rstd[tb + t] = __builtin_bit_cast(float, __builtin_amdgcn_readfirstlane(__builtin_bit_cast(int, row_rstd(xa[t]))));
            asm volatile("" ::: "memory"); }
        f32x4 acc[2]; acc[0] = (f32x4){0.f, 0.f, 0.f, 0.f}; acc[1] = acc[0];
#pragma unroll 1
        for (int s = 0; s < 4; ++s) {
            const int col = 256 * s + 4 * lane;
            int t0s = t0; asm volatile("" : "+s"(t0s));
            const bf16* wl = WRT + (size_t)(32 + l15) * 1024 + 256 * s + 8 * g;
            u32x4 wlf[8][2];
#pragma unroll
            for (int ks = 0; ks < 8; ++ks)
#pragma unroll
                for (int et = 0; et < 2; ++et) wlf[ks][et] = *(const u32x4*)(wl + (size_t)et * 16 * 1024 + 32 * ks);
            const f32x4 g4 = *(const f32x4*)(ng + col) * (*(const f32x4*)(mod + 4 * 1024 + col) + 1.0f), s4 = *(const f32x4*)(mod + 3 * 1024 + col);
            u32x2 lo[16];
#pragma unroll
            for (int tb = 0; tb < 16; tb += 8) {
                f32x4 xr[8];
#pragma unroll
                for (int t = 0; t < 8; ++t) { const int tr = tb + t < ntok ? t0s + tb + t : t0s; xr[t] = *(const f32x4*)(xs + (size_t)tr * D + col); }
#pragma unroll
                for (int t = 0; t < 8; ++t) { const int tr = tb + t < ntok ? t0s + tb + t : t0s; const f32x4 hv = xr[t] * rstd[tb + t] * g4 + s4;
                    const u32x2 w = pk4(hv); if (tb + t < ntok) *(u32x2*)(H2 + (size_t)tr * D + col) = w;
                    *(LAS u32x2*)(tile + (tb + t) * 528 + lane * 8) = w; lo[tb + t] = pk4(hv - bf4(w)); } }
            LDS_WAIT(); asm volatile("" ::: "memory");
            const LAS unsigned char* th = lds + E_TAB + l15 * E_TP + (256 * s + 8 * g) * 2;
#pragma unroll
            for (int ks = 0; ks < 8; ++ks) { const bf16x8 fb = as_frag(*(const LAS u32x4*)(tile + l15 * 528 + ks * 64 + g * 16));
#pragma unroll
                for (int et = 0; et < 2; ++et) { acc[et] = mfma16(as_frag(*(const LAS u32x4*)(th + et * 16 * E_TP + 64 * ks)), fb, acc[et]);
                    acc[et] = mfma16(as_frag(wlf[ks][et]), fb, acc[et]); } }
            LDS_WAIT(); asm volatile("" ::: "memory");
#pragma unroll
            for (int t = 0; t < 16; ++t) *(LAS u32x2*)(tile + t * 528 + lane * 8) = lo[t];
            LDS_WAIT(); asm volatile("" ::: "memory");
#pragma unroll
            for (int ks = 0; ks < 8; ++ks) { const bf16x8 fb = as_frag(*(const LAS u32x4*)(tile + l15 * 528 + ks * 64 + g * 16));
#pragma unroll
                for (int et = 0; et < 2; ++et) acc[et] = mfma16(as_frag(*(const LAS u32x4*)(th + et * 16 * E_TP + 64 * ks)), fb, acc[et]); }
            LDS_WAIT(); asm volatile("" ::: "memory");
        }
        float v[8]; int key[8];
#pragma unroll
        for (int j = 0; j < 8; ++j) { const int e = (j < 4 ? 0 : 16) + 4 * g + (j & 3); v[j] = acc[j >> 2][j & 3] + rb[e]; key[j] = okey(v[j], e); }
        int kb[8], kc[8], kd2[8];
#pragma unroll
        for (int j = 0; j < 8; ++j) kb[j] = __shfl_xor(key[j], 16);
#pragma unroll
        for (int j = 0; j < 8; ++j) { kc[j] = __shfl_xor(key[j], 32); kd2[j] = __shfl_xor(kb[j], 32); }
        float vmax = fmaxf(fmaxf(fmaxf(v[0], v[1]), fmaxf(v[2], v[3])), fmaxf(fmaxf(v[4], v[5]), fmaxf(v[6], v[7])));
        vmax = fmaxf(vmax, __shfl_xor(vmax, 16)); vmax = fmaxf(vmax, __shfl_xor(vmax, 32));
        int rank[8]; float ex[8], part = 0.f;
#pragma unroll
        for (int j = 0; j < 8; ++j) { int r = 0;
#pragma unroll
            for (int q = 0; q < 8; ++q) r += (key[q] > key[j]) + (kb[q] > key[j]) + (kc[q] > key[j]) + (kd2[q] > key[j]);
            rank[j] = r; ex[j] = __expf(v[j] - vmax); part += r < 4 ? ex[j] : 0.f; }
        part += __shfl_xor(part, 16); part += __shfl_xor(part, 32);
        const float inv = frcp(part); const int t = t0 + l15;
#pragma unroll
        for (int j = 0; j < 8; ++j) if (rank[j] < 4 && l15 < ntok) { const int e = (j < 4 ? 0 : 16) + 4 * g + (j & 3);
            TKE[t * 4 + rank[j]] = e; TKG[t * 4 + rank[j]] = ex[j] * inv;
            __hip_atomic_fetch_add(hist + e, 1, __ATOMIC_RELAXED, __HIP_MEMORY_SCOPE_WORKGROUP); }
    }
    asm volatile("s_waitcnt vmcnt(0) lgkmcnt(0)" ::: "memory"); __syncthreads();
    if (tid < 32) { base[tid] = (int)atomicAdd(cnt + tid * CNT_STRIDE, (unsigned)hist[tid]); lcnt[tid] = 0; }
    __syncthreads();
    for (int it = 0;; ++it) {
        int t0, ntok;
        { const int tl = gw + it * NGW; const int xi = (int)blockIdx.x + (it - (nlat + NGW - 1) / NGW) * G_ * 8 + wave * G_;
          if (tl < nlat) { t0 = tl * 16; ntok = 16; } else if (it >= (nlat + NGW - 1) / NGW && xi < nctx) { t0 = TL + xi * 4; ntok = 4; } else if (it >= (nlat + NGW - 1) / NGW) break; else continue; }
        if ((lane >> 2) < ntok) { const int t = t0 + (lane >> 2), k = lane & 3;
            const int e = TKE[t * 4 + k]; const float gk = TKG[t * 4 + k];
            const int pos = base[e] + __hip_atomic_fetch_add(lcnt + e, 1, __ATOMIC_RELAXED, __HIP_MEMORY_SCOPE_WORKGROUP);
            SLOTL[(size_t)e * T + pos] = t * 4 + k; GATEL[(size_t)e * T + pos] = gk; }
    }
}
__device__ __forceinline__ void phase_final(const Args& a, int gw, int NGW, int lane) {
    unsigned char* ws = a.ws;
    const float* xs = (const float*)(ws + WS_XSB); const float* MODS = (const float*)(ws + WS_MODS); const bf16* YS = (const bf16*)(ws + WS_YS);
    for (int t = gw; t < TL; t += NGW) {
        const int mr = t >> 13;
        f32x4 m5[4], x[4];
#pragma unroll
        for (int j = 0; j < 4; ++j) m5[j] = *(const f32x4*)(MODS + (size_t)(3 * 5 + mr) * 6144 + 5 * 1024 + 256 * j + 4 * lane);
        f32x4 fg[4];
#pragma unroll
        for (int j = 0; j < 4; ++j) fg[j] = *(const f32x4*)(a.in[7] + 256 * j + 4 * lane);
        load_x_combined(x, xs + (size_t)t * D, true, YS, t, m5, lane);
        const float rstd = row_rstd(x);
#pragma unroll
        for (int j = 0; j < 4; ++j) { const int col = 256 * j + 4 * lane; *(f32x4*)(a.out + (size_t)t * D + col) = x[j] * rstd * fg[j]; }
    }
}

using pg8::Unit; using pg8::tile_map;
struct SchedStd {
    int G, c, nM, nN;
    __device__ __forceinline__ bool next(int i, Unit& u) const { const long L = (long)i * G + c; if (L >= (long)nM * nN) return false; int pm, pn; tile_map((int)L, nM, nN, pm, pn); u.pm = pm; u.pn = pn; u.e = 0; u.nv = pm; u.par = 0; return true; }
    __device__ __forceinline__ void a_ready(const Unit&) const {}
    __device__ __forceinline__ void done(const Unit&) const {}
    __device__ __forceinline__ unsigned row_off(const Unit&, int) const { return 0u; }
    __device__ __forceinline__ unsigned row_off_lds(const Unit&, int) const { return 0u; }
    __device__ __forceinline__ void prefetch_rows(const Unit&) const {}
};
struct SchedB1 {
    int G, c;
    __device__ __forceinline__ bool next(int i, Unit& u) const { const long L = (long)i * G + c; constexpr int n1 = 3 * NMT * 4; if (L >= n1 + 3 * NMT) return false; const int l = (int)L;
        if (l < n1) { const int j = l / (NMT * 4), r = l % (NMT * 4); int pm, pn; tile_map(r, NMT, 4, pm, pn); u.pm = j * NMT + pm; u.pn = j * 4 + pn; u.e = j; u.nv = pm; }
        else { const int r = l - n1, j = r / NMT, pm = r % NMT; u.pm = (3 + j) * NMT + pm; u.pn = 12 + j; u.e = 3 + j; u.nv = pm; }
        u.par = 0; return true; }
    __device__ __forceinline__ void a_ready(const Unit&) const {}
    __device__ __forceinline__ void done(const Unit&) const {}
    __device__ __forceinline__ unsigned row_off(const Unit&, int) const { return 0u; }
    __device__ __forceinline__ unsigned row_off_lds(const Unit&, int) const { return 0u; }
    __device__ __forceinline__ void prefetch_rows(const Unit&) const {}
};
struct SchedB2 {
    int G, c;
    __device__ __forceinline__ bool next(int i, Unit& u) const { const long L = (long)i * G + c; constexpr int n1 = 2 * NMT * 8; if (L >= n1 + NMT * 4) return false; const int l = (int)L;
        if (l < n1) { const int j = l / (NMT * 8), r = l % (NMT * 8); int pm, pn; tile_map(r, NMT, 8, pm, pn); u.pm = j * NMT + pm; u.pn = j * 8 + pn; u.e = j; u.nv = pm; }
        else { const int r = l - n1; int pm, pn; tile_map(r, NMT, 4, pm, pn); u.pm = 2 * NMT + pm; u.pn = 16 + pn; u.e = 2; u.nv = pm; }
        u.par = 0; return true; }
    __device__ __forceinline__ void a_ready(const Unit&) const {}
    __device__ __forceinline__ void done(const Unit&) const {}
    __device__ __forceinline__ unsigned row_off(const Unit&, int) const { return 0u; }
    __device__ __forceinline__ unsigned row_off_lds(const Unit&, int) const { return 0u; }
    __device__ __forceinline__ void prefetch_rows(const Unit&) const {}
};
struct SchedMoe {
    int G, c, nnt, ntiles, P; LAS unsigned char* lds; const int* slotl; const float* gatel; int wave;
    __device__ __forceinline__ bool next(int i, Unit& u) const { const long L = (long)i * G + c; const int ntp = (ntiles + P - 1) / P, ppg = nnt / (8 / P); if (L >= (long)ntp * ppg * 8) return false;
        const LAS int* tpre = (const LAS int*)(lds + LDSCTL_OFF + 64); const LAS int* ecnt = (const LAS int*)(lds + LDSCTL_OFF + 256); const LAS unsigned short* tile_e = (const LAS unsigned short*)(lds + LDSCTL_OFF + 512);
        const int xq = (int)(L >> 3), x8 = (int)(L & 7); int tile = (xq / ppg) * P + (x8 % P); const int pnl = (x8 / P) * ppg + xq % ppg; const bool dead = tile >= ntiles; tile = dead ? 0 : tile;
        const int e = __builtin_amdgcn_readfirstlane((int)tile_e[tile]), r0 = (tile - __builtin_amdgcn_readfirstlane(tpre[e])) * 256; int nv = __builtin_amdgcn_readfirstlane(ecnt[e]) - r0; nv = nv > 256 ? 256 : nv; nv = dead ? 0 : nv;
        u.pm = dead ? MAXTILES : tile; u.pn = e * nnt + pnl; u.e = e; u.nv = nv | (r0 << 9); u.par = i & 1; return true; }
    __device__ __forceinline__ void a_ready(const Unit& u) const {
        if (gatel != nullptr && wave == 0) { const size_t li = (size_t)u.e * T + (u.nv >> 9) + 4 * lane_id();
            __builtin_amdgcn_global_load_lds((const unsigned*)(slotl + li), (LAS unsigned*)(lds + LDSCTL_OFF + 8192 + 2048 * u.par), 16, 0, 0);
            __builtin_amdgcn_global_load_lds((const unsigned*)(gatel + li), (LAS unsigned*)(lds + LDSCTL_OFF + 8192 + 2048 * u.par + 1024), 16, 0, 0); } }
    __device__ __forceinline__ void done(const Unit&) const {}
    __device__ __forceinline__ void prefetch_rows(const Unit& u) const {
        if (wave == 0) __builtin_amdgcn_global_load_lds((const unsigned*)(slotl + (size_t)u.e * T + (u.nv >> 9) + 4 * lane_id()), (LAS unsigned*)(lds + LDSCTL_OFF + 8192 + 2048 * u.par), 16, 0, 0); }
    __device__ __forceinline__ unsigned row_off_lds(const Unit& u, int r) const { const int nv = u.nv & 511; const int sl = ((const LAS int*)(lds + LDSCTL_OFF + 8192 + 2048 * u.par))[r]; const int tok = r < nv ? (sl >> 2) : 0; return (unsigned)tok * 2048u; }
    __device__ __forceinline__ unsigned row_off(const Unit& u, int r) const { const int nv = u.nv & 511, r0 = u.nv >> 9; const int tok = r < nv ? (slotl[(size_t)u.e * T + r0 + r] >> 2) : 0; return (unsigned)tok * 2048u; }
};

using pg8::cvt_pk_bf16;
template <class P> __device__ __forceinline__ P* pin_ptr(P* p) { asm volatile("" : "+v"(p)); return p; }
struct EpiB1 {
    static constexpr bool PERM = true, AFTER_DRAIN = false;
    bf16* RKV; bf16* L1;
    __device__ __forceinline__ void operator()(const f32x4 (&acc)[2][2][4][2], const Unit& u, int wr, int wc, int fr, int fq) const {
        const int seg = u.e, row0 = u.nv * 256 + wr * 64 + fr;
        const int jj = seg - 3, ld = seg < 3 ? D : 128, col0 = (seg < 3 ? (u.pn - seg * 4) * 256 : 0) + wc * 32 + 8 * fq;
        bf16* base = seg < 3 ? RKV + (size_t)seg * T * D : L1 + (size_t)jj * T * 128;
#pragma unroll
        for (int ai = 0; ai < 2; ++ai)
#pragma unroll
            for (int m = 0; m < 4; ++m) { bf16* rowp = base + (size_t)(row0 + ai * 128 + m * 16) * ld + col0;
#pragma unroll
                for (int bj = 0; bj < 2; ++bj) { if (seg >= 3 && bj == 1) continue; f32x4 v0 = acc[ai][bj][m][0], v1 = acc[ai][bj][m][1];
                    if (jj == 0) {
#pragma unroll
                        for (int q = 0; q < 4; ++q) { v0[q] = tanh_fast(v0[q]); v1[q] = tanh_fast(v1[q]); } }
                    else if (jj == 2) {
#pragma unroll
                        for (int q = 0; q < 4; ++q) { v0[q] = sigm(v0[q]); v1[q] = sigm(v1[q]); } }
                    u32x4 w; w.x = cvt_pk_bf16(v0[0], v0[1]); w.y = cvt_pk_bf16(v0[2], v0[3]); w.z = cvt_pk_bf16(v1[0], v1[1]); w.w = cvt_pk_bf16(v1[2], v1[3]);
                    *(u32x4*)(rowp + bj * 128) = w; } }
    }
};
struct EpiB2 {
    static constexpr bool PERM = true, AFTER_DRAIN = false;
    bf16* RW; bf16* RA; bf16* Gg;
    __device__ __forceinline__ void operator()(const f32x4 (&acc)[2][2][4][2], const Unit& u, int wr, int wc, int fr, int fq) const {
        const int jj = u.e, row0 = u.nv * 256 + wr * 64 + fr, pnl = u.pn - jj * 8;
        const int dirn = jj < 2 ? (pnl >> 2) : 0, col0 = (jj < 2 ? (pnl & 3) : pnl) * 256 + wc * 32 + 8 * fq;
        bf16* base = (jj == 0 ? RW : jj == 1 ? RA : Gg) + (size_t)dirn * T * D;
#pragma unroll
        for (int ai = 0; ai < 2; ++ai)
#pragma unroll
            for (int m = 0; m < 4; ++m) { bf16* rowp = base + (size_t)(row0 + ai * 128 + m * 16) * D + col0;
#pragma unroll
                for (int bj = 0; bj < 2; ++bj) { const f32x4 v0 = acc[ai][bj][m][0], v1 = acc[ai][bj][m][1];
                    u32x4 w; w.x = cvt_pk_bf16(v0[0], v0[1]); w.y = cvt_pk_bf16(v0[2], v0[3]); w.z = cvt_pk_bf16(v1[0], v1[1]); w.w = cvt_pk_bf16(v1[2], v1[3]);
                    *(u32x4*)(rowp + bj * 128) = w; } }
    }
};
struct EpiRes {
    static constexpr bool PERM = true, AFTER_DRAIN = false;
    float* X; const float* gate; float* Xo;
    __device__ __forceinline__ void operator()(const f32x4 (&acc)[2][2][4][2], const Unit& u, int wr, int wc, int fr, int fq) const {
        const int row0 = u.pm * 256 + wr * 64 + fr, col0 = u.pn * 256 + wc * 32 + 8 * fq, mr = u.pm < NMT_L ? (u.pm >> 5) : 4;
        const float* gp = pin_ptr(gate + (size_t)mr * 6144 + col0);
        f32x4 gv[2][2];
#pragma unroll
        for (int bj = 0; bj < 2; ++bj)
#pragma unroll
            for (int n = 0; n < 2; ++n) gv[bj][n] = *(const f32x4*)(gp + bj * 128 + 4 * n);
        f32x4 xa[2][2][2], xb[2][2][2];
#define ER_LOAD(dst, b_) do { _Pragma("unroll") for (int m = 0; m < 2; ++m) _Pragma("unroll") for (int bj = 0; bj < 2; ++bj) _Pragma("unroll") for (int n = 0; n < 2; ++n) \
            dst[m][bj][n] = *(const f32x4*)(X + (size_t)(row0 + ((b_) >> 1) * 128 + (((b_) & 1) * 2 + m) * 16) * D + col0 + bj * 128 + 4 * n); } while (0)
#define ER_STORE(src, b_) do { _Pragma("unroll") for (int m = 0; m < 2; ++m) _Pragma("unroll") for (int bj = 0; bj < 2; ++bj) _Pragma("unroll") for (int n = 0; n < 2; ++n) \
            *(f32x4*)(Xo + (size_t)(row0 + ((b_) >> 1) * 128 + (((b_) & 1) * 2 + m) * 16) * D + col0 + bj * 128 + 4 * n) = src[m][bj][n] + gv[bj][n] * acc[(b_) >> 1][bj][((b_) & 1) * 2 + m][n]; } while (0)
        ER_LOAD(xa, 0); ER_LOAD(xb, 1); ER_STORE(xa, 0); ER_LOAD(xa, 2); ER_STORE(xb, 1); ER_LOAD(xb, 3); ER_STORE(xa, 2); ER_STORE(xb, 3);
#undef ER_LOAD
#undef ER_STORE
    }
};
struct EpiWin {
    static constexpr bool PERM = true, AFTER_DRAIN = false;
    bf16* BG; bf16* CU;
    __device__ __forceinline__ void operator()(const f32x4 (&acc)[2][2][4][2], const Unit& u, int wr, int wc, int fr, int fq) const {
        const int row0 = u.pm * 256 + wr * 64 + fr;
        if (u.pn < 4) {
            const int col0 = u.pn * 256 + wc * 32 + 8 * fq;
#pragma unroll
            for (int ai = 0; ai < 2; ++ai)
#pragma unroll
                for (int m = 0; m < 4; ++m) { bf16* rowp = BG + (size_t)(row0 + ai * 128 + m * 16) * D + col0;
#pragma unroll
                    for (int bj = 0; bj < 2; ++bj) { const f32x4 v0 = acc[ai][bj][m][0], v1 = acc[ai][bj][m][1];
                        u32x4 w; w.x = cvt_pk_bf16(v0[0], v0[1]); w.y = cvt_pk_bf16(v0[2], v0[3]); w.z = cvt_pk_bf16(v1[0], v1[1]); w.w = cvt_pk_bf16(v1[2], v1[3]);
                        *(u32x4*)(rowp + bj * 128) = w; } }
        } else {
            const int f0 = (u.pn - 4) * 128 + wc * 32 + 8 * fq;
#pragma unroll
            for (int ai = 0; ai < 2; ++ai)
#pragma unroll
                for (int m = 0; m < 4; ++m) { const f32x4 v0 = acc[ai][0][m][0] * acc[ai][1][m][0], v1 = acc[ai][0][m][1] * acc[ai][1][m][1];
                    u32x4 w; w.x = cvt_pk_bf16(v0[0], v0[1]); w.y = cvt_pk_bf16(v0[2], v0[3]); w.z = cvt_pk_bf16(v1[0], v1[1]); w.w = cvt_pk_bf16(v1[2], v1[3]);
                    *(u32x4*)(CU + (size_t)(row0 + ai * 128 + m * 16) * D + f0) = w; }
        }
    }
};
struct EpiGU {
    static constexpr bool PERM = true, AFTER_DRAIN = false;
    bf16* INTER; const float* bgu;
    __device__ __forceinline__ void operator()(const f32x4 (&acc)[2][2][4][2], const Unit& u, int wr, int wc, int fr, int fq) const {
        const int e = u.e, pnl = u.pn - e * 8, row0 = u.pm * 256 + wr * 64 + fr, f0 = pnl * 128 + wc * 32 + 8 * fq;
        typedef const __attribute__((address_space(1))) f32x4* GF4;
        const GF4 bp = (GF4)pin_ptr(bgu + (size_t)e * 2048 + f0);
        f32x4 bg[2], bu[2];
#pragma unroll
        for (int n = 0; n < 2; ++n) { bg[n] = bp[n]; bu[n] = bp[256 + n] + 1.0f; }
#pragma unroll
        for (int ai = 0; ai < 2; ++ai)
#pragma unroll
            for (int m = 0; m < 4; ++m) { f32x4 o[2];
#pragma unroll
                for (int n = 0; n < 2; ++n) { const f32x4 g = acc[ai][0][m][n] + bg[n], uu = acc[ai][1][m][n] + bu[n];
#pragma unroll
                    for (int q = 0; q < 4; ++q) { const float gc = fminf(g[q], 7.0f), uc1 = fminf(fmaxf(uu[q], -6.0f), 8.0f);
                        o[n][q] = uc1 * gc * frcp(1.0f + __builtin_amdgcn_exp2f(gc * (-1.702f * 1.44269504f))); } }
                u32x4 w; w.x = cvt_pk_bf16(o[0][0], o[0][1]); w.y = cvt_pk_bf16(o[0][2], o[0][3]); w.z = cvt_pk_bf16(o[1][0], o[1][1]); w.w = cvt_pk_bf16(o[1][2], o[1][3]);
                *(u32x4*)(INTER + (size_t)(row0 + ai * 128 + m * 16) * 1024 + f0) = w; }
    }
};
struct EpiDown {
    static constexpr bool PERM = true, AFTER_DRAIN = false;
    bf16* YS; const float* bdn; LAS unsigned char* lds;
    __device__ __forceinline__ void operator()(const f32x4 (&acc)[2][2][4][2], const Unit& u, int wr, int wc, int fr, int fq) const {
        const int e = u.e, pnl = u.pn - e * 4, col0 = pnl * 256 + wc * 32 + 8 * fq, nv = u.nv & 511;
        typedef const __attribute__((address_space(1))) f32x4* GF4;
        const GF4 bp = (GF4)pin_ptr(bdn + (size_t)e * 1024 + col0);
        f32x4 bv[2][2];
#pragma unroll
        for (int bj = 0; bj < 2; ++bj)
#pragma unroll
            for (int n = 0; n < 2; ++n) bv[bj][n] = bp[bj * 32 + n];
        const LAS int* sl = (const LAS int*)(lds + LDSCTL_OFF + 8192 + 2048 * u.par);
        int slot8[2][4]; float gt8[2][4];
#pragma unroll
        for (int ai = 0; ai < 2; ++ai)
#pragma unroll
            for (int m = 0; m < 4; ++m) { const int r = ai * 128 + wr * 64 + m * 16 + fr; slot8[ai][m] = sl[r]; gt8[ai][m] = ((const LAS float*)(sl + 256))[r]; }
#pragma unroll
        for (int ai = 0; ai < 2; ++ai) asm volatile("" : "+v"(slot8[ai][0]), "+v"(slot8[ai][1]), "+v"(slot8[ai][2]), "+v"(slot8[ai][3]), "+v"(gt8[ai][0]), "+v"(gt8[ai][1]), "+v"(gt8[ai][2]), "+v"(gt8[ai][3]));
        asm volatile("" : "+v"(bv[0][0]), "+v"(bv[0][1]), "+v"(bv[1][0]), "+v"(bv[1][1]));
#pragma unroll
        for (int ai = 0; ai < 2; ++ai)
#pragma unroll
            for (int m = 0; m < 4; ++m) { const int r = ai * 128 + wr * 64 + m * 16 + fr;
                if (r < nv) { const int slot = slot8[ai][m]; const float gt = gt8[ai][m];
                    bf16* rowp = YS + (size_t)slot * 1024 + col0;
#pragma unroll
                    for (int bj = 0; bj < 2; ++bj) { const f32x4 v0 = (acc[ai][bj][m][0] + bv[bj][0]) * gt, v1 = (acc[ai][bj][m][1] + bv[bj][1]) * gt;
                        u32x4 w; w.x = cvt_pk_bf16(v0[0], v0[1]); w.y = cvt_pk_bf16(v0[2], v0[3]); w.z = cvt_pk_bf16(v1[0], v1[1]); w.w = cvt_pk_bf16(v1[2], v1[3]);
                        *(u32x4*)(rowp + bj * 128) = w; } } }
    }
};

__device__ __forceinline__ int moe_tables(const unsigned* cnt, LAS unsigned char* lds, int tid) {
    LAS int* tpre = (LAS int*)(lds + LDSCTL_OFF + 64); LAS int* ecnt = (LAS int*)(lds + LDSCTL_OFF + 256); LAS unsigned short* tile_e = (LAS unsigned short*)(lds + LDSCTL_OFF + 512);
    if (tid < 64) { const int e = tid & 31;
        const int cn = tid < 32 ? (int)__hip_atomic_load(cnt + e * CNT_STRIDE, __ATOMIC_RELAXED, __HIP_MEMORY_SCOPE_AGENT) : 0;
        const int tl = (cn + 255) >> 8; int incl = tl;
#pragma unroll
        for (int d = 1; d < 32; d <<= 1) { const int o = __shfl_up(incl, d); if (tid >= d) incl += o; }
        if (tid < 32) { ecnt[e] = cn; tpre[e] = incl - tl; }
        if (tid == 31) tpre[32] = incl; }
    __syncthreads();
    const int nt = tpre[32];
    { const int e = tid >> 4, sub = tid & 15, t1 = tpre[e + 1]; for (int t = tpre[e] + sub; t < t1; t += 16) tile_e[t] = (unsigned short)e; }
    __syncthreads();
    return nt;
}

constexpr int NPHASES = 37;
typedef const Args __attribute__((address_space(4))) CArgs;
__global__ void __attribute__((amdgpu_flat_work_group_size(512, 512), amdgpu_waves_per_eu(2, 2))) fwd_kernel(Args a_) {
    extern __shared__ __attribute__((aligned(16))) unsigned char lds_raw[];
    LAS unsigned char* lds = (LAS unsigned char*)lds_raw;
    const int G = gridDim.x, NGW = G * 8;
    CArgs* ap0 = (CArgs*)__builtin_amdgcn_kernarg_segment_ptr();
    if (threadIdx.x < 4) ((LAS unsigned*)(lds + LDSCTL_OFF))[threadIdx.x] = 0u;
    __syncthreads();
    XcdBarrier bar = xcd_barrier_post((unsigned*)(a_.ws + WS_CTL) + CW_BAR, (volatile LAS unsigned*)(lds + LDSCTL_OFF));
    const int lo = a_.ph_lo, hi = a_.ph_hi;
    int ph = 0;
#ifndef MK_ONLY
#define MK_ONLY -1
#endif
#ifndef MK_DBL
#define MK_DBL 0
#endif
#ifdef MK_MARK
#define PH_MARK(s) asm volatile("; ##" s)
#else
#define PH_MARK(s)
#endif
#define PH_BEGIN(id) if ((MK_ONLY < 0 || MK_ONLY == (id)) && ph >= lo && ph < hi) { for (int rep_ = 0; rep_ <= ((MK_DBL >> (id)) & 1); ++rep_) { PH_MARK("PH_BEGIN"); CArgs* ap = ap0; asm volatile("" : "+s"(ap)); const Args a = *(const Args*)ap; unsigned char* const ws = a.ws; (void)ws; const int wave = (int)bar.wv; int tid = wave * 64 + lane_id(); asm volatile("" : "+v"(tid)); const int lane = tid & 63, gw = blockIdx.x * 8 + wave; (void)lane; (void)gw;
#define PH_END PH_MARK("PH_END"); } } if (ph >= lo && ph + 1 < hi) xcd_barrier(bar); ++ph;

    PH_BEGIN(0) p0_prologue(a, lds, tid, lane, wave, G); PH_END

#pragma unroll 1
    for (int layer = 0; layer < DEPTH; ++layer) {
        const int kind = layer & 1, lj = layer >> 1;
        const int rows = layer == 3 ? TL : T, nmt = rows / 256;
        const int rows_moe = layer < 2 ? T : TL;
        if (kind == 0) {
            PH_BEGIN(1) phase_a_rwkv(a, layer, lds, tid, gw, NGW, lane); PH_END
            PH_BEGIN(2) {
                pg8::Gemm g{(const bf16*)(ws + WS_XL), (const bf16*)(ws + WS_WRKV) + (size_t)lj * 3840 * 1024, 6 * T, 3840, 1024};
                SchedB1 S{G, (int)blockIdx.x}; EpiB1 E{(bf16*)(ws + WS_RKV), (bf16*)(ws + WS_L1)};
                pg8::gemm_phase<EpiB1, SchedB1, true, true, false>(lds, g, S, E, tid); } PH_END
            PH_BEGIN(3) phase_b2_direct(a, lj, gw, NGW, lane); PH_END
            PH_BEGIN(5) phase_s1_chunks(a, lj, lds, tid, G, (MK_DBL >> 5) & 1 & (rep_ == 0)); PH_END
            PH_BEGIN(15) phase_s2_chain(a, wave, lane, G); PH_END
            PH_BEGIN(6) phase_s3_readout(a, lj, layer == 2 ? TL : T, lds, tid, gw, NGW, lane); PH_END
        } else {
            PH_BEGIN(7) phase_a_conv(a, layer, rows, gw, NGW, lane); PH_END
            PH_BEGIN(8) {
                pg8::Gemm g{(const bf16*)(ws + WS_XL), (const bf16*)(ws + WS_WIN) + (size_t)lj * 3072 * 1024, rows, 3072, 1024};
                SchedStd S{G, (int)blockIdx.x, nmt, 12}; EpiWin E{(bf16*)(ws + WS_BG), (bf16*)(ws + WS_CUZ)};
                pg8::gemm_phase<EpiWin, SchedStd, true, true, false>(lds, g, S, E, tid); } PH_END
            PH_BEGIN(9) phase_cv(a, lj, rows, gw, NGW, lane); PH_END
        }
        PH_BEGIN(10) {
            const bf16* Wt = kind == 0 ? (const bf16*)(ws + WS_WO) + (size_t)lj * 1024 * 1024 : (const bf16*)(ws + WS_WOUT) + (size_t)lj * 1024 * 1024;
            pg8::Gemm g{(const bf16*)(ws + WS_Z), Wt, rows, 1024, 1024};
            SchedStd S{G, (int)blockIdx.x, layer == 2 ? NMT_L : nmt, 4}; EpiRes E{(float*)(ws + (layer < 2 ? WS_XSA : WS_XSB)), (const float*)(ws + WS_MODS) + (size_t)layer * 5 * 6144 + 2 * 1024, (float*)(ws + (rep_ ? WS_XL : (layer < 2 ? WS_XSA : WS_XSB)))};
            pg8::gemm_phase<EpiRes, SchedStd, true, true, false>(lds, g, S, E, tid); } PH_END
        PH_BEGIN(11) phase_e_route_mfma(a, layer, rows_moe, lds, tid, wave, gw, NGW, lane, rep_); PH_END
        PH_BEGIN(12) {
            const int nt = __builtin_amdgcn_readfirstlane(moe_tables((const unsigned*)(ws + WS_CTL) + CW_CNT + layer * 32 * CNT_STRIDE, lds, tid));
            pg8::Gemm g{(const bf16*)(ws + WS_H2), (const bf16*)(ws + WS_WGU) + (size_t)layer * 32 * 2048 * 1024, 0, 0, 1024};
            SchedMoe S{G, (int)blockIdx.x, 8, nt, 2, lds, (const int*)(ws + WS_SLOTL), nullptr, wave};
            EpiGU E{(bf16*)(ws + WS_INTER), a.in[30] + (size_t)layer * 32 * 2048};
            pg8::gemm_phase<EpiGU, SchedMoe, true, true, true>(lds, g, S, E, tid); } PH_END
        PH_BEGIN(13) {
            const int nt = __builtin_amdgcn_readfirstlane(moe_tables((const unsigned*)(ws + WS_CTL) + CW_CNT + layer * 32 * CNT_STRIDE, lds, tid));
            pg8::Gemm g{(const bf16*)(ws + WS_INTER), (const bf16*)(ws + WS_WDN) + (size_t)layer * 32 * 1024 * 1024, 0, 0, 1024};
            SchedMoe S{G, (int)blockIdx.x, 4, nt, 8, lds, (const int*)(ws + WS_SLOTL), (const float*)(ws + WS_GATEL), wave};
            EpiDown E{(bf16*)(ws + WS_YS), a.in[32] + (size_t)layer * 32 * 1024, lds};
            pg8::gemm_phase<EpiDown, SchedMoe, true, true, false>(lds, g, S, E, tid); } PH_END
    }
    PH_BEGIN(14) phase_final(a, gw, NGW, lane); PH_END
#undef PH_BEGIN
#undef PH_END
}

extern "C" void kernel_launch(void* const* d_in, const int* in_sizes, int n_in, void* d_out, int out_size, void* d_ws, size_t ws_size, hipStream_t stream) {
    static int grid = 0;
    if (grid == 0) {
        if (n_in != 33 || in_sizes[0] != TL * D || out_size != TL * D || ws_size < WS_END) { fprintf(stderr, "kernel_launch: unexpected problem (n_in %d, in0 %d, out %d, ws %zu < %zu)\n", n_in, n_in > 0 ? in_sizes[0] : -1, out_size, ws_size, (size_t)WS_END); grid = -1; return; }
        int dev = 0, cus = 0, per_cu = 0;
        if (hipGetDevice(&dev) != hipSuccess || hipDeviceGetAttribute(&cus, hipDeviceAttributeMultiprocessorCount, dev) != hipSuccess) { grid = -1; return; }
        if (hipFuncSetAttribute((const void*)fwd_kernel, hipFuncAttributeMaxDynamicSharedMemorySize, LDS_BYTES) != hipSuccess) { fprintf(stderr, "kernel_launch: hipFuncSetAttribute failed\n"); grid = -1; return; }
        if (hipOccupancyMaxActiveBlocksPerMultiprocessor(&per_cu, (const void*)fwd_kernel, 512, LDS_BYTES) != hipSuccess || per_cu < 1) fprintf(stderr, "kernel_launch: occupancy query says %d\n", per_cu);
        (void)hipGetLastError();
        grid = cus;
    }
    if (grid < 0) return;
    if (hipMemsetAsync((char*)d_ws + WS_CTL, 0, CTL_ZERO_BYTES, stream) != hipSuccess) return;
    Args a{};
    for (int i = 0; i < 33; ++i) a.in[i] = (const float*)d_in[i];
    a.out = (float*)d_out; a.ws = (unsigned char*)d_ws;
#if MK_PER_PHASE
    for (int p = 0; p < NPHASES; ++p) { a.ph_lo = p; a.ph_hi = p + 1; hipLaunchKernelGGL(fwd_kernel, dim3(grid), dim3(512), LDS_BYTES, stream, a); }
#else
    a.ph_lo = 0; a.ph_hi = NPHASES;
    hipLaunchKernelGGL(fwd_kernel, dim3(grid), dim3(512), LDS_BYTES, stream, a);
#endif
    const hipError_t le = hipPeekAtLastError();
    if (le != hipSuccess) fprintf(stderr, "kernel_launch: launch failed: %s\n", hipGetErrorName(le));
}
```

```cpp
#include <hip/hip_runtime.h>
#include <cstdio>
#include <cstdint>

#ifndef MK_PER_PHASE
#define MK_PER_PHASE 0
#endif

constexpr int D = 1024, NBATCH = 4, SEQ = 8192, TL = NBATCH * SEQ, CTXL = 256, TC = NBATCH * CTXL, T = TL + TC;
constexpr int NH = 16, HS = 64, NE = 32, TOPK = 4, DEPTH = 4;
constexpr int NMT = T / 256;
constexpr int NMT_L = TL / 256;
constexpr int MAXTILES = (T * TOPK) / 256 + NE;
constexpr int NSTEP = CTXL + SEQ;

__device__ __forceinline__ int lane_id() { return (int)__builtin_amdgcn_mbcnt_hi(~0u, __builtin_amdgcn_mbcnt_lo(~0u, 0u)); }
namespace pg8 {
#define PG8_LAS __attribute__((address_space(3)))
typedef unsigned short bf16_t;
typedef short bf16x8 __attribute__((ext_vector_type(8)));
typedef float f32x4 __attribute__((ext_vector_type(4)));
typedef unsigned u32x4 __attribute__((ext_vector_type(4)));
typedef unsigned u32x2 __attribute__((ext_vector_type(2)));
constexpr int BM = 256, BK = 64, HALF = 128, HTB = HALF * BK * 2  , STAGE_BYTES = 8 * HTB, NXCD = 8, WGM = 8;

__host__ __device__ __forceinline__ int lds_byte(int r, int c) { const int st = (r >> 4) * 2 + (c >> 5), rr = r & 15, cc = c & 31, ob = rr * 64 + cc * 2; return st * 1024 + (ob ^ (((ob >> 9) & 1) << 5)); }
__host__ __device__ __forceinline__ void stage_rc(int b, int& R, int& C) { const int st = b / 1024, sb = b % 1024, swz = sb ^ (((sb >> 9) & 1) << 5); R = (st >> 1) * 16 + swz / 64; C = (st & 1) * 32 + (swz % 64) / 2; }
__host__ __device__ __forceinline__ int perm32(int rho) { const int n = rho >> 4, i = rho & 15; return 8 * (i >> 2) + 4 * n + (i & 3); }

struct Unit { int pm, pn, e, nv, par; };
struct Gemm { const bf16_t* A; const bf16_t* Bt; int M, N, K; };

__device__ __forceinline__ void tile_map(int wgid, int nM, int nN, int& pm, int& pn) {
    const int nwg = nM * nN;
    { const int q = nwg / NXCD, r = nwg % NXCD, xcd = wgid % NXCD, off = wgid / NXCD; wgid = (xcd < r ? xcd * (q + 1) : r * (q + 1) + (xcd - r) * q) + off; }
    const int nig = WGM * nN, gid = wgid / nig, fm = gid * WGM, gsz = (nM - fm) < WGM ? (nM - fm) : WGM;
    pm = fm + ((wgid % nig) % gsz); pn = (wgid % nig) / gsz;
}
typedef __bf16 bf16x2_t __attribute__((ext_vector_type(2)));
typedef float f32x2_t __attribute__((ext_vector_type(2)));
__device__ __forceinline__ unsigned cvt_pk_bf16(float lo, float hi) { const f32x2_t v = {lo, hi}; const bf16x2_t b = __builtin_convertvector(v, bf16x2_t); return __builtin_bit_cast(unsigned, b); }

template <class Epi, class Sched, bool ALIGN_EPI = false, bool SP2 = false, bool GATHER = false>
__device__ __forceinline__ void gemm_phase(PG8_LAS unsigned char* lds, const Gemm g, const Sched& S, const Epi& E, int tid_in) {
    int tid_ = tid_in; asm volatile("" : "+v"(tid_));
    const int tid = tid_, wid = __builtin_amdgcn_readfirstlane(tid >> 6), lane = tid & 63, wr = wid >> 2, wc = wid & 3, fr = lane & 15, fq = lane >> 4;
    int K_ = g.K; asm volatile("" : "+s"(K_));
    const int K = K_, nt = K / BK;
    unsigned voffA[2], voffB[2]; int gR[2]; unsigned gC[2];
#pragma unroll
    for (int i = 0; i < 2; ++i) { int R, C; stage_rc(tid * 16 + i * 8192, R, C); const int Rb = Epi::PERM ? ((R & ~31) + perm32(R & 31)) : R;
        voffA[i] = (unsigned)(R * K + C) * 2u; voffB[i] = (unsigned)(Rb * K + C) * 2u; gR[i] = R; gC[i] = (unsigned)C * 2u; }
    unsigned oc[2][2], on[2][2], o2[2][2];
#pragma unroll
    for (int h = 0; h < 2; ++h)
#pragma unroll
        for (int i = 0; i < 2; ++i) { oc[h][i] = 0u; on[h][i] = 0u; o2[h][i] = 0u; }
    const size_t kstep = (size_t)(BK * 2);
    const size_t hstep = (size_t)HALF * K * 2;
    const size_t tstep = 2 * hstep;
    const unsigned ldsw = (unsigned)wid * 1024u;
    const int aoff = lds_byte(wr * 64 + fr, fq * 8), boff = lds_byte(wc * 32 + fr, fq * 8);
#define PG8_SA(b, h) (((b) * 2 + (h)) * HTB)
#define PG8_SB(b, h) ((4 + (b) * 2 + (h)) * HTB)
#define PG8_STAGE(bufoff, gbase, voff) do { _Pragma("unroll") for (int _i = 0; _i < 2; ++_i) \
        __builtin_amdgcn_global_load_lds((const unsigned*)((const char*)(gbase) + (voff)[_i]), (PG8_LAS unsigned*)(lds + (bufoff) + ldsw + _i * 8192), 16, 0, 0); } while (0)
#define PG8_STAGE_A(bufoff, base, h, O) do { if constexpr (GATHER) { PG8_STAGE(bufoff, base, (O)[h]); } else { PG8_STAGE(bufoff, (base) + (h) * hstep, voffA); } } while (0)
#define PG8_LDA(dst, b, h) do { _Pragma("unroll") for (int m = 0; m < 4; ++m) _Pragma("unroll") for (int k = 0; k < 2; ++k) dst[m][k] = *(const PG8_LAS bf16x8*)(lds + PG8_SA(b, h) + aoff + m * 2048 + k * 1024); } while (0)
#define PG8_LDB(dst, b, h) do { _Pragma("unroll") for (int n = 0; n < 2; ++n) _Pragma("unroll") for (int k = 0; k < 2; ++k) dst[n][k] = *(const PG8_LAS bf16x8*)(lds + PG8_SB(b, h) + boff + n * 2048 + k * 1024); } while (0)
#define PG8_MMA(ai, bj, At, Bt) do { __builtin_amdgcn_s_setprio(1); _Pragma("unroll") for (int m = 0; m < 4; ++m) _Pragma("unroll") for (int n = 0; n < 2; ++n) _Pragma("unroll") for (int k = 0; k < 2; ++k) \
        acc[ai][bj][m][n] = __builtin_amdgcn_mfma_f32_16x16x32_bf16(Bt[n][k], At[m][k], acc[ai][bj][m][n], 0, 0, 0); __builtin_amdgcn_s_setprio(0); } while (0)
#define PG8_WAIT_V(n) asm volatile("s_waitcnt vmcnt(" #n ")" ::: "memory")
#define PG8_WAIT_L(n) asm volatile("s_waitcnt lgkmcnt(" #n ")" ::: "memory")
#define PG8_BAR __builtin_amdgcn_s_barrier()
#define PG8_SCHED __builtin_amdgcn_sched_barrier(0)
    Unit cur, nxt; int ui = 0;
    if (!S.next(0, cur)) return;
    f32x4 acc[2][2][4][2];
#pragma unroll
    for (int a = 0; a < 2; ++a)
#pragma unroll
        for (int b = 0; b < 2; ++b)
#pragma unroll
            for (int m = 0; m < 4; ++m)
#pragma unroll
                for (int n = 0; n < 2; ++n) acc[a][b][m][n] = (f32x4){0.f, 0.f, 0.f, 0.f};
    bf16x8 At[4][2], B0[2][2], B1[2][2];
    const char* cA = GATHER ? (const char*)g.A : (const char*)g.A + (size_t)cur.pm * tstep; const char* cB = (const char*)g.Bt + (size_t)cur.pn * tstep;
    S.a_ready(cur);
    if constexpr (GATHER) {
#pragma unroll
        for (int h = 0; h < 2; ++h)
#pragma unroll
            for (int i = 0; i < 2; ++i) oc[h][i] = S.row_off(cur, h * HALF + gR[i]) + gC[i];
    }
    if constexpr (SP2) {
        PG8_STAGE(PG8_SB(0, 0), cB, voffB); PG8_STAGE(PG8_SB(0, 1), cB + hstep, voffB); PG8_STAGE_A(PG8_SA(0, 0), cA, 0, oc); PG8_STAGE_A(PG8_SA(0, 1), cA, 1, oc);
        if (wr == 1) PG8_BAR;
        PG8_WAIT_V(2); PG8_BAR;
        PG8_STAGE(PG8_SB(1, 0), cB + kstep, voffB); PG8_STAGE_A(PG8_SA(1, 0), cA + kstep, 0, oc); PG8_STAGE(PG8_SB(1, 1), cB + hstep + kstep, voffB);
        PG8_WAIT_V(6); PG8_BAR;
    } else {
        PG8_STAGE(PG8_SB(0, 0), cB, voffB); PG8_STAGE_A(PG8_SA(0, 0), cA, 0, oc); PG8_STAGE(PG8_SB(0, 1), cB + hstep, voffB); PG8_STAGE_A(PG8_SA(0, 1), cA, 1, oc);
        if (wr == 1) PG8_BAR;
        PG8_WAIT_V(4); PG8_BAR;
        PG8_STAGE(PG8_SB(1, 0), cB + kstep, voffB); PG8_STAGE_A(PG8_SA(1, 0), cA + kstep, 0, oc); PG8_STAGE(PG8_SB(1, 1), cB + hstep + kstep, voffB);
        PG8_WAIT_V(6); PG8_BAR;
    }
    for (;;) {
        const bool has_next = S.next(ui + 1, nxt);
        const char* nA = GATHER ? (const char*)g.A : (has_next ? (const char*)g.A + (size_t)nxt.pm * tstep : cA); const char* nB = has_next ? (const char*)g.Bt + (size_t)nxt.pn * tstep : cB;
        if constexpr (GATHER) { if (has_next) S.prefetch_rows(nxt); }
        for (int t = 0; t < nt; t += 2) {
            const bool last = (t == nt - 2);
            const char* a1 = cA + (size_t)(t + 1) * kstep;
            const char* a2 = last ? nA : cA + (size_t)(t + 2) * kstep; const char* b2 = last ? nB : cB + (size_t)(t + 2) * kstep;
            const char* a3 = a2 + kstep; const char* b3 = b2 + kstep;
            if constexpr (GATHER) {
                if (last) {
#pragma unroll
                    for (int h = 0; h < 2; ++h)
#pragma unroll
                        for (int i = 0; i < 2; ++i) on[h][i] = has_next ? (S.row_off_lds(nxt, h * HALF + gR[i]) + gC[i]) : oc[h][i];
                }
#pragma unroll
                for (int h = 0; h < 2; ++h)
#pragma unroll
                    for (int i = 0; i < 2; ++i) o2[h][i] = last ? on[h][i] : oc[h][i];
            }
            if (last && has_next) S.a_ready(nxt);
            if constexpr (SP2) {
            PG8_LDB(B0, 0, 0); PG8_LDB(B1, 0, 1); PG8_SCHED; PG8_LDA(At, 0, 0); PG8_STAGE_A(PG8_SA(1, 1), a1, 1, oc);
            PG8_WAIT_V(8); PG8_WAIT_L(0); PG8_BAR; PG8_MMA(0, 0, At, B0); PG8_MMA(0, 1, At, B1); PG8_BAR; PG8_SCHED;
            PG8_LDA(At, 0, 1); PG8_STAGE(PG8_SB(0, 0), b2, voffB); PG8_STAGE(PG8_SB(0, 1), b2 + hstep, voffB); PG8_STAGE_A(PG8_SA(0, 0), a2, 0, o2);
            PG8_WAIT_V(8); PG8_WAIT_L(0); PG8_BAR; PG8_MMA(1, 0, At, B0); PG8_MMA(1, 1, At, B1); PG8_BAR; PG8_SCHED;
            PG8_LDB(B0, 1, 0); PG8_LDB(B1, 1, 1); PG8_SCHED; PG8_LDA(At, 1, 0); PG8_STAGE_A(PG8_SA(0, 1), a2, 1, o2);
            PG8_WAIT_V(8); PG8_WAIT_L(0); PG8_BAR; PG8_MMA(0, 0, At, B0); PG8_MMA(0, 1, At, B1); PG8_BAR; PG8_SCHED;
            PG8_LDA(At, 1, 1); PG8_STAGE(PG8_SB(1, 0), b3, voffB); PG8_STAGE(PG8_SB(1, 1), b3 + hstep, voffB); PG8_STAGE_A(PG8_SA(1, 0), a3, 0, o2);
            PG8_WAIT_V(8); PG8_WAIT_L(0); PG8_BAR; PG8_MMA(1, 0, At, B0); PG8_MMA(1, 1, At, B1); PG8_BAR; PG8_SCHED;
            } else {
            PG8_LDB(B0, 0, 0); PG8_SCHED; PG8_LDA(At, 0, 0); PG8_STAGE_A(PG8_SA(1, 1), a1, 1, oc);
            PG8_WAIT_L(8); PG8_BAR; PG8_WAIT_L(0); PG8_MMA(0, 0, At, B0); PG8_BAR; PG8_SCHED;
            PG8_LDB(B1, 0, 1); PG8_STAGE(PG8_SB(0, 0), b2, voffB);
            PG8_BAR; PG8_WAIT_L(0); PG8_MMA(0, 1, At, B1); PG8_BAR;
            PG8_LDA(At, 0, 1); PG8_STAGE_A(PG8_SA(0, 0), a2, 0, o2);
            PG8_BAR; PG8_WAIT_L(0); PG8_MMA(1, 0, At, B0); PG8_BAR; PG8_SCHED;
            PG8_STAGE(PG8_SB(0, 1), b2 + hstep, voffB);
            PG8_WAIT_V(6); PG8_BAR; PG8_MMA(1, 1, At, B1); PG8_BAR;
            PG8_LDB(B0, 1, 0); PG8_SCHED; PG8_LDA(At, 1, 0); PG8_STAGE_A(PG8_SA(0, 1), a2, 1, o2);
            PG8_WAIT_L(8); PG8_BAR; PG8_WAIT_L(0); PG8_MMA(0, 0, At, B0); PG8_BAR; PG8_SCHED;
            PG8_LDB(B1, 1, 1); PG8_STAGE(PG8_SB(1, 0), b3, voffB);
            PG8_BAR; PG8_WAIT_L(0); PG8_MMA(0, 1, At, B1); PG8_BAR;
            PG8_LDA(At, 1, 1); PG8_STAGE_A(PG8_SA(1, 0), a3, 0, o2);
            PG8_BAR; PG8_WAIT_L(0); PG8_MMA(1, 0, At, B0); PG8_BAR; PG8_SCHED;
            PG8_STAGE(PG8_SB(1, 1), b3 + hstep, voffB);
            PG8_WAIT_V(6); PG8_BAR; PG8_MMA(1, 1, At, B1); PG8_BAR;
            }
        }
        if constexpr (ALIGN_EPI) { if (wr == 0) PG8_BAR; }
        if constexpr (!Epi::AFTER_DRAIN) { E(acc, cur, wr, wc, fr, fq); S.done(cur); }
        if (!has_next) break;
#pragma unroll
        for (int a = 0; a < 2; ++a)
#pragma unroll
            for (int b = 0; b < 2; ++b)
#pragma unroll
                for (int m = 0; m < 4; ++m)
#pragma unroll
                    for (int n = 0; n < 2; ++n) acc[a][b][m][n] = (f32x4){0.f, 0.f, 0.f, 0.f};
        cur = nxt; cA = nA; cB = nB; ++ui;
        if constexpr (GATHER) {
#pragma unroll
            for (int h = 0; h < 2; ++h)
#pragma unroll
                for (int i = 0; i < 2; ++i) oc[h][i] = on[h][i];
        }
        if constexpr (ALIGN_EPI) { if (wr == 1) PG8_BAR; }
    }
    PG8_WAIT_V(0);
    if constexpr (!ALIGN_EPI) { if (wr == 0) PG8_BAR; }
    PG8_BAR;
    if constexpr (Epi::AFTER_DRAIN) { E.fused(acc, cur, wr, wc, fr, fq, lds, wid, lane); S.done(cur); }
#undef PG8_SA
#undef PG8_SB
#undef PG8_STAGE
#undef PG8_STAGE_A
#undef PG8_LDA
#undef PG8_LDB
#undef PG8_MMA
#undef PG8_WAIT_V
#undef PG8_WAIT_L
#undef PG8_BAR
#undef PG8_SCHED
}
}

#define LAS __attribute__((address_space(3)))
typedef unsigned short bf16;
typedef float f32x4 __attribute__((ext_vector_type(4)));
typedef unsigned u32x2 __attribute__((ext_vector_type(2)));
typedef unsigned u32x4 __attribute__((ext_vector_type(4)));
#define LDS_WAIT() asm volatile("s_waitcnt lgkmcnt(0)" ::: "memory")
__device__ __forceinline__ unsigned pk2(float lo, float hi) { return pg8::cvt_pk_bf16(lo, hi); }
__device__ __forceinline__ unsigned f2bf(float f) { return pk2(f, f) & 0xffffu; }
__device__ __forceinline__ float bflo(unsigned w) { return __builtin_bit_cast(float, w << 16); }
__device__ __forceinline__ float bfhi(unsigned w) { return __builtin_bit_cast(float, w & 0xffff0000u); }
__device__ __forceinline__ float wave_sum(float v) {
#pragma unroll
    for (int o = 1; o < 64; o <<= 1) v += __shfl_xor(v, o);
    return v;
}
__device__ __forceinline__ float frcp(float x) { return __builtin_amdgcn_rcpf(x); }
__device__ __forceinline__ float sigm(float x) { return frcp(1.0f + __expf(-x)); }
__device__ __forceinline__ float tanh_fast(float x) { const float e = __expf(2.0f * x); return 1.0f - 2.0f * frcp(e + 1.0f); }

constexpr size_t MiB = 1u << 20;
constexpr size_t RF = (size_t)T * D * 4;
constexpr size_t RB = (size_t)T * D * 2;
constexpr size_t WS_CTL = 0, CTL_ZERO_BYTES = 1 * MiB;
constexpr size_t WS_MODS = 1 * MiB;
constexpr size_t WS_XSA = 2 * MiB, WS_XSB = WS_XSA + RF;
constexpr size_t WS_XL = WS_XSB + RF;
constexpr size_t WS_RKV = WS_XL + 6 * RB;
constexpr size_t WS_L1 = WS_RKV + 3 * RF;
constexpr size_t WS_WDEC = WS_L1 + 50 * MiB;
constexpr size_t WS_AA = WS_WDEC + 2 * RF;
constexpr size_t WS_G = WS_AA + 2 * RF;
constexpr size_t WS_KK = WS_G + RB;
constexpr size_t WS_KD = WS_KK + RF;
constexpr size_t WS_BETA = WS_KD + 2 * RF;
constexpr size_t WS_RKB = WS_BETA + 2 * RF;
constexpr size_t WS_C12 = WS_RKB + 3 * MiB;
constexpr size_t WS_WRT = WS_C12 + 6 * MiB;
constexpr size_t WS_Y = WS_C12 + 9 * MiB;
constexpr size_t WS_Z = WS_Y + 2 * RF;
constexpr size_t WS_H2 = WS_Z + RB;
constexpr size_t WS_SLOTL = WS_H2 + RB;
constexpr size_t WS_GATEL = WS_SLOTL + 5 * MiB;
constexpr size_t WS_WRKV = WS_GATEL + 5 * MiB;
constexpr size_t WS_L2T = WS_WRKV + 15 * MiB;
constexpr size_t WS_WO = WS_L2T + 5 * MiB;
constexpr size_t WS_WIN = WS_WO + 4 * MiB;
constexpr size_t WS_WOUT = WS_WIN + 12 * MiB;
constexpr size_t WS_WGU = WS_WOUT + 4 * MiB;
constexpr size_t WS_WDN = WS_WGU + 512 * MiB;
constexpr size_t WS_END = WS_WDN + 256 * MiB;
constexpr size_t WS_INTER = WS_WDEC;
constexpr size_t WS_YS = WS_KD;
constexpr size_t WS_BG = WS_RKV, WS_CUZ = WS_RKV + RB;
constexpr size_t WS_RAWW = WS_AA, WS_RAWA = WS_AA + RF;
constexpr size_t WS_RH = WS_AA;
constexpr size_t WS_PM = WS_WDEC;
constexpr size_t WS_RKB1 = WS_C12 + 1 * MiB;
constexpr size_t WS_QT = WS_XL;
constexpr size_t WS_HT = WS_XL + RF;
static_assert((size_t)128 * 132 * 4096 * 2 <= RF, "chunk state tensors");
static_assert((size_t)MAXTILES * 256 * 1024 * 2 <= 4 * RF, "INTER overlay");
static_assert((size_t)T * 4 * 1024 * 2 <= 2 * RF, "YS overlay");
static_assert((size_t)3 * T * 256 * 2 <= 50 * MiB, "L1OUT");
constexpr int CW_BAR = 4096;
constexpr int CW_CNT = 16384, CNT_STRIDE = 64;

constexpr int RING_BYTES = 131072;
constexpr int LDSCTL_OFF = RING_BYTES + 4096;
constexpr int LDS_BYTES = LDSCTL_OFF + 16384;

struct Args { const float* in[33]; float* out; unsigned char* ws; int ph_lo, ph_hi; };

__device__ __forceinline__ void transpose_item(const float* W, int N, bf16* WT, int dstK, int drow0, int k0, int n0, LAS float* scr, int lane) {
    float tv[64];
    const float* src = W + (size_t)k0 * N + n0 + lane;
#pragma unroll
    for (int i = 0; i < 64; ++i) tv[i] = src[(size_t)i * N];
#pragma unroll
    for (int i = 0; i < 64; ++i) scr[i * 65 + lane] = tv[i];
    LDS_WAIT(); asm volatile("" ::: "memory");
    const int c = lane & 7;
#pragma unroll
    for (int j = 0; j < 8; ++j) { const int n = (lane >> 3) + 8 * j; const LAS float* s = scr + (8 * c) * 65 + n;
        u32x4 o; o.x = pk2(s[0 * 65], s[1 * 65]); o.y = pk2(s[2 * 65], s[3 * 65]); o.z = pk2(s[4 * 65], s[5 * 65]); o.w = pk2(s[6 * 65], s[7 * 65]);
        *(u32x4*)(WT + (size_t)(drow0 + n) * dstK + k0 + 8 * c) = o; }
    LDS_WAIT(); asm volatile("" ::: "memory");
}
__device__ __forceinline__ int gu_map(int n0) { const int bj = n0 >= 1024 ? 1 : 0, f0 = n0 - bj * 1024; return (f0 >> 7) * 256 + bj * 128 + (f0 & 127); }
__device__ __forceinline__ int conv_map(int n0) { if (n0 < 1024) return n0; const int q = (n0 - 1024) >> 10, f0 = (n0 - 1024) & 1023; return 1024 + (f0 >> 7) * 256 + q * 128 + (f0 & 127); }

__device__ __forceinline__ void p0_prologue(const Args& a, LAS unsigned char* lds, int tid, int lane, int wave, int G) {
    unsigned char* ws = a.ws;
    LAS float* sl = (LAS float*)lds;
    LAS float* red = (LAS float*)(lds + 20480);
    for (int i = tid; i < 5 * 1024; i += 512) { const int r = i >> 10, k = i & 1023; const float cv = r < 4 ? a.in[1][r * 1024 + k] : a.in[3][k]; sl[i] = cv * sigm(cv); }
    __syncthreads();
    float* MODS = (float*)(ws + WS_MODS);
    for (int it = blockIdx.x; it < 4 * 96; it += G) {
        const int l = it / 96, n = (it % 96) * 64 + lane;
        const float* W = a.in[4] + (size_t)l * 1024 * 6144 + n;
        float acc[5] = {0.f, 0.f, 0.f, 0.f, 0.f};
        const int kb = wave * 128;
#pragma unroll 32
        for (int k = 0; k < 128; ++k) { const float wv = W[(size_t)(kb + k) * 6144];
#pragma unroll
            for (int r = 0; r < 5; ++r) acc[r] += sl[r * 1024 + kb + k] * wv; }
#pragma unroll
        for (int r = 0; r < 5; ++r) red[(wave * 5 + r) * 64 + lane] = acc[r];
        __syncthreads();
        if (wave < 5) { float s = a.in[5][l * 6144 + n];
#pragma unroll
            for (int w = 0; w < 8; ++w) s += red[(w * 5 + wave) * 64 + lane];
            MODS[(size_t)(l * 5 + wave) * 6144 + n] = s; }
        __syncthreads();
    }
    LAS float* scr = (LAS float*)(lds + wave * 16640);
    static_assert(8 * 16640 <= LDSCTL_OFF, "P0 scratch");
    const int gw = blockIdx.x * 8 + wave, NGW = G * 8;
    bf16* WRKV = (bf16*)(ws + WS_WRKV); bf16* WOt = (bf16*)(ws + WS_WO); bf16* WINt = (bf16*)(ws + WS_WIN); bf16* WOUTt = (bf16*)(ws + WS_WOUT);
    bf16* WGU = (bf16*)(ws + WS_WGU); bf16* WDN = (bf16*)(ws + WS_WDN);
    constexpr int I_GU = 128 * 512, I_DN = 128 * 256, I_RKV = 6 * 256, I_WO = 2 * 256, I_WIN = 2 * 768, I_WOUT = 2 * 256, I_W1 = 4 * 16, I_A1 = 4 * 16, I_G1 = 2 * 32;
    constexpr int NITEMS = I_GU + I_DN + I_RKV + I_WO + I_WIN + I_WOUT + I_W1 + I_A1 + I_G1;
    for (int it = NGW - 1 - gw; it < NITEMS; it += NGW) {
        int r = it;
        if (r < I_GU) { const int m = r >> 9, q = r & 511, kb = q >> 5, nb = q & 31;
            transpose_item(a.in[29] + (size_t)m * 1024 * 2048, 2048, WGU + (size_t)m * 2048 * 1024, 1024, gu_map(nb * 64), kb * 64, nb * 64, scr, lane); continue; } r -= I_GU;
        if (r < I_DN) { const int m = r >> 8, q = r & 255, kb = q >> 4, nb = q & 15;
            transpose_item(a.in[31] + (size_t)m * 1024 * 1024, 1024, WDN + (size_t)m * 1024 * 1024, 1024, nb * 64, kb * 64, nb * 64, scr, lane); continue; } r -= I_DN;
        if (r < I_RKV) { const int m = r >> 8, q = r & 255, kb = q >> 4, nb = q & 15, lr = m / 3, j = m % 3;
            transpose_item(a.in[9] + (size_t)m * 1024 * 1024, 1024, WRKV + (size_t)lr * 3840 * 1024, 1024, j * 1024 + nb * 64, kb * 64, nb * 64, scr, lane); continue; } r -= I_RKV;
        if (r < I_WO) { const int m = r >> 8, q = r & 255, kb = q >> 4, nb = q & 15;
            transpose_item(a.in[23] + (size_t)m * 1024 * 1024, 1024, WOt + (size_t)m * 1024 * 1024, 1024, nb * 64, kb * 64, nb * 64, scr, lane); continue; } r -= I_WO;
        if (r < I_WIN) { const int m = r / 768, q = r % 768, kb = q / 48, nb = q % 48;
            transpose_item(a.in[24] + (size_t)m * 1024 * 3072, 3072, WINt + (size_t)m * 3072 * 1024, 1024, conv_map(nb * 64), kb * 64, nb * 64, scr, lane); continue; } r -= I_WIN;
        if (r < I_WOUT) { const int m = r >> 8, q = r & 255, kb = q >> 4, nb = q & 15;
            transpose_item(a.in[26] + (size_t)m * 1024 * 1024, 1024, WOUTt + (size_t)m * 1024 * 1024, 1024, nb * 64, kb * 64, nb * 64, scr, lane); continue; } r -= I_WOUT;
        if (r < I_W1) { const int m = r >> 4, kb = r & 15, lr = m >> 1, e = m & 1;
            transpose_item(a.in[11] + (size_t)m * 1024 * 64, 64, WRKV + (size_t)lr * 3840 * 1024, 1024, 3072 + e * 64, kb * 64, 0, scr, lane); continue; } r -= I_W1;
        if (r < I_A1) { const int m = r >> 4, kb = r & 15, lr = m >> 1, e = m & 1;
            transpose_item(a.in[14] + (size_t)m * 1024 * 64, 64, WRKV + (size_t)lr * 3840 * 1024, 1024, 3328 + e * 64, kb * 64, 0, scr, lane); continue; } r -= I_A1;
        { const int m = r >> 5, q = r & 31, kb = q >> 1, nb = q & 1;
            transpose_item(a.in[16] + (size_t)m * 1024 * 128, 128, WRKV + (size_t)m * 3840 * 1024, 1024, 3584 + nb * 64, kb * 64, nb * 64, scr, lane); }
    }
    const int gt = blockIdx.x * 512 + tid, NGT = G * 512;
    for (int i = gt; i < 2 * 3 * 128 * 128; i += NGT) {
        const int pc = i & 127, rw = (i >> 7) & 127, pd = (i >> 14) % 3, lr = i / (3 * 16384);
        *(u32x4*)(WRKV + ((size_t)lr * 3840 + 3072 + pd * 256 + 128 + rw) * 1024 + pc * 8) = (u32x4){0u, 0u, 0u, 0u}; }
    bf16* L2T = (bf16*)(ws + WS_L2T);
    static_assert((2 * 128 * 5120) % (256 * 512) == 0, "L2T deal");
    for (int i0 = gt; i0 < 2 * 128 * 5120; i0 += 5 * NGT) {
        float v5[5]; bool ok5[5];
#pragma unroll
        for (int q = 0; q < 5; ++q) { const int i = i0 + q * NGT; const int n = i % 5120, k = (i / 5120) & 127, lr = i / (5120 * 128);
            const float* p; bool ok = true;
            if (n < 2048) { const int e = n >> 10, d = n & 1023; ok = (k >> 6) == e; p = a.in[12] + (((size_t)lr * 2 + e) * 64 + (k & 63)) * 1024 + d; }
            else if (n < 4096) { const int e = (n - 2048) >> 10, d = n & 1023; ok = (k >> 6) == e; p = a.in[15] + (((size_t)lr * 2 + e) * 64 + (k & 63)) * 1024 + d; }
            else { const int d = n - 4096; p = a.in[17] + ((size_t)lr * 128 + k) * 1024 + d; }
            v5[q] = *p; ok5[q] = ok; }
#pragma unroll
        for (int q = 0; q < 5; ++q) { const int i = i0 + q * NGT; const int n = i % 5120, k = (i / 5120) & 127, lr = i / (5120 * 128);
            L2T[((size_t)lr * 5120 + n) * 128 + k] = (bf16)f2bf(ok5[q] ? v5[q] : 0.f); }
    }
    bf16* WRT = (bf16*)(ws + WS_WRT);
    for (int i = gt; i < 4 * 32 * 1024; i += NGT) { const int k = i & 1023, e = (i >> 10) & 31, l = i >> 15;
        const float w = a.in[27][((size_t)l * 1024 + k) * 32 + e]; const unsigned hi = f2bf(w); const float lo = w - bflo(hi);
        WRT[((size_t)(l * 2 + 0) * 32 + e) * 1024 + k] = (bf16)hi; WRT[((size_t)(l * 2 + 1) * 32 + e) * 1024 + k] = (bf16)f2bf(lo); }
}
#define XB_TMO      128
#define XB_XCNT(j)  (256  + 64 * (j))
#define XB_XSUB(j)  (1280 + 64 * (j))
#define XB_XGEN(j)  (2304 + 64 * (j))
#define XB_TOP      3328
#define XB_TOPGEN   3392
#define XCD_BAR_WORDS 3456
#define XB_SPIN_CAP (1u << 23)

__device__ __forceinline__ unsigned xb_ld(unsigned* p)              { return __hip_atomic_load(p, __ATOMIC_RELAXED, __HIP_MEMORY_SCOPE_AGENT); }
__device__ __forceinline__ unsigned xb_add(unsigned* p, unsigned v) { return __hip_atomic_fetch_add(p, v, __ATOMIC_RELAXED, __HIP_MEMORY_SCOPE_AGENT); }
__device__ __forceinline__ unsigned xb_xcc_id() { return (unsigned)__builtin_amdgcn_s_getreg((3 << 11) | 20) & 0xFu; }
#define XB_SPIN(cond, bar) do { unsigned _sp = 0; while (cond) { __builtin_amdgcn_s_sleep(1); \
    if ((++_sp & 255u) == 0u) { if (xb_ld(&(bar)[XB_TMO])) break; if (_sp > XB_SPIN_CAP) { atomicAdd(&(bar)[XB_TMO], 1u); break; } } } } while (0)

struct XcdBarrier {
    unsigned wv;
    unsigned* bar; unsigned x;
    volatile LAS unsigned* st;
};

__device__ __forceinline__ XcdBarrier xcd_barrier_post(unsigned* bar, volatile LAS unsigned* st) {
    XcdBarrier b; b.wv = (unsigned)__builtin_amdgcn_readfirstlane((int)(threadIdx.x >> 6)); b.bar = bar; b.x = xb_xcc_id(); b.st = st;
    if (threadIdx.x == 0) (void)xb_add(&bar[XB_XCNT(b.x)], 1u);
    return b;
}
__device__ __forceinline__ void xcd_barrier_complete(unsigned* bar, unsigned x, unsigned& nloc, unsigned& nx) {
    const unsigned G = gridDim.x * gridDim.y * gridDim.z;
    unsigned sum, cnt, mine, sp = 0u;
    for (;;) {
        sum = 0u; cnt = 0u; mine = 0u;
#pragma unroll
        for (unsigned j = 0; j < 16; ++j) { const unsigned c = xb_ld(&bar[XB_XCNT(j)]); sum += c; cnt += (c > 0u) ? 1u : 0u; mine = (j == x) ? c : mine; }
        if (sum == G) break;
        __builtin_amdgcn_s_sleep(1);
        if ((++sp & 255u) == 0u) { if (xb_ld(&bar[XB_TMO])) break; if (sp > XB_SPIN_CAP) { atomicAdd(&bar[XB_TMO], 1u); break; } }
    }
    nloc = mine > 0u ? mine : 1u; nx = cnt > 0u ? cnt : 1u;
}

__device__ __forceinline__ void xcd_barrier(const XcdBarrier& b) {
    asm volatile("s_waitcnt vmcnt(0)" ::: "memory");
    __syncthreads();
    if (b.wv == 0u && lane_id() == 0) {
        unsigned* bar = b.bar;
        __builtin_amdgcn_s_waitcnt(0);
        unsigned nloc = b.st[0], nx = b.st[1];
        if (nloc == 0u) { xcd_barrier_complete(bar, b.x, nloc, nx); b.st[0] = nloc; b.st[1] = nx; }
        const unsigned old = xb_add(&bar[XB_XSUB(b.x)], 1u);
        const unsigned gen = old / nloc;
        if (old + 1u == (gen + 1u) * nloc) {
            __builtin_amdgcn_fence(__ATOMIC_RELEASE, "agent");
            asm volatile("s_waitcnt vmcnt(0)" ::: "memory");
            const unsigned og = xb_add(&bar[XB_TOP], 1u);
            const unsigned tg = og / nx;
            if (og + 1u == (tg + 1u) * nx) xb_add(&bar[XB_TOPGEN], 1u);
            else XB_SPIN(xb_ld(&bar[XB_TOPGEN]) == tg, bar);
            __builtin_amdgcn_fence(__ATOMIC_ACQUIRE, "agent");
            xb_add(&bar[XB_XGEN(b.x)], 1u);
            asm volatile("s_waitcnt vmcnt(0)" ::: "memory");
        } else {
            XB_SPIN(xb_ld(&bar[XB_XGEN(b.x)]) == gen, bar);
            __builtin_amdgcn_fence(__ATOMIC_ACQUIRE, "agent");
            asm volatile("s_waitcnt vmcnt(0)" ::: "memory");
        }
    }
    __syncthreads();
}

__device__ __forceinline__ f32x4 bf4(u32x2 w) { return (f32x4){bflo(w.x), bfhi(w.x), bflo(w.y), bfhi(w.y)}; }
__device__ __forceinline__ int mod_row(int row) { return row < TL ? (row >> 13) : 4; }

__device__ __forceinline__ void load_x_combined(f32x4 (&x)[4], const float* xrow, bool has_prev, const bf16* YS, int t, const f32x4 (&m5)[4], int lane) {
#pragma unroll
    for (int j = 0; j < 4; ++j) x[j] = *(const f32x4*)(xrow + 256 * j + 4 * lane);
    if (has_prev) {
        u32x2 y[4][4];
#pragma unroll
        for (int k = 0; k < 4; ++k)
#pragma unroll
            for (int j = 0; j < 4; ++j) y[k][j] = *(const u32x2*)(YS + ((size_t)t * 4 + k) * 1024 + 256 * j + 4 * lane);
#pragma unroll
        for (int j = 0; j < 4; ++j) { const f32x4 s = (bf4(y[0][j]) + bf4(y[1][j])) + (bf4(y[2][j]) + bf4(y[3][j])); x[j] += m5[j] * s; }
    }
}
__device__ __forceinline__ float row_rstd(const f32x4 (&x)[4]) {
    float ss = 0.f;
#pragma unroll
    for (int j = 0; j < 4; ++j) ss += (x[j].x * x[j].x + x[j].y * x[j].y) + (x[j].z * x[j].z + x[j].w * x[j].w);
    return rsqrtf(wave_sum(ss) * (1.0f / 1024.0f) + 1e-6f);
}

__device__ __forceinline__ void phase_a_rwkv(const Args& a, int layer, LAS unsigned char* lds, int tid, int gw, int NGW, int lane) {
    unsigned char* ws = a.ws; const int lj = layer >> 1; const bool has_prev = layer > 0;
    const float* xin_lat = layer == 0 ? a.in[0] : (const float*)(ws + WS_XSA);
    const float* xin_ctx = layer == 0 ? a.in[2] : (const float*)(ws + WS_XSA) + (size_t)TL * D;
    float* xout = (float*)(ws + (layer == 0 ? WS_XSA : WS_XSB));
    const float* MODS = (const float*)(ws + WS_MODS); const bf16* YS = (const bf16*)(ws + WS_YS); bf16* XL = (bf16*)(ws + WS_XL);
    const float* mug = a.in[8] + (size_t)lj * 6 * 2 * 1024; const float* ng = a.in[6] + (size_t)(layer * 2 + 0) * 1024;
    LAS float* mu = (LAS float*)lds;
    { f32x4 tm[6];
#pragma unroll
      for (int q = 0; q < 6; ++q) tm[q] = ((const f32x4*)mug)[tid + q * 512];
#pragma unroll
      for (int q = 0; q < 6; ++q) ((LAS f32x4*)mu)[tid + q * 512] = tm[q]; }
    __syncthreads();
    for (int it = gw; it < TL / 8 + TC / 2; it += NGW) {
        const int ntok = it < TL / 8 ? 8 : 2, t0 = it < TL / 8 ? it * 8 : TL + (it - TL / 8) * 2, mr = mod_row(t0);
        int rs, re; if (t0 < TL) { rs = t0 & ~63; re = rs + 63; } else { const int loc = t0 - TL; rs = TL + (loc & ~255); re = rs + 255; }
        const float* mod = MODS + (size_t)(layer * 5 + mr) * 6144;
        const float* m5p = MODS + (size_t)((has_prev ? layer - 1 : 0) * 5 + mr) * 6144 + 5 * 1024;
        f32x4 hm[4], h0[4], hp[4];
#pragma unroll
        for (int j = 0; j < 4; ++j) { hm[j] = (f32x4){0.f, 0.f, 0.f, 0.f}; h0[j] = hm[j]; hp[j] = hm[j]; }
        f32x4 rx[4], nx[4]; u32x2 ry[4][4], ny[4][4];
#define PA_LOAD(X, Y, tt) do { const int t_ = (tt); if (t_ >= rs && t_ <= re) { \
            const float* xrow_ = t_ < TL ? xin_lat + (size_t)t_ * D : xin_ctx + (size_t)(t_ - TL) * D; \
            _Pragma("unroll") for (int j = 0; j < 4; ++j) X[j] = *(const f32x4*)(xrow_ + 256 * j + 4 * lane); \
            if (has_prev) { _Pragma("unroll") for (int k = 0; k < 4; ++k) _Pragma("unroll") for (int j = 0; j < 4; ++j) Y[k][j] = *(const u32x2*)(YS + ((size_t)t_ * 4 + k) * 1024 + 256 * j + 4 * lane); } } } while (0)
#pragma unroll
        for (int j = 0; j < 4; ++j) { rx[j] = (f32x4){0.f, 0.f, 0.f, 0.f}; nx[j] = rx[j];
#pragma unroll
            for (int k = 0; k < 4; ++k) { ry[k][j] = (u32x2){0u, 0u}; ny[k][j] = ry[k][j]; } }
        PA_LOAD(rx, ry, t0 - 1);
        f32x4 gsc[4], sh4[4], m5v[4];
#pragma unroll
        for (int j = 0; j < 4; ++j) { const int col = 256 * j + 4 * lane; gsc[j] = *(const f32x4*)(ng + col) * (*(const f32x4*)(mod + 1024 + col) + 1.0f); sh4[j] = *(const f32x4*)(mod + col); m5v[j] = *(const f32x4*)(m5p + col); }
#pragma unroll
        for (int j = 0; j < 4; ++j) asm volatile("" : "+v"(gsc[j]), "+v"(sh4[j]), "+v"(m5v[j]), "+v"(rx[j]));
#pragma unroll 1
        for (int i = -1; i <= ntok; ++i) {
            const int t = t0 + i;
            if (i < ntok) PA_LOAD(nx, ny, t + 1);
            f32x4 hn[4];
            if (t >= rs && t <= re) {
                f32x4 x[4];
#pragma unroll
                for (int j = 0; j < 4; ++j) x[j] = rx[j];
                if (has_prev) {
#pragma unroll
                    for (int j = 0; j < 4; ++j) { f32x4 sm = (f32x4){0.f, 0.f, 0.f, 0.f};
#pragma unroll
                        for (int k = 0; k < 4; ++k) sm += (f32x4){bflo(ry[k][j].x), bfhi(ry[k][j].x), bflo(ry[k][j].y), bfhi(ry[k][j].y)};
                        x[j] += m5v[j] * sm; } }
                if (i >= 0 && i < ntok) {
#pragma unroll
                    for (int j = 0; j < 4; ++j) *(f32x4*)(xout + (size_t)t * D + 256 * j + 4 * lane) = x[j]; }
                const float rstd = row_rstd(x);
#pragma unroll
                for (int j = 0; j < 4; ++j) hn[j] = x[j] * rstd * gsc[j] + sh4[j];
            } else {
#pragma unroll
                for (int j = 0; j < 4; ++j) hn[j] = (f32x4){0.f, 0.f, 0.f, 0.f};
            }
#pragma unroll
            for (int j = 0; j < 4; ++j) { hm[j] = h0[j]; h0[j] = hp[j]; hp[j] = hn[j]; rx[j] = nx[j];
#pragma unroll
                for (int k = 0; k < 4; ++k) ry[k][j] = ny[k][j]; }
            if (i >= 1) {
                const int te = t - 1;
#pragma unroll
                for (int q = 0; q < 6; ++q) {
                    bf16* orow = XL + ((size_t)q * T + te) * D;
#pragma unroll
                    for (int j = 0; j < 4; ++j) { const int col = 256 * j + 4 * lane;
                        const f32x4 m0 = *(const LAS f32x4*)(mu + (q * 2 + 0) * 1024 + col), m1 = *(const LAS f32x4*)(mu + (q * 2 + 1) * 1024 + col);
                        const f32x4 o = h0[j] + m0 * (hm[j] - h0[j]) + m1 * (hp[j] - h0[j]);
                        u32x2 w; w.x = pk2(o.x, o.y); w.y = pk2(o.z, o.w); *(u32x2*)(orow + col) = w; }
                }
            }
        }
#undef PA_LOAD
    }
}
__device__ __forceinline__ void phase_a_conv(const Args& a, int layer, int rows, int gw, int NGW, int lane) {
    unsigned char* ws = a.ws;
    float* xs = (float*)(ws + (layer < 2 ? WS_XSA : WS_XSB));
    const float* MODS = (const float*)(ws + WS_MODS); const bf16* YS = (const bf16*)(ws + WS_YS); bf16* H = (bf16*)(ws + WS_XL);
    const float* ng = a.in[6] + (size_t)(layer * 2 + 0) * 1024;
    for (int t = gw; t < rows; t += NGW) {
        const int mr = mod_row(t);
        const float* mod = MODS + (size_t)(layer * 5 + mr) * 6144;
        f32x4 m5[4], x[4];
#pragma unroll
        for (int j = 0; j < 4; ++j) m5[j] = *(const f32x4*)(MODS + (size_t)((layer - 1) * 5 + mr) * 6144 + 5 * 1024 + 256 * j + 4 * lane);
        f32x4 gsc[4], sh4[4], ngv[4];
#pragma unroll
        for (int j = 0; j < 4; ++j) { const int col = 256 * j + 4 * lane; ngv[j] = *(const f32x4*)(ng + col); gsc[j] = *(const f32x4*)(mod + 1024 + col); sh4[j] = *(const f32x4*)(mod + col); }
        load_x_combined(x, xs + (size_t)t * D, true, YS, t, m5, lane);
#pragma unroll
        for (int j = 0; j < 4; ++j) gsc[j] = ngv[j] * (gsc[j] + 1.0f);
        const float rstd = row_rstd(x);
#pragma unroll
        for (int j = 0; j < 4; ++j) { const int col = 256 * j + 4 * lane;
            *(f32x4*)(xs + (size_t)t * D + col) = x[j];
            const f32x4 h = x[j] * rstd * gsc[j] + sh4[j];
            u32x2 w; w.x = pk2(h.x, h.y); w.y = pk2(h.z, h.w); *(u32x2*)(H + (size_t)t * D + col) = w; }
    }
}
#define DPPF(x, ctrl) __builtin_bit_cast(float, __builtin_amdgcn_update_dpp(0, __builtin_bit_cast(int, (x)), (ctrl), 0xf, 0xf, false))
__device__ __forceinline__ float row16_sum(float v) { v += DPPF(v, 0xB1); v += DPPF(v, 0x4E); v += DPPF(v, 0x141); v += DPPF(v, 0x140); return v; }
__device__ __forceinline__ u32x2 pk4(f32x4 v) { u32x2 w; w.x = pk2(v[0], v[1]); w.y = pk2(v[2], v[3]); return w; }
__device__ __forceinline__ void phase_c_prep(const Args& a, int lj, LAS unsigned char* lds, int tid, int gw, int NGW, int lane) {
    unsigned char* ws = a.ws;
    const bf16* Rr = (const bf16*)(ws + WS_RKV); const bf16* Kk = Rr + (size_t)T * D; const bf16* RA = (const bf16*)(ws + WS_RAWA); const bf16* RW = (const bf16*)(ws + WS_RAWW);
    bf16* KK = (bf16*)(ws + WS_KK); bf16* KD = (bf16*)(ws + WS_KD); bf16* BE = (bf16*)(ws + WS_BETA); float* RKB = (float*)(ws + WS_RKB);
    LAS float* tb = (LAS float*)lds;
    for (int i = tid; i < 7 * 256; i += 512) { const int t7 = i >> 8, q = i & 255;
        const float* src = t7 == 0 ? a.in[18] + lj * 1024 : t7 == 1 ? a.in[19] + lj * 1024 : t7 == 2 ? a.in[20] + lj * 1024 : t7 < 5 ? a.in[10] + lj * 2048 + (t7 - 3) * 1024 : a.in[13] + lj * 2048 + (t7 - 5) * 1024;
        ((LAS f32x4*)tb)[i] = ((const f32x4*)src)[q]; }
    __syncthreads();
    for (int row = gw; row < T; row += NGW) {
#pragma unroll
        for (int j = 0; j < 4; ++j) {
            const int col = 256 * j + 4 * lane; const size_t ro = (size_t)row * D + col;
            const f32x4 k = bf4(*(const u32x2*)(Kk + ro)), r = bf4(*(const u32x2*)(Rr + ro));
            f32x4 a0 = bf4(*(const u32x2*)(RA + ro)) + *(const LAS f32x4*)(tb + 5 * 1024 + col), a1 = bf4(*(const u32x2*)(RA + (size_t)T * D + ro)) + *(const LAS f32x4*)(tb + 6 * 1024 + col);
#pragma unroll
            for (int z = 0; z < 4; ++z) { a0[z] = sigm(a0[z]); a1[z] = sigm(a1[z]); }
            const f32x4 ck = *(const LAS f32x4*)(tb + col), ca = *(const LAS f32x4*)(tb + 1024 + col), cr = *(const LAS f32x4*)(tb + 2048 + col);
            const f32x4 kk = k * ck;
            const float ss = row16_sum((kk.x * kk.x + kk.y * kk.y) + (kk.z * kk.z + kk.w * kk.w));
            const f32x4 kd0 = k * ((a0 - 1.0f) * ca + 1.0f), kd1 = k * ((a1 - 1.0f) * ca + 1.0f);
            *(u32x2*)(KD + ro) = pk4(kd0); *(u32x2*)(KD + (size_t)T * D + ro) = pk4(kd1);
            const f32x4 p = r * (kd0 + kd1) * cr;
            const float rk = row16_sum((p.x + p.y) + (p.z + p.w));
            const f32x4 kkn = kk * fminf(__builtin_amdgcn_rsqf(ss), 1e12f);
            *(u32x2*)(KK + ro) = pk4(kkn); *(u32x2*)(BE + ro) = pk4(kkn * a0); *(u32x2*)(BE + (size_t)T * D + ro) = pk4(kkn * a1);
            if ((lane & 15) == 0) RKB[(size_t)row * 16 + 4 * j + (lane >> 4)] = rk;
        }
    }
}
typedef short bf16x8 __attribute__((ext_vector_type(8)));
__device__ __forceinline__ f32x4 mfma16(bf16x8 a, bf16x8 b, f32x4 c) { return __builtin_amdgcn_mfma_f32_16x16x32_bf16(a, b, c, 0, 0, 0); }
__device__ __forceinline__ bf16x8 as_frag(u32x4 w) { return __builtin_bit_cast(bf16x8, w); }
constexpr int CH_LD = 144;
constexpr int CH_MS = 64 * CH_LD;
constexpr int CH_AB = 0 * CH_MS, CH_KT = 1 * CH_MS, CH_BT = 2 * CH_MS, CH_RB = 3 * CH_MS, CH_VT = 4 * CH_MS, CH_ABT = 5 * CH_MS, CH_KHT = 6 * CH_MS, CH_BHT = 7 * CH_MS,
              CH_LK = 8 * CH_MS, CH_LB = 9 * CH_MS, CH_MK = 10 * CH_MS, CH_MB = 11 * CH_MS, CH_WT = 12 * CH_MS, CH_U0 = 13 * CH_MS, CH_DINV = 14 * CH_MS;
constexpr int CH_GC = LDSCTL_OFF + 2048;
constexpr int CH_PART = LDSCTL_OFF + 4096;
constexpr int NCHUNK = NSTEP / 64;
#ifndef S1_DBL
#define S1_DBL 0
#endif
static_assert(CH_DINV + 2048 <= RING_BYTES, "chunk LDS map");

__device__ __forceinline__ int scan_row(int s, int dir, int b) {
    if (s < CTXL) return TL + b * CTXL + (dir ? CTXL - 1 - s : s);
    const int i = s - CTXL; return b * SEQ + (dir ? SEQ - 1 - i : i);
}
#define CH_FRAG(mat, row, ks, kg) as_frag(*(const LAS u32x4*)(lds + (mat) + (row) * CH_LD + ((ks) * 32 + (kg) * 8) * 2))

__device__ __forceinline__ float s1_treduce16(const float (&a)[16], bool b3, bool b2) {
    float b[8];
#pragma unroll
    for (int i = 0; i < 8; ++i) { float x = a[i], y = a[i + 8];
        asm("s_nop 1\n\tv_permlane32_swap_b32 %0, %1" : "+v"(x), "+v"(y));
        b[i] = x + y; }
    float c[4];
#pragma unroll
    for (int i = 0; i < 4; ++i) { float x = b[i], y = b[i + 4];
        asm("s_nop 1\n\tv_permlane16_swap_b32 %0, %1" : "+v"(x), "+v"(y));
        c[i] = x + y; }
    float d[2];
#pragma unroll
    for (int i = 0; i < 2; ++i) { const float keep = b3 ? c[i + 2] : c[i], send = b3 ? c[i] : c[i + 2]; d[i] = keep + DPPF(send, 0x128); }
    const float keep = b2 ? d[1] : d[0], send = b2 ? d[0] : d[1];
    float e = keep + DPPF(send, 0x141);
    e += DPPF(e, 0xB1);
    e += DPPF(e, 0x4E);
    return e;
}
#define S1_BAR() do { asm volatile("s_waitcnt lgkmcnt(0)" ::: "memory"); __builtin_amdgcn_s_barrier(); asm volatile("" ::: "memory"); } while (0)
__device__ __forceinline__ void phase_s1_chunks(const Args& a, int lj, LAS unsigned char* lds, int tid, int G, int rh_scratch = 0) {
    unsigned char* ws = a.ws; const float* w0l = a.in[10] + lj * 2048; const float* a0l = a.in[13] + lj * 2048;
    const float* pkk = a.in[18] + lj * 1024; const float* pka = a.in[19] + lj * 1024; const float* prk = a.in[20] + lj * 1024;
    const int lane = tid & 63, wave = __builtin_amdgcn_readfirstlane(tid >> 6), l15 = lane & 15, g = lane >> 4;
    LAS float* part = (LAS float*)(lds + CH_PART); LAS float* gammaC = (LAS float*)(lds + CH_GC);
    unsigned nlw[8], nka[8], nkr[8], nrr[8], nvv[8]; float nw0 = 0.f, na0 = 0.f, npkk = 0.f, npka = 0.f, nprk = 0.f;
    typedef const __attribute__((address_space(1))) unsigned short* GUS;
#define S1_LOAD(ctx_) do { unsigned char* wsl = ws; asm volatile("" : "+s"(wsl));     \
        const int chain_ = (ctx_) / NCHUNK, c_ = (ctx_) - chain_ * NCHUNK, dir_ = chain_ >> 6, b_ = (chain_ >> 4) & 3, h_ = chain_ & 15; \
          \
          \
        const long o0 = (long)scan_row(64 * c_ + 8 * wave, dir_, b_) * D + h_ * 64, od = (long)dir_ * T * D, st = dir_ ? -(long)D : (long)D; \
        const bf16* LWp = (const bf16*)(wsl + WS_RAWW) + od + o0; const bf16* RAp = (const bf16*)(wsl + WS_RAWA) + od + o0; \
        const bf16* Rp = (const bf16*)(wsl + WS_RKV) + o0; const bf16* Kp = Rp + (size_t)T * D; const bf16* Vp = Rp + (size_t)2 * T * D; \
        nw0 = w0l[dir_ * 1024 + h_ * 64 + lane]; na0 = a0l[dir_ * 1024 + h_ * 64 + lane]; npkk = pkk[h_ * 64 + lane]; npka = pka[h_ * 64 + lane]; nprk = prk[h_ * 64 + lane]; \
        _Pragma("unroll") for (int j = 0; j < 8; ++j) { const long oj = st * j; \
            nlw[j] = ((GUS)(LWp + oj))[lane]; nka[j] = ((GUS)(RAp + oj))[lane]; nkr[j] = ((GUS)(Kp + oj))[lane]; nrr[j] = ((GUS)(Rp + oj))[lane]; nvv[j] = ((GUS)(Vp + oj))[lane]; } } while (0)
    unsigned clw[8], cka_[8], ckr[8], crr[8], cvv[8]; float cw0 = 0.f, ca0 = 0.f, cpkk = 0.f, cpka = 0.f, cprk = 0.f;
#define S1_TAKE() do { _Pragma("unroll") for (int j = 0; j < 8; ++j) { clw[j] = nlw[j]; cka_[j] = nka[j]; ckr[j] = nkr[j]; crr[j] = nrr[j]; cvv[j] = nvv[j]; } \
        cw0 = nw0; ca0 = na0; cpkk = npkk; cpka = npka; cprk = nprk; \
        _Pragma("unroll") for (int j = 0; j < 8; ++j) asm volatile("" : "+v"(clw[j]), "+v"(cka_[j]), "+v"(ckr[j]), "+v"(crr[j]), "+v"(cvv[j]) :: "memory"); \
        asm volatile("" : "+v"(cw0), "+v"(ca0), "+v"(cpkk), "+v"(cpka), "+v"(cprk) :: "memory"); } while (0)
    if ((int)blockIdx.x < 128 * NCHUNK) { S1_LOAD((int)blockIdx.x); S1_TAKE(); if ((int)blockIdx.x + G < 128 * NCHUNK) S1_LOAD((int)blockIdx.x + G); }
    for (int ct = blockIdx.x; ct < 128 * NCHUNK; ct += G) {
        const int chain = ct / NCHUNK, c = ct - chain * NCHUNK, dir = chain >> 6, b = (chain >> 4) & 3, h = chain & 15;
        unsigned zq = 0u; asm volatile("" : "+v"(zq));
        {
            const int k = lane, tq = wave;
            float lw[8], kd[8], be[8], kk[8], rr[8], vv[8];
            {
                const float w0k = cw0, a0k = ca0, ckk = cpkk, cka = cpka, crk = cprk;
                float* RKBd = (float*)(ws + (dir ? WS_RKB1 : WS_RKB));
                const int row0 = scan_row(64 * c + 8 * tq, dir, b), rst = dir ? -1 : 1;
                float av[8], kq[8], red[16];
                const float a0n = a0k * -1.44269504f, w0n = w0k * -1.44269504f;
#pragma unroll
                for (int j = 0; j < 8; ++j) { av[j] = frcp(1.0f + __builtin_amdgcn_exp2f(__builtin_fmaf(bflo(cka_[j]), -1.44269504f, a0n))); const float kr = bflo(ckr[j]);
                    lw[j] = -0.60653066f * frcp(1.0f + __builtin_amdgcn_exp2f(__builtin_fmaf(bflo(clw[j]), -1.44269504f, w0n)));
                    kq[j] = kr * ckk; kd[j] = kr * ((av[j] - 1.0f) * cka + 1.0f); rr[j] = bflo(crr[j]); vv[j] = bflo(cvv[j]);
                    red[2 * j] = kq[j] * kq[j]; red[2 * j + 1] = rr[j] * kd[j] * crk; }
                const float tot = s1_treduce16(red, (lane & 8) != 0, (lane & 4) != 0);
                if ((lane & 7) == 4) RKBd[(size_t)(row0 + rst * (lane >> 3)) * 16 + h] = tot;
#pragma unroll
                for (int j = 0; j < 8; ++j) { const float ss = __builtin_bit_cast(float, __builtin_amdgcn_readlane(__builtin_bit_cast(int, tot), 8 * j));
                    kk[j] = kq[j] * fminf(__builtin_amdgcn_rsqf(ss), 1e12f);     be[j] = kk[j] * av[j]; }
            }
            for (int r0_ = 0; r0_ <= ((S1_DBL >> 3) & 1); ++r0_) { if (r0_) S1_BAR();
            float p[8]; p[0] = lw[0];
#pragma unroll
            for (int j = 1; j < 8; ++j) p[j] = p[j - 1] + lw[j];
            part[tq * 64 + k] = p[7];
            S1_BAR();
            float off = 0.f, tot = 0.f;
#pragma unroll
            for (int q = 0; q < 8; ++q) { const float pv = part[q * 64 + k]; tot += pv; off += q < tq ? pv : 0.f; }
            const float eTot = __expf(tot); float ePrev = __expf(off);
            if (tq == 0) gammaC[k] = eTot;
            unsigned abw[4], khw[4], bhw[4], vw[4];
#pragma unroll
            for (int j = 0; j < 8; j += 2) {
                float ab2[2], kt2[2], bt2[2], rb2[2], kh2[2], bh2[2];
#pragma unroll
                for (int z = 0; z < 2; ++z) { const float cu = (off + p[j + z]) * 1.44269504f; const float eP = __builtin_amdgcn_exp2f(cu), eM = __builtin_amdgcn_exp2f(-cu), eC = eTot * eM;
                    ab2[z] = kk[j + z] * ePrev; ePrev = eP; kt2[z] = kd[j + z] * eM; bt2[z] = be[j + z] * eM; rb2[z] = rr[j + z] * eP; kh2[z] = kd[j + z] * eC; bh2[z] = be[j + z] * eC;
                }
                abw[j >> 1] = pk2(ab2[0], ab2[1]); khw[j >> 1] = pk2(kh2[0], kh2[1]); bhw[j >> 1] = pk2(bh2[0], bh2[1]); vw[j >> 1] = pk2(vv[j], vv[j + 1]);
                {
                    const unsigned ktw = pk2(kt2[0], kt2[1]), btw = pk2(bt2[0], bt2[1]), rbw = pk2(rb2[0], rb2[1]), aw = abw[j >> 1];
                    const int t = 8 * tq + j;
                    *(LAS bf16*)(lds + CH_AB + t * CH_LD + k * 2) = (bf16)aw; *(LAS bf16*)(lds + CH_AB + (t + 1) * CH_LD + k * 2) = (bf16)(aw >> 16);
                    *(LAS bf16*)(lds + CH_KT + t * CH_LD + k * 2) = (bf16)ktw; *(LAS bf16*)(lds + CH_KT + (t + 1) * CH_LD + k * 2) = (bf16)(ktw >> 16);
                    *(LAS bf16*)(lds + CH_BT + t * CH_LD + k * 2) = (bf16)btw; *(LAS bf16*)(lds + CH_BT + (t + 1) * CH_LD + k * 2) = (bf16)(btw >> 16);
                    *(LAS bf16*)(lds + CH_RB + t * CH_LD + k * 2) = (bf16)rbw; *(LAS bf16*)(lds + CH_RB + (t + 1) * CH_LD + k * 2) = (bf16)(rbw >> 16); }
            }
            *(LAS u32x4*)(lds + CH_ABT + k * CH_LD + tq * 16) = (u32x4){abw[0], abw[1], abw[2], abw[3]};
            *(LAS u32x4*)(lds + CH_KHT + k * CH_LD + tq * 16) = (u32x4){khw[0], khw[1], khw[2], khw[3]};
            *(LAS u32x4*)(lds + CH_BHT + k * CH_LD + tq * 16) = (u32x4){bhw[0], bhw[1], bhw[2], bhw[3]};
            *(LAS u32x4*)(lds + CH_VT + k * CH_LD + tq * 16) = (u32x4){vw[0], vw[1], vw[2], vw[3]};
            *(LAS u32x4*)(lds + CH_WT + k * CH_LD + tq * 16) = (u32x4){zq, zq, zq, zq}; *(LAS u32x4*)(lds + CH_U0 + k * CH_LD + tq * 16) = (u32x4){zq, zq, zq, zq};
            }
        }
        S1_BAR();
        for (int r1_ = 0; r1_ <= (S1_DBL & 1); ++r1_) { if (r1_) S1_BAR();
            const int mi = wave >> 1, half = wave & 1;
            const int matS = (mi & 1) ? CH_BT : CH_KT, matT = (mi & 2) ? CH_RB : CH_AB, matO = CH_LK + mi * CH_MS;
            const bool incl = (mi & 2) != 0;
            bf16x8 fs[4][2], ft[2][2];
#pragma unroll
            for (int ms = 0; ms < 4; ++ms)
#pragma unroll
                for (int ks = 0; ks < 2; ++ks) fs[ms][ks] = CH_FRAG(matS, 16 * ms + l15, ks, g);
#pragma unroll
            for (int nt = 0; nt < 2; ++nt)
#pragma unroll
                for (int ks = 0; ks < 2; ++ks) ft[nt][ks] = CH_FRAG(matT, 32 * half + 16 * nt + l15, ks, g);
#pragma unroll
            for (int nt = 0; nt < 2; ++nt) { const int t = 32 * half + 16 * nt + l15;
#pragma unroll
                for (int ms = 0; ms < 4; ++ms) { f32x4 d = (f32x4){0.f, 0.f, 0.f, 0.f};
                    d = mfma16(fs[ms][0], ft[nt][0], d); d = mfma16(fs[ms][1], ft[nt][1], d);
                    const int s0 = 16 * ms + 4 * g;
#pragma unroll
                    for (int i = 0; i < 4; ++i) { const bool keep = incl ? (s0 + i <= t) : (s0 + i < t); d[i] = keep ? d[i] : __builtin_bit_cast(float, zq); }
                    u32x2 w; w.x = pk2(d[0], d[1]); w.y = pk2(d[2], d[3]);
                    *(LAS u32x2*)(lds + matO + t * CH_LD + s0 * 2) = w; } }
        }
        S1_BAR();
        f32x4 rhsU[4];
#pragma unroll
        for (int I = 0; I < 4; ++I) rhsU[I] = (f32x4){0.f, 0.f, 0.f, 0.f};
        if (wave >= 4) {
            const int ctv = (wave & 3) * 16;
            const bf16x8 fv0 = CH_FRAG(CH_VT, ctv + l15, 0, g), fv1 = CH_FRAG(CH_VT, ctv + l15, 1, g);
#pragma unroll
            for (int I = 0; I < 4; ++I) { f32x4 d = (f32x4){0.f, 0.f, 0.f, 0.f};
                d = mfma16(CH_FRAG(CH_LK, 16 * I + l15, 0, g), fv0, d); d = mfma16(CH_FRAG(CH_LK, 16 * I + l15, 1, g), fv1, d); rhsU[I] = -d; }
        }
        for (int r2_ = 0; r2_ <= ((S1_DBL >> 1) & 1); ++r2_) if (wave == 0) {
            const int bb = lane >> 4, j = lane & 15;
            float x[16];
#pragma unroll
            for (int t = 0; t < 16; ++t) {
                const u32x4 r0 = *(const LAS u32x4*)(lds + CH_LB + (16 * bb + t) * CH_LD + 32 * bb), r1 = *(const LAS u32x4*)(lds + CH_LB + (16 * bb + t) * CH_LD + 32 * bb + 16);
                const unsigned rw[8] = {r0.x, r0.y, r0.z, r0.w, r1.x, r1.y, r1.z, r1.w};
                float acc = (t == j) ? 1.0f : 0.0f;
#pragma unroll
                for (int s = 0; s < t; ++s) { const float lv = (s & 1) ? bfhi(rw[s >> 1]) : bflo(rw[s >> 1]); acc -= lv * x[s]; }
                x[t] = acc;
                *(LAS bf16*)(lds + CH_DINV + ((bb * 16 + t) * 16 + j) * 2) = (bf16)f2bf(acc);
            }
        }
        S1_BAR();
        {
            const int matZ = wave < 4 ? CH_WT : CH_U0, ct16 = (wave & 3) * 16;
            for (int r4_ = 0; r4_ <= ((S1_DBL >> 4) & 1); ++r4_) { if (r4_) { *(LAS u32x4*)(lds + matZ + (ct16 + l15) * CH_LD + g * 32) = (u32x4){zq, zq, zq, zq}; *(LAS u32x4*)(lds + matZ + (ct16 + l15) * CH_LD + g * 32 + 16) = (u32x4){zq, zq, zq, zq}; LDS_WAIT(); }
#pragma unroll
            for (int I = 0; I < 4; ++I) {
                f32x4 rhs;
                if (wave < 4) { const u32x2 w = *(const LAS u32x2*)(lds + CH_ABT + (ct16 + l15) * CH_LD + (16 * I + 4 * g) * 2); rhs = (f32x4){bflo(w.x), bfhi(w.x), bflo(w.y), bfhi(w.y)}; }
                else rhs = rhsU[I];
                f32x4 d = (f32x4){0.f, 0.f, 0.f, 0.f};
                d = mfma16(CH_FRAG(CH_LB, 16 * I + l15, 0, g), CH_FRAG(matZ, ct16 + l15, 0, g), d); d = mfma16(CH_FRAG(CH_LB, 16 * I + l15, 1, g), CH_FRAG(matZ, ct16 + l15, 1, g), d);
                const f32x4 ac = rhs - d;
                const u32x2 dv = *(const LAS u32x2*)(lds + CH_DINV + ((I * 16 + l15) * 16 + 4 * g) * 2);
                const bf16x8 fa = as_frag((u32x4){dv.x, dv.y, zq, zq}), fb = as_frag((u32x4){pk2(ac[0], ac[1]), pk2(ac[2], ac[3]), zq, zq});
                const f32x4 z = mfma16(fa, fb, (f32x4){0.f, 0.f, 0.f, 0.f});
                u32x2 w; w.x = pk2(z[0], z[1]); w.y = pk2(z[2], z[3]);
                *(LAS u32x2*)(lds + matZ + (ct16 + l15) * CH_LD + (16 * I + 4 * g) * 2) = w;
                LDS_WAIT(); asm volatile("" ::: "memory");
            }
            }
        }
        S1_BAR();
        if (ct + G < 128 * NCHUNK) { S1_TAKE(); if (ct + 2 * G < 128 * NCHUNK) S1_LOAD(ct + 2 * G); }
        for (int r3_ = 0; r3_ <= ((S1_DBL >> 2) & 1); ++r3_) { if (r3_) S1_BAR();
            const int rt = wave >> 1, cp = (wave & 1) * 2;
            unsigned char* wsl = ws; asm volatile("" : "+s"(wsl));
            bf16* YL = (bf16*)(wsl + WS_Y); bf16* RH = (bf16*)(wsl + (rh_scratch ? WS_BETA + RF : WS_RH)); bf16* PM = (bf16*)(wsl + WS_PM); bf16* QT = (bf16*)(wsl + WS_QT);
            const int trow = scan_row(64 * c + 16 * rt + l15, dir, b);
#pragma unroll
            for (int q = 0; q < 2; ++q) { const int vt = cp + q; f32x4 d = (f32x4){0.f, 0.f, 0.f, 0.f};
#pragma unroll
                for (int ks = 0; ks < 2; ++ks) { d = mfma16(CH_FRAG(CH_VT, 16 * vt + l15, ks, g), CH_FRAG(CH_MK, 16 * rt + l15, ks, g), d); d = mfma16(CH_FRAG(CH_U0, 16 * vt + l15, ks, g), CH_FRAG(CH_MB, 16 * rt + l15, ks, g), d); }
                *(u32x2*)(YL + ((size_t)dir * T + trow) * D + h * 64 + 16 * vt + 4 * g) = pk4(d); }
#pragma unroll
            for (int q = 0; q < 2; ++q) { const int kt = cp + q; f32x4 d = (f32x4){0.f, 0.f, 0.f, 0.f};
#pragma unroll
                for (int ks = 0; ks < 2; ++ks) d = mfma16(CH_FRAG(CH_WT, 16 * kt + l15, ks, g), CH_FRAG(CH_MB, 16 * rt + l15, ks, g), d);
                const u32x2 rbw = *(const LAS u32x2*)(lds + CH_RB + (16 * rt + l15) * CH_LD + (16 * kt + 4 * g) * 2);
                u32x2 w; w.x = pk2(bflo(rbw.x) - d[0], bfhi(rbw.x) - d[1]); w.y = pk2(bflo(rbw.y) - d[2], bfhi(rbw.y) - d[3]);
                *(u32x2*)(RH + ((size_t)dir * T + trow) * D + h * 64 + 16 * kt + 4 * g) = w; }
            bf16* Pc = PM + ((size_t)c * 128 + chain) * 4096; bf16* Qc = QT + ((size_t)c * 128 + chain) * 4096;
            { const int krow = 16 * rt + l15; const float gc = gammaC[krow];
#pragma unroll
                for (int q = 0; q < 2; ++q) { const int kt = cp + q; f32x4 d = (f32x4){0.f, 0.f, 0.f, 0.f};
#pragma unroll
                    for (int ks = 0; ks < 2; ++ks) d = mfma16(CH_FRAG(CH_WT, 16 * kt + l15, ks, g), CH_FRAG(CH_BHT, krow, ks, g), d);
                    const int k0 = 16 * kt + 4 * g; f32x4 o;
#pragma unroll
                    for (int i = 0; i < 4; ++i) o[i] = ((k0 + i == krow) ? gc : 0.f) - d[i];
                    u32x2 w; w.x = pk2(o[0], o[1]); w.y = pk2(o[2], o[3]);
                    *(u32x2*)(Pc + ((rt * 2 + (kt >> 1)) * 64 + g * 16 + l15) * 8 + 4 * (kt & 1)) = w; } }
            { const int vrow = 16 * rt + l15;
#pragma unroll
                for (int q = 0; q < 2; ++q) { const int kt = cp + q; f32x4 d = (f32x4){0.f, 0.f, 0.f, 0.f};
#pragma unroll
                    for (int ks = 0; ks < 2; ++ks) { d = mfma16(CH_FRAG(CH_KHT, 16 * kt + l15, ks, g), CH_FRAG(CH_VT, vrow, ks, g), d); d = mfma16(CH_FRAG(CH_BHT, 16 * kt + l15, ks, g), CH_FRAG(CH_U0, vrow, ks, g), d); }
                    u32x2 w; w.x = pk2(d[0], d[1]); w.y = pk2(d[2], d[3]);
                    *(u32x2*)(Qc + ((rt * 2 + (kt >> 1)) * 64 + g * 16 + l15) * 8 + 4 * (kt & 1)) = w; } }
        }
        S1_BAR();
    }
}

template <int NG, int NKS>
__device__ __forceinline__ void b2_stream(const bf16* L1s, const bf16* W2s, bf16* outp, int cbase, int koff, int sub, int nsub, int l15, int g) {
    static_assert(NG * NKS == 4, "sixteen fragments");
    u32x4 wf[NG][4][NKS];
#pragma unroll
    for (int gr = 0; gr < NG; ++gr)
#pragma unroll
        for (int b = 0; b < 4; ++b)
#pragma unroll
            for (int ks = 0; ks < NKS; ++ks) wf[gr][b][ks] = *(const u32x4*)(W2s + (size_t)(cbase + 64 * gr + 16 * (l15 >> 2) + 4 * b + (l15 & 3)) * 128 + koff + 32 * ks + 8 * g);
    constexpr int NT = T / 16;
    u32x4 cf[NKS], nf[NKS];
#pragma unroll
    for (int ks = 0; ks < NKS; ++ks) { cf[ks] = *(const u32x4*)(L1s + (size_t)(sub * 16 + l15) * 128 + koff + 32 * ks + 8 * g); nf[ks] = cf[ks]; }
    for (int tile = sub; tile < NT; tile += nsub) {
        const int tn = tile + nsub < NT ? tile + nsub : tile;
#pragma unroll
        for (int ks = 0; ks < NKS; ++ks) nf[ks] = *(const u32x4*)(L1s + (size_t)(tn * 16 + l15) * 128 + koff + 32 * ks + 8 * g);
        bf16* orow = outp + (size_t)(tile * 16 + l15) * D + cbase + 16 * g;
#pragma unroll
        for (int gr = 0; gr < NG; ++gr) { unsigned w[8];
#pragma unroll
            for (int b = 0; b < 4; ++b) { f32x4 d = (f32x4){0.f, 0.f, 0.f, 0.f};
#pragma unroll
                for (int ks = 0; ks < NKS; ++ks) d = mfma16(as_frag(wf[gr][b][ks]), as_frag(cf[ks]), d);
                w[2 * b] = pk2(d[0], d[1]); w[2 * b + 1] = pk2(d[2], d[3]); }
            *(u32x4*)(orow + 64 * gr) = (u32x4){w[0], w[1], w[2], w[3]}; *(u32x4*)(orow + 64 * gr + 8) = (u32x4){w[4], w[5], w[6], w[7]}; }
#pragma unroll
        for (int ks = 0; ks < NKS; ++ks) cf[ks] = nf[ks];
    }
}
__device__ __forceinline__ void phase_b2_direct(const Args& a, int lj, int gw, int NGW, int lane) {
    unsigned char* ws = a.ws;
    const bf16* L1 = (const bf16*)(ws + WS_L1); const bf16* W2 = (const bf16*)(ws + WS_L2T) + (size_t)lj * 5120 * 128;
    const int l15 = lane & 15, g = lane >> 4;
    for (int vw = gw; vw < 2048; vw += NGW)
    if (vw < 32 * 43) { const int item = vw / 43, sub = vw - item * 43, set = item >> 3, lora = set >> 1, dirn = set & 1;
        bf16* outp = (bf16*)(ws + (lora == 0 ? WS_RAWW : WS_RAWA)) + (size_t)dirn * T * D;
        b2_stream<2, 2>(L1 + (size_t)lora * T * 128, W2 + (size_t)(lora * 2048 + dirn * 1024) * 128, outp, (item & 7) * 128, 64 * dirn, sub, 43, l15, g); }
    else { const int r = vw - 32 * 43, item = r / 42, sub = r - item * 42;
        if (item < 16) b2_stream<1, 4>(L1 + (size_t)2 * T * 128, W2 + (size_t)4096 * 128, (bf16*)(ws + WS_G), item * 64, 0, sub, 42, l15, g); }
}

struct S2Set { u32x4 p[4][2]; u32x4 q[2]; };
__device__ __forceinline__ void s2_load(S2Set& s, const bf16* Pc, const bf16* Qc, int vt, int l15, int g) {
    const int ln = g * 16 + l15;
    s.q[0] = *(const u32x4*)(Qc + ((vt * 2 + 0) * 64 + ln) * 8); s.q[1] = *(const u32x4*)(Qc + ((vt * 2 + 1) * 64 + ln) * 8);
#pragma unroll
    for (int m = 0; m < 4; ++m)
#pragma unroll
        for (int j = 0; j < 2; ++j) s.p[m][j] = *(const u32x4*)(Pc + ((m * 2 + j) * 64 + ln) * 8);
}
__device__ __forceinline__ void s2_step(f32x4 (&acc)[4], const S2Set& s, bf16* Hc, int g) {
    unsigned hw[4][2];
#pragma unroll
    for (int m = 0; m < 4; ++m) { hw[m][0] = pk2(acc[m][0], acc[m][1]); hw[m][1] = pk2(acc[m][2], acc[m][3]); }
#pragma unroll
    for (int m = 0; m < 4; ++m) *(u32x2*)(Hc + (m >> 1) * 512 + (m & 1) * 256) = (u32x2){hw[m][0], hw[m][1]};
    const bf16x8 hb0 = as_frag((u32x4){hw[0][0], hw[0][1], hw[1][0], hw[1][1]}), hb1 = as_frag((u32x4){hw[2][0], hw[2][1], hw[3][0], hw[3][1]});
#pragma unroll
    for (int m = 0; m < 4; ++m) {
        const unsigned q0 = (m & 2) ? ((m & 1) ? s.q[1].z : s.q[1].x) : ((m & 1) ? s.q[0].z : s.q[0].x), q1 = (m & 2) ? ((m & 1) ? s.q[1].w : s.q[1].y) : ((m & 1) ? s.q[0].w : s.q[0].y);
        f32x4 d = (f32x4){bflo(q0), bfhi(q0), bflo(q1), bfhi(q1)};
        d = mfma16(as_frag(s.p[m][0]), hb0, d);
        d = mfma16(as_frag(s.p[m][1]), hb1, d);
        acc[m] = d;
    }
}
__device__ __forceinline__ void phase_s2_chain(const Args& a, int wave, int lane, int G) {
    unsigned char* ws = a.ws;
    const bf16* PM = (const bf16*)(ws + WS_PM); const bf16* QT = (const bf16*)(ws + WS_QT); bf16* HT = (bf16*)(ws + WS_HT);
    const int l15 = lane & 15, g = lane >> 4;
    if (wave >= 2) return;
    static_assert(NCHUNK % 4 == 0, "S2 ring");
    for (int wt = blockIdx.x * 2 + wave; wt < 512; wt += G * 2) {
        const int chain = wt >> 2, vt = wt & 3;
        f32x4 acc[4];
#pragma unroll
        for (int m = 0; m < 4; ++m) acc[m] = (f32x4){0.f, 0.f, 0.f, 0.f};
        constexpr size_t CS = (size_t)128 * 4096;
        const bf16* Pc = PM + (size_t)chain * 4096; const bf16* Qc = QT + (size_t)chain * 4096;
        bf16* Hc = HT + (size_t)chain * 4096 + ((vt * 2) * 64 + (g >> 1) * 16 + l15) * 8 + 4 * (g & 1);
        S2Set s0, s1, s2, s3;
        s2_load(s0, Pc, Qc, vt, l15, g); s2_load(s1, Pc + CS, Qc + CS, vt, l15, g); s2_load(s2, Pc + 2 * CS, Qc + 2 * CS, vt, l15, g); s2_load(s3, Pc + 3 * CS, Qc + 3 * CS, vt, l15, g);
#pragma unroll 1
        for (int c = 0; c < NCHUNK; c += 4) {
            const int cn = c + 4 < NCHUNK ? c + 4 : c;
            const bf16* Pn = Pc + (size_t)cn * CS; const bf16* Qn = Qc + (size_t)cn * CS;
            s2_step(acc, s0, Hc + (size_t)c * CS, g);       s2_load(s0, Pn, Qn, vt, l15, g);
            s2_step(acc, s1, Hc + (size_t)(c + 1) * CS, g); s2_load(s1, Pn + CS, Qn + CS, vt, l15, g);
            s2_step(acc, s2, Hc + (size_t)(c + 2) * CS, g); s2_load(s2, Pn + 2 * CS, Qn + 2 * CS, vt, l15, g);
            s2_step(acc, s3, Hc + (size_t)(c + 3) * CS, g); s2_load(s3, Pn + 3 * CS, Qn + 3 * CS, vt, l15, g);
        }
    }
}

struct S3T { u32x2 yl[2][4]; u32x4 rh[2][2]; u32x2 vq2[4], gw2[4]; float bon0, bon1; };
__device__ __forceinline__ void s3_tile_load(S3T& s, const bf16* YL, const bf16* RH, const bf16* Vv, const bf16* Gg, const float* RKB, const float* RKB1, int row, int h, int g) {
    const size_t ro = (size_t)row * D + h * 64 + 4 * g;
#pragma unroll
    for (int dir = 0; dir < 2; ++dir) {
#pragma unroll
        for (int vt = 0; vt < 4; ++vt) s.yl[dir][vt] = *(const u32x2*)(YL + (size_t)dir * T * D + ro + 16 * vt);
        const bf16* rh = RH + ((size_t)dir * T + row) * D + h * 64 + 8 * g;
        s.rh[dir][0] = *(const u32x4*)(rh); s.rh[dir][1] = *(const u32x4*)(rh + 32); }
#pragma unroll
    for (int vt = 0; vt < 4; ++vt) { s.vq2[vt] = *(const u32x2*)(Vv + ro + 16 * vt); s.gw2[vt] = *(const u32x2*)(Gg + ro + 16 * vt); }
    s.bon0 = RKB[(size_t)row * 16 + h]; s.bon1 = RKB1[(size_t)row * 16 + h];
}
__device__ __forceinline__ void s3_tile_finish(const S3T& s, const u32x4 (&hh)[2][4][2], const LAS float* lnt, bf16* Z, int row, int h, int g) {
    const float bon = s.bon0 + s.bon1;
    f32x4 acc[4];
#pragma unroll
    for (int vt = 0; vt < 4; ++vt) acc[vt] = bf4(s.yl[0][vt]) + bf4(s.yl[1][vt]);
#pragma unroll
    for (int dir = 0; dir < 2; ++dir) {
        const bf16x8 f0 = as_frag(s.rh[dir][0]), f1 = as_frag(s.rh[dir][1]);
#pragma unroll
        for (int vt = 0; vt < 4; ++vt) { acc[vt] = mfma16(as_frag(hh[dir][vt][0]), f0, acc[vt]); acc[vt] = mfma16(as_frag(hh[dir][vt][1]), f1, acc[vt]); }
    }
    float sm = 0.f;
#pragma unroll
    for (int vt = 0; vt < 4; ++vt) sm += (acc[vt][0] + acc[vt][1]) + (acc[vt][2] + acc[vt][3]);
    sm += __shfl_xor(sm, 16); sm += __shfl_xor(sm, 32);
    const float mean = sm * (1.0f / 64.0f); float vs = 0.f;
#pragma unroll
    for (int vt = 0; vt < 4; ++vt) { acc[vt] = acc[vt] - mean; vs += (acc[vt][0] * acc[vt][0] + acc[vt][1] * acc[vt][1]) + (acc[vt][2] * acc[vt][2] + acc[vt][3] * acc[vt][3]); }
    vs += __shfl_xor(vs, 16); vs += __shfl_xor(vs, 32);
    const float rstd = rsqrtf(vs * (1.0f / 64.0f) + 64.0f * 1e-5f);
#pragma unroll
    for (int vt = 0; vt < 4; ++vt) { const size_t o = (size_t)row * D + h * 64 + 16 * vt + 4 * g;
        const int col = h * 64 + 16 * vt + 4 * g; const f32x4 zz = acc[vt] * rstd * *(const LAS f32x4*)(lnt + col) + *(const LAS f32x4*)(lnt + 1024 + col) + bf4(s.vq2[vt]) * bon;
        u32x2 w; w.x = pk2(zz[0] * bflo(s.gw2[vt].x), zz[1] * bfhi(s.gw2[vt].x)); w.y = pk2(zz[2] * bflo(s.gw2[vt].y), zz[3] * bfhi(s.gw2[vt].y));
        *(u32x2*)(Z + o) = w; }
}
__device__ __forceinline__ void phase_s3_readout(const Args& a, int lj, int nrows, LAS unsigned char* lds, int tid, int gw, int NGW, int lane) {
    unsigned char* ws = a.ws;
    const bf16* YL = (const bf16*)(ws + WS_Y); const bf16* RH = (const bf16*)(ws + WS_RH); const bf16* HT = (const bf16*)(ws + WS_HT);
    const bf16* Vv = (const bf16*)(ws + WS_RKV) + (size_t)2 * T * D; const float* RKB = (const float*)(ws + WS_RKB); const float* RKB1 = (const float*)(ws + WS_RKB1); const bf16* Gg = (const bf16*)(ws + WS_G); bf16* Z = (bf16*)(ws + WS_Z);
    const float* lng = a.in[21] + lj * 1024; const float* lnb = a.in[22] + lj * 1024;
    LAS float* lnt = (LAS float*)lds;
    ((LAS f32x4*)lnt)[tid] = tid < 256 ? ((const f32x4*)lng)[tid] : ((const f32x4*)lnb)[tid - 256];
    __syncthreads();
    const int l15 = lane & 15, g = lane >> 4, ntask = (TL / 64) * 16;
    for (int task = gw; task < ntask; task += NGW) {
        const int blk = task >> 4, h = task & 15, r0 = blk * 64;
        int b, cc[2];
        if (r0 < TL) { b = r0 >> 13; const int tb = (r0 & (SEQ - 1)) >> 6; cc[0] = 4 + tb; cc[1] = 4 + (127 - tb); }
        else { const int loc = r0 - TL; b = loc >> 8; const int tb = (loc & 255) >> 6; cc[0] = tb; cc[1] = 3 - tb; }
        S3T A, B;
        s3_tile_load(A, YL, RH, Vv, Gg, RKB, RKB1, r0 + l15, h, g);
        u32x4 hh[2][4][2];
#pragma unroll
        for (int dir = 0; dir < 2; ++dir) { const bf16* hc = HT + ((size_t)cc[dir] * 128 + (dir * 64 + b * 16 + h)) * 4096;
#pragma unroll
            for (int vt = 0; vt < 4; ++vt) { const bf16* hr = hc + ((vt * 2) * 64 + g * 16 + l15) * 8; hh[dir][vt][0] = *(const u32x4*)(hr); hh[dir][vt][1] = *(const u32x4*)(hr + 512); } }
        s3_tile_load(B, YL, RH, Vv, Gg, RKB, RKB1, r0 + 16 + l15, h, g);
        __builtin_amdgcn_sched_barrier(0);
        s3_tile_finish(A, hh, lnt, Z, r0 + l15, h, g);
        __builtin_amdgcn_sched_barrier(0);
        s3_tile_load(A, YL, RH, Vv, Gg, RKB, RKB1, r0 + 32 + l15, h, g);
        __builtin_amdgcn_sched_barrier(0);
        s3_tile_finish(B, hh, lnt, Z, r0 + 16 + l15, h, g);
        __builtin_amdgcn_sched_barrier(0);
        s3_tile_load(B, YL, RH, Vv, Gg, RKB, RKB1, r0 + 48 + l15, h, g);
        __builtin_amdgcn_sched_barrier(0);
        s3_tile_finish(A, hh, lnt, Z, r0 + 32 + l15, h, g);
        __builtin_amdgcn_sched_barrier(0);
        s3_tile_finish(B, hh, lnt, Z, r0 + 48 + l15, h, g);
    }
    if (nrows > TL) for (int c = gw; c < (TC / 16) * 16; c += NGW) {
        const int tt = c >> 4, h = c & 15, r0 = TL + tt * 16, loc = tt * 16, b = loc >> 8, tb = (loc & 255) >> 6;
        const int cc[2] = {tb, 3 - tb};
        S3T A;
        s3_tile_load(A, YL, RH, Vv, Gg, RKB, RKB1, r0 + l15, h, g);
        u32x4 hh[2][4][2];
#pragma unroll
        for (int dir = 0; dir < 2; ++dir) { const bf16* hc = HT + ((size_t)cc[dir] * 128 + (dir * 64 + b * 16 + h)) * 4096;
#pragma unroll
            for (int vt = 0; vt < 4; ++vt) { const bf16* hr = hc + ((vt * 2) * 64 + g * 16 + l15) * 8; hh[dir][vt][0] = *(const u32x4*)(hr); hh[dir][vt][1] = *(const u32x4*)(hr + 512); } }
        s3_tile_finish(A, hh, lnt, Z, r0 + l15, h, g);
    }
}
__device__ __forceinline__ void phase_cv(const Args& a, int lc, int rows, int gw, int NGW, int lane) {
    unsigned char* ws = a.ws;
    const bf16* BG = (const bf16*)(ws + WS_BG); const bf16* CU = (const bf16*)(ws + WS_CUZ); bf16* Z = (bf16*)(ws + WS_Z);
    const float* cw = a.in[25] + (size_t)lc * 3 * 1024;
    for (int t = gw; t < rows; t += NGW) {
        int rs, re; if (t < TL) { rs = t & ~63; re = rs + 63; } else { const int loc = t - TL; rs = TL + (loc & ~255); re = rs + 255; }
        const bool hp = t > rs, hn = t < re;
        u32x2 zc4[4], bg4[4], zp4[4], zn4[4]; f32x4 w04[4], w14[4], w24[4];
#pragma unroll
        for (int j = 0; j < 4; ++j) { const int col = 256 * j + 4 * lane; const size_t o = (size_t)t * D + col;
            zc4[j] = *(const u32x2*)(CU + o); bg4[j] = *(const u32x2*)(BG + o);
            zp4[j] = hp ? *(const u32x2*)(CU + o - D) : (u32x2){0u, 0u}; zn4[j] = hn ? *(const u32x2*)(CU + o + D) : (u32x2){0u, 0u};
            w04[j] = *(const f32x4*)(cw + col); w14[j] = *(const f32x4*)(cw + 1024 + col); w24[j] = *(const f32x4*)(cw + 2048 + col); }
#pragma unroll
        for (int j = 0; j < 4; ++j) { const int col = 256 * j + 4 * lane; const size_t o = (size_t)t * D + col;
            const u32x2 zc = zc4[j], bg = bg4[j], zp = zp4[j], zn = zn4[j];
            const f32x4 w0 = w04[j], w1 = w14[j], w2 = w24[j];
            const f32x4 zv = (f32x4){bflo(zc.x), bfhi(zc.x), bflo(zc.y), bfhi(zc.y)}, pv = (f32x4){bflo(zp.x), bfhi(zp.x), bflo(zp.y), bfhi(zp.y)}, nv = (f32x4){bflo(zn.x), bfhi(zn.x), bflo(zn.y), bfhi(zn.y)};
            const f32x4 bv = (f32x4){bflo(bg.x), bfhi(bg.x), bflo(bg.y), bfhi(bg.y)};
            const f32x4 r = bv * (w0 * pv + w1 * zv + w2 * nv);
            u32x2 w; w.x = pk2(r.x, r.y); w.y = pk2(r.z, r.w); *(u32x2*)(Z + o) = w; }
    }
}
typedef float f32x2v __attribute__((ext_vector_type(2)));
__device__ __forceinline__ float lane_bcast(float v, int srclane) { return __builtin_bit_cast(float, __builtin_amdgcn_readlane(__builtin_bit_cast(int, v), srclane)); }
__device__ __forceinline__ void phase_e_route(const Args& a, int layer, int rows, LAS unsigned char* lds, int tid, int gw, int NGW, int lane, int probe_rep = 0) {
    unsigned char* ws = a.ws;
    const float* xs = (const float*)(ws + (layer < 2 ? WS_XSA : WS_XSB));
    const float* MODS = (const float*)(ws + WS_MODS); bf16* H2 = (bf16*)(ws + WS_H2);
    const float* ng = a.in[6] + (size_t)(layer * 2 + 1) * 1024;
    const float* rw = a.in[27] + (size_t)layer * 1024 * 32; const float* rb = a.in[28] + layer * 32;
    unsigned* cnt = (unsigned*)(ws + WS_CTL) + CW_CNT + (layer + 4 * probe_rep) * 32 * CNT_STRIDE;
    int* SLOTL = (int*)(ws + (probe_rep ? WS_L1 : WS_SLOTL)); float* GATEL = (float*)(ws + (probe_rep ? WS_L1 + 8 * MiB : WS_GATEL));
    LAS float* wt = (LAS float*)lds;
    LAS int* hist = (LAS int*)(lds + LDSCTL_OFF + 3072); LAS int* base = hist + 32; LAS int* lcnt = hist + 64;
    int* TKE = (int*)(ws + WS_C12); float* TKG = (float*)(ws + WS_C12 + 4 * MiB);
    for (int i = tid; i < 32768; i += 512) wt[(i & 31) * 1024 + (i >> 5)] = rw[i];
    if (tid < 32) hist[tid] = 0;
    __syncthreads();
    const int my_e = lane >> 1; const float my_b = rb[my_e];
    const bool b5 = (lane & 32) != 0, b4 = (lane & 16) != 0, b3 = (lane & 8) != 0, b2 = (lane & 4) != 0, b1 = (lane & 2) != 0;
    for (int t = gw; t < rows; t += NGW) {
        const int mr = mod_row(t);
        const float* mod = MODS + (size_t)(layer * 5 + mr) * 6144;
        f32x4 x[4];
#pragma unroll
        for (int j = 0; j < 4; ++j) x[j] = *(const f32x4*)(xs + (size_t)t * D + 256 * j + 4 * lane);
        const float rstd = row_rstd(x);
#pragma unroll
        for (int j = 0; j < 4; ++j) { const int col = 256 * j + 4 * lane;
            x[j] = x[j] * rstd * *(const f32x4*)(ng + col) * (*(const f32x4*)(mod + 4 * 1024 + col) + 1.0f) + *(const f32x4*)(mod + 3 * 1024 + col);
            u32x2 w; w.x = pk2(x[j].x, x[j].y); w.y = pk2(x[j].z, x[j].w); *(u32x2*)(H2 + (size_t)t * D + col) = w; }
        float p[32];
#pragma unroll
        for (int eg = 0; eg < 8; ++eg) {
#pragma unroll
            for (int ee = 0; ee < 4; ++ee) { const int e = eg * 4 + ee; f32x2v s2 = (f32x2v){0.f, 0.f};
#pragma unroll
                for (int j = 0; j < 4; ++j) { const f32x4 wv = *(const LAS f32x4*)(wt + e * 1024 + 256 * j + 4 * lane);
                    s2 = __builtin_elementwise_fma((f32x2v){x[j].x, x[j].y}, (f32x2v){wv.x, wv.y}, s2); s2 = __builtin_elementwise_fma((f32x2v){x[j].z, x[j].w}, (f32x2v){wv.z, wv.w}, s2); }
                p[e] = s2.x + s2.y; }
            asm volatile("" ::: "memory");
        }
        float q16[16];
#pragma unroll
        for (int i = 0; i < 16; ++i) { const float send = b5 ? p[i] : p[i + 16]; const float keep = b5 ? p[i + 16] : p[i]; q16[i] = keep + __shfl_xor(send, 32); }
        float q8[8];
#pragma unroll
        for (int i = 0; i < 8; ++i) { const float send = b4 ? q16[i] : q16[i + 8]; const float keep = b4 ? q16[i + 8] : q16[i]; q8[i] = keep + __shfl_xor(send, 16); }
        float q4[4];
#pragma unroll
        for (int i = 0; i < 4; ++i) { const float send = b3 ? q8[i] : q8[i + 4]; const float keep = b3 ? q8[i + 4] : q8[i]; q4[i] = keep + __shfl_xor(send, 8); }
        float q2[2];
#pragma unroll
        for (int i = 0; i < 2; ++i) { const float send = b2 ? q4[i] : q4[i + 2]; const float keep = b2 ? q4[i + 2] : q4[i]; q2[i] = keep + __shfl_xor(send, 4); }
        float q1; { const float send = b1 ? q2[0] : q2[1]; const float keep = b1 ? q2[1] : q2[0]; q1 = keep + __shfl_xor(send, 2); }
        const float lg = q1 + __shfl_xor(q1, 1) + my_b;
        int rank = 0;
#pragma unroll 1
        for (int e = 0; e < 32; ++e) { const float o = lane_bcast(lg, 2 * e); rank += (o > lg || (o == lg && e < my_e)) ? 1 : 0; }
        const bool sel = rank < 4 && !(lane & 1);
        const unsigned long long m0 = __ballot(sel && rank == 0), m1 = __ballot(sel && rank == 1), m2 = __ballot(sel && rank == 2), m3 = __ballot(sel && rank == 3);
        const float v0 = lane_bcast(lg, (int)__builtin_ctzll(m0)), v1 = lane_bcast(lg, (int)__builtin_ctzll(m1)), v2 = lane_bcast(lg, (int)__builtin_ctzll(m2)), v3 = lane_bcast(lg, (int)__builtin_ctzll(m3));
        const float e1 = __expf(v1 - v0), e2 = __expf(v2 - v0), e3 = __expf(v3 - v0);
        const float inv = frcp(1.0f + e1 + e2 + e3);
        if (sel) {
            TKE[t * 4 + rank] = my_e; TKG[t * 4 + rank] = __expf(lg - v0) * inv;
            __hip_atomic_fetch_add(hist + my_e, 1, __ATOMIC_RELAXED, __HIP_MEMORY_SCOPE_WORKGROUP);
        }
    }
    asm volatile("s_waitcnt vmcnt(0) lgkmcnt(0)" ::: "memory"); __syncthreads();
    if (tid < 32) { base[tid] = (int)atomicAdd(cnt + tid * CNT_STRIDE, (unsigned)hist[tid]); lcnt[tid] = 0; }
    __syncthreads();
    for (int t = gw; t < rows; t += NGW) {
        if (lane < 4) { const int e = TKE[t * 4 + lane]; const float gk = TKG[t * 4 + lane];
            const int pos = base[e] + __hip_atomic_fetch_add(lcnt + e, 1, __ATOMIC_RELAXED, __HIP_MEMORY_SCOPE_WORKGROUP);
            SLOTL[(size_t)e * T + pos] = t * 4 + lane; GATEL[(size_t)e * T + pos] = gk; }
    }
}
__device__ __forceinline__ int okey(float v, int e) { const int i = __builtin_bit_cast(int, v); const int o = i ^ ((i >> 31) & 0x7fffffff); return (o & ~31) | (31 - e); }
__device__ __forceinline__ void phase_e_route_mfma(const Args& a, int layer, int rows, LAS unsigned char* lds, int tid, int wave, int gw, int NGW, int lane, int probe_rep = 0) {
    unsigned char* ws = a.ws;
    const float* xs = (const float*)(ws + (layer < 2 ? WS_XSA : WS_XSB));
    const float* MODS = (const float*)(ws + WS_MODS); bf16* H2 = (bf16*)(ws + WS_H2);
    const float* ng = a.in[6] + (size_t)(layer * 2 + 1) * 1024; const float* rb = a.in[28] + layer * 32;
    const bf16* WRT = (const bf16*)(ws + WS_WRT) + (size_t)layer * 2 * 32 * 1024;
    unsigned* cnt = (unsigned*)(ws + WS_CTL) + CW_CNT + (layer + 4 * probe_rep) * 32 * CNT_STRIDE;
    int* SLOTL = (int*)(ws + (probe_rep ? WS_L1 : WS_SLOTL)); float* GATEL = (float*)(ws + (probe_rep ? WS_L1 + 8 * MiB : WS_GATEL));
    LAS int* hist = (LAS int*)(lds + LDSCTL_OFF + 3072); LAS int* base = hist + 32; LAS int* lcnt = hist + 64;
    int* TKE = (int*)(ws + WS_C12); float* TKG = (float*)(ws + WS_C12 + 4 * MiB);
    LAS unsigned char* tile = lds + wave * 8448;
    if (tid < 32) hist[tid] = 0;
    constexpr int E_TAB = 8 * 8448, E_TP = 2064;
    static_assert(E_TAB + 32 * E_TP <= LDSCTL_OFF, "router table");
    { u32x4 tw[8];
#pragma unroll
      for (int q = 0; q < 8; ++q) { const int i = tid + q * 512, r = i >> 7, pc = i & 127; tw[q] = *(const u32x4*)(WRT + (size_t)r * 1024 + pc * 8); }
#pragma unroll
      for (int q = 0; q < 8; ++q) { const int i = tid + q * 512, r = i >> 7, pc = i & 127; *(LAS u32x4*)(lds + E_TAB + r * E_TP + pc * 16) = tw[q]; } }
    __syncthreads();
    const int l15 = lane & 15, g = lane >> 4;
    const int nlat = TL / 16, nctx = rows > TL ? TC / 4 : 0, G_ = NGW / 8;
    for (int it = 0;; ++it) {
        int t0, ntok;
        { const int tl = gw + it * NGW; const int xi = (int)blockIdx.x + (it - (nlat + NGW - 1) / NGW) * G_ * 8 + wave * G_;
          if (tl < nlat) { t0 = tl * 16; ntok = 16; } else if (it >= (nlat + NGW - 1) / NGW && xi < nctx) { t0 = TL + xi * 4; ntok = 4; } else if (it >= (nlat + NGW - 1) / NGW) break; else continue; }
        const float* mod = MODS + (size_t)(layer * 5 + mod_row(t0)) * 6144;
        float rstd[16];
#pragma unroll
        for (int tb = 0; tb < 16; tb += 8) {
            f32x4 xa[8][4];
#pragma unroll
            for (int t = 0; t < 8; ++t) { const int tr = tb + t < ntok ? t0 + tb + t : t0;
#pragma unroll
                for (int j = 0; j < 4; ++j) xa[t][j] = *(const f32x4*)(xs + (size_t)tr * D + 256 * j + 4 * lane); }
#pragma unroll
            for (int t = 0; t < 8; ++t) rstd[tb + t] = __builtin_bit_cast(float, __builtin_amdgcn_readfirstlane(__builtin_bit_cast(int, row_rstd(xa[t]))));
            asm volatile("" ::: "memory"); }
        f32x4 acc[2]; acc[0] = (f32x4){0.f, 0.f, 0.f, 0.f}; acc[1] = acc[0];
#pragma unroll 1
        for (int s = 0; s < 4; ++s) {
            const int col = 256 * s + 4 * lane;
            int t0s = t0; asm volatile("" : "+s"(t0s));
            const bf16* wl = WRT + (size_t)(32 + l15) * 1024 + 256 * s + 8 * g;
            u32x4 wlf[8][2];
#pragma unroll
            for (int ks = 0; ks < 8; ++ks)
#pragma unroll
                for (int et = 0; et < 2; ++et) wlf[ks][et] = *(const u32x4*)(wl + (size_t)et * 16 * 1024 + 32 * ks);
            const f32x4 g4 = *(const f32x4*)(ng + col) * (*(const f32x4*)(mod + 4 * 1024 + col) + 1.0f), s4 = *(const f32x4*)(mod + 3 * 1024 + col);
            u32x2 lo[16];
#pragma unroll
            for (int tb = 0; tb < 16; tb += 8) {
                f32x4 xr[8];
#pragma unroll
                for (int t = 0; t < 8; ++t) { const int tr = tb + t < ntok ? t0s + tb + t : t0s; xr[t] = *(const f32x4*)(xs + (size_t)tr * D + col); }
#pragma unroll
                for (int t = 0; t < 8; ++t) { const int tr = tb + t < ntok ? t0s + tb + t : t0s; const f32x4 hv = xr[t] * rstd[tb + t] * g4 + s4;
                    const u32x2 w = pk4(hv); if (tb + t < ntok) *(u32x2*)(H2 + (size_t)tr * D + col) = w;
                    *(LAS u32x2*)(tile + (tb + t) * 528 + lane * 8) = w; lo[tb + t] = pk4(hv - bf4(w)); } }
            LDS_WAIT(); asm volatile("" ::: "memory");
            const LAS unsigned char* th = lds + E_TAB + l15 * E_TP + (256 * s + 8 * g) * 2;
#pragma unroll
            for (int ks = 0; ks < 8; ++ks) { const bf16x8 fb = as_frag(*(const LAS u32x4*)(tile + l15 * 528 + ks * 64 + g * 16));
#pragma unroll
                for (int et = 0; et < 2; ++et) { acc[et] = mfma16(as_frag(*(const LAS u32x4*)(th + et * 16 * E_TP + 64 * ks)), fb, acc[et]);
                    acc[et] = mfma16(as_frag(wlf[ks][et]), fb, acc[et]); } }
            LDS_WAIT(); asm volatile("" ::: "memory");
#pragma unroll
            for (int t = 0; t < 16; ++t) *(LAS u32x2*)(tile + t * 528 + lane * 8) = lo[t];
            LDS_WAIT(); asm volatile("" ::: "memory");
#pragma unroll
            for (int ks = 0; ks < 8; ++ks) { const bf16x8 fb = as_frag(*(const LAS u32x4*)(tile + l15 * 528 + ks * 64 + g * 16));
#pragma unroll
                for (int et = 0; et < 2; ++et) acc[et] = mfma16(as_frag(*(const LAS u32x4*)(th + et * 16 * E_TP + 64 * ks)), fb, acc[et]); }
            LDS_WAIT(); asm volatile("" ::: "memory");
        }
        float v[8]; int key[8];
#pragma unroll
        for (int j = 0; j < 8; ++j) { const int e = (j < 4 ? 0 : 16) + 4 * g + (j & 3); v[j] = acc[j >> 2][j & 3] + rb[e]; key[j] = okey(v[j], e); }
        int kb[8], kc[8], kd2[8];
#pragma unroll
        for (int j = 0; j < 8; ++j) kb[j] = __shfl_xor(key[j], 16);
#pragma unroll
        for (int j = 0; j < 8; ++j) { kc[j] = __shfl_xor(key[j], 32); kd2[j] = __shfl_xor(kb[j], 32); }
        float vmax = fmaxf(fmaxf(fmaxf(v[0], v[1]), fmaxf(v[2], v[3])), fmaxf(fmaxf(v[4], v[5]), fmaxf(v[6], v[7])));
        vmax = fmaxf(vmax, __shfl_xor(vmax, 16)); vmax = fmaxf(vmax, __shfl_xor(vmax, 32));
        int rank[8]; float ex[8], part = 0.f;
#pragma unroll
        for (int j = 0; j < 8; ++j) { int r = 0;
#pragma unroll
            for (int q = 0; q < 8; ++q) r += (key[q] > key[j]) + (kb[q] > key[j]) + (kc[q] > key[j]) + (kd2[q] > key[j]);
            rank[j] = r; ex[j] = __expf(v[j] - vmax); part += r < 4 ? ex[j] : 0.f; }
        part += __shfl_xor(part, 16); part += __shfl_xor(part, 32);
        const float inv = frcp(part); const int t = t0 + l15;
#pragma unroll
        for (int j = 0; j < 8; ++j) if (rank[j] < 4 && l15 < ntok) { const int e = (j < 4 ? 0 : 16) + 4 * g + (j & 3);
            TKE[t * 4 + rank[j]] = e; TKG[t * 4 + rank[j]] = ex[j] * inv;
            __hip_atomic_fetch_add(hist + e, 1, __ATOMIC_RELAXED, __HIP_MEMORY_SCOPE_WORKGROUP); }
    }
    asm volatile("s_waitcnt vmcnt(0) lgkmcnt(0)" ::: "memory"); __syncthreads();
    if (tid < 32) { base[tid] = (int)atomicAdd(cnt + tid * CNT_STRIDE, (unsigned)hist[tid]); lcnt[tid] = 0; }
    __syncthreads();
    for (int it = 0;; ++it) {
        int t0, ntok;
        { const int tl = gw + it * NGW; const int xi = (int)blockIdx.x + (it - (nlat + NGW - 1) / NGW) * G_ * 8 + wave * G_;
          if (tl < nlat) { t0 = tl * 16; ntok = 16; } else if (it >= (nlat + NGW - 1) / NGW && xi < nctx) { t0 = TL + xi * 4; ntok = 4; } else if (it >= (nlat + NGW - 1) / NGW) break; else continue; }
        if ((lane >> 2) < ntok) { const int t = t0 + (lane >> 2), k = lane & 3;
            const int e = TKE[t * 4 + k]; const float gk = TKG[t * 4 + k];
            const int pos = base[e] + __hip_atomic_fetch_add(lcnt + e, 1, __ATOMIC_RELAXED, __HIP_MEMORY_SCOPE_WORKGROUP);
            SLOTL[(size_t)e * T + pos] = t * 4 + k; GATEL[(size_t)e * T + pos] = gk; }
    }
}
__device__ __forceinline__ void phase_final(const Args& a, int gw, int NGW, int lane) {
    unsigned char* ws = a.ws;
    const float* xs = (const float*)(ws + WS_XSB); const float* MODS = (const float*)(ws + WS_MODS); const bf16* YS = (const bf16*)(ws + WS_YS);
    for (int t = gw; t < TL; t += NGW) {
        const int mr = t >> 13;
        f32x4 m5[4], x[4];
#pragma unroll
        for (int j = 0; j < 4; ++j) m5[j] = *(const f32x4*)(MODS + (size_t)(3 * 5 + mr) * 6144 + 5 * 1024 + 256 * j + 4 * lane);
        f32x4 fg[4];
#pragma unroll
        for (int j = 0; j < 4; ++j) fg[j] = *(const f32x4*)(a.in[7] + 256 * j + 4 * lane);
        load_x_combined(x, xs + (size_t)t * D, true, YS, t, m5, lane);
        const float rstd = row_rstd(x);
#pragma unroll
        for (int j = 0; j < 4; ++j) { const int col = 256 * j + 4 * lane; *(f32x4*)(a.out + (size_t)t * D + col) = x[j] * rstd * fg[j]; }
    }
}

using pg8::Unit; using pg8::tile_map;
struct SchedStd {
    int G, c, nM, nN;
    __device__ __forceinline__ bool next(int i, Unit& u) const { const long L = (long)i * G + c; if (L >= (long)nM * nN) return false; int pm, pn; tile_map((int)L, nM, nN, pm, pn); u.pm = pm; u.pn = pn; u.e = 0; u.nv = pm; u.par = 0; return true; }
    __device__ __forceinline__ void a_ready(const Unit&) const {}
    __device__ __forceinline__ void done(const Unit&) const {}
    __device__ __forceinline__ unsigned row_off(const Unit&, int) const { return 0u; }
    __device__ __forceinline__ unsigned row_off_lds(const Unit&, int) const { return 0u; }
    __device__ __forceinline__ void prefetch_rows(const Unit&) const {}
};
struct SchedB1 {
    int G, c;
    __device__ __forceinline__ bool next(int i, Unit& u) const { const long L = (long)i * G + c; constexpr int n1 = 3 * NMT * 4; if (L >= n1 + 3 * NMT) return false; const int l = (int)L;
        if (l < n1) { const int j = l / (NMT * 4), r = l % (NMT * 4); int pm, pn; tile_map(r, NMT, 4, pm, pn); u.pm = j * NMT + pm; u.pn = j * 4 + pn; u.e = j; u.nv = pm; }
        else { const int r = l - n1, j = r / NMT, pm = r % NMT; u.pm = (3 + j) * NMT + pm; u.pn = 12 + j; u.e = 3 + j; u.nv = pm; }
        u.par = 0; return true; }
    __device__ __forceinline__ void a_ready(const Unit&) const {}
    __device__ __forceinline__ void done(const Unit&) const {}
    __device__ __forceinline__ unsigned row_off(const Unit&, int) const { return 0u; }
    __device__ __forceinline__ unsigned row_off_lds(const Unit&, int) const { return 0u; }
    __device__ __forceinline__ void prefetch_rows(const Unit&) const {}
};
struct SchedB2 {
    int G, c;
    __device__ __forceinline__ bool next(int i, Unit& u) const { const long L = (long)i * G + c; constexpr int n1 = 2 * NMT * 8; if (L >= n1 + NMT * 4) return false; const int l = (int)L;
        if (l < n1) { const int j = l / (NMT * 8), r = l % (NMT * 8); int pm, pn; tile_map(r, NMT, 8, pm, pn); u.pm = j * NMT + pm; u.pn = j * 8 + pn; u.e = j; u.nv = pm; }
        else { const int r = l - n1; int pm, pn; tile_map(r, NMT, 4, pm, pn); u.pm = 2 * NMT + pm; u.pn = 16 + pn; u.e = 2; u.nv = pm; }
        u.par = 0; return true; }
    __device__ __forceinline__ void a_ready(const Unit&) const {}
    __device__ __forceinline__ void done(const Unit&) const {}
    __device__ __forceinline__ unsigned row_off(const Unit&, int) const { return 0u; }
    __device__ __forceinline__ unsigned row_off_lds(const Unit&, int) const { return 0u; }
    __device__ __forceinline__ void prefetch_rows(const Unit&) const {}
};
struct SchedMoe {
    int G, c, nnt, ntiles, P; LAS unsigned char* lds; const int* slotl; const float* gatel; int wave;
    __device__ __forceinline__ bool next(int i, Unit& u) const { const long L = (long)i * G + c; const int ntp = (ntiles + P - 1) / P, ppg = nnt / (8 / P); if (L >= (long)ntp * ppg * 8) return false;
        const LAS int* tpre = (const LAS int*)(lds + LDSCTL_OFF + 64); const LAS int* ecnt = (const LAS int*)(lds + LDSCTL_OFF + 256); const LAS unsigned short* tile_e = (const LAS unsigned short*)(lds + LDSCTL_OFF + 512);
        const int xq = (int)(L >> 3), x8 = (int)(L & 7); int tile = (xq / ppg) * P + (x8 % P); const int pnl = (x8 / P) * ppg + xq % ppg; const bool dead = tile >= ntiles; tile = dead ? 0 : tile;
        const int e = __builtin_amdgcn_readfirstlane((int)tile_e[tile]), r0 = (tile - __builtin_amdgcn_readfirstlane(tpre[e])) * 256; int nv = __builtin_amdgcn_readfirstlane(ecnt[e]) - r0; nv = nv > 256 ? 256 : nv; nv = dead ? 0 : nv;
        u.pm = dead ? MAXTILES : tile; u.pn = e * nnt + pnl; u.e = e; u.nv = nv | (r0 << 9); u.par = i & 1; return true; }
    __device__ __forceinline__ void a_ready(const Unit& u) const {
        if (gatel != nullptr && wave == 0) { const size_t li = (size_t)u.e * T + (u.nv >> 9) + 4 * lane_id();
            __builtin_amdgcn_global_load_lds((const unsigned*)(slotl + li), (LAS unsigned*)(lds + LDSCTL_OFF + 8192 + 2048 * u.par), 16, 0, 0);
            __builtin_amdgcn_global_load_lds((const unsigned*)(gatel + li), (LAS unsigned*)(lds + LDSCTL_OFF + 8192 + 2048 * u.par + 1024), 16, 0, 0); } }
    __device__ __forceinline__ void done(const Unit&) const {}
    __device__ __forceinline__ void prefetch_rows(const Unit& u) const {
        if (wave == 0) __builtin_amdgcn_global_load_lds((const unsigned*)(slotl + (size_t)u.e * T + (u.nv >> 9) + 4 * lane_id()), (LAS unsigned*)(lds + LDSCTL_OFF + 8192 + 2048 * u.par), 16, 0, 0); }
    __device__ __forceinline__ unsigned row_off_lds(const Unit& u, int r) const { const int nv = u.nv & 511; const int sl = ((const LAS int*)(lds + LDSCTL_OFF + 8192 + 2048 * u.par))[r]; const int tok = r < nv ? (sl >> 2) : 0; return (unsigned)tok * 2048u; }
    __device__ __forceinline__ unsigned row_off(const Unit& u, int r) const { const int nv = u.nv & 511, r0 = u.nv >> 9; const int tok = r < nv ? (slotl[(size_t)u.e * T + r0 + r] >> 2) : 0; return (unsigned)tok * 2048u; }
};

using pg8::cvt_pk_bf16;
template <class P> __device__ __forceinline__ P* pin_ptr(P* p) { asm volatile("" : "+v"(p)); return p; }
struct EpiB1 {
    static constexpr bool PERM = true, AFTER_DRAIN = false;
    bf16* RKV; bf16* L1;
    __device__ __forceinline__ void operator()(const f32x4 (&acc)[2][2][4][2], const Unit& u, int wr, int wc, int fr, int fq) const {
        const int seg = u.e, row0 = u.nv * 256 + wr * 64 + fr;
        const int jj = seg - 3, ld = seg < 3 ? D : 128, col0 = (seg < 3 ? (u.pn - seg * 4) * 256 : 0) + wc * 32 + 8 * fq;
        bf16* base = seg < 3 ? RKV + (size_t)seg * T * D : L1 + (size_t)jj * T * 128;
#pragma unroll
        for (int ai = 0; ai < 2; ++ai)
#pragma unroll
            for (int m = 0; m < 4; ++m) { bf16* rowp = base + (size_t)(row0 + ai * 128 + m * 16) * ld + col0;
#pragma unroll
                for (int bj = 0; bj < 2; ++bj) { if (seg >= 3 && bj == 1) continue; f32x4 v0 = acc[ai][bj][m][0], v1 = acc[ai][bj][m][1];
                    if (jj == 0) {
#pragma unroll
                        for (int q = 0; q < 4; ++q) { v0[q] = tanh_fast(v0[q]); v1[q] = tanh_fast(v1[q]); } }
                    else if (jj == 2) {
#pragma unroll
                        for (int q = 0; q < 4; ++q) { v0[q] = sigm(v0[q]); v1[q] = sigm(v1[q]); } }
                    u32x4 w; w.x = cvt_pk_bf16(v0[0], v0[1]); w.y = cvt_pk_bf16(v0[2], v0[3]); w.z = cvt_pk_bf16(v1[0], v1[1]); w.w = cvt_pk_bf16(v1[2], v1[3]);
                    *(u32x4*)(rowp + bj * 128) = w; } }
    }
};
struct EpiB2 {
    static constexpr bool PERM = true, AFTER_DRAIN = false;
    bf16* RW; bf16* RA; bf16* Gg;
    __device__ __forceinline__ void operator()(const f32x4 (&acc)[2][2][4][2], const Unit& u, int wr, int wc, int fr, int fq) const {
        const int jj = u.e, row0 = u.nv * 256 + wr * 64 + fr, pnl = u.pn - jj * 8;
        const int dirn = jj < 2 ? (pnl >> 2) : 0, col0 = (jj < 2 ? (pnl & 3) : pnl) * 256 + wc * 32 + 8 * fq;
        bf16* base = (jj == 0 ? RW : jj == 1 ? RA : Gg) + (size_t)dirn * T * D;
#pragma unroll
        for (int ai = 0; ai < 2; ++ai)
#pragma unroll
            for (int m = 0; m < 4; ++m) { bf16* rowp = base + (size_t)(row0 + ai * 128 + m * 16) * D + col0;
#pragma unroll
                for (int bj = 0; bj < 2; ++bj) { const f32x4 v0 = acc[ai][bj][m][0], v1 = acc[ai][bj][m][1];
                    u32x4 w; w.x = cvt_pk_bf16(v0[0], v0[1]); w.y = cvt_pk_bf16(v0[2], v0[3]); w.z = cvt_pk_bf16(v1[0], v1[1]); w.w = cvt_pk_bf16(v1[2], v1[3]);
                    *(u32x4*)(rowp + bj * 128) = w; } }
    }
};
struct EpiRes {
    static constexpr bool PERM = true, AFTER_DRAIN = false;
    float* X; const float* gate; float* Xo;
    __device__ __forceinline__ void operator()(const f32x4 (&acc)[2][2][4][2], const Unit& u, int wr, int wc, int fr, int fq) const {
        const int row0 = u.pm * 256 + wr * 64 + fr, col0 = u.pn * 256 + wc * 32 + 8 * fq, mr = u.pm < NMT_L ? (u.pm >> 5) : 4;
        const float* gp = pin_ptr(gate + (size_t)mr * 6144 + col0);
        f32x4 gv[2][2];
#pragma unroll
        for (int bj = 0; bj < 2; ++bj)
#pragma unroll
            for (int n = 0; n < 2; ++n) gv[bj][n] = *(const f32x4*)(gp + bj * 128 + 4 * n);
        f32x4 xa[2][2][2], xb[2][2][2];
#define ER_LOAD(dst, b_) do { _Pragma("unroll") for (int m = 0; m < 2; ++m) _Pragma("unroll") for (int bj = 0; bj < 2; ++bj) _Pragma("unroll") for (int n = 0; n < 2; ++n) \
            dst[m][bj][n] = *(const f32x4*)(X + (size_t)(row0 + ((b_) >> 1) * 128 + (((b_) & 1) * 2 + m) * 16) * D + col0 + bj * 128 + 4 * n); } while (0)
#define ER_STORE(src, b_) do { _Pragma("unroll") for (int m = 0; m < 2; ++m) _Pragma("unroll") for (int bj = 0; bj < 2; ++bj) _Pragma("unroll") for (int n = 0; n < 2; ++n) \
            *(f32x4*)(Xo + (size_t)(row0 + ((b_) >> 1) * 128 + (((b_) & 1) * 2 + m) * 16) * D + col0 + bj * 128 + 4 * n) = src[m][bj][n] + gv[bj][n] * acc[(b_) >> 1][bj][((b_) & 1) * 2 + m][n]; } while (0)
        ER_LOAD(xa, 0); ER_LOAD(xb, 1); ER_STORE(xa, 0); ER_LOAD(xa, 2); ER_STORE(xb, 1); ER_LOAD(xb, 3); ER_STORE(xa, 2); ER_STORE(xb, 3);
#undef ER_LOAD
#undef ER_STORE
    }
};
struct EpiWin {
    static constexpr bool PERM = true, AFTER_DRAIN = false;
    bf16* BG; bf16* CU;
    __device__ __forceinline__ void operator()(const f32x4 (&acc)[2][2][4][2], const Unit& u, int wr, int wc, int fr, int fq) const {
        const int row0 = u.pm * 256 + wr * 64 + fr;
        if (u.pn < 4) {
            const int col0 = u.pn * 256 + wc * 32 + 8 * fq;
#pragma unroll
            for (int ai = 0; ai < 2; ++ai)
#pragma unroll
                for (int m = 0; m < 4; ++m) { bf16* rowp = BG + (size_t)(row0 + ai * 128 + m * 16) * D + col0;
#pragma unroll
                    for (int bj = 0; bj < 2; ++bj) { const f32x4 v0 = acc[ai][bj][m][0], v1 = acc[ai][bj][m][1];
                        u32x4 w; w.x = cvt_pk_bf16(v0[0], v0[1]); w.y = cvt_pk_bf16(v0[2], v0[3]); w.z = cvt_pk_bf16(v1[0], v1[1]); w.w = cvt_pk_bf16(v1[2], v1[3]);
                        *(u32x4*)(rowp + bj * 128) = w; } }
        } else {
            const int f0 = (u.pn - 4) * 128 + wc * 32 + 8 * fq;
#pragma unroll
            for (int ai = 0; ai < 2; ++ai)
#pragma unroll
                for (int m = 0; m < 4; ++m) { const f32x4 v0 = acc[ai][0][m][0] * acc[ai][1][m][0], v1 = acc[ai][0][m][1] * acc[ai][1][m][1];
                    u32x4 w; w.x = cvt_pk_bf16(v0[0], v0[1]); w.y = cvt_pk_bf16(v0[2], v0[3]); w.z = cvt_pk_bf16(v1[0], v1[1]); w.w = cvt_pk_bf16(v1[2], v1[3]);
                    *(u32x4*)(CU + (size_t)(row0 + ai * 128 + m * 16) * D + f0) = w; }
        }
    }
};
struct EpiGU {
    static constexpr bool PERM = true, AFTER_DRAIN = false;
    bf16* INTER; const float* bgu;
    __device__ __forceinline__ void operator()(const f32x4 (&acc)[2][2][4][2], const Unit& u, int wr, int wc, int fr, int fq) const {
        const int e = u.e, pnl = u.pn - e * 8, row0 = u.pm * 256 + wr * 64 + fr, f0 = pnl * 128 + wc * 32 + 8 * fq;
        typedef const __attribute__((address_space(1))) f32x4* GF4;
        const GF4 bp = (GF4)pin_ptr(bgu + (size_t)e * 2048 + f0);
        f32x4 bg[2], bu[2];
#pragma unroll
        for (int n = 0; n < 2; ++n) { bg[n] = bp[n]; bu[n] = bp[256 + n] + 1.0f; }
#pragma unroll
        for (int ai = 0; ai < 2; ++ai)
#pragma unroll
            for (int m = 0; m < 4; ++m) { f32x4 o[2];
#pragma unroll
                for (int n = 0; n < 2; ++n) { const f32x4 g = acc[ai][0][m][n] + bg[n], uu = acc[ai][1][m][n] + bu[n];
#pragma unroll
                    for (int q = 0; q < 4; ++q) { const float gc = fminf(g[q], 7.0f), uc1 = fminf(fmaxf(uu[q], -6.0f), 8.0f);
                        o[n][q] = uc1 * gc * frcp(1.0f + __builtin_amdgcn_exp2f(gc * (-1.702f * 1.44269504f))); } }
                u32x4 w; w.x = cvt_pk_bf16(o[0][0], o[0][1]); w.y = cvt_pk_bf16(o[0][2], o[0][3]); w.z = cvt_pk_bf16(o[1][0], o[1][1]); w.w = cvt_pk_bf16(o[1][2], o[1][3]);
                *(u32x4*)(INTER + (size_t)(row0 + ai * 128 + m * 16) * 1024 + f0) = w; }
    }
};
struct EpiDown {
    static constexpr bool PERM = true, AFTER_DRAIN = false;
    bf16* YS; const float* bdn; LAS unsigned char* lds;
    __device__ __forceinline__ void operator()(const f32x4 (&acc)[2][2][4][2], const Unit& u, int wr, int wc, int fr, int fq) const {
        const int e = u.e, pnl = u.pn - e * 4, col0 = pnl * 256 + wc * 32 + 8 * fq, nv = u.nv & 511;
        typedef const __attribute__((address_space(1))) f32x4* GF4;
        const GF4 bp = (GF4)pin_ptr(bdn + (size_t)e * 1024 + col0);
        f32x4 bv[2][2];
#pragma unroll
        for (int bj = 0; bj < 2; ++bj)
#pragma unroll
            for (int n = 0; n < 2; ++n) bv[bj][n] = bp[bj * 32 + n];
        const LAS int* sl = (const LAS int*)(lds + LDSCTL_OFF + 8192 + 2048 * u.par);
        int slot8[2][4]; float gt8[2][4];
#pragma unroll
        for (int ai = 0; ai < 2; ++ai)
#pragma unroll
            for (int m = 0; m < 4; ++m) { const int r = ai * 128 + wr * 64 + m * 16 + fr; slot8[ai][m] = sl[r]; gt8[ai][m] = ((const LAS float*)(sl + 256))[r]; }
#pragma unroll
        for (int ai = 0; ai < 2; ++ai) asm volatile("" : "+v"(slot8[ai][0]), "+v"(slot8[ai][1]), "+v"(slot8[ai][2]), "+v"(slot8[ai][3]), "+v"(gt8[ai][0]), "+v"(gt8[ai][1]), "+v"(gt8[ai][2]), "+v"(gt8[ai][3]));
        asm volatile("" : "+v"(bv[0][0]), "+v"(bv[0][1]), "+v"(bv[1][0]), "+v"(bv[1][1]));
#pragma unroll
        for (int ai = 0; ai < 2; ++ai)
#pragma unroll
            for (int m = 0; m < 4; ++m) { const int r = ai * 128 + wr * 64 + m * 16 + fr;
                if (r < nv) { const int slot = slot8[ai][m]; const float gt = gt8[ai][m];
                    bf16* rowp = YS + (size_t)slot * 1024 + col0;
#pragma unroll
                    for (int bj = 0; bj < 2; ++bj) { const f32x4 v0 = (acc[ai][bj][m][0] + bv[bj][0]) * gt, v1 = (acc[ai][bj][m][1] + bv[bj][1]) * gt;
                        u32x4 w; w.x = cvt_pk_bf16(v0[0], v0[1]); w.y = cvt_pk_bf16(v0[2], v0[3]); w.z = cvt_pk_bf16(v1[0], v1[1]); w.w = cvt_pk_bf16(v1[2], v1[3]);
                        *(u32x4*)(rowp + bj * 128) = w; } } }
    }
};

__device__ __forceinline__ int moe_tables(const unsigned* cnt, LAS unsigned char* lds, int tid) {
    LAS int* tpre = (LAS int*)(lds + LDSCTL_OFF + 64); LAS int* ecnt = (LAS int*)(lds + LDSCTL_OFF + 256); LAS unsigned short* tile_e = (LAS unsigned short*)(lds + LDSCTL_OFF + 512);
    if (tid < 64) { const int e = tid & 31;
        const int cn = tid < 32 ? (int)__hip_atomic_load(cnt + e * CNT_STRIDE, __ATOMIC_RELAXED, __HIP_MEMORY_SCOPE_AGENT) : 0;
        const int tl = (cn + 255) >> 8; int incl = tl;
#pragma unroll
        for (int d = 1; d < 32; d <<= 1) { const int o = __shfl_up(incl, d); if (tid >= d) incl += o; }
        if (tid < 32) { ecnt[e] = cn; tpre[e] = incl - tl; }
        if (tid == 31) tpre[32] = incl; }
    __syncthreads();
    const int nt = tpre[32];
    { const int e = tid >> 4, sub = tid & 15, t1 = tpre[e + 1]; for (int t = tpre[e] + sub; t < t1; t += 16) tile_e[t] = (unsigned short)e; }
    __syncthreads();
    return nt;
}

constexpr int NPHASES = 37;
typedef const Args __attribute__((address_space(4))) CArgs;
__global__ void __attribute__((amdgpu_flat_work_group_size(512, 512), amdgpu_waves_per_eu(2, 2))) fwd_kernel(Args a_) {
    extern __shared__ __attribute__((aligned(16))) unsigned char lds_raw[];
    LAS unsigned char* lds = (LAS unsigned char*)lds_raw;
    const int G = gridDim.x, NGW = G * 8;
    CArgs* ap0 = (CArgs*)__builtin_amdgcn_kernarg_segment_ptr();
    if (threadIdx.x < 4) ((LAS unsigned*)(lds + LDSCTL_OFF))[threadIdx.x] = 0u;
    __syncthreads();
    XcdBarrier bar = xcd_barrier_post((unsigned*)(a_.ws + WS_CTL) + CW_BAR, (volatile LAS unsigned*)(lds + LDSCTL_OFF));
    const int lo = a_.ph_lo, hi = a_.ph_hi;
    int ph = 0;
#ifndef MK_ONLY
#define MK_ONLY -1
#endif
#ifndef MK_DBL
#define MK_DBL 0
#endif
#ifdef MK_MARK
#define PH_MARK(s) asm volatile("; ##" s)
#else
#define PH_MARK(s)
#endif
#define PH_BEGIN(id) if ((MK_ONLY < 0 || MK_ONLY == (id)) && ph >= lo && ph < hi) { for (int rep_ = 0; rep_ <= ((MK_DBL >> (id)) & 1); ++rep_) { PH_MARK("PH_BEGIN"); CArgs* ap = ap0; asm volatile("" : "+s"(ap)); const Args a = *(const Args*)ap; unsigned char* const ws = a.ws; (void)ws; const int wave = (int)bar.wv; int tid = wave * 64 + lane_id(); asm volatile("" : "+v"(tid)); const int lane = tid & 63, gw = blockIdx.x * 8 + wave; (void)lane; (void)gw;
#define PH_END PH_MARK("PH_END"); } } if (ph >= lo && ph + 1 < hi) xcd_barrier(bar); ++ph;

    PH_BEGIN(0) p0_prologue(a, lds, tid, lane, wave, G); PH_END

#pragma unroll 1
    for (int layer = 0; layer < DEPTH; ++layer) {
        const int kind = layer & 1, lj = layer >> 1;
        const int rows = layer == 3 ? TL : T, nmt = rows / 256;
        const int rows_moe = layer < 2 ? T : TL;
        if (kind == 0) {
            PH_BEGIN(1) phase_a_rwkv(a, layer, lds, tid, gw, NGW, lane); PH_END
            PH_BEGIN(2) {
                pg8::Gemm g{(const bf16*)(ws + WS_XL), (const bf16*)(ws + WS_WRKV) + (size_t)lj * 3840 * 1024, 6 * T, 3840, 1024};
                SchedB1 S{G, (int)blockIdx.x}; EpiB1 E{(bf16*)(ws + WS_RKV), (bf16*)(ws + WS_L1)};
                pg8::gemm_phase<EpiB1, SchedB1, true, true, false>(lds, g, S, E, tid); } PH_END
            PH_BEGIN(3) phase_b2_direct(a, lj, gw, NGW, lane); PH_END
            PH_BEGIN(5) phase_s1_chunks(a, lj, lds, tid, G, (MK_DBL >> 5) & 1 & (rep_ == 0)); PH_END
            PH_BEGIN(15) phase_s2_chain(a, wave, lane, G); PH_END
            PH_BEGIN(6) phase_s3_readout(a, lj, layer == 2 ? TL : T, lds, tid, gw, NGW, lane); PH_END
        } else {
            PH_BEGIN(7) phase_a_conv(a, layer, rows, gw, NGW, lane); PH_END
            PH_BEGIN(8) {
                pg8::Gemm g{(const bf16*)(ws + WS_XL), (const bf16*)(ws + WS_WIN) + (size_t)lj * 3072 * 1024, rows, 3072, 1024};
                SchedStd S{G, (int)blockIdx.x, nmt, 12}; EpiWin E{(bf16*)(ws + WS_BG), (bf16*)(ws + WS_CUZ)};
                pg8::gemm_phase<EpiWin, SchedStd, true, true, false>(lds, g, S, E, tid); } PH_END
            PH_BEGIN(9) phase_cv(a, lj, rows, gw, NGW, lane); PH_END
        }
        PH_BEGIN(10) {
            const bf16* Wt = kind == 0 ? (const bf16*)(ws + WS_WO) + (size_t)lj * 1024 * 1024 : (const bf16*)(ws + WS_WOUT) + (size_t)lj * 1024 * 1024;
            pg8::Gemm g{(const bf16*)(ws + WS_Z), Wt, rows, 1024, 1024};
            SchedStd S{G, (int)blockIdx.x, layer == 2 ? NMT_L : nmt, 4}; EpiRes E{(float*)(ws + (layer < 2 ? WS_XSA : WS_XSB)), (const float*)(ws + WS_MODS) + (size_t)layer * 5 * 6144 + 2 * 1024, (float*)(ws + (rep_ ? WS_XL : (layer < 2 ? WS_XSA : WS_XSB)))};
            pg8::gemm_phase<EpiRes, SchedStd, true, true, false>(lds, g, S, E, tid); } PH_END
        PH_BEGIN(11) phase_e_route_mfma(a, layer, rows_moe, lds, tid, wave, gw, NGW, lane, rep_); PH_END
        PH_BEGIN(12) {
            const int nt = __builtin_amdgcn_readfirstlane(moe_tables((const unsigned*)(ws + WS_CTL) + CW_CNT + layer * 32 * CNT_STRIDE, lds, tid));
            pg8::Gemm g{(const bf16*)(ws + WS_H2), (const bf16*)(ws + WS_WGU) + (size_t)layer * 32 * 2048 * 1024, 0, 0, 1024};
            SchedMoe S{G, (int)blockIdx.x, 8, nt, 2, lds, (const int*)(ws + WS_SLOTL), nullptr, wave};
            EpiGU E{(bf16*)(ws + WS_INTER), a.in[30] + (size_t)layer * 32 * 2048};
            pg8::gemm_phase<EpiGU, SchedMoe, true, true, true>(lds, g, S, E, tid); } PH_END
        PH_BEGIN(13) {
            const int nt = __builtin_amdgcn_readfirstlane(moe_tables((const unsigned*)(ws + WS_CTL) + CW_CNT + layer * 32 * CNT_STRIDE, lds, tid));
            pg8::Gemm g{(const bf16*)(ws + WS_INTER), (const bf16*)(ws + WS_WDN) + (size_t)layer * 32 * 1024 * 1024, 0, 0, 1024};
            SchedMoe S{G, (int)blockIdx.x, 4, nt, 8, lds, (const int*)(ws + WS_SLOTL), (const float*)(ws + WS_GATEL), wave};
            EpiDown E{(bf16*)(ws + WS_YS), a.in[32] + (size_t)layer * 32 * 1024, lds};
            pg8::gemm_phase<EpiDown, SchedMoe, true, true, false>(lds, g, S, E, tid); } PH_END
    }
    PH_BEGIN(14) phase_final(a, gw, NGW, lane); PH_END
#undef PH_BEGIN
#undef PH_END
}

extern "C" void kernel_launch(void* const* d_in, const int* in_sizes, int n_in, void* d_out, int out_size, void* d_ws, size_t ws_size, hipStream_t stream) {
    static int grid = 0;
    if (grid == 0) {
        if (n_in != 33 || in_sizes[0] != TL * D || out_size != TL * D || ws_size < WS_END) { fprintf(stderr, "kernel_launch: unexpected problem (n_in %d, in0 %d, out %d, ws %zu < %zu)\n", n_in, n_in > 0 ? in_sizes[0] : -1, out_size, ws_size, (size_t)WS_END); grid = -1; return; }
        int dev = 0, cus = 0, per_cu = 0;
        if (hipGetDevice(&dev) != hipSuccess || hipDeviceGetAttribute(&cus, hipDeviceAttributeMultiprocessorCount, dev) != hipSuccess) { grid = -1; return; }
        if (hipFuncSetAttribute((const void*)fwd_kernel, hipFuncAttributeMaxDynamicSharedMemorySize, LDS_BYTES) != hipSuccess) { fprintf(stderr, "kernel_launch: hipFuncSetAttribute failed\n"); grid = -1; return; }
        if (hipOccupancyMaxActiveBlocksPerMultiprocessor(&per_cu, (const void*)fwd_kernel, 512, LDS_BYTES) != hipSuccess || per_cu < 1) fprintf(stderr, "kernel_launch: occupancy query says %d\n", per_cu);
        (void)hipGetLastError();
        grid = cus;
    }
    if (grid < 0) return;
    if (hipMemsetAsync((char*)d_ws + WS_CTL, 0, CTL_ZERO_BYTES, stream) != hipSuccess) return;
    Args a{};
    for (int i = 0; i < 33; ++i) a.in[i] = (const float*)d_in[i];
    a.out = (float*)d_out; a.ws = (unsigned char*)d_ws;
#if MK_PER_PHASE
    for (int p = 0; p < NPHASES; ++p) { a.ph_lo = p; a.ph_hi = p + 1; hipLaunchKernelGGL(fwd_kernel, dim3(grid), dim3(512), LDS_BYTES, stream, a); }
#else
    a.ph_lo = 0; a.ph_hi = NPHASES;
    hipLaunchKernelGGL(fwd_kernel, dim3(grid), dim3(512), LDS_BYTES, stream, a);
#endif
    const hipError_t le = hipPeekAtLastError();
    if (le != hipSuccess) fprintf(stderr, "kernel_launch: launch failed: %s\n", hipGetErrorName(le));
}
```
